# Optimizing an MI355X kernel written in HIP

```python
import math
import jax, jax.numpy as jnp
from jax import lax
import numpy as np

D_MODEL = 1024
BATCH = 4
SEQ = 8192
DEPTH = 1

GRID_W = 64
CTX_LEN = 256
HEAD_DIM = 64
A_HEADS = 4
R_HEADS = 4
R_DK = 64
R_DV = 128
A_QK = A_HEADS * 2 * HEAD_DIM
A_V = A_HEADS * 2 * HEAD_DIM
R_QK = R_HEADS * R_DK
R_V = R_HEADS * R_DV
D_IN = 2 * A_QK + A_V + 2 * R_QK + 2 * R_V
D_MIX = A_V + R_V
Q_BLOCK = 128
RET_CHUNK = 128
ROPE_BASE = 10000.0
N_EXPERTS = 64
N_GROUPS = 8
TOPK_GROUPS = 4
TOP_K = 8
D_EXPERT = D_MODEL // 4
D_SHARED = D_MODEL // 4
ROUTED_SCALE = 2.5
MOE_BLOCK = 128
NORM_EPS = 1e-6

kernel_name = "hybrid_diffattn_retention_moe_dit_layer"


def rmsnorm(x, g):
    xf = x.astype(jnp.float32)
    y = xf * lax.rsqrt(jnp.mean(xf * xf, axis=-1, keepdims=True) + NORM_EPS)
    return (y * g.astype(jnp.float32)).astype(x.dtype)


def modulate(h, shift, scale):
    return h * (1 + scale[:, None]) + shift[:, None]


def axial_rope_tables(n_tokens):
    n_rows = n_tokens // GRID_W
    rows = jnp.broadcast_to(jnp.arange(n_rows, dtype=jnp.float32)[:, None], (n_rows, GRID_W)).reshape(-1)
    cols = jnp.broadcast_to(jnp.arange(GRID_W, dtype=jnp.float32)[None, :], (n_rows, GRID_W)).reshape(-1)
    n_freq = HEAD_DIM // 4
    inv_freq = ROPE_BASE ** (-jnp.arange(n_freq, dtype=jnp.float32) / n_freq)
    ang = jnp.stack([rows[:, None] * inv_freq, cols[:, None] * inv_freq], axis=1)
    return jnp.cos(ang), jnp.sin(ang)


def apply_axial_rope(x, cos, sin):
    n_freq = HEAD_DIM // 4
    xr = x.reshape(x.shape[:-1] + (2, 2, n_freq)).astype(jnp.float32)
    shp = (cos.shape[0],) + (1,) * (x.ndim - 3) + (2, n_freq)
    c = cos.reshape(shp)
    s = sin.reshape(shp)
    x1, x2 = xr[..., 0, :], xr[..., 1, :]
    out = jnp.stack([x1 * c - x2 * s, x1 * s + x2 * c], axis=-2)
    return out.reshape(x.shape).astype(x.dtype)


def project_heads(h, w_in):
    bn, t, _ = h.shape
    p = h @ w_in
    sizes = (A_QK, A_QK, A_V, R_QK, R_QK, R_V, R_V)
    cuts = [sum(sizes[:i + 1]) for i in range(len(sizes) - 1)]
    dq, dk, dv, rq, rk, rv, rg = jnp.split(p, cuts, axis=-1)
    return (dq.reshape(bn, t, A_HEADS, 2, HEAD_DIM),
            dk.reshape(bn, t, A_HEADS, 2, HEAD_DIM),
            dv.reshape(bn, t, A_HEADS, 2 * HEAD_DIM),
            rq.reshape(bn, t, R_HEADS, R_DK),
            rk.reshape(bn, t, R_HEADS, R_DK),
            rv.reshape(bn, t, R_HEADS, R_DV),
            rg)


def diff_attend(q, k, v, lam):
    s = jnp.einsum('bqhmd,bkhmd->bhmqk', q, k).astype(jnp.float32)
    p = jax.nn.softmax(s, axis=-1)
    a = p[:, :, 0] - lam * p[:, :, 1]
    return jnp.einsum('bhqk,bkhe->bqhe', a.astype(v.dtype), v)


def retention_chunked(q, k, v, log_gamma, state0):
    b, t, h, dk = q.shape
    dv = v.shape[-1]
    n = t // RET_CHUNK
    f32 = jnp.float32
    qc = q.astype(f32).reshape(b, n, RET_CHUNK, h, dk)
    kc = k.astype(f32).reshape(b, n, RET_CHUNK, h, dk)
    vc = v.astype(f32).reshape(b, n, RET_CHUNK, h, dv)
    lg = log_gamma.astype(f32)
    pos = jnp.arange(RET_CHUNK, dtype=f32)
    rel = pos[:, None] - pos[None, :]
    decay = jnp.where(rel[None] >= 0, jnp.exp(jnp.maximum(rel, 0.0)[None] * lg[:, None, None]), 0.0)
    scores = jnp.einsum('bnihd,bnjhd->bnhij', qc, kc) * decay
    intra = jnp.einsum('bnhij,bnjhe->bnihe', scores, vc)
    k_dec = kc * jnp.exp((RET_CHUNK - 1 - pos)[:, None] * lg)[:, :, None]
    chunk_kv = jnp.einsum('bnjhd,bnjhe->nbhde', k_dec, vc)
    g_chunk = jnp.exp(RET_CHUNK * lg)[None, :, None, None]

    def step(s, kv_i):
        return g_chunk * s + kv_i, s

    state_final, state_prev = lax.scan(step, state0.astype(f32), chunk_kv)
    q_dec = qc * jnp.exp((pos + 1)[:, None] * lg)[:, :, None]
    cross = jnp.einsum('bnihd,nbhde->bnihe', q_dec, state_prev)
    out = (intra + cross).reshape(b, t, h, dv)
    return out.astype(v.dtype), state_final


def bidir_retention(q_c, k_c, v_c, q_x, k_x, v_x, logg_f, logg_b):
    b = q_x.shape[0]
    s0 = jnp.zeros((b, R_HEADS, R_DK, R_DV), jnp.float32)
    flip = lambda a: jnp.flip(a, axis=1)
    o_cf, s_cf = retention_chunked(q_c, k_c, v_c, logg_f, s0)
    o_xf, _ = retention_chunked(q_x, k_x, v_x, logg_f, s_cf)
    o_cb, s_cb = retention_chunked(flip(q_c), flip(k_c), flip(v_c), logg_b, s0)
    o_xb, _ = retention_chunked(flip(q_x), flip(k_x), flip(v_x), logg_b, s_cb)
    return o_cf + flip(o_cb), o_xf + flip(o_xb)


def mixer_merge(att, ret, gate, lam_init, dattn_norm_g, ret_norm_g, w_out):
    bn, t = att.shape[:2]
    a = (rmsnorm(att, dattn_norm_g) * (1 - lam_init)).reshape(bn, t, A_V)
    r = jax.nn.silu(gate) * rmsnorm(ret, ret_norm_g).reshape(bn, t, R_V)
    return jnp.concatenate([a, r], axis=-1) @ w_out


def moe_ffn(h, router_w, router_bias, w1, w3, w2, sw1, sw3, sw2):
    t, d = h.shape
    scores = jax.nn.sigmoid((h @ router_w).astype(jnp.float32))
    sel = scores + router_bias.astype(jnp.float32)
    grp = sel.reshape(t, N_GROUPS, N_EXPERTS // N_GROUPS)
    grp_score = lax.top_k(grp, 2)[0].sum(-1)
    _, top_g = lax.top_k(grp_score, TOPK_GROUPS)
    gmask = jax.nn.one_hot(top_g, N_GROUPS, dtype=jnp.float32).sum(axis=1) > 0
    emask = jnp.repeat(gmask, N_EXPERTS // N_GROUPS, axis=1)
    _, top_e = lax.top_k(jnp.where(emask, sel, -jnp.inf), TOP_K)
    wts = jnp.take_along_axis(scores, top_e, axis=1)
    wts = wts / jnp.sum(wts, axis=-1, keepdims=True) * ROUTED_SCALE
    n_assign = t * TOP_K
    e_flat = top_e.reshape(n_assign)
    t_flat = jnp.repeat(jnp.arange(t, dtype=jnp.int32), TOP_K)
    w_flat = wts.reshape(n_assign)
    order = jnp.argsort(e_flat)
    e_s, t_s, w_s = e_flat[order], t_flat[order], w_flat[order]
    counts = jax.ops.segment_sum(jnp.ones((n_assign,), jnp.int32), e_flat, num_segments=N_EXPERTS)
    padded = (counts + MOE_BLOCK - 1) // MOE_BLOCK * MOE_BLOCK
    pad_end = jnp.cumsum(padded)
    pad_start = pad_end - padded
    start = jnp.cumsum(counts) - counts
    dest = pad_start[e_s] + jnp.arange(n_assign, dtype=jnp.int32) - start[e_s]
    n_pad = -(-n_assign // MOE_BLOCK) * MOE_BLOCK + N_EXPERTS * MOE_BLOCK
    n_blk = n_pad // MOE_BLOCK
    tok_buf = jnp.full((n_pad,), t, jnp.int32).at[dest].set(t_s)
    w_buf = jnp.zeros((n_pad,), jnp.float32).at[dest].set(w_s)
    blk_exp = jnp.clip(jnp.searchsorted(pad_end, jnp.arange(n_blk, dtype=jnp.int32) * MOE_BLOCK, side='right'),
                       0, N_EXPERTS - 1).astype(jnp.int32)
    h_pad = jnp.concatenate([h, jnp.zeros((1, d), h.dtype)], axis=0)

    def body(acc, inp):
        tok, wt, e = inp
        xb = h_pad[tok]
        yb = (jax.nn.silu(xb @ w1[e]) * (xb @ w3[e])) @ w2[e]
        return acc.at[tok].add((yb * wt[:, None].astype(yb.dtype)).astype(acc.dtype)), None

    acc0 = jnp.zeros((t + 1, d), h.dtype)
    acc, _ = lax.scan(body, acc0, (tok_buf.reshape(n_blk, MOE_BLOCK), w_buf.reshape(n_blk, MOE_BLOCK), blk_exp))
    shared = (jax.nn.silu(h @ sw1) * (h @ sw3)) @ sw2
    return acc[:t] + shared


def hybrid_layer(x, xc, mod_x, mod_c, cos, sin, lam_init, update_ctx,
                 norm1_g, w_in, lambda_q1, lambda_k1, lambda_q2, lambda_k2, dattn_norm_g,
                 ret_decay_fwd, ret_decay_bwd, ret_norm_g, w_out,
                 norm2_g, router_w, router_bias, exp_w1, exp_w3, exp_w2,
                 shared_w1, shared_w3, shared_w2):
    b, s, d = x.shape
    sh1, sc1, g1, sh2, sc2, g2 = jnp.split(mod_x, 6, axis=-1)
    csh1, csc1, cg1, csh2, csc2, cg2 = jnp.split(mod_c, 6, axis=-1)

    hx = modulate(rmsnorm(x, norm1_g), sh1, sc1)
    hc = modulate(rmsnorm(xc, norm1_g), csh1, csc1)
    dq_x, dk_x, dv_x, rq_x, rk_x, rv_x, rg_x = project_heads(hx, w_in)
    dq_c, dk_c, dv_c, rq_c, rk_c, rv_c, rg_c = project_heads(hc, w_in)

    dq_x = apply_axial_rope(dq_x, cos, sin) * HEAD_DIM ** -0.5
    dk_x = apply_axial_rope(dk_x, cos, sin)
    rq_x = apply_axial_rope(rq_x, cos, sin)
    rk_x = apply_axial_rope(rk_x, cos, sin) * R_DK ** -0.5
    dq_c = dq_c * HEAD_DIM ** -0.5
    rk_c = rk_c * R_DK ** -0.5

    lam = (jnp.exp(jnp.sum(lambda_q1 * lambda_k1)) - jnp.exp(jnp.sum(lambda_q2 * lambda_k2))).astype(jnp.float32) + lam_init

    k_all = jnp.concatenate([dk_c, dk_x], axis=1)
    v_all = jnp.concatenate([dv_c, dv_x], axis=1)
    n_qblk = s // Q_BLOCK
    q_blocks = dq_x.reshape(b, n_qblk, Q_BLOCK, A_HEADS, 2, HEAD_DIM).swapaxes(0, 1)
    att_x = lax.map(lambda qb: diff_attend(qb, k_all, v_all, lam), q_blocks)
    att_x = att_x.swapaxes(0, 1).reshape(b, s, A_HEADS, 2 * HEAD_DIM)

    logg_f = jax.nn.log_sigmoid(ret_decay_fwd.astype(jnp.float32))
    logg_b = jax.nn.log_sigmoid(ret_decay_bwd.astype(jnp.float32))
    ret_c, ret_x = bidir_retention(rq_c, rk_c, rv_c, rq_x, rk_x, rv_x, logg_f, logg_b)

    y_x = mixer_merge(att_x, ret_x, rg_x, lam_init, dattn_norm_g, ret_norm_g, w_out)
    x = x + g1[:, None] * y_x
    h2 = modulate(rmsnorm(x, norm2_g), sh2, sc2)
    ffn_x = moe_ffn(h2.reshape(b * s, d), router_w, router_bias, exp_w1, exp_w3, exp_w2,
                    shared_w1, shared_w3, shared_w2).reshape(b, s, d)
    x = x + g2[:, None] * ffn_x

    if update_ctx:
        att_c = diff_attend(dq_c, dk_c, dv_c, lam)
        y_c = mixer_merge(att_c, ret_c, rg_c, lam_init, dattn_norm_g, ret_norm_g, w_out)
        xc = xc + cg1[:, None] * y_c
        bc, lc, _ = xc.shape
        h2c = modulate(rmsnorm(xc, norm2_g), csh2, csc2)
        ffn_c = moe_ffn(h2c.reshape(bc * lc, d), router_w, router_bias, exp_w1, exp_w3, exp_w2,
                        shared_w1, shared_w3, shared_w2).reshape(bc, lc, d)
        xc = xc + cg2[:, None] * ffn_c
    else:
        xc = None
    return x, xc


def setup_inputs(seed: int = 0) -> dict:
    key = jax.random.key(seed)
    ks = jax.random.split(key, 32)
    f32 = jnp.float32

    def nrm(k, shape, scale):
        return jax.random.normal(k, shape, f32) * scale

    gamma0 = 1.0 - 2.0 ** (-5.0 - jnp.arange(R_HEADS, dtype=f32))
    logit0 = jnp.log(gamma0) - jnp.log1p(-gamma0)
    return {
        "x": nrm(ks[0], (BATCH, SEQ, D_MODEL), 1.0),
        "c": nrm(ks[1], (BATCH, D_MODEL), 1.0),
        "ctx": nrm(ks[2], (BATCH, CTX_LEN, D_MODEL), 1.0),
        "c_ctx": nrm(ks[3], (D_MODEL,), 1.0),
        "ada_w": nrm(ks[4], (DEPTH, D_MODEL, 6 * D_MODEL), 0.5 * D_MODEL ** -0.5),
        "ada_b": nrm(ks[5], (DEPTH, 6 * D_MODEL), 0.02),
        "norm1_g": 1.0 + nrm(ks[6], (DEPTH, D_MODEL), 0.05),
        "w_in": nrm(ks[7], (DEPTH, D_MODEL, D_IN), D_MODEL ** -0.5),
        "lambda_q1": nrm(ks[8], (DEPTH, HEAD_DIM), 0.1),
        "lambda_k1": nrm(ks[9], (DEPTH, HEAD_DIM), 0.1),
        "lambda_q2": nrm(ks[10], (DEPTH, HEAD_DIM), 0.1),
        "lambda_k2": nrm(ks[11], (DEPTH, HEAD_DIM), 0.1),
        "dattn_norm_g": 1.0 + nrm(ks[12], (DEPTH, 2 * HEAD_DIM), 0.05),
        "ret_decay_fwd": logit0[None] + nrm(ks[13], (DEPTH, R_HEADS), 0.1),
        "ret_decay_bwd": logit0[None] + nrm(ks[14], (DEPTH, R_HEADS), 0.1),
        "ret_norm_g": 1.0 + nrm(ks[15], (DEPTH, R_DV), 0.05),
        "w_out": nrm(ks[16], (DEPTH, D_MIX, D_MODEL), D_MIX ** -0.5),
        "norm2_g": 1.0 + nrm(ks[17], (DEPTH, D_MODEL), 0.05),
        "router_w": nrm(ks[18], (DEPTH, D_MODEL, N_EXPERTS), D_MODEL ** -0.5),
        "router_bias": nrm(ks[19], (DEPTH, N_EXPERTS), 0.01),
        "exp_w1": nrm(ks[20], (DEPTH, N_EXPERTS, D_MODEL, D_EXPERT), D_MODEL ** -0.5),
        "exp_w3": nrm(ks[21], (DEPTH, N_EXPERTS, D_MODEL, D_EXPERT), D_MODEL ** -0.5),
        "exp_w2": nrm(ks[22], (DEPTH, N_EXPERTS, D_EXPERT, D_MODEL), D_EXPERT ** -0.5),
        "shared_w1": nrm(ks[23], (DEPTH, D_MODEL, D_SHARED), D_MODEL ** -0.5),
        "shared_w3": nrm(ks[24], (DEPTH, D_MODEL, D_SHARED), D_MODEL ** -0.5),
        "shared_w2": nrm(ks[25], (DEPTH, D_SHARED, D_MODEL), D_SHARED ** -0.5),
        "final_norm_g": 1.0 + nrm(ks[26], (D_MODEL,), 0.05),
    }


def reference(x, c, ctx, c_ctx, ada_w, ada_b, norm1_g, w_in, lambda_q1, lambda_k1, lambda_q2, lambda_k2,
              dattn_norm_g, ret_decay_fwd, ret_decay_bwd, ret_norm_g, w_out, norm2_g, router_w, router_bias,
              exp_w1, exp_w3, exp_w2, shared_w1, shared_w3, shared_w2, final_norm_g):
    s = x.shape[1]
    cos, sin = axial_rope_tables(s)
    xc = ctx
    for l in range(DEPTH):
        lam_init = 0.8 - 0.6 * math.exp(-0.3 * l)
        mod_x = jax.nn.silu(c) @ ada_w[l] + ada_b[l]
        mod_c = (jax.nn.silu(c_ctx) @ ada_w[l] + ada_b[l])[None]
        x, xc = hybrid_layer(x, xc, mod_x, mod_c, cos, sin, lam_init, l < DEPTH - 1,
                             norm1_g[l], w_in[l], lambda_q1[l], lambda_k1[l], lambda_q2[l], lambda_k2[l],
                             dattn_norm_g[l], ret_decay_fwd[l], ret_decay_bwd[l], ret_norm_g[l], w_out[l],
                             norm2_g[l], router_w[l], router_bias[l], exp_w1[l], exp_w3[l], exp_w2[l],
                             shared_w1[l], shared_w3[l], shared_w2[l])
    return rmsnorm(x, final_norm_g)
```

```cpp
#include <hip/hip_runtime.h>
#include <stdint.h>

constexpr int D = 1024, NB = 4, SEQ = 8192, CTX = 256, RB = SEQ + CTX  , NR = NB * RB  , T = NB * SEQ;
constexpr int NE = 64, DE = 256, ECAP = 32768;
constexpr float EPS = 1e-6f;

__device__ __forceinline__ float siluf(float v) { return v / (1.0f + expf(-v)); }
__device__ __forceinline__ float wave_sum(float v) {
#pragma unroll
    for (int o = 32; o > 0; o >>= 1) v += __shfl_xor(v, o);
    return v;
}
__device__ __forceinline__ float wave_max(float v) {
#pragma unroll
    for (int o = 32; o > 0; o >>= 1) v = fmaxf(v, __shfl_xor(v, o));
    return v;
}
__device__ __forceinline__ float block_sum(float v, float* red) {
    v = wave_sum(v);
    __syncthreads();
    if ((threadIdx.x & 63) == 0) red[threadIdx.x >> 6] = v;
    __syncthreads();
    return red[0] + red[1] + red[2] + red[3];
}
__device__ __forceinline__ float block_max(float v, float* red) {
    v = wave_max(v);
    __syncthreads();
    if ((threadIdx.x & 63) == 0) red[threadIdx.x >> 6] = v;
    __syncthreads();
    return fmaxf(fmaxf(red[0], red[1]), fmaxf(red[2], red[3]));
}

__global__ __launch_bounds__(256) void k_mod(const float* c, const float* cctx, const float* ada_w, const float* ada_b, float* mod) {
    __shared__ float sc[5][D];
    for (int i = threadIdx.x; i < 5 * D; i += 256) {
        int r = i / D, k = i % D;
        float v = r < 4 ? c[r * D + k] : cctx[k];
        sc[r][k] = siluf(v);
    }
    __syncthreads();
    int j = blockIdx.x * 256 + threadIdx.x;
    float a0 = 0, a1 = 0, a2 = 0, a3 = 0, a4 = 0;
    for (int k = 0; k < D; ++k) {
        float w = ada_w[(size_t)k * 6 * D + j];
        a0 += sc[0][k] * w; a1 += sc[1][k] * w; a2 += sc[2][k] * w; a3 += sc[3][k] * w; a4 += sc[4][k] * w;
    }
    float bb = ada_b[j];
    mod[0 * 6 * D + j] = a0 + bb; mod[1 * 6 * D + j] = a1 + bb; mod[2 * 6 * D + j] = a2 + bb; mod[3 * 6 * D + j] = a3 + bb; mod[4 * 6 * D + j] = a4 + bb;
}

__global__ __launch_bounds__(256) void k_ln1(const float* x, const float* ctx, const float* g, const float* mod, float* H) {
    __shared__ float red[8];
    int R = blockIdx.x, b = R / RB, i = R % RB;
    const float* src = i < CTX ? ctx + ((size_t)b * CTX + i) * D : x + ((size_t)b * SEQ + (i - CTX)) * D;
    const float* m = mod + (size_t)(i < CTX ? 4 : b) * 6 * D;
    float4 v = ((const float4*)src)[threadIdx.x];
    float ss = block_sum(v.x * v.x + v.y * v.y + v.z * v.z + v.w * v.w, red);
    float rstd = rsqrtf(ss * (1.0f / D) + EPS);
    int c0 = threadIdx.x * 4;
    float4 gg = ((const float4*)g)[threadIdx.x], sh = *(const float4*)(m + c0), sc = *(const float4*)(m + D + c0);
    float4 o;
    o.x = v.x * rstd * gg.x * (1 + sc.x) + sh.x; o.y = v.y * rstd * gg.y * (1 + sc.y) + sh.y;
    o.z = v.z * rstd * gg.z * (1 + sc.z) + sh.z; o.w = v.w * rstd * gg.w * (1 + sc.w) + sh.w;
    ((float4*)(H + (size_t)R * D))[threadIdx.x] = o;
}

struct GemmP { const float* A; long lda; const int* rowidx; const int* Mptr; long M; const float* B; long ldb; long N; long K; long sAz; long sBz; long zshB; };

template <bool BT, class Epi>
__global__ __launch_bounds__(256) void sgemm(GemmP p, Epi epi) {
    __shared__ float As[16][132];
    __shared__ float Bs[16][132];
    const int tid = threadIdx.x, z = blockIdx.z;
    const int M = p.Mptr ? *p.Mptr : (int)p.M;
    const int m0 = blockIdx.y * 128, n0 = blockIdx.x * 128;
    if (m0 >= M) return;
    const float* A = p.A + (long)z * p.sAz;
    const float* B = p.B + (long)(z >> p.zshB) * p.sBz;
    const float* arow[2];
#pragma unroll
    for (int i = 0; i < 2; ++i) {
        int r = m0 + (tid >> 2) + 64 * i; if (r >= M) r = M - 1;
        long src = p.rowidx ? p.rowidx[r] : r;
        arow[i] = A + src * p.lda + (tid & 3) * 4;
    }
    const float* brow[2];
    bool bok = true;
    if (BT) {
#pragma unroll
        for (int i = 0; i < 2; ++i) { int n = n0 + (tid >> 2) + 64 * i; if (n >= p.N) n = p.N - 1; brow[i] = B + (long)n * p.ldb + (tid & 3) * 4; }
    } else {
        int n = n0 + (tid & 31) * 4; bok = n < p.N;
#pragma unroll
        for (int i = 0; i < 2; ++i) brow[i] = B + (long)((tid >> 5) + 8 * i) * p.ldb + (bok ? n : 0);
    }
    float acc[8][8];
#pragma unroll
    for (int i = 0; i < 8; ++i)
#pragma unroll
        for (int j = 0; j < 8; ++j) acc[i][j] = 0.f;
    const int ty = tid >> 4, tx = tid & 15;
    const int K = (int)p.K, N = (int)p.N;
    for (int k0 = 0; k0 < K; k0 += 16) {
        float4 a0 = *(const float4*)(arow[0] + k0), a1 = *(const float4*)(arow[1] + k0);
        float4 b0, b1;
        if (BT) { b0 = *(const float4*)(brow[0] + k0); b1 = *(const float4*)(brow[1] + k0); }
        else {
            b0 = *(const float4*)(brow[0] + (long)k0 * p.ldb); b1 = *(const float4*)(brow[1] + (long)k0 * p.ldb);
            if (!bok) { b0 = make_float4(0, 0, 0, 0); b1 = b0; }
        }
        __syncthreads();
        {
            int kq = (tid & 3) * 4, r = tid >> 2;
            As[kq + 0][r] = a0.x; As[kq + 1][r] = a0.y; As[kq + 2][r] = a0.z; As[kq + 3][r] = a0.w;
            As[kq + 0][r + 64] = a1.x; As[kq + 1][r + 64] = a1.y; As[kq + 2][r + 64] = a1.z; As[kq + 3][r + 64] = a1.w;
            if (BT) {
                Bs[kq + 0][r] = b0.x; Bs[kq + 1][r] = b0.y; Bs[kq + 2][r] = b0.z; Bs[kq + 3][r] = b0.w;
                Bs[kq + 0][r + 64] = b1.x; Bs[kq + 1][r + 64] = b1.y; Bs[kq + 2][r + 64] = b1.z; Bs[kq + 3][r + 64] = b1.w;
            } else {
                *(float4*)&Bs[tid >> 5][(tid & 31) * 4] = b0;
                *(float4*)&Bs[(tid >> 5) + 8][(tid & 31) * 4] = b1;
            }
        }
        __syncthreads();
#pragma unroll
        for (int kk = 0; kk < 16; ++kk) {
            float4 x0 = *(const float4*)&As[kk][ty * 4], x1 = *(const float4*)&As[kk][64 + ty * 4];
            float4 y0 = *(const float4*)&Bs[kk][tx * 4], y1 = *(const float4*)&Bs[kk][64 + tx * 4];
            float av[8] = {x0.x, x0.y, x0.z, x0.w, x1.x, x1.y, x1.z, x1.w};
            float bv[8] = {y0.x, y0.y, y0.z, y0.w, y1.x, y1.y, y1.z, y1.w};
#pragma unroll
            for (int i = 0; i < 8; ++i)
#pragma unroll
                for (int j = 0; j < 8; ++j) acc[i][j] = fmaf(av[i], bv[j], acc[i][j]);
        }
    }
#pragma unroll
    for (int i = 0; i < 8; ++i) {
        int row = m0 + (i < 4 ? ty * 4 + i : 64 + ty * 4 + i - 4);
        if (row < M) {
#pragma unroll
            for (int j = 0; j < 8; ++j) {
                int col = n0 + (j < 4 ? tx * 4 + j : 64 + tx * 4 + j - 4);
                if (col < p.N) epi(z, row, col, acc[i][j]);
            }
        }
    }
}

struct EpiStore { float* C; long ldc; long sCz;
    __device__ void operator()(int z, int row, int col, float v) const { C[(long)z * sCz + (long)row * ldc + col] = v; } };
struct EpiPV { float* O; long rowbase;
    __device__ void operator()(int z, int row, int col, float v) const { O[(long)(z & 1) * T * 512 + (rowbase + row) * 512 + (z >> 1) * 128 + col] = v; } };
struct EpiX1 { const float* x; const float* mod; float* x1;
    __device__ void operator()(int z, int row, int col, float v) const { int b = row / SEQ; x1[(long)row * D + col] = x[(long)row * D + col] + mod[(long)b * 6 * D + 2 * D + col] * v; } };
struct EpiAct { const float* U; float* Aout;
    __device__ void operator()(int z, int row, int col, float v) const { long o = (long)row * DE + col; Aout[o] = siluf(U[o]) * v; } };
struct EpiFfn { float* ffn; const int* tok; const float* wt; long first;
    __device__ void operator()(int z, int row, int col, float v) const {
        long t = tok ? tok[row] : row; float w = wt ? wt[row] : 1.0f; float* p = ffn + t * D + col;
        if (first) *p = w * v; else *p += w * v; } };

__global__ __launch_bounds__(256) void k_rope(float* P, int mode) {
    const int ngroups = mode == 0 ? 16 : 8;
    long idx = (long)blockIdx.x * 256 + threadIdx.x;
    long total = (long)NR * ngroups * 32;
    if (idx >= total) return;
    int f = idx & 15, a = (idx >> 4) & 1; int grp = (idx >> 5) % ngroups; long R = (idx >> 5) / ngroups;
    int i = R % RB;
    float* p = P + R * 1536 + grp * 64 + a * 32 + f;
    float x1 = p[0], x2 = p[16];
    float scale = 1.0f;
    if (mode == 0) { if (grp < 8) scale = 0.125f; } else { if (grp >= 4) scale = 0.125f; }
    if (i >= CTX) {
        int t = i - CTX; int pos = a == 0 ? t / 64 : t % 64;
        float inv_freq = (float)pow(10000.0, -(double)f / 16.0);
        float ang = (float)pos * inv_freq;
        float s, c; sincosf(ang, &s, &c);
        float o1 = x1 * c - x2 * s, o2 = x1 * s + x2 * c;
        x1 = o1; x2 = o2;
    }
    p[0] = x1 * scale; p[16] = x2 * scale;
}

__global__ __launch_bounds__(256) void k_softmax(float* S) {
    __shared__ float red[8];
    float* row = S + (long)blockIdx.x * RB;
    float v[33];
    float mx = -INFINITY;
#pragma unroll
    for (int i = 0; i < 33; ++i) { v[i] = row[i * 256 + threadIdx.x]; mx = fmaxf(mx, v[i]); }
    mx = block_max(mx, red);
    float sm = 0;
#pragma unroll
    for (int i = 0; i < 33; ++i) { v[i] = expf(v[i] - mx); sm += v[i]; }
    sm = block_sum(sm, red);
    float inv = 1.0f / sm;
#pragma unroll
    for (int i = 0; i < 33; ++i) row[i * 256 + threadIdx.x] = v[i] * inv;
}

__global__ __launch_bounds__(256) void k_ret(const float* Pret, const float* dec_f, const float* dec_b, float* ret) {
    __shared__ float sq[32][64], sk[32][64], sv[32][128];
    const int b = blockIdx.x >> 2, h = blockIdx.x & 3, tid = threadIdx.x;
    const int j = tid >> 1, hh = tid & 1;
    for (int dir = 0; dir < 2; ++dir) {
        float d = dir == 0 ? dec_f[h] : dec_b[h];
        float g = 1.0f / (1.0f + expf(-d));
        float S[32];
#pragma unroll
        for (int ii = 0; ii < 32; ++ii) S[ii] = 0.f;
        for (int ch = 0; ch < RB / 32; ++ch) {
            __syncthreads();
            for (int tt = 0; tt < 32; ++tt) {
                int s = ch * 32 + tt;
                int i = dir == 0 ? s : (s < CTX ? CTX - 1 - s : RB - 1 - (s - CTX));
                const float* src = Pret + ((long)b * RB + i) * 1536;
                if (tid < 64) sq[tt][tid] = src[h * 64 + tid];
                else if (tid < 128) sk[tt][tid - 64] = src[256 + h * 64 + tid - 64];
                else sv[tt][tid - 128] = src[512 + h * 128 + tid - 128];
            }
            __syncthreads();
            for (int tt = 0; tt < 32; ++tt) {
                float v = sv[tt][j];
                float o = 0.f;
#pragma unroll
                for (int ii = 0; ii < 32; ++ii) {
                    S[ii] = fmaf(g, S[ii], sk[tt][hh * 32 + ii] * v);
                    o = fmaf(sq[tt][hh * 32 + ii], S[ii], o);
                }
                o += __shfl_xor(o, 1);
                int s = ch * 32 + tt;
                if (s >= CTX && hh == 0) {
                    int i = dir == 0 ? s : RB - 1 - (s - CTX);
                    float* dst = ret + ((long)b * SEQ + (i - CTX)) * 512 + h * 128 + j;
                    if (dir == 0) *dst = o; else *dst += o;
                }
            }
        }
    }
}

__global__ __launch_bounds__(256) void k_merge(const float* O, const float* ret, const float* Pret, const float* lq1, const float* lk1, const float* lq2,
                                               const float* lk2, const float* gd, const float* gr, float* mix) {
    const int t = blockIdx.x, h = threadIdx.x >> 6, lane = threadIdx.x & 63;
    float s1 = wave_sum(lq1[lane] * lk1[lane]), s2 = wave_sum(lq2[lane] * lk2[lane]);
    float lam = expf(s1) - expf(s2) + 0.2f;
    const int b = t / SEQ, tt = t % SEQ;
    const float* o0 = O + (long)t * 512 + h * 128, * o1 = O + (long)T * 512 + (long)t * 512 + h * 128;
    float a0 = o0[lane] - lam * o1[lane], a1 = o0[lane + 64] - lam * o1[lane + 64];
    float ms = wave_sum(a0 * a0 + a1 * a1) * (1.0f / 128);
    float rs = rsqrtf(ms + EPS);
    mix[(long)t * D + h * 128 + lane] = a0 * rs * gd[lane] * 0.8f;
    mix[(long)t * D + h * 128 + lane + 64] = a1 * rs * gd[lane + 64] * 0.8f;
    const float* rr = ret + (long)t * 512 + h * 128;
    const float* rg = Pret + ((long)b * RB + CTX + tt) * 1536 + 1024 + h * 128;
    float r0 = rr[lane], r1 = rr[lane + 64];
    float ms2 = wave_sum(r0 * r0 + r1 * r1) * (1.0f / 128);
    float rs2 = rsqrtf(ms2 + EPS);
    mix[(long)t * D + 512 + h * 128 + lane] = siluf(rg[lane]) * r0 * rs2 * gr[lane];
    mix[(long)t * D + 512 + h * 128 + lane + 64] = siluf(rg[lane + 64]) * r1 * rs2 * gr[lane + 64];
}

__global__ __launch_bounds__(256) void k_ln2(const float* x1, const float* g, const float* mod, float* h2) {
    __shared__ float red[8];
    int t = blockIdx.x, b = t / SEQ;
    const float* m = mod + (size_t)b * 6 * D;
    float4 v = ((const float4*)(x1 + (size_t)t * D))[threadIdx.x];
    float ss = block_sum(v.x * v.x + v.y * v.y + v.z * v.z + v.w * v.w, red);
    float rstd = rsqrtf(ss * (1.0f / D) + EPS);
    int c0 = threadIdx.x * 4;
    float4 gg = ((const float4*)g)[threadIdx.x], sh = *(const float4*)(m + 3 * D + c0), sc = *(const float4*)(m + 4 * D + c0);
    float4 o;
    o.x = v.x * rstd * gg.x * (1 + sc.x) + sh.x; o.y = v.y * rstd * gg.y * (1 + sc.y) + sh.y;
    o.z = v.z * rstd * gg.z * (1 + sc.z) + sh.z; o.w = v.w * rstd * gg.w * (1 + sc.w) + sh.w;
    ((float4*)(h2 + (size_t)t * D))[threadIdx.x] = o;
}

__global__ __launch_bounds__(256) void k_topk(const float* logits, const float* bias, int* cnt, int* tok_list, float* wt_list) {
    const int t = blockIdx.x * 4 + (threadIdx.x >> 6), lane = threadIdx.x & 63;
    float score = 1.0f / (1.0f + expf(-logits[(long)t * NE + lane]));
    float sel = score + bias[lane];
    float m1 = sel, m2 = -INFINITY;
#pragma unroll
    for (int o = 1; o < 8; o <<= 1) {
        float p1 = __shfl_xor(m1, o), p2 = __shfl_xor(m2, o);
        float n1 = fmaxf(m1, p1), n2 = fmaxf(fminf(m1, p1), fmaxf(m2, p2));
        m1 = n1; m2 = n2;
    }
    float gs = m1 + m2;
    const int grp = lane >> 3;
    int grank = 0;
#pragma unroll
    for (int g2 = 0; g2 < 8; ++g2) {
        float og = __shfl(gs, g2 * 8);
        grank += (og > gs || (og == gs && g2 < grp)) ? 1 : 0;
    }
    float val = grank < 4 ? sel : -INFINITY;
    int rank = 0;
    for (int e = 0; e < 64; ++e) {
        float ov = __shfl(val, e);
        rank += (ov > val || (ov == val && e < lane)) ? 1 : 0;
    }
    bool chosen = rank < 8;
    float wsum = wave_sum(chosen ? score : 0.f);
    if (chosen) {
        int slot = atomicAdd(&cnt[lane], 1);
        tok_list[lane * ECAP + slot] = t;
        wt_list[lane * ECAP + slot] = score / wsum * 2.5f;
    }
}

__global__ __launch_bounds__(256) void k_final(const float* x1, const float* mod, const float* gf, float* out) {
    __shared__ float red[8];
    int t = blockIdx.x, b = t / SEQ;
    const float* m = mod + (size_t)b * 6 * D + 5 * D;
    float4 v = ((const float4*)(x1 + (size_t)t * D))[threadIdx.x];
    float4 f = ((const float4*)(out + (size_t)t * D))[threadIdx.x];
    float4 g2 = ((const float4*)m)[threadIdx.x];
    v.x += g2.x * f.x; v.y += g2.y * f.y; v.z += g2.z * f.z; v.w += g2.w * f.w;
    float ss = block_sum(v.x * v.x + v.y * v.y + v.z * v.z + v.w * v.w, red);
    float rstd = rsqrtf(ss * (1.0f / D) + EPS);
    float4 gg = ((const float4*)gf)[threadIdx.x];
    float4 o; o.x = v.x * rstd * gg.x; o.y = v.y * rstd * gg.y; o.z = v.z * rstd * gg.z; o.w = v.w * rstd * gg.w;
    ((float4*)(out + (size_t)t * D))[threadIdx.x] = o;
}

template <bool BT, class Epi>
static void launch_gemm(hipStream_t s, dim3 grid, GemmP p, Epi e) { hipLaunchKernelGGL((sgemm<BT, Epi>), grid, dim3(256), 0, s, p, e); }

extern "C" void kernel_launch(void* const* d_in, const int* in_sizes, int n_in, void* d_out, int out_size, void* d_ws, size_t ws_size, hipStream_t stream) {
    const float* x = (const float*)d_in[0]; const float* c = (const float*)d_in[1]; const float* ctx = (const float*)d_in[2]; const float* cctx = (const float*)d_in[3];
    const float* ada_w = (const float*)d_in[4]; const float* ada_b = (const float*)d_in[5]; const float* norm1_g = (const float*)d_in[6]; const float* w_in = (const float*)d_in[7];
    const float* lq1 = (const float*)d_in[8]; const float* lk1 = (const float*)d_in[9]; const float* lq2 = (const float*)d_in[10]; const float* lk2 = (const float*)d_in[11];
    const float* dattn_g = (const float*)d_in[12]; const float* dec_f = (const float*)d_in[13]; const float* dec_b = (const float*)d_in[14]; const float* ret_g = (const float*)d_in[15];
    const float* w_out = (const float*)d_in[16]; const float* norm2_g = (const float*)d_in[17]; const float* router_w = (const float*)d_in[18]; const float* router_b = (const float*)d_in[19];
    const float* ew1 = (const float*)d_in[20]; const float* ew3 = (const float*)d_in[21]; const float* ew2 = (const float*)d_in[22];
    const float* sw1 = (const float*)d_in[23]; const float* sw3 = (const float*)d_in[24]; const float* sw2 = (const float*)d_in[25]; const float* final_g = (const float*)d_in[26];
    float* out = (float*)d_out;
    char* ws = (char*)d_ws;
    float* mod = (float*)ws;
    int* cnt = (int*)(ws + 131072);
    size_t off = 1 << 20;
    float* RegP = (float*)(ws + off); off += (size_t)NR * 1536 * 4;
    float* RegH = (float*)(ws + off); off += (size_t)NR * 1024 * 4;
    float* RegS = (float*)(ws + off); off += (size_t)NR * 1024 * 4;
    float* logits = (float*)(ws + off); off += (size_t)T * NE * 4;
    int* tok_list = (int*)(ws + off); off += (size_t)NE * ECAP * 4;
    float* wt_list = (float*)(ws + off); off += (size_t)NE * ECAP * 4;
    hipStream_t s = stream;

    hipLaunchKernelGGL(k_mod, dim3(6 * D / 256), dim3(256), 0, s, c, cctx, ada_w, ada_b, mod);
    hipLaunchKernelGGL(k_ln1, dim3(NR), dim3(256), 0, s, x, ctx, norm1_g, mod, RegH);
    { GemmP p{RegH, D, nullptr, nullptr, NR, w_in, 3072, 1536, D, 0, 0, 0}; launch_gemm<false>(s, dim3(12, NR / 128, 1), p, EpiStore{RegP, 1536, 0}); }
    hipLaunchKernelGGL(k_rope, dim3((unsigned)(((long)NR * 16 * 32 + 255) / 256)), dim3(256), 0, s, RegP, 0);
    for (int b = 0; b < NB; ++b)
        for (int qc = 0; qc < SEQ / 512; ++qc) {
            const float* Aq = RegP + ((long)b * RB + CTX + qc * 512) * 1536;
            const float* Kb = RegP + ((long)b * RB) * 1536 + 512;
            GemmP p{Aq, 1536, nullptr, nullptr, 512, Kb, 1536, RB, 64, 64, 64, 0};
            launch_gemm<true>(s, dim3(RB / 128, 4, 8), p, EpiStore{RegS, RB, (long)512 * RB});
            hipLaunchKernelGGL(k_softmax, dim3(4096), dim3(256), 0, s, RegS);
            const float* Vb = RegP + ((long)b * RB) * 1536 + 1024;
            GemmP p2{RegS, RB, nullptr, nullptr, 512, Vb, 1536, 128, RB, (long)512 * RB, 128, 1};
            launch_gemm<false>(s, dim3(1, 4, 8), p2, EpiPV{out, (long)b * SEQ + qc * 512});
        }
    { GemmP p{RegH, D, nullptr, nullptr, NR, w_in + 1536, 3072, 1536, D, 0, 0, 0}; launch_gemm<false>(s, dim3(12, NR / 128, 1), p, EpiStore{RegP, 1536, 0}); }
    hipLaunchKernelGGL(k_rope, dim3((unsigned)(((long)NR * 8 * 32 + 255) / 256)), dim3(256), 0, s, RegP, 1);
    hipLaunchKernelGGL(k_ret, dim3(16), dim3(256), 0, s, RegP, dec_f, dec_b, RegS);
    hipLaunchKernelGGL(k_merge, dim3(T), dim3(256), 0, s, out, RegS, RegP, lq1, lk1, lq2, lk2, dattn_g, ret_g, RegH);
    { GemmP p{RegH, D, nullptr, nullptr, T, w_out, D, D, D, 0, 0, 0}; launch_gemm<false>(s, dim3(8, T / 128, 1), p, EpiX1{x, mod, RegS}); }
    float* x1 = RegS; float* h2 = RegP;
    hipLaunchKernelGGL(k_ln2, dim3(T), dim3(256), 0, s, x1, norm2_g, mod, h2);
    { GemmP p{h2, D, nullptr, nullptr, T, router_w, NE, NE, D, 0, 0, 0}; launch_gemm<false>(s, dim3(1, T / 128, 1), p, EpiStore{logits, NE, 0}); }
    (void)hipMemsetAsync(cnt, 0, 256, s);
    hipLaunchKernelGGL(k_topk, dim3(T / 4), dim3(256), 0, s, logits, router_b, cnt, tok_list, wt_list);
    float* Ubuf = RegH; float* Abuf = RegH + (size_t)T * DE;
    for (int e = -1; e < NE; ++e) {
        const float* w1 = e < 0 ? sw1 : ew1 + (size_t)e * D * DE; const float* w3 = e < 0 ? sw3 : ew3 + (size_t)e * D * DE; const float* w2 = e < 0 ? sw2 : ew2 + (size_t)e * DE * D;
        const int* rows = e < 0 ? nullptr : tok_list + (size_t)e * ECAP; const float* wts = e < 0 ? nullptr : wt_list + (size_t)e * ECAP;
        const int* mp = e < 0 ? nullptr : cnt + e;
        { GemmP p{h2, D, rows, mp, T, w1, DE, DE, D, 0, 0, 0}; launch_gemm<false>(s, dim3(2, T / 128, 1), p, EpiStore{Ubuf, DE, 0}); }
        { GemmP p{h2, D, rows, mp, T, w3, DE, DE, D, 0, 0, 0}; launch_gemm<false>(s, dim3(2, T / 128, 1), p, EpiAct{Ubuf, Abuf}); }
        { GemmP p{Abuf, DE, nullptr, mp, T, w2, D, D, DE, 0, 0, 0}; launch_gemm<false>(s, dim3(8, T / 128, 1), p, EpiFfn{out, rows, wts, e < 0 ? 1 : 0}); }
    }
    hipLaunchKernelGGL(k_final, dim3(T), dim3(256), 0, s, x1, mod, final_g, out);
}
```

```cpp
#include <hip/hip_runtime.h>
#include <stdint.h>

constexpr int D = 1024, NB = 4, SEQ = 8192, CTX = 256, RB = SEQ + CTX  , NR = NB * RB  , T = NB * SEQ;
constexpr int NE = 64, DE = 256, ECAP = 32768;
constexpr float EPS = 1e-6f;
typedef unsigned short bf16_t;

__device__ __forceinline__ float siluf(float v) { return v / (1.0f + expf(-v)); }
__device__ __forceinline__ float wave_sum(float v) {
#pragma unroll
    for (int o = 32; o > 0; o >>= 1) v += __shfl_xor(v, o);
    return v;
}
__device__ __forceinline__ float wave_max(float v) {
#pragma unroll
    for (int o = 32; o > 0; o >>= 1) v = fmaxf(v, __shfl_xor(v, o));
    return v;
}
__device__ __forceinline__ float block_sum(float v, float* red) {
    v = wave_sum(v);
    __syncthreads();
    if ((threadIdx.x & 63) == 0) red[threadIdx.x >> 6] = v;
    __syncthreads();
    return red[0] + red[1] + red[2] + red[3];
}
__device__ __forceinline__ float block_max(float v, float* red) {
    v = wave_max(v);
    __syncthreads();
    if ((threadIdx.x & 63) == 0) red[threadIdx.x >> 6] = v;
    __syncthreads();
    return fmaxf(fmaxf(red[0], red[1]), fmaxf(red[2], red[3]));
}

__global__ __launch_bounds__(256) void k_mod(const float* c, const float* cctx, const float* ada_w, const float* ada_b, float* mod) {
    __shared__ float sc[5][D];
    for (int i = threadIdx.x; i < 5 * D; i += 256) {
        int r = i / D, k = i % D;
        float v = r < 4 ? c[r * D + k] : cctx[k];
        sc[r][k] = siluf(v);
    }
    __syncthreads();
    int j = blockIdx.x * 256 + threadIdx.x;
    float a0 = 0, a1 = 0, a2 = 0, a3 = 0, a4 = 0;
    for (int k = 0; k < D; ++k) {
        float w = ada_w[(size_t)k * 6 * D + j];
        a0 += sc[0][k] * w; a1 += sc[1][k] * w; a2 += sc[2][k] * w; a3 += sc[3][k] * w; a4 += sc[4][k] * w;
    }
    float bb = ada_b[j];
    mod[0 * 6 * D + j] = a0 + bb; mod[1 * 6 * D + j] = a1 + bb; mod[2 * 6 * D + j] = a2 + bb; mod[3 * 6 * D + j] = a3 + bb; mod[4 * 6 * D + j] = a4 + bb;
}

__global__ __launch_bounds__(256) void k_ln1(const float* x, const float* ctx, const float* g, const float* mod, float* H) {
    __shared__ float red[8];
    int R = blockIdx.x, b = R / RB, i = R % RB;
    const float* src = i < CTX ? ctx + ((size_t)b * CTX + i) * D : x + ((size_t)b * SEQ + (i - CTX)) * D;
    const float* m = mod + (size_t)(i < CTX ? 4 : b) * 6 * D;
    float4 v = ((const float4*)src)[threadIdx.x];
    float ss = block_sum(v.x * v.x + v.y * v.y + v.z * v.z + v.w * v.w, red);
    float rstd = rsqrtf(ss * (1.0f / D) + EPS);
    int c0 = threadIdx.x * 4;
    float4 gg = ((const float4*)g)[threadIdx.x], sh = *(const float4*)(m + c0), sc = *(const float4*)(m + D + c0);
    float4 o;
    o.x = v.x * rstd * gg.x * (1 + sc.x) + sh.x; o.y = v.y * rstd * gg.y * (1 + sc.y) + sh.y;
    o.z = v.z * rstd * gg.z * (1 + sc.z) + sh.z; o.w = v.w * rstd * gg.w * (1 + sc.w) + sh.w;
    ((float4*)(H + (size_t)R * D))[threadIdx.x] = o;
}

struct GemmP { const float* A; long lda; const int* rowidx; const int* Mptr; long M; const float* B; long ldb; long N; long K; long sAz; long sBz; long zshB; };

template <bool BT, class Epi>
__global__ __launch_bounds__(256) void sgemm(GemmP p, Epi epi) {
    __shared__ float As[16][132];
    __shared__ float Bs[16][132];
    const int tid = threadIdx.x, z = blockIdx.z;
    const int M = p.Mptr ? *p.Mptr : (int)p.M;
    const int m0 = blockIdx.y * 128, n0 = blockIdx.x * 128;
    if (m0 >= M) return;
    const float* A = p.A + (long)z * p.sAz;
    const float* B = p.B + (long)(z >> p.zshB) * p.sBz;
    const float* arow[2];
#pragma unroll
    for (int i = 0; i < 2; ++i) {
        int r = m0 + (tid >> 2) + 64 * i; if (r >= M) r = M - 1;
        long src = p.rowidx ? p.rowidx[r] : r;
        arow[i] = A + src * p.lda + (tid & 3) * 4;
    }
    const float* brow[2];
    bool bok = true;
    if (BT) {
#pragma unroll
        for (int i = 0; i < 2; ++i) { int n = n0 + (tid >> 2) + 64 * i; if (n >= p.N) n = p.N - 1; brow[i] = B + (long)n * p.ldb + (tid & 3) * 4; }
    } else {
        int n = n0 + (tid & 31) * 4; bok = n < p.N;
#pragma unroll
        for (int i = 0; i < 2; ++i) brow[i] = B + (long)((tid >> 5) + 8 * i) * p.ldb + (bok ? n : 0);
    }
    float acc[8][8];
#pragma unroll
    for (int i = 0; i < 8; ++i)
#pragma unroll
        for (int j = 0; j < 8; ++j) acc[i][j] = 0.f;
    const int ty = tid >> 4, tx = tid & 15;
    const int K = (int)p.K, N = (int)p.N;
    for (int k0 = 0; k0 < K; k0 += 16) {
        float4 a0 = *(const float4*)(arow[0] + k0), a1 = *(const float4*)(arow[1] + k0);
        float4 b0, b1;
        if (BT) { b0 = *(const float4*)(brow[0] + k0); b1 = *(const float4*)(brow[1] + k0); }
        else {
            b0 = *(const float4*)(brow[0] + (long)k0 * p.ldb); b1 = *(const float4*)(brow[1] + (long)k0 * p.ldb);
            if (!bok) { b0 = make_float4(0, 0, 0, 0); b1 = b0; }
        }
        __syncthreads();
        {
            int kq = (tid & 3) * 4, r = tid >> 2;
            As[kq + 0][r] = a0.x; As[kq + 1][r] = a0.y; As[kq + 2][r] = a0.z; As[kq + 3][r] = a0.w;
            As[kq + 0][r + 64] = a1.x; As[kq + 1][r + 64] = a1.y; As[kq + 2][r + 64] = a1.z; As[kq + 3][r + 64] = a1.w;
            if (BT) {
                Bs[kq + 0][r] = b0.x; Bs[kq + 1][r] = b0.y; Bs[kq + 2][r] = b0.z; Bs[kq + 3][r] = b0.w;
                Bs[kq + 0][r + 64] = b1.x; Bs[kq + 1][r + 64] = b1.y; Bs[kq + 2][r + 64] = b1.z; Bs[kq + 3][r + 64] = b1.w;
            } else {
                *(float4*)&Bs[tid >> 5][(tid & 31) * 4] = b0;
                *(float4*)&Bs[(tid >> 5) + 8][(tid & 31) * 4] = b1;
            }
        }
        __syncthreads();
#pragma unroll
        for (int kk = 0; kk < 16; ++kk) {
            float4 x0 = *(const float4*)&As[kk][ty * 4], x1 = *(const float4*)&As[kk][64 + ty * 4];
            float4 y0 = *(const float4*)&Bs[kk][tx * 4], y1 = *(const float4*)&Bs[kk][64 + tx * 4];
            float av[8] = {x0.x, x0.y, x0.z, x0.w, x1.x, x1.y, x1.z, x1.w};
            float bv[8] = {y0.x, y0.y, y0.z, y0.w, y1.x, y1.y, y1.z, y1.w};
#pragma unroll
            for (int i = 0; i < 8; ++i)
#pragma unroll
                for (int j = 0; j < 8; ++j) acc[i][j] = fmaf(av[i], bv[j], acc[i][j]);
        }
    }
#pragma unroll
    for (int i = 0; i < 8; ++i) {
        int row = m0 + (i < 4 ? ty * 4 + i : 64 + ty * 4 + i - 4);
        if (row < M) {
#pragma unroll
            for (int j = 0; j < 8; ++j) {
                int col = n0 + (j < 4 ? tx * 4 + j : 64 + tx * 4 + j - 4);
                if (col < p.N) epi(z, row, col, acc[i][j]);
            }
        }
    }
}

struct EpiStore { float* C; long ldc; long sCz;
    __device__ void operator()(int z, int row, int col, float v) const { C[(long)z * sCz + (long)row * ldc + col] = v; } };
struct EpiPV { float* O; long rowbase;
    __device__ void operator()(int z, int row, int col, float v) const { O[(long)(z & 1) * T * 512 + (rowbase + row) * 512 + (z >> 1) * 128 + col] = v; } };
struct EpiX1 { const float* x; const float* mod; float* x1;
    __device__ void operator()(int z, int row, int col, float v) const { int b = row / SEQ; x1[(long)row * D + col] = x[(long)row * D + col] + mod[(long)b * 6 * D + 2 * D + col] * v; } };
struct EpiAct { const float* U; float* Aout;
    __device__ void operator()(int z, int row, int col, float v) const { long o = (long)row * DE + col; Aout[o] = siluf(U[o]) * v; } };
struct EpiFfn { float* ffn; const int* tok; const float* wt; long first;
    __device__ void operator()(int z, int row, int col, float v) const {
        long t = tok ? tok[row] : row; float w = wt ? wt[row] : 1.0f; float* p = ffn + t * D + col;
        if (first) *p = w * v; else *p += w * v; } };

__global__ __launch_bounds__(256) void k_rope(float* P, int mode) {
    const int ngroups = mode == 0 ? 16 : 8;
    long idx = (long)blockIdx.x * 256 + threadIdx.x;
    long total = (long)NR * ngroups * 32;
    if (idx >= total) return;
    int f = idx & 15, a = (idx >> 4) & 1; int grp = (idx >> 5) % ngroups; long R = (idx >> 5) / ngroups;
    int i = R % RB;
    float* p = P + R * 1536 + grp * 64 + a * 32 + f;
    float x1 = p[0], x2 = p[16];
    float scale = 1.0f;
    if (mode == 0) { if (grp < 8) scale = 0.125f; } else { if (grp >= 4) scale = 0.125f; }
    if (i >= CTX) {
        int t = i - CTX; int pos = a == 0 ? t / 64 : t % 64;
        float inv_freq = (float)pow(10000.0, -(double)f / 16.0);
        float ang = (float)pos * inv_freq;
        float s, c; sincosf(ang, &s, &c);
        float o1 = x1 * c - x2 * s, o2 = x1 * s + x2 * c;
        x1 = o1; x2 = o2;
    }
    p[0] = x1 * scale; p[16] = x2 * scale;
}

__global__ __launch_bounds__(256) void k_softmax(float* S) {
    __shared__ float red[8];
    float* row = S + (long)blockIdx.x * RB;
    float v[33];
    float mx = -INFINITY;
#pragma unroll
    for (int i = 0; i < 33; ++i) { v[i] = row[i * 256 + threadIdx.x]; mx = fmaxf(mx, v[i]); }
    mx = block_max(mx, red);
    float sm = 0;
#pragma unroll
    for (int i = 0; i < 33; ++i) { v[i] = expf(v[i] - mx); sm += v[i]; }
    sm = block_sum(sm, red);
    float inv = 1.0f / sm;
#pragma unroll
    for (int i = 0; i < 33; ++i) row[i * 256 + threadIdx.x] = v[i] * inv;
}

__global__ __launch_bounds__(256) void k_ret(const float* Pret, const float* dec_f, const float* dec_b, float* ret) {
    __shared__ float sq[32][64], sk[32][64], sv[32][128];
    const int b = blockIdx.x >> 2, h = blockIdx.x & 3, tid = threadIdx.x;
    const int j = tid >> 1, hh = tid & 1;
    for (int dir = 0; dir < 2; ++dir) {
        float d = dir == 0 ? dec_f[h] : dec_b[h];
        float g = 1.0f / (1.0f + expf(-d));
        float S[32];
#pragma unroll
        for (int ii = 0; ii < 32; ++ii) S[ii] = 0.f;
        for (int ch = 0; ch < RB / 32; ++ch) {
            __syncthreads();
            for (int tt = 0; tt < 32; ++tt) {
                int s = ch * 32 + tt;
                int i = dir == 0 ? s : (s < CTX ? CTX - 1 - s : RB - 1 - (s - CTX));
                const float* src = Pret + ((long)b * RB + i) * 1536;
                if (tid < 64) sq[tt][tid] = src[h * 64 + tid];
                else if (tid < 128) sk[tt][tid - 64] = src[256 + h * 64 + tid - 64];
                else sv[tt][tid - 128] = src[512 + h * 128 + tid - 128];
            }
            __syncthreads();
            for (int tt = 0; tt < 32; ++tt) {
                float v = sv[tt][j];
                float o = 0.f;
#pragma unroll
                for (int ii = 0; ii < 32; ++ii) {
                    S[ii] = fmaf(g, S[ii], sk[tt][hh * 32 + ii] * v);
                    o = fmaf(sq[tt][hh * 32 + ii], S[ii], o);
                }
                o += __shfl_xor(o, 1);
                int s = ch * 32 + tt;
                if (s >= CTX && hh == 0) {
                    int i = dir == 0 ? s : RB - 1 - (s - CTX);
                    float* dst = ret + ((long)b * SEQ + (i - CTX)) * 512 + h * 128 + j;
                    if (dir == 0) *dst = o; else *dst += o;
                }
            }
        }
    }
}

__global__ __launch_bounds__(256) void k_merge(const float* O, const float* ret, const float* Pret, const float* lq1, const float* lk1, const float* lq2,
                                               const float* lk2, const float* gd, const float* gr, float* mix, const bf16_t* MIXb) {
    const int t = blockIdx.x, h = threadIdx.x >> 6, lane = threadIdx.x & 63;
    float s1 = wave_sum(lq1[lane] * lk1[lane]), s2 = wave_sum(lq2[lane] * lk2[lane]);
    float lam = expf(s1) - expf(s2) + 0.2f;
    const int b = t / SEQ, tt = t % SEQ;
    const float* o0 = O + (long)t * 512 + h * 128, * o1 = O + (long)T * 512 + (long)t * 512 + h * 128;
    float a0 = o0[lane] - lam * o1[lane], a1 = o0[lane + 64] - lam * o1[lane + 64];
    float ms = wave_sum(a0 * a0 + a1 * a1) * (1.0f / 128);
    float rs = rsqrtf(ms + EPS);
    if (MIXb) { mix[(long)t * D + h * 128 + lane] = __uint_as_float(((unsigned)MIXb[(long)t * D + h * 128 + lane]) << 16); mix[(long)t * D + h * 128 + lane + 64] = __uint_as_float(((unsigned)MIXb[(long)t * D + h * 128 + lane + 64]) << 16); }
    else {
    mix[(long)t * D + h * 128 + lane] = a0 * rs * gd[lane] * 0.8f;
    mix[(long)t * D + h * 128 + lane + 64] = a1 * rs * gd[lane + 64] * 0.8f; }
    if (MIXb) { mix[(long)t * D + 512 + h * 128 + lane] = __uint_as_float(((unsigned)MIXb[(long)t * D + 512 + h * 128 + lane]) << 16); mix[(long)t * D + 512 + h * 128 + lane + 64] = __uint_as_float(((unsigned)MIXb[(long)t * D + 512 + h * 128 + lane + 64]) << 16); return; }
    const float* rr = ret + (long)t * 512 + h * 128;
    const float* rg = Pret + ((long)b * RB + CTX + tt) * 1536 + 1024 + h * 128;
    float r0 = rr[lane], r1 = rr[lane + 64];
    float ms2 = wave_sum(r0 * r0 + r1 * r1) * (1.0f / 128);
    float rs2 = rsqrtf(ms2 + EPS);
    mix[(long)t * D + 512 + h * 128 + lane] = siluf(rg[lane]) * r0 * rs2 * gr[lane];
    mix[(long)t * D + 512 + h * 128 + lane + 64] = siluf(rg[lane + 64]) * r1 * rs2 * gr[lane + 64];
}

__global__ __launch_bounds__(256) void k_ln2(const float* x1, const float* g, const float* mod, float* h2) {
    __shared__ float red[8];
    int t = blockIdx.x, b = t / SEQ;
    const float* m = mod + (size_t)b * 6 * D;
    float4 v = ((const float4*)(x1 + (size_t)t * D))[threadIdx.x];
    float ss = block_sum(v.x * v.x + v.y * v.y + v.z * v.z + v.w * v.w, red);
    float rstd = rsqrtf(ss * (1.0f / D) + EPS);
    int c0 = threadIdx.x * 4;
    float4 gg = ((const float4*)g)[threadIdx.x], sh = *(const float4*)(m + 3 * D + c0), sc = *(const float4*)(m + 4 * D + c0);
    float4 o;
    o.x = v.x * rstd * gg.x * (1 + sc.x) + sh.x; o.y = v.y * rstd * gg.y * (1 + sc.y) + sh.y;
    o.z = v.z * rstd * gg.z * (1 + sc.z) + sh.z; o.w = v.w * rstd * gg.w * (1 + sc.w) + sh.w;
    ((float4*)(h2 + (size_t)t * D))[threadIdx.x] = o;
}

__global__ __launch_bounds__(256) void k_topk(const float* logits, const float* bias, int* cnt, int* tok_list, float* wt_list) {
    const int t = blockIdx.x * 4 + (threadIdx.x >> 6), lane = threadIdx.x & 63;
    float score = 1.0f / (1.0f + expf(-logits[(long)t * NE + lane]));
    float sel = score + bias[lane];
    float m1 = sel, m2 = -INFINITY;
#pragma unroll
    for (int o = 1; o < 8; o <<= 1) {
        float p1 = __shfl_xor(m1, o), p2 = __shfl_xor(m2, o);
        float n1 = fmaxf(m1, p1), n2 = fmaxf(fminf(m1, p1), fmaxf(m2, p2));
        m1 = n1; m2 = n2;
    }
    float gs = m1 + m2;
    const int grp = lane >> 3;
    int grank = 0;
#pragma unroll
    for (int g2 = 0; g2 < 8; ++g2) {
        float og = __shfl(gs, g2 * 8);
        grank += (og > gs || (og == gs && g2 < grp)) ? 1 : 0;
    }
    float val = grank < 4 ? sel : -INFINITY;
    int rank = 0;
    for (int e = 0; e < 64; ++e) {
        float ov = __shfl(val, e);
        rank += (ov > val || (ov == val && e < lane)) ? 1 : 0;
    }
    bool chosen = rank < 8;
    float wsum = wave_sum(chosen ? score : 0.f);
    if (chosen) {
        int slot = atomicAdd(&cnt[lane], 1);
        tok_list[lane * ECAP + slot] = t;
        wt_list[lane * ECAP + slot] = score / wsum * 2.5f;
    }
}

__global__ __launch_bounds__(256) void k_final(const float* x1, const float* mod, const float* gf, float* out) {
    __shared__ float red[8];
    int t = blockIdx.x, b = t / SEQ;
    const float* m = mod + (size_t)b * 6 * D + 5 * D;
    float4 v = ((const float4*)(x1 + (size_t)t * D))[threadIdx.x];
    float4 f = ((const float4*)(out + (size_t)t * D))[threadIdx.x];
    float4 g2 = ((const float4*)m)[threadIdx.x];
    v.x += g2.x * f.x; v.y += g2.y * f.y; v.z += g2.z * f.z; v.w += g2.w * f.w;
    float ss = block_sum(v.x * v.x + v.y * v.y + v.z * v.z + v.w * v.w, red);
    float rstd = rsqrtf(ss * (1.0f / D) + EPS);
    float4 gg = ((const float4*)gf)[threadIdx.x];
    float4 o; o.x = v.x * rstd * gg.x; o.y = v.y * rstd * gg.y; o.z = v.z * rstd * gg.z; o.w = v.w * rstd * gg.w;
    ((float4*)(out + (size_t)t * D))[threadIdx.x] = o;
}


typedef short bf16x8 __attribute__((ext_vector_type(8)));
typedef short s16x4 __attribute__((ext_vector_type(4)));
typedef float f32x4 __attribute__((ext_vector_type(4)));
typedef float f32x16 __attribute__((ext_vector_type(16)));
typedef unsigned u32x2 __attribute__((ext_vector_type(2)));
typedef unsigned u32x4 __attribute__((ext_vector_type(4)));
extern __shared__ __attribute__((aligned(1024))) char smem[];
constexpr int NTHR = 512;
constexpr int GEMM_LDS = 131072;

__device__ __forceinline__ unsigned cvtpk(float lo, float hi) { unsigned r; asm volatile("v_cvt_pk_bf16_f32 %0, %1, %2" : "=v"(r) : "v"(lo), "v"(hi)); return r; }
__device__ __forceinline__ bf16_t f2bf(float v) { return (bf16_t)(cvtpk(v, v) & 0xffffu); }
__device__ __forceinline__ float bf2f(bf16_t v) { return __uint_as_float(((unsigned)v) << 16); }

struct MK {
    const float *x, *c, *ctx, *cctx, *ada_w, *ada_b, *norm1_g, *w_in, *lq1, *lk1, *lq2, *lk2, *dattn_g, *dec_f, *dec_b, *ret_g, *w_out, *norm2_g, *router_w, *router_b,
        *ew1, *ew3, *ew2, *sw1, *sw3, *sw2, *final_g;
    float* out;
    float* mod; float* ropec; float* ropes;
    bf16_t *w_inT, *w_outT, *W13t, *W2t, *routerT;
    bf16_t *H, *Q, *K, *V, *RQ, *RK, *KTf, *KTb, *VT, *RG, *MIX, *KV, *ST, *H2, *ACT;
    unsigned char* Y; int* cnt; int* tok_list; float* wt_list; int* tokmap;
    float* dbgP; long dbg_lo, dbg_hi; long conv_limit;
};

__device__ void ph_mod(const MK& p, int bid, int nb) {
    float* red = (float*)smem;
    for (int it = bid; it < 6 * D / 32; it += nb) {
        const int col = threadIdx.x & 31, kg = threadIdx.x >> 5, j = it * 32 + col;
        float a[5] = {0, 0, 0, 0, 0};
        for (int k = kg * 64; k < kg * 64 + 64; ++k) {
            float w = p.ada_w[(size_t)k * 6 * D + j];
#pragma unroll
            for (int r = 0; r < 5; ++r) { float cv = r < 4 ? p.c[r * D + k] : p.cctx[k]; a[r] += siluf(cv) * w; }
        }
        __syncthreads();
#pragma unroll
        for (int r = 0; r < 5; ++r) red[(kg * 5 + r) * 32 + col] = a[r];
        __syncthreads();
        if (threadIdx.x < 160) {
            int r = threadIdx.x >> 5; float s = 0;
            for (int g = 0; g < 16; ++g) s += red[(g * 5 + r) * 32 + col];
            p.mod[(size_t)r * 6 * D + j] = s + p.ada_b[j];
        }
    }
    if (bid == nb - 1) {
        for (int i = threadIdx.x; i < 128 * 16; i += NTHR) {
            int pos = i >> 4, f = i & 15;
            float inv_freq = (float)pow(10000.0, -(double)f / 16.0);
            float s, c; sincosf((float)pos * inv_freq, &s, &c);
            p.ropec[i] = c; p.ropes[i] = s;
        }
    }
    __syncthreads();
}

__device__ __forceinline__ void tr_tile(const float* src, int ldsrc, int k0, int n0, bf16_t* dst, int lddst, int mode  , bf16_t* dst2) {
    float* t = (float*)smem;
    __syncthreads();
    for (int i = threadIdx.x; i < 64 * 16; i += NTHR) {
        int r = i >> 4, c4 = (i & 15) * 4;
        float4 v = *(const float4*)(src + (size_t)(k0 + r) * ldsrc + n0 + c4);
        t[r * 65 + c4] = v.x; t[r * 65 + c4 + 1] = v.y; t[r * 65 + c4 + 2] = v.z; t[r * 65 + c4 + 3] = v.w;
    }
    __syncthreads();
    for (int i = threadIdx.x; i < 64 * 16; i += NTHR) {
        int n = i >> 4, k4 = (i & 15) * 4;
        float a = t[(k4 + 0) * 65 + n], b = t[(k4 + 1) * 65 + n], c = t[(k4 + 2) * 65 + n], d = t[(k4 + 3) * 65 + n];
        int nn = n0 + n, row = nn;
        if (mode == 1 || mode == 2) { int ct = nn >> 7, wc = (nn & 127) >> 5, within = nn & 31; row = ct * 256 + wc * 64 + (mode == 2 ? 32 : 0) + within; }
        u32x2 w; w.x = cvtpk(a, b); w.y = cvtpk(c, d);
        *(u32x2*)(dst + (size_t)row * lddst + k0 + k4) = w;
        if (mode == 3) {
            float ah = bf2f((bf16_t)(w.x & 0xffff)), bh = bf2f((bf16_t)(w.x >> 16)), ch = bf2f((bf16_t)(w.y & 0xffff)), dh = bf2f((bf16_t)(w.y >> 16));
            u32x2 l; l.x = cvtpk(a - ah, b - bh); l.y = cvtpk(c - ch, d - dh);
            *(u32x2*)(dst2 + (size_t)row * lddst + k0 + k4) = l;
        }
    }
}
__device__ void ph_convert(const MK& p, int bid, int nb) {
    const int n_win = 16 * 48, n_wout = 16 * 16, n_rt = 16, n_e13 = 65 * 2 * 16 * 4, n_e2 = 65 * 4 * 16;
    int total = n_win + n_wout + n_rt + n_e13 + n_e2; if (p.conv_limit < total) total = (int)p.conv_limit;
    for (int it = bid; it < total; it += nb) {
        int j = it;
        if (j < n_win) { tr_tile(p.w_in, 3072, (j / 48) * 64, (j % 48) * 64, p.w_inT, 1024, 0, nullptr); continue; } j -= n_win;
        if (j < n_wout) { tr_tile(p.w_out, 1024, (j / 16) * 64, (j % 16) * 64, p.w_outT, 1024, 0, nullptr); continue; } j -= n_wout;
        if (j < n_rt) { tr_tile(p.router_w, 64, j * 64, 0, p.routerT, 1024, 3, p.routerT + 64 * 1024); continue; } j -= n_rt;
        if (j < n_e13) {
            int e = j / 128, r = j % 128, which = r / 64, tt = r % 64;
            const float* src = e < 64 ? (which ? p.ew3 : p.ew1) + (size_t)e * D * DE : (which ? p.sw3 : p.sw1);
            tr_tile(src, DE, (tt / 4) * 64, (tt % 4) * 64, p.W13t + (size_t)e * 512 * 1024, 1024, 1 + which, nullptr); continue; } j -= n_e13;
        { int e = j / 64, tt = j % 64;
          const float* src = e < 64 ? p.ew2 + (size_t)e * DE * D : p.sw2;
          tr_tile(src, D, (tt / 16) * 64, (tt % 16) * 64, p.W2t + (size_t)e * 1024 * 256, 256, 0, nullptr); }
    }
    __syncthreads();
}

__device__ void ph_ln1(const MK& p, int bid, int nb) {
    const int wid = threadIdx.x >> 6, lane = threadIdx.x & 63;
    for (int R = bid * 8 + wid; R < NR; R += nb * 8) {
        int b = R / RB, i = R % RB;
        const float* src = i < CTX ? p.ctx + ((size_t)b * CTX + i) * D : p.x + ((size_t)b * SEQ + (i - CTX)) * D;
        const float* m = p.mod + (size_t)(i < CTX ? 4 : b) * 6 * D;
        float4 v[4]; float ss = 0;
#pragma unroll
        for (int q = 0; q < 4; ++q) { v[q] = *(const float4*)(src + q * 256 + lane * 4); ss += v[q].x * v[q].x + v[q].y * v[q].y + v[q].z * v[q].z + v[q].w * v[q].w; }
        ss = wave_sum(ss);
        float rstd = rsqrtf(ss * (1.0f / D) + EPS);
#pragma unroll
        for (int q = 0; q < 4; ++q) {
            int c0 = q * 256 + lane * 4;
            float4 gg = *(const float4*)(p.norm1_g + c0), sh = *(const float4*)(m + c0), sc = *(const float4*)(m + D + c0);
            float o0 = v[q].x * rstd * gg.x * (1 + sc.x) + sh.x, o1 = v[q].y * rstd * gg.y * (1 + sc.y) + sh.y;
            float o2 = v[q].z * rstd * gg.z * (1 + sc.z) + sh.z, o3 = v[q].w * rstd * gg.w * (1 + sc.w) + sh.w;
            u32x2 w; w.x = cvtpk(o0, o1); w.y = cvtpk(o2, o3);
            *(u32x2*)(p.H + (size_t)R * D + c0) = w;
        }
    }
}

__device__ __forceinline__ int lds_byte(int r, int c) { int st = (r >> 4) * 2 + (c >> 5), ob = (r & 15) * 64 + (c & 31) * 2; return st * 1024 + (ob ^ (((ob >> 9) & 1) << 5)); }
__device__ __forceinline__ void stage_rc(int b, int& R, int& C) { int st = b >> 10, sb = b & 1023, swz = sb ^ (((sb >> 9) & 1) << 5); R = (st / 2) * 16 + swz / 64; C = (st % 2) * 32 + (swz % 64) / 2; }
#define WAIT_V0() asm volatile("s_waitcnt vmcnt(0)" ::: "memory")
__device__ __forceinline__ void gemm_core(const bf16_t* const (&Ap)[4], const bf16_t* const (&Bp)[4], int nt, f32x4 (&acc)[8][4]) {
    const int tid = threadIdx.x, wid = tid >> 6, lane = tid & 63, wr = wid >> 2, wc = wid & 3, fr = lane & 15, fq = lane >> 4;
#pragma unroll
    for (int m = 0; m < 8; ++m)
#pragma unroll
        for (int n = 0; n < 4; ++n) acc[m][n] = (f32x4){0.f, 0.f, 0.f, 0.f};
#define G_SA(b) (smem + (b) * 65536)
#define G_SB(b) (smem + (b) * 65536 + 32768)
#define G_STAGE(buf, kt) do { _Pragma("unroll") for (int i = 0; i < 4; ++i) {                                                     \
        __builtin_amdgcn_global_load_lds((const unsigned*)(Ap[i] + (kt) * 64), (unsigned*)(G_SA(buf) + wid * 1024 + i * 8192), 16, 0, 0); \
        __builtin_amdgcn_global_load_lds((const unsigned*)(Bp[i] + (kt) * 64), (unsigned*)(G_SB(buf) + wid * 1024 + i * 8192), 16, 0, 0); } } while (0)
    G_STAGE(0, 0); WAIT_V0(); __syncthreads();
    for (int t = 0; t < nt; ++t) {
        const int cur = t & 1;
        if (t + 1 < nt) G_STAGE(cur ^ 1, t + 1);
#pragma unroll
        for (int ks = 0; ks < 2; ++ks) {
            bf16x8 At[8], Bf[4];
#pragma unroll
            for (int m = 0; m < 8; ++m) At[m] = *(const bf16x8*)(G_SA(cur) + lds_byte(wr * 128 + m * 16 + fr, ks * 32 + fq * 8));
#pragma unroll
            for (int n = 0; n < 4; ++n) Bf[n] = *(const bf16x8*)(G_SB(cur) + lds_byte(wc * 64 + n * 16 + fr, ks * 32 + fq * 8));
#pragma unroll
            for (int m = 0; m < 8; ++m)
#pragma unroll
                for (int n = 0; n < 4; ++n) acc[m][n] = __builtin_amdgcn_mfma_f32_16x16x32_bf16(Bf[n], At[m], acc[m][n], 0, 0, 0);
            __builtin_amdgcn_sched_barrier(0);
        }
        WAIT_V0(); __syncthreads();
    }
}
__device__ __forceinline__ void stage_ptrs(const bf16_t* base, long ld, const bf16_t* (&P)[4]) {
    const int wid = threadIdx.x >> 6, lane = threadIdx.x & 63;
#pragma unroll
    for (int i = 0; i < 4; ++i) { int R, C; stage_rc(wid * 1024 + i * 8192 + lane * 16, R, C); P[i] = base + (long)R * ld + C; }
}

__device__ void ph_gemm_in(const MK& p, int bid, int nb) {
    const int tid = threadIdx.x, wid = tid >> 6, lane = tid & 63, wr = wid >> 2, wc = wid & 3, fr = lane & 15, fq = lane >> 4;
    const int nM = NR / 256, nN = 12;
    for (int tile = bid; tile < nM * nN; tile += nb) {
        const int pm = tile / nN, pn = tile % nN;
        if (pn < p.dbg_lo || pn >= p.dbg_hi) continue;
        const int brow = pm * 256, bcol = pn * 256;
        const bf16_t *Ap[4], *Bp[4];
        stage_ptrs(p.H + (size_t)brow * D, D, Ap); stage_ptrs(p.w_inT + (size_t)bcol * D, D, Bp);
        f32x4 acc[8][4];
        gemm_core(Ap, Bp, D / 64, acc);
        const int b = brow / RB, i0 = brow % RB;
        const bool lat = i0 >= CTX;
        const int seg = pn;
        const bool do_rope = lat && (seg <= 3 || seg == 6 || seg == 7);
        float lg2f = 0.f, lg2b = 0.f;
        if (seg == 7) { float df = p.dec_f[wc], db = p.dec_b[wc]; lg2f = log2f(1.0f / (1.0f + expf(-df))); lg2b = log2f(1.0f / (1.0f + expf(-db))); }
        const int cw = bcol + wc * 64;
#pragma unroll
        for (int m = 0; m < 8; ++m) {
            int ioff = m * 16; asm volatile("" : "+v"(ioff) :: "memory");
            const int i = i0 + wr * 128 + fr + ioff, t = i - CTX;
            float v[4][4];
#pragma unroll
            for (int n = 0; n < 4; ++n)
#pragma unroll
                for (int j = 0; j < 4; ++j) v[n][j] = acc[m][n][j];
            if (do_rope) {
                const int prow = t >> 6, pcol = t & 63;
                const float4 c0 = *(const float4*)(p.ropec + prow * 16 + fq * 4), s0 = *(const float4*)(p.ropes + prow * 16 + fq * 4);
                const float4 c1 = *(const float4*)(p.ropec + pcol * 16 + fq * 4), s1 = *(const float4*)(p.ropes + pcol * 16 + fq * 4);
                const float cc0[4] = {c0.x, c0.y, c0.z, c0.w}, ss0[4] = {s0.x, s0.y, s0.z, s0.w}, cc1[4] = {c1.x, c1.y, c1.z, c1.w}, ss1[4] = {s1.x, s1.y, s1.z, s1.w};
#pragma unroll
                for (int j = 0; j < 4; ++j) {
                    float x1 = v[0][j], x2 = v[1][j]; v[0][j] = x1 * cc0[j] - x2 * ss0[j]; v[1][j] = x1 * ss0[j] + x2 * cc0[j];
                    float y1 = v[2][j], y2 = v[3][j]; v[2][j] = y1 * cc1[j] - y2 * ss1[j]; v[3][j] = y1 * ss1[j] + y2 * cc1[j];
                }
            }
            if (seg == 7) {
#pragma unroll
                for (int n = 0; n < 4; ++n)
#pragma unroll
                    for (int j = 0; j < 4; ++j) v[n][j] *= 0.125f;
            }
            if (p.dbgP) {
                {
                    float* dp = p.dbgP + (size_t)(brow + wr * 128 + fr + ioff) * 1536 + (cw % 1536) + fq * 4; const float sc = seg <= 1 ? 0.125f : 1.0f;
#pragma unroll
                    for (int n = 0; n < 4; ++n) *(float4*)(dp + n * 16) = make_float4(v[n][0] * sc, v[n][1] * sc, v[n][2] * sc, v[n][3] * sc);
                }
            } else {
                u32x2 w[4];
#pragma unroll
                for (int n = 0; n < 4; ++n) { w[n].x = cvtpk(v[n][0], v[n][1]); w[n].y = cvtpk(v[n][2], v[n][3]); }
                if (seg <= 5) {
                    const int cc = cw - (seg <= 1 ? 0 : seg <= 3 ? 512 : 1024), h = cc >> 7, wi = (cc & 127) + fq * 4;
                    bf16_t* dp = seg <= 1 ? p.Q + (((size_t)(b * 4 + h) * SEQ + t) * 128 + wi) : (seg <= 3 ? p.K : p.V) + (((size_t)(b * 4 + h) * RB + i) * 128 + wi);
                    if (seg > 1 || lat) {
#pragma unroll
                        for (int n = 0; n < 4; ++n) *(u32x2*)(dp + n * 16) = w[n];
                    }
                } else if (seg <= 7) {
                    bf16_t* dp = (seg == 6 ? p.RQ : p.RK) + (((size_t)(b * 4 + wc) * RB + i) * 64 + fq * 4);
#pragma unroll
                    for (int n = 0; n < 4; ++n) *(u32x2*)(dp + n * 16) = w[n];
                    if (seg == 7) {
                        const int pos = i & 127;
                        const float ff = exp2f((float)(127 - pos) * lg2f), fb = exp2f((float)pos * lg2b);
                        const size_t o = ((size_t)(b * 4 + wc) * 64 + fq * 4) * RB + i;
#pragma unroll
                        for (int n = 0; n < 4; ++n)
#pragma unroll
                            for (int j = 0; j < 4; ++j) { p.KTf[o + (size_t)(n * 16 + j) * RB] = f2bf(v[n][j] * ff); p.KTb[o + (size_t)(n * 16 + j) * RB] = f2bf(v[n][j] * fb); }
                    }
                } else if (seg <= 9) {
                    const int cc = cw - 2048, h = cc >> 7, e = (cc & 127) + fq * 4;
                    const size_t o = ((size_t)(b * 4 + h) * 128 + e) * RB + i;
#pragma unroll
                    for (int n = 0; n < 4; ++n)
#pragma unroll
                        for (int j = 0; j < 4; ++j) p.VT[o + (size_t)(n * 16 + j) * RB] = f2bf(v[n][j]);
                } else if (lat) {
                    bf16_t* dp = p.RG + ((size_t)(b * SEQ + t) * 512 + (cw - 2560) + fq * 4);
#pragma unroll
                    for (int n = 0; n < 4; ++n) *(u32x2*)(dp + n * 16) = w[n];
                }
            }
        }
    }
}


constexpr int A_KVBLK = 64;
constexpr float A_SCALE = 0.125f, A_THR = 8.f;
constexpr int A_SHM_V = A_KVBLK * 128 * 2, A_SHM_K = A_KVBLK * 128 * 2;
#define KSWZ(row, colB) ((row) * 256 + ((colB) ^ (((row) & 7) << 4)))
#define SBAR() __builtin_amdgcn_sched_barrier(0)
__device__ __forceinline__ int crow(int r, int hi) { return (r & 3) + 8 * (r >> 2) + 4 * hi; }

__device__ __forceinline__ void partialSM(f32x16& p0, f32x16& p1, float& m_reg, float& mn, float& alpha) {
    constexpr float C = A_SCALE * 1.4426950408889634f;
    float pmax = p0[0];
#pragma unroll
    for (int r = 1; r < 16; ++r) pmax = fmaxf(pmax, p0[r]);
#pragma unroll
    for (int r = 0; r < 16; ++r) pmax = fmaxf(pmax, p1[r]);
    { auto rr = __builtin_amdgcn_permlane32_swap(__float_as_uint(pmax), __float_as_uint(pmax), false, false);
      pmax = fmaxf(__uint_as_float(rr[0]), __uint_as_float(rr[1])); }
    if (__builtin_expect(__all(pmax - m_reg <= A_THR / A_SCALE), 1)) { mn = m_reg; alpha = 1.f; }
    else { mn = fmaxf(m_reg, pmax); alpha = __builtin_amdgcn_exp2f((m_reg - mn) * C); m_reg = mn; }
    float mnC = -mn * C;
#pragma unroll
    for (int r = 0; r < 16; ++r) p0[r] = fmaf(p0[r], C, mnC);
#pragma unroll
    for (int r = 0; r < 16; ++r) p1[r] = fmaf(p1[r], C, mnC);
#pragma unroll
    for (int r = 0; r < 16; ++r) p0[r] = __builtin_amdgcn_exp2f(p0[r]);
}
#define PK4(P, BASE, OUT) do { unsigned a0 = cvtpk(P[BASE + 0], P[BASE + 1]), a1 = cvtpk(P[BASE + 2], P[BASE + 3]);   \
    unsigned b0 = cvtpk(P[BASE + 4], P[BASE + 5]), b1 = cvtpk(P[BASE + 6], P[BASE + 7]);                              \
    auto r0 = __builtin_amdgcn_permlane32_swap(a0, b0, false, false); auto r1 = __builtin_amdgcn_permlane32_swap(a1, b1, false, false); \
    u32x4 w = {r0[0], r1[0], r0[1], r1[1]}; OUT = *reinterpret_cast<bf16x8*>(&w); } while (0)
__device__ __forceinline__ void finishSM(f32x16& p0, f32x16& p1, float alpha, float& l_reg, bf16x8& pa0, bf16x8& pa1, bf16x8& pa2, bf16x8& pa3) {
#pragma unroll
    for (int r = 0; r < 16; ++r) p1[r] = __builtin_amdgcn_exp2f(p1[r]);
    float ps = 0;
#pragma unroll
    for (int r = 0; r < 16; ++r) ps += p0[r];
#pragma unroll
    for (int r = 0; r < 16; ++r) ps += p1[r];
    { auto rr = __builtin_amdgcn_permlane32_swap(__float_as_uint(ps), __float_as_uint(ps), false, false);
      ps = __uint_as_float(rr[0]) + __uint_as_float(rr[1]); }
    l_reg = l_reg * alpha + ps;
    PK4(p0, 0, pa0); PK4(p0, 8, pa1); PK4(p1, 0, pa2); PK4(p1, 8, pa3);
}
__device__ __forceinline__ void qkt(f32x16& p0, f32x16& p1, const char* Ks, const bf16x8* qr, int r32, int hi, int mapc) {
    p0 = f32x16{}; p1 = f32x16{};
#pragma unroll
    for (int d0 = 0; d0 < 4; ++d0) { int cb = (mapc + d0 * 16 + hi * 8) * 2;
        bf16x8 b0 = *reinterpret_cast<const bf16x8*>(Ks + KSWZ(r32, cb));
        bf16x8 b1 = *reinterpret_cast<const bf16x8*>(Ks + KSWZ(32 + r32, cb));
        p0 = __builtin_amdgcn_mfma_f32_32x32x16_bf16(b0, qr[d0], p0, 0, 0, 0);
        p1 = __builtin_amdgcn_mfma_f32_32x32x16_bf16(b1, qr[d0], p1, 0, 0, 0); }
}
__device__ __forceinline__ int v_st(int k, int c) { const int kk = (k & ~0xC) | ((k & 4) << 1) | ((k & 8) >> 1); return ((kk >> 3) * 4 + (c >> 5)) * 512 + ((kk & 7) * 32 + (c & 31)) * 2; }
__device__ __forceinline__ int v_rd_base(int lane) { return ((lane & 3) << 3) | (((lane >> 2) & 3) << 6) | (((lane >> 4) & 1) << 5) | (((lane >> 5) & 1) << 8); }
constexpr int v_rd_off(int d0, int ks, int half) { return d0 * 512 + ks * 4096 + half * 2048; }
template <int OFF> __device__ __forceinline__ s16x4 tr_read(int vb) {
    s16x4 r; asm volatile("ds_read_b64_tr_b16 %0, %1 offset:%2" : "=&v"(r) : "v"(vb), "i"(OFF) : "memory"); return r;
}
template <int D0> __device__ __forceinline__ void pv_one(f32x16& od, int vb, bf16x8 pa0, bf16x8 pa1, bf16x8 pa2, bf16x8 pa3) {
    const s16x4 l0 = tr_read<v_rd_off(D0, 0, 0)>(vb), h0 = tr_read<v_rd_off(D0, 0, 1)>(vb), l1 = tr_read<v_rd_off(D0, 1, 0)>(vb), h1 = tr_read<v_rd_off(D0, 1, 1)>(vb);
    const s16x4 l2 = tr_read<v_rd_off(D0, 2, 0)>(vb), h2 = tr_read<v_rd_off(D0, 2, 1)>(vb), l3 = tr_read<v_rd_off(D0, 3, 0)>(vb), h3 = tr_read<v_rd_off(D0, 3, 1)>(vb);
    asm volatile("s_waitcnt lgkmcnt(0)" ::: "memory"); SBAR();
#define PKV(L, H) (bf16x8){L[0], L[1], L[2], L[3], H[0], H[1], H[2], H[3]}
    od = __builtin_amdgcn_mfma_f32_32x32x16_bf16(pa0, PKV(l0, h0), od, 0, 0, 0);
    od = __builtin_amdgcn_mfma_f32_32x32x16_bf16(pa1, PKV(l1, h1), od, 0, 0, 0);
    od = __builtin_amdgcn_mfma_f32_32x32x16_bf16(pa2, PKV(l2, h2), od, 0, 0, 0);
    od = __builtin_amdgcn_mfma_f32_32x32x16_bf16(pa3, PKV(l3, h3), od, 0, 0, 0);
}
__device__ __forceinline__ void pv_d0(f32x16* o, int vb, bf16x8 pa0, bf16x8 pa1, bf16x8 pa2, bf16x8 pa3) {
    pv_one<0>(o[0], vb, pa0, pa1, pa2, pa3); pv_one<1>(o[1], vb, pa0, pa1, pa2, pa3); pv_one<2>(o[2], vb, pa0, pa1, pa2, pa3); pv_one<3>(o[3], vb, pa0, pa1, pa2, pa3);
}

__device__ __forceinline__ void attn_item(const bf16_t* __restrict__ Qb, const bf16_t* __restrict__ Kh, const bf16_t* __restrict__ Vh, bf16_t* __restrict__ mixrow,
                                          const float* __restrict__ gd, float lam) {
    char* lds = smem;
    const int tid = threadIdx.x, wid = tid >> 6, lane = tid & 63, r32 = lane & 31, hi = lane >> 5;
    const int map = wid >> 2, wq = wid & 3, mapc = map * 64;
    char* V_lds = lds; char* K_lds = lds + 2 * A_SHM_V;
    float* wsw = (float*)(lds + 2 * A_SHM_V + 2 * A_SHM_K) + wid * 64; float* li_l = wsw; float* al_l = wsw + 32;
    float m_reg = -1e30f, l_reg = 0; f32x16 o[4] = {}; bf16x8 qr[4];
    const bf16_t* Qw = Qb + (long)(wq * 32 + r32) * 128 + mapc + hi * 8;
#pragma unroll
    for (int d0 = 0; d0 < 4; ++d0) qr[d0] = *reinterpret_cast<const bf16x8*>(Qw + d0 * 16);
    const int sr = tid >> 4, sc = (tid & 15) * 8, vst0 = v_st(sr, sc), vst1 = v_st(32 + sr, sc);
    const int vb0 = (int)(uintptr_t)V_lds + v_rd_base(lane);
    struct { bf16x8 vs0, vs1, ks0, ks1; } sr_[1];
#define SLOAD(i, k0) do { sr_[i].vs0 = *(const bf16x8*)(&Vh[(long)((k0) + sr) * 128 + sc]); sr_[i].vs1 = *(const bf16x8*)(&Vh[(long)((k0) + 32 + sr) * 128 + sc]); \
    sr_[i].ks0 = *(const bf16x8*)(&Kh[(long)((k0) + sr) * 128 + sc]); sr_[i].ks1 = *(const bf16x8*)(&Kh[(long)((k0) + 32 + sr) * 128 + sc]); } while (0)
#define SWRITE(b, i) do { *(bf16x8*)(V_lds + (b) * A_SHM_V + vst0) = sr_[i].vs0;          \
    *(bf16x8*)(V_lds + (b) * A_SHM_V + vst1) = sr_[i].vs1; int kc = sc * 2;               \
    *(bf16x8*)(K_lds + (b) * A_SHM_K + KSWZ(sr, kc)) = sr_[i].ks0;                       \
    *(bf16x8*)(K_lds + (b) * A_SHM_K + KSWZ(32 + sr, kc)) = sr_[i].ks1; } while (0)
#define SWAIT() asm volatile("s_waitcnt vmcnt(0)" ::: "memory")
#define RESC(a) do { if (__any((a) < 1.f)) { if (hi == 0) al_l[r32] = (a); asm volatile("s_waitcnt lgkmcnt(0)" ::: "memory"); \
    _Pragma("unroll") for (int d = 0; d < 4; ++d) _Pragma("unroll") for (int r = 0; r < 16; ++r) o[d][r] *= al_l[crow(r, hi)]; } } while (0)
    f32x16 pA0, pA1, pB0, pB1; float mnA, mnB, alA, alB; bf16x8 pa0, pa1, pa2, pa3; const int NT = RB / A_KVBLK;
    constexpr int SE = 0, SO = 0;
    SLOAD(SE, 0); asm volatile("s_waitcnt vmcnt(0)" ::: "memory"); SWRITE(0, SE); __syncthreads();
    qkt(pA0, pA1, K_lds, qr, r32, hi, mapc); partialSM(pA0, pA1, m_reg, mnA, alA);
    SLOAD(SO, A_KVBLK);
    SWAIT(); SWRITE(1, SO); __syncthreads();
    for (int j = 1; j + 1 < NT; j += 2) {
        SBAR(); qkt(pB0, pB1, K_lds + A_SHM_K, qr, r32, hi, mapc);
        finishSM(pA0, pA1, alA, l_reg, pa0, pa1, pa2, pa3); SBAR();
        SLOAD(SO, (j + 1) * A_KVBLK); SBAR();
        pv_d0(o, vb0, pa0, pa1, pa2, pa3); partialSM(pB0, pB1, m_reg, mnB, alB);
        __syncthreads(); SWAIT(); SWRITE(0, SE);
        RESC(alB); __syncthreads();
        SBAR(); qkt(pA0, pA1, K_lds, qr, r32, hi, mapc);
        finishSM(pB0, pB1, alB, l_reg, pa0, pa1, pa2, pa3); SBAR();
        SLOAD(SE, (j + 2) * A_KVBLK); SBAR();
        pv_d0(o, vb0 + A_SHM_V, pa0, pa1, pa2, pa3); partialSM(pA0, pA1, m_reg, mnA, alA);
        __syncthreads(); SWAIT(); SWRITE(1, SO);
        RESC(alA); __syncthreads();
    }
    SBAR(); qkt(pB0, pB1, K_lds + A_SHM_K, qr, r32, hi, mapc);
    finishSM(pA0, pA1, alA, l_reg, pa0, pa1, pa2, pa3); SBAR();
    pv_d0(o, vb0, pa0, pa1, pa2, pa3); partialSM(pB0, pB1, m_reg, mnB, alB);
    __syncthreads(); RESC(alB);
    finishSM(pB0, pB1, alB, l_reg, pa0, pa1, pa2, pa3); SBAR();
    pv_d0(o, vb0 + A_SHM_V, pa0, pa1, pa2, pa3);
    if (hi == 0) li_l[r32] = l_reg;
    asm volatile("s_waitcnt lgkmcnt(0)" ::: "memory");
    float rl[16];
#pragma unroll
    for (int r = 0; r < 16; ++r) rl[r] = __builtin_amdgcn_rcpf(li_l[crow(r, hi)]);
    __syncthreads();
    {
        float* xo = (float*)lds + map * 16384 + (wq * 32) * 128 + r32;
#pragma unroll
        for (int r = 0; r < 16; ++r)
#pragma unroll
            for (int d0 = 0; d0 < 4; ++d0) xo[crow(r, hi) * 128 + d0 * 32] = o[d0][r] * rl[r];
    }
    __syncthreads();
    {
        const float g0 = gd[lane * 2], g1 = gd[lane * 2 + 1];
#pragma unroll 4
        for (int rr = 0; rr < 16; ++rr) {
            const int row = wid * 16 + rr;
            const float2 a0 = *(const float2*)((const float*)lds + row * 128 + lane * 2), a1 = *(const float2*)((const float*)lds + 16384 + row * 128 + lane * 2);
            const float xv = a0.x - lam * a1.x, yv = a0.y - lam * a1.y;
            const float ss = wave_sum(xv * xv + yv * yv);
            const float rs = rsqrtf(ss * (1.0f / 128) + EPS) * 0.8f;
            *(unsigned*)(mixrow + (long)row * 1024 + lane * 2) = cvtpk(xv * rs * g0, yv * rs * g1);
        }
    }
    __syncthreads();
#undef SLOAD
#undef SWRITE
#undef SWAIT
#undef RESC
}

__device__ void ph_attn(const MK& p, int bid, int nb) {
    const int lane = threadIdx.x & 63;
    float s1 = wave_sum(p.lq1[lane] * p.lk1[lane]), s2 = wave_sum(p.lq2[lane] * p.lk2[lane]);
    const float lam = expf(s1) - expf(s2) + 0.2f;
    const int nrounds = (1024 + nb - 1) / nb;
    for (int rr = 0; rr < nrounds; ++rr) {
        int item;
        if (nb == 256) { int x = bid & 7, j = bid >> 3, hh = rr * 8 + x; item = (hh >> 1) * 64 + (hh & 1) * 32 + j; }
        else { item = rr * nb + bid; if (item >= 1024) break; }
        const int bh = item >> 6, qb = item & 63, b = bh >> 2, h = bh & 3;
        attn_item(p.Q + ((size_t)bh * SEQ + qb * 128) * 128, p.K + (size_t)bh * RB * 128, p.V + (size_t)bh * RB * 128,
                  p.MIX + ((size_t)(b * SEQ + qb * 128)) * 1024 + h * 128, p.dattn_g, lam);
    }
}


__device__ __forceinline__ bf16x8 ldfrag(const bf16_t* p) { return *reinterpret_cast<const bf16x8*>(p); }

__device__ void ph_kv(const MK& p, int bid, int nb) {
    const int wid = threadIdx.x >> 6, lane = threadIdx.x & 63, r32 = lane & 31, hi = lane >> 5;
    const int nitems = 16 * 2 * 66;
    for (int it = bid * 8 + wid; it < nitems; it += nb * 8) {
        const int c = it % 66, chain = it / 66, dir = chain & 1, bh = chain >> 1;
        const bf16_t* vt = p.VT + (size_t)bh * 128 * RB + c * 128 + hi * 8;
        const bf16_t* kt = (dir ? p.KTb : p.KTf) + (size_t)bh * 64 * RB + c * 128 + hi * 8;
        f32x16 acc[4][2];
#pragma unroll
        for (int mt = 0; mt < 4; ++mt) { acc[mt][0] = f32x16{}; acc[mt][1] = f32x16{}; }
#pragma unroll 2
        for (int ks = 0; ks < 8; ++ks) {
            bf16x8 a[4], b[2];
#pragma unroll
            for (int mt = 0; mt < 4; ++mt) a[mt] = ldfrag(vt + (size_t)(mt * 32 + r32) * RB + ks * 16);
#pragma unroll
            for (int nt = 0; nt < 2; ++nt) b[nt] = ldfrag(kt + (size_t)(nt * 32 + r32) * RB + ks * 16);
#pragma unroll
            for (int mt = 0; mt < 4; ++mt)
#pragma unroll
                for (int nt = 0; nt < 2; ++nt) acc[mt][nt] = __builtin_amdgcn_mfma_f32_32x32x16_bf16(a[mt], b[nt], acc[mt][nt], 0, 0, 0);
        }
        bf16_t* dst = p.KV + (size_t)it * 8192;
#pragma unroll
        for (int mt = 0; mt < 4; ++mt)
#pragma unroll
            for (int nt = 0; nt < 2; ++nt)
#pragma unroll
                for (int r = 0; r < 16; ++r) dst[(mt * 32 + crow(r, hi)) * 64 + nt * 32 + r32] = f2bf(acc[mt][nt][r]);
    }
}

__device__ void ph_scan(const MK& p, int bid, int nb) {
    for (int e = bid * NTHR + threadIdx.x; e < 32 * 8192; e += nb * NTHR) {
        const int chain = e >> 13, el = e & 8191, dir = chain & 1, bh = chain >> 1, h = bh & 3;
        const float d = dir ? p.dec_b[h] : p.dec_f[h];
        const float g128 = exp2f(128.0f * log2f(1.0f / (1.0f + expf(-d))));
        const bf16_t* kv = p.KV + (size_t)chain * 66 * 8192 + el;
        bf16_t* st = p.ST + (size_t)chain * 66 * 8192 + el;
        float S = 0.f;
        for (int n = 0; n < 66; ++n) {
            const int c = dir == 0 ? n : (n == 0 ? 1 : (n == 1 ? 0 : 67 - n));
            st[(size_t)c * 8192] = f2bf(S);
            S = fmaf(g128, S, bf2f(kv[(size_t)c * 8192]));
        }
    }
}

__device__ void ph_ret(const MK& p, int bid, int nb) {
    const int tid = threadIdx.x, wid = tid >> 6, lane = tid & 63, r32 = lane & 31, hi = lane >> 5, wq = wid & 3, half = wid >> 2;
    float* img = (float*)smem;
    for (int it = bid; it < 4 * 64 * 2; it += nb) {
        const int hp = it & 1, lc = (it >> 1) & 63, b = it >> 7, h = hp * 2 + half, bh = b * 4 + h;
        const int ib = CTX + lc * 128, c = 2 + lc;
        const float lf = log2f(1.0f / (1.0f + expf(-p.dec_f[h]))), lb = log2f(1.0f / (1.0f + expf(-p.dec_b[h])));
        const bf16_t* rq = p.RQ + ((size_t)bh * RB + ib + wq * 32 + r32) * 64 + hi * 8;
        bf16x8 q[4];
#pragma unroll
        for (int ks = 0; ks < 4; ++ks) q[ks] = ldfrag(rq + ks * 16);
        f32x16 o[4];
        {
            const bf16_t* stf = p.ST + ((size_t)(bh * 2 + 0) * 66 + c) * 8192 + hi * 8;
            const bf16_t* stb = p.ST + ((size_t)(bh * 2 + 1) * 66 + c) * 8192 + hi * 8;
            {
                float rf[16];
#pragma unroll
                for (int r = 0; r < 16; ++r) rf[r] = __builtin_amdgcn_exp2f((float)(wq * 32 + crow(r, hi) + 1) * lf);
#pragma unroll
                for (int d0 = 0; d0 < 4; ++d0) {
                    f32x16 tf = f32x16{};
#pragma unroll
                    for (int ks = 0; ks < 4; ++ks) tf = __builtin_amdgcn_mfma_f32_32x32x16_bf16(q[ks], ldfrag(stf + (size_t)(d0 * 32 + r32) * 64 + ks * 16), tf, 0, 0, 0);
#pragma unroll
                    for (int r = 0; r < 16; ++r) o[d0][r] = tf[r] * rf[r];
                    asm volatile("" ::: "memory");
                }
            }
            {
                float rf[16];
#pragma unroll
                for (int r = 0; r < 16; ++r) rf[r] = __builtin_amdgcn_exp2f((float)(128 - (wq * 32 + crow(r, hi))) * lb);
#pragma unroll
                for (int d0 = 0; d0 < 4; ++d0) {
                    f32x16 tb = f32x16{};
#pragma unroll
                    for (int ks = 0; ks < 4; ++ks) tb = __builtin_amdgcn_mfma_f32_32x32x16_bf16(q[ks], ldfrag(stb + (size_t)(d0 * 32 + r32) * 64 + ks * 16), tb, 0, 0, 0);
#pragma unroll
                    for (int r = 0; r < 16; ++r) o[d0][r] += tb[r] * rf[r];
                    asm volatile("" ::: "memory");
                }
            }
        }
        {
            const int qi = wq * 32 + r32;
            const bf16_t* vt = p.VT + (size_t)bh * 128 * RB + ib + hi * 8;
#pragma unroll 1
            for (int jb = 0; jb < 4; ++jb) {
                asm volatile("" ::: "memory");
                const bf16_t* rk = p.RK + ((size_t)bh * RB + ib + jb * 32 + r32) * 64 + hi * 8;
                f32x16 pp = f32x16{};
#pragma unroll
                for (int ks = 0; ks < 4; ++ks) pp = __builtin_amdgcn_mfma_f32_32x32x16_bf16(ldfrag(rk + ks * 16), q[ks], pp, 0, 0, 0);
#pragma unroll
                for (int r = 0; r < 16; ++r) {
                    const int dd = qi - (jb * 32 + crow(r, hi));
                    const float ex = __builtin_amdgcn_exp2f(dd > 0 ? (float)dd * lf : (float)(-dd) * lb); const float w = dd == 0 ? 2.0f : ex;
                    pp[r] *= w;
                }
                bf16x8 pa0, pa1;
                PK4(pp, 0, pa0); PK4(pp, 8, pa1);
#pragma unroll
                for (int d0 = 0; d0 < 4; ++d0) {
                    o[d0] = __builtin_amdgcn_mfma_f32_32x32x16_bf16(pa0, ldfrag(vt + (size_t)(d0 * 32 + r32) * RB + jb * 32), o[d0], 0, 0, 0);
                    o[d0] = __builtin_amdgcn_mfma_f32_32x32x16_bf16(pa1, ldfrag(vt + (size_t)(d0 * 32 + r32) * RB + jb * 32 + 16), o[d0], 0, 0, 0);
                }
            }
        }
        __syncthreads();
        {
            float* xo = img + half * 16384 + (wq * 32) * 128 + r32;
#pragma unroll
            for (int r = 0; r < 16; ++r)
#pragma unroll
                for (int d0 = 0; d0 < 4; ++d0) xo[crow(r, hi) * 128 + d0 * 32] = o[d0][r];
        }
        __syncthreads();
        {
            const float g0 = p.ret_g[lane * 2], g1 = p.ret_g[lane * 2 + 1];
#pragma unroll 4
            for (int rr = 0; rr < 32; ++rr) {
                const int row = wid * 32 + rr, itl = row >> 7, rw = row & 127, hh = hp * 2 + itl;
                const float2 a = *(const float2*)(img + row * 128 + lane * 2);
                const float ss = wave_sum(a.x * a.x + a.y * a.y);
                const float rs = rsqrtf(ss * (1.0f / 128) + EPS);
                const size_t tt = (size_t)b * SEQ + lc * 128 + rw;
                const unsigned gg = *(const unsigned*)(p.RG + tt * 512 + hh * 128 + lane * 2);
                const float ga = bf2f((bf16_t)(gg & 0xffff)), gb = bf2f((bf16_t)(gg >> 16));
                *(unsigned*)(p.MIX + tt * 1024 + 512 + hh * 128 + lane * 2) = cvtpk(siluf(ga) * a.x * rs * g0, siluf(gb) * a.y * rs * g1);
            }
        }
    }
}


__device__ void ph_gemm_out(const MK& p, int bid, int nb) {
    const int tid = threadIdx.x, wid = tid >> 6, lane = tid & 63, wr = wid >> 2, wc = wid & 3, fr = lane & 15, fq = lane >> 4;
    for (int tile = bid; tile < (T / 256) * 4; tile += nb) {
        const int pm = tile >> 2, pn = tile & 3, brow = pm * 256, bcol = pn * 256;
        const bf16_t *Ap[4], *Bp[4];
        stage_ptrs(p.MIX + (size_t)brow * D, D, Ap); stage_ptrs(p.w_outT + (size_t)bcol * D, D, Bp);
        f32x4 acc[8][4];
        gemm_core(Ap, Bp, D / 64, acc);
        const float* g1 = p.mod + (size_t)(brow / SEQ) * 6 * D + 2 * D + bcol + wc * 64 + fq * 4;
#pragma unroll
        for (int m = 0; m < 8; ++m) {
            int ioff = m * 16; asm volatile("" : "+v"(ioff) :: "memory");
            const size_t o = (size_t)(brow + wr * 128 + fr + ioff) * D + bcol + wc * 64 + fq * 4;
#pragma unroll
            for (int n = 0; n < 4; ++n) {
                const float4 xv = *(const float4*)(p.x + o + n * 16), g = *(const float4*)(g1 + n * 16);
                *(float4*)(p.out + o + n * 16) = make_float4(xv.x + g.x * acc[m][n][0], xv.y + g.y * acc[m][n][1], xv.z + g.z * acc[m][n][2], xv.w + g.w * acc[m][n][3]);
            }
        }
    }
}

__device__ __forceinline__ bool route_token(float logit, float bias, int lane, float& wt) {
    const float score = 1.0f / (1.0f + expf(-logit));
    const float sel = score + bias;
    float m1 = sel, m2 = -INFINITY;
#pragma unroll
    for (int o = 1; o < 8; o <<= 1) {
        float p1 = __shfl_xor(m1, o), p2 = __shfl_xor(m2, o);
        float n1 = fmaxf(m1, p1), n2 = fmaxf(fminf(m1, p1), fmaxf(m2, p2));
        m1 = n1; m2 = n2;
    }
    const float gs = m1 + m2;
    const int grp = lane >> 3;
    int grank = 0;
#pragma unroll
    for (int g2 = 0; g2 < 8; ++g2) { float og = __uint_as_float(__builtin_amdgcn_readlane(__float_as_uint(gs), g2 * 8)); grank += (og > gs || (og == gs && g2 < grp)) ? 1 : 0; }
    const float val = grank < 4 ? sel : -INFINITY;
    int rank = 0;
#pragma unroll
    for (int e = 0; e < 64; ++e) { float ov = __uint_as_float(__builtin_amdgcn_readlane(__float_as_uint(val), e)); rank += (ov > val || (ov == val && e < lane)) ? 1 : 0; }
    const bool chosen = rank < 8;
    const float wsum = wave_sum(chosen ? score : 0.f);
    wt = score / wsum * 2.5f;
    return chosen;
}
__device__ void ph_route(const MK& p, int bid, int nb) {
    const int tid = threadIdx.x, wid = tid >> 6, lane = tid & 63, r32 = lane & 31, hi = lane >> 5;
    int* wcnt = (int*)smem;
    int* basel = wcnt + 512;
    const float bias = p.router_b[lane];
    for (int item = bid; item < T / 256; item += nb) {
        const int t0 = item * 256 + wid * 32, b = (item * 256) / SEQ;
        const float* xr = p.out + (size_t)(t0 + r32) * D + hi * 8;
        float ss = 0.f;
#pragma unroll 8
        for (int ks = 0; ks < 64; ++ks) { const float4 a = *(const float4*)(xr + ks * 16), c = *(const float4*)(xr + ks * 16 + 4);
            ss += a.x * a.x + a.y * a.y + a.z * a.z + a.w * a.w + c.x * c.x + c.y * c.y + c.z * c.z + c.w * c.w; }
        ss += __shfl_xor(ss, 32);
        const float rstd = rsqrtf(ss * (1.0f / D) + EPS);
        const float* mg = p.norm2_g + hi * 8; const float* msh = p.mod + (size_t)b * 6 * D + 3 * D + hi * 8; const float* msc = p.mod + (size_t)b * 6 * D + 4 * D + hi * 8;
        const bf16_t* rT = p.routerT + (size_t)r32 * D + hi * 8;
        bf16_t* h2w = p.H2 + (size_t)(t0 + r32) * D + hi * 8;
        f32x16 acc0 = f32x16{}, acc1 = f32x16{};
#pragma unroll 2
        for (int ks = 0; ks < 64; ++ks) {
            const int k0 = ks * 16;
            float hv[8];
            { const float4 a = *(const float4*)(xr + k0), c = *(const float4*)(xr + k0 + 4);
              const float4 g0 = *(const float4*)(mg + k0), g1 = *(const float4*)(mg + k0 + 4), s0 = *(const float4*)(msc + k0), s1 = *(const float4*)(msc + k0 + 4),
                           h0 = *(const float4*)(msh + k0), h1 = *(const float4*)(msh + k0 + 4);
              hv[0] = a.x * rstd * g0.x * (1 + s0.x) + h0.x; hv[1] = a.y * rstd * g0.y * (1 + s0.y) + h0.y; hv[2] = a.z * rstd * g0.z * (1 + s0.z) + h0.z; hv[3] = a.w * rstd * g0.w * (1 + s0.w) + h0.w;
              hv[4] = c.x * rstd * g1.x * (1 + s1.x) + h1.x; hv[5] = c.y * rstd * g1.y * (1 + s1.y) + h1.y; hv[6] = c.z * rstd * g1.z * (1 + s1.z) + h1.z; hv[7] = c.w * rstd * g1.w * (1 + s1.w) + h1.w; }
            u32x4 wh, wl;
            wh.x = cvtpk(hv[0], hv[1]); wh.y = cvtpk(hv[2], hv[3]); wh.z = cvtpk(hv[4], hv[5]); wh.w = cvtpk(hv[6], hv[7]);
            wl.x = cvtpk(hv[0] - __uint_as_float(wh.x << 16), hv[1] - __uint_as_float(wh.x & 0xffff0000u));
            wl.y = cvtpk(hv[2] - __uint_as_float(wh.y << 16), hv[3] - __uint_as_float(wh.y & 0xffff0000u));
            wl.z = cvtpk(hv[4] - __uint_as_float(wh.z << 16), hv[5] - __uint_as_float(wh.z & 0xffff0000u));
            wl.w = cvtpk(hv[6] - __uint_as_float(wh.w << 16), hv[7] - __uint_as_float(wh.w & 0xffff0000u));
            *(u32x4*)(h2w + k0) = wh;
            const bf16x8 ah = *reinterpret_cast<bf16x8*>(&wh), al = *reinterpret_cast<bf16x8*>(&wl);
            const bf16x8 bh0 = ldfrag(rT + k0), bh1 = ldfrag(rT + 32 * D + k0), bl0 = ldfrag(rT + 64 * D + k0), bl1 = ldfrag(rT + 96 * D + k0);
            acc0 = __builtin_amdgcn_mfma_f32_32x32x16_bf16(ah, bh0, acc0, 0, 0, 0); acc0 = __builtin_amdgcn_mfma_f32_32x32x16_bf16(ah, bl0, acc0, 0, 0, 0); acc0 = __builtin_amdgcn_mfma_f32_32x32x16_bf16(al, bh0, acc0, 0, 0, 0);
            acc1 = __builtin_amdgcn_mfma_f32_32x32x16_bf16(ah, bh1, acc1, 0, 0, 0); acc1 = __builtin_amdgcn_mfma_f32_32x32x16_bf16(ah, bl1, acc1, 0, 0, 0); acc1 = __builtin_amdgcn_mfma_f32_32x32x16_bf16(al, bh1, acc1, 0, 0, 0);
        }
        int mycount = 0;
#pragma unroll
        for (int r = 0; r < 16; ++r) {
            auto sw = __builtin_amdgcn_permlane32_swap(__float_as_uint(acc0[r]), __float_as_uint(acc1[r]), false, false);
            float wt;
            mycount += route_token(__uint_as_float(sw[0]), bias, lane, wt) ? 1 : 0;
            mycount += route_token(__uint_as_float(sw[1]), bias, lane, wt) ? 1 : 0;
        }
        __syncthreads();
        wcnt[wid * 64 + lane] = mycount;
        __syncthreads();
        if (wid == 0) { int tot = 0;
#pragma unroll
            for (int w = 0; w < 8; ++w) tot += wcnt[w * 64 + lane];
            basel[lane] = atomicAdd(&p.cnt[lane], tot); }
        __syncthreads();
        int running = basel[lane];
        for (int w = 0; w < wid; ++w) running += wcnt[w * 64 + lane];
#pragma unroll
        for (int r = 0; r < 16; ++r) {
            auto sw = __builtin_amdgcn_permlane32_swap(__float_as_uint(acc0[r]), __float_as_uint(acc1[r]), false, false);
#pragma unroll
            for (int hf = 0; hf < 2; ++hf) {
                float wt; const bool ch = route_token(__uint_as_float(sw[hf]), bias, lane, wt);
                const int t = t0 + crow(r, hf);
                const unsigned long long bal = __ballot(ch);
                if (ch) {
                    const int kidx = __popcll(bal & ((1ull << lane) - 1ull));
                    p.tok_list[(size_t)lane * ECAP + running] = t; p.wt_list[(size_t)lane * ECAP + running] = wt;
                    p.tokmap[(size_t)t * 8 + kidx] = lane * ECAP + running; ++running;
                }
            }
        }
    }
}

constexpr int MOE_AUX = 131072;
__device__ __forceinline__ void moe_tables(const MK& p, int colt, int* tpre, int* rbase) {
    __syncthreads();
    if (threadIdx.x == 0) { int tp = 0, rb = 0;
        for (int e = 0; e < 65; ++e) { const int c = e < 64 ? p.cnt[e] : T; tpre[e] = tp; rbase[e] = rb; tp += ((c + 255) >> 8) * colt; rb += c; }
        tpre[65] = tp; rbase[65] = rb; }
    __syncthreads();
}
__device__ void ph_moe_up(const MK& p, int bid, int nb) {
    const int tid = threadIdx.x, wid = tid >> 6, lane = tid & 63, wr = wid >> 2, wc = wid & 3, fr = lane & 15, fq = lane >> 4;
    int* tpre = (int*)(smem + MOE_AUX); int* rbase = tpre + 80;
    moe_tables(p, 2, tpre, rbase);
    const int ntiles = tpre[65];
    for (int tile = bid; tile < ntiles; tile += nb) {
        int e = 0; while (tile >= tpre[e + 1]) ++e;
        const int j = tile - tpre[e], rt = j >> 1, ct = j & 1, cnt_e = e < 64 ? p.cnt[e] : T;
        const bf16_t *Ap[4], *Bp[4];
#pragma unroll
        for (int i = 0; i < 4; ++i) { int R, C; stage_rc(wid * 1024 + i * 8192 + lane * 16, R, C);
            int slot = rt * 256 + R; if (slot >= cnt_e) slot = 0;
            const int tok = e < 64 ? p.tok_list[(size_t)e * ECAP + slot] : slot;
            Ap[i] = p.H2 + (size_t)tok * D + C; }
        stage_ptrs(p.W13t + ((size_t)e * 512 + ct * 256) * D, D, Bp);
        f32x4 acc[8][4];
        gemm_core(Ap, Bp, D / 64, acc);
#pragma unroll
        for (int m = 0; m < 8; ++m) {
            int ioff = m * 16; asm volatile("" : "+v"(ioff) :: "memory");
            const int slot = rt * 256 + wr * 128 + fr + ioff;
            if (slot < cnt_e) {
                bf16_t* dp = p.ACT + (size_t)(rbase[e] + slot) * DE + ct * 128 + wc * 32 + fq * 4;
#pragma unroll
                for (int n = 0; n < 2; ++n) {
                    u32x2 w; w.x = cvtpk(siluf(acc[m][n][0]) * acc[m][n + 2][0], siluf(acc[m][n][1]) * acc[m][n + 2][1]);
                    w.y = cvtpk(siluf(acc[m][n][2]) * acc[m][n + 2][2], siluf(acc[m][n][3]) * acc[m][n + 2][3]);
                    *(u32x2*)(dp + n * 16) = w;
                }
            }
        }
    }
}
constexpr float Y_SCALE = 64.0f;
__device__ void ph_moe_down(const MK& p, int bid, int nb) {
    const int tid = threadIdx.x, wid = tid >> 6, lane = tid & 63, wr = wid >> 2, wc = wid & 3, fr = lane & 15, fq = lane >> 4;
    int* tpre = (int*)(smem + MOE_AUX); int* rbase = tpre + 80;
    moe_tables(p, 4, tpre, rbase);
    const int ntiles = tpre[65];
    for (int tile = bid; tile < ntiles; tile += nb) {
        int e = 0; while (tile >= tpre[e + 1]) ++e;
        const int j = tile - tpre[e], rt = j >> 2, ct = j & 3, cnt_e = e < 64 ? p.cnt[e] : T;
        const bf16_t *Ap[4], *Bp[4];
        stage_ptrs(p.ACT + (size_t)(rbase[e] + rt * 256) * DE, DE, Ap);
        stage_ptrs(p.W2t + ((size_t)e * D + ct * 256) * DE, DE, Bp);
        f32x4 acc[8][4];
        gemm_core(Ap, Bp, DE / 64, acc);
        const int col0 = ct * 256 + wc * 64 + fq * 4;
#pragma unroll
        for (int m = 0; m < 8; ++m) {
            int ioff = m * 16; asm volatile("" : "+v"(ioff) :: "memory");
            const int slot = rt * 256 + wr * 128 + fr + ioff;
            if (slot < cnt_e) {
                if (e < 64) {
                    const float w = p.wt_list[(size_t)e * ECAP + slot] * Y_SCALE;
                    unsigned char* dp = p.Y + (size_t)(rbase[e] + slot) * D + col0;
#pragma unroll
                    for (int n = 0; n < 4; ++n) {
                        float v0 = fminf(fmaxf(acc[m][n][0] * w, -448.f), 448.f), v1 = fminf(fmaxf(acc[m][n][1] * w, -448.f), 448.f);
                        float v2 = fminf(fmaxf(acc[m][n][2] * w, -448.f), 448.f), v3 = fminf(fmaxf(acc[m][n][3] * w, -448.f), 448.f);
                        int pk = 0; pk = __builtin_amdgcn_cvt_pk_fp8_f32(v0, v1, pk, false); pk = __builtin_amdgcn_cvt_pk_fp8_f32(v2, v3, pk, true);
                        *(int*)(dp + n * 16) = pk;
                    }
                } else {
                    const int bb = slot / SEQ;
                    float* xp = p.out + (size_t)slot * D + col0; const float* g2 = p.mod + (size_t)bb * 6 * D + 5 * D + col0;
#pragma unroll
                    for (int n = 0; n < 4; ++n) {
                        float4 xv = *(float4*)(xp + n * 16); const float4 g = *(const float4*)(g2 + n * 16);
                        xv.x += g.x * acc[m][n][0]; xv.y += g.y * acc[m][n][1]; xv.z += g.z * acc[m][n][2]; xv.w += g.w * acc[m][n][3];
                        *(float4*)(xp + n * 16) = xv;
                    }
                }
            }
        }
    }
}

__device__ void ph_final(const MK& p, int bid, int nb) {
    const int wid = threadIdx.x >> 6, lane = threadIdx.x & 63;
    int* tpre = (int*)(smem + MOE_AUX); int* rbase = tpre + 80;
    moe_tables(p, 1, tpre, rbase);
    for (int t = bid * 8 + wid; t < T; t += nb * 8) {
        const int b = t / SEQ;
        float f[16];
#pragma unroll
        for (int i = 0; i < 16; ++i) f[i] = 0.f;
#pragma unroll
        for (int k = 0; k < 8; ++k) {
            const int id = p.tokmap[(size_t)t * 8 + k], e = id >> 15, slot = id & (ECAP - 1);
            const unsigned char* yr = p.Y + (size_t)(rbase[e] + slot) * D + lane * 4;
#pragma unroll
            for (int q = 0; q < 4; ++q) {
                const int w = *(const int*)(yr + q * 256);
                const auto lo = __builtin_amdgcn_cvt_pk_f32_fp8(w, false); const auto hi = __builtin_amdgcn_cvt_pk_f32_fp8(w, true);
                f[q * 4 + 0] += lo[0]; f[q * 4 + 1] += lo[1]; f[q * 4 + 2] += hi[0]; f[q * 4 + 3] += hi[1];
            }
        }
        const float* g2 = p.mod + (size_t)b * 6 * D + 5 * D + lane * 4;
        float* xo = p.out + (size_t)t * D + lane * 4;
        float v[16]; float ss = 0.f;
#pragma unroll
        for (int q = 0; q < 4; ++q) {
            const float4 xv = *(const float4*)(xo + q * 256), g = *(const float4*)(g2 + q * 256);
            v[q * 4 + 0] = xv.x + g.x * f[q * 4 + 0] * (1.0f / Y_SCALE); v[q * 4 + 1] = xv.y + g.y * f[q * 4 + 1] * (1.0f / Y_SCALE);
            v[q * 4 + 2] = xv.z + g.z * f[q * 4 + 2] * (1.0f / Y_SCALE); v[q * 4 + 3] = xv.w + g.w * f[q * 4 + 3] * (1.0f / Y_SCALE);
            ss += v[q * 4] * v[q * 4] + v[q * 4 + 1] * v[q * 4 + 1] + v[q * 4 + 2] * v[q * 4 + 2] + v[q * 4 + 3] * v[q * 4 + 3];
        }
        ss = wave_sum(ss);
        const float rstd = rsqrtf(ss * (1.0f / D) + EPS);
#pragma unroll
        for (int q = 0; q < 4; ++q) {
            const float4 gf = *(const float4*)(p.final_g + q * 256 + lane * 4);
            *(float4*)(xo + q * 256) = make_float4(v[q * 4] * rstd * gf.x, v[q * 4 + 1] * rstd * gf.y, v[q * 4 + 2] * rstd * gf.z, v[q * 4 + 3] * rstd * gf.w);
        }
    }
}

template <int PH> __global__ __launch_bounds__(512, 2) void k_phase(MK p) {
    const int bid = blockIdx.x, nb = gridDim.x;
    if (PH == 0) { if (bid == 0 && threadIdx.x < 80) p.cnt[threadIdx.x] = 0; ph_mod(p, bid, nb); ph_convert(p, bid, nb); }
    if (PH == 1) ph_ln1(p, bid, nb);
    if (PH == 2) ph_gemm_in(p, bid, nb);
    if (PH == 3) { ph_attn(p, bid, nb); ph_kv(p, bid, nb); }
    if (PH == 4) ph_scan(p, bid, nb);
    if (PH == 5) ph_ret(p, bid, nb);
    if (PH == 6) ph_gemm_out(p, bid, nb);
    if (PH == 7) ph_route(p, bid, nb);
    if (PH == 8) ph_moe_up(p, bid, nb);
    if (PH == 9) ph_moe_down(p, bid, nb);
    if (PH == 10) ph_final(p, bid, nb);
}

constexpr int LDS_TOTAL = 132096;
template <int PH> static void launch_phase(hipStream_t s, const MK& p) {
    (void)hipFuncSetAttribute((const void*)k_phase<PH>, hipFuncAttributeMaxDynamicSharedMemorySize, LDS_TOTAL);
    hipLaunchKernelGGL((k_phase<PH>), dim3(256), dim3(512), LDS_TOTAL, s, p);
}
constexpr size_t MiB = 1048576;
extern "C" void kernel_launch(void* const* d_in, const int* in_sizes, int n_in, void* d_out, int out_size, void* d_ws, size_t ws_size, hipStream_t stream) {
    char* ws = (char*)d_ws;
    MK mk{};
    mk.x = (const float*)d_in[0]; mk.c = (const float*)d_in[1]; mk.ctx = (const float*)d_in[2]; mk.cctx = (const float*)d_in[3]; mk.ada_w = (const float*)d_in[4]; mk.ada_b = (const float*)d_in[5];
    mk.norm1_g = (const float*)d_in[6]; mk.w_in = (const float*)d_in[7]; mk.lq1 = (const float*)d_in[8]; mk.lk1 = (const float*)d_in[9]; mk.lq2 = (const float*)d_in[10]; mk.lk2 = (const float*)d_in[11];
    mk.dattn_g = (const float*)d_in[12]; mk.dec_f = (const float*)d_in[13]; mk.dec_b = (const float*)d_in[14]; mk.ret_g = (const float*)d_in[15]; mk.w_out = (const float*)d_in[16];
    mk.norm2_g = (const float*)d_in[17]; mk.router_w = (const float*)d_in[18]; mk.router_b = (const float*)d_in[19]; mk.ew1 = (const float*)d_in[20]; mk.ew3 = (const float*)d_in[21];
    mk.ew2 = (const float*)d_in[22]; mk.sw1 = (const float*)d_in[23]; mk.sw3 = (const float*)d_in[24]; mk.sw2 = (const float*)d_in[25]; mk.final_g = (const float*)d_in[26];
    mk.out = (float*)d_out;
    mk.mod = (float*)ws; mk.cnt = (int*)(ws + 131072); mk.ropec = (float*)(ws + 262144); mk.ropes = (float*)(ws + 262144 + 8192);
    mk.w_inT = (bf16_t*)(ws + 1 * MiB); mk.w_outT = (bf16_t*)(ws + 7 * MiB); mk.routerT = (bf16_t*)(ws + 9 * MiB); mk.W2t = (bf16_t*)(ws + 9 * MiB + 524288);
    mk.H = (bf16_t*)(ws + 42 * MiB); mk.MIX = (bf16_t*)(ws + 42 * MiB); mk.KV = (bf16_t*)(ws + 112 * MiB); mk.ST = (bf16_t*)(ws + 147 * MiB); mk.ACT = (bf16_t*)(ws + 42 * MiB);
    mk.W13t = (bf16_t*)(ws + 194 * MiB); mk.H2 = (bf16_t*)(ws + 260 * MiB);
    mk.Q = (bf16_t*)(ws + 260 * MiB); mk.K = (bf16_t*)(ws + 292 * MiB); mk.V = (bf16_t*)(ws + 325 * MiB); mk.RQ = (bf16_t*)(ws + 358 * MiB); mk.RK = (bf16_t*)(ws + 375 * MiB);
    mk.KTf = (bf16_t*)(ws + 392 * MiB); mk.KTb = (bf16_t*)(ws + 409 * MiB); mk.VT = (bf16_t*)(ws + 426 * MiB); mk.RG = (bf16_t*)(ws + 459 * MiB);
    mk.Y = (unsigned char*)(ws + 194 * MiB); mk.tok_list = (int*)(ws + 452 * MiB); mk.wt_list = (float*)(ws + 460 * MiB); mk.tokmap = (int*)(ws + 468 * MiB);
    mk.dbgP = nullptr; mk.dbg_lo = 0; mk.dbg_hi = 12; mk.conv_limit = 1 << 30;
    hipStream_t s = stream;
    launch_phase<0>(s, mk); launch_phase<1>(s, mk); launch_phase<2>(s, mk); launch_phase<3>(s, mk); launch_phase<4>(s, mk); launch_phase<5>(s, mk);
    launch_phase<6>(s, mk); launch_phase<7>(s, mk); launch_phase<8>(s, mk); launch_phase<9>(s, mk); launch_phase<10>(s, mk);
}
```

```cpp
#include <hip/hip_runtime.h>
#include <hip/hip_cooperative_groups.h>
#include <cstdio>
namespace cg = cooperative_groups;
#include <stdint.h>

constexpr int D = 1024, NB = 4, SEQ = 8192, CTX = 256, RB = SEQ + CTX  , NR = NB * RB  , T = NB * SEQ;
constexpr int NE = 64, DE = 256, ECAP = 32768;
constexpr float EPS = 1e-6f;
typedef unsigned short bf16_t;

__device__ __forceinline__ float siluf(float v) { return v / (1.0f + expf(-v)); }
__device__ __forceinline__ float wave_sum(float v) {
#pragma unroll
    for (int o = 32; o > 0; o >>= 1) v += __shfl_xor(v, o);
    return v;
}
__device__ __forceinline__ float wave_max(float v) {
#pragma unroll
    for (int o = 32; o > 0; o >>= 1) v = fmaxf(v, __shfl_xor(v, o));
    return v;
}
__device__ __forceinline__ float block_sum(float v, float* red) {
    v = wave_sum(v);
    __syncthreads();
    if ((threadIdx.x & 63) == 0) red[threadIdx.x >> 6] = v;
    __syncthreads();
    return red[0] + red[1] + red[2] + red[3];
}
__device__ __forceinline__ float block_max(float v, float* red) {
    v = wave_max(v);
    __syncthreads();
    if ((threadIdx.x & 63) == 0) red[threadIdx.x >> 6] = v;
    __syncthreads();
    return fmaxf(fmaxf(red[0], red[1]), fmaxf(red[2], red[3]));
}

typedef short bf16x8 __attribute__((ext_vector_type(8)));
typedef short s16x4 __attribute__((ext_vector_type(4)));
typedef float f32x4 __attribute__((ext_vector_type(4)));
typedef float f32x16 __attribute__((ext_vector_type(16)));
typedef unsigned u32x2 __attribute__((ext_vector_type(2)));
typedef unsigned u32x4 __attribute__((ext_vector_type(4)));
extern __shared__ __attribute__((aligned(1024))) char smem[];
constexpr int NTHR = 512;
constexpr int GEMM_LDS = 131072;

__device__ __forceinline__ unsigned cvtpk(float lo, float hi) { unsigned r; asm volatile("v_cvt_pk_bf16_f32 %0, %1, %2" : "=v"(r) : "v"(lo), "v"(hi)); return r; }
__device__ __forceinline__ bf16_t f2bf(float v) { return (bf16_t)(cvtpk(v, v) & 0xffffu); }
__device__ __forceinline__ float bf2f(bf16_t v) { return __uint_as_float(((unsigned)v) << 16); }

constexpr size_t MiB = 1048576;
struct MK {
    const float *x, *c, *ctx, *cctx, *ada_w, *ada_b, *norm1_g, *w_in, *lq1, *lk1, *lq2, *lk2, *dattn_g, *dec_f, *dec_b, *ret_g, *w_out, *norm2_g, *router_w, *router_b,
        *ew1, *ew3, *ew2, *sw1, *sw3, *sw2, *final_g;
    float* out; char* ws;
    float* dbgP; long dbg_lo, dbg_hi; long conv_limit;
#define WSF(name, type, off) __device__ __forceinline__ type* name() const { return (type*)(ws + (off)); }
    WSF(mod, float, 0) WSF(cnt, int, 131072) WSF(ropec, float, 262144) WSF(ropes, float, 262144 + 8192)
    WSF(w_inT, bf16_t, 1 * MiB) WSF(w_outT, bf16_t, 7 * MiB) WSF(routerT, bf16_t, 9 * MiB) WSF(W2t, bf16_t, 9 * MiB + 524288)
    WSF(H, bf16_t, 42 * MiB) WSF(MIX, bf16_t, 42 * MiB) WSF(KV, bf16_t, 112 * MiB) WSF(ST, bf16_t, 147 * MiB) WSF(ACT, bf16_t, 42 * MiB)
    WSF(W13t, bf16_t, 194 * MiB) WSF(H2, bf16_t, 260 * MiB)
    WSF(Q, bf16_t, 260 * MiB) WSF(K, bf16_t, 292 * MiB) WSF(V, bf16_t, 325 * MiB) WSF(RQ, bf16_t, 358 * MiB) WSF(RK, bf16_t, 375 * MiB)
    WSF(KTf, bf16_t, 392 * MiB) WSF(KTb, bf16_t, 409 * MiB) WSF(VT, bf16_t, 426 * MiB) WSF(RG, bf16_t, 459 * MiB)
    WSF(Y, unsigned char, 194 * MiB) WSF(tok_list, int, 452 * MiB) WSF(wt_list, float, 460 * MiB) WSF(tokmap, int, 468 * MiB)
#undef WSF
};

__device__ __forceinline__ void ph_mod(const MK& p, int bid, int nb, int tid_l) {
    float* red = (float*)smem;
    for (int it = bid; it < 6 * D / 32; it += nb) {
        const int col = tid_l & 31, kg = tid_l >> 5, j = it * 32 + col;
        float a[5] = {0, 0, 0, 0, 0};
        for (int k = kg * 64; k < kg * 64 + 64; ++k) {
            float w = p.ada_w[(size_t)k * 6 * D + j];
#pragma unroll
            for (int r = 0; r < 5; ++r) { float cv = r < 4 ? p.c[r * D + k] : p.cctx[k]; a[r] += siluf(cv) * w; }
        }
        __syncthreads();
#pragma unroll
        for (int r = 0; r < 5; ++r) red[(kg * 5 + r) * 32 + col] = a[r];
        __syncthreads();
        if (tid_l < 160) {
            int r = tid_l >> 5; float s = 0;
            for (int g = 0; g < 16; ++g) s += red[(g * 5 + r) * 32 + col];
            p.mod()[(size_t)r * 6 * D + j] = s + p.ada_b[j];
        }
    }
    if (bid == nb - 1) {
        for (int i = tid_l; i < 128 * 16; i += NTHR) {
            int pos = i >> 4, f = i & 15;
            float inv_freq = (float)pow(10000.0, -(double)f / 16.0);
            float s, c; sincosf((float)pos * inv_freq, &s, &c);
            p.ropec()[i] = c; p.ropes()[i] = s;
        }
    }
    __syncthreads();
}

__device__ __forceinline__ void tr_tile(const float* src, int ldsrc, int k0, int n0, bf16_t* dst, int lddst, int mode  , bf16_t* dst2, int tid_l) {
    float* t = (float*)smem;
    __syncthreads();
    for (int i = tid_l; i < 64 * 16; i += NTHR) {
        int r = i >> 4, c4 = (i & 15) * 4;
        float4 v = *(const float4*)(src + (size_t)(k0 + r) * ldsrc + n0 + c4);
        t[r * 65 + c4] = v.x; t[r * 65 + c4 + 1] = v.y; t[r * 65 + c4 + 2] = v.z; t[r * 65 + c4 + 3] = v.w;
    }
    __syncthreads();
    for (int i = tid_l; i < 64 * 16; i += NTHR) {
        int n = i >> 4, k4 = (i & 15) * 4;
        float a = t[(k4 + 0) * 65 + n], b = t[(k4 + 1) * 65 + n], c = t[(k4 + 2) * 65 + n], d = t[(k4 + 3) * 65 + n];
        int nn = n0 + n, row = nn;
        if (mode == 1 || mode == 2) { int ct = nn >> 7, wc = (nn & 127) >> 5, within = nn & 31; row = ct * 256 + wc * 64 + (mode == 2 ? 32 : 0) + within; }
        u32x2 w; w.x = cvtpk(a, b); w.y = cvtpk(c, d);
        *(u32x2*)(dst + (size_t)row * lddst + k0 + k4) = w;
        if (mode == 3) {
            float ah = bf2f((bf16_t)(w.x & 0xffff)), bh = bf2f((bf16_t)(w.x >> 16)), ch = bf2f((bf16_t)(w.y & 0xffff)), dh = bf2f((bf16_t)(w.y >> 16));
            u32x2 l; l.x = cvtpk(a - ah, b - bh); l.y = cvtpk(c - ch, d - dh);
            *(u32x2*)(dst2 + (size_t)row * lddst + k0 + k4) = l;
        }
    }
}
__device__ __forceinline__ void ph_convert(const MK& p, int bid, int nb, int tid_l) {
    const int n_win = 16 * 48, n_wout = 16 * 16, n_rt = 16, n_e13 = 65 * 2 * 16 * 4, n_e2 = 65 * 4 * 16;
    int total = n_win + n_wout + n_rt + n_e13 + n_e2; if (p.conv_limit < total) total = (int)p.conv_limit;
    for (int it = bid; it < total; it += nb) {
        int j = it;
        if (j < n_win) { tr_tile(p.w_in, 3072, (j / 48) * 64, (j % 48) * 64, p.w_inT(), 1024, 0, nullptr, tid_l); continue; } j -= n_win;
        if (j < n_wout) { tr_tile(p.w_out, 1024, (j / 16) * 64, (j % 16) * 64, p.w_outT(), 1024, 0, nullptr, tid_l); continue; } j -= n_wout;
        if (j < n_rt) { tr_tile(p.router_w, 64, j * 64, 0, p.routerT(), 1024, 3, p.routerT() + 64 * 1024, tid_l); continue; } j -= n_rt;
        if (j < n_e13) {
            int e = j / 128, r = j % 128, which = r / 64, tt = r % 64;
            const float* src = e < 64 ? (which ? p.ew3 : p.ew1) + (size_t)e * D * DE : (which ? p.sw3 : p.sw1);
            tr_tile(src, DE, (tt / 4) * 64, (tt % 4) * 64, p.W13t() + (size_t)e * 512 * 1024, 1024, 1 + which, nullptr, tid_l); continue; } j -= n_e13;
        { int e = j / 64, tt = j % 64;
          const float* src = e < 64 ? p.ew2 + (size_t)e * DE * D : p.sw2;
          tr_tile(src, D, (tt / 16) * 64, (tt % 16) * 64, p.W2t() + (size_t)e * 1024 * 256, 256, 0, nullptr, tid_l); }
    }
    __syncthreads();
}

__device__ __forceinline__ void ph_ln1(const MK& p, int bid, int nb, int tid_l) {
    const int wid = tid_l >> 6, lane = tid_l & 63;
    for (int R = bid * 8 + wid; R < NR; R += nb * 8) {
        int b = R / RB, i = R % RB;
        const float* src = i < CTX ? p.ctx + ((size_t)b * CTX + i) * D : p.x + ((size_t)b * SEQ + (i - CTX)) * D;
        const float* m = p.mod() + (size_t)(i < CTX ? 4 : b) * 6 * D;
        float4 v[4]; float ss = 0;
#pragma unroll
        for (int q = 0; q < 4; ++q) { v[q] = *(const float4*)(src + q * 256 + lane * 4); ss += v[q].x * v[q].x + v[q].y * v[q].y + v[q].z * v[q].z + v[q].w * v[q].w; }
        ss = wave_sum(ss);
        float rstd = rsqrtf(ss * (1.0f / D) + EPS);
#pragma unroll
        for (int q = 0; q < 4; ++q) {
            int c0 = q * 256 + lane * 4;
            float4 gg = *(const float4*)(p.norm1_g + c0), sh = *(const float4*)(m + c0), sc = *(const float4*)(m + D + c0);
            float o0 = v[q].x * rstd * gg.x * (1 + sc.x) + sh.x, o1 = v[q].y * rstd * gg.y * (1 + sc.y) + sh.y;
            float o2 = v[q].z * rstd * gg.z * (1 + sc.z) + sh.z, o3 = v[q].w * rstd * gg.w * (1 + sc.w) + sh.w;
            u32x2 w; w.x = cvtpk(o0, o1); w.y = cvtpk(o2, o3);
            *(u32x2*)(p.H() + (size_t)R * D + c0) = w;
        }
    }
}

__device__ __forceinline__ int lds_byte(int r, int c) { int st = (r >> 4) * 2 + (c >> 5), ob = (r & 15) * 64 + (c & 31) * 2; return st * 1024 + (ob ^ (((ob >> 9) & 1) << 5)); }
__device__ __forceinline__ void stage_rc(int b, int& R, int& C) { int st = b >> 10, sb = b & 1023, swz = sb ^ (((sb >> 9) & 1) << 5); R = (st / 2) * 16 + swz / 64; C = (st % 2) * 32 + (swz % 64) / 2; }
#define WAIT_V0() asm volatile("s_waitcnt vmcnt(0)" ::: "memory")
__device__ __forceinline__ void gemm_core(const char* Abase, const unsigned (&Ao)[4], const char* Bbase, const unsigned (&Bo)[4], int nt, f32x4 (&acc)[8][4], int tid_l) {
    const int tid = tid_l, wid = tid >> 6, lane = tid & 63, wr = wid >> 2, wc = wid & 3, fr = lane & 15, fq = lane >> 4;
#pragma unroll
    for (int m = 0; m < 8; ++m)
#pragma unroll
        for (int n = 0; n < 4; ++n) acc[m][n] = (f32x4){0.f, 0.f, 0.f, 0.f};
#define G_SA(b) (smem + (b) * 65536)
#define G_SB(b) (smem + (b) * 65536 + 32768)
#define G_STAGE(buf, kt) do { _Pragma("unroll") for (int i = 0; i < 4; ++i) {                                                     \
        __builtin_amdgcn_global_load_lds((const unsigned*)(Abase + (Ao[i] + (unsigned)(kt) * 128u)), (unsigned*)(G_SA(buf) + wid * 1024 + i * 8192), 16, 0, 0); \
        __builtin_amdgcn_global_load_lds((const unsigned*)(Bbase + (Bo[i] + (unsigned)(kt) * 128u)), (unsigned*)(G_SB(buf) + wid * 1024 + i * 8192), 16, 0, 0); } } while (0)
    G_STAGE(0, 0); WAIT_V0(); __syncthreads();
#pragma unroll 1
    for (int t = 0; t < nt; ++t) {
        const int cur = t & 1;
        if (t + 1 < nt) G_STAGE(cur ^ 1, t + 1);
#pragma unroll
        for (int ks = 0; ks < 2; ++ks) {
            bf16x8 At[8], Bf[4];
#pragma unroll
            for (int m = 0; m < 8; ++m) At[m] = *(const bf16x8*)(G_SA(cur) + lds_byte(wr * 128 + m * 16 + fr, ks * 32 + fq * 8));
#pragma unroll
            for (int n = 0; n < 4; ++n) Bf[n] = *(const bf16x8*)(G_SB(cur) + lds_byte(wc * 64 + n * 16 + fr, ks * 32 + fq * 8));
#pragma unroll
            for (int m = 0; m < 8; ++m)
#pragma unroll
                for (int n = 0; n < 4; ++n) acc[m][n] = __builtin_amdgcn_mfma_f32_16x16x32_bf16(Bf[n], At[m], acc[m][n], 0, 0, 0);
            __builtin_amdgcn_sched_barrier(0);
        }
        WAIT_V0(); __syncthreads();
    }
}
__device__ __forceinline__ void stage_offs(unsigned ld_bytes, unsigned (&P)[4], int tid_l) {
    const int wid = tid_l >> 6, lane = tid_l & 63;
#pragma unroll
    for (int i = 0; i < 4; ++i) { int R, C; stage_rc(wid * 1024 + i * 8192 + lane * 16, R, C); P[i] = (unsigned)R * ld_bytes + (unsigned)C * 2u; }
}

__device__ __forceinline__ void ph_gemm_in(const MK& p, int bid, int nb, int tid_l) {
    const int tid = tid_l, wid = tid >> 6, lane = tid & 63, wr = wid >> 2, wc = wid & 3, fr = lane & 15, fq = lane >> 4;
    const int nM = NR / 256, nN = 12;
    for (int tile = bid; tile < nM * nN; tile += nb) {
        const int pm = tile / nN, pn = tile % nN;
        if (pn < p.dbg_lo || pn >= p.dbg_hi) continue;
        const int brow = pm * 256, bcol = pn * 256;
        unsigned Ao[4], Bo[4];
        stage_offs(D * 2, Ao, tid_l); stage_offs(D * 2, Bo, tid_l);
        f32x4 acc[8][4];
        gemm_core((const char*)(p.H() + (size_t)brow * D), Ao, (const char*)(p.w_inT() + (size_t)bcol * D), Bo, D / 64, acc, tid_l);
        const int b = brow / RB, i0 = brow % RB;
        const bool lat = i0 >= CTX;
        const int seg = pn;
        const bool do_rope = lat && (seg <= 3 || seg == 6 || seg == 7);
        float lg2f = 0.f, lg2b = 0.f;
        if (seg == 7) { float df = p.dec_f[wc], db = p.dec_b[wc]; lg2f = log2f(1.0f / (1.0f + expf(-df))); lg2b = log2f(1.0f / (1.0f + expf(-db))); }
        const int cw = bcol + wc * 64;
#pragma unroll
        for (int m = 0; m < 8; ++m) {
            int ioff = m * 16; asm volatile("" : "+v"(ioff) :: "memory");
            const int i = i0 + wr * 128 + fr + ioff, t = i - CTX;
            float v[4][4];
#pragma unroll
            for (int n = 0; n < 4; ++n)
#pragma unroll
                for (int j = 0; j < 4; ++j) v[n][j] = acc[m][n][j];
            if (do_rope) {
                const int prow = t >> 6, pcol = t & 63;
                const float4 c0 = *(const float4*)(p.ropec() + prow * 16 + fq * 4), s0 = *(const float4*)(p.ropes() + prow * 16 + fq * 4);
                const float4 c1 = *(const float4*)(p.ropec() + pcol * 16 + fq * 4), s1 = *(const float4*)(p.ropes() + pcol * 16 + fq * 4);
                const float cc0[4] = {c0.x, c0.y, c0.z, c0.w}, ss0[4] = {s0.x, s0.y, s0.z, s0.w}, cc1[4] = {c1.x, c1.y, c1.z, c1.w}, ss1[4] = {s1.x, s1.y, s1.z, s1.w};
#pragma unroll
                for (int j = 0; j < 4; ++j) {
                    float x1 = v[0][j], x2 = v[1][j]; v[0][j] = x1 * cc0[j] - x2 * ss0[j]; v[1][j] = x1 * ss0[j] + x2 * cc0[j];
                    float y1 = v[2][j], y2 = v[3][j]; v[2][j] = y1 * cc1[j] - y2 * ss1[j]; v[3][j] = y1 * ss1[j] + y2 * cc1[j];
                }
            }
            if (seg == 7) {
#pragma unroll
                for (int n = 0; n < 4; ++n)
#pragma unroll
                    for (int j = 0; j < 4; ++j) v[n][j] *= 0.125f;
            }
            if (p.dbgP) {
                {
                    float* dp = p.dbgP + (size_t)(brow + wr * 128 + fr + ioff) * 1536 + (cw % 1536) + fq * 4; const float sc = seg <= 1 ? 0.125f : 1.0f;
#pragma unroll
                    for (int n = 0; n < 4; ++n) *(float4*)(dp + n * 16) = make_float4(v[n][0] * sc, v[n][1] * sc, v[n][2] * sc, v[n][3] * sc);
                }
            } else {
                u32x2 w[4];
#pragma unroll
                for (int n = 0; n < 4; ++n) { w[n].x = cvtpk(v[n][0], v[n][1]); w[n].y = cvtpk(v[n][2], v[n][3]); }
                if (seg <= 5) {
                    const int cc = cw - (seg <= 1 ? 0 : seg <= 3 ? 512 : 1024), h = cc >> 7, wi = (cc & 127) + fq * 4;
                    bf16_t* dp = seg <= 1 ? p.Q() + (((size_t)(b * 4 + h) * SEQ + t) * 128 + wi) : (seg <= 3 ? p.K() : p.V()) + (((size_t)(b * 4 + h) * RB + i) * 128 + wi);
                    if (seg > 1 || lat) {
#pragma unroll
                        for (int n = 0; n < 4; ++n) *(u32x2*)(dp + n * 16) = w[n];
                    }
                } else if (seg <= 7) {
                    bf16_t* dp = (seg == 6 ? p.RQ() : p.RK()) + (((size_t)(b * 4 + wc) * RB + i) * 64 + fq * 4);
#pragma unroll
                    for (int n = 0; n < 4; ++n) *(u32x2*)(dp + n * 16) = w[n];
                    if (seg == 7) {
                        const int pos = i & 127;
                        const float ff = exp2f((float)(127 - pos) * lg2f), fb = exp2f((float)pos * lg2b);
                        const size_t o = ((size_t)(b * 4 + wc) * 64 + fq * 4) * RB + i;
#pragma unroll
                        for (int n = 0; n < 4; ++n)
#pragma unroll
                            for (int j = 0; j < 4; ++j) { p.KTf()[o + (size_t)(n * 16 + j) * RB] = f2bf(v[n][j] * ff); p.KTb()[o + (size_t)(n * 16 + j) * RB] = f2bf(v[n][j] * fb); }
                    }
                } else if (seg <= 9) {
                    const int cc = cw - 2048, h = cc >> 7, e = (cc & 127) + fq * 4;
                    const size_t o = ((size_t)(b * 4 + h) * 128 + e) * RB + i;
#pragma unroll
                    for (int n = 0; n < 4; ++n)
#pragma unroll
                        for (int j = 0; j < 4; ++j) p.VT()[o + (size_t)(n * 16 + j) * RB] = f2bf(v[n][j]);
                } else if (lat) {
                    bf16_t* dp = p.RG() + ((size_t)(b * SEQ + t) * 512 + (cw - 2560) + fq * 4);
#pragma unroll
                    for (int n = 0; n < 4; ++n) *(u32x2*)(dp + n * 16) = w[n];
                }
            }
        }
    }
}


constexpr int A_KVBLK = 64;
constexpr float A_SCALE = 0.125f, A_THR = 8.f;
constexpr int A_SHM_V = A_KVBLK * 128 * 2, A_SHM_K = A_KVBLK * 128 * 2;
#define KSWZ(row, colB) ((row) * 256 + ((colB) ^ (((row) & 7) << 4)))
#define SBAR() __builtin_amdgcn_sched_barrier(0)
__device__ __forceinline__ int crow(int r, int hi) { return (r & 3) + 8 * (r >> 2) + 4 * hi; }

__device__ __forceinline__ void partialSM(f32x16& p0, f32x16& p1, float& m_reg, float& mn, float& alpha) {
    constexpr float C = A_SCALE * 1.4426950408889634f;
    float pmax = p0[0];
#pragma unroll
    for (int r = 1; r < 16; ++r) pmax = fmaxf(pmax, p0[r]);
#pragma unroll
    for (int r = 0; r < 16; ++r) pmax = fmaxf(pmax, p1[r]);
    { auto rr = __builtin_amdgcn_permlane32_swap(__float_as_uint(pmax), __float_as_uint(pmax), false, false);
      pmax = fmaxf(__uint_as_float(rr[0]), __uint_as_float(rr[1])); }
    if (__builtin_expect(__all(pmax - m_reg <= A_THR / A_SCALE), 1)) { mn = m_reg; alpha = 1.f; }
    else { mn = fmaxf(m_reg, pmax); alpha = __builtin_amdgcn_exp2f((m_reg - mn) * C); m_reg = mn; }
    float mnC = -mn * C;
#pragma unroll
    for (int r = 0; r < 16; ++r) p0[r] = fmaf(p0[r], C, mnC);
#pragma unroll
    for (int r = 0; r < 16; ++r) p1[r] = fmaf(p1[r], C, mnC);
#pragma unroll
    for (int r = 0; r < 16; ++r) p0[r] = __builtin_amdgcn_exp2f(p0[r]);
}
#define PK4(P, BASE, OUT) do { unsigned a0 = cvtpk(P[BASE + 0], P[BASE + 1]), a1 = cvtpk(P[BASE + 2], P[BASE + 3]);   \
    unsigned b0 = cvtpk(P[BASE + 4], P[BASE + 5]), b1 = cvtpk(P[BASE + 6], P[BASE + 7]);                              \
    auto r0 = __builtin_amdgcn_permlane32_swap(a0, b0, false, false); auto r1 = __builtin_amdgcn_permlane32_swap(a1, b1, false, false); \
    u32x4 w = {r0[0], r1[0], r0[1], r1[1]}; OUT = *reinterpret_cast<bf16x8*>(&w); } while (0)
__device__ __forceinline__ void finishSM(f32x16& p0, f32x16& p1, float alpha, float& l_reg, bf16x8& pa0, bf16x8& pa1, bf16x8& pa2, bf16x8& pa3) {
#pragma unroll
    for (int r = 0; r < 16; ++r) p1[r] = __builtin_amdgcn_exp2f(p1[r]);
    float ps = 0;
#pragma unroll
    for (int r = 0; r < 16; ++r) ps += p0[r];
#pragma unroll
    for (int r = 0; r < 16; ++r) ps += p1[r];
    { auto rr = __builtin_amdgcn_permlane32_swap(__float_as_uint(ps), __float_as_uint(ps), false, false);
      ps = __uint_as_float(rr[0]) + __uint_as_float(rr[1]); }
    l_reg = l_reg * alpha + ps;
    PK4(p0, 0, pa0); PK4(p0, 8, pa1); PK4(p1, 0, pa2); PK4(p1, 8, pa3);
}
__device__ __forceinline__ void qkt(f32x16& p0, f32x16& p1, const char* Ks, const bf16x8* qr, int r32, int hi, int mapc) {
    p0 = f32x16{}; p1 = f32x16{};
#pragma unroll
    for (int d0 = 0; d0 < 4; ++d0) { int cb = (mapc + d0 * 16 + hi * 8) * 2;
        bf16x8 b0 = *reinterpret_cast<const bf16x8*>(Ks + KSWZ(r32, cb));
        bf16x8 b1 = *reinterpret_cast<const bf16x8*>(Ks + KSWZ(32 + r32, cb));
        p0 = __builtin_amdgcn_mfma_f32_32x32x16_bf16(b0, qr[d0], p0, 0, 0, 0);
        p1 = __builtin_amdgcn_mfma_f32_32x32x16_bf16(b1, qr[d0], p1, 0, 0, 0); }
}
__device__ __forceinline__ int v_st(int k, int c) { const int kk = (k & ~0xC) | ((k & 4) << 1) | ((k & 8) >> 1); return ((kk >> 3) * 4 + (c >> 5)) * 512 + ((kk & 7) * 32 + (c & 31)) * 2; }
__device__ __forceinline__ int v_rd_base(int lane) { return ((lane & 3) << 3) | (((lane >> 2) & 3) << 6) | (((lane >> 4) & 1) << 5) | (((lane >> 5) & 1) << 8); }
constexpr int v_rd_off(int d0, int ks, int half) { return d0 * 512 + ks * 4096 + half * 2048; }
template <int OFF> __device__ __forceinline__ s16x4 tr_read(int vb) {
    s16x4 r; asm volatile("ds_read_b64_tr_b16 %0, %1 offset:%2" : "=&v"(r) : "v"(vb), "i"(OFF) : "memory"); return r;
}
template <int D0> __device__ __forceinline__ void pv_one(f32x16& od, int vb, bf16x8 pa0, bf16x8 pa1, bf16x8 pa2, bf16x8 pa3) {
    const s16x4 l0 = tr_read<v_rd_off(D0, 0, 0)>(vb), h0 = tr_read<v_rd_off(D0, 0, 1)>(vb), l1 = tr_read<v_rd_off(D0, 1, 0)>(vb), h1 = tr_read<v_rd_off(D0, 1, 1)>(vb);
    const s16x4 l2 = tr_read<v_rd_off(D0, 2, 0)>(vb), h2 = tr_read<v_rd_off(D0, 2, 1)>(vb), l3 = tr_read<v_rd_off(D0, 3, 0)>(vb), h3 = tr_read<v_rd_off(D0, 3, 1)>(vb);
    asm volatile("s_waitcnt lgkmcnt(0)" ::: "memory"); SBAR();
#define PKV(L, H) (bf16x8){L[0], L[1], L[2], L[3], H[0], H[1], H[2], H[3]}
    od = __builtin_amdgcn_mfma_f32_32x32x16_bf16(pa0, PKV(l0, h0), od, 0, 0, 0);
    od = __builtin_amdgcn_mfma_f32_32x32x16_bf16(pa1, PKV(l1, h1), od, 0, 0, 0);
    od = __builtin_amdgcn_mfma_f32_32x32x16_bf16(pa2, PKV(l2, h2), od, 0, 0, 0);
    od = __builtin_amdgcn_mfma_f32_32x32x16_bf16(pa3, PKV(l3, h3), od, 0, 0, 0);
}
__device__ __forceinline__ void pv_d0(f32x16* o, int vb, bf16x8 pa0, bf16x8 pa1, bf16x8 pa2, bf16x8 pa3) {
    pv_one<0>(o[0], vb, pa0, pa1, pa2, pa3); pv_one<1>(o[1], vb, pa0, pa1, pa2, pa3); pv_one<2>(o[2], vb, pa0, pa1, pa2, pa3); pv_one<3>(o[3], vb, pa0, pa1, pa2, pa3);
}

__device__ __forceinline__ void attn_item(const bf16_t* __restrict__ Qb, const bf16_t* __restrict__ Kh, const bf16_t* __restrict__ Vh, bf16_t* __restrict__ mixrow,
                                          const float* __restrict__ gd, float lam, int tid_l) {
    char* lds = smem;
    const int tid = tid_l, wid = tid >> 6, lane = tid & 63, r32 = lane & 31, hi = lane >> 5;
    const int map = wid >> 2, wq = wid & 3, mapc = map * 64;
    char* V_lds = lds; char* K_lds = lds + 2 * A_SHM_V;
    float* wsw = (float*)(lds + 2 * A_SHM_V + 2 * A_SHM_K) + wid * 64; float* li_l = wsw; float* al_l = wsw + 32;
    float m_reg = -1e30f, l_reg = 0; f32x16 o[4] = {}; bf16x8 qr[4];
    const bf16_t* Qw = Qb + (long)(wq * 32 + r32) * 128 + mapc + hi * 8;
#pragma unroll
    for (int d0 = 0; d0 < 4; ++d0) qr[d0] = *reinterpret_cast<const bf16x8*>(Qw + d0 * 16);
    const int sr = tid >> 4, sc = (tid & 15) * 8, vst0 = v_st(sr, sc), vst1 = v_st(32 + sr, sc);
    const int vb0 = (int)(uintptr_t)V_lds + v_rd_base(lane);
    struct { bf16x8 vs0, vs1, ks0, ks1; } sr_[1];
#define SLOAD(i, k0) do { sr_[i].vs0 = *(const bf16x8*)(&Vh[(long)((k0) + sr) * 128 + sc]); sr_[i].vs1 = *(const bf16x8*)(&Vh[(long)((k0) + 32 + sr) * 128 + sc]); \
    sr_[i].ks0 = *(const bf16x8*)(&Kh[(long)((k0) + sr) * 128 + sc]); sr_[i].ks1 = *(const bf16x8*)(&Kh[(long)((k0) + 32 + sr) * 128 + sc]); } while (0)
#define SWRITE(b, i) do { *(bf16x8*)(V_lds + (b) * A_SHM_V + vst0) = sr_[i].vs0;          \
    *(bf16x8*)(V_lds + (b) * A_SHM_V + vst1) = sr_[i].vs1; int kc = sc * 2;               \
    *(bf16x8*)(K_lds + (b) * A_SHM_K + KSWZ(sr, kc)) = sr_[i].ks0;                       \
    *(bf16x8*)(K_lds + (b) * A_SHM_K + KSWZ(32 + sr, kc)) = sr_[i].ks1; } while (0)
#define SWAIT() asm volatile("s_waitcnt vmcnt(0)" ::: "memory")
#define RESC(a) do { if (__any((a) < 1.f)) { if (hi == 0) al_l[r32] = (a); asm volatile("s_waitcnt lgkmcnt(0)" ::: "memory"); \
    _Pragma("unroll") for (int d = 0; d < 4; ++d) _Pragma("unroll") for (int r = 0; r < 16; ++r) o[d][r] *= al_l[crow(r, hi)]; } } while (0)
    f32x16 pA0, pA1, pB0, pB1; float mnA, mnB, alA, alB; bf16x8 pa0, pa1, pa2, pa3; const int NT = RB / A_KVBLK;
    constexpr int SE = 0, SO = 0;
    SLOAD(SE, 0); asm volatile("s_waitcnt vmcnt(0)" ::: "memory"); SWRITE(0, SE); __syncthreads();
    qkt(pA0, pA1, K_lds, qr, r32, hi, mapc); partialSM(pA0, pA1, m_reg, mnA, alA);
    SLOAD(SO, A_KVBLK);
    SWAIT(); SWRITE(1, SO); __syncthreads();
    for (int j = 1; j + 1 < NT; j += 2) {
        SBAR(); qkt(pB0, pB1, K_lds + A_SHM_K, qr, r32, hi, mapc);
        finishSM(pA0, pA1, alA, l_reg, pa0, pa1, pa2, pa3); SBAR();
        SLOAD(SO, (j + 1) * A_KVBLK); SBAR();
        pv_d0(o, vb0, pa0, pa1, pa2, pa3); partialSM(pB0, pB1, m_reg, mnB, alB);
        __syncthreads(); SWAIT(); SWRITE(0, SE);
        RESC(alB); __syncthreads();
        SBAR(); qkt(pA0, pA1, K_lds, qr, r32, hi, mapc);
        finishSM(pB0, pB1, alB, l_reg, pa0, pa1, pa2, pa3); SBAR();
        SLOAD(SE, (j + 2) * A_KVBLK); SBAR();
        pv_d0(o, vb0 + A_SHM_V, pa0, pa1, pa2, pa3); partialSM(pA0, pA1, m_reg, mnA, alA);
        __syncthreads(); SWAIT(); SWRITE(1, SO);
        RESC(alA); __syncthreads();
    }
    SBAR(); qkt(pB0, pB1, K_lds + A_SHM_K, qr, r32, hi, mapc);
    finishSM(pA0, pA1, alA, l_reg, pa0, pa1, pa2, pa3); SBAR();
    pv_d0(o, vb0, pa0, pa1, pa2, pa3); partialSM(pB0, pB1, m_reg, mnB, alB);
    __syncthreads(); RESC(alB);
    finishSM(pB0, pB1, alB, l_reg, pa0, pa1, pa2, pa3); SBAR();
    pv_d0(o, vb0 + A_SHM_V, pa0, pa1, pa2, pa3);
    if (hi == 0) li_l[r32] = l_reg;
    asm volatile("s_waitcnt lgkmcnt(0)" ::: "memory");
    float rl[16];
#pragma unroll
    for (int r = 0; r < 16; ++r) rl[r] = __builtin_amdgcn_rcpf(li_l[crow(r, hi)]);
    __syncthreads();
    {
        float* xo = (float*)lds + map * 16384 + (wq * 32) * 128 + r32;
#pragma unroll
        for (int r = 0; r < 16; ++r)
#pragma unroll
            for (int d0 = 0; d0 < 4; ++d0) xo[crow(r, hi) * 128 + d0 * 32] = o[d0][r] * rl[r];
    }
    __syncthreads();
    {
        const float g0 = gd[lane * 2], g1 = gd[lane * 2 + 1];
#pragma unroll 4
        for (int rr = 0; rr < 16; ++rr) {
            const int row = wid * 16 + rr;
            const float2 a0 = *(const float2*)((const float*)lds + row * 128 + lane * 2), a1 = *(const float2*)((const float*)lds + 16384 + row * 128 + lane * 2);
            const float xv = a0.x - lam * a1.x, yv = a0.y - lam * a1.y;
            const float ss = wave_sum(xv * xv + yv * yv);
            const float rs = rsqrtf(ss * (1.0f / 128) + EPS) * 0.8f;
            *(unsigned*)(mixrow + (long)row * 1024 + lane * 2) = cvtpk(xv * rs * g0, yv * rs * g1);
        }
    }
    __syncthreads();
#undef SLOAD
#undef SWRITE
#undef SWAIT
#undef RESC
}

__device__ __forceinline__ void ph_attn(const MK& p, int bid, int nb, int tid_l) {
    const int lane = tid_l & 63;
    float s1 = wave_sum(p.lq1[lane] * p.lk1[lane]), s2 = wave_sum(p.lq2[lane] * p.lk2[lane]);
    const float lam = expf(s1) - expf(s2) + 0.2f;
    const int nrounds = (1024 + nb - 1) / nb;
    for (int rr = 0; rr < nrounds; ++rr) {
        int item;
        if (nb == 256) { int x = bid & 7, j = bid >> 3, hh = rr * 8 + x; item = (hh >> 1) * 64 + (hh & 1) * 32 + j; }
        else { item = rr * nb + bid; if (item >= 1024) break; }
        const int bh = item >> 6, qb = item & 63, b = bh >> 2, h = bh & 3;
        attn_item(p.Q() + ((size_t)bh * SEQ + qb * 128) * 128, p.K() + (size_t)bh * RB * 128, p.V() + (size_t)bh * RB * 128,
                  p.MIX() + ((size_t)(b * SEQ + qb * 128)) * 1024 + h * 128, p.dattn_g, lam, tid_l);
    }
}


__device__ __forceinline__ bf16x8 ldfrag(const bf16_t* p) { return *reinterpret_cast<const bf16x8*>(p); }

__device__ __forceinline__ void ph_kv(const MK& p, int bid, int nb, int tid_l) {
    const int wid = tid_l >> 6, lane = tid_l & 63, r32 = lane & 31, hi = lane >> 5;
    const int nitems = 16 * 2 * 66;
    for (int it = bid * 8 + wid; it < nitems; it += nb * 8) {
        const int c = it % 66, chain = it / 66, dir = chain & 1, bh = chain >> 1;
        const bf16_t* vt = p.VT() + (size_t)bh * 128 * RB + c * 128 + hi * 8;
        const bf16_t* kt = (dir ? p.KTb() : p.KTf()) + (size_t)bh * 64 * RB + c * 128 + hi * 8;
        f32x16 acc[4][2];
#pragma unroll
        for (int mt = 0; mt < 4; ++mt) { acc[mt][0] = f32x16{}; acc[mt][1] = f32x16{}; }
#pragma unroll 2
        for (int ks = 0; ks < 8; ++ks) {
            bf16x8 a[4], b[2];
#pragma unroll
            for (int mt = 0; mt < 4; ++mt) a[mt] = ldfrag(vt + (size_t)(mt * 32 + r32) * RB + ks * 16);
#pragma unroll
            for (int nt = 0; nt < 2; ++nt) b[nt] = ldfrag(kt + (size_t)(nt * 32 + r32) * RB + ks * 16);
#pragma unroll
            for (int mt = 0; mt < 4; ++mt)
#pragma unroll
                for (int nt = 0; nt < 2; ++nt) acc[mt][nt] = __builtin_amdgcn_mfma_f32_32x32x16_bf16(a[mt], b[nt], acc[mt][nt], 0, 0, 0);
        }
        bf16_t* dst = p.KV() + (size_t)it * 8192;
#pragma unroll
        for (int mt = 0; mt < 4; ++mt)
#pragma unroll
            for (int nt = 0; nt < 2; ++nt)
#pragma unroll
                for (int r = 0; r < 16; ++r) dst[(mt * 32 + crow(r, hi)) * 64 + nt * 32 + r32] = f2bf(acc[mt][nt][r]);
    }
}

__device__ __forceinline__ void ph_scan(const MK& p, int bid, int nb, int tid_l) {
    for (int e = bid * NTHR + tid_l; e < 32 * 8192; e += nb * NTHR) {
        const int chain = e >> 13, el = e & 8191, dir = chain & 1, bh = chain >> 1, h = bh & 3;
        const float d = dir ? p.dec_b[h] : p.dec_f[h];
        const float g128 = exp2f(128.0f * log2f(1.0f / (1.0f + expf(-d))));
        const bf16_t* kv = p.KV() + (size_t)chain * 66 * 8192 + el;
        bf16_t* st = p.ST() + (size_t)chain * 66 * 8192 + el;
        float S = 0.f;
        for (int n = 0; n < 66; ++n) {
            const int c = dir == 0 ? n : (n == 0 ? 1 : (n == 1 ? 0 : 67 - n));
            st[(size_t)c * 8192] = f2bf(S);
            S = fmaf(g128, S, bf2f(kv[(size_t)c * 8192]));
        }
    }
}

__device__ __forceinline__ void ph_ret(const MK& p, int bid, int nb, int tid_l) {
    const int tid = tid_l, wid = tid >> 6, lane = tid & 63, r32 = lane & 31, hi = lane >> 5, wq = wid & 3, half = wid >> 2;
    float* img = (float*)smem;
    for (int it = bid; it < 4 * 64 * 2; it += nb) {
        const int hp = it & 1, lc = (it >> 1) & 63, b = it >> 7, h = hp * 2 + half, bh = b * 4 + h;
        const int ib = CTX + lc * 128, c = 2 + lc;
        const float lf = log2f(1.0f / (1.0f + expf(-p.dec_f[h]))), lb = log2f(1.0f / (1.0f + expf(-p.dec_b[h])));
        const bf16_t* rq = p.RQ() + ((size_t)bh * RB + ib + wq * 32 + r32) * 64 + hi * 8;
        bf16x8 q[4];
#pragma unroll
        for (int ks = 0; ks < 4; ++ks) q[ks] = ldfrag(rq + ks * 16);
        f32x16 o[4];
        {
            const bf16_t* stf = p.ST() + ((size_t)(bh * 2 + 0) * 66 + c) * 8192 + hi * 8;
            const bf16_t* stb = p.ST() + ((size_t)(bh * 2 + 1) * 66 + c) * 8192 + hi * 8;
            {
                float rf[16];
#pragma unroll
                for (int r = 0; r < 16; ++r) rf[r] = __builtin_amdgcn_exp2f((float)(wq * 32 + crow(r, hi) + 1) * lf);
#pragma unroll
                for (int d0 = 0; d0 < 4; ++d0) {
                    f32x16 tf = f32x16{};
#pragma unroll
                    for (int ks = 0; ks < 4; ++ks) tf = __builtin_amdgcn_mfma_f32_32x32x16_bf16(q[ks], ldfrag(stf + (size_t)(d0 * 32 + r32) * 64 + ks * 16), tf, 0, 0, 0);
#pragma unroll
                    for (int r = 0; r < 16; ++r) o[d0][r] = tf[r] * rf[r];
                    asm volatile("" ::: "memory");
                }
            }
            {
                float rf[16];
#pragma unroll
                for (int r = 0; r < 16; ++r) rf[r] = __builtin_amdgcn_exp2f((float)(128 - (wq * 32 + crow(r, hi))) * lb);
#pragma unroll
                for (int d0 = 0; d0 < 4; ++d0) {
                    f32x16 tb = f32x16{};
#pragma unroll
                    for (int ks = 0; ks < 4; ++ks) tb = __builtin_amdgcn_mfma_f32_32x32x16_bf16(q[ks], ldfrag(stb + (size_t)(d0 * 32 + r32) * 64 + ks * 16), tb, 0, 0, 0);
#pragma unroll
                    for (int r = 0; r < 16; ++r) o[d0][r] += tb[r] * rf[r];
                    asm volatile("" ::: "memory");
                }
            }
        }
        {
            const int qi = wq * 32 + r32;
            const bf16_t* vt = p.VT() + (size_t)bh * 128 * RB + ib + hi * 8;
#pragma unroll 1
            for (int jb = 0; jb < 4; ++jb) {
                asm volatile("" ::: "memory");
                const bf16_t* rk = p.RK() + ((size_t)bh * RB + ib + jb * 32 + r32) * 64 + hi * 8;
                f32x16 pp = f32x16{};
#pragma unroll
                for (int ks = 0; ks < 4; ++ks) pp = __builtin_amdgcn_mfma_f32_32x32x16_bf16(ldfrag(rk + ks * 16), q[ks], pp, 0, 0, 0);
#pragma unroll
                for (int r = 0; r < 16; ++r) {
                    const int dd = qi - (jb * 32 + crow(r, hi));
                    const float ex = __builtin_amdgcn_exp2f(dd > 0 ? (float)dd * lf : (float)(-dd) * lb); const float w = dd == 0 ? 2.0f : ex;
                    pp[r] *= w;
                }
                bf16x8 pa0, pa1;
                PK4(pp, 0, pa0); PK4(pp, 8, pa1);
#pragma unroll
                for (int d0 = 0; d0 < 4; ++d0) {
                    o[d0] = __builtin_amdgcn_mfma_f32_32x32x16_bf16(pa0, ldfrag(vt + (size_t)(d0 * 32 + r32) * RB + jb * 32), o[d0], 0, 0, 0);
                    o[d0] = __builtin_amdgcn_mfma_f32_32x32x16_bf16(pa1, ldfrag(vt + (size_t)(d0 * 32 + r32) * RB + jb * 32 + 16), o[d0], 0, 0, 0);
                }
            }
        }
        __syncthreads();
        {
            float* xo = img + half * 16384 + (wq * 32) * 128 + r32;
#pragma unroll
            for (int r = 0; r < 16; ++r)
#pragma unroll
                for (int d0 = 0; d0 < 4; ++d0) xo[crow(r, hi) * 128 + d0 * 32] = o[d0][r];
        }
        __syncthreads();
        {
            const float g0 = p.ret_g[lane * 2], g1 = p.ret_g[lane * 2 + 1];
#pragma unroll 4
            for (int rr = 0; rr < 32; ++rr) {
                const int row = wid * 32 + rr, itl = row >> 7, rw = row & 127, hh = hp * 2 + itl;
                const float2 a = *(const float2*)(img + row * 128 + lane * 2);
                const float ss = wave_sum(a.x * a.x + a.y * a.y);
                const float rs = rsqrtf(ss * (1.0f / 128) + EPS);
                const size_t tt = (size_t)b * SEQ + lc * 128 + rw;
                const unsigned gg = *(const unsigned*)(p.RG() + tt * 512 + hh * 128 + lane * 2);
                const float ga = bf2f((bf16_t)(gg & 0xffff)), gb = bf2f((bf16_t)(gg >> 16));
                *(unsigned*)(p.MIX() + tt * 1024 + 512 + hh * 128 + lane * 2) = cvtpk(siluf(ga) * a.x * rs * g0, siluf(gb) * a.y * rs * g1);
            }
        }
    }
}


__device__ __forceinline__ void ph_gemm_out(const MK& p, int bid, int nb, int tid_l) {
    const int tid = tid_l, wid = tid >> 6, lane = tid & 63, wr = wid >> 2, wc = wid & 3, fr = lane & 15, fq = lane >> 4;
    for (int tile = bid; tile < (T / 256) * 4; tile += nb) {
        const int pm = tile >> 2, pn = tile & 3, brow = pm * 256, bcol = pn * 256;
        unsigned Ao[4], Bo[4];
        stage_offs(D * 2, Ao, tid_l); stage_offs(D * 2, Bo, tid_l);
        f32x4 acc[8][4];
        gemm_core((const char*)(p.MIX() + (size_t)brow * D), Ao, (const char*)(p.w_outT() + (size_t)bcol * D), Bo, D / 64, acc, tid_l);
        const float* g1 = p.mod() + (size_t)(brow / SEQ) * 6 * D + 2 * D + bcol + wc * 64 + fq * 4;
#pragma unroll
        for (int m = 0; m < 8; ++m) {
            int ioff = m * 16; asm volatile("" : "+v"(ioff) :: "memory");
            const size_t o = (size_t)(brow + wr * 128 + fr + ioff) * D + bcol + wc * 64 + fq * 4;
#pragma unroll
            for (int n = 0; n < 4; ++n) {
                const float4 xv = *(const float4*)(p.x + o + n * 16), g = *(const float4*)(g1 + n * 16);
                *(float4*)(p.out + o + n * 16) = make_float4(xv.x + g.x * acc[m][n][0], xv.y + g.y * acc[m][n][1], xv.z + g.z * acc[m][n][2], xv.w + g.w * acc[m][n][3]);
            }
        }
    }
}

__device__ __forceinline__ bool route_token(float logit, float bias, int lane, float& wt) {
    const float score = 1.0f / (1.0f + expf(-logit));
    const float sel = score + bias;
    float m1 = sel, m2 = -INFINITY;
#pragma unroll
    for (int o = 1; o < 8; o <<= 1) {
        float p1 = __shfl_xor(m1, o), p2 = __shfl_xor(m2, o);
        float n1 = fmaxf(m1, p1), n2 = fmaxf(fminf(m1, p1), fmaxf(m2, p2));
        m1 = n1; m2 = n2;
    }
    const float gs = m1 + m2;
    const int grp = lane >> 3;
    int grank = 0;
#pragma unroll
    for (int g2 = 0; g2 < 8; ++g2) { float og = __uint_as_float(__builtin_amdgcn_readlane(__float_as_uint(gs), g2 * 8)); grank += (og > gs || (og == gs && g2 < grp)) ? 1 : 0; }
    const float val = grank < 4 ? sel : -INFINITY;
    int rank = 0;
#pragma unroll
    for (int e = 0; e < 64; ++e) { float ov = __uint_as_float(__builtin_amdgcn_readlane(__float_as_uint(val), e)); rank += (ov > val || (ov == val && e < lane)) ? 1 : 0; }
    const bool chosen = rank < 8;
    const float wsum = wave_sum(chosen ? score : 0.f);
    wt = score / wsum * 2.5f;
    return chosen;
}
__device__ __forceinline__ void ph_route(const MK& p, int bid, int nb, int tid_l) {
    const int tid = tid_l, wid = tid >> 6, lane = tid & 63, r32 = lane & 31, hi = lane >> 5;
    int* wcnt = (int*)smem;
    int* basel = wcnt + 512;
    const float bias = p.router_b[lane];
    for (int item = bid; item < T / 256; item += nb) {
        const int t0 = item * 256 + wid * 32, b = (item * 256) / SEQ;
        const float* xr = p.out + (size_t)(t0 + r32) * D + hi * 8;
        float ss = 0.f;
#pragma unroll 8
        for (int ks = 0; ks < 64; ++ks) { const float4 a = *(const float4*)(xr + ks * 16), c = *(const float4*)(xr + ks * 16 + 4);
            ss += a.x * a.x + a.y * a.y + a.z * a.z + a.w * a.w + c.x * c.x + c.y * c.y + c.z * c.z + c.w * c.w; }
        ss += __shfl_xor(ss, 32);
        const float rstd = rsqrtf(ss * (1.0f / D) + EPS);
        const float* mg = p.norm2_g + hi * 8; const float* msh = p.mod() + (size_t)b * 6 * D + 3 * D + hi * 8; const float* msc = p.mod() + (size_t)b * 6 * D + 4 * D + hi * 8;
        const bf16_t* rT = p.routerT() + (size_t)r32 * D + hi * 8;
        bf16_t* h2w = p.H2() + (size_t)(t0 + r32) * D + hi * 8;
        f32x16 acc0 = f32x16{}, acc1 = f32x16{};
#pragma unroll 2
        for (int ks = 0; ks < 64; ++ks) {
            const int k0 = ks * 16;
            float hv[8];
            { const float4 a = *(const float4*)(xr + k0), c = *(const float4*)(xr + k0 + 4);
              const float4 g0 = *(const float4*)(mg + k0), g1 = *(const float4*)(mg + k0 + 4), s0 = *(const float4*)(msc + k0), s1 = *(const float4*)(msc + k0 + 4),
                           h0 = *(const float4*)(msh + k0), h1 = *(const float4*)(msh + k0 + 4);
              hv[0] = a.x * rstd * g0.x * (1 + s0.x) + h0.x; hv[1] = a.y * rstd * g0.y * (1 + s0.y) + h0.y; hv[2] = a.z * rstd * g0.z * (1 + s0.z) + h0.z; hv[3] = a.w * rstd * g0.w * (1 + s0.w) + h0.w;
              hv[4] = c.x * rstd * g1.x * (1 + s1.x) + h1.x; hv[5] = c.y * rstd * g1.y * (1 + s1.y) + h1.y; hv[6] = c.z * rstd * g1.z * (1 + s1.z) + h1.z; hv[7] = c.w * rstd * g1.w * (1 + s1.w) + h1.w; }
            u32x4 wh, wl;
            wh.x = cvtpk(hv[0], hv[1]); wh.y = cvtpk(hv[2], hv[3]); wh.z = cvtpk(hv[4], hv[5]); wh.w = cvtpk(hv[6], hv[7]);
            wl.x = cvtpk(hv[0] - __uint_as_float(wh.x << 16), hv[1] - __uint_as_float(wh.x & 0xffff0000u));
            wl.y = cvtpk(hv[2] - __uint_as_float(wh.y << 16), hv[3] - __uint_as_float(wh.y & 0xffff0000u));
            wl.z = cvtpk(hv[4] - __uint_as_float(wh.z << 16), hv[5] - __uint_as_float(wh.z & 0xffff0000u));
            wl.w = cvtpk(hv[6] - __uint_as_float(wh.w << 16), hv[7] - __uint_as_float(wh.w & 0xffff0000u));
            *(u32x4*)(h2w + k0) = wh;
            const bf16x8 ah = *reinterpret_cast<bf16x8*>(&wh), al = *reinterpret_cast<bf16x8*>(&wl);
            const bf16x8 bh0 = ldfrag(rT + k0), bh1 = ldfrag(rT + 32 * D + k0), bl0 = ldfrag(rT + 64 * D + k0), bl1 = ldfrag(rT + 96 * D + k0);
            acc0 = __builtin_amdgcn_mfma_f32_32x32x16_bf16(ah, bh0, acc0, 0, 0, 0); acc0 = __builtin_amdgcn_mfma_f32_32x32x16_bf16(ah, bl0, acc0, 0, 0, 0); acc0 = __builtin_amdgcn_mfma_f32_32x32x16_bf16(al, bh0, acc0, 0, 0, 0);
            acc1 = __builtin_amdgcn_mfma_f32_32x32x16_bf16(ah, bh1, acc1, 0, 0, 0); acc1 = __builtin_amdgcn_mfma_f32_32x32x16_bf16(ah, bl1, acc1, 0, 0, 0); acc1 = __builtin_amdgcn_mfma_f32_32x32x16_bf16(al, bh1, acc1, 0, 0, 0);
        }
        int mycount = 0;
#pragma unroll
        for (int r = 0; r < 16; ++r) {
            auto sw = __builtin_amdgcn_permlane32_swap(__float_as_uint(acc0[r]), __float_as_uint(acc1[r]), false, false);
            float wt;
            mycount += route_token(__uint_as_float(sw[0]), bias, lane, wt) ? 1 : 0;
            mycount += route_token(__uint_as_float(sw[1]), bias, lane, wt) ? 1 : 0;
        }
        __syncthreads();
        wcnt[wid * 64 + lane] = mycount;
        __syncthreads();
        if (wid == 0) { int tot = 0;
#pragma unroll
            for (int w = 0; w < 8; ++w) tot += wcnt[w * 64 + lane];
            basel[lane] = atomicAdd(&p.cnt()[lane], tot); }
        __syncthreads();
        int running = basel[lane];
        for (int w = 0; w < wid; ++w) running += wcnt[w * 64 + lane];
#pragma unroll
        for (int r = 0; r < 16; ++r) {
            auto sw = __builtin_amdgcn_permlane32_swap(__float_as_uint(acc0[r]), __float_as_uint(acc1[r]), false, false);
#pragma unroll
            for (int hf = 0; hf < 2; ++hf) {
                float wt; const bool ch = route_token(__uint_as_float(sw[hf]), bias, lane, wt);
                const int t = t0 + crow(r, hf);
                const unsigned long long bal = __ballot(ch);
                if (ch) {
                    const int kidx = __popcll(bal & ((1ull << lane) - 1ull));
                    p.tok_list()[(size_t)lane * ECAP + running] = t; p.wt_list()[(size_t)lane * ECAP + running] = wt;
                    p.tokmap()[(size_t)t * 8 + kidx] = lane * ECAP + running; ++running;
                }
            }
        }
    }
}

constexpr int MOE_AUX = 131072;
__device__ __forceinline__ void moe_tables(const MK& p, int colt, int* tpre, int* rbase, int tid_l) {
    __syncthreads();
    if (tid_l == 0) { int tp = 0, rb = 0;
        for (int e = 0; e < 65; ++e) { const int c = e < 64 ? p.cnt()[e] : T; tpre[e] = tp; rbase[e] = rb; tp += ((c + 255) >> 8) * colt; rb += c; }
        tpre[65] = tp; rbase[65] = rb; }
    __syncthreads();
}
__device__ __forceinline__ void ph_moe_up(const MK& p, int bid, int nb, int tid_l) {
    const int tid = tid_l, wid = tid >> 6, lane = tid & 63, wr = wid >> 2, wc = wid & 3, fr = lane & 15, fq = lane >> 4;
    int* tpre = (int*)(smem + MOE_AUX); int* rbase = tpre + 80;
    moe_tables(p, 2, tpre, rbase, tid_l);
    const int ntiles = tpre[65];
    for (int tile = bid; tile < ntiles; tile += nb) {
        int e = 0; while (tile >= tpre[e + 1]) ++e;
        const int j = tile - tpre[e], rt = j >> 1, ct = j & 1, cnt_e = e < 64 ? p.cnt()[e] : T;
        unsigned Ao[4], Bo[4];
#pragma unroll
        for (int i = 0; i < 4; ++i) { int R, C; stage_rc(wid * 1024 + i * 8192 + lane * 16, R, C);
            int slot = rt * 256 + R; if (slot >= cnt_e) slot = 0;
            const int tok = e < 64 ? p.tok_list()[(size_t)e * ECAP + slot] : slot;
            Ao[i] = (unsigned)tok * (D * 2u) + (unsigned)C * 2u; }
        stage_offs(D * 2, Bo, tid_l);
        f32x4 acc[8][4];
        gemm_core((const char*)p.H2(), Ao, (const char*)(p.W13t() + ((size_t)e * 512 + ct * 256) * D), Bo, D / 64, acc, tid_l);
#pragma unroll
        for (int m = 0; m < 8; ++m) {
            int ioff = m * 16; asm volatile("" : "+v"(ioff) :: "memory");
            const int slot = rt * 256 + wr * 128 + fr + ioff;
            if (slot < cnt_e) {
                bf16_t* dp = p.ACT() + (size_t)(rbase[e] + slot) * DE + ct * 128 + wc * 32 + fq * 4;
#pragma unroll
                for (int n = 0; n < 2; ++n) {
                    u32x2 w; w.x = cvtpk(siluf(acc[m][n][0]) * acc[m][n + 2][0], siluf(acc[m][n][1]) * acc[m][n + 2][1]);
                    w.y = cvtpk(siluf(acc[m][n][2]) * acc[m][n + 2][2], siluf(acc[m][n][3]) * acc[m][n + 2][3]);
                    *(u32x2*)(dp + n * 16) = w;
                }
            }
        }
    }
}
constexpr float Y_SCALE = 64.0f;
__device__ __forceinline__ void ph_moe_down(const MK& p, int bid, int nb, int tid_l) {
    const int tid = tid_l, wid = tid >> 6, lane = tid & 63, wr = wid >> 2, wc = wid & 3, fr = lane & 15, fq = lane >> 4;
    int* tpre = (int*)(smem + MOE_AUX); int* rbase = tpre + 80;
    moe_tables(p, 4, tpre, rbase, tid_l);
    const int ntiles = tpre[65];
    for (int tile = bid; tile < ntiles; tile += nb) {
        int e = 0; while (tile >= tpre[e + 1]) ++e;
        const int j = tile - tpre[e], rt = j >> 2, ct = j & 3, cnt_e = e < 64 ? p.cnt()[e] : T;
        unsigned Ao[4], Bo[4];
        stage_offs(DE * 2, Ao, tid_l); stage_offs(DE * 2, Bo, tid_l);
        f32x4 acc[8][4];
        gemm_core((const char*)(p.ACT() + (size_t)(rbase[e] + rt * 256) * DE), Ao, (const char*)(p.W2t() + ((size_t)e * D + ct * 256) * DE), Bo, DE / 64, acc, tid_l);
        const int col0 = ct * 256 + wc * 64 + fq * 4;
        if (e < 64) {
            const float* wl = p.wt_list() + (size_t)e * ECAP;
            unsigned char* yb = p.Y() + (size_t)rbase[e] * D + col0;
#pragma unroll
            for (int m = 0; m < 8; ++m) {
                int ioff = m * 16; asm volatile("" : "+v"(ioff) :: "memory");
                const int slot = rt * 256 + wr * 128 + fr + ioff;
                if (slot < cnt_e) {
                    const float w = wl[slot] * Y_SCALE;
                    unsigned char* dp = yb + (size_t)slot * D;
#pragma unroll
                    for (int n = 0; n < 4; ++n) {
                        float v0 = fminf(fmaxf(acc[m][n][0] * w, -448.f), 448.f), v1 = fminf(fmaxf(acc[m][n][1] * w, -448.f), 448.f);
                        float v2 = fminf(fmaxf(acc[m][n][2] * w, -448.f), 448.f), v3 = fminf(fmaxf(acc[m][n][3] * w, -448.f), 448.f);
                        int pk = 0; pk = __builtin_amdgcn_cvt_pk_fp8_f32(v0, v1, pk, false); pk = __builtin_amdgcn_cvt_pk_fp8_f32(v2, v3, pk, true);
                        *(int*)(dp + n * 16) = pk;
                    }
                }
            }
        } else {
            const float* g2 = p.mod() + (size_t)((rt * 256) / SEQ) * 6 * D + 5 * D + col0;
            float4 gv[4];
#pragma unroll
            for (int n = 0; n < 4; ++n) gv[n] = *(const float4*)(g2 + n * 16);
            float* xb = p.out + (size_t)(rt * 256) * D + col0;
#pragma unroll
            for (int m = 0; m < 8; ++m) {
                int ioff = m * 16; asm volatile("" : "+v"(ioff) :: "memory");
                float* xp = xb + (size_t)(wr * 128 + fr + ioff) * D;
#pragma unroll
                for (int n = 0; n < 4; ++n) {
                    float4 xv = *(float4*)(xp + n * 16);
                    xv.x += gv[n].x * acc[m][n][0]; xv.y += gv[n].y * acc[m][n][1]; xv.z += gv[n].z * acc[m][n][2]; xv.w += gv[n].w * acc[m][n][3];
                    *(float4*)(xp + n * 16) = xv;
                }
            }
        }
    }
}

__device__ __forceinline__ void ph_final(const MK& p, int bid, int nb, int tid_l) {
    const int wid = tid_l >> 6, lane = tid_l & 63;
    int* tpre = (int*)(smem + MOE_AUX); int* rbase = tpre + 80;
    moe_tables(p, 1, tpre, rbase, tid_l);
    for (int t = bid * 8 + wid; t < T; t += nb * 8) {
        const int b = t / SEQ;
        float f[16];
#pragma unroll
        for (int i = 0; i < 16; ++i) f[i] = 0.f;
#pragma unroll
        for (int k = 0; k < 8; ++k) {
            const int id = p.tokmap()[(size_t)t * 8 + k], e = id >> 15, slot = id & (ECAP - 1);
            const unsigned char* yr = p.Y() + (size_t)(rbase[e] + slot) * D + lane * 4;
#pragma unroll
            for (int q = 0; q < 4; ++q) {
                const int w = *(const int*)(yr + q * 256);
                const auto lo = __builtin_amdgcn_cvt_pk_f32_fp8(w, false); const auto hi = __builtin_amdgcn_cvt_pk_f32_fp8(w, true);
                f[q * 4 + 0] += lo[0]; f[q * 4 + 1] += lo[1]; f[q * 4 + 2] += hi[0]; f[q * 4 + 3] += hi[1];
            }
        }
        const float* g2 = p.mod() + (size_t)b * 6 * D + 5 * D + lane * 4;
        float* xo = p.out + (size_t)t * D + lane * 4;
        float v[16]; float ss = 0.f;
#pragma unroll
        for (int q = 0; q < 4; ++q) {
            const float4 xv = *(const float4*)(xo + q * 256), g = *(const float4*)(g2 + q * 256);
            v[q * 4 + 0] = xv.x + g.x * f[q * 4 + 0] * (1.0f / Y_SCALE); v[q * 4 + 1] = xv.y + g.y * f[q * 4 + 1] * (1.0f / Y_SCALE);
            v[q * 4 + 2] = xv.z + g.z * f[q * 4 + 2] * (1.0f / Y_SCALE); v[q * 4 + 3] = xv.w + g.w * f[q * 4 + 3] * (1.0f / Y_SCALE);
            ss += v[q * 4] * v[q * 4] + v[q * 4 + 1] * v[q * 4 + 1] + v[q * 4 + 2] * v[q * 4 + 2] + v[q * 4 + 3] * v[q * 4 + 3];
        }
        ss = wave_sum(ss);
        const float rstd = rsqrtf(ss * (1.0f / D) + EPS);
#pragma unroll
        for (int q = 0; q < 4; ++q) {
            const float4 gf = *(const float4*)(p.final_g + q * 256 + lane * 4);
            *(float4*)(xo + q * 256) = make_float4(v[q * 4] * rstd * gf.x, v[q * 4 + 1] * rstd * gf.y, v[q * 4 + 2] * rstd * gf.z, v[q * 4 + 3] * rstd * gf.w);
        }
    }
}

__global__ __launch_bounds__(512, 2) void k_mega(MK p) {
    cg::grid_group grid = cg::this_grid();
    const int bid = blockIdx.x, nb = gridDim.x;
#define PH_TID() int t_ = threadIdx.x; asm volatile("" : "+v"(t_))
    { PH_TID(); if (bid == 0 && t_ < 80) p.cnt()[t_] = 0; ph_mod(p, bid, nb, t_); ph_convert(p, bid, nb, t_); }
    grid.sync();
    { PH_TID(); ph_ln1(p, bid, nb, t_); }
    grid.sync();
    { PH_TID(); ph_gemm_in(p, bid, nb, t_); }
    grid.sync();
    { PH_TID(); ph_attn(p, bid, nb, t_); }
    { PH_TID(); ph_kv(p, bid, nb, t_); }
    grid.sync();
    { PH_TID(); ph_scan(p, bid, nb, t_); }
    grid.sync();
    { PH_TID(); ph_ret(p, bid, nb, t_); }
    grid.sync();
    { PH_TID(); ph_gemm_out(p, bid, nb, t_); }
    grid.sync();
    { PH_TID(); ph_route(p, bid, nb, t_); }
    grid.sync();
    { PH_TID(); ph_moe_up(p, bid, nb, t_); }
    grid.sync();
    { PH_TID(); ph_moe_down(p, bid, nb, t_); }
    grid.sync();
    { PH_TID(); ph_final(p, bid, nb, t_); }
#undef PH_TID
}
constexpr int LDS_TOTAL = 132096;
extern "C" void kernel_launch(void* const* d_in, const int* in_sizes, int n_in, void* d_out, int out_size, void* d_ws, size_t ws_size, hipStream_t stream) {
    char* ws = (char*)d_ws;
    MK mk{};
    mk.x = (const float*)d_in[0]; mk.c = (const float*)d_in[1]; mk.ctx = (const float*)d_in[2]; mk.cctx = (const float*)d_in[3]; mk.ada_w = (const float*)d_in[4]; mk.ada_b = (const float*)d_in[5];
    mk.norm1_g = (const float*)d_in[6]; mk.w_in = (const float*)d_in[7]; mk.lq1 = (const float*)d_in[8]; mk.lk1 = (const float*)d_in[9]; mk.lq2 = (const float*)d_in[10]; mk.lk2 = (const float*)d_in[11];
    mk.dattn_g = (const float*)d_in[12]; mk.dec_f = (const float*)d_in[13]; mk.dec_b = (const float*)d_in[14]; mk.ret_g = (const float*)d_in[15]; mk.w_out = (const float*)d_in[16];
    mk.norm2_g = (const float*)d_in[17]; mk.router_w = (const float*)d_in[18]; mk.router_b = (const float*)d_in[19]; mk.ew1 = (const float*)d_in[20]; mk.ew3 = (const float*)d_in[21];
    mk.ew2 = (const float*)d_in[22]; mk.sw1 = (const float*)d_in[23]; mk.sw3 = (const float*)d_in[24]; mk.sw2 = (const float*)d_in[25]; mk.final_g = (const float*)d_in[26];
    mk.out = (float*)d_out;
    mk.ws = ws;
    mk.dbgP = nullptr; mk.dbg_lo = 0; mk.dbg_hi = 12; mk.conv_limit = 1 << 30;
    static int grid_blocks = 0;
    if (!grid_blocks) {
        (void)hipFuncSetAttribute((const void*)k_mega, hipFuncAttributeMaxDynamicSharedMemorySize, LDS_TOTAL);
        int dev = 0, cus = 0, per_cu = 0;
        (void)hipGetDevice(&dev);
        (void)hipDeviceGetAttribute(&cus, hipDeviceAttributeMultiprocessorCount, dev);
        (void)hipOccupancyMaxActiveBlocksPerMultiprocessor(&per_cu, k_mega, 512, LDS_TOTAL);
        if (per_cu > 1) per_cu = 1;
        grid_blocks = cus * per_cu;
        if (grid_blocks <= 0) { fprintf(stderr, "occupancy query failed: cus %d per_cu %d\n", cus, per_cu); grid_blocks = 256; }
    }
    void* args[] = {&mk};
    hipError_t e = hipLaunchCooperativeKernel((void*)k_mega, dim3(grid_blocks), dim3(512), args, LDS_TOTAL, stream);
    if (e != hipSuccess) fprintf(stderr, "cooperative launch failed: %s (grid %d)\n", hipGetErrorString(e), grid_blocks);
}
```

```cpp
#include <hip/hip_runtime.h>
#include <hip/hip_cooperative_groups.h>
#include <cstdio>
namespace cg = cooperative_groups;
#ifndef DUP
#define DUP 0
#endif
#include <stdint.h>

constexpr int D = 1024, NB = 4, SEQ = 8192, CTX = 256, RB = SEQ + CTX  , NR = NB * RB  , T = NB * SEQ;
constexpr int NE = 64, DE = 256, ECAP = 32768;
constexpr float EPS = 1e-6f;
typedef unsigned short bf16_t;

__device__ __forceinline__ float siluf(float v) { return v / (1.0f + expf(-v)); }
__device__ __forceinline__ float wave_sum(float v) {
#pragma unroll
    for (int o = 32; o > 0; o >>= 1) v += __shfl_xor(v, o);
    return v;
}
__device__ __forceinline__ float wave_max(float v) {
#pragma unroll
    for (int o = 32; o > 0; o >>= 1) v = fmaxf(v, __shfl_xor(v, o));
    return v;
}
__device__ __forceinline__ float block_sum(float v, float* red) {
    v = wave_sum(v);
    __syncthreads();
    if ((threadIdx.x & 63) == 0) red[threadIdx.x >> 6] = v;
    __syncthreads();
    return red[0] + red[1] + red[2] + red[3];
}
__device__ __forceinline__ float block_max(float v, float* red) {
    v = wave_max(v);
    __syncthreads();
    if ((threadIdx.x & 63) == 0) red[threadIdx.x >> 6] = v;
    __syncthreads();
    return fmaxf(fmaxf(red[0], red[1]), fmaxf(red[2], red[3]));
}

typedef short bf16x8 __attribute__((ext_vector_type(8)));
typedef short s16x4 __attribute__((ext_vector_type(4)));
typedef float f32x4 __attribute__((ext_vector_type(4)));
typedef float f32x16 __attribute__((ext_vector_type(16)));
typedef unsigned u32x2 __attribute__((ext_vector_type(2)));
typedef unsigned u32x4 __attribute__((ext_vector_type(4)));
extern __shared__ __attribute__((aligned(1024))) char smem[];
constexpr int NTHR = 512;
constexpr int GEMM_LDS = 131072;

__device__ __forceinline__ unsigned cvtpk(float lo, float hi) { unsigned r; asm volatile("v_cvt_pk_bf16_f32 %0, %1, %2" : "=v"(r) : "v"(lo), "v"(hi)); return r; }
__device__ __forceinline__ bf16_t f2bf(float v) { return (bf16_t)(cvtpk(v, v) & 0xffffu); }
__device__ __forceinline__ float bf2f(bf16_t v) { return __uint_as_float(((unsigned)v) << 16); }

constexpr size_t MiB = 1048576;
struct MK {
    const float *x, *c, *ctx, *cctx, *ada_w, *ada_b, *norm1_g, *w_in, *lq1, *lk1, *lq2, *lk2, *dattn_g, *dec_f, *dec_b, *ret_g, *w_out, *norm2_g, *router_w, *router_b,
        *ew1, *ew3, *ew2, *sw1, *sw3, *sw2, *final_g;
    float* out; char* ws;
    float* dbgP; long dbg_lo, dbg_hi; long conv_limit;
#define WSF(name, type, off) __device__ __forceinline__ type* name() const { return (type*)(ws + (off)); }
    WSF(mod, float, 0) WSF(cnt, int, 131072) WSF(ropec, float, 262144) WSF(ropes, float, 262144 + 8192)
    WSF(w_inT, bf16_t, 1 * MiB) WSF(w_outT, bf16_t, 7 * MiB) WSF(routerT, bf16_t, 9 * MiB) WSF(W2t, bf16_t, 9 * MiB + 524288)
    WSF(H, bf16_t, 42 * MiB) WSF(MIX, bf16_t, 42 * MiB) WSF(KV, bf16_t, 112 * MiB) WSF(ST, bf16_t, 147 * MiB) WSF(ACT, bf16_t, 42 * MiB)
    WSF(W13t, bf16_t, 194 * MiB) WSF(H2, bf16_t, 260 * MiB)
    WSF(Q, bf16_t, 260 * MiB) WSF(K, bf16_t, 292 * MiB) WSF(V, bf16_t, 325 * MiB) WSF(RQ, bf16_t, 358 * MiB) WSF(RK, bf16_t, 375 * MiB)
    WSF(KTf, bf16_t, 392 * MiB) WSF(KTb, bf16_t, 409 * MiB) WSF(VT, bf16_t, 426 * MiB) WSF(RG, bf16_t, 459 * MiB)
    WSF(Y, unsigned char, 194 * MiB) WSF(tok_list, int, 452 * MiB) WSF(wt_list, float, 460 * MiB) WSF(tokmap, int, 468 * MiB)
#undef WSF
};

__device__ __forceinline__ void ph_mod(const MK& p, int bid, int nb, int tid_l) {
    float* red = (float*)smem;
    for (int it = bid; it < 6 * D / 32; it += nb) {
        const int col = tid_l & 31, kg = tid_l >> 5, j = it * 32 + col;
        float a[5] = {0, 0, 0, 0, 0};
        for (int k = kg * 64; k < kg * 64 + 64; ++k) {
            float w = p.ada_w[(size_t)k * 6 * D + j];
#pragma unroll
            for (int r = 0; r < 5; ++r) { float cv = r < 4 ? p.c[r * D + k] : p.cctx[k]; a[r] += siluf(cv) * w; }
        }
        __syncthreads();
#pragma unroll
        for (int r = 0; r < 5; ++r) red[(kg * 5 + r) * 32 + col] = a[r];
        __syncthreads();
        if (tid_l < 160) {
            int r = tid_l >> 5; float s = 0;
            for (int g = 0; g < 16; ++g) s += red[(g * 5 + r) * 32 + col];
            p.mod()[(size_t)r * 6 * D + j] = s + p.ada_b[j];
        }
    }
    if (bid == nb - 1) {
        for (int i = tid_l; i < 128 * 16; i += NTHR) {
            int pos = i >> 4, f = i & 15;
            float inv_freq = (float)pow(10000.0, -(double)f / 16.0);
            float s, c; sincosf((float)pos * inv_freq, &s, &c);
            p.ropec()[i] = c; p.ropes()[i] = s;
        }
    }
    __syncthreads();
}

__device__ __forceinline__ void tr_tile(const float* src, int ldsrc, int k0, int n0, bf16_t* dst, int lddst, int mode  , bf16_t* dst2, int tid_l) {
    float* t = (float*)smem;
    __syncthreads();
    for (int i = tid_l; i < 64 * 16; i += NTHR) {
        int r = i >> 4, c4 = (i & 15) * 4;
        float4 v = *(const float4*)(src + (size_t)(k0 + r) * ldsrc + n0 + c4);
        t[r * 65 + c4] = v.x; t[r * 65 + c4 + 1] = v.y; t[r * 65 + c4 + 2] = v.z; t[r * 65 + c4 + 3] = v.w;
    }
    __syncthreads();
    for (int i = tid_l; i < 64 * 16; i += NTHR) {
        int n = i >> 4, k4 = (i & 15) * 4;
        float a = t[(k4 + 0) * 65 + n], b = t[(k4 + 1) * 65 + n], c = t[(k4 + 2) * 65 + n], d = t[(k4 + 3) * 65 + n];
        int nn = n0 + n, row = nn;
        if (mode == 1 || mode == 2) { int ct = nn >> 7, wc = (nn & 127) >> 5, within = nn & 31; row = ct * 256 + wc * 64 + (mode == 2 ? 32 : 0) + within; }
        u32x2 w; w.x = cvtpk(a, b); w.y = cvtpk(c, d);
        *(u32x2*)(dst + (size_t)row * lddst + k0 + k4) = w;
        if (mode == 3) {
            float ah = bf2f((bf16_t)(w.x & 0xffff)), bh = bf2f((bf16_t)(w.x >> 16)), ch = bf2f((bf16_t)(w.y & 0xffff)), dh = bf2f((bf16_t)(w.y >> 16));
            u32x2 l; l.x = cvtpk(a - ah, b - bh); l.y = cvtpk(c - ch, d - dh);
            *(u32x2*)(dst2 + (size_t)row * lddst + k0 + k4) = l;
        }
    }
}
__device__ __forceinline__ void ph_convert(const MK& p, int bid, int nb, int tid_l) {
    const int n_win = 16 * 48, n_wout = 16 * 16, n_rt = 16, n_e13 = 65 * 2 * 16 * 4, n_e2 = 65 * 4 * 16;
    int total = n_win + n_wout + n_rt + n_e13 + n_e2; if (p.conv_limit < total) total = (int)p.conv_limit;
    for (int it = bid; it < total; it += nb) {
        int j = it;
        if (j < n_win) { tr_tile(p.w_in, 3072, (j / 48) * 64, (j % 48) * 64, p.w_inT(), 1024, 0, nullptr, tid_l); continue; } j -= n_win;
        if (j < n_wout) { tr_tile(p.w_out, 1024, (j / 16) * 64, (j % 16) * 64, p.w_outT(), 1024, 0, nullptr, tid_l); continue; } j -= n_wout;
        if (j < n_rt) { tr_tile(p.router_w, 64, j * 64, 0, p.routerT(), 1024, 3, p.routerT() + 64 * 1024, tid_l); continue; } j -= n_rt;
        if (j < n_e13) {
            int e = j / 128, r = j % 128, which = r / 64, tt = r % 64;
            const float* src = e < 64 ? (which ? p.ew3 : p.ew1) + (size_t)e * D * DE : (which ? p.sw3 : p.sw1);
            tr_tile(src, DE, (tt / 4) * 64, (tt % 4) * 64, p.W13t() + (size_t)e * 512 * 1024, 1024, 1 + which, nullptr, tid_l); continue; } j -= n_e13;
        { int e = j / 64, tt = j % 64;
          const float* src = e < 64 ? p.ew2 + (size_t)e * DE * D : p.sw2;
          tr_tile(src, D, (tt / 16) * 64, (tt % 16) * 64, p.W2t() + (size_t)e * 1024 * 256, 256, 0, nullptr, tid_l); }
    }
    __syncthreads();
}

__device__ __forceinline__ void ph_ln1(const MK& p, int bid, int nb, int tid_l) {
    const int wid = tid_l >> 6, lane = tid_l & 63;
    for (int R = bid * 8 + wid; R < NR; R += nb * 8) {
        int b = R / RB, i = R % RB;
        const float* src = i < CTX ? p.ctx + ((size_t)b * CTX + i) * D : p.x + ((size_t)b * SEQ + (i - CTX)) * D;
        const float* m = p.mod() + (size_t)(i < CTX ? 4 : b) * 6 * D;
        float4 v[4]; float ss = 0;
#pragma unroll
        for (int q = 0; q < 4; ++q) { v[q] = *(const float4*)(src + q * 256 + lane * 4); ss += v[q].x * v[q].x + v[q].y * v[q].y + v[q].z * v[q].z + v[q].w * v[q].w; }
        ss = wave_sum(ss);
        float rstd = rsqrtf(ss * (1.0f / D) + EPS);
#pragma unroll
        for (int q = 0; q < 4; ++q) {
            int c0 = q * 256 + lane * 4;
            float4 gg = *(const float4*)(p.norm1_g + c0), sh = *(const float4*)(m + c0), sc = *(const float4*)(m + D + c0);
            float o0 = v[q].x * rstd * gg.x * (1 + sc.x) + sh.x, o1 = v[q].y * rstd * gg.y * (1 + sc.y) + sh.y;
            float o2 = v[q].z * rstd * gg.z * (1 + sc.z) + sh.z, o3 = v[q].w * rstd * gg.w * (1 + sc.w) + sh.w;
            u32x2 w; w.x = cvtpk(o0, o1); w.y = cvtpk(o2, o3);
            *(u32x2*)(p.H() + (size_t)R * D + c0) = w;
        }
    }
}

__device__ __forceinline__ int lds_byte(int r, int c) { int st = (r >> 4) * 2 + (c >> 5), ob = (r & 15) * 64 + (c & 31) * 2; return st * 1024 + (ob ^ (((ob >> 9) & 1) << 5)); }
__device__ __forceinline__ void stage_rc(int b, int& R, int& C) { int st = b >> 10, sb = b & 1023, swz = sb ^ (((sb >> 9) & 1) << 5); R = (st / 2) * 16 + swz / 64; C = (st % 2) * 32 + (swz % 64) / 2; }
#define WAIT_V0() asm volatile("s_waitcnt vmcnt(0)" ::: "memory")
__device__ __forceinline__ void gemm_core(const char* Abase, const unsigned (&Ao)[4], const char* Bbase, const unsigned (&Bo)[4], int nt, f32x4 (&acc)[8][4], int tid_l, bool pre) {
    const int tid = tid_l, wid = tid >> 6, lane = tid & 63, wr = wid >> 2, wc = wid & 3, fr = lane & 15, fq = lane >> 4;
#pragma unroll
    for (int m = 0; m < 8; ++m)
#pragma unroll
        for (int n = 0; n < 4; ++n) acc[m][n] = (f32x4){0.f, 0.f, 0.f, 0.f};
#define G_SA(b) (smem + (b) * 65536)
#define G_SB(b) (smem + (b) * 65536 + 32768)
#define G_STAGE(buf, kt) do { _Pragma("unroll") for (int i = 0; i < 4; ++i) {                                                     \
        __builtin_amdgcn_global_load_lds((const unsigned*)(Abase + (Ao[i] + (unsigned)(kt) * 128u)), (unsigned*)(G_SA(buf) + wid * 1024 + i * 8192), 16, 0, 0); \
        __builtin_amdgcn_global_load_lds((const unsigned*)(Bbase + (Bo[i] + (unsigned)(kt) * 128u)), (unsigned*)(G_SB(buf) + wid * 1024 + i * 8192), 16, 0, 0); } } while (0)
    if (!pre) G_STAGE(0, 0);
    WAIT_V0(); __syncthreads();
#pragma unroll 1
    for (int t = 0; t < nt; ++t) {
        const int cur = t & 1;
        if (t + 1 < nt) G_STAGE(cur ^ 1, t + 1);
#pragma unroll
        for (int ks = 0; ks < 2; ++ks) {
            bf16x8 At[8], Bf[4];
#pragma unroll
            for (int m = 0; m < 8; ++m) At[m] = *(const bf16x8*)(G_SA(cur) + lds_byte(wr * 128 + m * 16 + fr, ks * 32 + fq * 8));
#pragma unroll
            for (int n = 0; n < 4; ++n) Bf[n] = *(const bf16x8*)(G_SB(cur) + lds_byte(wc * 64 + n * 16 + fr, ks * 32 + fq * 8));
#pragma unroll
            for (int m = 0; m < 8; ++m)
#pragma unroll
                for (int n = 0; n < 4; ++n) acc[m][n] = __builtin_amdgcn_mfma_f32_16x16x32_bf16(Bf[n], At[m], acc[m][n], 0, 0, 0);
            __builtin_amdgcn_sched_barrier(0);
        }
        WAIT_V0(); __syncthreads();
    }
}
__device__ __forceinline__ void gemm_prefetch(const char* Abase, const unsigned (&Ao)[4], const char* Bbase, const unsigned (&Bo)[4], int tid_l) {
    const int wid = tid_l >> 6;
    G_STAGE(0, 0);
}
__device__ __forceinline__ void stage_offs(unsigned ld_bytes, unsigned (&P)[4], int tid_l) {
    const int wid = tid_l >> 6, lane = tid_l & 63;
#pragma unroll
    for (int i = 0; i < 4; ++i) { int R, C; stage_rc(wid * 1024 + i * 8192 + lane * 16, R, C); P[i] = (unsigned)R * ld_bytes + (unsigned)C * 2u; }
}

__device__ __forceinline__ void ph_gemm_in(const MK& p, int bid, int nb, int tid_l) {
    const int tid = tid_l, wid = tid >> 6, lane = tid & 63, wr = wid >> 2, wc = wid & 3, fr = lane & 15, fq = lane >> 4;
    const int nM = NR / 256, nN = 12;
    unsigned Ao[4], Bo[4];
    stage_offs(D * 2, Ao, tid_l); stage_offs(D * 2, Bo, tid_l);
    bool pre = false;
    for (int tile = bid; tile < nM * nN; tile += nb) {
        const int pm = tile / nN, pn = tile % nN;
        const int brow = pm * 256, bcol = pn * 256;
        f32x4 acc[8][4];
        gemm_core((const char*)(p.H() + (size_t)brow * D), Ao, (const char*)(p.w_inT() + (size_t)bcol * D), Bo, D / 64, acc, tid_l, pre);
        { const int nx = tile + nb; pre = nx < nM * nN;
          if (pre) gemm_prefetch((const char*)(p.H() + (size_t)((nx / nN) * 256) * D), Ao, (const char*)(p.w_inT() + (size_t)((nx % nN) * 256) * D), Bo, tid_l); }
        const int b = brow / RB, i0 = brow % RB;
        const bool lat = i0 >= CTX;
        const int seg = pn;
        const bool do_rope = lat && (seg <= 3 || seg == 6 || seg == 7);
        float lg2f = 0.f, lg2b = 0.f;
        if (seg == 7) { float df = p.dec_f[wc], db = p.dec_b[wc]; lg2f = log2f(1.0f / (1.0f + expf(-df))); lg2b = log2f(1.0f / (1.0f + expf(-db))); }
        const int cw = bcol + wc * 64;
        float4 c0, s0, c1, s1;
        if (do_rope) { const int t0_ = i0 + wr * 128 + fr - CTX, prow = t0_ >> 6, pcol = t0_ & 63;
            c0 = *(const float4*)(p.ropec() + prow * 16 + fq * 4); s0 = *(const float4*)(p.ropes() + prow * 16 + fq * 4);
            c1 = *(const float4*)(p.ropec() + pcol * 16 + fq * 4); s1 = *(const float4*)(p.ropes() + pcol * 16 + fq * 4); }
#pragma unroll
        for (int m = 0; m < 8; ++m) {
            int ioff = m * 16; asm volatile("" : "+v"(ioff) :: "memory");
            const int i = i0 + wr * 128 + fr + ioff, t = i - CTX;
            float v[4][4];
#pragma unroll
            for (int n = 0; n < 4; ++n)
#pragma unroll
                for (int j = 0; j < 4; ++j) v[n][j] = acc[m][n][j];
            float4 nc0, ns0, nc1, ns1;
            if (do_rope && m < 7) { const int tn = t + 16, prow = tn >> 6, pcol = tn & 63;
                nc0 = *(const float4*)(p.ropec() + prow * 16 + fq * 4); ns0 = *(const float4*)(p.ropes() + prow * 16 + fq * 4);
                nc1 = *(const float4*)(p.ropec() + pcol * 16 + fq * 4); ns1 = *(const float4*)(p.ropes() + pcol * 16 + fq * 4); }
            if (do_rope) {
                const float cc0[4] = {c0.x, c0.y, c0.z, c0.w}, ss0[4] = {s0.x, s0.y, s0.z, s0.w}, cc1[4] = {c1.x, c1.y, c1.z, c1.w}, ss1[4] = {s1.x, s1.y, s1.z, s1.w};
#pragma unroll
                for (int j = 0; j < 4; ++j) {
                    float x1 = v[0][j], x2 = v[1][j]; v[0][j] = x1 * cc0[j] - x2 * ss0[j]; v[1][j] = x1 * ss0[j] + x2 * cc0[j];
                    float y1 = v[2][j], y2 = v[3][j]; v[2][j] = y1 * cc1[j] - y2 * ss1[j]; v[3][j] = y1 * ss1[j] + y2 * cc1[j];
                }
            }
            if (seg == 7) {
#pragma unroll
                for (int n = 0; n < 4; ++n)
#pragma unroll
                    for (int j = 0; j < 4; ++j) v[n][j] *= 0.125f;
            }
            if (p.dbgP) {
                {
                    float* dp = p.dbgP + (size_t)(brow + wr * 128 + fr + ioff) * 1536 + (cw % 1536) + fq * 4; const float sc = seg <= 1 ? 0.125f : 1.0f;
#pragma unroll
                    for (int n = 0; n < 4; ++n) *(float4*)(dp + n * 16) = make_float4(v[n][0] * sc, v[n][1] * sc, v[n][2] * sc, v[n][3] * sc);
                }
            } else {
                u32x2 w[4];
#pragma unroll
                for (int n = 0; n < 4; ++n) { w[n].x = cvtpk(v[n][0], v[n][1]); w[n].y = cvtpk(v[n][2], v[n][3]); }
                if (seg <= 5) {
                    const int cc = cw - (seg <= 1 ? 0 : seg <= 3 ? 512 : 1024), h = cc >> 7, wi = (cc & 127) + fq * 4;
                    bf16_t* dp = seg <= 1 ? p.Q() + (((size_t)(b * 4 + h) * SEQ + t) * 128 + wi) : (seg <= 3 ? p.K() : p.V()) + (((size_t)(b * 4 + h) * RB + i) * 128 + wi);
                    if (seg > 1 || lat) {
#pragma unroll
                        for (int n = 0; n < 4; ++n) *(u32x2*)(dp + n * 16) = w[n];
                    }
                } else if (seg <= 7) {
                    bf16_t* dp = (seg == 6 ? p.RQ() : p.RK()) + (((size_t)(b * 4 + wc) * RB + i) * 64 + fq * 4);
#pragma unroll
                    for (int n = 0; n < 4; ++n) *(u32x2*)(dp + n * 16) = w[n];
                    if (seg == 7) {
                        const int pos = i & 127;
                        const float ff = exp2f((float)(127 - pos) * lg2f), fb = exp2f((float)pos * lg2b);
                        const size_t o = ((size_t)(b * 4 + wc) * 64 + fq * 4) * RB + i;
#pragma unroll
                        for (int n = 0; n < 4; ++n)
#pragma unroll
                            for (int j = 0; j < 4; ++j) { p.KTf()[o + (size_t)(n * 16 + j) * RB] = f2bf(v[n][j] * ff); p.KTb()[o + (size_t)(n * 16 + j) * RB] = f2bf(v[n][j] * fb); }
                    }
                } else if (seg <= 9) {
                    const int cc = cw - 2048, h = cc >> 7, e = (cc & 127) + fq * 4;
                    const size_t o = ((size_t)(b * 4 + h) * 128 + e) * RB + i;
#pragma unroll
                    for (int n = 0; n < 4; ++n)
#pragma unroll
                        for (int j = 0; j < 4; ++j) p.VT()[o + (size_t)(n * 16 + j) * RB] = f2bf(v[n][j]);
                } else if (lat) {
                    bf16_t* dp = p.RG() + ((size_t)(b * SEQ + t) * 512 + (cw - 2560) + fq * 4);
#pragma unroll
                    for (int n = 0; n < 4; ++n) *(u32x2*)(dp + n * 16) = w[n];
                }
            }
            if (do_rope && m < 7) { c0 = nc0; s0 = ns0; c1 = nc1; s1 = ns1; }
        }
    }
}


constexpr int A_KVBLK = 64;
constexpr float A_SCALE = 0.125f, A_THR = 8.f;
constexpr int A_SHM_V = A_KVBLK * 128 * 2, A_SHM_K = A_KVBLK * 128 * 2;
#define KSWZ(row, colB) ((row) * 256 + ((colB) ^ (((row) & 7) << 4)))
#define SBAR() __builtin_amdgcn_sched_barrier(0)
__device__ __forceinline__ int crow(int r, int hi) { return (r & 3) + 8 * (r >> 2) + 4 * hi; }

__device__ __forceinline__ void partialSM(f32x16& p0, f32x16& p1, float& m_reg, float& mn, float& alpha) {
    constexpr float C = A_SCALE * 1.4426950408889634f;
    float pmax = p0[0];
#pragma unroll
    for (int r = 1; r < 16; ++r) pmax = fmaxf(pmax, p0[r]);
#pragma unroll
    for (int r = 0; r < 16; ++r) pmax = fmaxf(pmax, p1[r]);
    { auto rr = __builtin_amdgcn_permlane32_swap(__float_as_uint(pmax), __float_as_uint(pmax), false, false);
      pmax = fmaxf(__uint_as_float(rr[0]), __uint_as_float(rr[1])); }
    if (__builtin_expect(__all(pmax - m_reg <= A_THR / A_SCALE), 1)) { mn = m_reg; alpha = 1.f; }
    else { mn = fmaxf(m_reg, pmax); alpha = __builtin_amdgcn_exp2f((m_reg - mn) * C); m_reg = mn; }
    float mnC = -mn * C;
#pragma unroll
    for (int r = 0; r < 16; ++r) p0[r] = fmaf(p0[r], C, mnC);
#pragma unroll
    for (int r = 0; r < 16; ++r) p1[r] = fmaf(p1[r], C, mnC);
#pragma unroll
    for (int r = 0; r < 16; ++r) p0[r] = __builtin_amdgcn_exp2f(p0[r]);
}
#define PK4(P, BASE, OUT) do { unsigned a0 = cvtpk(P[BASE + 0], P[BASE + 1]), a1 = cvtpk(P[BASE + 2], P[BASE + 3]);   \
    unsigned b0 = cvtpk(P[BASE + 4], P[BASE + 5]), b1 = cvtpk(P[BASE + 6], P[BASE + 7]);                              \
    auto r0 = __builtin_amdgcn_permlane32_swap(a0, b0, false, false); auto r1 = __builtin_amdgcn_permlane32_swap(a1, b1, false, false); \
    u32x4 w = {r0[0], r1[0], r0[1], r1[1]}; OUT = *reinterpret_cast<bf16x8*>(&w); } while (0)
__device__ __forceinline__ void finishSM(f32x16& p0, f32x16& p1, float alpha, float& l_reg, bf16x8& pa0, bf16x8& pa1, bf16x8& pa2, bf16x8& pa3) {
#pragma unroll
    for (int r = 0; r < 16; ++r) p1[r] = __builtin_amdgcn_exp2f(p1[r]);
    float ps = 0;
#pragma unroll
    for (int r = 0; r < 16; ++r) ps += p0[r];
#pragma unroll
    for (int r = 0; r < 16; ++r) ps += p1[r];
    { auto rr = __builtin_amdgcn_permlane32_swap(__float_as_uint(ps), __float_as_uint(ps), false, false);
      ps = __uint_as_float(rr[0]) + __uint_as_float(rr[1]); }
    l_reg = l_reg * alpha + ps;
    PK4(p0, 0, pa0); PK4(p0, 8, pa1); PK4(p1, 0, pa2); PK4(p1, 8, pa3);
}
__device__ __forceinline__ void qkt(f32x16& p0, f32x16& p1, const char* Ks, const bf16x8* qr, int r32, int hi, int mapc) {
    p0 = f32x16{}; p1 = f32x16{};
#pragma unroll
    for (int d0 = 0; d0 < 4; ++d0) { int cb = (mapc + d0 * 16 + hi * 8) * 2;
        bf16x8 b0 = *reinterpret_cast<const bf16x8*>(Ks + KSWZ(r32, cb));
        bf16x8 b1 = *reinterpret_cast<const bf16x8*>(Ks + KSWZ(32 + r32, cb));
        p0 = __builtin_amdgcn_mfma_f32_32x32x16_bf16(b0, qr[d0], p0, 0, 0, 0);
        p1 = __builtin_amdgcn_mfma_f32_32x32x16_bf16(b1, qr[d0], p1, 0, 0, 0); }
}
__device__ __forceinline__ int v_st(int k, int c) { const int kk = (k & ~0xC) | ((k & 4) << 1) | ((k & 8) >> 1); return ((kk >> 3) * 4 + (c >> 5)) * 512 + ((kk & 7) * 32 + (c & 31)) * 2; }
__device__ __forceinline__ int v_rd_base(int lane) { return ((lane & 3) << 3) | (((lane >> 2) & 3) << 6) | (((lane >> 4) & 1) << 5) | (((lane >> 5) & 1) << 8); }
constexpr int v_rd_off(int d0, int ks, int half) { return d0 * 512 + ks * 4096 + half * 2048; }
template <int OFF> __device__ __forceinline__ s16x4 tr_read(int vb) {
    s16x4 r; asm volatile("ds_read_b64_tr_b16 %0, %1 offset:%2" : "=&v"(r) : "v"(vb), "i"(OFF) : "memory"); return r;
}
template <int D0> __device__ __forceinline__ void pv_one(f32x16& od, int vb, bf16x8 pa0, bf16x8 pa1, bf16x8 pa2, bf16x8 pa3) {
    const s16x4 l0 = tr_read<v_rd_off(D0, 0, 0)>(vb), h0 = tr_read<v_rd_off(D0, 0, 1)>(vb), l1 = tr_read<v_rd_off(D0, 1, 0)>(vb), h1 = tr_read<v_rd_off(D0, 1, 1)>(vb);
    const s16x4 l2 = tr_read<v_rd_off(D0, 2, 0)>(vb), h2 = tr_read<v_rd_off(D0, 2, 1)>(vb), l3 = tr_read<v_rd_off(D0, 3, 0)>(vb), h3 = tr_read<v_rd_off(D0, 3, 1)>(vb);
    asm volatile("s_waitcnt lgkmcnt(0)" ::: "memory"); SBAR();
#define PKV(L, H) (bf16x8){L[0], L[1], L[2], L[3], H[0], H[1], H[2], H[3]}
    od = __builtin_amdgcn_mfma_f32_32x32x16_bf16(pa0, PKV(l0, h0), od, 0, 0, 0);
    od = __builtin_amdgcn_mfma_f32_32x32x16_bf16(pa1, PKV(l1, h1), od, 0, 0, 0);
    od = __builtin_amdgcn_mfma_f32_32x32x16_bf16(pa2, PKV(l2, h2), od, 0, 0, 0);
    od = __builtin_amdgcn_mfma_f32_32x32x16_bf16(pa3, PKV(l3, h3), od, 0, 0, 0);
}
__device__ __forceinline__ void pv_d0(f32x16* o, int vb, bf16x8 pa0, bf16x8 pa1, bf16x8 pa2, bf16x8 pa3) {
    pv_one<0>(o[0], vb, pa0, pa1, pa2, pa3); pv_one<1>(o[1], vb, pa0, pa1, pa2, pa3); pv_one<2>(o[2], vb, pa0, pa1, pa2, pa3); pv_one<3>(o[3], vb, pa0, pa1, pa2, pa3);
}

__device__ __forceinline__ void attn_item(const bf16_t* __restrict__ Qb, const bf16_t* __restrict__ Kh, const bf16_t* __restrict__ Vh, bf16_t* __restrict__ mixrow,
                                          const float* __restrict__ gd, float lam, int tid_l) {
    char* lds = smem;
    const int tid = tid_l, wid = tid >> 6, lane = tid & 63, r32 = lane & 31, hi = lane >> 5;
    const int map = wid >> 2, wq = wid & 3, mapc = map * 64;
    char* V_lds = lds; char* K_lds = lds + 2 * A_SHM_V;
    float* wsw = (float*)(lds + 2 * A_SHM_V + 2 * A_SHM_K) + wid * 64; float* li_l = wsw; float* al_l = wsw + 32;
    float m_reg = -1e30f, l_reg = 0; f32x16 o[4] = {}; bf16x8 qr[4];
    const bf16_t* Qw = Qb + (long)(wq * 32 + r32) * 128 + mapc + hi * 8;
#pragma unroll
    for (int d0 = 0; d0 < 4; ++d0) qr[d0] = *reinterpret_cast<const bf16x8*>(Qw + d0 * 16);
    const int sr = tid >> 4, sc = (tid & 15) * 8, vst0 = v_st(sr, sc), vst1 = v_st(32 + sr, sc);
    const int vb0 = (int)(uintptr_t)V_lds + v_rd_base(lane);
    struct { bf16x8 vs0, vs1, ks0, ks1; } sr_[1];
#define SLOAD(i, k0) do { sr_[i].vs0 = *(const bf16x8*)(&Vh[(long)((k0) + sr) * 128 + sc]); sr_[i].vs1 = *(const bf16x8*)(&Vh[(long)((k0) + 32 + sr) * 128 + sc]); \
    sr_[i].ks0 = *(const bf16x8*)(&Kh[(long)((k0) + sr) * 128 + sc]); sr_[i].ks1 = *(const bf16x8*)(&Kh[(long)((k0) + 32 + sr) * 128 + sc]); } while (0)
#define SWRITE(b, i) do { *(bf16x8*)(V_lds + (b) * A_SHM_V + vst0) = sr_[i].vs0;          \
    *(bf16x8*)(V_lds + (b) * A_SHM_V + vst1) = sr_[i].vs1; int kc = sc * 2;               \
    *(bf16x8*)(K_lds + (b) * A_SHM_K + KSWZ(sr, kc)) = sr_[i].ks0;                       \
    *(bf16x8*)(K_lds + (b) * A_SHM_K + KSWZ(32 + sr, kc)) = sr_[i].ks1; } while (0)
#define SWAIT() asm volatile("s_waitcnt vmcnt(0)" ::: "memory")
#define RESC(a) do { if (__any((a) < 1.f)) { if (hi == 0) al_l[r32] = (a); asm volatile("s_waitcnt lgkmcnt(0)" ::: "memory"); \
    _Pragma("unroll") for (int d = 0; d < 4; ++d) _Pragma("unroll") for (int r = 0; r < 16; ++r) o[d][r] *= al_l[crow(r, hi)]; } } while (0)
    f32x16 pA0, pA1, pB0, pB1; float mnA, mnB, alA, alB; bf16x8 pa0, pa1, pa2, pa3; const int NT = RB / A_KVBLK;
    constexpr int SE = 0, SO = 0;
    SLOAD(SE, 0); asm volatile("s_waitcnt vmcnt(0)" ::: "memory"); SWRITE(0, SE); __syncthreads();
    qkt(pA0, pA1, K_lds, qr, r32, hi, mapc); partialSM(pA0, pA1, m_reg, mnA, alA);
    SLOAD(SO, A_KVBLK);
    SWAIT(); SWRITE(1, SO); __syncthreads();
    for (int j = 1; j + 1 < NT; j += 2) {
        SBAR(); qkt(pB0, pB1, K_lds + A_SHM_K, qr, r32, hi, mapc);
        finishSM(pA0, pA1, alA, l_reg, pa0, pa1, pa2, pa3); SBAR();
        SLOAD(SO, (j + 1) * A_KVBLK); SBAR();
        pv_d0(o, vb0, pa0, pa1, pa2, pa3); partialSM(pB0, pB1, m_reg, mnB, alB);
        __syncthreads(); SWAIT(); SWRITE(0, SE);
        RESC(alB); __syncthreads();
        SBAR(); qkt(pA0, pA1, K_lds, qr, r32, hi, mapc);
        finishSM(pB0, pB1, alB, l_reg, pa0, pa1, pa2, pa3); SBAR();
        SLOAD(SE, (j + 2) * A_KVBLK); SBAR();
        pv_d0(o, vb0 + A_SHM_V, pa0, pa1, pa2, pa3); partialSM(pA0, pA1, m_reg, mnA, alA);
        __syncthreads(); SWAIT(); SWRITE(1, SO);
        RESC(alA); __syncthreads();
    }
    SBAR(); qkt(pB0, pB1, K_lds + A_SHM_K, qr, r32, hi, mapc);
    finishSM(pA0, pA1, alA, l_reg, pa0, pa1, pa2, pa3); SBAR();
    pv_d0(o, vb0, pa0, pa1, pa2, pa3); partialSM(pB0, pB1, m_reg, mnB, alB);
    __syncthreads(); RESC(alB);
    finishSM(pB0, pB1, alB, l_reg, pa0, pa1, pa2, pa3); SBAR();
    pv_d0(o, vb0 + A_SHM_V, pa0, pa1, pa2, pa3);
    if (hi == 0) li_l[r32] = l_reg;
    asm volatile("s_waitcnt lgkmcnt(0)" ::: "memory");
    float rl[16];
#pragma unroll
    for (int r = 0; r < 16; ++r) rl[r] = __builtin_amdgcn_rcpf(li_l[crow(r, hi)]);
    __syncthreads();
    {
        float* xo = (float*)lds + map * 16384 + (wq * 32) * 128 + r32;
#pragma unroll
        for (int r = 0; r < 16; ++r)
#pragma unroll
            for (int d0 = 0; d0 < 4; ++d0) xo[crow(r, hi) * 128 + d0 * 32] = o[d0][r] * rl[r];
    }
    __syncthreads();
    {
        const float g0 = gd[lane * 2], g1 = gd[lane * 2 + 1];
#pragma unroll 4
        for (int rr = 0; rr < 16; ++rr) {
            const int row = wid * 16 + rr;
            const float2 a0 = *(const float2*)((const float*)lds + row * 128 + lane * 2), a1 = *(const float2*)((const float*)lds + 16384 + row * 128 + lane * 2);
            const float xv = a0.x - lam * a1.x, yv = a0.y - lam * a1.y;
            const float ss = wave_sum(xv * xv + yv * yv);
            const float rs = rsqrtf(ss * (1.0f / 128) + EPS) * 0.8f;
            *(unsigned*)(mixrow + (long)row * 1024 + lane * 2) = cvtpk(xv * rs * g0, yv * rs * g1);
        }
    }
    __syncthreads();
#undef SLOAD
#undef SWRITE
#undef SWAIT
#undef RESC
}

__device__ __forceinline__ void ph_attn(const MK& p, int bid, int nb, int tid_l) {
    const int lane = tid_l & 63;
    float s1 = wave_sum(p.lq1[lane] * p.lk1[lane]), s2 = wave_sum(p.lq2[lane] * p.lk2[lane]);
    const float lam = expf(s1) - expf(s2) + 0.2f;
    const int nrounds = (1024 + nb - 1) / nb;
    for (int rr = 0; rr < nrounds; ++rr) {
        int item;
        if (nb == 256) { int x = bid & 7, j = bid >> 3, hh = rr * 8 + x; item = (hh >> 1) * 64 + (hh & 1) * 32 + j; }
        else { item = rr * nb + bid; if (item >= 1024) break; }
        const int bh = item >> 6, qb = item & 63, b = bh >> 2, h = bh & 3;
        attn_item(p.Q() + ((size_t)bh * SEQ + qb * 128) * 128, p.K() + (size_t)bh * RB * 128, p.V() + (size_t)bh * RB * 128,
                  p.MIX() + ((size_t)(b * SEQ + qb * 128)) * 1024 + h * 128, p.dattn_g, lam, tid_l);
    }
}


__device__ __forceinline__ bf16x8 ldfrag(const bf16_t* p) { return *reinterpret_cast<const bf16x8*>(p); }

__device__ __forceinline__ void ph_kv(const MK& p, int bid, int nb, int tid_l) {
    const int wid = tid_l >> 6, lane = tid_l & 63, r32 = lane & 31, hi = lane >> 5;
    const int nitems = 16 * 2 * 66;
    for (int it = bid * 8 + wid; it < nitems; it += nb * 8) {
        const int c = it % 66, chain = it / 66, dir = chain & 1, bh = chain >> 1;
        const bf16_t* vt = p.VT() + (size_t)bh * 128 * RB + c * 128 + hi * 8;
        const bf16_t* kt = (dir ? p.KTb() : p.KTf()) + (size_t)bh * 64 * RB + c * 128 + hi * 8;
        f32x16 acc[4][2];
#pragma unroll
        for (int mt = 0; mt < 4; ++mt) { acc[mt][0] = f32x16{}; acc[mt][1] = f32x16{}; }
#pragma unroll 2
        for (int ks = 0; ks < 8; ++ks) {
            bf16x8 a[4], b[2];
#pragma unroll
            for (int mt = 0; mt < 4; ++mt) a[mt] = ldfrag(vt + (size_t)(mt * 32 + r32) * RB + ks * 16);
#pragma unroll
            for (int nt = 0; nt < 2; ++nt) b[nt] = ldfrag(kt + (size_t)(nt * 32 + r32) * RB + ks * 16);
#pragma unroll
            for (int mt = 0; mt < 4; ++mt)
#pragma unroll
                for (int nt = 0; nt < 2; ++nt) acc[mt][nt] = __builtin_amdgcn_mfma_f32_32x32x16_bf16(a[mt], b[nt], acc[mt][nt], 0, 0, 0);
        }
        bf16_t* dst = p.KV() + (size_t)it * 8192;
#pragma unroll
        for (int mt = 0; mt < 4; ++mt)
#pragma unroll
            for (int nt = 0; nt < 2; ++nt)
#pragma unroll
                for (int r = 0; r < 16; ++r) dst[(mt * 32 + crow(r, hi)) * 64 + nt * 32 + r32] = f2bf(acc[mt][nt][r]);
    }
}

__device__ __forceinline__ void ph_scan(const MK& p, int bid, int nb, int tid_l) {
    for (int e = bid * NTHR + tid_l; e < 32 * 8192; e += nb * NTHR) {
        const int chain = e >> 13, el = e & 8191, dir = chain & 1, bh = chain >> 1, h = bh & 3;
        const float d = dir ? p.dec_b[h] : p.dec_f[h];
        const float g128 = exp2f(128.0f * log2f(1.0f / (1.0f + expf(-d))));
        const bf16_t* kv = p.KV() + (size_t)chain * 66 * 8192 + el;
        bf16_t* st = p.ST() + (size_t)chain * 66 * 8192 + el;
        float S = 0.f;
        for (int n = 0; n < 66; ++n) {
            const int c = dir == 0 ? n : (n == 0 ? 1 : (n == 1 ? 0 : 67 - n));
            st[(size_t)c * 8192] = f2bf(S);
            S = fmaf(g128, S, bf2f(kv[(size_t)c * 8192]));
        }
    }
}

__device__ __forceinline__ void ph_ret(const MK& p, int bid, int nb, int tid_l) {
    const int tid = tid_l, wid = tid >> 6, lane = tid & 63, r32 = lane & 31, hi = lane >> 5, wq = wid & 3, half = wid >> 2;
    float* img = (float*)smem;
    for (int it = bid; it < 4 * 64 * 2; it += nb) {
        const int hp = it & 1, lc = (it >> 1) & 63, b = it >> 7, h = hp * 2 + half, bh = b * 4 + h;
        const int ib = CTX + lc * 128, c = 2 + lc;
        const float lf = log2f(1.0f / (1.0f + expf(-p.dec_f[h]))), lb = log2f(1.0f / (1.0f + expf(-p.dec_b[h])));
        const bf16_t* rq = p.RQ() + ((size_t)bh * RB + ib + wq * 32 + r32) * 64 + hi * 8;
        bf16x8 q[4];
#pragma unroll
        for (int ks = 0; ks < 4; ++ks) q[ks] = ldfrag(rq + ks * 16);
        f32x16 o[4];
        {
            const bf16_t* stf = p.ST() + ((size_t)(bh * 2 + 0) * 66 + c) * 8192 + hi * 8;
            const bf16_t* stb = p.ST() + ((size_t)(bh * 2 + 1) * 66 + c) * 8192 + hi * 8;
            {
                float rf[16];
#pragma unroll
                for (int r = 0; r < 16; ++r) rf[r] = __builtin_amdgcn_exp2f((float)(wq * 32 + crow(r, hi) + 1) * lf);
#pragma unroll
                for (int d0 = 0; d0 < 4; ++d0) {
                    f32x16 tf = f32x16{};
#pragma unroll
                    for (int ks = 0; ks < 4; ++ks) tf = __builtin_amdgcn_mfma_f32_32x32x16_bf16(q[ks], ldfrag(stf + (size_t)(d0 * 32 + r32) * 64 + ks * 16), tf, 0, 0, 0);
#pragma unroll
                    for (int r = 0; r < 16; ++r) o[d0][r] = tf[r] * rf[r];
                    asm volatile("" ::: "memory");
                }
            }
            {
                float rf[16];
#pragma unroll
                for (int r = 0; r < 16; ++r) rf[r] = __builtin_amdgcn_exp2f((float)(128 - (wq * 32 + crow(r, hi))) * lb);
#pragma unroll
                for (int d0 = 0; d0 < 4; ++d0) {
                    f32x16 tb = f32x16{};
#pragma unroll
                    for (int ks = 0; ks < 4; ++ks) tb = __builtin_amdgcn_mfma_f32_32x32x16_bf16(q[ks], ldfrag(stb + (size_t)(d0 * 32 + r32) * 64 + ks * 16), tb, 0, 0, 0);
#pragma unroll
                    for (int r = 0; r < 16; ++r) o[d0][r] += tb[r] * rf[r];
                    asm volatile("" ::: "memory");
                }
            }
        }
        {
            const int qi = wq * 32 + r32;
            const bf16_t* vt = p.VT() + (size_t)bh * 128 * RB + ib + hi * 8;
#pragma unroll 1
            for (int jb = 0; jb < 4; ++jb) {
                asm volatile("" ::: "memory");
                const bf16_t* rk = p.RK() + ((size_t)bh * RB + ib + jb * 32 + r32) * 64 + hi * 8;
                f32x16 pp = f32x16{};
#pragma unroll
                for (int ks = 0; ks < 4; ++ks) pp = __builtin_amdgcn_mfma_f32_32x32x16_bf16(ldfrag(rk + ks * 16), q[ks], pp, 0, 0, 0);
#pragma unroll
                for (int r = 0; r < 16; ++r) {
                    const int dd = qi - (jb * 32 + crow(r, hi));
                    const float ex = __builtin_amdgcn_exp2f(dd > 0 ? (float)dd * lf : (float)(-dd) * lb); const float w = dd == 0 ? 2.0f : ex;
                    pp[r] *= w;
                }
                bf16x8 pa0, pa1;
                PK4(pp, 0, pa0); PK4(pp, 8, pa1);
#pragma unroll
                for (int d0 = 0; d0 < 4; ++d0) {
                    o[d0] = __builtin_amdgcn_mfma_f32_32x32x16_bf16(pa0, ldfrag(vt + (size_t)(d0 * 32 + r32) * RB + jb * 32), o[d0], 0, 0, 0);
                    o[d0] = __builtin_amdgcn_mfma_f32_32x32x16_bf16(pa1, ldfrag(vt + (size_t)(d0 * 32 + r32) * RB + jb * 32 + 16), o[d0], 0, 0, 0);
                }
            }
        }
        __syncthreads();
        {
            float* xo = img + half * 16384 + (wq * 32) * 128 + r32;
#pragma unroll
            for (int r = 0; r < 16; ++r)
#pragma unroll
                for (int d0 = 0; d0 < 4; ++d0) xo[crow(r, hi) * 128 + d0 * 32] = o[d0][r];
        }
        __syncthreads();
        {
            const float g0 = p.ret_g[lane * 2], g1 = p.ret_g[lane * 2 + 1];
#pragma unroll 4
            for (int rr = 0; rr < 32; ++rr) {
                const int row = wid * 32 + rr, itl = row >> 7, rw = row & 127, hh = hp * 2 + itl;
                const float2 a = *(const float2*)(img + row * 128 + lane * 2);
                const float ss = wave_sum(a.x * a.x + a.y * a.y);
                const float rs = rsqrtf(ss * (1.0f / 128) + EPS);
                const size_t tt = (size_t)b * SEQ + lc * 128 + rw;
                const unsigned gg = *(const unsigned*)(p.RG() + tt * 512 + hh * 128 + lane * 2);
                const float ga = bf2f((bf16_t)(gg & 0xffff)), gb = bf2f((bf16_t)(gg >> 16));
                *(unsigned*)(p.MIX() + tt * 1024 + 512 + hh * 128 + lane * 2) = cvtpk(siluf(ga) * a.x * rs * g0, siluf(gb) * a.y * rs * g1);
            }
        }
    }
}


__device__ __forceinline__ void ph_gemm_out(const MK& p, int bid, int nb, int tid_l) {
    const int tid = tid_l, wid = tid >> 6, lane = tid & 63, wr = wid >> 2, wc = wid & 3, fr = lane & 15, fq = lane >> 4;
    unsigned Ao[4], Bo[4];
    stage_offs(D * 2, Ao, tid_l); stage_offs(D * 2, Bo, tid_l);
    bool pre = false;
    for (int tile = bid; tile < (T / 256) * 4; tile += nb) {
        const int pm = tile >> 2, pn = tile & 3, brow = pm * 256, bcol = pn * 256;
        f32x4 acc[8][4];
        gemm_core((const char*)(p.MIX() + (size_t)brow * D), Ao, (const char*)(p.w_outT() + (size_t)bcol * D), Bo, D / 64, acc, tid_l, pre);
        { const int nx = tile + nb; pre = nx < (T / 256) * 4;
          if (pre) gemm_prefetch((const char*)(p.MIX() + (size_t)((nx >> 2) * 256) * D), Ao, (const char*)(p.w_outT() + (size_t)((nx & 3) * 256) * D), Bo, tid_l); }
        const float* g1 = p.mod() + (size_t)(brow / SEQ) * 6 * D + 2 * D + bcol + wc * 64 + fq * 4;
        float4 gv[4], xv[4];
        const size_t o0 = (size_t)(brow + wr * 128 + fr) * D + bcol + wc * 64 + fq * 4;
#pragma unroll
        for (int n = 0; n < 4; ++n) { gv[n] = *(const float4*)(g1 + n * 16); xv[n] = *(const float4*)(p.x + o0 + n * 16); }
#pragma unroll
        for (int m = 0; m < 8; ++m) {
            int ioff = m * 16; asm volatile("" : "+v"(ioff) :: "memory");
            const size_t o = o0 + (size_t)ioff * D;
            float4 xn[4];
            if (m < 7) {
#pragma unroll
                for (int n = 0; n < 4; ++n) xn[n] = *(const float4*)(p.x + o + (size_t)16 * D + n * 16);
            }
#pragma unroll
            for (int n = 0; n < 4; ++n)
                *(float4*)(p.out + o + n * 16) = make_float4(xv[n].x + gv[n].x * acc[m][n][0], xv[n].y + gv[n].y * acc[m][n][1], xv[n].z + gv[n].z * acc[m][n][2], xv[n].w + gv[n].w * acc[m][n][3]);
            if (m < 7) {
#pragma unroll
                for (int n = 0; n < 4; ++n) xv[n] = xn[n];
            }
        }
    }
}

__device__ __forceinline__ bool route_token(float logit, float bias, int lane, float& wt) {
    const float score = 1.0f / (1.0f + expf(-logit));
    const float sel = score + bias;
    float m1 = sel, m2 = -INFINITY;
#pragma unroll
    for (int o = 1; o < 8; o <<= 1) {
        float p1 = __shfl_xor(m1, o), p2 = __shfl_xor(m2, o);
        float n1 = fmaxf(m1, p1), n2 = fmaxf(fminf(m1, p1), fmaxf(m2, p2));
        m1 = n1; m2 = n2;
    }
    const float gs = m1 + m2;
    const int grp = lane >> 3;
    int grank = 0;
#pragma unroll
    for (int g2 = 0; g2 < 8; ++g2) { float og = __uint_as_float(__builtin_amdgcn_readlane(__float_as_uint(gs), g2 * 8)); grank += (og > gs || (og == gs && g2 < grp)) ? 1 : 0; }
    const float val = grank < 4 ? sel : -INFINITY;
    int rank = 0;
#pragma unroll
    for (int e = 0; e < 64; ++e) { float ov = __uint_as_float(__builtin_amdgcn_readlane(__float_as_uint(val), e)); rank += (ov > val || (ov == val && e < lane)) ? 1 : 0; }
    const bool chosen = rank < 8;
    const float wsum = wave_sum(chosen ? score : 0.f);
    wt = score / wsum * 2.5f;
    return chosen;
}
template <bool DUMMY, int MODE = 0> __device__ __forceinline__ void ph_route(const MK& p, int bid, int nb, int tid_l) {
    int* cntp = p.cnt() + (DUMMY ? 128 : 0); int* tl = DUMMY ? (int*)(p.ws + 480 * MiB) : p.tok_list(); float* wl_ = DUMMY ? (float*)(p.ws + 488 * MiB) : p.wt_list(); int* tm = DUMMY ? (int*)(p.ws + 496 * MiB) : p.tokmap();
    const int tid = tid_l, wid = tid >> 6, lane = tid & 63, fr = lane & 15, fq = lane >> 4;
    float* lg = (float*)smem;
    int* wcnt = (int*)(smem + 34816);
    int* basel = wcnt + 128;
    bf16_t* H2lo = (bf16_t*)(p.ws + 325 * MiB);
    for (int item = bid; item < T / 128; item += nb) {
        const int t0 = item * 128 + wid * 16, b = (item * 128) / SEQ;
        const float* msh = p.mod() + (size_t)b * 6 * D + 3 * D; const float* msc = p.mod() + (size_t)b * 6 * D + 4 * D;
#pragma unroll 1
        for (int r0 = 0; r0 < 16; r0 += 4) {
            float4 xv[4][4];
#pragma unroll
            for (int rr = 0; rr < 4; ++rr)
#pragma unroll
                for (int q = 0; q < 4; ++q) xv[rr][q] = *(const float4*)(p.out + (size_t)(t0 + r0 + rr) * D + q * 256 + lane * 4);
#pragma unroll
            for (int rr = 0; rr < 4; ++rr) {
                float ss = 0.f;
#pragma unroll
                for (int q = 0; q < 4; ++q) ss += xv[rr][q].x * xv[rr][q].x + xv[rr][q].y * xv[rr][q].y + xv[rr][q].z * xv[rr][q].z + xv[rr][q].w * xv[rr][q].w;
                ss = wave_sum(ss);
                const float rstd = rsqrtf(ss * (1.0f / D) + EPS);
#pragma unroll
                for (int q = 0; q < 4; ++q) {
                    const int c0 = q * 256 + lane * 4;
                    const float4 gg = *(const float4*)(p.norm2_g + c0), sh = *(const float4*)(msh + c0), sc = *(const float4*)(msc + c0);
                    const float h0 = xv[rr][q].x * rstd * gg.x * (1 + sc.x) + sh.x, h1 = xv[rr][q].y * rstd * gg.y * (1 + sc.y) + sh.y;
                    const float h2v = xv[rr][q].z * rstd * gg.z * (1 + sc.z) + sh.z, h3 = xv[rr][q].w * rstd * gg.w * (1 + sc.w) + sh.w;
                    u32x2 wh, wl2; wh.x = cvtpk(h0, h1); wh.y = cvtpk(h2v, h3);
                    wl2.x = cvtpk(h0 - __uint_as_float(wh.x << 16), h1 - __uint_as_float(wh.x & 0xffff0000u));
                    wl2.y = cvtpk(h2v - __uint_as_float(wh.y << 16), h3 - __uint_as_float(wh.y & 0xffff0000u));
                    *(u32x2*)(p.H2() + (size_t)(t0 + r0 + rr) * D + c0) = wh;
                    *(u32x2*)(H2lo + (size_t)(t0 + r0 + rr) * D + c0) = wl2;
                }
            }
        }
        asm volatile("s_waitcnt vmcnt(0)" ::: "memory");
        __syncthreads();
        if (MODE == 3) continue;
        f32x4 acc[4];
#pragma unroll
        for (int nt = 0; nt < 4; ++nt) acc[nt] = (f32x4){0.f, 0.f, 0.f, 0.f};
        {
            const bf16_t* ah_p = p.H2() + (size_t)(t0 + fr) * D + fq * 8; const bf16_t* al_p = H2lo + (size_t)(t0 + fr) * D + fq * 8;
            const bf16_t* rT = p.routerT() + (size_t)fr * D + fq * 8;
#pragma unroll 4
            for (int ks = 0; ks < 32; ++ks) {
                const int k0 = ks * 32;
                const bf16x8 ah = ldfrag(ah_p + k0), al = ldfrag(al_p + k0);
#pragma unroll
                for (int nt = 0; nt < 4; ++nt) {
                    const bf16x8 bh = ldfrag(rT + (size_t)(nt * 16) * D + k0), bl = ldfrag(rT + (size_t)(64 + nt * 16) * D + k0);
                    acc[nt] = __builtin_amdgcn_mfma_f32_16x16x32_bf16(ah, bh, acc[nt], 0, 0, 0);
                    acc[nt] = __builtin_amdgcn_mfma_f32_16x16x32_bf16(ah, bl, acc[nt], 0, 0, 0);
                    acc[nt] = __builtin_amdgcn_mfma_f32_16x16x32_bf16(al, bh, acc[nt], 0, 0, 0);
                }
            }
        }
#pragma unroll
        for (int nt = 0; nt < 4; ++nt)
#pragma unroll
            for (int j = 0; j < 4; ++j) lg[(wid * 16 + fq * 4 + j) * 65 + nt * 16 + fr] = acc[nt][j];
        __syncthreads();
        if (MODE == 2) continue;
        float sc_[64]; unsigned long long ch = 0ull; float wscale = 0.f;
        const int tt = (wid & 1) * 64 + lane, t = item * 128 + tt;
        if (wid < 2) {
            float v[64];
#pragma unroll
            for (int e = 0; e < 64; ++e) { const float x = lg[tt * 65 + e]; sc_[e] = 1.0f / (1.0f + expf(-x)); v[e] = sc_[e] + p.router_b[e]; }
            float gs[8];
#pragma unroll
            for (int g = 0; g < 8; ++g) { float m1 = v[8 * g], m2 = -INFINITY;
#pragma unroll
                for (int i = 1; i < 8; ++i) { const float x = v[8 * g + i]; m2 = fmaxf(m2, fminf(m1, x)); m1 = fmaxf(m1, x); }
                gs[g] = m1 + m2; }
#pragma unroll
            for (int g = 0; g < 8; ++g) { int rank = 0;
#pragma unroll
                for (int g2 = 0; g2 < 8; ++g2) if (g2 != g) rank += (gs[g2] > gs[g] || (gs[g2] == gs[g] && g2 < g)) ? 1 : 0;
                if (rank >= 4) {
#pragma unroll
                    for (int i = 0; i < 8; ++i) v[8 * g + i] = -INFINITY; } }
#pragma unroll
            for (int it = 0; it < 8; ++it) {
                float m = v[0];
#pragma unroll
                for (int e = 1; e < 64; ++e) m = fmaxf(m, v[e]);
                bool found = false;
#pragma unroll
                for (int e = 0; e < 64; ++e) { const bool hit = !found && v[e] == m; if (hit) { ch |= (1ull << e); v[e] = -INFINITY; } found = found || hit; }
            }
            float wsum = 0.f;
#pragma unroll
            for (int e = 0; e < 64; ++e) wsum += ((ch >> e) & 1ull) ? sc_[e] : 0.f;
            wscale = 2.5f / wsum;
#pragma unroll
            for (int e = 0; e < 64; ++e) { const unsigned long long mk = __ballot((ch >> e) & 1ull); if (lane == 0) wcnt[wid * 64 + e] = __popcll(mk); }
        }
        __syncthreads();
        if (wid == 0) basel[lane] = atomicAdd(&cntp[lane], wcnt[lane] + wcnt[64 + lane]);
        __syncthreads();
        if (wid < 2) {
            int kidx = 0;
#pragma unroll
            for (int e = 0; e < 64; ++e) {
                const bool c = (ch >> e) & 1ull;
                const unsigned long long mk = __ballot(c);
                if (c) {
                    const int slot = basel[e] + (wid == 1 ? wcnt[e] : 0) + __popcll(mk & ((1ull << lane) - 1ull));
                    tl[(size_t)e * ECAP + slot] = t; wl_[(size_t)e * ECAP + slot] = sc_[e] * wscale;
                    tm[(size_t)t * 8 + kidx] = e * ECAP + slot; ++kidx;
                }
            }
        }
    }
}

constexpr int MOE_AUX = 131072;
__device__ __forceinline__ void moe_tables(const MK& p, int colt, int* tpre, int* rbase, int tid_l) {
    __syncthreads();
    if (tid_l == 0) { int tp = 0, rb = 0;
        for (int e = 0; e < 65; ++e) { const int c = e < 64 ? p.cnt()[e] : T; tpre[e] = tp; rbase[e] = rb; tp += ((c + 255) >> 8) * colt; rb += c; }
        tpre[65] = tp; rbase[65] = rb; }
    __syncthreads();
}
__device__ __forceinline__ void ph_moe_up(const MK& p, int bid, int nb, int tid_l) {
    const int tid = tid_l, wid = tid >> 6, lane = tid & 63, wr = wid >> 2, wc = wid & 3, fr = lane & 15, fq = lane >> 4;
    int* tpre = (int*)(smem + MOE_AUX); int* rbase = tpre + 80;
    moe_tables(p, 2, tpre, rbase, tid_l);
    const int ntiles = tpre[65];
    unsigned Ao[4], Bo[4];
    stage_offs(D * 2, Bo, tid_l);
    auto setupA = [&](int tile, int& e, int& rt, int& ct, int& cnt_e) {
        while (tile >= tpre[e + 1]) ++e;
        const int j = tile - tpre[e]; rt = j >> 1; ct = j & 1; cnt_e = rbase[e + 1] - rbase[e];
#pragma unroll
        for (int i = 0; i < 4; ++i) { int R, C; stage_rc(wid * 1024 + i * 8192 + lane * 16, R, C);
            int slot = rt * 256 + R; if (slot >= cnt_e) slot = 0;
            const int tok = e < 64 ? p.tok_list()[(size_t)e * ECAP + slot] : slot;
            Ao[i] = (unsigned)tok * (D * 2u) + (unsigned)C * 2u; }
    };
    bool pre = false;
    int e = 0, rt = 0, ct = 0, cnt_e = 0;
    if (bid < ntiles) setupA(bid, e, rt, ct, cnt_e);
    for (int tile = bid; tile < ntiles; tile += nb) {
        f32x4 acc[8][4];
        gemm_core((const char*)p.H2(), Ao, (const char*)(p.W13t() + ((size_t)e * 512 + ct * 256) * D), Bo, D / 64, acc, tid_l, pre);
        const int e_c = e, rt_c = rt, ct_c = ct, cnt_c = cnt_e;
        { const int nx = tile + nb; pre = nx < ntiles;
          if (pre) { setupA(nx, e, rt, ct, cnt_e); gemm_prefetch((const char*)p.H2(), Ao, (const char*)(p.W13t() + ((size_t)e * 512 + ct * 256) * D), Bo, tid_l); } }
#pragma unroll
        for (int m = 0; m < 8; ++m) {
            int ioff = m * 16; asm volatile("" : "+v"(ioff) :: "memory");
            const int slot = rt_c * 256 + wr * 128 + fr + ioff;
            if (slot < cnt_c) {
                bf16_t* dp = p.ACT() + (size_t)(rbase[e_c] + slot) * DE + ct_c * 128 + wc * 32 + fq * 4;
#pragma unroll
                for (int n = 0; n < 2; ++n) {
                    u32x2 w; w.x = cvtpk(siluf(acc[m][n][0]) * acc[m][n + 2][0], siluf(acc[m][n][1]) * acc[m][n + 2][1]);
                    w.y = cvtpk(siluf(acc[m][n][2]) * acc[m][n + 2][2], siluf(acc[m][n][3]) * acc[m][n + 2][3]);
                    *(u32x2*)(dp + n * 16) = w;
                }
            }
        }
    }
}
constexpr float Y_SCALE = 64.0f;
template <bool DUMMY> __device__ __forceinline__ void ph_moe_down(const MK& p, int bid, int nb, int tid_l) {
    const int tid = tid_l, wid = tid >> 6, lane = tid & 63, wr = wid >> 2, wc = wid & 3, fr = lane & 15, fq = lane >> 4;
    int* tpre = (int*)(smem + MOE_AUX); int* rbase = tpre + 80;
    moe_tables(p, 4, tpre, rbase, tid_l);
    const int ntiles = DUMMY ? tpre[64] : tpre[65];
    unsigned Ao[4], Bo[4];
    stage_offs(DE * 2, Ao, tid_l); stage_offs(DE * 2, Bo, tid_l);
    bool pre = false;
    int e = 0;
    for (int tile = bid; tile < ntiles; tile += nb) {
        while (tile >= tpre[e + 1]) ++e;
        const int j = tile - tpre[e], rt = j >> 2, ct = j & 3, cnt_e = rbase[e + 1] - rbase[e];
        f32x4 acc[8][4];
        gemm_core((const char*)(p.ACT() + (size_t)(rbase[e] + rt * 256) * DE), Ao, (const char*)(p.W2t() + ((size_t)e * D + ct * 256) * DE), Bo, DE / 64, acc, tid_l, pre);
        { const int nx = tile + nb; pre = nx < ntiles;
          if (pre) { int e2 = e; while (nx >= tpre[e2 + 1]) ++e2; const int j2 = nx - tpre[e2], rt2 = j2 >> 2, ct2 = j2 & 3;
              gemm_prefetch((const char*)(p.ACT() + (size_t)(rbase[e2] + rt2 * 256) * DE), Ao, (const char*)(p.W2t() + ((size_t)e2 * D + ct2 * 256) * DE), Bo, tid_l); } }
        const int col0 = ct * 256 + wc * 64 + fq * 4;
        if (e < 64) {
            const float* wl = p.wt_list() + (size_t)e * ECAP;
            unsigned char* yb = p.Y() + (size_t)rbase[e] * D + col0;
            float wv[8];
#pragma unroll
            for (int m = 0; m < 8; ++m) { const int sl = rt * 256 + wr * 128 + fr + m * 16; wv[m] = wl[sl < cnt_e ? sl : 0] * Y_SCALE; }
#pragma unroll
            for (int m = 0; m < 8; ++m) {
                int ioff = m * 16; asm volatile("" : "+v"(ioff) :: "memory");
                const int slot = rt * 256 + wr * 128 + fr + ioff;
                if (slot < cnt_e) {
                    const float w = wv[m];
                    unsigned char* dp = yb + (size_t)slot * D;
#pragma unroll
                    for (int n = 0; n < 4; ++n) {
                        float v0 = fminf(fmaxf(acc[m][n][0] * w, -448.f), 448.f), v1 = fminf(fmaxf(acc[m][n][1] * w, -448.f), 448.f);
                        float v2 = fminf(fmaxf(acc[m][n][2] * w, -448.f), 448.f), v3 = fminf(fmaxf(acc[m][n][3] * w, -448.f), 448.f);
                        int pk = 0; pk = __builtin_amdgcn_cvt_pk_fp8_f32(v0, v1, pk, false); pk = __builtin_amdgcn_cvt_pk_fp8_f32(v2, v3, pk, true);
                        *(int*)(dp + n * 16) = pk;
                    }
                }
            }
        } else {
            const float* g2 = p.mod() + (size_t)((rt * 256) / SEQ) * 6 * D + 5 * D + col0;
            float4 gv[4];
#pragma unroll
            for (int n = 0; n < 4; ++n) gv[n] = *(const float4*)(g2 + n * 16);
            float* xb = p.out + (size_t)(rt * 256) * D + col0;
#pragma unroll
            for (int m = 0; m < 8; ++m) {
                int ioff = m * 16; asm volatile("" : "+v"(ioff) :: "memory");
                float* xp = xb + (size_t)(wr * 128 + fr + ioff) * D;
#pragma unroll
                for (int n = 0; n < 4; ++n) {
                    float4 xv = *(float4*)(xp + n * 16);
                    xv.x += gv[n].x * acc[m][n][0]; xv.y += gv[n].y * acc[m][n][1]; xv.z += gv[n].z * acc[m][n][2]; xv.w += gv[n].w * acc[m][n][3];
                    *(float4*)(xp + n * 16) = xv;
                }
            }
        }
    }
}

template <bool DUMMY> __device__ __forceinline__ void ph_final(const MK& p, int bid, int nb, int tid_l) {
    const int wid = tid_l >> 6, lane = tid_l & 63;
    int* tpre = (int*)(smem + MOE_AUX); int* rbase = tpre + 80;
    moe_tables(p, 1, tpre, rbase, tid_l);
    for (int t = bid * 8 + wid; t < T; t += nb * 8) {
        const int b = t / SEQ;
        float f[16];
#pragma unroll
        for (int i = 0; i < 16; ++i) f[i] = 0.f;
#pragma unroll
        for (int k = 0; k < 8; ++k) {
            const int id = p.tokmap()[(size_t)t * 8 + k], e = id >> 15, slot = id & (ECAP - 1);
            const unsigned char* yr = p.Y() + (size_t)(rbase[e] + slot) * D + lane * 4;
#pragma unroll
            for (int q = 0; q < 4; ++q) {
                const int w = *(const int*)(yr + q * 256);
                const auto lo = __builtin_amdgcn_cvt_pk_f32_fp8(w, false); const auto hi = __builtin_amdgcn_cvt_pk_f32_fp8(w, true);
                f[q * 4 + 0] += lo[0]; f[q * 4 + 1] += lo[1]; f[q * 4 + 2] += hi[0]; f[q * 4 + 3] += hi[1];
            }
        }
        const float* g2 = p.mod() + (size_t)b * 6 * D + 5 * D + lane * 4;
        float* xo = p.out + (size_t)t * D + lane * 4;
        float v[16]; float ss = 0.f;
#pragma unroll
        for (int q = 0; q < 4; ++q) {
            const float4 xv = *(const float4*)(xo + q * 256), g = *(const float4*)(g2 + q * 256);
            v[q * 4 + 0] = xv.x + g.x * f[q * 4 + 0] * (1.0f / Y_SCALE); v[q * 4 + 1] = xv.y + g.y * f[q * 4 + 1] * (1.0f / Y_SCALE);
            v[q * 4 + 2] = xv.z + g.z * f[q * 4 + 2] * (1.0f / Y_SCALE); v[q * 4 + 3] = xv.w + g.w * f[q * 4 + 3] * (1.0f / Y_SCALE);
            ss += v[q * 4] * v[q * 4] + v[q * 4 + 1] * v[q * 4 + 1] + v[q * 4 + 2] * v[q * 4 + 2] + v[q * 4 + 3] * v[q * 4 + 3];
        }
        ss = wave_sum(ss);
        const float rstd = rsqrtf(ss * (1.0f / D) + EPS);
#pragma unroll
        for (int q = 0; q < 4; ++q) {
            const float4 gf = *(const float4*)(p.final_g + q * 256 + lane * 4);
            *(float4*)((DUMMY ? (float*)(p.ws + 42 * MiB) + (size_t)t * D + lane * 4 : xo) + q * 256) = make_float4(v[q * 4] * rstd * gf.x, v[q * 4 + 1] * rstd * gf.y, v[q * 4 + 2] * rstd * gf.z, v[q * 4 + 3] * rstd * gf.w);
        }
    }
}

__global__ __launch_bounds__(512, 2) void k_mega(MK p) {
    cg::grid_group grid = cg::this_grid();
    const int bid = blockIdx.x, nb = gridDim.x;
#define PH_TID() int t_ = threadIdx.x; asm volatile("" : "+v"(t_))
    { PH_TID(); if (bid == 0 && t_ < 256) p.cnt()[t_] = 0; ph_mod(p, bid, nb, t_); ph_convert(p, bid, nb, t_); }
#if DUP == 10
    { PH_TID(); ph_convert(p, bid, nb, t_); }
#endif
    grid.sync();
    { PH_TID(); ph_ln1(p, bid, nb, t_); }
#if DUP == 1
    { PH_TID(); ph_ln1(p, bid, nb, t_); }
#endif
    grid.sync();
    { PH_TID(); ph_gemm_in(p, bid, nb, t_); }
#if DUP == 2
    { PH_TID(); ph_gemm_in(p, bid, nb, t_); }
#endif
    grid.sync();
    { PH_TID(); ph_attn(p, bid, nb, t_); }
#if DUP == 3
    { PH_TID(); ph_attn(p, bid, nb, t_); }
#endif
    { PH_TID(); ph_kv(p, bid, nb, t_); }
#if DUP == 11
    { PH_TID(); ph_kv(p, bid, nb, t_); }
#endif
    grid.sync();
    { PH_TID(); ph_scan(p, bid, nb, t_); }
    grid.sync();
    { PH_TID(); ph_ret(p, bid, nb, t_); }
#if DUP == 5
    { PH_TID(); ph_ret(p, bid, nb, t_); }
#endif
    grid.sync();
    { PH_TID(); ph_gemm_out(p, bid, nb, t_); }
#if DUP == 6
    { PH_TID(); ph_gemm_out(p, bid, nb, t_); }
#endif
    grid.sync();
#if DUP == 7
    { PH_TID(); ph_route<true>(p, bid, nb, t_); }
#endif
#if DUP == 72
    { PH_TID(); ph_route<true, 2>(p, bid, nb, t_); }
#endif
#if DUP == 73
    { PH_TID(); ph_route<true, 3>(p, bid, nb, t_); }
#endif
    { PH_TID(); ph_route<false>(p, bid, nb, t_); }
    grid.sync();
    { PH_TID(); ph_moe_up(p, bid, nb, t_); }
#if DUP == 8
    { PH_TID(); ph_moe_up(p, bid, nb, t_); }
#endif
    grid.sync();
#if DUP == 9
    { PH_TID(); ph_moe_down<true>(p, bid, nb, t_); }
#endif
    { PH_TID(); ph_moe_down<false>(p, bid, nb, t_); }
    grid.sync();
#if DUP == 13
    { PH_TID(); ph_final<true>(p, bid, nb, t_); }
#endif
    { PH_TID(); ph_final<false>(p, bid, nb, t_); }
#undef PH_TID
}
constexpr int LDS_TOTAL = 132096;
extern "C" void kernel_launch(void* const* d_in, const int* in_sizes, int n_in, void* d_out, int out_size, void* d_ws, size_t ws_size, hipStream_t stream) {
    char* ws = (char*)d_ws;
    MK mk{};
    mk.x = (const float*)d_in[0]; mk.c = (const float*)d_in[1]; mk.ctx = (const float*)d_in[2]; mk.cctx = (const float*)d_in[3]; mk.ada_w = (const float*)d_in[4]; mk.ada_b = (const float*)d_in[5];
    mk.norm1_g = (const float*)d_in[6]; mk.w_in = (const float*)d_in[7]; mk.lq1 = (const float*)d_in[8]; mk.lk1 = (const float*)d_in[9]; mk.lq2 = (const float*)d_in[10]; mk.lk2 = (const float*)d_in[11];
    mk.dattn_g = (const float*)d_in[12]; mk.dec_f = (const float*)d_in[13]; mk.dec_b = (const float*)d_in[14]; mk.ret_g = (const float*)d_in[15]; mk.w_out = (const float*)d_in[16];
    mk.norm2_g = (const float*)d_in[17]; mk.router_w = (const float*)d_in[18]; mk.router_b = (const float*)d_in[19]; mk.ew1 = (const float*)d_in[20]; mk.ew3 = (const float*)d_in[21];
    mk.ew2 = (const float*)d_in[22]; mk.sw1 = (const float*)d_in[23]; mk.sw3 = (const float*)d_in[24]; mk.sw2 = (const float*)d_in[25]; mk.final_g = (const float*)d_in[26];
    mk.out = (float*)d_out;
    mk.ws = ws;
    mk.dbgP = nullptr; mk.dbg_lo = 0; mk.dbg_hi = 12; mk.conv_limit = 1 << 30;
    static int grid_blocks = 0;
    if (!grid_blocks) {
        (void)hipFuncSetAttribute((const void*)k_mega, hipFuncAttributeMaxDynamicSharedMemorySize, LDS_TOTAL);
        int dev = 0, cus = 0, per_cu = 0;
        (void)hipGetDevice(&dev);
        (void)hipDeviceGetAttribute(&cus, hipDeviceAttributeMultiprocessorCount, dev);
        (void)hipOccupancyMaxActiveBlocksPerMultiprocessor(&per_cu, k_mega, 512, LDS_TOTAL);
        if (per_cu > 1) per_cu = 1;
        grid_blocks = cus * per_cu;
        if (grid_blocks <= 0) { fprintf(stderr, "occupancy query failed: cus %d per_cu %d\n", cus, per_cu); grid_blocks = 256; }
    }
    void* args[] = {&mk};
    hipError_t e = hipLaunchCooperativeKernel((void*)k_mega, dim3(grid_blocks), dim3(512), args, LDS_TOTAL, stream);
    if (e != hipSuccess) fprintf(stderr, "cooperative launch failed: %s (grid %d)\n", hipGetErrorString(e), grid_blocks);
}
```

```cpp
#include <hip/hip_runtime.h>
#include <hip/hip_cooperative_groups.h>
#include <cstdio>
namespace cg = cooperative_groups;
#ifndef DUP
#define DUP 0
#endif
#include <stdint.h>

constexpr int D = 1024, NB = 4, SEQ = 8192, CTX = 256, RB = SEQ + CTX  , NR = NB * RB  , T = NB * SEQ;
constexpr int NE = 64, DE = 256, ECAP = 32768;
constexpr float EPS = 1e-6f;
typedef unsigned short bf16_t;

__device__ __forceinline__ float siluf(float v) { return v / (1.0f + expf(-v)); }
__device__ __forceinline__ float wave_sum(float v) {
#pragma unroll
    for (int o = 32; o > 0; o >>= 1) v += __shfl_xor(v, o);
    return v;
}
__device__ __forceinline__ float wave_max(float v) {
#pragma unroll
    for (int o = 32; o > 0; o >>= 1) v = fmaxf(v, __shfl_xor(v, o));
    return v;
}
__device__ __forceinline__ float block_sum(float v, float* red) {
    v = wave_sum(v);
    __syncthreads();
    if ((threadIdx.x & 63) == 0) red[threadIdx.x >> 6] = v;
    __syncthreads();
    return red[0] + red[1] + red[2] + red[3];
}
__device__ __forceinline__ float block_max(float v, float* red) {
    v = wave_max(v);
    __syncthreads();
    if ((threadIdx.x & 63) == 0) red[threadIdx.x >> 6] = v;
    __syncthreads();
    return fmaxf(fmaxf(red[0], red[1]), fmaxf(red[2], red[3]));
}

typedef short bf16x8 __attribute__((ext_vector_type(8)));
typedef short s16x4 __attribute__((ext_vector_type(4)));
typedef float f32x4 __attribute__((ext_vector_type(4)));
typedef float f32x16 __attribute__((ext_vector_type(16)));
typedef unsigned u32x2 __attribute__((ext_vector_type(2)));
typedef unsigned u32x4 __attribute__((ext_vector_type(4)));
extern __shared__ __attribute__((aligned(1024))) char smem[];
constexpr int NTHR = 512;
constexpr int GEMM_LDS = 131072;

__device__ __forceinline__ unsigned cvtpk(float lo, float hi) { unsigned r; asm volatile("v_cvt_pk_bf16_f32 %0, %1, %2" : "=v"(r) : "v"(lo), "v"(hi)); return r; }
__device__ __forceinline__ bf16_t f2bf(float v) { return (bf16_t)(cvtpk(v, v) & 0xffffu); }
__device__ __forceinline__ float bf2f(bf16_t v) { return __uint_as_float(((unsigned)v) << 16); }

constexpr size_t MiB = 1048576;
struct MK {
    const float *x, *c, *ctx, *cctx, *ada_w, *ada_b, *norm1_g, *w_in, *lq1, *lk1, *lq2, *lk2, *dattn_g, *dec_f, *dec_b, *ret_g, *w_out, *norm2_g, *router_w, *router_b,
        *ew1, *ew3, *ew2, *sw1, *sw3, *sw2, *final_g;
    float* out; char* ws;
    float* dbgP; long dbg_lo, dbg_hi; long conv_limit;
#define WSF(name, type, off) __device__ __forceinline__ type* name() const { return (type*)(ws + (off)); }
    WSF(mod, float, 0) WSF(cnt, int, 131072) WSF(ropec, float, 262144) WSF(ropes, float, 262144 + 8192)
    WSF(w_inT, bf16_t, 1 * MiB) WSF(w_outT, bf16_t, 7 * MiB) WSF(routerT, bf16_t, 9 * MiB) WSF(W2t, bf16_t, 9 * MiB + 524288)
    WSF(H, bf16_t, 42 * MiB) WSF(MIX, bf16_t, 42 * MiB) WSF(KV, bf16_t, 112 * MiB) WSF(ST, bf16_t, 147 * MiB) WSF(ACT, bf16_t, 42 * MiB)
    WSF(W13t, bf16_t, 194 * MiB) WSF(H2, bf16_t, 260 * MiB)
    WSF(Q, bf16_t, 260 * MiB) WSF(K, bf16_t, 292 * MiB) WSF(V, bf16_t, 325 * MiB) WSF(RQ, bf16_t, 358 * MiB) WSF(RK, bf16_t, 375 * MiB)
    WSF(KTf, bf16_t, 392 * MiB) WSF(KTb, bf16_t, 409 * MiB) WSF(VT, bf16_t, 426 * MiB) WSF(RG, bf16_t, 459 * MiB)
    WSF(Y, unsigned char, 194 * MiB) WSF(tok_list, int, 452 * MiB) WSF(wt_list, float, 460 * MiB) WSF(tokmap, int, 468 * MiB)
#undef WSF
};

__device__ __forceinline__ void ph_mod(const MK& p, int bid, int nb, int tid_l) {
    float* red = (float*)smem;
    for (int it = bid; it < 6 * D / 32; it += nb) {
        const int col = tid_l & 31, kg = tid_l >> 5, j = it * 32 + col;
        float a[5] = {0, 0, 0, 0, 0};
        for (int k = kg * 64; k < kg * 64 + 64; ++k) {
            float w = p.ada_w[(size_t)k * 6 * D + j];
#pragma unroll
            for (int r = 0; r < 5; ++r) { float cv = r < 4 ? p.c[r * D + k] : p.cctx[k]; a[r] += siluf(cv) * w; }
        }
        __syncthreads();
#pragma unroll
        for (int r = 0; r < 5; ++r) red[(kg * 5 + r) * 32 + col] = a[r];
        __syncthreads();
        if (tid_l < 160) {
            int r = tid_l >> 5; float s = 0;
            for (int g = 0; g < 16; ++g) s += red[(g * 5 + r) * 32 + col];
            p.mod()[(size_t)r * 6 * D + j] = s + p.ada_b[j];
        }
    }
    if (bid == nb - 1) {
        for (int i = tid_l; i < 128 * 16; i += NTHR) {
            int pos = i >> 4, f = i & 15;
            float inv_freq = (float)pow(10000.0, -(double)f / 16.0);
            float s, c; sincosf((float)pos * inv_freq, &s, &c);
            p.ropec()[i] = c; p.ropes()[i] = s;
        }
    }
    __syncthreads();
}

__device__ __forceinline__ void tr_tile(const float* src, int ldsrc, int k0, int n0, bf16_t* dst, int lddst, int mode  , bf16_t* dst2, int tid_l) {
    float* t = (float*)smem;
    __syncthreads();
    for (int i = tid_l; i < 64 * 16; i += NTHR) {
        int r = i >> 4, c4 = (i & 15) * 4;
        float4 v = *(const float4*)(src + (size_t)(k0 + r) * ldsrc + n0 + c4);
        t[r * 65 + c4] = v.x; t[r * 65 + c4 + 1] = v.y; t[r * 65 + c4 + 2] = v.z; t[r * 65 + c4 + 3] = v.w;
    }
    __syncthreads();
    for (int i = tid_l; i < 64 * 16; i += NTHR) {
        int n = i >> 4, k4 = (i & 15) * 4;
        float a = t[(k4 + 0) * 65 + n], b = t[(k4 + 1) * 65 + n], c = t[(k4 + 2) * 65 + n], d = t[(k4 + 3) * 65 + n];
        int nn = n0 + n, row = nn;
        if (mode == 1 || mode == 2) { int ct = nn >> 7, wc = (nn & 127) >> 5, within = nn & 31; row = ct * 256 + wc * 64 + (mode == 2 ? 32 : 0) + within; }
        u32x2 w; w.x = cvtpk(a, b); w.y = cvtpk(c, d);
        *(u32x2*)(dst + (size_t)row * lddst + k0 + k4) = w;
        if (mode == 3) {
            float ah = bf2f((bf16_t)(w.x & 0xffff)), bh = bf2f((bf16_t)(w.x >> 16)), ch = bf2f((bf16_t)(w.y & 0xffff)), dh = bf2f((bf16_t)(w.y >> 16));
            u32x2 l; l.x = cvtpk(a - ah, b - bh); l.y = cvtpk(c - ch, d - dh);
            *(u32x2*)(dst2 + (size_t)row * lddst + k0 + k4) = l;
        }
    }
}
__device__ __forceinline__ void ph_convert(const MK& p, int bid, int nb, int tid_l) {
    const int n_win = 16 * 48, n_wout = 16 * 16, n_rt = 16, n_e13 = 65 * 2 * 16 * 4, n_e2 = 65 * 4 * 16;
    int total = n_win + n_wout + n_rt + n_e13 + n_e2; if (p.conv_limit < total) total = (int)p.conv_limit;
    for (int it = bid; it < total; it += nb) {
        int j = it;
        if (j < n_win) { tr_tile(p.w_in, 3072, (j / 48) * 64, (j % 48) * 64, p.w_inT(), 1024, 0, nullptr, tid_l); continue; } j -= n_win;
        if (j < n_wout) { tr_tile(p.w_out, 1024, (j / 16) * 64, (j % 16) * 64, p.w_outT(), 1024, 0, nullptr, tid_l); continue; } j -= n_wout;
        if (j < n_rt) { tr_tile(p.router_w, 64, j * 64, 0, p.routerT(), 1024, 3, p.routerT() + 64 * 1024, tid_l); continue; } j -= n_rt;
        if (j < n_e13) {
            int e = j / 128, r = j % 128, which = r / 64, tt = r % 64;
            const float* src = e < 64 ? (which ? p.ew3 : p.ew1) + (size_t)e * D * DE : (which ? p.sw3 : p.sw1);
            tr_tile(src, DE, (tt / 4) * 64, (tt % 4) * 64, p.W13t() + (size_t)e * 512 * 1024, 1024, 1 + which, nullptr, tid_l); continue; } j -= n_e13;
        { int e = j / 64, tt = j % 64;
          const float* src = e < 64 ? p.ew2 + (size_t)e * DE * D : p.sw2;
          tr_tile(src, D, (tt / 16) * 64, (tt % 16) * 64, p.W2t() + (size_t)e * 1024 * 256, 256, 0, nullptr, tid_l); }
    }
    __syncthreads();
}

__device__ __forceinline__ void ph_ln1(const MK& p, int bid, int nb, int tid_l) {
    const int wid = tid_l >> 6, lane = tid_l & 63;
    for (int R = bid * 8 + wid; R < NR; R += nb * 8) {
        int b = R / RB, i = R % RB;
        const float* src = i < CTX ? p.ctx + ((size_t)b * CTX + i) * D : p.x + ((size_t)b * SEQ + (i - CTX)) * D;
        const float* m = p.mod() + (size_t)(i < CTX ? 4 : b) * 6 * D;
        float4 v[4]; float ss = 0;
#pragma unroll
        for (int q = 0; q < 4; ++q) { v[q] = *(const float4*)(src + q * 256 + lane * 4); ss += v[q].x * v[q].x + v[q].y * v[q].y + v[q].z * v[q].z + v[q].w * v[q].w; }
        ss = wave_sum(ss);
        float rstd = rsqrtf(ss * (1.0f / D) + EPS);
#pragma unroll
        for (int q = 0; q < 4; ++q) {
            int c0 = q * 256 + lane * 4;
            float4 gg = *(const float4*)(p.norm1_g + c0), sh = *(const float4*)(m + c0), sc = *(const float4*)(m + D + c0);
            float o0 = v[q].x * rstd * gg.x * (1 + sc.x) + sh.x, o1 = v[q].y * rstd * gg.y * (1 + sc.y) + sh.y;
            float o2 = v[q].z * rstd * gg.z * (1 + sc.z) + sh.z, o3 = v[q].w * rstd * gg.w * (1 + sc.w) + sh.w;
            u32x2 w; w.x = cvtpk(o0, o1); w.y = cvtpk(o2, o3);
            *(u32x2*)(p.H() + (size_t)R * D + c0) = w;
        }
    }
}

__device__ __forceinline__ int lds_byte(int r, int c) { int st = (r >> 4) * 2 + (c >> 5), ob = (r & 15) * 64 + (c & 31) * 2; return st * 1024 + (ob ^ (((ob >> 9) & 1) << 5)); }
__device__ __forceinline__ void stage_rc(int b, int& R, int& C) { int st = b >> 10, sb = b & 1023, swz = sb ^ (((sb >> 9) & 1) << 5); R = (st / 2) * 16 + swz / 64; C = (st % 2) * 32 + (swz % 64) / 2; }
#define WAIT_V0() asm volatile("s_waitcnt vmcnt(0)" ::: "memory")
__device__ __forceinline__ void gemm_core(const char* Abase, const unsigned (&Ao)[4], const char* Bbase, const unsigned (&Bo)[4], int nt, f32x4 (&acc)[8][4], int tid_l, bool pre) {
    const int tid = tid_l, wid = tid >> 6, lane = tid & 63, wr = wid >> 2, wc = wid & 3, fr = lane & 15, fq = lane >> 4;
#pragma unroll
    for (int m = 0; m < 8; ++m)
#pragma unroll
        for (int n = 0; n < 4; ++n) acc[m][n] = (f32x4){0.f, 0.f, 0.f, 0.f};
#define G_SA(b) (smem + (b) * 65536)
#define G_SB(b) (smem + (b) * 65536 + 32768)
#define G_STAGE(buf, kt) do { _Pragma("unroll") for (int i = 0; i < 4; ++i) {                                                     \
        __builtin_amdgcn_global_load_lds((const unsigned*)(Abase + (Ao[i] + (unsigned)(kt) * 128u)), (unsigned*)(G_SA(buf) + wid * 1024 + i * 8192), 16, 0, 0); \
        __builtin_amdgcn_global_load_lds((const unsigned*)(Bbase + (Bo[i] + (unsigned)(kt) * 128u)), (unsigned*)(G_SB(buf) + wid * 1024 + i * 8192), 16, 0, 0); } } while (0)
    if (!pre) G_STAGE(0, 0);
    WAIT_V0(); __syncthreads();
#pragma unroll 1
    for (int t = 0; t < nt; ++t) {
        const int cur = t & 1;
        if (t + 1 < nt) G_STAGE(cur ^ 1, t + 1);
#pragma unroll
        for (int ks = 0; ks < 2; ++ks) {
            bf16x8 At[8], Bf[4];
#pragma unroll
            for (int m = 0; m < 8; ++m) At[m] = *(const bf16x8*)(G_SA(cur) + lds_byte(wr * 128 + m * 16 + fr, ks * 32 + fq * 8));
#pragma unroll
            for (int n = 0; n < 4; ++n) Bf[n] = *(const bf16x8*)(G_SB(cur) + lds_byte(wc * 64 + n * 16 + fr, ks * 32 + fq * 8));
#pragma unroll
            for (int m = 0; m < 8; ++m)
#pragma unroll
                for (int n = 0; n < 4; ++n) acc[m][n] = __builtin_amdgcn_mfma_f32_16x16x32_bf16(Bf[n], At[m], acc[m][n], 0, 0, 0);
            __builtin_amdgcn_sched_barrier(0);
        }
        WAIT_V0(); __syncthreads();
    }
}
__device__ __forceinline__ void gemm_prefetch(const char* Abase, const unsigned (&Ao)[4], const char* Bbase, const unsigned (&Bo)[4], int tid_l) {
    const int wid = tid_l >> 6;
    G_STAGE(0, 0);
}
__device__ __forceinline__ void stage_offs(unsigned ld_bytes, unsigned (&P)[4], int tid_l) {
    const int wid = tid_l >> 6, lane = tid_l & 63;
#pragma unroll
    for (int i = 0; i < 4; ++i) { int R, C; stage_rc(wid * 1024 + i * 8192 + lane * 16, R, C); P[i] = (unsigned)R * ld_bytes + (unsigned)C * 2u; }
}

__device__ __forceinline__ void ph_gemm_in(const MK& p, int bid, int nb, int tid_l) {
    const int tid = tid_l, wid = tid >> 6, lane = tid & 63, wr = wid >> 2, wc = wid & 3, fr = lane & 15, fq = lane >> 4;
    const int nM = NR / 256, nN = 12;
    unsigned Ao[4], Bo[4];
    stage_offs(D * 2, Ao, tid_l); stage_offs(D * 2, Bo, tid_l);
    bool pre = false;
    for (int tile = bid; tile < nM * nN; tile += nb) {
        const int pm = tile / nN, pn = tile % nN;
        const int brow = pm * 256, bcol = pn * 256;
        f32x4 acc[8][4];
        gemm_core((const char*)(p.H() + (size_t)brow * D), Ao, (const char*)(p.w_inT() + (size_t)bcol * D), Bo, D / 64, acc, tid_l, pre);
        { const int nx = tile + nb; pre = nx < nM * nN;
          if (pre) gemm_prefetch((const char*)(p.H() + (size_t)((nx / nN) * 256) * D), Ao, (const char*)(p.w_inT() + (size_t)((nx % nN) * 256) * D), Bo, tid_l); }
        const int b = brow / RB, i0 = brow % RB;
        const bool lat = i0 >= CTX;
        const int seg = pn;
        const bool do_rope = lat && (seg <= 3 || seg == 6 || seg == 7);
        float lg2f = 0.f, lg2b = 0.f;
        if (seg == 7) { float df = p.dec_f[wc], db = p.dec_b[wc]; lg2f = log2f(1.0f / (1.0f + expf(-df))); lg2b = log2f(1.0f / (1.0f + expf(-db))); }
        const int cw = bcol + wc * 64;
        float4 c0, s0, c1, s1;
        if (do_rope) { const int t0_ = i0 + wr * 128 + fr - CTX, prow = t0_ >> 6, pcol = t0_ & 63;
            c0 = *(const float4*)(p.ropec() + prow * 16 + fq * 4); s0 = *(const float4*)(p.ropes() + prow * 16 + fq * 4);
            c1 = *(const float4*)(p.ropec() + pcol * 16 + fq * 4); s1 = *(const float4*)(p.ropes() + pcol * 16 + fq * 4); }
#pragma unroll
        for (int m = 0; m < 8; ++m) {
            int ioff = m * 16; asm volatile("" : "+v"(ioff) :: "memory");
            const int i = i0 + wr * 128 + fr + ioff, t = i - CTX;
            float v[4][4];
#pragma unroll
            for (int n = 0; n < 4; ++n)
#pragma unroll
                for (int j = 0; j < 4; ++j) v[n][j] = acc[m][n][j];
            float4 nc0, ns0, nc1, ns1;
            if (do_rope && m < 7) { const int tn = t + 16, prow = tn >> 6, pcol = tn & 63;
                nc0 = *(const float4*)(p.ropec() + prow * 16 + fq * 4); ns0 = *(const float4*)(p.ropes() + prow * 16 + fq * 4);
                nc1 = *(const float4*)(p.ropec() + pcol * 16 + fq * 4); ns1 = *(const float4*)(p.ropes() + pcol * 16 + fq * 4); }
            if (do_rope) {
                const float cc0[4] = {c0.x, c0.y, c0.z, c0.w}, ss0[4] = {s0.x, s0.y, s0.z, s0.w}, cc1[4] = {c1.x, c1.y, c1.z, c1.w}, ss1[4] = {s1.x, s1.y, s1.z, s1.w};
#pragma unroll
                for (int j = 0; j < 4; ++j) {
                    float x1 = v[0][j], x2 = v[1][j]; v[0][j] = x1 * cc0[j] - x2 * ss0[j]; v[1][j] = x1 * ss0[j] + x2 * cc0[j];
                    float y1 = v[2][j], y2 = v[3][j]; v[2][j] = y1 * cc1[j] - y2 * ss1[j]; v[3][j] = y1 * ss1[j] + y2 * cc1[j];
                }
            }
            if (seg == 7) {
#pragma unroll
                for (int n = 0; n < 4; ++n)
#pragma unroll
                    for (int j = 0; j < 4; ++j) v[n][j] *= 0.125f;
            }
            if (p.dbgP) {
                {
                    float* dp = p.dbgP + (size_t)(brow + wr * 128 + fr + ioff) * 1536 + (cw % 1536) + fq * 4; const float sc = seg <= 1 ? 0.125f : 1.0f;
#pragma unroll
                    for (int n = 0; n < 4; ++n) *(float4*)(dp + n * 16) = make_float4(v[n][0] * sc, v[n][1] * sc, v[n][2] * sc, v[n][3] * sc);
                }
            } else {
                u32x2 w[4];
#pragma unroll
                for (int n = 0; n < 4; ++n) { w[n].x = cvtpk(v[n][0], v[n][1]); w[n].y = cvtpk(v[n][2], v[n][3]); }
                if (seg <= 5) {
                    const int cc = cw - (seg <= 1 ? 0 : seg <= 3 ? 512 : 1024), h = cc >> 7, wi = (cc & 127) + fq * 4;
                    bf16_t* dp = seg <= 1 ? p.Q() + (((size_t)(b * 4 + h) * SEQ + t) * 128 + wi) : (seg <= 3 ? p.K() : p.V()) + (((size_t)(b * 4 + h) * RB + i) * 128 + wi);
                    if (seg > 1 || lat) {
#pragma unroll
                        for (int n = 0; n < 4; ++n) *(u32x2*)(dp + n * 16) = w[n];
                    }
                } else if (seg <= 7) {
                    bf16_t* dp = (seg == 6 ? p.RQ() : p.RK()) + (((size_t)(b * 4 + wc) * RB + i) * 64 + fq * 4);
#pragma unroll
                    for (int n = 0; n < 4; ++n) *(u32x2*)(dp + n * 16) = w[n];
                    if (seg == 7) {
                        const int pos = i & 127;
                        const float ff = exp2f((float)(127 - pos) * lg2f), fb = exp2f((float)pos * lg2b);
                        const size_t o = ((size_t)(b * 4 + wc) * 64 + fq * 4) * RB + i;
#pragma unroll
                        for (int n = 0; n < 4; ++n)
#pragma unroll
                            for (int j = 0; j < 4; ++j) { p.KTf()[o + (size_t)(n * 16 + j) * RB] = f2bf(v[n][j] * ff); p.KTb()[o + (size_t)(n * 16 + j) * RB] = f2bf(v[n][j] * fb); }
                    }
                } else if (seg <= 9) {
                    const int cc = cw - 2048, h = cc >> 7, e = (cc & 127) + fq * 4;
                    const size_t o = ((size_t)(b * 4 + h) * 128 + e) * RB + i;
#pragma unroll
                    for (int n = 0; n < 4; ++n)
#pragma unroll
                        for (int j = 0; j < 4; ++j) p.VT()[o + (size_t)(n * 16 + j) * RB] = f2bf(v[n][j]);
                } else if (lat) {
                    bf16_t* dp = p.RG() + ((size_t)(b * SEQ + t) * 512 + (cw - 2560) + fq * 4);
#pragma unroll
                    for (int n = 0; n < 4; ++n) *(u32x2*)(dp + n * 16) = w[n];
                }
            }
            if (do_rope && m < 7) { c0 = nc0; s0 = ns0; c1 = nc1; s1 = ns1; }
        }
    }
}


constexpr int A_KVBLK = 64;
constexpr float A_SCALE = 0.125f, A_THR = 8.f;
constexpr int A_SHM_V = A_KVBLK * 128 * 2, A_SHM_K = A_KVBLK * 128 * 2;
#define KSWZ(row, colB) ((row) * 256 + ((colB) ^ (((row) & 7) << 4)))
#define SBAR() __builtin_amdgcn_sched_barrier(0)
__device__ __forceinline__ int crow(int r, int hi) { return (r & 3) + 8 * (r >> 2) + 4 * hi; }

__device__ __forceinline__ void partialSM(f32x16& p0, f32x16& p1, float& m_reg, float& mn, float& alpha) {
    constexpr float C = A_SCALE * 1.4426950408889634f;
    float pmax = p0[0];
#pragma unroll
    for (int r = 1; r < 16; ++r) pmax = fmaxf(pmax, p0[r]);
#pragma unroll
    for (int r = 0; r < 16; ++r) pmax = fmaxf(pmax, p1[r]);
    { auto rr = __builtin_amdgcn_permlane32_swap(__float_as_uint(pmax), __float_as_uint(pmax), false, false);
      pmax = fmaxf(__uint_as_float(rr[0]), __uint_as_float(rr[1])); }
    if (__builtin_expect(__all(pmax - m_reg <= A_THR / A_SCALE), 1)) { mn = m_reg; alpha = 1.f; }
    else { mn = fmaxf(m_reg, pmax); alpha = __builtin_amdgcn_exp2f((m_reg - mn) * C); m_reg = mn; }
    float mnC = -mn * C;
#pragma unroll
    for (int r = 0; r < 16; ++r) p0[r] = fmaf(p0[r], C, mnC);
#pragma unroll
    for (int r = 0; r < 16; ++r) p1[r] = fmaf(p1[r], C, mnC);
#pragma unroll
    for (int r = 0; r < 16; ++r) p0[r] = __builtin_amdgcn_exp2f(p0[r]);
}
#define PK4(P, BASE, OUT) do { unsigned a0 = cvtpk(P[BASE + 0], P[BASE + 1]), a1 = cvtpk(P[BASE + 2], P[BASE + 3]);   \
    unsigned b0 = cvtpk(P[BASE + 4], P[BASE + 5]), b1 = cvtpk(P[BASE + 6], P[BASE + 7]);                              \
    auto r0 = __builtin_amdgcn_permlane32_swap(a0, b0, false, false); auto r1 = __builtin_amdgcn_permlane32_swap(a1, b1, false, false); \
    u32x4 w = {r0[0], r1[0], r0[1], r1[1]}; OUT = *reinterpret_cast<bf16x8*>(&w); } while (0)
__device__ __forceinline__ void finishSM(f32x16& p0, f32x16& p1, float alpha, float& l_reg, bf16x8& pa0, bf16x8& pa1, bf16x8& pa2, bf16x8& pa3) {
#pragma unroll
    for (int r = 0; r < 16; ++r) p1[r] = __builtin_amdgcn_exp2f(p1[r]);
    float ps = 0;
#pragma unroll
    for (int r = 0; r < 16; ++r) ps += p0[r];
#pragma unroll
    for (int r = 0; r < 16; ++r) ps += p1[r];
    { auto rr = __builtin_amdgcn_permlane32_swap(__float_as_uint(ps), __float_as_uint(ps), false, false);
      ps = __uint_as_float(rr[0]) + __uint_as_float(rr[1]); }
    l_reg = l_reg * alpha + ps;
    PK4(p0, 0, pa0); PK4(p0, 8, pa1); PK4(p1, 0, pa2); PK4(p1, 8, pa3);
}
__device__ __forceinline__ void qkt(f32x16& p0, f32x16& p1, const char* Ks, const bf16x8* qr, int r32, int hi, int mapc) {
    p0 = f32x16{}; p1 = f32x16{};
#pragma unroll
    for (int d0 = 0; d0 < 4; ++d0) { int cb = (mapc + d0 * 16 + hi * 8) * 2;
        bf16x8 b0 = *reinterpret_cast<const bf16x8*>(Ks + KSWZ(r32, cb));
        bf16x8 b1 = *reinterpret_cast<const bf16x8*>(Ks + KSWZ(32 + r32, cb));
        p0 = __builtin_amdgcn_mfma_f32_32x32x16_bf16(b0, qr[d0], p0, 0, 0, 0);
        p1 = __builtin_amdgcn_mfma_f32_32x32x16_bf16(b1, qr[d0], p1, 0, 0, 0); }
}
__device__ __forceinline__ int v_st(int k, int c) { const int kk = (k & ~0xC) | ((k & 4) << 1) | ((k & 8) >> 1); return ((kk >> 3) * 4 + (c >> 5)) * 512 + ((kk & 7) * 32 + (c & 31)) * 2; }
__device__ __forceinline__ int v_rd_base(int lane) { return ((lane & 3) << 3) | (((lane >> 2) & 3) << 6) | (((lane >> 4) & 1) << 5) | (((lane >> 5) & 1) << 8); }
constexpr int v_rd_off(int d0, int ks, int half) { return d0 * 512 + ks * 4096 + half * 2048; }
template <int OFF> __device__ __forceinline__ s16x4 tr_read(int vb) {
    s16x4 r; asm volatile("ds_read_b64_tr_b16 %0, %1 offset:%2" : "=&v"(r) : "v"(vb), "i"(OFF) : "memory"); return r;
}
template <int D0> __device__ __forceinline__ void pv_one(f32x16& od, int vb, bf16x8 pa0, bf16x8 pa1, bf16x8 pa2, bf16x8 pa3) {
    const s16x4 l0 = tr_read<v_rd_off(D0, 0, 0)>(vb), h0 = tr_read<v_rd_off(D0, 0, 1)>(vb), l1 = tr_read<v_rd_off(D0, 1, 0)>(vb), h1 = tr_read<v_rd_off(D0, 1, 1)>(vb);
    const s16x4 l2 = tr_read<v_rd_off(D0, 2, 0)>(vb), h2 = tr_read<v_rd_off(D0, 2, 1)>(vb), l3 = tr_read<v_rd_off(D0, 3, 0)>(vb), h3 = tr_read<v_rd_off(D0, 3, 1)>(vb);
    asm volatile("s_waitcnt lgkmcnt(0)" ::: "memory"); SBAR();
#define PKV(L, H) (bf16x8){L[0], L[1], L[2], L[3], H[0], H[1], H[2], H[3]}
    od = __builtin_amdgcn_mfma_f32_32x32x16_bf16(pa0, PKV(l0, h0), od, 0, 0, 0);
    od = __builtin_amdgcn_mfma_f32_32x32x16_bf16(pa1, PKV(l1, h1), od, 0, 0, 0);
    od = __builtin_amdgcn_mfma_f32_32x32x16_bf16(pa2, PKV(l2, h2), od, 0, 0, 0);
    od = __builtin_amdgcn_mfma_f32_32x32x16_bf16(pa3, PKV(l3, h3), od, 0, 0, 0);
}
__device__ __forceinline__ void pv_d0(f32x16* o, int vb, bf16x8 pa0, bf16x8 pa1, bf16x8 pa2, bf16x8 pa3) {
    pv_one<0>(o[0], vb, pa0, pa1, pa2, pa3); pv_one<1>(o[1], vb, pa0, pa1, pa2, pa3); pv_one<2>(o[2], vb, pa0, pa1, pa2, pa3); pv_one<3>(o[3], vb, pa0, pa1, pa2, pa3);
}

__device__ __forceinline__ void attn_item(const bf16_t* __restrict__ Qb, const bf16_t* __restrict__ Kh, const bf16_t* __restrict__ Vh, bf16_t* __restrict__ mixrow,
                                          const float* __restrict__ gd, float lam, int tid_l) {
    char* lds = smem;
    const int tid = tid_l, wid = tid >> 6, lane = tid & 63, r32 = lane & 31, hi = lane >> 5;
    const int map = wid >> 2, wq = wid & 3, mapc = map * 64;
    char* V_lds = lds; char* K_lds = lds + 2 * A_SHM_V;
    float* wsw = (float*)(lds + 2 * A_SHM_V + 2 * A_SHM_K) + wid * 64; float* li_l = wsw; float* al_l = wsw + 32;
    float m_reg = -1e30f, l_reg = 0; f32x16 o[4] = {}; bf16x8 qr[4];
    const bf16_t* Qw = Qb + (long)(wq * 32 + r32) * 128 + mapc + hi * 8;
#pragma unroll
    for (int d0 = 0; d0 < 4; ++d0) qr[d0] = *reinterpret_cast<const bf16x8*>(Qw + d0 * 16);
    const int sr = tid >> 4, sc = (tid & 15) * 8, vst0 = v_st(sr, sc), vst1 = v_st(32 + sr, sc);
    const int vb0 = (int)(uintptr_t)V_lds + v_rd_base(lane);
    struct { bf16x8 vs0, vs1, ks0, ks1; } sr_[1];
#define SLOAD(i, k0) do { sr_[i].vs0 = *(const bf16x8*)(&Vh[(long)((k0) + sr) * 128 + sc]); sr_[i].vs1 = *(const bf16x8*)(&Vh[(long)((k0) + 32 + sr) * 128 + sc]); \
    sr_[i].ks0 = *(const bf16x8*)(&Kh[(long)((k0) + sr) * 128 + sc]); sr_[i].ks1 = *(const bf16x8*)(&Kh[(long)((k0) + 32 + sr) * 128 + sc]); } while (0)
#define SWRITE(b, i) do { *(bf16x8*)(V_lds + (b) * A_SHM_V + vst0) = sr_[i].vs0;          \
    *(bf16x8*)(V_lds + (b) * A_SHM_V + vst1) = sr_[i].vs1; int kc = sc * 2;               \
    *(bf16x8*)(K_lds + (b) * A_SHM_K + KSWZ(sr, kc)) = sr_[i].ks0;                       \
    *(bf16x8*)(K_lds + (b) * A_SHM_K + KSWZ(32 + sr, kc)) = sr_[i].ks1; } while (0)
#define SWAIT() asm volatile("s_waitcnt vmcnt(0)" ::: "memory")
#define RESC(a) do { if (__any((a) < 1.f)) { if (hi == 0) al_l[r32] = (a); asm volatile("s_waitcnt lgkmcnt(0)" ::: "memory"); \
    _Pragma("unroll") for (int d = 0; d < 4; ++d) _Pragma("unroll") for (int r = 0; r < 16; ++r) o[d][r] *= al_l[crow(r, hi)]; } } while (0)
    f32x16 pA0, pA1, pB0, pB1; float mnA, mnB, alA, alB; bf16x8 pa0, pa1, pa2, pa3; const int NT = RB / A_KVBLK;
    constexpr int SE = 0, SO = 0;
    SLOAD(SE, 0); asm volatile("s_waitcnt vmcnt(0)" ::: "memory"); SWRITE(0, SE); __syncthreads();
    qkt(pA0, pA1, K_lds, qr, r32, hi, mapc); partialSM(pA0, pA1, m_reg, mnA, alA);
    SLOAD(SO, A_KVBLK);
    SWAIT(); SWRITE(1, SO); __syncthreads();
    for (int j = 1; j + 1 < NT; j += 2) {
        SBAR(); qkt(pB0, pB1, K_lds + A_SHM_K, qr, r32, hi, mapc);
        finishSM(pA0, pA1, alA, l_reg, pa0, pa1, pa2, pa3); SBAR();
        SLOAD(SO, (j + 1) * A_KVBLK); SBAR();
        pv_d0(o, vb0, pa0, pa1, pa2, pa3); partialSM(pB0, pB1, m_reg, mnB, alB);
        __syncthreads(); SWAIT(); SWRITE(0, SE);
        RESC(alB); __syncthreads();
        SBAR(); qkt(pA0, pA1, K_lds, qr, r32, hi, mapc);
        finishSM(pB0, pB1, alB, l_reg, pa0, pa1, pa2, pa3); SBAR();
        SLOAD(SE, (j + 2) * A_KVBLK); SBAR();
        pv_d0(o, vb0 + A_SHM_V, pa0, pa1, pa2, pa3); partialSM(pA0, pA1, m_reg, mnA, alA);
        __syncthreads(); SWAIT(); SWRITE(1, SO);
        RESC(alA); __syncthreads();
    }
    SBAR(); qkt(pB0, pB1, K_lds + A_SHM_K, qr, r32, hi, mapc);
    finishSM(pA0, pA1, alA, l_reg, pa0, pa1, pa2, pa3); SBAR();
    pv_d0(o, vb0, pa0, pa1, pa2, pa3); partialSM(pB0, pB1, m_reg, mnB, alB);
    __syncthreads(); RESC(alB);
    finishSM(pB0, pB1, alB, l_reg, pa0, pa1, pa2, pa3); SBAR();
    pv_d0(o, vb0 + A_SHM_V, pa0, pa1, pa2, pa3);
    if (hi == 0) li_l[r32] = l_reg;
    asm volatile("s_waitcnt lgkmcnt(0)" ::: "memory");
    float rl[16];
#pragma unroll
    for (int r = 0; r < 16; ++r) rl[r] = __builtin_amdgcn_rcpf(li_l[crow(r, hi)]);
    __syncthreads();
    {
        float* xo = (float*)lds + map * 16384 + (wq * 32) * 128 + r32;
#pragma unroll
        for (int r = 0; r < 16; ++r)
#pragma unroll
            for (int d0 = 0; d0 < 4; ++d0) xo[crow(r, hi) * 128 + d0 * 32] = o[d0][r] * rl[r];
    }
    __syncthreads();
    {
        const float g0 = gd[lane * 2], g1 = gd[lane * 2 + 1];
#pragma unroll 4
        for (int rr = 0; rr < 16; ++rr) {
            const int row = wid * 16 + rr;
            const float2 a0 = *(const float2*)((const float*)lds + row * 128 + lane * 2), a1 = *(const float2*)((const float*)lds + 16384 + row * 128 + lane * 2);
            const float xv = a0.x - lam * a1.x, yv = a0.y - lam * a1.y;
            const float ss = wave_sum(xv * xv + yv * yv);
            const float rs = rsqrtf(ss * (1.0f / 128) + EPS) * 0.8f;
            *(unsigned*)(mixrow + (long)row * 1024 + lane * 2) = cvtpk(xv * rs * g0, yv * rs * g1);
        }
    }
    __syncthreads();
#undef SLOAD
#undef SWRITE
#undef SWAIT
#undef RESC
}

__device__ __forceinline__ void ph_attn(const MK& p, int bid, int nb, int tid_l) {
    const int lane = tid_l & 63;
    float s1 = wave_sum(p.lq1[lane] * p.lk1[lane]), s2 = wave_sum(p.lq2[lane] * p.lk2[lane]);
    const float lam = expf(s1) - expf(s2) + 0.2f;
    const int nrounds = (1024 + nb - 1) / nb;
    for (int rr = 0; rr < nrounds; ++rr) {
        int item;
        if (nb == 256) { int x = bid & 7, j = bid >> 3, hh = rr * 8 + x; item = (hh >> 1) * 64 + (hh & 1) * 32 + j; }
        else { item = rr * nb + bid; if (item >= 1024) break; }
        const int bh = item >> 6, qb = item & 63, b = bh >> 2, h = bh & 3;
        attn_item(p.Q() + ((size_t)bh * SEQ + qb * 128) * 128, p.K() + (size_t)bh * RB * 128, p.V() + (size_t)bh * RB * 128,
                  p.MIX() + ((size_t)(b * SEQ + qb * 128)) * 1024 + h * 128, p.dattn_g, lam, tid_l);
    }
}


__device__ __forceinline__ bf16x8 ldfrag(const bf16_t* p) { return *reinterpret_cast<const bf16x8*>(p); }

__device__ __forceinline__ void ph_kv(const MK& p, int bid, int nb, int tid_l) {
    const int wid = tid_l >> 6, lane = tid_l & 63, r32 = lane & 31, hi = lane >> 5;
    const int nitems = 16 * 2 * 66;
    for (int it = bid * 8 + wid; it < nitems; it += nb * 8) {
        const int c = it % 66, chain = it / 66, dir = chain & 1, bh = chain >> 1;
        const bf16_t* vt = p.VT() + (size_t)bh * 128 * RB + c * 128 + hi * 8;
        const bf16_t* kt = (dir ? p.KTb() : p.KTf()) + (size_t)bh * 64 * RB + c * 128 + hi * 8;
        f32x16 acc[4][2];
#pragma unroll
        for (int mt = 0; mt < 4; ++mt) { acc[mt][0] = f32x16{}; acc[mt][1] = f32x16{}; }
#pragma unroll 2
        for (int ks = 0; ks < 8; ++ks) {
            bf16x8 a[4], b[2];
#pragma unroll
            for (int mt = 0; mt < 4; ++mt) a[mt] = ldfrag(vt + (size_t)(mt * 32 + r32) * RB + ks * 16);
#pragma unroll
            for (int nt = 0; nt < 2; ++nt) b[nt] = ldfrag(kt + (size_t)(nt * 32 + r32) * RB + ks * 16);
#pragma unroll
            for (int mt = 0; mt < 4; ++mt)
#pragma unroll
                for (int nt = 0; nt < 2; ++nt) acc[mt][nt] = __builtin_amdgcn_mfma_f32_32x32x16_bf16(a[mt], b[nt], acc[mt][nt], 0, 0, 0);
        }
        bf16_t* dst = p.KV() + (size_t)it * 8192;
#pragma unroll
        for (int mt = 0; mt < 4; ++mt)
#pragma unroll
            for (int nt = 0; nt < 2; ++nt)
#pragma unroll
                for (int r = 0; r < 16; ++r) dst[(mt * 32 + crow(r, hi)) * 64 + nt * 32 + r32] = f2bf(acc[mt][nt][r]);
    }
}

__device__ __forceinline__ void ph_scan(const MK& p, int bid, int nb, int tid_l) {
    for (int e = bid * NTHR + tid_l; e < 32 * 8192; e += nb * NTHR) {
        const int chain = e >> 13, el = e & 8191, dir = chain & 1, bh = chain >> 1, h = bh & 3;
        const float d = dir ? p.dec_b[h] : p.dec_f[h];
        const float g128 = exp2f(128.0f * log2f(1.0f / (1.0f + expf(-d))));
        const bf16_t* kv = p.KV() + (size_t)chain * 66 * 8192 + el;
        bf16_t* st = p.ST() + (size_t)chain * 66 * 8192 + el;
        float S = 0.f;
        for (int n = 0; n < 66; ++n) {
            const int c = dir == 0 ? n : (n == 0 ? 1 : (n == 1 ? 0 : 67 - n));
            st[(size_t)c * 8192] = f2bf(S);
            S = fmaf(g128, S, bf2f(kv[(size_t)c * 8192]));
        }
    }
}

__device__ __forceinline__ void ph_ret(const MK& p, int bid, int nb, int tid_l) {
    const int tid = tid_l, wid = tid >> 6, lane = tid & 63, r32 = lane & 31, hi = lane >> 5, wq = wid & 3, half = wid >> 2;
    float* img = (float*)smem;
    for (int it = bid; it < 4 * 64 * 2; it += nb) {
        const int hp = it & 1, lc = (it >> 1) & 63, b = it >> 7, h = hp * 2 + half, bh = b * 4 + h;
        const int ib = CTX + lc * 128, c = 2 + lc;
        const float lf = log2f(1.0f / (1.0f + expf(-p.dec_f[h]))), lb = log2f(1.0f / (1.0f + expf(-p.dec_b[h])));
        const bf16_t* rq = p.RQ() + ((size_t)bh * RB + ib + wq * 32 + r32) * 64 + hi * 8;
        bf16x8 q[4];
#pragma unroll
        for (int ks = 0; ks < 4; ++ks) q[ks] = ldfrag(rq + ks * 16);
        f32x16 o[4];
        {
            const bf16_t* stf = p.ST() + ((size_t)(bh * 2 + 0) * 66 + c) * 8192 + hi * 8;
            const bf16_t* stb = p.ST() + ((size_t)(bh * 2 + 1) * 66 + c) * 8192 + hi * 8;
            {
                float rf[16];
#pragma unroll
                for (int r = 0; r < 16; ++r) rf[r] = __builtin_amdgcn_exp2f((float)(wq * 32 + crow(r, hi) + 1) * lf);
#pragma unroll
                for (int d0 = 0; d0 < 4; ++d0) {
                    f32x16 tf = f32x16{};
#pragma unroll
                    for (int ks = 0; ks < 4; ++ks) tf = __builtin_amdgcn_mfma_f32_32x32x16_bf16(q[ks], ldfrag(stf + (size_t)(d0 * 32 + r32) * 64 + ks * 16), tf, 0, 0, 0);
#pragma unroll
                    for (int r = 0; r < 16; ++r) o[d0][r] = tf[r] * rf[r];
                    asm volatile("" ::: "memory");
                }
            }
            {
                float rf[16];
#pragma unroll
                for (int r = 0; r < 16; ++r) rf[r] = __builtin_amdgcn_exp2f((float)(128 - (wq * 32 + crow(r, hi))) * lb);
#pragma unroll
                for (int d0 = 0; d0 < 4; ++d0) {
                    f32x16 tb = f32x16{};
#pragma unroll
                    for (int ks = 0; ks < 4; ++ks) tb = __builtin_amdgcn_mfma_f32_32x32x16_bf16(q[ks], ldfrag(stb + (size_t)(d0 * 32 + r32) * 64 + ks * 16), tb, 0, 0, 0);
#pragma unroll
                    for (int r = 0; r < 16; ++r) o[d0][r] += tb[r] * rf[r];
                    asm volatile("" ::: "memory");
                }
            }
        }
        {
            const int qi = wq * 32 + r32;
            const bf16_t* vt = p.VT() + (size_t)bh * 128 * RB + ib + hi * 8;
#pragma unroll 1
            for (int jb = 0; jb < 4; ++jb) {
                asm volatile("" ::: "memory");
                const bf16_t* rk = p.RK() + ((size_t)bh * RB + ib + jb * 32 + r32) * 64 + hi * 8;
                f32x16 pp = f32x16{};
#pragma unroll
                for (int ks = 0; ks < 4; ++ks) pp = __builtin_amdgcn_mfma_f32_32x32x16_bf16(ldfrag(rk + ks * 16), q[ks], pp, 0, 0, 0);
#pragma unroll
                for (int r = 0; r < 16; ++r) {
                    const int dd = qi - (jb * 32 + crow(r, hi));
                    const float ex = __builtin_amdgcn_exp2f(dd > 0 ? (float)dd * lf : (float)(-dd) * lb); const float w = dd == 0 ? 2.0f : ex;
                    pp[r] *= w;
                }
                bf16x8 pa0, pa1;
                PK4(pp, 0, pa0); PK4(pp, 8, pa1);
#pragma unroll
                for (int d0 = 0; d0 < 4; ++d0) {
                    o[d0] = __builtin_amdgcn_mfma_f32_32x32x16_bf16(pa0, ldfrag(vt + (size_t)(d0 * 32 + r32) * RB + jb * 32), o[d0], 0, 0, 0);
                    o[d0] = __builtin_amdgcn_mfma_f32_32x32x16_bf16(pa1, ldfrag(vt + (size_t)(d0 * 32 + r32) * RB + jb * 32 + 16), o[d0], 0, 0, 0);
                }
            }
        }
        __syncthreads();
        {
            float* xo = img + half * 16384 + (wq * 32) * 128 + r32;
#pragma unroll
            for (int r = 0; r < 16; ++r)
#pragma unroll
                for (int d0 = 0; d0 < 4; ++d0) xo[crow(r, hi) * 128 + d0 * 32] = o[d0][r];
        }
        __syncthreads();
        {
            const float g0 = p.ret_g[lane * 2], g1 = p.ret_g[lane * 2 + 1];
#pragma unroll 4
            for (int rr = 0; rr < 32; ++rr) {
                const int row = wid * 32 + rr, itl = row >> 7, rw = row & 127, hh = hp * 2 + itl;
                const float2 a = *(const float2*)(img + row * 128 + lane * 2);
                const float ss = wave_sum(a.x * a.x + a.y * a.y);
                const float rs = rsqrtf(ss * (1.0f / 128) + EPS);
                const size_t tt = (size_t)b * SEQ + lc * 128 + rw;
                const unsigned gg = *(const unsigned*)(p.RG() + tt * 512 + hh * 128 + lane * 2);
                const float ga = bf2f((bf16_t)(gg & 0xffff)), gb = bf2f((bf16_t)(gg >> 16));
                *(unsigned*)(p.MIX() + tt * 1024 + 512 + hh * 128 + lane * 2) = cvtpk(siluf(ga) * a.x * rs * g0, siluf(gb) * a.y * rs * g1);
            }
        }
    }
}


__device__ __forceinline__ void ph_gemm_out(const MK& p, int bid, int nb, int tid_l) {
    const int tid = tid_l, wid = tid >> 6, lane = tid & 63, wr = wid >> 2, wc = wid & 3, fr = lane & 15, fq = lane >> 4;
    unsigned Ao[4], Bo[4];
    stage_offs(D * 2, Ao, tid_l); stage_offs(D * 2, Bo, tid_l);
    bool pre = false;
    for (int tile = bid; tile < (T / 256) * 4; tile += nb) {
        const int pm = tile >> 2, pn = tile & 3, brow = pm * 256, bcol = pn * 256;
        f32x4 acc[8][4];
        gemm_core((const char*)(p.MIX() + (size_t)brow * D), Ao, (const char*)(p.w_outT() + (size_t)bcol * D), Bo, D / 64, acc, tid_l, pre);
        { const int nx = tile + nb; pre = nx < (T / 256) * 4;
          if (pre) gemm_prefetch((const char*)(p.MIX() + (size_t)((nx >> 2) * 256) * D), Ao, (const char*)(p.w_outT() + (size_t)((nx & 3) * 256) * D), Bo, tid_l); }
        const float* g1 = p.mod() + (size_t)(brow / SEQ) * 6 * D + 2 * D + bcol + wc * 64 + fq * 4;
        float4 gv[4], xv[4];
        const size_t o0 = (size_t)(brow + wr * 128 + fr) * D + bcol + wc * 64 + fq * 4;
#pragma unroll
        for (int n = 0; n < 4; ++n) { gv[n] = *(const float4*)(g1 + n * 16); xv[n] = *(const float4*)(p.x + o0 + n * 16); }
#pragma unroll
        for (int m = 0; m < 8; ++m) {
            int ioff = m * 16; asm volatile("" : "+v"(ioff) :: "memory");
            const size_t o = o0 + (size_t)ioff * D;
            float4 xn[4];
            if (m < 7) {
#pragma unroll
                for (int n = 0; n < 4; ++n) xn[n] = *(const float4*)(p.x + o + (size_t)16 * D + n * 16);
            }
#pragma unroll
            for (int n = 0; n < 4; ++n)
                *(float4*)(p.out + o + n * 16) = make_float4(xv[n].x + gv[n].x * acc[m][n][0], xv[n].y + gv[n].y * acc[m][n][1], xv[n].z + gv[n].z * acc[m][n][2], xv[n].w + gv[n].w * acc[m][n][3]);
            if (m < 7) {
#pragma unroll
                for (int n = 0; n < 4; ++n) xv[n] = xn[n];
            }
        }
    }
}

__device__ __forceinline__ bool route_token(float logit, float bias, int lane, float& wt) {
    const float score = 1.0f / (1.0f + expf(-logit));
    const float sel = score + bias;
    float m1 = sel, m2 = -INFINITY;
#pragma unroll
    for (int o = 1; o < 8; o <<= 1) {
        float p1 = __shfl_xor(m1, o), p2 = __shfl_xor(m2, o);
        float n1 = fmaxf(m1, p1), n2 = fmaxf(fminf(m1, p1), fmaxf(m2, p2));
        m1 = n1; m2 = n2;
    }
    const float gs = m1 + m2;
    const int grp = lane >> 3;
    int grank = 0;
#pragma unroll
    for (int g2 = 0; g2 < 8; ++g2) { float og = __uint_as_float(__builtin_amdgcn_readlane(__float_as_uint(gs), g2 * 8)); grank += (og > gs || (og == gs && g2 < grp)) ? 1 : 0; }
    const float val = grank < 4 ? sel : -INFINITY;
    int rank = 0;
#pragma unroll
    for (int e = 0; e < 64; ++e) { float ov = __uint_as_float(__builtin_amdgcn_readlane(__float_as_uint(val), e)); rank += (ov > val || (ov == val && e < lane)) ? 1 : 0; }
    const bool chosen = rank < 8;
    const float wsum = wave_sum(chosen ? score : 0.f);
    wt = score / wsum * 2.5f;
    return chosen;
}
template <bool DUMMY, int MODE = 0> __device__ __forceinline__ void ph_route(const MK& p, int bid, int nb, int tid_l) {
    int* cntp = p.cnt() + (DUMMY ? 128 : 0); int* tl = DUMMY ? (int*)(p.ws + 480 * MiB) : p.tok_list(); float* wl_ = DUMMY ? (float*)(p.ws + 488 * MiB) : p.wt_list(); int* tm = DUMMY ? (int*)(p.ws + 496 * MiB) : p.tokmap();
    const int tid = tid_l, wid = tid >> 6, lane = tid & 63, fr = lane & 15, fq = lane >> 4;
    float* lg = (float*)smem;
    int* wcnt = (int*)(smem + 34816);
    int* basel = wcnt + 128;
    bf16_t* H2lo = (bf16_t*)(p.ws + 325 * MiB);
    for (int item = bid; item < T / 128; item += nb) {
        const int t0 = item * 128 + wid * 16, b = (item * 128) / SEQ;
        const float* msh = p.mod() + (size_t)b * 6 * D + 3 * D; const float* msc = p.mod() + (size_t)b * 6 * D + 4 * D;
#pragma unroll 1
        for (int r0 = 0; r0 < 16; r0 += 4) {
            float4 xv[4][4];
#pragma unroll
            for (int rr = 0; rr < 4; ++rr)
#pragma unroll
                for (int q = 0; q < 4; ++q) xv[rr][q] = *(const float4*)(p.out + (size_t)(t0 + r0 + rr) * D + q * 256 + lane * 4);
#pragma unroll
            for (int rr = 0; rr < 4; ++rr) {
                float ss = 0.f;
#pragma unroll
                for (int q = 0; q < 4; ++q) ss += xv[rr][q].x * xv[rr][q].x + xv[rr][q].y * xv[rr][q].y + xv[rr][q].z * xv[rr][q].z + xv[rr][q].w * xv[rr][q].w;
                ss = wave_sum(ss);
                const float rstd = rsqrtf(ss * (1.0f / D) + EPS);
#pragma unroll
                for (int q = 0; q < 4; ++q) {
                    const int c0 = q * 256 + lane * 4;
                    const float4 gg = *(const float4*)(p.norm2_g + c0), sh = *(const float4*)(msh + c0), sc = *(const float4*)(msc + c0);
                    const float h0 = xv[rr][q].x * rstd * gg.x * (1 + sc.x) + sh.x, h1 = xv[rr][q].y * rstd * gg.y * (1 + sc.y) + sh.y;
                    const float h2v = xv[rr][q].z * rstd * gg.z * (1 + sc.z) + sh.z, h3 = xv[rr][q].w * rstd * gg.w * (1 + sc.w) + sh.w;
                    u32x2 wh, wl2; wh.x = cvtpk(h0, h1); wh.y = cvtpk(h2v, h3);
                    wl2.x = cvtpk(h0 - __uint_as_float(wh.x << 16), h1 - __uint_as_float(wh.x & 0xffff0000u));
                    wl2.y = cvtpk(h2v - __uint_as_float(wh.y << 16), h3 - __uint_as_float(wh.y & 0xffff0000u));
                    *(u32x2*)(p.H2() + (size_t)(t0 + r0 + rr) * D + c0) = wh;
                    *(u32x2*)(H2lo + (size_t)(t0 + r0 + rr) * D + c0) = wl2;
                }
            }
        }
        asm volatile("s_waitcnt vmcnt(0)" ::: "memory");
        __syncthreads();
        if (MODE == 3) continue;
        f32x4 acc[4];
#pragma unroll
        for (int nt = 0; nt < 4; ++nt) acc[nt] = (f32x4){0.f, 0.f, 0.f, 0.f};
        {
            const bf16_t* ah_p = p.H2() + (size_t)(t0 + fr) * D + fq * 8; const bf16_t* al_p = H2lo + (size_t)(t0 + fr) * D + fq * 8;
            const bf16_t* rT = p.routerT() + (size_t)fr * D + fq * 8;
#pragma unroll 4
            for (int ks = 0; ks < 32; ++ks) {
                const int k0 = ks * 32;
                const bf16x8 ah = ldfrag(ah_p + k0), al = ldfrag(al_p + k0);
#pragma unroll
                for (int nt = 0; nt < 4; ++nt) {
                    const bf16x8 bh = ldfrag(rT + (size_t)(nt * 16) * D + k0), bl = ldfrag(rT + (size_t)(64 + nt * 16) * D + k0);
                    acc[nt] = __builtin_amdgcn_mfma_f32_16x16x32_bf16(ah, bh, acc[nt], 0, 0, 0);
                    acc[nt] = __builtin_amdgcn_mfma_f32_16x16x32_bf16(ah, bl, acc[nt], 0, 0, 0);
                    acc[nt] = __builtin_amdgcn_mfma_f32_16x16x32_bf16(al, bh, acc[nt], 0, 0, 0);
                }
            }
        }
#pragma unroll
        for (int nt = 0; nt < 4; ++nt)
#pragma unroll
            for (int j = 0; j < 4; ++j) lg[(wid * 16 + fq * 4 + j) * 65 + nt * 16 + fr] = acc[nt][j];
        __syncthreads();
        if (MODE == 2) continue;
        float sc_[64]; unsigned long long ch = 0ull; float wscale = 0.f;
        const int tt = (wid & 1) * 64 + lane, t = item * 128 + tt;
        if (wid < 2) {
            float v[64];
#pragma unroll
            for (int e = 0; e < 64; ++e) { const float x = lg[tt * 65 + e]; sc_[e] = 1.0f / (1.0f + expf(-x)); v[e] = sc_[e] + p.router_b[e]; }
            float gs[8];
#pragma unroll
            for (int g = 0; g < 8; ++g) { float m1 = v[8 * g], m2 = -INFINITY;
#pragma unroll
                for (int i = 1; i < 8; ++i) { const float x = v[8 * g + i]; m2 = fmaxf(m2, fminf(m1, x)); m1 = fmaxf(m1, x); }
                gs[g] = m1 + m2; }
#pragma unroll
            for (int g = 0; g < 8; ++g) { int rank = 0;
#pragma unroll
                for (int g2 = 0; g2 < 8; ++g2) if (g2 != g) rank += (gs[g2] > gs[g] || (gs[g2] == gs[g] && g2 < g)) ? 1 : 0;
                if (rank >= 4) {
#pragma unroll
                    for (int i = 0; i < 8; ++i) v[8 * g + i] = -INFINITY; } }
#pragma unroll
            for (int it = 0; it < 8; ++it) {
                float m = v[0];
#pragma unroll
                for (int e = 1; e < 64; ++e) m = fmaxf(m, v[e]);
                bool found = false;
#pragma unroll
                for (int e = 0; e < 64; ++e) { const bool hit = !found && v[e] == m; if (hit) { ch |= (1ull << e); v[e] = -INFINITY; } found = found || hit; }
            }
            float wsum = 0.f;
#pragma unroll
            for (int e = 0; e < 64; ++e) wsum += ((ch >> e) & 1ull) ? sc_[e] : 0.f;
            wscale = 2.5f / wsum;
#pragma unroll
            for (int e = 0; e < 64; ++e) { const unsigned long long mk = __ballot((ch >> e) & 1ull); if (lane == 0) wcnt[wid * 64 + e] = __popcll(mk); }
        }
        __syncthreads();
        if (wid == 0) basel[lane] = atomicAdd(&cntp[lane], wcnt[lane] + wcnt[64 + lane]);
        __syncthreads();
        if (wid < 2) {
            int kidx = 0;
#pragma unroll
            for (int e = 0; e < 64; ++e) {
                const bool c = (ch >> e) & 1ull;
                const unsigned long long mk = __ballot(c);
                if (c) {
                    const int slot = basel[e] + (wid == 1 ? wcnt[e] : 0) + __popcll(mk & ((1ull << lane) - 1ull));
                    tl[(size_t)e * ECAP + slot] = t; wl_[(size_t)e * ECAP + slot] = sc_[e] * wscale;
                    tm[(size_t)t * 8 + kidx] = e * ECAP + slot; ++kidx;
                }
            }
        }
    }
}

constexpr int MOE_AUX = 131072;
__device__ __forceinline__ void moe_tables(const MK& p, int colt, int* tpre, int* rbase, int tid_l) {
    __syncthreads();
    if (tid_l == 0) { int tp = 0, rb = 0;
        for (int e = 0; e < 65; ++e) { const int c = e < 64 ? p.cnt()[e] : T; tpre[e] = tp; rbase[e] = rb; tp += ((c + 255) >> 8) * colt; rb += c; }
        tpre[65] = tp; rbase[65] = rb; }
    __syncthreads();
}
__device__ __forceinline__ void ph_moe_up(const MK& p, int bid, int nb, int tid_l) {
    const int tid = tid_l, wid = tid >> 6, lane = tid & 63, wr = wid >> 2, wc = wid & 3, fr = lane & 15, fq = lane >> 4;
    int* tpre = (int*)(smem + MOE_AUX); int* rbase = tpre + 80;
    moe_tables(p, 2, tpre, rbase, tid_l);
    const int ntiles = tpre[65];
    unsigned Ao[4], Bo[4];
    stage_offs(D * 2, Bo, tid_l);
    auto setupA = [&](int tile, int& e, int& rt, int& ct, int& cnt_e) {
        while (tile >= tpre[e + 1]) ++e;
        const int j = tile - tpre[e]; rt = j >> 1; ct = j & 1; cnt_e = rbase[e + 1] - rbase[e];
#pragma unroll
        for (int i = 0; i < 4; ++i) { int R, C; stage_rc(wid * 1024 + i * 8192 + lane * 16, R, C);
            int slot = rt * 256 + R; if (slot >= cnt_e) slot = 0;
            const int tok = e < 64 ? p.tok_list()[(size_t)e * ECAP + slot] : slot;
            Ao[i] = (unsigned)tok * (D * 2u) + (unsigned)C * 2u; }
    };
    bool pre = false;
    int e = 0, rt = 0, ct = 0, cnt_e = 0;
    if (bid < ntiles) setupA(bid, e, rt, ct, cnt_e);
    for (int tile = bid; tile < ntiles; tile += nb) {
        f32x4 acc[8][4];
        gemm_core((const char*)p.H2(), Ao, (const char*)(p.W13t() + ((size_t)e * 512 + ct * 256) * D), Bo, D / 64, acc, tid_l, pre);
        const int e_c = e, rt_c = rt, ct_c = ct, cnt_c = cnt_e;
        { const int nx = tile + nb; pre = nx < ntiles;
          if (pre) { setupA(nx, e, rt, ct, cnt_e); gemm_prefetch((const char*)p.H2(), Ao, (const char*)(p.W13t() + ((size_t)e * 512 + ct * 256) * D), Bo, tid_l); } }
#pragma unroll
        for (int m = 0; m < 8; ++m) {
            int ioff = m * 16; asm volatile("" : "+v"(ioff) :: "memory");
            const int slot = rt_c * 256 + wr * 128 + fr + ioff;
            if (slot < cnt_c) {
                bf16_t* dp = p.ACT() + (size_t)(rbase[e_c] + slot) * DE + ct_c * 128 + wc * 32 + fq * 4;
#pragma unroll
                for (int n = 0; n < 2; ++n) {
                    u32x2 w; w.x = cvtpk(siluf(acc[m][n][0]) * acc[m][n + 2][0], siluf(acc[m][n][1]) * acc[m][n + 2][1]);
                    w.y = cvtpk(siluf(acc[m][n][2]) * acc[m][n + 2][2], siluf(acc[m][n][3]) * acc[m][n + 2][3]);
                    *(u32x2*)(dp + n * 16) = w;
                }
            }
        }
    }
}
constexpr float Y_SCALE = 64.0f;
template <bool DUMMY> __device__ __forceinline__ void ph_moe_down(const MK& p, int bid, int nb, int tid_l) {
    const int tid = tid_l, wid = tid >> 6, lane = tid & 63, wr = wid >> 2, wc = wid & 3, fr = lane & 15, fq = lane >> 4;
    int* tpre = (int*)(smem + MOE_AUX); int* rbase = tpre + 80;
    moe_tables(p, 4, tpre, rbase, tid_l);
    const int ntiles = DUMMY ? tpre[64] : tpre[65];
    unsigned Ao[4], Bo[4];
    stage_offs(DE * 2, Ao, tid_l); stage_offs(DE * 2, Bo, tid_l);
    bool pre = false;
    int e = 0;
    for (int tile = bid; tile < ntiles; tile += nb) {
        while (tile >= tpre[e + 1]) ++e;
        const int j = tile - tpre[e], rt = j >> 2, ct = j & 3, cnt_e = rbase[e + 1] - rbase[e];
        f32x4 acc[8][4];
        gemm_core((const char*)(p.ACT() + (size_t)(rbase[e] + rt * 256) * DE), Ao, (const char*)(p.W2t() + ((size_t)e * D + ct * 256) * DE), Bo, DE / 64, acc, tid_l, pre);
        { const int nx = tile + nb; pre = nx < ntiles;
          if (pre) { int e2 = e; while (nx >= tpre[e2 + 1]) ++e2; const int j2 = nx - tpre[e2], rt2 = j2 >> 2, ct2 = j2 & 3;
              gemm_prefetch((const char*)(p.ACT() + (size_t)(rbase[e2] + rt2 * 256) * DE), Ao, (const char*)(p.W2t() + ((size_t)e2 * D + ct2 * 256) * DE), Bo, tid_l); } }
        const int col0 = ct * 256 + wc * 64 + fq * 4;
        if (e < 64) {
            const float* wl = p.wt_list() + (size_t)e * ECAP;
            unsigned char* yb = p.Y() + (size_t)rbase[e] * D + col0;
            float wv[8];
#pragma unroll
            for (int m = 0; m < 8; ++m) { const int sl = rt * 256 + wr * 128 + fr + m * 16; wv[m] = wl[sl < cnt_e ? sl : 0] * Y_SCALE; }
#pragma unroll
            for (int m = 0; m < 8; ++m) {
                int ioff = m * 16; asm volatile("" : "+v"(ioff) :: "memory");
                const int slot = rt * 256 + wr * 128 + fr + ioff;
                if (slot < cnt_e) {
                    const float w = wv[m];
                    unsigned char* dp = yb + (size_t)slot * D;
#pragma unroll
                    for (int n = 0; n < 4; ++n) {
                        float v0 = fminf(fmaxf(acc[m][n][0] * w, -448.f), 448.f), v1 = fminf(fmaxf(acc[m][n][1] * w, -448.f), 448.f);
                        float v2 = fminf(fmaxf(acc[m][n][2] * w, -448.f), 448.f), v3 = fminf(fmaxf(acc[m][n][3] * w, -448.f), 448.f);
                        int pk = 0; pk = __builtin_amdgcn_cvt_pk_fp8_f32(v0, v1, pk, false); pk = __builtin_amdgcn_cvt_pk_fp8_f32(v2, v3, pk, true);
                        *(int*)(dp + n * 16) = pk;
                    }
                }
            }
        } else {
            const float* g2 = p.mod() + (size_t)((rt * 256) / SEQ) * 6 * D + 5 * D + col0;
            float4 gv[4];
#pragma unroll
            for (int n = 0; n < 4; ++n) gv[n] = *(const float4*)(g2 + n * 16);
            float* xb = p.out + (size_t)(rt * 256) * D + col0;
#pragma unroll
            for (int m = 0; m < 8; ++m) {
                int ioff = m * 16; asm volatile("" : "+v"(ioff) :: "memory");
                float* xp = xb + (size_t)(wr * 128 + fr + ioff) * D;
#pragma unroll
                for (int n = 0; n < 4; ++n) {
                    float4 xv = *(float4*)(xp + n * 16);
                    xv.x += gv[n].x * acc[m][n][0]; xv.y += gv[n].y * acc[m][n][1]; xv.z += gv[n].z * acc[m][n][2]; xv.w += gv[n].w * acc[m][n][3];
                    *(float4*)(xp + n * 16) = xv;
                }
            }
        }
    }
}

template <bool DUMMY> __device__ __forceinline__ void ph_final(const MK& p, int bid, int nb, int tid_l) {
    const int wid = tid_l >> 6, lane = tid_l & 63;
    int* tpre = (int*)(smem + MOE_AUX); int* rbase = tpre + 80;
    moe_tables(p, 1, tpre, rbase, tid_l);
    for (int t = bid * 8 + wid; t < T; t += nb * 8) {
        const int b = t / SEQ;
        float f[16];
#pragma unroll
        for (int i = 0; i < 16; ++i) f[i] = 0.f;
#pragma unroll
        for (int k = 0; k < 8; ++k) {
            const int id = p.tokmap()[(size_t)t * 8 + k], e = id >> 15, slot = id & (ECAP - 1);
            const unsigned char* yr = p.Y() + (size_t)(rbase[e] + slot) * D + lane * 4;
#pragma unroll
            for (int q = 0; q < 4; ++q) {
                const int w = *(const int*)(yr + q * 256);
                const auto lo = __builtin_amdgcn_cvt_pk_f32_fp8(w, false); const auto hi = __builtin_amdgcn_cvt_pk_f32_fp8(w, true);
                f[q * 4 + 0] += lo[0]; f[q * 4 + 1] += lo[1]; f[q * 4 + 2] += hi[0]; f[q * 4 + 3] += hi[1];
            }
        }
        const float* g2 = p.mod() + (size_t)b * 6 * D + 5 * D + lane * 4;
        float* xo = p.out + (size_t)t * D + lane * 4;
        float v[16]; float ss = 0.f;
#pragma unroll
        for (int q = 0; q < 4; ++q) {
            const float4 xv = *(const float4*)(xo + q * 256), g = *(const float4*)(g2 + q * 256);
            v[q * 4 + 0] = xv.x + g.x * f[q * 4 + 0] * (1.0f / Y_SCALE); v[q * 4 + 1] = xv.y + g.y * f[q * 4 + 1] * (1.0f / Y_SCALE);
            v[q * 4 + 2] = xv.z + g.z * f[q * 4 + 2] * (1.0f / Y_SCALE); v[q * 4 + 3] = xv.w + g.w * f[q * 4 + 3] * (1.0f / Y_SCALE);
            ss += v[q * 4] * v[q * 4] + v[q * 4 + 1] * v[q * 4 + 1] + v[q * 4 + 2] * v[q * 4 + 2] + v[q * 4 + 3] * v[q * 4 + 3];
        }
        ss = wave_sum(ss);
        const float rstd = rsqrtf(ss * (1.0f / D) + EPS);
#pragma unroll
        for (int q = 0; q < 4; ++q) {
            const float4 gf = *(const float4*)(p.final_g + q * 256 + lane * 4);
            *(float4*)((DUMMY ? (float*)(p.ws + 42 * MiB) + (size_t)t * D + lane * 4 : xo) + q * 256) = make_float4(v[q * 4] * rstd * gf.x, v[q * 4 + 1] * rstd * gf.y, v[q * 4 + 2] * rstd * gf.z, v[q * 4 + 3] * rstd * gf.w);
        }
    }
}


#define XB_TMO      128
#define XB_XCNT(j)  (256  + 64 * (j))
#define XB_XSUB(j)  (1280 + 64 * (j))
#define XB_XGEN(j)  (2304 + 64 * (j))
#define XB_TOP      3328
#define XB_TOPGEN   3392
#define XCD_BAR_WORDS 3456
#define XB_SPIN_CAP (1u << 22)
#define LAS __attribute__((address_space(3)))
__device__ __forceinline__ unsigned xb_ld(unsigned* p)              { return __hip_atomic_load(p, __ATOMIC_RELAXED, __HIP_MEMORY_SCOPE_AGENT); }
__device__ __forceinline__ unsigned xb_add(unsigned* p, unsigned v) { return __hip_atomic_fetch_add(p, v, __ATOMIC_RELAXED, __HIP_MEMORY_SCOPE_AGENT); }
__device__ __forceinline__ unsigned xb_xcc_id() { return (unsigned)__builtin_amdgcn_s_getreg((3 << 11) | 20) & 0xFu; }
#define XB_SPIN(cond, bar) do { unsigned _sp = 0; while (cond) { __builtin_amdgcn_s_sleep(1); \
    if ((++_sp & 255u) == 0u) { if (xb_ld(&(bar)[XB_TMO])) break; if (_sp > XB_SPIN_CAP) { atomicAdd(&(bar)[XB_TMO], 1u); break; } } } } while (0)
struct XcdBarrier { unsigned* bar; unsigned x; volatile LAS unsigned* st; };
__device__ __forceinline__ XcdBarrier xcd_barrier_post(unsigned* bar, volatile LAS unsigned* st, int tid) {
    XcdBarrier b; b.bar = bar; b.x = xb_xcc_id(); b.st = st;
    if (tid == 0) (void)xb_add(&bar[XB_XCNT(b.x)], 1u);
    return b;
}
__device__ __forceinline__ void xcd_barrier_complete(unsigned* bar, unsigned x, unsigned& nloc, unsigned& nx) {
    const unsigned G = gridDim.x * gridDim.y * gridDim.z;
    unsigned sum, cnt, mine, sp = 0u;
    for (;;) {
        sum = 0u; cnt = 0u; mine = 0u;
#pragma unroll
        for (unsigned j = 0; j < 16; ++j) { const unsigned c = xb_ld(&bar[XB_XCNT(j)]); sum += c; cnt += (c > 0u) ? 1u : 0u; mine = (j == x) ? c : mine; }
        if (sum == G) break;
        __builtin_amdgcn_s_sleep(1);
        if ((++sp & 255u) == 0u) { if (xb_ld(&bar[XB_TMO])) break; if (sp > XB_SPIN_CAP) { atomicAdd(&bar[XB_TMO], 1u); break; } }
    }
    nloc = mine > 0u ? mine : 1u; nx = cnt > 0u ? cnt : 1u;
}
__device__ __forceinline__ void xcd_barrier(const XcdBarrier& b, int tid) {
    asm volatile("s_waitcnt vmcnt(0)" ::: "memory");
    __syncthreads();
    if (tid == 0) {
        unsigned* bar = b.bar;
        __builtin_amdgcn_s_waitcnt(0);
        unsigned nloc = b.st[0], nx = b.st[1];
        if (nloc == 0u) { xcd_barrier_complete(bar, b.x, nloc, nx); b.st[0] = nloc; b.st[1] = nx; }
        const unsigned old = xb_add(&bar[XB_XSUB(b.x)], 1u);
        const unsigned gen = old / nloc;
        if (old + 1u == (gen + 1u) * nloc) {
            __builtin_amdgcn_fence(__ATOMIC_RELEASE, "agent");
            asm volatile("s_waitcnt vmcnt(0)" ::: "memory");
            const unsigned og = xb_add(&bar[XB_TOP], 1u);
            const unsigned tg = og / nx;
            if (og + 1u == (tg + 1u) * nx) xb_add(&bar[XB_TOPGEN], 1u);
            else XB_SPIN(xb_ld(&bar[XB_TOPGEN]) == tg, bar);
            __builtin_amdgcn_fence(__ATOMIC_ACQUIRE, "agent");
            xb_add(&bar[XB_XGEN(b.x)], 1u);
            asm volatile("s_waitcnt vmcnt(0)" ::: "memory");
        } else {
            XB_SPIN(xb_ld(&bar[XB_XGEN(b.x)]) == gen, bar);
            __builtin_amdgcn_fence(__ATOMIC_ACQUIRE, "agent");
            asm volatile("s_waitcnt vmcnt(0)" ::: "memory");
        }
    }
    __syncthreads();
}

__global__ __launch_bounds__(512, 2) void k_mega(MK p) {
    cg::grid_group grid = cg::this_grid();
    const int bid = blockIdx.x, nb = gridDim.x;
    volatile LAS unsigned* xst = (volatile LAS unsigned*)(smem + 131072 + 768);
    if (threadIdx.x < 4) xst[threadIdx.x] = 0u;
    __syncthreads();
    const XcdBarrier xb = xcd_barrier_post((unsigned*)(p.ws + 524288), xst, (int)threadIdx.x);
#define PH_TID() int t_ = threadIdx.x; asm volatile("" : "+v"(t_))
    { PH_TID(); if (bid == 0 && t_ < 256) p.cnt()[t_] = 0; ph_mod(p, bid, nb, t_); ph_convert(p, bid, nb, t_); }
#if DUP == 10
    { PH_TID(); ph_convert(p, bid, nb, t_); }
#endif
    grid.sync();
    { PH_TID(); ph_ln1(p, bid, nb, t_); }
#if DUP == 1
    { PH_TID(); ph_ln1(p, bid, nb, t_); }
#endif
    xcd_barrier(xb, (int)threadIdx.x);
    { PH_TID(); ph_gemm_in(p, bid, nb, t_); }
#if DUP == 2
    { PH_TID(); ph_gemm_in(p, bid, nb, t_); }
#endif
    xcd_barrier(xb, (int)threadIdx.x);
    { PH_TID(); ph_attn(p, bid, nb, t_); }
#if DUP == 3
    { PH_TID(); ph_attn(p, bid, nb, t_); }
#endif
    { PH_TID(); ph_kv(p, bid, nb, t_); }
#if DUP == 11
    { PH_TID(); ph_kv(p, bid, nb, t_); }
#endif
    xcd_barrier(xb, (int)threadIdx.x);
    { PH_TID(); ph_scan(p, bid, nb, t_); }
    xcd_barrier(xb, (int)threadIdx.x);
    { PH_TID(); ph_ret(p, bid, nb, t_); }
#if DUP == 5
    { PH_TID(); ph_ret(p, bid, nb, t_); }
#endif
    xcd_barrier(xb, (int)threadIdx.x);
    { PH_TID(); ph_gemm_out(p, bid, nb, t_); }
#if DUP == 6
    { PH_TID(); ph_gemm_out(p, bid, nb, t_); }
#endif
    xcd_barrier(xb, (int)threadIdx.x);
#if DUP == 7
    { PH_TID(); ph_route<true>(p, bid, nb, t_); }
#endif
#if DUP == 72
    { PH_TID(); ph_route<true, 2>(p, bid, nb, t_); }
#endif
#if DUP == 73
    { PH_TID(); ph_route<true, 3>(p, bid, nb, t_); }
#endif
    { PH_TID(); ph_route<false>(p, bid, nb, t_); }
    xcd_barrier(xb, (int)threadIdx.x);
    { PH_TID(); ph_moe_up(p, bid, nb, t_); }
#if DUP == 8
    { PH_TID(); ph_moe_up(p, bid, nb, t_); }
#endif
    xcd_barrier(xb, (int)threadIdx.x);
#if DUP == 9
    { PH_TID(); ph_moe_down<true>(p, bid, nb, t_); }
#endif
    { PH_TID(); ph_moe_down<false>(p, bid, nb, t_); }
    xcd_barrier(xb, (int)threadIdx.x);
#if DUP == 13
    { PH_TID(); ph_final<true>(p, bid, nb, t_); }
#endif
    { PH_TID(); ph_final<false>(p, bid, nb, t_); }
#undef PH_TID
}
constexpr int LDS_TOTAL = 132096;
extern "C" void kernel_launch(void* const* d_in, const int* in_sizes, int n_in, void* d_out, int out_size, void* d_ws, size_t ws_size, hipStream_t stream) {
    char* ws = (char*)d_ws;
    MK mk{};
    mk.x = (const float*)d_in[0]; mk.c = (const float*)d_in[1]; mk.ctx = (const float*)d_in[2]; mk.cctx = (const float*)d_in[3]; mk.ada_w = (const float*)d_in[4]; mk.ada_b = (const float*)d_in[5];
    mk.norm1_g = (const float*)d_in[6]; mk.w_in = (const float*)d_in[7]; mk.lq1 = (const float*)d_in[8]; mk.lk1 = (const float*)d_in[9]; mk.lq2 = (const float*)d_in[10]; mk.lk2 = (const float*)d_in[11];
    mk.dattn_g = (const float*)d_in[12]; mk.dec_f = (const float*)d_in[13]; mk.dec_b = (const float*)d_in[14]; mk.ret_g = (const float*)d_in[15]; mk.w_out = (const float*)d_in[16];
    mk.norm2_g = (const float*)d_in[17]; mk.router_w = (const float*)d_in[18]; mk.router_b = (const float*)d_in[19]; mk.ew1 = (const float*)d_in[20]; mk.ew3 = (const float*)d_in[21];
    mk.ew2 = (const float*)d_in[22]; mk.sw1 = (const float*)d_in[23]; mk.sw3 = (const float*)d_in[24]; mk.sw2 = (const float*)d_in[25]; mk.final_g = (const float*)d_in[26];
    mk.out = (float*)d_out;
    mk.ws = ws;
    mk.dbgP = nullptr; mk.dbg_lo = 0; mk.dbg_hi = 12; mk.conv_limit = 1 << 30;
    static int grid_blocks = 0;
    if (!grid_blocks) {
        (void)hipFuncSetAttribute((const void*)k_mega, hipFuncAttributeMaxDynamicSharedMemorySize, LDS_TOTAL);
        int dev = 0, cus = 0, per_cu = 0;
        (void)hipGetDevice(&dev);
        (void)hipDeviceGetAttribute(&cus, hipDeviceAttributeMultiprocessorCount, dev);
        (void)hipOccupancyMaxActiveBlocksPerMultiprocessor(&per_cu, k_mega, 512, LDS_TOTAL);
        if (per_cu > 1) per_cu = 1;
        grid_blocks = cus * per_cu;
        if (grid_blocks <= 0) { fprintf(stderr, "occupancy query failed: cus %d per_cu %d\n", cus, per_cu); grid_blocks = 256; }
    }
    (void)hipMemsetAsync(ws + 524288, 0, XCD_BAR_WORDS * 4, stream);
    void* args[] = {&mk};
    hipError_t e = hipLaunchCooperativeKernel((void*)k_mega, dim3(grid_blocks), dim3(512), args, LDS_TOTAL, stream);
    if (e != hipSuccess) fprintf(stderr, "cooperative launch failed: %s (grid %d)\n", hipGetErrorString(e), grid_blocks);
}
```

```cpp
#include <hip/hip_runtime.h>
#include <hip/hip_cooperative_groups.h>
#include <cstdio>
namespace cg = cooperative_groups;
#ifndef DUP
#define DUP 0
#endif
#include <stdint.h>

constexpr int D = 1024, NB = 4, SEQ = 8192, CTX = 256, RB = SEQ + CTX  , NR = NB * RB  , T = NB * SEQ;
constexpr int NE = 64, DE = 256, ECAP = 32768;
constexpr float EPS = 1e-6f;
typedef unsigned short bf16_t;

__device__ __forceinline__ float siluf(float v) { return v / (1.0f + expf(-v)); }
__device__ __forceinline__ float wave_sum(float v) {
#pragma unroll
    for (int o = 32; o > 0; o >>= 1) v += __shfl_xor(v, o);
    return v;
}
__device__ __forceinline__ float wave_max(float v) {
#pragma unroll
    for (int o = 32; o > 0; o >>= 1) v = fmaxf(v, __shfl_xor(v, o));
    return v;
}
__device__ __forceinline__ float block_sum(float v, float* red) {
    v = wave_sum(v);
    __syncthreads();
    if ((threadIdx.x & 63) == 0) red[threadIdx.x >> 6] = v;
    __syncthreads();
    return red[0] + red[1] + red[2] + red[3];
}
__device__ __forceinline__ float block_max(float v, float* red) {
    v = wave_max(v);
    __syncthreads();
    if ((threadIdx.x & 63) == 0) red[threadIdx.x >> 6] = v;
    __syncthreads();
    return fmaxf(fmaxf(red[0], red[1]), fmaxf(red[2], red[3]));
}

typedef short bf16x8 __attribute__((ext_vector_type(8)));
typedef short s16x4 __attribute__((ext_vector_type(4)));
typedef float f32x4 __attribute__((ext_vector_type(4)));
typedef float f32x16 __attribute__((ext_vector_type(16)));
typedef unsigned u32x2 __attribute__((ext_vector_type(2)));
typedef unsigned u32x4 __attribute__((ext_vector_type(4)));
extern __shared__ __attribute__((aligned(1024))) char smem[];
constexpr int NTHR = 512;
constexpr int GEMM_LDS = 131072;

__device__ __forceinline__ unsigned cvtpk(float lo, float hi) { unsigned r; asm volatile("v_cvt_pk_bf16_f32 %0, %1, %2" : "=v"(r) : "v"(lo), "v"(hi)); return r; }
__device__ __forceinline__ bf16_t f2bf(float v) { return (bf16_t)(cvtpk(v, v) & 0xffffu); }
__device__ __forceinline__ float bf2f(bf16_t v) { return __uint_as_float(((unsigned)v) << 16); }

constexpr size_t MiB = 1048576;
struct MK {
    const float *x, *c, *ctx, *cctx, *ada_w, *ada_b, *norm1_g, *w_in, *lq1, *lk1, *lq2, *lk2, *dattn_g, *dec_f, *dec_b, *ret_g, *w_out, *norm2_g, *router_w, *router_b,
        *ew1, *ew3, *ew2, *sw1, *sw3, *sw2, *final_g;
    float* out; char* ws;
    float* dbgP; long dbg_lo, dbg_hi; long conv_limit;
#define WSF(name, type, off) __device__ __forceinline__ type* name() const { return (type*)(ws + (off)); }
    WSF(mod, float, 0) WSF(cnt, int, 131072) WSF(ropec, float, 262144) WSF(ropes, float, 262144 + 8192)
    WSF(w_inT, bf16_t, 1 * MiB) WSF(w_outT, bf16_t, 7 * MiB) WSF(routerT, bf16_t, 9 * MiB) WSF(W2t, bf16_t, 9 * MiB + 524288)
    WSF(H, bf16_t, 42 * MiB) WSF(MIX, bf16_t, 42 * MiB) WSF(KV, bf16_t, 112 * MiB) WSF(ST, bf16_t, 147 * MiB) WSF(ACT, bf16_t, 42 * MiB)
    WSF(W13t, bf16_t, 194 * MiB) WSF(H2, bf16_t, 260 * MiB)
    WSF(Q, bf16_t, 260 * MiB) WSF(K, bf16_t, 292 * MiB) WSF(V, bf16_t, 325 * MiB) WSF(RQ, bf16_t, 358 * MiB) WSF(RK, bf16_t, 375 * MiB)
    WSF(KTf, bf16_t, 392 * MiB) WSF(KTb, bf16_t, 409 * MiB) WSF(VT, bf16_t, 426 * MiB) WSF(RG, bf16_t, 459 * MiB)
    WSF(Y, unsigned char, 194 * MiB) WSF(tok_list, int, 452 * MiB) WSF(wt_list, float, 460 * MiB) WSF(tokmap, int, 468 * MiB)
#undef WSF
};

__device__ __forceinline__ void ph_mod(const MK& p, int bid, int nb, int tid_l) {
    float* red = (float*)smem;
    for (int it = bid; it < 6 * D / 32; it += nb) {
        const int col = tid_l & 31, kg = tid_l >> 5, j = it * 32 + col;
        float a[5] = {0, 0, 0, 0, 0};
        for (int k = kg * 64; k < kg * 64 + 64; ++k) {
            float w = p.ada_w[(size_t)k * 6 * D + j];
#pragma unroll
            for (int r = 0; r < 5; ++r) { float cv = r < 4 ? p.c[r * D + k] : p.cctx[k]; a[r] += siluf(cv) * w; }
        }
        __syncthreads();
#pragma unroll
        for (int r = 0; r < 5; ++r) red[(kg * 5 + r) * 32 + col] = a[r];
        __syncthreads();
        if (tid_l < 160) {
            int r = tid_l >> 5; float s = 0;
            for (int g = 0; g < 16; ++g) s += red[(g * 5 + r) * 32 + col];
            p.mod()[(size_t)r * 6 * D + j] = s + p.ada_b[j];
        }
    }
    if (bid == nb - 1) {
        for (int i = tid_l; i < 128 * 16; i += NTHR) {
            int pos = i >> 4, f = i & 15;
            float inv_freq = (float)pow(10000.0, -(double)f / 16.0);
            float s, c; sincosf((float)pos * inv_freq, &s, &c);
            p.ropec()[i] = c; p.ropes()[i] = s;
        }
    }
    __syncthreads();
}

__device__ __forceinline__ void tr_tile(const float* src, int ldsrc, int k0, int n0, bf16_t* dst, int lddst, int mode  , bf16_t* dst2, int tid_l) {
    float* t = (float*)smem;
    __syncthreads();
    for (int i = tid_l; i < 64 * 16; i += NTHR) {
        int r = i >> 4, c4 = (i & 15) * 4;
        float4 v = *(const float4*)(src + (size_t)(k0 + r) * ldsrc + n0 + c4);
        t[r * 65 + c4] = v.x; t[r * 65 + c4 + 1] = v.y; t[r * 65 + c4 + 2] = v.z; t[r * 65 + c4 + 3] = v.w;
    }
    __syncthreads();
    for (int i = tid_l; i < 64 * 16; i += NTHR) {
        int n = i >> 4, k4 = (i & 15) * 4;
        float a = t[(k4 + 0) * 65 + n], b = t[(k4 + 1) * 65 + n], c = t[(k4 + 2) * 65 + n], d = t[(k4 + 3) * 65 + n];
        int nn = n0 + n, row = nn;
        if (mode == 1 || mode == 2) { int ct = nn >> 7, wc = (nn & 127) >> 5, within = nn & 31; row = ct * 256 + wc * 64 + (mode == 2 ? 32 : 0) + within; }
        u32x2 w; w.x = cvtpk(a, b); w.y = cvtpk(c, d);
        *(u32x2*)(dst + (size_t)row * lddst + k0 + k4) = w;
        if (mode == 3) {
            float ah = bf2f((bf16_t)(w.x & 0xffff)), bh = bf2f((bf16_t)(w.x >> 16)), ch = bf2f((bf16_t)(w.y & 0xffff)), dh = bf2f((bf16_t)(w.y >> 16));
            u32x2 l; l.x = cvtpk(a - ah, b - bh); l.y = cvtpk(c - ch, d - dh);
            *(u32x2*)(dst2 + (size_t)row * lddst + k0 + k4) = l;
        }
    }
}
__device__ __forceinline__ void ph_convert(const MK& p, int bid, int nb, int tid_l) {
    const int n_win = 16 * 48, n_wout = 16 * 16, n_rt = 16, n_e13 = 65 * 2 * 16 * 4, n_e2 = 65 * 4 * 16;
    int total = n_win + n_wout + n_rt + n_e13 + n_e2; if (p.conv_limit < total) total = (int)p.conv_limit;
    for (int it = bid; it < total; it += nb) {
        int j = it;
        if (j < n_win) { tr_tile(p.w_in, 3072, (j / 48) * 64, (j % 48) * 64, p.w_inT(), 1024, 0, nullptr, tid_l); continue; } j -= n_win;
        if (j < n_wout) { tr_tile(p.w_out, 1024, (j / 16) * 64, (j % 16) * 64, p.w_outT(), 1024, 0, nullptr, tid_l); continue; } j -= n_wout;
        if (j < n_rt) { tr_tile(p.router_w, 64, j * 64, 0, p.routerT(), 1024, 3, p.routerT() + 64 * 1024, tid_l); continue; } j -= n_rt;
        if (j < n_e13) {
            int e = j / 128, r = j % 128, which = r / 64, tt = r % 64;
            const float* src = e < 64 ? (which ? p.ew3 : p.ew1) + (size_t)e * D * DE : (which ? p.sw3 : p.sw1);
            tr_tile(src, DE, (tt / 4) * 64, (tt % 4) * 64, p.W13t() + (size_t)e * 512 * 1024, 1024, 1 + which, nullptr, tid_l); continue; } j -= n_e13;
        { int e = j / 64, tt = j % 64;
          const float* src = e < 64 ? p.ew2 + (size_t)e * DE * D : p.sw2;
          tr_tile(src, D, (tt / 16) * 64, (tt % 16) * 64, p.W2t() + (size_t)e * 1024 * 256, 256, 0, nullptr, tid_l); }
    }
    __syncthreads();
}

__device__ __forceinline__ void ph_ln1(const MK& p, int bid, int nb, int tid_l) {
    const int wid = tid_l >> 6, lane = tid_l & 63;
    for (int R = bid * 8 + wid; R < NR; R += nb * 8) {
        int b = R / RB, i = R % RB;
        const float* src = i < CTX ? p.ctx + ((size_t)b * CTX + i) * D : p.x + ((size_t)b * SEQ + (i - CTX)) * D;
        const float* m = p.mod() + (size_t)(i < CTX ? 4 : b) * 6 * D;
        float4 v[4]; float ss = 0;
#pragma unroll
        for (int q = 0; q < 4; ++q) { v[q] = *(const float4*)(src + q * 256 + lane * 4); ss += v[q].x * v[q].x + v[q].y * v[q].y + v[q].z * v[q].z + v[q].w * v[q].w; }
        ss = wave_sum(ss);
        float rstd = rsqrtf(ss * (1.0f / D) + EPS);
#pragma unroll
        for (int q = 0; q < 4; ++q) {
            int c0 = q * 256 + lane * 4;
            float4 gg = *(const float4*)(p.norm1_g + c0), sh = *(const float4*)(m + c0), sc = *(const float4*)(m + D + c0);
            float o0 = v[q].x * rstd * gg.x * (1 + sc.x) + sh.x, o1 = v[q].y * rstd * gg.y * (1 + sc.y) + sh.y;
            float o2 = v[q].z * rstd * gg.z * (1 + sc.z) + sh.z, o3 = v[q].w * rstd * gg.w * (1 + sc.w) + sh.w;
            u32x2 w; w.x = cvtpk(o0, o1); w.y = cvtpk(o2, o3);
            *(u32x2*)(p.H() + (size_t)R * D + c0) = w;
        }
    }
}

__device__ __forceinline__ int lds_byte(int r, int c) { int st = (r >> 4) * 2 + (c >> 5), ob = (r & 15) * 64 + (c & 31) * 2; return st * 1024 + (ob ^ (((ob >> 9) & 1) << 5)); }
__device__ __forceinline__ void stage_rc(int b, int& R, int& C) { int st = b >> 10, sb = b & 1023, swz = sb ^ (((sb >> 9) & 1) << 5); R = (st / 2) * 16 + swz / 64; C = (st % 2) * 32 + (swz % 64) / 2; }
#define WAIT_V0() asm volatile("s_waitcnt vmcnt(0)" ::: "memory")
__device__ __forceinline__ void gemm_core(const char* Abase, const unsigned (&Ao)[4], const char* Bbase, const unsigned (&Bo)[4], int nt, f32x4 (&acc)[8][4], int tid_l, bool pre) {
    const int tid = tid_l, wid = tid >> 6, lane = tid & 63, wr = wid >> 2, wc = wid & 3, fr = lane & 15, fq = lane >> 4;
#pragma unroll
    for (int m = 0; m < 8; ++m)
#pragma unroll
        for (int n = 0; n < 4; ++n) acc[m][n] = (f32x4){0.f, 0.f, 0.f, 0.f};
#define G_SA(b) (smem + (b) * 32768)
#define G_SB(b) (smem + 65536 + (b) * 32768)
#define G_STAGE(buf, kt) do { _Pragma("unroll") for (int i = 0; i < 4; ++i) {                                                     \
        __builtin_amdgcn_global_load_lds((const unsigned*)(Abase + (Ao[i] + (unsigned)(kt) * 128u)), (unsigned*)(G_SA(buf) + wid * 1024 + i * 8192), 16, 0, 0); \
        __builtin_amdgcn_global_load_lds((const unsigned*)(Bbase + (Bo[i] + (unsigned)(kt) * 128u)), (unsigned*)(G_SB(buf) + wid * 1024 + i * 8192), 16, 0, 0); } } while (0)
    if (!pre) G_STAGE(0, 0);
    WAIT_V0(); __syncthreads();
#define G_KSTEP(cur, t) do {                                                                                                   \
        if ((t) + 1 < nt) G_STAGE((cur) ^ 1, (t) + 1);                                                                          \
        _Pragma("unroll") for (int ks = 0; ks < 2; ++ks) {                                                                      \
            bf16x8 At[8], Bf[4];                                                                                                \
            _Pragma("unroll") for (int m = 0; m < 8; ++m) At[m] = *(const bf16x8*)(G_SA(cur) + lds_byte(wr * 128 + m * 16 + fr, ks * 32 + fq * 8)); \
            _Pragma("unroll") for (int n = 0; n < 4; ++n) Bf[n] = *(const bf16x8*)(G_SB(cur) + lds_byte(wc * 64 + n * 16 + fr, ks * 32 + fq * 8));  \
            _Pragma("unroll") for (int m = 0; m < 8; ++m) _Pragma("unroll") for (int n = 0; n < 4; ++n)                         \
                acc[m][n] = __builtin_amdgcn_mfma_f32_16x16x32_bf16(Bf[n], At[m], acc[m][n], 0, 0, 0);                          \
            __builtin_amdgcn_sched_barrier(0);                                                                                  \
        }                                                                                                                       \
        WAIT_V0(); __syncthreads(); } while (0)
#pragma unroll 1
    for (int t = 0; t < nt; ++t) { const int cur = t & 1; G_KSTEP(cur, t); }
}
#ifndef XPREFETCH
#define XPREFETCH 0
#endif
__device__ __forceinline__ void gemm_prefetch(const char* Abase, const unsigned (&Ao)[4], const char* Bbase, const unsigned (&Bo)[4], int tid_l) {
    const int wid = tid_l >> 6;
    G_STAGE(0, 0);
}
__device__ __forceinline__ void stage_offs(unsigned ld_bytes, unsigned (&P)[4], int tid_l) {
    const int wid = tid_l >> 6, lane = tid_l & 63;
#pragma unroll
    for (int i = 0; i < 4; ++i) { int R, C; stage_rc(wid * 1024 + i * 8192 + lane * 16, R, C); P[i] = (unsigned)R * ld_bytes + (unsigned)C * 2u; }
}

constexpr int WAREA = 18432;
__device__ __forceinline__ char* wave_area(int wid) { return smem + wid * WAREA; }

__device__ __forceinline__ void ph_gemm_in(const MK& p, int bid, int nb, int tid_l) {
    const int nM = NR / 256, nN = 12;
    unsigned Ao[4], Bo[4];
    stage_offs(D * 2, Ao, tid_l); stage_offs(D * 2, Bo, tid_l);
    bool pre = false;
    for (int tile = bid; tile < nM * nN; tile += nb) {
        const int pm = tile / nN, pn = tile % nN;
        const int brow = pm * 256, bcol = pn * 256;
        f32x4 acc[8][4];
        gemm_core((const char*)(p.H() + (size_t)brow * D), Ao, (const char*)(p.w_inT() + (size_t)bcol * D), Bo, D / 64, acc, tid_l, pre);
        { const int nx = tile + nb; pre = XPREFETCH && nx < nM * nN;
          if (pre) gemm_prefetch((const char*)(p.H() + (size_t)((nx / nN) * 256) * D), Ao, (const char*)(p.w_inT() + (size_t)((nx % nN) * 256) * D), Bo, tid_l); }
        int tid_e = tid_l; asm volatile("" : "+v"(tid_e));
        const int wid = tid_e >> 6, lane = tid_e & 63, wr = wid >> 2, wc = wid & 3, fr = lane & 15, fq = lane >> 4;
        const int b = brow / RB, i0 = brow % RB;
        const bool lat = i0 >= CTX;
        const int seg = pn;
        const bool do_rope = lat && (seg <= 3 || seg == 6 || seg == 7);
        const int cw = bcol + wc * 64;
        const int iw = i0 + wr * 128;
        if (do_rope) {
            float4 c0, s0, c1, s1;
            { const int t0_ = iw + fr - CTX, prow = t0_ >> 6, pcol = t0_ & 63;
              c0 = *(const float4*)(p.ropec() + prow * 16 + fq * 4); s0 = *(const float4*)(p.ropes() + prow * 16 + fq * 4);
              c1 = *(const float4*)(p.ropec() + pcol * 16 + fq * 4); s1 = *(const float4*)(p.ropes() + pcol * 16 + fq * 4); }
#pragma unroll
            for (int m = 0; m < 8; ++m) {
                int ioff = m * 16; asm volatile("" : "+v"(ioff) :: "memory");
                float4 nc0, ns0, nc1, ns1;
                if (m < 7) { const int tn = iw + fr + ioff + 16 - CTX, prow = tn >> 6, pcol = tn & 63;
                    nc0 = *(const float4*)(p.ropec() + prow * 16 + fq * 4); ns0 = *(const float4*)(p.ropes() + prow * 16 + fq * 4);
                    nc1 = *(const float4*)(p.ropec() + pcol * 16 + fq * 4); ns1 = *(const float4*)(p.ropes() + pcol * 16 + fq * 4); }
                const float cc0[4] = {c0.x, c0.y, c0.z, c0.w}, ss0[4] = {s0.x, s0.y, s0.z, s0.w}, cc1[4] = {c1.x, c1.y, c1.z, c1.w}, ss1[4] = {s1.x, s1.y, s1.z, s1.w};
#pragma unroll
                for (int j = 0; j < 4; ++j) {
                    const float x1 = acc[m][0][j], x2 = acc[m][1][j]; acc[m][0][j] = x1 * cc0[j] - x2 * ss0[j]; acc[m][1][j] = x1 * ss0[j] + x2 * cc0[j];
                    const float y1 = acc[m][2][j], y2 = acc[m][3][j]; acc[m][2][j] = y1 * cc1[j] - y2 * ss1[j]; acc[m][3][j] = y1 * ss1[j] + y2 * cc1[j];
                }
                if (m < 7) { c0 = nc0; s0 = ns0; c1 = nc1; s1 = ns1; }
            }
        }
        if (seg == 7) {
#pragma unroll
            for (int m = 0; m < 8; ++m)
#pragma unroll
                for (int n = 0; n < 4; ++n) acc[m][n] = acc[m][n] * 0.125f;
        }
        char* wa = wave_area(wid);
        if (seg <= 7 || seg >= 10) {
#pragma unroll
            for (int m = 0; m < 8; ++m)
#pragma unroll
                for (int n = 0; n < 4; ++n) { u32x2 w; w.x = cvtpk(acc[m][n][0], acc[m][n][1]); w.y = cvtpk(acc[m][n][2], acc[m][n][3]);
                    *(u32x2*)(wa + (m * 16 + fr) * 144 + n * 32 + fq * 8) = w; }
            asm volatile("s_waitcnt lgkmcnt(0)" ::: "memory");
            const int chunk = lane & 7, rsub = lane >> 3;
            bf16_t* base; long rstride; bool ok = true;
            if (seg <= 1)      { const int h = cw >> 7;          base = p.Q() + (((size_t)(b * 4 + h) * SEQ + (iw - CTX)) * 128 + (cw & 127));        rstride = 128; ok = lat; }
            else if (seg <= 3) { const int h = (cw - 512) >> 7;  base = p.K() + (((size_t)(b * 4 + h) * RB + iw) * 128 + ((cw - 512) & 127));          rstride = 128; }
            else if (seg <= 5) { const int h = (cw - 1024) >> 7; base = p.V() + (((size_t)(b * 4 + h) * RB + iw) * 128 + ((cw - 1024) & 127));         rstride = 128; }
            else if (seg == 6) {                                base = p.RQ() + ((size_t)(b * 4 + wc) * RB + iw) * 64;                                 rstride = 64; }
            else if (seg == 7) {                                base = p.RK() + ((size_t)(b * 4 + wc) * RB + iw) * 64;                                 rstride = 64; }
            else               {                                base = p.RG() + ((size_t)(b * SEQ + (iw - CTX)) * 512 + (cw - 2560));                  rstride = 512; ok = lat; }
            if (ok) {
#pragma unroll 4
                for (int it = 0; it < 16; ++it) { const int row = it * 8 + rsub;
                    *(u32x4*)(base + (long)row * rstride + chunk * 8) = *(const u32x4*)(wa + row * 144 + chunk * 16); }
            }
        }
        if (seg >= 7 && seg <= 9) {
            const int npass = seg == 7 ? 2 : 1;
            float lg2 = 0.f;
#pragma unroll 1
            for (int ps = 0; ps < npass; ++ps) {
                if (seg == 7) { const float dv = ps == 0 ? p.dec_f[wc] : p.dec_b[wc]; lg2 = log2f(1.0f / (1.0f + expf(-dv))); }
                asm volatile("s_waitcnt lgkmcnt(0)" ::: "memory");
#pragma unroll
                for (int m = 0; m < 8; ++m) {
                    float f = 1.0f;
                    if (seg == 7) { const int pos = (iw + m * 16 + fr) & 127; f = exp2f((float)(ps == 0 ? 127 - pos : pos) * lg2); }
#pragma unroll
                    for (int n = 0; n < 4; ++n)
#pragma unroll
                        for (int j = 0; j < 4; ++j) *(bf16_t*)(wa + (n * 16 + fq * 4 + j) * 272 + (m * 16 + fr) * 2) = f2bf(acc[m][n][j] * f);
                }
                asm volatile("s_waitcnt lgkmcnt(0)" ::: "memory");
                const int chunk = lane & 15, csub = lane >> 4;
                bf16_t* base;
                if (seg == 7) base = (ps == 0 ? p.KTf() : p.KTb()) + ((size_t)(b * 4 + wc) * 64) * RB + iw;
                else { const int h = (cw - 2048) >> 7, e0 = (cw - 2048) & 127; base = p.VT() + ((size_t)(b * 4 + h) * 128 + e0) * RB + iw; }
#pragma unroll 4
                for (int it = 0; it < 16; ++it) { const int col = it * 4 + csub;
                    *(u32x4*)(base + (size_t)col * RB + chunk * 8) = *(const u32x4*)(wa + col * 272 + chunk * 16); }
            }
        }
        __syncthreads();
    }
}


constexpr int A_KVBLK = 64;
constexpr float A_SCALE = 0.125f, A_THR = 8.f;
constexpr int A_SHM_V = A_KVBLK * 128 * 2, A_SHM_K = A_KVBLK * 128 * 2;
#define KSWZ(row, colB) ((row) * 256 + ((colB) ^ (((row) & 7) << 4)))
#define SBAR() __builtin_amdgcn_sched_barrier(0)
__device__ __forceinline__ int crow(int r, int hi) { return (r & 3) + 8 * (r >> 2) + 4 * hi; }

__device__ __forceinline__ void partialSM(f32x16& p0, f32x16& p1, float& m_reg, float& mn, float& alpha) {
    constexpr float C = A_SCALE * 1.4426950408889634f;
    float pmax = p0[0];
#pragma unroll
    for (int r = 1; r < 16; ++r) pmax = fmaxf(pmax, p0[r]);
#pragma unroll
    for (int r = 0; r < 16; ++r) pmax = fmaxf(pmax, p1[r]);
    { auto rr = __builtin_amdgcn_permlane32_swap(__float_as_uint(pmax), __float_as_uint(pmax), false, false);
      pmax = fmaxf(__uint_as_float(rr[0]), __uint_as_float(rr[1])); }
    if (__builtin_expect(__all(pmax - m_reg <= A_THR / A_SCALE), 1)) { mn = m_reg; alpha = 1.f; }
    else { mn = fmaxf(m_reg, pmax); alpha = __builtin_amdgcn_exp2f((m_reg - mn) * C); m_reg = mn; }
    float mnC = -mn * C;
#pragma unroll
    for (int r = 0; r < 16; ++r) p0[r] = fmaf(p0[r], C, mnC);
#pragma unroll
    for (int r = 0; r < 16; ++r) p1[r] = fmaf(p1[r], C, mnC);
#pragma unroll
    for (int r = 0; r < 16; ++r) p0[r] = __builtin_amdgcn_exp2f(p0[r]);
}
#define PK4(P, BASE, OUT) do { unsigned a0 = cvtpk(P[BASE + 0], P[BASE + 1]), a1 = cvtpk(P[BASE + 2], P[BASE + 3]);   \
    unsigned b0 = cvtpk(P[BASE + 4], P[BASE + 5]), b1 = cvtpk(P[BASE + 6], P[BASE + 7]);                              \
    auto r0 = __builtin_amdgcn_permlane32_swap(a0, b0, false, false); auto r1 = __builtin_amdgcn_permlane32_swap(a1, b1, false, false); \
    u32x4 w = {r0[0], r1[0], r0[1], r1[1]}; OUT = *reinterpret_cast<bf16x8*>(&w); } while (0)
__device__ __forceinline__ void finishSM(f32x16& p0, f32x16& p1, float alpha, float& l_reg, bf16x8& pa0, bf16x8& pa1, bf16x8& pa2, bf16x8& pa3) {
#pragma unroll
    for (int r = 0; r < 16; ++r) p1[r] = __builtin_amdgcn_exp2f(p1[r]);
    float ps = 0;
#pragma unroll
    for (int r = 0; r < 16; ++r) ps += p0[r];
#pragma unroll
    for (int r = 0; r < 16; ++r) ps += p1[r];
    { auto rr = __builtin_amdgcn_permlane32_swap(__float_as_uint(ps), __float_as_uint(ps), false, false);
      ps = __uint_as_float(rr[0]) + __uint_as_float(rr[1]); }
    l_reg = l_reg * alpha + ps;
    PK4(p0, 0, pa0); PK4(p0, 8, pa1); PK4(p1, 0, pa2); PK4(p1, 8, pa3);
}
__device__ __forceinline__ void qkt(f32x16& p0, f32x16& p1, const char* Ks, const bf16x8* qr, int r32, int hi, int mapc) {
    p0 = f32x16{}; p1 = f32x16{};
#pragma unroll
    for (int d0 = 0; d0 < 4; ++d0) { int cb = (mapc + d0 * 16 + hi * 8) * 2;
        bf16x8 b0 = *reinterpret_cast<const bf16x8*>(Ks + KSWZ(r32, cb));
        bf16x8 b1 = *reinterpret_cast<const bf16x8*>(Ks + KSWZ(32 + r32, cb));
        p0 = __builtin_amdgcn_mfma_f32_32x32x16_bf16(b0, qr[d0], p0, 0, 0, 0);
        p1 = __builtin_amdgcn_mfma_f32_32x32x16_bf16(b1, qr[d0], p1, 0, 0, 0); }
}
__device__ __forceinline__ int v_st(int k, int c) { const int kk = (k & ~0xC) | ((k & 4) << 1) | ((k & 8) >> 1); return ((kk >> 3) * 4 + (c >> 5)) * 512 + ((kk & 7) * 32 + (c & 31)) * 2; }
__device__ __forceinline__ int v_rd_base(int lane) { return ((lane & 3) << 3) | (((lane >> 2) & 3) << 6) | (((lane >> 4) & 1) << 5) | (((lane >> 5) & 1) << 8); }
constexpr int v_rd_off(int d0, int ks, int half) { return d0 * 512 + ks * 4096 + half * 2048; }
template <int OFF> __device__ __forceinline__ s16x4 tr_read(int vb) {
    s16x4 r; asm volatile("ds_read_b64_tr_b16 %0, %1 offset:%2" : "=&v"(r) : "v"(vb), "i"(OFF) : "memory"); return r;
}
template <int D0> __device__ __forceinline__ void pv_one(f32x16& od, int vb, bf16x8 pa0, bf16x8 pa1, bf16x8 pa2, bf16x8 pa3) {
    const s16x4 l0 = tr_read<v_rd_off(D0, 0, 0)>(vb), h0 = tr_read<v_rd_off(D0, 0, 1)>(vb), l1 = tr_read<v_rd_off(D0, 1, 0)>(vb), h1 = tr_read<v_rd_off(D0, 1, 1)>(vb);
    const s16x4 l2 = tr_read<v_rd_off(D0, 2, 0)>(vb), h2 = tr_read<v_rd_off(D0, 2, 1)>(vb), l3 = tr_read<v_rd_off(D0, 3, 0)>(vb), h3 = tr_read<v_rd_off(D0, 3, 1)>(vb);
    asm volatile("s_waitcnt lgkmcnt(0)" ::: "memory"); SBAR();
#define PKV(L, H) (bf16x8){L[0], L[1], L[2], L[3], H[0], H[1], H[2], H[3]}
    od = __builtin_amdgcn_mfma_f32_32x32x16_bf16(pa0, PKV(l0, h0), od, 0, 0, 0);
    od = __builtin_amdgcn_mfma_f32_32x32x16_bf16(pa1, PKV(l1, h1), od, 0, 0, 0);
    od = __builtin_amdgcn_mfma_f32_32x32x16_bf16(pa2, PKV(l2, h2), od, 0, 0, 0);
    od = __builtin_amdgcn_mfma_f32_32x32x16_bf16(pa3, PKV(l3, h3), od, 0, 0, 0);
}
__device__ __forceinline__ void pv_d0(f32x16* o, int vb, bf16x8 pa0, bf16x8 pa1, bf16x8 pa2, bf16x8 pa3) {
    pv_one<0>(o[0], vb, pa0, pa1, pa2, pa3); pv_one<1>(o[1], vb, pa0, pa1, pa2, pa3); pv_one<2>(o[2], vb, pa0, pa1, pa2, pa3); pv_one<3>(o[3], vb, pa0, pa1, pa2, pa3);
}

__device__ __forceinline__ void attn_item(const bf16_t* __restrict__ Qb, const bf16_t* __restrict__ Kh, const bf16_t* __restrict__ Vh, bf16_t* __restrict__ mixrow,
                                          const float* __restrict__ gd, float lam, int tid_l) {
    char* lds = smem;
    const int tid = tid_l, wid = tid >> 6, lane = tid & 63, r32 = lane & 31, hi = lane >> 5;
    const int map = wid >> 2, wq = wid & 3, mapc = map * 64;
    char* V_lds = lds; char* K_lds = lds + 2 * A_SHM_V;
    float* wsw = (float*)(lds + 2 * A_SHM_V + 2 * A_SHM_K) + wid * 64; float* li_l = wsw; float* al_l = wsw + 32;
    float m_reg = -1e30f, l_reg = 0; f32x16 o[4] = {}; bf16x8 qr[4];
    const bf16_t* Qw = Qb + (long)(wq * 32 + r32) * 128 + mapc + hi * 8;
#pragma unroll
    for (int d0 = 0; d0 < 4; ++d0) qr[d0] = *reinterpret_cast<const bf16x8*>(Qw + d0 * 16);
    const int sr = tid >> 4, sc = (tid & 15) * 8, vst0 = v_st(sr, sc), vst1 = v_st(32 + sr, sc);
    const int vb0 = (int)(uintptr_t)V_lds + v_rd_base(lane);
    struct { bf16x8 vs0, vs1, ks0, ks1; } sr_[1];
#define SLOAD(i, k0) do { sr_[i].vs0 = *(const bf16x8*)(&Vh[(long)((k0) + sr) * 128 + sc]); sr_[i].vs1 = *(const bf16x8*)(&Vh[(long)((k0) + 32 + sr) * 128 + sc]); \
    sr_[i].ks0 = *(const bf16x8*)(&Kh[(long)((k0) + sr) * 128 + sc]); sr_[i].ks1 = *(const bf16x8*)(&Kh[(long)((k0) + 32 + sr) * 128 + sc]); } while (0)
#define SWRITE(b, i) do { *(bf16x8*)(V_lds + (b) * A_SHM_V + vst0) = sr_[i].vs0;          \
    *(bf16x8*)(V_lds + (b) * A_SHM_V + vst1) = sr_[i].vs1; int kc = sc * 2;               \
    *(bf16x8*)(K_lds + (b) * A_SHM_K + KSWZ(sr, kc)) = sr_[i].ks0;                       \
    *(bf16x8*)(K_lds + (b) * A_SHM_K + KSWZ(32 + sr, kc)) = sr_[i].ks1; } while (0)
#define SWAIT() asm volatile("s_waitcnt vmcnt(0)" ::: "memory")
#define RESC(a) do { if (__any((a) < 1.f)) { if (hi == 0) al_l[r32] = (a); asm volatile("s_waitcnt lgkmcnt(0)" ::: "memory"); \
    _Pragma("unroll") for (int d = 0; d < 4; ++d) _Pragma("unroll") for (int r = 0; r < 16; ++r) o[d][r] *= al_l[crow(r, hi)]; } } while (0)
    f32x16 pA0, pA1, pB0, pB1; float mnA, mnB, alA, alB; bf16x8 pa0, pa1, pa2, pa3; const int NT = RB / A_KVBLK;
    constexpr int SE = 0, SO = 0;
    SLOAD(SE, 0); asm volatile("s_waitcnt vmcnt(0)" ::: "memory"); SWRITE(0, SE); __syncthreads();
    qkt(pA0, pA1, K_lds, qr, r32, hi, mapc); partialSM(pA0, pA1, m_reg, mnA, alA);
    SLOAD(SO, A_KVBLK);
    SWAIT(); SWRITE(1, SO); __syncthreads();
    for (int j = 1; j + 1 < NT; j += 2) {
        SBAR(); qkt(pB0, pB1, K_lds + A_SHM_K, qr, r32, hi, mapc);
        finishSM(pA0, pA1, alA, l_reg, pa0, pa1, pa2, pa3); SBAR();
        SLOAD(SO, (j + 1) * A_KVBLK); SBAR();
        pv_d0(o, vb0, pa0, pa1, pa2, pa3); partialSM(pB0, pB1, m_reg, mnB, alB);
        __syncthreads(); SWAIT(); SWRITE(0, SE);
        RESC(alB); __syncthreads();
        SBAR(); qkt(pA0, pA1, K_lds, qr, r32, hi, mapc);
        finishSM(pB0, pB1, alB, l_reg, pa0, pa1, pa2, pa3); SBAR();
        SLOAD(SE, (j + 2) * A_KVBLK); SBAR();
        pv_d0(o, vb0 + A_SHM_V, pa0, pa1, pa2, pa3); partialSM(pA0, pA1, m_reg, mnA, alA);
        __syncthreads(); SWAIT(); SWRITE(1, SO);
        RESC(alA); __syncthreads();
    }
    SBAR(); qkt(pB0, pB1, K_lds + A_SHM_K, qr, r32, hi, mapc);
    finishSM(pA0, pA1, alA, l_reg, pa0, pa1, pa2, pa3); SBAR();
    pv_d0(o, vb0, pa0, pa1, pa2, pa3); partialSM(pB0, pB1, m_reg, mnB, alB);
    __syncthreads(); RESC(alB);
    finishSM(pB0, pB1, alB, l_reg, pa0, pa1, pa2, pa3); SBAR();
    pv_d0(o, vb0 + A_SHM_V, pa0, pa1, pa2, pa3);
    if (hi == 0) li_l[r32] = l_reg;
    asm volatile("s_waitcnt lgkmcnt(0)" ::: "memory");
    float rl[16];
#pragma unroll
    for (int r = 0; r < 16; ++r) rl[r] = __builtin_amdgcn_rcpf(li_l[crow(r, hi)]);
    __syncthreads();
    {
        float* xo = (float*)lds + map * 16384 + (wq * 32) * 128 + r32;
#pragma unroll
        for (int r = 0; r < 16; ++r)
#pragma unroll
            for (int d0 = 0; d0 < 4; ++d0) xo[crow(r, hi) * 128 + d0 * 32] = o[d0][r] * rl[r];
    }
    __syncthreads();
    {
        const float g0 = gd[lane * 2], g1 = gd[lane * 2 + 1];
#pragma unroll 4
        for (int rr = 0; rr < 16; ++rr) {
            const int row = wid * 16 + rr;
            const float2 a0 = *(const float2*)((const float*)lds + row * 128 + lane * 2), a1 = *(const float2*)((const float*)lds + 16384 + row * 128 + lane * 2);
            const float xv = a0.x - lam * a1.x, yv = a0.y - lam * a1.y;
            const float ss = wave_sum(xv * xv + yv * yv);
            const float rs = rsqrtf(ss * (1.0f / 128) + EPS) * 0.8f;
            *(unsigned*)(mixrow + (long)row * 1024 + lane * 2) = cvtpk(xv * rs * g0, yv * rs * g1);
        }
    }
    __syncthreads();
#undef SLOAD
#undef SWRITE
#undef SWAIT
#undef RESC
}

__device__ __forceinline__ void ph_attn(const MK& p, int bid, int nb, int tid_l) {
    const int lane = tid_l & 63;
    float s1 = wave_sum(p.lq1[lane] * p.lk1[lane]), s2 = wave_sum(p.lq2[lane] * p.lk2[lane]);
    const float lam = expf(s1) - expf(s2) + 0.2f;
    const int nrounds = (1024 + nb - 1) / nb;
    for (int rr = 0; rr < nrounds; ++rr) {
        int item;
        if (nb == 256) { int x = bid & 7, j = bid >> 3, hh = rr * 8 + x; item = (hh >> 1) * 64 + (hh & 1) * 32 + j; }
        else { item = rr * nb + bid; if (item >= 1024) break; }
        const int bh = item >> 6, qb = item & 63, b = bh >> 2, h = bh & 3;
        attn_item(p.Q() + ((size_t)bh * SEQ + qb * 128) * 128, p.K() + (size_t)bh * RB * 128, p.V() + (size_t)bh * RB * 128,
                  p.MIX() + ((size_t)(b * SEQ + qb * 128)) * 1024 + h * 128, p.dattn_g, lam, tid_l);
    }
}


__device__ __forceinline__ bf16x8 ldfrag(const bf16_t* p) { return *reinterpret_cast<const bf16x8*>(p); }

__device__ __forceinline__ void ph_kv(const MK& p, int bid, int nb, int tid_l) {
    const int wid = tid_l >> 6, lane = tid_l & 63, r32 = lane & 31, hi = lane >> 5;
    const int nitems = 16 * 2 * 66;
    for (int it = bid * 8 + wid; it < nitems; it += nb * 8) {
        const int c = it % 66, chain = it / 66, dir = chain & 1, bh = chain >> 1;
        const bf16_t* vt = p.VT() + (size_t)bh * 128 * RB + c * 128 + hi * 8;
        const bf16_t* kt = (dir ? p.KTb() : p.KTf()) + (size_t)bh * 64 * RB + c * 128 + hi * 8;
        f32x16 acc[4][2];
#pragma unroll
        for (int mt = 0; mt < 4; ++mt) { acc[mt][0] = f32x16{}; acc[mt][1] = f32x16{}; }
#pragma unroll 2
        for (int ks = 0; ks < 8; ++ks) {
            bf16x8 a[4], b[2];
#pragma unroll
            for (int mt = 0; mt < 4; ++mt) a[mt] = ldfrag(vt + (size_t)(mt * 32 + r32) * RB + ks * 16);
#pragma unroll
            for (int nt = 0; nt < 2; ++nt) b[nt] = ldfrag(kt + (size_t)(nt * 32 + r32) * RB + ks * 16);
#pragma unroll
            for (int mt = 0; mt < 4; ++mt)
#pragma unroll
                for (int nt = 0; nt < 2; ++nt) acc[mt][nt] = __builtin_amdgcn_mfma_f32_32x32x16_bf16(a[mt], b[nt], acc[mt][nt], 0, 0, 0);
        }
        bf16_t* dst = p.KV() + (size_t)it * 8192;
#pragma unroll
        for (int mt = 0; mt < 4; ++mt)
#pragma unroll
            for (int nt = 0; nt < 2; ++nt)
#pragma unroll
                for (int r = 0; r < 16; ++r) dst[(mt * 32 + crow(r, hi)) * 64 + nt * 32 + r32] = f2bf(acc[mt][nt][r]);
    }
}

__device__ __forceinline__ void ph_scan(const MK& p, int bid, int nb, int tid_l) {
    for (int e = bid * NTHR + tid_l; e < 32 * 8192; e += nb * NTHR) {
        const int chain = e >> 13, el = e & 8191, dir = chain & 1, bh = chain >> 1, h = bh & 3;
        const float d = dir ? p.dec_b[h] : p.dec_f[h];
        const float g128 = exp2f(128.0f * log2f(1.0f / (1.0f + expf(-d))));
        const bf16_t* kv = p.KV() + (size_t)chain * 66 * 8192 + el;
        bf16_t* st = p.ST() + (size_t)chain * 66 * 8192 + el;
        float S = 0.f;
        for (int n = 0; n < 66; ++n) {
            const int c = dir == 0 ? n : (n == 0 ? 1 : (n == 1 ? 0 : 67 - n));
            st[(size_t)c * 8192] = f2bf(S);
            S = fmaf(g128, S, bf2f(kv[(size_t)c * 8192]));
        }
    }
}

__device__ __forceinline__ void ph_ret(const MK& p, int bid, int nb, int tid_l) {
    const int tid = tid_l, wid = tid >> 6, lane = tid & 63, r32 = lane & 31, hi = lane >> 5, wq = wid & 3, half = wid >> 2;
    float* img = (float*)smem;
    for (int it = bid; it < 4 * 64 * 2; it += nb) {
        const int hp = it & 1, lc = (it >> 1) & 63, b = it >> 7, h = hp * 2 + half, bh = b * 4 + h;
        const int ib = CTX + lc * 128, c = 2 + lc;
        const float lf = log2f(1.0f / (1.0f + expf(-p.dec_f[h]))), lb = log2f(1.0f / (1.0f + expf(-p.dec_b[h])));
        const bf16_t* rq = p.RQ() + ((size_t)bh * RB + ib + wq * 32 + r32) * 64 + hi * 8;
        bf16x8 q[4];
#pragma unroll
        for (int ks = 0; ks < 4; ++ks) q[ks] = ldfrag(rq + ks * 16);
        f32x16 o[4];
        {
            const bf16_t* stf = p.ST() + ((size_t)(bh * 2 + 0) * 66 + c) * 8192 + hi * 8;
            const bf16_t* stb = p.ST() + ((size_t)(bh * 2 + 1) * 66 + c) * 8192 + hi * 8;
            {
                float rf[16];
#pragma unroll
                for (int r = 0; r < 16; ++r) rf[r] = __builtin_amdgcn_exp2f((float)(wq * 32 + crow(r, hi) + 1) * lf);
#pragma unroll
                for (int d0 = 0; d0 < 4; ++d0) {
                    f32x16 tf = f32x16{};
#pragma unroll
                    for (int ks = 0; ks < 4; ++ks) tf = __builtin_amdgcn_mfma_f32_32x32x16_bf16(q[ks], ldfrag(stf + (size_t)(d0 * 32 + r32) * 64 + ks * 16), tf, 0, 0, 0);
#pragma unroll
                    for (int r = 0; r < 16; ++r) o[d0][r] = tf[r] * rf[r];
                    asm volatile("" ::: "memory");
                }
            }
            {
                float rf[16];
#pragma unroll
                for (int r = 0; r < 16; ++r) rf[r] = __builtin_amdgcn_exp2f((float)(128 - (wq * 32 + crow(r, hi))) * lb);
#pragma unroll
                for (int d0 = 0; d0 < 4; ++d0) {
                    f32x16 tb = f32x16{};
#pragma unroll
                    for (int ks = 0; ks < 4; ++ks) tb = __builtin_amdgcn_mfma_f32_32x32x16_bf16(q[ks], ldfrag(stb + (size_t)(d0 * 32 + r32) * 64 + ks * 16), tb, 0, 0, 0);
#pragma unroll
                    for (int r = 0; r < 16; ++r) o[d0][r] += tb[r] * rf[r];
                    asm volatile("" ::: "memory");
                }
            }
        }
        {
            const int qi = wq * 32 + r32;
            const bf16_t* vt = p.VT() + (size_t)bh * 128 * RB + ib + hi * 8;
#pragma unroll 1
            for (int jb = 0; jb < 4; ++jb) {
                asm volatile("" ::: "memory");
                const bf16_t* rk = p.RK() + ((size_t)bh * RB + ib + jb * 32 + r32) * 64 + hi * 8;
                f32x16 pp = f32x16{};
#pragma unroll
                for (int ks = 0; ks < 4; ++ks) pp = __builtin_amdgcn_mfma_f32_32x32x16_bf16(ldfrag(rk + ks * 16), q[ks], pp, 0, 0, 0);
#pragma unroll
                for (int r = 0; r < 16; ++r) {
                    const int dd = qi - (jb * 32 + crow(r, hi));
                    const float ex = __builtin_amdgcn_exp2f(dd > 0 ? (float)dd * lf : (float)(-dd) * lb); const float w = dd == 0 ? 2.0f : ex;
                    pp[r] *= w;
                }
                bf16x8 pa0, pa1;
                PK4(pp, 0, pa0); PK4(pp, 8, pa1);
#pragma unroll
                for (int d0 = 0; d0 < 4; ++d0) {
                    o[d0] = __builtin_amdgcn_mfma_f32_32x32x16_bf16(pa0, ldfrag(vt + (size_t)(d0 * 32 + r32) * RB + jb * 32), o[d0], 0, 0, 0);
                    o[d0] = __builtin_amdgcn_mfma_f32_32x32x16_bf16(pa1, ldfrag(vt + (size_t)(d0 * 32 + r32) * RB + jb * 32 + 16), o[d0], 0, 0, 0);
                }
            }
        }
        __syncthreads();
        {
            float* xo = img + half * 16384 + (wq * 32) * 128 + r32;
#pragma unroll
            for (int r = 0; r < 16; ++r)
#pragma unroll
                for (int d0 = 0; d0 < 4; ++d0) xo[crow(r, hi) * 128 + d0 * 32] = o[d0][r];
        }
        __syncthreads();
        {
            const float g0 = p.ret_g[lane * 2], g1 = p.ret_g[lane * 2 + 1];
#pragma unroll 4
            for (int rr = 0; rr < 32; ++rr) {
                const int row = wid * 32 + rr, itl = row >> 7, rw = row & 127, hh = hp * 2 + itl;
                const float2 a = *(const float2*)(img + row * 128 + lane * 2);
                const float ss = wave_sum(a.x * a.x + a.y * a.y);
                const float rs = rsqrtf(ss * (1.0f / 128) + EPS);
                const size_t tt = (size_t)b * SEQ + lc * 128 + rw;
                const unsigned gg = *(const unsigned*)(p.RG() + tt * 512 + hh * 128 + lane * 2);
                const float ga = bf2f((bf16_t)(gg & 0xffff)), gb = bf2f((bf16_t)(gg >> 16));
                *(unsigned*)(p.MIX() + tt * 1024 + 512 + hh * 128 + lane * 2) = cvtpk(siluf(ga) * a.x * rs * g0, siluf(gb) * a.y * rs * g1);
            }
        }
    }
}


__device__ __forceinline__ void ph_gemm_out(const MK& p, int bid, int nb, int tid_l) {
    unsigned Ao[4], Bo[4];
    stage_offs(D * 2, Ao, tid_l); stage_offs(D * 2, Bo, tid_l);
    bool pre = false;
    for (int tile = bid; tile < (T / 256) * 4; tile += nb) {
        const int pm = tile >> 2, pn = tile & 3, brow = pm * 256, bcol = pn * 256;
        f32x4 acc[8][4];
        gemm_core((const char*)(p.MIX() + (size_t)brow * D), Ao, (const char*)(p.w_outT() + (size_t)bcol * D), Bo, D / 64, acc, tid_l, pre);
        { const int nx = tile + nb; pre = XPREFETCH && nx < (T / 256) * 4;
          if (pre) gemm_prefetch((const char*)(p.MIX() + (size_t)((nx >> 2) * 256) * D), Ao, (const char*)(p.w_outT() + (size_t)((nx & 3) * 256) * D), Bo, tid_l); }
        int tid_e = tid_l; asm volatile("" : "+v"(tid_e));
        const int wid = tid_e >> 6, lane = tid_e & 63, wr = wid >> 2, wc = wid & 3, fr = lane & 15, fq = lane >> 4;
        const float* g1 = p.mod() + (size_t)(brow / SEQ) * 6 * D + 2 * D + bcol + wc * 64 + fq * 4;
        float4 gv[4], xv[4];
        const size_t o0 = (size_t)(brow + wr * 128 + fr) * D + bcol + wc * 64 + fq * 4;
#pragma unroll
        for (int n = 0; n < 4; ++n) { gv[n] = *(const float4*)(g1 + n * 16); xv[n] = *(const float4*)(p.x + o0 + n * 16); }
#pragma unroll
        for (int m = 0; m < 8; ++m) {
            int ioff = m * 16; asm volatile("" : "+v"(ioff) :: "memory");
            const size_t o = o0 + (size_t)ioff * D;
            float4 xn[4];
            if (m < 7) {
#pragma unroll
                for (int n = 0; n < 4; ++n) xn[n] = *(const float4*)(p.x + o + (size_t)16 * D + n * 16);
            }
#pragma unroll
            for (int n = 0; n < 4; ++n)
                *(float4*)(p.out + o + n * 16) = make_float4(xv[n].x + gv[n].x * acc[m][n][0], xv[n].y + gv[n].y * acc[m][n][1], xv[n].z + gv[n].z * acc[m][n][2], xv[n].w + gv[n].w * acc[m][n][3]);
            if (m < 7) {
#pragma unroll
                for (int n = 0; n < 4; ++n) xv[n] = xn[n];
            }
        }
    }
}

__device__ __forceinline__ bool route_token(float logit, float bias, int lane, float& wt) {
    const float score = 1.0f / (1.0f + expf(-logit));
    const float sel = score + bias;
    float m1 = sel, m2 = -INFINITY;
#pragma unroll
    for (int o = 1; o < 8; o <<= 1) {
        float p1 = __shfl_xor(m1, o), p2 = __shfl_xor(m2, o);
        float n1 = fmaxf(m1, p1), n2 = fmaxf(fminf(m1, p1), fmaxf(m2, p2));
        m1 = n1; m2 = n2;
    }
    const float gs = m1 + m2;
    const int grp = lane >> 3;
    int grank = 0;
#pragma unroll
    for (int g2 = 0; g2 < 8; ++g2) { float og = __uint_as_float(__builtin_amdgcn_readlane(__float_as_uint(gs), g2 * 8)); grank += (og > gs || (og == gs && g2 < grp)) ? 1 : 0; }
    const float val = grank < 4 ? sel : -INFINITY;
    int rank = 0;
#pragma unroll
    for (int e = 0; e < 64; ++e) { float ov = __uint_as_float(__builtin_amdgcn_readlane(__float_as_uint(val), e)); rank += (ov > val || (ov == val && e < lane)) ? 1 : 0; }
    const bool chosen = rank < 8;
    const float wsum = wave_sum(chosen ? score : 0.f);
    wt = score / wsum * 2.5f;
    return chosen;
}
template <bool DUMMY, int MODE = 0> __device__ __forceinline__ void ph_route(const MK& p, int bid, int nb, int tid_l) {
    int* cntp = p.cnt() + (DUMMY ? 128 : 0); int* tl = DUMMY ? (int*)(p.ws + 480 * MiB) : p.tok_list(); float* wl_ = DUMMY ? (float*)(p.ws + 488 * MiB) : p.wt_list(); int* tm = DUMMY ? (int*)(p.ws + 496 * MiB) : p.tokmap();
    const int tid = tid_l, wid = tid >> 6, lane = tid & 63, fr = lane & 15, fq = lane >> 4;
    float* lg = (float*)smem;
    int* wcnt = (int*)(smem + 34816);
    int* basel = wcnt + 128;
    bf16_t* H2lo = (bf16_t*)(p.ws + 325 * MiB);
    for (int item = bid; item < T / 128; item += nb) {
        const int t0 = item * 128 + wid * 16, b = (item * 128) / SEQ;
        const float* msh = p.mod() + (size_t)b * 6 * D + 3 * D; const float* msc = p.mod() + (size_t)b * 6 * D + 4 * D;
#pragma unroll 1
        for (int r0 = 0; r0 < 16; r0 += 4) {
            float4 xv[4][4];
#pragma unroll
            for (int rr = 0; rr < 4; ++rr)
#pragma unroll
                for (int q = 0; q < 4; ++q) xv[rr][q] = *(const float4*)(p.out + (size_t)(t0 + r0 + rr) * D + q * 256 + lane * 4);
#pragma unroll
            for (int rr = 0; rr < 4; ++rr) {
                float ss = 0.f;
#pragma unroll
                for (int q = 0; q < 4; ++q) ss += xv[rr][q].x * xv[rr][q].x + xv[rr][q].y * xv[rr][q].y + xv[rr][q].z * xv[rr][q].z + xv[rr][q].w * xv[rr][q].w;
                ss = wave_sum(ss);
                const float rstd = rsqrtf(ss * (1.0f / D) + EPS);
#pragma unroll
                for (int q = 0; q < 4; ++q) {
                    const int c0 = q * 256 + lane * 4;
                    const float4 gg = *(const float4*)(p.norm2_g + c0), sh = *(const float4*)(msh + c0), sc = *(const float4*)(msc + c0);
                    const float h0 = xv[rr][q].x * rstd * gg.x * (1 + sc.x) + sh.x, h1 = xv[rr][q].y * rstd * gg.y * (1 + sc.y) + sh.y;
                    const float h2v = xv[rr][q].z * rstd * gg.z * (1 + sc.z) + sh.z, h3 = xv[rr][q].w * rstd * gg.w * (1 + sc.w) + sh.w;
                    u32x2 wh, wl2; wh.x = cvtpk(h0, h1); wh.y = cvtpk(h2v, h3);
                    wl2.x = cvtpk(h0 - __uint_as_float(wh.x << 16), h1 - __uint_as_float(wh.x & 0xffff0000u));
                    wl2.y = cvtpk(h2v - __uint_as_float(wh.y << 16), h3 - __uint_as_float(wh.y & 0xffff0000u));
                    *(u32x2*)(p.H2() + (size_t)(t0 + r0 + rr) * D + c0) = wh;
                    *(u32x2*)(H2lo + (size_t)(t0 + r0 + rr) * D + c0) = wl2;
                }
            }
        }
        asm volatile("s_waitcnt vmcnt(0)" ::: "memory");
        __syncthreads();
        if (MODE == 3) continue;
        f32x4 acc[4];
#pragma unroll
        for (int nt = 0; nt < 4; ++nt) acc[nt] = (f32x4){0.f, 0.f, 0.f, 0.f};
        {
            const bf16_t* ah_p = p.H2() + (size_t)(t0 + fr) * D + fq * 8; const bf16_t* al_p = H2lo + (size_t)(t0 + fr) * D + fq * 8;
            const bf16_t* rT = p.routerT() + (size_t)fr * D + fq * 8;
#pragma unroll 4
            for (int ks = 0; ks < 32; ++ks) {
                const int k0 = ks * 32;
                const bf16x8 ah = ldfrag(ah_p + k0), al = ldfrag(al_p + k0);
#pragma unroll
                for (int nt = 0; nt < 4; ++nt) {
                    const bf16x8 bh = ldfrag(rT + (size_t)(nt * 16) * D + k0), bl = ldfrag(rT + (size_t)(64 + nt * 16) * D + k0);
                    acc[nt] = __builtin_amdgcn_mfma_f32_16x16x32_bf16(ah, bh, acc[nt], 0, 0, 0);
                    acc[nt] = __builtin_amdgcn_mfma_f32_16x16x32_bf16(ah, bl, acc[nt], 0, 0, 0);
                    acc[nt] = __builtin_amdgcn_mfma_f32_16x16x32_bf16(al, bh, acc[nt], 0, 0, 0);
                }
            }
        }
#pragma unroll
        for (int nt = 0; nt < 4; ++nt)
#pragma unroll
            for (int j = 0; j < 4; ++j) lg[(wid * 16 + fq * 4 + j) * 65 + nt * 16 + fr] = acc[nt][j];
        __syncthreads();
        if (MODE == 2) continue;
        float sc_[64]; unsigned long long ch = 0ull; float wscale = 0.f;
        const int tt = (wid & 1) * 64 + lane, t = item * 128 + tt;
        if (wid < 2) {
            float v[64];
#pragma unroll
            for (int e = 0; e < 64; ++e) { const float x = lg[tt * 65 + e]; sc_[e] = 1.0f / (1.0f + expf(-x)); v[e] = sc_[e] + p.router_b[e]; }
            float gs[8];
#pragma unroll
            for (int g = 0; g < 8; ++g) { float m1 = v[8 * g], m2 = -INFINITY;
#pragma unroll
                for (int i = 1; i < 8; ++i) { const float x = v[8 * g + i]; m2 = fmaxf(m2, fminf(m1, x)); m1 = fmaxf(m1, x); }
                gs[g] = m1 + m2; }
#pragma unroll
            for (int g = 0; g < 8; ++g) { int rank = 0;
#pragma unroll
                for (int g2 = 0; g2 < 8; ++g2) if (g2 != g) rank += (gs[g2] > gs[g] || (gs[g2] == gs[g] && g2 < g)) ? 1 : 0;
                if (rank >= 4) {
#pragma unroll
                    for (int i = 0; i < 8; ++i) v[8 * g + i] = -INFINITY; } }
#pragma unroll
            for (int it = 0; it < 8; ++it) {
                float m = v[0];
#pragma unroll
                for (int e = 1; e < 64; ++e) m = fmaxf(m, v[e]);
                bool found = false;
#pragma unroll
                for (int e = 0; e < 64; ++e) { const bool hit = !found && v[e] == m; if (hit) { ch |= (1ull << e); v[e] = -INFINITY; } found = found || hit; }
            }
            float wsum = 0.f;
#pragma unroll
            for (int e = 0; e < 64; ++e) wsum += ((ch >> e) & 1ull) ? sc_[e] : 0.f;
            wscale = 2.5f / wsum;
#pragma unroll
            for (int e = 0; e < 64; ++e) { const unsigned long long mk = __ballot((ch >> e) & 1ull); if (lane == 0) wcnt[wid * 64 + e] = __popcll(mk); }
        }
        __syncthreads();
        if (wid == 0) basel[lane] = atomicAdd(&cntp[lane], wcnt[lane] + wcnt[64 + lane]);
        __syncthreads();
        if (wid < 2) {
            int kidx = 0;
#pragma unroll
            for (int e = 0; e < 64; ++e) {
                const bool c = (ch >> e) & 1ull;
                const unsigned long long mk = __ballot(c);
                if (c) {
                    const int slot = basel[e] + (wid == 1 ? wcnt[e] : 0) + __popcll(mk & ((1ull << lane) - 1ull));
                    tl[(size_t)e * ECAP + slot] = t; wl_[(size_t)e * ECAP + slot] = sc_[e] * wscale;
                    tm[(size_t)t * 8 + kidx] = e * ECAP + slot; ++kidx;
                }
            }
        }
    }
}

constexpr int MOE_AUX = 147456;
__device__ __forceinline__ void moe_tables(const MK& p, int colt, int* tpre, int* rbase, int tid_l) {
    __syncthreads();
    if (tid_l == 0) { int tp = 0, rb = 0;
        for (int e = 0; e < 65; ++e) { const int c = e < 64 ? p.cnt()[e] : T; tpre[e] = tp; rbase[e] = rb; tp += ((c + 255) >> 8) * colt; rb += c; }
        tpre[65] = tp; rbase[65] = rb; }
    __syncthreads();
}
__device__ __forceinline__ void ph_moe_up(const MK& p, int bid, int nb, int tid_l) {
    const int wid0 = tid_l >> 6, lane0 = tid_l & 63;
    int* tpre = (int*)(smem + MOE_AUX); int* rbase = tpre + 80;
    moe_tables(p, 2, tpre, rbase, tid_l);
    const int ntiles = tpre[65];
    unsigned Ao[4], Bo[4];
    stage_offs(D * 2, Bo, tid_l);
    int e = 0;
    for (int tile = bid; tile < ntiles; tile += nb) {
        while (tile >= tpre[e + 1]) ++e;
        const int j = tile - tpre[e], rt = j >> 1, ct = j & 1, cnt_e = rbase[e + 1] - rbase[e];
#pragma unroll
        for (int i = 0; i < 4; ++i) { int R, C; stage_rc(wid0 * 1024 + i * 8192 + lane0 * 16, R, C);
            int slot = rt * 256 + R; if (slot >= cnt_e) slot = 0;
            const int tok = e < 64 ? p.tok_list()[(size_t)e * ECAP + slot] : slot;
            Ao[i] = (unsigned)tok * (D * 2u) + (unsigned)C * 2u; }
        f32x4 acc[8][4];
        gemm_core((const char*)p.H2(), Ao, (const char*)(p.W13t() + ((size_t)e * 512 + ct * 256) * D), Bo, D / 64, acc, tid_l, false);
        int tid_e = tid_l; asm volatile("" : "+v"(tid_e));
        const int wid = tid_e >> 6, lane = tid_e & 63, wr = wid >> 2, wc = wid & 3, fr = lane & 15, fq = lane >> 4;
#pragma unroll
        for (int m = 0; m < 8; ++m) {
            int ioff = m * 16; asm volatile("" : "+v"(ioff) :: "memory");
            const int slot = rt * 256 + wr * 128 + fr + ioff;
            if (slot < cnt_e) {
                bf16_t* dp = p.ACT() + (size_t)(rbase[e] + slot) * DE + ct * 128 + wc * 32 + fq * 4;
#pragma unroll
                for (int n = 0; n < 2; ++n) {
                    u32x2 w; w.x = cvtpk(siluf(acc[m][n][0]) * acc[m][n + 2][0], siluf(acc[m][n][1]) * acc[m][n + 2][1]);
                    w.y = cvtpk(siluf(acc[m][n][2]) * acc[m][n + 2][2], siluf(acc[m][n][3]) * acc[m][n + 2][3]);
                    *(u32x2*)(dp + n * 16) = w;
                }
            }
        }
    }
}
constexpr float Y_SCALE = 64.0f;
template <bool DUMMY, int MODE = 0> __device__ __forceinline__ void ph_moe_down(const MK& p, int bid, int nb, int tid_l) {
    int* tpre = (int*)(smem + MOE_AUX); int* rbase = tpre + 80;
    moe_tables(p, 4, tpre, rbase, tid_l);
    const int ntiles = DUMMY ? tpre[64] : tpre[65];
    unsigned Ao[4], Bo[4];
    stage_offs(DE * 2, Ao, tid_l); stage_offs(DE * 2, Bo, tid_l);
    bool pre = false;
    int e = 0;
    for (int tile = bid; tile < ntiles; tile += nb) {
        while (tile >= tpre[e + 1]) ++e;
        const int j = tile - tpre[e], rt = j >> 2, ct = j & 3, cnt_e = rbase[e + 1] - rbase[e];
        f32x4 acc[8][4];
        gemm_core((const char*)(p.ACT() + (size_t)(rbase[e] + rt * 256) * DE), Ao, (const char*)(p.W2t() + ((size_t)e * D + ct * 256) * DE), Bo, DE / 64, acc, tid_l, pre);
        { const int nx = tile + nb; pre = XPREFETCH && nx < ntiles;
          if (pre) { int e2 = e; while (nx >= tpre[e2 + 1]) ++e2; const int j2 = nx - tpre[e2], rt2 = j2 >> 2, ct2 = j2 & 3;
              gemm_prefetch((const char*)(p.ACT() + (size_t)(rbase[e2] + rt2 * 256) * DE), Ao, (const char*)(p.W2t() + ((size_t)e2 * D + ct2 * 256) * DE), Bo, tid_l); } }
        int tid_e = tid_l; asm volatile("" : "+v"(tid_e));
        const int wid = tid_e >> 6, lane = tid_e & 63, wr = wid >> 2, wc = wid & 3, fr = lane & 15, fq = lane >> 4;
        const int col0 = ct * 256 + wc * 64 + fq * 4;
        if (e < 64) {
            const float* wl = p.wt_list() + (size_t)e * ECAP;
            float wv[8];
#pragma unroll
            for (int m = 0; m < 8; ++m) { const int sl = rt * 256 + wr * 128 + fr + m * 16; wv[m] = wl[sl < cnt_e ? sl : 0] * Y_SCALE; }
            char* wa = wave_area(wid);
#pragma unroll
            for (int m = 0; m < 8; ++m) {
                const float w = wv[m];
#pragma unroll
                for (int n = 0; n < 4; ++n) {
                    float v0 = fminf(fmaxf(acc[m][n][0] * w, -448.f), 448.f), v1 = fminf(fmaxf(acc[m][n][1] * w, -448.f), 448.f);
                    float v2 = fminf(fmaxf(acc[m][n][2] * w, -448.f), 448.f), v3 = fminf(fmaxf(acc[m][n][3] * w, -448.f), 448.f);
                    int pk = 0; pk = __builtin_amdgcn_cvt_pk_fp8_f32(v0, v1, pk, false); pk = __builtin_amdgcn_cvt_pk_fp8_f32(v2, v3, pk, true);
                    *(int*)(wa + (m * 16 + fr) * 80 + n * 16 + fq * 4) = pk;
                }
            }
            asm volatile("s_waitcnt lgkmcnt(0)" ::: "memory");
            {
                const int chunk = lane & 3, rsub = lane >> 2;
                unsigned char* yb = p.Y() + (size_t)rbase[e] * D + ct * 256 + wc * 64 + chunk * 16;
#pragma unroll
                for (int it = 0; it < 8; ++it) {
                    const int row = it * 16 + rsub, slot = rt * 256 + wr * 128 + row;
                    const u32x4 v = *(const u32x4*)(wa + row * 80 + chunk * 16);
                    if (MODE == 1) asm volatile("" :: "v"(v)); else if (slot < cnt_e) *(u32x4*)(yb + (size_t)slot * D) = v;
                }
            }
        } else {
            const float* g2 = p.mod() + (size_t)((rt * 256) / SEQ) * 6 * D + 5 * D + col0;
            float4 gv[4];
#pragma unroll
            for (int n = 0; n < 4; ++n) gv[n] = *(const float4*)(g2 + n * 16);
            float* xb = p.out + (size_t)(rt * 256) * D + col0;
#pragma unroll
            for (int m = 0; m < 8; ++m) {
                int ioff = m * 16; asm volatile("" : "+v"(ioff) :: "memory");
                float* xp = xb + (size_t)(wr * 128 + fr + ioff) * D;
#pragma unroll
                for (int n = 0; n < 4; ++n) {
                    float4 xv = *(float4*)(xp + n * 16);
                    xv.x += gv[n].x * acc[m][n][0]; xv.y += gv[n].y * acc[m][n][1]; xv.z += gv[n].z * acc[m][n][2]; xv.w += gv[n].w * acc[m][n][3];
                    *(float4*)(xp + n * 16) = xv;
                }
            }
        }
        __syncthreads();
    }
}

template <bool DUMMY> __device__ __forceinline__ void ph_final(const MK& p, int bid, int nb, int tid_l) {
    const int wid = tid_l >> 6, lane = tid_l & 63;
    int* tpre = (int*)(smem + MOE_AUX); int* rbase = tpre + 80;
    moe_tables(p, 1, tpre, rbase, tid_l);
    for (int t = bid * 8 + wid; t < T; t += nb * 8) {
        const int b = t / SEQ;
        float f[16];
#pragma unroll
        for (int i = 0; i < 16; ++i) f[i] = 0.f;
#pragma unroll
        for (int k = 0; k < 8; ++k) {
            const int id = p.tokmap()[(size_t)t * 8 + k], e = id >> 15, slot = id & (ECAP - 1);
            const unsigned char* yr = p.Y() + (size_t)(rbase[e] + slot) * D + lane * 4;
#pragma unroll
            for (int q = 0; q < 4; ++q) {
                const int w = *(const int*)(yr + q * 256);
                const auto lo = __builtin_amdgcn_cvt_pk_f32_fp8(w, false); const auto hi = __builtin_amdgcn_cvt_pk_f32_fp8(w, true);
                f[q * 4 + 0] += lo[0]; f[q * 4 + 1] += lo[1]; f[q * 4 + 2] += hi[0]; f[q * 4 + 3] += hi[1];
            }
        }
        const float* g2 = p.mod() + (size_t)b * 6 * D + 5 * D + lane * 4;
        float* xo = p.out + (size_t)t * D + lane * 4;
        float v[16]; float ss = 0.f;
#pragma unroll
        for (int q = 0; q < 4; ++q) {
            const float4 xv = *(const float4*)(xo + q * 256), g = *(const float4*)(g2 + q * 256);
            v[q * 4 + 0] = xv.x + g.x * f[q * 4 + 0] * (1.0f / Y_SCALE); v[q * 4 + 1] = xv.y + g.y * f[q * 4 + 1] * (1.0f / Y_SCALE);
            v[q * 4 + 2] = xv.z + g.z * f[q * 4 + 2] * (1.0f / Y_SCALE); v[q * 4 + 3] = xv.w + g.w * f[q * 4 + 3] * (1.0f / Y_SCALE);
            ss += v[q * 4] * v[q * 4] + v[q * 4 + 1] * v[q * 4 + 1] + v[q * 4 + 2] * v[q * 4 + 2] + v[q * 4 + 3] * v[q * 4 + 3];
        }
        ss = wave_sum(ss);
        const float rstd = rsqrtf(ss * (1.0f / D) + EPS);
#pragma unroll
        for (int q = 0; q < 4; ++q) {
            const float4 gf = *(const float4*)(p.final_g + q * 256 + lane * 4);
            *(float4*)((DUMMY ? (float*)(p.ws + 42 * MiB) + (size_t)t * D + lane * 4 : xo) + q * 256) = make_float4(v[q * 4] * rstd * gf.x, v[q * 4 + 1] * rstd * gf.y, v[q * 4 + 2] * rstd * gf.z, v[q * 4 + 3] * rstd * gf.w);
        }
    }
}


#define XB_TMO      128
#define XB_XCNT(j)  (256  + 64 * (j))
#define XB_XSUB(j)  (1280 + 64 * (j))
#define XB_XGEN(j)  (2304 + 64 * (j))
#define XB_TOP      3328
#define XB_TOPGEN   3392
#define XCD_BAR_WORDS 3456
#define XB_SPIN_CAP (1u << 22)
#define LAS __attribute__((address_space(3)))
__device__ __forceinline__ unsigned xb_ld(unsigned* p)              { return __hip_atomic_load(p, __ATOMIC_RELAXED, __HIP_MEMORY_SCOPE_AGENT); }
__device__ __forceinline__ unsigned xb_add(unsigned* p, unsigned v) { return __hip_atomic_fetch_add(p, v, __ATOMIC_RELAXED, __HIP_MEMORY_SCOPE_AGENT); }
__device__ __forceinline__ unsigned xb_xcc_id() { return (unsigned)__builtin_amdgcn_s_getreg((3 << 11) | 20) & 0xFu; }
#define XB_SPIN(cond, bar) do { unsigned _sp = 0; while (cond) { __builtin_amdgcn_s_sleep(1); \
    if ((++_sp & 255u) == 0u) { if (xb_ld(&(bar)[XB_TMO])) break; if (_sp > XB_SPIN_CAP) { atomicAdd(&(bar)[XB_TMO], 1u); break; } } } } while (0)
struct XcdBarrier { unsigned* bar; unsigned x; volatile LAS unsigned* st; };
__device__ __forceinline__ XcdBarrier xcd_barrier_post(unsigned* bar, volatile LAS unsigned* st, int tid) {
    XcdBarrier b; b.bar = bar; b.x = xb_xcc_id(); b.st = st;
    if (tid == 0) (void)xb_add(&bar[XB_XCNT(b.x)], 1u);
    return b;
}
__device__ __forceinline__ void xcd_barrier_complete(unsigned* bar, unsigned x, unsigned& nloc, unsigned& nx) {
    const unsigned G = gridDim.x * gridDim.y * gridDim.z;
    unsigned sum, cnt, mine, sp = 0u;
    for (;;) {
        sum = 0u; cnt = 0u; mine = 0u;
#pragma unroll
        for (unsigned j = 0; j < 16; ++j) { const unsigned c = xb_ld(&bar[XB_XCNT(j)]); sum += c; cnt += (c > 0u) ? 1u : 0u; mine = (j == x) ? c : mine; }
        if (sum == G) break;
        __builtin_amdgcn_s_sleep(1);
        if ((++sp & 255u) == 0u) { if (xb_ld(&bar[XB_TMO])) break; if (sp > XB_SPIN_CAP) { atomicAdd(&bar[XB_TMO], 1u); break; } }
    }
    nloc = mine > 0u ? mine : 1u; nx = cnt > 0u ? cnt : 1u;
}
__device__ __forceinline__ void xcd_barrier(const XcdBarrier& b, int tid) {
    asm volatile("s_waitcnt vmcnt(0)" ::: "memory");
    __syncthreads();
    if (tid == 0) {
        unsigned* bar = b.bar;
        __builtin_amdgcn_s_waitcnt(0);
        unsigned nloc = b.st[0], nx = b.st[1];
        if (nloc == 0u) { xcd_barrier_complete(bar, b.x, nloc, nx); b.st[0] = nloc; b.st[1] = nx; }
        const unsigned old = xb_add(&bar[XB_XSUB(b.x)], 1u);
        const unsigned gen = old / nloc;
        if (old + 1u == (gen + 1u) * nloc) {
            __builtin_amdgcn_fence(__ATOMIC_RELEASE, "agent");
            asm volatile("s_waitcnt vmcnt(0)" ::: "memory");
            const unsigned og = xb_add(&bar[XB_TOP], 1u);
            const unsigned tg = og / nx;
            if (og + 1u == (tg + 1u) * nx) xb_add(&bar[XB_TOPGEN], 1u);
            else XB_SPIN(xb_ld(&bar[XB_TOPGEN]) == tg, bar);
            __builtin_amdgcn_fence(__ATOMIC_ACQUIRE, "agent");
            xb_add(&bar[XB_XGEN(b.x)], 1u);
            asm volatile("s_waitcnt vmcnt(0)" ::: "memory");
        } else {
            XB_SPIN(xb_ld(&bar[XB_XGEN(b.x)]) == gen, bar);
            __builtin_amdgcn_fence(__ATOMIC_ACQUIRE, "agent");
            asm volatile("s_waitcnt vmcnt(0)" ::: "memory");
        }
    }
    __syncthreads();
}

__global__ __launch_bounds__(512, 2) void k_mega(MK p) {
    cg::grid_group grid = cg::this_grid();
    const int bid = blockIdx.x, nb = gridDim.x;
    volatile LAS unsigned* xst = (volatile LAS unsigned*)(smem + 147456 + 768);
    if (threadIdx.x < 4) xst[threadIdx.x] = 0u;
    __syncthreads();
    const XcdBarrier xb = xcd_barrier_post((unsigned*)(p.ws + 524288), xst, (int)threadIdx.x);
#define PH_TID() int t_ = threadIdx.x; asm volatile("" : "+v"(t_))
    { PH_TID(); if (bid == 0 && t_ < 256) p.cnt()[t_] = 0; ph_mod(p, bid, nb, t_); ph_convert(p, bid, nb, t_); }
#if DUP == 10
    { PH_TID(); ph_convert(p, bid, nb, t_); }
#endif
    grid.sync();
    { PH_TID(); ph_ln1(p, bid, nb, t_); }
#if DUP == 1
    { PH_TID(); ph_ln1(p, bid, nb, t_); }
#endif
    xcd_barrier(xb, (int)threadIdx.x);
    { PH_TID(); ph_gemm_in(p, bid, nb, t_); }
#if DUP == 2
    { PH_TID(); ph_gemm_in(p, bid, nb, t_); }
#endif
    xcd_barrier(xb, (int)threadIdx.x);
    { PH_TID(); ph_attn(p, bid, nb, t_); }
#if DUP == 3
    { PH_TID(); ph_attn(p, bid, nb, t_); }
#endif
    { PH_TID(); ph_kv(p, bid, nb, t_); }
#if DUP == 11
    { PH_TID(); ph_kv(p, bid, nb, t_); }
#endif
    xcd_barrier(xb, (int)threadIdx.x);
    { PH_TID(); ph_scan(p, bid, nb, t_); }
    xcd_barrier(xb, (int)threadIdx.x);
    { PH_TID(); ph_ret(p, bid, nb, t_); }
#if DUP == 5
    { PH_TID(); ph_ret(p, bid, nb, t_); }
#endif
    xcd_barrier(xb, (int)threadIdx.x);
    { PH_TID(); ph_gemm_out(p, bid, nb, t_); }
#if DUP == 6
    { PH_TID(); ph_gemm_out(p, bid, nb, t_); }
#endif
    xcd_barrier(xb, (int)threadIdx.x);
#if DUP == 7
    { PH_TID(); ph_route<true>(p, bid, nb, t_); }
#endif
#if DUP == 72
    { PH_TID(); ph_route<true, 2>(p, bid, nb, t_); }
#endif
#if DUP == 73
    { PH_TID(); ph_route<true, 3>(p, bid, nb, t_); }
#endif
    { PH_TID(); ph_route<false>(p, bid, nb, t_); }
    xcd_barrier(xb, (int)threadIdx.x);
    { PH_TID(); ph_moe_up(p, bid, nb, t_); }
#if DUP == 8
    { PH_TID(); ph_moe_up(p, bid, nb, t_); }
#endif
    xcd_barrier(xb, (int)threadIdx.x);
#if DUP == 9
    { PH_TID(); ph_moe_down<true>(p, bid, nb, t_); }
#endif
#if DUP == 91
    { PH_TID(); ph_moe_down<true, 1>(p, bid, nb, t_); }
#endif
    { PH_TID(); ph_moe_down<false>(p, bid, nb, t_); }
    xcd_barrier(xb, (int)threadIdx.x);
#if DUP == 13
    { PH_TID(); ph_final<true>(p, bid, nb, t_); }
#endif
    { PH_TID(); ph_final<false>(p, bid, nb, t_); }
#undef PH_TID
}
constexpr int LDS_TOTAL = 148480;
extern "C" void kernel_launch(void* const* d_in, const int* in_sizes, int n_in, void* d_out, int out_size, void* d_ws, size_t ws_size, hipStream_t stream) {
    char* ws = (char*)d_ws;
    MK mk{};
    mk.x = (const float*)d_in[0]; mk.c = (const float*)d_in[1]; mk.ctx = (const float*)d_in[2]; mk.cctx = (const float*)d_in[3]; mk.ada_w = (const float*)d_in[4]; mk.ada_b = (const float*)d_in[5];
    mk.norm1_g = (const float*)d_in[6]; mk.w_in = (const float*)d_in[7]; mk.lq1 = (const float*)d_in[8]; mk.lk1 = (const float*)d_in[9]; mk.lq2 = (const float*)d_in[10]; mk.lk2 = (const float*)d_in[11];
    mk.dattn_g = (const float*)d_in[12]; mk.dec_f = (const float*)d_in[13]; mk.dec_b = (const float*)d_in[14]; mk.ret_g = (const float*)d_in[15]; mk.w_out = (const float*)d_in[16];
    mk.norm2_g = (const float*)d_in[17]; mk.router_w = (const float*)d_in[18]; mk.router_b = (const float*)d_in[19]; mk.ew1 = (const float*)d_in[20]; mk.ew3 = (const float*)d_in[21];
    mk.ew2 = (const float*)d_in[22]; mk.sw1 = (const float*)d_in[23]; mk.sw3 = (const float*)d_in[24]; mk.sw2 = (const float*)d_in[25]; mk.final_g = (const float*)d_in[26];
    mk.out = (float*)d_out;
    mk.ws = ws;
    mk.dbgP = nullptr; mk.dbg_lo = 0; mk.dbg_hi = 12; mk.conv_limit = 1 << 30;
    static int grid_blocks = 0;
    if (!grid_blocks) {
        (void)hipFuncSetAttribute((const void*)k_mega, hipFuncAttributeMaxDynamicSharedMemorySize, LDS_TOTAL);
        int dev = 0, cus = 0, per_cu = 0;
        (void)hipGetDevice(&dev);
        (void)hipDeviceGetAttribute(&cus, hipDeviceAttributeMultiprocessorCount, dev);
        (void)hipOccupancyMaxActiveBlocksPerMultiprocessor(&per_cu, k_mega, 512, LDS_TOTAL);
        if (per_cu > 1) per_cu = 1;
        grid_blocks = cus * per_cu;
        if (grid_blocks <= 0) { fprintf(stderr, "occupancy query failed: cus %d per_cu %d\n", cus, per_cu); grid_blocks = 256; }
    }
    (void)hipMemsetAsync(ws + 524288, 0, XCD_BAR_WORDS * 4, stream);
    void* args[] = {&mk};
    hipError_t e = hipLaunchCooperativeKernel((void*)k_mega, dim3(grid_blocks), dim3(512), args, LDS_TOTAL, stream);
    if (e != hipSuccess) fprintf(stderr, "cooperative launch failed: %s (grid %d)\n", hipGetErrorString(e), grid_blocks);
}
```

```cpp
#include <hip/hip_runtime.h>
#include <hip/hip_cooperative_groups.h>
#include <cstdio>
namespace cg = cooperative_groups;
#ifndef DUP
#define DUP 0
#endif
#include <stdint.h>

constexpr int D = 1024, NB = 4, SEQ = 8192, CTX = 256, RB = SEQ + CTX  , NR = NB * RB  , T = NB * SEQ;
constexpr int NE = 64, DE = 256, ECAP = 32768;
constexpr float EPS = 1e-6f;
typedef unsigned short bf16_t;

__device__ __forceinline__ float siluf(float v) { return v / (1.0f + expf(-v)); }
__device__ __forceinline__ float wave_sum(float v) {
#pragma unroll
    for (int o = 32; o > 0; o >>= 1) v += __shfl_xor(v, o);
    return v;
}
__device__ __forceinline__ float wave_max(float v) {
#pragma unroll
    for (int o = 32; o > 0; o >>= 1) v = fmaxf(v, __shfl_xor(v, o));
    return v;
}
__device__ __forceinline__ float block_sum(float v, float* red) {
    v = wave_sum(v);
    __syncthreads();
    if ((threadIdx.x & 63) == 0) red[threadIdx.x >> 6] = v;
    __syncthreads();
    return red[0] + red[1] + red[2] + red[3];
}
__device__ __forceinline__ float block_max(float v, float* red) {
    v = wave_max(v);
    __syncthreads();
    if ((threadIdx.x & 63) == 0) red[threadIdx.x >> 6] = v;
    __syncthreads();
    return fmaxf(fmaxf(red[0], red[1]), fmaxf(red[2], red[3]));
}

typedef short bf16x8 __attribute__((ext_vector_type(8)));
typedef short s16x4 __attribute__((ext_vector_type(4)));
typedef float f32x4 __attribute__((ext_vector_type(4)));
typedef float f32x16 __attribute__((ext_vector_type(16)));
typedef unsigned u32x2 __attribute__((ext_vector_type(2)));
typedef unsigned u32x4 __attribute__((ext_vector_type(4)));
extern __shared__ __attribute__((aligned(1024))) char smem[];
constexpr int NTHR = 512;
constexpr int GEMM_LDS = 131072;

__device__ __forceinline__ unsigned cvtpk(float lo, float hi) { unsigned r; asm volatile("v_cvt_pk_bf16_f32 %0, %1, %2" : "=v"(r) : "v"(lo), "v"(hi)); return r; }
__device__ __forceinline__ bf16_t f2bf(float v) { return (bf16_t)(cvtpk(v, v) & 0xffffu); }
__device__ __forceinline__ float bf2f(bf16_t v) { return __uint_as_float(((unsigned)v) << 16); }

constexpr size_t MiB = 1048576;
struct MK {
    const float *x, *c, *ctx, *cctx, *ada_w, *ada_b, *norm1_g, *w_in, *lq1, *lk1, *lq2, *lk2, *dattn_g, *dec_f, *dec_b, *ret_g, *w_out, *norm2_g, *router_w, *router_b,
        *ew1, *ew3, *ew2, *sw1, *sw3, *sw2, *final_g;
    float* out; char* ws;
    float* dbgP; long dbg_lo, dbg_hi; long conv_limit;
#define WSF(name, type, off) __device__ __forceinline__ type* name() const { return (type*)(ws + (off)); }
    WSF(mod, float, 0) WSF(cnt, int, 131072) WSF(ropec, float, 262144) WSF(ropes, float, 262144 + 8192)
    WSF(w_inT, bf16_t, 1 * MiB) WSF(w_outT, bf16_t, 7 * MiB) WSF(routerT, bf16_t, 9 * MiB) WSF(W2t, bf16_t, 9 * MiB + 524288)
    WSF(H, bf16_t, 42 * MiB) WSF(MIX, bf16_t, 42 * MiB) WSF(KV, bf16_t, 112 * MiB) WSF(ST, bf16_t, 147 * MiB) WSF(ACT, bf16_t, 42 * MiB)
    WSF(W13t, bf16_t, 194 * MiB) WSF(H2, bf16_t, 260 * MiB)
    WSF(Q, bf16_t, 260 * MiB) WSF(K, bf16_t, 292 * MiB) WSF(V, bf16_t, 325 * MiB) WSF(RQ, bf16_t, 358 * MiB) WSF(RK, bf16_t, 375 * MiB)
    WSF(KTf, bf16_t, 392 * MiB) WSF(KTb, bf16_t, 409 * MiB) WSF(VT, bf16_t, 426 * MiB) WSF(RG, bf16_t, 459 * MiB)
    WSF(Y, unsigned char, 194 * MiB) WSF(tok_list, int, 452 * MiB) WSF(wt_list, float, 460 * MiB) WSF(tokmap, int, 468 * MiB)
#undef WSF
};

__device__ __forceinline__ void ph_mod(const MK& p, int bid, int nb, int tid_l) {
    float* red = (float*)smem;
    for (int it = bid; it < 6 * D / 32; it += nb) {
        const int col = tid_l & 31, kg = tid_l >> 5, j = it * 32 + col;
        float a[5] = {0, 0, 0, 0, 0};
        for (int k = kg * 64; k < kg * 64 + 64; ++k) {
            float w = p.ada_w[(size_t)k * 6 * D + j];
#pragma unroll
            for (int r = 0; r < 5; ++r) { float cv = r < 4 ? p.c[r * D + k] : p.cctx[k]; a[r] += siluf(cv) * w; }
        }
        __syncthreads();
#pragma unroll
        for (int r = 0; r < 5; ++r) red[(kg * 5 + r) * 32 + col] = a[r];
        __syncthreads();
        if (tid_l < 160) {
            int r = tid_l >> 5; float s = 0;
            for (int g = 0; g < 16; ++g) s += red[(g * 5 + r) * 32 + col];
            p.mod()[(size_t)r * 6 * D + j] = s + p.ada_b[j];
        }
    }
    if (bid == nb - 1) {
        for (int i = tid_l; i < 128 * 16; i += NTHR) {
            int pos = i >> 4, f = i & 15;
            float inv_freq = (float)pow(10000.0, -(double)f / 16.0);
            float s, c; sincosf((float)pos * inv_freq, &s, &c);
            p.ropec()[i] = c; p.ropes()[i] = s;
        }
    }
    __syncthreads();
}

__device__ __forceinline__ void tr_tile(const float* src, int ldsrc, int k0, int n0, bf16_t* dst, int lddst, int mode  , bf16_t* dst2, int tid_l) {
    float* t = (float*)smem;
    __syncthreads();
    for (int i = tid_l; i < 64 * 16; i += NTHR) {
        int r = i >> 4, c4 = (i & 15) * 4;
        float4 v = *(const float4*)(src + (size_t)(k0 + r) * ldsrc + n0 + c4);
        t[r * 65 + c4] = v.x; t[r * 65 + c4 + 1] = v.y; t[r * 65 + c4 + 2] = v.z; t[r * 65 + c4 + 3] = v.w;
    }
    __syncthreads();
    for (int i = tid_l; i < 64 * 16; i += NTHR) {
        int n = i >> 4, k4 = (i & 15) * 4;
        float a = t[(k4 + 0) * 65 + n], b = t[(k4 + 1) * 65 + n], c = t[(k4 + 2) * 65 + n], d = t[(k4 + 3) * 65 + n];
        int nn = n0 + n, row = nn;
        if (mode == 1 || mode == 2) { int ct = nn >> 7; row = ct * 256 + (mode == 2 ? 128 : 0) + (nn & 127); }
        u32x2 w; w.x = cvtpk(a, b); w.y = cvtpk(c, d);
        *(u32x2*)(dst + (size_t)row * lddst + k0 + k4) = w;
        if (mode == 3) {
            float ah = bf2f((bf16_t)(w.x & 0xffff)), bh = bf2f((bf16_t)(w.x >> 16)), ch = bf2f((bf16_t)(w.y & 0xffff)), dh = bf2f((bf16_t)(w.y >> 16));
            u32x2 l; l.x = cvtpk(a - ah, b - bh); l.y = cvtpk(c - ch, d - dh);
            *(u32x2*)(dst2 + (size_t)row * lddst + k0 + k4) = l;
        }
    }
}
__device__ __forceinline__ void ph_convert(const MK& p, int bid, int nb, int tid_l) {
    const int n_win = 16 * 48, n_wout = 16 * 16, n_rt = 16, n_e13 = 65 * 2 * 16 * 4, n_e2 = 65 * 4 * 16;
    int total = n_win + n_wout + n_rt + n_e13 + n_e2; if (p.conv_limit < total) total = (int)p.conv_limit;
    for (int it = bid; it < total; it += nb) {
        int j = it;
        if (j < n_win) { tr_tile(p.w_in, 3072, (j / 48) * 64, (j % 48) * 64, p.w_inT(), 1024, 0, nullptr, tid_l); continue; } j -= n_win;
        if (j < n_wout) { tr_tile(p.w_out, 1024, (j / 16) * 64, (j % 16) * 64, p.w_outT(), 1024, 0, nullptr, tid_l); continue; } j -= n_wout;
        if (j < n_rt) { tr_tile(p.router_w, 64, j * 64, 0, p.routerT(), 1024, 3, p.routerT() + 64 * 1024, tid_l); continue; } j -= n_rt;
        if (j < n_e13) {
            int e = j / 128, r = j % 128, which = r / 64, tt = r % 64;
            const float* src = e < 64 ? (which ? p.ew3 : p.ew1) + (size_t)e * D * DE : (which ? p.sw3 : p.sw1);
            tr_tile(src, DE, (tt / 4) * 64, (tt % 4) * 64, p.W13t() + (size_t)e * 512 * 1024, 1024, 1 + which, nullptr, tid_l); continue; } j -= n_e13;
        { int e = j / 64, tt = j % 64;
          const float* src = e < 64 ? p.ew2 + (size_t)e * DE * D : p.sw2;
          tr_tile(src, D, (tt / 16) * 64, (tt % 16) * 64, p.W2t() + (size_t)e * 1024 * 256, 256, 0, nullptr, tid_l); }
    }
    __syncthreads();
}

__device__ __forceinline__ void ph_ln1(const MK& p, int bid, int nb, int tid_l) {
    const int wid = tid_l >> 6, lane = tid_l & 63;
    for (int R = bid * 8 + wid; R < NR; R += nb * 8) {
        int b = R / RB, i = R % RB;
        const float* src = i < CTX ? p.ctx + ((size_t)b * CTX + i) * D : p.x + ((size_t)b * SEQ + (i - CTX)) * D;
        const float* m = p.mod() + (size_t)(i < CTX ? 4 : b) * 6 * D;
        float4 v[4]; float ss = 0;
#pragma unroll
        for (int q = 0; q < 4; ++q) { v[q] = *(const float4*)(src + q * 256 + lane * 4); ss += v[q].x * v[q].x + v[q].y * v[q].y + v[q].z * v[q].z + v[q].w * v[q].w; }
        ss = wave_sum(ss);
        float rstd = rsqrtf(ss * (1.0f / D) + EPS);
#pragma unroll
        for (int q = 0; q < 4; ++q) {
            int c0 = q * 256 + lane * 4;
            float4 gg = *(const float4*)(p.norm1_g + c0), sh = *(const float4*)(m + c0), sc = *(const float4*)(m + D + c0);
            float o0 = v[q].x * rstd * gg.x * (1 + sc.x) + sh.x, o1 = v[q].y * rstd * gg.y * (1 + sc.y) + sh.y;
            float o2 = v[q].z * rstd * gg.z * (1 + sc.z) + sh.z, o3 = v[q].w * rstd * gg.w * (1 + sc.w) + sh.w;
            u32x2 w; w.x = cvtpk(o0, o1); w.y = cvtpk(o2, o3);
            *(u32x2*)(p.H() + (size_t)R * D + c0) = w;
        }
    }
}

__device__ __forceinline__ int lds_byte(int r, int c) { int st = (r >> 4) * 2 + (c >> 5), ob = (r & 15) * 64 + (c & 31) * 2; return st * 1024 + (ob ^ (((ob >> 9) & 1) << 5)); }
__device__ __forceinline__ void stage_rc(int b, int& R, int& C) { int st = b >> 10, sb = b & 1023, swz = sb ^ (((sb >> 9) & 1) << 5); R = (st / 2) * 16 + swz / 64; C = (st % 2) * 32 + (swz % 64) / 2; }
#define WAIT_V0() asm volatile("s_waitcnt vmcnt(0)" ::: "memory")
__device__ __forceinline__ void gemm_core(const char* Abase, const unsigned (&Ao)[4], const char* Bbase, const unsigned (&Bo)[4], int nt, f32x4 (&acc)[8][4], int tid_l, bool pre) {
    const int tid = tid_l, wid = tid >> 6, lane = tid & 63, wr = wid >> 2, wc = wid & 3, fr = lane & 15, fq = lane >> 4;
#pragma unroll
    for (int m = 0; m < 8; ++m)
#pragma unroll
        for (int n = 0; n < 4; ++n) acc[m][n] = (f32x4){0.f, 0.f, 0.f, 0.f};
#define G_SA(b) (smem + (b) * 32768)
#define G_SB(b) (smem + 65536 + (b) * 32768)
#define G_STAGE(buf, kt) do { _Pragma("unroll") for (int i = 0; i < 4; ++i) {                                                     \
        __builtin_amdgcn_global_load_lds((const unsigned*)(Abase + (Ao[i] + (unsigned)(kt) * 128u)), (unsigned*)(G_SA(buf) + wid * 1024 + i * 8192), 16, 0, 0); \
        __builtin_amdgcn_global_load_lds((const unsigned*)(Bbase + (Bo[i] + (unsigned)(kt) * 128u)), (unsigned*)(G_SB(buf) + wid * 1024 + i * 8192), 16, 0, 0); } } while (0)
    if (!pre) G_STAGE(0, 0);
    WAIT_V0(); __syncthreads();
#define G_KSTEP(cur, t) do {                                                                                                   \
        if ((t) + 1 < nt) G_STAGE((cur) ^ 1, (t) + 1);                                                                          \
        _Pragma("unroll") for (int ks = 0; ks < 2; ++ks) {                                                                      \
            bf16x8 At[8], Bf[4];                                                                                                \
            _Pragma("unroll") for (int m = 0; m < 8; ++m) At[m] = *(const bf16x8*)(G_SA(cur) + lds_byte(wr * 128 + m * 16 + fr, ks * 32 + fq * 8)); \
            _Pragma("unroll") for (int n = 0; n < 4; ++n) Bf[n] = *(const bf16x8*)(G_SB(cur) + lds_byte(wc * 64 + n * 16 + fr, ks * 32 + fq * 8));  \
            _Pragma("unroll") for (int m = 0; m < 8; ++m) _Pragma("unroll") for (int n = 0; n < 4; ++n)                         \
                acc[m][n] = __builtin_amdgcn_mfma_f32_16x16x32_bf16(Bf[n], At[m], acc[m][n], 0, 0, 0);                          \
            __builtin_amdgcn_sched_barrier(0);                                                                                  \
        }                                                                                                                       \
        WAIT_V0(); __syncthreads(); } while (0)
#pragma unroll 1
    for (int t = 0; t < nt; ++t) { const int cur = t & 1; G_KSTEP(cur, t); }
}
#ifndef XPREFETCH
#define XPREFETCH 0
#endif
__device__ __forceinline__ void gemm_prefetch(const char* Abase, const unsigned (&Ao)[4], const char* Bbase, const unsigned (&Bo)[4], int tid_l) {
    const int wid = tid_l >> 6;
    G_STAGE(0, 0);
}
__device__ __forceinline__ void stage_offs(unsigned ld_bytes, unsigned (&P)[4], int tid_l) {
    const int wid = tid_l >> 6, lane = tid_l & 63;
#pragma unroll
    for (int i = 0; i < 4; ++i) { int R, C; stage_rc(wid * 1024 + i * 8192 + lane * 16, R, C); P[i] = (unsigned)R * ld_bytes + (unsigned)C * 2u; }
}

constexpr int WAREA = 18432;
__device__ __forceinline__ char* wave_area(int wid) { return smem + wid * WAREA; }

constexpr int A_KVBLK = 64;
constexpr float A_SCALE = 0.125f, A_THR = 8.f;
constexpr int A_SHM_V = A_KVBLK * 128 * 2, A_SHM_K = A_KVBLK * 128 * 2;
#define KSWZ(row, colB) ((row) * 256 + ((colB) ^ (((row) & 7) << 4)))
#define SBAR() __builtin_amdgcn_sched_barrier(0)
__device__ __forceinline__ int crow(int r, int hi) { return (r & 3) + 8 * (r >> 2) + 4 * hi; }

__device__ __forceinline__ void partialSM(f32x16& p0, f32x16& p1, float& m_reg, float& mn, float& alpha) {
    constexpr float C = A_SCALE * 1.4426950408889634f;
    float pmax = p0[0];
#pragma unroll
    for (int r = 1; r < 16; ++r) pmax = fmaxf(pmax, p0[r]);
#pragma unroll
    for (int r = 0; r < 16; ++r) pmax = fmaxf(pmax, p1[r]);
    { auto rr = __builtin_amdgcn_permlane32_swap(__float_as_uint(pmax), __float_as_uint(pmax), false, false);
      pmax = fmaxf(__uint_as_float(rr[0]), __uint_as_float(rr[1])); }
    if (__builtin_expect(__all(pmax - m_reg <= A_THR / A_SCALE), 1)) { mn = m_reg; alpha = 1.f; }
    else { mn = fmaxf(m_reg, pmax); alpha = __builtin_amdgcn_exp2f((m_reg - mn) * C); m_reg = mn; }
    float mnC = -mn * C;
#pragma unroll
    for (int r = 0; r < 16; ++r) p0[r] = fmaf(p0[r], C, mnC);
#pragma unroll
    for (int r = 0; r < 16; ++r) p1[r] = fmaf(p1[r], C, mnC);
#pragma unroll
    for (int r = 0; r < 16; ++r) p0[r] = __builtin_amdgcn_exp2f(p0[r]);
}
#define PK4(P, BASE, OUT) do { unsigned a0 = cvtpk(P[BASE + 0], P[BASE + 1]), a1 = cvtpk(P[BASE + 2], P[BASE + 3]);   \
    unsigned b0 = cvtpk(P[BASE + 4], P[BASE + 5]), b1 = cvtpk(P[BASE + 6], P[BASE + 7]);                              \
    auto r0 = __builtin_amdgcn_permlane32_swap(a0, b0, false, false); auto r1 = __builtin_amdgcn_permlane32_swap(a1, b1, false, false); \
    u32x4 w = {r0[0], r1[0], r0[1], r1[1]}; OUT = *reinterpret_cast<bf16x8*>(&w); } while (0)
__device__ __forceinline__ void finishSM(f32x16& p0, f32x16& p1, float alpha, float& l_reg, bf16x8& pa0, bf16x8& pa1, bf16x8& pa2, bf16x8& pa3) {
#pragma unroll
    for (int r = 0; r < 16; ++r) p1[r] = __builtin_amdgcn_exp2f(p1[r]);
    float ps = 0;
#pragma unroll
    for (int r = 0; r < 16; ++r) ps += p0[r];
#pragma unroll
    for (int r = 0; r < 16; ++r) ps += p1[r];
    { auto rr = __builtin_amdgcn_permlane32_swap(__float_as_uint(ps), __float_as_uint(ps), false, false);
      ps = __uint_as_float(rr[0]) + __uint_as_float(rr[1]); }
    l_reg = l_reg * alpha + ps;
    PK4(p0, 0, pa0); PK4(p0, 8, pa1); PK4(p1, 0, pa2); PK4(p1, 8, pa3);
}
__device__ __forceinline__ void qkt(f32x16& p0, f32x16& p1, const char* Ks, const bf16x8* qr, int r32, int hi, int mapc) {
    p0 = f32x16{}; p1 = f32x16{};
#pragma unroll
    for (int d0 = 0; d0 < 4; ++d0) { int cb = (mapc + d0 * 16 + hi * 8) * 2;
        bf16x8 b0 = *reinterpret_cast<const bf16x8*>(Ks + KSWZ(r32, cb));
        bf16x8 b1 = *reinterpret_cast<const bf16x8*>(Ks + KSWZ(32 + r32, cb));
        p0 = __builtin_amdgcn_mfma_f32_32x32x16_bf16(b0, qr[d0], p0, 0, 0, 0);
        p1 = __builtin_amdgcn_mfma_f32_32x32x16_bf16(b1, qr[d0], p1, 0, 0, 0); }
}
__device__ __forceinline__ int v_st(int k, int c) { const int kk = (k & ~0xC) | ((k & 4) << 1) | ((k & 8) >> 1); return ((kk >> 3) * 4 + (c >> 5)) * 512 + ((kk & 7) * 32 + (c & 31)) * 2; }
__device__ __forceinline__ int v_rd_base(int lane) { return ((lane & 3) << 3) | (((lane >> 2) & 3) << 6) | (((lane >> 4) & 1) << 5) | (((lane >> 5) & 1) << 8); }
constexpr int v_rd_off(int d0, int ks, int half) { return d0 * 512 + ks * 4096 + half * 2048; }
template <int OFF> __device__ __forceinline__ s16x4 tr_read(int vb) {
    s16x4 r; asm volatile("ds_read_b64_tr_b16 %0, %1 offset:%2" : "=&v"(r) : "v"(vb), "i"(OFF) : "memory"); return r;
}
template <int D0> __device__ __forceinline__ void pv_one(f32x16& od, int vb, bf16x8 pa0, bf16x8 pa1, bf16x8 pa2, bf16x8 pa3) {
    const s16x4 l0 = tr_read<v_rd_off(D0, 0, 0)>(vb), h0 = tr_read<v_rd_off(D0, 0, 1)>(vb), l1 = tr_read<v_rd_off(D0, 1, 0)>(vb), h1 = tr_read<v_rd_off(D0, 1, 1)>(vb);
    const s16x4 l2 = tr_read<v_rd_off(D0, 2, 0)>(vb), h2 = tr_read<v_rd_off(D0, 2, 1)>(vb), l3 = tr_read<v_rd_off(D0, 3, 0)>(vb), h3 = tr_read<v_rd_off(D0, 3, 1)>(vb);
    asm volatile("s_waitcnt lgkmcnt(0)" ::: "memory"); SBAR();
#define PKV(L, H) (bf16x8){L[0], L[1], L[2], L[3], H[0], H[1], H[2], H[3]}
    od = __builtin_amdgcn_mfma_f32_32x32x16_bf16(pa0, PKV(l0, h0), od, 0, 0, 0);
    od = __builtin_amdgcn_mfma_f32_32x32x16_bf16(pa1, PKV(l1, h1), od, 0, 0, 0);
    od = __builtin_amdgcn_mfma_f32_32x32x16_bf16(pa2, PKV(l2, h2), od, 0, 0, 0);
    od = __builtin_amdgcn_mfma_f32_32x32x16_bf16(pa3, PKV(l3, h3), od, 0, 0, 0);
}
__device__ __forceinline__ void pv_d0(f32x16* o, int vb, bf16x8 pa0, bf16x8 pa1, bf16x8 pa2, bf16x8 pa3) {
    pv_one<0>(o[0], vb, pa0, pa1, pa2, pa3); pv_one<1>(o[1], vb, pa0, pa1, pa2, pa3); pv_one<2>(o[2], vb, pa0, pa1, pa2, pa3); pv_one<3>(o[3], vb, pa0, pa1, pa2, pa3);
}

__device__ __forceinline__ void attn_item(const bf16_t* __restrict__ Qb, const bf16_t* __restrict__ Kh, const bf16_t* __restrict__ Vh, bf16_t* __restrict__ mixrow,
                                          const float* __restrict__ gd, float lam, int tid_l) {
    char* lds = smem;
    const int tid = tid_l, wid = tid >> 6, lane = tid & 63, r32 = lane & 31, hi = lane >> 5;
    const int map = wid >> 2, wq = wid & 3, mapc = map * 64;
    char* V_lds = lds; char* K_lds = lds + 2 * A_SHM_V;
    float* wsw = (float*)(lds + 2 * A_SHM_V + 2 * A_SHM_K) + wid * 64; float* li_l = wsw; float* al_l = wsw + 32;
    float m_reg = -1e30f, l_reg = 0; f32x16 o[4] = {}; bf16x8 qr[4];
    const bf16_t* Qw = Qb + (long)(wq * 32 + r32) * 128 + mapc + hi * 8;
#pragma unroll
    for (int d0 = 0; d0 < 4; ++d0) qr[d0] = *reinterpret_cast<const bf16x8*>(Qw + d0 * 16);
    const int sr = tid >> 4, sc = (tid & 15) * 8, vst0 = v_st(sr, sc), vst1 = v_st(32 + sr, sc);
    const int vb0 = (int)(uintptr_t)V_lds + v_rd_base(lane);
    struct { bf16x8 vs0, vs1, ks0, ks1; } sr_[1];
#define SLOAD(i, k0) do { sr_[i].vs0 = *(const bf16x8*)(&Vh[(long)((k0) + sr) * 128 + sc]); sr_[i].vs1 = *(const bf16x8*)(&Vh[(long)((k0) + 32 + sr) * 128 + sc]); \
    sr_[i].ks0 = *(const bf16x8*)(&Kh[(long)((k0) + sr) * 128 + sc]); sr_[i].ks1 = *(const bf16x8*)(&Kh[(long)((k0) + 32 + sr) * 128 + sc]); } while (0)
#define SWRITE(b, i) do { *(bf16x8*)(V_lds + (b) * A_SHM_V + vst0) = sr_[i].vs0;          \
    *(bf16x8*)(V_lds + (b) * A_SHM_V + vst1) = sr_[i].vs1; int kc = sc * 2;               \
    *(bf16x8*)(K_lds + (b) * A_SHM_K + KSWZ(sr, kc)) = sr_[i].ks0;                       \
    *(bf16x8*)(K_lds + (b) * A_SHM_K + KSWZ(32 + sr, kc)) = sr_[i].ks1; } while (0)
#define SWAIT() asm volatile("s_waitcnt vmcnt(0)" ::: "memory")
#define RESC(a) do { if (__any((a) < 1.f)) { if (hi == 0) al_l[r32] = (a); asm volatile("s_waitcnt lgkmcnt(0)" ::: "memory"); \
    _Pragma("unroll") for (int d = 0; d < 4; ++d) _Pragma("unroll") for (int r = 0; r < 16; ++r) o[d][r] *= al_l[crow(r, hi)]; } } while (0)
    f32x16 pA0, pA1, pB0, pB1; float mnA, mnB, alA, alB; bf16x8 pa0, pa1, pa2, pa3; const int NT = RB / A_KVBLK;
    constexpr int SE = 0, SO = 0;
    SLOAD(SE, 0); asm volatile("s_waitcnt vmcnt(0)" ::: "memory"); SWRITE(0, SE); __syncthreads();
    qkt(pA0, pA1, K_lds, qr, r32, hi, mapc); partialSM(pA0, pA1, m_reg, mnA, alA);
    SLOAD(SO, A_KVBLK);
    SWAIT(); SWRITE(1, SO); __syncthreads();
    for (int j = 1; j + 1 < NT; j += 2) {
        SBAR(); qkt(pB0, pB1, K_lds + A_SHM_K, qr, r32, hi, mapc);
        finishSM(pA0, pA1, alA, l_reg, pa0, pa1, pa2, pa3); SBAR();
        SLOAD(SO, (j + 1) * A_KVBLK); SBAR();
        pv_d0(o, vb0, pa0, pa1, pa2, pa3); partialSM(pB0, pB1, m_reg, mnB, alB);
        __syncthreads(); SWAIT(); SWRITE(0, SE);
        RESC(alB); __syncthreads();
        SBAR(); qkt(pA0, pA1, K_lds, qr, r32, hi, mapc);
        finishSM(pB0, pB1, alB, l_reg, pa0, pa1, pa2, pa3); SBAR();
        SLOAD(SE, (j + 2) * A_KVBLK); SBAR();
        pv_d0(o, vb0 + A_SHM_V, pa0, pa1, pa2, pa3); partialSM(pA0, pA1, m_reg, mnA, alA);
        __syncthreads(); SWAIT(); SWRITE(1, SO);
        RESC(alA); __syncthreads();
    }
    SBAR(); qkt(pB0, pB1, K_lds + A_SHM_K, qr, r32, hi, mapc);
    finishSM(pA0, pA1, alA, l_reg, pa0, pa1, pa2, pa3); SBAR();
    pv_d0(o, vb0, pa0, pa1, pa2, pa3); partialSM(pB0, pB1, m_reg, mnB, alB);
    __syncthreads(); RESC(alB);
    finishSM(pB0, pB1, alB, l_reg, pa0, pa1, pa2, pa3); SBAR();
    pv_d0(o, vb0 + A_SHM_V, pa0, pa1, pa2, pa3);
    if (hi == 0) li_l[r32] = l_reg;
    asm volatile("s_waitcnt lgkmcnt(0)" ::: "memory");
    float rl[16];
#pragma unroll
    for (int r = 0; r < 16; ++r) rl[r] = __builtin_amdgcn_rcpf(li_l[crow(r, hi)]);
    __syncthreads();
    {
        float* xo = (float*)lds + map * 16384 + (wq * 32) * 128 + r32;
#pragma unroll
        for (int r = 0; r < 16; ++r)
#pragma unroll
            for (int d0 = 0; d0 < 4; ++d0) xo[crow(r, hi) * 128 + d0 * 32] = o[d0][r] * rl[r];
    }
    __syncthreads();
    {
        const float g0 = gd[lane * 2], g1 = gd[lane * 2 + 1];
#pragma unroll 4
        for (int rr = 0; rr < 16; ++rr) {
            const int row = wid * 16 + rr;
            const float2 a0 = *(const float2*)((const float*)lds + row * 128 + lane * 2), a1 = *(const float2*)((const float*)lds + 16384 + row * 128 + lane * 2);
            const float xv = a0.x - lam * a1.x, yv = a0.y - lam * a1.y;
            const float ss = wave_sum(xv * xv + yv * yv);
            const float rs = rsqrtf(ss * (1.0f / 128) + EPS) * 0.8f;
            *(unsigned*)(mixrow + (long)row * 1024 + lane * 2) = cvtpk(xv * rs * g0, yv * rs * g1);
        }
    }
    __syncthreads();
#undef SLOAD
#undef SWRITE
#undef SWAIT
#undef RESC
}

__device__ __forceinline__ void ph_attn(const MK& p, int bid, int nb, int tid_l) {
    const int lane = tid_l & 63;
    float s1 = wave_sum(p.lq1[lane] * p.lk1[lane]), s2 = wave_sum(p.lq2[lane] * p.lk2[lane]);
    const float lam = expf(s1) - expf(s2) + 0.2f;
    const int nrounds = (1024 + nb - 1) / nb;
    for (int rr = 0; rr < nrounds; ++rr) {
        int item;
        if (nb == 256) { int x = bid & 7, j = bid >> 3, hh = rr * 8 + x; item = (hh >> 1) * 64 + (hh & 1) * 32 + j; }
        else { item = rr * nb + bid; if (item >= 1024) break; }
        const int bh = item >> 6, qb = item & 63, b = bh >> 2, h = bh & 3;
        attn_item(p.Q() + ((size_t)bh * SEQ + qb * 128) * 128, p.K() + (size_t)bh * RB * 128, p.V() + (size_t)bh * RB * 128,
                  p.MIX() + ((size_t)(b * SEQ + qb * 128)) * 1024 + h * 128, p.dattn_g, lam, tid_l);
    }
}


__device__ __forceinline__ bf16x8 ldfrag(const bf16_t* p) { return *reinterpret_cast<const bf16x8*>(p); }

__device__ __forceinline__ void ph_kv(const MK& p, int bid, int nb, int tid_l) {
    const int wid = tid_l >> 6, lane = tid_l & 63, r32 = lane & 31, hi = lane >> 5;
    const int nitems = 16 * 2 * 66;
    for (int it = bid * 8 + wid; it < nitems; it += nb * 8) {
        const int c = it % 66, chain = it / 66, dir = chain & 1, bh = chain >> 1;
        const bf16_t* vt = p.VT() + (size_t)bh * 128 * RB + c * 128 + hi * 8;
        const bf16_t* kt = (dir ? p.KTb() : p.KTf()) + (size_t)bh * 64 * RB + c * 128 + hi * 8;
        f32x16 acc[4][2];
#pragma unroll
        for (int mt = 0; mt < 4; ++mt) { acc[mt][0] = f32x16{}; acc[mt][1] = f32x16{}; }
#pragma unroll 2
        for (int ks = 0; ks < 8; ++ks) {
            bf16x8 a[4], b[2];
#pragma unroll
            for (int mt = 0; mt < 4; ++mt) a[mt] = ldfrag(vt + (size_t)(mt * 32 + r32) * RB + ks * 16);
#pragma unroll
            for (int nt = 0; nt < 2; ++nt) b[nt] = ldfrag(kt + (size_t)(nt * 32 + r32) * RB + ks * 16);
#pragma unroll
            for (int mt = 0; mt < 4; ++mt)
#pragma unroll
                for (int nt = 0; nt < 2; ++nt) acc[mt][nt] = __builtin_amdgcn_mfma_f32_32x32x16_bf16(a[mt], b[nt], acc[mt][nt], 0, 0, 0);
        }
        bf16_t* dst = p.KV() + (size_t)it * 8192;
#pragma unroll
        for (int mt = 0; mt < 4; ++mt)
#pragma unroll
            for (int nt = 0; nt < 2; ++nt)
#pragma unroll
                for (int r = 0; r < 16; ++r) dst[(mt * 32 + crow(r, hi)) * 64 + nt * 32 + r32] = f2bf(acc[mt][nt][r]);
    }
}

__device__ __forceinline__ void ph_scan(const MK& p, int bid, int nb, int tid_l) {
    for (int e = bid * NTHR + tid_l; e < 32 * 8192; e += nb * NTHR) {
        const int chain = e >> 13, el = e & 8191, dir = chain & 1, bh = chain >> 1, h = bh & 3;
        const float d = dir ? p.dec_b[h] : p.dec_f[h];
        const float g128 = exp2f(128.0f * log2f(1.0f / (1.0f + expf(-d))));
        const bf16_t* kv = p.KV() + (size_t)chain * 66 * 8192 + el;
        bf16_t* st = p.ST() + (size_t)chain * 66 * 8192 + el;
        float S = 0.f;
        for (int n = 0; n < 66; ++n) {
            const int c = dir == 0 ? n : (n == 0 ? 1 : (n == 1 ? 0 : 67 - n));
            st[(size_t)c * 8192] = f2bf(S);
            S = fmaf(g128, S, bf2f(kv[(size_t)c * 8192]));
        }
    }
}

__device__ __forceinline__ void ph_ret(const MK& p, int bid, int nb, int tid_l) {
    const int tid = tid_l, wid = tid >> 6, lane = tid & 63, r32 = lane & 31, hi = lane >> 5, wq = wid & 3, half = wid >> 2;
    float* img = (float*)smem;
    for (int it = bid; it < 4 * 64 * 2; it += nb) {
        const int hp = it & 1, lc = (it >> 1) & 63, b = it >> 7, h = hp * 2 + half, bh = b * 4 + h;
        const int ib = CTX + lc * 128, c = 2 + lc;
        const float lf = log2f(1.0f / (1.0f + expf(-p.dec_f[h]))), lb = log2f(1.0f / (1.0f + expf(-p.dec_b[h])));
        const bf16_t* rq = p.RQ() + ((size_t)bh * RB + ib + wq * 32 + r32) * 64 + hi * 8;
        bf16x8 q[4];
#pragma unroll
        for (int ks = 0; ks < 4; ++ks) q[ks] = ldfrag(rq + ks * 16);
        f32x16 o[4];
        {
            const bf16_t* stf = p.ST() + ((size_t)(bh * 2 + 0) * 66 + c) * 8192 + hi * 8;
            const bf16_t* stb = p.ST() + ((size_t)(bh * 2 + 1) * 66 + c) * 8192 + hi * 8;
            {
                float rf[16];
#pragma unroll
                for (int r = 0; r < 16; ++r) rf[r] = __builtin_amdgcn_exp2f((float)(wq * 32 + crow(r, hi) + 1) * lf);
#pragma unroll
                for (int d0 = 0; d0 < 4; ++d0) {
                    f32x16 tf = f32x16{};
#pragma unroll
                    for (int ks = 0; ks < 4; ++ks) tf = __builtin_amdgcn_mfma_f32_32x32x16_bf16(q[ks], ldfrag(stf + (size_t)(d0 * 32 + r32) * 64 + ks * 16), tf, 0, 0, 0);
#pragma unroll
                    for (int r = 0; r < 16; ++r) o[d0][r] = tf[r] * rf[r];
                    asm volatile("" ::: "memory");
                }
            }
            {
                float rf[16];
#pragma unroll
                for (int r = 0; r < 16; ++r) rf[r] = __builtin_amdgcn_exp2f((float)(128 - (wq * 32 + crow(r, hi))) * lb);
#pragma unroll
                for (int d0 = 0; d0 < 4; ++d0) {
                    f32x16 tb = f32x16{};
#pragma unroll
                    for (int ks = 0; ks < 4; ++ks) tb = __builtin_amdgcn_mfma_f32_32x32x16_bf16(q[ks], ldfrag(stb + (size_t)(d0 * 32 + r32) * 64 + ks * 16), tb, 0, 0, 0);
#pragma unroll
                    for (int r = 0; r < 16; ++r) o[d0][r] += tb[r] * rf[r];
                    asm volatile("" ::: "memory");
                }
            }
        }
        {
            const int qi = wq * 32 + r32;
            const bf16_t* vt = p.VT() + (size_t)bh * 128 * RB + ib + hi * 8;
#pragma unroll 1
            for (int jb = 0; jb < 4; ++jb) {
                asm volatile("" ::: "memory");
                const bf16_t* rk = p.RK() + ((size_t)bh * RB + ib + jb * 32 + r32) * 64 + hi * 8;
                f32x16 pp = f32x16{};
#pragma unroll
                for (int ks = 0; ks < 4; ++ks) pp = __builtin_amdgcn_mfma_f32_32x32x16_bf16(ldfrag(rk + ks * 16), q[ks], pp, 0, 0, 0);
#pragma unroll
                for (int r = 0; r < 16; ++r) {
                    const int dd = qi - (jb * 32 + crow(r, hi));
                    const float ex = __builtin_amdgcn_exp2f(dd > 0 ? (float)dd * lf : (float)(-dd) * lb); const float w = dd == 0 ? 2.0f : ex;
                    pp[r] *= w;
                }
                bf16x8 pa0, pa1;
                PK4(pp, 0, pa0); PK4(pp, 8, pa1);
#pragma unroll
                for (int d0 = 0; d0 < 4; ++d0) {
                    o[d0] = __builtin_amdgcn_mfma_f32_32x32x16_bf16(pa0, ldfrag(vt + (size_t)(d0 * 32 + r32) * RB + jb * 32), o[d0], 0, 0, 0);
                    o[d0] = __builtin_amdgcn_mfma_f32_32x32x16_bf16(pa1, ldfrag(vt + (size_t)(d0 * 32 + r32) * RB + jb * 32 + 16), o[d0], 0, 0, 0);
                }
            }
        }
        __syncthreads();
        {
            float* xo = img + half * 16384 + (wq * 32) * 128 + r32;
#pragma unroll
            for (int r = 0; r < 16; ++r)
#pragma unroll
                for (int d0 = 0; d0 < 4; ++d0) xo[crow(r, hi) * 128 + d0 * 32] = o[d0][r];
        }
        __syncthreads();
        {
            const float g0 = p.ret_g[lane * 2], g1 = p.ret_g[lane * 2 + 1];
#pragma unroll 4
            for (int rr = 0; rr < 32; ++rr) {
                const int row = wid * 32 + rr, itl = row >> 7, rw = row & 127, hh = hp * 2 + itl;
                const float2 a = *(const float2*)(img + row * 128 + lane * 2);
                const float ss = wave_sum(a.x * a.x + a.y * a.y);
                const float rs = rsqrtf(ss * (1.0f / 128) + EPS);
                const size_t tt = (size_t)b * SEQ + lc * 128 + rw;
                const unsigned gg = *(const unsigned*)(p.RG() + tt * 512 + hh * 128 + lane * 2);
                const float ga = bf2f((bf16_t)(gg & 0xffff)), gb = bf2f((bf16_t)(gg >> 16));
                *(unsigned*)(p.MIX() + tt * 1024 + 512 + hh * 128 + lane * 2) = cvtpk(siluf(ga) * a.x * rs * g0, siluf(gb) * a.y * rs * g1);
            }
        }
    }
}


namespace pg8 {
constexpr int BM = 256, BK = 64, HALF = 128, HTB = HALF * BK * 2;
__device__ __forceinline__ int perm32(int rho) { const int n = rho >> 4, i = rho & 15; return 8 * (i >> 2) + 4 * n + (i & 3); }
struct GUnit { const char* A; const char* B; int i0, i1, i2, i3; };
template <class Epi, class Sched, bool GATHER, bool ALIGN_EPI>
__device__ __forceinline__ void gemm(int K, const Sched& S, const Epi& E, int tid_l) {
    const int tid = tid_l, wid = __builtin_amdgcn_readfirstlane(tid >> 6), lane = tid & 63, wr = wid >> 2, wc = wid & 3, fr = lane & 15, fq = lane >> 4;
    const int nt = K / BK;
    unsigned voffB[2], vAc[2][2], vAn[2][2];
    const size_t kstep = (size_t)(BK * 2);
    const size_t hstepB = (size_t)HALF * K * 2;
#pragma unroll
    for (int i = 0; i < 2; ++i) { int R, C; stage_rc(tid * 16 + i * 8192, R, C); const int Rb = Epi::PERM ? ((R & ~31) + perm32(R & 31)) : R;
        voffB[i] = (unsigned)(Rb * K + C) * 2u; }
    const unsigned ldsw = (unsigned)wid * 1024u;
    const int aoff = lds_byte(wr * 64 + fr, fq * 8), boff = lds_byte(wc * 32 + fr, fq * 8);
#define PG8_SA(b, h) (((b) * 2 + (h)) * HTB)
#define PG8_SB(b, h) ((4 + (b) * 2 + (h)) * HTB)
#define PG8_STAGE(bufoff, gbase, voff) do { _Pragma("unroll") for (int _i = 0; _i < 2; ++_i) \
        __builtin_amdgcn_global_load_lds((const unsigned*)((const char*)(gbase) + (voff)[_i]), (unsigned*)(smem + (bufoff) + ldsw + _i * 8192), 16, 0, 0); } while (0)
#define PG8_LDA(dst, b, h) do { _Pragma("unroll") for (int m = 0; m < 4; ++m) _Pragma("unroll") for (int k = 0; k < 2; ++k) dst[m][k] = *(const bf16x8*)(smem + PG8_SA(b, h) + aoff + m * 2048 + k * 1024); } while (0)
#define PG8_LDB(dst, b, h) do { _Pragma("unroll") for (int n = 0; n < 2; ++n) _Pragma("unroll") for (int k = 0; k < 2; ++k) dst[n][k] = *(const bf16x8*)(smem + PG8_SB(b, h) + boff + n * 2048 + k * 1024); } while (0)
#define PG8_MMA(ai, bj, At, Bt) do { __builtin_amdgcn_s_setprio(1); _Pragma("unroll") for (int m = 0; m < 4; ++m) _Pragma("unroll") for (int n = 0; n < 2; ++n) _Pragma("unroll") for (int k = 0; k < 2; ++k) \
        acc[ai][bj][m][n] = __builtin_amdgcn_mfma_f32_16x16x32_bf16(Bt[n][k], At[m][k], acc[ai][bj][m][n], 0, 0, 0); __builtin_amdgcn_s_setprio(0); } while (0)
#define PG8_WAIT_V(n) asm volatile("s_waitcnt vmcnt(" #n ")" ::: "memory")
#define PG8_WAIT_L(n) asm volatile("s_waitcnt lgkmcnt(" #n ")" ::: "memory")
#define PG8_BAR __builtin_amdgcn_s_barrier()
#define PG8_SCHED __builtin_amdgcn_sched_barrier(0)
    GUnit cur, nxt; int ui = 0;
    if (!S.next(0, cur, vAc)) return;
    f32x4 acc[2][2][4][2];
#pragma unroll
    for (int a = 0; a < 2; ++a)
#pragma unroll
        for (int b = 0; b < 2; ++b)
#pragma unroll
            for (int m = 0; m < 4; ++m)
#pragma unroll
                for (int n = 0; n < 2; ++n) acc[a][b][m][n] = (f32x4){0.f, 0.f, 0.f, 0.f};
    bf16x8 At[4][2], B0[2][2], B1[2][2];
    const char* cA = cur.A; const char* cB = cur.B;
    PG8_STAGE(PG8_SB(0, 0), cB, voffB); PG8_STAGE(PG8_SB(0, 1), cB + hstepB, voffB); PG8_STAGE(PG8_SA(0, 0), cA, vAc[0]); PG8_STAGE(PG8_SA(0, 1), cA, vAc[1]);
    if (wr == 1) PG8_BAR;
    PG8_WAIT_V(2); PG8_BAR;
    PG8_STAGE(PG8_SB(1, 0), cB + kstep, voffB); PG8_STAGE(PG8_SA(1, 0), cA + kstep, vAc[0]); PG8_STAGE(PG8_SB(1, 1), cB + hstepB + kstep, voffB);
    PG8_WAIT_V(6); PG8_BAR;
    for (;;) {
        const bool has_next = S.next(ui + 1, nxt, vAn);
        if (!GATHER || !has_next) {
#pragma unroll
            for (int h = 0; h < 2; ++h)
#pragma unroll
                for (int i = 0; i < 2; ++i) vAn[h][i] = vAc[h][i];
        }
        const char* nA = has_next ? nxt.A : cA; const char* nB = has_next ? nxt.B : cB;
#pragma unroll 1
        for (int t = 0; t < nt; t += 2) {
            const bool last = (t == nt - 2);
            const char* a1 = cA + (size_t)(t + 1) * kstep;
            const char* a2 = last ? nA : cA + (size_t)(t + 2) * kstep; const char* b2 = last ? nB : cB + (size_t)(t + 2) * kstep;
            const char* a3 = a2 + kstep; const char* b3 = b2 + kstep;
            unsigned va2[2][2];
#pragma unroll
            for (int h = 0; h < 2; ++h)
#pragma unroll
                for (int i = 0; i < 2; ++i) va2[h][i] = (GATHER && last) ? vAn[h][i] : vAc[h][i];
            PG8_LDB(B0, 0, 0); PG8_LDB(B1, 0, 1); PG8_SCHED; PG8_LDA(At, 0, 0); PG8_STAGE(PG8_SA(1, 1), a1, vAc[1]);
            PG8_WAIT_V(8); PG8_WAIT_L(0); PG8_BAR; PG8_MMA(0, 0, At, B0); PG8_MMA(0, 1, At, B1); PG8_BAR; PG8_SCHED;
            PG8_LDA(At, 0, 1); PG8_STAGE(PG8_SB(0, 0), b2, voffB); PG8_STAGE(PG8_SB(0, 1), b2 + hstepB, voffB); PG8_STAGE(PG8_SA(0, 0), a2, va2[0]);
            PG8_WAIT_V(8); PG8_WAIT_L(0); PG8_BAR; PG8_MMA(1, 0, At, B0); PG8_MMA(1, 1, At, B1); PG8_BAR; PG8_SCHED;
            PG8_LDB(B0, 1, 0); PG8_LDB(B1, 1, 1); PG8_SCHED; PG8_LDA(At, 1, 0); PG8_STAGE(PG8_SA(0, 1), a2, va2[1]);
            PG8_WAIT_V(8); PG8_WAIT_L(0); PG8_BAR; PG8_MMA(0, 0, At, B0); PG8_MMA(0, 1, At, B1); PG8_BAR; PG8_SCHED;
            PG8_LDA(At, 1, 1); PG8_STAGE(PG8_SB(1, 0), b3, voffB); PG8_STAGE(PG8_SB(1, 1), b3 + hstepB, voffB); PG8_STAGE(PG8_SA(1, 0), a3, va2[0]);
            PG8_WAIT_V(8); PG8_WAIT_L(0); PG8_BAR; PG8_MMA(1, 0, At, B0); PG8_MMA(1, 1, At, B1); PG8_BAR; PG8_SCHED;
        }
        if (ALIGN_EPI) { if (wr == 0) PG8_BAR; }
        E(acc, cur, wr, wc, fr, fq);
        if (!has_next) break;
#pragma unroll
        for (int a = 0; a < 2; ++a)
#pragma unroll
            for (int b = 0; b < 2; ++b)
#pragma unroll
                for (int m = 0; m < 4; ++m)
#pragma unroll
                    for (int n = 0; n < 2; ++n) acc[a][b][m][n] = (f32x4){0.f, 0.f, 0.f, 0.f};
        cur = nxt; cA = nA; cB = nB; ++ui;
#pragma unroll
        for (int h = 0; h < 2; ++h)
#pragma unroll
            for (int i = 0; i < 2; ++i) vAc[h][i] = vAn[h][i];
        if (ALIGN_EPI) { if (wr == 1) PG8_BAR; }
    }
    PG8_WAIT_V(0);
    if (!ALIGN_EPI) { if (wr == 0) PG8_BAR; }
    PG8_BAR;
#undef PG8_SA
#undef PG8_SB
#undef PG8_STAGE
#undef PG8_LDA
#undef PG8_LDB
#undef PG8_MMA
#undef PG8_WAIT_V
#undef PG8_WAIT_L
#undef PG8_BAR
#undef PG8_SCHED
}
__device__ __forceinline__ void plain_voffA(int K, unsigned (&vA)[2][2], int tid_l) {
#pragma unroll
    for (int i = 0; i < 2; ++i) { int R, C; stage_rc(tid_l * 16 + i * 8192, R, C); vA[0][i] = (unsigned)(R * K + C) * 2u; vA[1][i] = (unsigned)((R + HALF) * K + C) * 2u; }
}
}


struct SchedIn { const MK* p; int bid, nb, tid_l;
    __device__ __forceinline__ bool next(int i, pg8::GUnit& u, unsigned (&vA)[2][2]) const {
        const int tile = bid + i * nb; if (tile >= (NR / 256) * 12) return false;
        const int pm = tile / 12, pn = tile % 12;
        u.A = (const char*)(p->H() + (size_t)(pm * 256) * D); u.B = (const char*)(p->w_inT() + (size_t)(pn * 256) * D); u.i0 = pm; u.i1 = pn; u.i2 = 0; u.i3 = 0;
        pg8::plain_voffA(D, vA, tid_l); return true; } };
struct EpiIn { static constexpr bool PERM = false; const MK* p;
    __device__ __forceinline__ void operator()(f32x4 (&acc)[2][2][4][2], const pg8::GUnit& u, int wr, int wc, int fr_in, int fq_in) const {
        int fr = fr_in, fq = fq_in; asm volatile("" : "+v"(fr), "+v"(fq));
        const int pm = u.i0, seg = u.i1, brow = pm * 256;
        const int b = brow / RB, i0 = brow % RB;
        const bool lat = i0 >= CTX;
        const int wid = wr * 4 + wc, lane = fq * 16 + fr;
        if (lat && (seg <= 3 || seg == 6 || seg == 7)) {
#pragma unroll
            for (int ai = 0; ai < 2; ++ai)
#pragma unroll
                for (int m = 0; m < 4; ++m) {
                    const int t = i0 + ai * 128 + wr * 64 + m * 16 + fr - CTX, pos = (wc & 1) ? (t & 63) : (t >> 6);
                    const f32x4 cc = *(const f32x4*)(p->ropec() + pos * 16 + fq * 4), ss = *(const f32x4*)(p->ropes() + pos * 16 + fq * 4);
#pragma unroll
                    for (int bj = 0; bj < 2; ++bj) { const f32x4 x1 = acc[ai][bj][m][0], x2 = acc[ai][bj][m][1];
                        acc[ai][bj][m][0] = x1 * cc - x2 * ss; acc[ai][bj][m][1] = x1 * ss + x2 * cc; }
                }
        }
        if (seg == 7) {
#pragma unroll
            for (int ai = 0; ai < 2; ++ai)
#pragma unroll
                for (int bj = 0; bj < 2; ++bj)
#pragma unroll
                    for (int m = 0; m < 4; ++m) { acc[ai][bj][m][0] = acc[ai][bj][m][0] * 0.125f; acc[ai][bj][m][1] = acc[ai][bj][m][1] * 0.125f; }
        }
        if (seg <= 7 || seg >= 10) {
#pragma unroll
            for (int bj = 0; bj < 2; ++bj) {
                bf16_t* base; long rstride; bool ok = true;
                if (seg <= 1)      { const int h = (seg & 1) * 2 + bj;       base = p->Q() + (((size_t)(b * 4 + h) * SEQ + (i0 - CTX)) * 128 + wc * 32 + fq * 4); rstride = 128; ok = lat; }
                else if (seg <= 3) { const int h = (seg - 2) * 2 + bj;       base = p->K() + (((size_t)(b * 4 + h) * RB + i0) * 128 + wc * 32 + fq * 4);          rstride = 128; }
                else if (seg <= 5) { const int h = (seg - 4) * 2 + bj;       base = p->V() + (((size_t)(b * 4 + h) * RB + i0) * 128 + wc * 32 + fq * 4);          rstride = 128; }
                else if (seg == 6) { const int h = bj * 2 + (wc >> 1);       base = p->RQ() + (((size_t)(b * 4 + h) * RB + i0) * 64 + (wc & 1) * 32 + fq * 4);    rstride = 64; }
                else if (seg == 7) { const int h = bj * 2 + (wc >> 1);       base = p->RK() + (((size_t)(b * 4 + h) * RB + i0) * 64 + (wc & 1) * 32 + fq * 4);    rstride = 64; }
                else               {                                         base = p->RG() + ((size_t)(b * SEQ + (i0 - CTX)) * 512 + (seg - 10) * 256 + bj * 128 + wc * 32 + fq * 4); rstride = 512; ok = lat; }
                if (ok) {
#pragma unroll
                    for (int ai = 0; ai < 2; ++ai)
#pragma unroll
                        for (int m = 0; m < 4; ++m) { bf16_t* rp = base + (long)(ai * 128 + wr * 64 + m * 16 + fr) * rstride;
#pragma unroll
                            for (int n = 0; n < 2; ++n) { u32x2 w; w.x = cvtpk(acc[ai][bj][m][n][0], acc[ai][bj][m][n][1]); w.y = cvtpk(acc[ai][bj][m][n][2], acc[ai][bj][m][n][3]);
                                *(u32x2*)(rp + n * 16) = w; } }
                }
            }
        }
        if (seg >= 7 && seg <= 9) {
            char* img = smem + 131072 + wid * 3968;
            const int npass = seg == 7 ? 2 : 1;
#pragma unroll 1
            for (int ps = 0; ps < npass; ++ps) {
#pragma unroll
                for (int bj = 0; bj < 2; ++bj) {
                    float lg2 = 0.f; bf16_t* baseT;
                    if (seg == 7) { const int h = bj * 2 + (wc >> 1); const float dv = ps == 0 ? p->dec_f[h] : p->dec_b[h]; lg2 = log2f(1.0f / (1.0f + expf(-dv)));
                        baseT = (ps == 0 ? p->KTf() : p->KTb()) + ((size_t)(b * 4 + h) * 64 + (wc & 1) * 32) * RB + i0; }
                    else { const int h = (seg - 8) * 2 + bj; baseT = p->VT() + ((size_t)(b * 4 + h) * 128 + wc * 32) * RB + i0; }
#pragma unroll
                    for (int ai = 0; ai < 2; ++ai)
#pragma unroll
                        for (int mp = 0; mp < 2; ++mp) {
                            asm volatile("s_waitcnt lgkmcnt(0)" ::: "memory");
#pragma unroll
                            for (int mm = 0; mm < 2; ++mm) { const int m = mp * 2 + mm;
                                float f = 1.0f;
                                if (seg == 7) { const int pos = (i0 + ai * 128 + wr * 64 + m * 16 + fr) & 127; f = exp2f((float)(ps == 0 ? 127 - pos : pos) * lg2); }
#pragma unroll
                                for (int n = 0; n < 2; ++n)
#pragma unroll
                                    for (int j = 0; j < 4; ++j) *(bf16_t*)(img + (n * 16 + fq * 4 + j) * 80 + (mm * 16 + fr) * 2) = f2bf(acc[ai][bj][m][n][j] * f); }
                            asm volatile("s_waitcnt lgkmcnt(0)" ::: "memory");
                            const int ib = ai * 128 + wr * 64 + mp * 32;
#pragma unroll
                            for (int k = 0; k < 2; ++k) { const int q = lane + 64 * k, col = q >> 2, ch = q & 3;
                                *(u32x4*)(baseT + (size_t)col * RB + ib + ch * 8) = *(const u32x4*)(img + col * 80 + ch * 16); }
                        }
                }
            }
        }
    } };
__device__ __forceinline__ void ph_gemm_in(const MK& p, int bid, int nb, int tid_l) {
    SchedIn S{&p, bid, nb, tid_l}; EpiIn E{&p};
    pg8::gemm<EpiIn, SchedIn, false, true>(D, S, E, tid_l);
}

struct SchedOut { const MK* p; int bid, nb, tid_l;
    __device__ __forceinline__ bool next(int i, pg8::GUnit& u, unsigned (&vA)[2][2]) const {
        const int tile = bid + i * nb; if (tile >= (T / 256) * 4) return false;
        const int pm = tile >> 2, pn = tile & 3;
        u.A = (const char*)(p->MIX() + (size_t)(pm * 256) * D); u.B = (const char*)(p->w_outT() + (size_t)(pn * 256) * D); u.i0 = pm; u.i1 = pn; u.i2 = 0; u.i3 = 0;
        pg8::plain_voffA(D, vA, tid_l); return true; } };
struct EpiOut { static constexpr bool PERM = false; const MK* p;
    __device__ __forceinline__ void operator()(const f32x4 (&acc)[2][2][4][2], const pg8::GUnit& u, int wr, int wc, int fr, int fq) const {
        const int brow = u.i0 * 256, bcol = u.i1 * 256;
        const float* g1 = p->mod() + (size_t)(brow / SEQ) * 6 * D + 2 * D + bcol + wc * 32 + fq * 4;
        f32x4 gv[2][2];
#pragma unroll
        for (int bj = 0; bj < 2; ++bj)
#pragma unroll
            for (int n = 0; n < 2; ++n) gv[bj][n] = *(const f32x4*)(g1 + bj * 128 + n * 16);
#pragma unroll
        for (int ai = 0; ai < 2; ++ai)
#pragma unroll
            for (int m = 0; m < 4; ++m) {
                const size_t o = (size_t)(brow + ai * 128 + wr * 64 + m * 16 + fr) * D + bcol + wc * 32 + fq * 4;
                f32x4 xv[2][2];
#pragma unroll
                for (int bj = 0; bj < 2; ++bj)
#pragma unroll
                    for (int n = 0; n < 2; ++n) xv[bj][n] = *(const f32x4*)(p->x + o + bj * 128 + n * 16);
#pragma unroll
                for (int bj = 0; bj < 2; ++bj)
#pragma unroll
                    for (int n = 0; n < 2; ++n) *(f32x4*)(p->out + o + bj * 128 + n * 16) = xv[bj][n] + gv[bj][n] * acc[ai][bj][m][n];
                if (m & 1) asm volatile("" ::: "memory");
            }
    } };
__device__ __forceinline__ void ph_gemm_out(const MK& p, int bid, int nb, int tid_l) {
    SchedOut S{&p, bid, nb, tid_l}; EpiOut E{&p};
    pg8::gemm<EpiOut, SchedOut, false, true>(D, S, E, tid_l);
}

__device__ __forceinline__ bool route_token(float logit, float bias, int lane, float& wt) {
    const float score = 1.0f / (1.0f + expf(-logit));
    const float sel = score + bias;
    float m1 = sel, m2 = -INFINITY;
#pragma unroll
    for (int o = 1; o < 8; o <<= 1) {
        float p1 = __shfl_xor(m1, o), p2 = __shfl_xor(m2, o);
        float n1 = fmaxf(m1, p1), n2 = fmaxf(fminf(m1, p1), fmaxf(m2, p2));
        m1 = n1; m2 = n2;
    }
    const float gs = m1 + m2;
    const int grp = lane >> 3;
    int grank = 0;
#pragma unroll
    for (int g2 = 0; g2 < 8; ++g2) { float og = __uint_as_float(__builtin_amdgcn_readlane(__float_as_uint(gs), g2 * 8)); grank += (og > gs || (og == gs && g2 < grp)) ? 1 : 0; }
    const float val = grank < 4 ? sel : -INFINITY;
    int rank = 0;
#pragma unroll
    for (int e = 0; e < 64; ++e) { float ov = __uint_as_float(__builtin_amdgcn_readlane(__float_as_uint(val), e)); rank += (ov > val || (ov == val && e < lane)) ? 1 : 0; }
    const bool chosen = rank < 8;
    const float wsum = wave_sum(chosen ? score : 0.f);
    wt = score / wsum * 2.5f;
    return chosen;
}
template <bool DUMMY, int MODE = 0> __device__ __forceinline__ void ph_route(const MK& p, int bid, int nb, int tid_l) {
    int* cntp = p.cnt() + (DUMMY ? 128 : 0); int* tl = DUMMY ? (int*)(p.ws + 480 * MiB) : p.tok_list(); float* wl_ = DUMMY ? (float*)(p.ws + 488 * MiB) : p.wt_list(); int* tm = DUMMY ? (int*)(p.ws + 496 * MiB) : p.tokmap();
    const int tid = tid_l, wid = tid >> 6, lane = tid & 63, fr = lane & 15, fq = lane >> 4;
    float* lg = (float*)smem;
    int* wcnt = (int*)(smem + 34816);
    int* basel = wcnt + 128;
    bf16_t* H2lo = (bf16_t*)(p.ws + 325 * MiB);
    for (int item = bid; item < T / 128; item += nb) {
        const int t0 = item * 128 + wid * 16, b = (item * 128) / SEQ;
        const float* msh = p.mod() + (size_t)b * 6 * D + 3 * D; const float* msc = p.mod() + (size_t)b * 6 * D + 4 * D;
#pragma unroll 1
        for (int r0 = 0; r0 < 16; r0 += 4) {
            float4 xv[4][4];
#pragma unroll
            for (int rr = 0; rr < 4; ++rr)
#pragma unroll
                for (int q = 0; q < 4; ++q) xv[rr][q] = *(const float4*)(p.out + (size_t)(t0 + r0 + rr) * D + q * 256 + lane * 4);
#pragma unroll
            for (int rr = 0; rr < 4; ++rr) {
                float ss = 0.f;
#pragma unroll
                for (int q = 0; q < 4; ++q) ss += xv[rr][q].x * xv[rr][q].x + xv[rr][q].y * xv[rr][q].y + xv[rr][q].z * xv[rr][q].z + xv[rr][q].w * xv[rr][q].w;
                ss = wave_sum(ss);
                const float rstd = rsqrtf(ss * (1.0f / D) + EPS);
#pragma unroll
                for (int q = 0; q < 4; ++q) {
                    const int c0 = q * 256 + lane * 4;
                    const float4 gg = *(const float4*)(p.norm2_g + c0), sh = *(const float4*)(msh + c0), sc = *(const float4*)(msc + c0);
                    const float h0 = xv[rr][q].x * rstd * gg.x * (1 + sc.x) + sh.x, h1 = xv[rr][q].y * rstd * gg.y * (1 + sc.y) + sh.y;
                    const float h2v = xv[rr][q].z * rstd * gg.z * (1 + sc.z) + sh.z, h3 = xv[rr][q].w * rstd * gg.w * (1 + sc.w) + sh.w;
                    u32x2 wh, wl2; wh.x = cvtpk(h0, h1); wh.y = cvtpk(h2v, h3);
                    wl2.x = cvtpk(h0 - __uint_as_float(wh.x << 16), h1 - __uint_as_float(wh.x & 0xffff0000u));
                    wl2.y = cvtpk(h2v - __uint_as_float(wh.y << 16), h3 - __uint_as_float(wh.y & 0xffff0000u));
                    *(u32x2*)(p.H2() + (size_t)(t0 + r0 + rr) * D + c0) = wh;
                    *(u32x2*)(H2lo + (size_t)(t0 + r0 + rr) * D + c0) = wl2;
                }
            }
        }
        asm volatile("s_waitcnt vmcnt(0)" ::: "memory");
        __syncthreads();
        if (MODE == 3) continue;
        f32x4 acc[4];
#pragma unroll
        for (int nt = 0; nt < 4; ++nt) acc[nt] = (f32x4){0.f, 0.f, 0.f, 0.f};
        {
            const bf16_t* ah_p = p.H2() + (size_t)(t0 + fr) * D + fq * 8; const bf16_t* al_p = H2lo + (size_t)(t0 + fr) * D + fq * 8;
            const bf16_t* rT = p.routerT() + (size_t)fr * D + fq * 8;
#pragma unroll 4
            for (int ks = 0; ks < 32; ++ks) {
                const int k0 = ks * 32;
                const bf16x8 ah = ldfrag(ah_p + k0), al = ldfrag(al_p + k0);
#pragma unroll
                for (int nt = 0; nt < 4; ++nt) {
                    const bf16x8 bh = ldfrag(rT + (size_t)(nt * 16) * D + k0), bl = ldfrag(rT + (size_t)(64 + nt * 16) * D + k0);
                    acc[nt] = __builtin_amdgcn_mfma_f32_16x16x32_bf16(ah, bh, acc[nt], 0, 0, 0);
                    acc[nt] = __builtin_amdgcn_mfma_f32_16x16x32_bf16(ah, bl, acc[nt], 0, 0, 0);
                    acc[nt] = __builtin_amdgcn_mfma_f32_16x16x32_bf16(al, bh, acc[nt], 0, 0, 0);
                }
            }
        }
#pragma unroll
        for (int nt = 0; nt < 4; ++nt)
#pragma unroll
            for (int j = 0; j < 4; ++j) lg[(wid * 16 + fq * 4 + j) * 65 + nt * 16 + fr] = acc[nt][j];
        __syncthreads();
        if (MODE == 2) continue;
        float sc_[64]; unsigned long long ch = 0ull; float wscale = 0.f;
        const int tt = (wid & 1) * 64 + lane, t = item * 128 + tt;
        if (wid < 2) {
            float v[64];
#pragma unroll
            for (int e = 0; e < 64; ++e) { const float x = lg[tt * 65 + e]; sc_[e] = 1.0f / (1.0f + expf(-x)); v[e] = sc_[e] + p.router_b[e]; }
            float gs[8];
#pragma unroll
            for (int g = 0; g < 8; ++g) { float m1 = v[8 * g], m2 = -INFINITY;
#pragma unroll
                for (int i = 1; i < 8; ++i) { const float x = v[8 * g + i]; m2 = fmaxf(m2, fminf(m1, x)); m1 = fmaxf(m1, x); }
                gs[g] = m1 + m2; }
#pragma unroll
            for (int g = 0; g < 8; ++g) { int rank = 0;
#pragma unroll
                for (int g2 = 0; g2 < 8; ++g2) if (g2 != g) rank += (gs[g2] > gs[g] || (gs[g2] == gs[g] && g2 < g)) ? 1 : 0;
                if (rank >= 4) {
#pragma unroll
                    for (int i = 0; i < 8; ++i) v[8 * g + i] = -INFINITY; } }
#pragma unroll
            for (int it = 0; it < 8; ++it) {
                float m = v[0];
#pragma unroll
                for (int e = 1; e < 64; ++e) m = fmaxf(m, v[e]);
                bool found = false;
#pragma unroll
                for (int e = 0; e < 64; ++e) { const bool hit = !found && v[e] == m; if (hit) { ch |= (1ull << e); v[e] = -INFINITY; } found = found || hit; }
            }
            float wsum = 0.f;
#pragma unroll
            for (int e = 0; e < 64; ++e) wsum += ((ch >> e) & 1ull) ? sc_[e] : 0.f;
            wscale = 2.5f / wsum;
#pragma unroll
            for (int e = 0; e < 64; ++e) { const unsigned long long mk = __ballot((ch >> e) & 1ull); if (lane == 0) wcnt[wid * 64 + e] = __popcll(mk); }
        }
        __syncthreads();
        if (wid == 0) basel[lane] = atomicAdd(&cntp[lane], wcnt[lane] + wcnt[64 + lane]);
        __syncthreads();
        if (wid < 2) {
            int kidx = 0;
#pragma unroll
            for (int e = 0; e < 64; ++e) {
                const bool c = (ch >> e) & 1ull;
                const unsigned long long mk = __ballot(c);
                if (c) {
                    const int slot = basel[e] + (wid == 1 ? wcnt[e] : 0) + __popcll(mk & ((1ull << lane) - 1ull));
                    tl[(size_t)e * ECAP + slot] = t; wl_[(size_t)e * ECAP + slot] = sc_[e] * wscale;
                    tm[(size_t)t * 8 + kidx] = e * ECAP + slot; ++kidx;
                }
            }
        }
    }
}

constexpr int MOE_AUX = 162816;
__device__ __forceinline__ void moe_tables(const MK& p, int colt, int* tpre, int* rbase, int tid_l) {
    __syncthreads();
    if (tid_l == 0) { int tp = 0, rb = 0;
        for (int e = 0; e < 65; ++e) { const int c = e < 64 ? p.cnt()[e] : T; tpre[e] = tp; rbase[e] = rb; tp += ((c + 255) >> 8) * colt; rb += c; }
        tpre[65] = tp; rbase[65] = rb; }
    __syncthreads();
}
struct SchedUp { const MK* p; int bid, nb, tid_l, ntiles; const int* tpre; const int* rbase; mutable int e_hint;
    __device__ __forceinline__ bool next(int i, pg8::GUnit& u, unsigned (&vA)[2][2]) const {
        const int tile = bid + i * nb; if (tile >= ntiles) return false;
        int e = e_hint; while (tile >= tpre[e + 1]) ++e; e_hint = e;
        const int j = tile - tpre[e], rt = j >> 1, ct = j & 1, cnt_e = rbase[e + 1] - rbase[e];
        u.A = (const char*)p->H2(); u.B = (const char*)(p->W13t() + ((size_t)e * 512 + ct * 256) * D); u.i0 = e; u.i1 = rt; u.i2 = ct; u.i3 = cnt_e;
#pragma unroll
        for (int i2 = 0; i2 < 2; ++i2) { int R, C; stage_rc(tid_l * 16 + i2 * 8192, R, C);
#pragma unroll
            for (int h = 0; h < 2; ++h) { int slot = rt * 256 + h * 128 + R; if (slot >= cnt_e) slot = 0;
                const int tok = e < 64 ? p->tok_list()[(size_t)e * ECAP + slot] : slot;
                vA[h][i2] = (unsigned)tok * (D * 2u) + (unsigned)C * 2u; } }
        return true; } };
struct EpiUp { static constexpr bool PERM = true; const MK* p; const int* rbase;
    __device__ __forceinline__ void operator()(const f32x4 (&acc)[2][2][4][2], const pg8::GUnit& u, int wr, int wc, int fr, int fq) const {
        const int e = u.i0, rt = u.i1, ct = u.i2, cnt_e = u.i3;
        bf16_t* ab = p->ACT() + (size_t)rbase[e] * DE + ct * 128 + wc * 32 + fq * 8;
#pragma unroll
        for (int ai = 0; ai < 2; ++ai)
#pragma unroll
            for (int m = 0; m < 4; ++m) {
                const int slot = rt * 256 + ai * 128 + wr * 64 + m * 16 + fr;
                u32x4 w;
                w.x = cvtpk(siluf(acc[ai][0][m][0][0]) * acc[ai][1][m][0][0], siluf(acc[ai][0][m][0][1]) * acc[ai][1][m][0][1]);
                w.y = cvtpk(siluf(acc[ai][0][m][0][2]) * acc[ai][1][m][0][2], siluf(acc[ai][0][m][0][3]) * acc[ai][1][m][0][3]);
                w.z = cvtpk(siluf(acc[ai][0][m][1][0]) * acc[ai][1][m][1][0], siluf(acc[ai][0][m][1][1]) * acc[ai][1][m][1][1]);
                w.w = cvtpk(siluf(acc[ai][0][m][1][2]) * acc[ai][1][m][1][2], siluf(acc[ai][0][m][1][3]) * acc[ai][1][m][1][3]);
                if (slot < cnt_e) *(u32x4*)(ab + (size_t)slot * DE) = w;
            }
    } };
__device__ __forceinline__ void ph_moe_up(const MK& p, int bid, int nb, int tid_l) {
    int* tpre = (int*)(smem + MOE_AUX); int* rbase = tpre + 80;
    moe_tables(p, 2, tpre, rbase, tid_l);
    SchedUp S{&p, bid, nb, tid_l, tpre[65], tpre, rbase, 0}; EpiUp E{&p, rbase};
    pg8::gemm<EpiUp, SchedUp, true, true>(D, S, E, tid_l);
}
constexpr float Y_SCALE = 64.0f;
struct SchedDown { const MK* p; int bid, nb, tid_l, ntiles; const int* tpre; const int* rbase; mutable int e_hint;
    __device__ __forceinline__ bool next(int i, pg8::GUnit& u, unsigned (&vA)[2][2]) const {
        const int tile = bid + i * nb; if (tile >= ntiles) return false;
        int e = e_hint; while (tile >= tpre[e + 1]) ++e; e_hint = e;
        const int j = tile - tpre[e], rt = j >> 2, ct = j & 3, cnt_e = rbase[e + 1] - rbase[e];
        u.A = (const char*)(p->ACT() + (size_t)(rbase[e] + rt * 256) * DE); u.B = (const char*)(p->W2t() + ((size_t)e * D + ct * 256) * DE); u.i0 = e; u.i1 = rt; u.i2 = ct; u.i3 = cnt_e;
        pg8::plain_voffA(DE, vA, tid_l); return true; } };
template <int MODE> struct EpiDown { static constexpr bool PERM = true; const MK* p; const int* rbase;
    __device__ __forceinline__ void operator()(const f32x4 (&acc)[2][2][4][2], const pg8::GUnit& u, int wr, int wc, int fr, int fq) const {
        const int e = u.i0, rt = u.i1, ct = u.i2, cnt_e = u.i3;
        const int col0 = ct * 256 + wc * 32 + fq * 8;
        if (e < 64) {
            const float* wl = p->wt_list() + (size_t)e * ECAP;
            float wv[2][4];
#pragma unroll
            for (int ai = 0; ai < 2; ++ai)
#pragma unroll
                for (int m = 0; m < 4; ++m) { const int sl = rt * 256 + ai * 128 + wr * 64 + m * 16 + fr; wv[ai][m] = wl[sl < cnt_e ? sl : 0] * Y_SCALE; }
            const int wid = wr * 4 + wc, lane = fq * 16 + fr;
            char* wa = smem + 131072 + wid * 3968;
            unsigned char* yb = p->Y() + (size_t)rbase[e] * D + ct * 256 + wc * 64 + (lane & 3) * 16;
#pragma unroll
            for (int ai = 0; ai < 2; ++ai)
#pragma unroll
                for (int m = 0; m < 4; ++m) {
                    const float w = wv[ai][m];
                    char* img = wa + ((m & 1) ? 1280 : 0);
#pragma unroll
                    for (int bj = 0; bj < 2; ++bj) {
                        u32x2 pk;
#pragma unroll
                        for (int n = 0; n < 2; ++n) {
                            float v0 = fminf(fmaxf(acc[ai][bj][m][n][0] * w, -448.f), 448.f), v1 = fminf(fmaxf(acc[ai][bj][m][n][1] * w, -448.f), 448.f);
                            float v2 = fminf(fmaxf(acc[ai][bj][m][n][2] * w, -448.f), 448.f), v3 = fminf(fmaxf(acc[ai][bj][m][n][3] * w, -448.f), 448.f);
                            int q = 0; q = __builtin_amdgcn_cvt_pk_fp8_f32(v0, v1, q, false); q = __builtin_amdgcn_cvt_pk_fp8_f32(v2, v3, q, true);
                            if (n == 0) pk.x = (unsigned)q; else pk.y = (unsigned)q;
                        }
                        *(u32x2*)(img + fr * 80 + bj * 32 + fq * 8) = pk;
                    }
                    asm volatile("s_waitcnt lgkmcnt(0)" ::: "memory");
                    const int rr = lane >> 2, slot = rt * 256 + ai * 128 + wr * 64 + m * 16 + rr;
                    const u32x4 v = *(const u32x4*)(img + rr * 80 + (lane & 3) * 16);
                    if (MODE == 1) asm volatile("" :: "v"(v)); else if (slot < cnt_e) *(u32x4*)(yb + (size_t)slot * D) = v;
                }
        } else {
            const float* g2 = p->mod() + (size_t)((rt * 256) / SEQ) * 6 * D + 5 * D + col0;
            f32x4 gv[2][2];
#pragma unroll
            for (int bj = 0; bj < 2; ++bj)
#pragma unroll
                for (int n = 0; n < 2; ++n) gv[bj][n] = *(const f32x4*)(g2 + bj * 128 + n * 4);
            float* xb = p->out + (size_t)(rt * 256) * D + col0;
#pragma unroll
            for (int ai = 0; ai < 2; ++ai)
#pragma unroll
                for (int m = 0; m < 4; ++m) {
                    float* xp = xb + (size_t)(ai * 128 + wr * 64 + m * 16 + fr) * D;
                    f32x4 xv[2][2];
#pragma unroll
                    for (int bj = 0; bj < 2; ++bj)
#pragma unroll
                        for (int n = 0; n < 2; ++n) xv[bj][n] = *(const f32x4*)(xp + bj * 128 + n * 4);
#pragma unroll
                    for (int bj = 0; bj < 2; ++bj)
#pragma unroll
                        for (int n = 0; n < 2; ++n) *(f32x4*)(xp + bj * 128 + n * 4) = xv[bj][n] + gv[bj][n] * acc[ai][bj][m][n];
                    if (m & 1) asm volatile("" ::: "memory");
                }
        }
    } };
template <bool DUMMY, int MODE = 0> __device__ __forceinline__ void ph_moe_down(const MK& p, int bid, int nb, int tid_l) {
    int* tpre = (int*)(smem + MOE_AUX); int* rbase = tpre + 80;
    moe_tables(p, 4, tpre, rbase, tid_l);
    SchedDown S{&p, bid, nb, tid_l, DUMMY ? tpre[64] : tpre[65], tpre, rbase, 0}; EpiDown<MODE> E{&p, rbase};
    pg8::gemm<EpiDown<MODE>, SchedDown, false, true>(DE, S, E, tid_l);
}

template <bool DUMMY> __device__ __forceinline__ void ph_final(const MK& p, int bid, int nb, int tid_l) {
    const int wid = tid_l >> 6, lane = tid_l & 63;
    int* tpre = (int*)(smem + MOE_AUX); int* rbase = tpre + 80;
    moe_tables(p, 1, tpre, rbase, tid_l);
    for (int t = bid * 8 + wid; t < T; t += nb * 8) {
        const int b = t / SEQ;
        float f[16];
#pragma unroll
        for (int i = 0; i < 16; ++i) f[i] = 0.f;
#pragma unroll
        for (int k = 0; k < 8; ++k) {
            const int id = p.tokmap()[(size_t)t * 8 + k], e = id >> 15, slot = id & (ECAP - 1);
            const unsigned char* yr = p.Y() + (size_t)(rbase[e] + slot) * D + lane * 4;
#pragma unroll
            for (int q = 0; q < 4; ++q) {
                const int w = *(const int*)(yr + q * 256);
                const auto lo = __builtin_amdgcn_cvt_pk_f32_fp8(w, false); const auto hi = __builtin_amdgcn_cvt_pk_f32_fp8(w, true);
                f[q * 4 + 0] += lo[0]; f[q * 4 + 1] += lo[1]; f[q * 4 + 2] += hi[0]; f[q * 4 + 3] += hi[1];
            }
        }
        const int pcol = ((lane >> 3) & 1) * 128 + (lane >> 4) * 32 + (lane & 7) * 4;
        const float* g2 = p.mod() + (size_t)b * 6 * D + 5 * D + pcol;
        float* xo = p.out + (size_t)t * D + pcol;
        float v[16]; float ss = 0.f;
#pragma unroll
        for (int q = 0; q < 4; ++q) {
            const float4 xv = *(const float4*)(xo + q * 256), g = *(const float4*)(g2 + q * 256);
            v[q * 4 + 0] = xv.x + g.x * f[q * 4 + 0] * (1.0f / Y_SCALE); v[q * 4 + 1] = xv.y + g.y * f[q * 4 + 1] * (1.0f / Y_SCALE);
            v[q * 4 + 2] = xv.z + g.z * f[q * 4 + 2] * (1.0f / Y_SCALE); v[q * 4 + 3] = xv.w + g.w * f[q * 4 + 3] * (1.0f / Y_SCALE);
            ss += v[q * 4] * v[q * 4] + v[q * 4 + 1] * v[q * 4 + 1] + v[q * 4 + 2] * v[q * 4 + 2] + v[q * 4 + 3] * v[q * 4 + 3];
        }
        ss = wave_sum(ss);
        const float rstd = rsqrtf(ss * (1.0f / D) + EPS);
#pragma unroll
        for (int q = 0; q < 4; ++q) {
            const float4 gf = *(const float4*)(p.final_g + q * 256 + pcol);
            *(float4*)((DUMMY ? (float*)(p.ws + 42 * MiB) + (size_t)t * D + pcol : xo) + q * 256) = make_float4(v[q * 4] * rstd * gf.x, v[q * 4 + 1] * rstd * gf.y, v[q * 4 + 2] * rstd * gf.z, v[q * 4 + 3] * rstd * gf.w);
        }
    }
}


#define XB_TMO      128
#define XB_XCNT(j)  (256  + 64 * (j))
#define XB_XSUB(j)  (1280 + 64 * (j))
#define XB_XGEN(j)  (2304 + 64 * (j))
#define XB_TOP      3328
#define XB_TOPGEN   3392
#define XCD_BAR_WORDS 3456
#define XB_SPIN_CAP (1u << 22)
#define LAS __attribute__((address_space(3)))
__device__ __forceinline__ unsigned xb_ld(unsigned* p)              { return __hip_atomic_load(p, __ATOMIC_RELAXED, __HIP_MEMORY_SCOPE_AGENT); }
__device__ __forceinline__ unsigned xb_add(unsigned* p, unsigned v) { return __hip_atomic_fetch_add(p, v, __ATOMIC_RELAXED, __HIP_MEMORY_SCOPE_AGENT); }
__device__ __forceinline__ unsigned xb_xcc_id() { return (unsigned)__builtin_amdgcn_s_getreg((3 << 11) | 20) & 0xFu; }
#define XB_SPIN(cond, bar) do { unsigned _sp = 0; while (cond) { __builtin_amdgcn_s_sleep(1); \
    if ((++_sp & 255u) == 0u) { if (xb_ld(&(bar)[XB_TMO])) break; if (_sp > XB_SPIN_CAP) { atomicAdd(&(bar)[XB_TMO], 1u); break; } } } } while (0)
struct XcdBarrier { unsigned* bar; unsigned x; volatile LAS unsigned* st; };
__device__ __forceinline__ XcdBarrier xcd_barrier_post(unsigned* bar, volatile LAS unsigned* st, int tid) {
    XcdBarrier b; b.bar = bar; b.x = xb_xcc_id(); b.st = st;
    if (tid == 0) (void)xb_add(&bar[XB_XCNT(b.x)], 1u);
    return b;
}
__device__ __forceinline__ void xcd_barrier_complete(unsigned* bar, unsigned x, unsigned& nloc, unsigned& nx) {
    const unsigned G = gridDim.x * gridDim.y * gridDim.z;
    unsigned sum, cnt, mine, sp = 0u;
    for (;;) {
        sum = 0u; cnt = 0u; mine = 0u;
#pragma unroll
        for (unsigned j = 0; j < 16; ++j) { const unsigned c = xb_ld(&bar[XB_XCNT(j)]); sum += c; cnt += (c > 0u) ? 1u : 0u; mine = (j == x) ? c : mine; }
        if (sum == G) break;
        __builtin_amdgcn_s_sleep(1);
        if ((++sp & 255u) == 0u) { if (xb_ld(&bar[XB_TMO])) break; if (sp > XB_SPIN_CAP) { atomicAdd(&bar[XB_TMO], 1u); break; } }
    }
    nloc = mine > 0u ? mine : 1u; nx = cnt > 0u ? cnt : 1u;
}
__device__ __forceinline__ void xcd_barrier(const XcdBarrier& b, int tid) {
    asm volatile("s_waitcnt vmcnt(0)" ::: "memory");
    __syncthreads();
    if (tid == 0) {
        unsigned* bar = b.bar;
        __builtin_amdgcn_s_waitcnt(0);
        unsigned nloc = b.st[0], nx = b.st[1];
        if (nloc == 0u) { xcd_barrier_complete(bar, b.x, nloc, nx); b.st[0] = nloc; b.st[1] = nx; }
        const unsigned old = xb_add(&bar[XB_XSUB(b.x)], 1u);
        const unsigned gen = old / nloc;
        if (old + 1u == (gen + 1u) * nloc) {
            __builtin_amdgcn_fence(__ATOMIC_RELEASE, "agent");
            asm volatile("s_waitcnt vmcnt(0)" ::: "memory");
            const unsigned og = xb_add(&bar[XB_TOP], 1u);
            const unsigned tg = og / nx;
            if (og + 1u == (tg + 1u) * nx) xb_add(&bar[XB_TOPGEN], 1u);
            else XB_SPIN(xb_ld(&bar[XB_TOPGEN]) == tg, bar);
            __builtin_amdgcn_fence(__ATOMIC_ACQUIRE, "agent");
            xb_add(&bar[XB_XGEN(b.x)], 1u);
            asm volatile("s_waitcnt vmcnt(0)" ::: "memory");
        } else {
            XB_SPIN(xb_ld(&bar[XB_XGEN(b.x)]) == gen, bar);
            __builtin_amdgcn_fence(__ATOMIC_ACQUIRE, "agent");
            asm volatile("s_waitcnt vmcnt(0)" ::: "memory");
        }
    }
    __syncthreads();
}

__global__ __launch_bounds__(512, 2) void k_mega(MK p) {
    cg::grid_group grid = cg::this_grid();
    const int bid = blockIdx.x, nb = gridDim.x;
    volatile LAS unsigned* xst = (volatile LAS unsigned*)(smem + 162816 + 768);
    if (threadIdx.x < 4) xst[threadIdx.x] = 0u;
    __syncthreads();
    const XcdBarrier xb = xcd_barrier_post((unsigned*)(p.ws + 524288), xst, (int)threadIdx.x);
#define PH_TID() int t_ = threadIdx.x; asm volatile("" : "+v"(t_))
    { PH_TID(); if (bid == 0 && t_ < 256) p.cnt()[t_] = 0; ph_mod(p, bid, nb, t_); ph_convert(p, bid, nb, t_); }
#if DUP == 10
    { PH_TID(); ph_convert(p, bid, nb, t_); }
#endif
    grid.sync();
    { PH_TID(); ph_ln1(p, bid, nb, t_); }
#if DUP == 1
    { PH_TID(); ph_ln1(p, bid, nb, t_); }
#endif
    xcd_barrier(xb, (int)threadIdx.x);
    { PH_TID(); ph_gemm_in(p, bid, nb, t_); }
#if DUP == 2
    { PH_TID(); ph_gemm_in(p, bid, nb, t_); }
#endif
    xcd_barrier(xb, (int)threadIdx.x);
    { PH_TID(); ph_attn(p, bid, nb, t_); }
#if DUP == 3
    { PH_TID(); ph_attn(p, bid, nb, t_); }
#endif
    { PH_TID(); ph_kv(p, bid, nb, t_); }
#if DUP == 11
    { PH_TID(); ph_kv(p, bid, nb, t_); }
#endif
    xcd_barrier(xb, (int)threadIdx.x);
    { PH_TID(); ph_scan(p, bid, nb, t_); }
    xcd_barrier(xb, (int)threadIdx.x);
    { PH_TID(); ph_ret(p, bid, nb, t_); }
#if DUP == 5
    { PH_TID(); ph_ret(p, bid, nb, t_); }
#endif
    xcd_barrier(xb, (int)threadIdx.x);
    { PH_TID(); ph_gemm_out(p, bid, nb, t_); }
#if DUP == 6
    { PH_TID(); ph_gemm_out(p, bid, nb, t_); }
#endif
    xcd_barrier(xb, (int)threadIdx.x);
#if DUP == 7
    { PH_TID(); ph_route<true>(p, bid, nb, t_); }
#endif
#if DUP == 72
    { PH_TID(); ph_route<true, 2>(p, bid, nb, t_); }
#endif
#if DUP == 73
    { PH_TID(); ph_route<true, 3>(p, bid, nb, t_); }
#endif
    { PH_TID(); ph_route<false>(p, bid, nb, t_); }
    xcd_barrier(xb, (int)threadIdx.x);
    { PH_TID(); ph_moe_up(p, bid, nb, t_); }
#if DUP == 8
    { PH_TID(); ph_moe_up(p, bid, nb, t_); }
#endif
    xcd_barrier(xb, (int)threadIdx.x);
#if DUP == 9
    { PH_TID(); ph_moe_down<true>(p, bid, nb, t_); }
#endif
#if DUP == 91
    { PH_TID(); ph_moe_down<true, 1>(p, bid, nb, t_); }
#endif
    { PH_TID(); ph_moe_down<false>(p, bid, nb, t_); }
    xcd_barrier(xb, (int)threadIdx.x);
#if DUP == 13
    { PH_TID(); ph_final<true>(p, bid, nb, t_); }
#endif
    { PH_TID(); ph_final<false>(p, bid, nb, t_); }
#undef PH_TID
}
constexpr int LDS_TOTAL = 163840;
extern "C" void kernel_launch(void* const* d_in, const int* in_sizes, int n_in, void* d_out, int out_size, void* d_ws, size_t ws_size, hipStream_t stream) {
    char* ws = (char*)d_ws;
    MK mk{};
    mk.x = (const float*)d_in[0]; mk.c = (const float*)d_in[1]; mk.ctx = (const float*)d_in[2]; mk.cctx = (const float*)d_in[3]; mk.ada_w = (const float*)d_in[4]; mk.ada_b = (const float*)d_in[5];
    mk.norm1_g = (const float*)d_in[6]; mk.w_in = (const float*)d_in[7]; mk.lq1 = (const float*)d_in[8]; mk.lk1 = (const float*)d_in[9]; mk.lq2 = (const float*)d_in[10]; mk.lk2 = (const float*)d_in[11];
    mk.dattn_g = (const float*)d_in[12]; mk.dec_f = (const float*)d_in[13]; mk.dec_b = (const float*)d_in[14]; mk.ret_g = (const float*)d_in[15]; mk.w_out = (const float*)d_in[16];
    mk.norm2_g = (const float*)d_in[17]; mk.router_w = (const float*)d_in[18]; mk.router_b = (const float*)d_in[19]; mk.ew1 = (const float*)d_in[20]; mk.ew3 = (const float*)d_in[21];
    mk.ew2 = (const float*)d_in[22]; mk.sw1 = (const float*)d_in[23]; mk.sw3 = (const float*)d_in[24]; mk.sw2 = (const float*)d_in[25]; mk.final_g = (const float*)d_in[26];
    mk.out = (float*)d_out;
    mk.ws = ws;
    mk.dbgP = nullptr; mk.dbg_lo = 0; mk.dbg_hi = 12; mk.conv_limit = 1 << 30;
    static int grid_blocks = 0;
    if (!grid_blocks) {
        (void)hipFuncSetAttribute((const void*)k_mega, hipFuncAttributeMaxDynamicSharedMemorySize, LDS_TOTAL);
        int dev = 0, cus = 0, per_cu = 0;
        (void)hipGetDevice(&dev);
        (void)hipDeviceGetAttribute(&cus, hipDeviceAttributeMultiprocessorCount, dev);
        (void)hipOccupancyMaxActiveBlocksPerMultiprocessor(&per_cu, k_mega, 512, LDS_TOTAL);
        if (per_cu > 1) per_cu = 1;
        grid_blocks = cus * per_cu;
        if (grid_blocks <= 0) { fprintf(stderr, "occupancy query failed: cus %d per_cu %d\n", cus, per_cu); grid_blocks = 256; }
    }
    (void)hipMemsetAsync(ws + 524288, 0, XCD_BAR_WORDS * 4, stream);
    void* args[] = {&mk};
    hipError_t e = hipLaunchCooperativeKernel((void*)k_mega, dim3(grid_blocks), dim3(512), args, LDS_TOTAL, stream);
    if (e != hipSuccess) fprintf(stderr, "cooperative launch failed: %s (grid %d)\n", hipGetErrorString(e), grid_blocks);
}
```

```cpp
#include <hip/hip_runtime.h>
#include <hip/hip_cooperative_groups.h>
#include <cstdio>
namespace cg = cooperative_groups;
#ifndef DUP
#define DUP 0
#endif
#include <stdint.h>

constexpr int D = 1024, NB = 4, SEQ = 8192, CTX = 256, RB = SEQ + CTX  , NR = NB * RB  , T = NB * SEQ;
constexpr int NE = 64, DE = 256, ECAP = 32768;
constexpr float EPS = 1e-6f;
typedef unsigned short bf16_t;

__device__ __forceinline__ float siluf(float v) { return v / (1.0f + expf(-v)); }
__device__ __forceinline__ float wave_sum(float v) {
#pragma unroll
    for (int o = 32; o > 0; o >>= 1) v += __shfl_xor(v, o);
    return v;
}
__device__ __forceinline__ float wave_max(float v) {
#pragma unroll
    for (int o = 32; o > 0; o >>= 1) v = fmaxf(v, __shfl_xor(v, o));
    return v;
}
__device__ __forceinline__ float block_sum(float v, float* red) {
    v = wave_sum(v);
    __syncthreads();
    if ((threadIdx.x & 63) == 0) red[threadIdx.x >> 6] = v;
    __syncthreads();
    return red[0] + red[1] + red[2] + red[3];
}
__device__ __forceinline__ float block_max(float v, float* red) {
    v = wave_max(v);
    __syncthreads();
    if ((threadIdx.x & 63) == 0) red[threadIdx.x >> 6] = v;
    __syncthreads();
    return fmaxf(fmaxf(red[0], red[1]), fmaxf(red[2], red[3]));
}

typedef short bf16x8 __attribute__((ext_vector_type(8)));
typedef short s16x4 __attribute__((ext_vector_type(4)));
typedef float f32x4 __attribute__((ext_vector_type(4)));
typedef float f32x16 __attribute__((ext_vector_type(16)));
typedef unsigned u32x2 __attribute__((ext_vector_type(2)));
typedef unsigned u32x4 __attribute__((ext_vector_type(4)));
extern __shared__ __attribute__((aligned(1024))) char smem[];
constexpr int NTHR = 512;
constexpr int GEMM_LDS = 131072;

__device__ __forceinline__ unsigned cvtpk(float lo, float hi) { unsigned r; asm volatile("v_cvt_pk_bf16_f32 %0, %1, %2" : "=v"(r) : "v"(lo), "v"(hi)); return r; }
__device__ __forceinline__ bf16_t f2bf(float v) { return (bf16_t)(cvtpk(v, v) & 0xffffu); }
__device__ __forceinline__ float bf2f(bf16_t v) { return __uint_as_float(((unsigned)v) << 16); }

constexpr size_t MiB = 1048576;
struct MK {
    const float *x, *c, *ctx, *cctx, *ada_w, *ada_b, *norm1_g, *w_in, *lq1, *lk1, *lq2, *lk2, *dattn_g, *dec_f, *dec_b, *ret_g, *w_out, *norm2_g, *router_w, *router_b,
        *ew1, *ew3, *ew2, *sw1, *sw3, *sw2, *final_g;
    float* out; char* ws;
    float* dbgP; long dbg_lo, dbg_hi; long conv_limit;
#define WSF(name, type, off) __device__ __forceinline__ type* name() const { return (type*)(ws + (off)); }
    WSF(mod, float, 0) WSF(cnt, int, 131072) WSF(ropec, float, 262144) WSF(ropes, float, 262144 + 8192)
    WSF(w_inT, bf16_t, 1 * MiB) WSF(w_outT, bf16_t, 7 * MiB) WSF(routerT, bf16_t, 9 * MiB) WSF(W2t, bf16_t, 9 * MiB + 524288)
    WSF(H, bf16_t, 42 * MiB) WSF(MIX, bf16_t, 42 * MiB) WSF(KV, bf16_t, 112 * MiB) WSF(ST, bf16_t, 147 * MiB) WSF(ACT, bf16_t, 42 * MiB)
    WSF(W13t, bf16_t, 194 * MiB) WSF(H2, bf16_t, 260 * MiB)
    WSF(Q, bf16_t, 260 * MiB) WSF(K, bf16_t, 292 * MiB) WSF(V, bf16_t, 325 * MiB) WSF(RQ, bf16_t, 358 * MiB) WSF(RK, bf16_t, 375 * MiB)
    WSF(KTf, bf16_t, 392 * MiB) WSF(KTb, bf16_t, 409 * MiB) WSF(VT, bf16_t, 426 * MiB) WSF(RG, bf16_t, 459 * MiB)
    WSF(Y, unsigned char, 194 * MiB) WSF(tok_list, int, 452 * MiB) WSF(wt_list, float, 460 * MiB) WSF(tokmap, int, 468 * MiB)
#undef WSF
};

__device__ __forceinline__ void ph_mod(const MK& p, int bid, int nb, int tid_l) {
    float* red = (float*)smem;
    for (int it = bid; it < 6 * D / 32; it += nb) {
        const int col = tid_l & 31, kg = tid_l >> 5, j = it * 32 + col;
        float a[5] = {0, 0, 0, 0, 0};
        for (int k = kg * 64; k < kg * 64 + 64; ++k) {
            float w = p.ada_w[(size_t)k * 6 * D + j];
#pragma unroll
            for (int r = 0; r < 5; ++r) { float cv = r < 4 ? p.c[r * D + k] : p.cctx[k]; a[r] += siluf(cv) * w; }
        }
        __syncthreads();
#pragma unroll
        for (int r = 0; r < 5; ++r) red[(kg * 5 + r) * 32 + col] = a[r];
        __syncthreads();
        if (tid_l < 160) {
            int r = tid_l >> 5; float s = 0;
            for (int g = 0; g < 16; ++g) s += red[(g * 5 + r) * 32 + col];
            p.mod()[(size_t)r * 6 * D + j] = s + p.ada_b[j];
        }
    }
    if (bid == nb - 1) {
        for (int i = tid_l; i < 128 * 16; i += NTHR) {
            int pos = i >> 4, f = i & 15;
            float inv_freq = (float)pow(10000.0, -(double)f / 16.0);
            float s, c; sincosf((float)pos * inv_freq, &s, &c);
            p.ropec()[i] = c; p.ropes()[i] = s;
        }
    }
    __syncthreads();
}

__device__ __forceinline__ void tr_tile(const float* src, int ldsrc, int k0, int n0, bf16_t* dst, int lddst, int mode  , bf16_t* dst2, int tid_l) {
    float* t = (float*)smem;
    __syncthreads();
    for (int i = tid_l; i < 64 * 16; i += NTHR) {
        int r = i >> 4, c4 = (i & 15) * 4;
        float4 v = *(const float4*)(src + (size_t)(k0 + r) * ldsrc + n0 + c4);
        t[r * 65 + c4] = v.x; t[r * 65 + c4 + 1] = v.y; t[r * 65 + c4 + 2] = v.z; t[r * 65 + c4 + 3] = v.w;
    }
    __syncthreads();
    for (int i = tid_l; i < 64 * 16; i += NTHR) {
        int n = i >> 4, k4 = (i & 15) * 4;
        float a = t[(k4 + 0) * 65 + n], b = t[(k4 + 1) * 65 + n], c = t[(k4 + 2) * 65 + n], d = t[(k4 + 3) * 65 + n];
        int nn = n0 + n, row = nn;
        if (mode == 1 || mode == 2) { int ct = nn >> 7; row = ct * 256 + (mode == 2 ? 128 : 0) + (nn & 127); }
        u32x2 w; w.x = cvtpk(a, b); w.y = cvtpk(c, d);
        *(u32x2*)(dst + (size_t)row * lddst + k0 + k4) = w;
        if (mode == 3) {
            float ah = bf2f((bf16_t)(w.x & 0xffff)), bh = bf2f((bf16_t)(w.x >> 16)), ch = bf2f((bf16_t)(w.y & 0xffff)), dh = bf2f((bf16_t)(w.y >> 16));
            u32x2 l; l.x = cvtpk(a - ah, b - bh); l.y = cvtpk(c - ch, d - dh);
            *(u32x2*)(dst2 + (size_t)row * lddst + k0 + k4) = l;
        }
    }
}
constexpr int CV_STATIC = 16 * 48 + 16 * 16 + 16, CV_E13 = 65 * 2 * 16 * 4, CV_E2 = 65 * 4 * 16, CV_TOTAL = CV_STATIC + CV_E13 + CV_E2;
__device__ __forceinline__ void convert_tile(const MK& p, int j, int tid_l) {
    const int n_win = 16 * 48, n_wout = 16 * 16, n_rt = 16;
    if (j < n_win) { tr_tile(p.w_in, 3072, (j / 48) * 64, (j % 48) * 64, p.w_inT(), 1024, 0, nullptr, tid_l); return; } j -= n_win;
    if (j < n_wout) { tr_tile(p.w_out, 1024, (j / 16) * 64, (j % 16) * 64, p.w_outT(), 1024, 0, nullptr, tid_l); return; } j -= n_wout;
    if (j < n_rt) { tr_tile(p.router_w, 64, j * 64, 0, p.routerT(), 1024, 3, p.routerT() + 64 * 1024, tid_l); return; } j -= n_rt;
    if (j < CV_E13) {
        int e = j / 128, r = j % 128, which = r / 64, tt = r % 64;
        const float* src = e < 64 ? (which ? p.ew3 : p.ew1) + (size_t)e * D * DE : (which ? p.sw3 : p.sw1);
        tr_tile(src, DE, (tt / 4) * 64, (tt % 4) * 64, p.W13t() + (size_t)e * 512 * 1024, 1024, 1 + which, nullptr, tid_l); return; } j -= CV_E13;
    { int e = j / 64, tt = j % 64;
      const float* src = e < 64 ? p.ew2 + (size_t)e * DE * D : p.sw2;
      tr_tile(src, D, (tt / 16) * 64, (tt % 16) * 64, p.W2t() + (size_t)e * 1024 * 256, 256, 0, nullptr, tid_l); }
}
__device__ __forceinline__ void ph_convert(const MK& p, int bid, int nb, int tid_l) {
    for (int it = bid; it < CV_STATIC; it += nb) convert_tile(p, it, tid_l);
    __syncthreads();
}
__device__ __forceinline__ void ph_convert_dyn(const MK& p, int tid_l) {
    int* q = (int*)smem + 8192;
    for (;;) {
        __syncthreads();
        if (tid_l == 0) q[0] = atomicAdd(&p.cnt()[200], 8);
        __syncthreads();
        const int base = q[0];
        if (base >= CV_E13 + CV_E2) break;
        for (int k = 0; k < 8; ++k) if (base + k < CV_E13 + CV_E2) convert_tile(p, CV_STATIC + base + k, tid_l);
    }
    __syncthreads();
}

__device__ __forceinline__ void ph_ln1(const MK& p, int bid, int nb, int tid_l) {
    const int wid = tid_l >> 6, lane = tid_l & 63;
    for (int R = bid * 8 + wid; R < NR; R += nb * 8) {
        int b = R / RB, i = R % RB;
        const float* src = i < CTX ? p.ctx + ((size_t)b * CTX + i) * D : p.x + ((size_t)b * SEQ + (i - CTX)) * D;
        const float* m = p.mod() + (size_t)(i < CTX ? 4 : b) * 6 * D;
        float4 v[4]; float ss = 0;
#pragma unroll
        for (int q = 0; q < 4; ++q) { v[q] = *(const float4*)(src + q * 256 + lane * 4); ss += v[q].x * v[q].x + v[q].y * v[q].y + v[q].z * v[q].z + v[q].w * v[q].w; }
        ss = wave_sum(ss);
        float rstd = rsqrtf(ss * (1.0f / D) + EPS);
#pragma unroll
        for (int q = 0; q < 4; ++q) {
            int c0 = q * 256 + lane * 4;
            float4 gg = *(const float4*)(p.norm1_g + c0), sh = *(const float4*)(m + c0), sc = *(const float4*)(m + D + c0);
            float o0 = v[q].x * rstd * gg.x * (1 + sc.x) + sh.x, o1 = v[q].y * rstd * gg.y * (1 + sc.y) + sh.y;
            float o2 = v[q].z * rstd * gg.z * (1 + sc.z) + sh.z, o3 = v[q].w * rstd * gg.w * (1 + sc.w) + sh.w;
            u32x2 w; w.x = cvtpk(o0, o1); w.y = cvtpk(o2, o3);
            *(u32x2*)(p.H() + (size_t)R * D + c0) = w;
        }
    }
}

__device__ __forceinline__ int lds_byte(int r, int c) { int st = (r >> 4) * 2 + (c >> 5), ob = (r & 15) * 64 + (c & 31) * 2; return st * 1024 + (ob ^ (((ob >> 9) & 1) << 5)); }
__device__ __forceinline__ void stage_rc(int b, int& R, int& C) { int st = b >> 10, sb = b & 1023, swz = sb ^ (((sb >> 9) & 1) << 5); R = (st / 2) * 16 + swz / 64; C = (st % 2) * 32 + (swz % 64) / 2; }
#define WAIT_V0() asm volatile("s_waitcnt vmcnt(0)" ::: "memory")
__device__ __forceinline__ void gemm_core(const char* Abase, const unsigned (&Ao)[4], const char* Bbase, const unsigned (&Bo)[4], int nt, f32x4 (&acc)[8][4], int tid_l, bool pre) {
    const int tid = tid_l, wid = tid >> 6, lane = tid & 63, wr = wid >> 2, wc = wid & 3, fr = lane & 15, fq = lane >> 4;
#pragma unroll
    for (int m = 0; m < 8; ++m)
#pragma unroll
        for (int n = 0; n < 4; ++n) acc[m][n] = (f32x4){0.f, 0.f, 0.f, 0.f};
#define G_SA(b) (smem + (b) * 32768)
#define G_SB(b) (smem + 65536 + (b) * 32768)
#define G_STAGE(buf, kt) do { _Pragma("unroll") for (int i = 0; i < 4; ++i) {                                                     \
        __builtin_amdgcn_global_load_lds((const unsigned*)(Abase + (Ao[i] + (unsigned)(kt) * 128u)), (unsigned*)(G_SA(buf) + wid * 1024 + i * 8192), 16, 0, 0); \
        __builtin_amdgcn_global_load_lds((const unsigned*)(Bbase + (Bo[i] + (unsigned)(kt) * 128u)), (unsigned*)(G_SB(buf) + wid * 1024 + i * 8192), 16, 0, 0); } } while (0)
    if (!pre) G_STAGE(0, 0);
    WAIT_V0(); __syncthreads();
#define G_KSTEP(cur, t) do {                                                                                                   \
        if ((t) + 1 < nt) G_STAGE((cur) ^ 1, (t) + 1);                                                                          \
        _Pragma("unroll") for (int ks = 0; ks < 2; ++ks) {                                                                      \
            bf16x8 At[8], Bf[4];                                                                                                \
            _Pragma("unroll") for (int m = 0; m < 8; ++m) At[m] = *(const bf16x8*)(G_SA(cur) + lds_byte(wr * 128 + m * 16 + fr, ks * 32 + fq * 8)); \
            _Pragma("unroll") for (int n = 0; n < 4; ++n) Bf[n] = *(const bf16x8*)(G_SB(cur) + lds_byte(wc * 64 + n * 16 + fr, ks * 32 + fq * 8));  \
            _Pragma("unroll") for (int m = 0; m < 8; ++m) _Pragma("unroll") for (int n = 0; n < 4; ++n)                         \
                acc[m][n] = __builtin_amdgcn_mfma_f32_16x16x32_bf16(Bf[n], At[m], acc[m][n], 0, 0, 0);                          \
            __builtin_amdgcn_sched_barrier(0);                                                                                  \
        }                                                                                                                       \
        WAIT_V0(); __syncthreads(); } while (0)
#pragma unroll 1
    for (int t = 0; t < nt; ++t) { const int cur = t & 1; G_KSTEP(cur, t); }
}
#ifndef XPREFETCH
#define XPREFETCH 0
#endif
__device__ __forceinline__ void gemm_prefetch(const char* Abase, const unsigned (&Ao)[4], const char* Bbase, const unsigned (&Bo)[4], int tid_l) {
    const int wid = tid_l >> 6;
    G_STAGE(0, 0);
}
__device__ __forceinline__ void stage_offs(unsigned ld_bytes, unsigned (&P)[4], int tid_l) {
    const int wid = tid_l >> 6, lane = tid_l & 63;
#pragma unroll
    for (int i = 0; i < 4; ++i) { int R, C; stage_rc(wid * 1024 + i * 8192 + lane * 16, R, C); P[i] = (unsigned)R * ld_bytes + (unsigned)C * 2u; }
}

constexpr int WAREA = 18432;
__device__ __forceinline__ char* wave_area(int wid) { return smem + wid * WAREA; }

constexpr int A_KVBLK = 64;
constexpr float A_SCALE = 0.125f, A_THR = 8.f;
constexpr int A_SHM_V = A_KVBLK * 128 * 2, A_SHM_K = A_KVBLK * 128 * 2;
#define KSWZ(row, colB) ((row) * 256 + ((colB) ^ (((row) & 7) << 4)))
#define SBAR() __builtin_amdgcn_sched_barrier(0)
__device__ __forceinline__ int crow(int r, int hi) { return (r & 3) + 8 * (r >> 2) + 4 * hi; }

__device__ __forceinline__ void partialSM(f32x16& p0, f32x16& p1, float& m_reg, float& mn, float& alpha) {
    constexpr float C = A_SCALE * 1.4426950408889634f;
    float pmax = p0[0];
#pragma unroll
    for (int r = 1; r < 16; ++r) pmax = fmaxf(pmax, p0[r]);
#pragma unroll
    for (int r = 0; r < 16; ++r) pmax = fmaxf(pmax, p1[r]);
    { auto rr = __builtin_amdgcn_permlane32_swap(__float_as_uint(pmax), __float_as_uint(pmax), false, false);
      pmax = fmaxf(__uint_as_float(rr[0]), __uint_as_float(rr[1])); }
    if (__builtin_expect(__all(pmax - m_reg <= A_THR / A_SCALE), 1)) { mn = m_reg; alpha = 1.f; }
    else { mn = fmaxf(m_reg, pmax); alpha = __builtin_amdgcn_exp2f((m_reg - mn) * C); m_reg = mn; }
    float mnC = -mn * C;
#pragma unroll
    for (int r = 0; r < 16; ++r) p0[r] = fmaf(p0[r], C, mnC);
#pragma unroll
    for (int r = 0; r < 16; ++r) p1[r] = fmaf(p1[r], C, mnC);
#pragma unroll
    for (int r = 0; r < 16; ++r) p0[r] = __builtin_amdgcn_exp2f(p0[r]);
}
#define PK4(P, BASE, OUT) do { unsigned a0 = cvtpk(P[BASE + 0], P[BASE + 1]), a1 = cvtpk(P[BASE + 2], P[BASE + 3]);   \
    unsigned b0 = cvtpk(P[BASE + 4], P[BASE + 5]), b1 = cvtpk(P[BASE + 6], P[BASE + 7]);                              \
    auto r0 = __builtin_amdgcn_permlane32_swap(a0, b0, false, false); auto r1 = __builtin_amdgcn_permlane32_swap(a1, b1, false, false); \
    u32x4 w = {r0[0], r1[0], r0[1], r1[1]}; OUT = *reinterpret_cast<bf16x8*>(&w); } while (0)
__device__ __forceinline__ void finishSM(f32x16& p0, f32x16& p1, float alpha, float& l_reg, bf16x8& pa0, bf16x8& pa1, bf16x8& pa2, bf16x8& pa3) {
#pragma unroll
    for (int r = 0; r < 16; ++r) p1[r] = __builtin_amdgcn_exp2f(p1[r]);
    float ps = 0;
#pragma unroll
    for (int r = 0; r < 16; ++r) ps += p0[r];
#pragma unroll
    for (int r = 0; r < 16; ++r) ps += p1[r];
    { auto rr = __builtin_amdgcn_permlane32_swap(__float_as_uint(ps), __float_as_uint(ps), false, false);
      ps = __uint_as_float(rr[0]) + __uint_as_float(rr[1]); }
    l_reg = l_reg * alpha + ps;
    PK4(p0, 0, pa0); PK4(p0, 8, pa1); PK4(p1, 0, pa2); PK4(p1, 8, pa3);
}
__device__ __forceinline__ void qkt(f32x16& p0, f32x16& p1, const char* Ks, const bf16x8* qr, int r32, int hi, int mapc) {
    p0 = f32x16{}; p1 = f32x16{};
#pragma unroll
    for (int d0 = 0; d0 < 4; ++d0) { int cb = (mapc + d0 * 16 + hi * 8) * 2;
        bf16x8 b0 = *reinterpret_cast<const bf16x8*>(Ks + KSWZ(r32, cb));
        bf16x8 b1 = *reinterpret_cast<const bf16x8*>(Ks + KSWZ(32 + r32, cb));
        p0 = __builtin_amdgcn_mfma_f32_32x32x16_bf16(b0, qr[d0], p0, 0, 0, 0);
        p1 = __builtin_amdgcn_mfma_f32_32x32x16_bf16(b1, qr[d0], p1, 0, 0, 0); }
}
__device__ __forceinline__ int v_st(int k, int c) { const int kk = (k & ~0xC) | ((k & 4) << 1) | ((k & 8) >> 1); return ((kk >> 3) * 4 + (c >> 5)) * 512 + ((kk & 7) * 32 + (c & 31)) * 2; }
__device__ __forceinline__ int v_rd_base(int lane) { return ((lane & 3) << 3) | (((lane >> 2) & 3) << 6) | (((lane >> 4) & 1) << 5) | (((lane >> 5) & 1) << 8); }
constexpr int v_rd_off(int d0, int ks, int half) { return d0 * 512 + ks * 4096 + half * 2048; }
template <int OFF> __device__ __forceinline__ s16x4 tr_read(int vb) {
    s16x4 r; asm volatile("ds_read_b64_tr_b16 %0, %1 offset:%2" : "=&v"(r) : "v"(vb), "i"(OFF) : "memory"); return r;
}
template <int D0> __device__ __forceinline__ void pv_one(f32x16& od, int vb, bf16x8 pa0, bf16x8 pa1, bf16x8 pa2, bf16x8 pa3) {
    const s16x4 l0 = tr_read<v_rd_off(D0, 0, 0)>(vb), h0 = tr_read<v_rd_off(D0, 0, 1)>(vb), l1 = tr_read<v_rd_off(D0, 1, 0)>(vb), h1 = tr_read<v_rd_off(D0, 1, 1)>(vb);
    const s16x4 l2 = tr_read<v_rd_off(D0, 2, 0)>(vb), h2 = tr_read<v_rd_off(D0, 2, 1)>(vb), l3 = tr_read<v_rd_off(D0, 3, 0)>(vb), h3 = tr_read<v_rd_off(D0, 3, 1)>(vb);
    asm volatile("s_waitcnt lgkmcnt(0)" ::: "memory"); SBAR();
#define PKV(L, H) (bf16x8){L[0], L[1], L[2], L[3], H[0], H[1], H[2], H[3]}
    od = __builtin_amdgcn_mfma_f32_32x32x16_bf16(pa0, PKV(l0, h0), od, 0, 0, 0);
    od = __builtin_amdgcn_mfma_f32_32x32x16_bf16(pa1, PKV(l1, h1), od, 0, 0, 0);
    od = __builtin_amdgcn_mfma_f32_32x32x16_bf16(pa2, PKV(l2, h2), od, 0, 0, 0);
    od = __builtin_amdgcn_mfma_f32_32x32x16_bf16(pa3, PKV(l3, h3), od, 0, 0, 0);
}
__device__ __forceinline__ void pv_d0(f32x16* o, int vb, bf16x8 pa0, bf16x8 pa1, bf16x8 pa2, bf16x8 pa3) {
    pv_one<0>(o[0], vb, pa0, pa1, pa2, pa3); pv_one<1>(o[1], vb, pa0, pa1, pa2, pa3); pv_one<2>(o[2], vb, pa0, pa1, pa2, pa3); pv_one<3>(o[3], vb, pa0, pa1, pa2, pa3);
}

__device__ __forceinline__ void attn_item(const bf16_t* __restrict__ Qb, const bf16_t* __restrict__ Kh, const bf16_t* __restrict__ Vh, bf16_t* __restrict__ mixrow,
                                          const float* __restrict__ gd, float lam, int tid_l) {
    char* lds = smem;
    const int tid = tid_l, wid = tid >> 6, lane = tid & 63, r32 = lane & 31, hi = lane >> 5;
    const int map = wid >> 2, wq = wid & 3, mapc = map * 64;
    char* V_lds = lds; char* K_lds = lds + 3 * A_SHM_V;
    float* wsw = (float*)(lds + 3 * A_SHM_V + 3 * A_SHM_K) + wid * 64; float* li_l = wsw; float* al_l = wsw + 32;
    float m_reg = -1e30f, l_reg = 0; f32x16 o[4] = {}; bf16x8 qr[4];
    const bf16_t* Qw = Qb + (long)(wq * 32 + r32) * 128 + mapc + hi * 8;
#pragma unroll
    for (int d0 = 0; d0 < 4; ++d0) qr[d0] = *reinterpret_cast<const bf16x8*>(Qw + d0 * 16);
    const int vb0 = (int)(uintptr_t)V_lds + v_rd_base(lane);
    int kofs[2], vofs[2];
#pragma unroll
    for (int i = 0; i < 2; ++i) {
        const int x = wid * 1024 + i * 8192 + lane * 16;
        { const int row = x >> 8, cs = x & 255, colB = cs ^ ((row & 7) << 4); kofs[i] = row * 128 + (colB >> 1); }
        { const int sub = x >> 9, wn = x & 511, kk = (sub >> 2) * 8 + (wn >> 6), k = (kk & ~0xC) | ((kk & 4) << 1) | ((kk & 8) >> 1), c = (sub & 3) * 32 + ((wn & 63) >> 1); vofs[i] = k * 128 + c; }
    }
#define DMA_TILE(slot, k0) do { _Pragma("unroll") for (int i = 0; i < 2; ++i) {                                                                   \
        __builtin_amdgcn_global_load_lds((const unsigned*)(Kh + (long)(k0) * 128 + kofs[i]), (unsigned*)(K_lds + (slot) * A_SHM_K + wid * 1024 + i * 8192), 16, 0, 0); \
        __builtin_amdgcn_global_load_lds((const unsigned*)(Vh + (long)(k0) * 128 + vofs[i]), (unsigned*)(V_lds + (slot) * A_SHM_V + wid * 1024 + i * 8192), 16, 0, 0); } } while (0)
#define RESC(a) do { if (__any((a) < 1.f)) { if (hi == 0) al_l[r32] = (a); asm volatile("s_waitcnt lgkmcnt(0)" ::: "memory"); \
    _Pragma("unroll") for (int d = 0; d < 4; ++d) _Pragma("unroll") for (int r = 0; r < 16; ++r) o[d][r] *= al_l[crow(r, hi)]; } } while (0)
    f32x16 pA0, pA1, pB0, pB1; float mnA, mnB, alA, alB; bf16x8 pa0, pa1, pa2, pa3; const int NT = RB / A_KVBLK;
    DMA_TILE(0, 0); DMA_TILE(1, A_KVBLK);
    asm volatile("s_waitcnt vmcnt(0)" ::: "memory"); __syncthreads();
    qkt(pA0, pA1, K_lds, qr, r32, hi, mapc); partialSM(pA0, pA1, m_reg, mnA, alA);
    int pb = 0, cb = 1, nb_ = 2;
#define ROT() do { pb = cb; cb = nb_; nb_ = (nb_ == 2) ? 0 : nb_ + 1; } while (0)
    for (int j = 1; j + 1 < NT; j += 2) {
        asm volatile("s_waitcnt vmcnt(0)" ::: "memory"); __syncthreads();
        DMA_TILE(nb_, (j + 1) * A_KVBLK);
        SBAR(); qkt(pB0, pB1, K_lds + cb * A_SHM_K, qr, r32, hi, mapc);
        finishSM(pA0, pA1, alA, l_reg, pa0, pa1, pa2, pa3); SBAR();
        pv_d0(o, vb0 + pb * A_SHM_V, pa0, pa1, pa2, pa3); partialSM(pB0, pB1, m_reg, mnB, alB);
        RESC(alB); ROT();
        asm volatile("s_waitcnt vmcnt(0)" ::: "memory"); __syncthreads();
        DMA_TILE(nb_, (j + 2) * A_KVBLK);
        SBAR(); qkt(pA0, pA1, K_lds + cb * A_SHM_K, qr, r32, hi, mapc);
        finishSM(pB0, pB1, alB, l_reg, pa0, pa1, pa2, pa3); SBAR();
        pv_d0(o, vb0 + pb * A_SHM_V, pa0, pa1, pa2, pa3); partialSM(pA0, pA1, m_reg, mnA, alA);
        RESC(alA); ROT();
    }
    asm volatile("s_waitcnt vmcnt(0)" ::: "memory"); __syncthreads();
    SBAR(); qkt(pB0, pB1, K_lds + cb * A_SHM_K, qr, r32, hi, mapc);
    finishSM(pA0, pA1, alA, l_reg, pa0, pa1, pa2, pa3); SBAR();
    pv_d0(o, vb0 + pb * A_SHM_V, pa0, pa1, pa2, pa3); partialSM(pB0, pB1, m_reg, mnB, alB);
    RESC(alB);
    finishSM(pB0, pB1, alB, l_reg, pa0, pa1, pa2, pa3); SBAR();
    pv_d0(o, vb0 + cb * A_SHM_V, pa0, pa1, pa2, pa3);
#undef ROT
#undef DMA_TILE
    if (hi == 0) li_l[r32] = l_reg;
    asm volatile("s_waitcnt lgkmcnt(0)" ::: "memory");
    float rl[16];
#pragma unroll
    for (int r = 0; r < 16; ++r) rl[r] = __builtin_amdgcn_rcpf(li_l[crow(r, hi)]);
    __syncthreads();
    {
        float* xo = (float*)lds + map * 16384 + (wq * 32) * 128 + r32;
#pragma unroll
        for (int r = 0; r < 16; ++r)
#pragma unroll
            for (int d0 = 0; d0 < 4; ++d0) xo[crow(r, hi) * 128 + d0 * 32] = o[d0][r] * rl[r];
    }
    __syncthreads();
    {
        const float g0 = gd[lane * 2], g1 = gd[lane * 2 + 1];
#pragma unroll 4
        for (int rr = 0; rr < 16; ++rr) {
            const int row = wid * 16 + rr;
            const float2 a0 = *(const float2*)((const float*)lds + row * 128 + lane * 2), a1 = *(const float2*)((const float*)lds + 16384 + row * 128 + lane * 2);
            const float xv = a0.x - lam * a1.x, yv = a0.y - lam * a1.y;
            const float ss = wave_sum(xv * xv + yv * yv);
            const float rs = rsqrtf(ss * (1.0f / 128) + EPS) * 0.8f;
            *(unsigned*)(mixrow + (long)row * 1024 + lane * 2) = cvtpk(xv * rs * g0, yv * rs * g1);
        }
    }
    __syncthreads();
#undef RESC
}

__device__ __forceinline__ void ph_attn(const MK& p, int bid, int nb, int tid_l) {
    const int lane = tid_l & 63;
    float s1 = wave_sum(p.lq1[lane] * p.lk1[lane]), s2 = wave_sum(p.lq2[lane] * p.lk2[lane]);
    const float lam = expf(s1) - expf(s2) + 0.2f;
    const int nrounds = (1024 + nb - 1) / nb;
    for (int rr = 0; rr < nrounds; ++rr) {
        int item;
        if (nb == 256) { int x = bid & 7, j = bid >> 3, hh = rr * 8 + x; item = (hh >> 1) * 64 + (hh & 1) * 32 + j; }
        else { item = rr * nb + bid; if (item >= 1024) break; }
        const int bh = item >> 6, qb = item & 63, b = bh >> 2, h = bh & 3;
        attn_item(p.Q() + ((size_t)bh * SEQ + qb * 128) * 128, p.K() + (size_t)bh * RB * 128, p.V() + (size_t)bh * RB * 128,
                  p.MIX() + ((size_t)(b * SEQ + qb * 128)) * 1024 + h * 128, p.dattn_g, lam, tid_l);
    }
}


__device__ __forceinline__ bf16x8 ldfrag(const bf16_t* p) { return *reinterpret_cast<const bf16x8*>(p); }

__device__ __forceinline__ void ph_kv(const MK& p, int bid, int nb, int tid_l) {
    const int wid = tid_l >> 6, lane = tid_l & 63, r32 = lane & 31, hi = lane >> 5;
    const int nitems = 16 * 2 * 66;
    for (int it = bid * 8 + wid; it < nitems; it += nb * 8) {
        const int c = it % 66, chain = it / 66, dir = chain & 1, bh = chain >> 1;
        const bf16_t* vt = p.VT() + (size_t)bh * 128 * RB + c * 128 + hi * 8;
        const bf16_t* kt = (dir ? p.KTb() : p.KTf()) + (size_t)bh * 64 * RB + c * 128 + hi * 8;
        f32x16 acc[4][2];
#pragma unroll
        for (int mt = 0; mt < 4; ++mt) { acc[mt][0] = f32x16{}; acc[mt][1] = f32x16{}; }
#pragma unroll 2
        for (int ks = 0; ks < 8; ++ks) {
            bf16x8 a[4], b[2];
#pragma unroll
            for (int mt = 0; mt < 4; ++mt) a[mt] = ldfrag(vt + (size_t)(mt * 32 + r32) * RB + ks * 16);
#pragma unroll
            for (int nt = 0; nt < 2; ++nt) b[nt] = ldfrag(kt + (size_t)(nt * 32 + r32) * RB + ks * 16);
#pragma unroll
            for (int mt = 0; mt < 4; ++mt)
#pragma unroll
                for (int nt = 0; nt < 2; ++nt) acc[mt][nt] = __builtin_amdgcn_mfma_f32_32x32x16_bf16(a[mt], b[nt], acc[mt][nt], 0, 0, 0);
        }
        bf16_t* dst = p.KV() + (size_t)it * 8192;
#pragma unroll
        for (int mt = 0; mt < 4; ++mt)
#pragma unroll
            for (int nt = 0; nt < 2; ++nt)
#pragma unroll
                for (int r = 0; r < 16; ++r) dst[(mt * 32 + crow(r, hi)) * 64 + nt * 32 + r32] = f2bf(acc[mt][nt][r]);
    }
}

__device__ __forceinline__ void ph_scan(const MK& p, int bid, int nb, int tid_l) {
    for (int e = bid * NTHR + tid_l; e < 32 * 8192; e += nb * NTHR) {
        const int chain = e >> 13, el = e & 8191, dir = chain & 1, bh = chain >> 1, h = bh & 3;
        const float d = dir ? p.dec_b[h] : p.dec_f[h];
        const float g128 = exp2f(128.0f * log2f(1.0f / (1.0f + expf(-d))));
        const bf16_t* kv = p.KV() + (size_t)chain * 66 * 8192 + el;
        bf16_t* st = p.ST() + (size_t)chain * 66 * 8192 + el;
        float S = 0.f;
        for (int n = 0; n < 66; ++n) {
            const int c = dir == 0 ? n : (n == 0 ? 1 : (n == 1 ? 0 : 67 - n));
            st[(size_t)c * 8192] = f2bf(S);
            S = fmaf(g128, S, bf2f(kv[(size_t)c * 8192]));
        }
    }
}

__device__ __forceinline__ void ph_ret(const MK& p, int bid, int nb, int tid_l) {
    const int tid = tid_l, wid = tid >> 6, lane = tid & 63, r32 = lane & 31, hi = lane >> 5, wq = wid & 3, half = wid >> 2;
    float* img = (float*)smem;
    for (int it = bid; it < 4 * 64 * 2; it += nb) {
        const int hp = it & 1, lc = (it >> 1) & 63, b = it >> 7, h = hp * 2 + half, bh = b * 4 + h;
        const int ib = CTX + lc * 128, c = 2 + lc;
        const float lf = log2f(1.0f / (1.0f + expf(-p.dec_f[h]))), lb = log2f(1.0f / (1.0f + expf(-p.dec_b[h])));
        const bf16_t* rq = p.RQ() + ((size_t)bh * RB + ib + wq * 32 + r32) * 64 + hi * 8;
        bf16x8 q[4];
#pragma unroll
        for (int ks = 0; ks < 4; ++ks) q[ks] = ldfrag(rq + ks * 16);
        f32x16 o[4];
        {
            const bf16_t* stf = p.ST() + ((size_t)(bh * 2 + 0) * 66 + c) * 8192 + hi * 8;
            const bf16_t* stb = p.ST() + ((size_t)(bh * 2 + 1) * 66 + c) * 8192 + hi * 8;
            {
                float rf[16];
#pragma unroll
                for (int r = 0; r < 16; ++r) rf[r] = __builtin_amdgcn_exp2f((float)(wq * 32 + crow(r, hi) + 1) * lf);
#pragma unroll
                for (int d0 = 0; d0 < 4; ++d0) {
                    f32x16 tf = f32x16{};
#pragma unroll
                    for (int ks = 0; ks < 4; ++ks) tf = __builtin_amdgcn_mfma_f32_32x32x16_bf16(q[ks], ldfrag(stf + (size_t)(d0 * 32 + r32) * 64 + ks * 16), tf, 0, 0, 0);
#pragma unroll
                    for (int r = 0; r < 16; ++r) o[d0][r] = tf[r] * rf[r];
                    asm volatile("" ::: "memory");
                }
            }
            {
                float rf[16];
#pragma unroll
                for (int r = 0; r < 16; ++r) rf[r] = __builtin_amdgcn_exp2f((float)(128 - (wq * 32 + crow(r, hi))) * lb);
#pragma unroll
                for (int d0 = 0; d0 < 4; ++d0) {
                    f32x16 tb = f32x16{};
#pragma unroll
                    for (int ks = 0; ks < 4; ++ks) tb = __builtin_amdgcn_mfma_f32_32x32x16_bf16(q[ks], ldfrag(stb + (size_t)(d0 * 32 + r32) * 64 + ks * 16), tb, 0, 0, 0);
#pragma unroll
                    for (int r = 0; r < 16; ++r) o[d0][r] += tb[r] * rf[r];
                    asm volatile("" ::: "memory");
                }
            }
        }
        {
            const int qi = wq * 32 + r32;
            const bf16_t* vt = p.VT() + (size_t)bh * 128 * RB + ib + hi * 8;
#pragma unroll 1
            for (int jb = 0; jb < 4; ++jb) {
                asm volatile("" ::: "memory");
                const bf16_t* rk = p.RK() + ((size_t)bh * RB + ib + jb * 32 + r32) * 64 + hi * 8;
                f32x16 pp = f32x16{};
#pragma unroll
                for (int ks = 0; ks < 4; ++ks) pp = __builtin_amdgcn_mfma_f32_32x32x16_bf16(ldfrag(rk + ks * 16), q[ks], pp, 0, 0, 0);
#pragma unroll
                for (int r = 0; r < 16; ++r) {
                    const int dd = qi - (jb * 32 + crow(r, hi));
                    const float ex = __builtin_amdgcn_exp2f(dd > 0 ? (float)dd * lf : (float)(-dd) * lb); const float w = dd == 0 ? 2.0f : ex;
                    pp[r] *= w;
                }
                bf16x8 pa0, pa1;
                PK4(pp, 0, pa0); PK4(pp, 8, pa1);
#pragma unroll
                for (int d0 = 0; d0 < 4; ++d0) {
                    o[d0] = __builtin_amdgcn_mfma_f32_32x32x16_bf16(pa0, ldfrag(vt + (size_t)(d0 * 32 + r32) * RB + jb * 32), o[d0], 0, 0, 0);
                    o[d0] = __builtin_amdgcn_mfma_f32_32x32x16_bf16(pa1, ldfrag(vt + (size_t)(d0 * 32 + r32) * RB + jb * 32 + 16), o[d0], 0, 0, 0);
                }
            }
        }
        __syncthreads();
        {
            float* xo = img + half * 16384 + (wq * 32) * 128 + r32;
#pragma unroll
            for (int r = 0; r < 16; ++r)
#pragma unroll
                for (int d0 = 0; d0 < 4; ++d0) xo[crow(r, hi) * 128 + d0 * 32] = o[d0][r];
        }
        __syncthreads();
        {
            const float g0 = p.ret_g[lane * 2], g1 = p.ret_g[lane * 2 + 1];
#pragma unroll 4
            for (int rr = 0; rr < 32; ++rr) {
                const int row = wid * 32 + rr, itl = row >> 7, rw = row & 127, hh = hp * 2 + itl;
                const float2 a = *(const float2*)(img + row * 128 + lane * 2);
                const float ss = wave_sum(a.x * a.x + a.y * a.y);
                const float rs = rsqrtf(ss * (1.0f / 128) + EPS);
                const size_t tt = (size_t)b * SEQ + lc * 128 + rw;
                const unsigned gg = *(const unsigned*)(p.RG() + tt * 512 + hh * 128 + lane * 2);
                const float ga = bf2f((bf16_t)(gg & 0xffff)), gb = bf2f((bf16_t)(gg >> 16));
                *(unsigned*)(p.MIX() + tt * 1024 + 512 + hh * 128 + lane * 2) = cvtpk(siluf(ga) * a.x * rs * g0, siluf(gb) * a.y * rs * g1);
            }
        }
    }
}


namespace pg8 {
constexpr int BM = 256, BK = 64, HALF = 128, HTB = HALF * BK * 2;
__device__ __forceinline__ int perm32(int rho) { const int n = rho >> 4, i = rho & 15; return 8 * (i >> 2) + 4 * n + (i & 3); }
struct GUnit { const char* A; const char* B; int i0, i1, i2, i3; };
template <class Epi, class Sched, bool GATHER, bool ALIGN_EPI>
__device__ __forceinline__ void gemm(int K, const Sched& S, const Epi& E, int tid_l) {
    const int tid = tid_l, wid = __builtin_amdgcn_readfirstlane(tid >> 6), lane = tid & 63, wr = wid >> 2, wc = wid & 3, fr = lane & 15, fq = lane >> 4;
    const int nt = K / BK;
    unsigned voffB[2], vAc[2][2], vAn[2][2];
    const size_t kstep = (size_t)(BK * 2);
    const size_t hstepB = (size_t)HALF * K * 2;
#pragma unroll
    for (int i = 0; i < 2; ++i) { int R, C; stage_rc(tid * 16 + i * 8192, R, C); const int Rb = Epi::PERM ? ((R & ~31) + perm32(R & 31)) : R;
        voffB[i] = (unsigned)(Rb * K + C) * 2u; }
    const unsigned ldsw = (unsigned)wid * 1024u;
    const int aoff = lds_byte(wr * 64 + fr, fq * 8), boff = lds_byte(wc * 32 + fr, fq * 8);
#define PG8_SA(b, h) (((b) * 2 + (h)) * HTB)
#define PG8_SB(b, h) ((4 + (b) * 2 + (h)) * HTB)
#define PG8_STAGE(bufoff, gbase, voff) do { _Pragma("unroll") for (int _i = 0; _i < 2; ++_i) \
        __builtin_amdgcn_global_load_lds((const unsigned*)((const char*)(gbase) + (voff)[_i]), (unsigned*)(smem + (bufoff) + ldsw + _i * 8192), 16, 0, 0); } while (0)
#define PG8_LDA(dst, b, h) do { _Pragma("unroll") for (int m = 0; m < 4; ++m) _Pragma("unroll") for (int k = 0; k < 2; ++k) dst[m][k] = *(const bf16x8*)(smem + PG8_SA(b, h) + aoff + m * 2048 + k * 1024); } while (0)
#define PG8_LDB(dst, b, h) do { _Pragma("unroll") for (int n = 0; n < 2; ++n) _Pragma("unroll") for (int k = 0; k < 2; ++k) dst[n][k] = *(const bf16x8*)(smem + PG8_SB(b, h) + boff + n * 2048 + k * 1024); } while (0)
#define PG8_MMA(ai, bj, At, Bt) do { __builtin_amdgcn_s_setprio(1); _Pragma("unroll") for (int m = 0; m < 4; ++m) _Pragma("unroll") for (int n = 0; n < 2; ++n) _Pragma("unroll") for (int k = 0; k < 2; ++k) \
        acc[ai][bj][m][n] = __builtin_amdgcn_mfma_f32_16x16x32_bf16(Bt[n][k], At[m][k], acc[ai][bj][m][n], 0, 0, 0); __builtin_amdgcn_s_setprio(0); } while (0)
#define PG8_WAIT_V(n) asm volatile("s_waitcnt vmcnt(" #n ")" ::: "memory")
#define PG8_WAIT_L(n) asm volatile("s_waitcnt lgkmcnt(" #n ")" ::: "memory")
#define PG8_BAR __builtin_amdgcn_s_barrier()
#define PG8_SCHED __builtin_amdgcn_sched_barrier(0)
    GUnit cur, nxt; int ui = 0;
    if (!S.next(0, cur, vAc)) return;
    f32x4 acc[2][2][4][2];
#pragma unroll
    for (int a = 0; a < 2; ++a)
#pragma unroll
        for (int b = 0; b < 2; ++b)
#pragma unroll
            for (int m = 0; m < 4; ++m)
#pragma unroll
                for (int n = 0; n < 2; ++n) acc[a][b][m][n] = (f32x4){0.f, 0.f, 0.f, 0.f};
    bf16x8 At[4][2], B0[2][2], B1[2][2];
    const char* cA = cur.A; const char* cB = cur.B;
    PG8_STAGE(PG8_SB(0, 0), cB, voffB); PG8_STAGE(PG8_SB(0, 1), cB + hstepB, voffB); PG8_STAGE(PG8_SA(0, 0), cA, vAc[0]); PG8_STAGE(PG8_SA(0, 1), cA, vAc[1]);
    if (wr == 1) PG8_BAR;
    PG8_WAIT_V(2); PG8_BAR;
    PG8_STAGE(PG8_SB(1, 0), cB + kstep, voffB); PG8_STAGE(PG8_SA(1, 0), cA + kstep, vAc[0]); PG8_STAGE(PG8_SB(1, 1), cB + hstepB + kstep, voffB);
    PG8_WAIT_V(6); PG8_BAR;
    for (;;) {
        const bool has_next = S.next(ui + 1, nxt, vAn);
        if (!GATHER || !has_next) {
#pragma unroll
            for (int h = 0; h < 2; ++h)
#pragma unroll
                for (int i = 0; i < 2; ++i) vAn[h][i] = vAc[h][i];
        }
        const char* nA = has_next ? nxt.A : cA; const char* nB = has_next ? nxt.B : cB;
#pragma unroll 1
        for (int t = 0; t < nt; t += 2) {
            const bool last = (t == nt - 2);
            const char* a1 = cA + (size_t)(t + 1) * kstep;
            const char* a2 = last ? nA : cA + (size_t)(t + 2) * kstep; const char* b2 = last ? nB : cB + (size_t)(t + 2) * kstep;
            const char* a3 = a2 + kstep; const char* b3 = b2 + kstep;
            unsigned va2[2][2];
#pragma unroll
            for (int h = 0; h < 2; ++h)
#pragma unroll
                for (int i = 0; i < 2; ++i) va2[h][i] = (GATHER && last) ? vAn[h][i] : vAc[h][i];
            PG8_LDB(B0, 0, 0); PG8_LDB(B1, 0, 1); PG8_SCHED; PG8_LDA(At, 0, 0); PG8_STAGE(PG8_SA(1, 1), a1, vAc[1]);
            PG8_WAIT_V(8); PG8_WAIT_L(0); PG8_BAR; PG8_MMA(0, 0, At, B0); PG8_MMA(0, 1, At, B1); PG8_BAR; PG8_SCHED;
            PG8_LDA(At, 0, 1); PG8_STAGE(PG8_SB(0, 0), b2, voffB); PG8_STAGE(PG8_SB(0, 1), b2 + hstepB, voffB); PG8_STAGE(PG8_SA(0, 0), a2, va2[0]);
            PG8_WAIT_V(8); PG8_WAIT_L(0); PG8_BAR; PG8_MMA(1, 0, At, B0); PG8_MMA(1, 1, At, B1); PG8_BAR; PG8_SCHED;
            PG8_LDB(B0, 1, 0); PG8_LDB(B1, 1, 1); PG8_SCHED; PG8_LDA(At, 1, 0); PG8_STAGE(PG8_SA(0, 1), a2, va2[1]);
            PG8_WAIT_V(8); PG8_WAIT_L(0); PG8_BAR; PG8_MMA(0, 0, At, B0); PG8_MMA(0, 1, At, B1); PG8_BAR; PG8_SCHED;
            PG8_LDA(At, 1, 1); PG8_STAGE(PG8_SB(1, 0), b3, voffB); PG8_STAGE(PG8_SB(1, 1), b3 + hstepB, voffB); PG8_STAGE(PG8_SA(1, 0), a3, va2[0]);
            PG8_WAIT_V(8); PG8_WAIT_L(0); PG8_BAR; PG8_MMA(1, 0, At, B0); PG8_MMA(1, 1, At, B1); PG8_BAR; PG8_SCHED;
        }
        if (ALIGN_EPI) { if (wr == 0) PG8_BAR; }
        E(acc, cur, wr, wc, fr, fq);
        if (!has_next) break;
#pragma unroll
        for (int a = 0; a < 2; ++a)
#pragma unroll
            for (int b = 0; b < 2; ++b)
#pragma unroll
                for (int m = 0; m < 4; ++m)
#pragma unroll
                    for (int n = 0; n < 2; ++n) acc[a][b][m][n] = (f32x4){0.f, 0.f, 0.f, 0.f};
        cur = nxt; cA = nA; cB = nB; ++ui;
#pragma unroll
        for (int h = 0; h < 2; ++h)
#pragma unroll
            for (int i = 0; i < 2; ++i) vAc[h][i] = vAn[h][i];
        if (ALIGN_EPI) { if (wr == 1) PG8_BAR; }
    }
    PG8_WAIT_V(0);
    if (!ALIGN_EPI) { if (wr == 0) PG8_BAR; }
    PG8_BAR;
#undef PG8_SA
#undef PG8_SB
#undef PG8_STAGE
#undef PG8_LDA
#undef PG8_LDB
#undef PG8_MMA
#undef PG8_WAIT_V
#undef PG8_WAIT_L
#undef PG8_BAR
#undef PG8_SCHED
}
__device__ __forceinline__ void plain_voffA(int K, unsigned (&vA)[2][2], int tid_l) {
#pragma unroll
    for (int i = 0; i < 2; ++i) { int R, C; stage_rc(tid_l * 16 + i * 8192, R, C); vA[0][i] = (unsigned)(R * K + C) * 2u; vA[1][i] = (unsigned)((R + HALF) * K + C) * 2u; }
}
}


struct SchedIn { const MK* p; int bid, nb, tid_l;
    __device__ __forceinline__ bool next(int i, pg8::GUnit& u, unsigned (&vA)[2][2]) const {
        const int tile = bid + i * nb; if (tile >= (NR / 256) * 12) return false;
        const int pm = tile / 12, pn = tile % 12;
        u.A = (const char*)(p->H() + (size_t)(pm * 256) * D); u.B = (const char*)(p->w_inT() + (size_t)(pn * 256) * D); u.i0 = pm; u.i1 = pn; u.i2 = 0; u.i3 = 0;
        pg8::plain_voffA(D, vA, tid_l); return true; } };
struct EpiIn { static constexpr bool PERM = false; const MK* p;
    __device__ __forceinline__ void operator()(f32x4 (&acc)[2][2][4][2], const pg8::GUnit& u, int wr, int wc, int fr_in, int fq_in) const {
        int fr = fr_in, fq = fq_in; asm volatile("" : "+v"(fr), "+v"(fq));
        const int pm = u.i0, seg = u.i1, brow = pm * 256;
        const int b = brow / RB, i0 = brow % RB;
        const bool lat = i0 >= CTX;
        const int wid = wr * 4 + wc, lane = fq * 16 + fr;
        if (lat && (seg <= 3 || seg == 6 || seg == 7)) {
#pragma unroll
            for (int ai = 0; ai < 2; ++ai)
#pragma unroll
                for (int m = 0; m < 4; ++m) {
                    const int t = i0 + ai * 128 + wr * 64 + m * 16 + fr - CTX, pos = (wc & 1) ? (t & 63) : (t >> 6);
                    const f32x4 cc = *(const f32x4*)(p->ropec() + pos * 16 + fq * 4), ss = *(const f32x4*)(p->ropes() + pos * 16 + fq * 4);
#pragma unroll
                    for (int bj = 0; bj < 2; ++bj) { const f32x4 x1 = acc[ai][bj][m][0], x2 = acc[ai][bj][m][1];
                        acc[ai][bj][m][0] = x1 * cc - x2 * ss; acc[ai][bj][m][1] = x1 * ss + x2 * cc; }
                }
        }
        if (seg == 7) {
#pragma unroll
            for (int ai = 0; ai < 2; ++ai)
#pragma unroll
                for (int bj = 0; bj < 2; ++bj)
#pragma unroll
                    for (int m = 0; m < 4; ++m) { acc[ai][bj][m][0] = acc[ai][bj][m][0] * 0.125f; acc[ai][bj][m][1] = acc[ai][bj][m][1] * 0.125f; }
        }
        if (seg <= 7 || seg >= 10) {
#pragma unroll
            for (int bj = 0; bj < 2; ++bj) {
                bf16_t* base; long rstride; bool ok = true;
                if (seg <= 1)      { const int h = (seg & 1) * 2 + bj;       base = p->Q() + (((size_t)(b * 4 + h) * SEQ + (i0 - CTX)) * 128 + wc * 32 + fq * 4); rstride = 128; ok = lat; }
                else if (seg <= 3) { const int h = (seg - 2) * 2 + bj;       base = p->K() + (((size_t)(b * 4 + h) * RB + i0) * 128 + wc * 32 + fq * 4);          rstride = 128; }
                else if (seg <= 5) { const int h = (seg - 4) * 2 + bj;       base = p->V() + (((size_t)(b * 4 + h) * RB + i0) * 128 + wc * 32 + fq * 4);          rstride = 128; }
                else if (seg == 6) { const int h = bj * 2 + (wc >> 1);       base = p->RQ() + (((size_t)(b * 4 + h) * RB + i0) * 64 + (wc & 1) * 32 + fq * 4);    rstride = 64; }
                else if (seg == 7) { const int h = bj * 2 + (wc >> 1);       base = p->RK() + (((size_t)(b * 4 + h) * RB + i0) * 64 + (wc & 1) * 32 + fq * 4);    rstride = 64; }
                else               {                                         base = p->RG() + ((size_t)(b * SEQ + (i0 - CTX)) * 512 + (seg - 10) * 256 + bj * 128 + wc * 32 + fq * 4); rstride = 512; ok = lat; }
                if (ok) {
#pragma unroll
                    for (int ai = 0; ai < 2; ++ai)
#pragma unroll
                        for (int m = 0; m < 4; ++m) { bf16_t* rp = base + (long)(ai * 128 + wr * 64 + m * 16 + fr) * rstride;
#pragma unroll
                            for (int n = 0; n < 2; ++n) { u32x2 w; w.x = cvtpk(acc[ai][bj][m][n][0], acc[ai][bj][m][n][1]); w.y = cvtpk(acc[ai][bj][m][n][2], acc[ai][bj][m][n][3]);
                                *(u32x2*)(rp + n * 16) = w; } }
                }
            }
        }
        if (seg >= 7 && seg <= 9) {
            char* img = smem + 131072 + wid * 3968;
            const int npass = seg == 7 ? 2 : 1;
#pragma unroll 1
            for (int ps = 0; ps < npass; ++ps) {
#pragma unroll
                for (int bj = 0; bj < 2; ++bj) {
                    float lg2 = 0.f; bf16_t* baseT;
                    if (seg == 7) { const int h = bj * 2 + (wc >> 1); const float dv = ps == 0 ? p->dec_f[h] : p->dec_b[h]; lg2 = log2f(1.0f / (1.0f + expf(-dv)));
                        baseT = (ps == 0 ? p->KTf() : p->KTb()) + ((size_t)(b * 4 + h) * 64 + (wc & 1) * 32) * RB + i0; }
                    else { const int h = (seg - 8) * 2 + bj; baseT = p->VT() + ((size_t)(b * 4 + h) * 128 + wc * 32) * RB + i0; }
#pragma unroll
                    for (int ai = 0; ai < 2; ++ai)
#pragma unroll
                        for (int mp = 0; mp < 2; ++mp) {
                            asm volatile("s_waitcnt lgkmcnt(0)" ::: "memory");
#pragma unroll
                            for (int mm = 0; mm < 2; ++mm) { const int m = mp * 2 + mm;
                                float f = 1.0f;
                                if (seg == 7) { const int pos = (i0 + ai * 128 + wr * 64 + m * 16 + fr) & 127; f = exp2f((float)(ps == 0 ? 127 - pos : pos) * lg2); }
#pragma unroll
                                for (int n = 0; n < 2; ++n)
#pragma unroll
                                    for (int j = 0; j < 4; ++j) *(bf16_t*)(img + (n * 16 + fq * 4 + j) * 80 + (mm * 16 + fr) * 2) = f2bf(acc[ai][bj][m][n][j] * f); }
                            asm volatile("s_waitcnt lgkmcnt(0)" ::: "memory");
                            const int ib = ai * 128 + wr * 64 + mp * 32;
#pragma unroll
                            for (int k = 0; k < 2; ++k) { const int q = lane + 64 * k, col = q >> 2, ch = q & 3;
                                *(u32x4*)(baseT + (size_t)col * RB + ib + ch * 8) = *(const u32x4*)(img + col * 80 + ch * 16); }
                        }
                }
            }
        }
    } };
__device__ __forceinline__ void ph_gemm_in(const MK& p, int bid, int nb, int tid_l) {
    SchedIn S{&p, bid, nb, tid_l}; EpiIn E{&p};
    pg8::gemm<EpiIn, SchedIn, false, true>(D, S, E, tid_l);
}

struct SchedOut { const MK* p; int bid, nb, tid_l;
    __device__ __forceinline__ bool next(int i, pg8::GUnit& u, unsigned (&vA)[2][2]) const {
        const int tile = bid + i * nb; if (tile >= (T / 256) * 4) return false;
        const int pm = tile >> 2, pn = tile & 3;
        u.A = (const char*)(p->MIX() + (size_t)(pm * 256) * D); u.B = (const char*)(p->w_outT() + (size_t)(pn * 256) * D); u.i0 = pm; u.i1 = pn; u.i2 = 0; u.i3 = 0;
        pg8::plain_voffA(D, vA, tid_l); return true; } };
struct EpiOut { static constexpr bool PERM = false; const MK* p;
    __device__ __forceinline__ void operator()(const f32x4 (&acc)[2][2][4][2], const pg8::GUnit& u, int wr, int wc, int fr, int fq) const {
        const int brow = u.i0 * 256, bcol = u.i1 * 256;
        const float* g1 = p->mod() + (size_t)(brow / SEQ) * 6 * D + 2 * D + bcol + wc * 32 + fq * 4;
        f32x4 gv[2][2];
#pragma unroll
        for (int bj = 0; bj < 2; ++bj)
#pragma unroll
            for (int n = 0; n < 2; ++n) gv[bj][n] = *(const f32x4*)(g1 + bj * 128 + n * 16);
#pragma unroll
        for (int ai = 0; ai < 2; ++ai)
#pragma unroll
            for (int m = 0; m < 4; ++m) {
                const size_t o = (size_t)(brow + ai * 128 + wr * 64 + m * 16 + fr) * D + bcol + wc * 32 + fq * 4;
                f32x4 xv[2][2];
#pragma unroll
                for (int bj = 0; bj < 2; ++bj)
#pragma unroll
                    for (int n = 0; n < 2; ++n) xv[bj][n] = *(const f32x4*)(p->x + o + bj * 128 + n * 16);
#pragma unroll
                for (int bj = 0; bj < 2; ++bj)
#pragma unroll
                    for (int n = 0; n < 2; ++n) *(f32x4*)(p->out + o + bj * 128 + n * 16) = xv[bj][n] + gv[bj][n] * acc[ai][bj][m][n];
                if (m & 1) asm volatile("" ::: "memory");
            }
    } };
__device__ __forceinline__ void ph_gemm_out(const MK& p, int bid, int nb, int tid_l) {
    SchedOut S{&p, bid, nb, tid_l}; EpiOut E{&p};
    pg8::gemm<EpiOut, SchedOut, false, true>(D, S, E, tid_l);
}

__device__ __forceinline__ bool route_token(float logit, float bias, int lane, float& wt) {
    const float score = 1.0f / (1.0f + expf(-logit));
    const float sel = score + bias;
    float m1 = sel, m2 = -INFINITY;
#pragma unroll
    for (int o = 1; o < 8; o <<= 1) {
        float p1 = __shfl_xor(m1, o), p2 = __shfl_xor(m2, o);
        float n1 = fmaxf(m1, p1), n2 = fmaxf(fminf(m1, p1), fmaxf(m2, p2));
        m1 = n1; m2 = n2;
    }
    const float gs = m1 + m2;
    const int grp = lane >> 3;
    int grank = 0;
#pragma unroll
    for (int g2 = 0; g2 < 8; ++g2) { float og = __uint_as_float(__builtin_amdgcn_readlane(__float_as_uint(gs), g2 * 8)); grank += (og > gs || (og == gs && g2 < grp)) ? 1 : 0; }
    const float val = grank < 4 ? sel : -INFINITY;
    int rank = 0;
#pragma unroll
    for (int e = 0; e < 64; ++e) { float ov = __uint_as_float(__builtin_amdgcn_readlane(__float_as_uint(val), e)); rank += (ov > val || (ov == val && e < lane)) ? 1 : 0; }
    const bool chosen = rank < 8;
    const float wsum = wave_sum(chosen ? score : 0.f);
    wt = score / wsum * 2.5f;
    return chosen;
}
template <bool DUMMY, int MODE = 0> __device__ __forceinline__ void ph_route(const MK& p, int bid, int nb, int tid_l) {
    int* cntp = p.cnt() + (DUMMY ? 128 : 0); int* tl = DUMMY ? (int*)(p.ws + 480 * MiB) : p.tok_list(); float* wl_ = DUMMY ? (float*)(p.ws + 488 * MiB) : p.wt_list(); int* tm = DUMMY ? (int*)(p.ws + 496 * MiB) : p.tokmap();
    const int tid = tid_l, wid = tid >> 6, lane = tid & 63, fr = lane & 15, fq = lane >> 4;
    float* lg = (float*)smem;
    int* wcnt = (int*)(smem + 34816);
    int* basel = wcnt + 128;
    bf16_t* H2lo = (bf16_t*)(p.ws + 325 * MiB);
    for (int item = bid; item < T / 128; item += nb) {
        const int t0 = item * 128 + wid * 16, b = (item * 128) / SEQ;
        const float* msh = p.mod() + (size_t)b * 6 * D + 3 * D; const float* msc = p.mod() + (size_t)b * 6 * D + 4 * D;
#pragma unroll 1
        for (int r0 = 0; r0 < 16; r0 += 4) {
            float4 xv[4][4];
#pragma unroll
            for (int rr = 0; rr < 4; ++rr)
#pragma unroll
                for (int q = 0; q < 4; ++q) xv[rr][q] = *(const float4*)(p.out + (size_t)(t0 + r0 + rr) * D + q * 256 + lane * 4);
#pragma unroll
            for (int rr = 0; rr < 4; ++rr) {
                float ss = 0.f;
#pragma unroll
                for (int q = 0; q < 4; ++q) ss += xv[rr][q].x * xv[rr][q].x + xv[rr][q].y * xv[rr][q].y + xv[rr][q].z * xv[rr][q].z + xv[rr][q].w * xv[rr][q].w;
                ss = wave_sum(ss);
                const float rstd = rsqrtf(ss * (1.0f / D) + EPS);
#pragma unroll
                for (int q = 0; q < 4; ++q) {
                    const int c0 = q * 256 + lane * 4;
                    const float4 gg = *(const float4*)(p.norm2_g + c0), sh = *(const float4*)(msh + c0), sc = *(const float4*)(msc + c0);
                    const float h0 = xv[rr][q].x * rstd * gg.x * (1 + sc.x) + sh.x, h1 = xv[rr][q].y * rstd * gg.y * (1 + sc.y) + sh.y;
                    const float h2v = xv[rr][q].z * rstd * gg.z * (1 + sc.z) + sh.z, h3 = xv[rr][q].w * rstd * gg.w * (1 + sc.w) + sh.w;
                    u32x2 wh, wl2; wh.x = cvtpk(h0, h1); wh.y = cvtpk(h2v, h3);
                    wl2.x = cvtpk(h0 - __uint_as_float(wh.x << 16), h1 - __uint_as_float(wh.x & 0xffff0000u));
                    wl2.y = cvtpk(h2v - __uint_as_float(wh.y << 16), h3 - __uint_as_float(wh.y & 0xffff0000u));
                    *(u32x2*)(p.H2() + (size_t)(t0 + r0 + rr) * D + c0) = wh;
                    *(u32x2*)(H2lo + (size_t)(t0 + r0 + rr) * D + c0) = wl2;
                }
            }
        }
        asm volatile("s_waitcnt vmcnt(0)" ::: "memory");
        __syncthreads();
        if (MODE == 3) continue;
        f32x4 acc[4];
#pragma unroll
        for (int nt = 0; nt < 4; ++nt) acc[nt] = (f32x4){0.f, 0.f, 0.f, 0.f};
        {
            const bf16_t* ah_p = p.H2() + (size_t)(t0 + fr) * D + fq * 8; const bf16_t* al_p = H2lo + (size_t)(t0 + fr) * D + fq * 8;
            const bf16_t* rT = p.routerT() + (size_t)fr * D + fq * 8;
#pragma unroll 4
            for (int ks = 0; ks < 32; ++ks) {
                const int k0 = ks * 32;
                const bf16x8 ah = ldfrag(ah_p + k0), al = ldfrag(al_p + k0);
#pragma unroll
                for (int nt = 0; nt < 4; ++nt) {
                    const bf16x8 bh = ldfrag(rT + (size_t)(nt * 16) * D + k0), bl = ldfrag(rT + (size_t)(64 + nt * 16) * D + k0);
                    acc[nt] = __builtin_amdgcn_mfma_f32_16x16x32_bf16(ah, bh, acc[nt], 0, 0, 0);
                    acc[nt] = __builtin_amdgcn_mfma_f32_16x16x32_bf16(ah, bl, acc[nt], 0, 0, 0);
                    acc[nt] = __builtin_amdgcn_mfma_f32_16x16x32_bf16(al, bh, acc[nt], 0, 0, 0);
                }
            }
        }
#pragma unroll
        for (int nt = 0; nt < 4; ++nt)
#pragma unroll
            for (int j = 0; j < 4; ++j) lg[(wid * 16 + fq * 4 + j) * 65 + nt * 16 + fr] = acc[nt][j];
        __syncthreads();
        if (MODE == 2) continue;
        float sc_[64]; unsigned long long ch = 0ull; float wscale = 0.f;
        const int tt = (wid & 1) * 64 + lane, t = item * 128 + tt;
        if (wid < 2) {
            float v[64];
#pragma unroll
            for (int e = 0; e < 64; ++e) { const float x = lg[tt * 65 + e]; sc_[e] = 1.0f / (1.0f + expf(-x)); v[e] = sc_[e] + p.router_b[e]; }
            float gs[8];
#pragma unroll
            for (int g = 0; g < 8; ++g) { float m1 = v[8 * g], m2 = -INFINITY;
#pragma unroll
                for (int i = 1; i < 8; ++i) { const float x = v[8 * g + i]; m2 = fmaxf(m2, fminf(m1, x)); m1 = fmaxf(m1, x); }
                gs[g] = m1 + m2; }
#pragma unroll
            for (int g = 0; g < 8; ++g) { int rank = 0;
#pragma unroll
                for (int g2 = 0; g2 < 8; ++g2) if (g2 != g) rank += (gs[g2] > gs[g] || (gs[g2] == gs[g] && g2 < g)) ? 1 : 0;
                if (rank >= 4) {
#pragma unroll
                    for (int i = 0; i < 8; ++i) v[8 * g + i] = -INFINITY; } }
#pragma unroll
            for (int it = 0; it < 8; ++it) {
                float m = v[0];
#pragma unroll
                for (int e = 1; e < 64; ++e) m = fmaxf(m, v[e]);
                bool found = false;
#pragma unroll
                for (int e = 0; e < 64; ++e) { const bool hit = !found && v[e] == m; if (hit) { ch |= (1ull << e); v[e] = -INFINITY; } found = found || hit; }
            }
            float wsum = 0.f;
#pragma unroll
            for (int e = 0; e < 64; ++e) wsum += ((ch >> e) & 1ull) ? sc_[e] : 0.f;
            wscale = 2.5f / wsum;
#pragma unroll
            for (int e = 0; e < 64; ++e) { const unsigned long long mk = __ballot((ch >> e) & 1ull); if (lane == 0) wcnt[wid * 64 + e] = __popcll(mk); }
        }
        __syncthreads();
        if (wid == 0) basel[lane] = atomicAdd(&cntp[lane], wcnt[lane] + wcnt[64 + lane]);
        __syncthreads();
        if (wid < 2) {
            int kidx = 0;
#pragma unroll
            for (int e = 0; e < 64; ++e) {
                const bool c = (ch >> e) & 1ull;
                const unsigned long long mk = __ballot(c);
                if (c) {
                    const int slot = basel[e] + (wid == 1 ? wcnt[e] : 0) + __popcll(mk & ((1ull << lane) - 1ull));
                    tl[(size_t)e * ECAP + slot] = t; wl_[(size_t)e * ECAP + slot] = sc_[e] * wscale;
                    tm[(size_t)t * 8 + kidx] = e * ECAP + slot; ++kidx;
                }
            }
        }
    }
}

constexpr int MOE_AUX = 162816;
__device__ __forceinline__ void moe_tables(const MK& p, int colt, int* tpre, int* rbase, int tid_l) {
    __syncthreads();
    if (tid_l == 0) { int tp = 0, rb = 0;
        for (int e = 0; e < 65; ++e) { const int c = e < 64 ? p.cnt()[e] : T; tpre[e] = tp; rbase[e] = rb; tp += ((c + 255) >> 8) * colt; rb += c; }
        tpre[65] = tp; rbase[65] = rb; }
    __syncthreads();
}
struct SchedUp { const MK* p; int bid, nb, tid_l, ntiles; const int* tpre; const int* rbase; mutable int e_hint;
    __device__ __forceinline__ bool next(int i, pg8::GUnit& u, unsigned (&vA)[2][2]) const {
        const int tile = bid + i * nb; if (tile >= ntiles) return false;
        int e = e_hint; while (tile >= tpre[e + 1]) ++e; e_hint = e;
        const int j = tile - tpre[e], rt = j >> 1, ct = j & 1, cnt_e = rbase[e + 1] - rbase[e];
        u.A = (const char*)p->H2(); u.B = (const char*)(p->W13t() + ((size_t)e * 512 + ct * 256) * D); u.i0 = e; u.i1 = rt; u.i2 = ct; u.i3 = cnt_e;
#pragma unroll
        for (int i2 = 0; i2 < 2; ++i2) { int R, C; stage_rc(tid_l * 16 + i2 * 8192, R, C);
#pragma unroll
            for (int h = 0; h < 2; ++h) { int slot = rt * 256 + h * 128 + R; if (slot >= cnt_e) slot = 0;
                const int tok = e < 64 ? p->tok_list()[(size_t)e * ECAP + slot] : slot;
                vA[h][i2] = (unsigned)tok * (D * 2u) + (unsigned)C * 2u; } }
        return true; } };
struct EpiUp { static constexpr bool PERM = true; const MK* p; const int* rbase;
    __device__ __forceinline__ void operator()(const f32x4 (&acc)[2][2][4][2], const pg8::GUnit& u, int wr, int wc, int fr, int fq) const {
        const int e = u.i0, rt = u.i1, ct = u.i2, cnt_e = u.i3;
        bf16_t* ab = p->ACT() + (size_t)rbase[e] * DE + ct * 128 + wc * 32 + fq * 8;
#pragma unroll
        for (int ai = 0; ai < 2; ++ai)
#pragma unroll
            for (int m = 0; m < 4; ++m) {
                const int slot = rt * 256 + ai * 128 + wr * 64 + m * 16 + fr;
                u32x4 w;
                w.x = cvtpk(siluf(acc[ai][0][m][0][0]) * acc[ai][1][m][0][0], siluf(acc[ai][0][m][0][1]) * acc[ai][1][m][0][1]);
                w.y = cvtpk(siluf(acc[ai][0][m][0][2]) * acc[ai][1][m][0][2], siluf(acc[ai][0][m][0][3]) * acc[ai][1][m][0][3]);
                w.z = cvtpk(siluf(acc[ai][0][m][1][0]) * acc[ai][1][m][1][0], siluf(acc[ai][0][m][1][1]) * acc[ai][1][m][1][1]);
                w.w = cvtpk(siluf(acc[ai][0][m][1][2]) * acc[ai][1][m][1][2], siluf(acc[ai][0][m][1][3]) * acc[ai][1][m][1][3]);
                if (slot < cnt_e) *(u32x4*)(ab + (size_t)slot * DE) = w;
            }
    } };
__device__ __forceinline__ void ph_moe_up(const MK& p, int bid, int nb, int tid_l) {
    int* tpre = (int*)(smem + MOE_AUX); int* rbase = tpre + 80;
    moe_tables(p, 2, tpre, rbase, tid_l);
    SchedUp S{&p, bid, nb, tid_l, tpre[65], tpre, rbase, 0}; EpiUp E{&p, rbase};
    pg8::gemm<EpiUp, SchedUp, true, true>(D, S, E, tid_l);
}
constexpr float Y_SCALE = 64.0f;
struct SchedDown { const MK* p; int bid, nb, tid_l, ntiles; const int* tpre; const int* rbase; mutable int e_hint;
    __device__ __forceinline__ bool next(int i, pg8::GUnit& u, unsigned (&vA)[2][2]) const {
        const int tile = bid + i * nb; if (tile >= ntiles) return false;
        int e = e_hint; while (tile >= tpre[e + 1]) ++e; e_hint = e;
        const int j = tile - tpre[e], rt = j >> 2, ct = j & 3, cnt_e = rbase[e + 1] - rbase[e];
        u.A = (const char*)(p->ACT() + (size_t)(rbase[e] + rt * 256) * DE); u.B = (const char*)(p->W2t() + ((size_t)e * D + ct * 256) * DE); u.i0 = e; u.i1 = rt; u.i2 = ct; u.i3 = cnt_e;
        pg8::plain_voffA(DE, vA, tid_l); return true; } };
template <int MODE> struct EpiDown { static constexpr bool PERM = true; const MK* p; const int* rbase;
    __device__ __forceinline__ void operator()(const f32x4 (&acc)[2][2][4][2], const pg8::GUnit& u, int wr, int wc, int fr, int fq) const {
        const int e = u.i0, rt = u.i1, ct = u.i2, cnt_e = u.i3;
        const int col0 = ct * 256 + wc * 32 + fq * 8;
        if (e < 64) {
            const float* wl = p->wt_list() + (size_t)e * ECAP;
            float wv[2][4];
#pragma unroll
            for (int ai = 0; ai < 2; ++ai)
#pragma unroll
                for (int m = 0; m < 4; ++m) { const int sl = rt * 256 + ai * 128 + wr * 64 + m * 16 + fr; wv[ai][m] = wl[sl < cnt_e ? sl : 0] * Y_SCALE; }
            const int wid = wr * 4 + wc, lane = fq * 16 + fr;
            char* wa = smem + 131072 + wid * 3968;
            unsigned char* yb = p->Y() + (size_t)rbase[e] * D + ct * 256 + wc * 64 + (lane & 3) * 16;
#pragma unroll
            for (int ai = 0; ai < 2; ++ai)
#pragma unroll
                for (int m = 0; m < 4; ++m) {
                    const float w = wv[ai][m];
                    char* img = wa + ((m & 1) ? 1280 : 0);
#pragma unroll
                    for (int bj = 0; bj < 2; ++bj) {
                        u32x2 pk;
#pragma unroll
                        for (int n = 0; n < 2; ++n) {
                            float v0 = fminf(fmaxf(acc[ai][bj][m][n][0] * w, -448.f), 448.f), v1 = fminf(fmaxf(acc[ai][bj][m][n][1] * w, -448.f), 448.f);
                            float v2 = fminf(fmaxf(acc[ai][bj][m][n][2] * w, -448.f), 448.f), v3 = fminf(fmaxf(acc[ai][bj][m][n][3] * w, -448.f), 448.f);
                            int q = 0; q = __builtin_amdgcn_cvt_pk_fp8_f32(v0, v1, q, false); q = __builtin_amdgcn_cvt_pk_fp8_f32(v2, v3, q, true);
                            if (n == 0) pk.x = (unsigned)q; else pk.y = (unsigned)q;
                        }
                        *(u32x2*)(img + fr * 80 + bj * 32 + fq * 8) = pk;
                    }
                    asm volatile("s_waitcnt lgkmcnt(0)" ::: "memory");
                    const int rr = lane >> 2, slot = rt * 256 + ai * 128 + wr * 64 + m * 16 + rr;
                    const u32x4 v = *(const u32x4*)(img + rr * 80 + (lane & 3) * 16);
                    if (MODE == 1) asm volatile("" :: "v"(v)); else if (slot < cnt_e) *(u32x4*)(yb + (size_t)slot * D) = v;
                }
        } else {
            const float* g2 = p->mod() + (size_t)((rt * 256) / SEQ) * 6 * D + 5 * D + col0;
            f32x4 gv[2][2];
#pragma unroll
            for (int bj = 0; bj < 2; ++bj)
#pragma unroll
                for (int n = 0; n < 2; ++n) gv[bj][n] = *(const f32x4*)(g2 + bj * 128 + n * 4);
            float* xb = p->out + (size_t)(rt * 256) * D + col0;
#pragma unroll
            for (int ai = 0; ai < 2; ++ai)
#pragma unroll
                for (int m = 0; m < 4; ++m) {
                    float* xp = xb + (size_t)(ai * 128 + wr * 64 + m * 16 + fr) * D;
                    f32x4 xv[2][2];
#pragma unroll
                    for (int bj = 0; bj < 2; ++bj)
#pragma unroll
                        for (int n = 0; n < 2; ++n) xv[bj][n] = *(const f32x4*)(xp + bj * 128 + n * 4);
#pragma unroll
                    for (int bj = 0; bj < 2; ++bj)
#pragma unroll
                        for (int n = 0; n < 2; ++n) *(f32x4*)(xp + bj * 128 + n * 4) = xv[bj][n] + gv[bj][n] * acc[ai][bj][m][n];
                    if (m & 1) asm volatile("" ::: "memory");
                }
        }
    } };
template <bool DUMMY, int MODE = 0> __device__ __forceinline__ void ph_moe_down(const MK& p, int bid, int nb, int tid_l) {
    int* tpre = (int*)(smem + MOE_AUX); int* rbase = tpre + 80;
    moe_tables(p, 4, tpre, rbase, tid_l);
    SchedDown S{&p, bid, nb, tid_l, DUMMY ? tpre[64] : tpre[65], tpre, rbase, 0}; EpiDown<MODE> E{&p, rbase};
    pg8::gemm<EpiDown<MODE>, SchedDown, false, true>(DE, S, E, tid_l);
}

template <bool DUMMY> __device__ __forceinline__ void ph_final(const MK& p, int bid, int nb, int tid_l) {
    const int wid = tid_l >> 6, lane = tid_l & 63;
    int* tpre = (int*)(smem + MOE_AUX); int* rbase = tpre + 80;
    moe_tables(p, 1, tpre, rbase, tid_l);
    for (int t = bid * 8 + wid; t < T; t += nb * 8) {
        const int b = t / SEQ;
        float f[16];
#pragma unroll
        for (int i = 0; i < 16; ++i) f[i] = 0.f;
#pragma unroll
        for (int k = 0; k < 8; ++k) {
            const int id = p.tokmap()[(size_t)t * 8 + k], e = id >> 15, slot = id & (ECAP - 1);
            const unsigned char* yr = p.Y() + (size_t)(rbase[e] + slot) * D + lane * 4;
#pragma unroll
            for (int q = 0; q < 4; ++q) {
                const int w = *(const int*)(yr + q * 256);
                const auto lo = __builtin_amdgcn_cvt_pk_f32_fp8(w, false); const auto hi = __builtin_amdgcn_cvt_pk_f32_fp8(w, true);
                f[q * 4 + 0] += lo[0]; f[q * 4 + 1] += lo[1]; f[q * 4 + 2] += hi[0]; f[q * 4 + 3] += hi[1];
            }
        }
        const int pcol = ((lane >> 3) & 1) * 128 + (lane >> 4) * 32 + (lane & 7) * 4;
        const float* g2 = p.mod() + (size_t)b * 6 * D + 5 * D + pcol;
        float* xo = p.out + (size_t)t * D + pcol;
        float v[16]; float ss = 0.f;
#pragma unroll
        for (int q = 0; q < 4; ++q) {
            const float4 xv = *(const float4*)(xo + q * 256), g = *(const float4*)(g2 + q * 256);
            v[q * 4 + 0] = xv.x + g.x * f[q * 4 + 0] * (1.0f / Y_SCALE); v[q * 4 + 1] = xv.y + g.y * f[q * 4 + 1] * (1.0f / Y_SCALE);
            v[q * 4 + 2] = xv.z + g.z * f[q * 4 + 2] * (1.0f / Y_SCALE); v[q * 4 + 3] = xv.w + g.w * f[q * 4 + 3] * (1.0f / Y_SCALE);
            ss += v[q * 4] * v[q * 4] + v[q * 4 + 1] * v[q * 4 + 1] + v[q * 4 + 2] * v[q * 4 + 2] + v[q * 4 + 3] * v[q * 4 + 3];
        }
        ss = wave_sum(ss);
        const float rstd = rsqrtf(ss * (1.0f / D) + EPS);
#pragma unroll
        for (int q = 0; q < 4; ++q) {
            const float4 gf = *(const float4*)(p.final_g + q * 256 + pcol);
            *(float4*)((DUMMY ? (float*)(p.ws + 42 * MiB) + (size_t)t * D + pcol : xo) + q * 256) = make_float4(v[q * 4] * rstd * gf.x, v[q * 4 + 1] * rstd * gf.y, v[q * 4 + 2] * rstd * gf.z, v[q * 4 + 3] * rstd * gf.w);
        }
    }
}


#define XB_TMO      128
#define XB_XCNT(j)  (256  + 64 * (j))
#define XB_XSUB(j)  (1280 + 64 * (j))
#define XB_XGEN(j)  (2304 + 64 * (j))
#define XB_TOP      3328
#define XB_TOPGEN   3392
#define XCD_BAR_WORDS 3456
#define XB_SPIN_CAP (1u << 22)
#define LAS __attribute__((address_space(3)))
__device__ __forceinline__ unsigned xb_ld(unsigned* p)              { return __hip_atomic_load(p, __ATOMIC_RELAXED, __HIP_MEMORY_SCOPE_AGENT); }
__device__ __forceinline__ unsigned xb_add(unsigned* p, unsigned v) { return __hip_atomic_fetch_add(p, v, __ATOMIC_RELAXED, __HIP_MEMORY_SCOPE_AGENT); }
__device__ __forceinline__ unsigned xb_xcc_id() { return (unsigned)__builtin_amdgcn_s_getreg((3 << 11) | 20) & 0xFu; }
#define XB_SPIN(cond, bar) do { unsigned _sp = 0; while (cond) { __builtin_amdgcn_s_sleep(1); \
    if ((++_sp & 255u) == 0u) { if (xb_ld(&(bar)[XB_TMO])) break; if (_sp > XB_SPIN_CAP) { atomicAdd(&(bar)[XB_TMO], 1u); break; } } } } while (0)
struct XcdBarrier { unsigned* bar; unsigned x; volatile LAS unsigned* st; };
__device__ __forceinline__ XcdBarrier xcd_barrier_post(unsigned* bar, volatile LAS unsigned* st, int tid) {
    XcdBarrier b; b.bar = bar; b.x = xb_xcc_id(); b.st = st;
    if (tid == 0) (void)xb_add(&bar[XB_XCNT(b.x)], 1u);
    return b;
}
__device__ __forceinline__ void xcd_barrier_complete(unsigned* bar, unsigned x, unsigned& nloc, unsigned& nx) {
    const unsigned G = gridDim.x * gridDim.y * gridDim.z;
    unsigned sum, cnt, mine, sp = 0u;
    for (;;) {
        sum = 0u; cnt = 0u; mine = 0u;
#pragma unroll
        for (unsigned j = 0; j < 16; ++j) { const unsigned c = xb_ld(&bar[XB_XCNT(j)]); sum += c; cnt += (c > 0u) ? 1u : 0u; mine = (j == x) ? c : mine; }
        if (sum == G) break;
        __builtin_amdgcn_s_sleep(1);
        if ((++sp & 255u) == 0u) { if (xb_ld(&bar[XB_TMO])) break; if (sp > XB_SPIN_CAP) { atomicAdd(&bar[XB_TMO], 1u); break; } }
    }
    nloc = mine > 0u ? mine : 1u; nx = cnt > 0u ? cnt : 1u;
}
__device__ __forceinline__ void xcd_barrier(const XcdBarrier& b, int tid) {
    asm volatile("s_waitcnt vmcnt(0)" ::: "memory");
    __syncthreads();
    if (tid == 0) {
        unsigned* bar = b.bar;
        __builtin_amdgcn_s_waitcnt(0);
        unsigned nloc = b.st[0], nx = b.st[1];
        if (nloc == 0u) { xcd_barrier_complete(bar, b.x, nloc, nx); b.st[0] = nloc; b.st[1] = nx; }
        const unsigned old = xb_add(&bar[XB_XSUB(b.x)], 1u);
        const unsigned gen = old / nloc;
        if (old + 1u == (gen + 1u) * nloc) {
            __builtin_amdgcn_fence(__ATOMIC_RELEASE, "agent");
            asm volatile("s_waitcnt vmcnt(0)" ::: "memory");
            const unsigned og = xb_add(&bar[XB_TOP], 1u);
            const unsigned tg = og / nx;
            if (og + 1u == (tg + 1u) * nx) xb_add(&bar[XB_TOPGEN], 1u);
            else XB_SPIN(xb_ld(&bar[XB_TOPGEN]) == tg, bar);
            __builtin_amdgcn_fence(__ATOMIC_ACQUIRE, "agent");
            xb_add(&bar[XB_XGEN(b.x)], 1u);
            asm volatile("s_waitcnt vmcnt(0)" ::: "memory");
        } else {
            XB_SPIN(xb_ld(&bar[XB_XGEN(b.x)]) == gen, bar);
            __builtin_amdgcn_fence(__ATOMIC_ACQUIRE, "agent");
            asm volatile("s_waitcnt vmcnt(0)" ::: "memory");
        }
    }
    __syncthreads();
}

__global__ __launch_bounds__(512, 2) void k_mega(MK p) {
    cg::grid_group grid = cg::this_grid();
    const int bid = blockIdx.x, nb = gridDim.x;
    volatile LAS unsigned* xst = (volatile LAS unsigned*)(smem + 162816 + 768);
    if (threadIdx.x < 4) xst[threadIdx.x] = 0u;
    __syncthreads();
    const XcdBarrier xb = xcd_barrier_post((unsigned*)(p.ws + 524288), xst, (int)threadIdx.x);
#define PH_TID() int t_ = threadIdx.x; asm volatile("" : "+v"(t_))
    { PH_TID(); if (bid == 0 && t_ < 256) p.cnt()[t_] = 0; ph_mod(p, bid, nb, t_); ph_convert(p, bid, nb, t_); }
#if DUP == 10
    { PH_TID(); ph_convert(p, bid, nb, t_); }
#endif
    grid.sync();
    { PH_TID(); ph_ln1(p, bid, nb, t_); }
#if DUP == 1
    { PH_TID(); ph_ln1(p, bid, nb, t_); }
#endif
    xcd_barrier(xb, (int)threadIdx.x);
    { PH_TID(); ph_gemm_in(p, bid, nb, t_); }
    { PH_TID(); ph_convert_dyn(p, t_); }
#if DUP == 2
    { PH_TID(); ph_gemm_in(p, bid, nb, t_); }
#endif
    xcd_barrier(xb, (int)threadIdx.x);
    { PH_TID(); ph_attn(p, bid, nb, t_); }
#if DUP == 3
    { PH_TID(); ph_attn(p, bid, nb, t_); }
#endif
    { PH_TID(); ph_kv(p, bid, nb, t_); }
#if DUP == 11
    { PH_TID(); ph_kv(p, bid, nb, t_); }
#endif
    xcd_barrier(xb, (int)threadIdx.x);
    { PH_TID(); ph_scan(p, bid, nb, t_); }
    xcd_barrier(xb, (int)threadIdx.x);
    { PH_TID(); ph_ret(p, bid, nb, t_); }
#if DUP == 5
    { PH_TID(); ph_ret(p, bid, nb, t_); }
#endif
    xcd_barrier(xb, (int)threadIdx.x);
    { PH_TID(); ph_gemm_out(p, bid, nb, t_); }
#if DUP == 6
    { PH_TID(); ph_gemm_out(p, bid, nb, t_); }
#endif
    xcd_barrier(xb, (int)threadIdx.x);
#if DUP == 7
    { PH_TID(); ph_route<true>(p, bid, nb, t_); }
#endif
#if DUP == 72
    { PH_TID(); ph_route<true, 2>(p, bid, nb, t_); }
#endif
#if DUP == 73
    { PH_TID(); ph_route<true, 3>(p, bid, nb, t_); }
#endif
    { PH_TID(); ph_route<false>(p, bid, nb, t_); }
    xcd_barrier(xb, (int)threadIdx.x);
    { PH_TID(); ph_moe_up(p, bid, nb, t_); }
#if DUP == 8
    { PH_TID(); ph_moe_up(p, bid, nb, t_); }
#endif
    xcd_barrier(xb, (int)threadIdx.x);
#if DUP == 9
    { PH_TID(); ph_moe_down<true>(p, bid, nb, t_); }
#endif
#if DUP == 91
    { PH_TID(); ph_moe_down<true, 1>(p, bid, nb, t_); }
#endif
    { PH_TID(); ph_moe_down<false>(p, bid, nb, t_); }
    xcd_barrier(xb, (int)threadIdx.x);
#if DUP == 13
    { PH_TID(); ph_final<true>(p, bid, nb, t_); }
#endif
    { PH_TID(); ph_final<false>(p, bid, nb, t_); }
#undef PH_TID
}
constexpr int LDS_TOTAL = 163840;
extern "C" void kernel_launch(void* const* d_in, const int* in_sizes, int n_in, void* d_out, int out_size, void* d_ws, size_t ws_size, hipStream_t stream) {
    char* ws = (char*)d_ws;
    MK mk{};
    mk.x = (const float*)d_in[0]; mk.c = (const float*)d_in[1]; mk.ctx = (const float*)d_in[2]; mk.cctx = (const float*)d_in[3]; mk.ada_w = (const float*)d_in[4]; mk.ada_b = (const float*)d_in[5];
    mk.norm1_g = (const float*)d_in[6]; mk.w_in = (const float*)d_in[7]; mk.lq1 = (const float*)d_in[8]; mk.lk1 = (const float*)d_in[9]; mk.lq2 = (const float*)d_in[10]; mk.lk2 = (const float*)d_in[11];
    mk.dattn_g = (const float*)d_in[12]; mk.dec_f = (const float*)d_in[13]; mk.dec_b = (const float*)d_in[14]; mk.ret_g = (const float*)d_in[15]; mk.w_out = (const float*)d_in[16];
    mk.norm2_g = (const float*)d_in[17]; mk.router_w = (const float*)d_in[18]; mk.router_b = (const float*)d_in[19]; mk.ew1 = (const float*)d_in[20]; mk.ew3 = (const float*)d_in[21];
    mk.ew2 = (const float*)d_in[22]; mk.sw1 = (const float*)d_in[23]; mk.sw3 = (const float*)d_in[24]; mk.sw2 = (const float*)d_in[25]; mk.final_g = (const float*)d_in[26];
    mk.out = (float*)d_out;
    mk.ws = ws;
    mk.dbgP = nullptr; mk.dbg_lo = 0; mk.dbg_hi = 12; mk.conv_limit = 1 << 30;
    static int grid_blocks = 0;
    if (!grid_blocks) {
        (void)hipFuncSetAttribute((const void*)k_mega, hipFuncAttributeMaxDynamicSharedMemorySize, LDS_TOTAL);
        int dev = 0, cus = 0, per_cu = 0;
        (void)hipGetDevice(&dev);
        (void)hipDeviceGetAttribute(&cus, hipDeviceAttributeMultiprocessorCount, dev);
        (void)hipOccupancyMaxActiveBlocksPerMultiprocessor(&per_cu, k_mega, 512, LDS_TOTAL);
        if (per_cu > 1) per_cu = 1;
        grid_blocks = cus * per_cu;
        if (grid_blocks <= 0) { fprintf(stderr, "occupancy query failed: cus %d per_cu %d\n", cus, per_cu); grid_blocks = 256; }
    }
    (void)hipMemsetAsync(ws + 524288, 0, XCD_BAR_WORDS * 4, stream);
    void* args[] = {&mk};
    hipError_t e = hipLaunchCooperativeKernel((void*)k_mega, dim3(grid_blocks), dim3(512), args, LDS_TOTAL, stream);
    if (e != hipSuccess) fprintf(stderr, "cooperative launch failed: %s (grid %d)\n", hipGetErrorString(e), grid_blocks);
}
```

```cpp
#include <hip/hip_runtime.h>
#include <hip/hip_cooperative_groups.h>
#include <cstdio>
namespace cg = cooperative_groups;
#ifndef DUP
#define DUP 0
#endif
#include <stdint.h>

constexpr int D = 1024, NB = 4, SEQ = 8192, CTX = 256, RB = SEQ + CTX  , NR = NB * RB  , T = NB * SEQ;
constexpr int NE = 64, DE = 256, ECAP = 32768;
constexpr float EPS = 1e-6f;
typedef unsigned short bf16_t;

__device__ __forceinline__ float siluf(float v) { return v / (1.0f + expf(-v)); }
__device__ __forceinline__ float wave_sum(float v) {
#pragma unroll
    for (int o = 32; o > 0; o >>= 1) v += __shfl_xor(v, o);
    return v;
}
__device__ __forceinline__ float wave_max(float v) {
#pragma unroll
    for (int o = 32; o > 0; o >>= 1) v = fmaxf(v, __shfl_xor(v, o));
    return v;
}
__device__ __forceinline__ float block_sum(float v, float* red) {
    v = wave_sum(v);
    __syncthreads();
    if ((threadIdx.x & 63) == 0) red[threadIdx.x >> 6] = v;
    __syncthreads();
    return red[0] + red[1] + red[2] + red[3];
}
__device__ __forceinline__ float block_max(float v, float* red) {
    v = wave_max(v);
    __syncthreads();
    if ((threadIdx.x & 63) == 0) red[threadIdx.x >> 6] = v;
    __syncthreads();
    return fmaxf(fmaxf(red[0], red[1]), fmaxf(red[2], red[3]));
}

typedef short bf16x8 __attribute__((ext_vector_type(8)));
typedef short s16x4 __attribute__((ext_vector_type(4)));
typedef float f32x4 __attribute__((ext_vector_type(4)));
typedef float f32x16 __attribute__((ext_vector_type(16)));
typedef unsigned u32x2 __attribute__((ext_vector_type(2)));
typedef unsigned u32x4 __attribute__((ext_vector_type(4)));
extern __shared__ __attribute__((aligned(1024))) char smem[];
constexpr int NTHR = 512;
constexpr int GEMM_LDS = 131072;

__device__ __forceinline__ unsigned cvtpk(float lo, float hi) { unsigned r; asm volatile("v_cvt_pk_bf16_f32 %0, %1, %2" : "=v"(r) : "v"(lo), "v"(hi)); return r; }
__device__ __forceinline__ bf16_t f2bf(float v) { return (bf16_t)(cvtpk(v, v) & 0xffffu); }
__device__ __forceinline__ float bf2f(bf16_t v) { return __uint_as_float(((unsigned)v) << 16); }

constexpr size_t MiB = 1048576;
struct MK {
    const float *x, *c, *ctx, *cctx, *ada_w, *ada_b, *norm1_g, *w_in, *lq1, *lk1, *lq2, *lk2, *dattn_g, *dec_f, *dec_b, *ret_g, *w_out, *norm2_g, *router_w, *router_b,
        *ew1, *ew3, *ew2, *sw1, *sw3, *sw2, *final_g;
    float* out; char* ws;
    float* dbgP; long dbg_lo, dbg_hi; long conv_limit;
#define WSF(name, type, off) __device__ __forceinline__ type* name() const { return (type*)(ws + (off)); }
    WSF(mod, float, 0) WSF(cnt, int, 131072) WSF(ropec, float, 262144) WSF(ropes, float, 262144 + 8192)
    WSF(w_inT, bf16_t, 1 * MiB) WSF(w_outT, bf16_t, 7 * MiB) WSF(routerT, bf16_t, 9 * MiB) WSF(W2t, bf16_t, 9 * MiB + 524288)
    WSF(H, bf16_t, 42 * MiB) WSF(MIX, bf16_t, 42 * MiB) WSF(KV, bf16_t, 112 * MiB) WSF(ST, bf16_t, 147 * MiB) WSF(ACT, bf16_t, 42 * MiB)
    WSF(W13t, bf16_t, 194 * MiB) WSF(H2, bf16_t, 260 * MiB)
    WSF(Q, bf16_t, 260 * MiB) WSF(K, bf16_t, 292 * MiB) WSF(V, bf16_t, 325 * MiB) WSF(RQ, bf16_t, 358 * MiB) WSF(RK, bf16_t, 375 * MiB)
    WSF(KTf, bf16_t, 392 * MiB) WSF(KTb, bf16_t, 409 * MiB) WSF(VT, bf16_t, 426 * MiB) WSF(RG, bf16_t, 459 * MiB)
    WSF(Y, unsigned char, 194 * MiB) WSF(tok_list, int, 452 * MiB) WSF(wt_list, float, 460 * MiB) WSF(tokmap, int, 468 * MiB)
#undef WSF
};

__device__ __forceinline__ void ph_mod(const MK& p, int bid, int nb, int tid_l) {
    float* red = (float*)smem;
    for (int it = bid; it < 6 * D / 32; it += nb) {
        const int col = tid_l & 31, kg = tid_l >> 5, j = it * 32 + col;
        float a[5] = {0, 0, 0, 0, 0};
        for (int k = kg * 64; k < kg * 64 + 64; ++k) {
            float w = p.ada_w[(size_t)k * 6 * D + j];
#pragma unroll
            for (int r = 0; r < 5; ++r) { float cv = r < 4 ? p.c[r * D + k] : p.cctx[k]; a[r] += siluf(cv) * w; }
        }
        __syncthreads();
#pragma unroll
        for (int r = 0; r < 5; ++r) red[(kg * 5 + r) * 32 + col] = a[r];
        __syncthreads();
        if (tid_l < 160) {
            int r = tid_l >> 5; float s = 0;
            for (int g = 0; g < 16; ++g) s += red[(g * 5 + r) * 32 + col];
            p.mod()[(size_t)r * 6 * D + j] = s + p.ada_b[j];
        }
    }
    if (bid == nb - 1) {
        for (int i = tid_l; i < 128 * 16; i += NTHR) {
            int pos = i >> 4, f = i & 15;
            float inv_freq = (float)pow(10000.0, -(double)f / 16.0);
            float s, c; sincosf((float)pos * inv_freq, &s, &c);
            p.ropec()[i] = c; p.ropes()[i] = s;
        }
    }
    __syncthreads();
}

__device__ __forceinline__ void tr_tile(const float* src, int ldsrc, int k0, int n0, bf16_t* dst, int lddst, int mode  , bf16_t* dst2, int tid_l) {
    float* t = (float*)smem;
    __syncthreads();
    for (int i = tid_l; i < 64 * 16; i += NTHR) {
        int r = i >> 4, c4 = (i & 15) * 4;
        float4 v = *(const float4*)(src + (size_t)(k0 + r) * ldsrc + n0 + c4);
        t[r * 65 + c4] = v.x; t[r * 65 + c4 + 1] = v.y; t[r * 65 + c4 + 2] = v.z; t[r * 65 + c4 + 3] = v.w;
    }
    __syncthreads();
    for (int i = tid_l; i < 64 * 16; i += NTHR) {
        int n = i >> 4, k4 = (i & 15) * 4;
        float a = t[(k4 + 0) * 65 + n], b = t[(k4 + 1) * 65 + n], c = t[(k4 + 2) * 65 + n], d = t[(k4 + 3) * 65 + n];
        int nn = n0 + n, row = nn;
        if (mode == 1 || mode == 2) { int ct = nn >> 7; row = ct * 256 + (mode == 2 ? 128 : 0) + (nn & 127); }
        u32x2 w; w.x = cvtpk(a, b); w.y = cvtpk(c, d);
        *(u32x2*)(dst + (size_t)row * lddst + k0 + k4) = w;
        if (mode == 3) {
            float ah = bf2f((bf16_t)(w.x & 0xffff)), bh = bf2f((bf16_t)(w.x >> 16)), ch = bf2f((bf16_t)(w.y & 0xffff)), dh = bf2f((bf16_t)(w.y >> 16));
            u32x2 l; l.x = cvtpk(a - ah, b - bh); l.y = cvtpk(c - ch, d - dh);
            *(u32x2*)(dst2 + (size_t)row * lddst + k0 + k4) = l;
        }
    }
}
constexpr int CV_STATIC = 16 * 48 + 16 * 16 + 16, CV_E13 = 65 * 2 * 16 * 4, CV_E2 = 65 * 4 * 16, CV_TOTAL = CV_STATIC + CV_E13 + CV_E2;
__device__ __forceinline__ void convert_tile(const MK& p, int j, int tid_l) {
    const int n_win = 16 * 48, n_wout = 16 * 16, n_rt = 16;
    if (j < n_win) { tr_tile(p.w_in, 3072, (j / 48) * 64, (j % 48) * 64, p.w_inT(), 1024, 0, nullptr, tid_l); return; } j -= n_win;
    if (j < n_wout) { tr_tile(p.w_out, 1024, (j / 16) * 64, (j % 16) * 64, p.w_outT(), 1024, 0, nullptr, tid_l); return; } j -= n_wout;
    if (j < n_rt) { tr_tile(p.router_w, 64, j * 64, 0, p.routerT(), 1024, 3, p.routerT() + 64 * 1024, tid_l); return; } j -= n_rt;
    if (j < CV_E13) {
        int e = j / 128, r = j % 128, which = r / 64, tt = r % 64;
        const float* src = e < 64 ? (which ? p.ew3 : p.ew1) + (size_t)e * D * DE : (which ? p.sw3 : p.sw1);
        tr_tile(src, DE, (tt / 4) * 64, (tt % 4) * 64, p.W13t() + (size_t)e * 512 * 1024, 1024, 1 + which, nullptr, tid_l); return; } j -= CV_E13;
    { int e = j / 64, tt = j % 64;
      const float* src = e < 64 ? p.ew2 + (size_t)e * DE * D : p.sw2;
      tr_tile(src, D, (tt / 16) * 64, (tt % 16) * 64, p.W2t() + (size_t)e * 1024 * 256, 256, 0, nullptr, tid_l); }
}
__device__ __forceinline__ void ph_convert(const MK& p, int bid, int nb, int tid_l) {
    for (int it = bid; it < CV_STATIC; it += nb) convert_tile(p, it, tid_l);
    __syncthreads();
}
__device__ __forceinline__ void ph_convert_dyn(const MK& p, int tid_l) {
    int* q = (int*)smem + 8192;
    for (;;) {
        __syncthreads();
        if (tid_l == 0) q[0] = atomicAdd(&p.cnt()[200], 8);
        __syncthreads();
        const int base = q[0];
        if (base >= CV_E13 + CV_E2) break;
        for (int k = 0; k < 8; ++k) if (base + k < CV_E13 + CV_E2) convert_tile(p, CV_STATIC + base + k, tid_l);
    }
    __syncthreads();
}

__device__ __forceinline__ void ph_ln1(const MK& p, int bid, int nb, int tid_l) {
    const int wid = tid_l >> 6, lane = tid_l & 63;
    for (int R = bid * 8 + wid; R < NR; R += nb * 8) {
        int b = R / RB, i = R % RB;
        const float* src = i < CTX ? p.ctx + ((size_t)b * CTX + i) * D : p.x + ((size_t)b * SEQ + (i - CTX)) * D;
        const float* m = p.mod() + (size_t)(i < CTX ? 4 : b) * 6 * D;
        float4 v[4]; float ss = 0;
#pragma unroll
        for (int q = 0; q < 4; ++q) { v[q] = *(const float4*)(src + q * 256 + lane * 4); ss += v[q].x * v[q].x + v[q].y * v[q].y + v[q].z * v[q].z + v[q].w * v[q].w; }
        ss = wave_sum(ss);
        float rstd = rsqrtf(ss * (1.0f / D) + EPS);
#pragma unroll
        for (int q = 0; q < 4; ++q) {
            int c0 = q * 256 + lane * 4;
            float4 gg = *(const float4*)(p.norm1_g + c0), sh = *(const float4*)(m + c0), sc = *(const float4*)(m + D + c0);
            float o0 = v[q].x * rstd * gg.x * (1 + sc.x) + sh.x, o1 = v[q].y * rstd * gg.y * (1 + sc.y) + sh.y;
            float o2 = v[q].z * rstd * gg.z * (1 + sc.z) + sh.z, o3 = v[q].w * rstd * gg.w * (1 + sc.w) + sh.w;
            u32x2 w; w.x = cvtpk(o0, o1); w.y = cvtpk(o2, o3);
            *(u32x2*)(p.H() + (size_t)R * D + c0) = w;
        }
    }
}

__device__ __forceinline__ int lds_byte(int r, int c) { int st = (r >> 4) * 2 + (c >> 5), ob = (r & 15) * 64 + (c & 31) * 2; return st * 1024 + (ob ^ (((ob >> 9) & 1) << 5)); }
__device__ __forceinline__ void stage_rc(int b, int& R, int& C) { int st = b >> 10, sb = b & 1023, swz = sb ^ (((sb >> 9) & 1) << 5); R = (st / 2) * 16 + swz / 64; C = (st % 2) * 32 + (swz % 64) / 2; }
#define WAIT_V0() asm volatile("s_waitcnt vmcnt(0)" ::: "memory")
__device__ __forceinline__ void gemm_core(const char* Abase, const unsigned (&Ao)[4], const char* Bbase, const unsigned (&Bo)[4], int nt, f32x4 (&acc)[8][4], int tid_l, bool pre) {
    const int tid = tid_l, wid = tid >> 6, lane = tid & 63, wr = wid >> 2, wc = wid & 3, fr = lane & 15, fq = lane >> 4;
#pragma unroll
    for (int m = 0; m < 8; ++m)
#pragma unroll
        for (int n = 0; n < 4; ++n) acc[m][n] = (f32x4){0.f, 0.f, 0.f, 0.f};
#define G_SA(b) (smem + (b) * 32768)
#define G_SB(b) (smem + 65536 + (b) * 32768)
#define G_STAGE(buf, kt) do { _Pragma("unroll") for (int i = 0; i < 4; ++i) {                                                     \
        __builtin_amdgcn_global_load_lds((const unsigned*)(Abase + (Ao[i] + (unsigned)(kt) * 128u)), (unsigned*)(G_SA(buf) + wid * 1024 + i * 8192), 16, 0, 0); \
        __builtin_amdgcn_global_load_lds((const unsigned*)(Bbase + (Bo[i] + (unsigned)(kt) * 128u)), (unsigned*)(G_SB(buf) + wid * 1024 + i * 8192), 16, 0, 0); } } while (0)
    if (!pre) G_STAGE(0, 0);
    WAIT_V0(); __syncthreads();
#define G_KSTEP(cur, t) do {                                                                                                   \
        if ((t) + 1 < nt) G_STAGE((cur) ^ 1, (t) + 1);                                                                          \
        _Pragma("unroll") for (int ks = 0; ks < 2; ++ks) {                                                                      \
            bf16x8 At[8], Bf[4];                                                                                                \
            _Pragma("unroll") for (int m = 0; m < 8; ++m) At[m] = *(const bf16x8*)(G_SA(cur) + lds_byte(wr * 128 + m * 16 + fr, ks * 32 + fq * 8)); \
            _Pragma("unroll") for (int n = 0; n < 4; ++n) Bf[n] = *(const bf16x8*)(G_SB(cur) + lds_byte(wc * 64 + n * 16 + fr, ks * 32 + fq * 8));  \
            _Pragma("unroll") for (int m = 0; m < 8; ++m) _Pragma("unroll") for (int n = 0; n < 4; ++n)                         \
                acc[m][n] = __builtin_amdgcn_mfma_f32_16x16x32_bf16(Bf[n], At[m], acc[m][n], 0, 0, 0);                          \
            __builtin_amdgcn_sched_barrier(0);                                                                                  \
        }                                                                                                                       \
        WAIT_V0(); __syncthreads(); } while (0)
#pragma unroll 1
    for (int t = 0; t < nt; ++t) { const int cur = t & 1; G_KSTEP(cur, t); }
}
#ifndef XPREFETCH
#define XPREFETCH 0
#endif
__device__ __forceinline__ void gemm_prefetch(const char* Abase, const unsigned (&Ao)[4], const char* Bbase, const unsigned (&Bo)[4], int tid_l) {
    const int wid = tid_l >> 6;
    G_STAGE(0, 0);
}
__device__ __forceinline__ void stage_offs(unsigned ld_bytes, unsigned (&P)[4], int tid_l) {
    const int wid = tid_l >> 6, lane = tid_l & 63;
#pragma unroll
    for (int i = 0; i < 4; ++i) { int R, C; stage_rc(wid * 1024 + i * 8192 + lane * 16, R, C); P[i] = (unsigned)R * ld_bytes + (unsigned)C * 2u; }
}

constexpr int WAREA = 18432;
__device__ __forceinline__ char* wave_area(int wid) { return smem + wid * WAREA; }

constexpr int A_KVBLK = 64;
constexpr float A_SCALE = 0.125f, A_THR = 8.f;
constexpr int A_SHM_V = A_KVBLK * 128 * 2, A_SHM_K = A_KVBLK * 128 * 2;
#define KSWZ(row, colB) ((row) * 256 + ((colB) ^ (((row) & 7) << 4)))
#define SBAR() __builtin_amdgcn_sched_barrier(0)
__device__ __forceinline__ int crow(int r, int hi) { return (r & 3) + 8 * (r >> 2) + 4 * hi; }

template <int PROBE = 0> __device__ __forceinline__ void partialSM(f32x16& p0, f32x16& p1, float& m_reg, float& mn, float& alpha) {
    constexpr float C = A_SCALE * 1.4426950408889634f;
    float pmax = p0[0];
#pragma unroll
    for (int r = 1; r < 16; ++r) pmax = fmaxf(pmax, p0[r]);
#pragma unroll
    for (int r = 0; r < 16; ++r) pmax = fmaxf(pmax, p1[r]);
    { auto rr = __builtin_amdgcn_permlane32_swap(__float_as_uint(pmax), __float_as_uint(pmax), false, false);
      pmax = fmaxf(__uint_as_float(rr[0]), __uint_as_float(rr[1])); }
    if (__builtin_expect(__all(pmax - m_reg <= A_THR / A_SCALE), 1)) { mn = m_reg; alpha = 1.f; }
    else { mn = fmaxf(m_reg, pmax); alpha = __builtin_amdgcn_exp2f((m_reg - mn) * C); m_reg = mn; }
    float mnC = -mn * C;
#pragma unroll
    for (int r = 0; r < 16; ++r) p0[r] = fmaf(p0[r], C, mnC);
#pragma unroll
    for (int r = 0; r < 16; ++r) p1[r] = fmaf(p1[r], C, mnC);
#pragma unroll
    for (int r = 0; r < 16; ++r) p0[r] = PROBE == 3 ? p0[r] * 1e-3f : __builtin_amdgcn_exp2f(p0[r]);
}
#define PK4(P, BASE, OUT) do { unsigned a0 = cvtpk(P[BASE + 0], P[BASE + 1]), a1 = cvtpk(P[BASE + 2], P[BASE + 3]);   \
    unsigned b0 = cvtpk(P[BASE + 4], P[BASE + 5]), b1 = cvtpk(P[BASE + 6], P[BASE + 7]);                              \
    auto r0 = __builtin_amdgcn_permlane32_swap(a0, b0, false, false); auto r1 = __builtin_amdgcn_permlane32_swap(a1, b1, false, false); \
    u32x4 w = {r0[0], r1[0], r0[1], r1[1]}; OUT = *reinterpret_cast<bf16x8*>(&w); } while (0)
template <int PROBE = 0> __device__ __forceinline__ void finishSM(f32x16& p0, f32x16& p1, float alpha, float& l_reg, bf16x8& pa0, bf16x8& pa1, bf16x8& pa2, bf16x8& pa3) {
#pragma unroll
    for (int r = 0; r < 16; ++r) p1[r] = PROBE == 3 ? p1[r] * 1e-3f : __builtin_amdgcn_exp2f(p1[r]);
    float ps = 0;
#pragma unroll
    for (int r = 0; r < 16; ++r) ps += p0[r];
#pragma unroll
    for (int r = 0; r < 16; ++r) ps += p1[r];
    { auto rr = __builtin_amdgcn_permlane32_swap(__float_as_uint(ps), __float_as_uint(ps), false, false);
      ps = __uint_as_float(rr[0]) + __uint_as_float(rr[1]); }
    l_reg = l_reg * alpha + ps;
    PK4(p0, 0, pa0); PK4(p0, 8, pa1); PK4(p1, 0, pa2); PK4(p1, 8, pa3);
}
__device__ __forceinline__ void qkt(f32x16& p0, f32x16& p1, const char* Ks, const bf16x8* qr, int r32, int hi, int mapc) {
    p0 = f32x16{}; p1 = f32x16{};
#pragma unroll
    for (int d0 = 0; d0 < 4; ++d0) { int cb = (mapc + d0 * 16 + hi * 8) * 2;
        bf16x8 b0 = *reinterpret_cast<const bf16x8*>(Ks + KSWZ(r32, cb));
        bf16x8 b1 = *reinterpret_cast<const bf16x8*>(Ks + KSWZ(32 + r32, cb));
        p0 = __builtin_amdgcn_mfma_f32_32x32x16_bf16(b0, qr[d0], p0, 0, 0, 0);
        p1 = __builtin_amdgcn_mfma_f32_32x32x16_bf16(b1, qr[d0], p1, 0, 0, 0); }
}
__device__ __forceinline__ int v_st(int k, int c) { const int kk = (k & ~0xC) | ((k & 4) << 1) | ((k & 8) >> 1); return ((kk >> 3) * 4 + (c >> 5)) * 512 + ((kk & 7) * 32 + (c & 31)) * 2; }
__device__ __forceinline__ int v_rd_base(int lane) { return ((lane & 3) << 3) | (((lane >> 2) & 3) << 6) | (((lane >> 4) & 1) << 5) | (((lane >> 5) & 1) << 8); }
constexpr int v_rd_off(int d0, int ks, int half) { return d0 * 512 + ks * 4096 + half * 2048; }
template <int OFF> __device__ __forceinline__ s16x4 tr_read(int vb) {
    s16x4 r; asm volatile("ds_read_b64_tr_b16 %0, %1 offset:%2" : "=&v"(r) : "v"(vb), "i"(OFF) : "memory"); return r;
}
template <int D0> __device__ __forceinline__ void pv_one(f32x16& od, int vb, bf16x8 pa0, bf16x8 pa1, bf16x8 pa2, bf16x8 pa3) {
    const s16x4 l0 = tr_read<v_rd_off(D0, 0, 0)>(vb), h0 = tr_read<v_rd_off(D0, 0, 1)>(vb), l1 = tr_read<v_rd_off(D0, 1, 0)>(vb), h1 = tr_read<v_rd_off(D0, 1, 1)>(vb);
    const s16x4 l2 = tr_read<v_rd_off(D0, 2, 0)>(vb), h2 = tr_read<v_rd_off(D0, 2, 1)>(vb), l3 = tr_read<v_rd_off(D0, 3, 0)>(vb), h3 = tr_read<v_rd_off(D0, 3, 1)>(vb);
    asm volatile("s_waitcnt lgkmcnt(0)" ::: "memory"); SBAR();
#define PKV(L, H) (bf16x8){L[0], L[1], L[2], L[3], H[0], H[1], H[2], H[3]}
    od = __builtin_amdgcn_mfma_f32_32x32x16_bf16(pa0, PKV(l0, h0), od, 0, 0, 0);
    od = __builtin_amdgcn_mfma_f32_32x32x16_bf16(pa1, PKV(l1, h1), od, 0, 0, 0);
    od = __builtin_amdgcn_mfma_f32_32x32x16_bf16(pa2, PKV(l2, h2), od, 0, 0, 0);
    od = __builtin_amdgcn_mfma_f32_32x32x16_bf16(pa3, PKV(l3, h3), od, 0, 0, 0);
}
template <int D0> __device__ __forceinline__ void pv_two(f32x16& oa, f32x16& ob, int vb, bf16x8 pa0, bf16x8 pa1, bf16x8 pa2, bf16x8 pa3) {
    const s16x4 l0 = tr_read<v_rd_off(D0, 0, 0)>(vb), h0 = tr_read<v_rd_off(D0, 0, 1)>(vb), l1 = tr_read<v_rd_off(D0, 1, 0)>(vb), h1 = tr_read<v_rd_off(D0, 1, 1)>(vb);
    const s16x4 l2 = tr_read<v_rd_off(D0, 2, 0)>(vb), h2 = tr_read<v_rd_off(D0, 2, 1)>(vb), l3 = tr_read<v_rd_off(D0, 3, 0)>(vb), h3 = tr_read<v_rd_off(D0, 3, 1)>(vb);
    const s16x4 m0 = tr_read<v_rd_off(D0 + 1, 0, 0)>(vb), g0 = tr_read<v_rd_off(D0 + 1, 0, 1)>(vb), m1 = tr_read<v_rd_off(D0 + 1, 1, 0)>(vb), g1 = tr_read<v_rd_off(D0 + 1, 1, 1)>(vb);
    const s16x4 m2 = tr_read<v_rd_off(D0 + 1, 2, 0)>(vb), g2 = tr_read<v_rd_off(D0 + 1, 2, 1)>(vb), m3 = tr_read<v_rd_off(D0 + 1, 3, 0)>(vb), g3 = tr_read<v_rd_off(D0 + 1, 3, 1)>(vb);
    asm volatile("s_waitcnt lgkmcnt(0)" ::: "memory"); SBAR();
    oa = __builtin_amdgcn_mfma_f32_32x32x16_bf16(pa0, PKV(l0, h0), oa, 0, 0, 0);
    ob = __builtin_amdgcn_mfma_f32_32x32x16_bf16(pa0, PKV(m0, g0), ob, 0, 0, 0);
    oa = __builtin_amdgcn_mfma_f32_32x32x16_bf16(pa1, PKV(l1, h1), oa, 0, 0, 0);
    ob = __builtin_amdgcn_mfma_f32_32x32x16_bf16(pa1, PKV(m1, g1), ob, 0, 0, 0);
    oa = __builtin_amdgcn_mfma_f32_32x32x16_bf16(pa2, PKV(l2, h2), oa, 0, 0, 0);
    ob = __builtin_amdgcn_mfma_f32_32x32x16_bf16(pa2, PKV(m2, g2), ob, 0, 0, 0);
    oa = __builtin_amdgcn_mfma_f32_32x32x16_bf16(pa3, PKV(l3, h3), oa, 0, 0, 0);
    ob = __builtin_amdgcn_mfma_f32_32x32x16_bf16(pa3, PKV(m3, g3), ob, 0, 0, 0);
}
__device__ __forceinline__ void pv_d0(f32x16* o, int vb, bf16x8 pa0, bf16x8 pa1, bf16x8 pa2, bf16x8 pa3) {
    pv_two<0>(o[0], o[1], vb, pa0, pa1, pa2, pa3); pv_two<2>(o[2], o[3], vb, pa0, pa1, pa2, pa3);
}

template <int PROBE> __device__ __forceinline__ void attn_item(const bf16_t* __restrict__ Qb, const bf16_t* __restrict__ Kh, const bf16_t* __restrict__ Vh, bf16_t* __restrict__ mixrow,
                                          const float* __restrict__ gd, float lam, int tid_l) {
    char* lds = smem;
    const int tid = tid_l, wid = tid >> 6, lane = tid & 63, r32 = lane & 31, hi = lane >> 5;
    const int map = wid >> 2, wq = wid & 3, mapc = map * 64;
    char* V_lds = lds; char* K_lds = lds + 3 * A_SHM_V;
    float* wsw = (float*)(lds + 3 * A_SHM_V + 3 * A_SHM_K) + wid * 64; float* li_l = wsw; float* al_l = wsw + 32;
    float m_reg = -1e30f, l_reg = 0; f32x16 o[4] = {}; bf16x8 qr[4];
    const bf16_t* Qw = Qb + (long)(wq * 32 + r32) * 128 + mapc + hi * 8;
#pragma unroll
    for (int d0 = 0; d0 < 4; ++d0) qr[d0] = *reinterpret_cast<const bf16x8*>(Qw + d0 * 16);
    const int vb0 = (int)(uintptr_t)V_lds + v_rd_base(lane);
    unsigned kofs[2], vofs[2];
    const int widu = __builtin_amdgcn_readfirstlane(wid);
#pragma unroll
    for (int i = 0; i < 2; ++i) {
        const int x = wid * 1024 + i * 8192 + lane * 16;
        { const int row = x >> 8, cs = x & 255, colB = cs ^ ((row & 7) << 4); kofs[i] = (unsigned)(row * 256 + colB); }
        { const int sub = x >> 9, wn = x & 511, kk = (sub >> 2) * 8 + (wn >> 6), k = (kk & ~0xC) | ((kk & 4) << 1) | ((kk & 8) >> 1), c = (sub & 3) * 32 + ((wn & 63) >> 1); vofs[i] = (unsigned)(k * 256 + c * 2); }
    }
#define DMA_TILE(slot, k0) do { const char* kt_ = (const char*)Kh + (size_t)(k0) * 256; const char* vt_ = (const char*)Vh + (size_t)(k0) * 256;                  \
      _Pragma("unroll") for (int i = 0; i < 2; ++i) {                                                                   \
        __builtin_amdgcn_global_load_lds((const unsigned*)(kt_ + kofs[i]), (unsigned*)(K_lds + (slot) * A_SHM_K + widu * 1024 + i * 8192), 16, 0, 0); \
        __builtin_amdgcn_global_load_lds((const unsigned*)(vt_ + vofs[i]), (unsigned*)(V_lds + (slot) * A_SHM_V + widu * 1024 + i * 8192), 16, 0, 0); } } while (0)
#define RESC(a) do { if (__any((a) < 1.f)) { if (hi == 0) al_l[r32] = (a); asm volatile("s_waitcnt lgkmcnt(0)" ::: "memory"); \
    _Pragma("unroll") for (int d = 0; d < 4; ++d) _Pragma("unroll") for (int r = 0; r < 16; ++r) o[d][r] *= al_l[crow(r, hi)]; } } while (0)
    f32x16 pA0, pA1, pB0, pB1; float mnA, mnB, alA, alB; bf16x8 pa0, pa1, pa2, pa3; const int NT = RB / A_KVBLK;
    DMA_TILE(0, 0); DMA_TILE(1, A_KVBLK);
    asm volatile("s_waitcnt vmcnt(0)" ::: "memory"); __syncthreads();
    qkt(pA0, pA1, K_lds, qr, r32, hi, mapc); partialSM<PROBE>(pA0, pA1, m_reg, mnA, alA);
    int pb = 0, cb = 1, nb_ = 2;
#define ROT() do { pb = cb; cb = nb_; nb_ = (nb_ == 2) ? 0 : nb_ + 1; } while (0)
    for (int j = 1; j + 1 < NT; j += 2) {
        asm volatile("s_waitcnt vmcnt(0)" ::: "memory"); __syncthreads();
        if (PROBE != 1) DMA_TILE(nb_, (j + 1) * A_KVBLK);
        SBAR(); qkt(pB0, pB1, K_lds + cb * A_SHM_K, qr, r32, hi, mapc);
        finishSM<PROBE>(pA0, pA1, alA, l_reg, pa0, pa1, pa2, pa3); SBAR();
        pv_d0(o, vb0 + pb * A_SHM_V, pa0, pa1, pa2, pa3); partialSM<PROBE>(pB0, pB1, m_reg, mnB, alB);
        RESC(alB); ROT();
        asm volatile("s_waitcnt vmcnt(0)" ::: "memory"); __syncthreads();
        if (PROBE != 1) DMA_TILE(nb_, (j + 2) * A_KVBLK);
        SBAR(); qkt(pA0, pA1, K_lds + cb * A_SHM_K, qr, r32, hi, mapc);
        finishSM<PROBE>(pB0, pB1, alB, l_reg, pa0, pa1, pa2, pa3); SBAR();
        pv_d0(o, vb0 + pb * A_SHM_V, pa0, pa1, pa2, pa3); partialSM<PROBE>(pA0, pA1, m_reg, mnA, alA);
        RESC(alA); ROT();
    }
    asm volatile("s_waitcnt vmcnt(0)" ::: "memory"); __syncthreads();
    SBAR(); qkt(pB0, pB1, K_lds + cb * A_SHM_K, qr, r32, hi, mapc);
    finishSM<PROBE>(pA0, pA1, alA, l_reg, pa0, pa1, pa2, pa3); SBAR();
    pv_d0(o, vb0 + pb * A_SHM_V, pa0, pa1, pa2, pa3); partialSM<PROBE>(pB0, pB1, m_reg, mnB, alB);
    RESC(alB);
    finishSM<PROBE>(pB0, pB1, alB, l_reg, pa0, pa1, pa2, pa3); SBAR();
    pv_d0(o, vb0 + cb * A_SHM_V, pa0, pa1, pa2, pa3);
#undef ROT
#undef DMA_TILE
    if (hi == 0) li_l[r32] = l_reg;
    asm volatile("s_waitcnt lgkmcnt(0)" ::: "memory");
    float rl[16];
#pragma unroll
    for (int r = 0; r < 16; ++r) rl[r] = __builtin_amdgcn_rcpf(li_l[crow(r, hi)]);
    __syncthreads();
    {
        float* xo = (float*)lds + map * 16384 + (wq * 32) * 128 + r32;
#pragma unroll
        for (int r = 0; r < 16; ++r)
#pragma unroll
            for (int d0 = 0; d0 < 4; ++d0) xo[crow(r, hi) * 128 + d0 * 32] = o[d0][r] * rl[r];
    }
    __syncthreads();
    {
        const float g0 = gd[lane * 2], g1 = gd[lane * 2 + 1];
#pragma unroll 4
        for (int rr = 0; rr < 16; ++rr) {
            const int row = wid * 16 + rr;
            const float2 a0 = *(const float2*)((const float*)lds + row * 128 + lane * 2), a1 = *(const float2*)((const float*)lds + 16384 + row * 128 + lane * 2);
            const float xv = a0.x - lam * a1.x, yv = a0.y - lam * a1.y;
            const float ss = wave_sum(xv * xv + yv * yv);
            const float rs = rsqrtf(ss * (1.0f / 128) + EPS) * 0.8f;
            *(unsigned*)(mixrow + (long)row * 1024 + lane * 2) = cvtpk(xv * rs * g0, yv * rs * g1);
        }
    }
    __syncthreads();
#undef RESC
}


template <int PROBE> __device__ __forceinline__ void ph_attn(const MK& p, int bid, int nb, int tid_l) {
    const int lane = tid_l & 63;
    float s1 = wave_sum(p.lq1[lane] * p.lk1[lane]), s2 = wave_sum(p.lq2[lane] * p.lk2[lane]);
    const float lam = expf(s1) - expf(s2) + 0.2f;
    const int nrounds = (1024 + nb - 1) / nb;
    for (int rr = 0; rr < nrounds; ++rr) {
        int item;
        if (nb == 256) { int x = bid & 7, j = bid >> 3, hh = rr * 8 + x; item = (hh >> 1) * 64 + (hh & 1) * 32 + j; }
        else { item = rr * nb + bid; if (item >= 1024) break; }
        const int bh = item >> 6, qb = item & 63, b = bh >> 2, h = bh & 3;
        attn_item<PROBE>(p.Q() + ((size_t)bh * SEQ + qb * 128) * 128, p.K() + (size_t)bh * RB * 128, p.V() + (size_t)bh * RB * 128,
                  PROBE ? (bf16_t*)(p.ws + 492 * MiB) + h * 128 : p.MIX() + ((size_t)(b * SEQ + qb * 128)) * 1024 + h * 128, p.dattn_g, lam, tid_l);
    }
}


__device__ __forceinline__ bf16x8 ldfrag(const bf16_t* p) { return *reinterpret_cast<const bf16x8*>(p); }

__device__ __forceinline__ void ph_kv(const MK& p, int bid, int nb, int tid_l) {
    const int wid = tid_l >> 6, lane = tid_l & 63, r32 = lane & 31, hi = lane >> 5;
    const int nitems = 16 * 2 * 66;
    for (int it = bid * 8 + wid; it < nitems; it += nb * 8) {
        const int c = it % 66, chain = it / 66, dir = chain & 1, bh = chain >> 1;
        const bf16_t* vt = p.VT() + (size_t)bh * 128 * RB + c * 128 + hi * 8;
        const bf16_t* kt = (dir ? p.KTb() : p.KTf()) + (size_t)bh * 64 * RB + c * 128 + hi * 8;
        f32x16 acc[4][2];
#pragma unroll
        for (int mt = 0; mt < 4; ++mt) { acc[mt][0] = f32x16{}; acc[mt][1] = f32x16{}; }
#pragma unroll 2
        for (int ks = 0; ks < 8; ++ks) {
            bf16x8 a[4], b[2];
#pragma unroll
            for (int mt = 0; mt < 4; ++mt) a[mt] = ldfrag(vt + (size_t)(mt * 32 + r32) * RB + ks * 16);
#pragma unroll
            for (int nt = 0; nt < 2; ++nt) b[nt] = ldfrag(kt + (size_t)(nt * 32 + r32) * RB + ks * 16);
#pragma unroll
            for (int mt = 0; mt < 4; ++mt)
#pragma unroll
                for (int nt = 0; nt < 2; ++nt) acc[mt][nt] = __builtin_amdgcn_mfma_f32_32x32x16_bf16(a[mt], b[nt], acc[mt][nt], 0, 0, 0);
        }
        bf16_t* dst = p.KV() + (size_t)it * 8192;
#pragma unroll
        for (int mt = 0; mt < 4; ++mt)
#pragma unroll
            for (int nt = 0; nt < 2; ++nt)
#pragma unroll
                for (int r = 0; r < 16; ++r) dst[(mt * 32 + crow(r, hi)) * 64 + nt * 32 + r32] = f2bf(acc[mt][nt][r]);
    }
}

__device__ __forceinline__ void ph_scan(const MK& p, int bid, int nb, int tid_l) {
    for (int e = bid * NTHR + tid_l; e < 32 * 8192; e += nb * NTHR) {
        const int chain = e >> 13, el = e & 8191, dir = chain & 1, bh = chain >> 1, h = bh & 3;
        const float d = dir ? p.dec_b[h] : p.dec_f[h];
        const float g128 = exp2f(128.0f * log2f(1.0f / (1.0f + expf(-d))));
        const bf16_t* kv = p.KV() + (size_t)chain * 66 * 8192 + el;
        bf16_t* st = p.ST() + (size_t)chain * 66 * 8192 + el;
        float S = 0.f;
        for (int n = 0; n < 66; ++n) {
            const int c = dir == 0 ? n : (n == 0 ? 1 : (n == 1 ? 0 : 67 - n));
            st[(size_t)c * 8192] = f2bf(S);
            S = fmaf(g128, S, bf2f(kv[(size_t)c * 8192]));
        }
    }
}

__device__ __forceinline__ void ph_ret(const MK& p, int bid, int nb, int tid_l) {
    const int tid = tid_l, wid = tid >> 6, lane = tid & 63, r32 = lane & 31, hi = lane >> 5, wq = wid & 3, half = wid >> 2;
    float* img = (float*)smem;
    for (int it = bid; it < 4 * 64 * 2; it += nb) {
        const int hp = it & 1, lc = (it >> 1) & 63, b = it >> 7, h = hp * 2 + half, bh = b * 4 + h;
        const int ib = CTX + lc * 128, c = 2 + lc;
        const float lf = log2f(1.0f / (1.0f + expf(-p.dec_f[h]))), lb = log2f(1.0f / (1.0f + expf(-p.dec_b[h])));
        const bf16_t* rq = p.RQ() + ((size_t)bh * RB + ib + wq * 32 + r32) * 64 + hi * 8;
        bf16x8 q[4];
#pragma unroll
        for (int ks = 0; ks < 4; ++ks) q[ks] = ldfrag(rq + ks * 16);
        f32x16 o[4];
        {
            const bf16_t* stf = p.ST() + ((size_t)(bh * 2 + 0) * 66 + c) * 8192 + hi * 8;
            const bf16_t* stb = p.ST() + ((size_t)(bh * 2 + 1) * 66 + c) * 8192 + hi * 8;
            {
                float rf[16];
#pragma unroll
                for (int r = 0; r < 16; ++r) rf[r] = __builtin_amdgcn_exp2f((float)(wq * 32 + crow(r, hi) + 1) * lf);
#pragma unroll
                for (int d0 = 0; d0 < 4; ++d0) {
                    f32x16 tf = f32x16{};
#pragma unroll
                    for (int ks = 0; ks < 4; ++ks) tf = __builtin_amdgcn_mfma_f32_32x32x16_bf16(q[ks], ldfrag(stf + (size_t)(d0 * 32 + r32) * 64 + ks * 16), tf, 0, 0, 0);
#pragma unroll
                    for (int r = 0; r < 16; ++r) o[d0][r] = tf[r] * rf[r];
                    asm volatile("" ::: "memory");
                }
            }
            {
                float rf[16];
#pragma unroll
                for (int r = 0; r < 16; ++r) rf[r] = __builtin_amdgcn_exp2f((float)(128 - (wq * 32 + crow(r, hi))) * lb);
#pragma unroll
                for (int d0 = 0; d0 < 4; ++d0) {
                    f32x16 tb = f32x16{};
#pragma unroll
                    for (int ks = 0; ks < 4; ++ks) tb = __builtin_amdgcn_mfma_f32_32x32x16_bf16(q[ks], ldfrag(stb + (size_t)(d0 * 32 + r32) * 64 + ks * 16), tb, 0, 0, 0);
#pragma unroll
                    for (int r = 0; r < 16; ++r) o[d0][r] += tb[r] * rf[r];
                    asm volatile("" ::: "memory");
                }
            }
        }
        {
            const int qi = wq * 32 + r32;
            const bf16_t* vt = p.VT() + (size_t)bh * 128 * RB + ib + hi * 8;
#pragma unroll 1
            for (int jb = 0; jb < 4; ++jb) {
                asm volatile("" ::: "memory");
                const bf16_t* rk = p.RK() + ((size_t)bh * RB + ib + jb * 32 + r32) * 64 + hi * 8;
                f32x16 pp = f32x16{};
#pragma unroll
                for (int ks = 0; ks < 4; ++ks) pp = __builtin_amdgcn_mfma_f32_32x32x16_bf16(ldfrag(rk + ks * 16), q[ks], pp, 0, 0, 0);
#pragma unroll
                for (int r = 0; r < 16; ++r) {
                    const int dd = qi - (jb * 32 + crow(r, hi));
                    const float ex = __builtin_amdgcn_exp2f(dd > 0 ? (float)dd * lf : (float)(-dd) * lb); const float w = dd == 0 ? 2.0f : ex;
                    pp[r] *= w;
                }
                bf16x8 pa0, pa1;
                PK4(pp, 0, pa0); PK4(pp, 8, pa1);
#pragma unroll
                for (int d0 = 0; d0 < 4; ++d0) {
                    o[d0] = __builtin_amdgcn_mfma_f32_32x32x16_bf16(pa0, ldfrag(vt + (size_t)(d0 * 32 + r32) * RB + jb * 32), o[d0], 0, 0, 0);
                    o[d0] = __builtin_amdgcn_mfma_f32_32x32x16_bf16(pa1, ldfrag(vt + (size_t)(d0 * 32 + r32) * RB + jb * 32 + 16), o[d0], 0, 0, 0);
                }
            }
        }
        __syncthreads();
        {
            float* xo = img + half * 16384 + (wq * 32) * 128 + r32;
#pragma unroll
            for (int r = 0; r < 16; ++r)
#pragma unroll
                for (int d0 = 0; d0 < 4; ++d0) xo[crow(r, hi) * 128 + d0 * 32] = o[d0][r];
        }
        __syncthreads();
        {
            const float g0 = p.ret_g[lane * 2], g1 = p.ret_g[lane * 2 + 1];
#pragma unroll 4
            for (int rr = 0; rr < 32; ++rr) {
                const int row = wid * 32 + rr, itl = row >> 7, rw = row & 127, hh = hp * 2 + itl;
                const float2 a = *(const float2*)(img + row * 128 + lane * 2);
                const float ss = wave_sum(a.x * a.x + a.y * a.y);
                const float rs = rsqrtf(ss * (1.0f / 128) + EPS);
                const size_t tt = (size_t)b * SEQ + lc * 128 + rw;
                const unsigned gg = *(const unsigned*)(p.RG() + tt * 512 + hh * 128 + lane * 2);
                const float ga = bf2f((bf16_t)(gg & 0xffff)), gb = bf2f((bf16_t)(gg >> 16));
                *(unsigned*)(p.MIX() + tt * 1024 + 512 + hh * 128 + lane * 2) = cvtpk(siluf(ga) * a.x * rs * g0, siluf(gb) * a.y * rs * g1);
            }
        }
    }
}


namespace pg8 {
constexpr int BM = 256, BK = 64, HALF = 128, HTB = HALF * BK * 2;
__device__ __forceinline__ int perm32(int rho) { const int n = rho >> 4, i = rho & 15; return 8 * (i >> 2) + 4 * n + (i & 3); }
struct GUnit { const char* A; const char* B; int i0, i1, i2, i3; };
template <class Epi, class Sched, bool GATHER, bool ALIGN_EPI>
__device__ __forceinline__ void gemm(int K, const Sched& S, const Epi& E, int tid_l) {
    const int tid = tid_l, wid = __builtin_amdgcn_readfirstlane(tid >> 6), lane = tid & 63, wr = wid >> 2, wc = wid & 3, fr = lane & 15, fq = lane >> 4;
    const int nt = K / BK;
    unsigned voffB[2], vAc[2][2], vAn[2][2];
    const size_t kstep = (size_t)(BK * 2);
    const size_t hstepB = (size_t)HALF * K * 2;
#pragma unroll
    for (int i = 0; i < 2; ++i) { int R, C; stage_rc(tid * 16 + i * 8192, R, C); const int Rb = Epi::PERM ? ((R & ~31) + perm32(R & 31)) : R;
        voffB[i] = (unsigned)(Rb * K + C) * 2u; }
    const unsigned ldsw = (unsigned)wid * 1024u;
    const int aoff = lds_byte(wr * 64 + fr, fq * 8), boff = lds_byte(wc * 32 + fr, fq * 8);
#define PG8_SA(b, h) (((b) * 2 + (h)) * HTB)
#define PG8_SB(b, h) ((4 + (b) * 2 + (h)) * HTB)
#define PG8_STAGE(bufoff, gbase, voff) do { _Pragma("unroll") for (int _i = 0; _i < 2; ++_i) \
        __builtin_amdgcn_global_load_lds((const unsigned*)((const char*)(gbase) + (voff)[_i]), (unsigned*)(smem + (bufoff) + ldsw + _i * 8192), 16, 0, 0); } while (0)
#define PG8_LDA(dst, b, h) do { _Pragma("unroll") for (int m = 0; m < 4; ++m) _Pragma("unroll") for (int k = 0; k < 2; ++k) dst[m][k] = *(const bf16x8*)(smem + PG8_SA(b, h) + aoff + m * 2048 + k * 1024); } while (0)
#define PG8_LDB(dst, b, h) do { _Pragma("unroll") for (int n = 0; n < 2; ++n) _Pragma("unroll") for (int k = 0; k < 2; ++k) dst[n][k] = *(const bf16x8*)(smem + PG8_SB(b, h) + boff + n * 2048 + k * 1024); } while (0)
#define PG8_MMA(ai, bj, At, Bt) do { __builtin_amdgcn_s_setprio(1); _Pragma("unroll") for (int m = 0; m < 4; ++m) _Pragma("unroll") for (int n = 0; n < 2; ++n) _Pragma("unroll") for (int k = 0; k < 2; ++k) \
        acc[ai][bj][m][n] = __builtin_amdgcn_mfma_f32_16x16x32_bf16(Bt[n][k], At[m][k], acc[ai][bj][m][n], 0, 0, 0); __builtin_amdgcn_s_setprio(0); } while (0)
#define PG8_WAIT_V(n) asm volatile("s_waitcnt vmcnt(" #n ")" ::: "memory")
#define PG8_WAIT_L(n) asm volatile("s_waitcnt lgkmcnt(" #n ")" ::: "memory")
#define PG8_BAR __builtin_amdgcn_s_barrier()
#define PG8_SCHED __builtin_amdgcn_sched_barrier(0)
    GUnit cur, nxt; int ui = 0;
    if (!S.next(0, cur, vAc)) return;
    f32x4 acc[2][2][4][2];
#pragma unroll
    for (int a = 0; a < 2; ++a)
#pragma unroll
        for (int b = 0; b < 2; ++b)
#pragma unroll
            for (int m = 0; m < 4; ++m)
#pragma unroll
                for (int n = 0; n < 2; ++n) acc[a][b][m][n] = (f32x4){0.f, 0.f, 0.f, 0.f};
    bf16x8 At[4][2], B0[2][2], B1[2][2];
    const char* cA = cur.A; const char* cB = cur.B;
    PG8_STAGE(PG8_SB(0, 0), cB, voffB); PG8_STAGE(PG8_SB(0, 1), cB + hstepB, voffB); PG8_STAGE(PG8_SA(0, 0), cA, vAc[0]); PG8_STAGE(PG8_SA(0, 1), cA, vAc[1]);
    if (wr == 1) PG8_BAR;
    PG8_WAIT_V(2); PG8_BAR;
    PG8_STAGE(PG8_SB(1, 0), cB + kstep, voffB); PG8_STAGE(PG8_SA(1, 0), cA + kstep, vAc[0]); PG8_STAGE(PG8_SB(1, 1), cB + hstepB + kstep, voffB);
    PG8_WAIT_V(6); PG8_BAR;
    for (;;) {
        const bool has_next = S.next(ui + 1, nxt, vAn);
        if (!GATHER || !has_next) {
#pragma unroll
            for (int h = 0; h < 2; ++h)
#pragma unroll
                for (int i = 0; i < 2; ++i) vAn[h][i] = vAc[h][i];
        }
        const char* nA = has_next ? nxt.A : cA; const char* nB = has_next ? nxt.B : cB;
#pragma unroll 1
        for (int t = 0; t < nt; t += 2) {
            const bool last = (t == nt - 2);
            const char* a1 = cA + (size_t)(t + 1) * kstep;
            const char* a2 = last ? nA : cA + (size_t)(t + 2) * kstep; const char* b2 = last ? nB : cB + (size_t)(t + 2) * kstep;
            const char* a3 = a2 + kstep; const char* b3 = b2 + kstep;
            unsigned va2[2][2];
#pragma unroll
            for (int h = 0; h < 2; ++h)
#pragma unroll
                for (int i = 0; i < 2; ++i) va2[h][i] = (GATHER && last) ? vAn[h][i] : vAc[h][i];
            PG8_LDB(B0, 0, 0); PG8_LDB(B1, 0, 1); PG8_SCHED; PG8_LDA(At, 0, 0); PG8_STAGE(PG8_SA(1, 1), a1, vAc[1]);
            PG8_WAIT_V(8); PG8_WAIT_L(0); PG8_BAR; PG8_MMA(0, 0, At, B0); PG8_MMA(0, 1, At, B1); PG8_BAR; PG8_SCHED;
            PG8_LDA(At, 0, 1); PG8_STAGE(PG8_SB(0, 0), b2, voffB); PG8_STAGE(PG8_SB(0, 1), b2 + hstepB, voffB); PG8_STAGE(PG8_SA(0, 0), a2, va2[0]);
            PG8_WAIT_V(8); PG8_WAIT_L(0); PG8_BAR; PG8_MMA(1, 0, At, B0); PG8_MMA(1, 1, At, B1); PG8_BAR; PG8_SCHED;
            PG8_LDB(B0, 1, 0); PG8_LDB(B1, 1, 1); PG8_SCHED; PG8_LDA(At, 1, 0); PG8_STAGE(PG8_SA(0, 1), a2, va2[1]);
            PG8_WAIT_V(8); PG8_WAIT_L(0); PG8_BAR; PG8_MMA(0, 0, At, B0); PG8_MMA(0, 1, At, B1); PG8_BAR; PG8_SCHED;
            PG8_LDA(At, 1, 1); PG8_STAGE(PG8_SB(1, 0), b3, voffB); PG8_STAGE(PG8_SB(1, 1), b3 + hstepB, voffB); PG8_STAGE(PG8_SA(1, 0), a3, va2[0]);
            PG8_WAIT_V(8); PG8_WAIT_L(0); PG8_BAR; PG8_MMA(1, 0, At, B0); PG8_MMA(1, 1, At, B1); PG8_BAR; PG8_SCHED;
        }
        if (ALIGN_EPI) { if (wr == 0) PG8_BAR; }
        E(acc, cur, wr, wc, fr, fq);
        if (!has_next) break;
#pragma unroll
        for (int a = 0; a < 2; ++a)
#pragma unroll
            for (int b = 0; b < 2; ++b)
#pragma unroll
                for (int m = 0; m < 4; ++m)
#pragma unroll
                    for (int n = 0; n < 2; ++n) acc[a][b][m][n] = (f32x4){0.f, 0.f, 0.f, 0.f};
        cur = nxt; cA = nA; cB = nB; ++ui;
#pragma unroll
        for (int h = 0; h < 2; ++h)
#pragma unroll
            for (int i = 0; i < 2; ++i) vAc[h][i] = vAn[h][i];
        if (ALIGN_EPI) { if (wr == 1) PG8_BAR; }
    }
    PG8_WAIT_V(0);
    if (!ALIGN_EPI) { if (wr == 0) PG8_BAR; }
    PG8_BAR;
#undef PG8_SA
#undef PG8_SB
#undef PG8_STAGE
#undef PG8_LDA
#undef PG8_LDB
#undef PG8_MMA
#undef PG8_WAIT_V
#undef PG8_WAIT_L
#undef PG8_BAR
#undef PG8_SCHED
}
__device__ __forceinline__ void plain_voffA(int K, unsigned (&vA)[2][2], int tid_l) {
#pragma unroll
    for (int i = 0; i < 2; ++i) { int R, C; stage_rc(tid_l * 16 + i * 8192, R, C); vA[0][i] = (unsigned)(R * K + C) * 2u; vA[1][i] = (unsigned)((R + HALF) * K + C) * 2u; }
}
}


struct SchedIn { const MK* p; int bid, nb, tid_l;
    __device__ __forceinline__ bool next(int i, pg8::GUnit& u, unsigned (&vA)[2][2]) const {
        const int tile = bid + i * nb; if (tile >= (NR / 256) * 12) return false;
        const int pm = tile / 12, pn = tile % 12;
        u.A = (const char*)(p->H() + (size_t)(pm * 256) * D); u.B = (const char*)(p->w_inT() + (size_t)(pn * 256) * D); u.i0 = pm; u.i1 = pn; u.i2 = 0; u.i3 = 0;
        pg8::plain_voffA(D, vA, tid_l); return true; } };
struct EpiIn { static constexpr bool PERM = false; const MK* p;
    __device__ __forceinline__ void operator()(f32x4 (&acc)[2][2][4][2], const pg8::GUnit& u, int wr, int wc, int fr_in, int fq_in) const {
        int fr = fr_in, fq = fq_in; asm volatile("" : "+v"(fr), "+v"(fq));
        const int pm = u.i0, seg = u.i1, brow = pm * 256;
        const int b = brow / RB, i0 = brow % RB;
        const bool lat = i0 >= CTX;
        const int wid = wr * 4 + wc, lane = fq * 16 + fr;
        if (lat && (seg <= 3 || seg == 6 || seg == 7)) {
#pragma unroll
            for (int ai = 0; ai < 2; ++ai)
#pragma unroll
                for (int m = 0; m < 4; ++m) {
                    const int t = i0 + ai * 128 + wr * 64 + m * 16 + fr - CTX, pos = (wc & 1) ? (t & 63) : (t >> 6);
                    const f32x4 cc = *(const f32x4*)(p->ropec() + pos * 16 + fq * 4), ss = *(const f32x4*)(p->ropes() + pos * 16 + fq * 4);
#pragma unroll
                    for (int bj = 0; bj < 2; ++bj) { const f32x4 x1 = acc[ai][bj][m][0], x2 = acc[ai][bj][m][1];
                        acc[ai][bj][m][0] = x1 * cc - x2 * ss; acc[ai][bj][m][1] = x1 * ss + x2 * cc; }
                }
        }
        if (seg == 7) {
#pragma unroll
            for (int ai = 0; ai < 2; ++ai)
#pragma unroll
                for (int bj = 0; bj < 2; ++bj)
#pragma unroll
                    for (int m = 0; m < 4; ++m) { acc[ai][bj][m][0] = acc[ai][bj][m][0] * 0.125f; acc[ai][bj][m][1] = acc[ai][bj][m][1] * 0.125f; }
        }
        if (seg <= 7 || seg >= 10) {
#pragma unroll
            for (int bj = 0; bj < 2; ++bj) {
                bf16_t* base; long rstride; bool ok = true;
                if (seg <= 1)      { const int h = (seg & 1) * 2 + bj;       base = p->Q() + (((size_t)(b * 4 + h) * SEQ + (i0 - CTX)) * 128 + wc * 32 + fq * 4); rstride = 128; ok = lat; }
                else if (seg <= 3) { const int h = (seg - 2) * 2 + bj;       base = p->K() + (((size_t)(b * 4 + h) * RB + i0) * 128 + wc * 32 + fq * 4);          rstride = 128; }
                else if (seg <= 5) { const int h = (seg - 4) * 2 + bj;       base = p->V() + (((size_t)(b * 4 + h) * RB + i0) * 128 + wc * 32 + fq * 4);          rstride = 128; }
                else if (seg == 6) { const int h = bj * 2 + (wc >> 1);       base = p->RQ() + (((size_t)(b * 4 + h) * RB + i0) * 64 + (wc & 1) * 32 + fq * 4);    rstride = 64; }
                else if (seg == 7) { const int h = bj * 2 + (wc >> 1);       base = p->RK() + (((size_t)(b * 4 + h) * RB + i0) * 64 + (wc & 1) * 32 + fq * 4);    rstride = 64; }
                else               {                                         base = p->RG() + ((size_t)(b * SEQ + (i0 - CTX)) * 512 + (seg - 10) * 256 + bj * 128 + wc * 32 + fq * 4); rstride = 512; ok = lat; }
                if (ok) {
#pragma unroll
                    for (int ai = 0; ai < 2; ++ai)
#pragma unroll
                        for (int m = 0; m < 4; ++m) { bf16_t* rp = base + (long)(ai * 128 + wr * 64 + m * 16 + fr) * rstride;
#pragma unroll
                            for (int n = 0; n < 2; ++n) { u32x2 w; w.x = cvtpk(acc[ai][bj][m][n][0], acc[ai][bj][m][n][1]); w.y = cvtpk(acc[ai][bj][m][n][2], acc[ai][bj][m][n][3]);
                                *(u32x2*)(rp + n * 16) = w; } }
                }
            }
        }
        if (seg >= 7 && seg <= 9) {
            char* img = smem + 131072 + wid * 3968;
            const int npass = seg == 7 ? 2 : 1;
#pragma unroll 1
            for (int ps = 0; ps < npass; ++ps) {
#pragma unroll
                for (int bj = 0; bj < 2; ++bj) {
                    float lg2 = 0.f; bf16_t* baseT;
                    if (seg == 7) { const int h = bj * 2 + (wc >> 1); const float dv = ps == 0 ? p->dec_f[h] : p->dec_b[h]; lg2 = log2f(1.0f / (1.0f + expf(-dv)));
                        baseT = (ps == 0 ? p->KTf() : p->KTb()) + ((size_t)(b * 4 + h) * 64 + (wc & 1) * 32) * RB + i0; }
                    else { const int h = (seg - 8) * 2 + bj; baseT = p->VT() + ((size_t)(b * 4 + h) * 128 + wc * 32) * RB + i0; }
#pragma unroll
                    for (int ai = 0; ai < 2; ++ai)
#pragma unroll
                        for (int mp = 0; mp < 2; ++mp) {
                            asm volatile("s_waitcnt lgkmcnt(0)" ::: "memory");
#pragma unroll
                            for (int mm = 0; mm < 2; ++mm) { const int m = mp * 2 + mm;
                                float f = 1.0f;
                                if (seg == 7) { const int pos = (i0 + ai * 128 + wr * 64 + m * 16 + fr) & 127; f = exp2f((float)(ps == 0 ? 127 - pos : pos) * lg2); }
#pragma unroll
                                for (int n = 0; n < 2; ++n)
#pragma unroll
                                    for (int j = 0; j < 4; ++j) *(bf16_t*)(img + (n * 16 + fq * 4 + j) * 80 + (mm * 16 + fr) * 2) = f2bf(acc[ai][bj][m][n][j] * f); }
                            asm volatile("s_waitcnt lgkmcnt(0)" ::: "memory");
                            const int ib = ai * 128 + wr * 64 + mp * 32;
#pragma unroll
                            for (int k = 0; k < 2; ++k) { const int q = lane + 64 * k, col = q >> 2, ch = q & 3;
                                *(u32x4*)(baseT + (size_t)col * RB + ib + ch * 8) = *(const u32x4*)(img + col * 80 + ch * 16); }
                        }
                }
            }
        }
    } };
__device__ __forceinline__ void ph_gemm_in(const MK& p, int bid, int nb, int tid_l) {
    SchedIn S{&p, bid, nb, tid_l}; EpiIn E{&p};
    pg8::gemm<EpiIn, SchedIn, false, true>(D, S, E, tid_l);
}

struct SchedOut { const MK* p; int bid, nb, tid_l;
    __device__ __forceinline__ bool next(int i, pg8::GUnit& u, unsigned (&vA)[2][2]) const {
        const int tile = bid + i * nb; if (tile >= (T / 256) * 4) return false;
        const int pm = tile >> 2, pn = tile & 3;
        u.A = (const char*)(p->MIX() + (size_t)(pm * 256) * D); u.B = (const char*)(p->w_outT() + (size_t)(pn * 256) * D); u.i0 = pm; u.i1 = pn; u.i2 = 0; u.i3 = 0;
        pg8::plain_voffA(D, vA, tid_l); return true; } };
struct EpiOut { static constexpr bool PERM = false; const MK* p;
    __device__ __forceinline__ void operator()(const f32x4 (&acc)[2][2][4][2], const pg8::GUnit& u, int wr, int wc, int fr, int fq) const {
        const int brow = u.i0 * 256, bcol = u.i1 * 256;
        const float* g1 = p->mod() + (size_t)(brow / SEQ) * 6 * D + 2 * D + bcol + wc * 32 + fq * 4;
        f32x4 gv[2][2];
#pragma unroll
        for (int bj = 0; bj < 2; ++bj)
#pragma unroll
            for (int n = 0; n < 2; ++n) gv[bj][n] = *(const f32x4*)(g1 + bj * 128 + n * 16);
#pragma unroll
        for (int ai = 0; ai < 2; ++ai)
#pragma unroll
            for (int m = 0; m < 4; ++m) {
                const size_t o = (size_t)(brow + ai * 128 + wr * 64 + m * 16 + fr) * D + bcol + wc * 32 + fq * 4;
                f32x4 xv[2][2];
#pragma unroll
                for (int bj = 0; bj < 2; ++bj)
#pragma unroll
                    for (int n = 0; n < 2; ++n) xv[bj][n] = *(const f32x4*)(p->x + o + bj * 128 + n * 16);
#pragma unroll
                for (int bj = 0; bj < 2; ++bj)
#pragma unroll
                    for (int n = 0; n < 2; ++n) *(f32x4*)(p->out + o + bj * 128 + n * 16) = xv[bj][n] + gv[bj][n] * acc[ai][bj][m][n];
                if (m & 1) asm volatile("" ::: "memory");
            }
    } };
__device__ __forceinline__ void ph_gemm_out(const MK& p, int bid, int nb, int tid_l) {
    SchedOut S{&p, bid, nb, tid_l}; EpiOut E{&p};
    pg8::gemm<EpiOut, SchedOut, false, true>(D, S, E, tid_l);
}

template <bool DUMMY, int MODE = 0> __device__ __forceinline__ void ph_route(const MK& p, int bid, int nb, int tid_l) {
    int* cntp = p.cnt() + (DUMMY ? 128 : 0); int* tl = DUMMY ? (int*)(p.ws + 480 * MiB) : p.tok_list(); float* wl_ = DUMMY ? (float*)(p.ws + 488 * MiB) : p.wt_list(); int* tm = DUMMY ? (int*)(p.ws + 496 * MiB) : p.tokmap();
    const int tid = tid_l, wid = tid >> 6, lane = tid & 63, fr = lane & 15, fq = lane >> 4;
    float* lg = (float*)smem;
    int* wcnt = (int*)(smem + 34816);
    int* basel = wcnt + 128;
    bf16_t* H2lo = (bf16_t*)(p.ws + 325 * MiB);
    for (int item = bid; item < T / 128; item += nb) {
        const int t0 = item * 128 + wid * 16, b = (item * 128) / SEQ;
        const float* msh = p.mod() + (size_t)b * 6 * D + 3 * D; const float* msc = p.mod() + (size_t)b * 6 * D + 4 * D;
#pragma unroll 1
        for (int r0 = 0; r0 < 16; r0 += 4) {
            float4 xv[4][4];
#pragma unroll
            for (int rr = 0; rr < 4; ++rr)
#pragma unroll
                for (int q = 0; q < 4; ++q) xv[rr][q] = *(const float4*)(p.out + (size_t)(t0 + r0 + rr) * D + q * 256 + lane * 4);
#pragma unroll
            for (int rr = 0; rr < 4; ++rr) {
                float ss = 0.f;
#pragma unroll
                for (int q = 0; q < 4; ++q) ss += xv[rr][q].x * xv[rr][q].x + xv[rr][q].y * xv[rr][q].y + xv[rr][q].z * xv[rr][q].z + xv[rr][q].w * xv[rr][q].w;
                ss = wave_sum(ss);
                const float rstd = rsqrtf(ss * (1.0f / D) + EPS);
#pragma unroll
                for (int q = 0; q < 4; ++q) {
                    const int c0 = q * 256 + lane * 4;
                    const float4 gg = *(const float4*)(p.norm2_g + c0), sh = *(const float4*)(msh + c0), sc = *(const float4*)(msc + c0);
                    const float h0 = xv[rr][q].x * rstd * gg.x * (1 + sc.x) + sh.x, h1 = xv[rr][q].y * rstd * gg.y * (1 + sc.y) + sh.y;
                    const float h2v = xv[rr][q].z * rstd * gg.z * (1 + sc.z) + sh.z, h3 = xv[rr][q].w * rstd * gg.w * (1 + sc.w) + sh.w;
                    u32x2 wh, wl2; wh.x = cvtpk(h0, h1); wh.y = cvtpk(h2v, h3);
                    wl2.x = cvtpk(h0 - __uint_as_float(wh.x << 16), h1 - __uint_as_float(wh.x & 0xffff0000u));
                    wl2.y = cvtpk(h2v - __uint_as_float(wh.y << 16), h3 - __uint_as_float(wh.y & 0xffff0000u));
                    *(u32x2*)(p.H2() + (size_t)(t0 + r0 + rr) * D + c0) = wh;
                    *(u32x2*)(H2lo + (size_t)(t0 + r0 + rr) * D + c0) = wl2;
                }
            }
        }
        asm volatile("s_waitcnt vmcnt(0)" ::: "memory");
        __syncthreads();
        if (MODE == 3) continue;
        f32x4 acc[4];
#pragma unroll
        for (int nt = 0; nt < 4; ++nt) acc[nt] = (f32x4){0.f, 0.f, 0.f, 0.f};
        {
            const bf16_t* ah_p = p.H2() + (size_t)(t0 + fr) * D + fq * 8; const bf16_t* al_p = H2lo + (size_t)(t0 + fr) * D + fq * 8;
            const bf16_t* rT = p.routerT() + (size_t)fr * D + fq * 8;
#pragma unroll 4
            for (int ks = 0; ks < 32; ++ks) {
                const int k0 = ks * 32;
                const bf16x8 ah = ldfrag(ah_p + k0), al = ldfrag(al_p + k0);
#pragma unroll
                for (int nt = 0; nt < 4; ++nt) {
                    const bf16x8 bh = ldfrag(rT + (size_t)(nt * 16) * D + k0), bl = ldfrag(rT + (size_t)(64 + nt * 16) * D + k0);
                    acc[nt] = __builtin_amdgcn_mfma_f32_16x16x32_bf16(ah, bh, acc[nt], 0, 0, 0);
                    acc[nt] = __builtin_amdgcn_mfma_f32_16x16x32_bf16(ah, bl, acc[nt], 0, 0, 0);
                    acc[nt] = __builtin_amdgcn_mfma_f32_16x16x32_bf16(al, bh, acc[nt], 0, 0, 0);
                }
            }
        }
#pragma unroll
        for (int nt = 0; nt < 4; ++nt)
#pragma unroll
            for (int j = 0; j < 4; ++j) lg[(wid * 16 + fq * 4 + j) * 65 + nt * 16 + fr] = acc[nt][j];
        __syncthreads();
        if (MODE == 2) continue;
        float sc_[64]; unsigned long long ch = 0ull; float wscale = 0.f;
        const int tt = (wid & 1) * 64 + lane, t = item * 128 + tt;
        if (wid < 2) {
            float v[64];
#pragma unroll
            for (int e = 0; e < 64; ++e) { const float x = lg[tt * 65 + e]; sc_[e] = 1.0f / (1.0f + expf(-x)); v[e] = sc_[e] + p.router_b[e]; }
            float gs[8];
#pragma unroll
            for (int g = 0; g < 8; ++g) { float m1 = v[8 * g], m2 = -INFINITY;
#pragma unroll
                for (int i = 1; i < 8; ++i) { const float x = v[8 * g + i]; m2 = fmaxf(m2, fminf(m1, x)); m1 = fmaxf(m1, x); }
                gs[g] = m1 + m2; }
#pragma unroll
            for (int g = 0; g < 8; ++g) { int rank = 0;
#pragma unroll
                for (int g2 = 0; g2 < 8; ++g2) if (g2 != g) rank += (gs[g2] > gs[g] || (gs[g2] == gs[g] && g2 < g)) ? 1 : 0;
                if (rank >= 4) {
#pragma unroll
                    for (int i = 0; i < 8; ++i) v[8 * g + i] = -INFINITY; } }
#pragma unroll
            for (int it = 0; it < 8; ++it) {
                float m = v[0];
#pragma unroll
                for (int e = 1; e < 64; ++e) m = fmaxf(m, v[e]);
                bool found = false;
#pragma unroll
                for (int e = 0; e < 64; ++e) { const bool hit = !found && v[e] == m; if (hit) { ch |= (1ull << e); v[e] = -INFINITY; } found = found || hit; }
            }
            float wsum = 0.f;
#pragma unroll
            for (int e = 0; e < 64; ++e) wsum += ((ch >> e) & 1ull) ? sc_[e] : 0.f;
            wscale = 2.5f / wsum;
#pragma unroll
            for (int e = 0; e < 64; ++e) { const unsigned long long mk = __ballot((ch >> e) & 1ull); if (lane == 0) wcnt[wid * 64 + e] = __popcll(mk); }
        }
        __syncthreads();
        if (wid == 0) basel[lane] = atomicAdd(&cntp[lane], wcnt[lane] + wcnt[64 + lane]);
        __syncthreads();
        if (wid < 2) {
            int kidx = 0;
#pragma unroll
            for (int e = 0; e < 64; ++e) {
                const bool c = (ch >> e) & 1ull;
                const unsigned long long mk = __ballot(c);
                if (c) {
                    const int slot = basel[e] + (wid == 1 ? wcnt[e] : 0) + __popcll(mk & ((1ull << lane) - 1ull));
                    tl[(size_t)e * ECAP + slot] = t; wl_[(size_t)e * ECAP + slot] = sc_[e] * wscale;
                    tm[(size_t)t * 8 + kidx] = e * ECAP + slot; ++kidx;
                }
            }
        }
    }
}

constexpr int MOE_AUX = 162816;
__device__ __forceinline__ void moe_tables(const MK& p, int colt, int* tpre, int* rbase, int tid_l) {
    __syncthreads();
    if (tid_l == 0) { int tp = 0, rb = 0;
        for (int e = 0; e < 65; ++e) { const int c = e < 64 ? p.cnt()[e] : T; tpre[e] = tp; rbase[e] = rb; tp += ((c + 255) >> 8) * colt; rb += c; }
        tpre[65] = tp; rbase[65] = rb; }
    __syncthreads();
}
struct SchedUp { const MK* p; int bid, nb, tid_l, ntiles; const int* tpre; const int* rbase; mutable int e_hint;
    __device__ __forceinline__ bool next(int i, pg8::GUnit& u, unsigned (&vA)[2][2]) const {
        const int tile = bid + i * nb; if (tile >= ntiles) return false;
        int e = e_hint; while (tile >= tpre[e + 1]) ++e; e_hint = e;
        const int j = tile - tpre[e], rt = j >> 1, ct = j & 1, cnt_e = rbase[e + 1] - rbase[e];
        u.A = (const char*)p->H2(); u.B = (const char*)(p->W13t() + ((size_t)e * 512 + ct * 256) * D); u.i0 = e; u.i1 = rt; u.i2 = ct; u.i3 = cnt_e;
#pragma unroll
        for (int i2 = 0; i2 < 2; ++i2) { int R, C; stage_rc(tid_l * 16 + i2 * 8192, R, C);
#pragma unroll
            for (int h = 0; h < 2; ++h) { int slot = rt * 256 + h * 128 + R; if (slot >= cnt_e) slot = 0;
                const int tok = e < 64 ? p->tok_list()[(size_t)e * ECAP + slot] : slot;
                vA[h][i2] = (unsigned)tok * (D * 2u) + (unsigned)C * 2u; } }
        return true; } };
struct EpiUp { static constexpr bool PERM = true; const MK* p; const int* rbase;
    __device__ __forceinline__ void operator()(const f32x4 (&acc)[2][2][4][2], const pg8::GUnit& u, int wr, int wc, int fr, int fq) const {
        const int e = u.i0, rt = u.i1, ct = u.i2, cnt_e = u.i3;
        bf16_t* ab = p->ACT() + (size_t)rbase[e] * DE + ct * 128 + wc * 32 + fq * 8;
#pragma unroll
        for (int ai = 0; ai < 2; ++ai)
#pragma unroll
            for (int m = 0; m < 4; ++m) {
                const int slot = rt * 256 + ai * 128 + wr * 64 + m * 16 + fr;
                u32x4 w;
                w.x = cvtpk(siluf(acc[ai][0][m][0][0]) * acc[ai][1][m][0][0], siluf(acc[ai][0][m][0][1]) * acc[ai][1][m][0][1]);
                w.y = cvtpk(siluf(acc[ai][0][m][0][2]) * acc[ai][1][m][0][2], siluf(acc[ai][0][m][0][3]) * acc[ai][1][m][0][3]);
                w.z = cvtpk(siluf(acc[ai][0][m][1][0]) * acc[ai][1][m][1][0], siluf(acc[ai][0][m][1][1]) * acc[ai][1][m][1][1]);
                w.w = cvtpk(siluf(acc[ai][0][m][1][2]) * acc[ai][1][m][1][2], siluf(acc[ai][0][m][1][3]) * acc[ai][1][m][1][3]);
                if (slot < cnt_e) *(u32x4*)(ab + (size_t)slot * DE) = w;
            }
    } };
__device__ __forceinline__ void ph_moe_up(const MK& p, int bid, int nb, int tid_l) {
    int* tpre = (int*)(smem + MOE_AUX); int* rbase = tpre + 80;
    moe_tables(p, 2, tpre, rbase, tid_l);
    SchedUp S{&p, bid, nb, tid_l, tpre[65], tpre, rbase, 0}; EpiUp E{&p, rbase};
    pg8::gemm<EpiUp, SchedUp, true, true>(D, S, E, tid_l);
}
constexpr float Y_SCALE = 64.0f;
struct SchedDown { const MK* p; int bid, nb, tid_l, ntiles; const int* tpre; const int* rbase; mutable int e_hint;
    __device__ __forceinline__ bool next(int i, pg8::GUnit& u, unsigned (&vA)[2][2]) const {
        const int tile = bid + i * nb; if (tile >= ntiles) return false;
        int e = e_hint; while (tile >= tpre[e + 1]) ++e; e_hint = e;
        const int j = tile - tpre[e], rt = j >> 2, ct = j & 3, cnt_e = rbase[e + 1] - rbase[e];
        u.A = (const char*)(p->ACT() + (size_t)(rbase[e] + rt * 256) * DE); u.B = (const char*)(p->W2t() + ((size_t)e * D + ct * 256) * DE); u.i0 = e; u.i1 = rt; u.i2 = ct; u.i3 = cnt_e;
        pg8::plain_voffA(DE, vA, tid_l); return true; } };
template <int MODE> struct EpiDown { static constexpr bool PERM = true; const MK* p; const int* rbase;
    __device__ __forceinline__ void operator()(const f32x4 (&acc)[2][2][4][2], const pg8::GUnit& u, int wr, int wc, int fr, int fq) const {
        const int e = u.i0, rt = u.i1, ct = u.i2, cnt_e = u.i3;
        const int col0 = ct * 256 + wc * 32 + fq * 8;
        if (e < 64) {
            const float* wl = p->wt_list() + (size_t)e * ECAP;
            float wv[2][4];
#pragma unroll
            for (int ai = 0; ai < 2; ++ai)
#pragma unroll
                for (int m = 0; m < 4; ++m) { const int sl = rt * 256 + ai * 128 + wr * 64 + m * 16 + fr; wv[ai][m] = wl[sl < cnt_e ? sl : 0] * Y_SCALE; }
            const int wid = wr * 4 + wc, lane = fq * 16 + fr;
            char* wa = smem + 131072 + wid * 3968;
            unsigned char* yb = p->Y() + (size_t)rbase[e] * D + ct * 256 + wc * 64 + (lane & 3) * 16;
#pragma unroll
            for (int ai = 0; ai < 2; ++ai)
#pragma unroll
                for (int m = 0; m < 4; ++m) {
                    const float w = wv[ai][m];
                    char* img = wa + ((m & 1) ? 1280 : 0);
#pragma unroll
                    for (int bj = 0; bj < 2; ++bj) {
                        u32x2 pk;
#pragma unroll
                        for (int n = 0; n < 2; ++n) {
                            float v0 = fminf(fmaxf(acc[ai][bj][m][n][0] * w, -448.f), 448.f), v1 = fminf(fmaxf(acc[ai][bj][m][n][1] * w, -448.f), 448.f);
                            float v2 = fminf(fmaxf(acc[ai][bj][m][n][2] * w, -448.f), 448.f), v3 = fminf(fmaxf(acc[ai][bj][m][n][3] * w, -448.f), 448.f);
                            int q = 0; q = __builtin_amdgcn_cvt_pk_fp8_f32(v0, v1, q, false); q = __builtin_amdgcn_cvt_pk_fp8_f32(v2, v3, q, true);
                            if (n == 0) pk.x = (unsigned)q; else pk.y = (unsigned)q;
                        }
                        *(u32x2*)(img + fr * 80 + bj * 32 + fq * 8) = pk;
                    }
                    asm volatile("s_waitcnt lgkmcnt(0)" ::: "memory");
                    const int rr = lane >> 2, slot = rt * 256 + ai * 128 + wr * 64 + m * 16 + rr;
                    const u32x4 v = *(const u32x4*)(img + rr * 80 + (lane & 3) * 16);
                    if (MODE == 1) asm volatile("" :: "v"(v)); else if (slot < cnt_e) *(u32x4*)(yb + (size_t)slot * D) = v;
                }
        } else {
            const float* g2 = p->mod() + (size_t)((rt * 256) / SEQ) * 6 * D + 5 * D + col0;
            f32x4 gv[2][2];
#pragma unroll
            for (int bj = 0; bj < 2; ++bj)
#pragma unroll
                for (int n = 0; n < 2; ++n) gv[bj][n] = *(const f32x4*)(g2 + bj * 128 + n * 4);
            float* xb = p->out + (size_t)(rt * 256) * D + col0;
#pragma unroll
            for (int ai = 0; ai < 2; ++ai)
#pragma unroll
                for (int m = 0; m < 4; ++m) {
                    float* xp = xb + (size_t)(ai * 128 + wr * 64 + m * 16 + fr) * D;
                    f32x4 xv[2][2];
#pragma unroll
                    for (int bj = 0; bj < 2; ++bj)
#pragma unroll
                        for (int n = 0; n < 2; ++n) xv[bj][n] = *(const f32x4*)(xp + bj * 128 + n * 4);
#pragma unroll
                    for (int bj = 0; bj < 2; ++bj)
#pragma unroll
                        for (int n = 0; n < 2; ++n) *(f32x4*)(xp + bj * 128 + n * 4) = xv[bj][n] + gv[bj][n] * acc[ai][bj][m][n];
                    if (m & 1) asm volatile("" ::: "memory");
                }
        }
    } };
template <bool DUMMY, int MODE = 0> __device__ __forceinline__ void ph_moe_down(const MK& p, int bid, int nb, int tid_l) {
    int* tpre = (int*)(smem + MOE_AUX); int* rbase = tpre + 80;
    moe_tables(p, 4, tpre, rbase, tid_l);
    SchedDown S{&p, bid, nb, tid_l, DUMMY ? tpre[64] : tpre[65], tpre, rbase, 0}; EpiDown<MODE> E{&p, rbase};
    pg8::gemm<EpiDown<MODE>, SchedDown, false, true>(DE, S, E, tid_l);
}

template <bool DUMMY> __device__ __forceinline__ void ph_final(const MK& p, int bid, int nb, int tid_l) {
    const int wid = tid_l >> 6, lane = tid_l & 63;
    int* tpre = (int*)(smem + MOE_AUX); int* rbase = tpre + 80;
    moe_tables(p, 1, tpre, rbase, tid_l);
    for (int t = bid * 8 + wid; t < T; t += nb * 8) {
        const int b = t / SEQ;
        float f[16];
#pragma unroll
        for (int i = 0; i < 16; ++i) f[i] = 0.f;
#pragma unroll
        for (int k = 0; k < 8; ++k) {
            const int id = p.tokmap()[(size_t)t * 8 + k], e = id >> 15, slot = id & (ECAP - 1);
            const unsigned char* yr = p.Y() + (size_t)(rbase[e] + slot) * D + lane * 4;
#pragma unroll
            for (int q = 0; q < 4; ++q) {
                const int w = *(const int*)(yr + q * 256);
                const auto lo = __builtin_amdgcn_cvt_pk_f32_fp8(w, false); const auto hi = __builtin_amdgcn_cvt_pk_f32_fp8(w, true);
                f[q * 4 + 0] += lo[0]; f[q * 4 + 1] += lo[1]; f[q * 4 + 2] += hi[0]; f[q * 4 + 3] += hi[1];
            }
        }
        const int pcol = ((lane >> 3) & 1) * 128 + (lane >> 4) * 32 + (lane & 7) * 4;
        const float* g2 = p.mod() + (size_t)b * 6 * D + 5 * D + pcol;
        float* xo = p.out + (size_t)t * D + pcol;
        float v[16]; float ss = 0.f;
#pragma unroll
        for (int q = 0; q < 4; ++q) {
            const float4 xv = *(const float4*)(xo + q * 256), g = *(const float4*)(g2 + q * 256);
            v[q * 4 + 0] = xv.x + g.x * f[q * 4 + 0] * (1.0f / Y_SCALE); v[q * 4 + 1] = xv.y + g.y * f[q * 4 + 1] * (1.0f / Y_SCALE);
            v[q * 4 + 2] = xv.z + g.z * f[q * 4 + 2] * (1.0f / Y_SCALE); v[q * 4 + 3] = xv.w + g.w * f[q * 4 + 3] * (1.0f / Y_SCALE);
            ss += v[q * 4] * v[q * 4] + v[q * 4 + 1] * v[q * 4 + 1] + v[q * 4 + 2] * v[q * 4 + 2] + v[q * 4 + 3] * v[q * 4 + 3];
        }
        ss = wave_sum(ss);
        const float rstd = rsqrtf(ss * (1.0f / D) + EPS);
#pragma unroll
        for (int q = 0; q < 4; ++q) {
            const float4 gf = *(const float4*)(p.final_g + q * 256 + pcol);
            *(float4*)((DUMMY ? (float*)(p.ws + 42 * MiB) + (size_t)t * D + pcol : xo) + q * 256) = make_float4(v[q * 4] * rstd * gf.x, v[q * 4 + 1] * rstd * gf.y, v[q * 4 + 2] * rstd * gf.z, v[q * 4 + 3] * rstd * gf.w);
        }
    }
}


#define XB_TMO      128
#define XB_XCNT(j)  (256  + 64 * (j))
#define XB_XSUB(j)  (1280 + 64 * (j))
#define XB_XGEN(j)  (2304 + 64 * (j))
#define XB_TOP      3328
#define XB_TOPGEN   3392
#define XCD_BAR_WORDS 3456
#define XB_SPIN_CAP (1u << 22)
#define LAS __attribute__((address_space(3)))
__device__ __forceinline__ unsigned xb_ld(unsigned* p)              { return __hip_atomic_load(p, __ATOMIC_RELAXED, __HIP_MEMORY_SCOPE_AGENT); }
__device__ __forceinline__ unsigned xb_add(unsigned* p, unsigned v) { return __hip_atomic_fetch_add(p, v, __ATOMIC_RELAXED, __HIP_MEMORY_SCOPE_AGENT); }
__device__ __forceinline__ unsigned xb_xcc_id() { return (unsigned)__builtin_amdgcn_s_getreg((3 << 11) | 20) & 0xFu; }
#define XB_SPIN(cond, bar) do { unsigned _sp = 0; while (cond) { __builtin_amdgcn_s_sleep(1); \
    if ((++_sp & 255u) == 0u) { if (xb_ld(&(bar)[XB_TMO])) break; if (_sp > XB_SPIN_CAP) { atomicAdd(&(bar)[XB_TMO], 1u); break; } } } } while (0)
struct XcdBarrier { unsigned* bar; unsigned x; volatile LAS unsigned* st; };
__device__ __forceinline__ XcdBarrier xcd_barrier_post(unsigned* bar, volatile LAS unsigned* st, int tid) {
    XcdBarrier b; b.bar = bar; b.x = xb_xcc_id(); b.st = st;
    if (tid == 0) (void)xb_add(&bar[XB_XCNT(b.x)], 1u);
    return b;
}
__device__ __forceinline__ void xcd_barrier_complete(unsigned* bar, unsigned x, unsigned& nloc, unsigned& nx) {
    const unsigned G = gridDim.x * gridDim.y * gridDim.z;
    unsigned sum, cnt, mine, sp = 0u;
    for (;;) {
        sum = 0u; cnt = 0u; mine = 0u;
#pragma unroll
        for (unsigned j = 0; j < 16; ++j) { const unsigned c = xb_ld(&bar[XB_XCNT(j)]); sum += c; cnt += (c > 0u) ? 1u : 0u; mine = (j == x) ? c : mine; }
        if (sum == G) break;
        __builtin_amdgcn_s_sleep(1);
        if ((++sp & 255u) == 0u) { if (xb_ld(&bar[XB_TMO])) break; if (sp > XB_SPIN_CAP) { atomicAdd(&bar[XB_TMO], 1u); break; } }
    }
    nloc = mine > 0u ? mine : 1u; nx = cnt > 0u ? cnt : 1u;
}
__device__ __forceinline__ void xcd_barrier(const XcdBarrier& b, int tid) {
    asm volatile("s_waitcnt vmcnt(0)" ::: "memory");
    __syncthreads();
    if (tid == 0) {
        unsigned* bar = b.bar;
        __builtin_amdgcn_s_waitcnt(0);
        unsigned nloc = b.st[0], nx = b.st[1];
        if (nloc == 0u) { xcd_barrier_complete(bar, b.x, nloc, nx); b.st[0] = nloc; b.st[1] = nx; }
        const unsigned old = xb_add(&bar[XB_XSUB(b.x)], 1u);
        const unsigned gen = old / nloc;
        if (old + 1u == (gen + 1u) * nloc) {
            __builtin_amdgcn_fence(__ATOMIC_RELEASE, "agent");
            asm volatile("s_waitcnt vmcnt(0)" ::: "memory");
            const unsigned og = xb_add(&bar[XB_TOP], 1u);
            const unsigned tg = og / nx;
            if (og + 1u == (tg + 1u) * nx) xb_add(&bar[XB_TOPGEN], 1u);
            else XB_SPIN(xb_ld(&bar[XB_TOPGEN]) == tg, bar);
            __builtin_amdgcn_fence(__ATOMIC_ACQUIRE, "agent");
            xb_add(&bar[XB_XGEN(b.x)], 1u);
            asm volatile("s_waitcnt vmcnt(0)" ::: "memory");
        } else {
            XB_SPIN(xb_ld(&bar[XB_XGEN(b.x)]) == gen, bar);
            __builtin_amdgcn_fence(__ATOMIC_ACQUIRE, "agent");
            asm volatile("s_waitcnt vmcnt(0)" ::: "memory");
        }
    }
    __syncthreads();
}

__device__ __forceinline__ int lane_id_volatile() { int l; asm volatile("v_mbcnt_lo_u32_b32 %0, -1, 0\n\tv_mbcnt_hi_u32_b32 %0, -1, %0" : "=v"(l)); return l; }
__global__ __launch_bounds__(512, 2) void k_mega(MK p) {
    cg::grid_group grid = cg::this_grid();
    const int bid = blockIdx.x, nb = gridDim.x;
    volatile LAS unsigned* xst = (volatile LAS unsigned*)(smem + 162816 + 768);
    if (threadIdx.x < 4) xst[threadIdx.x] = 0u;
    __syncthreads();
    const XcdBarrier xb = xcd_barrier_post((unsigned*)(p.ws + 524288), xst, (int)threadIdx.x);
    const int wv_ = __builtin_amdgcn_readfirstlane((int)threadIdx.x >> 6);
#define LANE_ID() lane_id_volatile()
#define PH_TID() int t_ = wv_ * 64 + LANE_ID(); asm volatile("" : "+v"(t_))
    { PH_TID(); if (bid == 0 && t_ < 256) p.cnt()[t_] = 0; ph_mod(p, bid, nb, t_); ph_convert(p, bid, nb, t_); }
#if DUP == 10
    { PH_TID(); ph_convert(p, bid, nb, t_); }
#endif
    grid.sync();
    { PH_TID(); ph_ln1(p, bid, nb, t_); }
#if DUP == 1
    { PH_TID(); ph_ln1(p, bid, nb, t_); }
#endif
    xcd_barrier(xb, wv_ * 64 + LANE_ID());
    { PH_TID(); ph_gemm_in(p, bid, nb, t_); }
    { PH_TID(); ph_convert_dyn(p, t_); }
#if DUP == 2
    { PH_TID(); ph_gemm_in(p, bid, nb, t_); }
#endif
    xcd_barrier(xb, wv_ * 64 + LANE_ID());
    { PH_TID(); ph_attn<0>(p, bid, nb, t_); }
#if DUP == 3
    { PH_TID(); ph_attn<2>(p, bid, nb, t_); }
#endif
#if DUP == 31
    { PH_TID(); ph_attn<1>(p, bid, nb, t_); }
#endif
#if DUP == 33
    { PH_TID(); ph_attn<3>(p, bid, nb, t_); }
#endif
    { PH_TID(); ph_kv(p, bid, nb, t_); }
#if DUP == 11
    { PH_TID(); ph_kv(p, bid, nb, t_); }
#endif
    xcd_barrier(xb, wv_ * 64 + LANE_ID());
    { PH_TID(); ph_scan(p, bid, nb, t_); }
    xcd_barrier(xb, wv_ * 64 + LANE_ID());
    { PH_TID(); ph_ret(p, bid, nb, t_); }
#if DUP == 5
    { PH_TID(); ph_ret(p, bid, nb, t_); }
#endif
    xcd_barrier(xb, wv_ * 64 + LANE_ID());
    { PH_TID(); ph_gemm_out(p, bid, nb, t_); }
#if DUP == 6
    { PH_TID(); ph_gemm_out(p, bid, nb, t_); }
#endif
    xcd_barrier(xb, wv_ * 64 + LANE_ID());
#if DUP == 7
    { PH_TID(); ph_route<true>(p, bid, nb, t_); }
#endif
#if DUP == 72
    { PH_TID(); ph_route<true, 2>(p, bid, nb, t_); }
#endif
#if DUP == 73
    { PH_TID(); ph_route<true, 3>(p, bid, nb, t_); }
#endif
    { PH_TID(); ph_route<false>(p, bid, nb, t_); }
    xcd_barrier(xb, wv_ * 64 + LANE_ID());
    { PH_TID(); ph_moe_up(p, bid, nb, t_); }
#if DUP == 8
    { PH_TID(); ph_moe_up(p, bid, nb, t_); }
#endif
    xcd_barrier(xb, wv_ * 64 + LANE_ID());
#if DUP == 9
    { PH_TID(); ph_moe_down<true>(p, bid, nb, t_); }
#endif
#if DUP == 91
    { PH_TID(); ph_moe_down<true, 1>(p, bid, nb, t_); }
#endif
    { PH_TID(); ph_moe_down<false>(p, bid, nb, t_); }
    xcd_barrier(xb, wv_ * 64 + LANE_ID());
#if DUP == 13
    { PH_TID(); ph_final<true>(p, bid, nb, t_); }
#endif
    { PH_TID(); ph_final<false>(p, bid, nb, t_); }
#undef PH_TID
#undef LANE_ID
}
constexpr int LDS_TOTAL = 163840;
extern "C" void kernel_launch(void* const* d_in, const int* in_sizes, int n_in, void* d_out, int out_size, void* d_ws, size_t ws_size, hipStream_t stream) {
    char* ws = (char*)d_ws;
    MK mk{};
    mk.x = (const float*)d_in[0]; mk.c = (const float*)d_in[1]; mk.ctx = (const float*)d_in[2]; mk.cctx = (const float*)d_in[3]; mk.ada_w = (const float*)d_in[4]; mk.ada_b = (const float*)d_in[5];
    mk.norm1_g = (const float*)d_in[6]; mk.w_in = (const float*)d_in[7]; mk.lq1 = (const float*)d_in[8]; mk.lk1 = (const float*)d_in[9]; mk.lq2 = (const float*)d_in[10]; mk.lk2 = (const float*)d_in[11];
    mk.dattn_g = (const float*)d_in[12]; mk.dec_f = (const float*)d_in[13]; mk.dec_b = (const float*)d_in[14]; mk.ret_g = (const float*)d_in[15]; mk.w_out = (const float*)d_in[16];
    mk.norm2_g = (const float*)d_in[17]; mk.router_w = (const float*)d_in[18]; mk.router_b = (const float*)d_in[19]; mk.ew1 = (const float*)d_in[20]; mk.ew3 = (const float*)d_in[21];
    mk.ew2 = (const float*)d_in[22]; mk.sw1 = (const float*)d_in[23]; mk.sw3 = (const float*)d_in[24]; mk.sw2 = (const float*)d_in[25]; mk.final_g = (const float*)d_in[26];
    mk.out = (float*)d_out;
    mk.ws = ws;
    mk.dbgP = nullptr; mk.dbg_lo = 0; mk.dbg_hi = 12; mk.conv_limit = 1 << 30;
    static int grid_blocks = 0;
    if (!grid_blocks) {
        (void)hipFuncSetAttribute((const void*)k_mega, hipFuncAttributeMaxDynamicSharedMemorySize, LDS_TOTAL);
        int dev = 0, cus = 0, per_cu = 0;
        (void)hipGetDevice(&dev);
        (void)hipDeviceGetAttribute(&cus, hipDeviceAttributeMultiprocessorCount, dev);
        (void)hipOccupancyMaxActiveBlocksPerMultiprocessor(&per_cu, k_mega, 512, LDS_TOTAL);
        if (per_cu > 1) per_cu = 1;
        grid_blocks = cus * per_cu;
        if (grid_blocks <= 0) { fprintf(stderr, "occupancy query failed: cus %d per_cu %d\n", cus, per_cu); grid_blocks = 256; }
    }
    (void)hipMemsetAsync(ws + 524288, 0, XCD_BAR_WORDS * 4, stream);
    void* args[] = {&mk};
    hipError_t e = hipLaunchCooperativeKernel((void*)k_mega, dim3(grid_blocks), dim3(512), args, LDS_TOTAL, stream);
    if (e != hipSuccess) fprintf(stderr, "cooperative launch failed: %s (grid %d)\n", hipGetErrorString(e), grid_blocks);
}
```

```cpp
#include <hip/hip_runtime.h>
#include <hip/hip_cooperative_groups.h>
#include <cstdio>
namespace cg = cooperative_groups;
#ifndef DUP
#define DUP 0
#endif
#include <stdint.h>

constexpr int D = 1024, NB = 4, SEQ = 8192, CTX = 256, RB = SEQ + CTX  , NR = NB * RB  , T = NB * SEQ;
constexpr int NE = 64, DE = 256, ECAP = 32768;
constexpr float EPS = 1e-6f;
typedef unsigned short bf16_t;

__device__ __forceinline__ float siluf(float v) { return v / (1.0f + expf(-v)); }
__device__ __forceinline__ float wave_sum(float v) {
#pragma unroll
    for (int o = 32; o > 0; o >>= 1) v += __shfl_xor(v, o);
    return v;
}
__device__ __forceinline__ float wave_max(float v) {
#pragma unroll
    for (int o = 32; o > 0; o >>= 1) v = fmaxf(v, __shfl_xor(v, o));
    return v;
}
__device__ __forceinline__ float block_sum(float v, float* red) {
    v = wave_sum(v);
    __syncthreads();
    if ((threadIdx.x & 63) == 0) red[threadIdx.x >> 6] = v;
    __syncthreads();
    return red[0] + red[1] + red[2] + red[3];
}
__device__ __forceinline__ float block_max(float v, float* red) {
    v = wave_max(v);
    __syncthreads();
    if ((threadIdx.x & 63) == 0) red[threadIdx.x >> 6] = v;
    __syncthreads();
    return fmaxf(fmaxf(red[0], red[1]), fmaxf(red[2], red[3]));
}

typedef short bf16x8 __attribute__((ext_vector_type(8)));
typedef short s16x4 __attribute__((ext_vector_type(4)));
typedef float f32x4 __attribute__((ext_vector_type(4)));
typedef float f32x16 __attribute__((ext_vector_type(16)));
typedef unsigned u32x2 __attribute__((ext_vector_type(2)));
typedef unsigned u32x4 __attribute__((ext_vector_type(4)));
extern __shared__ __attribute__((aligned(1024))) char smem[];
constexpr int NTHR = 512;
constexpr int GEMM_LDS = 131072;

__device__ __forceinline__ unsigned cvtpk(float lo, float hi) { unsigned r; asm volatile("v_cvt_pk_bf16_f32 %0, %1, %2" : "=v"(r) : "v"(lo), "v"(hi)); return r; }
__device__ __forceinline__ bf16_t f2bf(float v) { return (bf16_t)(cvtpk(v, v) & 0xffffu); }
__device__ __forceinline__ float bf2f(bf16_t v) { return __uint_as_float(((unsigned)v) << 16); }

constexpr size_t MiB = 1048576;
struct MK {
    const float *x, *c, *ctx, *cctx, *ada_w, *ada_b, *norm1_g, *w_in, *lq1, *lk1, *lq2, *lk2, *dattn_g, *dec_f, *dec_b, *ret_g, *w_out, *norm2_g, *router_w, *router_b,
        *ew1, *ew3, *ew2, *sw1, *sw3, *sw2, *final_g;
    float* out; char* ws;
    float* dbgP; long dbg_lo, dbg_hi; long conv_limit;
#define WSF(name, type, off) __device__ __forceinline__ type* name() const { return (type*)(ws + (off)); }
    WSF(mod, float, 0) WSF(cnt, int, 131072) WSF(ropec, float, 262144) WSF(ropes, float, 262144 + 8192)
    WSF(w_inT, bf16_t, 1 * MiB) WSF(w_outT, bf16_t, 7 * MiB) WSF(routerT, bf16_t, 9 * MiB) WSF(W2t, bf16_t, 9 * MiB + 524288)
    WSF(H, bf16_t, 42 * MiB) WSF(MIX, bf16_t, 42 * MiB) WSF(KV, bf16_t, 112 * MiB) WSF(ST, bf16_t, 147 * MiB) WSF(ACT, bf16_t, 42 * MiB)
    WSF(W13t, bf16_t, 194 * MiB) WSF(H2, bf16_t, 260 * MiB)
    WSF(Q, bf16_t, 260 * MiB) WSF(K, bf16_t, 292 * MiB) WSF(V, bf16_t, 325 * MiB) WSF(RQ, bf16_t, 358 * MiB) WSF(RK, bf16_t, 375 * MiB)
    WSF(KTf, bf16_t, 392 * MiB) WSF(KTb, bf16_t, 409 * MiB) WSF(VT, bf16_t, 426 * MiB) WSF(RG, bf16_t, 459 * MiB)
    WSF(Y, unsigned char, 194 * MiB) WSF(tok_list, int, 452 * MiB) WSF(wt_list, float, 460 * MiB) WSF(tokmap, int, 468 * MiB)
#undef WSF
};

__device__ __forceinline__ void ph_mod(const MK& p, int bid, int nb, int tid_l) {
    float* red = (float*)smem;
    for (int it = bid; it < 6 * D / 32; it += nb) {
        const int col = tid_l & 31, kg = tid_l >> 5, j = it * 32 + col;
        float a[5] = {0, 0, 0, 0, 0};
        for (int k = kg * 64; k < kg * 64 + 64; ++k) {
            float w = p.ada_w[(size_t)k * 6 * D + j];
#pragma unroll
            for (int r = 0; r < 5; ++r) { float cv = r < 4 ? p.c[r * D + k] : p.cctx[k]; a[r] += siluf(cv) * w; }
        }
        __syncthreads();
#pragma unroll
        for (int r = 0; r < 5; ++r) red[(kg * 5 + r) * 32 + col] = a[r];
        __syncthreads();
        if (tid_l < 160) {
            int r = tid_l >> 5; float s = 0;
            for (int g = 0; g < 16; ++g) s += red[(g * 5 + r) * 32 + col];
            p.mod()[(size_t)r * 6 * D + j] = s + p.ada_b[j];
        }
    }
    if (bid == nb - 1) {
        for (int i = tid_l; i < 128 * 16; i += NTHR) {
            int pos = i >> 4, f = i & 15;
            float inv_freq = (float)pow(10000.0, -(double)f / 16.0);
            float s, c; sincosf((float)pos * inv_freq, &s, &c);
            p.ropec()[i] = c; p.ropes()[i] = s;
        }
    }
    __syncthreads();
}

__device__ __forceinline__ void tr_tile(const float* src, int ldsrc, int k0, int n0, bf16_t* dst, int lddst, int mode  , bf16_t* dst2, int tid_l) {
    float* t = (float*)smem;
    __syncthreads();
    for (int i = tid_l; i < 64 * 16; i += NTHR) {
        int r = i >> 4, c4 = (i & 15) * 4;
        float4 v = *(const float4*)(src + (size_t)(k0 + r) * ldsrc + n0 + c4);
        t[r * 65 + c4] = v.x; t[r * 65 + c4 + 1] = v.y; t[r * 65 + c4 + 2] = v.z; t[r * 65 + c4 + 3] = v.w;
    }
    __syncthreads();
    for (int i = tid_l; i < 64 * 16; i += NTHR) {
        int n = i >> 4, k4 = (i & 15) * 4;
        float a = t[(k4 + 0) * 65 + n], b = t[(k4 + 1) * 65 + n], c = t[(k4 + 2) * 65 + n], d = t[(k4 + 3) * 65 + n];
        int nn = n0 + n, row = nn;
        if (mode == 1 || mode == 2) { int ct = nn >> 7; row = ct * 256 + (mode == 2 ? 128 : 0) + (nn & 127); }
        u32x2 w; w.x = cvtpk(a, b); w.y = cvtpk(c, d);
        *(u32x2*)(dst + (size_t)row * lddst + k0 + k4) = w;
        if (mode == 3) {
            float ah = bf2f((bf16_t)(w.x & 0xffff)), bh = bf2f((bf16_t)(w.x >> 16)), ch = bf2f((bf16_t)(w.y & 0xffff)), dh = bf2f((bf16_t)(w.y >> 16));
            u32x2 l; l.x = cvtpk(a - ah, b - bh); l.y = cvtpk(c - ch, d - dh);
            *(u32x2*)(dst2 + (size_t)row * lddst + k0 + k4) = l;
        }
    }
}
constexpr int CV_STATIC = 16 * 48 + 16 * 16 + 16, CV_E13 = 65 * 2 * 16 * 4, CV_E2 = 65 * 4 * 16, CV_TOTAL = CV_STATIC + CV_E13 + CV_E2;
__device__ __forceinline__ void convert_tile(const MK& p, int j, int tid_l) {
    const int n_win = 16 * 48, n_wout = 16 * 16, n_rt = 16;
    if (j < n_win) { tr_tile(p.w_in, 3072, (j / 48) * 64, (j % 48) * 64, p.w_inT(), 1024, 0, nullptr, tid_l); return; } j -= n_win;
    if (j < n_wout) { tr_tile(p.w_out, 1024, (j / 16) * 64, (j % 16) * 64, p.w_outT(), 1024, 0, nullptr, tid_l); return; } j -= n_wout;
    if (j < n_rt) { tr_tile(p.router_w, 64, j * 64, 0, p.routerT(), 1024, 3, p.routerT() + 64 * 1024, tid_l); return; } j -= n_rt;
    if (j < CV_E13) {
        int e = j / 128, r = j % 128, which = r / 64, tt = r % 64;
        const float* src = e < 64 ? (which ? p.ew3 : p.ew1) + (size_t)e * D * DE : (which ? p.sw3 : p.sw1);
        tr_tile(src, DE, (tt / 4) * 64, (tt % 4) * 64, p.W13t() + (size_t)e * 512 * 1024, 1024, 1 + which, nullptr, tid_l); return; } j -= CV_E13;
    { int e = j / 64, tt = j % 64;
      const float* src = e < 64 ? p.ew2 + (size_t)e * DE * D : p.sw2;
      tr_tile(src, D, (tt / 16) * 64, (tt % 16) * 64, p.W2t() + (size_t)e * 1024 * 256, 256, 0, nullptr, tid_l); }
}
__device__ __forceinline__ void ph_convert(const MK& p, int bid, int nb, int tid_l) {
    for (int it = bid; it < CV_STATIC; it += nb) convert_tile(p, it, tid_l);
    __syncthreads();
}
__device__ __forceinline__ void ph_convert_dyn(const MK& p, int tid_l) {
    int* q = (int*)smem + 8192;
    for (;;) {
        __syncthreads();
        if (tid_l == 0) q[0] = atomicAdd(&p.cnt()[200], 8);
        __syncthreads();
        const int base = q[0];
        if (base >= CV_E13 + CV_E2) break;
        for (int k = 0; k < 8; ++k) if (base + k < CV_E13 + CV_E2) convert_tile(p, CV_STATIC + base + k, tid_l);
    }
    __syncthreads();
}

__device__ __forceinline__ void ph_ln1(const MK& p, int bid, int nb, int tid_l) {
    const int wid = tid_l >> 6, lane = tid_l & 63;
    for (int R = bid * 8 + wid; R < NR; R += nb * 8) {
        int b = R / RB, i = R % RB;
        const float* src = i < CTX ? p.ctx + ((size_t)b * CTX + i) * D : p.x + ((size_t)b * SEQ + (i - CTX)) * D;
        const float* m = p.mod() + (size_t)(i < CTX ? 4 : b) * 6 * D;
        float4 v[4]; float ss = 0;
#pragma unroll
        for (int q = 0; q < 4; ++q) { v[q] = *(const float4*)(src + q * 256 + lane * 4); ss += v[q].x * v[q].x + v[q].y * v[q].y + v[q].z * v[q].z + v[q].w * v[q].w; }
        ss = wave_sum(ss);
        float rstd = rsqrtf(ss * (1.0f / D) + EPS);
#pragma unroll
        for (int q = 0; q < 4; ++q) {
            int c0 = q * 256 + lane * 4;
            float4 gg = *(const float4*)(p.norm1_g + c0), sh = *(const float4*)(m + c0), sc = *(const float4*)(m + D + c0);
            float o0 = v[q].x * rstd * gg.x * (1 + sc.x) + sh.x, o1 = v[q].y * rstd * gg.y * (1 + sc.y) + sh.y;
            float o2 = v[q].z * rstd * gg.z * (1 + sc.z) + sh.z, o3 = v[q].w * rstd * gg.w * (1 + sc.w) + sh.w;
            u32x2 w; w.x = cvtpk(o0, o1); w.y = cvtpk(o2, o3);
            *(u32x2*)(p.H() + (size_t)R * D + c0) = w;
        }
    }
}

__device__ __forceinline__ int lds_byte(int r, int c) { int st = (r >> 4) * 2 + (c >> 5), ob = (r & 15) * 64 + (c & 31) * 2; return st * 1024 + (ob ^ (((ob >> 9) & 1) << 5)); }
__device__ __forceinline__ void stage_rc(int b, int& R, int& C) { int st = b >> 10, sb = b & 1023, swz = sb ^ (((sb >> 9) & 1) << 5); R = (st / 2) * 16 + swz / 64; C = (st % 2) * 32 + (swz % 64) / 2; }
#define WAIT_V0() asm volatile("s_waitcnt vmcnt(0)" ::: "memory")
__device__ __forceinline__ void gemm_core(const char* Abase, const unsigned (&Ao)[4], const char* Bbase, const unsigned (&Bo)[4], int nt, f32x4 (&acc)[8][4], int tid_l, bool pre) {
    const int tid = tid_l, wid = tid >> 6, lane = tid & 63, wr = wid >> 2, wc = wid & 3, fr = lane & 15, fq = lane >> 4;
#pragma unroll
    for (int m = 0; m < 8; ++m)
#pragma unroll
        for (int n = 0; n < 4; ++n) acc[m][n] = (f32x4){0.f, 0.f, 0.f, 0.f};
#define G_SA(b) (smem + (b) * 32768)
#define G_SB(b) (smem + 65536 + (b) * 32768)
#define G_STAGE(buf, kt) do { _Pragma("unroll") for (int i = 0; i < 4; ++i) {                                                     \
        __builtin_amdgcn_global_load_lds((const unsigned*)(Abase + (Ao[i] + (unsigned)(kt) * 128u)), (unsigned*)(G_SA(buf) + wid * 1024 + i * 8192), 16, 0, 0); \
        __builtin_amdgcn_global_load_lds((const unsigned*)(Bbase + (Bo[i] + (unsigned)(kt) * 128u)), (unsigned*)(G_SB(buf) + wid * 1024 + i * 8192), 16, 0, 0); } } while (0)
    if (!pre) G_STAGE(0, 0);
    WAIT_V0(); __syncthreads();
#define G_KSTEP(cur, t) do {                                                                                                   \
        if ((t) + 1 < nt) G_STAGE((cur) ^ 1, (t) + 1);                                                                          \
        _Pragma("unroll") for (int ks = 0; ks < 2; ++ks) {                                                                      \
            bf16x8 At[8], Bf[4];                                                                                                \
            _Pragma("unroll") for (int m = 0; m < 8; ++m) At[m] = *(const bf16x8*)(G_SA(cur) + lds_byte(wr * 128 + m * 16 + fr, ks * 32 + fq * 8)); \
            _Pragma("unroll") for (int n = 0; n < 4; ++n) Bf[n] = *(const bf16x8*)(G_SB(cur) + lds_byte(wc * 64 + n * 16 + fr, ks * 32 + fq * 8));  \
            _Pragma("unroll") for (int m = 0; m < 8; ++m) _Pragma("unroll") for (int n = 0; n < 4; ++n)                         \
                acc[m][n] = __builtin_amdgcn_mfma_f32_16x16x32_bf16(Bf[n], At[m], acc[m][n], 0, 0, 0);                          \
            __builtin_amdgcn_sched_barrier(0);                                                                                  \
        }                                                                                                                       \
        WAIT_V0(); __syncthreads(); } while (0)
#pragma unroll 1
    for (int t = 0; t < nt; ++t) { const int cur = t & 1; G_KSTEP(cur, t); }
}
#ifndef XPREFETCH
#define XPREFETCH 0
#endif
__device__ __forceinline__ void gemm_prefetch(const char* Abase, const unsigned (&Ao)[4], const char* Bbase, const unsigned (&Bo)[4], int tid_l) {
    const int wid = tid_l >> 6;
    G_STAGE(0, 0);
}
__device__ __forceinline__ void stage_offs(unsigned ld_bytes, unsigned (&P)[4], int tid_l) {
    const int wid = tid_l >> 6, lane = tid_l & 63;
#pragma unroll
    for (int i = 0; i < 4; ++i) { int R, C; stage_rc(wid * 1024 + i * 8192 + lane * 16, R, C); P[i] = (unsigned)R * ld_bytes + (unsigned)C * 2u; }
}

constexpr int WAREA = 18432;
__device__ __forceinline__ char* wave_area(int wid) { return smem + wid * WAREA; }

constexpr int A_KVBLK = 64;
constexpr float A_SCALE = 0.125f, A_THR = 8.f;
constexpr int A_SHM_V = A_KVBLK * 128 * 2, A_SHM_K = A_KVBLK * 128 * 2;
#define KSWZ(row, colB) ((row) * 256 + ((colB) ^ (((row) & 7) << 4)))
#define SBAR() __builtin_amdgcn_sched_barrier(0)
__device__ __forceinline__ int crow(int r, int hi) { return (r & 3) + 8 * (r >> 2) + 4 * hi; }

constexpr float A_THRL = 11.0f;
template <bool FIRST> __device__ __forceinline__ void partialSM2(f32x16& p0, f32x16& p1, float& mhat, f32x16& negm, float& alpha) {
    float pmax = p0[0];
#pragma unroll
    for (int r = 1; r < 16; ++r) pmax = fmaxf(pmax, p0[r]);
#pragma unroll
    for (int r = 0; r < 16; ++r) pmax = fmaxf(pmax, p1[r]);
    { auto rr = __builtin_amdgcn_permlane32_swap(__float_as_uint(pmax), __float_as_uint(pmax), false, false);
      pmax = fmaxf(__uint_as_float(rr[0]), __uint_as_float(rr[1])); }
    alpha = 1.f;
    if (FIRST || __builtin_expect(__any(pmax > A_THRL), 0)) {
        const float dl = FIRST ? pmax : fmaxf(pmax, 0.f);
        mhat += dl;
#pragma unroll
        for (int r = 0; r < 16; ++r) { p0[r] -= dl; p1[r] -= dl; }
#pragma unroll
        for (int r = 0; r < 16; ++r) negm[r] = -mhat;
        if (!FIRST) alpha = __builtin_amdgcn_exp2f(-dl);
    }
#pragma unroll
    for (int r = 0; r < 16; ++r) p0[r] = __builtin_amdgcn_exp2f(p0[r]);
}
__device__ __forceinline__ void qkt2(f32x16& p0, f32x16& p1, const char* Ks, const bf16x8* qr, const f32x16& negm, int r32, int hi, int mapc) {
#pragma unroll
    for (int d0 = 0; d0 < 4; ++d0) { int cb = (mapc + d0 * 16 + hi * 8) * 2;
        bf16x8 b0 = *reinterpret_cast<const bf16x8*>(Ks + KSWZ(r32, cb));
        bf16x8 b1 = *reinterpret_cast<const bf16x8*>(Ks + KSWZ(32 + r32, cb));
        if (d0 == 0) { p0 = __builtin_amdgcn_mfma_f32_32x32x16_bf16(b0, qr[0], negm, 0, 0, 0); p1 = __builtin_amdgcn_mfma_f32_32x32x16_bf16(b1, qr[0], negm, 0, 0, 0); }
        else { p0 = __builtin_amdgcn_mfma_f32_32x32x16_bf16(b0, qr[d0], p0, 0, 0, 0); p1 = __builtin_amdgcn_mfma_f32_32x32x16_bf16(b1, qr[d0], p1, 0, 0, 0); } }
}
template <int PROBE = 0> __device__ __forceinline__ void partialSM(f32x16& p0, f32x16& p1, float& m_reg, float& mn, float& alpha) {
    constexpr float C = A_SCALE * 1.4426950408889634f;
    float pmax = p0[0];
#pragma unroll
    for (int r = 1; r < 16; ++r) pmax = fmaxf(pmax, p0[r]);
#pragma unroll
    for (int r = 0; r < 16; ++r) pmax = fmaxf(pmax, p1[r]);
    { auto rr = __builtin_amdgcn_permlane32_swap(__float_as_uint(pmax), __float_as_uint(pmax), false, false);
      pmax = fmaxf(__uint_as_float(rr[0]), __uint_as_float(rr[1])); }
    if (__builtin_expect(__all(pmax - m_reg <= A_THR / A_SCALE), 1)) { mn = m_reg; alpha = 1.f; }
    else { mn = fmaxf(m_reg, pmax); alpha = __builtin_amdgcn_exp2f((m_reg - mn) * C); m_reg = mn; }
    float mnC = -mn * C;
#pragma unroll
    for (int r = 0; r < 16; ++r) p0[r] = fmaf(p0[r], C, mnC);
#pragma unroll
    for (int r = 0; r < 16; ++r) p1[r] = fmaf(p1[r], C, mnC);
#pragma unroll
    for (int r = 0; r < 16; ++r) p0[r] = PROBE == 3 ? p0[r] * 1e-3f : __builtin_amdgcn_exp2f(p0[r]);
}
#define PK4(P, BASE, OUT) do { unsigned a0 = cvtpk(P[BASE + 0], P[BASE + 1]), a1 = cvtpk(P[BASE + 2], P[BASE + 3]);   \
    unsigned b0 = cvtpk(P[BASE + 4], P[BASE + 5]), b1 = cvtpk(P[BASE + 6], P[BASE + 7]);                              \
    auto r0 = __builtin_amdgcn_permlane32_swap(a0, b0, false, false); auto r1 = __builtin_amdgcn_permlane32_swap(a1, b1, false, false); \
    u32x4 w = {r0[0], r1[0], r0[1], r1[1]}; OUT = *reinterpret_cast<bf16x8*>(&w); } while (0)
template <int PROBE = 0, bool DIRECT = false> __device__ __forceinline__ void finishSM(f32x16& p0, f32x16& p1, float alpha, float& l_reg, bf16x8& pa0, bf16x8& pa1, bf16x8& pa2, bf16x8& pa3) {
#pragma unroll
    for (int r = 0; r < 16; ++r) p1[r] = PROBE == 3 ? p1[r] * 1e-3f : __builtin_amdgcn_exp2f(p1[r]);
    float ps = 0;
#pragma unroll
    for (int r = 0; r < 16; ++r) ps += p0[r];
#pragma unroll
    for (int r = 0; r < 16; ++r) ps += p1[r];
    { auto rr = __builtin_amdgcn_permlane32_swap(__float_as_uint(ps), __float_as_uint(ps), false, false);
      ps = __uint_as_float(rr[0]) + __uint_as_float(rr[1]); }
    l_reg = l_reg * alpha + ps;
    if (DIRECT) {
#define PKD(P, B, OUT) do { u32x4 w = {cvtpk(P[B], P[B + 1]), cvtpk(P[B + 2], P[B + 3]), cvtpk(P[B + 4], P[B + 5]), cvtpk(P[B + 6], P[B + 7])}; OUT = *reinterpret_cast<bf16x8*>(&w); } while (0)
        PKD(p0, 0, pa0); PKD(p0, 8, pa1); PKD(p1, 0, pa2); PKD(p1, 8, pa3);
#undef PKD
    } else { PK4(p0, 0, pa0); PK4(p0, 8, pa1); PK4(p1, 0, pa2); PK4(p1, 8, pa3); }
}
__device__ __forceinline__ void qkt(f32x16& p0, f32x16& p1, const char* Ks, const bf16x8* qr, int r32, int hi, int mapc) {
    p0 = f32x16{}; p1 = f32x16{};
#pragma unroll
    for (int d0 = 0; d0 < 4; ++d0) { int cb = (mapc + d0 * 16 + hi * 8) * 2;
        bf16x8 b0 = *reinterpret_cast<const bf16x8*>(Ks + KSWZ(r32, cb));
        bf16x8 b1 = *reinterpret_cast<const bf16x8*>(Ks + KSWZ(32 + r32, cb));
        p0 = __builtin_amdgcn_mfma_f32_32x32x16_bf16(b0, qr[d0], p0, 0, 0, 0);
        p1 = __builtin_amdgcn_mfma_f32_32x32x16_bf16(b1, qr[d0], p1, 0, 0, 0); }
}
__device__ __forceinline__ int v_st(int k, int c) { const int kk = (k & ~0xC) | ((k & 4) << 1) | ((k & 8) >> 1); return ((kk >> 3) * 4 + (c >> 5)) * 512 + ((kk & 7) * 32 + (c & 31)) * 2; }
__device__ __forceinline__ int v_rd_base(int lane) { return ((lane & 3) << 3) | (((lane >> 2) & 3) << 6) | (((lane >> 4) & 1) << 5) | (((lane >> 5) & 1) << 8); }
constexpr int v_rd_off(int d0, int ks, int half) { return d0 * 512 + ks * 4096 + half * 2048; }
template <int OFF> __device__ __forceinline__ s16x4 tr_read(int vb) {
    s16x4 r; asm volatile("ds_read_b64_tr_b16 %0, %1 offset:%2" : "=&v"(r) : "v"(vb), "i"(OFF) : "memory"); return r;
}
template <int D0> __device__ __forceinline__ void pv_one(f32x16& od, int vb, bf16x8 pa0, bf16x8 pa1, bf16x8 pa2, bf16x8 pa3) {
    const s16x4 l0 = tr_read<v_rd_off(D0, 0, 0)>(vb), h0 = tr_read<v_rd_off(D0, 0, 1)>(vb), l1 = tr_read<v_rd_off(D0, 1, 0)>(vb), h1 = tr_read<v_rd_off(D0, 1, 1)>(vb);
    const s16x4 l2 = tr_read<v_rd_off(D0, 2, 0)>(vb), h2 = tr_read<v_rd_off(D0, 2, 1)>(vb), l3 = tr_read<v_rd_off(D0, 3, 0)>(vb), h3 = tr_read<v_rd_off(D0, 3, 1)>(vb);
    asm volatile("s_waitcnt lgkmcnt(0)" ::: "memory"); SBAR();
#define PKV(L, H) (bf16x8){L[0], L[1], L[2], L[3], H[0], H[1], H[2], H[3]}
    od = __builtin_amdgcn_mfma_f32_32x32x16_bf16(pa0, PKV(l0, h0), od, 0, 0, 0);
    od = __builtin_amdgcn_mfma_f32_32x32x16_bf16(pa1, PKV(l1, h1), od, 0, 0, 0);
    od = __builtin_amdgcn_mfma_f32_32x32x16_bf16(pa2, PKV(l2, h2), od, 0, 0, 0);
    od = __builtin_amdgcn_mfma_f32_32x32x16_bf16(pa3, PKV(l3, h3), od, 0, 0, 0);
}
template <int D0> __device__ __forceinline__ void pv_two(f32x16& oa, f32x16& ob, int vb, bf16x8 pa0, bf16x8 pa1, bf16x8 pa2, bf16x8 pa3) {
    const s16x4 l0 = tr_read<v_rd_off(D0, 0, 0)>(vb), h0 = tr_read<v_rd_off(D0, 0, 1)>(vb), l1 = tr_read<v_rd_off(D0, 1, 0)>(vb), h1 = tr_read<v_rd_off(D0, 1, 1)>(vb);
    const s16x4 l2 = tr_read<v_rd_off(D0, 2, 0)>(vb), h2 = tr_read<v_rd_off(D0, 2, 1)>(vb), l3 = tr_read<v_rd_off(D0, 3, 0)>(vb), h3 = tr_read<v_rd_off(D0, 3, 1)>(vb);
    const s16x4 m0 = tr_read<v_rd_off(D0 + 1, 0, 0)>(vb), g0 = tr_read<v_rd_off(D0 + 1, 0, 1)>(vb), m1 = tr_read<v_rd_off(D0 + 1, 1, 0)>(vb), g1 = tr_read<v_rd_off(D0 + 1, 1, 1)>(vb);
    const s16x4 m2 = tr_read<v_rd_off(D0 + 1, 2, 0)>(vb), g2 = tr_read<v_rd_off(D0 + 1, 2, 1)>(vb), m3 = tr_read<v_rd_off(D0 + 1, 3, 0)>(vb), g3 = tr_read<v_rd_off(D0 + 1, 3, 1)>(vb);
    asm volatile("s_waitcnt lgkmcnt(0)" ::: "memory"); SBAR();
    oa = __builtin_amdgcn_mfma_f32_32x32x16_bf16(pa0, PKV(l0, h0), oa, 0, 0, 0);
    ob = __builtin_amdgcn_mfma_f32_32x32x16_bf16(pa0, PKV(m0, g0), ob, 0, 0, 0);
    oa = __builtin_amdgcn_mfma_f32_32x32x16_bf16(pa1, PKV(l1, h1), oa, 0, 0, 0);
    ob = __builtin_amdgcn_mfma_f32_32x32x16_bf16(pa1, PKV(m1, g1), ob, 0, 0, 0);
    oa = __builtin_amdgcn_mfma_f32_32x32x16_bf16(pa2, PKV(l2, h2), oa, 0, 0, 0);
    ob = __builtin_amdgcn_mfma_f32_32x32x16_bf16(pa2, PKV(m2, g2), ob, 0, 0, 0);
    oa = __builtin_amdgcn_mfma_f32_32x32x16_bf16(pa3, PKV(l3, h3), oa, 0, 0, 0);
    ob = __builtin_amdgcn_mfma_f32_32x32x16_bf16(pa3, PKV(m3, g3), ob, 0, 0, 0);
}
__device__ __forceinline__ void pv_d0(f32x16* o, int vb, bf16x8 pa0, bf16x8 pa1, bf16x8 pa2, bf16x8 pa3) {
    pv_one<0>(o[0], vb, pa0, pa1, pa2, pa3); pv_one<1>(o[1], vb, pa0, pa1, pa2, pa3); pv_one<2>(o[2], vb, pa0, pa1, pa2, pa3); pv_one<3>(o[3], vb, pa0, pa1, pa2, pa3);
}

template <int PROBE> __device__ __forceinline__ void attn_item(const bf16_t* __restrict__ Qb, const bf16_t* __restrict__ Kh, const bf16_t* __restrict__ Vh, bf16_t* __restrict__ mixrow,
                                          const float* __restrict__ gd, float lam, int tid_l) {
    char* lds = smem;
    const int tid = tid_l, wid = tid >> 6, lane = tid & 63, r32 = lane & 31, hi = lane >> 5;
    const int map = wid >> 2, wq = wid & 3, mapc = map * 64;
    char* V_lds = lds; char* K_lds = lds + 3 * A_SHM_V;
    float* wsw = (float*)(lds + 3 * A_SHM_V + 3 * A_SHM_K) + wid * 64; float* li_l = wsw; float* al_l = wsw + 32;
    float m_reg = 0.f, l_reg = 0; f32x16 o[4] = {}; bf16x8 qr[4]; f32x16 negm = f32x16{};
    const bf16_t* Qw = Qb + (long)(wq * 32 + r32) * 128 + mapc + hi * 8;
#pragma unroll
    for (int d0 = 0; d0 < 4; ++d0) qr[d0] = *reinterpret_cast<const bf16x8*>(Qw + d0 * 16);
    const int vb0 = (int)(uintptr_t)V_lds + v_rd_base(lane);
    unsigned kofs[2], vofs[2];
    const int widu = __builtin_amdgcn_readfirstlane(wid);
#pragma unroll
    for (int i = 0; i < 2; ++i) {
        const int x = wid * 1024 + i * 8192 + lane * 16;
        { const int row = x >> 8, cs = x & 255, colB = cs ^ ((row & 7) << 4); kofs[i] = (unsigned)(row * 256 + colB); }
        { const int sub = x >> 9, wn = x & 511, k = (sub >> 2) * 8 + (wn >> 6), c = (sub & 3) * 32 + ((wn & 63) >> 1); vofs[i] = (unsigned)(k * 256 + c * 2); }
    }
#define DMA_TILE(slot, k0) do { const char* kt_ = (const char*)Kh + (size_t)(k0) * 256; const char* vt_ = (const char*)Vh + (size_t)(k0) * 256;                  \
      _Pragma("unroll") for (int i = 0; i < 2; ++i) {                                                                   \
        __builtin_amdgcn_global_load_lds((const unsigned*)(kt_ + kofs[i]), (unsigned*)(K_lds + (slot) * A_SHM_K + widu * 1024 + i * 8192), 16, 0, 0); \
        __builtin_amdgcn_global_load_lds((const unsigned*)(vt_ + vofs[i]), (unsigned*)(V_lds + (slot) * A_SHM_V + widu * 1024 + i * 8192), 16, 0, 0); } } while (0)
#define RESC(a) do { if (__any((a) < 1.f)) { if (hi == 0) al_l[r32] = (a); asm volatile("s_waitcnt lgkmcnt(0)" ::: "memory"); \
    _Pragma("unroll") for (int d = 0; d < 4; ++d) _Pragma("unroll") for (int r = 0; r < 16; ++r) o[d][r] *= al_l[crow(r, hi)]; } } while (0)
    f32x16 pA0, pA1, pB0, pB1; float mnA, mnB, alA, alB; bf16x8 pa0, pa1, pa2, pa3; const int NT = RB / A_KVBLK;
    DMA_TILE(0, 0); DMA_TILE(1, A_KVBLK);
    asm volatile("s_waitcnt vmcnt(0)" ::: "memory"); __syncthreads();
    qkt2(pA0, pA1, K_lds, qr, negm, r32, hi, mapc); partialSM2<true>(pA0, pA1, m_reg, negm, alA);
    int pb = 0, cb = 1, nb_ = 2;
#define ROT() do { pb = cb; cb = nb_; nb_ = (nb_ == 2) ? 0 : nb_ + 1; } while (0)
    for (int j = 1; j + 1 < NT; j += 2) {
        asm volatile("s_waitcnt vmcnt(0)" ::: "memory"); __syncthreads();
        if (PROBE != 1) DMA_TILE(nb_, (j + 1) * A_KVBLK);
        SBAR(); qkt2(pB0, pB1, K_lds + cb * A_SHM_K, qr, negm, r32, hi, mapc);
        finishSM<PROBE, true>(pA0, pA1, alA, l_reg, pa0, pa1, pa2, pa3); SBAR();
        pv_d0(o, vb0 + pb * A_SHM_V, pa0, pa1, pa2, pa3); partialSM2<false>(pB0, pB1, m_reg, negm, alB);
        RESC(alB); ROT();
        asm volatile("s_waitcnt vmcnt(0)" ::: "memory"); __syncthreads();
        if (PROBE != 1) DMA_TILE(nb_, (j + 2) * A_KVBLK);
        SBAR(); qkt2(pA0, pA1, K_lds + cb * A_SHM_K, qr, negm, r32, hi, mapc);
        finishSM<PROBE, true>(pB0, pB1, alB, l_reg, pa0, pa1, pa2, pa3); SBAR();
        pv_d0(o, vb0 + pb * A_SHM_V, pa0, pa1, pa2, pa3); partialSM2<false>(pA0, pA1, m_reg, negm, alA);
        RESC(alA); ROT();
    }
    asm volatile("s_waitcnt vmcnt(0)" ::: "memory"); __syncthreads();
    SBAR(); qkt2(pB0, pB1, K_lds + cb * A_SHM_K, qr, negm, r32, hi, mapc);
    finishSM<PROBE, true>(pA0, pA1, alA, l_reg, pa0, pa1, pa2, pa3); SBAR();
    pv_d0(o, vb0 + pb * A_SHM_V, pa0, pa1, pa2, pa3); partialSM2<false>(pB0, pB1, m_reg, negm, alB);
    RESC(alB);
    finishSM<PROBE, true>(pB0, pB1, alB, l_reg, pa0, pa1, pa2, pa3); SBAR();
    pv_d0(o, vb0 + cb * A_SHM_V, pa0, pa1, pa2, pa3);
#undef ROT
#undef DMA_TILE
    if (hi == 0) li_l[r32] = l_reg;
    asm volatile("s_waitcnt lgkmcnt(0)" ::: "memory");
    float rl[16];
#pragma unroll
    for (int r = 0; r < 16; ++r) rl[r] = __builtin_amdgcn_rcpf(li_l[crow(r, hi)]);
    __syncthreads();
    {
        float* xo = (float*)lds + map * 16384 + (wq * 32) * 128 + r32;
#pragma unroll
        for (int r = 0; r < 16; ++r)
#pragma unroll
            for (int d0 = 0; d0 < 4; ++d0) xo[crow(r, hi) * 128 + d0 * 32] = o[d0][r] * rl[r];
    }
    __syncthreads();
    {
        const float g0 = gd[lane * 2], g1 = gd[lane * 2 + 1];
#pragma unroll 4
        for (int rr = 0; rr < 16; ++rr) {
            const int row = wid * 16 + rr;
            const float2 a0 = *(const float2*)((const float*)lds + row * 128 + lane * 2), a1 = *(const float2*)((const float*)lds + 16384 + row * 128 + lane * 2);
            const float xv = a0.x - lam * a1.x, yv = a0.y - lam * a1.y;
            const float ss = wave_sum(xv * xv + yv * yv);
            const float rs = rsqrtf(ss * (1.0f / 128) + EPS) * 0.8f;
            *(unsigned*)(mixrow + (long)row * 1024 + lane * 2) = cvtpk(xv * rs * g0, yv * rs * g1);
        }
    }
    __syncthreads();
#undef RESC
}


template <int PROBE> __device__ __forceinline__ void ph_attn(const MK& p, int bid, int nb, int tid_l) {
    const int lane = tid_l & 63;
    float s1 = wave_sum(p.lq1[lane] * p.lk1[lane]), s2 = wave_sum(p.lq2[lane] * p.lk2[lane]);
    const float lam = expf(s1) - expf(s2) + 0.2f;
    const int nrounds = (1024 + nb - 1) / nb;
    for (int rr = 0; rr < nrounds; ++rr) {
        int item;
        if (nb == 256) { int x = bid & 7, j = bid >> 3, hh = rr * 8 + x; item = (hh >> 1) * 64 + (hh & 1) * 32 + j; }
        else { item = rr * nb + bid; if (item >= 1024) break; }
        const int bh = item >> 6, qb = item & 63, b = bh >> 2, h = bh & 3;
        attn_item<PROBE>(p.Q() + ((size_t)bh * SEQ + qb * 128) * 128, p.K() + (size_t)bh * RB * 128, p.V() + (size_t)bh * RB * 128,
                  PROBE ? (bf16_t*)(p.ws + 492 * MiB) + h * 128 : p.MIX() + ((size_t)(b * SEQ + qb * 128)) * 1024 + h * 128, p.dattn_g, lam, tid_l);
    }
}


__device__ __forceinline__ bf16x8 ldfrag(const bf16_t* p) { return *reinterpret_cast<const bf16x8*>(p); }

__device__ __forceinline__ void ph_kv(const MK& p, int bid, int nb, int tid_l) {
    const int wid = tid_l >> 6, lane = tid_l & 63, r32 = lane & 31, hi = lane >> 5;
    const int nitems = 16 * 2 * 66;
    for (int it = bid * 8 + wid; it < nitems; it += nb * 8) {
        const int c = it % 66, chain = it / 66, dir = chain & 1, bh = chain >> 1;
        const bf16_t* vt = p.VT() + (size_t)bh * 128 * RB + c * 128 + hi * 8;
        const bf16_t* kt = (dir ? p.KTb() : p.KTf()) + (size_t)bh * 64 * RB + c * 128 + hi * 8;
        f32x16 acc[4][2];
#pragma unroll
        for (int mt = 0; mt < 4; ++mt) { acc[mt][0] = f32x16{}; acc[mt][1] = f32x16{}; }
#pragma unroll 2
        for (int ks = 0; ks < 8; ++ks) {
            bf16x8 a[4], b[2];
#pragma unroll
            for (int mt = 0; mt < 4; ++mt) a[mt] = ldfrag(vt + (size_t)(mt * 32 + r32) * RB + ks * 16);
#pragma unroll
            for (int nt = 0; nt < 2; ++nt) b[nt] = ldfrag(kt + (size_t)(nt * 32 + r32) * RB + ks * 16);
#pragma unroll
            for (int mt = 0; mt < 4; ++mt)
#pragma unroll
                for (int nt = 0; nt < 2; ++nt) acc[mt][nt] = __builtin_amdgcn_mfma_f32_32x32x16_bf16(a[mt], b[nt], acc[mt][nt], 0, 0, 0);
        }
        bf16_t* dst = p.KV() + (size_t)it * 8192;
#pragma unroll
        for (int mt = 0; mt < 4; ++mt)
#pragma unroll
            for (int nt = 0; nt < 2; ++nt)
#pragma unroll
                for (int r = 0; r < 16; ++r) dst[(mt * 32 + crow(r, hi)) * 64 + nt * 32 + r32] = f2bf(acc[mt][nt][r]);
    }
}

__device__ __forceinline__ void ph_scan(const MK& p, int bid, int nb, int tid_l) {
    for (int e = bid * NTHR + tid_l; e < 32 * 8192; e += nb * NTHR) {
        const int chain = e >> 13, el = e & 8191, dir = chain & 1, bh = chain >> 1, h = bh & 3;
        const float d = dir ? p.dec_b[h] : p.dec_f[h];
        const float g128 = exp2f(128.0f * log2f(1.0f / (1.0f + expf(-d))));
        const bf16_t* kv = p.KV() + (size_t)chain * 66 * 8192 + el;
        bf16_t* st = p.ST() + (size_t)chain * 66 * 8192 + el;
        float S = 0.f;
        for (int n = 0; n < 66; ++n) {
            const int c = dir == 0 ? n : (n == 0 ? 1 : (n == 1 ? 0 : 67 - n));
            st[(size_t)c * 8192] = f2bf(S);
            S = fmaf(g128, S, bf2f(kv[(size_t)c * 8192]));
        }
    }
}

__device__ __forceinline__ void ph_ret(const MK& p, int bid, int nb, int tid_l) {
    const int tid = tid_l, wid = tid >> 6, lane = tid & 63, r32 = lane & 31, hi = lane >> 5, wq = wid & 3, half = wid >> 2;
    float* img = (float*)smem;
    for (int it = bid; it < 4 * 64 * 2; it += nb) {
        const int hp = it & 1, lc = (it >> 1) & 63, b = it >> 7, h = hp * 2 + half, bh = b * 4 + h;
        const int ib = CTX + lc * 128, c = 2 + lc;
        const float lf = log2f(1.0f / (1.0f + expf(-p.dec_f[h]))), lb = log2f(1.0f / (1.0f + expf(-p.dec_b[h])));
        const bf16_t* rq = p.RQ() + ((size_t)bh * RB + ib + wq * 32 + r32) * 64 + hi * 8;
        bf16x8 q[4];
#pragma unroll
        for (int ks = 0; ks < 4; ++ks) q[ks] = ldfrag(rq + ks * 16);
        f32x16 o[4];
        {
            const bf16_t* stf = p.ST() + ((size_t)(bh * 2 + 0) * 66 + c) * 8192 + hi * 8;
            const bf16_t* stb = p.ST() + ((size_t)(bh * 2 + 1) * 66 + c) * 8192 + hi * 8;
            {
                float rf[16];
#pragma unroll
                for (int r = 0; r < 16; ++r) rf[r] = __builtin_amdgcn_exp2f((float)(wq * 32 + crow(r, hi) + 1) * lf);
#pragma unroll
                for (int d0 = 0; d0 < 4; ++d0) {
                    f32x16 tf = f32x16{};
#pragma unroll
                    for (int ks = 0; ks < 4; ++ks) tf = __builtin_amdgcn_mfma_f32_32x32x16_bf16(q[ks], ldfrag(stf + (size_t)(d0 * 32 + r32) * 64 + ks * 16), tf, 0, 0, 0);
#pragma unroll
                    for (int r = 0; r < 16; ++r) o[d0][r] = tf[r] * rf[r];
                    asm volatile("" ::: "memory");
                }
            }
            {
                float rf[16];
#pragma unroll
                for (int r = 0; r < 16; ++r) rf[r] = __builtin_amdgcn_exp2f((float)(128 - (wq * 32 + crow(r, hi))) * lb);
#pragma unroll
                for (int d0 = 0; d0 < 4; ++d0) {
                    f32x16 tb = f32x16{};
#pragma unroll
                    for (int ks = 0; ks < 4; ++ks) tb = __builtin_amdgcn_mfma_f32_32x32x16_bf16(q[ks], ldfrag(stb + (size_t)(d0 * 32 + r32) * 64 + ks * 16), tb, 0, 0, 0);
#pragma unroll
                    for (int r = 0; r < 16; ++r) o[d0][r] += tb[r] * rf[r];
                    asm volatile("" ::: "memory");
                }
            }
        }
        {
            const int qi = wq * 32 + r32;
            const bf16_t* vt = p.VT() + (size_t)bh * 128 * RB + ib + hi * 8;
#pragma unroll 1
            for (int jb = 0; jb < 4; ++jb) {
                asm volatile("" ::: "memory");
                const bf16_t* rk = p.RK() + ((size_t)bh * RB + ib + jb * 32 + r32) * 64 + hi * 8;
                f32x16 pp = f32x16{};
#pragma unroll
                for (int ks = 0; ks < 4; ++ks) pp = __builtin_amdgcn_mfma_f32_32x32x16_bf16(ldfrag(rk + ks * 16), q[ks], pp, 0, 0, 0);
#pragma unroll
                for (int r = 0; r < 16; ++r) {
                    const int dd = qi - (jb * 32 + crow(r, hi));
                    const float ex = __builtin_amdgcn_exp2f(dd > 0 ? (float)dd * lf : (float)(-dd) * lb); const float w = dd == 0 ? 2.0f : ex;
                    pp[r] *= w;
                }
                bf16x8 pa0, pa1;
                PK4(pp, 0, pa0); PK4(pp, 8, pa1);
#pragma unroll
                for (int d0 = 0; d0 < 4; ++d0) {
                    o[d0] = __builtin_amdgcn_mfma_f32_32x32x16_bf16(pa0, ldfrag(vt + (size_t)(d0 * 32 + r32) * RB + jb * 32), o[d0], 0, 0, 0);
                    o[d0] = __builtin_amdgcn_mfma_f32_32x32x16_bf16(pa1, ldfrag(vt + (size_t)(d0 * 32 + r32) * RB + jb * 32 + 16), o[d0], 0, 0, 0);
                }
            }
        }
        __syncthreads();
        {
            float* xo = img + half * 16384 + (wq * 32) * 128 + r32;
#pragma unroll
            for (int r = 0; r < 16; ++r)
#pragma unroll
                for (int d0 = 0; d0 < 4; ++d0) xo[crow(r, hi) * 128 + d0 * 32] = o[d0][r];
        }
        __syncthreads();
        {
            const float g0 = p.ret_g[lane * 2], g1 = p.ret_g[lane * 2 + 1];
#pragma unroll 4
            for (int rr = 0; rr < 32; ++rr) {
                const int row = wid * 32 + rr, itl = row >> 7, rw = row & 127, hh = hp * 2 + itl;
                const float2 a = *(const float2*)(img + row * 128 + lane * 2);
                const float ss = wave_sum(a.x * a.x + a.y * a.y);
                const float rs = rsqrtf(ss * (1.0f / 128) + EPS);
                const size_t tt = (size_t)b * SEQ + lc * 128 + rw;
                const unsigned gg = *(const unsigned*)(p.RG() + tt * 512 + hh * 128 + lane * 2);
                const float ga = bf2f((bf16_t)(gg & 0xffff)), gb = bf2f((bf16_t)(gg >> 16));
                *(unsigned*)(p.MIX() + tt * 1024 + 512 + hh * 128 + lane * 2) = cvtpk(siluf(ga) * a.x * rs * g0, siluf(gb) * a.y * rs * g1);
            }
        }
    }
}


namespace pg8 {
constexpr int BM = 256, BK = 64, HALF = 128, HTB = HALF * BK * 2;
__device__ __forceinline__ int perm32(int rho) { const int n = rho >> 4, i = rho & 15; return 8 * (i >> 2) + 4 * n + (i & 3); }
struct GUnit { const char* A; const char* B; int i0, i1, i2, i3; };
template <class Epi, class Sched, bool GATHER, bool ALIGN_EPI>
__device__ __forceinline__ void gemm(int K, const Sched& S, const Epi& E, int tid_l) {
    const int tid = tid_l, wid = __builtin_amdgcn_readfirstlane(tid >> 6), lane = tid & 63, wr = wid >> 2, wc = wid & 3, fr = lane & 15, fq = lane >> 4;
    const int nt = K / BK;
    unsigned voffB[2], vAc[2][2], vAn[2][2];
    const size_t kstep = (size_t)(BK * 2);
    const size_t hstepB = (size_t)HALF * K * 2;
#pragma unroll
    for (int i = 0; i < 2; ++i) { int R, C; stage_rc(tid * 16 + i * 8192, R, C); const int Rb = Epi::PERM ? ((R & ~31) + perm32(R & 31)) : R;
        voffB[i] = (unsigned)(Rb * K + C) * 2u; }
    const unsigned ldsw = (unsigned)wid * 1024u;
    const int aoff = lds_byte(wr * 64 + fr, fq * 8), boff = lds_byte(wc * 32 + fr, fq * 8);
#define PG8_SA(b, h) (((b) * 2 + (h)) * HTB)
#define PG8_SB(b, h) ((4 + (b) * 2 + (h)) * HTB)
#define PG8_STAGE(bufoff, gbase, voff) do { _Pragma("unroll") for (int _i = 0; _i < 2; ++_i) \
        __builtin_amdgcn_global_load_lds((const unsigned*)((const char*)(gbase) + (voff)[_i]), (unsigned*)(smem + (bufoff) + ldsw + _i * 8192), 16, 0, 0); } while (0)
#define PG8_LDA(dst, b, h) do { _Pragma("unroll") for (int m = 0; m < 4; ++m) _Pragma("unroll") for (int k = 0; k < 2; ++k) dst[m][k] = *(const bf16x8*)(smem + PG8_SA(b, h) + aoff + m * 2048 + k * 1024); } while (0)
#define PG8_LDB(dst, b, h) do { _Pragma("unroll") for (int n = 0; n < 2; ++n) _Pragma("unroll") for (int k = 0; k < 2; ++k) dst[n][k] = *(const bf16x8*)(smem + PG8_SB(b, h) + boff + n * 2048 + k * 1024); } while (0)
#define PG8_MMA(ai, bj, At, Bt) do { __builtin_amdgcn_s_setprio(1); _Pragma("unroll") for (int m = 0; m < 4; ++m) _Pragma("unroll") for (int n = 0; n < 2; ++n) _Pragma("unroll") for (int k = 0; k < 2; ++k) \
        acc[ai][bj][m][n] = __builtin_amdgcn_mfma_f32_16x16x32_bf16(Bt[n][k], At[m][k], acc[ai][bj][m][n], 0, 0, 0); __builtin_amdgcn_s_setprio(0); } while (0)
#define PG8_WAIT_V(n) asm volatile("s_waitcnt vmcnt(" #n ")" ::: "memory")
#define PG8_WAIT_L(n) asm volatile("s_waitcnt lgkmcnt(" #n ")" ::: "memory")
#define PG8_BAR __builtin_amdgcn_s_barrier()
#define PG8_SCHED __builtin_amdgcn_sched_barrier(0)
    GUnit cur, nxt; int ui = 0;
    if (!S.next(0, cur, vAc)) return;
    f32x4 acc[2][2][4][2];
#pragma unroll
    for (int a = 0; a < 2; ++a)
#pragma unroll
        for (int b = 0; b < 2; ++b)
#pragma unroll
            for (int m = 0; m < 4; ++m)
#pragma unroll
                for (int n = 0; n < 2; ++n) acc[a][b][m][n] = (f32x4){0.f, 0.f, 0.f, 0.f};
    bf16x8 At[4][2], B0[2][2], B1[2][2];
    const char* cA = cur.A; const char* cB = cur.B;
    PG8_STAGE(PG8_SB(0, 0), cB, voffB); PG8_STAGE(PG8_SB(0, 1), cB + hstepB, voffB); PG8_STAGE(PG8_SA(0, 0), cA, vAc[0]); PG8_STAGE(PG8_SA(0, 1), cA, vAc[1]);
    if (wr == 1) PG8_BAR;
    PG8_WAIT_V(2); PG8_BAR;
    PG8_STAGE(PG8_SB(1, 0), cB + kstep, voffB); PG8_STAGE(PG8_SA(1, 0), cA + kstep, vAc[0]); PG8_STAGE(PG8_SB(1, 1), cB + hstepB + kstep, voffB);
    PG8_WAIT_V(6); PG8_BAR;
    for (;;) {
        const bool has_next = S.next(ui + 1, nxt, vAn);
        if (!GATHER || !has_next) {
#pragma unroll
            for (int h = 0; h < 2; ++h)
#pragma unroll
                for (int i = 0; i < 2; ++i) vAn[h][i] = vAc[h][i];
        }
        const char* nA = has_next ? nxt.A : cA; const char* nB = has_next ? nxt.B : cB;
#pragma unroll 1
        for (int t = 0; t < nt; t += 2) {
            const bool last = (t == nt - 2);
            const char* a1 = cA + (size_t)(t + 1) * kstep;
            const char* a2 = last ? nA : cA + (size_t)(t + 2) * kstep; const char* b2 = last ? nB : cB + (size_t)(t + 2) * kstep;
            const char* a3 = a2 + kstep; const char* b3 = b2 + kstep;
            unsigned va2[2][2];
#pragma unroll
            for (int h = 0; h < 2; ++h)
#pragma unroll
                for (int i = 0; i < 2; ++i) va2[h][i] = (GATHER && last) ? vAn[h][i] : vAc[h][i];
            PG8_LDB(B0, 0, 0); PG8_LDB(B1, 0, 1); PG8_SCHED; PG8_LDA(At, 0, 0); PG8_STAGE(PG8_SA(1, 1), a1, vAc[1]);
            PG8_WAIT_V(8); PG8_WAIT_L(0); PG8_BAR; PG8_MMA(0, 0, At, B0); PG8_MMA(0, 1, At, B1); PG8_BAR; PG8_SCHED;
            PG8_LDA(At, 0, 1); PG8_STAGE(PG8_SB(0, 0), b2, voffB); PG8_STAGE(PG8_SB(0, 1), b2 + hstepB, voffB); PG8_STAGE(PG8_SA(0, 0), a2, va2[0]);
            PG8_WAIT_V(8); PG8_WAIT_L(0); PG8_BAR; PG8_MMA(1, 0, At, B0); PG8_MMA(1, 1, At, B1); PG8_BAR; PG8_SCHED;
            PG8_LDB(B0, 1, 0); PG8_LDB(B1, 1, 1); PG8_SCHED; PG8_LDA(At, 1, 0); PG8_STAGE(PG8_SA(0, 1), a2, va2[1]);
            PG8_WAIT_V(8); PG8_WAIT_L(0); PG8_BAR; PG8_MMA(0, 0, At, B0); PG8_MMA(0, 1, At, B1); PG8_BAR; PG8_SCHED;
            PG8_LDA(At, 1, 1); PG8_STAGE(PG8_SB(1, 0), b3, voffB); PG8_STAGE(PG8_SB(1, 1), b3 + hstepB, voffB); PG8_STAGE(PG8_SA(1, 0), a3, va2[0]);
            PG8_WAIT_V(8); PG8_WAIT_L(0); PG8_BAR; PG8_MMA(1, 0, At, B0); PG8_MMA(1, 1, At, B1); PG8_BAR; PG8_SCHED;
        }
        if (ALIGN_EPI) { if (wr == 0) PG8_BAR; }
        E(acc, cur, wr, wc, fr, fq);
        if (!has_next) break;
#pragma unroll
        for (int a = 0; a < 2; ++a)
#pragma unroll
            for (int b = 0; b < 2; ++b)
#pragma unroll
                for (int m = 0; m < 4; ++m)
#pragma unroll
                    for (int n = 0; n < 2; ++n) acc[a][b][m][n] = (f32x4){0.f, 0.f, 0.f, 0.f};
        cur = nxt; cA = nA; cB = nB; ++ui;
#pragma unroll
        for (int h = 0; h < 2; ++h)
#pragma unroll
            for (int i = 0; i < 2; ++i) vAc[h][i] = vAn[h][i];
        if (ALIGN_EPI) { if (wr == 1) PG8_BAR; }
    }
    PG8_WAIT_V(0);
    if (!ALIGN_EPI) { if (wr == 0) PG8_BAR; }
    PG8_BAR;
#undef PG8_SA
#undef PG8_SB
#undef PG8_STAGE
#undef PG8_LDA
#undef PG8_LDB
#undef PG8_MMA
#undef PG8_WAIT_V
#undef PG8_WAIT_L
#undef PG8_BAR
#undef PG8_SCHED
}
__device__ __forceinline__ void plain_voffA(int K, unsigned (&vA)[2][2], int tid_l) {
#pragma unroll
    for (int i = 0; i < 2; ++i) { int R, C; stage_rc(tid_l * 16 + i * 8192, R, C); vA[0][i] = (unsigned)(R * K + C) * 2u; vA[1][i] = (unsigned)((R + HALF) * K + C) * 2u; }
}
}


struct SchedIn { const MK* p; int bid, nb, tid_l;
    __device__ __forceinline__ bool next(int i, pg8::GUnit& u, unsigned (&vA)[2][2]) const {
        const int tile = bid + i * nb; if (tile >= (NR / 256) * 12) return false;
        const int pm = tile / 12, pn = tile % 12;
        u.A = (const char*)(p->H() + (size_t)(pm * 256) * D); u.B = (const char*)(p->w_inT() + (size_t)(pn * 256) * D); u.i0 = pm; u.i1 = pn; u.i2 = 0; u.i3 = 0;
        pg8::plain_voffA(D, vA, tid_l); return true; } };
struct EpiIn { static constexpr bool PERM = false; const MK* p;
    __device__ __forceinline__ void operator()(f32x4 (&acc)[2][2][4][2], const pg8::GUnit& u, int wr, int wc, int fr_in, int fq_in) const {
        int fr = fr_in, fq = fq_in; asm volatile("" : "+v"(fr), "+v"(fq));
        const int pm = u.i0, seg = u.i1, brow = pm * 256;
        const int b = brow / RB, i0 = brow % RB;
        const bool lat = i0 >= CTX;
        const int wid = wr * 4 + wc, lane = fq * 16 + fr;
        if (lat && (seg <= 3 || seg == 6 || seg == 7)) {
#pragma unroll
            for (int ai = 0; ai < 2; ++ai)
#pragma unroll
                for (int m = 0; m < 4; ++m) {
                    const int t = i0 + ai * 128 + wr * 64 + m * 16 + fr - CTX, pos = (wc & 1) ? (t & 63) : (t >> 6);
                    const f32x4 cc = *(const f32x4*)(p->ropec() + pos * 16 + fq * 4), ss = *(const f32x4*)(p->ropes() + pos * 16 + fq * 4);
#pragma unroll
                    for (int bj = 0; bj < 2; ++bj) { const f32x4 x1 = acc[ai][bj][m][0], x2 = acc[ai][bj][m][1];
                        acc[ai][bj][m][0] = x1 * cc - x2 * ss; acc[ai][bj][m][1] = x1 * ss + x2 * cc; }
                }
        }
        if (seg == 7 || seg <= 1) {
            const float sc_ = seg == 7 ? 0.125f : 0.125f * 1.4426950408889634f;
#pragma unroll
            for (int ai = 0; ai < 2; ++ai)
#pragma unroll
                for (int bj = 0; bj < 2; ++bj)
#pragma unroll
                    for (int m = 0; m < 4; ++m) { acc[ai][bj][m][0] = acc[ai][bj][m][0] * sc_; acc[ai][bj][m][1] = acc[ai][bj][m][1] * sc_; }
        }
        if (seg <= 7 || seg >= 10) {
#pragma unroll
            for (int bj = 0; bj < 2; ++bj) {
                bf16_t* base; long rstride; bool ok = true;
                if (seg <= 1)      { const int h = (seg & 1) * 2 + bj;       base = p->Q() + (((size_t)(b * 4 + h) * SEQ + (i0 - CTX)) * 128 + wc * 32 + fq * 4); rstride = 128; ok = lat; }
                else if (seg <= 3) { const int h = (seg - 2) * 2 + bj;       base = p->K() + (((size_t)(b * 4 + h) * RB + i0) * 128 + wc * 32 + fq * 4);          rstride = 128; }
                else if (seg <= 5) { const int h = (seg - 4) * 2 + bj;       base = p->V() + (((size_t)(b * 4 + h) * RB + i0) * 128 + wc * 32 + fq * 4);          rstride = 128; }
                else if (seg == 6) { const int h = bj * 2 + (wc >> 1);       base = p->RQ() + (((size_t)(b * 4 + h) * RB + i0) * 64 + (wc & 1) * 32 + fq * 4);    rstride = 64; }
                else if (seg == 7) { const int h = bj * 2 + (wc >> 1);       base = p->RK() + (((size_t)(b * 4 + h) * RB + i0) * 64 + (wc & 1) * 32 + fq * 4);    rstride = 64; }
                else               {                                         base = p->RG() + ((size_t)(b * SEQ + (i0 - CTX)) * 512 + (seg - 10) * 256 + bj * 128 + wc * 32 + fq * 4); rstride = 512; ok = lat; }
                if (ok) {
#pragma unroll
                    for (int ai = 0; ai < 2; ++ai)
#pragma unroll
                        for (int m = 0; m < 4; ++m) { bf16_t* rp = base + (long)(ai * 128 + wr * 64 + m * 16 + fr) * rstride;
#pragma unroll
                            for (int n = 0; n < 2; ++n) { u32x2 w; w.x = cvtpk(acc[ai][bj][m][n][0], acc[ai][bj][m][n][1]); w.y = cvtpk(acc[ai][bj][m][n][2], acc[ai][bj][m][n][3]);
                                *(u32x2*)(rp + n * 16) = w; } }
                }
            }
        }
        if (seg >= 7 && seg <= 9) {
            char* img = smem + 131072 + wid * 3968;
            const int npass = seg == 7 ? 2 : 1;
#pragma unroll 1
            for (int ps = 0; ps < npass; ++ps) {
#pragma unroll
                for (int bj = 0; bj < 2; ++bj) {
                    float lg2 = 0.f; bf16_t* baseT;
                    if (seg == 7) { const int h = bj * 2 + (wc >> 1); const float dv = ps == 0 ? p->dec_f[h] : p->dec_b[h]; lg2 = log2f(1.0f / (1.0f + expf(-dv)));
                        baseT = (ps == 0 ? p->KTf() : p->KTb()) + ((size_t)(b * 4 + h) * 64 + (wc & 1) * 32) * RB + i0; }
                    else { const int h = (seg - 8) * 2 + bj; baseT = p->VT() + ((size_t)(b * 4 + h) * 128 + wc * 32) * RB + i0; }
#pragma unroll
                    for (int ai = 0; ai < 2; ++ai)
#pragma unroll
                        for (int mp = 0; mp < 2; ++mp) {
                            asm volatile("s_waitcnt lgkmcnt(0)" ::: "memory");
#pragma unroll
                            for (int mm = 0; mm < 2; ++mm) { const int m = mp * 2 + mm;
                                float f = 1.0f;
                                if (seg == 7) { const int pos = (i0 + ai * 128 + wr * 64 + m * 16 + fr) & 127; f = exp2f((float)(ps == 0 ? 127 - pos : pos) * lg2); }
#pragma unroll
                                for (int n = 0; n < 2; ++n)
#pragma unroll
                                    for (int j = 0; j < 4; ++j) *(bf16_t*)(img + (n * 16 + fq * 4 + j) * 80 + (mm * 16 + fr) * 2) = f2bf(acc[ai][bj][m][n][j] * f); }
                            asm volatile("s_waitcnt lgkmcnt(0)" ::: "memory");
                            const int ib = ai * 128 + wr * 64 + mp * 32;
#pragma unroll
                            for (int k = 0; k < 2; ++k) { const int q = lane + 64 * k, col = q >> 2, ch = q & 3;
                                *(u32x4*)(baseT + (size_t)col * RB + ib + ch * 8) = *(const u32x4*)(img + col * 80 + ch * 16); }
                        }
                }
            }
        }
    } };
__device__ __forceinline__ void ph_gemm_in(const MK& p, int bid, int nb, int tid_l) {
    SchedIn S{&p, bid, nb, tid_l}; EpiIn E{&p};
    pg8::gemm<EpiIn, SchedIn, false, true>(D, S, E, tid_l);
}

struct SchedOut { const MK* p; int bid, nb, tid_l;
    __device__ __forceinline__ bool next(int i, pg8::GUnit& u, unsigned (&vA)[2][2]) const {
        const int tile = bid + i * nb; if (tile >= (T / 256) * 4) return false;
        const int pm = tile >> 2, pn = tile & 3;
        u.A = (const char*)(p->MIX() + (size_t)(pm * 256) * D); u.B = (const char*)(p->w_outT() + (size_t)(pn * 256) * D); u.i0 = pm; u.i1 = pn; u.i2 = 0; u.i3 = 0;
        pg8::plain_voffA(D, vA, tid_l); return true; } };
struct EpiOut { static constexpr bool PERM = false; const MK* p;
    __device__ __forceinline__ void operator()(const f32x4 (&acc)[2][2][4][2], const pg8::GUnit& u, int wr, int wc, int fr, int fq) const {
        const int brow = u.i0 * 256, bcol = u.i1 * 256;
        const float* g1 = p->mod() + (size_t)(brow / SEQ) * 6 * D + 2 * D + bcol + wc * 32 + fq * 4;
        f32x4 gv[2][2];
#pragma unroll
        for (int bj = 0; bj < 2; ++bj)
#pragma unroll
            for (int n = 0; n < 2; ++n) gv[bj][n] = *(const f32x4*)(g1 + bj * 128 + n * 16);
#pragma unroll
        for (int ai = 0; ai < 2; ++ai)
#pragma unroll
            for (int m = 0; m < 4; ++m) {
                const size_t o = (size_t)(brow + ai * 128 + wr * 64 + m * 16 + fr) * D + bcol + wc * 32 + fq * 4;
                f32x4 xv[2][2];
#pragma unroll
                for (int bj = 0; bj < 2; ++bj)
#pragma unroll
                    for (int n = 0; n < 2; ++n) xv[bj][n] = *(const f32x4*)(p->x + o + bj * 128 + n * 16);
#pragma unroll
                for (int bj = 0; bj < 2; ++bj)
#pragma unroll
                    for (int n = 0; n < 2; ++n) *(f32x4*)(p->out + o + bj * 128 + n * 16) = xv[bj][n] + gv[bj][n] * acc[ai][bj][m][n];
                if (m & 1) asm volatile("" ::: "memory");
            }
    } };
__device__ __forceinline__ void ph_gemm_out(const MK& p, int bid, int nb, int tid_l) {
    SchedOut S{&p, bid, nb, tid_l}; EpiOut E{&p};
    pg8::gemm<EpiOut, SchedOut, false, true>(D, S, E, tid_l);
}

template <bool DUMMY, int MODE = 0> __device__ __forceinline__ void ph_route(const MK& p, int bid, int nb, int tid_l) {
    int* cntp = p.cnt() + (DUMMY ? 128 : 0); int* tl = DUMMY ? (int*)(p.ws + 480 * MiB) : p.tok_list(); float* wl_ = DUMMY ? (float*)(p.ws + 488 * MiB) : p.wt_list(); int* tm = DUMMY ? (int*)(p.ws + 496 * MiB) : p.tokmap();
    const int tid = tid_l, wid = tid >> 6, lane = tid & 63, fr = lane & 15, fq = lane >> 4;
    float* lg = (float*)smem;
    int* wcnt = (int*)(smem + 34816);
    int* basel = wcnt + 128;
    bf16_t* H2lo = (bf16_t*)(p.ws + 325 * MiB);
    for (int item = bid; item < T / 128; item += nb) {
        const int t0 = item * 128 + wid * 16, b = (item * 128) / SEQ;
        const float* msh = p.mod() + (size_t)b * 6 * D + 3 * D; const float* msc = p.mod() + (size_t)b * 6 * D + 4 * D;
#pragma unroll 1
        for (int r0 = 0; r0 < 16; r0 += 4) {
            float4 xv[4][4];
#pragma unroll
            for (int rr = 0; rr < 4; ++rr)
#pragma unroll
                for (int q = 0; q < 4; ++q) xv[rr][q] = *(const float4*)(p.out + (size_t)(t0 + r0 + rr) * D + q * 256 + lane * 4);
#pragma unroll
            for (int rr = 0; rr < 4; ++rr) {
                float ss = 0.f;
#pragma unroll
                for (int q = 0; q < 4; ++q) ss += xv[rr][q].x * xv[rr][q].x + xv[rr][q].y * xv[rr][q].y + xv[rr][q].z * xv[rr][q].z + xv[rr][q].w * xv[rr][q].w;
                ss = wave_sum(ss);
                const float rstd = rsqrtf(ss * (1.0f / D) + EPS);
#pragma unroll
                for (int q = 0; q < 4; ++q) {
                    const int c0 = q * 256 + lane * 4;
                    const float4 gg = *(const float4*)(p.norm2_g + c0), sh = *(const float4*)(msh + c0), sc = *(const float4*)(msc + c0);
                    const float h0 = xv[rr][q].x * rstd * gg.x * (1 + sc.x) + sh.x, h1 = xv[rr][q].y * rstd * gg.y * (1 + sc.y) + sh.y;
                    const float h2v = xv[rr][q].z * rstd * gg.z * (1 + sc.z) + sh.z, h3 = xv[rr][q].w * rstd * gg.w * (1 + sc.w) + sh.w;
                    u32x2 wh, wl2; wh.x = cvtpk(h0, h1); wh.y = cvtpk(h2v, h3);
                    wl2.x = cvtpk(h0 - __uint_as_float(wh.x << 16), h1 - __uint_as_float(wh.x & 0xffff0000u));
                    wl2.y = cvtpk(h2v - __uint_as_float(wh.y << 16), h3 - __uint_as_float(wh.y & 0xffff0000u));
                    *(u32x2*)(p.H2() + (size_t)(t0 + r0 + rr) * D + c0) = wh;
                    *(u32x2*)(H2lo + (size_t)(t0 + r0 + rr) * D + c0) = wl2;
                }
            }
        }
        asm volatile("s_waitcnt vmcnt(0)" ::: "memory");
        __syncthreads();
        if (MODE == 3) continue;
        f32x4 acc[4];
#pragma unroll
        for (int nt = 0; nt < 4; ++nt) acc[nt] = (f32x4){0.f, 0.f, 0.f, 0.f};
        {
            const bf16_t* ah_p = p.H2() + (size_t)(t0 + fr) * D + fq * 8; const bf16_t* al_p = H2lo + (size_t)(t0 + fr) * D + fq * 8;
            const bf16_t* rT = p.routerT() + (size_t)fr * D + fq * 8;
#pragma unroll 4
            for (int ks = 0; ks < 32; ++ks) {
                const int k0 = ks * 32;
                const bf16x8 ah = ldfrag(ah_p + k0), al = ldfrag(al_p + k0);
#pragma unroll
                for (int nt = 0; nt < 4; ++nt) {
                    const bf16x8 bh = ldfrag(rT + (size_t)(nt * 16) * D + k0), bl = ldfrag(rT + (size_t)(64 + nt * 16) * D + k0);
                    acc[nt] = __builtin_amdgcn_mfma_f32_16x16x32_bf16(ah, bh, acc[nt], 0, 0, 0);
                    acc[nt] = __builtin_amdgcn_mfma_f32_16x16x32_bf16(ah, bl, acc[nt], 0, 0, 0);
                    acc[nt] = __builtin_amdgcn_mfma_f32_16x16x32_bf16(al, bh, acc[nt], 0, 0, 0);
                }
            }
        }
#pragma unroll
        for (int nt = 0; nt < 4; ++nt)
#pragma unroll
            for (int j = 0; j < 4; ++j) lg[(wid * 16 + fq * 4 + j) * 65 + nt * 16 + fr] = acc[nt][j];
        __syncthreads();
        if (MODE == 2) continue;
        float sc_[64]; unsigned long long ch = 0ull; float wscale = 0.f;
        const int tt = (wid & 1) * 64 + lane, t = item * 128 + tt;
        if (wid < 2) {
            float v[64];
#pragma unroll
            for (int e = 0; e < 64; ++e) { const float x = lg[tt * 65 + e]; sc_[e] = 1.0f / (1.0f + expf(-x)); v[e] = sc_[e] + p.router_b[e]; }
            float gs[8];
#pragma unroll
            for (int g = 0; g < 8; ++g) { float m1 = v[8 * g], m2 = -INFINITY;
#pragma unroll
                for (int i = 1; i < 8; ++i) { const float x = v[8 * g + i]; m2 = fmaxf(m2, fminf(m1, x)); m1 = fmaxf(m1, x); }
                gs[g] = m1 + m2; }
#pragma unroll
            for (int g = 0; g < 8; ++g) { int rank = 0;
#pragma unroll
                for (int g2 = 0; g2 < 8; ++g2) if (g2 != g) rank += (gs[g2] > gs[g] || (gs[g2] == gs[g] && g2 < g)) ? 1 : 0;
                if (rank >= 4) {
#pragma unroll
                    for (int i = 0; i < 8; ++i) v[8 * g + i] = -INFINITY; } }
#pragma unroll
            for (int it = 0; it < 8; ++it) {
                float m = v[0];
#pragma unroll
                for (int e = 1; e < 64; ++e) m = fmaxf(m, v[e]);
                bool found = false;
#pragma unroll
                for (int e = 0; e < 64; ++e) { const bool hit = !found && v[e] == m; if (hit) { ch |= (1ull << e); v[e] = -INFINITY; } found = found || hit; }
            }
            float wsum = 0.f;
#pragma unroll
            for (int e = 0; e < 64; ++e) wsum += ((ch >> e) & 1ull) ? sc_[e] : 0.f;
            wscale = 2.5f / wsum;
#pragma unroll
            for (int e = 0; e < 64; ++e) { const unsigned long long mk = __ballot((ch >> e) & 1ull); if (lane == 0) wcnt[wid * 64 + e] = __popcll(mk); }
        }
        __syncthreads();
        if (wid == 0) basel[lane] = atomicAdd(&cntp[lane], wcnt[lane] + wcnt[64 + lane]);
        __syncthreads();
        if (wid < 2) {
            int kidx = 0;
#pragma unroll
            for (int e = 0; e < 64; ++e) {
                const bool c = (ch >> e) & 1ull;
                const unsigned long long mk = __ballot(c);
                if (c) {
                    const int slot = basel[e] + (wid == 1 ? wcnt[e] : 0) + __popcll(mk & ((1ull << lane) - 1ull));
                    tl[(size_t)e * ECAP + slot] = t; wl_[(size_t)e * ECAP + slot] = sc_[e] * wscale;
                    tm[(size_t)t * 8 + kidx] = e * ECAP + slot; ++kidx;
                }
            }
        }
    }
}

constexpr int MOE_AUX = 162816;
__device__ __forceinline__ void moe_tables(const MK& p, int colt, int* tpre, int* rbase, int tid_l) {
    __syncthreads();
    if (tid_l == 0) { int tp = 0, rb = 0;
        for (int e = 0; e < 65; ++e) { const int c = e < 64 ? p.cnt()[e] : T; tpre[e] = tp; rbase[e] = rb; tp += ((c + 255) >> 8) * colt; rb += c; }
        tpre[65] = tp; rbase[65] = rb; }
    __syncthreads();
}
struct SchedUp { const MK* p; int bid, nb, tid_l, ntiles; const int* tpre; const int* rbase; mutable int e_hint;
    __device__ __forceinline__ bool next(int i, pg8::GUnit& u, unsigned (&vA)[2][2]) const {
        const int tile = bid + i * nb; if (tile >= ntiles) return false;
        int e = e_hint; while (tile >= tpre[e + 1]) ++e; e_hint = e;
        const int j = tile - tpre[e], rt = j >> 1, ct = j & 1, cnt_e = rbase[e + 1] - rbase[e];
        u.A = (const char*)p->H2(); u.B = (const char*)(p->W13t() + ((size_t)e * 512 + ct * 256) * D); u.i0 = e; u.i1 = rt; u.i2 = ct; u.i3 = cnt_e;
#pragma unroll
        for (int i2 = 0; i2 < 2; ++i2) { int R, C; stage_rc(tid_l * 16 + i2 * 8192, R, C);
#pragma unroll
            for (int h = 0; h < 2; ++h) { int slot = rt * 256 + h * 128 + R; if (slot >= cnt_e) slot = 0;
                const int tok = e < 64 ? p->tok_list()[(size_t)e * ECAP + slot] : slot;
                vA[h][i2] = (unsigned)tok * (D * 2u) + (unsigned)C * 2u; } }
        return true; } };
struct EpiUp { static constexpr bool PERM = true; const MK* p; const int* rbase;
    __device__ __forceinline__ void operator()(const f32x4 (&acc)[2][2][4][2], const pg8::GUnit& u, int wr, int wc, int fr, int fq) const {
        const int e = u.i0, rt = u.i1, ct = u.i2, cnt_e = u.i3;
        bf16_t* ab = p->ACT() + (size_t)rbase[e] * DE + ct * 128 + wc * 32 + fq * 8;
#pragma unroll
        for (int ai = 0; ai < 2; ++ai)
#pragma unroll
            for (int m = 0; m < 4; ++m) {
                const int slot = rt * 256 + ai * 128 + wr * 64 + m * 16 + fr;
                u32x4 w;
                w.x = cvtpk(siluf(acc[ai][0][m][0][0]) * acc[ai][1][m][0][0], siluf(acc[ai][0][m][0][1]) * acc[ai][1][m][0][1]);
                w.y = cvtpk(siluf(acc[ai][0][m][0][2]) * acc[ai][1][m][0][2], siluf(acc[ai][0][m][0][3]) * acc[ai][1][m][0][3]);
                w.z = cvtpk(siluf(acc[ai][0][m][1][0]) * acc[ai][1][m][1][0], siluf(acc[ai][0][m][1][1]) * acc[ai][1][m][1][1]);
                w.w = cvtpk(siluf(acc[ai][0][m][1][2]) * acc[ai][1][m][1][2], siluf(acc[ai][0][m][1][3]) * acc[ai][1][m][1][3]);
                if (slot < cnt_e) *(u32x4*)(ab + (size_t)slot * DE) = w;
            }
    } };
__device__ __forceinline__ void ph_moe_up(const MK& p, int bid, int nb, int tid_l) {
    int* tpre = (int*)(smem + MOE_AUX); int* rbase = tpre + 80;
    moe_tables(p, 2, tpre, rbase, tid_l);
    SchedUp S{&p, bid, nb, tid_l, tpre[65], tpre, rbase, 0}; EpiUp E{&p, rbase};
    pg8::gemm<EpiUp, SchedUp, true, true>(D, S, E, tid_l);
}
constexpr float Y_SCALE = 64.0f;
struct SchedDown { const MK* p; int bid, nb, tid_l, ntiles; const int* tpre; const int* rbase; mutable int e_hint;
    __device__ __forceinline__ bool next(int i, pg8::GUnit& u, unsigned (&vA)[2][2]) const {
        const int tile = bid + i * nb; if (tile >= ntiles) return false;
        int e = e_hint; while (tile >= tpre[e + 1]) ++e; e_hint = e;
        const int j = tile - tpre[e], rt = j >> 2, ct = j & 3, cnt_e = rbase[e + 1] - rbase[e];
        u.A = (const char*)(p->ACT() + (size_t)(rbase[e] + rt * 256) * DE); u.B = (const char*)(p->W2t() + ((size_t)e * D + ct * 256) * DE); u.i0 = e; u.i1 = rt; u.i2 = ct; u.i3 = cnt_e;
        pg8::plain_voffA(DE, vA, tid_l); return true; } };
template <int MODE> struct EpiDown { static constexpr bool PERM = true; const MK* p; const int* rbase;
    __device__ __forceinline__ void operator()(const f32x4 (&acc)[2][2][4][2], const pg8::GUnit& u, int wr, int wc, int fr, int fq) const {
        const int e = u.i0, rt = u.i1, ct = u.i2, cnt_e = u.i3;
        const int col0 = ct * 256 + wc * 32 + fq * 8;
        if (e < 64) {
            const float* wl = p->wt_list() + (size_t)e * ECAP;
            float wv[2][4];
#pragma unroll
            for (int ai = 0; ai < 2; ++ai)
#pragma unroll
                for (int m = 0; m < 4; ++m) { const int sl = rt * 256 + ai * 128 + wr * 64 + m * 16 + fr; wv[ai][m] = wl[sl < cnt_e ? sl : 0] * Y_SCALE; }
            const int wid = wr * 4 + wc, lane = fq * 16 + fr;
            char* wa = smem + 131072 + wid * 3968;
            unsigned char* yb = p->Y() + (size_t)rbase[e] * D + ct * 256 + wc * 64 + (lane & 3) * 16;
#pragma unroll
            for (int ai = 0; ai < 2; ++ai)
#pragma unroll
                for (int m = 0; m < 4; ++m) {
                    const float w = wv[ai][m];
                    char* img = wa + ((m & 1) ? 1280 : 0);
#pragma unroll
                    for (int bj = 0; bj < 2; ++bj) {
                        u32x2 pk;
#pragma unroll
                        for (int n = 0; n < 2; ++n) {
                            float v0 = fminf(fmaxf(acc[ai][bj][m][n][0] * w, -448.f), 448.f), v1 = fminf(fmaxf(acc[ai][bj][m][n][1] * w, -448.f), 448.f);
                            float v2 = fminf(fmaxf(acc[ai][bj][m][n][2] * w, -448.f), 448.f), v3 = fminf(fmaxf(acc[ai][bj][m][n][3] * w, -448.f), 448.f);
                            int q = 0; q = __builtin_amdgcn_cvt_pk_fp8_f32(v0, v1, q, false); q = __builtin_amdgcn_cvt_pk_fp8_f32(v2, v3, q, true);
                            if (n == 0) pk.x = (unsigned)q; else pk.y = (unsigned)q;
                        }
                        *(u32x2*)(img + fr * 80 + bj * 32 + fq * 8) = pk;
                    }
                    asm volatile("s_waitcnt lgkmcnt(0)" ::: "memory");
                    const int rr = lane >> 2, slot = rt * 256 + ai * 128 + wr * 64 + m * 16 + rr;
                    const u32x4 v = *(const u32x4*)(img + rr * 80 + (lane & 3) * 16);
                    if (MODE == 1) asm volatile("" :: "v"(v)); else if (slot < cnt_e) *(u32x4*)(yb + (size_t)slot * D) = v;
                }
        } else {
            const float* g2 = p->mod() + (size_t)((rt * 256) / SEQ) * 6 * D + 5 * D + col0;
            f32x4 gv[2][2];
#pragma unroll
            for (int bj = 0; bj < 2; ++bj)
#pragma unroll
                for (int n = 0; n < 2; ++n) gv[bj][n] = *(const f32x4*)(g2 + bj * 128 + n * 4);
            float* xb = p->out + (size_t)(rt * 256) * D + col0;
#pragma unroll
            for (int ai = 0; ai < 2; ++ai)
#pragma unroll
                for (int m = 0; m < 4; ++m) {
                    float* xp = xb + (size_t)(ai * 128 + wr * 64 + m * 16 + fr) * D;
                    f32x4 xv[2][2];
#pragma unroll
                    for (int bj = 0; bj < 2; ++bj)
#pragma unroll
                        for (int n = 0; n < 2; ++n) xv[bj][n] = *(const f32x4*)(xp + bj * 128 + n * 4);
#pragma unroll
                    for (int bj = 0; bj < 2; ++bj)
#pragma unroll
                        for (int n = 0; n < 2; ++n) *(f32x4*)(xp + bj * 128 + n * 4) = xv[bj][n] + gv[bj][n] * acc[ai][bj][m][n];
                    if (m & 1) asm volatile("" ::: "memory");
                }
        }
    } };
template <bool DUMMY, int MODE = 0> __device__ __forceinline__ void ph_moe_down(const MK& p, int bid, int nb, int tid_l) {
    int* tpre = (int*)(smem + MOE_AUX); int* rbase = tpre + 80;
    moe_tables(p, 4, tpre, rbase, tid_l);
    SchedDown S{&p, bid, nb, tid_l, DUMMY ? tpre[64] : tpre[65], tpre, rbase, 0}; EpiDown<MODE> E{&p, rbase};
    pg8::gemm<EpiDown<MODE>, SchedDown, false, true>(DE, S, E, tid_l);
}

template <bool DUMMY> __device__ __forceinline__ void ph_final(const MK& p, int bid, int nb, int tid_l) {
    const int wid = tid_l >> 6, lane = tid_l & 63;
    int* tpre = (int*)(smem + MOE_AUX); int* rbase = tpre + 80;
    moe_tables(p, 1, tpre, rbase, tid_l);
    for (int t = bid * 8 + wid; t < T; t += nb * 8) {
        const int b = t / SEQ;
        float f[16];
#pragma unroll
        for (int i = 0; i < 16; ++i) f[i] = 0.f;
#pragma unroll
        for (int k = 0; k < 8; ++k) {
            const int id = p.tokmap()[(size_t)t * 8 + k], e = id >> 15, slot = id & (ECAP - 1);
            const unsigned char* yr = p.Y() + (size_t)(rbase[e] + slot) * D + lane * 4;
#pragma unroll
            for (int q = 0; q < 4; ++q) {
                const int w = *(const int*)(yr + q * 256);
                const auto lo = __builtin_amdgcn_cvt_pk_f32_fp8(w, false); const auto hi = __builtin_amdgcn_cvt_pk_f32_fp8(w, true);
                f[q * 4 + 0] += lo[0]; f[q * 4 + 1] += lo[1]; f[q * 4 + 2] += hi[0]; f[q * 4 + 3] += hi[1];
            }
        }
        const int pcol = ((lane >> 3) & 1) * 128 + (lane >> 4) * 32 + (lane & 7) * 4;
        const float* g2 = p.mod() + (size_t)b * 6 * D + 5 * D + pcol;
        float* xo = p.out + (size_t)t * D + pcol;
        float v[16]; float ss = 0.f;
#pragma unroll
        for (int q = 0; q < 4; ++q) {
            const float4 xv = *(const float4*)(xo + q * 256), g = *(const float4*)(g2 + q * 256);
            v[q * 4 + 0] = xv.x + g.x * f[q * 4 + 0] * (1.0f / Y_SCALE); v[q * 4 + 1] = xv.y + g.y * f[q * 4 + 1] * (1.0f / Y_SCALE);
            v[q * 4 + 2] = xv.z + g.z * f[q * 4 + 2] * (1.0f / Y_SCALE); v[q * 4 + 3] = xv.w + g.w * f[q * 4 + 3] * (1.0f / Y_SCALE);
            ss += v[q * 4] * v[q * 4] + v[q * 4 + 1] * v[q * 4 + 1] + v[q * 4 + 2] * v[q * 4 + 2] + v[q * 4 + 3] * v[q * 4 + 3];
        }
        ss = wave_sum(ss);
        const float rstd = rsqrtf(ss * (1.0f / D) + EPS);
#pragma unroll
        for (int q = 0; q < 4; ++q) {
            const float4 gf = *(const float4*)(p.final_g + q * 256 + pcol);
            *(float4*)((DUMMY ? (float*)(p.ws + 42 * MiB) + (size_t)t * D + pcol : xo) + q * 256) = make_float4(v[q * 4] * rstd * gf.x, v[q * 4 + 1] * rstd * gf.y, v[q * 4 + 2] * rstd * gf.z, v[q * 4 + 3] * rstd * gf.w);
        }
    }
}


#define XB_TMO      128
#define XB_XCNT(j)  (256  + 64 * (j))
#define XB_XSUB(j)  (1280 + 64 * (j))
#define XB_XGEN(j)  (2304 + 64 * (j))
#define XB_TOP      3328
#define XB_TOPGEN   3392
#define XCD_BAR_WORDS 3456
#define XB_SPIN_CAP (1u << 22)
#define LAS __attribute__((address_space(3)))
__device__ __forceinline__ unsigned xb_ld(unsigned* p)              { return __hip_atomic_load(p, __ATOMIC_RELAXED, __HIP_MEMORY_SCOPE_AGENT); }
__device__ __forceinline__ unsigned xb_add(unsigned* p, unsigned v) { return __hip_atomic_fetch_add(p, v, __ATOMIC_RELAXED, __HIP_MEMORY_SCOPE_AGENT); }
__device__ __forceinline__ unsigned xb_xcc_id() { return (unsigned)__builtin_amdgcn_s_getreg((3 << 11) | 20) & 0xFu; }
#define XB_SPIN(cond, bar) do { unsigned _sp = 0; while (cond) { __builtin_amdgcn_s_sleep(1); \
    if ((++_sp & 255u) == 0u) { if (xb_ld(&(bar)[XB_TMO])) break; if (_sp > XB_SPIN_CAP) { atomicAdd(&(bar)[XB_TMO], 1u); break; } } } } while (0)
struct XcdBarrier { unsigned* bar; unsigned x; volatile LAS unsigned* st; };
__device__ __forceinline__ XcdBarrier xcd_barrier_post(unsigned* bar, volatile LAS unsigned* st, int tid) {
    XcdBarrier b; b.bar = bar; b.x = xb_xcc_id(); b.st = st;
    if (tid == 0) (void)xb_add(&bar[XB_XCNT(b.x)], 1u);
    return b;
}
__device__ __forceinline__ void xcd_barrier_complete(unsigned* bar, unsigned x, unsigned& nloc, unsigned& nx) {
    const unsigned G = gridDim.x * gridDim.y * gridDim.z;
    unsigned sum, cnt, mine, sp = 0u;
    for (;;) {
        sum = 0u; cnt = 0u; mine = 0u;
#pragma unroll
        for (unsigned j = 0; j < 16; ++j) { const unsigned c = xb_ld(&bar[XB_XCNT(j)]); sum += c; cnt += (c > 0u) ? 1u : 0u; mine = (j == x) ? c : mine; }
        if (sum == G) break;
        __builtin_amdgcn_s_sleep(1);
        if ((++sp & 255u) == 0u) { if (xb_ld(&bar[XB_TMO])) break; if (sp > XB_SPIN_CAP) { atomicAdd(&bar[XB_TMO], 1u); break; } }
    }
    nloc = mine > 0u ? mine : 1u; nx = cnt > 0u ? cnt : 1u;
}
__device__ __forceinline__ void xcd_barrier(const XcdBarrier& b, int tid) {
    asm volatile("s_waitcnt vmcnt(0)" ::: "memory");
    __syncthreads();
    if (tid == 0) {
        unsigned* bar = b.bar;
        __builtin_amdgcn_s_waitcnt(0);
        unsigned nloc = b.st[0], nx = b.st[1];
        if (nloc == 0u) { xcd_barrier_complete(bar, b.x, nloc, nx); b.st[0] = nloc; b.st[1] = nx; }
        const unsigned old = xb_add(&bar[XB_XSUB(b.x)], 1u);
        const unsigned gen = old / nloc;
        if (old + 1u == (gen + 1u) * nloc) {
            __builtin_amdgcn_fence(__ATOMIC_RELEASE, "agent");
            asm volatile("s_waitcnt vmcnt(0)" ::: "memory");
            const unsigned og = xb_add(&bar[XB_TOP], 1u);
            const unsigned tg = og / nx;
            if (og + 1u == (tg + 1u) * nx) xb_add(&bar[XB_TOPGEN], 1u);
            else XB_SPIN(xb_ld(&bar[XB_TOPGEN]) == tg, bar);
            __builtin_amdgcn_fence(__ATOMIC_ACQUIRE, "agent");
            xb_add(&bar[XB_XGEN(b.x)], 1u);
            asm volatile("s_waitcnt vmcnt(0)" ::: "memory");
        } else {
            XB_SPIN(xb_ld(&bar[XB_XGEN(b.x)]) == gen, bar);
            __builtin_amdgcn_fence(__ATOMIC_ACQUIRE, "agent");
            asm volatile("s_waitcnt vmcnt(0)" ::: "memory");
        }
    }
    __syncthreads();
}

__device__ __forceinline__ int lane_id_volatile() { int l; asm volatile("v_mbcnt_lo_u32_b32 %0, -1, 0\n\tv_mbcnt_hi_u32_b32 %0, -1, %0" : "=v"(l)); return l; }
__global__ __launch_bounds__(512, 2) void k_mega(MK p) {
    cg::grid_group grid = cg::this_grid();
    const int bid = blockIdx.x, nb = gridDim.x;
    volatile LAS unsigned* xst = (volatile LAS unsigned*)(smem + 162816 + 768);
    if (threadIdx.x < 4) xst[threadIdx.x] = 0u;
    __syncthreads();
    const XcdBarrier xb = xcd_barrier_post((unsigned*)(p.ws + 524288), xst, (int)threadIdx.x);
    const int wv_ = __builtin_amdgcn_readfirstlane((int)threadIdx.x >> 6);
#define LANE_ID() lane_id_volatile()
#define PH_TID() int t_ = wv_ * 64 + LANE_ID(); asm volatile("" : "+v"(t_))
    { PH_TID(); if (bid == 0 && t_ < 256) p.cnt()[t_] = 0; ph_mod(p, bid, nb, t_); ph_convert(p, bid, nb, t_); }
#if DUP == 10
    { PH_TID(); ph_convert(p, bid, nb, t_); }
#endif
    grid.sync();
    { PH_TID(); ph_ln1(p, bid, nb, t_); }
#if DUP == 1
    { PH_TID(); ph_ln1(p, bid, nb, t_); }
#endif
    xcd_barrier(xb, wv_ * 64 + LANE_ID());
    { PH_TID(); ph_gemm_in(p, bid, nb, t_); }
    { PH_TID(); ph_convert_dyn(p, t_); }
#if DUP == 2
    { PH_TID(); ph_gemm_in(p, bid, nb, t_); }
#endif
    xcd_barrier(xb, wv_ * 64 + LANE_ID());
    { PH_TID(); ph_attn<0>(p, bid, nb, t_); }
#if DUP == 3
    { PH_TID(); ph_attn<2>(p, bid, nb, t_); }
#endif
#if DUP == 31
    { PH_TID(); ph_attn<1>(p, bid, nb, t_); }
#endif
#if DUP == 33
    { PH_TID(); ph_attn<3>(p, bid, nb, t_); }
#endif
    { PH_TID(); ph_kv(p, bid, nb, t_); }
#if DUP == 11
    { PH_TID(); ph_kv(p, bid, nb, t_); }
#endif
    xcd_barrier(xb, wv_ * 64 + LANE_ID());
    { PH_TID(); ph_scan(p, bid, nb, t_); }
    xcd_barrier(xb, wv_ * 64 + LANE_ID());
    { PH_TID(); ph_ret(p, bid, nb, t_); }
#if DUP == 5
    { PH_TID(); ph_ret(p, bid, nb, t_); }
#endif
    xcd_barrier(xb, wv_ * 64 + LANE_ID());
    { PH_TID(); ph_gemm_out(p, bid, nb, t_); }
#if DUP == 6
    { PH_TID(); ph_gemm_out(p, bid, nb, t_); }
#endif
    xcd_barrier(xb, wv_ * 64 + LANE_ID());
#if DUP == 7
    { PH_TID(); ph_route<true>(p, bid, nb, t_); }
#endif
#if DUP == 72
    { PH_TID(); ph_route<true, 2>(p, bid, nb, t_); }
#endif
#if DUP == 73
    { PH_TID(); ph_route<true, 3>(p, bid, nb, t_); }
#endif
    { PH_TID(); ph_route<false>(p, bid, nb, t_); }
    xcd_barrier(xb, wv_ * 64 + LANE_ID());
    { PH_TID(); ph_moe_up(p, bid, nb, t_); }
#if DUP == 8
    { PH_TID(); ph_moe_up(p, bid, nb, t_); }
#endif
    xcd_barrier(xb, wv_ * 64 + LANE_ID());
#if DUP == 9
    { PH_TID(); ph_moe_down<true>(p, bid, nb, t_); }
#endif
#if DUP == 91
    { PH_TID(); ph_moe_down<true, 1>(p, bid, nb, t_); }
#endif
    { PH_TID(); ph_moe_down<false>(p, bid, nb, t_); }
    xcd_barrier(xb, wv_ * 64 + LANE_ID());
#if DUP == 13
    { PH_TID(); ph_final<true>(p, bid, nb, t_); }
#endif
    { PH_TID(); ph_final<false>(p, bid, nb, t_); }
#undef PH_TID
#undef LANE_ID
}
constexpr int LDS_TOTAL = 163840;
extern "C" void kernel_launch(void* const* d_in, const int* in_sizes, int n_in, void* d_out, int out_size, void* d_ws, size_t ws_size, hipStream_t stream) {
    char* ws = (char*)d_ws;
    MK mk{};
    mk.x = (const float*)d_in[0]; mk.c = (const float*)d_in[1]; mk.ctx = (const float*)d_in[2]; mk.cctx = (const float*)d_in[3]; mk.ada_w = (const float*)d_in[4]; mk.ada_b = (const float*)d_in[5];
    mk.norm1_g = (const float*)d_in[6]; mk.w_in = (const float*)d_in[7]; mk.lq1 = (const float*)d_in[8]; mk.lk1 = (const float*)d_in[9]; mk.lq2 = (const float*)d_in[10]; mk.lk2 = (const float*)d_in[11];
    mk.dattn_g = (const float*)d_in[12]; mk.dec_f = (const float*)d_in[13]; mk.dec_b = (const float*)d_in[14]; mk.ret_g = (const float*)d_in[15]; mk.w_out = (const float*)d_in[16];
    mk.norm2_g = (const float*)d_in[17]; mk.router_w = (const float*)d_in[18]; mk.router_b = (const float*)d_in[19]; mk.ew1 = (const float*)d_in[20]; mk.ew3 = (const float*)d_in[21];
    mk.ew2 = (const float*)d_in[22]; mk.sw1 = (const float*)d_in[23]; mk.sw3 = (const float*)d_in[24]; mk.sw2 = (const float*)d_in[25]; mk.final_g = (const float*)d_in[26];
    mk.out = (float*)d_out;
    mk.ws = ws;
    mk.dbgP = nullptr; mk.dbg_lo = 0; mk.dbg_hi = 12; mk.conv_limit = 1 << 30;
    static int grid_blocks = 0;
    if (!grid_blocks) {
        (void)hipFuncSetAttribute((const void*)k_mega, hipFuncAttributeMaxDynamicSharedMemorySize, LDS_TOTAL);
        int dev = 0, cus = 0, per_cu = 0;
        (void)hipGetDevice(&dev);
        (void)hipDeviceGetAttribute(&cus, hipDeviceAttributeMultiprocessorCount, dev);
        (void)hipOccupancyMaxActiveBlocksPerMultiprocessor(&per_cu, k_mega, 512, LDS_TOTAL);
        if (per_cu > 1) per_cu = 1;
        grid_blocks = cus * per_cu;
        if (grid_blocks <= 0) { fprintf(stderr, "occupancy query failed: cus %d per_cu %d\n", cus, per_cu); grid_blocks = 256; }
    }
    (void)hipMemsetAsync(ws + 524288, 0, XCD_BAR_WORDS * 4, stream);
    void* args[] = {&mk};
    hipError_t e = hipLaunchCooperativeKernel((void*)k_mega, dim3(grid_blocks), dim3(512), args, LDS_TOTAL, stream);
    if (e != hipSuccess) fprintf(stderr, "cooperative launch failed: %s (grid %d)\n", hipGetErrorString(e), grid_blocks);
}
```

```cpp
#include <hip/hip_runtime.h>
#include <hip/hip_cooperative_groups.h>
#include <cstdio>
namespace cg = cooperative_groups;
#ifndef DUP
#define DUP 0
#endif
#include <stdint.h>

constexpr int D = 1024, NB = 4, SEQ = 8192, CTX = 256, RB = SEQ + CTX  , NR = NB * RB  , T = NB * SEQ;
constexpr int NE = 64, DE = 256, ECAP = 32768;
constexpr float EPS = 1e-6f;
typedef unsigned short bf16_t;

__device__ __forceinline__ float siluf(float v) { return v / (1.0f + expf(-v)); }
__device__ __forceinline__ float silu_fast(float v) { return v * __builtin_amdgcn_rcpf(1.0f + __builtin_amdgcn_exp2f(-1.4426950408889634f * v)); }
__device__ __forceinline__ float wave_sum(float v) {
#pragma unroll
    for (int o = 32; o > 0; o >>= 1) v += __shfl_xor(v, o);
    return v;
}
__device__ __forceinline__ float wave_max(float v) {
#pragma unroll
    for (int o = 32; o > 0; o >>= 1) v = fmaxf(v, __shfl_xor(v, o));
    return v;
}
__device__ __forceinline__ float block_sum(float v, float* red) {
    v = wave_sum(v);
    __syncthreads();
    if ((threadIdx.x & 63) == 0) red[threadIdx.x >> 6] = v;
    __syncthreads();
    return red[0] + red[1] + red[2] + red[3];
}
__device__ __forceinline__ float block_max(float v, float* red) {
    v = wave_max(v);
    __syncthreads();
    if ((threadIdx.x & 63) == 0) red[threadIdx.x >> 6] = v;
    __syncthreads();
    return fmaxf(fmaxf(red[0], red[1]), fmaxf(red[2], red[3]));
}

typedef short bf16x8 __attribute__((ext_vector_type(8)));
typedef short s16x4 __attribute__((ext_vector_type(4)));
typedef float f32x4 __attribute__((ext_vector_type(4)));
typedef float f32x16 __attribute__((ext_vector_type(16)));
typedef unsigned u32x2 __attribute__((ext_vector_type(2)));
typedef unsigned u32x4 __attribute__((ext_vector_type(4)));
extern __shared__ __attribute__((aligned(1024))) char smem[];
constexpr int NTHR = 512;
constexpr int GEMM_LDS = 131072;

__device__ __forceinline__ unsigned cvtpk(float lo, float hi) { unsigned r; asm volatile("v_cvt_pk_bf16_f32 %0, %1, %2" : "=v"(r) : "v"(lo), "v"(hi)); return r; }
__device__ __forceinline__ bf16_t f2bf(float v) { return (bf16_t)(cvtpk(v, v) & 0xffffu); }
__device__ __forceinline__ float bf2f(bf16_t v) { return __uint_as_float(((unsigned)v) << 16); }

constexpr size_t MiB = 1048576;
struct MK {
    const float *x, *c, *ctx, *cctx, *ada_w, *ada_b, *norm1_g, *w_in, *lq1, *lk1, *lq2, *lk2, *dattn_g, *dec_f, *dec_b, *ret_g, *w_out, *norm2_g, *router_w, *router_b,
        *ew1, *ew3, *ew2, *sw1, *sw3, *sw2, *final_g;
    float* out; char* ws;
    float* dbgP; long dbg_lo, dbg_hi; long conv_limit;
#define WSF(name, type, off) __device__ __forceinline__ type* name() const { return (type*)(ws + (off)); }
    WSF(mod, float, 0) WSF(cnt, int, 131072) WSF(ropec, float, 262144) WSF(ropes, float, 262144 + 8192)
    WSF(w_inT, bf16_t, 1 * MiB) WSF(w_outT, bf16_t, 7 * MiB) WSF(routerT, bf16_t, 9 * MiB) WSF(W2t, bf16_t, 9 * MiB + 524288)
    WSF(H, bf16_t, 42 * MiB) WSF(MIX, bf16_t, 42 * MiB) WSF(KV, bf16_t, 112 * MiB) WSF(ST, bf16_t, 147 * MiB) WSF(ACT, bf16_t, 42 * MiB)
    WSF(W13t, bf16_t, 194 * MiB) WSF(H2, bf16_t, 260 * MiB)
    WSF(Q, bf16_t, 260 * MiB) WSF(K, bf16_t, 292 * MiB) WSF(V, bf16_t, 325 * MiB) WSF(RQ, bf16_t, 358 * MiB) WSF(RK, bf16_t, 375 * MiB)
    WSF(KTf, bf16_t, 392 * MiB) WSF(KTb, bf16_t, 409 * MiB) WSF(VT, bf16_t, 426 * MiB) WSF(RG, bf16_t, 459 * MiB)
    WSF(Y, unsigned char, 194 * MiB) WSF(tok_list, int, 452 * MiB) WSF(wt_list, float, 460 * MiB) WSF(tokmap, int, 468 * MiB)
#undef WSF
};

__device__ __forceinline__ void ph_mod(const MK& p, int bid, int nb, int tid_l) {
    float* red = (float*)smem;
    for (int it = bid; it < 6 * D / 32; it += nb) {
        const int col = tid_l & 31, kg = tid_l >> 5, j = it * 32 + col;
        float a[5] = {0, 0, 0, 0, 0};
        for (int k = kg * 64; k < kg * 64 + 64; ++k) {
            float w = p.ada_w[(size_t)k * 6 * D + j];
#pragma unroll
            for (int r = 0; r < 5; ++r) { float cv = r < 4 ? p.c[r * D + k] : p.cctx[k]; a[r] += siluf(cv) * w; }
        }
        __syncthreads();
#pragma unroll
        for (int r = 0; r < 5; ++r) red[(kg * 5 + r) * 32 + col] = a[r];
        __syncthreads();
        if (tid_l < 160) {
            int r = tid_l >> 5; float s = 0;
            for (int g = 0; g < 16; ++g) s += red[(g * 5 + r) * 32 + col];
            p.mod()[(size_t)r * 6 * D + j] = s + p.ada_b[j];
        }
    }
    if (bid == nb - 1) {
        for (int i = tid_l; i < 128 * 16; i += NTHR) {
            int pos = i >> 4, f = i & 15;
            float inv_freq = (float)pow(10000.0, -(double)f / 16.0);
            float s, c; sincosf((float)pos * inv_freq, &s, &c);
            p.ropec()[i] = c; p.ropes()[i] = s;
        }
    }
    __syncthreads();
}

__device__ __forceinline__ void tr_tile(const float* src, int ldsrc, int k0, int n0, bf16_t* dst, int lddst, int mode  , bf16_t* dst2, int tid_l) {
    float* t = (float*)smem;
    __syncthreads();
    for (int i = tid_l; i < 64 * 16; i += NTHR) {
        int r = i >> 4, c4 = (i & 15) * 4;
        float4 v = *(const float4*)(src + (size_t)(k0 + r) * ldsrc + n0 + c4);
        t[r * 65 + c4] = v.x; t[r * 65 + c4 + 1] = v.y; t[r * 65 + c4 + 2] = v.z; t[r * 65 + c4 + 3] = v.w;
    }
    __syncthreads();
    for (int i = tid_l; i < 64 * 16; i += NTHR) {
        int n = i >> 4, k4 = (i & 15) * 4;
        float a = t[(k4 + 0) * 65 + n], b = t[(k4 + 1) * 65 + n], c = t[(k4 + 2) * 65 + n], d = t[(k4 + 3) * 65 + n];
        int nn = n0 + n, row = nn;
        if (mode == 1 || mode == 2) { int ct = nn >> 7; row = ct * 256 + (mode == 2 ? 128 : 0) + (nn & 127); }
        u32x2 w; w.x = cvtpk(a, b); w.y = cvtpk(c, d);
        *(u32x2*)(dst + (size_t)row * lddst + k0 + k4) = w;
        if (mode == 3) {
            float ah = bf2f((bf16_t)(w.x & 0xffff)), bh = bf2f((bf16_t)(w.x >> 16)), ch = bf2f((bf16_t)(w.y & 0xffff)), dh = bf2f((bf16_t)(w.y >> 16));
            u32x2 l; l.x = cvtpk(a - ah, b - bh); l.y = cvtpk(c - ch, d - dh);
            *(u32x2*)(dst2 + (size_t)row * lddst + k0 + k4) = l;
        }
    }
}
constexpr int CV_STATIC = 16 * 48 + 16 * 16 + 16, CV_E13 = 65 * 2 * 16 * 4, CV_E2 = 65 * 4 * 16, CV_TOTAL = CV_STATIC + CV_E13 + CV_E2;
__device__ __forceinline__ void convert_tile(const MK& p, int j, int tid_l) {
    const int n_win = 16 * 48, n_wout = 16 * 16, n_rt = 16;
    if (j < n_win) { tr_tile(p.w_in, 3072, (j / 48) * 64, (j % 48) * 64, p.w_inT(), 1024, 0, nullptr, tid_l); return; } j -= n_win;
    if (j < n_wout) { tr_tile(p.w_out, 1024, (j / 16) * 64, (j % 16) * 64, p.w_outT(), 1024, 0, nullptr, tid_l); return; } j -= n_wout;
    if (j < n_rt) { tr_tile(p.router_w, 64, j * 64, 0, p.routerT(), 1024, 3, p.routerT() + 64 * 1024, tid_l); return; } j -= n_rt;
    if (j < CV_E13) {
        int e = j / 128, r = j % 128, which = r / 64, tt = r % 64;
        const float* src = e < 64 ? (which ? p.ew3 : p.ew1) + (size_t)e * D * DE : (which ? p.sw3 : p.sw1);
        tr_tile(src, DE, (tt / 4) * 64, (tt % 4) * 64, p.W13t() + (size_t)e * 512 * 1024, 1024, 1 + which, nullptr, tid_l); return; } j -= CV_E13;
    { int e = j / 64, tt = j % 64;
      const float* src = e < 64 ? p.ew2 + (size_t)e * DE * D : p.sw2;
      tr_tile(src, D, (tt / 16) * 64, (tt % 16) * 64, p.W2t() + (size_t)e * 1024 * 256, 256, 0, nullptr, tid_l); }
}
__device__ __forceinline__ void ph_convert(const MK& p, int bid, int nb, int tid_l) {
    for (int it = bid; it < CV_STATIC; it += nb) convert_tile(p, it, tid_l);
    __syncthreads();
}
__device__ __forceinline__ void ph_convert_dyn(const MK& p, int tid_l) {
    int* q = (int*)smem + 8192;
    for (;;) {
        __syncthreads();
        if (tid_l == 0) q[0] = atomicAdd(&p.cnt()[200], 8);
        __syncthreads();
        const int base = q[0];
        if (base >= CV_E13 + CV_E2) break;
        for (int k = 0; k < 8; ++k) if (base + k < CV_E13 + CV_E2) convert_tile(p, CV_STATIC + base + k, tid_l);
    }
    __syncthreads();
}

__device__ __forceinline__ void ph_ln1(const MK& p, int bid, int nb, int tid_l) {
    const int wid = tid_l >> 6, lane = tid_l & 63;
    for (int R = bid * 8 + wid; R < NR; R += nb * 8) {
        int b = R / RB, i = R % RB;
        const float* src = i < CTX ? p.ctx + ((size_t)b * CTX + i) * D : p.x + ((size_t)b * SEQ + (i - CTX)) * D;
        const float* m = p.mod() + (size_t)(i < CTX ? 4 : b) * 6 * D;
        float4 v[4]; float ss = 0;
#pragma unroll
        for (int q = 0; q < 4; ++q) { v[q] = *(const float4*)(src + q * 256 + lane * 4); ss += v[q].x * v[q].x + v[q].y * v[q].y + v[q].z * v[q].z + v[q].w * v[q].w; }
        ss = wave_sum(ss);
        float rstd = rsqrtf(ss * (1.0f / D) + EPS);
#pragma unroll
        for (int q = 0; q < 4; ++q) {
            int c0 = q * 256 + lane * 4;
            float4 gg = *(const float4*)(p.norm1_g + c0), sh = *(const float4*)(m + c0), sc = *(const float4*)(m + D + c0);
            float o0 = v[q].x * rstd * gg.x * (1 + sc.x) + sh.x, o1 = v[q].y * rstd * gg.y * (1 + sc.y) + sh.y;
            float o2 = v[q].z * rstd * gg.z * (1 + sc.z) + sh.z, o3 = v[q].w * rstd * gg.w * (1 + sc.w) + sh.w;
            u32x2 w; w.x = cvtpk(o0, o1); w.y = cvtpk(o2, o3);
            *(u32x2*)(p.H() + (size_t)R * D + c0) = w;
        }
    }
}

__device__ __forceinline__ int lds_byte(int r, int c) { int st = (r >> 4) * 2 + (c >> 5), ob = (r & 15) * 64 + (c & 31) * 2; return st * 1024 + (ob ^ (((ob >> 9) & 1) << 5)); }
__device__ __forceinline__ void stage_rc(int b, int& R, int& C) { int st = b >> 10, sb = b & 1023, swz = sb ^ (((sb >> 9) & 1) << 5); R = (st / 2) * 16 + swz / 64; C = (st % 2) * 32 + (swz % 64) / 2; }
#define WAIT_V0() asm volatile("s_waitcnt vmcnt(0)" ::: "memory")
__device__ __forceinline__ void gemm_core(const char* Abase, const unsigned (&Ao)[4], const char* Bbase, const unsigned (&Bo)[4], int nt, f32x4 (&acc)[8][4], int tid_l, bool pre) {
    const int tid = tid_l, wid = tid >> 6, lane = tid & 63, wr = wid >> 2, wc = wid & 3, fr = lane & 15, fq = lane >> 4;
#pragma unroll
    for (int m = 0; m < 8; ++m)
#pragma unroll
        for (int n = 0; n < 4; ++n) acc[m][n] = (f32x4){0.f, 0.f, 0.f, 0.f};
#define G_SA(b) (smem + (b) * 32768)
#define G_SB(b) (smem + 65536 + (b) * 32768)
#define G_STAGE(buf, kt) do { _Pragma("unroll") for (int i = 0; i < 4; ++i) {                                                     \
        __builtin_amdgcn_global_load_lds((const unsigned*)(Abase + (Ao[i] + (unsigned)(kt) * 128u)), (unsigned*)(G_SA(buf) + wid * 1024 + i * 8192), 16, 0, 0); \
        __builtin_amdgcn_global_load_lds((const unsigned*)(Bbase + (Bo[i] + (unsigned)(kt) * 128u)), (unsigned*)(G_SB(buf) + wid * 1024 + i * 8192), 16, 0, 0); } } while (0)
    if (!pre) G_STAGE(0, 0);
    WAIT_V0(); __syncthreads();
#define G_KSTEP(cur, t) do {                                                                                                   \
        if ((t) + 1 < nt) G_STAGE((cur) ^ 1, (t) + 1);                                                                          \
        _Pragma("unroll") for (int ks = 0; ks < 2; ++ks) {                                                                      \
            bf16x8 At[8], Bf[4];                                                                                                \
            _Pragma("unroll") for (int m = 0; m < 8; ++m) At[m] = *(const bf16x8*)(G_SA(cur) + lds_byte(wr * 128 + m * 16 + fr, ks * 32 + fq * 8)); \
            _Pragma("unroll") for (int n = 0; n < 4; ++n) Bf[n] = *(const bf16x8*)(G_SB(cur) + lds_byte(wc * 64 + n * 16 + fr, ks * 32 + fq * 8));  \
            _Pragma("unroll") for (int m = 0; m < 8; ++m) _Pragma("unroll") for (int n = 0; n < 4; ++n)                         \
                acc[m][n] = __builtin_amdgcn_mfma_f32_16x16x32_bf16(Bf[n], At[m], acc[m][n], 0, 0, 0);                          \
            __builtin_amdgcn_sched_barrier(0);                                                                                  \
        }                                                                                                                       \
        WAIT_V0(); __syncthreads(); } while (0)
#pragma unroll 1
    for (int t = 0; t < nt; ++t) { const int cur = t & 1; G_KSTEP(cur, t); }
}
#ifndef XPREFETCH
#define XPREFETCH 0
#endif
__device__ __forceinline__ void gemm_prefetch(const char* Abase, const unsigned (&Ao)[4], const char* Bbase, const unsigned (&Bo)[4], int tid_l) {
    const int wid = tid_l >> 6;
    G_STAGE(0, 0);
}
__device__ __forceinline__ void stage_offs(unsigned ld_bytes, unsigned (&P)[4], int tid_l) {
    const int wid = tid_l >> 6, lane = tid_l & 63;
#pragma unroll
    for (int i = 0; i < 4; ++i) { int R, C; stage_rc(wid * 1024 + i * 8192 + lane * 16, R, C); P[i] = (unsigned)R * ld_bytes + (unsigned)C * 2u; }
}

constexpr int WAREA = 18432;
__device__ __forceinline__ char* wave_area(int wid) { return smem + wid * WAREA; }

constexpr int A_KVBLK = 64;
constexpr float A_SCALE = 0.125f, A_THR = 8.f;
constexpr int A_SHM_V = A_KVBLK * 128 * 2, A_SHM_K = A_KVBLK * 128 * 2;
#define KSWZ(row, colB) ((row) * 256 + ((colB) ^ (((row) & 7) << 4)))
#define SBAR() __builtin_amdgcn_sched_barrier(0)
__device__ __forceinline__ int crow(int r, int hi) { return (r & 3) + 8 * (r >> 2) + 4 * hi; }

constexpr float A_THRL = 11.0f;
template <bool FIRST> __device__ __forceinline__ void partialSM2(f32x16& p0, f32x16& p1, float& mhat, f32x16& negm, float& alpha) {
    float pmax = p0[0];
#pragma unroll
    for (int r = 1; r < 16; ++r) pmax = fmaxf(pmax, p0[r]);
#pragma unroll
    for (int r = 0; r < 16; ++r) pmax = fmaxf(pmax, p1[r]);
    { auto rr = __builtin_amdgcn_permlane32_swap(__float_as_uint(pmax), __float_as_uint(pmax), false, false);
      pmax = fmaxf(__uint_as_float(rr[0]), __uint_as_float(rr[1])); }
    alpha = 1.f;
    if (FIRST || __builtin_expect(__any(pmax > A_THRL), 0)) {
        const float dl = FIRST ? pmax : fmaxf(pmax, 0.f);
        mhat += dl;
#pragma unroll
        for (int r = 0; r < 16; ++r) { p0[r] -= dl; p1[r] -= dl; }
#pragma unroll
        for (int r = 0; r < 16; ++r) negm[r] = -mhat;
        if (!FIRST) alpha = __builtin_amdgcn_exp2f(-dl);
    }
#pragma unroll
    for (int r = 0; r < 16; ++r) p0[r] = __builtin_amdgcn_exp2f(p0[r]);
}
__device__ __forceinline__ void qkt2(f32x16& p0, f32x16& p1, const char* Ks, const bf16x8* qr, const f32x16& negm, int r32, int hi, int mapc) {
#pragma unroll
    for (int d0 = 0; d0 < 4; ++d0) { int cb = (mapc + d0 * 16 + hi * 8) * 2;
        bf16x8 b0 = *reinterpret_cast<const bf16x8*>(Ks + KSWZ(r32, cb));
        bf16x8 b1 = *reinterpret_cast<const bf16x8*>(Ks + KSWZ(32 + r32, cb));
        if (d0 == 0) { p0 = __builtin_amdgcn_mfma_f32_32x32x16_bf16(b0, qr[0], negm, 0, 0, 0); p1 = __builtin_amdgcn_mfma_f32_32x32x16_bf16(b1, qr[0], negm, 0, 0, 0); }
        else { p0 = __builtin_amdgcn_mfma_f32_32x32x16_bf16(b0, qr[d0], p0, 0, 0, 0); p1 = __builtin_amdgcn_mfma_f32_32x32x16_bf16(b1, qr[d0], p1, 0, 0, 0); } }
}
template <int PROBE = 0> __device__ __forceinline__ void partialSM(f32x16& p0, f32x16& p1, float& m_reg, float& mn, float& alpha) {
    constexpr float C = A_SCALE * 1.4426950408889634f;
    float pmax = p0[0];
#pragma unroll
    for (int r = 1; r < 16; ++r) pmax = fmaxf(pmax, p0[r]);
#pragma unroll
    for (int r = 0; r < 16; ++r) pmax = fmaxf(pmax, p1[r]);
    { auto rr = __builtin_amdgcn_permlane32_swap(__float_as_uint(pmax), __float_as_uint(pmax), false, false);
      pmax = fmaxf(__uint_as_float(rr[0]), __uint_as_float(rr[1])); }
    if (__builtin_expect(__all(pmax - m_reg <= A_THR / A_SCALE), 1)) { mn = m_reg; alpha = 1.f; }
    else { mn = fmaxf(m_reg, pmax); alpha = __builtin_amdgcn_exp2f((m_reg - mn) * C); m_reg = mn; }
    float mnC = -mn * C;
#pragma unroll
    for (int r = 0; r < 16; ++r) p0[r] = fmaf(p0[r], C, mnC);
#pragma unroll
    for (int r = 0; r < 16; ++r) p1[r] = fmaf(p1[r], C, mnC);
#pragma unroll
    for (int r = 0; r < 16; ++r) p0[r] = PROBE == 3 ? p0[r] * 1e-3f : __builtin_amdgcn_exp2f(p0[r]);
}
#define PK4(P, BASE, OUT) do { unsigned a0 = cvtpk(P[BASE + 0], P[BASE + 1]), a1 = cvtpk(P[BASE + 2], P[BASE + 3]);   \
    unsigned b0 = cvtpk(P[BASE + 4], P[BASE + 5]), b1 = cvtpk(P[BASE + 6], P[BASE + 7]);                              \
    auto r0 = __builtin_amdgcn_permlane32_swap(a0, b0, false, false); auto r1 = __builtin_amdgcn_permlane32_swap(a1, b1, false, false); \
    u32x4 w = {r0[0], r1[0], r0[1], r1[1]}; OUT = *reinterpret_cast<bf16x8*>(&w); } while (0)
template <int PROBE = 0, bool DIRECT = false> __device__ __forceinline__ void finishSM(f32x16& p0, f32x16& p1, float alpha, float& l_reg, bf16x8& pa0, bf16x8& pa1, bf16x8& pa2, bf16x8& pa3) {
#pragma unroll
    for (int r = 0; r < 16; ++r) p1[r] = PROBE == 3 ? p1[r] * 1e-3f : __builtin_amdgcn_exp2f(p1[r]);
    float ps = 0;
#pragma unroll
    for (int r = 0; r < 16; ++r) ps += p0[r];
#pragma unroll
    for (int r = 0; r < 16; ++r) ps += p1[r];
    { auto rr = __builtin_amdgcn_permlane32_swap(__float_as_uint(ps), __float_as_uint(ps), false, false);
      ps = __uint_as_float(rr[0]) + __uint_as_float(rr[1]); }
    l_reg = l_reg * alpha + ps;
    if (DIRECT) {
#define PKD(P, B, OUT) do { u32x4 w = {cvtpk(P[B], P[B + 1]), cvtpk(P[B + 2], P[B + 3]), cvtpk(P[B + 4], P[B + 5]), cvtpk(P[B + 6], P[B + 7])}; OUT = *reinterpret_cast<bf16x8*>(&w); } while (0)
        PKD(p0, 0, pa0); PKD(p0, 8, pa1); PKD(p1, 0, pa2); PKD(p1, 8, pa3);
#undef PKD
    } else { PK4(p0, 0, pa0); PK4(p0, 8, pa1); PK4(p1, 0, pa2); PK4(p1, 8, pa3); }
}
__device__ __forceinline__ void qkt(f32x16& p0, f32x16& p1, const char* Ks, const bf16x8* qr, int r32, int hi, int mapc) {
    p0 = f32x16{}; p1 = f32x16{};
#pragma unroll
    for (int d0 = 0; d0 < 4; ++d0) { int cb = (mapc + d0 * 16 + hi * 8) * 2;
        bf16x8 b0 = *reinterpret_cast<const bf16x8*>(Ks + KSWZ(r32, cb));
        bf16x8 b1 = *reinterpret_cast<const bf16x8*>(Ks + KSWZ(32 + r32, cb));
        p0 = __builtin_amdgcn_mfma_f32_32x32x16_bf16(b0, qr[d0], p0, 0, 0, 0);
        p1 = __builtin_amdgcn_mfma_f32_32x32x16_bf16(b1, qr[d0], p1, 0, 0, 0); }
}
__device__ __forceinline__ int v_st(int k, int c) { const int kk = (k & ~0xC) | ((k & 4) << 1) | ((k & 8) >> 1); return ((kk >> 3) * 4 + (c >> 5)) * 512 + ((kk & 7) * 32 + (c & 31)) * 2; }
__device__ __forceinline__ int v_rd_base(int lane) { return ((lane & 3) << 3) | (((lane >> 2) & 3) << 6) | (((lane >> 4) & 1) << 5) | (((lane >> 5) & 1) << 8); }
constexpr int v_rd_off(int d0, int ks, int half) { return d0 * 512 + ks * 4096 + half * 2048; }
template <int OFF> __device__ __forceinline__ s16x4 tr_read(int vb) {
    s16x4 r; asm volatile("ds_read_b64_tr_b16 %0, %1 offset:%2" : "=&v"(r) : "v"(vb), "i"(OFF) : "memory"); return r;
}
template <int D0> __device__ __forceinline__ void pv_one(f32x16& od, int vb, bf16x8 pa0, bf16x8 pa1, bf16x8 pa2, bf16x8 pa3) {
    const s16x4 l0 = tr_read<v_rd_off(D0, 0, 0)>(vb), h0 = tr_read<v_rd_off(D0, 0, 1)>(vb), l1 = tr_read<v_rd_off(D0, 1, 0)>(vb), h1 = tr_read<v_rd_off(D0, 1, 1)>(vb);
    const s16x4 l2 = tr_read<v_rd_off(D0, 2, 0)>(vb), h2 = tr_read<v_rd_off(D0, 2, 1)>(vb), l3 = tr_read<v_rd_off(D0, 3, 0)>(vb), h3 = tr_read<v_rd_off(D0, 3, 1)>(vb);
    asm volatile("s_waitcnt lgkmcnt(0)" ::: "memory"); SBAR();
#define PKV(L, H) (bf16x8){L[0], L[1], L[2], L[3], H[0], H[1], H[2], H[3]}
    od = __builtin_amdgcn_mfma_f32_32x32x16_bf16(pa0, PKV(l0, h0), od, 0, 0, 0);
    od = __builtin_amdgcn_mfma_f32_32x32x16_bf16(pa1, PKV(l1, h1), od, 0, 0, 0);
    od = __builtin_amdgcn_mfma_f32_32x32x16_bf16(pa2, PKV(l2, h2), od, 0, 0, 0);
    od = __builtin_amdgcn_mfma_f32_32x32x16_bf16(pa3, PKV(l3, h3), od, 0, 0, 0);
}
template <int D0> __device__ __forceinline__ void pv_two(f32x16& oa, f32x16& ob, int vb, bf16x8 pa0, bf16x8 pa1, bf16x8 pa2, bf16x8 pa3) {
    const s16x4 l0 = tr_read<v_rd_off(D0, 0, 0)>(vb), h0 = tr_read<v_rd_off(D0, 0, 1)>(vb), l1 = tr_read<v_rd_off(D0, 1, 0)>(vb), h1 = tr_read<v_rd_off(D0, 1, 1)>(vb);
    const s16x4 l2 = tr_read<v_rd_off(D0, 2, 0)>(vb), h2 = tr_read<v_rd_off(D0, 2, 1)>(vb), l3 = tr_read<v_rd_off(D0, 3, 0)>(vb), h3 = tr_read<v_rd_off(D0, 3, 1)>(vb);
    const s16x4 m0 = tr_read<v_rd_off(D0 + 1, 0, 0)>(vb), g0 = tr_read<v_rd_off(D0 + 1, 0, 1)>(vb), m1 = tr_read<v_rd_off(D0 + 1, 1, 0)>(vb), g1 = tr_read<v_rd_off(D0 + 1, 1, 1)>(vb);
    const s16x4 m2 = tr_read<v_rd_off(D0 + 1, 2, 0)>(vb), g2 = tr_read<v_rd_off(D0 + 1, 2, 1)>(vb), m3 = tr_read<v_rd_off(D0 + 1, 3, 0)>(vb), g3 = tr_read<v_rd_off(D0 + 1, 3, 1)>(vb);
    asm volatile("s_waitcnt lgkmcnt(0)" ::: "memory"); SBAR();
    oa = __builtin_amdgcn_mfma_f32_32x32x16_bf16(pa0, PKV(l0, h0), oa, 0, 0, 0);
    ob = __builtin_amdgcn_mfma_f32_32x32x16_bf16(pa0, PKV(m0, g0), ob, 0, 0, 0);
    oa = __builtin_amdgcn_mfma_f32_32x32x16_bf16(pa1, PKV(l1, h1), oa, 0, 0, 0);
    ob = __builtin_amdgcn_mfma_f32_32x32x16_bf16(pa1, PKV(m1, g1), ob, 0, 0, 0);
    oa = __builtin_amdgcn_mfma_f32_32x32x16_bf16(pa2, PKV(l2, h2), oa, 0, 0, 0);
    ob = __builtin_amdgcn_mfma_f32_32x32x16_bf16(pa2, PKV(m2, g2), ob, 0, 0, 0);
    oa = __builtin_amdgcn_mfma_f32_32x32x16_bf16(pa3, PKV(l3, h3), oa, 0, 0, 0);
    ob = __builtin_amdgcn_mfma_f32_32x32x16_bf16(pa3, PKV(m3, g3), ob, 0, 0, 0);
}
__device__ __forceinline__ void pv_d0(f32x16* o, int vb, bf16x8 pa0, bf16x8 pa1, bf16x8 pa2, bf16x8 pa3) {
    pv_one<0>(o[0], vb, pa0, pa1, pa2, pa3); pv_one<1>(o[1], vb, pa0, pa1, pa2, pa3); pv_one<2>(o[2], vb, pa0, pa1, pa2, pa3); pv_one<3>(o[3], vb, pa0, pa1, pa2, pa3);
}

template <int PROBE> __device__ __forceinline__ void attn_item(const bf16_t* __restrict__ Qb, const bf16_t* __restrict__ Kh, const bf16_t* __restrict__ Vh, bf16_t* __restrict__ mixrow,
                                          const float* __restrict__ gd, float lam, int tid_l) {
    char* lds = smem;
    const int tid = tid_l, wid = tid >> 6, lane = tid & 63, r32 = lane & 31, hi = lane >> 5;
    const int map = wid >> 2, wq = wid & 3, mapc = map * 64;
    char* K_lds = lds; char* V_lds = lds + 4 * A_SHM_K;
    float* wsw = (float*)(lds + 4 * A_SHM_V + 4 * A_SHM_K) + wid * 64; float* li_l = wsw; float* al_l = wsw + 32;
    float m_reg = 0.f, l_reg = 0; f32x16 o[4] = {}; bf16x8 qr[4]; f32x16 negm = f32x16{};
    const bf16_t* Qw = Qb + (long)(wq * 32 + r32) * 128 + mapc + hi * 8;
#pragma unroll
    for (int d0 = 0; d0 < 4; ++d0) qr[d0] = *reinterpret_cast<const bf16x8*>(Qw + d0 * 16);
    const int vb0 = (int)(uintptr_t)V_lds + v_rd_base(lane);
    unsigned kofs[2], vofs[2];
    const int widu = __builtin_amdgcn_readfirstlane(wid);
#pragma unroll
    for (int i = 0; i < 2; ++i) {
        const int x = wid * 1024 + i * 8192 + lane * 16;
        { const int row = x >> 8, cs = x & 255, colB = cs ^ ((row & 7) << 4); kofs[i] = (unsigned)(row * 256 + colB); }
        { const int sub = x >> 9, wn = x & 511, k = (sub >> 2) * 8 + (wn >> 6), c = (sub & 3) * 32 + ((wn & 63) >> 1); vofs[i] = (unsigned)(k * 256 + c * 2); }
    }
#define DMA_TILE(slot, k0) do { const char* kt_ = (const char*)Kh + (size_t)(k0) * 256; const char* vt_ = (const char*)Vh + (size_t)(k0) * 256;                  \
      _Pragma("unroll") for (int i = 0; i < 2; ++i) {                                                                   \
        __builtin_amdgcn_global_load_lds((const unsigned*)(kt_ + kofs[i]), (unsigned*)(K_lds + (slot) * A_SHM_K + widu * 1024 + i * 8192), 16, 0, 0); \
        __builtin_amdgcn_global_load_lds((const unsigned*)(vt_ + vofs[i]), (unsigned*)(V_lds + (slot) * A_SHM_V + widu * 1024 + i * 8192), 16, 0, 0); } } while (0)
#define RESC(a) do { if (__any((a) < 1.f)) { if (hi == 0) al_l[r32] = (a); asm volatile("s_waitcnt lgkmcnt(0)" ::: "memory"); \
    _Pragma("unroll") for (int d = 0; d < 4; ++d) _Pragma("unroll") for (int r = 0; r < 16; ++r) o[d][r] *= al_l[crow(r, hi)]; } } while (0)
    f32x16 pA0, pA1, pB0, pB1; float mnA, mnB, alA, alB; bf16x8 pa0, pa1, pa2, pa3; const int NT = RB / A_KVBLK;
    DMA_TILE(0, 0); DMA_TILE(1, A_KVBLK);
    asm volatile("s_waitcnt vmcnt(0)" ::: "memory"); __syncthreads();
    qkt2(pA0, pA1, K_lds, qr, negm, r32, hi, mapc); partialSM2<true>(pA0, pA1, m_reg, negm, alA);
#define ATILE(X0, X1, ALX, Y0, Y1, ALY, CS, PS, NS, T_, DODMA) do {                                                                  \
        asm volatile("s_waitcnt vmcnt(0)" ::: "memory"); __syncthreads();                                                            \
        if (DODMA && PROBE != 1) DMA_TILE(NS, ((T_) + 1) * A_KVBLK);                                                                 \
        SBAR(); qkt2(X0, X1, K_lds + (CS) * A_SHM_K, qr, negm, r32, hi, mapc);                                                       \
        finishSM<PROBE, true>(Y0, Y1, ALY, l_reg, pa0, pa1, pa2, pa3); SBAR();                                                       \
        pv_d0(o, vb0 + (PS) * A_SHM_V, pa0, pa1, pa2, pa3); partialSM2<false>(X0, X1, m_reg, negm, ALX);                             \
        RESC(ALX); } while (0)
#pragma unroll 1
    for (int j = 1; j + 3 < NT; j += 4) {
        ATILE(pB0, pB1, alB, pA0, pA1, alA, 1, 0, 2, j, true);
        ATILE(pA0, pA1, alA, pB0, pB1, alB, 2, 1, 3, j + 1, true);
        ATILE(pB0, pB1, alB, pA0, pA1, alA, 3, 2, 0, j + 2, true);
        ATILE(pA0, pA1, alA, pB0, pB1, alB, 0, 3, 1, j + 3, true);
    }
    ATILE(pB0, pB1, alB, pA0, pA1, alA, 1, 0, 2, NT - 3, true);
    ATILE(pA0, pA1, alA, pB0, pB1, alB, 2, 1, 3, NT - 2, true);
    ATILE(pB0, pB1, alB, pA0, pA1, alA, 3, 2, 0, NT - 1, false);
    finishSM<PROBE, true>(pB0, pB1, alB, l_reg, pa0, pa1, pa2, pa3); SBAR();
    pv_d0(o, vb0 + 3 * A_SHM_V, pa0, pa1, pa2, pa3);
#undef ATILE
#undef DMA_TILE
    if (hi == 0) li_l[r32] = l_reg;
    asm volatile("s_waitcnt lgkmcnt(0)" ::: "memory");
    float rl[16];
#pragma unroll
    for (int r = 0; r < 16; ++r) rl[r] = __builtin_amdgcn_rcpf(li_l[crow(r, hi)]);
    __syncthreads();
    {
        float* xo = (float*)lds + map * 16384 + (wq * 32) * 128 + r32;
#pragma unroll
        for (int r = 0; r < 16; ++r)
#pragma unroll
            for (int d0 = 0; d0 < 4; ++d0) xo[crow(r, hi) * 128 + d0 * 32] = o[d0][r] * rl[r];
    }
    __syncthreads();
    {
        int l2 = lane; asm volatile("" : "+v"(l2));
        const float g0 = gd[l2 * 2], g1 = gd[l2 * 2 + 1];
#pragma unroll 4
        for (int rr = 0; rr < 16; ++rr) {
            const int row = wid * 16 + rr;
            const float2 a0 = *(const float2*)((const float*)lds + row * 128 + l2 * 2), a1 = *(const float2*)((const float*)lds + 16384 + row * 128 + l2 * 2);
            const float xv = a0.x - lam * a1.x, yv = a0.y - lam * a1.y;
            const float ss = wave_sum(xv * xv + yv * yv);
            const float rs = rsqrtf(ss * (1.0f / 128) + EPS) * 0.8f;
            *(unsigned*)(mixrow + (long)row * 1024 + l2 * 2) = cvtpk(xv * rs * g0, yv * rs * g1);
        }
    }
    __syncthreads();
#undef RESC
}


template <int PROBE> __device__ __forceinline__ void ph_attn(const MK& p, int bid, int nb, int tid_l) {
    const int lane = tid_l & 63;
    float s1 = wave_sum(p.lq1[lane] * p.lk1[lane]), s2 = wave_sum(p.lq2[lane] * p.lk2[lane]);
    const float lam = expf(s1) - expf(s2) + 0.2f;
    const int nrounds = (1024 + nb - 1) / nb;
    for (int rr = 0; rr < nrounds; ++rr) {
        int item;
        if (nb == 256) { int x = bid & 7, j = bid >> 3, hh = rr * 8 + x; item = (hh >> 1) * 64 + (hh & 1) * 32 + j; }
        else { item = rr * nb + bid; if (item >= 1024) break; }
        const int bh = item >> 6, qb = item & 63, b = bh >> 2, h = bh & 3;
        attn_item<PROBE>(p.Q() + ((size_t)bh * SEQ + qb * 128) * 128, p.K() + (size_t)bh * RB * 128, p.V() + (size_t)bh * RB * 128,
                  PROBE ? (bf16_t*)(p.ws + 492 * MiB) + h * 128 : p.MIX() + ((size_t)(b * SEQ + qb * 128)) * 1024 + h * 128, p.dattn_g, lam, tid_l);
    }
}


__device__ __forceinline__ bf16x8 ldfrag(const bf16_t* p) { return *reinterpret_cast<const bf16x8*>(p); }

__device__ __forceinline__ void ph_kv(const MK& p, int bid, int nb, int tid_l) {
    const int wid = tid_l >> 6, lane = tid_l & 63, r32 = lane & 31, hi = lane >> 5;
    const int nitems = 16 * 2 * 66;
    for (int it = bid * 8 + wid; it < nitems; it += nb * 8) {
        const int c = it % 66, chain = it / 66, dir = chain & 1, bh = chain >> 1;
        const bf16_t* vt = p.VT() + (size_t)bh * 128 * RB + c * 128 + hi * 8;
        const bf16_t* kt = (dir ? p.KTb() : p.KTf()) + (size_t)bh * 64 * RB + c * 128 + hi * 8;
        f32x16 acc[4][2];
#pragma unroll
        for (int mt = 0; mt < 4; ++mt) { acc[mt][0] = f32x16{}; acc[mt][1] = f32x16{}; }
#pragma unroll 2
        for (int ks = 0; ks < 8; ++ks) {
            bf16x8 a[4], b[2];
#pragma unroll
            for (int mt = 0; mt < 4; ++mt) a[mt] = ldfrag(vt + (size_t)(mt * 32 + r32) * RB + ks * 16);
#pragma unroll
            for (int nt = 0; nt < 2; ++nt) b[nt] = ldfrag(kt + (size_t)(nt * 32 + r32) * RB + ks * 16);
#pragma unroll
            for (int mt = 0; mt < 4; ++mt)
#pragma unroll
                for (int nt = 0; nt < 2; ++nt) acc[mt][nt] = __builtin_amdgcn_mfma_f32_32x32x16_bf16(a[mt], b[nt], acc[mt][nt], 0, 0, 0);
        }
        bf16_t* dst = p.KV() + (size_t)it * 8192;
#pragma unroll
        for (int mt = 0; mt < 4; ++mt)
#pragma unroll
            for (int nt = 0; nt < 2; ++nt)
#pragma unroll
                for (int r = 0; r < 16; ++r) dst[(mt * 32 + crow(r, hi)) * 64 + nt * 32 + r32] = f2bf(acc[mt][nt][r]);
    }
}

__device__ __forceinline__ void ph_scan(const MK& p, int bid, int nb, int tid_l) {
    for (int e = bid * NTHR + tid_l; e < 32 * 8192; e += nb * NTHR) {
        const int chain = e >> 13, el = e & 8191, dir = chain & 1, bh = chain >> 1, h = bh & 3;
        const float d = dir ? p.dec_b[h] : p.dec_f[h];
        const float g128 = exp2f(128.0f * log2f(1.0f / (1.0f + expf(-d))));
        const bf16_t* kv = p.KV() + (size_t)chain * 66 * 8192 + el;
        bf16_t* st = p.ST() + (size_t)chain * 66 * 8192 + el;
        float S = 0.f;
        for (int n = 0; n < 66; ++n) {
            const int c = dir == 0 ? n : (n == 0 ? 1 : (n == 1 ? 0 : 67 - n));
            st[(size_t)c * 8192] = f2bf(S);
            S = fmaf(g128, S, bf2f(kv[(size_t)c * 8192]));
        }
    }
}

__device__ __forceinline__ void ph_ret(const MK& p, int bid, int nb, int tid_l) {
    const int tid = tid_l, wid = tid >> 6, lane = tid & 63, r32 = lane & 31, hi = lane >> 5, wq = wid & 3, half = wid >> 2;
    float* img = (float*)smem;
    for (int it = bid; it < 4 * 64 * 2; it += nb) {
        const int hp = it & 1, lc = (it >> 1) & 63, b = it >> 7, h = hp * 2 + half, bh = b * 4 + h;
        const int ib = CTX + lc * 128, c = 2 + lc;
        const float lf = log2f(1.0f / (1.0f + expf(-p.dec_f[h]))), lb = log2f(1.0f / (1.0f + expf(-p.dec_b[h])));
        const bf16_t* rq = p.RQ() + ((size_t)bh * RB + ib + wq * 32 + r32) * 64 + hi * 8;
        bf16x8 q[4];
#pragma unroll
        for (int ks = 0; ks < 4; ++ks) q[ks] = ldfrag(rq + ks * 16);
        f32x16 o[4];
        {
            const bf16_t* stf = p.ST() + ((size_t)(bh * 2 + 0) * 66 + c) * 8192 + hi * 8;
            const bf16_t* stb = p.ST() + ((size_t)(bh * 2 + 1) * 66 + c) * 8192 + hi * 8;
            {
                float rf[16];
#pragma unroll
                for (int r = 0; r < 16; ++r) rf[r] = __builtin_amdgcn_exp2f((float)(wq * 32 + crow(r, hi) + 1) * lf);
#pragma unroll
                for (int d0 = 0; d0 < 4; ++d0) {
                    f32x16 tf = f32x16{};
#pragma unroll
                    for (int ks = 0; ks < 4; ++ks) tf = __builtin_amdgcn_mfma_f32_32x32x16_bf16(q[ks], ldfrag(stf + (size_t)(d0 * 32 + r32) * 64 + ks * 16), tf, 0, 0, 0);
#pragma unroll
                    for (int r = 0; r < 16; ++r) o[d0][r] = tf[r] * rf[r];
                    asm volatile("" ::: "memory");
                }
            }
            {
                float rf[16];
#pragma unroll
                for (int r = 0; r < 16; ++r) rf[r] = __builtin_amdgcn_exp2f((float)(128 - (wq * 32 + crow(r, hi))) * lb);
#pragma unroll
                for (int d0 = 0; d0 < 4; ++d0) {
                    f32x16 tb = f32x16{};
#pragma unroll
                    for (int ks = 0; ks < 4; ++ks) tb = __builtin_amdgcn_mfma_f32_32x32x16_bf16(q[ks], ldfrag(stb + (size_t)(d0 * 32 + r32) * 64 + ks * 16), tb, 0, 0, 0);
#pragma unroll
                    for (int r = 0; r < 16; ++r) o[d0][r] += tb[r] * rf[r];
                    asm volatile("" ::: "memory");
                }
            }
        }
        {
            const int qi = wq * 32 + r32;
            const bf16_t* vt = p.VT() + (size_t)bh * 128 * RB + ib + hi * 8;
#pragma unroll 1
            for (int jb = 0; jb < 4; ++jb) {
                asm volatile("" ::: "memory");
                const bf16_t* rk = p.RK() + ((size_t)bh * RB + ib + jb * 32 + r32) * 64 + hi * 8;
                f32x16 pp = f32x16{};
#pragma unroll
                for (int ks = 0; ks < 4; ++ks) pp = __builtin_amdgcn_mfma_f32_32x32x16_bf16(ldfrag(rk + ks * 16), q[ks], pp, 0, 0, 0);
#pragma unroll
                for (int r = 0; r < 16; ++r) {
                    const int dd = qi - (jb * 32 + crow(r, hi));
                    const float ex = __builtin_amdgcn_exp2f(dd > 0 ? (float)dd * lf : (float)(-dd) * lb); const float w = dd == 0 ? 2.0f : ex;
                    pp[r] *= w;
                }
                bf16x8 pa0, pa1;
                PK4(pp, 0, pa0); PK4(pp, 8, pa1);
#pragma unroll
                for (int d0 = 0; d0 < 4; ++d0) {
                    o[d0] = __builtin_amdgcn_mfma_f32_32x32x16_bf16(pa0, ldfrag(vt + (size_t)(d0 * 32 + r32) * RB + jb * 32), o[d0], 0, 0, 0);
                    o[d0] = __builtin_amdgcn_mfma_f32_32x32x16_bf16(pa1, ldfrag(vt + (size_t)(d0 * 32 + r32) * RB + jb * 32 + 16), o[d0], 0, 0, 0);
                }
            }
        }
        __syncthreads();
        {
            float* xo = img + half * 16384 + (wq * 32) * 128 + r32;
#pragma unroll
            for (int r = 0; r < 16; ++r)
#pragma unroll
                for (int d0 = 0; d0 < 4; ++d0) xo[crow(r, hi) * 128 + d0 * 32] = o[d0][r];
        }
        __syncthreads();
        {
            const float g0 = p.ret_g[lane * 2], g1 = p.ret_g[lane * 2 + 1];
#pragma unroll 4
            for (int rr = 0; rr < 32; ++rr) {
                const int row = wid * 32 + rr, itl = row >> 7, rw = row & 127, hh = hp * 2 + itl;
                const float2 a = *(const float2*)(img + row * 128 + lane * 2);
                const float ss = wave_sum(a.x * a.x + a.y * a.y);
                const float rs = rsqrtf(ss * (1.0f / 128) + EPS);
                const size_t tt = (size_t)b * SEQ + lc * 128 + rw;
                const unsigned gg = *(const unsigned*)(p.RG() + tt * 512 + hh * 128 + lane * 2);
                const float ga = bf2f((bf16_t)(gg & 0xffff)), gb = bf2f((bf16_t)(gg >> 16));
                *(unsigned*)(p.MIX() + tt * 1024 + 512 + hh * 128 + lane * 2) = cvtpk(silu_fast(ga) * a.x * rs * g0, silu_fast(gb) * a.y * rs * g1);
            }
        }
    }
}


namespace pg8 {
constexpr int BM = 256, BK = 64, HALF = 128, HTB = HALF * BK * 2;
__device__ __forceinline__ int perm32(int rho) { const int n = rho >> 4, i = rho & 15; return 8 * (i >> 2) + 4 * n + (i & 3); }
struct GUnit { const char* A; const char* B; int i0, i1, i2, i3; };
template <class Epi, class Sched, bool GATHER, bool ALIGN_EPI>
__device__ __forceinline__ void gemm(int K, const Sched& S, const Epi& E, int tid_l) {
    const int tid = tid_l, wid = __builtin_amdgcn_readfirstlane(tid >> 6), lane = tid & 63, wr = wid >> 2, wc = wid & 3, fr = lane & 15, fq = lane >> 4;
    const int nt = K / BK;
    unsigned voffB[2], vAc[2][2], vAn[2][2];
    const size_t kstep = (size_t)(BK * 2);
    const size_t hstepB = (size_t)HALF * K * 2;
#pragma unroll
    for (int i = 0; i < 2; ++i) { int R, C; stage_rc(tid * 16 + i * 8192, R, C); const int Rb = Epi::PERM ? ((R & ~31) + perm32(R & 31)) : R;
        voffB[i] = (unsigned)(Rb * K + C) * 2u; }
    const unsigned ldsw = (unsigned)wid * 1024u;
    const int aoff = lds_byte(wr * 64 + fr, fq * 8), boff = lds_byte(wc * 32 + fr, fq * 8);
#define PG8_SA(b, h) (((b) * 2 + (h)) * HTB)
#define PG8_SB(b, h) ((4 + (b) * 2 + (h)) * HTB)
#define PG8_STAGE(bufoff, gbase, voff) do { _Pragma("unroll") for (int _i = 0; _i < 2; ++_i) \
        __builtin_amdgcn_global_load_lds((const unsigned*)((const char*)(gbase) + (voff)[_i]), (unsigned*)(smem + (bufoff) + ldsw + _i * 8192), 16, 0, 0); } while (0)
#define PG8_LDA(dst, b, h) do { _Pragma("unroll") for (int m = 0; m < 4; ++m) _Pragma("unroll") for (int k = 0; k < 2; ++k) dst[m][k] = *(const bf16x8*)(smem + PG8_SA(b, h) + aoff + m * 2048 + k * 1024); } while (0)
#define PG8_LDB(dst, b, h) do { _Pragma("unroll") for (int n = 0; n < 2; ++n) _Pragma("unroll") for (int k = 0; k < 2; ++k) dst[n][k] = *(const bf16x8*)(smem + PG8_SB(b, h) + boff + n * 2048 + k * 1024); } while (0)
#define PG8_MMA(ai, bj, At, Bt) do { __builtin_amdgcn_s_setprio(1); _Pragma("unroll") for (int m = 0; m < 4; ++m) _Pragma("unroll") for (int n = 0; n < 2; ++n) _Pragma("unroll") for (int k = 0; k < 2; ++k) \
        acc[ai][bj][m][n] = __builtin_amdgcn_mfma_f32_16x16x32_bf16(Bt[n][k], At[m][k], acc[ai][bj][m][n], 0, 0, 0); __builtin_amdgcn_s_setprio(0); } while (0)
#define PG8_WAIT_V(n) asm volatile("s_waitcnt vmcnt(" #n ")" ::: "memory")
#define PG8_WAIT_L(n) asm volatile("s_waitcnt lgkmcnt(" #n ")" ::: "memory")
#define PG8_BAR __builtin_amdgcn_s_barrier()
#define PG8_SCHED __builtin_amdgcn_sched_barrier(0)
    GUnit cur, nxt; int ui = 0;
    if (!S.next(0, cur, vAc)) return;
    f32x4 acc[2][2][4][2];
#pragma unroll
    for (int a = 0; a < 2; ++a)
#pragma unroll
        for (int b = 0; b < 2; ++b)
#pragma unroll
            for (int m = 0; m < 4; ++m)
#pragma unroll
                for (int n = 0; n < 2; ++n) acc[a][b][m][n] = (f32x4){0.f, 0.f, 0.f, 0.f};
    bf16x8 At[4][2], B0[2][2], B1[2][2];
    const char* cA = cur.A; const char* cB = cur.B;
    PG8_STAGE(PG8_SB(0, 0), cB, voffB); PG8_STAGE(PG8_SB(0, 1), cB + hstepB, voffB); PG8_STAGE(PG8_SA(0, 0), cA, vAc[0]); PG8_STAGE(PG8_SA(0, 1), cA, vAc[1]);
    if (wr == 1) PG8_BAR;
    PG8_WAIT_V(2); PG8_BAR;
    PG8_STAGE(PG8_SB(1, 0), cB + kstep, voffB); PG8_STAGE(PG8_SA(1, 0), cA + kstep, vAc[0]); PG8_STAGE(PG8_SB(1, 1), cB + hstepB + kstep, voffB);
    PG8_WAIT_V(6); PG8_BAR;
    for (;;) {
        const bool has_next = S.next(ui + 1, nxt, vAn);
        if (!GATHER || !has_next) {
#pragma unroll
            for (int h = 0; h < 2; ++h)
#pragma unroll
                for (int i = 0; i < 2; ++i) vAn[h][i] = vAc[h][i];
        }
        const char* nA = has_next ? nxt.A : cA; const char* nB = has_next ? nxt.B : cB;
#pragma unroll 1
        for (int t = 0; t < nt; t += 2) {
            const bool last = (t == nt - 2);
            const char* a1 = cA + (size_t)(t + 1) * kstep;
            const char* a2 = last ? nA : cA + (size_t)(t + 2) * kstep; const char* b2 = last ? nB : cB + (size_t)(t + 2) * kstep;
            const char* a3 = a2 + kstep; const char* b3 = b2 + kstep;
            unsigned va2[2][2];
#pragma unroll
            for (int h = 0; h < 2; ++h)
#pragma unroll
                for (int i = 0; i < 2; ++i) va2[h][i] = (GATHER && last) ? vAn[h][i] : vAc[h][i];
            PG8_LDB(B0, 0, 0); PG8_LDB(B1, 0, 1); PG8_SCHED; PG8_LDA(At, 0, 0); PG8_STAGE(PG8_SA(1, 1), a1, vAc[1]);
            PG8_WAIT_V(8); PG8_WAIT_L(0); PG8_BAR; PG8_MMA(0, 0, At, B0); PG8_MMA(0, 1, At, B1); PG8_BAR; PG8_SCHED;
            PG8_LDA(At, 0, 1); PG8_STAGE(PG8_SB(0, 0), b2, voffB); PG8_STAGE(PG8_SB(0, 1), b2 + hstepB, voffB); PG8_STAGE(PG8_SA(0, 0), a2, va2[0]);
            PG8_WAIT_V(8); PG8_WAIT_L(0); PG8_BAR; PG8_MMA(1, 0, At, B0); PG8_MMA(1, 1, At, B1); PG8_BAR; PG8_SCHED;
            PG8_LDB(B0, 1, 0); PG8_LDB(B1, 1, 1); PG8_SCHED; PG8_LDA(At, 1, 0); PG8_STAGE(PG8_SA(0, 1), a2, va2[1]);
            PG8_WAIT_V(8); PG8_WAIT_L(0); PG8_BAR; PG8_MMA(0, 0, At, B0); PG8_MMA(0, 1, At, B1); PG8_BAR; PG8_SCHED;
            PG8_LDA(At, 1, 1); PG8_STAGE(PG8_SB(1, 0), b3, voffB); PG8_STAGE(PG8_SB(1, 1), b3 + hstepB, voffB); PG8_STAGE(PG8_SA(1, 0), a3, va2[0]);
            PG8_WAIT_V(8); PG8_WAIT_L(0); PG8_BAR; PG8_MMA(1, 0, At, B0); PG8_MMA(1, 1, At, B1); PG8_BAR; PG8_SCHED;
        }
        if (ALIGN_EPI) { if (wr == 0) PG8_BAR; }
        E(acc, cur, wr, wc, fr, fq);
        if (!has_next) break;
#pragma unroll
        for (int a = 0; a < 2; ++a)
#pragma unroll
            for (int b = 0; b < 2; ++b)
#pragma unroll
                for (int m = 0; m < 4; ++m)
#pragma unroll
                    for (int n = 0; n < 2; ++n) acc[a][b][m][n] = (f32x4){0.f, 0.f, 0.f, 0.f};
        cur = nxt; cA = nA; cB = nB; ++ui;
#pragma unroll
        for (int h = 0; h < 2; ++h)
#pragma unroll
            for (int i = 0; i < 2; ++i) vAc[h][i] = vAn[h][i];
        if (ALIGN_EPI) { if (wr == 1) PG8_BAR; }
    }
    PG8_WAIT_V(0);
    if (!ALIGN_EPI) { if (wr == 0) PG8_BAR; }
    PG8_BAR;
#undef PG8_SA
#undef PG8_SB
#undef PG8_STAGE
#undef PG8_LDA
#undef PG8_LDB
#undef PG8_MMA
#undef PG8_WAIT_V
#undef PG8_WAIT_L
#undef PG8_BAR
#undef PG8_SCHED
}
__device__ __forceinline__ void plain_voffA(int K, unsigned (&vA)[2][2], int tid_l) {
#pragma unroll
    for (int i = 0; i < 2; ++i) { int R, C; stage_rc(tid_l * 16 + i * 8192, R, C); vA[0][i] = (unsigned)(R * K + C) * 2u; vA[1][i] = (unsigned)((R + HALF) * K + C) * 2u; }
}
}


struct SchedIn { const MK* p; int bid, nb, tid_l;
    __device__ __forceinline__ bool next(int i, pg8::GUnit& u, unsigned (&vA)[2][2]) const {
        const int tile = bid + i * nb; if (tile >= (NR / 256) * 12) return false;
        const int pm = tile / 12, pn = tile % 12;
        u.A = (const char*)(p->H() + (size_t)(pm * 256) * D); u.B = (const char*)(p->w_inT() + (size_t)(pn * 256) * D); u.i0 = pm; u.i1 = pn; u.i2 = 0; u.i3 = 0;
        pg8::plain_voffA(D, vA, tid_l); return true; } };
struct EpiIn { static constexpr bool PERM = false; const MK* p;
    __device__ __forceinline__ void operator()(f32x4 (&acc)[2][2][4][2], const pg8::GUnit& u, int wr, int wc, int fr_in, int fq_in) const {
        int fr = fr_in, fq = fq_in; asm volatile("" : "+v"(fr), "+v"(fq));
        const int pm = u.i0, seg = u.i1, brow = pm * 256;
        const int b = brow / RB, i0 = brow % RB;
        const bool lat = i0 >= CTX;
        const int wid = wr * 4 + wc, lane = fq * 16 + fr;
        if (lat && (seg <= 3 || seg == 6 || seg == 7)) {
#pragma unroll
            for (int ai = 0; ai < 2; ++ai)
#pragma unroll
                for (int m = 0; m < 4; ++m) {
                    const int t = i0 + ai * 128 + wr * 64 + m * 16 + fr - CTX, pos = (wc & 1) ? (t & 63) : (t >> 6);
                    const f32x4 cc = *(const f32x4*)(p->ropec() + pos * 16 + fq * 4), ss = *(const f32x4*)(p->ropes() + pos * 16 + fq * 4);
#pragma unroll
                    for (int bj = 0; bj < 2; ++bj) { const f32x4 x1 = acc[ai][bj][m][0], x2 = acc[ai][bj][m][1];
                        acc[ai][bj][m][0] = x1 * cc - x2 * ss; acc[ai][bj][m][1] = x1 * ss + x2 * cc; }
                }
        }
        if (seg == 7 || seg <= 1) {
            const float sc_ = seg == 7 ? 0.125f : 0.125f * 1.4426950408889634f;
#pragma unroll
            for (int ai = 0; ai < 2; ++ai)
#pragma unroll
                for (int bj = 0; bj < 2; ++bj)
#pragma unroll
                    for (int m = 0; m < 4; ++m) { acc[ai][bj][m][0] = acc[ai][bj][m][0] * sc_; acc[ai][bj][m][1] = acc[ai][bj][m][1] * sc_; }
        }
        if (seg <= 7 || seg >= 10) {
#pragma unroll
            for (int bj = 0; bj < 2; ++bj) {
                bf16_t* base; long rstride; bool ok = true;
                if (seg <= 1)      { const int h = (seg & 1) * 2 + bj;       base = p->Q() + (((size_t)(b * 4 + h) * SEQ + (i0 - CTX)) * 128 + wc * 32 + fq * 4); rstride = 128; ok = lat; }
                else if (seg <= 3) { const int h = (seg - 2) * 2 + bj;       base = p->K() + (((size_t)(b * 4 + h) * RB + i0) * 128 + wc * 32 + fq * 4);          rstride = 128; }
                else if (seg <= 5) { const int h = (seg - 4) * 2 + bj;       base = p->V() + (((size_t)(b * 4 + h) * RB + i0) * 128 + wc * 32 + fq * 4);          rstride = 128; }
                else if (seg == 6) { const int h = bj * 2 + (wc >> 1);       base = p->RQ() + (((size_t)(b * 4 + h) * RB + i0) * 64 + (wc & 1) * 32 + fq * 4);    rstride = 64; }
                else if (seg == 7) { const int h = bj * 2 + (wc >> 1);       base = p->RK() + (((size_t)(b * 4 + h) * RB + i0) * 64 + (wc & 1) * 32 + fq * 4);    rstride = 64; }
                else               {                                         base = p->RG() + ((size_t)(b * SEQ + (i0 - CTX)) * 512 + (seg - 10) * 256 + bj * 128 + wc * 32 + fq * 4); rstride = 512; ok = lat; }
                if (ok) {
#pragma unroll
                    for (int ai = 0; ai < 2; ++ai)
#pragma unroll
                        for (int m = 0; m < 4; ++m) { bf16_t* rp = base + (long)(ai * 128 + wr * 64 + m * 16 + fr) * rstride;
#pragma unroll
                            for (int n = 0; n < 2; ++n) { u32x2 w; w.x = cvtpk(acc[ai][bj][m][n][0], acc[ai][bj][m][n][1]); w.y = cvtpk(acc[ai][bj][m][n][2], acc[ai][bj][m][n][3]);
                                *(u32x2*)(rp + n * 16) = w; } }
                }
            }
        }
        if (seg >= 7 && seg <= 9) {
            char* img = smem + 131072 + wid * 3968;
            const int npass = seg == 7 ? 2 : 1;
#pragma unroll 1
            for (int ps = 0; ps < npass; ++ps) {
#pragma unroll
                for (int bj = 0; bj < 2; ++bj) {
                    float lg2 = 0.f; bf16_t* baseT;
                    if (seg == 7) { const int h = bj * 2 + (wc >> 1); const float dv = ps == 0 ? p->dec_f[h] : p->dec_b[h]; lg2 = log2f(1.0f / (1.0f + expf(-dv)));
                        baseT = (ps == 0 ? p->KTf() : p->KTb()) + ((size_t)(b * 4 + h) * 64 + (wc & 1) * 32) * RB + i0; }
                    else { const int h = (seg - 8) * 2 + bj; baseT = p->VT() + ((size_t)(b * 4 + h) * 128 + wc * 32) * RB + i0; }
#pragma unroll
                    for (int ai = 0; ai < 2; ++ai)
#pragma unroll
                        for (int mp = 0; mp < 2; ++mp) {
                            asm volatile("s_waitcnt lgkmcnt(0)" ::: "memory");
#pragma unroll
                            for (int mm = 0; mm < 2; ++mm) { const int m = mp * 2 + mm;
                                float f = 1.0f;
                                if (seg == 7) { const int pos = (i0 + ai * 128 + wr * 64 + m * 16 + fr) & 127; f = __builtin_amdgcn_exp2f((float)(ps == 0 ? 127 - pos : pos) * lg2); }
#pragma unroll
                                for (int n = 0; n < 2; ++n)
#pragma unroll
                                    for (int j = 0; j < 4; ++j) *(bf16_t*)(img + (n * 16 + fq * 4 + j) * 80 + (mm * 16 + fr) * 2) = f2bf(acc[ai][bj][m][n][j] * f); }
                            asm volatile("s_waitcnt lgkmcnt(0)" ::: "memory");
                            const int ib = ai * 128 + wr * 64 + mp * 32;
#pragma unroll
                            for (int k = 0; k < 2; ++k) { const int q = lane + 64 * k, col = q >> 2, ch = q & 3;
                                *(u32x4*)(baseT + (size_t)col * RB + ib + ch * 8) = *(const u32x4*)(img + col * 80 + ch * 16); }
                        }
                }
            }
        }
    } };
__device__ __forceinline__ void ph_gemm_in(const MK& p, int bid, int nb, int tid_l) {
    SchedIn S{&p, bid, nb, tid_l}; EpiIn E{&p};
    pg8::gemm<EpiIn, SchedIn, false, true>(D, S, E, tid_l);
}

struct SchedOut { const MK* p; int bid, nb, tid_l;
    __device__ __forceinline__ bool next(int i, pg8::GUnit& u, unsigned (&vA)[2][2]) const {
        const int tile = bid + i * nb; if (tile >= (T / 256) * 4) return false;
        const int pm = tile >> 2, pn = tile & 3;
        u.A = (const char*)(p->MIX() + (size_t)(pm * 256) * D); u.B = (const char*)(p->w_outT() + (size_t)(pn * 256) * D); u.i0 = pm; u.i1 = pn; u.i2 = 0; u.i3 = 0;
        pg8::plain_voffA(D, vA, tid_l); return true; } };
struct EpiOut { static constexpr bool PERM = false; const MK* p;
    __device__ __forceinline__ void operator()(const f32x4 (&acc)[2][2][4][2], const pg8::GUnit& u, int wr, int wc, int fr, int fq) const {
        const int brow = u.i0 * 256, bcol = u.i1 * 256;
        const float* g1 = p->mod() + (size_t)(brow / SEQ) * 6 * D + 2 * D + bcol + wc * 32 + fq * 4;
        f32x4 gv[2][2];
#pragma unroll
        for (int bj = 0; bj < 2; ++bj)
#pragma unroll
            for (int n = 0; n < 2; ++n) gv[bj][n] = *(const f32x4*)(g1 + bj * 128 + n * 16);
#pragma unroll
        for (int ai = 0; ai < 2; ++ai)
#pragma unroll
            for (int m = 0; m < 4; ++m) {
                const size_t o = (size_t)(brow + ai * 128 + wr * 64 + m * 16 + fr) * D + bcol + wc * 32 + fq * 4;
                f32x4 xv[2][2];
#pragma unroll
                for (int bj = 0; bj < 2; ++bj)
#pragma unroll
                    for (int n = 0; n < 2; ++n) xv[bj][n] = *(const f32x4*)(p->x + o + bj * 128 + n * 16);
#pragma unroll
                for (int bj = 0; bj < 2; ++bj)
#pragma unroll
                    for (int n = 0; n < 2; ++n) *(f32x4*)(p->out + o + bj * 128 + n * 16) = xv[bj][n] + gv[bj][n] * acc[ai][bj][m][n];
                if (m & 1) asm volatile("" ::: "memory");
            }
    } };
__device__ __forceinline__ void ph_gemm_out(const MK& p, int bid, int nb, int tid_l) {
    SchedOut S{&p, bid, nb, tid_l}; EpiOut E{&p};
    pg8::gemm<EpiOut, SchedOut, false, true>(D, S, E, tid_l);
}

template <bool DUMMY, int MODE = 0> __device__ __forceinline__ void ph_route(const MK& p, int bid, int nb, int tid_l) {
    int* cntp = p.cnt() + (DUMMY ? 128 : 0); int* tl = DUMMY ? (int*)(p.ws + 480 * MiB) : p.tok_list(); float* wl_ = DUMMY ? (float*)(p.ws + 488 * MiB) : p.wt_list(); int* tm = DUMMY ? (int*)(p.ws + 496 * MiB) : p.tokmap();
    const int tid = tid_l, wid = tid >> 6, lane = tid & 63, fr = lane & 15, fq = lane >> 4;
    float* lg = (float*)smem;
    int* wcnt = (int*)(smem + 34816);
    int* basel = wcnt + 128;
    bf16_t* H2lo = (bf16_t*)(p.ws + 325 * MiB);
    for (int item = bid; item < T / 128; item += nb) {
        const int t0 = item * 128 + wid * 16, b = (item * 128) / SEQ;
        const float* msh = p.mod() + (size_t)b * 6 * D + 3 * D; const float* msc = p.mod() + (size_t)b * 6 * D + 4 * D;
#pragma unroll 1
        for (int r0 = 0; r0 < 16; r0 += 4) {
            float4 xv[4][4];
#pragma unroll
            for (int rr = 0; rr < 4; ++rr)
#pragma unroll
                for (int q = 0; q < 4; ++q) xv[rr][q] = *(const float4*)(p.out + (size_t)(t0 + r0 + rr) * D + q * 256 + lane * 4);
#pragma unroll
            for (int rr = 0; rr < 4; ++rr) {
                float ss = 0.f;
#pragma unroll
                for (int q = 0; q < 4; ++q) ss += xv[rr][q].x * xv[rr][q].x + xv[rr][q].y * xv[rr][q].y + xv[rr][q].z * xv[rr][q].z + xv[rr][q].w * xv[rr][q].w;
                ss = wave_sum(ss);
                const float rstd = rsqrtf(ss * (1.0f / D) + EPS);
#pragma unroll
                for (int q = 0; q < 4; ++q) {
                    const int c0 = q * 256 + lane * 4;
                    const float4 gg = *(const float4*)(p.norm2_g + c0), sh = *(const float4*)(msh + c0), sc = *(const float4*)(msc + c0);
                    const float h0 = xv[rr][q].x * rstd * gg.x * (1 + sc.x) + sh.x, h1 = xv[rr][q].y * rstd * gg.y * (1 + sc.y) + sh.y;
                    const float h2v = xv[rr][q].z * rstd * gg.z * (1 + sc.z) + sh.z, h3 = xv[rr][q].w * rstd * gg.w * (1 + sc.w) + sh.w;
                    u32x2 wh, wl2; wh.x = cvtpk(h0, h1); wh.y = cvtpk(h2v, h3);
                    wl2.x = cvtpk(h0 - __uint_as_float(wh.x << 16), h1 - __uint_as_float(wh.x & 0xffff0000u));
                    wl2.y = cvtpk(h2v - __uint_as_float(wh.y << 16), h3 - __uint_as_float(wh.y & 0xffff0000u));
                    *(u32x2*)(p.H2() + (size_t)(t0 + r0 + rr) * D + c0) = wh;
                    *(u32x2*)(H2lo + (size_t)(t0 + r0 + rr) * D + c0) = wl2;
                }
            }
        }
        asm volatile("s_waitcnt vmcnt(0)" ::: "memory");
        __syncthreads();
        if (MODE == 3) continue;
        f32x4 acc[4];
#pragma unroll
        for (int nt = 0; nt < 4; ++nt) acc[nt] = (f32x4){0.f, 0.f, 0.f, 0.f};
        {
            const bf16_t* ah_p = p.H2() + (size_t)(t0 + fr) * D + fq * 8; const bf16_t* al_p = H2lo + (size_t)(t0 + fr) * D + fq * 8;
            const bf16_t* rT = p.routerT() + (size_t)fr * D + fq * 8;
#pragma unroll 4
            for (int ks = 0; ks < 32; ++ks) {
                const int k0 = ks * 32;
                const bf16x8 ah = ldfrag(ah_p + k0), al = ldfrag(al_p + k0);
#pragma unroll
                for (int nt = 0; nt < 4; ++nt) {
                    const bf16x8 bh = ldfrag(rT + (size_t)(nt * 16) * D + k0), bl = ldfrag(rT + (size_t)(64 + nt * 16) * D + k0);
                    acc[nt] = __builtin_amdgcn_mfma_f32_16x16x32_bf16(ah, bh, acc[nt], 0, 0, 0);
                    acc[nt] = __builtin_amdgcn_mfma_f32_16x16x32_bf16(ah, bl, acc[nt], 0, 0, 0);
                    acc[nt] = __builtin_amdgcn_mfma_f32_16x16x32_bf16(al, bh, acc[nt], 0, 0, 0);
                }
            }
        }
#pragma unroll
        for (int nt = 0; nt < 4; ++nt)
#pragma unroll
            for (int j = 0; j < 4; ++j) lg[(wid * 16 + fq * 4 + j) * 65 + nt * 16 + fr] = acc[nt][j];
        __syncthreads();
        if (MODE == 2) continue;
        float sc_[64]; unsigned long long ch = 0ull; float wscale = 0.f;
        const int tt = (wid & 1) * 64 + lane, t = item * 128 + tt;
        if (wid < 2) {
            float v[64];
#pragma unroll
            for (int e = 0; e < 64; ++e) { const float x = lg[tt * 65 + e]; sc_[e] = __builtin_amdgcn_rcpf(1.0f + __builtin_amdgcn_exp2f(-1.4426950408889634f * x)); v[e] = sc_[e] + p.router_b[e]; }
            float gs[8];
#pragma unroll
            for (int g = 0; g < 8; ++g) { float m1 = v[8 * g], m2 = -INFINITY;
#pragma unroll
                for (int i = 1; i < 8; ++i) { const float x = v[8 * g + i]; m2 = fmaxf(m2, fminf(m1, x)); m1 = fmaxf(m1, x); }
                gs[g] = m1 + m2; }
#pragma unroll
            for (int g = 0; g < 8; ++g) { int rank = 0;
#pragma unroll
                for (int g2 = 0; g2 < 8; ++g2) if (g2 != g) rank += (gs[g2] > gs[g] || (gs[g2] == gs[g] && g2 < g)) ? 1 : 0;
                if (rank >= 4) {
#pragma unroll
                    for (int i = 0; i < 8; ++i) v[8 * g + i] = -INFINITY; } }
#pragma unroll
            for (int it = 0; it < 8; ++it) {
                float m = v[0];
#pragma unroll
                for (int e = 1; e < 64; ++e) m = fmaxf(m, v[e]);
                bool found = false;
#pragma unroll
                for (int e = 0; e < 64; ++e) { const bool hit = !found && v[e] == m; if (hit) { ch |= (1ull << e); v[e] = -INFINITY; } found = found || hit; }
            }
            float wsum = 0.f;
#pragma unroll
            for (int e = 0; e < 64; ++e) wsum += ((ch >> e) & 1ull) ? sc_[e] : 0.f;
            wscale = 2.5f / wsum;
#pragma unroll
            for (int e = 0; e < 64; ++e) { const unsigned long long mk = __ballot((ch >> e) & 1ull); if (lane == 0) wcnt[wid * 64 + e] = __popcll(mk); }
        }
        __syncthreads();
        if (wid == 0) basel[lane] = atomicAdd(&cntp[lane], wcnt[lane] + wcnt[64 + lane]);
        __syncthreads();
        if (wid < 2) {
            int kidx = 0;
#pragma unroll
            for (int e = 0; e < 64; ++e) {
                const bool c = (ch >> e) & 1ull;
                const unsigned long long mk = __ballot(c);
                if (c) {
                    const int slot = basel[e] + (wid == 1 ? wcnt[e] : 0) + __popcll(mk & ((1ull << lane) - 1ull));
                    tl[(size_t)e * ECAP + slot] = t; wl_[(size_t)e * ECAP + slot] = sc_[e] * wscale;
                    tm[(size_t)t * 8 + kidx] = e * ECAP + slot; ++kidx;
                }
            }
        }
    }
}

constexpr int MOE_AUX = 162816;
__device__ __forceinline__ void moe_tables(const MK& p, int colt, int* tpre, int* rbase, int tid_l) {
    __syncthreads();
    if (tid_l == 0) { int tp = 0, rb = 0;
        for (int e = 0; e < 65; ++e) { const int c = e < 64 ? p.cnt()[e] : T; tpre[e] = tp; rbase[e] = rb; tp += ((c + 255) >> 8) * colt; rb += c; }
        tpre[65] = tp; rbase[65] = rb; }
    __syncthreads();
}
struct SchedUp { const MK* p; int bid, nb, tid_l, ntiles; const int* tpre; const int* rbase; mutable int e_hint;
    __device__ __forceinline__ bool next(int i, pg8::GUnit& u, unsigned (&vA)[2][2]) const {
        const int tile = bid + i * nb; if (tile >= ntiles) return false;
        int e = e_hint; while (tile >= tpre[e + 1]) ++e; e_hint = e;
        const int j = tile - tpre[e], rt = j >> 1, ct = j & 1, cnt_e = rbase[e + 1] - rbase[e];
        u.A = (const char*)p->H2(); u.B = (const char*)(p->W13t() + ((size_t)e * 512 + ct * 256) * D); u.i0 = e; u.i1 = rt; u.i2 = ct; u.i3 = cnt_e;
#pragma unroll
        for (int i2 = 0; i2 < 2; ++i2) { int R, C; stage_rc(tid_l * 16 + i2 * 8192, R, C);
#pragma unroll
            for (int h = 0; h < 2; ++h) { int slot = rt * 256 + h * 128 + R; if (slot >= cnt_e) slot = 0;
                const int tok = e < 64 ? p->tok_list()[(size_t)e * ECAP + slot] : slot;
                vA[h][i2] = (unsigned)tok * (D * 2u) + (unsigned)C * 2u; } }
        return true; } };
struct EpiUp { static constexpr bool PERM = true; const MK* p; const int* rbase;
    __device__ __forceinline__ void operator()(const f32x4 (&acc)[2][2][4][2], const pg8::GUnit& u, int wr, int wc, int fr, int fq) const {
        const int e = u.i0, rt = u.i1, ct = u.i2, cnt_e = u.i3;
        bf16_t* ab = p->ACT() + (size_t)rbase[e] * DE + ct * 128 + wc * 32 + fq * 8;
#pragma unroll
        for (int ai = 0; ai < 2; ++ai)
#pragma unroll
            for (int m = 0; m < 4; ++m) {
                const int slot = rt * 256 + ai * 128 + wr * 64 + m * 16 + fr;
                u32x4 w;
                w.x = cvtpk(silu_fast(acc[ai][0][m][0][0]) * acc[ai][1][m][0][0], silu_fast(acc[ai][0][m][0][1]) * acc[ai][1][m][0][1]);
                w.y = cvtpk(silu_fast(acc[ai][0][m][0][2]) * acc[ai][1][m][0][2], silu_fast(acc[ai][0][m][0][3]) * acc[ai][1][m][0][3]);
                w.z = cvtpk(silu_fast(acc[ai][0][m][1][0]) * acc[ai][1][m][1][0], silu_fast(acc[ai][0][m][1][1]) * acc[ai][1][m][1][1]);
                w.w = cvtpk(silu_fast(acc[ai][0][m][1][2]) * acc[ai][1][m][1][2], silu_fast(acc[ai][0][m][1][3]) * acc[ai][1][m][1][3]);
                if (slot < cnt_e) *(u32x4*)(ab + (size_t)slot * DE) = w;
            }
    } };
__device__ __forceinline__ void ph_moe_up(const MK& p, int bid, int nb, int tid_l) {
    int* tpre = (int*)(smem + MOE_AUX); int* rbase = tpre + 80;
    moe_tables(p, 2, tpre, rbase, tid_l);
    SchedUp S{&p, bid, nb, tid_l, tpre[65], tpre, rbase, 0}; EpiUp E{&p, rbase};
    pg8::gemm<EpiUp, SchedUp, true, true>(D, S, E, tid_l);
}
constexpr float Y_SCALE = 64.0f;
struct SchedDown { const MK* p; int bid, nb, tid_l, ntiles; const int* tpre; const int* rbase; mutable int e_hint;
    __device__ __forceinline__ bool next(int i, pg8::GUnit& u, unsigned (&vA)[2][2]) const {
        const int tile = bid + i * nb; if (tile >= ntiles) return false;
        int e = e_hint; while (tile >= tpre[e + 1]) ++e; e_hint = e;
        const int j = tile - tpre[e], rt = j >> 2, ct = j & 3, cnt_e = rbase[e + 1] - rbase[e];
        u.A = (const char*)(p->ACT() + (size_t)(rbase[e] + rt * 256) * DE); u.B = (const char*)(p->W2t() + ((size_t)e * D + ct * 256) * DE); u.i0 = e; u.i1 = rt; u.i2 = ct; u.i3 = cnt_e;
        pg8::plain_voffA(DE, vA, tid_l); return true; } };
template <int MODE> struct EpiDown { static constexpr bool PERM = true; const MK* p; const int* rbase;
    __device__ __forceinline__ void operator()(const f32x4 (&acc)[2][2][4][2], const pg8::GUnit& u, int wr, int wc, int fr, int fq) const {
        const int e = u.i0, rt = u.i1, ct = u.i2, cnt_e = u.i3;
        const int col0 = ct * 256 + wc * 32 + fq * 8;
        if (e < 64) {
            const float* wl = p->wt_list() + (size_t)e * ECAP;
            float wv[2][4];
#pragma unroll
            for (int ai = 0; ai < 2; ++ai)
#pragma unroll
                for (int m = 0; m < 4; ++m) { const int sl = rt * 256 + ai * 128 + wr * 64 + m * 16 + fr; wv[ai][m] = wl[sl < cnt_e ? sl : 0] * Y_SCALE; }
            const int wid = wr * 4 + wc, lane = fq * 16 + fr;
            char* wa = smem + 131072 + wid * 3968;
            unsigned char* yb = p->Y() + (size_t)rbase[e] * D + ct * 256 + wc * 64 + (lane & 3) * 16;
#pragma unroll
            for (int ai = 0; ai < 2; ++ai)
#pragma unroll
                for (int m = 0; m < 4; ++m) {
                    const float w = wv[ai][m];
                    char* img = wa + ((m & 1) ? 1280 : 0);
#pragma unroll
                    for (int bj = 0; bj < 2; ++bj) {
                        u32x2 pk;
#pragma unroll
                        for (int n = 0; n < 2; ++n) {
                            float v0 = __builtin_amdgcn_fmed3f(acc[ai][bj][m][n][0] * w, -448.f, 448.f), v1 = __builtin_amdgcn_fmed3f(acc[ai][bj][m][n][1] * w, -448.f, 448.f);
                            float v2 = __builtin_amdgcn_fmed3f(acc[ai][bj][m][n][2] * w, -448.f, 448.f), v3 = __builtin_amdgcn_fmed3f(acc[ai][bj][m][n][3] * w, -448.f, 448.f);
                            int q = 0; q = __builtin_amdgcn_cvt_pk_fp8_f32(v0, v1, q, false); q = __builtin_amdgcn_cvt_pk_fp8_f32(v2, v3, q, true);
                            if (n == 0) pk.x = (unsigned)q; else pk.y = (unsigned)q;
                        }
                        *(u32x2*)(img + fr * 80 + bj * 32 + fq * 8) = pk;
                    }
                    asm volatile("s_waitcnt lgkmcnt(0)" ::: "memory");
                    const int rr = lane >> 2, slot = rt * 256 + ai * 128 + wr * 64 + m * 16 + rr;
                    const u32x4 v = *(const u32x4*)(img + rr * 80 + (lane & 3) * 16);
                    if (MODE == 1) asm volatile("" :: "v"(v)); else if (slot < cnt_e) *(u32x4*)(yb + (size_t)slot * D) = v;
                }
        } else {
            const float* g2 = p->mod() + (size_t)((rt * 256) / SEQ) * 6 * D + 5 * D + col0;
            f32x4 gv[2][2];
#pragma unroll
            for (int bj = 0; bj < 2; ++bj)
#pragma unroll
                for (int n = 0; n < 2; ++n) gv[bj][n] = *(const f32x4*)(g2 + bj * 128 + n * 4);
            float* xb = p->out + (size_t)(rt * 256) * D + col0;
#pragma unroll
            for (int ai = 0; ai < 2; ++ai)
#pragma unroll
                for (int m = 0; m < 4; ++m) {
                    float* xp = xb + (size_t)(ai * 128 + wr * 64 + m * 16 + fr) * D;
                    f32x4 xv[2][2];
#pragma unroll
                    for (int bj = 0; bj < 2; ++bj)
#pragma unroll
                        for (int n = 0; n < 2; ++n) xv[bj][n] = *(const f32x4*)(xp + bj * 128 + n * 4);
#pragma unroll
                    for (int bj = 0; bj < 2; ++bj)
#pragma unroll
                        for (int n = 0; n < 2; ++n) *(f32x4*)(xp + bj * 128 + n * 4) = xv[bj][n] + gv[bj][n] * acc[ai][bj][m][n];
                    if (m & 1) asm volatile("" ::: "memory");
                }
        }
    } };
template <bool DUMMY, int MODE = 0> __device__ __forceinline__ void ph_moe_down(const MK& p, int bid, int nb, int tid_l) {
    int* tpre = (int*)(smem + MOE_AUX); int* rbase = tpre + 80;
    moe_tables(p, 4, tpre, rbase, tid_l);
    SchedDown S{&p, bid, nb, tid_l, DUMMY ? tpre[64] : tpre[65], tpre, rbase, 0}; EpiDown<MODE> E{&p, rbase};
    pg8::gemm<EpiDown<MODE>, SchedDown, false, true>(DE, S, E, tid_l);
}

template <bool DUMMY> __device__ __forceinline__ void ph_final(const MK& p, int bid, int nb, int tid_l) {
    const int wid = tid_l >> 6, lane = tid_l & 63;
    int* tpre = (int*)(smem + MOE_AUX); int* rbase = tpre + 80;
    moe_tables(p, 1, tpre, rbase, tid_l);
    for (int t = bid * 8 + wid; t < T; t += nb * 8) {
        const int b = t / SEQ;
        float f[16];
#pragma unroll
        for (int i = 0; i < 16; ++i) f[i] = 0.f;
#pragma unroll
        for (int k = 0; k < 8; ++k) {
            const int id = p.tokmap()[(size_t)t * 8 + k], e = id >> 15, slot = id & (ECAP - 1);
            const unsigned char* yr = p.Y() + (size_t)(rbase[e] + slot) * D + lane * 4;
#pragma unroll
            for (int q = 0; q < 4; ++q) {
                const int w = *(const int*)(yr + q * 256);
                const auto lo = __builtin_amdgcn_cvt_pk_f32_fp8(w, false); const auto hi = __builtin_amdgcn_cvt_pk_f32_fp8(w, true);
                f[q * 4 + 0] += lo[0]; f[q * 4 + 1] += lo[1]; f[q * 4 + 2] += hi[0]; f[q * 4 + 3] += hi[1];
            }
        }
        const int pcol = ((lane >> 3) & 1) * 128 + (lane >> 4) * 32 + (lane & 7) * 4;
        const float* g2 = p.mod() + (size_t)b * 6 * D + 5 * D + pcol;
        float* xo = p.out + (size_t)t * D + pcol;
        float v[16]; float ss = 0.f;
#pragma unroll
        for (int q = 0; q < 4; ++q) {
            const float4 xv = *(const float4*)(xo + q * 256), g = *(const float4*)(g2 + q * 256);
            v[q * 4 + 0] = xv.x + g.x * f[q * 4 + 0] * (1.0f / Y_SCALE); v[q * 4 + 1] = xv.y + g.y * f[q * 4 + 1] * (1.0f / Y_SCALE);
            v[q * 4 + 2] = xv.z + g.z * f[q * 4 + 2] * (1.0f / Y_SCALE); v[q * 4 + 3] = xv.w + g.w * f[q * 4 + 3] * (1.0f / Y_SCALE);
            ss += v[q * 4] * v[q * 4] + v[q * 4 + 1] * v[q * 4 + 1] + v[q * 4 + 2] * v[q * 4 + 2] + v[q * 4 + 3] * v[q * 4 + 3];
        }
        ss = wave_sum(ss);
        const float rstd = rsqrtf(ss * (1.0f / D) + EPS);
#pragma unroll
        for (int q = 0; q < 4; ++q) {
            const float4 gf = *(const float4*)(p.final_g + q * 256 + pcol);
            *(float4*)((DUMMY ? (float*)(p.ws + 42 * MiB) + (size_t)t * D + pcol : xo) + q * 256) = make_float4(v[q * 4] * rstd * gf.x, v[q * 4 + 1] * rstd * gf.y, v[q * 4 + 2] * rstd * gf.z, v[q * 4 + 3] * rstd * gf.w);
        }
    }
}


#define XB_TMO      128
#define XB_XCNT(j)  (256  + 64 * (j))
#define XB_XSUB(j)  (1280 + 64 * (j))
#define XB_XGEN(j)  (2304 + 64 * (j))
#define XB_TOP      3328
#define XB_TOPGEN   3392
#define XCD_BAR_WORDS 3456
#define XB_SPIN_CAP (1u << 22)
#define LAS __attribute__((address_space(3)))
__device__ __forceinline__ unsigned xb_ld(unsigned* p)              { return __hip_atomic_load(p, __ATOMIC_RELAXED, __HIP_MEMORY_SCOPE_AGENT); }
__device__ __forceinline__ unsigned xb_add(unsigned* p, unsigned v) { return __hip_atomic_fetch_add(p, v, __ATOMIC_RELAXED, __HIP_MEMORY_SCOPE_AGENT); }
__device__ __forceinline__ unsigned xb_xcc_id() { return (unsigned)__builtin_amdgcn_s_getreg((3 << 11) | 20) & 0xFu; }
#define XB_SPIN(cond, bar) do { unsigned _sp = 0; while (cond) { __builtin_amdgcn_s_sleep(1); \
    if ((++_sp & 255u) == 0u) { if (xb_ld(&(bar)[XB_TMO])) break; if (_sp > XB_SPIN_CAP) { atomicAdd(&(bar)[XB_TMO], 1u); break; } } } } while (0)
struct XcdBarrier { unsigned* bar; unsigned x; volatile LAS unsigned* st; };
__device__ __forceinline__ XcdBarrier xcd_barrier_post(unsigned* bar, volatile LAS unsigned* st, int tid) {
    XcdBarrier b; b.bar = bar; b.x = xb_xcc_id(); b.st = st;
    if (tid == 0) (void)xb_add(&bar[XB_XCNT(b.x)], 1u);
    return b;
}
__device__ __forceinline__ void xcd_barrier_complete(unsigned* bar, unsigned x, unsigned& nloc, unsigned& nx) {
    const unsigned G = gridDim.x * gridDim.y * gridDim.z;
    unsigned sum, cnt, mine, sp = 0u;
    for (;;) {
        sum = 0u; cnt = 0u; mine = 0u;
#pragma unroll
        for (unsigned j = 0; j < 16; ++j) { const unsigned c = xb_ld(&bar[XB_XCNT(j)]); sum += c; cnt += (c > 0u) ? 1u : 0u; mine = (j == x) ? c : mine; }
        if (sum == G) break;
        __builtin_amdgcn_s_sleep(1);
        if ((++sp & 255u) == 0u) { if (xb_ld(&bar[XB_TMO])) break; if (sp > XB_SPIN_CAP) { atomicAdd(&bar[XB_TMO], 1u); break; } }
    }
    nloc = mine > 0u ? mine : 1u; nx = cnt > 0u ? cnt : 1u;
}
__device__ __forceinline__ void xcd_barrier(const XcdBarrier& b, int tid) {
    asm volatile("s_waitcnt vmcnt(0)" ::: "memory");
    __syncthreads();
    if (tid == 0) {
        unsigned* bar = b.bar;
        __builtin_amdgcn_s_waitcnt(0);
        unsigned nloc = b.st[0], nx = b.st[1];
        if (nloc == 0u) { xcd_barrier_complete(bar, b.x, nloc, nx); b.st[0] = nloc; b.st[1] = nx; }
        const unsigned old = xb_add(&bar[XB_XSUB(b.x)], 1u);
        const unsigned gen = old / nloc;
        if (old + 1u == (gen + 1u) * nloc) {
            __builtin_amdgcn_fence(__ATOMIC_RELEASE, "agent");
            asm volatile("s_waitcnt vmcnt(0)" ::: "memory");
            const unsigned og = xb_add(&bar[XB_TOP], 1u);
            const unsigned tg = og / nx;
            if (og + 1u == (tg + 1u) * nx) xb_add(&bar[XB_TOPGEN], 1u);
            else XB_SPIN(xb_ld(&bar[XB_TOPGEN]) == tg, bar);
            __builtin_amdgcn_fence(__ATOMIC_ACQUIRE, "agent");
            xb_add(&bar[XB_XGEN(b.x)], 1u);
            asm volatile("s_waitcnt vmcnt(0)" ::: "memory");
        } else {
            XB_SPIN(xb_ld(&bar[XB_XGEN(b.x)]) == gen, bar);
            __builtin_amdgcn_fence(__ATOMIC_ACQUIRE, "agent");
            asm volatile("s_waitcnt vmcnt(0)" ::: "memory");
        }
    }
    __syncthreads();
}

__device__ __forceinline__ int lane_id_volatile() { int l; asm volatile("v_mbcnt_lo_u32_b32 %0, -1, 0\n\tv_mbcnt_hi_u32_b32 %0, -1, %0" : "=v"(l)); return l; }
__global__ __launch_bounds__(512, 2) void k_mega(MK p) {
    cg::grid_group grid = cg::this_grid();
    const int bid = blockIdx.x, nb = gridDim.x;
    volatile LAS unsigned* xst = (volatile LAS unsigned*)(smem + 162816 + 768);
    if (threadIdx.x < 4) xst[threadIdx.x] = 0u;
    __syncthreads();
    const XcdBarrier xb = xcd_barrier_post((unsigned*)(p.ws + 524288), xst, (int)threadIdx.x);
    const int wv_ = __builtin_amdgcn_readfirstlane((int)threadIdx.x >> 6);
#define LANE_ID() lane_id_volatile()
#define PH_TID() int t_ = wv_ * 64 + LANE_ID(); asm volatile("" : "+v"(t_))
    { PH_TID(); if (bid == 0 && t_ < 256) p.cnt()[t_] = 0; ph_mod(p, bid, nb, t_); ph_convert(p, bid, nb, t_); }
#if DUP == 10
    { PH_TID(); ph_convert(p, bid, nb, t_); }
#endif
    grid.sync();
    { PH_TID(); ph_ln1(p, bid, nb, t_); }
#if DUP == 1
    { PH_TID(); ph_ln1(p, bid, nb, t_); }
#endif
    xcd_barrier(xb, wv_ * 64 + LANE_ID());
    { PH_TID(); ph_gemm_in(p, bid, nb, t_); }
    { PH_TID(); ph_convert_dyn(p, t_); }
#if DUP == 2
    { PH_TID(); ph_gemm_in(p, bid, nb, t_); }
#endif
    xcd_barrier(xb, wv_ * 64 + LANE_ID());
    { PH_TID(); ph_attn<0>(p, bid, nb, t_); }
#if DUP == 3
    { PH_TID(); ph_attn<2>(p, bid, nb, t_); }
#endif
#if DUP == 31
    { PH_TID(); ph_attn<1>(p, bid, nb, t_); }
#endif
#if DUP == 33
    { PH_TID(); ph_attn<3>(p, bid, nb, t_); }
#endif
    { PH_TID(); ph_kv(p, bid, nb, t_); }
#if DUP == 11
    { PH_TID(); ph_kv(p, bid, nb, t_); }
#endif
    xcd_barrier(xb, wv_ * 64 + LANE_ID());
    { PH_TID(); ph_scan(p, bid, nb, t_); }
    xcd_barrier(xb, wv_ * 64 + LANE_ID());
    { PH_TID(); ph_ret(p, bid, nb, t_); }
#if DUP == 5
    { PH_TID(); ph_ret(p, bid, nb, t_); }
#endif
    xcd_barrier(xb, wv_ * 64 + LANE_ID());
    { PH_TID(); ph_gemm_out(p, bid, nb, t_); }
#if DUP == 6
    { PH_TID(); ph_gemm_out(p, bid, nb, t_); }
#endif
    xcd_barrier(xb, wv_ * 64 + LANE_ID());
#if DUP == 7
    { PH_TID(); ph_route<true>(p, bid, nb, t_); }
#endif
#if DUP == 72
    { PH_TID(); ph_route<true, 2>(p, bid, nb, t_); }
#endif
#if DUP == 73
    { PH_TID(); ph_route<true, 3>(p, bid, nb, t_); }
#endif
    { PH_TID(); ph_route<false>(p, bid, nb, t_); }
    xcd_barrier(xb, wv_ * 64 + LANE_ID());
    { PH_TID(); ph_moe_up(p, bid, nb, t_); }
#if DUP == 8
    { PH_TID(); ph_moe_up(p, bid, nb, t_); }
#endif
    xcd_barrier(xb, wv_ * 64 + LANE_ID());
#if DUP == 9
    { PH_TID(); ph_moe_down<true>(p, bid, nb, t_); }
#endif
#if DUP == 91
    { PH_TID(); ph_moe_down<true, 1>(p, bid, nb, t_); }
#endif
    { PH_TID(); ph_moe_down<false>(p, bid, nb, t_); }
    xcd_barrier(xb, wv_ * 64 + LANE_ID());
#if DUP == 13
    { PH_TID(); ph_final<true>(p, bid, nb, t_); }
#endif
    { PH_TID(); ph_final<false>(p, bid, nb, t_); }
#undef PH_TID
#undef LANE_ID
}
constexpr int LDS_TOTAL = 163840;
extern "C" void kernel_launch(void* const* d_in, const int* in_sizes, int n_in, void* d_out, int out_size, void* d_ws, size_t ws_size, hipStream_t stream) {
    char* ws = (char*)d_ws;
    MK mk{};
    mk.x = (const float*)d_in[0]; mk.c = (const float*)d_in[1]; mk.ctx = (const float*)d_in[2]; mk.cctx = (const float*)d_in[3]; mk.ada_w = (const float*)d_in[4]; mk.ada_b = (const float*)d_in[5];
    mk.norm1_g = (const float*)d_in[6]; mk.w_in = (const float*)d_in[7]; mk.lq1 = (const float*)d_in[8]; mk.lk1 = (const float*)d_in[9]; mk.lq2 = (const float*)d_in[10]; mk.lk2 = (const float*)d_in[11];
    mk.dattn_g = (const float*)d_in[12]; mk.dec_f = (const float*)d_in[13]; mk.dec_b = (const float*)d_in[14]; mk.ret_g = (const float*)d_in[15]; mk.w_out = (const float*)d_in[16];
    mk.norm2_g = (const float*)d_in[17]; mk.router_w = (const float*)d_in[18]; mk.router_b = (const float*)d_in[19]; mk.ew1 = (const float*)d_in[20]; mk.ew3 = (const float*)d_in[21];
    mk.ew2 = (const float*)d_in[22]; mk.sw1 = (const float*)d_in[23]; mk.sw3 = (const float*)d_in[24]; mk.sw2 = (const float*)d_in[25]; mk.final_g = (const float*)d_in[26];
    mk.out = (float*)d_out;
    mk.ws = ws;
    mk.dbgP = nullptr; mk.dbg_lo = 0; mk.dbg_hi = 12; mk.conv_limit = 1 << 30;
    static int grid_blocks = 0;
    if (!grid_blocks) {
        (void)hipFuncSetAttribute((const void*)k_mega, hipFuncAttributeMaxDynamicSharedMemorySize, LDS_TOTAL);
        int dev = 0, cus = 0, per_cu = 0;
        (void)hipGetDevice(&dev);
        (void)hipDeviceGetAttribute(&cus, hipDeviceAttributeMultiprocessorCount, dev);
        (void)hipOccupancyMaxActiveBlocksPerMultiprocessor(&per_cu, k_mega, 512, LDS_TOTAL);
        if (per_cu > 1) per_cu = 1;
        grid_blocks = cus * per_cu;
        if (grid_blocks <= 0) { fprintf(stderr, "occupancy query failed: cus %d per_cu %d\n", cus, per_cu); grid_blocks = 256; }
    }
    (void)hipMemsetAsync(ws + 524288, 0, XCD_BAR_WORDS * 4, stream);
    void* args[] = {&mk};
    hipError_t e = hipLaunchCooperativeKernel((void*)k_mega, dim3(grid_blocks), dim3(512), args, LDS_TOTAL, stream);
    if (e != hipSuccess) fprintf(stderr, "cooperative launch failed: %s (grid %d)\n", hipGetErrorString(e), grid_blocks);
}
```

```cpp
#include <hip/hip_runtime.h>
#include <hip/hip_cooperative_groups.h>
#include <cstdio>
namespace cg = cooperative_groups;
#ifndef DUP
#define DUP 0
#endif
#include <stdint.h>

constexpr int D = 1024, NB = 4, SEQ = 8192, CTX = 256, RB = SEQ + CTX  , NR = NB * RB  , T = NB * SEQ;
constexpr int NE = 64, DE = 256, ECAP = 32768;
constexpr float EPS = 1e-6f;
typedef unsigned short bf16_t;

__device__ __forceinline__ float siluf(float v) { return v / (1.0f + expf(-v)); }
__device__ __forceinline__ float silu_fast(float v) { return v * __builtin_amdgcn_rcpf(1.0f + __builtin_amdgcn_exp2f(-1.4426950408889634f * v)); }
__device__ __forceinline__ float wave_sum(float v) {
#pragma unroll
    for (int o = 32; o > 0; o >>= 1) v += __shfl_xor(v, o);
    return v;
}
__device__ __forceinline__ float wave_max(float v) {
#pragma unroll
    for (int o = 32; o > 0; o >>= 1) v = fmaxf(v, __shfl_xor(v, o));
    return v;
}
__device__ __forceinline__ float block_sum(float v, float* red) {
    v = wave_sum(v);
    __syncthreads();
    if ((threadIdx.x & 63) == 0) red[threadIdx.x >> 6] = v;
    __syncthreads();
    return red[0] + red[1] + red[2] + red[3];
}
__device__ __forceinline__ float block_max(float v, float* red) {
    v = wave_max(v);
    __syncthreads();
    if ((threadIdx.x & 63) == 0) red[threadIdx.x >> 6] = v;
    __syncthreads();
    return fmaxf(fmaxf(red[0], red[1]), fmaxf(red[2], red[3]));
}

typedef short bf16x8 __attribute__((ext_vector_type(8)));
typedef short s16x4 __attribute__((ext_vector_type(4)));
typedef float f32x4 __attribute__((ext_vector_type(4)));
typedef float f32x16 __attribute__((ext_vector_type(16)));
typedef unsigned u32x2 __attribute__((ext_vector_type(2)));
typedef unsigned u32x4 __attribute__((ext_vector_type(4)));
extern __shared__ __attribute__((aligned(1024))) char smem[];
constexpr int NTHR = 512;
constexpr int GEMM_LDS = 131072;

__device__ __forceinline__ unsigned cvtpk(float lo, float hi) { unsigned r; asm volatile("v_cvt_pk_bf16_f32 %0, %1, %2" : "=v"(r) : "v"(lo), "v"(hi)); return r; }
__device__ __forceinline__ bf16_t f2bf(float v) { return (bf16_t)(cvtpk(v, v) & 0xffffu); }
__device__ __forceinline__ float bf2f(bf16_t v) { return __uint_as_float(((unsigned)v) << 16); }

constexpr size_t MiB = 1048576;
struct MK {
    const float *x, *c, *ctx, *cctx, *ada_w, *ada_b, *norm1_g, *w_in, *lq1, *lk1, *lq2, *lk2, *dattn_g, *dec_f, *dec_b, *ret_g, *w_out, *norm2_g, *router_w, *router_b,
        *ew1, *ew3, *ew2, *sw1, *sw3, *sw2, *final_g;
    float* out; char* ws;
    float* dbgP; long dbg_lo, dbg_hi; long conv_limit;
#define WSF(name, type, off) __device__ __forceinline__ type* name() const { return (type*)(ws + (off)); }
    WSF(mod, float, 0) WSF(cnt, int, 131072) WSF(ropec, float, 262144) WSF(ropes, float, 262144 + 8192)
    WSF(w_inT, bf16_t, 1 * MiB) WSF(w_outT, bf16_t, 7 * MiB) WSF(routerT, bf16_t, 9 * MiB) WSF(W2t, bf16_t, 9 * MiB + 524288)
    WSF(H, bf16_t, 42 * MiB) WSF(MIX, bf16_t, 42 * MiB) WSF(KV, bf16_t, 112 * MiB) WSF(ST, bf16_t, 147 * MiB) WSF(ACT, bf16_t, 42 * MiB)
    WSF(W13t, bf16_t, 194 * MiB) WSF(H2, bf16_t, 260 * MiB)
    WSF(Q, bf16_t, 260 * MiB) WSF(K, bf16_t, 292 * MiB) WSF(V, bf16_t, 325 * MiB) WSF(RQ, bf16_t, 358 * MiB) WSF(RK, bf16_t, 375 * MiB)
    WSF(KTf, bf16_t, 392 * MiB) WSF(KTb, bf16_t, 409 * MiB) WSF(VT, bf16_t, 426 * MiB) WSF(RG, bf16_t, 459 * MiB)
    WSF(Y, unsigned char, 194 * MiB) WSF(tok_list, int, 452 * MiB) WSF(wt_list, float, 460 * MiB) WSF(tokmap, int, 468 * MiB)
#undef WSF
};

__device__ __forceinline__ void ph_mod(const MK& p, int bid, int nb, int tid_l) {
    float* red = (float*)smem;
    for (int it = bid; it < 6 * D / 32; it += nb) {
        const int col = tid_l & 31, kg = tid_l >> 5, j = it * 32 + col;
        float a[5] = {0, 0, 0, 0, 0};
        for (int k = kg * 64; k < kg * 64 + 64; ++k) {
            float w = p.ada_w[(size_t)k * 6 * D + j];
#pragma unroll
            for (int r = 0; r < 5; ++r) { float cv = r < 4 ? p.c[r * D + k] : p.cctx[k]; a[r] += siluf(cv) * w; }
        }
        __syncthreads();
#pragma unroll
        for (int r = 0; r < 5; ++r) red[(kg * 5 + r) * 32 + col] = a[r];
        __syncthreads();
        if (tid_l < 160) {
            int r = tid_l >> 5; float s = 0;
            for (int g = 0; g < 16; ++g) s += red[(g * 5 + r) * 32 + col];
            p.mod()[(size_t)r * 6 * D + j] = s + p.ada_b[j];
        }
    }
    if (bid == nb - 1) {
        for (int i = tid_l; i < 128 * 16; i += NTHR) {
            int pos = i >> 4, f = i & 15;
            float inv_freq = (float)pow(10000.0, -(double)f / 16.0);
            float s, c; sincosf((float)pos * inv_freq, &s, &c);
            p.ropec()[i] = c; p.ropes()[i] = s;
        }
    }
    __syncthreads();
}

__device__ __forceinline__ void tr_tile(const float* src, int ldsrc, int k0, int n0, bf16_t* dst, int lddst, int mode  , bf16_t* dst2, int tid_l) {
    float* t = (float*)smem;
    __syncthreads();
    for (int i = tid_l; i < 64 * 16; i += NTHR) {
        int r = i >> 4, c4 = (i & 15) * 4;
        float4 v = *(const float4*)(src + (size_t)(k0 + r) * ldsrc + n0 + c4);
        t[r * 65 + c4] = v.x; t[r * 65 + c4 + 1] = v.y; t[r * 65 + c4 + 2] = v.z; t[r * 65 + c4 + 3] = v.w;
    }
    __syncthreads();
    for (int i = tid_l; i < 64 * 16; i += NTHR) {
        int n = i >> 4, k4 = (i & 15) * 4;
        float a = t[(k4 + 0) * 65 + n], b = t[(k4 + 1) * 65 + n], c = t[(k4 + 2) * 65 + n], d = t[(k4 + 3) * 65 + n];
        int nn = n0 + n, row = nn;
        if (mode == 1 || mode == 2) { int ct = nn >> 7; row = ct * 256 + (mode == 2 ? 128 : 0) + (nn & 127); }
        u32x2 w; w.x = cvtpk(a, b); w.y = cvtpk(c, d);
        *(u32x2*)(dst + (size_t)row * lddst + k0 + k4) = w;
        if (mode == 3) {
            float ah = bf2f((bf16_t)(w.x & 0xffff)), bh = bf2f((bf16_t)(w.x >> 16)), ch = bf2f((bf16_t)(w.y & 0xffff)), dh = bf2f((bf16_t)(w.y >> 16));
            u32x2 l; l.x = cvtpk(a - ah, b - bh); l.y = cvtpk(c - ch, d - dh);
            *(u32x2*)(dst2 + (size_t)row * lddst + k0 + k4) = l;
        }
    }
}
constexpr int CV_STATIC = 16 * 48 + 16 * 16 + 16, CV_E13 = 65 * 2 * 16 * 4, CV_E2 = 65 * 4 * 16, CV_TOTAL = CV_STATIC + CV_E13 + CV_E2;
__device__ __forceinline__ void convert_tile(const MK& p, int j, int tid_l) {
    const int n_win = 16 * 48, n_wout = 16 * 16, n_rt = 16;
    if (j < n_win) { tr_tile(p.w_in, 3072, (j / 48) * 64, (j % 48) * 64, p.w_inT(), 1024, 0, nullptr, tid_l); return; } j -= n_win;
    if (j < n_wout) { tr_tile(p.w_out, 1024, (j / 16) * 64, (j % 16) * 64, p.w_outT(), 1024, 0, nullptr, tid_l); return; } j -= n_wout;
    if (j < n_rt) { tr_tile(p.router_w, 64, j * 64, 0, p.routerT(), 1024, 3, p.routerT() + 64 * 1024, tid_l); return; } j -= n_rt;
    if (j < CV_E13) {
        int e = j / 128, r = j % 128, which = r / 64, tt = r % 64;
        const float* src = e < 64 ? (which ? p.ew3 : p.ew1) + (size_t)e * D * DE : (which ? p.sw3 : p.sw1);
        tr_tile(src, DE, (tt / 4) * 64, (tt % 4) * 64, p.W13t() + (size_t)e * 512 * 1024, 1024, 1 + which, nullptr, tid_l); return; } j -= CV_E13;
    { int e = j / 64, tt = j % 64;
      const float* src = e < 64 ? p.ew2 + (size_t)e * DE * D : p.sw2;
      tr_tile(src, D, (tt / 16) * 64, (tt % 16) * 64, p.W2t() + (size_t)e * 1024 * 256, 256, 0, nullptr, tid_l); }
}
__device__ __forceinline__ void ph_convert(const MK& p, int bid, int nb, int tid_l) {
    for (int it = bid; it < CV_STATIC; it += nb) convert_tile(p, it, tid_l);
    __syncthreads();
}
__device__ __forceinline__ void ph_convert_dyn(const MK& p, int tid_l) {
    int* q = (int*)smem + 8192;
    for (;;) {
        __syncthreads();
        if (tid_l == 0) q[0] = atomicAdd(&p.cnt()[200], 8);
        __syncthreads();
        const int base = q[0];
        if (base >= CV_E13 + CV_E2) break;
        for (int k = 0; k < 8; ++k) if (base + k < CV_E13 + CV_E2) convert_tile(p, CV_STATIC + base + k, tid_l);
    }
    __syncthreads();
}

__device__ __forceinline__ void ph_ln1(const MK& p, int bid, int nb, int tid_l) {
    const int wid = tid_l >> 6, lane = tid_l & 63;
    for (int R = bid * 8 + wid; R < NR; R += nb * 8) {
        int b = R / RB, i = R % RB;
        const float* src = i < CTX ? p.ctx + ((size_t)b * CTX + i) * D : p.x + ((size_t)b * SEQ + (i - CTX)) * D;
        const float* m = p.mod() + (size_t)(i < CTX ? 4 : b) * 6 * D;
        float4 v[4]; float ss = 0;
#pragma unroll
        for (int q = 0; q < 4; ++q) { v[q] = *(const float4*)(src + q * 256 + lane * 4); ss += v[q].x * v[q].x + v[q].y * v[q].y + v[q].z * v[q].z + v[q].w * v[q].w; }
        ss = wave_sum(ss);
        float rstd = rsqrtf(ss * (1.0f / D) + EPS);
#pragma unroll
        for (int q = 0; q < 4; ++q) {
            int c0 = q * 256 + lane * 4;
            float4 gg = *(const float4*)(p.norm1_g + c0), sh = *(const float4*)(m + c0), sc = *(const float4*)(m + D + c0);
            float o0 = v[q].x * rstd * gg.x * (1 + sc.x) + sh.x, o1 = v[q].y * rstd * gg.y * (1 + sc.y) + sh.y;
            float o2 = v[q].z * rstd * gg.z * (1 + sc.z) + sh.z, o3 = v[q].w * rstd * gg.w * (1 + sc.w) + sh.w;
            u32x2 w; w.x = cvtpk(o0, o1); w.y = cvtpk(o2, o3);
            *(u32x2*)(p.H() + (size_t)R * D + c0) = w;
        }
    }
}

__device__ __forceinline__ int lds_byte(int r, int c) { int st = (r >> 4) * 2 + (c >> 5), ob = (r & 15) * 64 + (c & 31) * 2; return st * 1024 + (ob ^ (((ob >> 9) & 1) << 5)); }
__device__ __forceinline__ void stage_rc(int b, int& R, int& C) { int st = b >> 10, sb = b & 1023, swz = sb ^ (((sb >> 9) & 1) << 5); R = (st / 2) * 16 + swz / 64; C = (st % 2) * 32 + (swz % 64) / 2; }
#define WAIT_V0() asm volatile("s_waitcnt vmcnt(0)" ::: "memory")
__device__ __forceinline__ void gemm_core(const char* Abase, const unsigned (&Ao)[4], const char* Bbase, const unsigned (&Bo)[4], int nt, f32x4 (&acc)[8][4], int tid_l, bool pre) {
    const int tid = tid_l, wid = tid >> 6, lane = tid & 63, wr = wid >> 2, wc = wid & 3, fr = lane & 15, fq = lane >> 4;
#pragma unroll
    for (int m = 0; m < 8; ++m)
#pragma unroll
        for (int n = 0; n < 4; ++n) acc[m][n] = (f32x4){0.f, 0.f, 0.f, 0.f};
#define G_SA(b) (smem + (b) * 32768)
#define G_SB(b) (smem + 65536 + (b) * 32768)
#define G_STAGE(buf, kt) do { _Pragma("unroll") for (int i = 0; i < 4; ++i) {                                                     \
        __builtin_amdgcn_global_load_lds((const unsigned*)(Abase + (Ao[i] + (unsigned)(kt) * 128u)), (unsigned*)(G_SA(buf) + wid * 1024 + i * 8192), 16, 0, 0); \
        __builtin_amdgcn_global_load_lds((const unsigned*)(Bbase + (Bo[i] + (unsigned)(kt) * 128u)), (unsigned*)(G_SB(buf) + wid * 1024 + i * 8192), 16, 0, 0); } } while (0)
    if (!pre) G_STAGE(0, 0);
    WAIT_V0(); __syncthreads();
#define G_KSTEP(cur, t) do {                                                                                                   \
        if ((t) + 1 < nt) G_STAGE((cur) ^ 1, (t) + 1);                                                                          \
        _Pragma("unroll") for (int ks = 0; ks < 2; ++ks) {                                                                      \
            bf16x8 At[8], Bf[4];                                                                                                \
            _Pragma("unroll") for (int m = 0; m < 8; ++m) At[m] = *(const bf16x8*)(G_SA(cur) + lds_byte(wr * 128 + m * 16 + fr, ks * 32 + fq * 8)); \
            _Pragma("unroll") for (int n = 0; n < 4; ++n) Bf[n] = *(const bf16x8*)(G_SB(cur) + lds_byte(wc * 64 + n * 16 + fr, ks * 32 + fq * 8));  \
            _Pragma("unroll") for (int m = 0; m < 8; ++m) _Pragma("unroll") for (int n = 0; n < 4; ++n)                         \
                acc[m][n] = __builtin_amdgcn_mfma_f32_16x16x32_bf16(Bf[n], At[m], acc[m][n], 0, 0, 0);                          \
            __builtin_amdgcn_sched_barrier(0);                                                                                  \
        }                                                                                                                       \
        WAIT_V0(); __syncthreads(); } while (0)
#pragma unroll 1
    for (int t = 0; t < nt; ++t) { const int cur = t & 1; G_KSTEP(cur, t); }
}
#ifndef XPREFETCH
#define XPREFETCH 0
#endif
__device__ __forceinline__ void gemm_prefetch(const char* Abase, const unsigned (&Ao)[4], const char* Bbase, const unsigned (&Bo)[4], int tid_l) {
    const int wid = tid_l >> 6;
    G_STAGE(0, 0);
}
__device__ __forceinline__ void stage_offs(unsigned ld_bytes, unsigned (&P)[4], int tid_l) {
    const int wid = tid_l >> 6, lane = tid_l & 63;
#pragma unroll
    for (int i = 0; i < 4; ++i) { int R, C; stage_rc(wid * 1024 + i * 8192 + lane * 16, R, C); P[i] = (unsigned)R * ld_bytes + (unsigned)C * 2u; }
}

constexpr int WAREA = 18432;
__device__ __forceinline__ char* wave_area(int wid) { return smem + wid * WAREA; }

constexpr int A_KVBLK = 64;
constexpr float A_SCALE = 0.125f, A_THR = 8.f;
constexpr int A_SHM_V = A_KVBLK * 128 * 2, A_SHM_K = A_KVBLK * 128 * 2;
#define KSWZ(row, colB) ((row) * 256 + ((colB) ^ (((row) & 7) << 4)))
#define SBAR() __builtin_amdgcn_sched_barrier(0)
__device__ __forceinline__ int crow(int r, int hi) { return (r & 3) + 8 * (r >> 2) + 4 * hi; }

constexpr float A_THRL = 11.0f;
template <bool FIRST> __device__ __forceinline__ void partialSM2(f32x16& p0, f32x16& p1, float& mhat, f32x16& negm, float& alpha) {
    float pmax = p0[0];
#pragma unroll
    for (int r = 1; r < 16; ++r) pmax = fmaxf(pmax, p0[r]);
#pragma unroll
    for (int r = 0; r < 16; ++r) pmax = fmaxf(pmax, p1[r]);
    { auto rr = __builtin_amdgcn_permlane32_swap(__float_as_uint(pmax), __float_as_uint(pmax), false, false);
      pmax = fmaxf(__uint_as_float(rr[0]), __uint_as_float(rr[1])); }
    alpha = 1.f;
    if (FIRST || __builtin_expect(__any(pmax > A_THRL), 0)) {
        const float dl = FIRST ? pmax : fmaxf(pmax, 0.f);
        mhat += dl;
#pragma unroll
        for (int r = 0; r < 16; ++r) { p0[r] -= dl; p1[r] -= dl; }
#pragma unroll
        for (int r = 0; r < 16; ++r) negm[r] = -mhat;
        if (!FIRST) alpha = __builtin_amdgcn_exp2f(-dl);
    }
#pragma unroll
    for (int r = 0; r < 16; ++r) p0[r] = __builtin_amdgcn_exp2f(p0[r]);
}
__device__ __forceinline__ void qkt2(f32x16& p0, f32x16& p1, const char* Ks, const bf16x8* qr, const f32x16& negm, int r32, int hi, int mapc) {
#pragma unroll
    for (int d0 = 0; d0 < 4; ++d0) { int cb = (mapc + d0 * 16 + hi * 8) * 2;
        bf16x8 b0 = *reinterpret_cast<const bf16x8*>(Ks + KSWZ(r32, cb));
        bf16x8 b1 = *reinterpret_cast<const bf16x8*>(Ks + KSWZ(32 + r32, cb));
        if (d0 == 0) { p0 = __builtin_amdgcn_mfma_f32_32x32x16_bf16(b0, qr[0], negm, 0, 0, 0); p1 = __builtin_amdgcn_mfma_f32_32x32x16_bf16(b1, qr[0], negm, 0, 0, 0); }
        else { p0 = __builtin_amdgcn_mfma_f32_32x32x16_bf16(b0, qr[d0], p0, 0, 0, 0); p1 = __builtin_amdgcn_mfma_f32_32x32x16_bf16(b1, qr[d0], p1, 0, 0, 0); } }
}
template <int PROBE = 0> __device__ __forceinline__ void partialSM(f32x16& p0, f32x16& p1, float& m_reg, float& mn, float& alpha) {
    constexpr float C = A_SCALE * 1.4426950408889634f;
    float pmax = p0[0];
#pragma unroll
    for (int r = 1; r < 16; ++r) pmax = fmaxf(pmax, p0[r]);
#pragma unroll
    for (int r = 0; r < 16; ++r) pmax = fmaxf(pmax, p1[r]);
    { auto rr = __builtin_amdgcn_permlane32_swap(__float_as_uint(pmax), __float_as_uint(pmax), false, false);
      pmax = fmaxf(__uint_as_float(rr[0]), __uint_as_float(rr[1])); }
    if (__builtin_expect(__all(pmax - m_reg <= A_THR / A_SCALE), 1)) { mn = m_reg; alpha = 1.f; }
    else { mn = fmaxf(m_reg, pmax); alpha = __builtin_amdgcn_exp2f((m_reg - mn) * C); m_reg = mn; }
    float mnC = -mn * C;
#pragma unroll
    for (int r = 0; r < 16; ++r) p0[r] = fmaf(p0[r], C, mnC);
#pragma unroll
    for (int r = 0; r < 16; ++r) p1[r] = fmaf(p1[r], C, mnC);
#pragma unroll
    for (int r = 0; r < 16; ++r) p0[r] = PROBE == 3 ? p0[r] * 1e-3f : __builtin_amdgcn_exp2f(p0[r]);
}
#define PK4(P, BASE, OUT) do { unsigned a0 = cvtpk(P[BASE + 0], P[BASE + 1]), a1 = cvtpk(P[BASE + 2], P[BASE + 3]);   \
    unsigned b0 = cvtpk(P[BASE + 4], P[BASE + 5]), b1 = cvtpk(P[BASE + 6], P[BASE + 7]);                              \
    auto r0 = __builtin_amdgcn_permlane32_swap(a0, b0, false, false); auto r1 = __builtin_amdgcn_permlane32_swap(a1, b1, false, false); \
    u32x4 w = {r0[0], r1[0], r0[1], r1[1]}; OUT = *reinterpret_cast<bf16x8*>(&w); } while (0)
template <int PROBE = 0, bool DIRECT = false> __device__ __forceinline__ void finishSM(f32x16& p0, f32x16& p1, float alpha, float& l_reg, bf16x8& pa0, bf16x8& pa1, bf16x8& pa2, bf16x8& pa3) {
#pragma unroll
    for (int r = 0; r < 16; ++r) p1[r] = PROBE == 3 ? p1[r] * 1e-3f : __builtin_amdgcn_exp2f(p1[r]);
    float ps = 0;
#pragma unroll
    for (int r = 0; r < 16; ++r) ps += p0[r];
#pragma unroll
    for (int r = 0; r < 16; ++r) ps += p1[r];
    { auto rr = __builtin_amdgcn_permlane32_swap(__float_as_uint(ps), __float_as_uint(ps), false, false);
      ps = __uint_as_float(rr[0]) + __uint_as_float(rr[1]); }
    l_reg = l_reg * alpha + ps;
    if (DIRECT) {
#define PKD(P, B, OUT) do { u32x4 w = {cvtpk(P[B], P[B + 1]), cvtpk(P[B + 2], P[B + 3]), cvtpk(P[B + 4], P[B + 5]), cvtpk(P[B + 6], P[B + 7])}; OUT = *reinterpret_cast<bf16x8*>(&w); } while (0)
        PKD(p0, 0, pa0); PKD(p0, 8, pa1); PKD(p1, 0, pa2); PKD(p1, 8, pa3);
#undef PKD
    } else { PK4(p0, 0, pa0); PK4(p0, 8, pa1); PK4(p1, 0, pa2); PK4(p1, 8, pa3); }
}
__device__ __forceinline__ void qkt(f32x16& p0, f32x16& p1, const char* Ks, const bf16x8* qr, int r32, int hi, int mapc) {
    p0 = f32x16{}; p1 = f32x16{};
#pragma unroll
    for (int d0 = 0; d0 < 4; ++d0) { int cb = (mapc + d0 * 16 + hi * 8) * 2;
        bf16x8 b0 = *reinterpret_cast<const bf16x8*>(Ks + KSWZ(r32, cb));
        bf16x8 b1 = *reinterpret_cast<const bf16x8*>(Ks + KSWZ(32 + r32, cb));
        p0 = __builtin_amdgcn_mfma_f32_32x32x16_bf16(b0, qr[d0], p0, 0, 0, 0);
        p1 = __builtin_amdgcn_mfma_f32_32x32x16_bf16(b1, qr[d0], p1, 0, 0, 0); }
}
__device__ __forceinline__ int v_st(int k, int c) { const int kk = (k & ~0xC) | ((k & 4) << 1) | ((k & 8) >> 1); return ((kk >> 3) * 4 + (c >> 5)) * 512 + ((kk & 7) * 32 + (c & 31)) * 2; }
__device__ __forceinline__ int v_rd_base(int lane) { return ((lane & 3) << 3) | (((lane >> 2) & 3) << 6) | (((lane >> 4) & 1) << 5) | (((lane >> 5) & 1) << 8); }
constexpr int v_rd_off(int d0, int ks, int half) { return d0 * 512 + ks * 4096 + half * 2048; }
template <int OFF> __device__ __forceinline__ s16x4 tr_read(int vb) {
    s16x4 r; asm volatile("ds_read_b64_tr_b16 %0, %1 offset:%2" : "=&v"(r) : "v"(vb), "i"(OFF) : "memory"); return r;
}
template <int D0> __device__ __forceinline__ void pv_one(f32x16& od, int vb, bf16x8 pa0, bf16x8 pa1, bf16x8 pa2, bf16x8 pa3) {
    const s16x4 l0 = tr_read<v_rd_off(D0, 0, 0)>(vb), h0 = tr_read<v_rd_off(D0, 0, 1)>(vb), l1 = tr_read<v_rd_off(D0, 1, 0)>(vb), h1 = tr_read<v_rd_off(D0, 1, 1)>(vb);
    const s16x4 l2 = tr_read<v_rd_off(D0, 2, 0)>(vb), h2 = tr_read<v_rd_off(D0, 2, 1)>(vb), l3 = tr_read<v_rd_off(D0, 3, 0)>(vb), h3 = tr_read<v_rd_off(D0, 3, 1)>(vb);
    asm volatile("s_waitcnt lgkmcnt(0)" ::: "memory"); SBAR();
#define PKV(L, H) (bf16x8){L[0], L[1], L[2], L[3], H[0], H[1], H[2], H[3]}
    od = __builtin_amdgcn_mfma_f32_32x32x16_bf16(pa0, PKV(l0, h0), od, 0, 0, 0);
    od = __builtin_amdgcn_mfma_f32_32x32x16_bf16(pa1, PKV(l1, h1), od, 0, 0, 0);
    od = __builtin_amdgcn_mfma_f32_32x32x16_bf16(pa2, PKV(l2, h2), od, 0, 0, 0);
    od = __builtin_amdgcn_mfma_f32_32x32x16_bf16(pa3, PKV(l3, h3), od, 0, 0, 0);
}
template <int D0> __device__ __forceinline__ void pv_two(f32x16& oa, f32x16& ob, int vb, bf16x8 pa0, bf16x8 pa1, bf16x8 pa2, bf16x8 pa3) {
    const s16x4 l0 = tr_read<v_rd_off(D0, 0, 0)>(vb), h0 = tr_read<v_rd_off(D0, 0, 1)>(vb), l1 = tr_read<v_rd_off(D0, 1, 0)>(vb), h1 = tr_read<v_rd_off(D0, 1, 1)>(vb);
    const s16x4 l2 = tr_read<v_rd_off(D0, 2, 0)>(vb), h2 = tr_read<v_rd_off(D0, 2, 1)>(vb), l3 = tr_read<v_rd_off(D0, 3, 0)>(vb), h3 = tr_read<v_rd_off(D0, 3, 1)>(vb);
    const s16x4 m0 = tr_read<v_rd_off(D0 + 1, 0, 0)>(vb), g0 = tr_read<v_rd_off(D0 + 1, 0, 1)>(vb), m1 = tr_read<v_rd_off(D0 + 1, 1, 0)>(vb), g1 = tr_read<v_rd_off(D0 + 1, 1, 1)>(vb);
    const s16x4 m2 = tr_read<v_rd_off(D0 + 1, 2, 0)>(vb), g2 = tr_read<v_rd_off(D0 + 1, 2, 1)>(vb), m3 = tr_read<v_rd_off(D0 + 1, 3, 0)>(vb), g3 = tr_read<v_rd_off(D0 + 1, 3, 1)>(vb);
    asm volatile("s_waitcnt lgkmcnt(0)" ::: "memory"); SBAR();
    oa = __builtin_amdgcn_mfma_f32_32x32x16_bf16(pa0, PKV(l0, h0), oa, 0, 0, 0);
    ob = __builtin_amdgcn_mfma_f32_32x32x16_bf16(pa0, PKV(m0, g0), ob, 0, 0, 0);
    oa = __builtin_amdgcn_mfma_f32_32x32x16_bf16(pa1, PKV(l1, h1), oa, 0, 0, 0);
    ob = __builtin_amdgcn_mfma_f32_32x32x16_bf16(pa1, PKV(m1, g1), ob, 0, 0, 0);
    oa = __builtin_amdgcn_mfma_f32_32x32x16_bf16(pa2, PKV(l2, h2), oa, 0, 0, 0);
    ob = __builtin_amdgcn_mfma_f32_32x32x16_bf16(pa2, PKV(m2, g2), ob, 0, 0, 0);
    oa = __builtin_amdgcn_mfma_f32_32x32x16_bf16(pa3, PKV(l3, h3), oa, 0, 0, 0);
    ob = __builtin_amdgcn_mfma_f32_32x32x16_bf16(pa3, PKV(m3, g3), ob, 0, 0, 0);
}
__device__ __forceinline__ void pv_d0(f32x16* o, int vb, bf16x8 pa0, bf16x8 pa1, bf16x8 pa2, bf16x8 pa3) {
    pv_one<0>(o[0], vb, pa0, pa1, pa2, pa3); pv_one<1>(o[1], vb, pa0, pa1, pa2, pa3); pv_one<2>(o[2], vb, pa0, pa1, pa2, pa3); pv_one<3>(o[3], vb, pa0, pa1, pa2, pa3);
}

template <int PROBE> __device__ __forceinline__ void attn_item(const bf16_t* __restrict__ Qb, const bf16_t* __restrict__ Kh, const bf16_t* __restrict__ Vh, bf16_t* __restrict__ mixrow,
                                          const float* __restrict__ gd, float lam, int tid_l) {
    char* lds = smem;
    const int tid = tid_l, wid = tid >> 6, lane = tid & 63, r32 = lane & 31, hi = lane >> 5;
    const int map = wid >> 2, wq = wid & 3, mapc = map * 64;
    char* K_lds = lds; char* V_lds = lds + 4 * A_SHM_K;
    float* wsw = (float*)(lds + 4 * A_SHM_V + 4 * A_SHM_K) + wid * 64; float* li_l = wsw; float* al_l = wsw + 32;
    float m_reg = 0.f, l_reg = 0; f32x16 o[4] = {}; bf16x8 qr[4]; f32x16 negm = f32x16{};
    const bf16_t* Qw = Qb + (long)(wq * 32 + r32) * 128 + mapc + hi * 8;
#pragma unroll
    for (int d0 = 0; d0 < 4; ++d0) qr[d0] = *reinterpret_cast<const bf16x8*>(Qw + d0 * 16);
    const int vb0 = (int)(uintptr_t)V_lds + v_rd_base(lane);
    unsigned kofs[2], vofs[2];
    const int widu = __builtin_amdgcn_readfirstlane(wid);
#pragma unroll
    for (int i = 0; i < 2; ++i) {
        const int x = wid * 1024 + i * 8192 + lane * 16;
        { const int row = x >> 8, cs = x & 255, colB = cs ^ ((row & 7) << 4); kofs[i] = (unsigned)(row * 256 + colB); }
        { const int sub = x >> 9, wn = x & 511, k = (sub >> 2) * 8 + (wn >> 6), c = (sub & 3) * 32 + ((wn & 63) >> 1); vofs[i] = (unsigned)(k * 256 + c * 2); }
    }
#define DMA_TILE(slot, k0) do { const char* kt_ = (const char*)Kh + (size_t)(k0) * 256; const char* vt_ = (const char*)Vh + (size_t)(k0) * 256;                  \
      _Pragma("unroll") for (int i = 0; i < 2; ++i) {                                                                   \
        __builtin_amdgcn_global_load_lds((const unsigned*)(kt_ + kofs[i]), (unsigned*)(K_lds + (slot) * A_SHM_K + widu * 1024 + i * 8192), 16, 0, 0); \
        __builtin_amdgcn_global_load_lds((const unsigned*)(vt_ + vofs[i]), (unsigned*)(V_lds + (slot) * A_SHM_V + widu * 1024 + i * 8192), 16, 0, 0); } } while (0)
#define RESC(a) do { if (__any((a) < 1.f)) { if (hi == 0) al_l[r32] = (a); asm volatile("s_waitcnt lgkmcnt(0)" ::: "memory"); \
    _Pragma("unroll") for (int d = 0; d < 4; ++d) _Pragma("unroll") for (int r = 0; r < 16; ++r) o[d][r] *= al_l[crow(r, hi)]; } } while (0)
    f32x16 pA0, pA1, pB0, pB1; float mnA, mnB, alA, alB; bf16x8 pa0, pa1, pa2, pa3; const int NT = RB / A_KVBLK;
    DMA_TILE(0, 0); DMA_TILE(1, A_KVBLK);
    asm volatile("s_waitcnt vmcnt(0)" ::: "memory"); __syncthreads();
    qkt2(pA0, pA1, K_lds, qr, negm, r32, hi, mapc); partialSM2<true>(pA0, pA1, m_reg, negm, alA);
#define ATILE(X0, X1, ALX, Y0, Y1, ALY, CS, PS, NS, T_, DODMA) do {                                                                  \
        asm volatile("s_waitcnt vmcnt(0)" ::: "memory"); __syncthreads();                                                            \
        if (DODMA && PROBE != 1) DMA_TILE(NS, ((T_) + 1) * A_KVBLK);                                                                 \
        SBAR(); qkt2(X0, X1, K_lds + (CS) * A_SHM_K, qr, negm, r32, hi, mapc);                                                       \
        finishSM<PROBE, true>(Y0, Y1, ALY, l_reg, pa0, pa1, pa2, pa3); SBAR();                                                       \
        pv_d0(o, vb0 + (PS) * A_SHM_V, pa0, pa1, pa2, pa3); partialSM2<false>(X0, X1, m_reg, negm, ALX);                             \
        RESC(ALX); } while (0)
#pragma unroll 1
    for (int j = 1; j + 3 < NT; j += 4) {
        ATILE(pB0, pB1, alB, pA0, pA1, alA, 1, 0, 2, j, true);
        ATILE(pA0, pA1, alA, pB0, pB1, alB, 2, 1, 3, j + 1, true);
        ATILE(pB0, pB1, alB, pA0, pA1, alA, 3, 2, 0, j + 2, true);
        ATILE(pA0, pA1, alA, pB0, pB1, alB, 0, 3, 1, j + 3, true);
    }
    ATILE(pB0, pB1, alB, pA0, pA1, alA, 1, 0, 2, NT - 3, true);
    ATILE(pA0, pA1, alA, pB0, pB1, alB, 2, 1, 3, NT - 2, true);
    ATILE(pB0, pB1, alB, pA0, pA1, alA, 3, 2, 0, NT - 1, false);
    finishSM<PROBE, true>(pB0, pB1, alB, l_reg, pa0, pa1, pa2, pa3); SBAR();
    pv_d0(o, vb0 + 3 * A_SHM_V, pa0, pa1, pa2, pa3);
#undef ATILE
#undef DMA_TILE
    if (hi == 0) li_l[r32] = l_reg;
    asm volatile("s_waitcnt lgkmcnt(0)" ::: "memory");
    float rl[16];
#pragma unroll
    for (int r = 0; r < 16; ++r) rl[r] = __builtin_amdgcn_rcpf(li_l[crow(r, hi)]);
    __syncthreads();
    {
        float* xo = (float*)lds + map * 16384 + (wq * 32) * 128 + r32;
#pragma unroll
        for (int r = 0; r < 16; ++r)
#pragma unroll
            for (int d0 = 0; d0 < 4; ++d0) xo[crow(r, hi) * 128 + d0 * 32] = o[d0][r] * rl[r];
    }
    __syncthreads();
    {
        int l2 = lane; asm volatile("" : "+v"(l2));
        const float g0 = gd[l2 * 2], g1 = gd[l2 * 2 + 1];
#pragma unroll 4
        for (int rr = 0; rr < 16; ++rr) {
            const int row = wid * 16 + rr;
            const float2 a0 = *(const float2*)((const float*)lds + row * 128 + l2 * 2), a1 = *(const float2*)((const float*)lds + 16384 + row * 128 + l2 * 2);
            const float xv = a0.x - lam * a1.x, yv = a0.y - lam * a1.y;
            const float ss = wave_sum(xv * xv + yv * yv);
            const float rs = rsqrtf(ss * (1.0f / 128) + EPS) * 0.8f;
            *(unsigned*)(mixrow + (long)row * 1024 + l2 * 2) = cvtpk(xv * rs * g0, yv * rs * g1);
        }
    }
    __syncthreads();
#undef RESC
}


template <int PROBE> __device__ __forceinline__ void ph_attn(const MK& p, int bid, int nb, int tid_l) {
    const int lane = tid_l & 63;
    float s1 = wave_sum(p.lq1[lane] * p.lk1[lane]), s2 = wave_sum(p.lq2[lane] * p.lk2[lane]);
    const float lam = expf(s1) - expf(s2) + 0.2f;
    const int nrounds = (1024 + nb - 1) / nb;
    for (int rr = 0; rr < nrounds; ++rr) {
        int item;
        if (nb == 256) { int x = bid & 7, j = bid >> 3, hh = rr * 8 + x; item = (hh >> 1) * 64 + (hh & 1) * 32 + j; }
        else { item = rr * nb + bid; if (item >= 1024) break; }
        const int bh = item >> 6, qb = item & 63, b = bh >> 2, h = bh & 3;
        attn_item<PROBE>(p.Q() + ((size_t)bh * SEQ + qb * 128) * 128, p.K() + (size_t)bh * RB * 128, p.V() + (size_t)bh * RB * 128,
                  PROBE ? (bf16_t*)(p.ws + 492 * MiB) + h * 128 : p.MIX() + ((size_t)(b * SEQ + qb * 128)) * 1024 + h * 128, p.dattn_g, lam, tid_l);
    }
}


__device__ __forceinline__ bf16x8 ldfrag(const bf16_t* p) { return *reinterpret_cast<const bf16x8*>(p); }

__device__ __forceinline__ void ph_kv(const MK& p, int bid, int nb, int tid_l) {
    const int wid = tid_l >> 6, lane = tid_l & 63, r32 = lane & 31, hi = lane >> 5;
    const int nitems = 16 * 2 * 66;
    for (int it = bid * 8 + wid; it < nitems; it += nb * 8) {
        const int c = it % 66, chain = it / 66, dir = chain & 1, bh = chain >> 1;
        const bf16_t* vt = p.VT() + (size_t)bh * 128 * RB + c * 128 + hi * 8;
        const bf16_t* kt = (dir ? p.KTb() : p.KTf()) + (size_t)bh * 64 * RB + c * 128 + hi * 8;
        f32x16 acc[4][2];
#pragma unroll
        for (int mt = 0; mt < 4; ++mt) { acc[mt][0] = f32x16{}; acc[mt][1] = f32x16{}; }
#pragma unroll 2
        for (int ks = 0; ks < 8; ++ks) {
            bf16x8 a[4], b[2];
#pragma unroll
            for (int mt = 0; mt < 4; ++mt) a[mt] = ldfrag(vt + (size_t)(mt * 32 + r32) * RB + ks * 16);
#pragma unroll
            for (int nt = 0; nt < 2; ++nt) b[nt] = ldfrag(kt + (size_t)(nt * 32 + r32) * RB + ks * 16);
#pragma unroll
            for (int mt = 0; mt < 4; ++mt)
#pragma unroll
                for (int nt = 0; nt < 2; ++nt) acc[mt][nt] = __builtin_amdgcn_mfma_f32_32x32x16_bf16(a[mt], b[nt], acc[mt][nt], 0, 0, 0);
        }
        bf16_t* dst = p.KV() + (size_t)it * 8192;
#pragma unroll
        for (int mt = 0; mt < 4; ++mt)
#pragma unroll
            for (int nt = 0; nt < 2; ++nt)
#pragma unroll
                for (int r = 0; r < 16; ++r) dst[(mt * 32 + crow(r, hi)) * 64 + nt * 32 + r32] = f2bf(acc[mt][nt][r]);
    }
}

__device__ __forceinline__ void ph_scan(const MK& p, int bid, int nb, int tid_l) {
    for (int e = bid * NTHR + tid_l; e < 32 * 8192; e += nb * NTHR) {
        const int chain = e >> 13, el = e & 8191, dir = chain & 1, bh = chain >> 1, h = bh & 3;
        const float d = dir ? p.dec_b[h] : p.dec_f[h];
        const float g128 = exp2f(128.0f * log2f(1.0f / (1.0f + expf(-d))));
        const bf16_t* kv = p.KV() + (size_t)chain * 66 * 8192 + el;
        bf16_t* st = p.ST() + (size_t)chain * 66 * 8192 + el;
        float S = 0.f;
        for (int n = 0; n < 66; ++n) {
            const int c = dir == 0 ? n : (n == 0 ? 1 : (n == 1 ? 0 : 67 - n));
            st[(size_t)c * 8192] = f2bf(S);
            S = fmaf(g128, S, bf2f(kv[(size_t)c * 8192]));
        }
    }
}

__device__ __forceinline__ void ph_ret(const MK& p, int bid, int nb, int tid_l) {
    const int tid = tid_l, wid = tid >> 6, lane = tid & 63, r32 = lane & 31, hi = lane >> 5, wq = wid & 3, half = wid >> 2;
    float* img = (float*)smem;
    for (int it = bid; it < 4 * 64 * 2; it += nb) {
        const int hp = it & 1, lc = (it >> 1) & 63, b = it >> 7, h = hp * 2 + half, bh = b * 4 + h;
        const int ib = CTX + lc * 128, c = 2 + lc;
        const float lf = log2f(1.0f / (1.0f + expf(-p.dec_f[h]))), lb = log2f(1.0f / (1.0f + expf(-p.dec_b[h])));
        const bf16_t* rq = p.RQ() + ((size_t)bh * RB + ib + wq * 32 + r32) * 64 + hi * 8;
        bf16x8 q[4];
#pragma unroll
        for (int ks = 0; ks < 4; ++ks) q[ks] = ldfrag(rq + ks * 16);
        f32x16 o[4];
        {
            const bf16_t* stf = p.ST() + ((size_t)(bh * 2 + 0) * 66 + c) * 8192 + hi * 8;
            const bf16_t* stb = p.ST() + ((size_t)(bh * 2 + 1) * 66 + c) * 8192 + hi * 8;
            {
                float rf[16];
#pragma unroll
                for (int r = 0; r < 16; ++r) rf[r] = __builtin_amdgcn_exp2f((float)(wq * 32 + crow(r, hi) + 1) * lf);
#pragma unroll
                for (int d0 = 0; d0 < 4; ++d0) {
                    f32x16 tf = f32x16{};
#pragma unroll
                    for (int ks = 0; ks < 4; ++ks) tf = __builtin_amdgcn_mfma_f32_32x32x16_bf16(q[ks], ldfrag(stf + (size_t)(d0 * 32 + r32) * 64 + ks * 16), tf, 0, 0, 0);
#pragma unroll
                    for (int r = 0; r < 16; ++r) o[d0][r] = tf[r] * rf[r];
                    asm volatile("" ::: "memory");
                }
            }
            {
                float rf[16];
#pragma unroll
                for (int r = 0; r < 16; ++r) rf[r] = __builtin_amdgcn_exp2f((float)(128 - (wq * 32 + crow(r, hi))) * lb);
#pragma unroll
                for (int d0 = 0; d0 < 4; ++d0) {
                    f32x16 tb = f32x16{};
#pragma unroll
                    for (int ks = 0; ks < 4; ++ks) tb = __builtin_amdgcn_mfma_f32_32x32x16_bf16(q[ks], ldfrag(stb + (size_t)(d0 * 32 + r32) * 64 + ks * 16), tb, 0, 0, 0);
#pragma unroll
                    for (int r = 0; r < 16; ++r) o[d0][r] += tb[r] * rf[r];
                    asm volatile("" ::: "memory");
                }
            }
        }
        {
            const int qi = wq * 32 + r32;
            const bf16_t* vt = p.VT() + (size_t)bh * 128 * RB + ib + hi * 8;
#pragma unroll 1
            for (int jb = 0; jb < 4; ++jb) {
                asm volatile("" ::: "memory");
                const bf16_t* rk = p.RK() + ((size_t)bh * RB + ib + jb * 32 + r32) * 64 + hi * 8;
                f32x16 pp = f32x16{};
#pragma unroll
                for (int ks = 0; ks < 4; ++ks) pp = __builtin_amdgcn_mfma_f32_32x32x16_bf16(ldfrag(rk + ks * 16), q[ks], pp, 0, 0, 0);
#pragma unroll
                for (int r = 0; r < 16; ++r) {
                    const int dd = qi - (jb * 32 + crow(r, hi));
                    const float ex = __builtin_amdgcn_exp2f(dd > 0 ? (float)dd * lf : (float)(-dd) * lb); const float w = dd == 0 ? 2.0f : ex;
                    pp[r] *= w;
                }
                bf16x8 pa0, pa1;
                PK4(pp, 0, pa0); PK4(pp, 8, pa1);
#pragma unroll
                for (int d0 = 0; d0 < 4; ++d0) {
                    o[d0] = __builtin_amdgcn_mfma_f32_32x32x16_bf16(pa0, ldfrag(vt + (size_t)(d0 * 32 + r32) * RB + jb * 32), o[d0], 0, 0, 0);
                    o[d0] = __builtin_amdgcn_mfma_f32_32x32x16_bf16(pa1, ldfrag(vt + (size_t)(d0 * 32 + r32) * RB + jb * 32 + 16), o[d0], 0, 0, 0);
                }
            }
        }
        __syncthreads();
        {
            float* xo = img + half * 16384 + (wq * 32) * 128 + r32;
#pragma unroll
            for (int r = 0; r < 16; ++r)
#pragma unroll
                for (int d0 = 0; d0 < 4; ++d0) xo[crow(r, hi) * 128 + d0 * 32] = o[d0][r];
        }
        __syncthreads();
        {
            const float g0 = p.ret_g[lane * 2], g1 = p.ret_g[lane * 2 + 1];
#pragma unroll 4
            for (int rr = 0; rr < 32; ++rr) {
                const int row = wid * 32 + rr, itl = row >> 7, rw = row & 127, hh = hp * 2 + itl;
                const float2 a = *(const float2*)(img + row * 128 + lane * 2);
                const float ss = wave_sum(a.x * a.x + a.y * a.y);
                const float rs = rsqrtf(ss * (1.0f / 128) + EPS);
                const size_t tt = (size_t)b * SEQ + lc * 128 + rw;
                const unsigned gg = *(const unsigned*)(p.RG() + tt * 512 + hh * 128 + lane * 2);
                const float ga = bf2f((bf16_t)(gg & 0xffff)), gb = bf2f((bf16_t)(gg >> 16));
                *(unsigned*)(p.MIX() + tt * 1024 + 512 + hh * 128 + lane * 2) = cvtpk(silu_fast(ga) * a.x * rs * g0, silu_fast(gb) * a.y * rs * g1);
            }
        }
    }
}


namespace pg8 {
constexpr int BM = 256, BK = 64, HALF = 128, HTB = HALF * BK * 2;
__device__ __forceinline__ int perm32(int rho) { const int n = rho >> 4, i = rho & 15; return 8 * (i >> 2) + 4 * n + (i & 3); }
struct GUnit { const char* A; const char* B; int i0, i1, i2, i3; };
template <class Epi, class Sched, bool GATHER, bool ALIGN_EPI>
__device__ __forceinline__ void gemm(int K, const Sched& S, const Epi& E, int tid_l) {
    const int tid = tid_l, wid = __builtin_amdgcn_readfirstlane(tid >> 6), lane = tid & 63, wr = wid >> 2, wc = wid & 3, fr = lane & 15, fq = lane >> 4;
    const int nt = K / BK;
    unsigned voffB[2], vAc[2][2], vAn[2][2];
    const size_t kstep = (size_t)(BK * 2);
    const size_t hstepB = (size_t)HALF * K * 2;
#pragma unroll
    for (int i = 0; i < 2; ++i) { int R, C; stage_rc(tid * 16 + i * 8192, R, C); const int Rb = Epi::PERM ? ((R & ~31) + perm32(R & 31)) : R;
        voffB[i] = (unsigned)(Rb * K + C) * 2u; }
    const unsigned ldsw = (unsigned)wid * 1024u;
    const int aoff = lds_byte(wr * 64 + fr, fq * 8), boff = lds_byte(wc * 32 + fr, fq * 8);
#define PG8_SA(b, h) (((b) * 2 + (h)) * HTB)
#define PG8_SB(b, h) ((4 + (b) * 2 + (h)) * HTB)
#define PG8_STAGE(bufoff, gbase, voff) do { _Pragma("unroll") for (int _i = 0; _i < 2; ++_i) \
        __builtin_amdgcn_global_load_lds((const unsigned*)((const char*)(gbase) + (voff)[_i]), (unsigned*)(smem + (bufoff) + ldsw + _i * 8192), 16, 0, 0); } while (0)
#define PG8_LDA(dst, b, h) do { _Pragma("unroll") for (int m = 0; m < 4; ++m) _Pragma("unroll") for (int k = 0; k < 2; ++k) dst[m][k] = *(const bf16x8*)(smem + PG8_SA(b, h) + aoff + m * 2048 + k * 1024); } while (0)
#define PG8_LDB(dst, b, h) do { _Pragma("unroll") for (int n = 0; n < 2; ++n) _Pragma("unroll") for (int k = 0; k < 2; ++k) dst[n][k] = *(const bf16x8*)(smem + PG8_SB(b, h) + boff + n * 2048 + k * 1024); } while (0)
#define PG8_MMA(ai, bj, At, Bt) do { __builtin_amdgcn_s_setprio(1); _Pragma("unroll") for (int m = 0; m < 4; ++m) _Pragma("unroll") for (int n = 0; n < 2; ++n) _Pragma("unroll") for (int k = 0; k < 2; ++k) \
        acc[ai][bj][m][n] = __builtin_amdgcn_mfma_f32_16x16x32_bf16(Bt[n][k], At[m][k], acc[ai][bj][m][n], 0, 0, 0); __builtin_amdgcn_s_setprio(0); } while (0)
#define PG8_WAIT_V(n) asm volatile("s_waitcnt vmcnt(" #n ")" ::: "memory")
#define PG8_WAIT_L(n) asm volatile("s_waitcnt lgkmcnt(" #n ")" ::: "memory")
#define PG8_BAR __builtin_amdgcn_s_barrier()
#define PG8_SCHED __builtin_amdgcn_sched_barrier(0)
    GUnit cur, nxt; int ui = 0;
    if (!S.next(0, cur, vAc)) return;
    f32x4 acc[2][2][4][2];
#pragma unroll
    for (int a = 0; a < 2; ++a)
#pragma unroll
        for (int b = 0; b < 2; ++b)
#pragma unroll
            for (int m = 0; m < 4; ++m)
#pragma unroll
                for (int n = 0; n < 2; ++n) acc[a][b][m][n] = (f32x4){0.f, 0.f, 0.f, 0.f};
    bf16x8 At[4][2], B0[2][2], B1[2][2];
    const char* cA = cur.A; const char* cB = cur.B;
    PG8_STAGE(PG8_SB(0, 0), cB, voffB); PG8_STAGE(PG8_SB(0, 1), cB + hstepB, voffB); PG8_STAGE(PG8_SA(0, 0), cA, vAc[0]); PG8_STAGE(PG8_SA(0, 1), cA, vAc[1]);
    if (wr == 1) PG8_BAR;
    PG8_WAIT_V(2); PG8_BAR;
    PG8_STAGE(PG8_SB(1, 0), cB + kstep, voffB); PG8_STAGE(PG8_SA(1, 0), cA + kstep, vAc[0]); PG8_STAGE(PG8_SB(1, 1), cB + hstepB + kstep, voffB);
    PG8_WAIT_V(6); PG8_BAR;
    for (;;) {
        const bool has_next = S.next(ui + 1, nxt, vAn);
        if (!GATHER || !has_next) {
#pragma unroll
            for (int h = 0; h < 2; ++h)
#pragma unroll
                for (int i = 0; i < 2; ++i) vAn[h][i] = vAc[h][i];
        }
        const char* nA = has_next ? nxt.A : cA; const char* nB = has_next ? nxt.B : cB;
#pragma unroll 1
        for (int t = 0; t < nt; t += 2) {
            const bool last = (t == nt - 2);
            const char* a1 = cA + (size_t)(t + 1) * kstep;
            const char* a2 = last ? nA : cA + (size_t)(t + 2) * kstep; const char* b2 = last ? nB : cB + (size_t)(t + 2) * kstep;
            const char* a3 = a2 + kstep; const char* b3 = b2 + kstep;
            unsigned va2[2][2];
#pragma unroll
            for (int h = 0; h < 2; ++h)
#pragma unroll
                for (int i = 0; i < 2; ++i) va2[h][i] = (GATHER && last) ? vAn[h][i] : vAc[h][i];
            PG8_LDB(B0, 0, 0); PG8_LDB(B1, 0, 1); PG8_SCHED; PG8_LDA(At, 0, 0); PG8_STAGE(PG8_SA(1, 1), a1, vAc[1]);
            PG8_WAIT_V(8); PG8_WAIT_L(0); PG8_BAR; PG8_MMA(0, 0, At, B0); PG8_MMA(0, 1, At, B1); PG8_BAR; PG8_SCHED;
            PG8_LDA(At, 0, 1); PG8_STAGE(PG8_SB(0, 0), b2, voffB); PG8_STAGE(PG8_SB(0, 1), b2 + hstepB, voffB); PG8_STAGE(PG8_SA(0, 0), a2, va2[0]);
            PG8_WAIT_V(8); PG8_WAIT_L(0); PG8_BAR; PG8_MMA(1, 0, At, B0); PG8_MMA(1, 1, At, B1); PG8_BAR; PG8_SCHED;
            PG8_LDB(B0, 1, 0); PG8_LDB(B1, 1, 1); PG8_SCHED; PG8_LDA(At, 1, 0); PG8_STAGE(PG8_SA(0, 1), a2, va2[1]);
            PG8_WAIT_V(8); PG8_WAIT_L(0); PG8_BAR; PG8_MMA(0, 0, At, B0); PG8_MMA(0, 1, At, B1); PG8_BAR; PG8_SCHED;
            PG8_LDA(At, 1, 1); PG8_STAGE(PG8_SB(1, 0), b3, voffB); PG8_STAGE(PG8_SB(1, 1), b3 + hstepB, voffB); PG8_STAGE(PG8_SA(1, 0), a3, va2[0]);
            PG8_WAIT_V(8); PG8_WAIT_L(0); PG8_BAR; PG8_MMA(1, 0, At, B0); PG8_MMA(1, 1, At, B1); PG8_BAR; PG8_SCHED;
        }
        if (ALIGN_EPI) { if (wr == 0) PG8_BAR; }
        E(acc, cur, wr, wc, fr, fq);
        if (!has_next) break;
#pragma unroll
        for (int a = 0; a < 2; ++a)
#pragma unroll
            for (int b = 0; b < 2; ++b)
#pragma unroll
                for (int m = 0; m < 4; ++m)
#pragma unroll
                    for (int n = 0; n < 2; ++n) acc[a][b][m][n] = (f32x4){0.f, 0.f, 0.f, 0.f};
        cur = nxt; cA = nA; cB = nB; ++ui;
#pragma unroll
        for (int h = 0; h < 2; ++h)
#pragma unroll
            for (int i = 0; i < 2; ++i) vAc[h][i] = vAn[h][i];
        if (ALIGN_EPI) { if (wr == 1) PG8_BAR; }
    }
    PG8_WAIT_V(0);
    if (!ALIGN_EPI) { if (wr == 0) PG8_BAR; }
    PG8_BAR;
#undef PG8_SA
#undef PG8_SB
#undef PG8_STAGE
#undef PG8_LDA
#undef PG8_LDB
#undef PG8_MMA
#undef PG8_WAIT_V
#undef PG8_WAIT_L
#undef PG8_BAR
#undef PG8_SCHED
}
__device__ __forceinline__ void plain_voffA(int K, unsigned (&vA)[2][2], int tid_l) {
#pragma unroll
    for (int i = 0; i < 2; ++i) { int R, C; stage_rc(tid_l * 16 + i * 8192, R, C); vA[0][i] = (unsigned)(R * K + C) * 2u; vA[1][i] = (unsigned)((R + HALF) * K + C) * 2u; }
}
}


struct SchedIn { const MK* p; int bid, nb, tid_l;
    __device__ __forceinline__ bool next(int i, pg8::GUnit& u, unsigned (&vA)[2][2]) const {
        const int tile = bid + i * nb; if (tile >= (NR / 256) * 12) return false;
        const int pm = tile / 12, pn = tile % 12;
        u.A = (const char*)(p->H() + (size_t)(pm * 256) * D); u.B = (const char*)(p->w_inT() + (size_t)(pn * 256) * D); u.i0 = pm; u.i1 = pn; u.i2 = 0; u.i3 = 0;
        pg8::plain_voffA(D, vA, tid_l); return true; } };
struct EpiIn { static constexpr bool PERM = false; const MK* p;
    __device__ __forceinline__ void operator()(f32x4 (&acc)[2][2][4][2], const pg8::GUnit& u, int wr, int wc, int fr_in, int fq_in) const {
        int fr = fr_in, fq = fq_in; asm volatile("" : "+v"(fr), "+v"(fq));
        const int pm = u.i0, seg = u.i1, brow = pm * 256;
        const int b = brow / RB, i0 = brow % RB;
        const bool lat = i0 >= CTX;
        const int wid = wr * 4 + wc, lane = fq * 16 + fr;
        if (lat && (seg <= 3 || seg == 6 || seg == 7)) {
#pragma unroll
            for (int ai = 0; ai < 2; ++ai)
#pragma unroll
                for (int m = 0; m < 4; ++m) {
                    const int t = i0 + ai * 128 + wr * 64 + m * 16 + fr - CTX, pos = (wc & 1) ? (t & 63) : (t >> 6);
                    const f32x4 cc = *(const f32x4*)(p->ropec() + pos * 16 + fq * 4), ss = *(const f32x4*)(p->ropes() + pos * 16 + fq * 4);
#pragma unroll
                    for (int bj = 0; bj < 2; ++bj) { const f32x4 x1 = acc[ai][bj][m][0], x2 = acc[ai][bj][m][1];
                        acc[ai][bj][m][0] = x1 * cc - x2 * ss; acc[ai][bj][m][1] = x1 * ss + x2 * cc; }
                }
        }
        if (seg == 7 || seg <= 1) {
            const float sc_ = seg == 7 ? 0.125f : 0.125f * 1.4426950408889634f;
#pragma unroll
            for (int ai = 0; ai < 2; ++ai)
#pragma unroll
                for (int bj = 0; bj < 2; ++bj)
#pragma unroll
                    for (int m = 0; m < 4; ++m) { acc[ai][bj][m][0] = acc[ai][bj][m][0] * sc_; acc[ai][bj][m][1] = acc[ai][bj][m][1] * sc_; }
        }
        if (seg <= 7 || seg >= 10) {
#pragma unroll
            for (int bj = 0; bj < 2; ++bj) {
                bf16_t* base; long rstride; bool ok = true;
                if (seg <= 1)      { const int h = (seg & 1) * 2 + bj;       base = p->Q() + (((size_t)(b * 4 + h) * SEQ + (i0 - CTX)) * 128 + wc * 32 + fq * 4); rstride = 128; ok = lat; }
                else if (seg <= 3) { const int h = (seg - 2) * 2 + bj;       base = p->K() + (((size_t)(b * 4 + h) * RB + i0) * 128 + wc * 32 + fq * 4);          rstride = 128; }
                else if (seg <= 5) { const int h = (seg - 4) * 2 + bj;       base = p->V() + (((size_t)(b * 4 + h) * RB + i0) * 128 + wc * 32 + fq * 4);          rstride = 128; }
                else if (seg == 6) { const int h = bj * 2 + (wc >> 1);       base = p->RQ() + (((size_t)(b * 4 + h) * RB + i0) * 64 + (wc & 1) * 32 + fq * 4);    rstride = 64; }
                else if (seg == 7) { const int h = bj * 2 + (wc >> 1);       base = p->RK() + (((size_t)(b * 4 + h) * RB + i0) * 64 + (wc & 1) * 32 + fq * 4);    rstride = 64; }
                else               {                                         base = p->RG() + ((size_t)(b * SEQ + (i0 - CTX)) * 512 + (seg - 10) * 256 + bj * 128 + wc * 32 + fq * 4); rstride = 512; ok = lat; }
                if (ok) {
#pragma unroll
                    for (int ai = 0; ai < 2; ++ai)
#pragma unroll
                        for (int m = 0; m < 4; ++m) { bf16_t* rp = base + (long)(ai * 128 + wr * 64 + m * 16 + fr) * rstride;
#pragma unroll
                            for (int n = 0; n < 2; ++n) { u32x2 w; w.x = cvtpk(acc[ai][bj][m][n][0], acc[ai][bj][m][n][1]); w.y = cvtpk(acc[ai][bj][m][n][2], acc[ai][bj][m][n][3]);
                                *(u32x2*)(rp + n * 16) = w; } }
                }
            }
        }
        if (seg >= 7 && seg <= 9) {
            char* img = smem + 131072 + wid * 3968;
            const int npass = seg == 7 ? 2 : 1;
#pragma unroll 1
            for (int ps = 0; ps < npass; ++ps) {
#pragma unroll
                for (int bj = 0; bj < 2; ++bj) {
                    float lg2 = 0.f; bf16_t* baseT;
                    if (seg == 7) { const int h = bj * 2 + (wc >> 1); const float dv = ps == 0 ? p->dec_f[h] : p->dec_b[h]; lg2 = log2f(1.0f / (1.0f + expf(-dv)));
                        baseT = (ps == 0 ? p->KTf() : p->KTb()) + ((size_t)(b * 4 + h) * 64 + (wc & 1) * 32) * RB + i0; }
                    else { const int h = (seg - 8) * 2 + bj; baseT = p->VT() + ((size_t)(b * 4 + h) * 128 + wc * 32) * RB + i0; }
#pragma unroll
                    for (int ai = 0; ai < 2; ++ai)
#pragma unroll
                        for (int mp = 0; mp < 2; ++mp) {
                            asm volatile("s_waitcnt lgkmcnt(0)" ::: "memory");
#pragma unroll
                            for (int mm = 0; mm < 2; ++mm) { const int m = mp * 2 + mm;
                                float f = 1.0f;
                                if (seg == 7) { const int pos = (i0 + ai * 128 + wr * 64 + m * 16 + fr) & 127; f = __builtin_amdgcn_exp2f((float)(ps == 0 ? 127 - pos : pos) * lg2); }
#pragma unroll
                                for (int n = 0; n < 2; ++n)
#pragma unroll
                                    for (int j = 0; j < 4; ++j) *(bf16_t*)(img + (n * 16 + fq * 4 + j) * 80 + (mm * 16 + fr) * 2) = f2bf(acc[ai][bj][m][n][j] * f); }
                            asm volatile("s_waitcnt lgkmcnt(0)" ::: "memory");
                            const int ib = ai * 128 + wr * 64 + mp * 32;
#pragma unroll
                            for (int k = 0; k < 2; ++k) { const int q = lane + 64 * k, col = q >> 2, ch = q & 3;
                                *(u32x4*)(baseT + (size_t)col * RB + ib + ch * 8) = *(const u32x4*)(img + col * 80 + ch * 16); }
                        }
                }
            }
        }
    } };
__device__ __forceinline__ void ph_gemm_in(const MK& p, int bid, int nb, int tid_l) {
    SchedIn S{&p, bid, nb, tid_l}; EpiIn E{&p};
    pg8::gemm<EpiIn, SchedIn, false, true>(D, S, E, tid_l);
}

struct SchedOut { const MK* p; int bid, nb, tid_l;
    __device__ __forceinline__ bool next(int i, pg8::GUnit& u, unsigned (&vA)[2][2]) const {
        const int tile = bid + i * nb; if (tile >= (T / 256) * 4) return false;
        const int pm = tile >> 2, pn = tile & 3;
        u.A = (const char*)(p->MIX() + (size_t)(pm * 256) * D); u.B = (const char*)(p->w_outT() + (size_t)(pn * 256) * D); u.i0 = pm; u.i1 = pn; u.i2 = 0; u.i3 = 0;
        pg8::plain_voffA(D, vA, tid_l); return true; } };
struct EpiOut { static constexpr bool PERM = false; const MK* p;
    __device__ __forceinline__ void operator()(const f32x4 (&acc)[2][2][4][2], const pg8::GUnit& u, int wr, int wc, int fr, int fq) const {
        const int brow = u.i0 * 256, bcol = u.i1 * 256;
        const float* g1 = p->mod() + (size_t)(brow / SEQ) * 6 * D + 2 * D + bcol + wc * 32 + fq * 4;
        f32x4 gv[2][2];
#pragma unroll
        for (int bj = 0; bj < 2; ++bj)
#pragma unroll
            for (int n = 0; n < 2; ++n) gv[bj][n] = *(const f32x4*)(g1 + bj * 128 + n * 16);
#pragma unroll
        for (int ai = 0; ai < 2; ++ai)
#pragma unroll
            for (int m = 0; m < 4; ++m) {
                const size_t o = (size_t)(brow + ai * 128 + wr * 64 + m * 16 + fr) * D + bcol + wc * 32 + fq * 4;
                f32x4 xv[2][2];
#pragma unroll
                for (int bj = 0; bj < 2; ++bj)
#pragma unroll
                    for (int n = 0; n < 2; ++n) xv[bj][n] = *(const f32x4*)(p->x + o + bj * 128 + n * 16);
#pragma unroll
                for (int bj = 0; bj < 2; ++bj)
#pragma unroll
                    for (int n = 0; n < 2; ++n) *(f32x4*)(p->out + o + bj * 128 + n * 16) = xv[bj][n] + gv[bj][n] * acc[ai][bj][m][n];
                if (m & 1) asm volatile("" ::: "memory");
            }
    } };
__device__ __forceinline__ void ph_gemm_out(const MK& p, int bid, int nb, int tid_l) {
    SchedOut S{&p, bid, nb, tid_l}; EpiOut E{&p};
    pg8::gemm<EpiOut, SchedOut, false, true>(D, S, E, tid_l);
}

template <bool DUMMY, int MODE = 0> __device__ __forceinline__ void ph_route(const MK& p, int bid, int nb, int tid_l) {
    int* cntp = p.cnt() + (DUMMY ? 128 : 0); int* tl = DUMMY ? (int*)(p.ws + 480 * MiB) : p.tok_list(); float* wl_ = DUMMY ? (float*)(p.ws + 488 * MiB) : p.wt_list(); int* tm = DUMMY ? (int*)(p.ws + 496 * MiB) : p.tokmap();
    const int tid = tid_l, wid = tid >> 6, lane = tid & 63, fr = lane & 15, fq = lane >> 4;
    float* lg = (float*)smem;
    int* wcnt = (int*)(smem + 34816);
    int* pref = wcnt + 512;
    bf16_t* H2lo = (bf16_t*)(p.ws + 325 * MiB);
    for (int item = bid; item < T / 128; item += nb) {
        const int t0 = item * 128 + wid * 16, b = (item * 128) / SEQ;
        const float* msh = p.mod() + (size_t)b * 6 * D + 3 * D; const float* msc = p.mod() + (size_t)b * 6 * D + 4 * D;
#pragma unroll 1
        for (int r0 = 0; r0 < 16; r0 += 4) {
            float4 xv[4][4];
#pragma unroll
            for (int rr = 0; rr < 4; ++rr)
#pragma unroll
                for (int q = 0; q < 4; ++q) xv[rr][q] = *(const float4*)(p.out + (size_t)(t0 + r0 + rr) * D + q * 256 + lane * 4);
#pragma unroll
            for (int rr = 0; rr < 4; ++rr) {
                float ss = 0.f;
#pragma unroll
                for (int q = 0; q < 4; ++q) ss += xv[rr][q].x * xv[rr][q].x + xv[rr][q].y * xv[rr][q].y + xv[rr][q].z * xv[rr][q].z + xv[rr][q].w * xv[rr][q].w;
                ss = wave_sum(ss);
                const float rstd = rsqrtf(ss * (1.0f / D) + EPS);
#pragma unroll
                for (int q = 0; q < 4; ++q) {
                    const int c0 = q * 256 + lane * 4;
                    const float4 gg = *(const float4*)(p.norm2_g + c0), sh = *(const float4*)(msh + c0), sc = *(const float4*)(msc + c0);
                    const float h0 = xv[rr][q].x * rstd * gg.x * (1 + sc.x) + sh.x, h1 = xv[rr][q].y * rstd * gg.y * (1 + sc.y) + sh.y;
                    const float h2v = xv[rr][q].z * rstd * gg.z * (1 + sc.z) + sh.z, h3 = xv[rr][q].w * rstd * gg.w * (1 + sc.w) + sh.w;
                    u32x2 wh, wl2; wh.x = cvtpk(h0, h1); wh.y = cvtpk(h2v, h3);
                    wl2.x = cvtpk(h0 - __uint_as_float(wh.x << 16), h1 - __uint_as_float(wh.x & 0xffff0000u));
                    wl2.y = cvtpk(h2v - __uint_as_float(wh.y << 16), h3 - __uint_as_float(wh.y & 0xffff0000u));
                    *(u32x2*)(p.H2() + (size_t)(t0 + r0 + rr) * D + c0) = wh;
                    *(u32x2*)(H2lo + (size_t)(t0 + r0 + rr) * D + c0) = wl2;
                }
            }
        }
        asm volatile("s_waitcnt vmcnt(0)" ::: "memory");
        __syncthreads();
        if (MODE == 3) continue;
        f32x4 acc[4];
#pragma unroll
        for (int nt = 0; nt < 4; ++nt) acc[nt] = (f32x4){0.f, 0.f, 0.f, 0.f};
        {
            const bf16_t* ah_p = p.H2() + (size_t)(t0 + fr) * D + fq * 8; const bf16_t* al_p = H2lo + (size_t)(t0 + fr) * D + fq * 8;
            const int widu = __builtin_amdgcn_readfirstlane(wid);
            unsigned rofs[4];
#pragma unroll
            for (int i = 0; i < 4; ++i) { const int x = wid * 1024 + i * 8192 + lane * 16, row = x >> 8, c = ((x & 255) >> 4) ^ (row & 15); rofs[i] = (unsigned)(row * 2048 + c * 16); }
#define RT_DMA(kc, buf) do { const char* src_ = (const char*)p.routerT() + (size_t)(kc) * 256;                                             \
            _Pragma("unroll") for (int i = 0; i < 4; ++i) __builtin_amdgcn_global_load_lds((const unsigned*)(src_ + rofs[i]), (unsigned*)(smem + 40960 + (buf) * 32768 + widu * 1024 + i * 8192), 16, 0, 0); } while (0)
            RT_DMA(0, 0);
#pragma unroll 1
            for (int kc = 0; kc < 8; ++kc) {
                bf16x8 ah[4], al[4];
#pragma unroll
                for (int ks = 0; ks < 4; ++ks) { ah[ks] = ldfrag(ah_p + kc * 128 + ks * 32); al[ks] = ldfrag(al_p + kc * 128 + ks * 32); }
                asm volatile("s_waitcnt vmcnt(0)" ::: "memory"); __syncthreads();
                if (kc + 1 < 8) RT_DMA(kc + 1, (kc + 1) & 1);
                const char* bb = smem + 40960 + (kc & 1) * 32768;
#pragma unroll
                for (int ks = 0; ks < 4; ++ks)
#pragma unroll
                    for (int nt = 0; nt < 4; ++nt) {
                        const int row = nt * 16 + fr, cc = ((ks * 4 + fq) ^ (row & 15)) * 16;
                        const bf16x8 bh = *(const bf16x8*)(bb + row * 256 + cc), bl = *(const bf16x8*)(bb + (64 + row) * 256 + cc);
                        acc[nt] = __builtin_amdgcn_mfma_f32_16x16x32_bf16(ah[ks], bh, acc[nt], 0, 0, 0);
                        acc[nt] = __builtin_amdgcn_mfma_f32_16x16x32_bf16(ah[ks], bl, acc[nt], 0, 0, 0);
                        acc[nt] = __builtin_amdgcn_mfma_f32_16x16x32_bf16(al[ks], bh, acc[nt], 0, 0, 0);
                    }
            }
#undef RT_DMA
        }
#pragma unroll
        for (int nt = 0; nt < 4; ++nt)
#pragma unroll
            for (int j = 0; j < 4; ++j) lg[(wid * 16 + fq * 4 + j) * 65 + nt * 16 + fr] = acc[nt][j];
        __syncthreads();
        if (MODE == 2) continue;
        int l3 = lane; asm volatile("" : "+v"(l3));
#define SHXF(v_, m_) __int_as_float(__builtin_amdgcn_ds_bpermute((l3 ^ (m_)) << 2, __float_as_int(v_)))
#define SHXI(v_, m_) __builtin_amdgcn_ds_bpermute((l3 ^ (m_)) << 2, (v_))
#define SHBF(v_, src_) __int_as_float(__builtin_amdgcn_ds_bpermute((src_) << 2, __float_as_int(v_)))
#define SHBI(v_, src_) __builtin_amdgcn_ds_bpermute((src_) << 2, (v_))
        const int q4 = l3 & 3, tt = wid * 16 + (l3 >> 2), t = item * 128 + tt, qbase = l3 & ~3;
        float sc_[16], v[16];
#pragma unroll
        for (int i = 0; i < 16; ++i) { const float x = lg[tt * 65 + q4 * 16 + i]; sc_[i] = __builtin_amdgcn_rcpf(1.0f + __builtin_amdgcn_exp2f(-1.4426950408889634f * x)); v[i] = sc_[i] + p.router_b[q4 * 16 + i]; }
        float gsA, gsB;
        { float m1 = v[0], m2 = -INFINITY;
#pragma unroll
          for (int i = 1; i < 8; ++i) { const float x = v[i]; m2 = fmaxf(m2, fminf(m1, x)); m1 = fmaxf(m1, x); }
          gsA = m1 + m2; m1 = v[8]; m2 = -INFINITY;
#pragma unroll
          for (int i = 9; i < 16; ++i) { const float x = v[i]; m2 = fmaxf(m2, fminf(m1, x)); m1 = fmaxf(m1, x); }
          gsB = m1 + m2; }
        { int rankA = 0, rankB = 0;
#pragma unroll
          for (int qq = 0; qq < 4; ++qq) {
              const float ga = SHBF(gsA, qbase | qq), gb = SHBF(gsB, qbase | qq);
              const int g0 = 2 * qq, g1 = 2 * qq + 1, mA = 2 * q4, mB = 2 * q4 + 1;
              rankA += (g0 != mA && (ga > gsA || (ga == gsA && g0 < mA))) ? 1 : 0; rankA += (g1 != mA && (gb > gsA || (gb == gsA && g1 < mA))) ? 1 : 0;
              rankB += (g0 != mB && (ga > gsB || (ga == gsB && g0 < mB))) ? 1 : 0; rankB += (g1 != mB && (gb > gsB || (gb == gsB && g1 < mB))) ? 1 : 0;
          }
          if (rankA >= 4) {
#pragma unroll
              for (int i = 0; i < 8; ++i) v[i] = -INFINITY; }
          if (rankB >= 4) {
#pragma unroll
              for (int i = 8; i < 16; ++i) v[i] = -INFINITY; } }
        unsigned chm = 0u;
#pragma unroll 1
        for (int it = 0; it < 8; ++it) {
            float lm = v[0];
#pragma unroll
            for (int i = 1; i < 16; ++i) lm = fmaxf(lm, v[i]);
            float gm = fmaxf(lm, SHXF(lm, 1)); gm = fmaxf(gm, SHXF(gm, 2));
            int cand = (lm == gm) ? q4 : 4;
            cand = min(cand, SHXI(cand, 1)); cand = min(cand, SHXI(cand, 2));
            const bool win = cand == q4;
            bool found = false;
#pragma unroll
            for (int i = 0; i < 16; ++i) { const bool hit = win && !found && v[i] == gm; if (hit) { chm |= (1u << i); v[i] = -INFINITY; } found = found || hit; }
        }
        float wsum = 0.f;
#pragma unroll
        for (int i = 0; i < 16; ++i) wsum += ((chm >> i) & 1u) ? sc_[i] : 0.f;
        wsum += SHXF(wsum, 1); wsum += SHXF(wsum, 2);
        const float wscale = 2.5f / wsum;
        const unsigned long long pat = 0x1111111111111111ull << q4;
#pragma unroll
        for (int i = 0; i < 16; ++i) { const unsigned long long bal = __ballot((chm >> i) & 1u); if (l3 < 4) wcnt[wid * 64 + l3 * 16 + i] = __popcll(bal & (0x1111111111111111ull << l3)); }
        __syncthreads();
        if (wid == 0) {
            int tot = 0;
#pragma unroll
            for (int w = 0; w < 8; ++w) tot += wcnt[w * 64 + lane];
            int run = atomicAdd(&cntp[lane], tot);
#pragma unroll
            for (int w = 0; w < 8; ++w) { const int c = wcnt[w * 64 + lane]; pref[w * 64 + lane] = run; run += c; }
        }
        __syncthreads();
        {
            const int pc = __popc(chm);
            int kbase = 0;
#pragma unroll
            for (int qq = 0; qq < 3; ++qq) { const int o = SHBI(pc, qbase | qq); kbase += (qq < q4) ? o : 0; }
#pragma unroll
            for (int i = 0; i < 16; ++i) {
                const bool c = (chm >> i) & 1u;
                const unsigned long long bal = __ballot(c);
                if (c) {
                    const int e = q4 * 16 + i;
                    const int slot = pref[wid * 64 + e] + __popcll(bal & pat & ((1ull << l3) - 1ull));
                    tl[(size_t)e * ECAP + slot] = t; wl_[(size_t)e * ECAP + slot] = sc_[i] * wscale;
                    tm[(size_t)t * 8 + kbase + __popc(chm & ((1u << i) - 1u))] = e * ECAP + slot;
                }
            }
        }
    }
}
#undef SHXF
#undef SHXI
#undef SHBF
#undef SHBI

constexpr int MOE_AUX = 162816;
__device__ __forceinline__ void moe_tables(const MK& p, int colt, int* tpre, int* rbase, int tid_l) {
    __syncthreads();
    if (tid_l == 0) { int tp = 0, rb = 0;
        for (int e = 0; e < 65; ++e) { const int c = e < 64 ? p.cnt()[e] : T; tpre[e] = tp; rbase[e] = rb; tp += ((c + 255) >> 8) * colt; rb += c; }
        tpre[65] = tp; rbase[65] = rb; }
    __syncthreads();
}
struct SchedUp { const MK* p; int bid, nb, tid_l, ntiles; const int* tpre; const int* rbase; mutable int e_hint;
    __device__ __forceinline__ bool next(int i, pg8::GUnit& u, unsigned (&vA)[2][2]) const {
        const int tile = bid + i * nb; if (tile >= ntiles) return false;
        int e = e_hint; while (tile >= tpre[e + 1]) ++e; e_hint = e;
        const int j = tile - tpre[e], rt = j >> 1, ct = j & 1, cnt_e = rbase[e + 1] - rbase[e];
        u.A = (const char*)p->H2(); u.B = (const char*)(p->W13t() + ((size_t)e * 512 + ct * 256) * D); u.i0 = e; u.i1 = rt; u.i2 = ct; u.i3 = cnt_e;
#pragma unroll
        for (int i2 = 0; i2 < 2; ++i2) { int R, C; stage_rc(tid_l * 16 + i2 * 8192, R, C);
#pragma unroll
            for (int h = 0; h < 2; ++h) { int slot = rt * 256 + h * 128 + R; if (slot >= cnt_e) slot = 0;
                const int tok = e < 64 ? p->tok_list()[(size_t)e * ECAP + slot] : slot;
                vA[h][i2] = (unsigned)tok * (D * 2u) + (unsigned)C * 2u; } }
        return true; } };
struct EpiUp { static constexpr bool PERM = true; const MK* p; const int* rbase;
    __device__ __forceinline__ void operator()(const f32x4 (&acc)[2][2][4][2], const pg8::GUnit& u, int wr, int wc, int fr, int fq) const {
        const int e = u.i0, rt = u.i1, ct = u.i2, cnt_e = u.i3;
        bf16_t* ab = p->ACT() + (size_t)rbase[e] * DE + ct * 128 + wc * 32 + fq * 8;
#pragma unroll
        for (int ai = 0; ai < 2; ++ai)
#pragma unroll
            for (int m = 0; m < 4; ++m) {
                const int slot = rt * 256 + ai * 128 + wr * 64 + m * 16 + fr;
                u32x4 w;
                w.x = cvtpk(silu_fast(acc[ai][0][m][0][0]) * acc[ai][1][m][0][0], silu_fast(acc[ai][0][m][0][1]) * acc[ai][1][m][0][1]);
                w.y = cvtpk(silu_fast(acc[ai][0][m][0][2]) * acc[ai][1][m][0][2], silu_fast(acc[ai][0][m][0][3]) * acc[ai][1][m][0][3]);
                w.z = cvtpk(silu_fast(acc[ai][0][m][1][0]) * acc[ai][1][m][1][0], silu_fast(acc[ai][0][m][1][1]) * acc[ai][1][m][1][1]);
                w.w = cvtpk(silu_fast(acc[ai][0][m][1][2]) * acc[ai][1][m][1][2], silu_fast(acc[ai][0][m][1][3]) * acc[ai][1][m][1][3]);
                if (slot < cnt_e) *(u32x4*)(ab + (size_t)slot * DE) = w;
            }
    } };
__device__ __forceinline__ void ph_moe_up(const MK& p, int bid, int nb, int tid_l) {
    int* tpre = (int*)(smem + MOE_AUX); int* rbase = tpre + 80;
    moe_tables(p, 2, tpre, rbase, tid_l);
    SchedUp S{&p, bid, nb, tid_l, tpre[65], tpre, rbase, 0}; EpiUp E{&p, rbase};
    pg8::gemm<EpiUp, SchedUp, true, true>(D, S, E, tid_l);
}
constexpr float Y_SCALE = 64.0f;
struct SchedDown { const MK* p; int bid, nb, tid_l, ntiles; const int* tpre; const int* rbase; mutable int e_hint;
    __device__ __forceinline__ bool next(int i, pg8::GUnit& u, unsigned (&vA)[2][2]) const {
        const int tile = bid + i * nb; if (tile >= ntiles) return false;
        int e = e_hint; while (tile >= tpre[e + 1]) ++e; e_hint = e;
        const int j = tile - tpre[e], rt = j >> 2, ct = j & 3, cnt_e = rbase[e + 1] - rbase[e];
        u.A = (const char*)(p->ACT() + (size_t)(rbase[e] + rt * 256) * DE); u.B = (const char*)(p->W2t() + ((size_t)e * D + ct * 256) * DE); u.i0 = e; u.i1 = rt; u.i2 = ct; u.i3 = cnt_e;
        pg8::plain_voffA(DE, vA, tid_l); return true; } };
template <int MODE> struct EpiDown { static constexpr bool PERM = true; const MK* p; const int* rbase;
    __device__ __forceinline__ void operator()(const f32x4 (&acc)[2][2][4][2], const pg8::GUnit& u, int wr, int wc, int fr, int fq) const {
        const int e = u.i0, rt = u.i1, ct = u.i2, cnt_e = u.i3;
        const int col0 = ct * 256 + wc * 32 + fq * 8;
        if (e < 64) {
            const float* wl = p->wt_list() + (size_t)e * ECAP;
            float wv[2][4];
#pragma unroll
            for (int ai = 0; ai < 2; ++ai)
#pragma unroll
                for (int m = 0; m < 4; ++m) { const int sl = rt * 256 + ai * 128 + wr * 64 + m * 16 + fr; wv[ai][m] = wl[sl < cnt_e ? sl : 0] * Y_SCALE; }
            const int wid = wr * 4 + wc, lane = fq * 16 + fr;
            char* wa = smem + 131072 + wid * 3968;
            unsigned char* yb = p->Y() + (size_t)rbase[e] * D + ct * 256 + wc * 64 + (lane & 3) * 16;
#pragma unroll
            for (int ai = 0; ai < 2; ++ai)
#pragma unroll
                for (int m = 0; m < 4; ++m) {
                    const float w = wv[ai][m];
                    char* img = wa + ((m & 1) ? 1280 : 0);
#pragma unroll
                    for (int bj = 0; bj < 2; ++bj) {
                        u32x2 pk;
#pragma unroll
                        for (int n = 0; n < 2; ++n) {
                            float v0 = __builtin_amdgcn_fmed3f(acc[ai][bj][m][n][0] * w, -448.f, 448.f), v1 = __builtin_amdgcn_fmed3f(acc[ai][bj][m][n][1] * w, -448.f, 448.f);
                            float v2 = __builtin_amdgcn_fmed3f(acc[ai][bj][m][n][2] * w, -448.f, 448.f), v3 = __builtin_amdgcn_fmed3f(acc[ai][bj][m][n][3] * w, -448.f, 448.f);
                            int q = 0; q = __builtin_amdgcn_cvt_pk_fp8_f32(v0, v1, q, false); q = __builtin_amdgcn_cvt_pk_fp8_f32(v2, v3, q, true);
                            if (n == 0) pk.x = (unsigned)q; else pk.y = (unsigned)q;
                        }
                        *(u32x2*)(img + fr * 80 + bj * 32 + fq * 8) = pk;
                    }
                    asm volatile("s_waitcnt lgkmcnt(0)" ::: "memory");
                    const int rr = lane >> 2, slot = rt * 256 + ai * 128 + wr * 64 + m * 16 + rr;
                    const u32x4 v = *(const u32x4*)(img + rr * 80 + (lane & 3) * 16);
                    if (MODE == 1) asm volatile("" :: "v"(v)); else if (slot < cnt_e) *(u32x4*)(yb + (size_t)slot * D) = v;
                }
        } else {
            const float* g2 = p->mod() + (size_t)((rt * 256) / SEQ) * 6 * D + 5 * D + col0;
            f32x4 gv[2][2];
#pragma unroll
            for (int bj = 0; bj < 2; ++bj)
#pragma unroll
                for (int n = 0; n < 2; ++n) gv[bj][n] = *(const f32x4*)(g2 + bj * 128 + n * 4);
            float* xb = p->out + (size_t)(rt * 256) * D + col0;
#pragma unroll
            for (int ai = 0; ai < 2; ++ai)
#pragma unroll
                for (int m = 0; m < 4; ++m) {
                    float* xp = xb + (size_t)(ai * 128 + wr * 64 + m * 16 + fr) * D;
                    f32x4 xv[2][2];
#pragma unroll
                    for (int bj = 0; bj < 2; ++bj)
#pragma unroll
                        for (int n = 0; n < 2; ++n) xv[bj][n] = *(const f32x4*)(xp + bj * 128 + n * 4);
#pragma unroll
                    for (int bj = 0; bj < 2; ++bj)
#pragma unroll
                        for (int n = 0; n < 2; ++n) *(f32x4*)(xp + bj * 128 + n * 4) = xv[bj][n] + gv[bj][n] * acc[ai][bj][m][n];
                    if (m & 1) asm volatile("" ::: "memory");
                }
        }
    } };
template <bool DUMMY, int MODE = 0> __device__ __forceinline__ void ph_moe_down(const MK& p, int bid, int nb, int tid_l) {
    int* tpre = (int*)(smem + MOE_AUX); int* rbase = tpre + 80;
    moe_tables(p, 4, tpre, rbase, tid_l);
    SchedDown S{&p, bid, nb, tid_l, DUMMY ? tpre[64] : tpre[65], tpre, rbase, 0}; EpiDown<MODE> E{&p, rbase};
    pg8::gemm<EpiDown<MODE>, SchedDown, false, true>(DE, S, E, tid_l);
}

template <bool DUMMY> __device__ __forceinline__ void ph_final(const MK& p, int bid, int nb, int tid_l) {
    const int wid = tid_l >> 6, lane = tid_l & 63;
    int* tpre = (int*)(smem + MOE_AUX); int* rbase = tpre + 80;
    moe_tables(p, 1, tpre, rbase, tid_l);
    for (int t = bid * 8 + wid; t < T; t += nb * 8) {
        const int b = t / SEQ;
        float f[16];
#pragma unroll
        for (int i = 0; i < 16; ++i) f[i] = 0.f;
#pragma unroll
        for (int k = 0; k < 8; ++k) {
            const int id = p.tokmap()[(size_t)t * 8 + k], e = id >> 15, slot = id & (ECAP - 1);
            const unsigned char* yr = p.Y() + (size_t)(rbase[e] + slot) * D + lane * 4;
#pragma unroll
            for (int q = 0; q < 4; ++q) {
                const int w = *(const int*)(yr + q * 256);
                const auto lo = __builtin_amdgcn_cvt_pk_f32_fp8(w, false); const auto hi = __builtin_amdgcn_cvt_pk_f32_fp8(w, true);
                f[q * 4 + 0] += lo[0]; f[q * 4 + 1] += lo[1]; f[q * 4 + 2] += hi[0]; f[q * 4 + 3] += hi[1];
            }
        }
        const int pcol = ((lane >> 3) & 1) * 128 + (lane >> 4) * 32 + (lane & 7) * 4;
        const float* g2 = p.mod() + (size_t)b * 6 * D + 5 * D + pcol;
        float* xo = p.out + (size_t)t * D + pcol;
        float v[16]; float ss = 0.f;
#pragma unroll
        for (int q = 0; q < 4; ++q) {
            const float4 xv = *(const float4*)(xo + q * 256), g = *(const float4*)(g2 + q * 256);
            v[q * 4 + 0] = xv.x + g.x * f[q * 4 + 0] * (1.0f / Y_SCALE); v[q * 4 + 1] = xv.y + g.y * f[q * 4 + 1] * (1.0f / Y_SCALE);
            v[q * 4 + 2] = xv.z + g.z * f[q * 4 + 2] * (1.0f / Y_SCALE); v[q * 4 + 3] = xv.w + g.w * f[q * 4 + 3] * (1.0f / Y_SCALE);
            ss += v[q * 4] * v[q * 4] + v[q * 4 + 1] * v[q * 4 + 1] + v[q * 4 + 2] * v[q * 4 + 2] + v[q * 4 + 3] * v[q * 4 + 3];
        }
        ss = wave_sum(ss);
        const float rstd = rsqrtf(ss * (1.0f / D) + EPS);
#pragma unroll
        for (int q = 0; q < 4; ++q) {
            const float4 gf = *(const float4*)(p.final_g + q * 256 + pcol);
            *(float4*)((DUMMY ? (float*)(p.ws + 42 * MiB) + (size_t)t * D + pcol : xo) + q * 256) = make_float4(v[q * 4] * rstd * gf.x, v[q * 4 + 1] * rstd * gf.y, v[q * 4 + 2] * rstd * gf.z, v[q * 4 + 3] * rstd * gf.w);
        }
    }
}


#define XB_TMO      128
#define XB_XCNT(j)  (256  + 64 * (j))
#define XB_XSUB(j)  (1280 + 64 * (j))
#define XB_XGEN(j)  (2304 + 64 * (j))
#define XB_TOP      3328
#define XB_TOPGEN   3392
#define XCD_BAR_WORDS 3456
#define XB_SPIN_CAP (1u << 22)
#define LAS __attribute__((address_space(3)))
__device__ __forceinline__ unsigned xb_ld(unsigned* p)              { return __hip_atomic_load(p, __ATOMIC_RELAXED, __HIP_MEMORY_SCOPE_AGENT); }
__device__ __forceinline__ unsigned xb_add(unsigned* p, unsigned v) { return __hip_atomic_fetch_add(p, v, __ATOMIC_RELAXED, __HIP_MEMORY_SCOPE_AGENT); }
__device__ __forceinline__ unsigned xb_xcc_id() { return (unsigned)__builtin_amdgcn_s_getreg((3 << 11) | 20) & 0xFu; }
#define XB_SPIN(cond, bar) do { unsigned _sp = 0; while (cond) { __builtin_amdgcn_s_sleep(1); \
    if ((++_sp & 255u) == 0u) { if (xb_ld(&(bar)[XB_TMO])) break; if (_sp > XB_SPIN_CAP) { atomicAdd(&(bar)[XB_TMO], 1u); break; } } } } while (0)
struct XcdBarrier { unsigned* bar; unsigned x; volatile LAS unsigned* st; };
__device__ __forceinline__ XcdBarrier xcd_barrier_post(unsigned* bar, volatile LAS unsigned* st, int tid) {
    XcdBarrier b; b.bar = bar; b.x = xb_xcc_id(); b.st = st;
    if (tid == 0) (void)xb_add(&bar[XB_XCNT(b.x)], 1u);
    return b;
}
__device__ __forceinline__ void xcd_barrier_complete(unsigned* bar, unsigned x, unsigned& nloc, unsigned& nx) {
    const unsigned G = gridDim.x * gridDim.y * gridDim.z;
    unsigned sum, cnt, mine, sp = 0u;
    for (;;) {
        sum = 0u; cnt = 0u; mine = 0u;
#pragma unroll
        for (unsigned j = 0; j < 16; ++j) { const unsigned c = xb_ld(&bar[XB_XCNT(j)]); sum += c; cnt += (c > 0u) ? 1u : 0u; mine = (j == x) ? c : mine; }
        if (sum == G) break;
        __builtin_amdgcn_s_sleep(1);
        if ((++sp & 255u) == 0u) { if (xb_ld(&bar[XB_TMO])) break; if (sp > XB_SPIN_CAP) { atomicAdd(&bar[XB_TMO], 1u); break; } }
    }
    nloc = mine > 0u ? mine : 1u; nx = cnt > 0u ? cnt : 1u;
}
__device__ __forceinline__ void xcd_barrier(const XcdBarrier& b, int tid) {
    asm volatile("s_waitcnt vmcnt(0)" ::: "memory");
    __syncthreads();
    if (tid == 0) {
        unsigned* bar = b.bar;
        __builtin_amdgcn_s_waitcnt(0);
        unsigned nloc = b.st[0], nx = b.st[1];
        if (nloc == 0u) { xcd_barrier_complete(bar, b.x, nloc, nx); b.st[0] = nloc; b.st[1] = nx; }
        const unsigned old = xb_add(&bar[XB_XSUB(b.x)], 1u);
        const unsigned gen = old / nloc;
        if (old + 1u == (gen + 1u) * nloc) {
            __builtin_amdgcn_fence(__ATOMIC_RELEASE, "agent");
            asm volatile("s_waitcnt vmcnt(0)" ::: "memory");
            const unsigned og = xb_add(&bar[XB_TOP], 1u);
            const unsigned tg = og / nx;
            if (og + 1u == (tg + 1u) * nx) xb_add(&bar[XB_TOPGEN], 1u);
            else XB_SPIN(xb_ld(&bar[XB_TOPGEN]) == tg, bar);
            __builtin_amdgcn_fence(__ATOMIC_ACQUIRE, "agent");
            xb_add(&bar[XB_XGEN(b.x)], 1u);
            asm volatile("s_waitcnt vmcnt(0)" ::: "memory");
        } else {
            XB_SPIN(xb_ld(&bar[XB_XGEN(b.x)]) == gen, bar);
            __builtin_amdgcn_fence(__ATOMIC_ACQUIRE, "agent");
            asm volatile("s_waitcnt vmcnt(0)" ::: "memory");
        }
    }
    __syncthreads();
}

__device__ __forceinline__ int lane_id_volatile() { int l; asm volatile("v_mbcnt_lo_u32_b32 %0, -1, 0\n\tv_mbcnt_hi_u32_b32 %0, -1, %0" : "=v"(l)); return l; }
__global__ __launch_bounds__(512, 2) void k_mega(MK p) {
    cg::grid_group grid = cg::this_grid();
    const int bid = blockIdx.x, nb = gridDim.x;
    volatile LAS unsigned* xst = (volatile LAS unsigned*)(smem + 162816 + 768);
    if (threadIdx.x < 4) xst[threadIdx.x] = 0u;
    __syncthreads();
    const XcdBarrier xb = xcd_barrier_post((unsigned*)(p.ws + 524288), xst, (int)threadIdx.x);
    const int wv_ = __builtin_amdgcn_readfirstlane((int)threadIdx.x >> 6);
#define LANE_ID() lane_id_volatile()
#define PH_TID() int t_ = wv_ * 64 + LANE_ID(); asm volatile("" : "+v"(t_))
    { PH_TID(); if (bid == 0 && t_ < 256) p.cnt()[t_] = 0; ph_mod(p, bid, nb, t_); ph_convert(p, bid, nb, t_); }
#if DUP == 10
    { PH_TID(); ph_convert(p, bid, nb, t_); }
#endif
    grid.sync();
    { PH_TID(); ph_ln1(p, bid, nb, t_); }
#if DUP == 1
    { PH_TID(); ph_ln1(p, bid, nb, t_); }
#endif
    xcd_barrier(xb, wv_ * 64 + LANE_ID());
    { PH_TID(); ph_gemm_in(p, bid, nb, t_); }
    { PH_TID(); ph_convert_dyn(p, t_); }
#if DUP == 2
    { PH_TID(); ph_gemm_in(p, bid, nb, t_); }
#endif
    xcd_barrier(xb, wv_ * 64 + LANE_ID());
    { PH_TID(); ph_attn<0>(p, bid, nb, t_); }
#if DUP == 3
    { PH_TID(); ph_attn<2>(p, bid, nb, t_); }
#endif
#if DUP == 31
    { PH_TID(); ph_attn<1>(p, bid, nb, t_); }
#endif
#if DUP == 33
    { PH_TID(); ph_attn<3>(p, bid, nb, t_); }
#endif
    { PH_TID(); ph_kv(p, bid, nb, t_); }
#if DUP == 11
    { PH_TID(); ph_kv(p, bid, nb, t_); }
#endif
    xcd_barrier(xb, wv_ * 64 + LANE_ID());
    { PH_TID(); ph_scan(p, bid, nb, t_); }
    xcd_barrier(xb, wv_ * 64 + LANE_ID());
    { PH_TID(); ph_ret(p, bid, nb, t_); }
#if DUP == 5
    { PH_TID(); ph_ret(p, bid, nb, t_); }
#endif
    xcd_barrier(xb, wv_ * 64 + LANE_ID());
    { PH_TID(); ph_gemm_out(p, bid, nb, t_); }
#if DUP == 6
    { PH_TID(); ph_gemm_out(p, bid, nb, t_); }
#endif
    xcd_barrier(xb, wv_ * 64 + LANE_ID());
#if DUP == 7
    { PH_TID(); ph_route<true>(p, bid, nb, t_); }
#endif
#if DUP == 72
    { PH_TID(); ph_route<true, 2>(p, bid, nb, t_); }
#endif
#if DUP == 73
    { PH_TID(); ph_route<true, 3>(p, bid, nb, t_); }
#endif
    { PH_TID(); ph_route<false>(p, bid, nb, t_); }
    xcd_barrier(xb, wv_ * 64 + LANE_ID());
    { PH_TID(); ph_moe_up(p, bid, nb, t_); }
#if DUP == 8
    { PH_TID(); ph_moe_up(p, bid, nb, t_); }
#endif
    xcd_barrier(xb, wv_ * 64 + LANE_ID());
#if DUP == 9
    { PH_TID(); ph_moe_down<true>(p, bid, nb, t_); }
#endif
#if DUP == 91
    { PH_TID(); ph_moe_down<true, 1>(p, bid, nb, t_); }
#endif
    { PH_TID(); ph_moe_down<false>(p, bid, nb, t_); }
    xcd_barrier(xb, wv_ * 64 + LANE_ID());
#if DUP == 13
    { PH_TID(); ph_final<true>(p, bid, nb, t_); }
#endif
    { PH_TID(); ph_final<false>(p, bid, nb, t_); }
#undef PH_TID
#undef LANE_ID
}
constexpr int LDS_TOTAL = 163840;
extern "C" void kernel_launch(void* const* d_in, const int* in_sizes, int n_in, void* d_out, int out_size, void* d_ws, size_t ws_size, hipStream_t stream) {
    char* ws = (char*)d_ws;
    MK mk{};
    mk.x = (const float*)d_in[0]; mk.c = (const float*)d_in[1]; mk.ctx = (const float*)d_in[2]; mk.cctx = (const float*)d_in[3]; mk.ada_w = (const float*)d_in[4]; mk.ada_b = (const float*)d_in[5];
    mk.norm1_g = (const float*)d_in[6]; mk.w_in = (const float*)d_in[7]; mk.lq1 = (const float*)d_in[8]; mk.lk1 = (const float*)d_in[9]; mk.lq2 = (const float*)d_in[10]; mk.lk2 = (const float*)d_in[11];
    mk.dattn_g = (const float*)d_in[12]; mk.dec_f = (const float*)d_in[13]; mk.dec_b = (const float*)d_in[14]; mk.ret_g = (const float*)d_in[15]; mk.w_out = (const float*)d_in[16];
    mk.norm2_g = (const float*)d_in[17]; mk.router_w = (const float*)d_in[18]; mk.router_b = (const float*)d_in[19]; mk.ew1 = (const float*)d_in[20]; mk.ew3 = (const float*)d_in[21];
    mk.ew2 = (const float*)d_in[22]; mk.sw1 = (const float*)d_in[23]; mk.sw3 = (const float*)d_in[24]; mk.sw2 = (const float*)d_in[25]; mk.final_g = (const float*)d_in[26];
    mk.out = (float*)d_out;
    mk.ws = ws;
    mk.dbgP = nullptr; mk.dbg_lo = 0; mk.dbg_hi = 12; mk.conv_limit = 1 << 30;
    static int grid_blocks = 0;
    if (!grid_blocks) {
        (void)hipFuncSetAttribute((const void*)k_mega, hipFuncAttributeMaxDynamicSharedMemorySize, LDS_TOTAL);
        int dev = 0, cus = 0, per_cu = 0;
        (void)hipGetDevice(&dev);
        (void)hipDeviceGetAttribute(&cus, hipDeviceAttributeMultiprocessorCount, dev);
        (void)hipOccupancyMaxActiveBlocksPerMultiprocessor(&per_cu, k_mega, 512, LDS_TOTAL);
        if (per_cu > 1) per_cu = 1;
        grid_blocks = cus * per_cu;
        if (grid_blocks <= 0) { fprintf(stderr, "occupancy query failed: cus %d per_cu %d\n", cus, per_cu); grid_blocks = 256; }
    }
    (void)hipMemsetAsync(ws + 524288, 0, XCD_BAR_WORDS * 4, stream);
    void* args[] = {&mk};
    hipError_t e = hipLaunchCooperativeKernel((void*)k_mega, dim3(grid_blocks), dim3(512), args, LDS_TOTAL, stream);
    if (e != hipSuccess) fprintf(stderr, "cooperative launch failed: %s (grid %d)\n", hipGetErrorString(e), grid_blocks);
}
```

```cpp
#include <hip/hip_runtime.h>
#include <hip/hip_cooperative_groups.h>
#include <cstdio>
namespace cg = cooperative_groups;
#ifndef DUP
#define DUP 0
#endif
#include <stdint.h>

constexpr int D = 1024, NB = 4, SEQ = 8192, CTX = 256, RB = SEQ + CTX  , NR = NB * RB  , T = NB * SEQ;
constexpr int NE = 64, DE = 256, ECAP = 32768;
constexpr float EPS = 1e-6f;
typedef unsigned short bf16_t;

__device__ __forceinline__ float siluf(float v) { return v / (1.0f + expf(-v)); }
__device__ __forceinline__ float silu_fast(float v) { return v * __builtin_amdgcn_rcpf(1.0f + __builtin_amdgcn_exp2f(-1.4426950408889634f * v)); }
__device__ __forceinline__ float wave_sum(float v) {
#pragma unroll
    for (int o = 32; o > 0; o >>= 1) v += __shfl_xor(v, o);
    return v;
}
__device__ __forceinline__ float wave_max(float v) {
#pragma unroll
    for (int o = 32; o > 0; o >>= 1) v = fmaxf(v, __shfl_xor(v, o));
    return v;
}
__device__ __forceinline__ float block_sum(float v, float* red) {
    v = wave_sum(v);
    __syncthreads();
    if ((threadIdx.x & 63) == 0) red[threadIdx.x >> 6] = v;
    __syncthreads();
    return red[0] + red[1] + red[2] + red[3];
}
__device__ __forceinline__ float block_max(float v, float* red) {
    v = wave_max(v);
    __syncthreads();
    if ((threadIdx.x & 63) == 0) red[threadIdx.x >> 6] = v;
    __syncthreads();
    return fmaxf(fmaxf(red[0], red[1]), fmaxf(red[2], red[3]));
}

typedef short bf16x8 __attribute__((ext_vector_type(8)));
typedef short s16x4 __attribute__((ext_vector_type(4)));
typedef float f32x4 __attribute__((ext_vector_type(4)));
typedef float f32x16 __attribute__((ext_vector_type(16)));
typedef unsigned u32x2 __attribute__((ext_vector_type(2)));
typedef unsigned u32x4 __attribute__((ext_vector_type(4)));
extern __shared__ __attribute__((aligned(1024))) char smem[];
constexpr int NTHR = 512;
constexpr int GEMM_LDS = 131072;

__device__ __forceinline__ unsigned cvtpk(float lo, float hi) { unsigned r; asm volatile("v_cvt_pk_bf16_f32 %0, %1, %2" : "=v"(r) : "v"(lo), "v"(hi)); return r; }
__device__ __forceinline__ bf16_t f2bf(float v) { return (bf16_t)(cvtpk(v, v) & 0xffffu); }
__device__ __forceinline__ float bf2f(bf16_t v) { return __uint_as_float(((unsigned)v) << 16); }

constexpr size_t MiB = 1048576;
struct MK {
    const float *x, *c, *ctx, *cctx, *ada_w, *ada_b, *norm1_g, *w_in, *lq1, *lk1, *lq2, *lk2, *dattn_g, *dec_f, *dec_b, *ret_g, *w_out, *norm2_g, *router_w, *router_b,
        *ew1, *ew3, *ew2, *sw1, *sw3, *sw2, *final_g;
    float* out; char* ws;
    float* dbgP; long dbg_lo, dbg_hi; long conv_limit;
#define WSF(name, type, off) __device__ __forceinline__ type* name() const { return (type*)(ws + (off)); }
    WSF(mod, float, 0) WSF(cnt, int, 131072) WSF(ropec, float, 262144) WSF(ropes, float, 262144 + 8192)
    WSF(w_inT, bf16_t, 1 * MiB) WSF(w_outT, bf16_t, 7 * MiB) WSF(routerT, bf16_t, 9 * MiB) WSF(W2t, bf16_t, 9 * MiB + 524288)
    WSF(H, bf16_t, 42 * MiB) WSF(MIX, bf16_t, 42 * MiB) WSF(KV, bf16_t, 112 * MiB) WSF(ST, bf16_t, 147 * MiB) WSF(ACT, bf16_t, 42 * MiB)
    WSF(W13t, bf16_t, 194 * MiB) WSF(H2, bf16_t, 260 * MiB)
    WSF(Q, bf16_t, 260 * MiB) WSF(K, bf16_t, 292 * MiB) WSF(V, bf16_t, 325 * MiB) WSF(RQ, bf16_t, 358 * MiB) WSF(RK, bf16_t, 375 * MiB)
    WSF(KTf, bf16_t, 392 * MiB) WSF(KTb, bf16_t, 409 * MiB) WSF(VT, bf16_t, 426 * MiB) WSF(RG, bf16_t, 459 * MiB)
    WSF(Y, unsigned char, 194 * MiB) WSF(tok_list, int, 484 * MiB) WSF(wt_list, float, 492 * MiB) WSF(tokmap, int, 500 * MiB)
    __device__ __forceinline__ bf16_t* X1() const { return (bf16_t*)out; }
#undef WSF
};

__device__ __forceinline__ void ph_mod(const MK& p, int bid, int nb, int tid_l) {
    float* red = (float*)smem;
    for (int it = bid; it < 6 * D / 32; it += nb) {
        const int col = tid_l & 31, kg = tid_l >> 5, j = it * 32 + col;
        float a[5] = {0, 0, 0, 0, 0};
        for (int k = kg * 64; k < kg * 64 + 64; ++k) {
            float w = p.ada_w[(size_t)k * 6 * D + j];
#pragma unroll
            for (int r = 0; r < 5; ++r) { float cv = r < 4 ? p.c[r * D + k] : p.cctx[k]; a[r] += siluf(cv) * w; }
        }
        __syncthreads();
#pragma unroll
        for (int r = 0; r < 5; ++r) red[(kg * 5 + r) * 32 + col] = a[r];
        __syncthreads();
        if (tid_l < 160) {
            int r = tid_l >> 5; float s = 0;
            for (int g = 0; g < 16; ++g) s += red[(g * 5 + r) * 32 + col];
            p.mod()[(size_t)r * 6 * D + j] = s + p.ada_b[j];
        }
    }
    if (bid == nb - 1) {
        for (int i = tid_l; i < 128 * 16; i += NTHR) {
            int pos = i >> 4, f = i & 15;
            float inv_freq = (float)pow(10000.0, -(double)f / 16.0);
            float s, c; sincosf((float)pos * inv_freq, &s, &c);
            p.ropec()[i] = c; p.ropes()[i] = s;
        }
    }
    __syncthreads();
}

__device__ __forceinline__ void tr_tile(const float* src, int ldsrc, int k0, int n0, bf16_t* dst, int lddst, int mode  , bf16_t* dst2, int tid_l) {
    float* t = (float*)smem;
    __syncthreads();
    for (int i = tid_l; i < 64 * 16; i += NTHR) {
        int r = i >> 4, c4 = (i & 15) * 4;
        float4 v = *(const float4*)(src + (size_t)(k0 + r) * ldsrc + n0 + c4);
        t[r * 65 + c4] = v.x; t[r * 65 + c4 + 1] = v.y; t[r * 65 + c4 + 2] = v.z; t[r * 65 + c4 + 3] = v.w;
    }
    __syncthreads();
    for (int i = tid_l; i < 64 * 16; i += NTHR) {
        int n = i >> 4, k4 = (i & 15) * 4;
        float a = t[(k4 + 0) * 65 + n], b = t[(k4 + 1) * 65 + n], c = t[(k4 + 2) * 65 + n], d = t[(k4 + 3) * 65 + n];
        int nn = n0 + n, row = nn;
        if (mode == 1 || mode == 2) { int ct = nn >> 7; row = ct * 256 + (mode == 2 ? 128 : 0) + (nn & 127); }
        u32x2 w; w.x = cvtpk(a, b); w.y = cvtpk(c, d);
        *(u32x2*)(dst + (size_t)row * lddst + k0 + k4) = w;
        if (mode == 3) {
            float ah = bf2f((bf16_t)(w.x & 0xffff)), bh = bf2f((bf16_t)(w.x >> 16)), ch = bf2f((bf16_t)(w.y & 0xffff)), dh = bf2f((bf16_t)(w.y >> 16));
            u32x2 l; l.x = cvtpk(a - ah, b - bh); l.y = cvtpk(c - ch, d - dh);
            *(u32x2*)(dst2 + (size_t)row * lddst + k0 + k4) = l;
        }
    }
}
constexpr int CV_STATIC = 16 * 48 + 16 * 16 + 16, CV_E13 = 65 * 2 * 16 * 4, CV_E2 = 65 * 4 * 16, CV_TOTAL = CV_STATIC + CV_E13 + CV_E2;
__device__ __forceinline__ void convert_tile(const MK& p, int j, int tid_l) {
    const int n_win = 16 * 48, n_wout = 16 * 16, n_rt = 16;
    if (j < n_win) { tr_tile(p.w_in, 3072, (j / 48) * 64, (j % 48) * 64, p.w_inT(), 1024, 0, nullptr, tid_l); return; } j -= n_win;
    if (j < n_wout) { tr_tile(p.w_out, 1024, (j / 16) * 64, (j % 16) * 64, p.w_outT(), 1024, 0, nullptr, tid_l); return; } j -= n_wout;
    if (j < n_rt) { tr_tile(p.router_w, 64, j * 64, 0, p.routerT(), 1024, 3, p.routerT() + 64 * 1024, tid_l); return; } j -= n_rt;
    if (j < CV_E13) {
        int e = j / 128, r = j % 128, which = r / 64, tt = r % 64;
        const float* src = e < 64 ? (which ? p.ew3 : p.ew1) + (size_t)e * D * DE : (which ? p.sw3 : p.sw1);
        tr_tile(src, DE, (tt / 4) * 64, (tt % 4) * 64, p.W13t() + (size_t)e * 512 * 1024, 1024, 1 + which, nullptr, tid_l); return; } j -= CV_E13;
    { int e = j / 64, tt = j % 64;
      const float* src = e < 64 ? p.ew2 + (size_t)e * DE * D : p.sw2;
      tr_tile(src, D, (tt / 16) * 64, (tt % 16) * 64, p.W2t() + (size_t)e * 1024 * 256, 256, 0, nullptr, tid_l); }
}
__device__ __forceinline__ void ph_convert(const MK& p, int bid, int nb, int tid_l) {
    for (int it = bid; it < CV_STATIC; it += nb) convert_tile(p, it, tid_l);
    __syncthreads();
}
__device__ __forceinline__ void ph_convert_dyn(const MK& p, int tid_l) {
    int* q = (int*)smem + 8192;
    for (;;) {
        __syncthreads();
        if (tid_l == 0) q[0] = atomicAdd(&p.cnt()[200], 8);
        __syncthreads();
        const int base = q[0];
        if (base >= CV_E13 + CV_E2) break;
        for (int k = 0; k < 8; ++k) if (base + k < CV_E13 + CV_E2) convert_tile(p, CV_STATIC + base + k, tid_l);
    }
    __syncthreads();
}

__device__ __forceinline__ void ph_ln1(const MK& p, int bid, int nb, int tid_l) {
    const int wid = tid_l >> 6, lane = tid_l & 63;
    for (int R = bid * 8 + wid; R < NR; R += nb * 8) {
        int b = R / RB, i = R % RB;
        const float* src = i < CTX ? p.ctx + ((size_t)b * CTX + i) * D : p.x + ((size_t)b * SEQ + (i - CTX)) * D;
        const float* m = p.mod() + (size_t)(i < CTX ? 4 : b) * 6 * D;
        float4 v[4]; float ss = 0;
#pragma unroll
        for (int q = 0; q < 4; ++q) { v[q] = *(const float4*)(src + q * 256 + lane * 4); ss += v[q].x * v[q].x + v[q].y * v[q].y + v[q].z * v[q].z + v[q].w * v[q].w; }
        ss = wave_sum(ss);
        float rstd = rsqrtf(ss * (1.0f / D) + EPS);
#pragma unroll
        for (int q = 0; q < 4; ++q) {
            int c0 = q * 256 + lane * 4;
            float4 gg = *(const float4*)(p.norm1_g + c0), sh = *(const float4*)(m + c0), sc = *(const float4*)(m + D + c0);
            float o0 = v[q].x * rstd * gg.x * (1 + sc.x) + sh.x, o1 = v[q].y * rstd * gg.y * (1 + sc.y) + sh.y;
            float o2 = v[q].z * rstd * gg.z * (1 + sc.z) + sh.z, o3 = v[q].w * rstd * gg.w * (1 + sc.w) + sh.w;
            u32x2 w; w.x = cvtpk(o0, o1); w.y = cvtpk(o2, o3);
            *(u32x2*)(p.H() + (size_t)R * D + c0) = w;
        }
    }
}

__device__ __forceinline__ int lds_byte(int r, int c) { int st = (r >> 4) * 2 + (c >> 5), ob = (r & 15) * 64 + (c & 31) * 2; return st * 1024 + (ob ^ (((ob >> 9) & 1) << 5)); }
__device__ __forceinline__ void stage_rc(int b, int& R, int& C) { int st = b >> 10, sb = b & 1023, swz = sb ^ (((sb >> 9) & 1) << 5); R = (st / 2) * 16 + swz / 64; C = (st % 2) * 32 + (swz % 64) / 2; }
#define WAIT_V0() asm volatile("s_waitcnt vmcnt(0)" ::: "memory")
__device__ __forceinline__ void gemm_core(const char* Abase, const unsigned (&Ao)[4], const char* Bbase, const unsigned (&Bo)[4], int nt, f32x4 (&acc)[8][4], int tid_l, bool pre) {
    const int tid = tid_l, wid = tid >> 6, lane = tid & 63, wr = wid >> 2, wc = wid & 3, fr = lane & 15, fq = lane >> 4;
#pragma unroll
    for (int m = 0; m < 8; ++m)
#pragma unroll
        for (int n = 0; n < 4; ++n) acc[m][n] = (f32x4){0.f, 0.f, 0.f, 0.f};
#define G_SA(b) (smem + (b) * 32768)
#define G_SB(b) (smem + 65536 + (b) * 32768)
#define G_STAGE(buf, kt) do { _Pragma("unroll") for (int i = 0; i < 4; ++i) {                                                     \
        __builtin_amdgcn_global_load_lds((const unsigned*)(Abase + (Ao[i] + (unsigned)(kt) * 128u)), (unsigned*)(G_SA(buf) + wid * 1024 + i * 8192), 16, 0, 0); \
        __builtin_amdgcn_global_load_lds((const unsigned*)(Bbase + (Bo[i] + (unsigned)(kt) * 128u)), (unsigned*)(G_SB(buf) + wid * 1024 + i * 8192), 16, 0, 0); } } while (0)
    if (!pre) G_STAGE(0, 0);
    WAIT_V0(); __syncthreads();
#define G_KSTEP(cur, t) do {                                                                                                   \
        if ((t) + 1 < nt) G_STAGE((cur) ^ 1, (t) + 1);                                                                          \
        _Pragma("unroll") for (int ks = 0; ks < 2; ++ks) {                                                                      \
            bf16x8 At[8], Bf[4];                                                                                                \
            _Pragma("unroll") for (int m = 0; m < 8; ++m) At[m] = *(const bf16x8*)(G_SA(cur) + lds_byte(wr * 128 + m * 16 + fr, ks * 32 + fq * 8)); \
            _Pragma("unroll") for (int n = 0; n < 4; ++n) Bf[n] = *(const bf16x8*)(G_SB(cur) + lds_byte(wc * 64 + n * 16 + fr, ks * 32 + fq * 8));  \
            _Pragma("unroll") for (int m = 0; m < 8; ++m) _Pragma("unroll") for (int n = 0; n < 4; ++n)                         \
                acc[m][n] = __builtin_amdgcn_mfma_f32_16x16x32_bf16(Bf[n], At[m], acc[m][n], 0, 0, 0);                          \
            __builtin_amdgcn_sched_barrier(0);                                                                                  \
        }                                                                                                                       \
        WAIT_V0(); __syncthreads(); } while (0)
#pragma unroll 1
    for (int t = 0; t < nt; ++t) { const int cur = t & 1; G_KSTEP(cur, t); }
}
#ifndef XPREFETCH
#define XPREFETCH 0
#endif
__device__ __forceinline__ void gemm_prefetch(const char* Abase, const unsigned (&Ao)[4], const char* Bbase, const unsigned (&Bo)[4], int tid_l) {
    const int wid = tid_l >> 6;
    G_STAGE(0, 0);
}
__device__ __forceinline__ void stage_offs(unsigned ld_bytes, unsigned (&P)[4], int tid_l) {
    const int wid = tid_l >> 6, lane = tid_l & 63;
#pragma unroll
    for (int i = 0; i < 4; ++i) { int R, C; stage_rc(wid * 1024 + i * 8192 + lane * 16, R, C); P[i] = (unsigned)R * ld_bytes + (unsigned)C * 2u; }
}

constexpr int WAREA = 18432;
__device__ __forceinline__ char* wave_area(int wid) { return smem + wid * WAREA; }

constexpr int A_KVBLK = 64;
constexpr float A_SCALE = 0.125f, A_THR = 8.f;
constexpr int A_SHM_V = A_KVBLK * 128 * 2, A_SHM_K = A_KVBLK * 128 * 2;
#define KSWZ(row, colB) ((row) * 256 + ((colB) ^ (((row) & 7) << 4)))
#define SBAR() __builtin_amdgcn_sched_barrier(0)
__device__ __forceinline__ int crow(int r, int hi) { return (r & 3) + 8 * (r >> 2) + 4 * hi; }

constexpr float A_THRL = 11.0f;
template <bool FIRST> __device__ __forceinline__ void partialSM2(f32x16& p0, f32x16& p1, float& mhat, f32x16& negm, float& alpha) {
    float pmax = p0[0];
#pragma unroll
    for (int r = 1; r < 16; ++r) pmax = fmaxf(pmax, p0[r]);
#pragma unroll
    for (int r = 0; r < 16; ++r) pmax = fmaxf(pmax, p1[r]);
    { auto rr = __builtin_amdgcn_permlane32_swap(__float_as_uint(pmax), __float_as_uint(pmax), false, false);
      pmax = fmaxf(__uint_as_float(rr[0]), __uint_as_float(rr[1])); }
    alpha = 1.f;
    if (FIRST || __builtin_expect(__any(pmax > A_THRL), 0)) {
        const float dl = FIRST ? pmax : fmaxf(pmax, 0.f);
        mhat += dl;
#pragma unroll
        for (int r = 0; r < 16; ++r) { p0[r] -= dl; p1[r] -= dl; }
#pragma unroll
        for (int r = 0; r < 16; ++r) negm[r] = -mhat;
        if (!FIRST) alpha = __builtin_amdgcn_exp2f(-dl);
    }
#pragma unroll
    for (int r = 0; r < 16; ++r) p0[r] = __builtin_amdgcn_exp2f(p0[r]);
}
__device__ __forceinline__ void qkt2(f32x16& p0, f32x16& p1, const char* Ks, const bf16x8* qr, const f32x16& negm, int r32, int hi, int mapc) {
#pragma unroll
    for (int d0 = 0; d0 < 4; ++d0) { int cb = (mapc + d0 * 16 + hi * 8) * 2;
        bf16x8 b0 = *reinterpret_cast<const bf16x8*>(Ks + KSWZ(r32, cb));
        bf16x8 b1 = *reinterpret_cast<const bf16x8*>(Ks + KSWZ(32 + r32, cb));
        if (d0 == 0) { p0 = __builtin_amdgcn_mfma_f32_32x32x16_bf16(b0, qr[0], negm, 0, 0, 0); p1 = __builtin_amdgcn_mfma_f32_32x32x16_bf16(b1, qr[0], negm, 0, 0, 0); }
        else { p0 = __builtin_amdgcn_mfma_f32_32x32x16_bf16(b0, qr[d0], p0, 0, 0, 0); p1 = __builtin_amdgcn_mfma_f32_32x32x16_bf16(b1, qr[d0], p1, 0, 0, 0); } }
}
template <int PROBE = 0> __device__ __forceinline__ void partialSM(f32x16& p0, f32x16& p1, float& m_reg, float& mn, float& alpha) {
    constexpr float C = A_SCALE * 1.4426950408889634f;
    float pmax = p0[0];
#pragma unroll
    for (int r = 1; r < 16; ++r) pmax = fmaxf(pmax, p0[r]);
#pragma unroll
    for (int r = 0; r < 16; ++r) pmax = fmaxf(pmax, p1[r]);
    { auto rr = __builtin_amdgcn_permlane32_swap(__float_as_uint(pmax), __float_as_uint(pmax), false, false);
      pmax = fmaxf(__uint_as_float(rr[0]), __uint_as_float(rr[1])); }
    if (__builtin_expect(__all(pmax - m_reg <= A_THR / A_SCALE), 1)) { mn = m_reg; alpha = 1.f; }
    else { mn = fmaxf(m_reg, pmax); alpha = __builtin_amdgcn_exp2f((m_reg - mn) * C); m_reg = mn; }
    float mnC = -mn * C;
#pragma unroll
    for (int r = 0; r < 16; ++r) p0[r] = fmaf(p0[r], C, mnC);
#pragma unroll
    for (int r = 0; r < 16; ++r) p1[r] = fmaf(p1[r], C, mnC);
#pragma unroll
    for (int r = 0; r < 16; ++r) p0[r] = PROBE == 3 ? p0[r] * 1e-3f : __builtin_amdgcn_exp2f(p0[r]);
}
#define PK4(P, BASE, OUT) do { unsigned a0 = cvtpk(P[BASE + 0], P[BASE + 1]), a1 = cvtpk(P[BASE + 2], P[BASE + 3]);   \
    unsigned b0 = cvtpk(P[BASE + 4], P[BASE + 5]), b1 = cvtpk(P[BASE + 6], P[BASE + 7]);                              \
    auto r0 = __builtin_amdgcn_permlane32_swap(a0, b0, false, false); auto r1 = __builtin_amdgcn_permlane32_swap(a1, b1, false, false); \
    u32x4 w = {r0[0], r1[0], r0[1], r1[1]}; OUT = *reinterpret_cast<bf16x8*>(&w); } while (0)
template <int PROBE = 0, bool DIRECT = false> __device__ __forceinline__ void finishSM(f32x16& p0, f32x16& p1, float alpha, float& l_reg, bf16x8& pa0, bf16x8& pa1, bf16x8& pa2, bf16x8& pa3) {
#pragma unroll
    for (int r = 0; r < 16; ++r) p1[r] = PROBE == 3 ? p1[r] * 1e-3f : __builtin_amdgcn_exp2f(p1[r]);
    float ps = 0;
#pragma unroll
    for (int r = 0; r < 16; ++r) ps += p0[r];
#pragma unroll
    for (int r = 0; r < 16; ++r) ps += p1[r];
    { auto rr = __builtin_amdgcn_permlane32_swap(__float_as_uint(ps), __float_as_uint(ps), false, false);
      ps = __uint_as_float(rr[0]) + __uint_as_float(rr[1]); }
    l_reg = l_reg * alpha + ps;
    if (DIRECT) {
#define PKD(P, B, OUT) do { u32x4 w = {cvtpk(P[B], P[B + 1]), cvtpk(P[B + 2], P[B + 3]), cvtpk(P[B + 4], P[B + 5]), cvtpk(P[B + 6], P[B + 7])}; OUT = *reinterpret_cast<bf16x8*>(&w); } while (0)
        PKD(p0, 0, pa0); PKD(p0, 8, pa1); PKD(p1, 0, pa2); PKD(p1, 8, pa3);
#undef PKD
    } else { PK4(p0, 0, pa0); PK4(p0, 8, pa1); PK4(p1, 0, pa2); PK4(p1, 8, pa3); }
}
__device__ __forceinline__ void qkt(f32x16& p0, f32x16& p1, const char* Ks, const bf16x8* qr, int r32, int hi, int mapc) {
    p0 = f32x16{}; p1 = f32x16{};
#pragma unroll
    for (int d0 = 0; d0 < 4; ++d0) { int cb = (mapc + d0 * 16 + hi * 8) * 2;
        bf16x8 b0 = *reinterpret_cast<const bf16x8*>(Ks + KSWZ(r32, cb));
        bf16x8 b1 = *reinterpret_cast<const bf16x8*>(Ks + KSWZ(32 + r32, cb));
        p0 = __builtin_amdgcn_mfma_f32_32x32x16_bf16(b0, qr[d0], p0, 0, 0, 0);
        p1 = __builtin_amdgcn_mfma_f32_32x32x16_bf16(b1, qr[d0], p1, 0, 0, 0); }
}
__device__ __forceinline__ int v_st(int k, int c) { const int kk = (k & ~0xC) | ((k & 4) << 1) | ((k & 8) >> 1); return ((kk >> 3) * 4 + (c >> 5)) * 512 + ((kk & 7) * 32 + (c & 31)) * 2; }
__device__ __forceinline__ int v_rd_base(int lane) { return ((lane & 3) << 3) | (((lane >> 2) & 3) << 6) | (((lane >> 4) & 1) << 5) | (((lane >> 5) & 1) << 8); }
constexpr int v_rd_off(int d0, int ks, int half) { return d0 * 512 + ks * 4096 + half * 2048; }
template <int OFF> __device__ __forceinline__ s16x4 tr_read(int vb) {
    s16x4 r; asm volatile("ds_read_b64_tr_b16 %0, %1 offset:%2" : "=&v"(r) : "v"(vb), "i"(OFF) : "memory"); return r;
}
template <int D0> __device__ __forceinline__ void pv_one(f32x16& od, int vb, bf16x8 pa0, bf16x8 pa1, bf16x8 pa2, bf16x8 pa3) {
    const s16x4 l0 = tr_read<v_rd_off(D0, 0, 0)>(vb), h0 = tr_read<v_rd_off(D0, 0, 1)>(vb), l1 = tr_read<v_rd_off(D0, 1, 0)>(vb), h1 = tr_read<v_rd_off(D0, 1, 1)>(vb);
    const s16x4 l2 = tr_read<v_rd_off(D0, 2, 0)>(vb), h2 = tr_read<v_rd_off(D0, 2, 1)>(vb), l3 = tr_read<v_rd_off(D0, 3, 0)>(vb), h3 = tr_read<v_rd_off(D0, 3, 1)>(vb);
    asm volatile("s_waitcnt lgkmcnt(0)" ::: "memory"); SBAR();
#define PKV(L, H) (bf16x8){L[0], L[1], L[2], L[3], H[0], H[1], H[2], H[3]}
    od = __builtin_amdgcn_mfma_f32_32x32x16_bf16(pa0, PKV(l0, h0), od, 0, 0, 0);
    od = __builtin_amdgcn_mfma_f32_32x32x16_bf16(pa1, PKV(l1, h1), od, 0, 0, 0);
    od = __builtin_amdgcn_mfma_f32_32x32x16_bf16(pa2, PKV(l2, h2), od, 0, 0, 0);
    od = __builtin_amdgcn_mfma_f32_32x32x16_bf16(pa3, PKV(l3, h3), od, 0, 0, 0);
}
template <int D0> __device__ __forceinline__ void pv_two(f32x16& oa, f32x16& ob, int vb, bf16x8 pa0, bf16x8 pa1, bf16x8 pa2, bf16x8 pa3) {
    const s16x4 l0 = tr_read<v_rd_off(D0, 0, 0)>(vb), h0 = tr_read<v_rd_off(D0, 0, 1)>(vb), l1 = tr_read<v_rd_off(D0, 1, 0)>(vb), h1 = tr_read<v_rd_off(D0, 1, 1)>(vb);
    const s16x4 l2 = tr_read<v_rd_off(D0, 2, 0)>(vb), h2 = tr_read<v_rd_off(D0, 2, 1)>(vb), l3 = tr_read<v_rd_off(D0, 3, 0)>(vb), h3 = tr_read<v_rd_off(D0, 3, 1)>(vb);
    const s16x4 m0 = tr_read<v_rd_off(D0 + 1, 0, 0)>(vb), g0 = tr_read<v_rd_off(D0 + 1, 0, 1)>(vb), m1 = tr_read<v_rd_off(D0 + 1, 1, 0)>(vb), g1 = tr_read<v_rd_off(D0 + 1, 1, 1)>(vb);
    const s16x4 m2 = tr_read<v_rd_off(D0 + 1, 2, 0)>(vb), g2 = tr_read<v_rd_off(D0 + 1, 2, 1)>(vb), m3 = tr_read<v_rd_off(D0 + 1, 3, 0)>(vb), g3 = tr_read<v_rd_off(D0 + 1, 3, 1)>(vb);
    asm volatile("s_waitcnt lgkmcnt(0)" ::: "memory"); SBAR();
    oa = __builtin_amdgcn_mfma_f32_32x32x16_bf16(pa0, PKV(l0, h0), oa, 0, 0, 0);
    ob = __builtin_amdgcn_mfma_f32_32x32x16_bf16(pa0, PKV(m0, g0), ob, 0, 0, 0);
    oa = __builtin_amdgcn_mfma_f32_32x32x16_bf16(pa1, PKV(l1, h1), oa, 0, 0, 0);
    ob = __builtin_amdgcn_mfma_f32_32x32x16_bf16(pa1, PKV(m1, g1), ob, 0, 0, 0);
    oa = __builtin_amdgcn_mfma_f32_32x32x16_bf16(pa2, PKV(l2, h2), oa, 0, 0, 0);
    ob = __builtin_amdgcn_mfma_f32_32x32x16_bf16(pa2, PKV(m2, g2), ob, 0, 0, 0);
    oa = __builtin_amdgcn_mfma_f32_32x32x16_bf16(pa3, PKV(l3, h3), oa, 0, 0, 0);
    ob = __builtin_amdgcn_mfma_f32_32x32x16_bf16(pa3, PKV(m3, g3), ob, 0, 0, 0);
}
__device__ __forceinline__ void pv_d0(f32x16* o, int vb, bf16x8 pa0, bf16x8 pa1, bf16x8 pa2, bf16x8 pa3) {
    pv_one<0>(o[0], vb, pa0, pa1, pa2, pa3); pv_one<1>(o[1], vb, pa0, pa1, pa2, pa3); pv_one<2>(o[2], vb, pa0, pa1, pa2, pa3); pv_one<3>(o[3], vb, pa0, pa1, pa2, pa3);
}

template <int PROBE> __device__ __forceinline__ void attn_item(const bf16_t* __restrict__ Qb, const bf16_t* __restrict__ Kh, const bf16_t* __restrict__ Vh, bf16_t* __restrict__ mixrow,
                                          const float* __restrict__ gd, float lam, int tid_l) {
    char* lds = smem;
    const int tid = tid_l, wid = tid >> 6, lane = tid & 63, r32 = lane & 31, hi = lane >> 5;
    const int map = wid >> 2, wq = wid & 3, mapc = map * 64;
    char* K_lds = lds; char* V_lds = lds + 4 * A_SHM_K;
    float* wsw = (float*)(lds + 4 * A_SHM_V + 4 * A_SHM_K) + wid * 64; float* li_l = wsw; float* al_l = wsw + 32;
    float m_reg = 0.f, l_reg = 0; f32x16 o[4] = {}; bf16x8 qr[4]; f32x16 negm = f32x16{};
    const bf16_t* Qw = Qb + (long)(wq * 32 + r32) * 128 + mapc + hi * 8;
#pragma unroll
    for (int d0 = 0; d0 < 4; ++d0) qr[d0] = *reinterpret_cast<const bf16x8*>(Qw + d0 * 16);
    const int vb0 = (int)(uintptr_t)V_lds + v_rd_base(lane);
    unsigned kofs[2], vofs[2];
    const int widu = __builtin_amdgcn_readfirstlane(wid);
#pragma unroll
    for (int i = 0; i < 2; ++i) {
        const int x = wid * 1024 + i * 8192 + lane * 16;
        { const int row = x >> 8, cs = x & 255, colB = cs ^ ((row & 7) << 4); kofs[i] = (unsigned)(row * 256 + colB); }
        { const int sub = x >> 9, wn = x & 511, k = (sub >> 2) * 8 + (wn >> 6), c = (sub & 3) * 32 + ((wn & 63) >> 1); vofs[i] = (unsigned)(k * 256 + c * 2); }
    }
#define DMA_TILE(slot, k0) do { const char* kt_ = (const char*)Kh + (size_t)(k0) * 256; const char* vt_ = (const char*)Vh + (size_t)(k0) * 256;                  \
      _Pragma("unroll") for (int i = 0; i < 2; ++i) {                                                                   \
        __builtin_amdgcn_global_load_lds((const unsigned*)(kt_ + kofs[i]), (unsigned*)(K_lds + (slot) * A_SHM_K + widu * 1024 + i * 8192), 16, 0, 0); \
        __builtin_amdgcn_global_load_lds((const unsigned*)(vt_ + vofs[i]), (unsigned*)(V_lds + (slot) * A_SHM_V + widu * 1024 + i * 8192), 16, 0, 0); } } while (0)
#define RESC(a) do { if (__any((a) < 1.f)) { if (hi == 0) al_l[r32] = (a); asm volatile("s_waitcnt lgkmcnt(0)" ::: "memory"); \
    _Pragma("unroll") for (int d = 0; d < 4; ++d) _Pragma("unroll") for (int r = 0; r < 16; ++r) o[d][r] *= al_l[crow(r, hi)]; } } while (0)
    f32x16 pA0, pA1, pB0, pB1; float mnA, mnB, alA, alB; bf16x8 pa0, pa1, pa2, pa3; const int NT = RB / A_KVBLK;
    DMA_TILE(0, 0); DMA_TILE(1, A_KVBLK);
    asm volatile("s_waitcnt vmcnt(0)" ::: "memory"); __syncthreads();
    qkt2(pA0, pA1, K_lds, qr, negm, r32, hi, mapc); partialSM2<true>(pA0, pA1, m_reg, negm, alA);
#define ATILE(X0, X1, ALX, Y0, Y1, ALY, CS, PS, NS, T_, DODMA) do {                                                                  \
        asm volatile("s_waitcnt vmcnt(0)" ::: "memory"); __syncthreads();                                                            \
        if (DODMA && PROBE != 1) DMA_TILE(NS, ((T_) + 1) * A_KVBLK);                                                                 \
        SBAR(); qkt2(X0, X1, K_lds + (CS) * A_SHM_K, qr, negm, r32, hi, mapc);                                                       \
        finishSM<PROBE, true>(Y0, Y1, ALY, l_reg, pa0, pa1, pa2, pa3); SBAR();                                                       \
        pv_d0(o, vb0 + (PS) * A_SHM_V, pa0, pa1, pa2, pa3); partialSM2<false>(X0, X1, m_reg, negm, ALX);                             \
        RESC(ALX); } while (0)
#pragma unroll 1
    for (int j = 1; j + 3 < NT; j += 4) {
        ATILE(pB0, pB1, alB, pA0, pA1, alA, 1, 0, 2, j, true);
        ATILE(pA0, pA1, alA, pB0, pB1, alB, 2, 1, 3, j + 1, true);
        ATILE(pB0, pB1, alB, pA0, pA1, alA, 3, 2, 0, j + 2, true);
        ATILE(pA0, pA1, alA, pB0, pB1, alB, 0, 3, 1, j + 3, true);
    }
    ATILE(pB0, pB1, alB, pA0, pA1, alA, 1, 0, 2, NT - 3, true);
    ATILE(pA0, pA1, alA, pB0, pB1, alB, 2, 1, 3, NT - 2, true);
    ATILE(pB0, pB1, alB, pA0, pA1, alA, 3, 2, 0, NT - 1, false);
    finishSM<PROBE, true>(pB0, pB1, alB, l_reg, pa0, pa1, pa2, pa3); SBAR();
    pv_d0(o, vb0 + 3 * A_SHM_V, pa0, pa1, pa2, pa3);
#undef ATILE
#undef DMA_TILE
    if (hi == 0) li_l[r32] = l_reg;
    asm volatile("s_waitcnt lgkmcnt(0)" ::: "memory");
    float rl[16];
#pragma unroll
    for (int r = 0; r < 16; ++r) rl[r] = __builtin_amdgcn_rcpf(li_l[crow(r, hi)]);
    __syncthreads();
    {
        float* xo = (float*)lds + map * 16384 + (wq * 32) * 128 + r32;
#pragma unroll
        for (int r = 0; r < 16; ++r)
#pragma unroll
            for (int d0 = 0; d0 < 4; ++d0) xo[crow(r, hi) * 128 + d0 * 32] = o[d0][r] * rl[r];
    }
    __syncthreads();
    {
        int l2 = lane; asm volatile("" : "+v"(l2));
        const float g0 = gd[l2 * 2], g1 = gd[l2 * 2 + 1];
#pragma unroll 4
        for (int rr = 0; rr < 16; ++rr) {
            const int row = wid * 16 + rr;
            const float2 a0 = *(const float2*)((const float*)lds + row * 128 + l2 * 2), a1 = *(const float2*)((const float*)lds + 16384 + row * 128 + l2 * 2);
            const float xv = a0.x - lam * a1.x, yv = a0.y - lam * a1.y;
            const float ss = wave_sum(xv * xv + yv * yv);
            const float rs = rsqrtf(ss * (1.0f / 128) + EPS) * 0.8f;
            *(unsigned*)(mixrow + (long)row * 1024 + l2 * 2) = cvtpk(xv * rs * g0, yv * rs * g1);
        }
    }
    __syncthreads();
#undef RESC
}


template <int PROBE> __device__ __forceinline__ void ph_attn(const MK& p, int bid, int nb, int tid_l) {
    const int lane = tid_l & 63;
    float s1 = wave_sum(p.lq1[lane] * p.lk1[lane]), s2 = wave_sum(p.lq2[lane] * p.lk2[lane]);
    const float lam = expf(s1) - expf(s2) + 0.2f;
    const int nrounds = (1024 + nb - 1) / nb;
    for (int rr = 0; rr < nrounds; ++rr) {
        int item;
        if (nb == 256) { int x = bid & 7, j = bid >> 3, hh = rr * 8 + x; item = (hh >> 1) * 64 + (hh & 1) * 32 + j; }
        else { item = rr * nb + bid; if (item >= 1024) break; }
        const int bh = item >> 6, qb = item & 63, b = bh >> 2, h = bh & 3;
        attn_item<PROBE>(p.Q() + ((size_t)bh * SEQ + qb * 128) * 128, p.K() + (size_t)bh * RB * 128, p.V() + (size_t)bh * RB * 128,
                  PROBE ? (bf16_t*)(p.ws + 492 * MiB) + h * 128 : p.MIX() + ((size_t)(b * SEQ + qb * 128)) * 1024 + h * 128, p.dattn_g, lam, tid_l);
    }
}


__device__ __forceinline__ bf16x8 ldfrag(const bf16_t* p) { return *reinterpret_cast<const bf16x8*>(p); }

__device__ __forceinline__ void ph_kv(const MK& p, int bid, int nb, int tid_l) {
    const int wid = tid_l >> 6, lane = tid_l & 63, r32 = lane & 31, hi = lane >> 5;
    const int nitems = 16 * 2 * 66;
    for (int it = bid * 8 + wid; it < nitems; it += nb * 8) {
        const int c = it % 66, chain = it / 66, dir = chain & 1, bh = chain >> 1;
        const bf16_t* vt = p.VT() + (size_t)bh * 128 * RB + c * 128 + hi * 8;
        const bf16_t* kt = (dir ? p.KTb() : p.KTf()) + (size_t)bh * 64 * RB + c * 128 + hi * 8;
        f32x16 acc[4][2];
#pragma unroll
        for (int mt = 0; mt < 4; ++mt) { acc[mt][0] = f32x16{}; acc[mt][1] = f32x16{}; }
#pragma unroll 2
        for (int ks = 0; ks < 8; ++ks) {
            bf16x8 a[4], b[2];
#pragma unroll
            for (int mt = 0; mt < 4; ++mt) a[mt] = ldfrag(vt + (size_t)(mt * 32 + r32) * RB + ks * 16);
#pragma unroll
            for (int nt = 0; nt < 2; ++nt) b[nt] = ldfrag(kt + (size_t)(nt * 32 + r32) * RB + ks * 16);
#pragma unroll
            for (int mt = 0; mt < 4; ++mt)
#pragma unroll
                for (int nt = 0; nt < 2; ++nt) acc[mt][nt] = __builtin_amdgcn_mfma_f32_32x32x16_bf16(a[mt], b[nt], acc[mt][nt], 0, 0, 0);
        }
        bf16_t* dst = p.KV() + (size_t)it * 8192;
#pragma unroll
        for (int mt = 0; mt < 4; ++mt)
#pragma unroll
            for (int nt = 0; nt < 2; ++nt)
#pragma unroll
                for (int r = 0; r < 16; ++r) dst[(mt * 32 + crow(r, hi)) * 64 + nt * 32 + r32] = f2bf(acc[mt][nt][r]);
    }
}

__device__ __forceinline__ void ph_scan(const MK& p, int bid, int nb, int tid_l) {
    for (int e = bid * NTHR + tid_l; e < 32 * 8192; e += nb * NTHR) {
        const int chain = e >> 13, el = e & 8191, dir = chain & 1, bh = chain >> 1, h = bh & 3;
        const float d = dir ? p.dec_b[h] : p.dec_f[h];
        const float g128 = exp2f(128.0f * log2f(1.0f / (1.0f + expf(-d))));
        const bf16_t* kv = p.KV() + (size_t)chain * 66 * 8192 + el;
        bf16_t* st = p.ST() + (size_t)chain * 66 * 8192 + el;
        float S = 0.f;
        for (int n = 0; n < 66; ++n) {
            const int c = dir == 0 ? n : (n == 0 ? 1 : (n == 1 ? 0 : 67 - n));
            st[(size_t)c * 8192] = f2bf(S);
            S = fmaf(g128, S, bf2f(kv[(size_t)c * 8192]));
        }
    }
}

__device__ __forceinline__ void ph_ret(const MK& p, int bid, int nb, int tid_l) {
    const int tid = tid_l, wid = tid >> 6, lane = tid & 63, r32 = lane & 31, hi = lane >> 5, wq = wid & 3, half = wid >> 2;
    float* img = (float*)smem;
    for (int it = bid; it < 4 * 64 * 2; it += nb) {
        const int hp = it & 1, lc = (it >> 1) & 63, b = it >> 7, h = hp * 2 + half, bh = b * 4 + h;
        const int ib = CTX + lc * 128, c = 2 + lc;
        const float lf = log2f(1.0f / (1.0f + expf(-p.dec_f[h]))), lb = log2f(1.0f / (1.0f + expf(-p.dec_b[h])));
        const bf16_t* rq = p.RQ() + ((size_t)bh * RB + ib + wq * 32 + r32) * 64 + hi * 8;
        bf16x8 q[4];
#pragma unroll
        for (int ks = 0; ks < 4; ++ks) q[ks] = ldfrag(rq + ks * 16);
        f32x16 o[4];
        {
            const bf16_t* stf = p.ST() + ((size_t)(bh * 2 + 0) * 66 + c) * 8192 + hi * 8;
            const bf16_t* stb = p.ST() + ((size_t)(bh * 2 + 1) * 66 + c) * 8192 + hi * 8;
            {
                float rf[16];
#pragma unroll
                for (int r = 0; r < 16; ++r) rf[r] = __builtin_amdgcn_exp2f((float)(wq * 32 + crow(r, hi) + 1) * lf);
#pragma unroll
                for (int d0 = 0; d0 < 4; ++d0) {
                    f32x16 tf = f32x16{};
#pragma unroll
                    for (int ks = 0; ks < 4; ++ks) tf = __builtin_amdgcn_mfma_f32_32x32x16_bf16(q[ks], ldfrag(stf + (size_t)(d0 * 32 + r32) * 64 + ks * 16), tf, 0, 0, 0);
#pragma unroll
                    for (int r = 0; r < 16; ++r) o[d0][r] = tf[r] * rf[r];
                    asm volatile("" ::: "memory");
                }
            }
            {
                float rf[16];
#pragma unroll
                for (int r = 0; r < 16; ++r) rf[r] = __builtin_amdgcn_exp2f((float)(128 - (wq * 32 + crow(r, hi))) * lb);
#pragma unroll
                for (int d0 = 0; d0 < 4; ++d0) {
                    f32x16 tb = f32x16{};
#pragma unroll
                    for (int ks = 0; ks < 4; ++ks) tb = __builtin_amdgcn_mfma_f32_32x32x16_bf16(q[ks], ldfrag(stb + (size_t)(d0 * 32 + r32) * 64 + ks * 16), tb, 0, 0, 0);
#pragma unroll
                    for (int r = 0; r < 16; ++r) o[d0][r] += tb[r] * rf[r];
                    asm volatile("" ::: "memory");
                }
            }
        }
        {
            const int qi = wq * 32 + r32;
            const bf16_t* vt = p.VT() + (size_t)bh * 128 * RB + ib + hi * 8;
#pragma unroll 1
            for (int jb = 0; jb < 4; ++jb) {
                asm volatile("" ::: "memory");
                const bf16_t* rk = p.RK() + ((size_t)bh * RB + ib + jb * 32 + r32) * 64 + hi * 8;
                f32x16 pp = f32x16{};
#pragma unroll
                for (int ks = 0; ks < 4; ++ks) pp = __builtin_amdgcn_mfma_f32_32x32x16_bf16(ldfrag(rk + ks * 16), q[ks], pp, 0, 0, 0);
#pragma unroll
                for (int r = 0; r < 16; ++r) {
                    const int dd = qi - (jb * 32 + crow(r, hi));
                    const float ex = __builtin_amdgcn_exp2f(dd > 0 ? (float)dd * lf : (float)(-dd) * lb); const float w = dd == 0 ? 2.0f : ex;
                    pp[r] *= w;
                }
                bf16x8 pa0, pa1;
                PK4(pp, 0, pa0); PK4(pp, 8, pa1);
#pragma unroll
                for (int d0 = 0; d0 < 4; ++d0) {
                    o[d0] = __builtin_amdgcn_mfma_f32_32x32x16_bf16(pa0, ldfrag(vt + (size_t)(d0 * 32 + r32) * RB + jb * 32), o[d0], 0, 0, 0);
                    o[d0] = __builtin_amdgcn_mfma_f32_32x32x16_bf16(pa1, ldfrag(vt + (size_t)(d0 * 32 + r32) * RB + jb * 32 + 16), o[d0], 0, 0, 0);
                }
            }
        }
        __syncthreads();
        {
            float* xo = img + half * 16384 + (wq * 32) * 128 + r32;
#pragma unroll
            for (int r = 0; r < 16; ++r)
#pragma unroll
                for (int d0 = 0; d0 < 4; ++d0) xo[crow(r, hi) * 128 + d0 * 32] = o[d0][r];
        }
        __syncthreads();
        {
            const float g0 = p.ret_g[lane * 2], g1 = p.ret_g[lane * 2 + 1];
#pragma unroll 4
            for (int rr = 0; rr < 32; ++rr) {
                const int row = wid * 32 + rr, itl = row >> 7, rw = row & 127, hh = hp * 2 + itl;
                const float2 a = *(const float2*)(img + row * 128 + lane * 2);
                const float ss = wave_sum(a.x * a.x + a.y * a.y);
                const float rs = rsqrtf(ss * (1.0f / 128) + EPS);
                const size_t tt = (size_t)b * SEQ + lc * 128 + rw;
                const unsigned gg = *(const unsigned*)(p.RG() + tt * 512 + hh * 128 + lane * 2);
                const float ga = bf2f((bf16_t)(gg & 0xffff)), gb = bf2f((bf16_t)(gg >> 16));
                *(unsigned*)(p.MIX() + tt * 1024 + 512 + hh * 128 + lane * 2) = cvtpk(silu_fast(ga) * a.x * rs * g0, silu_fast(gb) * a.y * rs * g1);
            }
        }
    }
}


namespace pg8 {
constexpr int BM = 256, BK = 64, HALF = 128, HTB = HALF * BK * 2;
__device__ __forceinline__ int perm32(int rho) { const int n = rho >> 4, i = rho & 15; return 8 * (i >> 2) + 4 * n + (i & 3); }
struct GUnit { const char* A; const char* B; int i0, i1, i2, i3; };
template <class Epi, class Sched, bool GATHER, bool ALIGN_EPI>
__device__ __forceinline__ void gemm(int K, const Sched& S, const Epi& E, int tid_l) {
    const int tid = tid_l, wid = __builtin_amdgcn_readfirstlane(tid >> 6), lane = tid & 63, wr = wid >> 2, wc = wid & 3, fr = lane & 15, fq = lane >> 4;
    const int nt = K / BK;
    unsigned voffB[2], vAc[2][2], vAn[2][2];
    const size_t kstep = (size_t)(BK * 2);
    const size_t hstepB = (size_t)HALF * K * 2;
#pragma unroll
    for (int i = 0; i < 2; ++i) { int R, C; stage_rc(tid * 16 + i * 8192, R, C); const int Rb = Epi::PERM ? ((R & ~31) + perm32(R & 31)) : R;
        voffB[i] = (unsigned)(Rb * K + C) * 2u; }
    const unsigned ldsw = (unsigned)wid * 1024u;
    const int aoff = lds_byte(wr * 64 + fr, fq * 8), boff = lds_byte(wc * 32 + fr, fq * 8);
#define PG8_SA(b, h) (((b) * 2 + (h)) * HTB)
#define PG8_SB(b, h) ((4 + (b) * 2 + (h)) * HTB)
#define PG8_STAGE(bufoff, gbase, voff) do { _Pragma("unroll") for (int _i = 0; _i < 2; ++_i) \
        __builtin_amdgcn_global_load_lds((const unsigned*)((const char*)(gbase) + (voff)[_i]), (unsigned*)(smem + (bufoff) + ldsw + _i * 8192), 16, 0, 0); } while (0)
#define PG8_LDA(dst, b, h) do { _Pragma("unroll") for (int m = 0; m < 4; ++m) _Pragma("unroll") for (int k = 0; k < 2; ++k) dst[m][k] = *(const bf16x8*)(smem + PG8_SA(b, h) + aoff + m * 2048 + k * 1024); } while (0)
#define PG8_LDB(dst, b, h) do { _Pragma("unroll") for (int n = 0; n < 2; ++n) _Pragma("unroll") for (int k = 0; k < 2; ++k) dst[n][k] = *(const bf16x8*)(smem + PG8_SB(b, h) + boff + n * 2048 + k * 1024); } while (0)
#define PG8_MMA(ai, bj, At, Bt) do { __builtin_amdgcn_s_setprio(1); _Pragma("unroll") for (int m = 0; m < 4; ++m) _Pragma("unroll") for (int n = 0; n < 2; ++n) _Pragma("unroll") for (int k = 0; k < 2; ++k) \
        acc[ai][bj][m][n] = __builtin_amdgcn_mfma_f32_16x16x32_bf16(Bt[n][k], At[m][k], acc[ai][bj][m][n], 0, 0, 0); __builtin_amdgcn_s_setprio(0); } while (0)
#define PG8_WAIT_V(n) asm volatile("s_waitcnt vmcnt(" #n ")" ::: "memory")
#define PG8_WAIT_L(n) asm volatile("s_waitcnt lgkmcnt(" #n ")" ::: "memory")
#define PG8_BAR __builtin_amdgcn_s_barrier()
#define PG8_SCHED __builtin_amdgcn_sched_barrier(0)
    GUnit cur, nxt; int ui = 0;
    if (!S.next(0, cur, vAc)) return;
    f32x4 acc[2][2][4][2];
#pragma unroll
    for (int a = 0; a < 2; ++a)
#pragma unroll
        for (int b = 0; b < 2; ++b)
#pragma unroll
            for (int m = 0; m < 4; ++m)
#pragma unroll
                for (int n = 0; n < 2; ++n) acc[a][b][m][n] = (f32x4){0.f, 0.f, 0.f, 0.f};
    bf16x8 At[4][2], B0[2][2], B1[2][2];
    const char* cA = cur.A; const char* cB = cur.B;
    PG8_STAGE(PG8_SB(0, 0), cB, voffB); PG8_STAGE(PG8_SB(0, 1), cB + hstepB, voffB); PG8_STAGE(PG8_SA(0, 0), cA, vAc[0]); PG8_STAGE(PG8_SA(0, 1), cA, vAc[1]);
    if (wr == 1) PG8_BAR;
    PG8_WAIT_V(2); PG8_BAR;
    PG8_STAGE(PG8_SB(1, 0), cB + kstep, voffB); PG8_STAGE(PG8_SA(1, 0), cA + kstep, vAc[0]); PG8_STAGE(PG8_SB(1, 1), cB + hstepB + kstep, voffB);
    PG8_WAIT_V(6); PG8_BAR;
    for (;;) {
        const bool has_next = S.next(ui + 1, nxt, vAn);
        if (!GATHER || !has_next) {
#pragma unroll
            for (int h = 0; h < 2; ++h)
#pragma unroll
                for (int i = 0; i < 2; ++i) vAn[h][i] = vAc[h][i];
        }
        const char* nA = has_next ? nxt.A : cA; const char* nB = has_next ? nxt.B : cB;
#pragma unroll 1
        for (int t = 0; t < nt; t += 2) {
            const bool last = (t == nt - 2);
            const char* a1 = cA + (size_t)(t + 1) * kstep;
            const char* a2 = last ? nA : cA + (size_t)(t + 2) * kstep; const char* b2 = last ? nB : cB + (size_t)(t + 2) * kstep;
            const char* a3 = a2 + kstep; const char* b3 = b2 + kstep;
            unsigned va2[2][2];
#pragma unroll
            for (int h = 0; h < 2; ++h)
#pragma unroll
                for (int i = 0; i < 2; ++i) va2[h][i] = (GATHER && last) ? vAn[h][i] : vAc[h][i];
            PG8_LDB(B0, 0, 0); PG8_LDB(B1, 0, 1); PG8_SCHED; PG8_LDA(At, 0, 0); PG8_STAGE(PG8_SA(1, 1), a1, vAc[1]);
            PG8_WAIT_V(8); PG8_WAIT_L(0); PG8_BAR; PG8_MMA(0, 0, At, B0); PG8_MMA(0, 1, At, B1); PG8_BAR; PG8_SCHED;
            PG8_LDA(At, 0, 1); PG8_STAGE(PG8_SB(0, 0), b2, voffB); PG8_STAGE(PG8_SB(0, 1), b2 + hstepB, voffB); PG8_STAGE(PG8_SA(0, 0), a2, va2[0]);
            PG8_WAIT_V(8); PG8_WAIT_L(0); PG8_BAR; PG8_MMA(1, 0, At, B0); PG8_MMA(1, 1, At, B1); PG8_BAR; PG8_SCHED;
            PG8_LDB(B0, 1, 0); PG8_LDB(B1, 1, 1); PG8_SCHED; PG8_LDA(At, 1, 0); PG8_STAGE(PG8_SA(0, 1), a2, va2[1]);
            PG8_WAIT_V(8); PG8_WAIT_L(0); PG8_BAR; PG8_MMA(0, 0, At, B0); PG8_MMA(0, 1, At, B1); PG8_BAR; PG8_SCHED;
            PG8_LDA(At, 1, 1); PG8_STAGE(PG8_SB(1, 0), b3, voffB); PG8_STAGE(PG8_SB(1, 1), b3 + hstepB, voffB); PG8_STAGE(PG8_SA(1, 0), a3, va2[0]);
            PG8_WAIT_V(8); PG8_WAIT_L(0); PG8_BAR; PG8_MMA(1, 0, At, B0); PG8_MMA(1, 1, At, B1); PG8_BAR; PG8_SCHED;
        }
        if (ALIGN_EPI) { if (wr == 0) PG8_BAR; }
        E(acc, cur, wr, wc, fr, fq);
        if (!has_next) break;
#pragma unroll
        for (int a = 0; a < 2; ++a)
#pragma unroll
            for (int b = 0; b < 2; ++b)
#pragma unroll
                for (int m = 0; m < 4; ++m)
#pragma unroll
                    for (int n = 0; n < 2; ++n) acc[a][b][m][n] = (f32x4){0.f, 0.f, 0.f, 0.f};
        cur = nxt; cA = nA; cB = nB; ++ui;
#pragma unroll
        for (int h = 0; h < 2; ++h)
#pragma unroll
            for (int i = 0; i < 2; ++i) vAc[h][i] = vAn[h][i];
        if (ALIGN_EPI) { if (wr == 1) PG8_BAR; }
    }
    PG8_WAIT_V(0);
    if (!ALIGN_EPI) { if (wr == 0) PG8_BAR; }
    PG8_BAR;
#undef PG8_SA
#undef PG8_SB
#undef PG8_STAGE
#undef PG8_LDA
#undef PG8_LDB
#undef PG8_MMA
#undef PG8_WAIT_V
#undef PG8_WAIT_L
#undef PG8_BAR
#undef PG8_SCHED
}
__device__ __forceinline__ void plain_voffA(int K, unsigned (&vA)[2][2], int tid_l) {
#pragma unroll
    for (int i = 0; i < 2; ++i) { int R, C; stage_rc(tid_l * 16 + i * 8192, R, C); vA[0][i] = (unsigned)(R * K + C) * 2u; vA[1][i] = (unsigned)((R + HALF) * K + C) * 2u; }
}
}


struct SchedIn { const MK* p; int bid, nb, tid_l;
    __device__ __forceinline__ bool next(int i, pg8::GUnit& u, unsigned (&vA)[2][2]) const {
        const int tile = bid + i * nb; if (tile >= (NR / 256) * 12) return false;
        const int pm = tile / 12, pn = tile % 12;
        u.A = (const char*)(p->H() + (size_t)(pm * 256) * D); u.B = (const char*)(p->w_inT() + (size_t)(pn * 256) * D); u.i0 = pm; u.i1 = pn; u.i2 = 0; u.i3 = 0;
        pg8::plain_voffA(D, vA, tid_l); return true; } };
struct EpiIn { static constexpr bool PERM = false; const MK* p;
    __device__ __forceinline__ void operator()(f32x4 (&acc)[2][2][4][2], const pg8::GUnit& u, int wr, int wc, int fr_in, int fq_in) const {
        int fr = fr_in, fq = fq_in; asm volatile("" : "+v"(fr), "+v"(fq));
        const int pm = u.i0, seg = u.i1, brow = pm * 256;
        const int b = brow / RB, i0 = brow % RB;
        const bool lat = i0 >= CTX;
        const int wid = wr * 4 + wc, lane = fq * 16 + fr;
        if (lat && (seg <= 3 || seg == 6 || seg == 7)) {
#pragma unroll
            for (int ai = 0; ai < 2; ++ai)
#pragma unroll
                for (int m = 0; m < 4; ++m) {
                    const int t = i0 + ai * 128 + wr * 64 + m * 16 + fr - CTX, pos = (wc & 1) ? (t & 63) : (t >> 6);
                    const f32x4 cc = *(const f32x4*)(p->ropec() + pos * 16 + fq * 4), ss = *(const f32x4*)(p->ropes() + pos * 16 + fq * 4);
#pragma unroll
                    for (int bj = 0; bj < 2; ++bj) { const f32x4 x1 = acc[ai][bj][m][0], x2 = acc[ai][bj][m][1];
                        acc[ai][bj][m][0] = x1 * cc - x2 * ss; acc[ai][bj][m][1] = x1 * ss + x2 * cc; }
                }
        }
        if (seg == 7 || seg <= 1) {
            const float sc_ = seg == 7 ? 0.125f : 0.125f * 1.4426950408889634f;
#pragma unroll
            for (int ai = 0; ai < 2; ++ai)
#pragma unroll
                for (int bj = 0; bj < 2; ++bj)
#pragma unroll
                    for (int m = 0; m < 4; ++m) { acc[ai][bj][m][0] = acc[ai][bj][m][0] * sc_; acc[ai][bj][m][1] = acc[ai][bj][m][1] * sc_; }
        }
        if (seg <= 7 || seg >= 10) {
#pragma unroll
            for (int bj = 0; bj < 2; ++bj) {
                bf16_t* base; long rstride; bool ok = true;
                if (seg <= 1)      { const int h = (seg & 1) * 2 + bj;       base = p->Q() + (((size_t)(b * 4 + h) * SEQ + (i0 - CTX)) * 128 + wc * 32 + fq * 4); rstride = 128; ok = lat; }
                else if (seg <= 3) { const int h = (seg - 2) * 2 + bj;       base = p->K() + (((size_t)(b * 4 + h) * RB + i0) * 128 + wc * 32 + fq * 4);          rstride = 128; }
                else if (seg <= 5) { const int h = (seg - 4) * 2 + bj;       base = p->V() + (((size_t)(b * 4 + h) * RB + i0) * 128 + wc * 32 + fq * 4);          rstride = 128; }
                else if (seg == 6) { const int h = bj * 2 + (wc >> 1);       base = p->RQ() + (((size_t)(b * 4 + h) * RB + i0) * 64 + (wc & 1) * 32 + fq * 4);    rstride = 64; }
                else if (seg == 7) { const int h = bj * 2 + (wc >> 1);       base = p->RK() + (((size_t)(b * 4 + h) * RB + i0) * 64 + (wc & 1) * 32 + fq * 4);    rstride = 64; }
                else               {                                         base = p->RG() + ((size_t)(b * SEQ + (i0 - CTX)) * 512 + (seg - 10) * 256 + bj * 128 + wc * 32 + fq * 4); rstride = 512; ok = lat; }
                if (ok) {
#pragma unroll
                    for (int ai = 0; ai < 2; ++ai)
#pragma unroll
                        for (int m = 0; m < 4; ++m) { bf16_t* rp = base + (long)(ai * 128 + wr * 64 + m * 16 + fr) * rstride;
#pragma unroll
                            for (int n = 0; n < 2; ++n) { u32x2 w; w.x = cvtpk(acc[ai][bj][m][n][0], acc[ai][bj][m][n][1]); w.y = cvtpk(acc[ai][bj][m][n][2], acc[ai][bj][m][n][3]);
                                *(u32x2*)(rp + n * 16) = w; } }
                }
            }
        }
        if (seg >= 7 && seg <= 9) {
            char* img = smem + 131072 + wid * 3968;
            const int npass = seg == 7 ? 2 : 1;
#pragma unroll 1
            for (int ps = 0; ps < npass; ++ps) {
#pragma unroll
                for (int bj = 0; bj < 2; ++bj) {
                    float lg2 = 0.f; bf16_t* baseT;
                    if (seg == 7) { const int h = bj * 2 + (wc >> 1); const float dv = ps == 0 ? p->dec_f[h] : p->dec_b[h]; lg2 = log2f(1.0f / (1.0f + expf(-dv)));
                        baseT = (ps == 0 ? p->KTf() : p->KTb()) + ((size_t)(b * 4 + h) * 64 + (wc & 1) * 32) * RB + i0; }
                    else { const int h = (seg - 8) * 2 + bj; baseT = p->VT() + ((size_t)(b * 4 + h) * 128 + wc * 32) * RB + i0; }
#pragma unroll
                    for (int ai = 0; ai < 2; ++ai)
#pragma unroll
                        for (int mp = 0; mp < 2; ++mp) {
                            asm volatile("s_waitcnt lgkmcnt(0)" ::: "memory");
#pragma unroll
                            for (int mm = 0; mm < 2; ++mm) { const int m = mp * 2 + mm;
                                float f = 1.0f;
                                if (seg == 7) { const int pos = (i0 + ai * 128 + wr * 64 + m * 16 + fr) & 127; f = __builtin_amdgcn_exp2f((float)(ps == 0 ? 127 - pos : pos) * lg2); }
#pragma unroll
                                for (int n = 0; n < 2; ++n)
#pragma unroll
                                    for (int j = 0; j < 4; ++j) *(bf16_t*)(img + (n * 16 + fq * 4 + j) * 80 + (mm * 16 + fr) * 2) = f2bf(acc[ai][bj][m][n][j] * f); }
                            asm volatile("s_waitcnt lgkmcnt(0)" ::: "memory");
                            const int ib = ai * 128 + wr * 64 + mp * 32;
#pragma unroll
                            for (int k = 0; k < 2; ++k) { const int q = lane + 64 * k, col = q >> 2, ch = q & 3;
                                *(u32x4*)(baseT + (size_t)col * RB + ib + ch * 8) = *(const u32x4*)(img + col * 80 + ch * 16); }
                        }
                }
            }
        }
    } };
__device__ __forceinline__ void ph_gemm_in(const MK& p, int bid, int nb, int tid_l) {
    SchedIn S{&p, bid, nb, tid_l}; EpiIn E{&p};
    pg8::gemm<EpiIn, SchedIn, false, true>(D, S, E, tid_l);
}

struct SchedOut { const MK* p; int bid, nb, tid_l;
    __device__ __forceinline__ bool next(int i, pg8::GUnit& u, unsigned (&vA)[2][2]) const {
        const int tile = bid + i * nb; if (tile >= (T / 256) * 4) return false;
        const int pm = tile >> 2, pn = tile & 3;
        u.A = (const char*)(p->MIX() + (size_t)(pm * 256) * D); u.B = (const char*)(p->w_outT() + (size_t)(pn * 256) * D); u.i0 = pm; u.i1 = pn; u.i2 = 0; u.i3 = 0;
        pg8::plain_voffA(D, vA, tid_l); return true; } };
struct EpiOut { static constexpr bool PERM = true; const MK* p;
    __device__ __forceinline__ void operator()(const f32x4 (&acc)[2][2][4][2], const pg8::GUnit& u, int wr, int wc, int fr, int fq) const {
        const int brow = u.i0 * 256, bcol = u.i1 * 256 + wc * 32 + fq * 8;
        const float* g1 = p->mod() + (size_t)(brow / SEQ) * 6 * D + 2 * D + bcol;
        f32x4 gv[2][2];
#pragma unroll
        for (int bj = 0; bj < 2; ++bj)
#pragma unroll
            for (int n = 0; n < 2; ++n) gv[bj][n] = *(const f32x4*)(g1 + bj * 128 + n * 4);
#pragma unroll
        for (int ai = 0; ai < 2; ++ai)
#pragma unroll
            for (int m = 0; m < 4; ++m) {
                const int row = brow + ai * 128 + wr * 64 + m * 16 + fr;
                const float* xp = p->x + (size_t)row * D + bcol;
                f32x4 xv[2][2];
#pragma unroll
                for (int bj = 0; bj < 2; ++bj)
#pragma unroll
                    for (int n = 0; n < 2; ++n) xv[bj][n] = *(const f32x4*)(xp + bj * 128 + n * 4);
#pragma unroll
                for (int bj = 0; bj < 2; ++bj) {
                    const f32x4 a = xv[bj][0] + gv[bj][0] * acc[ai][bj][m][0], b = xv[bj][1] + gv[bj][1] * acc[ai][bj][m][1];
                    const u32x4 w = {cvtpk(a[0], a[1]), cvtpk(a[2], a[3]), cvtpk(b[0], b[1]), cvtpk(b[2], b[3])};
                    *(u32x4*)(p->X1() + (size_t)row * 2048 + bcol + bj * 128) = w;
                }
                if (m & 1) asm volatile("" ::: "memory");
            }
    } };
__device__ __forceinline__ void ph_gemm_out(const MK& p, int bid, int nb, int tid_l) {
    SchedOut S{&p, bid, nb, tid_l}; EpiOut E{&p};
    pg8::gemm<EpiOut, SchedOut, false, true>(D, S, E, tid_l);
}

template <bool DUMMY, int MODE = 0> __device__ __forceinline__ void ph_route(const MK& p, int bid, int nb, int tid_l) {
    int* cntp = p.cnt() + (DUMMY ? 128 : 0); int* tl = DUMMY ? (int*)(p.ws + 480 * MiB) : p.tok_list(); float* wl_ = DUMMY ? (float*)(p.ws + 488 * MiB) : p.wt_list(); int* tm = DUMMY ? (int*)(p.ws + 496 * MiB) : p.tokmap();
    const int tid = tid_l, wid = tid >> 6, lane = tid & 63, fr = lane & 15, fq = lane >> 4;
    float* lg = (float*)smem;
    int* wcnt = (int*)(smem + 34816);
    int* pref = wcnt + 512;
    bf16_t* H2lo = (bf16_t*)(p.ws + 325 * MiB);
    for (int item = bid; item < T / 128; item += nb) {
        const int t0 = item * 128 + wid * 16, b = (item * 128) / SEQ;
        const float* msh = p.mod() + (size_t)b * 6 * D + 3 * D; const float* msc = p.mod() + (size_t)b * 6 * D + 4 * D;
#pragma unroll 1
        for (int r0 = 0; r0 < 16; r0 += 4) {
            float4 xv[4][4];
#pragma unroll
            for (int rr = 0; rr < 4; ++rr)
#pragma unroll
                for (int q = 0; q < 4; ++q) { const u32x2 w = *(const u32x2*)(p.X1() + (size_t)(t0 + r0 + rr) * 2048 + q * 256 + lane * 4);
                    xv[rr][q] = make_float4(__uint_as_float(w.x << 16), __uint_as_float(w.x & 0xffff0000u), __uint_as_float(w.y << 16), __uint_as_float(w.y & 0xffff0000u)); }
#pragma unroll
            for (int rr = 0; rr < 4; ++rr) {
                float ss = 0.f;
#pragma unroll
                for (int q = 0; q < 4; ++q) ss += xv[rr][q].x * xv[rr][q].x + xv[rr][q].y * xv[rr][q].y + xv[rr][q].z * xv[rr][q].z + xv[rr][q].w * xv[rr][q].w;
                ss = wave_sum(ss);
                const float rstd = rsqrtf(ss * (1.0f / D) + EPS);
#pragma unroll
                for (int q = 0; q < 4; ++q) {
                    const int c0 = q * 256 + lane * 4;
                    const float4 gg = *(const float4*)(p.norm2_g + c0), sh = *(const float4*)(msh + c0), sc = *(const float4*)(msc + c0);
                    const float h0 = xv[rr][q].x * rstd * gg.x * (1 + sc.x) + sh.x, h1 = xv[rr][q].y * rstd * gg.y * (1 + sc.y) + sh.y;
                    const float h2v = xv[rr][q].z * rstd * gg.z * (1 + sc.z) + sh.z, h3 = xv[rr][q].w * rstd * gg.w * (1 + sc.w) + sh.w;
                    u32x2 wh, wl2; wh.x = cvtpk(h0, h1); wh.y = cvtpk(h2v, h3);
                    wl2.x = cvtpk(h0 - __uint_as_float(wh.x << 16), h1 - __uint_as_float(wh.x & 0xffff0000u));
                    wl2.y = cvtpk(h2v - __uint_as_float(wh.y << 16), h3 - __uint_as_float(wh.y & 0xffff0000u));
                    *(u32x2*)(p.H2() + (size_t)(t0 + r0 + rr) * D + c0) = wh;
                    *(u32x2*)(H2lo + (size_t)(t0 + r0 + rr) * D + c0) = wl2;
                }
            }
        }
        asm volatile("s_waitcnt vmcnt(0)" ::: "memory");
        __syncthreads();
        if (MODE == 3) continue;
        f32x4 acc[4];
#pragma unroll
        for (int nt = 0; nt < 4; ++nt) acc[nt] = (f32x4){0.f, 0.f, 0.f, 0.f};
        {
            const bf16_t* ah_p = p.H2() + (size_t)(t0 + fr) * D + fq * 8; const bf16_t* al_p = H2lo + (size_t)(t0 + fr) * D + fq * 8;
            const int widu = __builtin_amdgcn_readfirstlane(wid);
            unsigned rofs[4];
#pragma unroll
            for (int i = 0; i < 4; ++i) { const int x = wid * 1024 + i * 8192 + lane * 16, row = x >> 8, c = ((x & 255) >> 4) ^ (row & 15); rofs[i] = (unsigned)(row * 2048 + c * 16); }
#define RT_DMA(kc, buf) do { const char* src_ = (const char*)p.routerT() + (size_t)(kc) * 256;                                             \
            _Pragma("unroll") for (int i = 0; i < 4; ++i) __builtin_amdgcn_global_load_lds((const unsigned*)(src_ + rofs[i]), (unsigned*)(smem + 40960 + (buf) * 32768 + widu * 1024 + i * 8192), 16, 0, 0); } while (0)
            RT_DMA(0, 0);
#pragma unroll 1
            for (int kc = 0; kc < 8; ++kc) {
                bf16x8 ah[4], al[4];
#pragma unroll
                for (int ks = 0; ks < 4; ++ks) { ah[ks] = ldfrag(ah_p + kc * 128 + ks * 32); al[ks] = ldfrag(al_p + kc * 128 + ks * 32); }
                asm volatile("s_waitcnt vmcnt(0)" ::: "memory"); __syncthreads();
                if (kc + 1 < 8) RT_DMA(kc + 1, (kc + 1) & 1);
                const char* bb = smem + 40960 + (kc & 1) * 32768;
#pragma unroll
                for (int ks = 0; ks < 4; ++ks)
#pragma unroll
                    for (int nt = 0; nt < 4; ++nt) {
                        const int row = nt * 16 + fr, cc = ((ks * 4 + fq) ^ (row & 15)) * 16;
                        const bf16x8 bh = *(const bf16x8*)(bb + row * 256 + cc), bl = *(const bf16x8*)(bb + (64 + row) * 256 + cc);
                        acc[nt] = __builtin_amdgcn_mfma_f32_16x16x32_bf16(ah[ks], bh, acc[nt], 0, 0, 0);
                        acc[nt] = __builtin_amdgcn_mfma_f32_16x16x32_bf16(ah[ks], bl, acc[nt], 0, 0, 0);
                        acc[nt] = __builtin_amdgcn_mfma_f32_16x16x32_bf16(al[ks], bh, acc[nt], 0, 0, 0);
                    }
            }
#undef RT_DMA
        }
#pragma unroll
        for (int nt = 0; nt < 4; ++nt)
#pragma unroll
            for (int j = 0; j < 4; ++j) lg[(wid * 16 + fq * 4 + j) * 65 + nt * 16 + fr] = acc[nt][j];
        __syncthreads();
        if (MODE == 2) continue;
        int l3 = lane; asm volatile("" : "+v"(l3));
#define SHXF(v_, m_) __int_as_float(__builtin_amdgcn_ds_bpermute((l3 ^ (m_)) << 2, __float_as_int(v_)))
#define SHXI(v_, m_) __builtin_amdgcn_ds_bpermute((l3 ^ (m_)) << 2, (v_))
#define SHBF(v_, src_) __int_as_float(__builtin_amdgcn_ds_bpermute((src_) << 2, __float_as_int(v_)))
#define SHBI(v_, src_) __builtin_amdgcn_ds_bpermute((src_) << 2, (v_))
        const int q4 = l3 & 3, tt = wid * 16 + (l3 >> 2), t = item * 128 + tt, qbase = l3 & ~3;
        float sc_[16], v[16];
#pragma unroll
        for (int i = 0; i < 16; ++i) { const float x = lg[tt * 65 + q4 * 16 + i]; sc_[i] = __builtin_amdgcn_rcpf(1.0f + __builtin_amdgcn_exp2f(-1.4426950408889634f * x)); v[i] = sc_[i] + p.router_b[q4 * 16 + i]; }
        float gsA, gsB;
        { float m1 = v[0], m2 = -INFINITY;
#pragma unroll
          for (int i = 1; i < 8; ++i) { const float x = v[i]; m2 = fmaxf(m2, fminf(m1, x)); m1 = fmaxf(m1, x); }
          gsA = m1 + m2; m1 = v[8]; m2 = -INFINITY;
#pragma unroll
          for (int i = 9; i < 16; ++i) { const float x = v[i]; m2 = fmaxf(m2, fminf(m1, x)); m1 = fmaxf(m1, x); }
          gsB = m1 + m2; }
        { int rankA = 0, rankB = 0;
#pragma unroll
          for (int qq = 0; qq < 4; ++qq) {
              const float ga = SHBF(gsA, qbase | qq), gb = SHBF(gsB, qbase | qq);
              const int g0 = 2 * qq, g1 = 2 * qq + 1, mA = 2 * q4, mB = 2 * q4 + 1;
              rankA += (g0 != mA && (ga > gsA || (ga == gsA && g0 < mA))) ? 1 : 0; rankA += (g1 != mA && (gb > gsA || (gb == gsA && g1 < mA))) ? 1 : 0;
              rankB += (g0 != mB && (ga > gsB || (ga == gsB && g0 < mB))) ? 1 : 0; rankB += (g1 != mB && (gb > gsB || (gb == gsB && g1 < mB))) ? 1 : 0;
          }
          if (rankA >= 4) {
#pragma unroll
              for (int i = 0; i < 8; ++i) v[i] = -INFINITY; }
          if (rankB >= 4) {
#pragma unroll
              for (int i = 8; i < 16; ++i) v[i] = -INFINITY; } }
        unsigned chm = 0u;
#pragma unroll 1
        for (int it = 0; it < 8; ++it) {
            float lm = v[0];
#pragma unroll
            for (int i = 1; i < 16; ++i) lm = fmaxf(lm, v[i]);
            float gm = fmaxf(lm, SHXF(lm, 1)); gm = fmaxf(gm, SHXF(gm, 2));
            int cand = (lm == gm) ? q4 : 4;
            cand = min(cand, SHXI(cand, 1)); cand = min(cand, SHXI(cand, 2));
            const bool win = cand == q4;
            bool found = false;
#pragma unroll
            for (int i = 0; i < 16; ++i) { const bool hit = win && !found && v[i] == gm; if (hit) { chm |= (1u << i); v[i] = -INFINITY; } found = found || hit; }
        }
        float wsum = 0.f;
#pragma unroll
        for (int i = 0; i < 16; ++i) wsum += ((chm >> i) & 1u) ? sc_[i] : 0.f;
        wsum += SHXF(wsum, 1); wsum += SHXF(wsum, 2);
        const float wscale = 2.5f / wsum;
        const unsigned long long pat = 0x1111111111111111ull << q4;
#pragma unroll
        for (int i = 0; i < 16; ++i) { const unsigned long long bal = __ballot((chm >> i) & 1u); if (l3 < 4) wcnt[wid * 64 + l3 * 16 + i] = __popcll(bal & (0x1111111111111111ull << l3)); }
        __syncthreads();
        if (wid == 0) {
            int tot = 0;
#pragma unroll
            for (int w = 0; w < 8; ++w) tot += wcnt[w * 64 + lane];
            int run = atomicAdd(&cntp[lane], tot);
#pragma unroll
            for (int w = 0; w < 8; ++w) { const int c = wcnt[w * 64 + lane]; pref[w * 64 + lane] = run; run += c; }
        }
        __syncthreads();
        {
            const int pc = __popc(chm);
            int kbase = 0;
#pragma unroll
            for (int qq = 0; qq < 3; ++qq) { const int o = SHBI(pc, qbase | qq); kbase += (qq < q4) ? o : 0; }
#pragma unroll
            for (int i = 0; i < 16; ++i) {
                const bool c = (chm >> i) & 1u;
                const unsigned long long bal = __ballot(c);
                if (c) {
                    const int e = q4 * 16 + i;
                    const int slot = pref[wid * 64 + e] + __popcll(bal & pat & ((1ull << l3) - 1ull));
                    tl[(size_t)e * ECAP + slot] = t; wl_[(size_t)e * ECAP + slot] = sc_[i] * wscale;
                    tm[(size_t)t * 8 + kbase + __popc(chm & ((1u << i) - 1u))] = e * ECAP + slot;
                }
            }
        }
    }
}
#undef SHXF
#undef SHXI
#undef SHBF
#undef SHBI

constexpr int MOE_AUX = 162816;
__device__ __forceinline__ void moe_tables(const MK& p, int colt, int* tpre, int* rbase, int tid_l) {
    __syncthreads();
    if (tid_l == 0) { int tp = 0, rb = 0;
        for (int e = 0; e < 65; ++e) { const int c = e < 64 ? p.cnt()[e] : T; tpre[e] = tp; rbase[e] = rb; tp += ((c + 255) >> 8) * colt; rb += c; }
        tpre[65] = tp; rbase[65] = rb; }
    __syncthreads();
}
struct SchedUp { const MK* p; int bid, nb, tid_l, ntiles; const int* tpre; const int* rbase; mutable int e_hint;
    __device__ __forceinline__ bool next(int i, pg8::GUnit& u, unsigned (&vA)[2][2]) const {
        const int tile = bid + i * nb; if (tile >= ntiles) return false;
        int e = e_hint; while (tile >= tpre[e + 1]) ++e; e_hint = e;
        const int j = tile - tpre[e], rt = j >> 1, ct = j & 1, cnt_e = rbase[e + 1] - rbase[e];
        u.A = (const char*)p->H2(); u.B = (const char*)(p->W13t() + ((size_t)e * 512 + ct * 256) * D); u.i0 = e; u.i1 = rt; u.i2 = ct; u.i3 = cnt_e;
#pragma unroll
        for (int i2 = 0; i2 < 2; ++i2) { int R, C; stage_rc(tid_l * 16 + i2 * 8192, R, C);
#pragma unroll
            for (int h = 0; h < 2; ++h) { int slot = rt * 256 + h * 128 + R; if (slot >= cnt_e) slot = 0;
                const int tok = e < 64 ? p->tok_list()[(size_t)e * ECAP + slot] : slot;
                vA[h][i2] = (unsigned)tok * (D * 2u) + (unsigned)C * 2u; } }
        return true; } };
struct EpiUp { static constexpr bool PERM = true; const MK* p; const int* rbase;
    __device__ __forceinline__ void operator()(const f32x4 (&acc)[2][2][4][2], const pg8::GUnit& u, int wr, int wc, int fr, int fq) const {
        const int e = u.i0, rt = u.i1, ct = u.i2, cnt_e = u.i3;
        bf16_t* ab = p->ACT() + (size_t)rbase[e] * DE + ct * 128 + wc * 32 + fq * 8;
#pragma unroll
        for (int ai = 0; ai < 2; ++ai)
#pragma unroll
            for (int m = 0; m < 4; ++m) {
                const int slot = rt * 256 + ai * 128 + wr * 64 + m * 16 + fr;
                u32x4 w;
                w.x = cvtpk(silu_fast(acc[ai][0][m][0][0]) * acc[ai][1][m][0][0], silu_fast(acc[ai][0][m][0][1]) * acc[ai][1][m][0][1]);
                w.y = cvtpk(silu_fast(acc[ai][0][m][0][2]) * acc[ai][1][m][0][2], silu_fast(acc[ai][0][m][0][3]) * acc[ai][1][m][0][3]);
                w.z = cvtpk(silu_fast(acc[ai][0][m][1][0]) * acc[ai][1][m][1][0], silu_fast(acc[ai][0][m][1][1]) * acc[ai][1][m][1][1]);
                w.w = cvtpk(silu_fast(acc[ai][0][m][1][2]) * acc[ai][1][m][1][2], silu_fast(acc[ai][0][m][1][3]) * acc[ai][1][m][1][3]);
                if (slot < cnt_e) *(u32x4*)(ab + (size_t)slot * DE) = w;
            }
    } };
__device__ __forceinline__ void ph_moe_up(const MK& p, int bid, int nb, int tid_l) {
    int* tpre = (int*)(smem + MOE_AUX); int* rbase = tpre + 80;
    moe_tables(p, 2, tpre, rbase, tid_l);
    SchedUp S{&p, bid, nb, tid_l, tpre[65], tpre, rbase, 0}; EpiUp E{&p, rbase};
    pg8::gemm<EpiUp, SchedUp, true, true>(D, S, E, tid_l);
}
constexpr float Y_SCALE = 64.0f;
struct SchedDown { const MK* p; int bid, nb, tid_l, ntiles; const int* tpre; const int* rbase; mutable int e_hint;
    __device__ __forceinline__ bool next(int i, pg8::GUnit& u, unsigned (&vA)[2][2]) const {
        const int tile = bid + i * nb; if (tile >= ntiles) return false;
        int e = e_hint; while (tile >= tpre[e + 1]) ++e; e_hint = e;
        const int j = tile - tpre[e], rt = j >> 2, ct = j & 3, cnt_e = rbase[e + 1] - rbase[e];
        u.A = (const char*)(p->ACT() + (size_t)(rbase[e] + rt * 256) * DE); u.B = (const char*)(p->W2t() + ((size_t)e * D + ct * 256) * DE); u.i0 = e; u.i1 = rt; u.i2 = ct; u.i3 = cnt_e;
        pg8::plain_voffA(DE, vA, tid_l); return true; } };
template <int MODE> struct EpiDown { static constexpr bool PERM = true; const MK* p; const int* rbase;
    __device__ __forceinline__ void operator()(const f32x4 (&acc)[2][2][4][2], const pg8::GUnit& u, int wr, int wc, int fr, int fq) const {
        const int e = u.i0, rt = u.i1, ct = u.i2, cnt_e = u.i3;
        {
            const float* wl = p->wt_list() + (size_t)(e < 64 ? e : 0) * ECAP;
            float wv[2][4];
#pragma unroll
            for (int ai = 0; ai < 2; ++ai)
#pragma unroll
                for (int m = 0; m < 4; ++m) { const int sl = rt * 256 + ai * 128 + wr * 64 + m * 16 + fr; wv[ai][m] = e < 64 ? wl[sl < cnt_e ? sl : 0] * Y_SCALE : Y_SCALE; }
            const int wid = wr * 4 + wc, lane = fq * 16 + fr;
            char* wa = smem + 131072 + wid * 3968;
            unsigned char* yb = p->Y() + (size_t)rbase[e] * D + ct * 256 + wc * 64 + (lane & 3) * 16;
#pragma unroll
            for (int ai = 0; ai < 2; ++ai)
#pragma unroll
                for (int m = 0; m < 4; ++m) {
                    const float w = wv[ai][m];
                    char* img = wa + ((m & 1) ? 1280 : 0);
#pragma unroll
                    for (int bj = 0; bj < 2; ++bj) {
                        u32x2 pk;
#pragma unroll
                        for (int n = 0; n < 2; ++n) {
                            float v0 = __builtin_amdgcn_fmed3f(acc[ai][bj][m][n][0] * w, -448.f, 448.f), v1 = __builtin_amdgcn_fmed3f(acc[ai][bj][m][n][1] * w, -448.f, 448.f);
                            float v2 = __builtin_amdgcn_fmed3f(acc[ai][bj][m][n][2] * w, -448.f, 448.f), v3 = __builtin_amdgcn_fmed3f(acc[ai][bj][m][n][3] * w, -448.f, 448.f);
                            int q = 0; q = __builtin_amdgcn_cvt_pk_fp8_f32(v0, v1, q, false); q = __builtin_amdgcn_cvt_pk_fp8_f32(v2, v3, q, true);
                            if (n == 0) pk.x = (unsigned)q; else pk.y = (unsigned)q;
                        }
                        *(u32x2*)(img + fr * 80 + bj * 32 + fq * 8) = pk;
                    }
                    asm volatile("s_waitcnt lgkmcnt(0)" ::: "memory");
                    const int rr = lane >> 2, slot = rt * 256 + ai * 128 + wr * 64 + m * 16 + rr;
                    const u32x4 v = *(const u32x4*)(img + rr * 80 + (lane & 3) * 16);
                    if (MODE == 1) asm volatile("" :: "v"(v)); else if (slot < cnt_e) *(u32x4*)(yb + (size_t)slot * D) = v;
                }
        }
    } };
template <bool DUMMY, int MODE = 0> __device__ __forceinline__ void ph_moe_down(const MK& p, int bid, int nb, int tid_l) {
    int* tpre = (int*)(smem + MOE_AUX); int* rbase = tpre + 80;
    moe_tables(p, 4, tpre, rbase, tid_l);
    SchedDown S{&p, bid, nb, tid_l, DUMMY ? tpre[64] : tpre[65], tpre, rbase, 0}; EpiDown<MODE> E{&p, rbase};
    pg8::gemm<EpiDown<MODE>, SchedDown, false, true>(DE, S, E, tid_l);
}

template <bool DUMMY> __device__ __forceinline__ void ph_final(const MK& p, int bid, int nb, int tid_l) {
    const int wid = tid_l >> 6, lane = tid_l & 63;
    int* tpre = (int*)(smem + MOE_AUX); int* rbase = tpre + 80;
    moe_tables(p, 1, tpre, rbase, tid_l);
    for (int t = bid * 8 + wid; t < T; t += nb * 8) {
        const int b = t / SEQ;
        float f[16];
#pragma unroll
        for (int i = 0; i < 16; ++i) f[i] = 0.f;
#pragma unroll
        for (int k = 0; k < 9; ++k) {
            int row;
            if (k < 8) { const int id = p.tokmap()[(size_t)t * 8 + k], e = id >> 15, slot = id & (ECAP - 1); row = rbase[e] + slot; } else row = rbase[64] + t;
            const unsigned char* yr = p.Y() + (size_t)row * D + lane * 4;
#pragma unroll
            for (int q = 0; q < 4; ++q) {
                const int w = *(const int*)(yr + q * 256);
                const auto lo = __builtin_amdgcn_cvt_pk_f32_fp8(w, false); const auto hi = __builtin_amdgcn_cvt_pk_f32_fp8(w, true);
                f[q * 4 + 0] += lo[0]; f[q * 4 + 1] += lo[1]; f[q * 4 + 2] += hi[0]; f[q * 4 + 3] += hi[1];
            }
        }
        const int pcol = ((lane >> 3) & 1) * 128 + (lane >> 4) * 32 + (lane & 7) * 4;
        const float* g2 = p.mod() + (size_t)b * 6 * D + 5 * D + pcol;
        const bf16_t* x1 = p.X1() + (size_t)t * 2048 + pcol;
        float* xo = p.out + (size_t)t * D + pcol;
        float v[16]; float ss = 0.f;
#pragma unroll
        for (int q = 0; q < 4; ++q) {
            const u32x2 xw = *(const u32x2*)(x1 + q * 256); const float4 g = *(const float4*)(g2 + q * 256);
            v[q * 4 + 0] = __uint_as_float(xw.x << 16) + g.x * f[q * 4 + 0] * (1.0f / Y_SCALE); v[q * 4 + 1] = __uint_as_float(xw.x & 0xffff0000u) + g.y * f[q * 4 + 1] * (1.0f / Y_SCALE);
            v[q * 4 + 2] = __uint_as_float(xw.y << 16) + g.z * f[q * 4 + 2] * (1.0f / Y_SCALE); v[q * 4 + 3] = __uint_as_float(xw.y & 0xffff0000u) + g.w * f[q * 4 + 3] * (1.0f / Y_SCALE);
            ss += v[q * 4] * v[q * 4] + v[q * 4 + 1] * v[q * 4 + 1] + v[q * 4 + 2] * v[q * 4 + 2] + v[q * 4 + 3] * v[q * 4 + 3];
        }
        ss = wave_sum(ss);
        const float rstd = rsqrtf(ss * (1.0f / D) + EPS);
#pragma unroll
        for (int q = 0; q < 4; ++q) {
            const float4 gf = *(const float4*)(p.final_g + q * 256 + pcol);
            *(float4*)((DUMMY ? (float*)(p.ws + 42 * MiB) + (size_t)t * D + pcol : xo) + q * 256) = make_float4(v[q * 4] * rstd * gf.x, v[q * 4 + 1] * rstd * gf.y, v[q * 4 + 2] * rstd * gf.z, v[q * 4 + 3] * rstd * gf.w);
        }
    }
}


#define XB_TMO      128
#define XB_XCNT(j)  (256  + 64 * (j))
#define XB_XSUB(j)  (1280 + 64 * (j))
#define XB_XGEN(j)  (2304 + 64 * (j))
#define XB_TOP      3328
#define XB_TOPGEN   3392
#define XCD_BAR_WORDS 3456
#define XB_SPIN_CAP (1u << 22)
#define LAS __attribute__((address_space(3)))
__device__ __forceinline__ unsigned xb_ld(unsigned* p)              { return __hip_atomic_load(p, __ATOMIC_RELAXED, __HIP_MEMORY_SCOPE_AGENT); }
__device__ __forceinline__ unsigned xb_add(unsigned* p, unsigned v) { return __hip_atomic_fetch_add(p, v, __ATOMIC_RELAXED, __HIP_MEMORY_SCOPE_AGENT); }
__device__ __forceinline__ unsigned xb_xcc_id() { return (unsigned)__builtin_amdgcn_s_getreg((3 << 11) | 20) & 0xFu; }
#define XB_SPIN(cond, bar) do { unsigned _sp = 0; while (cond) { __builtin_amdgcn_s_sleep(1); \
    if ((++_sp & 255u) == 0u) { if (xb_ld(&(bar)[XB_TMO])) break; if (_sp > XB_SPIN_CAP) { atomicAdd(&(bar)[XB_TMO], 1u); break; } } } } while (0)
struct XcdBarrier { unsigned* bar; unsigned x; volatile LAS unsigned* st; };
__device__ __forceinline__ XcdBarrier xcd_barrier_post(unsigned* bar, volatile LAS unsigned* st, int tid) {
    XcdBarrier b; b.bar = bar; b.x = xb_xcc_id(); b.st = st;
    if (tid == 0) (void)xb_add(&bar[XB_XCNT(b.x)], 1u);
    return b;
}
__device__ __forceinline__ void xcd_barrier_complete(unsigned* bar, unsigned x, unsigned& nloc, unsigned& nx) {
    const unsigned G = gridDim.x * gridDim.y * gridDim.z;
    unsigned sum, cnt, mine, sp = 0u;
    for (;;) {
        sum = 0u; cnt = 0u; mine = 0u;
#pragma unroll
        for (unsigned j = 0; j < 16; ++j) { const unsigned c = xb_ld(&bar[XB_XCNT(j)]); sum += c; cnt += (c > 0u) ? 1u : 0u; mine = (j == x) ? c : mine; }
        if (sum == G) break;
        __builtin_amdgcn_s_sleep(1);
        if ((++sp & 255u) == 0u) { if (xb_ld(&bar[XB_TMO])) break; if (sp > XB_SPIN_CAP) { atomicAdd(&bar[XB_TMO], 1u); break; } }
    }
    nloc = mine > 0u ? mine : 1u; nx = cnt > 0u ? cnt : 1u;
}
__device__ __forceinline__ void xcd_barrier(const XcdBarrier& b, int tid) {
    asm volatile("s_waitcnt vmcnt(0)" ::: "memory");
    __syncthreads();
    if (tid == 0) {
        unsigned* bar = b.bar;
        __builtin_amdgcn_s_waitcnt(0);
        unsigned nloc = b.st[0], nx = b.st[1];
        if (nloc == 0u) { xcd_barrier_complete(bar, b.x, nloc, nx); b.st[0] = nloc; b.st[1] = nx; }
        const unsigned old = xb_add(&bar[XB_XSUB(b.x)], 1u);
        const unsigned gen = old / nloc;
        if (old + 1u == (gen + 1u) * nloc) {
            __builtin_amdgcn_fence(__ATOMIC_RELEASE, "agent");
            asm volatile("s_waitcnt vmcnt(0)" ::: "memory");
            const unsigned og = xb_add(&bar[XB_TOP], 1u);
            const unsigned tg = og / nx;
            if (og + 1u == (tg + 1u) * nx) xb_add(&bar[XB_TOPGEN], 1u);
            else XB_SPIN(xb_ld(&bar[XB_TOPGEN]) == tg, bar);
            __builtin_amdgcn_fence(__ATOMIC_ACQUIRE, "agent");
            xb_add(&bar[XB_XGEN(b.x)], 1u);
            asm volatile("s_waitcnt vmcnt(0)" ::: "memory");
        } else {
            XB_SPIN(xb_ld(&bar[XB_XGEN(b.x)]) == gen, bar);
            __builtin_amdgcn_fence(__ATOMIC_ACQUIRE, "agent");
            asm volatile("s_waitcnt vmcnt(0)" ::: "memory");
        }
    }
    __syncthreads();
}

__device__ __forceinline__ int lane_id_volatile() { int l; asm volatile("v_mbcnt_lo_u32_b32 %0, -1, 0\n\tv_mbcnt_hi_u32_b32 %0, -1, %0" : "=v"(l)); return l; }
__global__ __launch_bounds__(512, 2) void k_mega(MK p) {
    cg::grid_group grid = cg::this_grid();
    const int bid = blockIdx.x, nb = gridDim.x;
    volatile LAS unsigned* xst = (volatile LAS unsigned*)(smem + 162816 + 768);
    if (threadIdx.x < 4) xst[threadIdx.x] = 0u;
    __syncthreads();
    const XcdBarrier xb = xcd_barrier_post((unsigned*)(p.ws + 524288), xst, (int)threadIdx.x);
    const int wv_ = __builtin_amdgcn_readfirstlane((int)threadIdx.x >> 6);
#define LANE_ID() lane_id_volatile()
#define PH_TID() int t_ = wv_ * 64 + LANE_ID(); asm volatile("" : "+v"(t_))
    { PH_TID(); if (bid == 0 && t_ < 256) p.cnt()[t_] = 0; ph_mod(p, bid, nb, t_); ph_convert(p, bid, nb, t_); }
#if DUP == 10
    { PH_TID(); ph_convert(p, bid, nb, t_); }
#endif
    grid.sync();
    { PH_TID(); ph_ln1(p, bid, nb, t_); }
#if DUP == 1
    { PH_TID(); ph_ln1(p, bid, nb, t_); }
#endif
    xcd_barrier(xb, wv_ * 64 + LANE_ID());
    { PH_TID(); ph_gemm_in(p, bid, nb, t_); }
    { PH_TID(); ph_convert_dyn(p, t_); }
#if DUP == 2
    { PH_TID(); ph_gemm_in(p, bid, nb, t_); }
#endif
    xcd_barrier(xb, wv_ * 64 + LANE_ID());
    { PH_TID(); ph_attn<0>(p, bid, nb, t_); }
#if DUP == 3
    { PH_TID(); ph_attn<2>(p, bid, nb, t_); }
#endif
#if DUP == 31
    { PH_TID(); ph_attn<1>(p, bid, nb, t_); }
#endif
#if DUP == 33
    { PH_TID(); ph_attn<3>(p, bid, nb, t_); }
#endif
    { PH_TID(); ph_kv(p, bid, nb, t_); }
#if DUP == 11
    { PH_TID(); ph_kv(p, bid, nb, t_); }
#endif
    xcd_barrier(xb, wv_ * 64 + LANE_ID());
    { PH_TID(); ph_scan(p, bid, nb, t_); }
    xcd_barrier(xb, wv_ * 64 + LANE_ID());
    { PH_TID(); ph_ret(p, bid, nb, t_); }
#if DUP == 5
    { PH_TID(); ph_ret(p, bid, nb, t_); }
#endif
    xcd_barrier(xb, wv_ * 64 + LANE_ID());
    { PH_TID(); ph_gemm_out(p, bid, nb, t_); }
#if DUP == 6
    { PH_TID(); ph_gemm_out(p, bid, nb, t_); }
#endif
    xcd_barrier(xb, wv_ * 64 + LANE_ID());
#if DUP == 7
    { PH_TID(); ph_route<true>(p, bid, nb, t_); }
#endif
#if DUP == 72
    { PH_TID(); ph_route<true, 2>(p, bid, nb, t_); }
#endif
#if DUP == 73
    { PH_TID(); ph_route<true, 3>(p, bid, nb, t_); }
#endif
    { PH_TID(); ph_route<false>(p, bid, nb, t_); }
    xcd_barrier(xb, wv_ * 64 + LANE_ID());
    { PH_TID(); ph_moe_up(p, bid, nb, t_); }
#if DUP == 8
    { PH_TID(); ph_moe_up(p, bid, nb, t_); }
#endif
    xcd_barrier(xb, wv_ * 64 + LANE_ID());
#if DUP == 9
    { PH_TID(); ph_moe_down<true>(p, bid, nb, t_); }
#endif
#if DUP == 91
    { PH_TID(); ph_moe_down<true, 1>(p, bid, nb, t_); }
#endif
    { PH_TID(); ph_moe_down<false>(p, bid, nb, t_); }
    xcd_barrier(xb, wv_ * 64 + LANE_ID());
#if DUP == 13
    { PH_TID(); ph_final<true>(p, bid, nb, t_); }
#endif
    { PH_TID(); ph_final<false>(p, bid, nb, t_); }
#undef PH_TID
#undef LANE_ID
}
constexpr int LDS_TOTAL = 163840;
extern "C" void kernel_launch(void* const* d_in, const int* in_sizes, int n_in, void* d_out, int out_size, void* d_ws, size_t ws_size, hipStream_t stream) {
    char* ws = (char*)d_ws;
    MK mk{};
    mk.x = (const float*)d_in[0]; mk.c = (const float*)d_in[1]; mk.ctx = (const float*)d_in[2]; mk.cctx = (const float*)d_in[3]; mk.ada_w = (const float*)d_in[4]; mk.ada_b = (const float*)d_in[5];
    mk.norm1_g = (const float*)d_in[6]; mk.w_in = (const float*)d_in[7]; mk.lq1 = (const float*)d_in[8]; mk.lk1 = (const float*)d_in[9]; mk.lq2 = (const float*)d_in[10]; mk.lk2 = (const float*)d_in[11];
    mk.dattn_g = (const float*)d_in[12]; mk.dec_f = (const float*)d_in[13]; mk.dec_b = (const float*)d_in[14]; mk.ret_g = (const float*)d_in[15]; mk.w_out = (const float*)d_in[16];
    mk.norm2_g = (const float*)d_in[17]; mk.router_w = (const float*)d_in[18]; mk.router_b = (const float*)d_in[19]; mk.ew1 = (const float*)d_in[20]; mk.ew3 = (const float*)d_in[21];
    mk.ew2 = (const float*)d_in[22]; mk.sw1 = (const float*)d_in[23]; mk.sw3 = (const float*)d_in[24]; mk.sw2 = (const float*)d_in[25]; mk.final_g = (const float*)d_in[26];
    mk.out = (float*)d_out;
    mk.ws = ws;
    mk.dbgP = nullptr; mk.dbg_lo = 0; mk.dbg_hi = 12; mk.conv_limit = 1 << 30;
    static int grid_blocks = 0;
    if (!grid_blocks) {
        (void)hipFuncSetAttribute((const void*)k_mega, hipFuncAttributeMaxDynamicSharedMemorySize, LDS_TOTAL);
        int dev = 0, cus = 0, per_cu = 0;
        (void)hipGetDevice(&dev);
        (void)hipDeviceGetAttribute(&cus, hipDeviceAttributeMultiprocessorCount, dev);
        (void)hipOccupancyMaxActiveBlocksPerMultiprocessor(&per_cu, k_mega, 512, LDS_TOTAL);
        if (per_cu > 1) per_cu = 1;
        grid_blocks = cus * per_cu;
        if (grid_blocks <= 0) { fprintf(stderr, "occupancy query failed: cus %d per_cu %d\n", cus, per_cu); grid_blocks = 256; }
    }
    (void)hipMemsetAsync(ws + 524288, 0, XCD_BAR_WORDS * 4, stream);
    void* args[] = {&mk};
    hipError_t e = hipLaunchCooperativeKernel((void*)k_mega, dim3(grid_blocks), dim3(512), args, LDS_TOTAL, stream);
    if (e != hipSuccess) fprintf(stderr, "cooperative launch failed: %s (grid %d)\n", hipGetErrorString(e), grid_blocks);
}
```

```cpp
#include <hip/hip_runtime.h>
#include <hip/hip_cooperative_groups.h>
#include <cstdio>
namespace cg = cooperative_groups;
#ifndef DUP
#define DUP 0
#endif
#include <stdint.h>

constexpr int D = 1024, NB = 4, SEQ = 8192, CTX = 256, RB = SEQ + CTX  , NR = NB * RB  , T = NB * SEQ;
constexpr int NE = 64, DE = 256, ECAP = 32768;
constexpr float EPS = 1e-6f;
typedef unsigned short bf16_t;

__device__ __forceinline__ float siluf(float v) { return v / (1.0f + expf(-v)); }
__device__ __forceinline__ float silu_fast(float v) { return v * __builtin_amdgcn_rcpf(1.0f + __builtin_amdgcn_exp2f(-1.4426950408889634f * v)); }
__device__ __forceinline__ float wave_sum(float v) {
#pragma unroll
    for (int o = 32; o > 0; o >>= 1) v += __shfl_xor(v, o);
    return v;
}
__device__ __forceinline__ float wave_max(float v) {
#pragma unroll
    for (int o = 32; o > 0; o >>= 1) v = fmaxf(v, __shfl_xor(v, o));
    return v;
}
__device__ __forceinline__ float block_sum(float v, float* red) {
    v = wave_sum(v);
    __syncthreads();
    if ((threadIdx.x & 63) == 0) red[threadIdx.x >> 6] = v;
    __syncthreads();
    return red[0] + red[1] + red[2] + red[3];
}
__device__ __forceinline__ float block_max(float v, float* red) {
    v = wave_max(v);
    __syncthreads();
    if ((threadIdx.x & 63) == 0) red[threadIdx.x >> 6] = v;
    __syncthreads();
    return fmaxf(fmaxf(red[0], red[1]), fmaxf(red[2], red[3]));
}

typedef short bf16x8 __attribute__((ext_vector_type(8)));
typedef short s16x4 __attribute__((ext_vector_type(4)));
typedef float f32x4 __attribute__((ext_vector_type(4)));
typedef float f32x16 __attribute__((ext_vector_type(16)));
typedef unsigned u32x2 __attribute__((ext_vector_type(2)));
typedef unsigned u32x4 __attribute__((ext_vector_type(4)));
extern __shared__ __attribute__((aligned(1024))) char smem[];
constexpr int NTHR = 512;
constexpr int GEMM_LDS = 131072;

__device__ __forceinline__ unsigned cvtpk(float lo, float hi) { unsigned r; asm volatile("v_cvt_pk_bf16_f32 %0, %1, %2" : "=v"(r) : "v"(lo), "v"(hi)); return r; }
__device__ __forceinline__ bf16_t f2bf(float v) { return (bf16_t)(cvtpk(v, v) & 0xffffu); }
__device__ __forceinline__ float bf2f(bf16_t v) { return __uint_as_float(((unsigned)v) << 16); }

constexpr size_t MiB = 1048576;
struct MK {
    const float *x, *c, *ctx, *cctx, *ada_w, *ada_b, *norm1_g, *w_in, *lq1, *lk1, *lq2, *lk2, *dattn_g, *dec_f, *dec_b, *ret_g, *w_out, *norm2_g, *router_w, *router_b,
        *ew1, *ew3, *ew2, *sw1, *sw3, *sw2, *final_g;
    float* out; char* ws;
    float* dbgP; long dbg_lo, dbg_hi; long conv_limit;
#define WSF(name, type, off) __device__ __forceinline__ type* name() const { return (type*)(ws + (off)); }
    WSF(mod, float, 0) WSF(cnt, int, 131072) WSF(ropec, float, 262144) WSF(ropes, float, 262144 + 8192)
    WSF(w_inT, bf16_t, 1 * MiB) WSF(w_outT, bf16_t, 7 * MiB) WSF(routerT, bf16_t, 9 * MiB) WSF(W2t, bf16_t, 9 * MiB + 524288)
    WSF(H, bf16_t, 42 * MiB) WSF(MIX, bf16_t, 42 * MiB) WSF(KV, bf16_t, 112 * MiB) WSF(ST, bf16_t, 147 * MiB) WSF(ACT, bf16_t, 42 * MiB)
    WSF(W13t, bf16_t, 194 * MiB) WSF(H2, bf16_t, 260 * MiB)
    WSF(Q, bf16_t, 260 * MiB) WSF(K, bf16_t, 292 * MiB) WSF(V, bf16_t, 325 * MiB) WSF(RQ, bf16_t, 358 * MiB) WSF(RK, bf16_t, 375 * MiB)
    WSF(KTf, bf16_t, 392 * MiB) WSF(KTb, bf16_t, 409 * MiB) WSF(VT, bf16_t, 426 * MiB) WSF(RG, bf16_t, 459 * MiB)
    WSF(Y, unsigned char, 194 * MiB) WSF(tok_list, int, 484 * MiB) WSF(wt_list, float, 492 * MiB) WSF(tokmap, int, 500 * MiB)
    __device__ __forceinline__ bf16_t* X1() const { return (bf16_t*)out; }
#undef WSF
};

__device__ __forceinline__ void ph_mod(const MK& p, int bid, int nb, int tid_l) {
    float* red = (float*)smem;
    for (int it = bid; it < 6 * D / 32; it += nb) {
        const int col = tid_l & 31, kg = tid_l >> 5, j = it * 32 + col;
        float a[5] = {0, 0, 0, 0, 0};
        for (int k = kg * 64; k < kg * 64 + 64; ++k) {
            float w = p.ada_w[(size_t)k * 6 * D + j];
#pragma unroll
            for (int r = 0; r < 5; ++r) { float cv = r < 4 ? p.c[r * D + k] : p.cctx[k]; a[r] += siluf(cv) * w; }
        }
        __syncthreads();
#pragma unroll
        for (int r = 0; r < 5; ++r) red[(kg * 5 + r) * 32 + col] = a[r];
        __syncthreads();
        if (tid_l < 160) {
            int r = tid_l >> 5; float s = 0;
            for (int g = 0; g < 16; ++g) s += red[(g * 5 + r) * 32 + col];
            p.mod()[(size_t)r * 6 * D + j] = s + p.ada_b[j];
        }
    }
    if (bid == nb - 1) {
        for (int i = tid_l; i < 128 * 16; i += NTHR) {
            int pos = i >> 4, f = i & 15;
            float inv_freq = (float)pow(10000.0, -(double)f / 16.0);
            float s, c; sincosf((float)pos * inv_freq, &s, &c);
            p.ropec()[i] = c; p.ropes()[i] = s;
        }
    }
    __syncthreads();
}

__device__ __forceinline__ void tr_tile(const float* src, int ldsrc, int k0, int n0, bf16_t* dst, int lddst, int mode  , bf16_t* dst2, int tid_l) {
    float* t = (float*)smem;
    __syncthreads();
    for (int i = tid_l; i < 64 * 16; i += NTHR) {
        int r = i >> 4, c4 = (i & 15) * 4;
        float4 v = *(const float4*)(src + (size_t)(k0 + r) * ldsrc + n0 + c4);
        t[r * 65 + c4] = v.x; t[r * 65 + c4 + 1] = v.y; t[r * 65 + c4 + 2] = v.z; t[r * 65 + c4 + 3] = v.w;
    }
    __syncthreads();
    for (int i = tid_l; i < 64 * 16; i += NTHR) {
        int n = i >> 4, k4 = (i & 15) * 4;
        float a = t[(k4 + 0) * 65 + n], b = t[(k4 + 1) * 65 + n], c = t[(k4 + 2) * 65 + n], d = t[(k4 + 3) * 65 + n];
        int nn = n0 + n, row = nn;
        if (mode == 1 || mode == 2) { int ct = nn >> 7; row = ct * 256 + (mode == 2 ? 128 : 0) + (nn & 127); }
        u32x2 w; w.x = cvtpk(a, b); w.y = cvtpk(c, d);
        *(u32x2*)(dst + (size_t)row * lddst + k0 + k4) = w;
        if (mode == 3) {
            float ah = bf2f((bf16_t)(w.x & 0xffff)), bh = bf2f((bf16_t)(w.x >> 16)), ch = bf2f((bf16_t)(w.y & 0xffff)), dh = bf2f((bf16_t)(w.y >> 16));
            u32x2 l; l.x = cvtpk(a - ah, b - bh); l.y = cvtpk(c - ch, d - dh);
            *(u32x2*)(dst2 + (size_t)row * lddst + k0 + k4) = l;
        }
    }
}
constexpr int CV_STATIC = 16 * 48 + 16 * 16 + 16, CV_E13 = 65 * 2 * 16 * 4, CV_E2 = 65 * 4 * 16, CV_TOTAL = CV_STATIC + CV_E13 + CV_E2;
__device__ __forceinline__ void convert_tile(const MK& p, int j, int tid_l) {
    const int n_win = 16 * 48, n_wout = 16 * 16, n_rt = 16;
    if (j < n_win) { tr_tile(p.w_in, 3072, (j / 48) * 64, (j % 48) * 64, p.w_inT(), 1024, 0, nullptr, tid_l); return; } j -= n_win;
    if (j < n_wout) { tr_tile(p.w_out, 1024, (j / 16) * 64, (j % 16) * 64, p.w_outT(), 1024, 0, nullptr, tid_l); return; } j -= n_wout;
    if (j < n_rt) { tr_tile(p.router_w, 64, j * 64, 0, p.routerT(), 1024, 3, p.routerT() + 64 * 1024, tid_l); return; } j -= n_rt;
    if (j < CV_E13) {
        int e = j / 128, r = j % 128, which = r / 64, tt = r % 64;
        const float* src = e < 64 ? (which ? p.ew3 : p.ew1) + (size_t)e * D * DE : (which ? p.sw3 : p.sw1);
        tr_tile(src, DE, (tt / 4) * 64, (tt % 4) * 64, p.W13t() + (size_t)e * 512 * 1024, 1024, 1 + which, nullptr, tid_l); return; } j -= CV_E13;
    { int e = j / 64, tt = j % 64;
      const float* src = e < 64 ? p.ew2 + (size_t)e * DE * D : p.sw2;
      tr_tile(src, D, (tt / 16) * 64, (tt % 16) * 64, p.W2t() + (size_t)e * 1024 * 256, 256, 0, nullptr, tid_l); }
}
__device__ __forceinline__ void ph_convert(const MK& p, int bid, int nb, int tid_l) {
    for (int it = bid; it < CV_STATIC; it += nb) convert_tile(p, it, tid_l);
    __syncthreads();
}
__device__ __forceinline__ void ph_convert_dyn(const MK& p, int tid_l) {
    int* q = (int*)smem + 8192;
    for (;;) {
        __syncthreads();
        if (tid_l == 0) q[0] = atomicAdd(&p.cnt()[200], 8);
        __syncthreads();
        const int base = q[0];
        if (base >= CV_E13 + CV_E2) break;
        for (int k = 0; k < 8; ++k) if (base + k < CV_E13 + CV_E2) convert_tile(p, CV_STATIC + base + k, tid_l);
    }
    __syncthreads();
}

__device__ __forceinline__ void ph_ln1(const MK& p, int bid, int nb, int tid_l) {
    const int wid = tid_l >> 6, lane = tid_l & 63;
    for (int R = bid * 8 + wid; R < NR; R += nb * 8) {
        int b = R / RB, i = R % RB;
        const float* src = i < CTX ? p.ctx + ((size_t)b * CTX + i) * D : p.x + ((size_t)b * SEQ + (i - CTX)) * D;
        const float* m = p.mod() + (size_t)(i < CTX ? 4 : b) * 6 * D;
        float4 v[4]; float ss = 0;
#pragma unroll
        for (int q = 0; q < 4; ++q) { v[q] = *(const float4*)(src + q * 256 + lane * 4); ss += v[q].x * v[q].x + v[q].y * v[q].y + v[q].z * v[q].z + v[q].w * v[q].w; }
        ss = wave_sum(ss);
        float rstd = rsqrtf(ss * (1.0f / D) + EPS);
#pragma unroll
        for (int q = 0; q < 4; ++q) {
            int c0 = q * 256 + lane * 4;
            float4 gg = *(const float4*)(p.norm1_g + c0), sh = *(const float4*)(m + c0), sc = *(const float4*)(m + D + c0);
            float o0 = v[q].x * rstd * gg.x * (1 + sc.x) + sh.x, o1 = v[q].y * rstd * gg.y * (1 + sc.y) + sh.y;
            float o2 = v[q].z * rstd * gg.z * (1 + sc.z) + sh.z, o3 = v[q].w * rstd * gg.w * (1 + sc.w) + sh.w;
            u32x2 w; w.x = cvtpk(o0, o1); w.y = cvtpk(o2, o3);
            *(u32x2*)(p.H() + (size_t)R * D + c0) = w;
        }
    }
}

__device__ __forceinline__ int lds_byte(int r, int c) { int st = (r >> 4) * 2 + (c >> 5), ob = (r & 15) * 64 + (c & 31) * 2; return st * 1024 + (ob ^ (((ob >> 9) & 1) << 5)); }
__device__ __forceinline__ void stage_rc(int b, int& R, int& C) { int st = b >> 10, sb = b & 1023, swz = sb ^ (((sb >> 9) & 1) << 5); R = (st / 2) * 16 + swz / 64; C = (st % 2) * 32 + (swz % 64) / 2; }
#define WAIT_V0() asm volatile("s_waitcnt vmcnt(0)" ::: "memory")
__device__ __forceinline__ void gemm_core(const char* Abase, const unsigned (&Ao)[4], const char* Bbase, const unsigned (&Bo)[4], int nt, f32x4 (&acc)[8][4], int tid_l, bool pre) {
    const int tid = tid_l, wid = tid >> 6, lane = tid & 63, wr = wid >> 2, wc = wid & 3, fr = lane & 15, fq = lane >> 4;
#pragma unroll
    for (int m = 0; m < 8; ++m)
#pragma unroll
        for (int n = 0; n < 4; ++n) acc[m][n] = (f32x4){0.f, 0.f, 0.f, 0.f};
#define G_SA(b) (smem + (b) * 32768)
#define G_SB(b) (smem + 65536 + (b) * 32768)
#define G_STAGE(buf, kt) do { _Pragma("unroll") for (int i = 0; i < 4; ++i) {                                                     \
        __builtin_amdgcn_global_load_lds((const unsigned*)(Abase + (Ao[i] + (unsigned)(kt) * 128u)), (unsigned*)(G_SA(buf) + wid * 1024 + i * 8192), 16, 0, 0); \
        __builtin_amdgcn_global_load_lds((const unsigned*)(Bbase + (Bo[i] + (unsigned)(kt) * 128u)), (unsigned*)(G_SB(buf) + wid * 1024 + i * 8192), 16, 0, 0); } } while (0)
    if (!pre) G_STAGE(0, 0);
    WAIT_V0(); __syncthreads();
#define G_KSTEP(cur, t) do {                                                                                                   \
        if ((t) + 1 < nt) G_STAGE((cur) ^ 1, (t) + 1);                                                                          \
        _Pragma("unroll") for (int ks = 0; ks < 2; ++ks) {                                                                      \
            bf16x8 At[8], Bf[4];                                                                                                \
            _Pragma("unroll") for (int m = 0; m < 8; ++m) At[m] = *(const bf16x8*)(G_SA(cur) + lds_byte(wr * 128 + m * 16 + fr, ks * 32 + fq * 8)); \
            _Pragma("unroll") for (int n = 0; n < 4; ++n) Bf[n] = *(const bf16x8*)(G_SB(cur) + lds_byte(wc * 64 + n * 16 + fr, ks * 32 + fq * 8));  \
            _Pragma("unroll") for (int m = 0; m < 8; ++m) _Pragma("unroll") for (int n = 0; n < 4; ++n)                         \
                acc[m][n] = __builtin_amdgcn_mfma_f32_16x16x32_bf16(Bf[n], At[m], acc[m][n], 0, 0, 0);                          \
            __builtin_amdgcn_sched_barrier(0);                                                                                  \
        }                                                                                                                       \
        WAIT_V0(); __syncthreads(); } while (0)
#pragma unroll 1
    for (int t = 0; t < nt; ++t) { const int cur = t & 1; G_KSTEP(cur, t); }
}
#ifndef XPREFETCH
#define XPREFETCH 0
#endif
__device__ __forceinline__ void gemm_prefetch(const char* Abase, const unsigned (&Ao)[4], const char* Bbase, const unsigned (&Bo)[4], int tid_l) {
    const int wid = tid_l >> 6;
    G_STAGE(0, 0);
}
__device__ __forceinline__ void stage_offs(unsigned ld_bytes, unsigned (&P)[4], int tid_l) {
    const int wid = tid_l >> 6, lane = tid_l & 63;
#pragma unroll
    for (int i = 0; i < 4; ++i) { int R, C; stage_rc(wid * 1024 + i * 8192 + lane * 16, R, C); P[i] = (unsigned)R * ld_bytes + (unsigned)C * 2u; }
}

constexpr int WAREA = 18432;
__device__ __forceinline__ char* wave_area(int wid) { return smem + wid * WAREA; }

constexpr int A_KVBLK = 64;
constexpr float A_SCALE = 0.125f, A_THR = 8.f;
constexpr int A_SHM_V = A_KVBLK * 128 * 2, A_SHM_K = A_KVBLK * 128 * 2;
#define KSWZ(row, colB) ((row) * 256 + ((colB) ^ (((row) & 7) << 4)))
#define SBAR() __builtin_amdgcn_sched_barrier(0)
__device__ __forceinline__ int crow(int r, int hi) { return (r & 3) + 8 * (r >> 2) + 4 * hi; }

constexpr float A_THRL = 11.0f;
template <bool FIRST> __device__ __forceinline__ void partialSM2(f32x16& p0, f32x16& p1, float& mhat, f32x16& negm, float& alpha) {
    float pmax = p0[0];
#pragma unroll
    for (int r = 1; r < 16; ++r) pmax = fmaxf(pmax, p0[r]);
#pragma unroll
    for (int r = 0; r < 16; ++r) pmax = fmaxf(pmax, p1[r]);
    { auto rr = __builtin_amdgcn_permlane32_swap(__float_as_uint(pmax), __float_as_uint(pmax), false, false);
      pmax = fmaxf(__uint_as_float(rr[0]), __uint_as_float(rr[1])); }
    alpha = 1.f;
    if (FIRST || __builtin_expect(__any(pmax > A_THRL), 0)) {
        const float dl = FIRST ? pmax : fmaxf(pmax, 0.f);
        mhat += dl;
#pragma unroll
        for (int r = 0; r < 16; ++r) { p0[r] -= dl; p1[r] -= dl; }
#pragma unroll
        for (int r = 0; r < 16; ++r) negm[r] = -mhat;
        if (!FIRST) alpha = __builtin_amdgcn_exp2f(-dl);
    }
#pragma unroll
    for (int r = 0; r < 16; ++r) p0[r] = __builtin_amdgcn_exp2f(p0[r]);
}
__device__ __forceinline__ void qkt2(f32x16& p0, f32x16& p1, const char* Ks, const bf16x8* qr, const f32x16& negm, int r32, int hi, int mapc) {
#pragma unroll
    for (int d0 = 0; d0 < 4; ++d0) { int cb = (mapc + d0 * 16 + hi * 8) * 2;
        bf16x8 b0 = *reinterpret_cast<const bf16x8*>(Ks + KSWZ(r32, cb));
        bf16x8 b1 = *reinterpret_cast<const bf16x8*>(Ks + KSWZ(32 + r32, cb));
        if (d0 == 0) { p0 = __builtin_amdgcn_mfma_f32_32x32x16_bf16(b0, qr[0], negm, 0, 0, 0); p1 = __builtin_amdgcn_mfma_f32_32x32x16_bf16(b1, qr[0], negm, 0, 0, 0); }
        else { p0 = __builtin_amdgcn_mfma_f32_32x32x16_bf16(b0, qr[d0], p0, 0, 0, 0); p1 = __builtin_amdgcn_mfma_f32_32x32x16_bf16(b1, qr[d0], p1, 0, 0, 0); } }
}
template <int PROBE = 0> __device__ __forceinline__ void partialSM(f32x16& p0, f32x16& p1, float& m_reg, float& mn, float& alpha) {
    constexpr float C = A_SCALE * 1.4426950408889634f;
    float pmax = p0[0];
#pragma unroll
    for (int r = 1; r < 16; ++r) pmax = fmaxf(pmax, p0[r]);
#pragma unroll
    for (int r = 0; r < 16; ++r) pmax = fmaxf(pmax, p1[r]);
    { auto rr = __builtin_amdgcn_permlane32_swap(__float_as_uint(pmax), __float_as_uint(pmax), false, false);
      pmax = fmaxf(__uint_as_float(rr[0]), __uint_as_float(rr[1])); }
    if (__builtin_expect(__all(pmax - m_reg <= A_THR / A_SCALE), 1)) { mn = m_reg; alpha = 1.f; }
    else { mn = fmaxf(m_reg, pmax); alpha = __builtin_amdgcn_exp2f((m_reg - mn) * C); m_reg = mn; }
    float mnC = -mn * C;
#pragma unroll
    for (int r = 0; r < 16; ++r) p0[r] = fmaf(p0[r], C, mnC);
#pragma unroll
    for (int r = 0; r < 16; ++r) p1[r] = fmaf(p1[r], C, mnC);
#pragma unroll
    for (int r = 0; r < 16; ++r) p0[r] = PROBE == 3 ? p0[r] * 1e-3f : __builtin_amdgcn_exp2f(p0[r]);
}
#define PK4(P, BASE, OUT) do { unsigned a0 = cvtpk(P[BASE + 0], P[BASE + 1]), a1 = cvtpk(P[BASE + 2], P[BASE + 3]);   \
    unsigned b0 = cvtpk(P[BASE + 4], P[BASE + 5]), b1 = cvtpk(P[BASE + 6], P[BASE + 7]);                              \
    auto r0 = __builtin_amdgcn_permlane32_swap(a0, b0, false, false); auto r1 = __builtin_amdgcn_permlane32_swap(a1, b1, false, false); \
    u32x4 w = {r0[0], r1[0], r0[1], r1[1]}; OUT = *reinterpret_cast<bf16x8*>(&w); } while (0)
template <int PROBE = 0, bool DIRECT = false> __device__ __forceinline__ void finishSM(f32x16& p0, f32x16& p1, float alpha, float& l_reg, bf16x8& pa0, bf16x8& pa1, bf16x8& pa2, bf16x8& pa3) {
#pragma unroll
    for (int r = 0; r < 16; ++r) p1[r] = PROBE == 3 ? p1[r] * 1e-3f : __builtin_amdgcn_exp2f(p1[r]);
    float ps = 0;
#pragma unroll
    for (int r = 0; r < 16; ++r) ps += p0[r];
#pragma unroll
    for (int r = 0; r < 16; ++r) ps += p1[r];
    { auto rr = __builtin_amdgcn_permlane32_swap(__float_as_uint(ps), __float_as_uint(ps), false, false);
      ps = __uint_as_float(rr[0]) + __uint_as_float(rr[1]); }
    l_reg = l_reg * alpha + ps;
    if (DIRECT) {
#define PKD(P, B, OUT) do { u32x4 w = {cvtpk(P[B], P[B + 1]), cvtpk(P[B + 2], P[B + 3]), cvtpk(P[B + 4], P[B + 5]), cvtpk(P[B + 6], P[B + 7])}; OUT = *reinterpret_cast<bf16x8*>(&w); } while (0)
        PKD(p0, 0, pa0); PKD(p0, 8, pa1); PKD(p1, 0, pa2); PKD(p1, 8, pa3);
#undef PKD
    } else { PK4(p0, 0, pa0); PK4(p0, 8, pa1); PK4(p1, 0, pa2); PK4(p1, 8, pa3); }
}
__device__ __forceinline__ void qkt(f32x16& p0, f32x16& p1, const char* Ks, const bf16x8* qr, int r32, int hi, int mapc) {
    p0 = f32x16{}; p1 = f32x16{};
#pragma unroll
    for (int d0 = 0; d0 < 4; ++d0) { int cb = (mapc + d0 * 16 + hi * 8) * 2;
        bf16x8 b0 = *reinterpret_cast<const bf16x8*>(Ks + KSWZ(r32, cb));
        bf16x8 b1 = *reinterpret_cast<const bf16x8*>(Ks + KSWZ(32 + r32, cb));
        p0 = __builtin_amdgcn_mfma_f32_32x32x16_bf16(b0, qr[d0], p0, 0, 0, 0);
        p1 = __builtin_amdgcn_mfma_f32_32x32x16_bf16(b1, qr[d0], p1, 0, 0, 0); }
}
__device__ __forceinline__ int v_st(int k, int c) { const int kk = (k & ~0xC) | ((k & 4) << 1) | ((k & 8) >> 1); return ((kk >> 3) * 4 + (c >> 5)) * 512 + ((kk & 7) * 32 + (c & 31)) * 2; }
__device__ __forceinline__ int v_rd_base(int lane) { return ((lane & 3) << 3) | (((lane >> 2) & 3) << 6) | (((lane >> 4) & 1) << 5) | (((lane >> 5) & 1) << 8); }
constexpr int v_rd_off(int d0, int ks, int half) { return d0 * 512 + ks * 4096 + half * 2048; }
template <int OFF> __device__ __forceinline__ s16x4 tr_read(int vb) {
    s16x4 r; asm volatile("ds_read_b64_tr_b16 %0, %1 offset:%2" : "=&v"(r) : "v"(vb), "i"(OFF) : "memory"); return r;
}
template <int D0> __device__ __forceinline__ void pv_one(f32x16& od, int vb, bf16x8 pa0, bf16x8 pa1, bf16x8 pa2, bf16x8 pa3) {
    const s16x4 l0 = tr_read<v_rd_off(D0, 0, 0)>(vb), h0 = tr_read<v_rd_off(D0, 0, 1)>(vb), l1 = tr_read<v_rd_off(D0, 1, 0)>(vb), h1 = tr_read<v_rd_off(D0, 1, 1)>(vb);
    const s16x4 l2 = tr_read<v_rd_off(D0, 2, 0)>(vb), h2 = tr_read<v_rd_off(D0, 2, 1)>(vb), l3 = tr_read<v_rd_off(D0, 3, 0)>(vb), h3 = tr_read<v_rd_off(D0, 3, 1)>(vb);
    asm volatile("s_waitcnt lgkmcnt(0)" ::: "memory"); SBAR();
#define PKV(L, H) (bf16x8){L[0], L[1], L[2], L[3], H[0], H[1], H[2], H[3]}
    od = __builtin_amdgcn_mfma_f32_32x32x16_bf16(pa0, PKV(l0, h0), od, 0, 0, 0);
    od = __builtin_amdgcn_mfma_f32_32x32x16_bf16(pa1, PKV(l1, h1), od, 0, 0, 0);
    od = __builtin_amdgcn_mfma_f32_32x32x16_bf16(pa2, PKV(l2, h2), od, 0, 0, 0);
    od = __builtin_amdgcn_mfma_f32_32x32x16_bf16(pa3, PKV(l3, h3), od, 0, 0, 0);
}
template <int D0> __device__ __forceinline__ void pv_two(f32x16& oa, f32x16& ob, int vb, bf16x8 pa0, bf16x8 pa1, bf16x8 pa2, bf16x8 pa3) {
    const s16x4 l0 = tr_read<v_rd_off(D0, 0, 0)>(vb), h0 = tr_read<v_rd_off(D0, 0, 1)>(vb), l1 = tr_read<v_rd_off(D0, 1, 0)>(vb), h1 = tr_read<v_rd_off(D0, 1, 1)>(vb);
    const s16x4 l2 = tr_read<v_rd_off(D0, 2, 0)>(vb), h2 = tr_read<v_rd_off(D0, 2, 1)>(vb), l3 = tr_read<v_rd_off(D0, 3, 0)>(vb), h3 = tr_read<v_rd_off(D0, 3, 1)>(vb);
    const s16x4 m0 = tr_read<v_rd_off(D0 + 1, 0, 0)>(vb), g0 = tr_read<v_rd_off(D0 + 1, 0, 1)>(vb), m1 = tr_read<v_rd_off(D0 + 1, 1, 0)>(vb), g1 = tr_read<v_rd_off(D0 + 1, 1, 1)>(vb);
    const s16x4 m2 = tr_read<v_rd_off(D0 + 1, 2, 0)>(vb), g2 = tr_read<v_rd_off(D0 + 1, 2, 1)>(vb), m3 = tr_read<v_rd_off(D0 + 1, 3, 0)>(vb), g3 = tr_read<v_rd_off(D0 + 1, 3, 1)>(vb);
    asm volatile("s_waitcnt lgkmcnt(0)" ::: "memory"); SBAR();
    oa = __builtin_amdgcn_mfma_f32_32x32x16_bf16(pa0, PKV(l0, h0), oa, 0, 0, 0);
    ob = __builtin_amdgcn_mfma_f32_32x32x16_bf16(pa0, PKV(m0, g0), ob, 0, 0, 0);
    oa = __builtin_amdgcn_mfma_f32_32x32x16_bf16(pa1, PKV(l1, h1), oa, 0, 0, 0);
    ob = __builtin_amdgcn_mfma_f32_32x32x16_bf16(pa1, PKV(m1, g1), ob, 0, 0, 0);
    oa = __builtin_amdgcn_mfma_f32_32x32x16_bf16(pa2, PKV(l2, h2), oa, 0, 0, 0);
    ob = __builtin_amdgcn_mfma_f32_32x32x16_bf16(pa2, PKV(m2, g2), ob, 0, 0, 0);
    oa = __builtin_amdgcn_mfma_f32_32x32x16_bf16(pa3, PKV(l3, h3), oa, 0, 0, 0);
    ob = __builtin_amdgcn_mfma_f32_32x32x16_bf16(pa3, PKV(m3, g3), ob, 0, 0, 0);
}
__device__ __forceinline__ void pv_d0(f32x16* o, int vb, bf16x8 pa0, bf16x8 pa1, bf16x8 pa2, bf16x8 pa3) {
    pv_one<0>(o[0], vb, pa0, pa1, pa2, pa3); pv_one<1>(o[1], vb, pa0, pa1, pa2, pa3); pv_one<2>(o[2], vb, pa0, pa1, pa2, pa3); pv_one<3>(o[3], vb, pa0, pa1, pa2, pa3);
}

template <int PROBE> __device__ __forceinline__ void attn_item(const bf16_t* __restrict__ Qb, const bf16_t* __restrict__ Kh, const bf16_t* __restrict__ Vh, bf16_t* __restrict__ mixrow,
                                          const float* __restrict__ gd, float lam, int tid_l) {
    char* lds = smem;
    const int tid = tid_l, wid = tid >> 6, lane = tid & 63, r32 = lane & 31, hi = lane >> 5;
    const int map = wid >> 2, wq = wid & 3, mapc = map * 64;
    char* K_lds = lds; char* V_lds = lds + 4 * A_SHM_K;
    float* wsw = (float*)(lds + 4 * A_SHM_V + 4 * A_SHM_K) + wid * 64; float* li_l = wsw; float* al_l = wsw + 32;
    float m_reg = 0.f, l_reg = 0; f32x16 o[4] = {}; bf16x8 qr[4]; f32x16 negm = f32x16{};
    const bf16_t* Qw = Qb + (long)(wq * 32 + r32) * 128 + mapc + hi * 8;
#pragma unroll
    for (int d0 = 0; d0 < 4; ++d0) qr[d0] = *reinterpret_cast<const bf16x8*>(Qw + d0 * 16);
    const int vb0 = (int)(uintptr_t)V_lds + v_rd_base(lane);
    unsigned kofs[2], vofs[2];
    const int widu = __builtin_amdgcn_readfirstlane(wid);
#pragma unroll
    for (int i = 0; i < 2; ++i) {
        const int x = wid * 1024 + i * 8192 + lane * 16;
        { const int row = x >> 8, cs = x & 255, colB = cs ^ ((row & 7) << 4); kofs[i] = (unsigned)(row * 256 + colB); }
        { const int sub = x >> 9, wn = x & 511, k = (sub >> 2) * 8 + (wn >> 6), c = (sub & 3) * 32 + ((wn & 63) >> 1); vofs[i] = (unsigned)(k * 256 + c * 2); }
    }
#define DMA_TILE(slot, k0) do { const char* kt_ = (const char*)Kh + (size_t)(k0) * 256; const char* vt_ = (const char*)Vh + (size_t)(k0) * 256;                  \
      _Pragma("unroll") for (int i = 0; i < 2; ++i) {                                                                   \
        __builtin_amdgcn_global_load_lds((const unsigned*)(kt_ + kofs[i]), (unsigned*)(K_lds + (slot) * A_SHM_K + widu * 1024 + i * 8192), 16, 0, 0); \
        __builtin_amdgcn_global_load_lds((const unsigned*)(vt_ + vofs[i]), (unsigned*)(V_lds + (slot) * A_SHM_V + widu * 1024 + i * 8192), 16, 0, 0); } } while (0)
#define RESC(a) do { if (__any((a) < 1.f)) { if (hi == 0) al_l[r32] = (a); asm volatile("s_waitcnt lgkmcnt(0)" ::: "memory"); \
    _Pragma("unroll") for (int d = 0; d < 4; ++d) _Pragma("unroll") for (int r = 0; r < 16; ++r) o[d][r] *= al_l[crow(r, hi)]; } } while (0)
    f32x16 pA0, pA1, pB0, pB1; float mnA, mnB, alA, alB; bf16x8 pa0, pa1, pa2, pa3; const int NT = RB / A_KVBLK;
    DMA_TILE(0, 0); DMA_TILE(1, A_KVBLK);
    asm volatile("s_waitcnt vmcnt(0)" ::: "memory"); __syncthreads();
    qkt2(pA0, pA1, K_lds, qr, negm, r32, hi, mapc); partialSM2<true>(pA0, pA1, m_reg, negm, alA);
#define ATILE(X0, X1, ALX, Y0, Y1, ALY, CS, PS, NS, T_, DODMA) do {                                                                  \
        asm volatile("s_waitcnt vmcnt(0)" ::: "memory"); __syncthreads();                                                            \
        if (DODMA && PROBE != 1) DMA_TILE(NS, ((T_) + 1) * A_KVBLK);                                                                 \
        SBAR(); qkt2(X0, X1, K_lds + (CS) * A_SHM_K, qr, negm, r32, hi, mapc);                                                       \
        finishSM<PROBE, true>(Y0, Y1, ALY, l_reg, pa0, pa1, pa2, pa3); SBAR();                                                       \
        pv_d0(o, vb0 + (PS) * A_SHM_V, pa0, pa1, pa2, pa3); partialSM2<false>(X0, X1, m_reg, negm, ALX);                             \
        RESC(ALX); } while (0)
#pragma unroll 1
    for (int j = 1; j + 3 < NT; j += 4) {
        ATILE(pB0, pB1, alB, pA0, pA1, alA, 1, 0, 2, j, true);
        ATILE(pA0, pA1, alA, pB0, pB1, alB, 2, 1, 3, j + 1, true);
        ATILE(pB0, pB1, alB, pA0, pA1, alA, 3, 2, 0, j + 2, true);
        ATILE(pA0, pA1, alA, pB0, pB1, alB, 0, 3, 1, j + 3, true);
    }
    ATILE(pB0, pB1, alB, pA0, pA1, alA, 1, 0, 2, NT - 3, true);
    ATILE(pA0, pA1, alA, pB0, pB1, alB, 2, 1, 3, NT - 2, true);
    ATILE(pB0, pB1, alB, pA0, pA1, alA, 3, 2, 0, NT - 1, false);
    finishSM<PROBE, true>(pB0, pB1, alB, l_reg, pa0, pa1, pa2, pa3); SBAR();
    pv_d0(o, vb0 + 3 * A_SHM_V, pa0, pa1, pa2, pa3);
#undef ATILE
#undef DMA_TILE
    if (hi == 0) li_l[r32] = l_reg;
    asm volatile("s_waitcnt lgkmcnt(0)" ::: "memory");
    float rl[16];
#pragma unroll
    for (int r = 0; r < 16; ++r) rl[r] = __builtin_amdgcn_rcpf(li_l[crow(r, hi)]);
    __syncthreads();
    {
        float* xo = (float*)lds + map * 16384 + (wq * 32) * 128 + r32;
#pragma unroll
        for (int r = 0; r < 16; ++r)
#pragma unroll
            for (int d0 = 0; d0 < 4; ++d0) xo[crow(r, hi) * 128 + d0 * 32] = o[d0][r] * rl[r];
    }
    __syncthreads();
    {
        int l2 = lane; asm volatile("" : "+v"(l2));
        const float g0 = gd[l2 * 2], g1 = gd[l2 * 2 + 1];
#pragma unroll 4
        for (int rr = 0; rr < 16; ++rr) {
            const int row = wid * 16 + rr;
            const float2 a0 = *(const float2*)((const float*)lds + row * 128 + l2 * 2), a1 = *(const float2*)((const float*)lds + 16384 + row * 128 + l2 * 2);
            const float xv = a0.x - lam * a1.x, yv = a0.y - lam * a1.y;
            const float ss = wave_sum(xv * xv + yv * yv);
            const float rs = rsqrtf(ss * (1.0f / 128) + EPS) * 0.8f;
            *(unsigned*)(mixrow + (long)row * 1024 + l2 * 2) = cvtpk(xv * rs * g0, yv * rs * g1);
        }
    }
    __syncthreads();
#undef RESC
}


template <int PROBE> __device__ __forceinline__ void ph_attn(const MK& p, int bid, int nb, int tid_l) {
    const int lane = tid_l & 63;
    float s1 = wave_sum(p.lq1[lane] * p.lk1[lane]), s2 = wave_sum(p.lq2[lane] * p.lk2[lane]);
    const float lam = expf(s1) - expf(s2) + 0.2f;
    const int nrounds = (1024 + nb - 1) / nb;
    for (int rr = 0; rr < nrounds; ++rr) {
        int item;
        if (nb == 256) { int x = bid & 7, j = bid >> 3, hh = rr * 8 + x; item = (hh >> 1) * 64 + (hh & 1) * 32 + j; }
        else { item = rr * nb + bid; if (item >= 1024) break; }
        const int bh = item >> 6, qb = item & 63, b = bh >> 2, h = bh & 3;
        attn_item<PROBE>(p.Q() + ((size_t)bh * SEQ + qb * 128) * 128, p.K() + (size_t)bh * RB * 128, p.V() + (size_t)bh * RB * 128,
                  PROBE ? (bf16_t*)(p.ws + 492 * MiB) + h * 128 : p.MIX() + ((size_t)(b * SEQ + qb * 128)) * 1024 + h * 128, p.dattn_g, lam, tid_l);
    }
}


__device__ __forceinline__ bf16x8 ldfrag(const bf16_t* p) { return *reinterpret_cast<const bf16x8*>(p); }

__device__ __forceinline__ void ph_kv(const MK& p, int bid, int nb, int tid_l) {
    const int wid = tid_l >> 6, lane = tid_l & 63, r32 = lane & 31, hi = lane >> 5;
    const int nitems = 16 * 2 * 66;
    for (int it = bid * 8 + wid; it < nitems; it += nb * 8) {
        const int c = it % 66, chain = it / 66, dir = chain & 1, bh = chain >> 1;
        const bf16_t* vt = p.VT() + (size_t)bh * 128 * RB + c * 128 + hi * 8;
        const bf16_t* kt = (dir ? p.KTb() : p.KTf()) + (size_t)bh * 64 * RB + c * 128 + hi * 8;
        f32x16 acc[4][2];
#pragma unroll
        for (int mt = 0; mt < 4; ++mt) { acc[mt][0] = f32x16{}; acc[mt][1] = f32x16{}; }
#pragma unroll 2
        for (int ks = 0; ks < 8; ++ks) {
            bf16x8 a[4], b[2];
#pragma unroll
            for (int mt = 0; mt < 4; ++mt) a[mt] = ldfrag(vt + (size_t)(mt * 32 + r32) * RB + ks * 16);
#pragma unroll
            for (int nt = 0; nt < 2; ++nt) b[nt] = ldfrag(kt + (size_t)(nt * 32 + r32) * RB + ks * 16);
#pragma unroll
            for (int mt = 0; mt < 4; ++mt)
#pragma unroll
                for (int nt = 0; nt < 2; ++nt) acc[mt][nt] = __builtin_amdgcn_mfma_f32_32x32x16_bf16(a[mt], b[nt], acc[mt][nt], 0, 0, 0);
        }
        bf16_t* dst = p.KV() + (size_t)it * 8192;
#pragma unroll
        for (int mt = 0; mt < 4; ++mt)
#pragma unroll
            for (int nt = 0; nt < 2; ++nt)
#pragma unroll
                for (int r = 0; r < 16; ++r) dst[(mt * 32 + crow(r, hi)) * 64 + nt * 32 + r32] = f2bf(acc[mt][nt][r]);
    }
}

__device__ __forceinline__ void ph_scan(const MK& p, int bid, int nb, int tid_l) {
    for (int e = bid * NTHR + tid_l; e < 32 * 8192; e += nb * NTHR) {
        const int chain = e >> 13, el = e & 8191, dir = chain & 1, bh = chain >> 1, h = bh & 3;
        const float d = dir ? p.dec_b[h] : p.dec_f[h];
        const float g128 = exp2f(128.0f * log2f(1.0f / (1.0f + expf(-d))));
        const bf16_t* kv = p.KV() + (size_t)chain * 66 * 8192 + el;
        bf16_t* st = p.ST() + (size_t)chain * 66 * 8192 + el;
        float S = 0.f;
        for (int n = 0; n < 66; ++n) {
            const int c = dir == 0 ? n : (n == 0 ? 1 : (n == 1 ? 0 : 67 - n));
            st[(size_t)c * 8192] = f2bf(S);
            S = fmaf(g128, S, bf2f(kv[(size_t)c * 8192]));
        }
    }
}

__device__ __forceinline__ void ph_ret(const MK& p, int bid, int nb, int tid_l) {
    const int tid = tid_l, wid = tid >> 6, lane = tid & 63, r32 = lane & 31, hi = lane >> 5, wq = wid & 3, half = wid >> 2;
    float* img = (float*)smem;
    for (int it = bid; it < 4 * 64 * 2; it += nb) {
        const int hp = it & 1, lc = (it >> 1) & 63, b = it >> 7, h = hp * 2 + half, bh = b * 4 + h;
        const int ib = CTX + lc * 128, c = 2 + lc;
        const float lf = log2f(1.0f / (1.0f + expf(-p.dec_f[h]))), lb = log2f(1.0f / (1.0f + expf(-p.dec_b[h])));
        const bf16_t* rq = p.RQ() + ((size_t)bh * RB + ib + wq * 32 + r32) * 64 + hi * 8;
        bf16x8 q[4];
#pragma unroll
        for (int ks = 0; ks < 4; ++ks) q[ks] = ldfrag(rq + ks * 16);
        f32x16 o[4];
        {
            const bf16_t* stf = p.ST() + ((size_t)(bh * 2 + 0) * 66 + c) * 8192 + hi * 8;
            const bf16_t* stb = p.ST() + ((size_t)(bh * 2 + 1) * 66 + c) * 8192 + hi * 8;
            {
                float rf[16];
#pragma unroll
                for (int r = 0; r < 16; ++r) rf[r] = __builtin_amdgcn_exp2f((float)(wq * 32 + crow(r, hi) + 1) * lf);
#pragma unroll
                for (int d0 = 0; d0 < 4; ++d0) {
                    f32x16 tf = f32x16{};
#pragma unroll
                    for (int ks = 0; ks < 4; ++ks) tf = __builtin_amdgcn_mfma_f32_32x32x16_bf16(q[ks], ldfrag(stf + (size_t)(d0 * 32 + r32) * 64 + ks * 16), tf, 0, 0, 0);
#pragma unroll
                    for (int r = 0; r < 16; ++r) o[d0][r] = tf[r] * rf[r];
                    asm volatile("" ::: "memory");
                }
            }
            {
                float rf[16];
#pragma unroll
                for (int r = 0; r < 16; ++r) rf[r] = __builtin_amdgcn_exp2f((float)(128 - (wq * 32 + crow(r, hi))) * lb);
#pragma unroll
                for (int d0 = 0; d0 < 4; ++d0) {
                    f32x16 tb = f32x16{};
#pragma unroll
                    for (int ks = 0; ks < 4; ++ks) tb = __builtin_amdgcn_mfma_f32_32x32x16_bf16(q[ks], ldfrag(stb + (size_t)(d0 * 32 + r32) * 64 + ks * 16), tb, 0, 0, 0);
#pragma unroll
                    for (int r = 0; r < 16; ++r) o[d0][r] += tb[r] * rf[r];
                    asm volatile("" ::: "memory");
                }
            }
        }
        {
            const int qi = wq * 32 + r32;
            const bf16_t* vt = p.VT() + (size_t)bh * 128 * RB + ib + hi * 8;
#pragma unroll 1
            for (int jb = 0; jb < 4; ++jb) {
                asm volatile("" ::: "memory");
                const bf16_t* rk = p.RK() + ((size_t)bh * RB + ib + jb * 32 + r32) * 64 + hi * 8;
                f32x16 pp = f32x16{};
#pragma unroll
                for (int ks = 0; ks < 4; ++ks) pp = __builtin_amdgcn_mfma_f32_32x32x16_bf16(ldfrag(rk + ks * 16), q[ks], pp, 0, 0, 0);
#pragma unroll
                for (int r = 0; r < 16; ++r) {
                    const int dd = qi - (jb * 32 + crow(r, hi));
                    const float ex = __builtin_amdgcn_exp2f(dd > 0 ? (float)dd * lf : (float)(-dd) * lb); const float w = dd == 0 ? 2.0f : ex;
                    pp[r] *= w;
                }
                bf16x8 pa0, pa1;
                PK4(pp, 0, pa0); PK4(pp, 8, pa1);
#pragma unroll
                for (int d0 = 0; d0 < 4; ++d0) {
                    o[d0] = __builtin_amdgcn_mfma_f32_32x32x16_bf16(pa0, ldfrag(vt + (size_t)(d0 * 32 + r32) * RB + jb * 32), o[d0], 0, 0, 0);
                    o[d0] = __builtin_amdgcn_mfma_f32_32x32x16_bf16(pa1, ldfrag(vt + (size_t)(d0 * 32 + r32) * RB + jb * 32 + 16), o[d0], 0, 0, 0);
                }
            }
        }
        __syncthreads();
        {
            float* xo = img + half * 16384 + (wq * 32) * 128 + r32;
#pragma unroll
            for (int r = 0; r < 16; ++r)
#pragma unroll
                for (int d0 = 0; d0 < 4; ++d0) xo[crow(r, hi) * 128 + d0 * 32] = o[d0][r];
        }
        __syncthreads();
        {
            const float g0 = p.ret_g[lane * 2], g1 = p.ret_g[lane * 2 + 1];
#pragma unroll 4
            for (int rr = 0; rr < 32; ++rr) {
                const int row = wid * 32 + rr, itl = row >> 7, rw = row & 127, hh = hp * 2 + itl;
                const float2 a = *(const float2*)(img + row * 128 + lane * 2);
                const float ss = wave_sum(a.x * a.x + a.y * a.y);
                const float rs = rsqrtf(ss * (1.0f / 128) + EPS);
                const size_t tt = (size_t)b * SEQ + lc * 128 + rw;
                const unsigned gg = *(const unsigned*)(p.RG() + tt * 512 + hh * 128 + lane * 2);
                const float ga = bf2f((bf16_t)(gg & 0xffff)), gb = bf2f((bf16_t)(gg >> 16));
                *(unsigned*)(p.MIX() + tt * 1024 + 512 + hh * 128 + lane * 2) = cvtpk(silu_fast(ga) * a.x * rs * g0, silu_fast(gb) * a.y * rs * g1);
            }
        }
    }
}


namespace pg8 {
constexpr int BM = 256, BK = 64, HALF = 128, HTB = HALF * BK * 2;
__device__ __forceinline__ int perm32(int rho) { const int n = rho >> 4, i = rho & 15; return 8 * (i >> 2) + 4 * n + (i & 3); }
struct GUnit { const char* A; const char* B; int i0, i1, i2, i3; };
template <class Epi, class Sched, bool GATHER, bool ALIGN_EPI>
__device__ __forceinline__ void gemm(int K, const Sched& S, const Epi& E, int tid_l) {
    const int tid = tid_l, wid = __builtin_amdgcn_readfirstlane(tid >> 6), lane = tid & 63, wr = wid >> 2, wc = wid & 3, fr = lane & 15, fq = lane >> 4;
    const int nt = K / BK;
    unsigned voffB[2], vAc[2][2], vAn[2][2];
    const size_t kstep = (size_t)(BK * 2);
    const size_t hstepB = (size_t)HALF * K * 2;
#pragma unroll
    for (int i = 0; i < 2; ++i) { int R, C; stage_rc(tid * 16 + i * 8192, R, C); const int Rb = Epi::PERM ? ((R & ~31) + perm32(R & 31)) : R;
        voffB[i] = (unsigned)(Rb * K + C) * 2u; }
    const unsigned ldsw = (unsigned)wid * 1024u;
    const int aoff = lds_byte(wr * 64 + fr, fq * 8), boff = lds_byte(wc * 32 + fr, fq * 8);
#define PG8_SA(b, h) (((b) * 2 + (h)) * HTB)
#define PG8_SB(b, h) ((4 + (b) * 2 + (h)) * HTB)
#define PG8_STAGE(bufoff, gbase, voff) do { _Pragma("unroll") for (int _i = 0; _i < 2; ++_i) \
        __builtin_amdgcn_global_load_lds((const unsigned*)((const char*)(gbase) + (voff)[_i]), (unsigned*)(smem + (bufoff) + ldsw + _i * 8192), 16, 0, 0); } while (0)
#define PG8_LDA(dst, b, h) do { _Pragma("unroll") for (int m = 0; m < 4; ++m) _Pragma("unroll") for (int k = 0; k < 2; ++k) dst[m][k] = *(const bf16x8*)(smem + PG8_SA(b, h) + aoff + m * 2048 + k * 1024); } while (0)
#define PG8_LDB(dst, b, h) do { _Pragma("unroll") for (int n = 0; n < 2; ++n) _Pragma("unroll") for (int k = 0; k < 2; ++k) dst[n][k] = *(const bf16x8*)(smem + PG8_SB(b, h) + boff + n * 2048 + k * 1024); } while (0)
#define PG8_MMA(ai, bj, At, Bt) do { __builtin_amdgcn_s_setprio(1); _Pragma("unroll") for (int m = 0; m < 4; ++m) _Pragma("unroll") for (int n = 0; n < 2; ++n) _Pragma("unroll") for (int k = 0; k < 2; ++k) \
        acc[ai][bj][m][n] = __builtin_amdgcn_mfma_f32_16x16x32_bf16(Bt[n][k], At[m][k], acc[ai][bj][m][n], 0, 0, 0); __builtin_amdgcn_s_setprio(0); } while (0)
#define PG8_WAIT_V(n) asm volatile("s_waitcnt vmcnt(" #n ")" ::: "memory")
#define PG8_WAIT_L(n) asm volatile("s_waitcnt lgkmcnt(" #n ")" ::: "memory")
#define PG8_BAR __builtin_amdgcn_s_barrier()
#define PG8_SCHED __builtin_amdgcn_sched_barrier(0)
    GUnit cur, nxt; int ui = 0;
    if (!S.next(0, cur, vAc)) return;
    f32x4 acc[2][2][4][2];
#pragma unroll
    for (int a = 0; a < 2; ++a)
#pragma unroll
        for (int b = 0; b < 2; ++b)
#pragma unroll
            for (int m = 0; m < 4; ++m)
#pragma unroll
                for (int n = 0; n < 2; ++n) acc[a][b][m][n] = (f32x4){0.f, 0.f, 0.f, 0.f};
    bf16x8 At[4][2], B0[2][2], B1[2][2];
    const char* cA = cur.A; const char* cB = cur.B;
    PG8_STAGE(PG8_SB(0, 0), cB, voffB); PG8_STAGE(PG8_SB(0, 1), cB + hstepB, voffB); PG8_STAGE(PG8_SA(0, 0), cA, vAc[0]); PG8_STAGE(PG8_SA(0, 1), cA, vAc[1]);
    if (wr == 1) PG8_BAR;
    PG8_WAIT_V(2); PG8_BAR;
    PG8_STAGE(PG8_SB(1, 0), cB + kstep, voffB); PG8_STAGE(PG8_SA(1, 0), cA + kstep, vAc[0]); PG8_STAGE(PG8_SB(1, 1), cB + hstepB + kstep, voffB);
    PG8_WAIT_V(6); PG8_BAR;
    for (;;) {
        const bool has_next = S.next(ui + 1, nxt, vAn);
        if (!GATHER || !has_next) {
#pragma unroll
            for (int h = 0; h < 2; ++h)
#pragma unroll
                for (int i = 0; i < 2; ++i) vAn[h][i] = vAc[h][i];
        }
        const char* nA = has_next ? nxt.A : cA; const char* nB = has_next ? nxt.B : cB;
#pragma unroll 1
        for (int t = 0; t < nt; t += 2) {
            const bool last = (t == nt - 2);
            const char* a1 = cA + (size_t)(t + 1) * kstep;
            const char* a2 = last ? nA : cA + (size_t)(t + 2) * kstep; const char* b2 = last ? nB : cB + (size_t)(t + 2) * kstep;
            const char* a3 = a2 + kstep; const char* b3 = b2 + kstep;
            unsigned va2[2][2];
#pragma unroll
            for (int h = 0; h < 2; ++h)
#pragma unroll
                for (int i = 0; i < 2; ++i) va2[h][i] = (GATHER && last) ? vAn[h][i] : vAc[h][i];
            PG8_LDB(B0, 0, 0); PG8_LDB(B1, 0, 1); PG8_SCHED; PG8_LDA(At, 0, 0); PG8_STAGE(PG8_SA(1, 1), a1, vAc[1]);
            PG8_WAIT_V(8); PG8_WAIT_L(0); PG8_BAR; PG8_MMA(0, 0, At, B0); PG8_MMA(0, 1, At, B1); PG8_BAR; PG8_SCHED;
            PG8_LDA(At, 0, 1); PG8_STAGE(PG8_SB(0, 0), b2, voffB); PG8_STAGE(PG8_SB(0, 1), b2 + hstepB, voffB); PG8_STAGE(PG8_SA(0, 0), a2, va2[0]);
            PG8_WAIT_V(8); PG8_WAIT_L(0); PG8_BAR; PG8_MMA(1, 0, At, B0); PG8_MMA(1, 1, At, B1); PG8_BAR; PG8_SCHED;
            PG8_LDB(B0, 1, 0); PG8_LDB(B1, 1, 1); PG8_SCHED; PG8_LDA(At, 1, 0); PG8_STAGE(PG8_SA(0, 1), a2, va2[1]);
            PG8_WAIT_V(8); PG8_WAIT_L(0); PG8_BAR; PG8_MMA(0, 0, At, B0); PG8_MMA(0, 1, At, B1); PG8_BAR; PG8_SCHED;
            PG8_LDA(At, 1, 1); PG8_STAGE(PG8_SB(1, 0), b3, voffB); PG8_STAGE(PG8_SB(1, 1), b3 + hstepB, voffB); PG8_STAGE(PG8_SA(1, 0), a3, va2[0]);
            PG8_WAIT_V(8); PG8_WAIT_L(0); PG8_BAR; PG8_MMA(1, 0, At, B0); PG8_MMA(1, 1, At, B1); PG8_BAR; PG8_SCHED;
        }
        if (ALIGN_EPI) { if (wr == 0) PG8_BAR; }
        E(acc, cur, wr, wc, fr, fq);
        if (!has_next) break;
#pragma unroll
        for (int a = 0; a < 2; ++a)
#pragma unroll
            for (int b = 0; b < 2; ++b)
#pragma unroll
                for (int m = 0; m < 4; ++m)
#pragma unroll
                    for (int n = 0; n < 2; ++n) acc[a][b][m][n] = (f32x4){0.f, 0.f, 0.f, 0.f};
        cur = nxt; cA = nA; cB = nB; ++ui;
#pragma unroll
        for (int h = 0; h < 2; ++h)
#pragma unroll
            for (int i = 0; i < 2; ++i) vAc[h][i] = vAn[h][i];
        if (ALIGN_EPI) { if (wr == 1) PG8_BAR; }
    }
    PG8_WAIT_V(0);
    if (!ALIGN_EPI) { if (wr == 0) PG8_BAR; }
    PG8_BAR;
#undef PG8_SA
#undef PG8_SB
#undef PG8_STAGE
#undef PG8_LDA
#undef PG8_LDB
#undef PG8_MMA
#undef PG8_WAIT_V
#undef PG8_WAIT_L
#undef PG8_BAR
#undef PG8_SCHED
}
__device__ __forceinline__ void plain_voffA(int K, unsigned (&vA)[2][2], int tid_l) {
#pragma unroll
    for (int i = 0; i < 2; ++i) { int R, C; stage_rc(tid_l * 16 + i * 8192, R, C); vA[0][i] = (unsigned)(R * K + C) * 2u; vA[1][i] = (unsigned)((R + HALF) * K + C) * 2u; }
}
}


__device__ __forceinline__ int xcd_vbid(int bid, int nb) { return (nb & 7) ? bid : (bid & 7) * (nb >> 3) + (bid >> 3); }
struct SchedIn { const MK* p; int bid, nb, tid_l;
    __device__ __forceinline__ bool next(int i, pg8::GUnit& u, unsigned (&vA)[2][2]) const {
        const int tile = xcd_vbid(bid, nb) + i * nb; if (tile >= (NR / 256) * 12) return false;
        const int pm = tile / 12, pn = tile % 12;
        u.A = (const char*)(p->H() + (size_t)(pm * 256) * D); u.B = (const char*)(p->w_inT() + (size_t)(pn * 256) * D); u.i0 = pm; u.i1 = pn; u.i2 = 0; u.i3 = 0;
        pg8::plain_voffA(D, vA, tid_l); return true; } };
struct EpiIn { static constexpr bool PERM = false; const MK* p;
    __device__ __forceinline__ void operator()(f32x4 (&acc)[2][2][4][2], const pg8::GUnit& u, int wr, int wc, int fr_in, int fq_in) const {
        int fr = fr_in, fq = fq_in; asm volatile("" : "+v"(fr), "+v"(fq));
        const int pm = u.i0, seg = u.i1, brow = pm * 256;
        const int b = brow / RB, i0 = brow % RB;
        const bool lat = i0 >= CTX;
        const int wid = wr * 4 + wc, lane = fq * 16 + fr;
        if (lat && (seg <= 3 || seg == 6 || seg == 7)) {
#pragma unroll
            for (int ai = 0; ai < 2; ++ai)
#pragma unroll
                for (int m = 0; m < 4; ++m) {
                    const int t = i0 + ai * 128 + wr * 64 + m * 16 + fr - CTX, pos = (wc & 1) ? (t & 63) : (t >> 6);
                    const f32x4 cc = *(const f32x4*)(p->ropec() + pos * 16 + fq * 4), ss = *(const f32x4*)(p->ropes() + pos * 16 + fq * 4);
#pragma unroll
                    for (int bj = 0; bj < 2; ++bj) { const f32x4 x1 = acc[ai][bj][m][0], x2 = acc[ai][bj][m][1];
                        acc[ai][bj][m][0] = x1 * cc - x2 * ss; acc[ai][bj][m][1] = x1 * ss + x2 * cc; }
                }
        }
        if (seg == 7 || seg <= 1) {
            const float sc_ = seg == 7 ? 0.125f : 0.125f * 1.4426950408889634f;
#pragma unroll
            for (int ai = 0; ai < 2; ++ai)
#pragma unroll
                for (int bj = 0; bj < 2; ++bj)
#pragma unroll
                    for (int m = 0; m < 4; ++m) { acc[ai][bj][m][0] = acc[ai][bj][m][0] * sc_; acc[ai][bj][m][1] = acc[ai][bj][m][1] * sc_; }
        }
        if (seg <= 7 || seg >= 10) {
#pragma unroll
            for (int bj = 0; bj < 2; ++bj) {
                bf16_t* base; long rstride; bool ok = true;
                if (seg <= 1)      { const int h = (seg & 1) * 2 + bj;       base = p->Q() + (((size_t)(b * 4 + h) * SEQ + (i0 - CTX)) * 128 + wc * 32 + fq * 4); rstride = 128; ok = lat; }
                else if (seg <= 3) { const int h = (seg - 2) * 2 + bj;       base = p->K() + (((size_t)(b * 4 + h) * RB + i0) * 128 + wc * 32 + fq * 4);          rstride = 128; }
                else if (seg <= 5) { const int h = (seg - 4) * 2 + bj;       base = p->V() + (((size_t)(b * 4 + h) * RB + i0) * 128 + wc * 32 + fq * 4);          rstride = 128; }
                else if (seg == 6) { const int h = bj * 2 + (wc >> 1);       base = p->RQ() + (((size_t)(b * 4 + h) * RB + i0) * 64 + (wc & 1) * 32 + fq * 4);    rstride = 64; }
                else if (seg == 7) { const int h = bj * 2 + (wc >> 1);       base = p->RK() + (((size_t)(b * 4 + h) * RB + i0) * 64 + (wc & 1) * 32 + fq * 4);    rstride = 64; }
                else               {                                         base = p->RG() + ((size_t)(b * SEQ + (i0 - CTX)) * 512 + (seg - 10) * 256 + bj * 128 + wc * 32 + fq * 4); rstride = 512; ok = lat; }
                if (ok) {
#pragma unroll
                    for (int ai = 0; ai < 2; ++ai)
#pragma unroll
                        for (int m = 0; m < 4; ++m) { bf16_t* rp = base + (long)(ai * 128 + wr * 64 + m * 16 + fr) * rstride;
#pragma unroll
                            for (int n = 0; n < 2; ++n) { u32x2 w; w.x = cvtpk(acc[ai][bj][m][n][0], acc[ai][bj][m][n][1]); w.y = cvtpk(acc[ai][bj][m][n][2], acc[ai][bj][m][n][3]);
                                *(u32x2*)(rp + n * 16) = w; } }
                }
            }
        }
        if (seg >= 7 && seg <= 9) {
            char* img = smem + 131072 + wid * 3968;
            const int npass = seg == 7 ? 2 : 1;
#pragma unroll 1
            for (int ps = 0; ps < npass; ++ps) {
#pragma unroll
                for (int bj = 0; bj < 2; ++bj) {
                    float lg2 = 0.f; bf16_t* baseT;
                    if (seg == 7) { const int h = bj * 2 + (wc >> 1); const float dv = ps == 0 ? p->dec_f[h] : p->dec_b[h]; lg2 = log2f(1.0f / (1.0f + expf(-dv)));
                        baseT = (ps == 0 ? p->KTf() : p->KTb()) + ((size_t)(b * 4 + h) * 64 + (wc & 1) * 32) * RB + i0; }
                    else { const int h = (seg - 8) * 2 + bj; baseT = p->VT() + ((size_t)(b * 4 + h) * 128 + wc * 32) * RB + i0; }
#pragma unroll
                    for (int ai = 0; ai < 2; ++ai)
#pragma unroll
                        for (int mp = 0; mp < 2; ++mp) {
                            asm volatile("s_waitcnt lgkmcnt(0)" ::: "memory");
#pragma unroll
                            for (int mm = 0; mm < 2; ++mm) { const int m = mp * 2 + mm;
                                float f = 1.0f;
                                if (seg == 7) { const int pos = (i0 + ai * 128 + wr * 64 + m * 16 + fr) & 127; f = __builtin_amdgcn_exp2f((float)(ps == 0 ? 127 - pos : pos) * lg2); }
#pragma unroll
                                for (int n = 0; n < 2; ++n)
#pragma unroll
                                    for (int j = 0; j < 4; ++j) *(bf16_t*)(img + (n * 16 + fq * 4 + j) * 80 + (mm * 16 + fr) * 2) = f2bf(acc[ai][bj][m][n][j] * f); }
                            asm volatile("s_waitcnt lgkmcnt(0)" ::: "memory");
                            const int ib = ai * 128 + wr * 64 + mp * 32;
#pragma unroll
                            for (int k = 0; k < 2; ++k) { const int q = lane + 64 * k, col = q >> 2, ch = q & 3;
                                *(u32x4*)(baseT + (size_t)col * RB + ib + ch * 8) = *(const u32x4*)(img + col * 80 + ch * 16); }
                        }
                }
            }
        }
    } };
__device__ __forceinline__ void ph_gemm_in(const MK& p, int bid, int nb, int tid_l) {
    SchedIn S{&p, bid, nb, tid_l}; EpiIn E{&p};
    pg8::gemm<EpiIn, SchedIn, false, true>(D, S, E, tid_l);
}

struct SchedOut { const MK* p; int bid, nb, tid_l;
    __device__ __forceinline__ bool next(int i, pg8::GUnit& u, unsigned (&vA)[2][2]) const {
        const int tile = xcd_vbid(bid, nb) + i * nb; if (tile >= (T / 256) * 4) return false;
        const int pm = tile >> 2, pn = tile & 3;
        u.A = (const char*)(p->MIX() + (size_t)(pm * 256) * D); u.B = (const char*)(p->w_outT() + (size_t)(pn * 256) * D); u.i0 = pm; u.i1 = pn; u.i2 = 0; u.i3 = 0;
        pg8::plain_voffA(D, vA, tid_l); return true; } };
struct EpiOut { static constexpr bool PERM = true; const MK* p;
    __device__ __forceinline__ void operator()(const f32x4 (&acc)[2][2][4][2], const pg8::GUnit& u, int wr, int wc, int fr, int fq) const {
        const int brow = u.i0 * 256, bcol = u.i1 * 256 + wc * 32 + fq * 8;
        const float* g1 = p->mod() + (size_t)(brow / SEQ) * 6 * D + 2 * D + bcol;
        f32x4 gv[2][2];
#pragma unroll
        for (int bj = 0; bj < 2; ++bj)
#pragma unroll
            for (int n = 0; n < 2; ++n) gv[bj][n] = *(const f32x4*)(g1 + bj * 128 + n * 4);
#pragma unroll
        for (int ai = 0; ai < 2; ++ai)
#pragma unroll
            for (int m = 0; m < 4; ++m) {
                const int row = brow + ai * 128 + wr * 64 + m * 16 + fr;
                const float* xp = p->x + (size_t)row * D + bcol;
                f32x4 xv[2][2];
#pragma unroll
                for (int bj = 0; bj < 2; ++bj)
#pragma unroll
                    for (int n = 0; n < 2; ++n) xv[bj][n] = *(const f32x4*)(xp + bj * 128 + n * 4);
#pragma unroll
                for (int bj = 0; bj < 2; ++bj) {
                    const f32x4 a = xv[bj][0] + gv[bj][0] * acc[ai][bj][m][0], b = xv[bj][1] + gv[bj][1] * acc[ai][bj][m][1];
                    const u32x4 w = {cvtpk(a[0], a[1]), cvtpk(a[2], a[3]), cvtpk(b[0], b[1]), cvtpk(b[2], b[3])};
                    *(u32x4*)(p->X1() + (size_t)row * 2048 + bcol + bj * 128) = w;
                }
                if (m & 1) asm volatile("" ::: "memory");
            }
    } };
__device__ __forceinline__ void ph_gemm_out(const MK& p, int bid, int nb, int tid_l) {
    SchedOut S{&p, bid, nb, tid_l}; EpiOut E{&p};
    pg8::gemm<EpiOut, SchedOut, false, true>(D, S, E, tid_l);
}

template <bool DUMMY, int MODE = 0> __device__ __forceinline__ void ph_route(const MK& p, int bid, int nb, int tid_l) {
    int* cntp = p.cnt() + (DUMMY ? 128 : 0); int* tl = DUMMY ? (int*)(p.ws + 480 * MiB) : p.tok_list(); float* wl_ = DUMMY ? (float*)(p.ws + 488 * MiB) : p.wt_list(); int* tm = DUMMY ? (int*)(p.ws + 496 * MiB) : p.tokmap();
    const int tid = tid_l, wid = tid >> 6, lane = tid & 63, fr = lane & 15, fq = lane >> 4;
    float* lg = (float*)smem;
    int* wcnt = (int*)(smem + 34816);
    int* pref = wcnt + 512;
    bf16_t* H2lo = (bf16_t*)(p.ws + 325 * MiB);
    for (int item = bid; item < T / 128; item += nb) {
        const int t0 = item * 128 + wid * 16, b = (item * 128) / SEQ;
        const float* msh = p.mod() + (size_t)b * 6 * D + 3 * D; const float* msc = p.mod() + (size_t)b * 6 * D + 4 * D;
#pragma unroll 1
        for (int r0 = 0; r0 < 16; r0 += 4) {
            float4 xv[4][4];
#pragma unroll
            for (int rr = 0; rr < 4; ++rr)
#pragma unroll
                for (int q = 0; q < 4; ++q) { const u32x2 w = *(const u32x2*)(p.X1() + (size_t)(t0 + r0 + rr) * 2048 + q * 256 + lane * 4);
                    xv[rr][q] = make_float4(__uint_as_float(w.x << 16), __uint_as_float(w.x & 0xffff0000u), __uint_as_float(w.y << 16), __uint_as_float(w.y & 0xffff0000u)); }
#pragma unroll
            for (int rr = 0; rr < 4; ++rr) {
                float ss = 0.f;
#pragma unroll
                for (int q = 0; q < 4; ++q) ss += xv[rr][q].x * xv[rr][q].x + xv[rr][q].y * xv[rr][q].y + xv[rr][q].z * xv[rr][q].z + xv[rr][q].w * xv[rr][q].w;
                ss = wave_sum(ss);
                const float rstd = rsqrtf(ss * (1.0f / D) + EPS);
#pragma unroll
                for (int q = 0; q < 4; ++q) {
                    const int c0 = q * 256 + lane * 4;
                    const float4 gg = *(const float4*)(p.norm2_g + c0), sh = *(const float4*)(msh + c0), sc = *(const float4*)(msc + c0);
                    const float h0 = xv[rr][q].x * rstd * gg.x * (1 + sc.x) + sh.x, h1 = xv[rr][q].y * rstd * gg.y * (1 + sc.y) + sh.y;
                    const float h2v = xv[rr][q].z * rstd * gg.z * (1 + sc.z) + sh.z, h3 = xv[rr][q].w * rstd * gg.w * (1 + sc.w) + sh.w;
                    u32x2 wh, wl2; wh.x = cvtpk(h0, h1); wh.y = cvtpk(h2v, h3);
                    wl2.x = cvtpk(h0 - __uint_as_float(wh.x << 16), h1 - __uint_as_float(wh.x & 0xffff0000u));
                    wl2.y = cvtpk(h2v - __uint_as_float(wh.y << 16), h3 - __uint_as_float(wh.y & 0xffff0000u));
                    *(u32x2*)(p.H2() + (size_t)(t0 + r0 + rr) * D + c0) = wh;
                    *(u32x2*)(H2lo + (size_t)(t0 + r0 + rr) * D + c0) = wl2;
                }
            }
        }
        asm volatile("s_waitcnt vmcnt(0)" ::: "memory");
        __syncthreads();
        if (MODE == 3) continue;
        f32x4 acc[4];
#pragma unroll
        for (int nt = 0; nt < 4; ++nt) acc[nt] = (f32x4){0.f, 0.f, 0.f, 0.f};
        {
            const bf16_t* ah_p = p.H2() + (size_t)(t0 + fr) * D + fq * 8; const bf16_t* al_p = H2lo + (size_t)(t0 + fr) * D + fq * 8;
            const int widu = __builtin_amdgcn_readfirstlane(wid);
            unsigned rofs[4];
#pragma unroll
            for (int i = 0; i < 4; ++i) { const int x = wid * 1024 + i * 8192 + lane * 16, row = x >> 8, c = ((x & 255) >> 4) ^ (row & 15); rofs[i] = (unsigned)(row * 2048 + c * 16); }
#define RT_DMA(kc, buf) do { const char* src_ = (const char*)p.routerT() + (size_t)(kc) * 256;                                             \
            _Pragma("unroll") for (int i = 0; i < 4; ++i) __builtin_amdgcn_global_load_lds((const unsigned*)(src_ + rofs[i]), (unsigned*)(smem + 40960 + (buf) * 32768 + widu * 1024 + i * 8192), 16, 0, 0); } while (0)
            RT_DMA(0, 0);
#pragma unroll 1
            for (int kc = 0; kc < 8; ++kc) {
                bf16x8 ah[4], al[4];
#pragma unroll
                for (int ks = 0; ks < 4; ++ks) { ah[ks] = ldfrag(ah_p + kc * 128 + ks * 32); al[ks] = ldfrag(al_p + kc * 128 + ks * 32); }
                asm volatile("s_waitcnt vmcnt(0)" ::: "memory"); __syncthreads();
                if (kc + 1 < 8) RT_DMA(kc + 1, (kc + 1) & 1);
                const char* bb = smem + 40960 + (kc & 1) * 32768;
#pragma unroll
                for (int ks = 0; ks < 4; ++ks)
#pragma unroll
                    for (int nt = 0; nt < 4; ++nt) {
                        const int row = nt * 16 + fr, cc = ((ks * 4 + fq) ^ (row & 15)) * 16;
                        const bf16x8 bh = *(const bf16x8*)(bb + row * 256 + cc), bl = *(const bf16x8*)(bb + (64 + row) * 256 + cc);
                        acc[nt] = __builtin_amdgcn_mfma_f32_16x16x32_bf16(ah[ks], bh, acc[nt], 0, 0, 0);
                        acc[nt] = __builtin_amdgcn_mfma_f32_16x16x32_bf16(ah[ks], bl, acc[nt], 0, 0, 0);
                        acc[nt] = __builtin_amdgcn_mfma_f32_16x16x32_bf16(al[ks], bh, acc[nt], 0, 0, 0);
                    }
            }
#undef RT_DMA
        }
#pragma unroll
        for (int nt = 0; nt < 4; ++nt)
#pragma unroll
            for (int j = 0; j < 4; ++j) lg[(wid * 16 + fq * 4 + j) * 65 + nt * 16 + fr] = acc[nt][j];
        __syncthreads();
        if (MODE == 2) continue;
        int l3 = lane; asm volatile("" : "+v"(l3));
#define SHXF(v_, m_) __int_as_float(__builtin_amdgcn_ds_bpermute((l3 ^ (m_)) << 2, __float_as_int(v_)))
#define SHXI(v_, m_) __builtin_amdgcn_ds_bpermute((l3 ^ (m_)) << 2, (v_))
#define SHBF(v_, src_) __int_as_float(__builtin_amdgcn_ds_bpermute((src_) << 2, __float_as_int(v_)))
#define SHBI(v_, src_) __builtin_amdgcn_ds_bpermute((src_) << 2, (v_))
        const int q4 = l3 & 3, tt = wid * 16 + (l3 >> 2), t = item * 128 + tt, qbase = l3 & ~3;
        float sc_[16], v[16];
#pragma unroll
        for (int i = 0; i < 16; ++i) { const float x = lg[tt * 65 + q4 * 16 + i]; sc_[i] = __builtin_amdgcn_rcpf(1.0f + __builtin_amdgcn_exp2f(-1.4426950408889634f * x)); v[i] = sc_[i] + p.router_b[q4 * 16 + i]; }
        float gsA, gsB;
        { float m1 = v[0], m2 = -INFINITY;
#pragma unroll
          for (int i = 1; i < 8; ++i) { const float x = v[i]; m2 = fmaxf(m2, fminf(m1, x)); m1 = fmaxf(m1, x); }
          gsA = m1 + m2; m1 = v[8]; m2 = -INFINITY;
#pragma unroll
          for (int i = 9; i < 16; ++i) { const float x = v[i]; m2 = fmaxf(m2, fminf(m1, x)); m1 = fmaxf(m1, x); }
          gsB = m1 + m2; }
        { int rankA = 0, rankB = 0;
#pragma unroll
          for (int qq = 0; qq < 4; ++qq) {
              const float ga = SHBF(gsA, qbase | qq), gb = SHBF(gsB, qbase | qq);
              const int g0 = 2 * qq, g1 = 2 * qq + 1, mA = 2 * q4, mB = 2 * q4 + 1;
              rankA += (g0 != mA && (ga > gsA || (ga == gsA && g0 < mA))) ? 1 : 0; rankA += (g1 != mA && (gb > gsA || (gb == gsA && g1 < mA))) ? 1 : 0;
              rankB += (g0 != mB && (ga > gsB || (ga == gsB && g0 < mB))) ? 1 : 0; rankB += (g1 != mB && (gb > gsB || (gb == gsB && g1 < mB))) ? 1 : 0;
          }
          if (rankA >= 4) {
#pragma unroll
              for (int i = 0; i < 8; ++i) v[i] = -INFINITY; }
          if (rankB >= 4) {
#pragma unroll
              for (int i = 8; i < 16; ++i) v[i] = -INFINITY; } }
        unsigned chm = 0u;
#pragma unroll 1
        for (int it = 0; it < 8; ++it) {
            float lm = v[0];
#pragma unroll
            for (int i = 1; i < 16; ++i) lm = fmaxf(lm, v[i]);
            float gm = fmaxf(lm, SHXF(lm, 1)); gm = fmaxf(gm, SHXF(gm, 2));
            int cand = (lm == gm) ? q4 : 4;
            cand = min(cand, SHXI(cand, 1)); cand = min(cand, SHXI(cand, 2));
            const bool win = cand == q4;
            bool found = false;
#pragma unroll
            for (int i = 0; i < 16; ++i) { const bool hit = win && !found && v[i] == gm; if (hit) { chm |= (1u << i); v[i] = -INFINITY; } found = found || hit; }
        }
        float wsum = 0.f;
#pragma unroll
        for (int i = 0; i < 16; ++i) wsum += ((chm >> i) & 1u) ? sc_[i] : 0.f;
        wsum += SHXF(wsum, 1); wsum += SHXF(wsum, 2);
        const float wscale = 2.5f / wsum;
        const unsigned long long pat = 0x1111111111111111ull << q4;
#pragma unroll
        for (int i = 0; i < 16; ++i) { const unsigned long long bal = __ballot((chm >> i) & 1u); if (l3 < 4) wcnt[wid * 64 + l3 * 16 + i] = __popcll(bal & (0x1111111111111111ull << l3)); }
        __syncthreads();
        if (wid == 0) {
            int tot = 0;
#pragma unroll
            for (int w = 0; w < 8; ++w) tot += wcnt[w * 64 + lane];
            int run = atomicAdd(&cntp[lane], tot);
#pragma unroll
            for (int w = 0; w < 8; ++w) { const int c = wcnt[w * 64 + lane]; pref[w * 64 + lane] = run; run += c; }
        }
        __syncthreads();
        {
            const int pc = __popc(chm);
            int kbase = 0;
#pragma unroll
            for (int qq = 0; qq < 3; ++qq) { const int o = SHBI(pc, qbase | qq); kbase += (qq < q4) ? o : 0; }
#pragma unroll
            for (int i = 0; i < 16; ++i) {
                const bool c = (chm >> i) & 1u;
                const unsigned long long bal = __ballot(c);
                if (c) {
                    const int e = q4 * 16 + i;
                    const int slot = pref[wid * 64 + e] + __popcll(bal & pat & ((1ull << l3) - 1ull));
                    tl[(size_t)e * ECAP + slot] = t; wl_[(size_t)e * ECAP + slot] = sc_[i] * wscale;
                    tm[(size_t)t * 8 + kbase + __popc(chm & ((1u << i) - 1u))] = e * ECAP + slot;
                }
            }
        }
    }
}
#undef SHXF
#undef SHXI
#undef SHBF
#undef SHBI

constexpr int MOE_AUX = 162816;
__device__ __forceinline__ void moe_tables(const MK& p, int colt, int* tpre, int* rbase, int tid_l) {
    __syncthreads();
    if (tid_l == 0) { int tp = 0, rb = 0;
        for (int e = 0; e < 65; ++e) { const int c = e < 64 ? p.cnt()[e] : T; tpre[e] = tp; rbase[e] = rb; tp += ((c + 255) >> 8) * colt; rb += c; }
        tpre[65] = tp; rbase[65] = rb; }
    __syncthreads();
}
struct SchedUp { const MK* p; int bid, nb, tid_l, ntiles; const int* tpre; const int* rbase; mutable int e_hint;
    __device__ __forceinline__ bool next(int i, pg8::GUnit& u, unsigned (&vA)[2][2]) const {
        const int tile = xcd_vbid(bid, nb) + i * nb; if (tile >= ntiles) return false;
        int e = e_hint; while (tile >= tpre[e + 1]) ++e; e_hint = e;
        const int j = tile - tpre[e], rt = j >> 1, ct = j & 1, cnt_e = rbase[e + 1] - rbase[e];
        u.A = (const char*)p->H2(); u.B = (const char*)(p->W13t() + ((size_t)e * 512 + ct * 256) * D); u.i0 = e; u.i1 = rt; u.i2 = ct; u.i3 = cnt_e;
#pragma unroll
        for (int i2 = 0; i2 < 2; ++i2) { int R, C; stage_rc(tid_l * 16 + i2 * 8192, R, C);
#pragma unroll
            for (int h = 0; h < 2; ++h) { int slot = rt * 256 + h * 128 + R; if (slot >= cnt_e) slot = 0;
                const int tok = e < 64 ? p->tok_list()[(size_t)e * ECAP + slot] : slot;
                vA[h][i2] = (unsigned)tok * (D * 2u) + (unsigned)C * 2u; } }
        return true; } };
struct EpiUp { static constexpr bool PERM = true; const MK* p; const int* rbase;
    __device__ __forceinline__ void operator()(const f32x4 (&acc)[2][2][4][2], const pg8::GUnit& u, int wr, int wc, int fr, int fq) const {
        const int e = u.i0, rt = u.i1, ct = u.i2, cnt_e = u.i3;
        bf16_t* ab = p->ACT() + (size_t)rbase[e] * DE + ct * 128 + wc * 32 + fq * 8;
#pragma unroll
        for (int ai = 0; ai < 2; ++ai)
#pragma unroll
            for (int m = 0; m < 4; ++m) {
                const int slot = rt * 256 + ai * 128 + wr * 64 + m * 16 + fr;
                u32x4 w;
                w.x = cvtpk(silu_fast(acc[ai][0][m][0][0]) * acc[ai][1][m][0][0], silu_fast(acc[ai][0][m][0][1]) * acc[ai][1][m][0][1]);
                w.y = cvtpk(silu_fast(acc[ai][0][m][0][2]) * acc[ai][1][m][0][2], silu_fast(acc[ai][0][m][0][3]) * acc[ai][1][m][0][3]);
                w.z = cvtpk(silu_fast(acc[ai][0][m][1][0]) * acc[ai][1][m][1][0], silu_fast(acc[ai][0][m][1][1]) * acc[ai][1][m][1][1]);
                w.w = cvtpk(silu_fast(acc[ai][0][m][1][2]) * acc[ai][1][m][1][2], silu_fast(acc[ai][0][m][1][3]) * acc[ai][1][m][1][3]);
                if (slot < cnt_e) *(u32x4*)(ab + (size_t)slot * DE) = w;
            }
    } };
__device__ __forceinline__ void ph_moe_up(const MK& p, int bid, int nb, int tid_l) {
    int* tpre = (int*)(smem + MOE_AUX); int* rbase = tpre + 80;
    moe_tables(p, 2, tpre, rbase, tid_l);
    SchedUp S{&p, bid, nb, tid_l, tpre[65], tpre, rbase, 0}; EpiUp E{&p, rbase};
    pg8::gemm<EpiUp, SchedUp, true, true>(D, S, E, tid_l);
}
constexpr float Y_SCALE = 64.0f;
struct SchedDown { const MK* p; int bid, nb, tid_l, ntiles; const int* tpre; const int* rbase; mutable int e_hint;
    __device__ __forceinline__ bool next(int i, pg8::GUnit& u, unsigned (&vA)[2][2]) const {
        const int tile = xcd_vbid(bid, nb) + i * nb; if (tile >= ntiles) return false;
        int e = e_hint; while (tile >= tpre[e + 1]) ++e; e_hint = e;
        const int j = tile - tpre[e], rt = j >> 2, ct = j & 3, cnt_e = rbase[e + 1] - rbase[e];
        u.A = (const char*)(p->ACT() + (size_t)(rbase[e] + rt * 256) * DE); u.B = (const char*)(p->W2t() + ((size_t)e * D + ct * 256) * DE); u.i0 = e; u.i1 = rt; u.i2 = ct; u.i3 = cnt_e;
        pg8::plain_voffA(DE, vA, tid_l); return true; } };
template <int MODE> struct EpiDown { static constexpr bool PERM = true; const MK* p; const int* rbase;
    __device__ __forceinline__ void operator()(const f32x4 (&acc)[2][2][4][2], const pg8::GUnit& u, int wr, int wc, int fr, int fq) const {
        const int e = u.i0, rt = u.i1, ct = u.i2, cnt_e = u.i3;
        {
            const float* wl = p->wt_list() + (size_t)(e < 64 ? e : 0) * ECAP;
            float wv[2][4];
#pragma unroll
            for (int ai = 0; ai < 2; ++ai)
#pragma unroll
                for (int m = 0; m < 4; ++m) { const int sl = rt * 256 + ai * 128 + wr * 64 + m * 16 + fr; wv[ai][m] = e < 64 ? wl[sl < cnt_e ? sl : 0] * Y_SCALE : Y_SCALE; }
            const int wid = wr * 4 + wc, lane = fq * 16 + fr;
            char* wa = smem + 131072 + wid * 3968;
            unsigned char* yb = p->Y() + (size_t)rbase[e] * D + ct * 256 + wc * 64 + (lane & 3) * 16;
#pragma unroll
            for (int ai = 0; ai < 2; ++ai)
#pragma unroll
                for (int m = 0; m < 4; ++m) {
                    const float w = wv[ai][m];
                    char* img = wa + ((m & 1) ? 1280 : 0);
#pragma unroll
                    for (int bj = 0; bj < 2; ++bj) {
                        u32x2 pk;
#pragma unroll
                        for (int n = 0; n < 2; ++n) {
                            float v0 = __builtin_amdgcn_fmed3f(acc[ai][bj][m][n][0] * w, -448.f, 448.f), v1 = __builtin_amdgcn_fmed3f(acc[ai][bj][m][n][1] * w, -448.f, 448.f);
                            float v2 = __builtin_amdgcn_fmed3f(acc[ai][bj][m][n][2] * w, -448.f, 448.f), v3 = __builtin_amdgcn_fmed3f(acc[ai][bj][m][n][3] * w, -448.f, 448.f);
                            int q = 0; q = __builtin_amdgcn_cvt_pk_fp8_f32(v0, v1, q, false); q = __builtin_amdgcn_cvt_pk_fp8_f32(v2, v3, q, true);
                            if (n == 0) pk.x = (unsigned)q; else pk.y = (unsigned)q;
                        }
                        *(u32x2*)(img + fr * 80 + bj * 32 + fq * 8) = pk;
                    }
                    asm volatile("s_waitcnt lgkmcnt(0)" ::: "memory");
                    const int rr = lane >> 2, slot = rt * 256 + ai * 128 + wr * 64 + m * 16 + rr;
                    const u32x4 v = *(const u32x4*)(img + rr * 80 + (lane & 3) * 16);
                    if (MODE == 1) asm volatile("" :: "v"(v)); else if (slot < cnt_e) *(u32x4*)(yb + (size_t)slot * D) = v;
                }
        }
    } };
template <bool DUMMY, int MODE = 0> __device__ __forceinline__ void ph_moe_down(const MK& p, int bid, int nb, int tid_l) {
    int* tpre = (int*)(smem + MOE_AUX); int* rbase = tpre + 80;
    moe_tables(p, 4, tpre, rbase, tid_l);
    SchedDown S{&p, bid, nb, tid_l, DUMMY ? tpre[64] : tpre[65], tpre, rbase, 0}; EpiDown<MODE> E{&p, rbase};
    pg8::gemm<EpiDown<MODE>, SchedDown, false, true>(DE, S, E, tid_l);
}

template <bool DUMMY> __device__ __forceinline__ void ph_final(const MK& p, int bid, int nb, int tid_l) {
    const int wid = tid_l >> 6, lane = tid_l & 63;
    int* tpre = (int*)(smem + MOE_AUX); int* rbase = tpre + 80;
    moe_tables(p, 1, tpre, rbase, tid_l);
    for (int t = bid * 8 + wid; t < T; t += nb * 8) {
        const int b = t / SEQ;
        float f[16];
#pragma unroll
        for (int i = 0; i < 16; ++i) f[i] = 0.f;
#pragma unroll
        for (int k = 0; k < 9; ++k) {
            int row;
            if (k < 8) { const int id = p.tokmap()[(size_t)t * 8 + k], e = id >> 15, slot = id & (ECAP - 1); row = rbase[e] + slot; } else row = rbase[64] + t;
            const unsigned char* yr = p.Y() + (size_t)row * D + lane * 4;
#pragma unroll
            for (int q = 0; q < 4; ++q) {
                const int w = *(const int*)(yr + q * 256);
                const auto lo = __builtin_amdgcn_cvt_pk_f32_fp8(w, false); const auto hi = __builtin_amdgcn_cvt_pk_f32_fp8(w, true);
                f[q * 4 + 0] += lo[0]; f[q * 4 + 1] += lo[1]; f[q * 4 + 2] += hi[0]; f[q * 4 + 3] += hi[1];
            }
        }
        const int pcol = ((lane >> 3) & 1) * 128 + (lane >> 4) * 32 + (lane & 7) * 4;
        const float* g2 = p.mod() + (size_t)b * 6 * D + 5 * D + pcol;
        const bf16_t* x1 = p.X1() + (size_t)t * 2048 + pcol;
        float* xo = p.out + (size_t)t * D + pcol;
        float v[16]; float ss = 0.f;
#pragma unroll
        for (int q = 0; q < 4; ++q) {
            const u32x2 xw = *(const u32x2*)(x1 + q * 256); const float4 g = *(const float4*)(g2 + q * 256);
            v[q * 4 + 0] = __uint_as_float(xw.x << 16) + g.x * f[q * 4 + 0] * (1.0f / Y_SCALE); v[q * 4 + 1] = __uint_as_float(xw.x & 0xffff0000u) + g.y * f[q * 4 + 1] * (1.0f / Y_SCALE);
            v[q * 4 + 2] = __uint_as_float(xw.y << 16) + g.z * f[q * 4 + 2] * (1.0f / Y_SCALE); v[q * 4 + 3] = __uint_as_float(xw.y & 0xffff0000u) + g.w * f[q * 4 + 3] * (1.0f / Y_SCALE);
            ss += v[q * 4] * v[q * 4] + v[q * 4 + 1] * v[q * 4 + 1] + v[q * 4 + 2] * v[q * 4 + 2] + v[q * 4 + 3] * v[q * 4 + 3];
        }
        ss = wave_sum(ss);
        const float rstd = rsqrtf(ss * (1.0f / D) + EPS);
#pragma unroll
        for (int q = 0; q < 4; ++q) {
            const float4 gf = *(const float4*)(p.final_g + q * 256 + pcol);
            *(float4*)((DUMMY ? (float*)(p.ws + 42 * MiB) + (size_t)t * D + pcol : xo) + q * 256) = make_float4(v[q * 4] * rstd * gf.x, v[q * 4 + 1] * rstd * gf.y, v[q * 4 + 2] * rstd * gf.z, v[q * 4 + 3] * rstd * gf.w);
        }
    }
}


#define XB_TMO      128
#define XB_XCNT(j)  (256  + 64 * (j))
#define XB_XSUB(j)  (1280 + 64 * (j))
#define XB_XGEN(j)  (2304 + 64 * (j))
#define XB_TOP      3328
#define XB_TOPGEN   3392
#define XCD_BAR_WORDS 3456
#define XB_SPIN_CAP (1u << 22)
#define LAS __attribute__((address_space(3)))
__device__ __forceinline__ unsigned xb_ld(unsigned* p)              { return __hip_atomic_load(p, __ATOMIC_RELAXED, __HIP_MEMORY_SCOPE_AGENT); }
__device__ __forceinline__ unsigned xb_add(unsigned* p, unsigned v) { return __hip_atomic_fetch_add(p, v, __ATOMIC_RELAXED, __HIP_MEMORY_SCOPE_AGENT); }
__device__ __forceinline__ unsigned xb_xcc_id() { return (unsigned)__builtin_amdgcn_s_getreg((3 << 11) | 20) & 0xFu; }
#define XB_SPIN(cond, bar) do { unsigned _sp = 0; while (cond) { __builtin_amdgcn_s_sleep(1); \
    if ((++_sp & 255u) == 0u) { if (xb_ld(&(bar)[XB_TMO])) break; if (_sp > XB_SPIN_CAP) { atomicAdd(&(bar)[XB_TMO], 1u); break; } } } } while (0)
struct XcdBarrier { unsigned* bar; unsigned x; volatile LAS unsigned* st; };
__device__ __forceinline__ XcdBarrier xcd_barrier_post(unsigned* bar, volatile LAS unsigned* st, int tid) {
    XcdBarrier b; b.bar = bar; b.x = xb_xcc_id(); b.st = st;
    if (tid == 0) (void)xb_add(&bar[XB_XCNT(b.x)], 1u);
    return b;
}
__device__ __forceinline__ void xcd_barrier_complete(unsigned* bar, unsigned x, unsigned& nloc, unsigned& nx) {
    const unsigned G = gridDim.x * gridDim.y * gridDim.z;
    unsigned sum, cnt, mine, sp = 0u;
    for (;;) {
        sum = 0u; cnt = 0u; mine = 0u;
#pragma unroll
        for (unsigned j = 0; j < 16; ++j) { const unsigned c = xb_ld(&bar[XB_XCNT(j)]); sum += c; cnt += (c > 0u) ? 1u : 0u; mine = (j == x) ? c : mine; }
        if (sum == G) break;
        __builtin_amdgcn_s_sleep(1);
        if ((++sp & 255u) == 0u) { if (xb_ld(&bar[XB_TMO])) break; if (sp > XB_SPIN_CAP) { atomicAdd(&bar[XB_TMO], 1u); break; } }
    }
    nloc = mine > 0u ? mine : 1u; nx = cnt > 0u ? cnt : 1u;
}
__device__ __forceinline__ void xcd_barrier(const XcdBarrier& b, int tid) {
    asm volatile("s_waitcnt vmcnt(0)" ::: "memory");
    __syncthreads();
    if (tid == 0) {
        unsigned* bar = b.bar;
        __builtin_amdgcn_s_waitcnt(0);
        unsigned nloc = b.st[0], nx = b.st[1];
        if (nloc == 0u) { xcd_barrier_complete(bar, b.x, nloc, nx); b.st[0] = nloc; b.st[1] = nx; }
        const unsigned old = xb_add(&bar[XB_XSUB(b.x)], 1u);
        const unsigned gen = old / nloc;
        if (old + 1u == (gen + 1u) * nloc) {
            __builtin_amdgcn_fence(__ATOMIC_RELEASE, "agent");
            asm volatile("s_waitcnt vmcnt(0)" ::: "memory");
            const unsigned og = xb_add(&bar[XB_TOP], 1u);
            const unsigned tg = og / nx;
            if (og + 1u == (tg + 1u) * nx) xb_add(&bar[XB_TOPGEN], 1u);
            else XB_SPIN(xb_ld(&bar[XB_TOPGEN]) == tg, bar);
            __builtin_amdgcn_fence(__ATOMIC_ACQUIRE, "agent");
            xb_add(&bar[XB_XGEN(b.x)], 1u);
            asm volatile("s_waitcnt vmcnt(0)" ::: "memory");
        } else {
            XB_SPIN(xb_ld(&bar[XB_XGEN(b.x)]) == gen, bar);
            __builtin_amdgcn_fence(__ATOMIC_ACQUIRE, "agent");
            asm volatile("s_waitcnt vmcnt(0)" ::: "memory");
        }
    }
    __syncthreads();
}

__device__ __forceinline__ int lane_id_volatile() { int l; asm volatile("v_mbcnt_lo_u32_b32 %0, -1, 0\n\tv_mbcnt_hi_u32_b32 %0, -1, %0" : "=v"(l)); return l; }
__global__ __launch_bounds__(512, 2) void k_mega(MK p) {
    cg::grid_group grid = cg::this_grid();
    const int bid = blockIdx.x, nb = gridDim.x;
    volatile LAS unsigned* xst = (volatile LAS unsigned*)(smem + 162816 + 768);
    if (threadIdx.x < 4) xst[threadIdx.x] = 0u;
    __syncthreads();
    const XcdBarrier xb = xcd_barrier_post((unsigned*)(p.ws + 524288), xst, (int)threadIdx.x);
    const int wv_ = __builtin_amdgcn_readfirstlane((int)threadIdx.x >> 6);
#define LANE_ID() lane_id_volatile()
#define PH_TID() int t_ = wv_ * 64 + LANE_ID(); asm volatile("" : "+v"(t_))
    { PH_TID(); if (bid == 0 && t_ < 256) p.cnt()[t_] = 0; ph_mod(p, bid, nb, t_); ph_convert(p, bid, nb, t_); }
#if DUP == 10
    { PH_TID(); ph_convert(p, bid, nb, t_); }
#endif
    grid.sync();
    { PH_TID(); ph_ln1(p, bid, nb, t_); }
#if DUP == 1
    { PH_TID(); ph_ln1(p, bid, nb, t_); }
#endif
    xcd_barrier(xb, wv_ * 64 + LANE_ID());
    { PH_TID(); ph_gemm_in(p, bid, nb, t_); }
    { PH_TID(); ph_convert_dyn(p, t_); }
#if DUP == 2
    { PH_TID(); ph_gemm_in(p, bid, nb, t_); }
#endif
    xcd_barrier(xb, wv_ * 64 + LANE_ID());
    { PH_TID(); ph_attn<0>(p, bid, nb, t_); }
#if DUP == 3
    { PH_TID(); ph_attn<2>(p, bid, nb, t_); }
#endif
#if DUP == 31
    { PH_TID(); ph_attn<1>(p, bid, nb, t_); }
#endif
#if DUP == 33
    { PH_TID(); ph_attn<3>(p, bid, nb, t_); }
#endif
    { PH_TID(); ph_kv(p, bid, nb, t_); }
#if DUP == 11
    { PH_TID(); ph_kv(p, bid, nb, t_); }
#endif
    xcd_barrier(xb, wv_ * 64 + LANE_ID());
    { PH_TID(); ph_scan(p, bid, nb, t_); }
    xcd_barrier(xb, wv_ * 64 + LANE_ID());
    { PH_TID(); ph_ret(p, bid, nb, t_); }
#if DUP == 5
    { PH_TID(); ph_ret(p, bid, nb, t_); }
#endif
    xcd_barrier(xb, wv_ * 64 + LANE_ID());
    { PH_TID(); ph_gemm_out(p, bid, nb, t_); }
#if DUP == 6
    { PH_TID(); ph_gemm_out(p, bid, nb, t_); }
#endif
    xcd_barrier(xb, wv_ * 64 + LANE_ID());
#if DUP == 7
    { PH_TID(); ph_route<true>(p, bid, nb, t_); }
#endif
#if DUP == 72
    { PH_TID(); ph_route<true, 2>(p, bid, nb, t_); }
#endif
#if DUP == 73
    { PH_TID(); ph_route<true, 3>(p, bid, nb, t_); }
#endif
    { PH_TID(); ph_route<false>(p, bid, nb, t_); }
    xcd_barrier(xb, wv_ * 64 + LANE_ID());
    { PH_TID(); ph_moe_up(p, bid, nb, t_); }
#if DUP == 8
    { PH_TID(); ph_moe_up(p, bid, nb, t_); }
#endif
    xcd_barrier(xb, wv_ * 64 + LANE_ID());
#if DUP == 9
    { PH_TID(); ph_moe_down<true>(p, bid, nb, t_); }
#endif
#if DUP == 91
    { PH_TID(); ph_moe_down<true, 1>(p, bid, nb, t_); }
#endif
    { PH_TID(); ph_moe_down<false>(p, bid, nb, t_); }
    xcd_barrier(xb, wv_ * 64 + LANE_ID());
#if DUP == 13
    { PH_TID(); ph_final<true>(p, bid, nb, t_); }
#endif
    { PH_TID(); ph_final<false>(p, bid, nb, t_); }
#undef PH_TID
#undef LANE_ID
}
constexpr int LDS_TOTAL = 163840;
extern "C" void kernel_launch(void* const* d_in, const int* in_sizes, int n_in, void* d_out, int out_size, void* d_ws, size_t ws_size, hipStream_t stream) {
    char* ws = (char*)d_ws;
    MK mk{};
    mk.x = (const float*)d_in[0]; mk.c = (const float*)d_in[1]; mk.ctx = (const float*)d_in[2]; mk.cctx = (const float*)d_in[3]; mk.ada_w = (const float*)d_in[4]; mk.ada_b = (const float*)d_in[5];
    mk.norm1_g = (const float*)d_in[6]; mk.w_in = (const float*)d_in[7]; mk.lq1 = (const float*)d_in[8]; mk.lk1 = (const float*)d_in[9]; mk.lq2 = (const float*)d_in[10]; mk.lk2 = (const float*)d_in[11];
    mk.dattn_g = (const float*)d_in[12]; mk.dec_f = (const float*)d_in[13]; mk.dec_b = (const float*)d_in[14]; mk.ret_g = (const float*)d_in[15]; mk.w_out = (const float*)d_in[16];
    mk.norm2_g = (const float*)d_in[17]; mk.router_w = (const float*)d_in[18]; mk.router_b = (const float*)d_in[19]; mk.ew1 = (const float*)d_in[20]; mk.ew3 = (const float*)d_in[21];
    mk.ew2 = (const float*)d_in[22]; mk.sw1 = (const float*)d_in[23]; mk.sw3 = (const float*)d_in[24]; mk.sw2 = (const float*)d_in[25]; mk.final_g = (const float*)d_in[26];
    mk.out = (float*)d_out;
    mk.ws = ws;
    mk.dbgP = nullptr; mk.dbg_lo = 0; mk.dbg_hi = 12; mk.conv_limit = 1 << 30;
    static int grid_blocks = 0;
    if (!grid_blocks) {
        (void)hipFuncSetAttribute((const void*)k_mega, hipFuncAttributeMaxDynamicSharedMemorySize, LDS_TOTAL);
        int dev = 0, cus = 0, per_cu = 0;
        (void)hipGetDevice(&dev);
        (void)hipDeviceGetAttribute(&cus, hipDeviceAttributeMultiprocessorCount, dev);
        (void)hipOccupancyMaxActiveBlocksPerMultiprocessor(&per_cu, k_mega, 512, LDS_TOTAL);
        if (per_cu > 1) per_cu = 1;
        grid_blocks = cus * per_cu;
        if (grid_blocks <= 0) { fprintf(stderr, "occupancy query failed: cus %d per_cu %d\n", cus, per_cu); grid_blocks = 256; }
    }
    (void)hipMemsetAsync(ws + 524288, 0, XCD_BAR_WORDS * 4, stream);
    void* args[] = {&mk};
    hipError_t e = hipLaunchCooperativeKernel((void*)k_mega, dim3(grid_blocks), dim3(512), args, LDS_TOTAL, stream);
    if (e != hipSuccess) fprintf(stderr, "cooperative launch failed: %s (grid %d)\n", hipGetErrorString(e), grid_blocks);
}
```

```cpp
#include <hip/hip_runtime.h>
#include <hip/hip_cooperative_groups.h>
#include <cstdio>
namespace cg = cooperative_groups;
#ifndef DUP
#define DUP 0
#endif
#include <stdint.h>

constexpr int D = 1024, NB = 4, SEQ = 8192, CTX = 256, RB = SEQ + CTX  , NR = NB * RB  , T = NB * SEQ;
constexpr int NE = 64, DE = 256, ECAP = 32768;
constexpr float EPS = 1e-6f;
typedef unsigned short bf16_t;

__device__ __forceinline__ float siluf(float v) { return v / (1.0f + expf(-v)); }
__device__ __forceinline__ float silu_fast(float v) { return v * __builtin_amdgcn_rcpf(1.0f + __builtin_amdgcn_exp2f(-1.4426950408889634f * v)); }
__device__ __forceinline__ float wave_sum(float v) {
#pragma unroll
    for (int o = 32; o > 0; o >>= 1) v += __shfl_xor(v, o);
    return v;
}
__device__ __forceinline__ float wave_max(float v) {
#pragma unroll
    for (int o = 32; o > 0; o >>= 1) v = fmaxf(v, __shfl_xor(v, o));
    return v;
}
__device__ __forceinline__ float block_sum(float v, float* red) {
    v = wave_sum(v);
    __syncthreads();
    if ((threadIdx.x & 63) == 0) red[threadIdx.x >> 6] = v;
    __syncthreads();
    return red[0] + red[1] + red[2] + red[3];
}
__device__ __forceinline__ float block_max(float v, float* red) {
    v = wave_max(v);
    __syncthreads();
    if ((threadIdx.x & 63) == 0) red[threadIdx.x >> 6] = v;
    __syncthreads();
    return fmaxf(fmaxf(red[0], red[1]), fmaxf(red[2], red[3]));
}

typedef short bf16x8 __attribute__((ext_vector_type(8)));
typedef short s16x4 __attribute__((ext_vector_type(4)));
typedef float f32x4 __attribute__((ext_vector_type(4)));
typedef float f32x16 __attribute__((ext_vector_type(16)));
typedef unsigned u32x2 __attribute__((ext_vector_type(2)));
typedef unsigned u32x4 __attribute__((ext_vector_type(4)));
extern __shared__ __attribute__((aligned(1024))) char smem[];
constexpr int NTHR = 512;
constexpr int GEMM_LDS = 131072;

__device__ __forceinline__ unsigned cvtpk(float lo, float hi) { unsigned r; asm volatile("v_cvt_pk_bf16_f32 %0, %1, %2" : "=v"(r) : "v"(lo), "v"(hi)); return r; }
__device__ __forceinline__ bf16_t f2bf(float v) { return (bf16_t)(cvtpk(v, v) & 0xffffu); }
__device__ __forceinline__ float bf2f(bf16_t v) { return __uint_as_float(((unsigned)v) << 16); }

constexpr size_t MiB = 1048576;
struct MK {
    const float *x, *c, *ctx, *cctx, *ada_w, *ada_b, *norm1_g, *w_in, *lq1, *lk1, *lq2, *lk2, *dattn_g, *dec_f, *dec_b, *ret_g, *w_out, *norm2_g, *router_w, *router_b,
        *ew1, *ew3, *ew2, *sw1, *sw3, *sw2, *final_g;
    float* out; char* ws;
    float* dbgP; long dbg_lo, dbg_hi; long conv_limit;
#define WSF(name, type, off) __device__ __forceinline__ type* name() const { return (type*)(ws + (off)); }
    WSF(mod, float, 0) WSF(cnt, int, 131072) WSF(ropec, float, 262144) WSF(ropes, float, 262144 + 8192)
    WSF(w_inT, bf16_t, 1 * MiB) WSF(w_outT, bf16_t, 7 * MiB) WSF(routerT, bf16_t, 9 * MiB) WSF(W2t, bf16_t, 9 * MiB + 524288)
    WSF(H, bf16_t, 42 * MiB) WSF(MIX, bf16_t, 42 * MiB) WSF(KV, bf16_t, 112 * MiB) WSF(ST, bf16_t, 147 * MiB) WSF(ACT, bf16_t, 42 * MiB)
    WSF(W13t, bf16_t, 194 * MiB) WSF(H2, bf16_t, 260 * MiB)
    WSF(Q, bf16_t, 260 * MiB) WSF(K, bf16_t, 292 * MiB) WSF(V, bf16_t, 325 * MiB) WSF(RQ, bf16_t, 358 * MiB) WSF(RK, bf16_t, 375 * MiB)
    WSF(KTf, bf16_t, 392 * MiB) WSF(KTb, bf16_t, 409 * MiB) WSF(VT, bf16_t, 426 * MiB) WSF(RG, bf16_t, 459 * MiB)
    WSF(Y, unsigned char, 194 * MiB) WSF(tok_list, int, 484 * MiB) WSF(wt_list, float, 492 * MiB) WSF(tokmap, int, 500 * MiB)
    __device__ __forceinline__ bf16_t* X1() const { return (bf16_t*)out; }
#undef WSF
};

__device__ __forceinline__ void ph_mod(const MK& p, int bid, int nb, int tid_l) {
    float* red = (float*)smem;
    for (int it = bid; it < 6 * D / 32; it += nb) {
        const int col = tid_l & 31, kg = tid_l >> 5, j = it * 32 + col;
        float a[5] = {0, 0, 0, 0, 0};
        for (int k = kg * 64; k < kg * 64 + 64; ++k) {
            float w = p.ada_w[(size_t)k * 6 * D + j];
#pragma unroll
            for (int r = 0; r < 5; ++r) { float cv = r < 4 ? p.c[r * D + k] : p.cctx[k]; a[r] += siluf(cv) * w; }
        }
        __syncthreads();
#pragma unroll
        for (int r = 0; r < 5; ++r) red[(kg * 5 + r) * 32 + col] = a[r];
        __syncthreads();
        if (tid_l < 160) {
            int r = tid_l >> 5; float s = 0;
            for (int g = 0; g < 16; ++g) s += red[(g * 5 + r) * 32 + col];
            p.mod()[(size_t)r * 6 * D + j] = s + p.ada_b[j];
        }
    }
    if (bid == nb - 1) {
        for (int i = tid_l; i < 128 * 16; i += NTHR) {
            int pos = i >> 4, f = i & 15;
            float inv_freq = (float)pow(10000.0, -(double)f / 16.0);
            float s, c; sincosf((float)pos * inv_freq, &s, &c);
            p.ropec()[i] = c; p.ropes()[i] = s;
        }
    }
    __syncthreads();
}

__device__ __forceinline__ void tr_tile(const float* src, int ldsrc, int k0, int n0, bf16_t* dst, int lddst, int mode  , bf16_t* dst2, int tid_l) {
    float* t = (float*)smem;
    __syncthreads();
    for (int i = tid_l; i < 64 * 16; i += NTHR) {
        int r = i >> 4, c4 = (i & 15) * 4;
        float4 v = *(const float4*)(src + (size_t)(k0 + r) * ldsrc + n0 + c4);
        t[r * 65 + c4] = v.x; t[r * 65 + c4 + 1] = v.y; t[r * 65 + c4 + 2] = v.z; t[r * 65 + c4 + 3] = v.w;
    }
    __syncthreads();
    for (int i = tid_l; i < 64 * 16; i += NTHR) {
        int n = i >> 4, k4 = (i & 15) * 4;
        float a = t[(k4 + 0) * 65 + n], b = t[(k4 + 1) * 65 + n], c = t[(k4 + 2) * 65 + n], d = t[(k4 + 3) * 65 + n];
        int nn = n0 + n, row = nn;
        if (mode == 1 || mode == 2) { int ct = nn >> 7; row = ct * 256 + (mode == 2 ? 128 : 0) + (nn & 127); }
        u32x2 w; w.x = cvtpk(a, b); w.y = cvtpk(c, d);
        *(u32x2*)(dst + (size_t)row * lddst + k0 + k4) = w;
        if (mode == 3) {
            float ah = bf2f((bf16_t)(w.x & 0xffff)), bh = bf2f((bf16_t)(w.x >> 16)), ch = bf2f((bf16_t)(w.y & 0xffff)), dh = bf2f((bf16_t)(w.y >> 16));
            u32x2 l; l.x = cvtpk(a - ah, b - bh); l.y = cvtpk(c - ch, d - dh);
            *(u32x2*)(dst2 + (size_t)row * lddst + k0 + k4) = l;
        }
    }
}
constexpr int CV_STATIC = 16 * 48 + 16 * 16 + 16, CV_E13 = 65 * 2 * 16 * 4, CV_E2 = 65 * 4 * 16, CV_TOTAL = CV_STATIC + CV_E13 + CV_E2;
__device__ __forceinline__ void convert_tile(const MK& p, int j, int tid_l) {
    const int n_win = 16 * 48, n_wout = 16 * 16, n_rt = 16;
    if (j < n_win) { tr_tile(p.w_in, 3072, (j / 48) * 64, (j % 48) * 64, p.w_inT(), 1024, 0, nullptr, tid_l); return; } j -= n_win;
    if (j < n_wout) { tr_tile(p.w_out, 1024, (j / 16) * 64, (j % 16) * 64, p.w_outT(), 1024, 0, nullptr, tid_l); return; } j -= n_wout;
    if (j < n_rt) { tr_tile(p.router_w, 64, j * 64, 0, p.routerT(), 1024, 3, p.routerT() + 64 * 1024, tid_l); return; } j -= n_rt;
    if (j < CV_E13) {
        int e = j / 128, r = j % 128, which = r / 64, tt = r % 64;
        const float* src = e < 64 ? (which ? p.ew3 : p.ew1) + (size_t)e * D * DE : (which ? p.sw3 : p.sw1);
        tr_tile(src, DE, (tt / 4) * 64, (tt % 4) * 64, p.W13t() + (size_t)e * 512 * 1024, 1024, 1 + which, nullptr, tid_l); return; } j -= CV_E13;
    { int e = j / 64, tt = j % 64;
      const float* src = e < 64 ? p.ew2 + (size_t)e * DE * D : p.sw2;
      tr_tile(src, D, (tt / 16) * 64, (tt % 16) * 64, p.W2t() + (size_t)e * 1024 * 256, 256, 0, nullptr, tid_l); }
}
__device__ __forceinline__ void ph_convert(const MK& p, int bid, int nb, int tid_l) {
    for (int it = bid; it < CV_STATIC; it += nb) convert_tile(p, it, tid_l);
    __syncthreads();
}
template <int LDSRC> __device__ __forceinline__ void tr_wave(const float* __restrict__ src, int k0, int n0, bf16_t* __restrict__ dst, int lddst, int mode, int lane, char* tb) {
    const int n4 = lane & 15, kg = lane >> 4;
    const float* s0 = src + (size_t)(k0 + kg * 16) * LDSRC + n0 + n4 * 4;
    f32x4 v[16];
#pragma unroll
    for (int it = 0; it < 16; ++it) v[it] = *(const f32x4*)(s0 + (size_t)it * LDSRC);
#pragma unroll
    for (int jn = 0; jn < 4; ++jn) {
        const int n = n4 * 4 + jn;
#pragma unroll
        for (int h = 0; h < 2; ++h) {
            const u32x4 w = {cvtpk(v[h * 8][jn], v[h * 8 + 1][jn]), cvtpk(v[h * 8 + 2][jn], v[h * 8 + 3][jn]), cvtpk(v[h * 8 + 4][jn], v[h * 8 + 5][jn]), cvtpk(v[h * 8 + 6][jn], v[h * 8 + 7][jn])};
            *(u32x4*)(tb + n * 128 + (((kg * 2 + h) ^ (n4 & 7)) << 4)) = w;
        }
    }
    asm volatile("s_waitcnt lgkmcnt(0)" ::: "memory");
#pragma unroll
    for (int it = 0; it < 8; ++it) {
        const int n = it * 8 + (lane >> 3), c = lane & 7;
        const u32x4 w = *(const u32x4*)(tb + n * 128 + ((c ^ ((n >> 2) & 7)) << 4));
        const int nn = n0 + n; int row = nn;
        if (mode == 1 || mode == 2) { const int ct = nn >> 7; row = ct * 256 + (mode == 2 ? 128 : 0) + (nn & 127); }
        *(u32x4*)(dst + (size_t)row * lddst + k0 + c * 8) = w;
    }
}
__device__ __forceinline__ void convert_tile_wave(const MK& p, int j, int lane, char* tb) {
    if (j < CV_E13) {
        const int e = j / 128, r = j % 128, which = r / 64, tt = r % 64;
        const float* src = e < 64 ? (which ? p.ew3 : p.ew1) + (size_t)e * D * DE : (which ? p.sw3 : p.sw1);
        tr_wave<DE>(src, (tt / 4) * 64, (tt % 4) * 64, p.W13t() + (size_t)e * 512 * 1024, 1024, 1 + which, lane, tb); return; }
    j -= CV_E13;
    { const int e = j / 64, tt = j % 64;
      const float* src = e < 64 ? p.ew2 + (size_t)e * DE * D : p.sw2;
      tr_wave<D>(src, (tt / 16) * 64, (tt % 16) * 64, p.W2t() + (size_t)e * 1024 * 256, 256, 0, lane, tb); }
}
__device__ __forceinline__ void ph_convert_dyn(const MK& p, int tid_l) {
    const int lane = tid_l & 63;
    char* tb = smem + (tid_l >> 6) * 8192;
    __syncthreads();
    for (;;) {
        int j = 0;
        if (lane == 0) j = atomicAdd(&p.cnt()[200], 8);
        j = __builtin_amdgcn_readfirstlane(j);
        if (j >= CV_E13 + CV_E2) break;
#pragma unroll 1
        for (int k = 0; k < 8; ++k) if (j + k < CV_E13 + CV_E2) convert_tile_wave(p, j + k, lane, tb);
    }
}

__device__ __forceinline__ void ph_ln1(const MK& p, int bid, int nb, int tid_l) {
    const int wid = tid_l >> 6, lane = tid_l & 63;
    for (int R = bid * 8 + wid; R < NR; R += nb * 8) {
        int b = R / RB, i = R % RB;
        const float* src = i < CTX ? p.ctx + ((size_t)b * CTX + i) * D : p.x + ((size_t)b * SEQ + (i - CTX)) * D;
        const float* m = p.mod() + (size_t)(i < CTX ? 4 : b) * 6 * D;
        float4 v[4]; float ss = 0;
#pragma unroll
        for (int q = 0; q < 4; ++q) { v[q] = *(const float4*)(src + q * 256 + lane * 4); ss += v[q].x * v[q].x + v[q].y * v[q].y + v[q].z * v[q].z + v[q].w * v[q].w; }
        ss = wave_sum(ss);
        float rstd = rsqrtf(ss * (1.0f / D) + EPS);
#pragma unroll
        for (int q = 0; q < 4; ++q) {
            int c0 = q * 256 + lane * 4;
            float4 gg = *(const float4*)(p.norm1_g + c0), sh = *(const float4*)(m + c0), sc = *(const float4*)(m + D + c0);
            float o0 = v[q].x * rstd * gg.x * (1 + sc.x) + sh.x, o1 = v[q].y * rstd * gg.y * (1 + sc.y) + sh.y;
            float o2 = v[q].z * rstd * gg.z * (1 + sc.z) + sh.z, o3 = v[q].w * rstd * gg.w * (1 + sc.w) + sh.w;
            u32x2 w; w.x = cvtpk(o0, o1); w.y = cvtpk(o2, o3);
            *(u32x2*)(p.H() + (size_t)R * D + c0) = w;
        }
    }
}

__device__ __forceinline__ int lds_byte(int r, int c) { int st = (r >> 4) * 2 + (c >> 5), ob = (r & 15) * 64 + (c & 31) * 2; return st * 1024 + (ob ^ (((ob >> 9) & 1) << 5)); }
__device__ __forceinline__ void stage_rc(int b, int& R, int& C) { int st = b >> 10, sb = b & 1023, swz = sb ^ (((sb >> 9) & 1) << 5); R = (st / 2) * 16 + swz / 64; C = (st % 2) * 32 + (swz % 64) / 2; }
#define WAIT_V0() asm volatile("s_waitcnt vmcnt(0)" ::: "memory")
__device__ __forceinline__ void gemm_core(const char* Abase, const unsigned (&Ao)[4], const char* Bbase, const unsigned (&Bo)[4], int nt, f32x4 (&acc)[8][4], int tid_l, bool pre) {
    const int tid = tid_l, wid = tid >> 6, lane = tid & 63, wr = wid >> 2, wc = wid & 3, fr = lane & 15, fq = lane >> 4;
#pragma unroll
    for (int m = 0; m < 8; ++m)
#pragma unroll
        for (int n = 0; n < 4; ++n) acc[m][n] = (f32x4){0.f, 0.f, 0.f, 0.f};
#define G_SA(b) (smem + (b) * 32768)
#define G_SB(b) (smem + 65536 + (b) * 32768)
#define G_STAGE(buf, kt) do { _Pragma("unroll") for (int i = 0; i < 4; ++i) {                                                     \
        __builtin_amdgcn_global_load_lds((const unsigned*)(Abase + (Ao[i] + (unsigned)(kt) * 128u)), (unsigned*)(G_SA(buf) + wid * 1024 + i * 8192), 16, 0, 0); \
        __builtin_amdgcn_global_load_lds((const unsigned*)(Bbase + (Bo[i] + (unsigned)(kt) * 128u)), (unsigned*)(G_SB(buf) + wid * 1024 + i * 8192), 16, 0, 0); } } while (0)
    if (!pre) G_STAGE(0, 0);
    WAIT_V0(); __syncthreads();
#define G_KSTEP(cur, t) do {                                                                                                   \
        if ((t) + 1 < nt) G_STAGE((cur) ^ 1, (t) + 1);                                                                          \
        _Pragma("unroll") for (int ks = 0; ks < 2; ++ks) {                                                                      \
            bf16x8 At[8], Bf[4];                                                                                                \
            _Pragma("unroll") for (int m = 0; m < 8; ++m) At[m] = *(const bf16x8*)(G_SA(cur) + lds_byte(wr * 128 + m * 16 + fr, ks * 32 + fq * 8)); \
            _Pragma("unroll") for (int n = 0; n < 4; ++n) Bf[n] = *(const bf16x8*)(G_SB(cur) + lds_byte(wc * 64 + n * 16 + fr, ks * 32 + fq * 8));  \
            _Pragma("unroll") for (int m = 0; m < 8; ++m) _Pragma("unroll") for (int n = 0; n < 4; ++n)                         \
                acc[m][n] = __builtin_amdgcn_mfma_f32_16x16x32_bf16(Bf[n], At[m], acc[m][n], 0, 0, 0);                          \
            __builtin_amdgcn_sched_barrier(0);                                                                                  \
        }                                                                                                                       \
        WAIT_V0(); __syncthreads(); } while (0)
#pragma unroll 1
    for (int t = 0; t < nt; ++t) { const int cur = t & 1; G_KSTEP(cur, t); }
}
#ifndef XPREFETCH
#define XPREFETCH 0
#endif
__device__ __forceinline__ void gemm_prefetch(const char* Abase, const unsigned (&Ao)[4], const char* Bbase, const unsigned (&Bo)[4], int tid_l) {
    const int wid = tid_l >> 6;
    G_STAGE(0, 0);
}
__device__ __forceinline__ void stage_offs(unsigned ld_bytes, unsigned (&P)[4], int tid_l) {
    const int wid = tid_l >> 6, lane = tid_l & 63;
#pragma unroll
    for (int i = 0; i < 4; ++i) { int R, C; stage_rc(wid * 1024 + i * 8192 + lane * 16, R, C); P[i] = (unsigned)R * ld_bytes + (unsigned)C * 2u; }
}

constexpr int WAREA = 18432;
__device__ __forceinline__ char* wave_area(int wid) { return smem + wid * WAREA; }

constexpr int A_KVBLK = 64;
constexpr float A_SCALE = 0.125f, A_THR = 8.f;
constexpr int A_SHM_V = A_KVBLK * 128 * 2, A_SHM_K = A_KVBLK * 128 * 2;
#define KSWZ(row, colB) ((row) * 256 + ((colB) ^ (((row) & 7) << 4)))
#define SBAR() __builtin_amdgcn_sched_barrier(0)
__device__ __forceinline__ int crow(int r, int hi) { return (r & 3) + 8 * (r >> 2) + 4 * hi; }

constexpr float A_THRL = 11.0f;
template <bool FIRST> __device__ __forceinline__ void partialSM2(f32x16& p0, f32x16& p1, float& mhat, f32x16& negm, float& alpha) {
    float pmax = p0[0];
#pragma unroll
    for (int r = 1; r < 16; ++r) pmax = fmaxf(pmax, p0[r]);
#pragma unroll
    for (int r = 0; r < 16; ++r) pmax = fmaxf(pmax, p1[r]);
    { auto rr = __builtin_amdgcn_permlane32_swap(__float_as_uint(pmax), __float_as_uint(pmax), false, false);
      pmax = fmaxf(__uint_as_float(rr[0]), __uint_as_float(rr[1])); }
    alpha = 1.f;
    if (FIRST || __builtin_expect(__any(pmax > A_THRL), 0)) {
        const float dl = FIRST ? pmax : fmaxf(pmax, 0.f);
        mhat += dl;
#pragma unroll
        for (int r = 0; r < 16; ++r) { p0[r] -= dl; p1[r] -= dl; }
#pragma unroll
        for (int r = 0; r < 16; ++r) negm[r] = -mhat;
        if (!FIRST) alpha = __builtin_amdgcn_exp2f(-dl);
    }
#pragma unroll
    for (int r = 0; r < 16; ++r) p0[r] = __builtin_amdgcn_exp2f(p0[r]);
}
__device__ __forceinline__ void qkt2(f32x16& p0, f32x16& p1, const char* Ks, const bf16x8* qr, const f32x16& negm, int r32, int hi, int mapc) {
#pragma unroll
    for (int d0 = 0; d0 < 4; ++d0) { int cb = (mapc + d0 * 16 + hi * 8) * 2;
        bf16x8 b0 = *reinterpret_cast<const bf16x8*>(Ks + KSWZ(r32, cb));
        bf16x8 b1 = *reinterpret_cast<const bf16x8*>(Ks + KSWZ(32 + r32, cb));
        if (d0 == 0) { p0 = __builtin_amdgcn_mfma_f32_32x32x16_bf16(b0, qr[0], negm, 0, 0, 0); p1 = __builtin_amdgcn_mfma_f32_32x32x16_bf16(b1, qr[0], negm, 0, 0, 0); }
        else { p0 = __builtin_amdgcn_mfma_f32_32x32x16_bf16(b0, qr[d0], p0, 0, 0, 0); p1 = __builtin_amdgcn_mfma_f32_32x32x16_bf16(b1, qr[d0], p1, 0, 0, 0); } }
}
template <int PROBE = 0> __device__ __forceinline__ void partialSM(f32x16& p0, f32x16& p1, float& m_reg, float& mn, float& alpha) {
    constexpr float C = A_SCALE * 1.4426950408889634f;
    float pmax = p0[0];
#pragma unroll
    for (int r = 1; r < 16; ++r) pmax = fmaxf(pmax, p0[r]);
#pragma unroll
    for (int r = 0; r < 16; ++r) pmax = fmaxf(pmax, p1[r]);
    { auto rr = __builtin_amdgcn_permlane32_swap(__float_as_uint(pmax), __float_as_uint(pmax), false, false);
      pmax = fmaxf(__uint_as_float(rr[0]), __uint_as_float(rr[1])); }
    if (__builtin_expect(__all(pmax - m_reg <= A_THR / A_SCALE), 1)) { mn = m_reg; alpha = 1.f; }
    else { mn = fmaxf(m_reg, pmax); alpha = __builtin_amdgcn_exp2f((m_reg - mn) * C); m_reg = mn; }
    float mnC = -mn * C;
#pragma unroll
    for (int r = 0; r < 16; ++r) p0[r] = fmaf(p0[r], C, mnC);
#pragma unroll
    for (int r = 0; r < 16; ++r) p1[r] = fmaf(p1[r], C, mnC);
#pragma unroll
    for (int r = 0; r < 16; ++r) p0[r] = PROBE == 3 ? p0[r] * 1e-3f : __builtin_amdgcn_exp2f(p0[r]);
}
#define PK4(P, BASE, OUT) do { unsigned a0 = cvtpk(P[BASE + 0], P[BASE + 1]), a1 = cvtpk(P[BASE + 2], P[BASE + 3]);   \
    unsigned b0 = cvtpk(P[BASE + 4], P[BASE + 5]), b1 = cvtpk(P[BASE + 6], P[BASE + 7]);                              \
    auto r0 = __builtin_amdgcn_permlane32_swap(a0, b0, false, false); auto r1 = __builtin_amdgcn_permlane32_swap(a1, b1, false, false); \
    u32x4 w = {r0[0], r1[0], r0[1], r1[1]}; OUT = *reinterpret_cast<bf16x8*>(&w); } while (0)
template <int PROBE = 0, bool DIRECT = false> __device__ __forceinline__ void finishSM(f32x16& p0, f32x16& p1, float alpha, float& l_reg, bf16x8& pa0, bf16x8& pa1, bf16x8& pa2, bf16x8& pa3) {
#pragma unroll
    for (int r = 0; r < 16; ++r) p1[r] = PROBE == 3 ? p1[r] * 1e-3f : __builtin_amdgcn_exp2f(p1[r]);
    float ps = 0;
#pragma unroll
    for (int r = 0; r < 16; ++r) ps += p0[r];
#pragma unroll
    for (int r = 0; r < 16; ++r) ps += p1[r];
    { auto rr = __builtin_amdgcn_permlane32_swap(__float_as_uint(ps), __float_as_uint(ps), false, false);
      ps = __uint_as_float(rr[0]) + __uint_as_float(rr[1]); }
    l_reg = l_reg * alpha + ps;
    if (DIRECT) {
#define PKD(P, B, OUT) do { u32x4 w = {cvtpk(P[B], P[B + 1]), cvtpk(P[B + 2], P[B + 3]), cvtpk(P[B + 4], P[B + 5]), cvtpk(P[B + 6], P[B + 7])}; OUT = *reinterpret_cast<bf16x8*>(&w); } while (0)
        PKD(p0, 0, pa0); PKD(p0, 8, pa1); PKD(p1, 0, pa2); PKD(p1, 8, pa3);
#undef PKD
    } else { PK4(p0, 0, pa0); PK4(p0, 8, pa1); PK4(p1, 0, pa2); PK4(p1, 8, pa3); }
}
__device__ __forceinline__ void qkt(f32x16& p0, f32x16& p1, const char* Ks, const bf16x8* qr, int r32, int hi, int mapc) {
    p0 = f32x16{}; p1 = f32x16{};
#pragma unroll
    for (int d0 = 0; d0 < 4; ++d0) { int cb = (mapc + d0 * 16 + hi * 8) * 2;
        bf16x8 b0 = *reinterpret_cast<const bf16x8*>(Ks + KSWZ(r32, cb));
        bf16x8 b1 = *reinterpret_cast<const bf16x8*>(Ks + KSWZ(32 + r32, cb));
        p0 = __builtin_amdgcn_mfma_f32_32x32x16_bf16(b0, qr[d0], p0, 0, 0, 0);
        p1 = __builtin_amdgcn_mfma_f32_32x32x16_bf16(b1, qr[d0], p1, 0, 0, 0); }
}
__device__ __forceinline__ int v_st(int k, int c) { const int kk = (k & ~0xC) | ((k & 4) << 1) | ((k & 8) >> 1); return ((kk >> 3) * 4 + (c >> 5)) * 512 + ((kk & 7) * 32 + (c & 31)) * 2; }
__device__ __forceinline__ int v_rd_base(int lane) { return ((lane & 3) << 3) | (((lane >> 2) & 3) << 6) | (((lane >> 4) & 1) << 5) | (((lane >> 5) & 1) << 8); }
constexpr int v_rd_off(int d0, int ks, int half) { return d0 * 512 + ks * 4096 + half * 2048; }
template <int OFF> __device__ __forceinline__ s16x4 tr_read(int vb) {
    s16x4 r; asm volatile("ds_read_b64_tr_b16 %0, %1 offset:%2" : "=&v"(r) : "v"(vb), "i"(OFF) : "memory"); return r;
}
template <int D0> __device__ __forceinline__ void pv_one(f32x16& od, int vb, bf16x8 pa0, bf16x8 pa1, bf16x8 pa2, bf16x8 pa3) {
    const s16x4 l0 = tr_read<v_rd_off(D0, 0, 0)>(vb), h0 = tr_read<v_rd_off(D0, 0, 1)>(vb), l1 = tr_read<v_rd_off(D0, 1, 0)>(vb), h1 = tr_read<v_rd_off(D0, 1, 1)>(vb);
    const s16x4 l2 = tr_read<v_rd_off(D0, 2, 0)>(vb), h2 = tr_read<v_rd_off(D0, 2, 1)>(vb), l3 = tr_read<v_rd_off(D0, 3, 0)>(vb), h3 = tr_read<v_rd_off(D0, 3, 1)>(vb);
    asm volatile("s_waitcnt lgkmcnt(0)" ::: "memory"); SBAR();
#define PKV(L, H) (bf16x8){L[0], L[1], L[2], L[3], H[0], H[1], H[2], H[3]}
    od = __builtin_amdgcn_mfma_f32_32x32x16_bf16(pa0, PKV(l0, h0), od, 0, 0, 0);
    od = __builtin_amdgcn_mfma_f32_32x32x16_bf16(pa1, PKV(l1, h1), od, 0, 0, 0);
    od = __builtin_amdgcn_mfma_f32_32x32x16_bf16(pa2, PKV(l2, h2), od, 0, 0, 0);
    od = __builtin_amdgcn_mfma_f32_32x32x16_bf16(pa3, PKV(l3, h3), od, 0, 0, 0);
}
template <int D0> __device__ __forceinline__ void pv_two(f32x16& oa, f32x16& ob, int vb, bf16x8 pa0, bf16x8 pa1, bf16x8 pa2, bf16x8 pa3) {
    const s16x4 l0 = tr_read<v_rd_off(D0, 0, 0)>(vb), h0 = tr_read<v_rd_off(D0, 0, 1)>(vb), l1 = tr_read<v_rd_off(D0, 1, 0)>(vb), h1 = tr_read<v_rd_off(D0, 1, 1)>(vb);
    const s16x4 l2 = tr_read<v_rd_off(D0, 2, 0)>(vb), h2 = tr_read<v_rd_off(D0, 2, 1)>(vb), l3 = tr_read<v_rd_off(D0, 3, 0)>(vb), h3 = tr_read<v_rd_off(D0, 3, 1)>(vb);
    const s16x4 m0 = tr_read<v_rd_off(D0 + 1, 0, 0)>(vb), g0 = tr_read<v_rd_off(D0 + 1, 0, 1)>(vb), m1 = tr_read<v_rd_off(D0 + 1, 1, 0)>(vb), g1 = tr_read<v_rd_off(D0 + 1, 1, 1)>(vb);
    const s16x4 m2 = tr_read<v_rd_off(D0 + 1, 2, 0)>(vb), g2 = tr_read<v_rd_off(D0 + 1, 2, 1)>(vb), m3 = tr_read<v_rd_off(D0 + 1, 3, 0)>(vb), g3 = tr_read<v_rd_off(D0 + 1, 3, 1)>(vb);
    asm volatile("s_waitcnt lgkmcnt(0)" ::: "memory"); SBAR();
    oa = __builtin_amdgcn_mfma_f32_32x32x16_bf16(pa0, PKV(l0, h0), oa, 0, 0, 0);
    ob = __builtin_amdgcn_mfma_f32_32x32x16_bf16(pa0, PKV(m0, g0), ob, 0, 0, 0);
    oa = __builtin_amdgcn_mfma_f32_32x32x16_bf16(pa1, PKV(l1, h1), oa, 0, 0, 0);
    ob = __builtin_amdgcn_mfma_f32_32x32x16_bf16(pa1, PKV(m1, g1), ob, 0, 0, 0);
    oa = __builtin_amdgcn_mfma_f32_32x32x16_bf16(pa2, PKV(l2, h2), oa, 0, 0, 0);
    ob = __builtin_amdgcn_mfma_f32_32x32x16_bf16(pa2, PKV(m2, g2), ob, 0, 0, 0);
    oa = __builtin_amdgcn_mfma_f32_32x32x16_bf16(pa3, PKV(l3, h3), oa, 0, 0, 0);
    ob = __builtin_amdgcn_mfma_f32_32x32x16_bf16(pa3, PKV(m3, g3), ob, 0, 0, 0);
}
__device__ __forceinline__ void pv_d0(f32x16* o, int vb, bf16x8 pa0, bf16x8 pa1, bf16x8 pa2, bf16x8 pa3) {
    pv_one<0>(o[0], vb, pa0, pa1, pa2, pa3); pv_one<1>(o[1], vb, pa0, pa1, pa2, pa3); pv_one<2>(o[2], vb, pa0, pa1, pa2, pa3); pv_one<3>(o[3], vb, pa0, pa1, pa2, pa3);
}

template <int PROBE> __device__ __forceinline__ void attn_item(const bf16_t* __restrict__ Qb, const bf16_t* __restrict__ Kh, const bf16_t* __restrict__ Vh, bf16_t* __restrict__ mixrow,
                                          const float* __restrict__ gd, float lam, int tid_l) {
    char* lds = smem;
    const int tid = tid_l, wid = tid >> 6, lane = tid & 63, r32 = lane & 31, hi = lane >> 5;
    const int map = wid >> 2, wq = wid & 3, mapc = map * 64;
    char* K_lds = lds; char* V_lds = lds + 4 * A_SHM_K;
    float* wsw = (float*)(lds + 4 * A_SHM_V + 4 * A_SHM_K) + wid * 64; float* li_l = wsw; float* al_l = wsw + 32;
    float m_reg = 0.f, l_reg = 0; f32x16 o[4] = {}; bf16x8 qr[4]; f32x16 negm = f32x16{};
    const bf16_t* Qw = Qb + (long)(wq * 32 + r32) * 128 + mapc + hi * 8;
#pragma unroll
    for (int d0 = 0; d0 < 4; ++d0) qr[d0] = *reinterpret_cast<const bf16x8*>(Qw + d0 * 16);
    const int vb0 = (int)(uintptr_t)V_lds + v_rd_base(lane);
    unsigned kofs[2], vofs[2];
    const int widu = __builtin_amdgcn_readfirstlane(wid);
#pragma unroll
    for (int i = 0; i < 2; ++i) {
        const int x = wid * 1024 + i * 8192 + lane * 16;
        { const int row = x >> 8, cs = x & 255, colB = cs ^ ((row & 7) << 4); kofs[i] = (unsigned)(row * 256 + colB); }
        { const int sub = x >> 9, wn = x & 511, k = (sub >> 2) * 8 + (wn >> 6), c = (sub & 3) * 32 + ((wn & 63) >> 1); vofs[i] = (unsigned)(k * 256 + c * 2); }
    }
#define DMA_TILE(slot, k0) do { const char* kt_ = (const char*)Kh + (size_t)(k0) * 256; const char* vt_ = (const char*)Vh + (size_t)(k0) * 256;                  \
      _Pragma("unroll") for (int i = 0; i < 2; ++i) {                                                                   \
        __builtin_amdgcn_global_load_lds((const unsigned*)(kt_ + kofs[i]), (unsigned*)(K_lds + (slot) * A_SHM_K + widu * 1024 + i * 8192), 16, 0, 0); \
        __builtin_amdgcn_global_load_lds((const unsigned*)(vt_ + vofs[i]), (unsigned*)(V_lds + (slot) * A_SHM_V + widu * 1024 + i * 8192), 16, 0, 0); } } while (0)
#define RESC(a) do { if (__any((a) < 1.f)) { if (hi == 0) al_l[r32] = (a); asm volatile("s_waitcnt lgkmcnt(0)" ::: "memory"); \
    _Pragma("unroll") for (int d = 0; d < 4; ++d) _Pragma("unroll") for (int r = 0; r < 16; ++r) o[d][r] *= al_l[crow(r, hi)]; } } while (0)
    f32x16 pA0, pA1, pB0, pB1; float mnA, mnB, alA, alB; bf16x8 pa0, pa1, pa2, pa3; const int NT = RB / A_KVBLK;
    DMA_TILE(0, 0); DMA_TILE(1, A_KVBLK);
    asm volatile("s_waitcnt vmcnt(0)" ::: "memory"); __syncthreads();
    qkt2(pA0, pA1, K_lds, qr, negm, r32, hi, mapc); partialSM2<true>(pA0, pA1, m_reg, negm, alA);
#define ATILE(X0, X1, ALX, Y0, Y1, ALY, CS, PS, NS, T_, DODMA) do {                                                                  \
        asm volatile("s_waitcnt vmcnt(0)" ::: "memory"); __syncthreads();                                                            \
        if (DODMA && PROBE != 1) DMA_TILE(NS, ((T_) + 1) * A_KVBLK);                                                                 \
        SBAR(); qkt2(X0, X1, K_lds + (CS) * A_SHM_K, qr, negm, r32, hi, mapc);                                                       \
        finishSM<PROBE, true>(Y0, Y1, ALY, l_reg, pa0, pa1, pa2, pa3); SBAR();                                                       \
        pv_d0(o, vb0 + (PS) * A_SHM_V, pa0, pa1, pa2, pa3); partialSM2<false>(X0, X1, m_reg, negm, ALX);                             \
        RESC(ALX); } while (0)
#pragma unroll 1
    for (int j = 1; j + 3 < NT; j += 4) {
        ATILE(pB0, pB1, alB, pA0, pA1, alA, 1, 0, 2, j, true);
        ATILE(pA0, pA1, alA, pB0, pB1, alB, 2, 1, 3, j + 1, true);
        ATILE(pB0, pB1, alB, pA0, pA1, alA, 3, 2, 0, j + 2, true);
        ATILE(pA0, pA1, alA, pB0, pB1, alB, 0, 3, 1, j + 3, true);
    }
    ATILE(pB0, pB1, alB, pA0, pA1, alA, 1, 0, 2, NT - 3, true);
    ATILE(pA0, pA1, alA, pB0, pB1, alB, 2, 1, 3, NT - 2, true);
    ATILE(pB0, pB1, alB, pA0, pA1, alA, 3, 2, 0, NT - 1, false);
    finishSM<PROBE, true>(pB0, pB1, alB, l_reg, pa0, pa1, pa2, pa3); SBAR();
    pv_d0(o, vb0 + 3 * A_SHM_V, pa0, pa1, pa2, pa3);
#undef ATILE
#undef DMA_TILE
    if (hi == 0) li_l[r32] = l_reg;
    asm volatile("s_waitcnt lgkmcnt(0)" ::: "memory");
    float rl[16];
#pragma unroll
    for (int r = 0; r < 16; ++r) rl[r] = __builtin_amdgcn_rcpf(li_l[crow(r, hi)]);
    __syncthreads();
    {
        float* xo = (float*)lds + map * 16384 + (wq * 32) * 128 + r32;
#pragma unroll
        for (int r = 0; r < 16; ++r)
#pragma unroll
            for (int d0 = 0; d0 < 4; ++d0) xo[crow(r, hi) * 128 + d0 * 32] = o[d0][r] * rl[r];
    }
    __syncthreads();
    {
        int l2 = lane; asm volatile("" : "+v"(l2));
        const float g0 = gd[l2 * 2], g1 = gd[l2 * 2 + 1];
#pragma unroll 4
        for (int rr = 0; rr < 16; ++rr) {
            const int row = wid * 16 + rr;
            const float2 a0 = *(const float2*)((const float*)lds + row * 128 + l2 * 2), a1 = *(const float2*)((const float*)lds + 16384 + row * 128 + l2 * 2);
            const float xv = a0.x - lam * a1.x, yv = a0.y - lam * a1.y;
            const float ss = wave_sum(xv * xv + yv * yv);
            const float rs = rsqrtf(ss * (1.0f / 128) + EPS) * 0.8f;
            *(unsigned*)(mixrow + (long)row * 1024 + l2 * 2) = cvtpk(xv * rs * g0, yv * rs * g1);
        }
    }
    __syncthreads();
#undef RESC
}


template <int PROBE> __device__ __forceinline__ void ph_attn(const MK& p, int bid, int nb, int tid_l) {
    const int lane = tid_l & 63;
    float s1 = wave_sum(p.lq1[lane] * p.lk1[lane]), s2 = wave_sum(p.lq2[lane] * p.lk2[lane]);
    const float lam = expf(s1) - expf(s2) + 0.2f;
    const int nrounds = (1024 + nb - 1) / nb;
    for (int rr = 0; rr < nrounds; ++rr) {
        int item;
        if (nb == 256) { int x = bid & 7, j = bid >> 3, hh = rr * 8 + x; item = (hh >> 1) * 64 + (hh & 1) * 32 + j; }
        else { item = rr * nb + bid; if (item >= 1024) break; }
        const int bh = item >> 6, qb = item & 63, b = bh >> 2, h = bh & 3;
        attn_item<PROBE>(p.Q() + ((size_t)bh * SEQ + qb * 128) * 128, p.K() + (size_t)bh * RB * 128, p.V() + (size_t)bh * RB * 128,
                  PROBE ? (bf16_t*)(p.ws + 492 * MiB) + h * 128 : p.MIX() + ((size_t)(b * SEQ + qb * 128)) * 1024 + h * 128, p.dattn_g, lam, tid_l);
    }
}


__device__ __forceinline__ bf16x8 ldfrag(const bf16_t* p) { return *reinterpret_cast<const bf16x8*>(p); }

__device__ __forceinline__ void ph_kv(const MK& p, int bid, int nb, int tid_l) {
    const int wid = tid_l >> 6, lane = tid_l & 63, r32 = lane & 31, hi = lane >> 5;
    const int nitems = 16 * 2 * 66;
    for (int it = bid * 8 + wid; it < nitems; it += nb * 8) {
        const int c = it % 66, chain = it / 66, dir = chain & 1, bh = chain >> 1;
        const bf16_t* vt = p.VT() + (size_t)bh * 128 * RB + c * 128 + hi * 8;
        const bf16_t* kt = (dir ? p.KTb() : p.KTf()) + (size_t)bh * 64 * RB + c * 128 + hi * 8;
        f32x16 acc[4][2];
#pragma unroll
        for (int mt = 0; mt < 4; ++mt) { acc[mt][0] = f32x16{}; acc[mt][1] = f32x16{}; }
#pragma unroll 2
        for (int ks = 0; ks < 8; ++ks) {
            bf16x8 a[4], b[2];
#pragma unroll
            for (int mt = 0; mt < 4; ++mt) a[mt] = ldfrag(vt + (size_t)(mt * 32 + r32) * RB + ks * 16);
#pragma unroll
            for (int nt = 0; nt < 2; ++nt) b[nt] = ldfrag(kt + (size_t)(nt * 32 + r32) * RB + ks * 16);
#pragma unroll
            for (int mt = 0; mt < 4; ++mt)
#pragma unroll
                for (int nt = 0; nt < 2; ++nt) acc[mt][nt] = __builtin_amdgcn_mfma_f32_32x32x16_bf16(a[mt], b[nt], acc[mt][nt], 0, 0, 0);
        }
        bf16_t* dst = p.KV() + (size_t)it * 8192;
#pragma unroll
        for (int mt = 0; mt < 4; ++mt)
#pragma unroll
            for (int nt = 0; nt < 2; ++nt)
#pragma unroll
                for (int r = 0; r < 16; ++r) dst[(mt * 32 + crow(r, hi)) * 64 + nt * 32 + r32] = f2bf(acc[mt][nt][r]);
    }
}

__device__ __forceinline__ void ph_scan(const MK& p, int bid, int nb, int tid_l) {
    for (int e = bid * NTHR + tid_l; e < 32 * 8192; e += nb * NTHR) {
        const int chain = e >> 13, el = e & 8191, dir = chain & 1, bh = chain >> 1, h = bh & 3;
        const float d = dir ? p.dec_b[h] : p.dec_f[h];
        const float g128 = exp2f(128.0f * log2f(1.0f / (1.0f + expf(-d))));
        const bf16_t* kv = p.KV() + (size_t)chain * 66 * 8192 + el;
        bf16_t* st = p.ST() + (size_t)chain * 66 * 8192 + el;
        float S = 0.f;
        for (int n = 0; n < 66; ++n) {
            const int c = dir == 0 ? n : (n == 0 ? 1 : (n == 1 ? 0 : 67 - n));
            st[(size_t)c * 8192] = f2bf(S);
            S = fmaf(g128, S, bf2f(kv[(size_t)c * 8192]));
        }
    }
}

__device__ __forceinline__ void ph_ret(const MK& p, int bid, int nb, int tid_l) {
    const int tid = tid_l, wid = tid >> 6, lane = tid & 63, r32 = lane & 31, hi = lane >> 5, wq = wid & 3, half = wid >> 2;
    float* img = (float*)smem;
    for (int it = bid; it < 4 * 64 * 2; it += nb) {
        const int hp = it & 1, lc = (it >> 1) & 63, b = it >> 7, h = hp * 2 + half, bh = b * 4 + h;
        const int ib = CTX + lc * 128, c = 2 + lc;
        const float lf = log2f(1.0f / (1.0f + expf(-p.dec_f[h]))), lb = log2f(1.0f / (1.0f + expf(-p.dec_b[h])));
        const bf16_t* rq = p.RQ() + ((size_t)bh * RB + ib + wq * 32 + r32) * 64 + hi * 8;
        bf16x8 q[4];
#pragma unroll
        for (int ks = 0; ks < 4; ++ks) q[ks] = ldfrag(rq + ks * 16);
        f32x16 o[4];
        {
            const bf16_t* stf = p.ST() + ((size_t)(bh * 2 + 0) * 66 + c) * 8192 + hi * 8;
            const bf16_t* stb = p.ST() + ((size_t)(bh * 2 + 1) * 66 + c) * 8192 + hi * 8;
            {
                float rf[16];
#pragma unroll
                for (int r = 0; r < 16; ++r) rf[r] = __builtin_amdgcn_exp2f((float)(wq * 32 + crow(r, hi) + 1) * lf);
#pragma unroll
                for (int d0 = 0; d0 < 4; ++d0) {
                    f32x16 tf = f32x16{};
#pragma unroll
                    for (int ks = 0; ks < 4; ++ks) tf = __builtin_amdgcn_mfma_f32_32x32x16_bf16(q[ks], ldfrag(stf + (size_t)(d0 * 32 + r32) * 64 + ks * 16), tf, 0, 0, 0);
#pragma unroll
                    for (int r = 0; r < 16; ++r) o[d0][r] = tf[r] * rf[r];
                    asm volatile("" ::: "memory");
                }
            }
            {
                float rf[16];
#pragma unroll
                for (int r = 0; r < 16; ++r) rf[r] = __builtin_amdgcn_exp2f((float)(128 - (wq * 32 + crow(r, hi))) * lb);
#pragma unroll
                for (int d0 = 0; d0 < 4; ++d0) {
                    f32x16 tb = f32x16{};
#pragma unroll
                    for (int ks = 0; ks < 4; ++ks) tb = __builtin_amdgcn_mfma_f32_32x32x16_bf16(q[ks], ldfrag(stb + (size_t)(d0 * 32 + r32) * 64 + ks * 16), tb, 0, 0, 0);
#pragma unroll
                    for (int r = 0; r < 16; ++r) o[d0][r] += tb[r] * rf[r];
                    asm volatile("" ::: "memory");
                }
            }
        }
        {
            const int qi = wq * 32 + r32;
            const bf16_t* vt = p.VT() + (size_t)bh * 128 * RB + ib + hi * 8;
#pragma unroll 1
            for (int jb = 0; jb < 4; ++jb) {
                asm volatile("" ::: "memory");
                const bf16_t* rk = p.RK() + ((size_t)bh * RB + ib + jb * 32 + r32) * 64 + hi * 8;
                f32x16 pp = f32x16{};
#pragma unroll
                for (int ks = 0; ks < 4; ++ks) pp = __builtin_amdgcn_mfma_f32_32x32x16_bf16(ldfrag(rk + ks * 16), q[ks], pp, 0, 0, 0);
#pragma unroll
                for (int r = 0; r < 16; ++r) {
                    const int dd = qi - (jb * 32 + crow(r, hi));
                    const float ex = __builtin_amdgcn_exp2f(dd > 0 ? (float)dd * lf : (float)(-dd) * lb); const float w = dd == 0 ? 2.0f : ex;
                    pp[r] *= w;
                }
                bf16x8 pa0, pa1;
                PK4(pp, 0, pa0); PK4(pp, 8, pa1);
#pragma unroll
                for (int d0 = 0; d0 < 4; ++d0) {
                    o[d0] = __builtin_amdgcn_mfma_f32_32x32x16_bf16(pa0, ldfrag(vt + (size_t)(d0 * 32 + r32) * RB + jb * 32), o[d0], 0, 0, 0);
                    o[d0] = __builtin_amdgcn_mfma_f32_32x32x16_bf16(pa1, ldfrag(vt + (size_t)(d0 * 32 + r32) * RB + jb * 32 + 16), o[d0], 0, 0, 0);
                }
            }
        }
        __syncthreads();
        {
            float* xo = img + half * 16384 + (wq * 32) * 128 + r32;
#pragma unroll
            for (int r = 0; r < 16; ++r)
#pragma unroll
                for (int d0 = 0; d0 < 4; ++d0) xo[crow(r, hi) * 128 + d0 * 32] = o[d0][r];
        }
        __syncthreads();
        {
            const float g0 = p.ret_g[lane * 2], g1 = p.ret_g[lane * 2 + 1];
#pragma unroll 4
            for (int rr = 0; rr < 32; ++rr) {
                const int row = wid * 32 + rr, itl = row >> 7, rw = row & 127, hh = hp * 2 + itl;
                const float2 a = *(const float2*)(img + row * 128 + lane * 2);
                const float ss = wave_sum(a.x * a.x + a.y * a.y);
                const float rs = rsqrtf(ss * (1.0f / 128) + EPS);
                const size_t tt = (size_t)b * SEQ + lc * 128 + rw;
                const unsigned gg = *(const unsigned*)(p.RG() + tt * 512 + hh * 128 + lane * 2);
                const float ga = bf2f((bf16_t)(gg & 0xffff)), gb = bf2f((bf16_t)(gg >> 16));
                *(unsigned*)(p.MIX() + tt * 1024 + 512 + hh * 128 + lane * 2) = cvtpk(silu_fast(ga) * a.x * rs * g0, silu_fast(gb) * a.y * rs * g1);
            }
        }
    }
}


namespace pg8 {
constexpr int BM = 256, BK = 64, HALF = 128, HTB = HALF * BK * 2;
__device__ __forceinline__ int perm32(int rho) { const int n = rho >> 4, i = rho & 15; return 8 * (i >> 2) + 4 * n + (i & 3); }
struct GUnit { const char* A; const char* B; int i0, i1, i2, i3; };
template <class Epi, class Sched, bool GATHER, bool ALIGN_EPI>
__device__ __forceinline__ void gemm(int K, const Sched& S, const Epi& E, int tid_l) {
    const int tid = tid_l, wid = __builtin_amdgcn_readfirstlane(tid >> 6), lane = tid & 63, wr = wid >> 2, wc = wid & 3, fr = lane & 15, fq = lane >> 4;
    const int nt = K / BK;
    unsigned voffB[2], vAc[2][2], vAn[2][2];
    const size_t kstep = (size_t)(BK * 2);
    const size_t hstepB = (size_t)HALF * K * 2;
#pragma unroll
    for (int i = 0; i < 2; ++i) { int R, C; stage_rc(tid * 16 + i * 8192, R, C); const int Rb = Epi::PERM ? ((R & ~31) + perm32(R & 31)) : R;
        voffB[i] = (unsigned)(Rb * K + C) * 2u; }
    const unsigned ldsw = (unsigned)wid * 1024u;
    const int aoff = lds_byte(wr * 64 + fr, fq * 8), boff = lds_byte(wc * 32 + fr, fq * 8);
#define PG8_SA(b, h) (((b) * 2 + (h)) * HTB)
#define PG8_SB(b, h) ((4 + (b) * 2 + (h)) * HTB)
#define PG8_STAGE(bufoff, gbase, voff) do { _Pragma("unroll") for (int _i = 0; _i < 2; ++_i) \
        __builtin_amdgcn_global_load_lds((const unsigned*)((const char*)(gbase) + (voff)[_i]), (unsigned*)(smem + (bufoff) + ldsw + _i * 8192), 16, 0, 0); } while (0)
#define PG8_LDA(dst, b, h) do { _Pragma("unroll") for (int m = 0; m < 4; ++m) _Pragma("unroll") for (int k = 0; k < 2; ++k) dst[m][k] = *(const bf16x8*)(smem + PG8_SA(b, h) + aoff + m * 2048 + k * 1024); } while (0)
#define PG8_LDB(dst, b, h) do { _Pragma("unroll") for (int n = 0; n < 2; ++n) _Pragma("unroll") for (int k = 0; k < 2; ++k) dst[n][k] = *(const bf16x8*)(smem + PG8_SB(b, h) + boff + n * 2048 + k * 1024); } while (0)
#define PG8_MMA(ai, bj, At, Bt) do { __builtin_amdgcn_s_setprio(1); _Pragma("unroll") for (int m = 0; m < 4; ++m) _Pragma("unroll") for (int n = 0; n < 2; ++n) _Pragma("unroll") for (int k = 0; k < 2; ++k) \
        acc[ai][bj][m][n] = __builtin_amdgcn_mfma_f32_16x16x32_bf16(Bt[n][k], At[m][k], acc[ai][bj][m][n], 0, 0, 0); __builtin_amdgcn_s_setprio(0); } while (0)
#define PG8_WAIT_V(n) asm volatile("s_waitcnt vmcnt(" #n ")" ::: "memory")
#define PG8_WAIT_L(n) asm volatile("s_waitcnt lgkmcnt(" #n ")" ::: "memory")
#define PG8_BAR __builtin_amdgcn_s_barrier()
#define PG8_SCHED __builtin_amdgcn_sched_barrier(0)
    GUnit cur, nxt; int ui = 0;
    if (!S.next(0, cur, vAc)) return;
    f32x4 acc[2][2][4][2];
#pragma unroll
    for (int a = 0; a < 2; ++a)
#pragma unroll
        for (int b = 0; b < 2; ++b)
#pragma unroll
            for (int m = 0; m < 4; ++m)
#pragma unroll
                for (int n = 0; n < 2; ++n) acc[a][b][m][n] = (f32x4){0.f, 0.f, 0.f, 0.f};
    bf16x8 At[4][2], B0[2][2], B1[2][2];
    const char* cA = cur.A; const char* cB = cur.B;
    PG8_STAGE(PG8_SB(0, 0), cB, voffB); PG8_STAGE(PG8_SB(0, 1), cB + hstepB, voffB); PG8_STAGE(PG8_SA(0, 0), cA, vAc[0]); PG8_STAGE(PG8_SA(0, 1), cA, vAc[1]);
    if (wr == 1) PG8_BAR;
    PG8_WAIT_V(2); PG8_BAR;
    PG8_STAGE(PG8_SB(1, 0), cB + kstep, voffB); PG8_STAGE(PG8_SA(1, 0), cA + kstep, vAc[0]); PG8_STAGE(PG8_SB(1, 1), cB + hstepB + kstep, voffB);
    PG8_WAIT_V(6); PG8_BAR;
    for (;;) {
        const bool has_next = S.next(ui + 1, nxt, vAn);
        if (!GATHER || !has_next) {
#pragma unroll
            for (int h = 0; h < 2; ++h)
#pragma unroll
                for (int i = 0; i < 2; ++i) vAn[h][i] = vAc[h][i];
        }
        const char* nA = has_next ? nxt.A : cA; const char* nB = has_next ? nxt.B : cB;
#pragma unroll 1
        for (int t = 0; t < nt; t += 2) {
            const bool last = (t == nt - 2);
            const char* a1 = cA + (size_t)(t + 1) * kstep;
            const char* a2 = last ? nA : cA + (size_t)(t + 2) * kstep; const char* b2 = last ? nB : cB + (size_t)(t + 2) * kstep;
            const char* a3 = a2 + kstep; const char* b3 = b2 + kstep;
            unsigned va2[2][2];
#pragma unroll
            for (int h = 0; h < 2; ++h)
#pragma unroll
                for (int i = 0; i < 2; ++i) va2[h][i] = (GATHER && last) ? vAn[h][i] : vAc[h][i];
            PG8_LDB(B0, 0, 0); PG8_LDB(B1, 0, 1); PG8_SCHED; PG8_LDA(At, 0, 0); PG8_STAGE(PG8_SA(1, 1), a1, vAc[1]);
            PG8_WAIT_V(8); PG8_WAIT_L(0); PG8_BAR; PG8_MMA(0, 0, At, B0); PG8_MMA(0, 1, At, B1); PG8_BAR; PG8_SCHED;
            PG8_LDA(At, 0, 1); PG8_STAGE(PG8_SB(0, 0), b2, voffB); PG8_STAGE(PG8_SB(0, 1), b2 + hstepB, voffB); PG8_STAGE(PG8_SA(0, 0), a2, va2[0]);
            PG8_WAIT_V(8); PG8_WAIT_L(0); PG8_BAR; PG8_MMA(1, 0, At, B0); PG8_MMA(1, 1, At, B1); PG8_BAR; PG8_SCHED;
            PG8_LDB(B0, 1, 0); PG8_LDB(B1, 1, 1); PG8_SCHED; PG8_LDA(At, 1, 0); PG8_STAGE(PG8_SA(0, 1), a2, va2[1]);
            PG8_WAIT_V(8); PG8_WAIT_L(0); PG8_BAR; PG8_MMA(0, 0, At, B0); PG8_MMA(0, 1, At, B1); PG8_BAR; PG8_SCHED;
            PG8_LDA(At, 1, 1); PG8_STAGE(PG8_SB(1, 0), b3, voffB); PG8_STAGE(PG8_SB(1, 1), b3 + hstepB, voffB); PG8_STAGE(PG8_SA(1, 0), a3, va2[0]);
            PG8_WAIT_V(8); PG8_WAIT_L(0); PG8_BAR; PG8_MMA(1, 0, At, B0); PG8_MMA(1, 1, At, B1); PG8_BAR; PG8_SCHED;
        }
        if (ALIGN_EPI) { if (wr == 0) PG8_BAR; }
        E(acc, cur, wr, wc, fr, fq);
        if (!has_next) break;
#pragma unroll
        for (int a = 0; a < 2; ++a)
#pragma unroll
            for (int b = 0; b < 2; ++b)
#pragma unroll
                for (int m = 0; m < 4; ++m)
#pragma unroll
                    for (int n = 0; n < 2; ++n) acc[a][b][m][n] = (f32x4){0.f, 0.f, 0.f, 0.f};
        cur = nxt; cA = nA; cB = nB; ++ui;
#pragma unroll
        for (int h = 0; h < 2; ++h)
#pragma unroll
            for (int i = 0; i < 2; ++i) vAc[h][i] = vAn[h][i];
        if (ALIGN_EPI) { if (wr == 1) PG8_BAR; }
    }
    PG8_WAIT_V(0);
    if (!ALIGN_EPI) { if (wr == 0) PG8_BAR; }
    PG8_BAR;
#undef PG8_SA
#undef PG8_SB
#undef PG8_STAGE
#undef PG8_LDA
#undef PG8_LDB
#undef PG8_MMA
#undef PG8_WAIT_V
#undef PG8_WAIT_L
#undef PG8_BAR
#undef PG8_SCHED
}
__device__ __forceinline__ void plain_voffA(int K, unsigned (&vA)[2][2], int tid_l) {
#pragma unroll
    for (int i = 0; i < 2; ++i) { int R, C; stage_rc(tid_l * 16 + i * 8192, R, C); vA[0][i] = (unsigned)(R * K + C) * 2u; vA[1][i] = (unsigned)((R + HALF) * K + C) * 2u; }
}
}


__device__ __forceinline__ int xcd_vbid(int bid, int nb) { return (nb & 7) ? bid : (bid & 7) * (nb >> 3) + (bid >> 3); }
struct SchedIn { const MK* p; int bid, nb, tid_l;
    __device__ __forceinline__ bool next(int i, pg8::GUnit& u, unsigned (&vA)[2][2]) const {
        const int tile = xcd_vbid(bid, nb) + i * nb; if (tile >= (NR / 256) * 12) return false;
        const int pm = tile / 12, pn = tile % 12;
        u.A = (const char*)(p->H() + (size_t)(pm * 256) * D); u.B = (const char*)(p->w_inT() + (size_t)(pn * 256) * D); u.i0 = pm; u.i1 = pn; u.i2 = 0; u.i3 = 0;
        pg8::plain_voffA(D, vA, tid_l); return true; } };
struct EpiIn { static constexpr bool PERM = false; const MK* p;
    __device__ __forceinline__ void operator()(f32x4 (&acc)[2][2][4][2], const pg8::GUnit& u, int wr, int wc, int fr_in, int fq_in) const {
        int fr = fr_in, fq = fq_in; asm volatile("" : "+v"(fr), "+v"(fq));
        const int pm = u.i0, seg = u.i1, brow = pm * 256;
        const int b = brow / RB, i0 = brow % RB;
        const bool lat = i0 >= CTX;
        const int wid = wr * 4 + wc, lane = fq * 16 + fr;
        if (lat && (seg <= 3 || seg == 6 || seg == 7)) {
#pragma unroll
            for (int ai = 0; ai < 2; ++ai)
#pragma unroll
                for (int m = 0; m < 4; ++m) {
                    const int t = i0 + ai * 128 + wr * 64 + m * 16 + fr - CTX, pos = (wc & 1) ? (t & 63) : (t >> 6);
                    const f32x4 cc = *(const f32x4*)(p->ropec() + pos * 16 + fq * 4), ss = *(const f32x4*)(p->ropes() + pos * 16 + fq * 4);
#pragma unroll
                    for (int bj = 0; bj < 2; ++bj) { const f32x4 x1 = acc[ai][bj][m][0], x2 = acc[ai][bj][m][1];
                        acc[ai][bj][m][0] = x1 * cc - x2 * ss; acc[ai][bj][m][1] = x1 * ss + x2 * cc; }
                }
        }
        if (seg == 7 || seg <= 1) {
            const float sc_ = seg == 7 ? 0.125f : 0.125f * 1.4426950408889634f;
#pragma unroll
            for (int ai = 0; ai < 2; ++ai)
#pragma unroll
                for (int bj = 0; bj < 2; ++bj)
#pragma unroll
                    for (int m = 0; m < 4; ++m) { acc[ai][bj][m][0] = acc[ai][bj][m][0] * sc_; acc[ai][bj][m][1] = acc[ai][bj][m][1] * sc_; }
        }
        if (seg <= 7 || seg >= 10) {
#pragma unroll
            for (int bj = 0; bj < 2; ++bj) {
                bf16_t* base; long rstride; bool ok = true;
                if (seg <= 1)      { const int h = (seg & 1) * 2 + bj;       base = p->Q() + (((size_t)(b * 4 + h) * SEQ + (i0 - CTX)) * 128 + wc * 32 + fq * 4); rstride = 128; ok = lat; }
                else if (seg <= 3) { const int h = (seg - 2) * 2 + bj;       base = p->K() + (((size_t)(b * 4 + h) * RB + i0) * 128 + wc * 32 + fq * 4);          rstride = 128; }
                else if (seg <= 5) { const int h = (seg - 4) * 2 + bj;       base = p->V() + (((size_t)(b * 4 + h) * RB + i0) * 128 + wc * 32 + fq * 4);          rstride = 128; }
                else if (seg == 6) { const int h = bj * 2 + (wc >> 1);       base = p->RQ() + (((size_t)(b * 4 + h) * RB + i0) * 64 + (wc & 1) * 32 + fq * 4);    rstride = 64; }
                else if (seg == 7) { const int h = bj * 2 + (wc >> 1);       base = p->RK() + (((size_t)(b * 4 + h) * RB + i0) * 64 + (wc & 1) * 32 + fq * 4);    rstride = 64; }
                else               {                                         base = p->RG() + ((size_t)(b * SEQ + (i0 - CTX)) * 512 + (seg - 10) * 256 + bj * 128 + wc * 32 + fq * 4); rstride = 512; ok = lat; }
                if (ok) {
#pragma unroll
                    for (int ai = 0; ai < 2; ++ai)
#pragma unroll
                        for (int m = 0; m < 4; ++m) { bf16_t* rp = base + (long)(ai * 128 + wr * 64 + m * 16 + fr) * rstride;
#pragma unroll
                            for (int n = 0; n < 2; ++n) { u32x2 w; w.x = cvtpk(acc[ai][bj][m][n][0], acc[ai][bj][m][n][1]); w.y = cvtpk(acc[ai][bj][m][n][2], acc[ai][bj][m][n][3]);
                                *(u32x2*)(rp + n * 16) = w; } }
                }
            }
        }
        if (seg >= 7 && seg <= 9) {
            char* img = smem + 131072 + wid * 3968;
            const int npass = seg == 7 ? 2 : 1;
#pragma unroll 1
            for (int ps = 0; ps < npass; ++ps) {
#pragma unroll
                for (int bj = 0; bj < 2; ++bj) {
                    float lg2 = 0.f; bf16_t* baseT;
                    if (seg == 7) { const int h = bj * 2 + (wc >> 1); const float dv = ps == 0 ? p->dec_f[h] : p->dec_b[h]; lg2 = log2f(1.0f / (1.0f + expf(-dv)));
                        baseT = (ps == 0 ? p->KTf() : p->KTb()) + ((size_t)(b * 4 + h) * 64 + (wc & 1) * 32) * RB + i0; }
                    else { const int h = (seg - 8) * 2 + bj; baseT = p->VT() + ((size_t)(b * 4 + h) * 128 + wc * 32) * RB + i0; }
#pragma unroll
                    for (int ai = 0; ai < 2; ++ai)
#pragma unroll
                        for (int mp = 0; mp < 2; ++mp) {
                            asm volatile("s_waitcnt lgkmcnt(0)" ::: "memory");
#pragma unroll
                            for (int mm = 0; mm < 2; ++mm) { const int m = mp * 2 + mm;
                                float f = 1.0f;
                                if (seg == 7) { const int pos = (i0 + ai * 128 + wr * 64 + m * 16 + fr) & 127; f = __builtin_amdgcn_exp2f((float)(ps == 0 ? 127 - pos : pos) * lg2); }
#pragma unroll
                                for (int n = 0; n < 2; ++n)
#pragma unroll
                                    for (int j = 0; j < 4; ++j) *(bf16_t*)(img + (n * 16 + fq * 4 + j) * 80 + (mm * 16 + fr) * 2) = f2bf(acc[ai][bj][m][n][j] * f); }
                            asm volatile("s_waitcnt lgkmcnt(0)" ::: "memory");
                            const int ib = ai * 128 + wr * 64 + mp * 32;
#pragma unroll
                            for (int k = 0; k < 2; ++k) { const int q = lane + 64 * k, col = q >> 2, ch = q & 3;
                                *(u32x4*)(baseT + (size_t)col * RB + ib + ch * 8) = *(const u32x4*)(img + col * 80 + ch * 16); }
                        }
                }
            }
        }
    } };
__device__ __forceinline__ void ph_gemm_in(const MK& p, int bid, int nb, int tid_l) {
    SchedIn S{&p, bid, nb, tid_l}; EpiIn E{&p};
    pg8::gemm<EpiIn, SchedIn, false, true>(D, S, E, tid_l);
}

struct SchedOut { const MK* p; int bid, nb, tid_l;
    __device__ __forceinline__ bool next(int i, pg8::GUnit& u, unsigned (&vA)[2][2]) const {
        const int tile = xcd_vbid(bid, nb) + i * nb; if (tile >= (T / 256) * 4) return false;
        const int pm = tile >> 2, pn = tile & 3;
        u.A = (const char*)(p->MIX() + (size_t)(pm * 256) * D); u.B = (const char*)(p->w_outT() + (size_t)(pn * 256) * D); u.i0 = pm; u.i1 = pn; u.i2 = 0; u.i3 = 0;
        pg8::plain_voffA(D, vA, tid_l); return true; } };
struct EpiOut { static constexpr bool PERM = true; const MK* p;
    __device__ __forceinline__ void operator()(const f32x4 (&acc)[2][2][4][2], const pg8::GUnit& u, int wr, int wc, int fr, int fq) const {
        const int brow = u.i0 * 256, bcol = u.i1 * 256 + wc * 32 + fq * 8;
        const float* g1 = p->mod() + (size_t)(brow / SEQ) * 6 * D + 2 * D + bcol;
        f32x4 gv[2][2];
#pragma unroll
        for (int bj = 0; bj < 2; ++bj)
#pragma unroll
            for (int n = 0; n < 2; ++n) gv[bj][n] = *(const f32x4*)(g1 + bj * 128 + n * 4);
#pragma unroll
        for (int ai = 0; ai < 2; ++ai)
#pragma unroll
            for (int m = 0; m < 4; ++m) {
                const int row = brow + ai * 128 + wr * 64 + m * 16 + fr;
                const float* xp = p->x + (size_t)row * D + bcol;
                f32x4 xv[2][2];
#pragma unroll
                for (int bj = 0; bj < 2; ++bj)
#pragma unroll
                    for (int n = 0; n < 2; ++n) xv[bj][n] = *(const f32x4*)(xp + bj * 128 + n * 4);
#pragma unroll
                for (int bj = 0; bj < 2; ++bj) {
                    const f32x4 a = xv[bj][0] + gv[bj][0] * acc[ai][bj][m][0], b = xv[bj][1] + gv[bj][1] * acc[ai][bj][m][1];
                    const u32x4 w = {cvtpk(a[0], a[1]), cvtpk(a[2], a[3]), cvtpk(b[0], b[1]), cvtpk(b[2], b[3])};
                    *(u32x4*)(p->X1() + (size_t)row * 2048 + bcol + bj * 128) = w;
                }
                if (m & 1) asm volatile("" ::: "memory");
            }
    } };
__device__ __forceinline__ void ph_gemm_out(const MK& p, int bid, int nb, int tid_l) {
    SchedOut S{&p, bid, nb, tid_l}; EpiOut E{&p};
    pg8::gemm<EpiOut, SchedOut, false, true>(D, S, E, tid_l);
}

template <bool DUMMY, int MODE = 0> __device__ __forceinline__ void ph_route(const MK& p, int bid, int nb, int tid_l) {
    int* cntp = p.cnt() + (DUMMY ? 128 : 0); int* tl = DUMMY ? (int*)(p.ws + 480 * MiB) : p.tok_list(); float* wl_ = DUMMY ? (float*)(p.ws + 488 * MiB) : p.wt_list(); int* tm = DUMMY ? (int*)(p.ws + 496 * MiB) : p.tokmap();
    const int tid = tid_l, wid = tid >> 6, lane = tid & 63, fr = lane & 15, fq = lane >> 4;
    float* lg = (float*)smem;
    int* wcnt = (int*)(smem + 34816);
    int* pref = wcnt + 512;
    bf16_t* H2lo = (bf16_t*)(p.ws + 325 * MiB);
    for (int item = bid; item < T / 128; item += nb) {
        const int t0 = item * 128 + wid * 16, b = (item * 128) / SEQ;
        const float* msh = p.mod() + (size_t)b * 6 * D + 3 * D; const float* msc = p.mod() + (size_t)b * 6 * D + 4 * D;
#pragma unroll 1
        for (int r0 = 0; r0 < 16; r0 += 4) {
            float4 xv[4][4];
#pragma unroll
            for (int rr = 0; rr < 4; ++rr)
#pragma unroll
                for (int q = 0; q < 4; ++q) { const u32x2 w = *(const u32x2*)(p.X1() + (size_t)(t0 + r0 + rr) * 2048 + q * 256 + lane * 4);
                    xv[rr][q] = make_float4(__uint_as_float(w.x << 16), __uint_as_float(w.x & 0xffff0000u), __uint_as_float(w.y << 16), __uint_as_float(w.y & 0xffff0000u)); }
#pragma unroll
            for (int rr = 0; rr < 4; ++rr) {
                float ss = 0.f;
#pragma unroll
                for (int q = 0; q < 4; ++q) ss += xv[rr][q].x * xv[rr][q].x + xv[rr][q].y * xv[rr][q].y + xv[rr][q].z * xv[rr][q].z + xv[rr][q].w * xv[rr][q].w;
                ss = wave_sum(ss);
                const float rstd = rsqrtf(ss * (1.0f / D) + EPS);
#pragma unroll
                for (int q = 0; q < 4; ++q) {
                    const int c0 = q * 256 + lane * 4;
                    const float4 gg = *(const float4*)(p.norm2_g + c0), sh = *(const float4*)(msh + c0), sc = *(const float4*)(msc + c0);
                    const float h0 = xv[rr][q].x * rstd * gg.x * (1 + sc.x) + sh.x, h1 = xv[rr][q].y * rstd * gg.y * (1 + sc.y) + sh.y;
                    const float h2v = xv[rr][q].z * rstd * gg.z * (1 + sc.z) + sh.z, h3 = xv[rr][q].w * rstd * gg.w * (1 + sc.w) + sh.w;
                    u32x2 wh, wl2; wh.x = cvtpk(h0, h1); wh.y = cvtpk(h2v, h3);
                    wl2.x = cvtpk(h0 - __uint_as_float(wh.x << 16), h1 - __uint_as_float(wh.x & 0xffff0000u));
                    wl2.y = cvtpk(h2v - __uint_as_float(wh.y << 16), h3 - __uint_as_float(wh.y & 0xffff0000u));
                    *(u32x2*)(p.H2() + (size_t)(t0 + r0 + rr) * D + c0) = wh;
                    *(u32x2*)(H2lo + (size_t)(t0 + r0 + rr) * D + c0) = wl2;
                }
            }
        }
        asm volatile("s_waitcnt vmcnt(0)" ::: "memory");
        __syncthreads();
        if (MODE == 3) continue;
        f32x4 acc[4];
#pragma unroll
        for (int nt = 0; nt < 4; ++nt) acc[nt] = (f32x4){0.f, 0.f, 0.f, 0.f};
        {
            const bf16_t* ah_p = p.H2() + (size_t)(t0 + fr) * D + fq * 8; const bf16_t* al_p = H2lo + (size_t)(t0 + fr) * D + fq * 8;
            const int widu = __builtin_amdgcn_readfirstlane(wid);
            unsigned rofs[4];
#pragma unroll
            for (int i = 0; i < 4; ++i) { const int x = wid * 1024 + i * 8192 + lane * 16, row = x >> 8, c = ((x & 255) >> 4) ^ (row & 15); rofs[i] = (unsigned)(row * 2048 + c * 16); }
#define RT_DMA(kc, buf) do { const char* src_ = (const char*)p.routerT() + (size_t)(kc) * 256;                                             \
            _Pragma("unroll") for (int i = 0; i < 4; ++i) __builtin_amdgcn_global_load_lds((const unsigned*)(src_ + rofs[i]), (unsigned*)(smem + 40960 + (buf) * 32768 + widu * 1024 + i * 8192), 16, 0, 0); } while (0)
            RT_DMA(0, 0);
#pragma unroll 1
            for (int kc = 0; kc < 8; ++kc) {
                bf16x8 ah[4], al[4];
#pragma unroll
                for (int ks = 0; ks < 4; ++ks) { ah[ks] = ldfrag(ah_p + kc * 128 + ks * 32); al[ks] = ldfrag(al_p + kc * 128 + ks * 32); }
                asm volatile("s_waitcnt vmcnt(0)" ::: "memory"); __syncthreads();
                if (kc + 1 < 8) RT_DMA(kc + 1, (kc + 1) & 1);
                const char* bb = smem + 40960 + (kc & 1) * 32768;
#pragma unroll
                for (int ks = 0; ks < 4; ++ks)
#pragma unroll
                    for (int nt = 0; nt < 4; ++nt) {
                        const int row = nt * 16 + fr, cc = ((ks * 4 + fq) ^ (row & 15)) * 16;
                        const bf16x8 bh = *(const bf16x8*)(bb + row * 256 + cc), bl = *(const bf16x8*)(bb + (64 + row) * 256 + cc);
                        acc[nt] = __builtin_amdgcn_mfma_f32_16x16x32_bf16(ah[ks], bh, acc[nt], 0, 0, 0);
                        acc[nt] = __builtin_amdgcn_mfma_f32_16x16x32_bf16(ah[ks], bl, acc[nt], 0, 0, 0);
                        acc[nt] = __builtin_amdgcn_mfma_f32_16x16x32_bf16(al[ks], bh, acc[nt], 0, 0, 0);
                    }
            }
#undef RT_DMA
        }
#pragma unroll
        for (int nt = 0; nt < 4; ++nt)
#pragma unroll
            for (int j = 0; j < 4; ++j) lg[(wid * 16 + fq * 4 + j) * 65 + nt * 16 + fr] = acc[nt][j];
        __syncthreads();
        if (MODE == 2) continue;
        int l3 = lane; asm volatile("" : "+v"(l3));
#define SHXF(v_, m_) __int_as_float(__builtin_amdgcn_ds_bpermute((l3 ^ (m_)) << 2, __float_as_int(v_)))
#define SHXI(v_, m_) __builtin_amdgcn_ds_bpermute((l3 ^ (m_)) << 2, (v_))
#define SHBF(v_, src_) __int_as_float(__builtin_amdgcn_ds_bpermute((src_) << 2, __float_as_int(v_)))
#define SHBI(v_, src_) __builtin_amdgcn_ds_bpermute((src_) << 2, (v_))
        const int q4 = l3 & 3, tt = wid * 16 + (l3 >> 2), t = item * 128 + tt, qbase = l3 & ~3;
        float sc_[16], v[16];
#pragma unroll
        for (int i = 0; i < 16; ++i) { const float x = lg[tt * 65 + q4 * 16 + i]; sc_[i] = __builtin_amdgcn_rcpf(1.0f + __builtin_amdgcn_exp2f(-1.4426950408889634f * x)); v[i] = sc_[i] + p.router_b[q4 * 16 + i]; }
        float gsA, gsB;
        { float m1 = v[0], m2 = -INFINITY;
#pragma unroll
          for (int i = 1; i < 8; ++i) { const float x = v[i]; m2 = fmaxf(m2, fminf(m1, x)); m1 = fmaxf(m1, x); }
          gsA = m1 + m2; m1 = v[8]; m2 = -INFINITY;
#pragma unroll
          for (int i = 9; i < 16; ++i) { const float x = v[i]; m2 = fmaxf(m2, fminf(m1, x)); m1 = fmaxf(m1, x); }
          gsB = m1 + m2; }
        { int rankA = 0, rankB = 0;
#pragma unroll
          for (int qq = 0; qq < 4; ++qq) {
              const float ga = SHBF(gsA, qbase | qq), gb = SHBF(gsB, qbase | qq);
              const int g0 = 2 * qq, g1 = 2 * qq + 1, mA = 2 * q4, mB = 2 * q4 + 1;
              rankA += (g0 != mA && (ga > gsA || (ga == gsA && g0 < mA))) ? 1 : 0; rankA += (g1 != mA && (gb > gsA || (gb == gsA && g1 < mA))) ? 1 : 0;
              rankB += (g0 != mB && (ga > gsB || (ga == gsB && g0 < mB))) ? 1 : 0; rankB += (g1 != mB && (gb > gsB || (gb == gsB && g1 < mB))) ? 1 : 0;
          }
          if (rankA >= 4) {
#pragma unroll
              for (int i = 0; i < 8; ++i) v[i] = -INFINITY; }
          if (rankB >= 4) {
#pragma unroll
              for (int i = 8; i < 16; ++i) v[i] = -INFINITY; } }
        unsigned chm = 0u;
#pragma unroll 1
        for (int it = 0; it < 8; ++it) {
            float lm = v[0];
#pragma unroll
            for (int i = 1; i < 16; ++i) lm = fmaxf(lm, v[i]);
            float gm = fmaxf(lm, SHXF(lm, 1)); gm = fmaxf(gm, SHXF(gm, 2));
            int cand = (lm == gm) ? q4 : 4;
            cand = min(cand, SHXI(cand, 1)); cand = min(cand, SHXI(cand, 2));
            const bool win = cand == q4;
            bool found = false;
#pragma unroll
            for (int i = 0; i < 16; ++i) { const bool hit = win && !found && v[i] == gm; if (hit) { chm |= (1u << i); v[i] = -INFINITY; } found = found || hit; }
        }
        float wsum = 0.f;
#pragma unroll
        for (int i = 0; i < 16; ++i) wsum += ((chm >> i) & 1u) ? sc_[i] : 0.f;
        wsum += SHXF(wsum, 1); wsum += SHXF(wsum, 2);
        const float wscale = 2.5f / wsum;
        const unsigned long long pat = 0x1111111111111111ull << q4;
#pragma unroll
        for (int i = 0; i < 16; ++i) { const unsigned long long bal = __ballot((chm >> i) & 1u); if (l3 < 4) wcnt[wid * 64 + l3 * 16 + i] = __popcll(bal & (0x1111111111111111ull << l3)); }
        __syncthreads();
        if (wid == 0) {
            int tot = 0;
#pragma unroll
            for (int w = 0; w < 8; ++w) tot += wcnt[w * 64 + lane];
            int run = atomicAdd(&cntp[lane], tot);
#pragma unroll
            for (int w = 0; w < 8; ++w) { const int c = wcnt[w * 64 + lane]; pref[w * 64 + lane] = run; run += c; }
        }
        __syncthreads();
        {
            const int pc = __popc(chm);
            int kbase = 0;
#pragma unroll
            for (int qq = 0; qq < 3; ++qq) { const int o = SHBI(pc, qbase | qq); kbase += (qq < q4) ? o : 0; }
#pragma unroll
            for (int i = 0; i < 16; ++i) {
                const bool c = (chm >> i) & 1u;
                const unsigned long long bal = __ballot(c);
                if (c) {
                    const int e = q4 * 16 + i;
                    const int slot = pref[wid * 64 + e] + __popcll(bal & pat & ((1ull << l3) - 1ull));
                    tl[(size_t)e * ECAP + slot] = t; wl_[(size_t)e * ECAP + slot] = sc_[i] * wscale;
                    tm[(size_t)t * 8 + kbase + __popc(chm & ((1u << i) - 1u))] = e * ECAP + slot;
                }
            }
        }
    }
}
#undef SHXF
#undef SHXI
#undef SHBF
#undef SHBI

constexpr int MOE_AUX = 162816;
__device__ __forceinline__ void moe_tables(const MK& p, int colt, int* tpre, int* rbase, int tid_l) {
    __syncthreads();
    if (tid_l == 0) { int tp = 0, rb = 0;
        for (int e = 0; e < 65; ++e) { const int c = e < 64 ? p.cnt()[e] : T; tpre[e] = tp; rbase[e] = rb; tp += ((c + 255) >> 8) * colt; rb += c; }
        tpre[65] = tp; rbase[65] = rb; }
    __syncthreads();
}
struct SchedUp { const MK* p; int bid, nb, tid_l, ntiles; const int* tpre; const int* rbase; mutable int e_hint;
    __device__ __forceinline__ bool next(int i, pg8::GUnit& u, unsigned (&vA)[2][2]) const {
        const int tile = xcd_vbid(bid, nb) + i * nb; if (tile >= ntiles) return false;
        int e = e_hint; while (tile >= tpre[e + 1]) ++e; e_hint = e;
        const int j = tile - tpre[e], rt = j >> 1, ct = j & 1, cnt_e = rbase[e + 1] - rbase[e];
        u.A = (const char*)p->H2(); u.B = (const char*)(p->W13t() + ((size_t)e * 512 + ct * 256) * D); u.i0 = e; u.i1 = rt; u.i2 = ct; u.i3 = cnt_e;
#pragma unroll
        for (int i2 = 0; i2 < 2; ++i2) { int R, C; stage_rc(tid_l * 16 + i2 * 8192, R, C);
#pragma unroll
            for (int h = 0; h < 2; ++h) { int slot = rt * 256 + h * 128 + R; if (slot >= cnt_e) slot = 0;
                const int tok = e < 64 ? p->tok_list()[(size_t)e * ECAP + slot] : slot;
                vA[h][i2] = (unsigned)tok * (D * 2u) + (unsigned)C * 2u; } }
        return true; } };
template <bool NOSTORE = false> struct EpiUpT { static constexpr bool PERM = true; const MK* p; const int* rbase;
    __device__ __forceinline__ void operator()(const f32x4 (&acc)[2][2][4][2], const pg8::GUnit& u, int wr, int wc, int fr, int fq) const {
        const int e = u.i0, rt = u.i1, ct = u.i2, cnt_e = u.i3;
        bf16_t* ab = p->ACT() + (size_t)rbase[e] * DE + ct * 128 + wc * 32 + fq * 8;
#pragma unroll
        for (int ai = 0; ai < 2; ++ai)
#pragma unroll
            for (int m = 0; m < 4; ++m) {
                const int slot = rt * 256 + ai * 128 + wr * 64 + m * 16 + fr;
                u32x4 w;
                w.x = cvtpk(silu_fast(acc[ai][0][m][0][0]) * acc[ai][1][m][0][0], silu_fast(acc[ai][0][m][0][1]) * acc[ai][1][m][0][1]);
                w.y = cvtpk(silu_fast(acc[ai][0][m][0][2]) * acc[ai][1][m][0][2], silu_fast(acc[ai][0][m][0][3]) * acc[ai][1][m][0][3]);
                w.z = cvtpk(silu_fast(acc[ai][0][m][1][0]) * acc[ai][1][m][1][0], silu_fast(acc[ai][0][m][1][1]) * acc[ai][1][m][1][1]);
                w.w = cvtpk(silu_fast(acc[ai][0][m][1][2]) * acc[ai][1][m][1][2], silu_fast(acc[ai][0][m][1][3]) * acc[ai][1][m][1][3]);
                if (NOSTORE) { if (slot < -cnt_e) *(u32x4*)(ab + (size_t)slot * DE) = w; } else if (slot < cnt_e) *(u32x4*)(ab + (size_t)slot * DE) = w;
            }
    } };
__device__ __forceinline__ void ph_moe_up(const MK& p, int bid, int nb, int tid_l) {
    int* tpre = (int*)(smem + MOE_AUX); int* rbase = tpre + 80;
    moe_tables(p, 2, tpre, rbase, tid_l);
    SchedUp S{&p, bid, nb, tid_l, tpre[65], tpre, rbase, 0}; EpiUpT<false> E{&p, rbase};
    pg8::gemm<EpiUpT<false>, SchedUp, true, true>(D, S, E, tid_l);
}
constexpr float Y_SCALE = 64.0f;
struct SchedDown { const MK* p; int bid, nb, tid_l, ntiles; const int* tpre; const int* rbase; mutable int e_hint;
    __device__ __forceinline__ bool next(int i, pg8::GUnit& u, unsigned (&vA)[2][2]) const {
        const int tile = xcd_vbid(bid, nb) + i * nb; if (tile >= ntiles) return false;
        int e = e_hint; while (tile >= tpre[e + 1]) ++e; e_hint = e;
        const int j = tile - tpre[e], rt = j >> 2, ct = j & 3, cnt_e = rbase[e + 1] - rbase[e];
        u.A = (const char*)(p->ACT() + (size_t)(rbase[e] + rt * 256) * DE); u.B = (const char*)(p->W2t() + ((size_t)e * D + ct * 256) * DE); u.i0 = e; u.i1 = rt; u.i2 = ct; u.i3 = cnt_e;
        pg8::plain_voffA(DE, vA, tid_l); return true; } };
template <int MODE> struct EpiDown { static constexpr bool PERM = true; const MK* p; const int* rbase;
    __device__ __forceinline__ void operator()(const f32x4 (&acc)[2][2][4][2], const pg8::GUnit& u, int wr, int wc, int fr, int fq) const {
        const int e = u.i0, rt = u.i1, ct = u.i2, cnt_e = u.i3;
        {
            const float* wl = p->wt_list() + (size_t)(e < 64 ? e : 0) * ECAP;
            float wv[2][4];
#pragma unroll
            for (int ai = 0; ai < 2; ++ai)
#pragma unroll
                for (int m = 0; m < 4; ++m) { const int sl = rt * 256 + ai * 128 + wr * 64 + m * 16 + fr; wv[ai][m] = e < 64 ? wl[sl < cnt_e ? sl : 0] * Y_SCALE : Y_SCALE; }
            const int wid = wr * 4 + wc, lane = fq * 16 + fr;
            char* wa = smem + 131072 + wid * 3968;
            unsigned char* yb = p->Y() + (size_t)rbase[e] * D + ct * 256 + wc * 64 + (lane & 3) * 16;
#pragma unroll
            for (int ai = 0; ai < 2; ++ai)
#pragma unroll
                for (int m = 0; m < 4; ++m) {
                    const float w = wv[ai][m];
                    char* img = wa + ((m & 1) ? 1280 : 0);
#pragma unroll
                    for (int bj = 0; bj < 2; ++bj) {
                        u32x2 pk;
#pragma unroll
                        for (int n = 0; n < 2; ++n) {
                            float v0 = __builtin_amdgcn_fmed3f(acc[ai][bj][m][n][0] * w, -448.f, 448.f), v1 = __builtin_amdgcn_fmed3f(acc[ai][bj][m][n][1] * w, -448.f, 448.f);
                            float v2 = __builtin_amdgcn_fmed3f(acc[ai][bj][m][n][2] * w, -448.f, 448.f), v3 = __builtin_amdgcn_fmed3f(acc[ai][bj][m][n][3] * w, -448.f, 448.f);
                            int q = 0; q = __builtin_amdgcn_cvt_pk_fp8_f32(v0, v1, q, false); q = __builtin_amdgcn_cvt_pk_fp8_f32(v2, v3, q, true);
                            if (n == 0) pk.x = (unsigned)q; else pk.y = (unsigned)q;
                        }
                        *(u32x2*)(img + fr * 80 + bj * 32 + fq * 8) = pk;
                    }
                    asm volatile("s_waitcnt lgkmcnt(0)" ::: "memory");
                    const int rr = lane >> 2, slot = rt * 256 + ai * 128 + wr * 64 + m * 16 + rr;
                    const u32x4 v = *(const u32x4*)(img + rr * 80 + (lane & 3) * 16);
                    if (MODE == 1) asm volatile("" :: "v"(v)); else if (slot < cnt_e) *(u32x4*)(yb + (size_t)slot * D) = v;
                }
        }
    } };
template <bool DUMMY, int MODE = 0> __device__ __forceinline__ void ph_moe_down(const MK& p, int bid, int nb, int tid_l) {
    int* tpre = (int*)(smem + MOE_AUX); int* rbase = tpre + 80;
    moe_tables(p, 4, tpre, rbase, tid_l);
    SchedDown S{&p, bid, nb, tid_l, DUMMY ? tpre[64] : tpre[65], tpre, rbase, 0}; EpiDown<MODE> E{&p, rbase};
    pg8::gemm<EpiDown<MODE>, SchedDown, false, true>(DE, S, E, tid_l);
}

#if DUP >= 21 && DUP <= 29
template <bool PERM_> struct EpiNull { static constexpr bool PERM = PERM_;
    __device__ __forceinline__ void operator()(const f32x4 (&acc)[2][2][4][2], const pg8::GUnit& u, int wr, int wc, int fr, int fq) const {
#pragma unroll
        for (int a = 0; a < 2; ++a)
#pragma unroll
            for (int b = 0; b < 2; ++b)
#pragma unroll
                for (int m = 0; m < 4; ++m) { asm volatile("" :: "v"(acc[a][b][m][0]), "v"(acc[a][b][m][1])); }
    } };
__device__ __forceinline__ void ph_probe_in(const MK& p, int bid, int nb, int tid_l) { SchedIn S{&p, bid, nb, tid_l}; EpiNull<false> E; pg8::gemm<EpiNull<false>, SchedIn, false, true>(D, S, E, tid_l); }
__device__ __forceinline__ void ph_probe_out(const MK& p, int bid, int nb, int tid_l) { SchedOut S{&p, bid, nb, tid_l}; EpiNull<true> E; pg8::gemm<EpiNull<true>, SchedOut, false, true>(D, S, E, tid_l); }
__device__ __forceinline__ void ph_probe_up(const MK& p, int bid, int nb, int tid_l) {
    int* tpre = (int*)(smem + MOE_AUX); int* rbase = tpre + 80; moe_tables(p, 2, tpre, rbase, tid_l);
    SchedUp S{&p, bid, nb, tid_l, tpre[65], tpre, rbase, 0}; EpiNull<true> E; pg8::gemm<EpiNull<true>, SchedUp, true, true>(D, S, E, tid_l); }
__device__ __forceinline__ void ph_probe_up_nostore(const MK& p, int bid, int nb, int tid_l) {
    int* tpre = (int*)(smem + MOE_AUX); int* rbase = tpre + 80; moe_tables(p, 2, tpre, rbase, tid_l);
    SchedUp S{&p, bid, nb, tid_l, tpre[65], tpre, rbase, 0}; EpiUpT<true> E{&p, rbase}; pg8::gemm<EpiUpT<true>, SchedUp, true, true>(D, S, E, tid_l); }
__device__ __forceinline__ void ph_probe_down(const MK& p, int bid, int nb, int tid_l) {
    int* tpre = (int*)(smem + MOE_AUX); int* rbase = tpre + 80; moe_tables(p, 4, tpre, rbase, tid_l);
    SchedDown S{&p, bid, nb, tid_l, tpre[65], tpre, rbase, 0}; EpiNull<true> E; pg8::gemm<EpiNull<true>, SchedDown, false, true>(DE, S, E, tid_l); }
#endif
template <bool DUMMY> __device__ __forceinline__ void ph_final(const MK& p, int bid, int nb, int tid_l) {
    const int wid = tid_l >> 6, lane = tid_l & 63;
    int* tpre = (int*)(smem + MOE_AUX); int* rbase = tpre + 80;
    moe_tables(p, 1, tpre, rbase, tid_l);
    for (int t = bid * 8 + wid; t < T; t += nb * 8) {
        const int b = t / SEQ;
        float f[16];
#pragma unroll
        for (int i = 0; i < 16; ++i) f[i] = 0.f;
#pragma unroll
        for (int k = 0; k < 9; ++k) {
            int row;
            if (k < 8) { const int id = p.tokmap()[(size_t)t * 8 + k], e = id >> 15, slot = id & (ECAP - 1); row = rbase[e] + slot; } else row = rbase[64] + t;
            const unsigned char* yr = p.Y() + (size_t)row * D + lane * 4;
#pragma unroll
            for (int q = 0; q < 4; ++q) {
                const int w = *(const int*)(yr + q * 256);
                const auto lo = __builtin_amdgcn_cvt_pk_f32_fp8(w, false); const auto hi = __builtin_amdgcn_cvt_pk_f32_fp8(w, true);
                f[q * 4 + 0] += lo[0]; f[q * 4 + 1] += lo[1]; f[q * 4 + 2] += hi[0]; f[q * 4 + 3] += hi[1];
            }
        }
        const int pcol = ((lane >> 3) & 1) * 128 + (lane >> 4) * 32 + (lane & 7) * 4;
        const float* g2 = p.mod() + (size_t)b * 6 * D + 5 * D + pcol;
        const bf16_t* x1 = p.X1() + (size_t)t * 2048 + pcol;
        float* xo = p.out + (size_t)t * D + pcol;
        float v[16]; float ss = 0.f;
#pragma unroll
        for (int q = 0; q < 4; ++q) {
            const u32x2 xw = *(const u32x2*)(x1 + q * 256); const float4 g = *(const float4*)(g2 + q * 256);
            v[q * 4 + 0] = __uint_as_float(xw.x << 16) + g.x * f[q * 4 + 0] * (1.0f / Y_SCALE); v[q * 4 + 1] = __uint_as_float(xw.x & 0xffff0000u) + g.y * f[q * 4 + 1] * (1.0f / Y_SCALE);
            v[q * 4 + 2] = __uint_as_float(xw.y << 16) + g.z * f[q * 4 + 2] * (1.0f / Y_SCALE); v[q * 4 + 3] = __uint_as_float(xw.y & 0xffff0000u) + g.w * f[q * 4 + 3] * (1.0f / Y_SCALE);
            ss += v[q * 4] * v[q * 4] + v[q * 4 + 1] * v[q * 4 + 1] + v[q * 4 + 2] * v[q * 4 + 2] + v[q * 4 + 3] * v[q * 4 + 3];
        }
        ss = wave_sum(ss);
        const float rstd = rsqrtf(ss * (1.0f / D) + EPS);
#pragma unroll
        for (int q = 0; q < 4; ++q) {
            const float4 gf = *(const float4*)(p.final_g + q * 256 + pcol);
            *(float4*)((DUMMY ? (float*)(p.ws + 42 * MiB) + (size_t)t * D + pcol : xo) + q * 256) = make_float4(v[q * 4] * rstd * gf.x, v[q * 4 + 1] * rstd * gf.y, v[q * 4 + 2] * rstd * gf.z, v[q * 4 + 3] * rstd * gf.w);
        }
    }
}


#define XB_TMO      128
#define XB_XCNT(j)  (256  + 64 * (j))
#define XB_XSUB(j)  (1280 + 64 * (j))
#define XB_XGEN(j)  (2304 + 64 * (j))
#define XB_TOP      3328
#define XB_TOPGEN   3392
#define XCD_BAR_WORDS 3456
#define XB_SPIN_CAP (1u << 22)
#define LAS __attribute__((address_space(3)))
__device__ __forceinline__ unsigned xb_ld(unsigned* p)              { return __hip_atomic_load(p, __ATOMIC_RELAXED, __HIP_MEMORY_SCOPE_AGENT); }
__device__ __forceinline__ unsigned xb_add(unsigned* p, unsigned v) { return __hip_atomic_fetch_add(p, v, __ATOMIC_RELAXED, __HIP_MEMORY_SCOPE_AGENT); }
__device__ __forceinline__ unsigned xb_xcc_id() { return (unsigned)__builtin_amdgcn_s_getreg((3 << 11) | 20) & 0xFu; }
#define XB_SPIN(cond, bar) do { unsigned _sp = 0; while (cond) { __builtin_amdgcn_s_sleep(1); \
    if ((++_sp & 255u) == 0u) { if (xb_ld(&(bar)[XB_TMO])) break; if (_sp > XB_SPIN_CAP) { atomicAdd(&(bar)[XB_TMO], 1u); break; } } } } while (0)
struct XcdBarrier { unsigned* bar; unsigned x; volatile LAS unsigned* st; };
__device__ __forceinline__ XcdBarrier xcd_barrier_post(unsigned* bar, volatile LAS unsigned* st, int tid) {
    XcdBarrier b; b.bar = bar; b.x = xb_xcc_id(); b.st = st;
    if (tid == 0) (void)xb_add(&bar[XB_XCNT(b.x)], 1u);
    return b;
}
__device__ __forceinline__ void xcd_barrier_complete(unsigned* bar, unsigned x, unsigned& nloc, unsigned& nx) {
    const unsigned G = gridDim.x * gridDim.y * gridDim.z;
    unsigned sum, cnt, mine, sp = 0u;
    for (;;) {
        sum = 0u; cnt = 0u; mine = 0u;
#pragma unroll
        for (unsigned j = 0; j < 16; ++j) { const unsigned c = xb_ld(&bar[XB_XCNT(j)]); sum += c; cnt += (c > 0u) ? 1u : 0u; mine = (j == x) ? c : mine; }
        if (sum == G) break;
        __builtin_amdgcn_s_sleep(1);
        if ((++sp & 255u) == 0u) { if (xb_ld(&bar[XB_TMO])) break; if (sp > XB_SPIN_CAP) { atomicAdd(&bar[XB_TMO], 1u); break; } }
    }
    nloc = mine > 0u ? mine : 1u; nx = cnt > 0u ? cnt : 1u;
}
__device__ __forceinline__ void xcd_barrier(const XcdBarrier& b, int tid) {
    asm volatile("s_waitcnt vmcnt(0)" ::: "memory");
    __syncthreads();
    if (tid == 0) {
        unsigned* bar = b.bar;
        __builtin_amdgcn_s_waitcnt(0);
        unsigned nloc = b.st[0], nx = b.st[1];
        if (nloc == 0u) { xcd_barrier_complete(bar, b.x, nloc, nx); b.st[0] = nloc; b.st[1] = nx; }
        const unsigned old = xb_add(&bar[XB_XSUB(b.x)], 1u);
        const unsigned gen = old / nloc;
        if (old + 1u == (gen + 1u) * nloc) {
            __builtin_amdgcn_fence(__ATOMIC_RELEASE, "agent");
            asm volatile("s_waitcnt vmcnt(0)" ::: "memory");
            const unsigned og = xb_add(&bar[XB_TOP], 1u);
            const unsigned tg = og / nx;
            if (og + 1u == (tg + 1u) * nx) xb_add(&bar[XB_TOPGEN], 1u);
            else XB_SPIN(xb_ld(&bar[XB_TOPGEN]) == tg, bar);
            __builtin_amdgcn_fence(__ATOMIC_ACQUIRE, "agent");
            xb_add(&bar[XB_XGEN(b.x)], 1u);
            asm volatile("s_waitcnt vmcnt(0)" ::: "memory");
        } else {
            XB_SPIN(xb_ld(&bar[XB_XGEN(b.x)]) == gen, bar);
            __builtin_amdgcn_fence(__ATOMIC_ACQUIRE, "agent");
            asm volatile("s_waitcnt vmcnt(0)" ::: "memory");
        }
    }
    __syncthreads();
}

__device__ __forceinline__ int lane_id_volatile() { int l; asm volatile("v_mbcnt_lo_u32_b32 %0, -1, 0\n\tv_mbcnt_hi_u32_b32 %0, -1, %0" : "=v"(l)); return l; }
__global__ __launch_bounds__(512, 2) void k_mega(MK p) {
    cg::grid_group grid = cg::this_grid();
    const int bid = blockIdx.x, nb = gridDim.x;
    volatile LAS unsigned* xst = (volatile LAS unsigned*)(smem + 162816 + 768);
    if (threadIdx.x < 4) xst[threadIdx.x] = 0u;
    __syncthreads();
    const XcdBarrier xb = xcd_barrier_post((unsigned*)(p.ws + 524288), xst, (int)threadIdx.x);
    const int wv_ = __builtin_amdgcn_readfirstlane((int)threadIdx.x >> 6);
#define LANE_ID() lane_id_volatile()
#define PH_TID() int t_ = wv_ * 64 + LANE_ID(); asm volatile("" : "+v"(t_))
    { PH_TID(); if (bid == 0 && t_ < 256) p.cnt()[t_] = 0; ph_mod(p, bid, nb, t_); ph_convert(p, bid, nb, t_); }
#if DUP == 10
    { PH_TID(); ph_convert(p, bid, nb, t_); }
#endif
    grid.sync();
    { PH_TID(); ph_ln1(p, bid, nb, t_); }
#if DUP == 1
    { PH_TID(); ph_ln1(p, bid, nb, t_); }
#endif
    xcd_barrier(xb, wv_ * 64 + LANE_ID());
    { PH_TID(); ph_gemm_in(p, bid, nb, t_); }
    { PH_TID(); ph_convert_dyn(p, t_); }
#if DUP == 2
    { PH_TID(); ph_gemm_in(p, bid, nb, t_); }
#endif
#if DUP == 21
    { PH_TID(); ph_probe_in(p, bid, nb, t_); }
#endif
    xcd_barrier(xb, wv_ * 64 + LANE_ID());
    { PH_TID(); ph_attn<0>(p, bid, nb, t_); }
#if DUP == 3
    { PH_TID(); ph_attn<2>(p, bid, nb, t_); }
#endif
#if DUP == 31
    { PH_TID(); ph_attn<1>(p, bid, nb, t_); }
#endif
#if DUP == 33
    { PH_TID(); ph_attn<3>(p, bid, nb, t_); }
#endif
    { PH_TID(); ph_kv(p, bid, nb, t_); }
#if DUP == 11
    { PH_TID(); ph_kv(p, bid, nb, t_); }
#endif
    xcd_barrier(xb, wv_ * 64 + LANE_ID());
    { PH_TID(); ph_scan(p, bid, nb, t_); }
    xcd_barrier(xb, wv_ * 64 + LANE_ID());
    { PH_TID(); ph_ret(p, bid, nb, t_); }
#if DUP == 5
    { PH_TID(); ph_ret(p, bid, nb, t_); }
#endif
    xcd_barrier(xb, wv_ * 64 + LANE_ID());
    { PH_TID(); ph_gemm_out(p, bid, nb, t_); }
#if DUP == 6
    { PH_TID(); ph_gemm_out(p, bid, nb, t_); }
#endif
#if DUP == 22
    { PH_TID(); ph_probe_out(p, bid, nb, t_); }
#endif
    xcd_barrier(xb, wv_ * 64 + LANE_ID());
#if DUP == 7
    { PH_TID(); ph_route<true>(p, bid, nb, t_); }
#endif
#if DUP == 72
    { PH_TID(); ph_route<true, 2>(p, bid, nb, t_); }
#endif
#if DUP == 73
    { PH_TID(); ph_route<true, 3>(p, bid, nb, t_); }
#endif
    { PH_TID(); ph_route<false>(p, bid, nb, t_); }
    xcd_barrier(xb, wv_ * 64 + LANE_ID());
    { PH_TID(); ph_moe_up(p, bid, nb, t_); }
#if DUP == 8
    { PH_TID(); ph_moe_up(p, bid, nb, t_); }
#endif
#if DUP == 23
    { PH_TID(); ph_probe_up(p, bid, nb, t_); }
#endif
#if DUP == 25
    { PH_TID(); ph_probe_up_nostore(p, bid, nb, t_); }
#endif
    xcd_barrier(xb, wv_ * 64 + LANE_ID());
#if DUP == 9
    { PH_TID(); ph_moe_down<true>(p, bid, nb, t_); }
#endif
#if DUP == 91
    { PH_TID(); ph_moe_down<true, 1>(p, bid, nb, t_); }
#endif
    { PH_TID(); ph_moe_down<false>(p, bid, nb, t_); }
#if DUP == 24
    { PH_TID(); ph_probe_down(p, bid, nb, t_); }
#endif
    xcd_barrier(xb, wv_ * 64 + LANE_ID());
#if DUP == 13
    { PH_TID(); ph_final<true>(p, bid, nb, t_); }
#endif
    { PH_TID(); ph_final<false>(p, bid, nb, t_); }
#undef PH_TID
#undef LANE_ID
}
constexpr int LDS_TOTAL = 163840;
extern "C" void kernel_launch(void* const* d_in, const int* in_sizes, int n_in, void* d_out, int out_size, void* d_ws, size_t ws_size, hipStream_t stream) {
    char* ws = (char*)d_ws;
    MK mk{};
    mk.x = (const float*)d_in[0]; mk.c = (const float*)d_in[1]; mk.ctx = (const float*)d_in[2]; mk.cctx = (const float*)d_in[3]; mk.ada_w = (const float*)d_in[4]; mk.ada_b = (const float*)d_in[5];
    mk.norm1_g = (const float*)d_in[6]; mk.w_in = (const float*)d_in[7]; mk.lq1 = (const float*)d_in[8]; mk.lk1 = (const float*)d_in[9]; mk.lq2 = (const float*)d_in[10]; mk.lk2 = (const float*)d_in[11];
    mk.dattn_g = (const float*)d_in[12]; mk.dec_f = (const float*)d_in[13]; mk.dec_b = (const float*)d_in[14]; mk.ret_g = (const float*)d_in[15]; mk.w_out = (const float*)d_in[16];
    mk.norm2_g = (const float*)d_in[17]; mk.router_w = (const float*)d_in[18]; mk.router_b = (const float*)d_in[19]; mk.ew1 = (const float*)d_in[20]; mk.ew3 = (const float*)d_in[21];
    mk.ew2 = (const float*)d_in[22]; mk.sw1 = (const float*)d_in[23]; mk.sw3 = (const float*)d_in[24]; mk.sw2 = (const float*)d_in[25]; mk.final_g = (const float*)d_in[26];
    mk.out = (float*)d_out;
    mk.ws = ws;
    mk.dbgP = nullptr; mk.dbg_lo = 0; mk.dbg_hi = 12; mk.conv_limit = 1 << 30;
    static int grid_blocks = 0;
    if (!grid_blocks) {
        (void)hipFuncSetAttribute((const void*)k_mega, hipFuncAttributeMaxDynamicSharedMemorySize, LDS_TOTAL);
        int dev = 0, cus = 0, per_cu = 0;
        (void)hipGetDevice(&dev);
        (void)hipDeviceGetAttribute(&cus, hipDeviceAttributeMultiprocessorCount, dev);
        (void)hipOccupancyMaxActiveBlocksPerMultiprocessor(&per_cu, k_mega, 512, LDS_TOTAL);
        if (per_cu > 1) per_cu = 1;
        grid_blocks = cus * per_cu;
        if (grid_blocks <= 0) { fprintf(stderr, "occupancy query failed: cus %d per_cu %d\n", cus, per_cu); grid_blocks = 256; }
    }
    (void)hipMemsetAsync(ws + 524288, 0, XCD_BAR_WORDS * 4, stream);
    void* args[] = {&mk};
    hipError_t e = hipLaunchCooperativeKernel((void*)k_mega, dim3(grid_blocks), dim3(512), args, LDS_TOTAL, stream);
    if (e != hipSuccess) fprintf(stderr, "cooperative launch failed: %s (grid %d)\n", hipGetErrorString(e), grid_blocks);
}
```

```cpp
#include <hip/hip_runtime.h>
#include <hip/hip_cooperative_groups.h>
#include <cstdio>
namespace cg = cooperative_groups;
#ifndef DUP
#define DUP 0
#endif
#include <stdint.h>

constexpr int D = 1024, NB = 4, SEQ = 8192, CTX = 256, RB = SEQ + CTX  , NR = NB * RB  , T = NB * SEQ;
constexpr int NE = 64, DE = 256, ECAP = 32768;
constexpr float EPS = 1e-6f;
typedef unsigned short bf16_t;

__device__ __forceinline__ float siluf(float v) { return v / (1.0f + expf(-v)); }
__device__ __forceinline__ float silu_fast(float v) { return v * __builtin_amdgcn_rcpf(1.0f + __builtin_amdgcn_exp2f(-1.4426950408889634f * v)); }
__device__ __forceinline__ float wave_sum(float v) {
#pragma unroll
    for (int o = 32; o > 0; o >>= 1) v += __shfl_xor(v, o);
    return v;
}
__device__ __forceinline__ float wave_max(float v) {
#pragma unroll
    for (int o = 32; o > 0; o >>= 1) v = fmaxf(v, __shfl_xor(v, o));
    return v;
}
__device__ __forceinline__ float block_sum(float v, float* red) {
    v = wave_sum(v);
    __syncthreads();
    if ((threadIdx.x & 63) == 0) red[threadIdx.x >> 6] = v;
    __syncthreads();
    return red[0] + red[1] + red[2] + red[3];
}
__device__ __forceinline__ float block_max(float v, float* red) {
    v = wave_max(v);
    __syncthreads();
    if ((threadIdx.x & 63) == 0) red[threadIdx.x >> 6] = v;
    __syncthreads();
    return fmaxf(fmaxf(red[0], red[1]), fmaxf(red[2], red[3]));
}

typedef short bf16x8 __attribute__((ext_vector_type(8)));
typedef short s16x4 __attribute__((ext_vector_type(4)));
typedef float f32x4 __attribute__((ext_vector_type(4)));
typedef float f32x16 __attribute__((ext_vector_type(16)));
typedef unsigned u32x2 __attribute__((ext_vector_type(2)));
typedef unsigned u32x4 __attribute__((ext_vector_type(4)));
extern __shared__ __attribute__((aligned(1024))) char smem[];
constexpr int NTHR = 512;
constexpr int GEMM_LDS = 131072;

__device__ __forceinline__ unsigned cvtpk(float lo, float hi) { unsigned r; asm volatile("v_cvt_pk_bf16_f32 %0, %1, %2" : "=v"(r) : "v"(lo), "v"(hi)); return r; }
__device__ __forceinline__ bf16_t f2bf(float v) { return (bf16_t)(cvtpk(v, v) & 0xffffu); }
__device__ __forceinline__ float bf2f(bf16_t v) { return __uint_as_float(((unsigned)v) << 16); }

constexpr size_t MiB = 1048576;
struct MK {
    const float *x, *c, *ctx, *cctx, *ada_w, *ada_b, *norm1_g, *w_in, *lq1, *lk1, *lq2, *lk2, *dattn_g, *dec_f, *dec_b, *ret_g, *w_out, *norm2_g, *router_w, *router_b,
        *ew1, *ew3, *ew2, *sw1, *sw3, *sw2, *final_g;
    float* out; char* ws;
    float* dbgP; long dbg_lo, dbg_hi; long conv_limit;
#define WSF(name, type, off) __device__ __forceinline__ type* name() const { return (type*)(ws + (off)); }
    WSF(mod, float, 0) WSF(cnt, int, 131072) WSF(ropec, float, 262144) WSF(ropes, float, 262144 + 8192)
    WSF(w_inT, bf16_t, 1 * MiB) WSF(w_outT, bf16_t, 7 * MiB) WSF(routerT, bf16_t, 9 * MiB) WSF(W2t, bf16_t, 9 * MiB + 524288)
    WSF(H, bf16_t, 42 * MiB) WSF(MIX, bf16_t, 42 * MiB) WSF(KV, bf16_t, 112 * MiB) WSF(ST, bf16_t, 147 * MiB) WSF(ACT, bf16_t, 42 * MiB)
    WSF(W13t, bf16_t, 194 * MiB) WSF(H2, bf16_t, 260 * MiB)
    WSF(Q, bf16_t, 260 * MiB) WSF(K, bf16_t, 292 * MiB) WSF(V, bf16_t, 325 * MiB) WSF(RQ, bf16_t, 358 * MiB) WSF(RK, bf16_t, 375 * MiB)
    WSF(KTf, bf16_t, 392 * MiB) WSF(KTb, bf16_t, 409 * MiB) WSF(VT, bf16_t, 426 * MiB) WSF(RG, bf16_t, 459 * MiB)
    WSF(Y, unsigned char, 194 * MiB) WSF(tok_list, int, 484 * MiB) WSF(wt_list, float, 492 * MiB) WSF(tokmap, int, 500 * MiB)
    __device__ __forceinline__ bf16_t* X1() const { return (bf16_t*)out; }
#undef WSF
};

__device__ __forceinline__ void ph_mod(const MK& p, int bid, int nb, int tid_l) {
    float* red = (float*)smem;
    for (int it = bid; it < 6 * D / 32; it += nb) {
        const int col = tid_l & 31, kg = tid_l >> 5, j = it * 32 + col;
        float a[5] = {0, 0, 0, 0, 0};
        for (int k = kg * 64; k < kg * 64 + 64; ++k) {
            float w = p.ada_w[(size_t)k * 6 * D + j];
#pragma unroll
            for (int r = 0; r < 5; ++r) { float cv = r < 4 ? p.c[r * D + k] : p.cctx[k]; a[r] += siluf(cv) * w; }
        }
        __syncthreads();
#pragma unroll
        for (int r = 0; r < 5; ++r) red[(kg * 5 + r) * 32 + col] = a[r];
        __syncthreads();
        if (tid_l < 160) {
            int r = tid_l >> 5; float s = 0;
            for (int g = 0; g < 16; ++g) s += red[(g * 5 + r) * 32 + col];
            p.mod()[(size_t)r * 6 * D + j] = s + p.ada_b[j];
        }
    }
    if (bid == nb - 1) {
        for (int i = tid_l; i < 128 * 16; i += NTHR) {
            int pos = i >> 4, f = i & 15;
            float inv_freq = (float)pow(10000.0, -(double)f / 16.0);
            float s, c; sincosf((float)pos * inv_freq, &s, &c);
            p.ropec()[i] = c; p.ropes()[i] = s;
        }
    }
    __syncthreads();
}

__device__ __forceinline__ void tr_tile(const float* src, int ldsrc, int k0, int n0, bf16_t* dst, int lddst, int mode  , bf16_t* dst2, int tid_l) {
    float* t = (float*)smem;
    __syncthreads();
    for (int i = tid_l; i < 64 * 16; i += NTHR) {
        int r = i >> 4, c4 = (i & 15) * 4;
        float4 v = *(const float4*)(src + (size_t)(k0 + r) * ldsrc + n0 + c4);
        t[r * 65 + c4] = v.x; t[r * 65 + c4 + 1] = v.y; t[r * 65 + c4 + 2] = v.z; t[r * 65 + c4 + 3] = v.w;
    }
    __syncthreads();
    for (int i = tid_l; i < 64 * 16; i += NTHR) {
        int n = i >> 4, k4 = (i & 15) * 4;
        float a = t[(k4 + 0) * 65 + n], b = t[(k4 + 1) * 65 + n], c = t[(k4 + 2) * 65 + n], d = t[(k4 + 3) * 65 + n];
        int nn = n0 + n, row = nn;
        if (mode == 1 || mode == 2) { int ct = nn >> 7; row = ct * 256 + (mode == 2 ? 128 : 0) + (nn & 127); }
        u32x2 w; w.x = cvtpk(a, b); w.y = cvtpk(c, d);
        *(u32x2*)(dst + (size_t)row * lddst + k0 + k4) = w;
        if (mode == 3) {
            float ah = bf2f((bf16_t)(w.x & 0xffff)), bh = bf2f((bf16_t)(w.x >> 16)), ch = bf2f((bf16_t)(w.y & 0xffff)), dh = bf2f((bf16_t)(w.y >> 16));
            u32x2 l; l.x = cvtpk(a - ah, b - bh); l.y = cvtpk(c - ch, d - dh);
            *(u32x2*)(dst2 + (size_t)row * lddst + k0 + k4) = l;
        }
    }
}
constexpr int CV_STATIC = 16 * 48 + 16 * 16 + 16, CV_E13 = 65 * 2 * 16 * 4, CV_E2 = 65 * 4 * 16, CV_TOTAL = CV_STATIC + CV_E13 + CV_E2;
__device__ __forceinline__ void convert_tile(const MK& p, int j, int tid_l) {
    const int n_win = 16 * 48, n_wout = 16 * 16, n_rt = 16;
    if (j < n_win) { tr_tile(p.w_in, 3072, (j / 48) * 64, (j % 48) * 64, p.w_inT(), 1024, 0, nullptr, tid_l); return; } j -= n_win;
    if (j < n_wout) { tr_tile(p.w_out, 1024, (j / 16) * 64, (j % 16) * 64, p.w_outT(), 1024, 0, nullptr, tid_l); return; } j -= n_wout;
    if (j < n_rt) { tr_tile(p.router_w, 64, j * 64, 0, p.routerT(), 1024, 3, p.routerT() + 64 * 1024, tid_l); return; } j -= n_rt;
    if (j < CV_E13) {
        int e = j / 128, r = j % 128, which = r / 64, tt = r % 64;
        const float* src = e < 64 ? (which ? p.ew3 : p.ew1) + (size_t)e * D * DE : (which ? p.sw3 : p.sw1);
        tr_tile(src, DE, (tt / 4) * 64, (tt % 4) * 64, p.W13t() + (size_t)e * 512 * 1024, 1024, 1 + which, nullptr, tid_l); return; } j -= CV_E13;
    { int e = j / 64, tt = j % 64;
      const float* src = e < 64 ? p.ew2 + (size_t)e * DE * D : p.sw2;
      tr_tile(src, D, (tt / 16) * 64, (tt % 16) * 64, p.W2t() + (size_t)e * 1024 * 256, 256, 0, nullptr, tid_l); }
}
__device__ __forceinline__ void ph_convert(const MK& p, int bid, int nb, int tid_l) {
    for (int it = bid; it < CV_STATIC; it += nb) convert_tile(p, it, tid_l);
    __syncthreads();
}
template <int LDSRC> __device__ __forceinline__ void tr_wave(const float* __restrict__ src, int k0, int n0, bf16_t* __restrict__ dst, int lddst, int mode, int lane, char* tb) {
    const int n4 = lane & 15, kg = lane >> 4;
    const float* s0 = src + (size_t)(k0 + kg * 16) * LDSRC + n0 + n4 * 4;
    f32x4 v[16];
#pragma unroll
    for (int it = 0; it < 16; ++it) v[it] = *(const f32x4*)(s0 + (size_t)it * LDSRC);
#pragma unroll
    for (int jn = 0; jn < 4; ++jn) {
        const int n = n4 * 4 + jn;
#pragma unroll
        for (int h = 0; h < 2; ++h) {
            const u32x4 w = {cvtpk(v[h * 8][jn], v[h * 8 + 1][jn]), cvtpk(v[h * 8 + 2][jn], v[h * 8 + 3][jn]), cvtpk(v[h * 8 + 4][jn], v[h * 8 + 5][jn]), cvtpk(v[h * 8 + 6][jn], v[h * 8 + 7][jn])};
            *(u32x4*)(tb + n * 128 + (((kg * 2 + h) ^ (n4 & 7)) << 4)) = w;
        }
    }
    asm volatile("s_waitcnt lgkmcnt(0)" ::: "memory");
#pragma unroll
    for (int it = 0; it < 8; ++it) {
        const int n = it * 8 + (lane >> 3), c = lane & 7;
        const u32x4 w = *(const u32x4*)(tb + n * 128 + ((c ^ ((n >> 2) & 7)) << 4));
        const int nn = n0 + n; int row = nn;
        if (mode == 1 || mode == 2) { const int ct = nn >> 7; row = ct * 256 + (mode == 2 ? 128 : 0) + (nn & 127); }
        *(u32x4*)(dst + (size_t)row * lddst + k0 + c * 8) = w;
    }
}
__device__ __forceinline__ void convert_tile_wave(const MK& p, int j, int lane, char* tb) {
    if (j < CV_E13) {
        const int e = j / 128, r = j % 128, which = r / 64, tt = r % 64;
        const float* src = e < 64 ? (which ? p.ew3 : p.ew1) + (size_t)e * D * DE : (which ? p.sw3 : p.sw1);
        tr_wave<DE>(src, (tt / 4) * 64, (tt % 4) * 64, p.W13t() + (size_t)e * 512 * 1024, 1024, 1 + which, lane, tb); return; }
    j -= CV_E13;
    { const int e = j / 64, tt = j % 64;
      const float* src = e < 64 ? p.ew2 + (size_t)e * DE * D : p.sw2;
      tr_wave<D>(src, (tt / 16) * 64, (tt % 16) * 64, p.W2t() + (size_t)e * 1024 * 256, 256, 0, lane, tb); }
}
__device__ __forceinline__ void ph_convert_dyn(const MK& p, int tid_l) {
    const int lane = tid_l & 63;
    char* tb = smem + (tid_l >> 6) * 8192;
    __syncthreads();
    for (;;) {
        int j = 0;
        if (lane == 0) j = atomicAdd(&p.cnt()[200], 8);
        j = __builtin_amdgcn_readfirstlane(j);
        if (j >= CV_E13) break;
#pragma unroll 1
        for (int k = 0; k < 8; ++k) if (j + k < CV_E13) convert_tile_wave(p, j + k, lane, tb);
    }
}

__device__ __forceinline__ void ph_ln1(const MK& p, int bid, int nb, int tid_l) {
    const int wid = tid_l >> 6, lane = tid_l & 63;
    for (int R = bid * 8 + wid; R < NR; R += nb * 8) {
        int b = R / RB, i = R % RB;
        const float* src = i < CTX ? p.ctx + ((size_t)b * CTX + i) * D : p.x + ((size_t)b * SEQ + (i - CTX)) * D;
        const float* m = p.mod() + (size_t)(i < CTX ? 4 : b) * 6 * D;
        float4 v[4]; float ss = 0;
#pragma unroll
        for (int q = 0; q < 4; ++q) { v[q] = *(const float4*)(src + q * 256 + lane * 4); ss += v[q].x * v[q].x + v[q].y * v[q].y + v[q].z * v[q].z + v[q].w * v[q].w; }
        ss = wave_sum(ss);
        float rstd = rsqrtf(ss * (1.0f / D) + EPS);
#pragma unroll
        for (int q = 0; q < 4; ++q) {
            int c0 = q * 256 + lane * 4;
            float4 gg = *(const float4*)(p.norm1_g + c0), sh = *(const float4*)(m + c0), sc = *(const float4*)(m + D + c0);
            float o0 = v[q].x * rstd * gg.x * (1 + sc.x) + sh.x, o1 = v[q].y * rstd * gg.y * (1 + sc.y) + sh.y;
            float o2 = v[q].z * rstd * gg.z * (1 + sc.z) + sh.z, o3 = v[q].w * rstd * gg.w * (1 + sc.w) + sh.w;
            u32x2 w; w.x = cvtpk(o0, o1); w.y = cvtpk(o2, o3);
            *(u32x2*)(p.H() + (size_t)R * D + c0) = w;
        }
    }
}

__device__ __forceinline__ int lds_byte(int r, int c) { int st = (r >> 4) * 2 + (c >> 5), ob = (r & 15) * 64 + (c & 31) * 2; return st * 1024 + (ob ^ (((ob >> 9) & 1) << 5)); }
__device__ __forceinline__ void stage_rc(int b, int& R, int& C) { int st = b >> 10, sb = b & 1023, swz = sb ^ (((sb >> 9) & 1) << 5); R = (st / 2) * 16 + swz / 64; C = (st % 2) * 32 + (swz % 64) / 2; }
#define WAIT_V0() asm volatile("s_waitcnt vmcnt(0)" ::: "memory")
__device__ __forceinline__ void gemm_core(const char* Abase, const unsigned (&Ao)[4], const char* Bbase, const unsigned (&Bo)[4], int nt, f32x4 (&acc)[8][4], int tid_l, bool pre) {
    const int tid = tid_l, wid = tid >> 6, lane = tid & 63, wr = wid >> 2, wc = wid & 3, fr = lane & 15, fq = lane >> 4;
#pragma unroll
    for (int m = 0; m < 8; ++m)
#pragma unroll
        for (int n = 0; n < 4; ++n) acc[m][n] = (f32x4){0.f, 0.f, 0.f, 0.f};
#define G_SA(b) (smem + (b) * 32768)
#define G_SB(b) (smem + 65536 + (b) * 32768)
#define G_STAGE(buf, kt) do { _Pragma("unroll") for (int i = 0; i < 4; ++i) {                                                     \
        __builtin_amdgcn_global_load_lds((const unsigned*)(Abase + (Ao[i] + (unsigned)(kt) * 128u)), (unsigned*)(G_SA(buf) + wid * 1024 + i * 8192), 16, 0, 0); \
        __builtin_amdgcn_global_load_lds((const unsigned*)(Bbase + (Bo[i] + (unsigned)(kt) * 128u)), (unsigned*)(G_SB(buf) + wid * 1024 + i * 8192), 16, 0, 0); } } while (0)
    if (!pre) G_STAGE(0, 0);
    WAIT_V0(); __syncthreads();
#define G_KSTEP(cur, t) do {                                                                                                   \
        if ((t) + 1 < nt) G_STAGE((cur) ^ 1, (t) + 1);                                                                          \
        _Pragma("unroll") for (int ks = 0; ks < 2; ++ks) {                                                                      \
            bf16x8 At[8], Bf[4];                                                                                                \
            _Pragma("unroll") for (int m = 0; m < 8; ++m) At[m] = *(const bf16x8*)(G_SA(cur) + lds_byte(wr * 128 + m * 16 + fr, ks * 32 + fq * 8)); \
            _Pragma("unroll") for (int n = 0; n < 4; ++n) Bf[n] = *(const bf16x8*)(G_SB(cur) + lds_byte(wc * 64 + n * 16 + fr, ks * 32 + fq * 8));  \
            _Pragma("unroll") for (int m = 0; m < 8; ++m) _Pragma("unroll") for (int n = 0; n < 4; ++n)                         \
                acc[m][n] = __builtin_amdgcn_mfma_f32_16x16x32_bf16(Bf[n], At[m], acc[m][n], 0, 0, 0);                          \
            __builtin_amdgcn_sched_barrier(0);                                                                                  \
        }                                                                                                                       \
        WAIT_V0(); __syncthreads(); } while (0)
#pragma unroll 1
    for (int t = 0; t < nt; ++t) { const int cur = t & 1; G_KSTEP(cur, t); }
}
#ifndef XPREFETCH
#define XPREFETCH 0
#endif
__device__ __forceinline__ void gemm_prefetch(const char* Abase, const unsigned (&Ao)[4], const char* Bbase, const unsigned (&Bo)[4], int tid_l) {
    const int wid = tid_l >> 6;
    G_STAGE(0, 0);
}
__device__ __forceinline__ void stage_offs(unsigned ld_bytes, unsigned (&P)[4], int tid_l) {
    const int wid = tid_l >> 6, lane = tid_l & 63;
#pragma unroll
    for (int i = 0; i < 4; ++i) { int R, C; stage_rc(wid * 1024 + i * 8192 + lane * 16, R, C); P[i] = (unsigned)R * ld_bytes + (unsigned)C * 2u; }
}

constexpr int WAREA = 18432;
__device__ __forceinline__ char* wave_area(int wid) { return smem + wid * WAREA; }

constexpr int A_KVBLK = 64;
constexpr float A_SCALE = 0.125f, A_THR = 8.f;
constexpr int A_SHM_V = A_KVBLK * 128 * 2, A_SHM_K = A_KVBLK * 128 * 2;
#define KSWZ(row, colB) ((row) * 256 + ((colB) ^ (((row) & 7) << 4)))
#define SBAR() __builtin_amdgcn_sched_barrier(0)
__device__ __forceinline__ int crow(int r, int hi) { return (r & 3) + 8 * (r >> 2) + 4 * hi; }

constexpr float A_THRL = 11.0f;
template <bool FIRST> __device__ __forceinline__ void partialSM2(f32x16& p0, f32x16& p1, float& mhat, f32x16& negm, float& alpha) {
    float pmax = p0[0];
#pragma unroll
    for (int r = 1; r < 16; ++r) pmax = fmaxf(pmax, p0[r]);
#pragma unroll
    for (int r = 0; r < 16; ++r) pmax = fmaxf(pmax, p1[r]);
    { auto rr = __builtin_amdgcn_permlane32_swap(__float_as_uint(pmax), __float_as_uint(pmax), false, false);
      pmax = fmaxf(__uint_as_float(rr[0]), __uint_as_float(rr[1])); }
    alpha = 1.f;
    if (FIRST || __builtin_expect(__any(pmax > A_THRL), 0)) {
        const float dl = FIRST ? pmax : fmaxf(pmax, 0.f);
        mhat += dl;
#pragma unroll
        for (int r = 0; r < 16; ++r) { p0[r] -= dl; p1[r] -= dl; }
#pragma unroll
        for (int r = 0; r < 16; ++r) negm[r] = -mhat;
        if (!FIRST) alpha = __builtin_amdgcn_exp2f(-dl);
    }
#pragma unroll
    for (int r = 0; r < 16; ++r) p0[r] = __builtin_amdgcn_exp2f(p0[r]);
}
__device__ __forceinline__ void qkt2(f32x16& p0, f32x16& p1, const char* Ks, const bf16x8* qr, const f32x16& negm, int r32, int hi, int mapc) {
#pragma unroll
    for (int d0 = 0; d0 < 4; ++d0) { int cb = (mapc + d0 * 16 + hi * 8) * 2;
        bf16x8 b0 = *reinterpret_cast<const bf16x8*>(Ks + KSWZ(r32, cb));
        bf16x8 b1 = *reinterpret_cast<const bf16x8*>(Ks + KSWZ(32 + r32, cb));
        if (d0 == 0) { p0 = __builtin_amdgcn_mfma_f32_32x32x16_bf16(b0, qr[0], negm, 0, 0, 0); p1 = __builtin_amdgcn_mfma_f32_32x32x16_bf16(b1, qr[0], negm, 0, 0, 0); }
        else { p0 = __builtin_amdgcn_mfma_f32_32x32x16_bf16(b0, qr[d0], p0, 0, 0, 0); p1 = __builtin_amdgcn_mfma_f32_32x32x16_bf16(b1, qr[d0], p1, 0, 0, 0); } }
}
template <int PROBE = 0> __device__ __forceinline__ void partialSM(f32x16& p0, f32x16& p1, float& m_reg, float& mn, float& alpha) {
    constexpr float C = A_SCALE * 1.4426950408889634f;
    float pmax = p0[0];
#pragma unroll
    for (int r = 1; r < 16; ++r) pmax = fmaxf(pmax, p0[r]);
#pragma unroll
    for (int r = 0; r < 16; ++r) pmax = fmaxf(pmax, p1[r]);
    { auto rr = __builtin_amdgcn_permlane32_swap(__float_as_uint(pmax), __float_as_uint(pmax), false, false);
      pmax = fmaxf(__uint_as_float(rr[0]), __uint_as_float(rr[1])); }
    if (__builtin_expect(__all(pmax - m_reg <= A_THR / A_SCALE), 1)) { mn = m_reg; alpha = 1.f; }
    else { mn = fmaxf(m_reg, pmax); alpha = __builtin_amdgcn_exp2f((m_reg - mn) * C); m_reg = mn; }
    float mnC = -mn * C;
#pragma unroll
    for (int r = 0; r < 16; ++r) p0[r] = fmaf(p0[r], C, mnC);
#pragma unroll
    for (int r = 0; r < 16; ++r) p1[r] = fmaf(p1[r], C, mnC);
#pragma unroll
    for (int r = 0; r < 16; ++r) p0[r] = PROBE == 3 ? p0[r] * 1e-3f : __builtin_amdgcn_exp2f(p0[r]);
}
#define PK4(P, BASE, OUT) do { unsigned a0 = cvtpk(P[BASE + 0], P[BASE + 1]), a1 = cvtpk(P[BASE + 2], P[BASE + 3]);   \
    unsigned b0 = cvtpk(P[BASE + 4], P[BASE + 5]), b1 = cvtpk(P[BASE + 6], P[BASE + 7]);                              \
    auto r0 = __builtin_amdgcn_permlane32_swap(a0, b0, false, false); auto r1 = __builtin_amdgcn_permlane32_swap(a1, b1, false, false); \
    u32x4 w = {r0[0], r1[0], r0[1], r1[1]}; OUT = *reinterpret_cast<bf16x8*>(&w); } while (0)
template <int PROBE = 0, bool DIRECT = false> __device__ __forceinline__ void finishSM(f32x16& p0, f32x16& p1, float alpha, float& l_reg, bf16x8& pa0, bf16x8& pa1, bf16x8& pa2, bf16x8& pa3) {
#pragma unroll
    for (int r = 0; r < 16; ++r) p1[r] = PROBE == 3 ? p1[r] * 1e-3f : __builtin_amdgcn_exp2f(p1[r]);
    float ps = 0;
#pragma unroll
    for (int r = 0; r < 16; ++r) ps += p0[r];
#pragma unroll
    for (int r = 0; r < 16; ++r) ps += p1[r];
    { auto rr = __builtin_amdgcn_permlane32_swap(__float_as_uint(ps), __float_as_uint(ps), false, false);
      ps = __uint_as_float(rr[0]) + __uint_as_float(rr[1]); }
    l_reg = l_reg * alpha + ps;
    if (DIRECT) {
#define PKD(P, B, OUT) do { u32x4 w = {cvtpk(P[B], P[B + 1]), cvtpk(P[B + 2], P[B + 3]), cvtpk(P[B + 4], P[B + 5]), cvtpk(P[B + 6], P[B + 7])}; OUT = *reinterpret_cast<bf16x8*>(&w); } while (0)
        PKD(p0, 0, pa0); PKD(p0, 8, pa1); PKD(p1, 0, pa2); PKD(p1, 8, pa3);
#undef PKD
    } else { PK4(p0, 0, pa0); PK4(p0, 8, pa1); PK4(p1, 0, pa2); PK4(p1, 8, pa3); }
}
__device__ __forceinline__ void qkt(f32x16& p0, f32x16& p1, const char* Ks, const bf16x8* qr, int r32, int hi, int mapc) {
    p0 = f32x16{}; p1 = f32x16{};
#pragma unroll
    for (int d0 = 0; d0 < 4; ++d0) { int cb = (mapc + d0 * 16 + hi * 8) * 2;
        bf16x8 b0 = *reinterpret_cast<const bf16x8*>(Ks + KSWZ(r32, cb));
        bf16x8 b1 = *reinterpret_cast<const bf16x8*>(Ks + KSWZ(32 + r32, cb));
        p0 = __builtin_amdgcn_mfma_f32_32x32x16_bf16(b0, qr[d0], p0, 0, 0, 0);
        p1 = __builtin_amdgcn_mfma_f32_32x32x16_bf16(b1, qr[d0], p1, 0, 0, 0); }
}
__device__ __forceinline__ int v_st(int k, int c) { const int kk = (k & ~0xC) | ((k & 4) << 1) | ((k & 8) >> 1); return ((kk >> 3) * 4 + (c >> 5)) * 512 + ((kk & 7) * 32 + (c & 31)) * 2; }
__device__ __forceinline__ int v_rd_base(int lane) { return ((lane & 3) << 3) | (((lane >> 2) & 3) << 6) | (((lane >> 4) & 1) << 5) | (((lane >> 5) & 1) << 8); }
constexpr int v_rd_off(int d0, int ks, int half) { return d0 * 512 + ks * 4096 + half * 2048; }
template <int OFF> __device__ __forceinline__ s16x4 tr_read(int vb) {
    s16x4 r; asm volatile("ds_read_b64_tr_b16 %0, %1 offset:%2" : "=&v"(r) : "v"(vb), "i"(OFF) : "memory"); return r;
}
template <int D0> __device__ __forceinline__ void pv_one(f32x16& od, int vb, bf16x8 pa0, bf16x8 pa1, bf16x8 pa2, bf16x8 pa3) {
    const s16x4 l0 = tr_read<v_rd_off(D0, 0, 0)>(vb), h0 = tr_read<v_rd_off(D0, 0, 1)>(vb), l1 = tr_read<v_rd_off(D0, 1, 0)>(vb), h1 = tr_read<v_rd_off(D0, 1, 1)>(vb);
    const s16x4 l2 = tr_read<v_rd_off(D0, 2, 0)>(vb), h2 = tr_read<v_rd_off(D0, 2, 1)>(vb), l3 = tr_read<v_rd_off(D0, 3, 0)>(vb), h3 = tr_read<v_rd_off(D0, 3, 1)>(vb);
    asm volatile("s_waitcnt lgkmcnt(0)" ::: "memory"); SBAR();
#define PKV(L, H) (bf16x8){L[0], L[1], L[2], L[3], H[0], H[1], H[2], H[3]}
    od = __builtin_amdgcn_mfma_f32_32x32x16_bf16(pa0, PKV(l0, h0), od, 0, 0, 0);
    od = __builtin_amdgcn_mfma_f32_32x32x16_bf16(pa1, PKV(l1, h1), od, 0, 0, 0);
    od = __builtin_amdgcn_mfma_f32_32x32x16_bf16(pa2, PKV(l2, h2), od, 0, 0, 0);
    od = __builtin_amdgcn_mfma_f32_32x32x16_bf16(pa3, PKV(l3, h3), od, 0, 0, 0);
}
template <int D0> __device__ __forceinline__ void pv_two(f32x16& oa, f32x16& ob, int vb, bf16x8 pa0, bf16x8 pa1, bf16x8 pa2, bf16x8 pa3) {
    const s16x4 l0 = tr_read<v_rd_off(D0, 0, 0)>(vb), h0 = tr_read<v_rd_off(D0, 0, 1)>(vb), l1 = tr_read<v_rd_off(D0, 1, 0)>(vb), h1 = tr_read<v_rd_off(D0, 1, 1)>(vb);
    const s16x4 l2 = tr_read<v_rd_off(D0, 2, 0)>(vb), h2 = tr_read<v_rd_off(D0, 2, 1)>(vb), l3 = tr_read<v_rd_off(D0, 3, 0)>(vb), h3 = tr_read<v_rd_off(D0, 3, 1)>(vb);
    const s16x4 m0 = tr_read<v_rd_off(D0 + 1, 0, 0)>(vb), g0 = tr_read<v_rd_off(D0 + 1, 0, 1)>(vb), m1 = tr_read<v_rd_off(D0 + 1, 1, 0)>(vb), g1 = tr_read<v_rd_off(D0 + 1, 1, 1)>(vb);
    const s16x4 m2 = tr_read<v_rd_off(D0 + 1, 2, 0)>(vb), g2 = tr_read<v_rd_off(D0 + 1, 2, 1)>(vb), m3 = tr_read<v_rd_off(D0 + 1, 3, 0)>(vb), g3 = tr_read<v_rd_off(D0 + 1, 3, 1)>(vb);
    asm volatile("s_waitcnt lgkmcnt(0)" ::: "memory"); SBAR();
    oa = __builtin_amdgcn_mfma_f32_32x32x16_bf16(pa0, PKV(l0, h0), oa, 0, 0, 0);
    ob = __builtin_amdgcn_mfma_f32_32x32x16_bf16(pa0, PKV(m0, g0), ob, 0, 0, 0);
    oa = __builtin_amdgcn_mfma_f32_32x32x16_bf16(pa1, PKV(l1, h1), oa, 0, 0, 0);
    ob = __builtin_amdgcn_mfma_f32_32x32x16_bf16(pa1, PKV(m1, g1), ob, 0, 0, 0);
    oa = __builtin_amdgcn_mfma_f32_32x32x16_bf16(pa2, PKV(l2, h2), oa, 0, 0, 0);
    ob = __builtin_amdgcn_mfma_f32_32x32x16_bf16(pa2, PKV(m2, g2), ob, 0, 0, 0);
    oa = __builtin_amdgcn_mfma_f32_32x32x16_bf16(pa3, PKV(l3, h3), oa, 0, 0, 0);
    ob = __builtin_amdgcn_mfma_f32_32x32x16_bf16(pa3, PKV(m3, g3), ob, 0, 0, 0);
}
__device__ __forceinline__ void pv_d0(f32x16* o, int vb, bf16x8 pa0, bf16x8 pa1, bf16x8 pa2, bf16x8 pa3) {
    pv_one<0>(o[0], vb, pa0, pa1, pa2, pa3); pv_one<1>(o[1], vb, pa0, pa1, pa2, pa3); pv_one<2>(o[2], vb, pa0, pa1, pa2, pa3); pv_one<3>(o[3], vb, pa0, pa1, pa2, pa3);
}

template <int PROBE> __device__ __forceinline__ void attn_item(const bf16_t* __restrict__ Qb, const bf16_t* __restrict__ Kh, const bf16_t* __restrict__ Vh, bf16_t* __restrict__ mixrow,
                                          const float* __restrict__ gd, float lam, int tid_l) {
    char* lds = smem;
    const int tid = tid_l, wid = tid >> 6, lane = tid & 63, r32 = lane & 31, hi = lane >> 5;
    const int map = wid >> 2, wq = wid & 3, mapc = map * 64;
    char* K_lds = lds; char* V_lds = lds + 4 * A_SHM_K;
    float* wsw = (float*)(lds + 4 * A_SHM_V + 4 * A_SHM_K) + wid * 64; float* li_l = wsw; float* al_l = wsw + 32;
    float m_reg = 0.f, l_reg = 0; f32x16 o[4] = {}; bf16x8 qr[4]; f32x16 negm = f32x16{};
    const bf16_t* Qw = Qb + (long)(wq * 32 + r32) * 128 + mapc + hi * 8;
#pragma unroll
    for (int d0 = 0; d0 < 4; ++d0) qr[d0] = *reinterpret_cast<const bf16x8*>(Qw + d0 * 16);
    const int vb0 = (int)(uintptr_t)V_lds + v_rd_base(lane);
    unsigned kofs[2], vofs[2];
    const int widu = __builtin_amdgcn_readfirstlane(wid);
#pragma unroll
    for (int i = 0; i < 2; ++i) {
        const int x = wid * 1024 + i * 8192 + lane * 16;
        { const int row = x >> 8, cs = x & 255, colB = cs ^ ((row & 7) << 4); kofs[i] = (unsigned)(row * 256 + colB); }
        { const int sub = x >> 9, wn = x & 511, k = (sub >> 2) * 8 + (wn >> 6), c = (sub & 3) * 32 + ((wn & 63) >> 1); vofs[i] = (unsigned)(k * 256 + c * 2); }
    }
#define DMA_TILE(slot, k0) do { const char* kt_ = (const char*)Kh + (size_t)(k0) * 256; const char* vt_ = (const char*)Vh + (size_t)(k0) * 256;                  \
      _Pragma("unroll") for (int i = 0; i < 2; ++i) {                                                                   \
        __builtin_amdgcn_global_load_lds((const unsigned*)(kt_ + kofs[i]), (unsigned*)(K_lds + (slot) * A_SHM_K + widu * 1024 + i * 8192), 16, 0, 0); \
        __builtin_amdgcn_global_load_lds((const unsigned*)(vt_ + vofs[i]), (unsigned*)(V_lds + (slot) * A_SHM_V + widu * 1024 + i * 8192), 16, 0, 0); } } while (0)
#define RESC(a) do { if (__any((a) < 1.f)) { if (hi == 0) al_l[r32] = (a); asm volatile("s_waitcnt lgkmcnt(0)" ::: "memory"); \
    _Pragma("unroll") for (int d = 0; d < 4; ++d) _Pragma("unroll") for (int r = 0; r < 16; ++r) o[d][r] *= al_l[crow(r, hi)]; } } while (0)
    f32x16 pA0, pA1, pB0, pB1; float mnA, mnB, alA, alB; bf16x8 pa0, pa1, pa2, pa3; const int NT = RB / A_KVBLK;
    DMA_TILE(0, 0); DMA_TILE(1, A_KVBLK);
    asm volatile("s_waitcnt vmcnt(0)" ::: "memory"); __syncthreads();
    qkt2(pA0, pA1, K_lds, qr, negm, r32, hi, mapc); partialSM2<true>(pA0, pA1, m_reg, negm, alA);
#define ATILE(X0, X1, ALX, Y0, Y1, ALY, CS, PS, NS, T_, DODMA) do {                                                                  \
        asm volatile("s_waitcnt vmcnt(0)" ::: "memory"); __syncthreads();                                                            \
        if (DODMA && PROBE != 1) DMA_TILE(NS, ((T_) + 1) * A_KVBLK);                                                                 \
        SBAR(); qkt2(X0, X1, K_lds + (CS) * A_SHM_K, qr, negm, r32, hi, mapc);                                                       \
        finishSM<PROBE, true>(Y0, Y1, ALY, l_reg, pa0, pa1, pa2, pa3); SBAR();                                                       \
        pv_d0(o, vb0 + (PS) * A_SHM_V, pa0, pa1, pa2, pa3); partialSM2<false>(X0, X1, m_reg, negm, ALX);                             \
        RESC(ALX); } while (0)
#pragma unroll 1
    for (int j = 1; j + 3 < NT; j += 4) {
        ATILE(pB0, pB1, alB, pA0, pA1, alA, 1, 0, 2, j, true);
        ATILE(pA0, pA1, alA, pB0, pB1, alB, 2, 1, 3, j + 1, true);
        ATILE(pB0, pB1, alB, pA0, pA1, alA, 3, 2, 0, j + 2, true);
        ATILE(pA0, pA1, alA, pB0, pB1, alB, 0, 3, 1, j + 3, true);
    }
    ATILE(pB0, pB1, alB, pA0, pA1, alA, 1, 0, 2, NT - 3, true);
    ATILE(pA0, pA1, alA, pB0, pB1, alB, 2, 1, 3, NT - 2, true);
    ATILE(pB0, pB1, alB, pA0, pA1, alA, 3, 2, 0, NT - 1, false);
    finishSM<PROBE, true>(pB0, pB1, alB, l_reg, pa0, pa1, pa2, pa3); SBAR();
    pv_d0(o, vb0 + 3 * A_SHM_V, pa0, pa1, pa2, pa3);
#undef ATILE
#undef DMA_TILE
    if (hi == 0) li_l[r32] = l_reg;
    asm volatile("s_waitcnt lgkmcnt(0)" ::: "memory");
    float rl[16];
#pragma unroll
    for (int r = 0; r < 16; ++r) rl[r] = __builtin_amdgcn_rcpf(li_l[crow(r, hi)]);
    __syncthreads();
    {
        float* xo = (float*)lds + map * 16384 + (wq * 32) * 128 + r32;
#pragma unroll
        for (int r = 0; r < 16; ++r)
#pragma unroll
            for (int d0 = 0; d0 < 4; ++d0) xo[crow(r, hi) * 128 + d0 * 32] = o[d0][r] * rl[r];
    }
    __syncthreads();
    {
        int l2 = lane; asm volatile("" : "+v"(l2));
        const float g0 = gd[l2 * 2], g1 = gd[l2 * 2 + 1];
#pragma unroll 4
        for (int rr = 0; rr < 16; ++rr) {
            const int row = wid * 16 + rr;
            const float2 a0 = *(const float2*)((const float*)lds + row * 128 + l2 * 2), a1 = *(const float2*)((const float*)lds + 16384 + row * 128 + l2 * 2);
            const float xv = a0.x - lam * a1.x, yv = a0.y - lam * a1.y;
            const float ss = wave_sum(xv * xv + yv * yv);
            const float rs = rsqrtf(ss * (1.0f / 128) + EPS) * 0.8f;
            *(unsigned*)(mixrow + (long)row * 1024 + l2 * 2) = cvtpk(xv * rs * g0, yv * rs * g1);
        }
    }
    __syncthreads();
#undef RESC
}


template <int PROBE> __device__ __forceinline__ void ph_attn(const MK& p, int bid, int nb, int tid_l) {
    const int lane = tid_l & 63;
    float s1 = wave_sum(p.lq1[lane] * p.lk1[lane]), s2 = wave_sum(p.lq2[lane] * p.lk2[lane]);
    const float lam = expf(s1) - expf(s2) + 0.2f;
    const int nrounds = (1024 + nb - 1) / nb;
    for (int rr = 0; rr < nrounds; ++rr) {
        int item;
        if (nb == 256) { int x = bid & 7, j = bid >> 3, hh = rr * 8 + x; item = (hh >> 1) * 64 + (hh & 1) * 32 + j; }
        else { item = rr * nb + bid; if (item >= 1024) break; }
        const int bh = item >> 6, qb = item & 63, b = bh >> 2, h = bh & 3;
        attn_item<PROBE>(p.Q() + ((size_t)bh * SEQ + qb * 128) * 128, p.K() + (size_t)bh * RB * 128, p.V() + (size_t)bh * RB * 128,
                  PROBE ? (bf16_t*)(p.ws + 492 * MiB) + h * 128 : p.MIX() + ((size_t)(b * SEQ + qb * 128)) * 1024 + h * 128, p.dattn_g, lam, tid_l);
    }
}


__device__ __forceinline__ bf16x8 ldfrag(const bf16_t* p) { return *reinterpret_cast<const bf16x8*>(p); }

__device__ __forceinline__ void ph_kv(const MK& p, int bid, int nb, int tid_l) {
    const int wid = tid_l >> 6, lane = tid_l & 63, r32 = lane & 31, hi = lane >> 5;
    const int nitems = 16 * 2 * 66;
    for (int it = bid * 8 + wid; it < nitems; it += nb * 8) {
        const int c = it % 66, chain = it / 66, dir = chain & 1, bh = chain >> 1;
        const bf16_t* vt = p.VT() + (size_t)bh * 128 * RB + c * 128 + hi * 8;
        const bf16_t* kt = (dir ? p.KTb() : p.KTf()) + (size_t)bh * 64 * RB + c * 128 + hi * 8;
        f32x16 acc[4][2];
#pragma unroll
        for (int mt = 0; mt < 4; ++mt) { acc[mt][0] = f32x16{}; acc[mt][1] = f32x16{}; }
#pragma unroll 2
        for (int ks = 0; ks < 8; ++ks) {
            bf16x8 a[4], b[2];
#pragma unroll
            for (int mt = 0; mt < 4; ++mt) a[mt] = ldfrag(vt + (size_t)(mt * 32 + r32) * RB + ks * 16);
#pragma unroll
            for (int nt = 0; nt < 2; ++nt) b[nt] = ldfrag(kt + (size_t)(nt * 32 + r32) * RB + ks * 16);
#pragma unroll
            for (int mt = 0; mt < 4; ++mt)
#pragma unroll
                for (int nt = 0; nt < 2; ++nt) acc[mt][nt] = __builtin_amdgcn_mfma_f32_32x32x16_bf16(a[mt], b[nt], acc[mt][nt], 0, 0, 0);
        }
        bf16_t* dst = p.KV() + (size_t)it * 8192;
#pragma unroll
        for (int mt = 0; mt < 4; ++mt)
#pragma unroll
            for (int nt = 0; nt < 2; ++nt)
#pragma unroll
                for (int r = 0; r < 16; ++r) dst[(mt * 32 + crow(r, hi)) * 64 + nt * 32 + r32] = f2bf(acc[mt][nt][r]);
    }
}

__device__ __forceinline__ void ph_scan(const MK& p, int bid, int nb, int tid_l) {
    if (tid_l >= 256) {
        const int lane = tid_l & 63, wq = __builtin_amdgcn_readfirstlane(tid_l >> 6); char* tb = smem + wq * 8192;
#pragma unroll 1
        for (int j = CV_E13 + bid * 4 + (wq - 4); j < CV_E13 + CV_E2; j += nb * 4) convert_tile_wave(p, j, lane, tb);
        return;
    }
    for (int e0 = bid * 256 + tid_l; e0 < 32 * 8192; e0 += nb * 1024) {
        float S[4], g128[4]; const bf16_t* kv[4]; bf16_t* st[4]; int dir[4];
#pragma unroll
        for (int q = 0; q < 4; ++q) {
            int e = e0 + q * nb * 256; if (e >= 32 * 8192) e = e0;
            const int chain = e >> 13, el = e & 8191, h = (chain >> 1) & 3; dir[q] = chain & 1;
            const float d = dir[q] ? p.dec_b[h] : p.dec_f[h];
            g128[q] = exp2f(128.0f * log2f(1.0f / (1.0f + expf(-d))));
            kv[q] = p.KV() + (size_t)chain * 66 * 8192 + el; st[q] = p.ST() + (size_t)chain * 66 * 8192 + el; S[q] = 0.f;
        }
#pragma unroll 2
        for (int n = 0; n < 66; ++n) {
            const int cb = n == 0 ? 1 : (n == 1 ? 0 : 67 - n);
            float x[4];
#pragma unroll
            for (int q = 0; q < 4; ++q) x[q] = bf2f(kv[q][(size_t)(dir[q] ? cb : n) * 8192]);
#pragma unroll
            for (int q = 0; q < 4; ++q) { st[q][(size_t)(dir[q] ? cb : n) * 8192] = f2bf(S[q]); S[q] = fmaf(g128[q], S[q], x[q]); }
        }
    }
}

__device__ __forceinline__ void ph_ret(const MK& p, int bid, int nb, int tid_l) {
    const int tid = tid_l, wid = tid >> 6, lane = tid & 63, r32 = lane & 31, hi = lane >> 5, wq = wid & 3, half = wid >> 2;
    float* img = (float*)smem;
    for (int it = bid; it < 4 * 64 * 2; it += nb) {
        const int hp = it & 1, lc = (it >> 1) & 63, b = it >> 7, h = hp * 2 + half, bh = b * 4 + h;
        const int ib = CTX + lc * 128, c = 2 + lc;
        const float lf = log2f(1.0f / (1.0f + expf(-p.dec_f[h]))), lb = log2f(1.0f / (1.0f + expf(-p.dec_b[h])));
        const bf16_t* rq = p.RQ() + ((size_t)bh * RB + ib + wq * 32 + r32) * 64 + hi * 8;
        bf16x8 q[4];
#pragma unroll
        for (int ks = 0; ks < 4; ++ks) q[ks] = ldfrag(rq + ks * 16);
        f32x16 o[4];
        {
            const bf16_t* stf = p.ST() + ((size_t)(bh * 2 + 0) * 66 + c) * 8192 + hi * 8;
            const bf16_t* stb = p.ST() + ((size_t)(bh * 2 + 1) * 66 + c) * 8192 + hi * 8;
            {
                float rf[16];
#pragma unroll
                for (int r = 0; r < 16; ++r) rf[r] = __builtin_amdgcn_exp2f((float)(wq * 32 + crow(r, hi) + 1) * lf);
#pragma unroll
                for (int d0 = 0; d0 < 4; ++d0) {
                    f32x16 tf = f32x16{};
#pragma unroll
                    for (int ks = 0; ks < 4; ++ks) tf = __builtin_amdgcn_mfma_f32_32x32x16_bf16(q[ks], ldfrag(stf + (size_t)(d0 * 32 + r32) * 64 + ks * 16), tf, 0, 0, 0);
#pragma unroll
                    for (int r = 0; r < 16; ++r) o[d0][r] = tf[r] * rf[r];
                    asm volatile("" ::: "memory");
                }
            }
            {
                float rf[16];
#pragma unroll
                for (int r = 0; r < 16; ++r) rf[r] = __builtin_amdgcn_exp2f((float)(128 - (wq * 32 + crow(r, hi))) * lb);
#pragma unroll
                for (int d0 = 0; d0 < 4; ++d0) {
                    f32x16 tb = f32x16{};
#pragma unroll
                    for (int ks = 0; ks < 4; ++ks) tb = __builtin_amdgcn_mfma_f32_32x32x16_bf16(q[ks], ldfrag(stb + (size_t)(d0 * 32 + r32) * 64 + ks * 16), tb, 0, 0, 0);
#pragma unroll
                    for (int r = 0; r < 16; ++r) o[d0][r] += tb[r] * rf[r];
                    asm volatile("" ::: "memory");
                }
            }
        }
        {
            const int qi = wq * 32 + r32;
            const bf16_t* vt = p.VT() + (size_t)bh * 128 * RB + ib + hi * 8;
#pragma unroll 1
            for (int jb = 0; jb < 4; ++jb) {
                asm volatile("" ::: "memory");
                const bf16_t* rk = p.RK() + ((size_t)bh * RB + ib + jb * 32 + r32) * 64 + hi * 8;
                f32x16 pp = f32x16{};
#pragma unroll
                for (int ks = 0; ks < 4; ++ks) pp = __builtin_amdgcn_mfma_f32_32x32x16_bf16(ldfrag(rk + ks * 16), q[ks], pp, 0, 0, 0);
#pragma unroll
                for (int r = 0; r < 16; ++r) {
                    const int dd = qi - (jb * 32 + crow(r, hi));
                    const float ex = __builtin_amdgcn_exp2f(dd > 0 ? (float)dd * lf : (float)(-dd) * lb); const float w = dd == 0 ? 2.0f : ex;
                    pp[r] *= w;
                }
                bf16x8 pa0, pa1;
                PK4(pp, 0, pa0); PK4(pp, 8, pa1);
#pragma unroll
                for (int d0 = 0; d0 < 4; ++d0) {
                    o[d0] = __builtin_amdgcn_mfma_f32_32x32x16_bf16(pa0, ldfrag(vt + (size_t)(d0 * 32 + r32) * RB + jb * 32), o[d0], 0, 0, 0);
                    o[d0] = __builtin_amdgcn_mfma_f32_32x32x16_bf16(pa1, ldfrag(vt + (size_t)(d0 * 32 + r32) * RB + jb * 32 + 16), o[d0], 0, 0, 0);
                }
            }
        }
        __syncthreads();
        {
            float* xo = img + half * 16384 + (wq * 32) * 128 + r32;
#pragma unroll
            for (int r = 0; r < 16; ++r)
#pragma unroll
                for (int d0 = 0; d0 < 4; ++d0) xo[crow(r, hi) * 128 + d0 * 32] = o[d0][r];
        }
        __syncthreads();
        {
            const float g0 = p.ret_g[lane * 2], g1 = p.ret_g[lane * 2 + 1];
#pragma unroll 4
            for (int rr = 0; rr < 32; ++rr) {
                const int row = wid * 32 + rr, itl = row >> 7, rw = row & 127, hh = hp * 2 + itl;
                const float2 a = *(const float2*)(img + row * 128 + lane * 2);
                const float ss = wave_sum(a.x * a.x + a.y * a.y);
                const float rs = rsqrtf(ss * (1.0f / 128) + EPS);
                const size_t tt = (size_t)b * SEQ + lc * 128 + rw;
                const unsigned gg = *(const unsigned*)(p.RG() + tt * 512 + hh * 128 + lane * 2);
                const float ga = bf2f((bf16_t)(gg & 0xffff)), gb = bf2f((bf16_t)(gg >> 16));
                *(unsigned*)(p.MIX() + tt * 1024 + 512 + hh * 128 + lane * 2) = cvtpk(silu_fast(ga) * a.x * rs * g0, silu_fast(gb) * a.y * rs * g1);
            }
        }
    }
}


namespace pg8 {
constexpr int BM = 256, BK = 64, HALF = 128, HTB = HALF * BK * 2;
__device__ __forceinline__ int perm32(int rho) { const int n = rho >> 4, i = rho & 15; return 8 * (i >> 2) + 4 * n + (i & 3); }
struct GUnit { const char* A; const char* B; int i0, i1, i2, i3; };
template <class Epi, class Sched, bool GATHER, bool ALIGN_EPI>
__device__ __forceinline__ void gemm(int K, const Sched& S, const Epi& E, int tid_l) {
    const int tid = tid_l, wid = __builtin_amdgcn_readfirstlane(tid >> 6), lane = tid & 63, wr = wid >> 2, wc = wid & 3, fr = lane & 15, fq = lane >> 4;
    const int nt = K / BK;
    unsigned voffB[2], vAc[2][2], vAn[2][2];
    const size_t kstep = (size_t)(BK * 2);
    const size_t hstepB = (size_t)HALF * K * 2;
#pragma unroll
    for (int i = 0; i < 2; ++i) { int R, C; stage_rc(tid * 16 + i * 8192, R, C); const int Rb = Epi::PERM ? ((R & ~31) + perm32(R & 31)) : R;
        voffB[i] = (unsigned)(Rb * K + C) * 2u; }
    const unsigned ldsw = (unsigned)wid * 1024u;
    const int aoff = lds_byte(wr * 64 + fr, fq * 8), boff = lds_byte(wc * 32 + fr, fq * 8);
#define PG8_SA(b, h) (((b) * 2 + (h)) * HTB)
#define PG8_SB(b, h) ((4 + (b) * 2 + (h)) * HTB)
#define PG8_STAGE(bufoff, gbase, voff) do { _Pragma("unroll") for (int _i = 0; _i < 2; ++_i) \
        __builtin_amdgcn_global_load_lds((const unsigned*)((const char*)(gbase) + (voff)[_i]), (unsigned*)(smem + (bufoff) + ldsw + _i * 8192), 16, 0, 0); } while (0)
#define PG8_LDA(dst, b, h) do { _Pragma("unroll") for (int m = 0; m < 4; ++m) _Pragma("unroll") for (int k = 0; k < 2; ++k) dst[m][k] = *(const bf16x8*)(smem + PG8_SA(b, h) + aoff + m * 2048 + k * 1024); } while (0)
#define PG8_LDB(dst, b, h) do { _Pragma("unroll") for (int n = 0; n < 2; ++n) _Pragma("unroll") for (int k = 0; k < 2; ++k) dst[n][k] = *(const bf16x8*)(smem + PG8_SB(b, h) + boff + n * 2048 + k * 1024); } while (0)
#define PG8_MMA(ai, bj, At, Bt) do { __builtin_amdgcn_s_setprio(1); _Pragma("unroll") for (int m = 0; m < 4; ++m) _Pragma("unroll") for (int n = 0; n < 2; ++n) _Pragma("unroll") for (int k = 0; k < 2; ++k) \
        acc[ai][bj][m][n] = __builtin_amdgcn_mfma_f32_16x16x32_bf16(Bt[n][k], At[m][k], acc[ai][bj][m][n], 0, 0, 0); __builtin_amdgcn_s_setprio(0); } while (0)
#define PG8_WAIT_V(n) asm volatile("s_waitcnt vmcnt(" #n ")" ::: "memory")
#define PG8_WAIT_L(n) asm volatile("s_waitcnt lgkmcnt(" #n ")" ::: "memory")
#define PG8_BAR __builtin_amdgcn_s_barrier()
#define PG8_SCHED __builtin_amdgcn_sched_barrier(0)
    GUnit cur, nxt; int ui = 0;
    if (!S.next(0, cur, vAc)) return;
    f32x4 acc[2][2][4][2];
#pragma unroll
    for (int a = 0; a < 2; ++a)
#pragma unroll
        for (int b = 0; b < 2; ++b)
#pragma unroll
            for (int m = 0; m < 4; ++m)
#pragma unroll
                for (int n = 0; n < 2; ++n) acc[a][b][m][n] = (f32x4){0.f, 0.f, 0.f, 0.f};
    bf16x8 At[4][2], B0[2][2], B1[2][2];
    const char* cA = cur.A; const char* cB = cur.B;
    PG8_STAGE(PG8_SB(0, 0), cB, voffB); PG8_STAGE(PG8_SB(0, 1), cB + hstepB, voffB); PG8_STAGE(PG8_SA(0, 0), cA, vAc[0]); PG8_STAGE(PG8_SA(0, 1), cA, vAc[1]);
    if (wr == 1) PG8_BAR;
    PG8_WAIT_V(2); PG8_BAR;
    PG8_STAGE(PG8_SB(1, 0), cB + kstep, voffB); PG8_STAGE(PG8_SA(1, 0), cA + kstep, vAc[0]); PG8_STAGE(PG8_SB(1, 1), cB + hstepB + kstep, voffB);
    PG8_WAIT_V(6); PG8_BAR;
    for (;;) {
        const bool has_next = S.next(ui + 1, nxt, vAn);
        if (!GATHER || !has_next) {
#pragma unroll
            for (int h = 0; h < 2; ++h)
#pragma unroll
                for (int i = 0; i < 2; ++i) vAn[h][i] = vAc[h][i];
        }
        const char* nA = has_next ? nxt.A : cA; const char* nB = has_next ? nxt.B : cB;
#pragma unroll 1
        for (int t = 0; t < nt; t += 2) {
            const bool last = (t == nt - 2);
            const char* a1 = cA + (size_t)(t + 1) * kstep;
            const char* a2 = last ? nA : cA + (size_t)(t + 2) * kstep; const char* b2 = last ? nB : cB + (size_t)(t + 2) * kstep;
            const char* a3 = a2 + kstep; const char* b3 = b2 + kstep;
            unsigned va2[2][2];
#pragma unroll
            for (int h = 0; h < 2; ++h)
#pragma unroll
                for (int i = 0; i < 2; ++i) va2[h][i] = (GATHER && last) ? vAn[h][i] : vAc[h][i];
            PG8_LDB(B0, 0, 0); PG8_LDB(B1, 0, 1); PG8_SCHED; PG8_LDA(At, 0, 0); PG8_STAGE(PG8_SA(1, 1), a1, vAc[1]);
            PG8_WAIT_V(8); PG8_WAIT_L(0); PG8_BAR; PG8_MMA(0, 0, At, B0); PG8_MMA(0, 1, At, B1); PG8_BAR; PG8_SCHED;
            PG8_LDA(At, 0, 1); PG8_STAGE(PG8_SB(0, 0), b2, voffB); PG8_STAGE(PG8_SB(0, 1), b2 + hstepB, voffB); PG8_STAGE(PG8_SA(0, 0), a2, va2[0]);
            PG8_WAIT_V(8); PG8_WAIT_L(0); PG8_BAR; PG8_MMA(1, 0, At, B0); PG8_MMA(1, 1, At, B1); PG8_BAR; PG8_SCHED;
            PG8_LDB(B0, 1, 0); PG8_LDB(B1, 1, 1); PG8_SCHED; PG8_LDA(At, 1, 0); PG8_STAGE(PG8_SA(0, 1), a2, va2[1]);
            PG8_WAIT_V(8); PG8_WAIT_L(0); PG8_BAR; PG8_MMA(0, 0, At, B0); PG8_MMA(0, 1, At, B1); PG8_BAR; PG8_SCHED;
            PG8_LDA(At, 1, 1); PG8_STAGE(PG8_SB(1, 0), b3, voffB); PG8_STAGE(PG8_SB(1, 1), b3 + hstepB, voffB); PG8_STAGE(PG8_SA(1, 0), a3, va2[0]);
            PG8_WAIT_V(8); PG8_WAIT_L(0); PG8_BAR; PG8_MMA(1, 0, At, B0); PG8_MMA(1, 1, At, B1); PG8_BAR; PG8_SCHED;
        }
        if (ALIGN_EPI) { if (wr == 0) PG8_BAR; }
        E(acc, cur, wr, wc, fr, fq);
        if (!has_next) break;
#pragma unroll
        for (int a = 0; a < 2; ++a)
#pragma unroll
            for (int b = 0; b < 2; ++b)
#pragma unroll
                for (int m = 0; m < 4; ++m)
#pragma unroll
                    for (int n = 0; n < 2; ++n) acc[a][b][m][n] = (f32x4){0.f, 0.f, 0.f, 0.f};
        cur = nxt; cA = nA; cB = nB; ++ui;
#pragma unroll
        for (int h = 0; h < 2; ++h)
#pragma unroll
            for (int i = 0; i < 2; ++i) vAc[h][i] = vAn[h][i];
        if (ALIGN_EPI) { if (wr == 1) PG8_BAR; }
    }
    PG8_WAIT_V(0);
    if (!ALIGN_EPI) { if (wr == 0) PG8_BAR; }
    PG8_BAR;
#undef PG8_SA
#undef PG8_SB
#undef PG8_STAGE
#undef PG8_LDA
#undef PG8_LDB
#undef PG8_MMA
#undef PG8_WAIT_V
#undef PG8_WAIT_L
#undef PG8_BAR
#undef PG8_SCHED
}
__device__ __forceinline__ void plain_voffA(int K, unsigned (&vA)[2][2], int tid_l) {
#pragma unroll
    for (int i = 0; i < 2; ++i) { int R, C; stage_rc(tid_l * 16 + i * 8192, R, C); vA[0][i] = (unsigned)(R * K + C) * 2u; vA[1][i] = (unsigned)((R + HALF) * K + C) * 2u; }
}
}


__device__ __forceinline__ int xcd_vbid(int bid, int nb) { return (nb & 7) ? bid : (bid & 7) * (nb >> 3) + (bid >> 3); }
struct SchedIn { const MK* p; int bid, nb, tid_l;
    __device__ __forceinline__ bool next(int i, pg8::GUnit& u, unsigned (&vA)[2][2]) const {
        const int tile = xcd_vbid(bid, nb) + i * nb; if (tile >= (NR / 256) * 12) return false;
        const int pm = tile / 12, pn = tile % 12;
        u.A = (const char*)(p->H() + (size_t)(pm * 256) * D); u.B = (const char*)(p->w_inT() + (size_t)(pn * 256) * D); u.i0 = pm; u.i1 = pn; u.i2 = 0; u.i3 = 0;
        pg8::plain_voffA(D, vA, tid_l); return true; } };
struct EpiIn { static constexpr bool PERM = false; const MK* p;
    __device__ __forceinline__ void operator()(f32x4 (&acc)[2][2][4][2], const pg8::GUnit& u, int wr, int wc, int fr_in, int fq_in) const {
        int fr = fr_in, fq = fq_in; asm volatile("" : "+v"(fr), "+v"(fq));
        const int pm = u.i0, seg = u.i1, brow = pm * 256;
        const int b = brow / RB, i0 = brow % RB;
        const bool lat = i0 >= CTX;
        const int wid = wr * 4 + wc, lane = fq * 16 + fr;
        if (lat && (seg <= 3 || seg == 6 || seg == 7)) {
#pragma unroll
            for (int ai = 0; ai < 2; ++ai)
#pragma unroll
                for (int m = 0; m < 4; ++m) {
                    const int t = i0 + ai * 128 + wr * 64 + m * 16 + fr - CTX, pos = (wc & 1) ? (t & 63) : (t >> 6);
                    const f32x4 cc = *(const f32x4*)(p->ropec() + pos * 16 + fq * 4), ss = *(const f32x4*)(p->ropes() + pos * 16 + fq * 4);
#pragma unroll
                    for (int bj = 0; bj < 2; ++bj) { const f32x4 x1 = acc[ai][bj][m][0], x2 = acc[ai][bj][m][1];
                        acc[ai][bj][m][0] = x1 * cc - x2 * ss; acc[ai][bj][m][1] = x1 * ss + x2 * cc; }
                }
        }
        if (seg == 7 || seg <= 1) {
            const float sc_ = seg == 7 ? 0.125f : 0.125f * 1.4426950408889634f;
#pragma unroll
            for (int ai = 0; ai < 2; ++ai)
#pragma unroll
                for (int bj = 0; bj < 2; ++bj)
#pragma unroll
                    for (int m = 0; m < 4; ++m) { acc[ai][bj][m][0] = acc[ai][bj][m][0] * sc_; acc[ai][bj][m][1] = acc[ai][bj][m][1] * sc_; }
        }
        if (seg <= 7 || seg >= 10) {
#pragma unroll
            for (int bj = 0; bj < 2; ++bj) {
                bf16_t* base; long rstride; bool ok = true;
                if (seg <= 1)      { const int h = (seg & 1) * 2 + bj;       base = p->Q() + (((size_t)(b * 4 + h) * SEQ + (i0 - CTX)) * 128 + wc * 32 + fq * 4); rstride = 128; ok = lat; }
                else if (seg <= 3) { const int h = (seg - 2) * 2 + bj;       base = p->K() + (((size_t)(b * 4 + h) * RB + i0) * 128 + wc * 32 + fq * 4);          rstride = 128; }
                else if (seg <= 5) { const int h = (seg - 4) * 2 + bj;       base = p->V() + (((size_t)(b * 4 + h) * RB + i0) * 128 + wc * 32 + fq * 4);          rstride = 128; }
                else if (seg == 6) { const int h = bj * 2 + (wc >> 1);       base = p->RQ() + (((size_t)(b * 4 + h) * RB + i0) * 64 + (wc & 1) * 32 + fq * 4);    rstride = 64; }
                else if (seg == 7) { const int h = bj * 2 + (wc >> 1);       base = p->RK() + (((size_t)(b * 4 + h) * RB + i0) * 64 + (wc & 1) * 32 + fq * 4);    rstride = 64; }
                else               {                                         base = p->RG() + ((size_t)(b * SEQ + (i0 - CTX)) * 512 + (seg - 10) * 256 + bj * 128 + wc * 32 + fq * 4); rstride = 512; ok = lat; }
                if (ok) {
#pragma unroll
                    for (int ai = 0; ai < 2; ++ai)
#pragma unroll
                        for (int m = 0; m < 4; ++m) { bf16_t* rp = base + (long)(ai * 128 + wr * 64 + m * 16 + fr) * rstride;
#pragma unroll
                            for (int n = 0; n < 2; ++n) { u32x2 w; w.x = cvtpk(acc[ai][bj][m][n][0], acc[ai][bj][m][n][1]); w.y = cvtpk(acc[ai][bj][m][n][2], acc[ai][bj][m][n][3]);
                                *(u32x2*)(rp + n * 16) = w; } }
                }
            }
        }
        if (seg >= 7 && seg <= 9) {
            char* img = smem + 131072 + wid * 3968;
            const int npass = seg == 7 ? 2 : 1;
#pragma unroll 1
            for (int ps = 0; ps < npass; ++ps) {
#pragma unroll
                for (int bj = 0; bj < 2; ++bj) {
                    float lg2 = 0.f; bf16_t* baseT;
                    if (seg == 7) { const int h = bj * 2 + (wc >> 1); const float dv = ps == 0 ? p->dec_f[h] : p->dec_b[h]; lg2 = log2f(1.0f / (1.0f + expf(-dv)));
                        baseT = (ps == 0 ? p->KTf() : p->KTb()) + ((size_t)(b * 4 + h) * 64 + (wc & 1) * 32) * RB + i0; }
                    else { const int h = (seg - 8) * 2 + bj; baseT = p->VT() + ((size_t)(b * 4 + h) * 128 + wc * 32) * RB + i0; }
#pragma unroll
                    for (int ai = 0; ai < 2; ++ai)
#pragma unroll
                        for (int mp = 0; mp < 2; ++mp) {
                            asm volatile("s_waitcnt lgkmcnt(0)" ::: "memory");
#pragma unroll
                            for (int mm = 0; mm < 2; ++mm) { const int m = mp * 2 + mm;
                                float f = 1.0f;
                                if (seg == 7) { const int pos = (i0 + ai * 128 + wr * 64 + m * 16 + fr) & 127; f = __builtin_amdgcn_exp2f((float)(ps == 0 ? 127 - pos : pos) * lg2); }
#pragma unroll
                                for (int n = 0; n < 2; ++n)
#pragma unroll
                                    for (int j = 0; j < 4; ++j) *(bf16_t*)(img + (n * 16 + fq * 4 + j) * 80 + (mm * 16 + fr) * 2) = f2bf(acc[ai][bj][m][n][j] * f); }
                            asm volatile("s_waitcnt lgkmcnt(0)" ::: "memory");
                            const int ib = ai * 128 + wr * 64 + mp * 32;
#pragma unroll
                            for (int k = 0; k < 2; ++k) { const int q = lane + 64 * k, col = q >> 2, ch = q & 3;
                                *(u32x4*)(baseT + (size_t)col * RB + ib + ch * 8) = *(const u32x4*)(img + col * 80 + ch * 16); }
                        }
                }
            }
        }
    } };
__device__ __forceinline__ void ph_gemm_in(const MK& p, int bid, int nb, int tid_l) {
    SchedIn S{&p, bid, nb, tid_l}; EpiIn E{&p};
    pg8::gemm<EpiIn, SchedIn, false, true>(D, S, E, tid_l);
}

struct SchedOut { const MK* p; int bid, nb, tid_l;
    __device__ __forceinline__ bool next(int i, pg8::GUnit& u, unsigned (&vA)[2][2]) const {
        const int tile = xcd_vbid(bid, nb) + i * nb; if (tile >= (T / 256) * 4) return false;
        const int pm = tile >> 2, pn = tile & 3;
        u.A = (const char*)(p->MIX() + (size_t)(pm * 256) * D); u.B = (const char*)(p->w_outT() + (size_t)(pn * 256) * D); u.i0 = pm; u.i1 = pn; u.i2 = 0; u.i3 = 0;
        pg8::plain_voffA(D, vA, tid_l); return true; } };
struct EpiOut { static constexpr bool PERM = true; const MK* p;
    __device__ __forceinline__ void operator()(const f32x4 (&acc)[2][2][4][2], const pg8::GUnit& u, int wr, int wc, int fr, int fq) const {
        const int brow = u.i0 * 256, bcol = u.i1 * 256 + wc * 32 + fq * 8;
        const float* g1 = p->mod() + (size_t)(brow / SEQ) * 6 * D + 2 * D + bcol;
        f32x4 gv[2][2];
#pragma unroll
        for (int bj = 0; bj < 2; ++bj)
#pragma unroll
            for (int n = 0; n < 2; ++n) gv[bj][n] = *(const f32x4*)(g1 + bj * 128 + n * 4);
#pragma unroll
        for (int ai = 0; ai < 2; ++ai)
#pragma unroll
            for (int m = 0; m < 4; ++m) {
                const int row = brow + ai * 128 + wr * 64 + m * 16 + fr;
                const float* xp = p->x + (size_t)row * D + bcol;
                f32x4 xv[2][2];
#pragma unroll
                for (int bj = 0; bj < 2; ++bj)
#pragma unroll
                    for (int n = 0; n < 2; ++n) xv[bj][n] = *(const f32x4*)(xp + bj * 128 + n * 4);
#pragma unroll
                for (int bj = 0; bj < 2; ++bj) {
                    const f32x4 a = xv[bj][0] + gv[bj][0] * acc[ai][bj][m][0], b = xv[bj][1] + gv[bj][1] * acc[ai][bj][m][1];
                    const u32x4 w = {cvtpk(a[0], a[1]), cvtpk(a[2], a[3]), cvtpk(b[0], b[1]), cvtpk(b[2], b[3])};
                    *(u32x4*)(p->X1() + (size_t)row * 2048 + bcol + bj * 128) = w;
                }
                if (m & 1) asm volatile("" ::: "memory");
            }
    } };
__device__ __forceinline__ void ph_gemm_out(const MK& p, int bid, int nb, int tid_l) {
    SchedOut S{&p, bid, nb, tid_l}; EpiOut E{&p};
    pg8::gemm<EpiOut, SchedOut, false, true>(D, S, E, tid_l);
}

template <bool DUMMY, int MODE = 0> __device__ __forceinline__ void ph_route(const MK& p, int bid, int nb, int tid_l) {
    int* cntp = p.cnt() + (DUMMY ? 128 : 0); int* tl = DUMMY ? (int*)(p.ws + 480 * MiB) : p.tok_list(); float* wl_ = DUMMY ? (float*)(p.ws + 488 * MiB) : p.wt_list(); int* tm = DUMMY ? (int*)(p.ws + 496 * MiB) : p.tokmap();
    const int tid = tid_l, wid = tid >> 6, lane = tid & 63, fr = lane & 15, fq = lane >> 4;
    float* lg = (float*)smem;
    int* wcnt = (int*)(smem + 34816);
    int* pref = wcnt + 512;
    bf16_t* H2lo = (bf16_t*)(p.ws + 325 * MiB);
    for (int item = bid; item < T / 128; item += nb) {
        const int t0 = item * 128 + wid * 16, b = (item * 128) / SEQ;
        const float* msh = p.mod() + (size_t)b * 6 * D + 3 * D; const float* msc = p.mod() + (size_t)b * 6 * D + 4 * D;
#pragma unroll 1
        for (int r0 = 0; r0 < 16; r0 += 4) {
            float4 xv[4][4];
#pragma unroll
            for (int rr = 0; rr < 4; ++rr)
#pragma unroll
                for (int q = 0; q < 4; ++q) { const u32x2 w = *(const u32x2*)(p.X1() + (size_t)(t0 + r0 + rr) * 2048 + q * 256 + lane * 4);
                    xv[rr][q] = make_float4(__uint_as_float(w.x << 16), __uint_as_float(w.x & 0xffff0000u), __uint_as_float(w.y << 16), __uint_as_float(w.y & 0xffff0000u)); }
#pragma unroll
            for (int rr = 0; rr < 4; ++rr) {
                float ss = 0.f;
#pragma unroll
                for (int q = 0; q < 4; ++q) ss += xv[rr][q].x * xv[rr][q].x + xv[rr][q].y * xv[rr][q].y + xv[rr][q].z * xv[rr][q].z + xv[rr][q].w * xv[rr][q].w;
                ss = wave_sum(ss);
                const float rstd = rsqrtf(ss * (1.0f / D) + EPS);
#pragma unroll
                for (int q = 0; q < 4; ++q) {
                    const int c0 = q * 256 + lane * 4;
                    const float4 gg = *(const float4*)(p.norm2_g + c0), sh = *(const float4*)(msh + c0), sc = *(const float4*)(msc + c0);
                    const float h0 = xv[rr][q].x * rstd * gg.x * (1 + sc.x) + sh.x, h1 = xv[rr][q].y * rstd * gg.y * (1 + sc.y) + sh.y;
                    const float h2v = xv[rr][q].z * rstd * gg.z * (1 + sc.z) + sh.z, h3 = xv[rr][q].w * rstd * gg.w * (1 + sc.w) + sh.w;
                    u32x2 wh, wl2; wh.x = cvtpk(h0, h1); wh.y = cvtpk(h2v, h3);
                    wl2.x = cvtpk(h0 - __uint_as_float(wh.x << 16), h1 - __uint_as_float(wh.x & 0xffff0000u));
                    wl2.y = cvtpk(h2v - __uint_as_float(wh.y << 16), h3 - __uint_as_float(wh.y & 0xffff0000u));
                    *(u32x2*)(p.H2() + (size_t)(t0 + r0 + rr) * D + c0) = wh;
                    *(u32x2*)(H2lo + (size_t)(t0 + r0 + rr) * D + c0) = wl2;
                }
            }
        }
        asm volatile("s_waitcnt vmcnt(0)" ::: "memory");
        __syncthreads();
        if (MODE == 3) continue;
        f32x4 acc[4];
#pragma unroll
        for (int nt = 0; nt < 4; ++nt) acc[nt] = (f32x4){0.f, 0.f, 0.f, 0.f};
        {
            const bf16_t* ah_p = p.H2() + (size_t)(t0 + fr) * D + fq * 8; const bf16_t* al_p = H2lo + (size_t)(t0 + fr) * D + fq * 8;
            const int widu = __builtin_amdgcn_readfirstlane(wid);
            unsigned rofs[4];
#pragma unroll
            for (int i = 0; i < 4; ++i) { const int x = wid * 1024 + i * 8192 + lane * 16, row = x >> 8, c = ((x & 255) >> 4) ^ (row & 15); rofs[i] = (unsigned)(row * 2048 + c * 16); }
#define RT_DMA(kc, buf) do { const char* src_ = (const char*)p.routerT() + (size_t)(kc) * 256;                                             \
            _Pragma("unroll") for (int i = 0; i < 4; ++i) __builtin_amdgcn_global_load_lds((const unsigned*)(src_ + rofs[i]), (unsigned*)(smem + 40960 + (buf) * 32768 + widu * 1024 + i * 8192), 16, 0, 0); } while (0)
            RT_DMA(0, 0);
#pragma unroll 1
            for (int kc = 0; kc < 8; ++kc) {
                bf16x8 ah[4], al[4];
#pragma unroll
                for (int ks = 0; ks < 4; ++ks) { ah[ks] = ldfrag(ah_p + kc * 128 + ks * 32); al[ks] = ldfrag(al_p + kc * 128 + ks * 32); }
                asm volatile("s_waitcnt vmcnt(0)" ::: "memory"); __syncthreads();
                if (kc + 1 < 8) RT_DMA(kc + 1, (kc + 1) & 1);
                const char* bb = smem + 40960 + (kc & 1) * 32768;
#pragma unroll
                for (int ks = 0; ks < 4; ++ks)
#pragma unroll
                    for (int nt = 0; nt < 4; ++nt) {
                        const int row = nt * 16 + fr, cc = ((ks * 4 + fq) ^ (row & 15)) * 16;
                        const bf16x8 bh = *(const bf16x8*)(bb + row * 256 + cc), bl = *(const bf16x8*)(bb + (64 + row) * 256 + cc);
                        acc[nt] = __builtin_amdgcn_mfma_f32_16x16x32_bf16(ah[ks], bh, acc[nt], 0, 0, 0);
                        acc[nt] = __builtin_amdgcn_mfma_f32_16x16x32_bf16(ah[ks], bl, acc[nt], 0, 0, 0);
                        acc[nt] = __builtin_amdgcn_mfma_f32_16x16x32_bf16(al[ks], bh, acc[nt], 0, 0, 0);
                    }
            }
#undef RT_DMA
        }
#pragma unroll
        for (int nt = 0; nt < 4; ++nt)
#pragma unroll
            for (int j = 0; j < 4; ++j) lg[(wid * 16 + fq * 4 + j) * 65 + nt * 16 + fr] = acc[nt][j];
        __syncthreads();
        if (MODE == 2) continue;
        int l3 = lane; asm volatile("" : "+v"(l3));
#define SHXF(v_, m_) __int_as_float(__builtin_amdgcn_ds_bpermute((l3 ^ (m_)) << 2, __float_as_int(v_)))
#define SHXI(v_, m_) __builtin_amdgcn_ds_bpermute((l3 ^ (m_)) << 2, (v_))
#define SHBF(v_, src_) __int_as_float(__builtin_amdgcn_ds_bpermute((src_) << 2, __float_as_int(v_)))
#define SHBI(v_, src_) __builtin_amdgcn_ds_bpermute((src_) << 2, (v_))
        const int q4 = l3 & 3, tt = wid * 16 + (l3 >> 2), t = item * 128 + tt, qbase = l3 & ~3;
        float sc_[16], v[16];
#pragma unroll
        for (int i = 0; i < 16; ++i) { const float x = lg[tt * 65 + q4 * 16 + i]; sc_[i] = __builtin_amdgcn_rcpf(1.0f + __builtin_amdgcn_exp2f(-1.4426950408889634f * x)); v[i] = sc_[i] + p.router_b[q4 * 16 + i]; }
        float gsA, gsB;
        { float m1 = v[0], m2 = -INFINITY;
#pragma unroll
          for (int i = 1; i < 8; ++i) { const float x = v[i]; m2 = fmaxf(m2, fminf(m1, x)); m1 = fmaxf(m1, x); }
          gsA = m1 + m2; m1 = v[8]; m2 = -INFINITY;
#pragma unroll
          for (int i = 9; i < 16; ++i) { const float x = v[i]; m2 = fmaxf(m2, fminf(m1, x)); m1 = fmaxf(m1, x); }
          gsB = m1 + m2; }
        { int rankA = 0, rankB = 0;
#pragma unroll
          for (int qq = 0; qq < 4; ++qq) {
              const float ga = SHBF(gsA, qbase | qq), gb = SHBF(gsB, qbase | qq);
              const int g0 = 2 * qq, g1 = 2 * qq + 1, mA = 2 * q4, mB = 2 * q4 + 1;
              rankA += (g0 != mA && (ga > gsA || (ga == gsA && g0 < mA))) ? 1 : 0; rankA += (g1 != mA && (gb > gsA || (gb == gsA && g1 < mA))) ? 1 : 0;
              rankB += (g0 != mB && (ga > gsB || (ga == gsB && g0 < mB))) ? 1 : 0; rankB += (g1 != mB && (gb > gsB || (gb == gsB && g1 < mB))) ? 1 : 0;
          }
          if (rankA >= 4) {
#pragma unroll
              for (int i = 0; i < 8; ++i) v[i] = -INFINITY; }
          if (rankB >= 4) {
#pragma unroll
              for (int i = 8; i < 16; ++i) v[i] = -INFINITY; } }
        unsigned chm = 0u;
#pragma unroll 1
        for (int it = 0; it < 8; ++it) {
            float lm = v[0];
#pragma unroll
            for (int i = 1; i < 16; ++i) lm = fmaxf(lm, v[i]);
            float gm = fmaxf(lm, SHXF(lm, 1)); gm = fmaxf(gm, SHXF(gm, 2));
            int cand = (lm == gm) ? q4 : 4;
            cand = min(cand, SHXI(cand, 1)); cand = min(cand, SHXI(cand, 2));
            const bool win = cand == q4;
            bool found = false;
#pragma unroll
            for (int i = 0; i < 16; ++i) { const bool hit = win && !found && v[i] == gm; if (hit) { chm |= (1u << i); v[i] = -INFINITY; } found = found || hit; }
        }
        float wsum = 0.f;
#pragma unroll
        for (int i = 0; i < 16; ++i) wsum += ((chm >> i) & 1u) ? sc_[i] : 0.f;
        wsum += SHXF(wsum, 1); wsum += SHXF(wsum, 2);
        const float wscale = 2.5f / wsum;
        const unsigned long long pat = 0x1111111111111111ull << q4;
#pragma unroll
        for (int i = 0; i < 16; ++i) { const unsigned long long bal = __ballot((chm >> i) & 1u); if (l3 < 4) wcnt[wid * 64 + l3 * 16 + i] = __popcll(bal & (0x1111111111111111ull << l3)); }
        __syncthreads();
        if (wid == 0) {
            int tot = 0;
#pragma unroll
            for (int w = 0; w < 8; ++w) tot += wcnt[w * 64 + lane];
            int run = atomicAdd(&cntp[lane], tot);
#pragma unroll
            for (int w = 0; w < 8; ++w) { const int c = wcnt[w * 64 + lane]; pref[w * 64 + lane] = run; run += c; }
        }
        __syncthreads();
        {
            const int pc = __popc(chm);
            int kbase = 0;
#pragma unroll
            for (int qq = 0; qq < 3; ++qq) { const int o = SHBI(pc, qbase | qq); kbase += (qq < q4) ? o : 0; }
#pragma unroll
            for (int i = 0; i < 16; ++i) {
                const bool c = (chm >> i) & 1u;
                const unsigned long long bal = __ballot(c);
                if (c) {
                    const int e = q4 * 16 + i;
                    const int slot = pref[wid * 64 + e] + __popcll(bal & pat & ((1ull << l3) - 1ull));
                    tl[(size_t)e * ECAP + slot] = t; wl_[(size_t)e * ECAP + slot] = sc_[i] * wscale;
                    tm[(size_t)t * 8 + kbase + __popc(chm & ((1u << i) - 1u))] = e * ECAP + slot;
                }
            }
        }
    }
}
#undef SHXF
#undef SHXI
#undef SHBF
#undef SHBI

constexpr int MOE_AUX = 162816;
__device__ __forceinline__ void moe_tables(const MK& p, int colt, int* tpre, int* rbase, int tid_l) {
    __syncthreads();
    if (tid_l == 0) { int tp = 0, rb = 0;
        for (int e = 0; e < 65; ++e) { const int c = e < 64 ? p.cnt()[e] : T; tpre[e] = tp; rbase[e] = rb; tp += ((c + 255) >> 8) * colt; rb += c; }
        tpre[65] = tp; rbase[65] = rb; }
    __syncthreads();
}
struct SchedUp { const MK* p; int bid, nb, tid_l, ntiles; const int* tpre; const int* rbase; mutable int e_hint;
    __device__ __forceinline__ bool next(int i, pg8::GUnit& u, unsigned (&vA)[2][2]) const {
        const int tile = xcd_vbid(bid, nb) + i * nb; if (tile >= ntiles) return false;
        int e = e_hint; while (tile >= tpre[e + 1]) ++e; e_hint = e;
        const int j = tile - tpre[e], rt = j >> 1, ct = j & 1, cnt_e = rbase[e + 1] - rbase[e];
        u.A = (const char*)p->H2(); u.B = (const char*)(p->W13t() + ((size_t)e * 512 + ct * 256) * D); u.i0 = e; u.i1 = rt; u.i2 = ct; u.i3 = cnt_e;
#pragma unroll
        for (int i2 = 0; i2 < 2; ++i2) { int R, C; stage_rc(tid_l * 16 + i2 * 8192, R, C);
#pragma unroll
            for (int h = 0; h < 2; ++h) { int slot = rt * 256 + h * 128 + R; if (slot >= cnt_e) slot = 0;
                const int tok = e < 64 ? p->tok_list()[(size_t)e * ECAP + slot] : slot;
                vA[h][i2] = (unsigned)tok * (D * 2u) + (unsigned)C * 2u; } }
        return true; } };
template <bool NOSTORE = false> struct EpiUpT { static constexpr bool PERM = true; const MK* p; const int* rbase;
    __device__ __forceinline__ void operator()(const f32x4 (&acc)[2][2][4][2], const pg8::GUnit& u, int wr, int wc, int fr, int fq) const {
        const int e = u.i0, rt = u.i1, ct = u.i2, cnt_e = u.i3;
        bf16_t* ab = p->ACT() + (size_t)rbase[e] * DE + ct * 128 + wc * 32 + fq * 8;
#pragma unroll
        for (int ai = 0; ai < 2; ++ai)
#pragma unroll
            for (int m = 0; m < 4; ++m) {
                const int slot = rt * 256 + ai * 128 + wr * 64 + m * 16 + fr;
                u32x4 w;
                w.x = cvtpk(silu_fast(acc[ai][0][m][0][0]) * acc[ai][1][m][0][0], silu_fast(acc[ai][0][m][0][1]) * acc[ai][1][m][0][1]);
                w.y = cvtpk(silu_fast(acc[ai][0][m][0][2]) * acc[ai][1][m][0][2], silu_fast(acc[ai][0][m][0][3]) * acc[ai][1][m][0][3]);
                w.z = cvtpk(silu_fast(acc[ai][0][m][1][0]) * acc[ai][1][m][1][0], silu_fast(acc[ai][0][m][1][1]) * acc[ai][1][m][1][1]);
                w.w = cvtpk(silu_fast(acc[ai][0][m][1][2]) * acc[ai][1][m][1][2], silu_fast(acc[ai][0][m][1][3]) * acc[ai][1][m][1][3]);
                if (NOSTORE) { if (slot < -cnt_e) *(u32x4*)(ab + (size_t)slot * DE) = w; } else if (slot < cnt_e) *(u32x4*)(ab + (size_t)slot * DE) = w;
            }
    } };
__device__ __forceinline__ void ph_moe_up(const MK& p, int bid, int nb, int tid_l) {
    int* tpre = (int*)(smem + MOE_AUX); int* rbase = tpre + 80;
    moe_tables(p, 2, tpre, rbase, tid_l);
    SchedUp S{&p, bid, nb, tid_l, tpre[65], tpre, rbase, 0}; EpiUpT<false> E{&p, rbase};
    pg8::gemm<EpiUpT<false>, SchedUp, true, true>(D, S, E, tid_l);
}
constexpr float Y_SCALE = 64.0f;
struct SchedDown { const MK* p; int bid, nb, tid_l, ntiles; const int* tpre; const int* rbase; mutable int e_hint;
    __device__ __forceinline__ bool next(int i, pg8::GUnit& u, unsigned (&vA)[2][2]) const {
        const int tile = xcd_vbid(bid, nb) + i * nb; if (tile >= ntiles) return false;
        int e = e_hint; while (tile >= tpre[e + 1]) ++e; e_hint = e;
        const int j = tile - tpre[e], rt = j >> 2, ct = j & 3, cnt_e = rbase[e + 1] - rbase[e];
        u.A = (const char*)(p->ACT() + (size_t)(rbase[e] + rt * 256) * DE); u.B = (const char*)(p->W2t() + ((size_t)e * D + ct * 256) * DE); u.i0 = e; u.i1 = rt; u.i2 = ct; u.i3 = cnt_e;
        pg8::plain_voffA(DE, vA, tid_l); return true; } };
template <int MODE> struct EpiDown { static constexpr bool PERM = true; const MK* p; const int* rbase;
    __device__ __forceinline__ void operator()(const f32x4 (&acc)[2][2][4][2], const pg8::GUnit& u, int wr, int wc, int fr, int fq) const {
        const int e = u.i0, rt = u.i1, ct = u.i2, cnt_e = u.i3;
        {
            const float* wl = p->wt_list() + (size_t)(e < 64 ? e : 0) * ECAP;
            float wv[2][4];
#pragma unroll
            for (int ai = 0; ai < 2; ++ai)
#pragma unroll
                for (int m = 0; m < 4; ++m) { const int sl = rt * 256 + ai * 128 + wr * 64 + m * 16 + fr; wv[ai][m] = e < 64 ? wl[sl < cnt_e ? sl : 0] * Y_SCALE : Y_SCALE; }
            const int wid = wr * 4 + wc, lane = fq * 16 + fr;
            char* wa = smem + 131072 + wid * 3968;
            unsigned char* yb = p->Y() + (size_t)rbase[e] * D + ct * 256 + wc * 64 + (lane & 3) * 16;
#pragma unroll
            for (int ai = 0; ai < 2; ++ai)
#pragma unroll
                for (int m = 0; m < 4; ++m) {
                    const float w = wv[ai][m];
                    char* img = wa + ((m & 1) ? 1280 : 0);
#pragma unroll
                    for (int bj = 0; bj < 2; ++bj) {
                        u32x2 pk;
#pragma unroll
                        for (int n = 0; n < 2; ++n) {
                            float v0 = __builtin_amdgcn_fmed3f(acc[ai][bj][m][n][0] * w, -448.f, 448.f), v1 = __builtin_amdgcn_fmed3f(acc[ai][bj][m][n][1] * w, -448.f, 448.f);
                            float v2 = __builtin_amdgcn_fmed3f(acc[ai][bj][m][n][2] * w, -448.f, 448.f), v3 = __builtin_amdgcn_fmed3f(acc[ai][bj][m][n][3] * w, -448.f, 448.f);
                            int q = 0; q = __builtin_amdgcn_cvt_pk_fp8_f32(v0, v1, q, false); q = __builtin_amdgcn_cvt_pk_fp8_f32(v2, v3, q, true);
                            if (n == 0) pk.x = (unsigned)q; else pk.y = (unsigned)q;
                        }
                        *(u32x2*)(img + fr * 80 + bj * 32 + fq * 8) = pk;
                    }
                    asm volatile("s_waitcnt lgkmcnt(0)" ::: "memory");
                    const int rr = lane >> 2, slot = rt * 256 + ai * 128 + wr * 64 + m * 16 + rr;
                    const u32x4 v = *(const u32x4*)(img + rr * 80 + (lane & 3) * 16);
                    if (MODE == 1) asm volatile("" :: "v"(v)); else if (slot < cnt_e) *(u32x4*)(yb + (size_t)slot * D) = v;
                }
        }
    } };
template <bool DUMMY, int MODE = 0> __device__ __forceinline__ void ph_moe_down(const MK& p, int bid, int nb, int tid_l) {
    int* tpre = (int*)(smem + MOE_AUX); int* rbase = tpre + 80;
    moe_tables(p, 4, tpre, rbase, tid_l);
    SchedDown S{&p, bid, nb, tid_l, DUMMY ? tpre[64] : tpre[65], tpre, rbase, 0}; EpiDown<MODE> E{&p, rbase};
    pg8::gemm<EpiDown<MODE>, SchedDown, false, true>(DE, S, E, tid_l);
}

#if DUP >= 21 && DUP <= 29
template <bool PERM_> struct EpiNull { static constexpr bool PERM = PERM_;
    __device__ __forceinline__ void operator()(const f32x4 (&acc)[2][2][4][2], const pg8::GUnit& u, int wr, int wc, int fr, int fq) const {
#pragma unroll
        for (int a = 0; a < 2; ++a)
#pragma unroll
            for (int b = 0; b < 2; ++b)
#pragma unroll
                for (int m = 0; m < 4; ++m) { asm volatile("" :: "v"(acc[a][b][m][0]), "v"(acc[a][b][m][1])); }
    } };
__device__ __forceinline__ void ph_probe_in(const MK& p, int bid, int nb, int tid_l) { SchedIn S{&p, bid, nb, tid_l}; EpiNull<false> E; pg8::gemm<EpiNull<false>, SchedIn, false, true>(D, S, E, tid_l); }
__device__ __forceinline__ void ph_probe_out(const MK& p, int bid, int nb, int tid_l) { SchedOut S{&p, bid, nb, tid_l}; EpiNull<true> E; pg8::gemm<EpiNull<true>, SchedOut, false, true>(D, S, E, tid_l); }
__device__ __forceinline__ void ph_probe_up(const MK& p, int bid, int nb, int tid_l) {
    int* tpre = (int*)(smem + MOE_AUX); int* rbase = tpre + 80; moe_tables(p, 2, tpre, rbase, tid_l);
    SchedUp S{&p, bid, nb, tid_l, tpre[65], tpre, rbase, 0}; EpiNull<true> E; pg8::gemm<EpiNull<true>, SchedUp, true, true>(D, S, E, tid_l); }
__device__ __forceinline__ void ph_probe_up_nostore(const MK& p, int bid, int nb, int tid_l) {
    int* tpre = (int*)(smem + MOE_AUX); int* rbase = tpre + 80; moe_tables(p, 2, tpre, rbase, tid_l);
    SchedUp S{&p, bid, nb, tid_l, tpre[65], tpre, rbase, 0}; EpiUpT<true> E{&p, rbase}; pg8::gemm<EpiUpT<true>, SchedUp, true, true>(D, S, E, tid_l); }
__device__ __forceinline__ void ph_probe_down(const MK& p, int bid, int nb, int tid_l) {
    int* tpre = (int*)(smem + MOE_AUX); int* rbase = tpre + 80; moe_tables(p, 4, tpre, rbase, tid_l);
    SchedDown S{&p, bid, nb, tid_l, tpre[65], tpre, rbase, 0}; EpiNull<true> E; pg8::gemm<EpiNull<true>, SchedDown, false, true>(DE, S, E, tid_l); }
#endif
template <bool DUMMY> __device__ __forceinline__ void ph_final(const MK& p, int bid, int nb, int tid_l) {
    const int wid = tid_l >> 6, lane = tid_l & 63;
    int* tpre = (int*)(smem + MOE_AUX); int* rbase = tpre + 80;
    moe_tables(p, 1, tpre, rbase, tid_l);
    for (int t = bid * 8 + wid; t < T; t += nb * 8) {
        const int b = t / SEQ;
        float f[16];
#pragma unroll
        for (int i = 0; i < 16; ++i) f[i] = 0.f;
#pragma unroll
        for (int k = 0; k < 9; ++k) {
            int row;
            if (k < 8) { const int id = p.tokmap()[(size_t)t * 8 + k], e = id >> 15, slot = id & (ECAP - 1); row = rbase[e] + slot; } else row = rbase[64] + t;
            const unsigned char* yr = p.Y() + (size_t)row * D + lane * 4;
#pragma unroll
            for (int q = 0; q < 4; ++q) {
                const int w = *(const int*)(yr + q * 256);
                const auto lo = __builtin_amdgcn_cvt_pk_f32_fp8(w, false); const auto hi = __builtin_amdgcn_cvt_pk_f32_fp8(w, true);
                f[q * 4 + 0] += lo[0]; f[q * 4 + 1] += lo[1]; f[q * 4 + 2] += hi[0]; f[q * 4 + 3] += hi[1];
            }
        }
        const int pcol = ((lane >> 3) & 1) * 128 + (lane >> 4) * 32 + (lane & 7) * 4;
        const float* g2 = p.mod() + (size_t)b * 6 * D + 5 * D + pcol;
        const bf16_t* x1 = p.X1() + (size_t)t * 2048 + pcol;
        float* xo = p.out + (size_t)t * D + pcol;
        float v[16]; float ss = 0.f;
#pragma unroll
        for (int q = 0; q < 4; ++q) {
            const u32x2 xw = *(const u32x2*)(x1 + q * 256); const float4 g = *(const float4*)(g2 + q * 256);
            v[q * 4 + 0] = __uint_as_float(xw.x << 16) + g.x * f[q * 4 + 0] * (1.0f / Y_SCALE); v[q * 4 + 1] = __uint_as_float(xw.x & 0xffff0000u) + g.y * f[q * 4 + 1] * (1.0f / Y_SCALE);
            v[q * 4 + 2] = __uint_as_float(xw.y << 16) + g.z * f[q * 4 + 2] * (1.0f / Y_SCALE); v[q * 4 + 3] = __uint_as_float(xw.y & 0xffff0000u) + g.w * f[q * 4 + 3] * (1.0f / Y_SCALE);
            ss += v[q * 4] * v[q * 4] + v[q * 4 + 1] * v[q * 4 + 1] + v[q * 4 + 2] * v[q * 4 + 2] + v[q * 4 + 3] * v[q * 4 + 3];
        }
        ss = wave_sum(ss);
        const float rstd = rsqrtf(ss * (1.0f / D) + EPS);
#pragma unroll
        for (int q = 0; q < 4; ++q) {
            const float4 gf = *(const float4*)(p.final_g + q * 256 + pcol);
            *(float4*)((DUMMY ? (float*)(p.ws + 42 * MiB) + (size_t)t * D + pcol : xo) + q * 256) = make_float4(v[q * 4] * rstd * gf.x, v[q * 4 + 1] * rstd * gf.y, v[q * 4 + 2] * rstd * gf.z, v[q * 4 + 3] * rstd * gf.w);
        }
    }
}


#define XB_TMO      128
#define XB_XCNT(j)  (256  + 64 * (j))
#define XB_XSUB(j)  (1280 + 64 * (j))
#define XB_XGEN(j)  (2304 + 64 * (j))
#define XB_TOP      3328
#define XB_TOPGEN   3392
#define XCD_BAR_WORDS 3456
#define XB_SPIN_CAP (1u << 22)
#define LAS __attribute__((address_space(3)))
__device__ __forceinline__ unsigned xb_ld(unsigned* p)              { return __hip_atomic_load(p, __ATOMIC_RELAXED, __HIP_MEMORY_SCOPE_AGENT); }
__device__ __forceinline__ unsigned xb_add(unsigned* p, unsigned v) { return __hip_atomic_fetch_add(p, v, __ATOMIC_RELAXED, __HIP_MEMORY_SCOPE_AGENT); }
__device__ __forceinline__ unsigned xb_xcc_id() { return (unsigned)__builtin_amdgcn_s_getreg((3 << 11) | 20) & 0xFu; }
#define XB_SPIN(cond, bar) do { unsigned _sp = 0; while (cond) { __builtin_amdgcn_s_sleep(1); \
    if ((++_sp & 255u) == 0u) { if (xb_ld(&(bar)[XB_TMO])) break; if (_sp > XB_SPIN_CAP) { atomicAdd(&(bar)[XB_TMO], 1u); break; } } } } while (0)
struct XcdBarrier { unsigned* bar; unsigned x; volatile LAS unsigned* st; };
__device__ __forceinline__ XcdBarrier xcd_barrier_post(unsigned* bar, volatile LAS unsigned* st, int tid) {
    XcdBarrier b; b.bar = bar; b.x = xb_xcc_id(); b.st = st;
    if (tid == 0) (void)xb_add(&bar[XB_XCNT(b.x)], 1u);
    return b;
}
__device__ __forceinline__ void xcd_barrier_complete(unsigned* bar, unsigned x, unsigned& nloc, unsigned& nx) {
    const unsigned G = gridDim.x * gridDim.y * gridDim.z;
    unsigned sum, cnt, mine, sp = 0u;
    for (;;) {
        sum = 0u; cnt = 0u; mine = 0u;
#pragma unroll
        for (unsigned j = 0; j < 16; ++j) { const unsigned c = xb_ld(&bar[XB_XCNT(j)]); sum += c; cnt += (c > 0u) ? 1u : 0u; mine = (j == x) ? c : mine; }
        if (sum == G) break;
        __builtin_amdgcn_s_sleep(1);
        if ((++sp & 255u) == 0u) { if (xb_ld(&bar[XB_TMO])) break; if (sp > XB_SPIN_CAP) { atomicAdd(&bar[XB_TMO], 1u); break; } }
    }
    nloc = mine > 0u ? mine : 1u; nx = cnt > 0u ? cnt : 1u;
}
__device__ __forceinline__ void xcd_barrier(const XcdBarrier& b, int tid) {
    asm volatile("s_waitcnt vmcnt(0)" ::: "memory");
    __syncthreads();
    if (tid == 0) {
        unsigned* bar = b.bar;
        __builtin_amdgcn_s_waitcnt(0);
        unsigned nloc = b.st[0], nx = b.st[1];
        if (nloc == 0u) { xcd_barrier_complete(bar, b.x, nloc, nx); b.st[0] = nloc; b.st[1] = nx; }
        const unsigned old = xb_add(&bar[XB_XSUB(b.x)], 1u);
        const unsigned gen = old / nloc;
        if (old + 1u == (gen + 1u) * nloc) {
            __builtin_amdgcn_fence(__ATOMIC_RELEASE, "agent");
            asm volatile("s_waitcnt vmcnt(0)" ::: "memory");
            const unsigned og = xb_add(&bar[XB_TOP], 1u);
            const unsigned tg = og / nx;
            if (og + 1u == (tg + 1u) * nx) xb_add(&bar[XB_TOPGEN], 1u);
            else XB_SPIN(xb_ld(&bar[XB_TOPGEN]) == tg, bar);
            __builtin_amdgcn_fence(__ATOMIC_ACQUIRE, "agent");
            xb_add(&bar[XB_XGEN(b.x)], 1u);
            asm volatile("s_waitcnt vmcnt(0)" ::: "memory");
        } else {
            XB_SPIN(xb_ld(&bar[XB_XGEN(b.x)]) == gen, bar);
            __builtin_amdgcn_fence(__ATOMIC_ACQUIRE, "agent");
            asm volatile("s_waitcnt vmcnt(0)" ::: "memory");
        }
    }
    __syncthreads();
}

__device__ __forceinline__ int lane_id_volatile() { int l; asm volatile("v_mbcnt_lo_u32_b32 %0, -1, 0\n\tv_mbcnt_hi_u32_b32 %0, -1, %0" : "=v"(l)); return l; }
__global__ __launch_bounds__(512, 2) void k_mega(MK p) {
    cg::grid_group grid = cg::this_grid();
    const int bid = blockIdx.x, nb = gridDim.x;
    volatile LAS unsigned* xst = (volatile LAS unsigned*)(smem + 162816 + 768);
    if (threadIdx.x < 4) xst[threadIdx.x] = 0u;
    __syncthreads();
    const XcdBarrier xb = xcd_barrier_post((unsigned*)(p.ws + 524288), xst, (int)threadIdx.x);
    const int wv_ = __builtin_amdgcn_readfirstlane((int)threadIdx.x >> 6);
#define LANE_ID() lane_id_volatile()
#define PH_TID() int t_ = wv_ * 64 + LANE_ID(); asm volatile("" : "+v"(t_))
    { PH_TID(); if (bid == 0 && t_ < 256) p.cnt()[t_] = 0; ph_mod(p, bid, nb, t_); ph_convert(p, bid, nb, t_); }
#if DUP == 10
    { PH_TID(); ph_convert(p, bid, nb, t_); }
#endif
    grid.sync();
    { PH_TID(); ph_ln1(p, bid, nb, t_); }
#if DUP == 1
    { PH_TID(); ph_ln1(p, bid, nb, t_); }
#endif
    xcd_barrier(xb, wv_ * 64 + LANE_ID());
    { PH_TID(); ph_gemm_in(p, bid, nb, t_); }
    { PH_TID(); ph_convert_dyn(p, t_); }
#if DUP == 2
    { PH_TID(); ph_gemm_in(p, bid, nb, t_); }
#endif
#if DUP == 21
    { PH_TID(); ph_probe_in(p, bid, nb, t_); }
#endif
    xcd_barrier(xb, wv_ * 64 + LANE_ID());
    { PH_TID(); ph_attn<0>(p, bid, nb, t_); }
#if DUP == 3
    { PH_TID(); ph_attn<2>(p, bid, nb, t_); }
#endif
#if DUP == 31
    { PH_TID(); ph_attn<1>(p, bid, nb, t_); }
#endif
#if DUP == 33
    { PH_TID(); ph_attn<3>(p, bid, nb, t_); }
#endif
    { PH_TID(); ph_kv(p, bid, nb, t_); }
#if DUP == 11
    { PH_TID(); ph_kv(p, bid, nb, t_); }
#endif
    xcd_barrier(xb, wv_ * 64 + LANE_ID());
    { PH_TID(); ph_scan(p, bid, nb, t_); }
    xcd_barrier(xb, wv_ * 64 + LANE_ID());
    { PH_TID(); ph_ret(p, bid, nb, t_); }
#if DUP == 5
    { PH_TID(); ph_ret(p, bid, nb, t_); }
#endif
    xcd_barrier(xb, wv_ * 64 + LANE_ID());
    { PH_TID(); ph_gemm_out(p, bid, nb, t_); }
#if DUP == 6
    { PH_TID(); ph_gemm_out(p, bid, nb, t_); }
#endif
#if DUP == 22
    { PH_TID(); ph_probe_out(p, bid, nb, t_); }
#endif
    xcd_barrier(xb, wv_ * 64 + LANE_ID());
#if DUP == 7
    { PH_TID(); ph_route<true>(p, bid, nb, t_); }
#endif
#if DUP == 72
    { PH_TID(); ph_route<true, 2>(p, bid, nb, t_); }
#endif
#if DUP == 73
    { PH_TID(); ph_route<true, 3>(p, bid, nb, t_); }
#endif
    { PH_TID(); ph_route<false>(p, bid, nb, t_); }
    xcd_barrier(xb, wv_ * 64 + LANE_ID());
    { PH_TID(); ph_moe_up(p, bid, nb, t_); }
#if DUP == 8
    { PH_TID(); ph_moe_up(p, bid, nb, t_); }
#endif
#if DUP == 23
    { PH_TID(); ph_probe_up(p, bid, nb, t_); }
#endif
#if DUP == 25
    { PH_TID(); ph_probe_up_nostore(p, bid, nb, t_); }
#endif
    xcd_barrier(xb, wv_ * 64 + LANE_ID());
#if DUP == 9
    { PH_TID(); ph_moe_down<true>(p, bid, nb, t_); }
#endif
#if DUP == 91
    { PH_TID(); ph_moe_down<true, 1>(p, bid, nb, t_); }
#endif
    { PH_TID(); ph_moe_down<false>(p, bid, nb, t_); }
#if DUP == 24
    { PH_TID(); ph_probe_down(p, bid, nb, t_); }
#endif
    xcd_barrier(xb, wv_ * 64 + LANE_ID());
#if DUP == 13
    { PH_TID(); ph_final<true>(p, bid, nb, t_); }
#endif
    { PH_TID(); ph_final<false>(p, bid, nb, t_); }
#undef PH_TID
#undef LANE_ID
}
constexpr int LDS_TOTAL = 163840;
extern "C" void kernel_launch(void* const* d_in, const int* in_sizes, int n_in, void* d_out, int out_size, void* d_ws, size_t ws_size, hipStream_t stream) {
    char* ws = (char*)d_ws;
    MK mk{};
    mk.x = (const float*)d_in[0]; mk.c = (const float*)d_in[1]; mk.ctx = (const float*)d_in[2]; mk.cctx = (const float*)d_in[3]; mk.ada_w = (const float*)d_in[4]; mk.ada_b = (const float*)d_in[5];
    mk.norm1_g = (const float*)d_in[6]; mk.w_in = (const float*)d_in[7]; mk.lq1 = (const float*)d_in[8]; mk.lk1 = (const float*)d_in[9]; mk.lq2 = (const float*)d_in[10]; mk.lk2 = (const float*)d_in[11];
    mk.dattn_g = (const float*)d_in[12]; mk.dec_f = (const float*)d_in[13]; mk.dec_b = (const float*)d_in[14]; mk.ret_g = (const float*)d_in[15]; mk.w_out = (const float*)d_in[16];
    mk.norm2_g = (const float*)d_in[17]; mk.router_w = (const float*)d_in[18]; mk.router_b = (const float*)d_in[19]; mk.ew1 = (const float*)d_in[20]; mk.ew3 = (const float*)d_in[21];
    mk.ew2 = (const float*)d_in[22]; mk.sw1 = (const float*)d_in[23]; mk.sw3 = (const float*)d_in[24]; mk.sw2 = (const float*)d_in[25]; mk.final_g = (const float*)d_in[26];
    mk.out = (float*)d_out;
    mk.ws = ws;
    mk.dbgP = nullptr; mk.dbg_lo = 0; mk.dbg_hi = 12; mk.conv_limit = 1 << 30;
    static int grid_blocks = 0;
    if (!grid_blocks) {
        (void)hipFuncSetAttribute((const void*)k_mega, hipFuncAttributeMaxDynamicSharedMemorySize, LDS_TOTAL);
        int dev = 0, cus = 0, per_cu = 0;
        (void)hipGetDevice(&dev);
        (void)hipDeviceGetAttribute(&cus, hipDeviceAttributeMultiprocessorCount, dev);
        (void)hipOccupancyMaxActiveBlocksPerMultiprocessor(&per_cu, k_mega, 512, LDS_TOTAL);
        if (per_cu > 1) per_cu = 1;
        grid_blocks = cus * per_cu;
        if (grid_blocks <= 0) { fprintf(stderr, "occupancy query failed: cus %d per_cu %d\n", cus, per_cu); grid_blocks = 256; }
    }
    (void)hipMemsetAsync(ws + 524288, 0, XCD_BAR_WORDS * 4, stream);
    void* args[] = {&mk};
    hipError_t e = hipLaunchCooperativeKernel((void*)k_mega, dim3(grid_blocks), dim3(512), args, LDS_TOTAL, stream);
    if (e != hipSuccess) fprintf(stderr, "cooperative launch failed: %s (grid %d)\n", hipGetErrorString(e), grid_blocks);
}
```

```cpp
#include <hip/hip_runtime.h>
#include <hip/hip_cooperative_groups.h>
#include <cstdio>
namespace cg = cooperative_groups;
#ifndef DUP
#define DUP 0
#endif
#include <stdint.h>

constexpr int D = 1024, NB = 4, SEQ = 8192, CTX = 256, RB = SEQ + CTX  , NR = NB * RB  , T = NB * SEQ;
constexpr int NE = 64, DE = 256, ECAP = 32768;
constexpr float EPS = 1e-6f;
typedef unsigned short bf16_t;

__device__ __forceinline__ float siluf(float v) { return v / (1.0f + expf(-v)); }
__device__ __forceinline__ float silu_fast(float v) { return v * __builtin_amdgcn_rcpf(1.0f + __builtin_amdgcn_exp2f(-1.4426950408889634f * v)); }
__device__ __forceinline__ float wave_sum(float v) {
#pragma unroll
    for (int o = 32; o > 0; o >>= 1) v += __shfl_xor(v, o);
    return v;
}
__device__ __forceinline__ float wave_max(float v) {
#pragma unroll
    for (int o = 32; o > 0; o >>= 1) v = fmaxf(v, __shfl_xor(v, o));
    return v;
}
__device__ __forceinline__ float block_sum(float v, float* red) {
    v = wave_sum(v);
    __syncthreads();
    if ((threadIdx.x & 63) == 0) red[threadIdx.x >> 6] = v;
    __syncthreads();
    return red[0] + red[1] + red[2] + red[3];
}
__device__ __forceinline__ float block_max(float v, float* red) {
    v = wave_max(v);
    __syncthreads();
    if ((threadIdx.x & 63) == 0) red[threadIdx.x >> 6] = v;
    __syncthreads();
    return fmaxf(fmaxf(red[0], red[1]), fmaxf(red[2], red[3]));
}

typedef short bf16x8 __attribute__((ext_vector_type(8)));
typedef short s16x4 __attribute__((ext_vector_type(4)));
typedef float f32x4 __attribute__((ext_vector_type(4)));
typedef float f32x16 __attribute__((ext_vector_type(16)));
typedef unsigned u32x2 __attribute__((ext_vector_type(2)));
typedef unsigned u32x4 __attribute__((ext_vector_type(4)));
extern __shared__ __attribute__((aligned(1024))) char smem[];
constexpr int NTHR = 512;
constexpr int GEMM_LDS = 131072;

__device__ __forceinline__ unsigned cvtpk(float lo, float hi) { unsigned r; asm volatile("v_cvt_pk_bf16_f32 %0, %1, %2" : "=v"(r) : "v"(lo), "v"(hi)); return r; }
__device__ __forceinline__ bf16_t f2bf(float v) { return (bf16_t)(cvtpk(v, v) & 0xffffu); }
__device__ __forceinline__ float bf2f(bf16_t v) { return __uint_as_float(((unsigned)v) << 16); }

constexpr size_t MiB = 1048576;
struct MK {
    const float *x, *c, *ctx, *cctx, *ada_w, *ada_b, *norm1_g, *w_in, *lq1, *lk1, *lq2, *lk2, *dattn_g, *dec_f, *dec_b, *ret_g, *w_out, *norm2_g, *router_w, *router_b,
        *ew1, *ew3, *ew2, *sw1, *sw3, *sw2, *final_g;
    float* out; char* ws;
    float* dbgP; long dbg_lo, dbg_hi; long conv_limit;
#define WSF(name, type, off) __device__ __forceinline__ type* name() const { return (type*)(ws + (off)); }
    WSF(mod, float, 0) WSF(cnt, int, 131072) WSF(ropec, float, 262144) WSF(ropes, float, 262144 + 8192)
    WSF(w_inT, bf16_t, 1 * MiB) WSF(w_outT, bf16_t, 7 * MiB) WSF(routerT, bf16_t, 9 * MiB) WSF(W2t, bf16_t, 9 * MiB + 524288)
    WSF(H, bf16_t, 42 * MiB) WSF(MIX, bf16_t, 42 * MiB) WSF(KV, bf16_t, 112 * MiB) WSF(ST, bf16_t, 147 * MiB) WSF(ACT, bf16_t, 42 * MiB)
    WSF(W13t, bf16_t, 194 * MiB) WSF(H2, bf16_t, 260 * MiB)
    WSF(Q, bf16_t, 260 * MiB) WSF(K, bf16_t, 292 * MiB) WSF(V, bf16_t, 325 * MiB) WSF(RQ, bf16_t, 358 * MiB) WSF(RK, bf16_t, 375 * MiB)
    WSF(KTf, bf16_t, 392 * MiB) WSF(KTb, bf16_t, 409 * MiB) WSF(VT, bf16_t, 426 * MiB) WSF(RG, bf16_t, 459 * MiB)
    WSF(Y, unsigned char, 194 * MiB) WSF(tok_list, int, 484 * MiB) WSF(wt_list, float, 492 * MiB) WSF(tokmap, int, 500 * MiB)
    __device__ __forceinline__ bf16_t* X1() const { return (bf16_t*)out; }
#undef WSF
};

__device__ __forceinline__ void ph_mod(const MK& p, int bid, int nb, int tid_l) {
    float* sl = (float*)smem;
    float* red = (float*)(smem + 32768);
    if (bid < 6 * D / 32) {
        for (int i = tid_l; i < 5 * D; i += NTHR) { const int r = i >> 10, k = i & 1023; const float cv = r < 4 ? p.c[r * D + k] : p.cctx[k]; sl[k * 8 + r] = siluf(cv); }
    }
    __syncthreads();
    for (int it = bid; it < 6 * D / 32; it += nb) {
        const int col = tid_l & 31, kg = tid_l >> 5, j = it * 32 + col;
        const float* wp = p.ada_w + (size_t)(kg * 64) * 6 * D + j;
        float a[5] = {0, 0, 0, 0, 0};
#pragma unroll 1
        for (int k0 = 0; k0 < 64; k0 += 16) {
            float w[16];
#pragma unroll
            for (int kk = 0; kk < 16; ++kk) w[kk] = wp[(size_t)(k0 + kk) * 6 * D];
#pragma unroll
            for (int kk = 0; kk < 16; ++kk) {
                const float4 s4 = *(const float4*)(sl + (kg * 64 + k0 + kk) * 8); const float s5 = sl[(kg * 64 + k0 + kk) * 8 + 4];
                a[0] += s4.x * w[kk]; a[1] += s4.y * w[kk]; a[2] += s4.z * w[kk]; a[3] += s4.w * w[kk]; a[4] += s5 * w[kk];
            }
        }
        __syncthreads();
#pragma unroll
        for (int r = 0; r < 5; ++r) red[(kg * 5 + r) * 32 + col] = a[r];
        __syncthreads();
        if (tid_l < 160) {
            int r = tid_l >> 5; float s = 0;
            for (int g = 0; g < 16; ++g) s += red[(g * 5 + r) * 32 + col];
            p.mod()[(size_t)r * 6 * D + j] = s + p.ada_b[j];
        }
    }
    if (bid == nb - 1) {
        for (int i = tid_l; i < 128 * 16; i += NTHR) {
            int pos = i >> 4, f = i & 15;
            float inv_freq = exp2f(-(float)f * (13.287712379549449f / 16.0f));
            float s, c; sincosf((float)pos * inv_freq, &s, &c);
            p.ropec()[i] = c; p.ropes()[i] = s;
        }
    }
    __syncthreads();
}

__device__ __forceinline__ void tr_tile(const float* src, int ldsrc, int k0, int n0, bf16_t* dst, int lddst, int mode  , bf16_t* dst2, int tid_l) {
    float* t = (float*)smem;
    __syncthreads();
    for (int i = tid_l; i < 64 * 16; i += NTHR) {
        int r = i >> 4, c4 = (i & 15) * 4;
        float4 v = *(const float4*)(src + (size_t)(k0 + r) * ldsrc + n0 + c4);
        t[r * 65 + c4] = v.x; t[r * 65 + c4 + 1] = v.y; t[r * 65 + c4 + 2] = v.z; t[r * 65 + c4 + 3] = v.w;
    }
    __syncthreads();
    for (int i = tid_l; i < 64 * 16; i += NTHR) {
        int n = i >> 4, k4 = (i & 15) * 4;
        float a = t[(k4 + 0) * 65 + n], b = t[(k4 + 1) * 65 + n], c = t[(k4 + 2) * 65 + n], d = t[(k4 + 3) * 65 + n];
        int nn = n0 + n, row = nn;
        if (mode == 1 || mode == 2) { int ct = nn >> 7; row = ct * 256 + (mode == 2 ? 128 : 0) + (nn & 127); }
        u32x2 w; w.x = cvtpk(a, b); w.y = cvtpk(c, d);
        *(u32x2*)(dst + (size_t)row * lddst + k0 + k4) = w;
        if (mode == 3) {
            float ah = bf2f((bf16_t)(w.x & 0xffff)), bh = bf2f((bf16_t)(w.x >> 16)), ch = bf2f((bf16_t)(w.y & 0xffff)), dh = bf2f((bf16_t)(w.y >> 16));
            u32x2 l; l.x = cvtpk(a - ah, b - bh); l.y = cvtpk(c - ch, d - dh);
            *(u32x2*)(dst2 + (size_t)row * lddst + k0 + k4) = l;
        }
    }
}
constexpr int CV_STATIC = 16 * 48 + 16 * 16 + 16, CV_E13 = 65 * 2 * 16 * 4, CV_E2 = 65 * 4 * 16, CV_TOTAL = CV_STATIC + CV_E13 + CV_E2;
__device__ __forceinline__ void convert_tile(const MK& p, int j, int tid_l) {
    const int n_win = 16 * 48, n_wout = 16 * 16, n_rt = 16;
    if (j < n_win) { tr_tile(p.w_in, 3072, (j / 48) * 64, (j % 48) * 64, p.w_inT(), 1024, 0, nullptr, tid_l); return; } j -= n_win;
    if (j < n_wout) { tr_tile(p.w_out, 1024, (j / 16) * 64, (j % 16) * 64, p.w_outT(), 1024, 0, nullptr, tid_l); return; } j -= n_wout;
    if (j < n_rt) { tr_tile(p.router_w, 64, j * 64, 0, p.routerT(), 1024, 3, p.routerT() + 64 * 1024, tid_l); return; } j -= n_rt;
    if (j < CV_E13) {
        int e = j / 128, r = j % 128, which = r / 64, tt = r % 64;
        const float* src = e < 64 ? (which ? p.ew3 : p.ew1) + (size_t)e * D * DE : (which ? p.sw3 : p.sw1);
        tr_tile(src, DE, (tt / 4) * 64, (tt % 4) * 64, p.W13t() + (size_t)e * 512 * 1024, 1024, 1 + which, nullptr, tid_l); return; } j -= CV_E13;
    { int e = j / 64, tt = j % 64;
      const float* src = e < 64 ? p.ew2 + (size_t)e * DE * D : p.sw2;
      tr_tile(src, D, (tt / 16) * 64, (tt % 16) * 64, p.W2t() + (size_t)e * 1024 * 256, 256, 0, nullptr, tid_l); }
}
__device__ __forceinline__ void ph_convert(const MK& p, int bid, int nb, int tid_l) {
    for (int it = bid; it < CV_STATIC; it += nb) convert_tile(p, it, tid_l);
    __syncthreads();
}
template <int LDSRC> __device__ __forceinline__ void tr_wave(const float* __restrict__ src, int k0, int n0, bf16_t* __restrict__ dst, int lddst, int mode, int lane, char* tb) {
    const int n4 = lane & 15, kg = lane >> 4;
    const float* s0 = src + (size_t)(k0 + kg * 16) * LDSRC + n0 + n4 * 4;
    f32x4 v[16];
#pragma unroll
    for (int it = 0; it < 16; ++it) v[it] = *(const f32x4*)(s0 + (size_t)it * LDSRC);
#pragma unroll
    for (int jn = 0; jn < 4; ++jn) {
        const int n = n4 * 4 + jn;
#pragma unroll
        for (int h = 0; h < 2; ++h) {
            const u32x4 w = {cvtpk(v[h * 8][jn], v[h * 8 + 1][jn]), cvtpk(v[h * 8 + 2][jn], v[h * 8 + 3][jn]), cvtpk(v[h * 8 + 4][jn], v[h * 8 + 5][jn]), cvtpk(v[h * 8 + 6][jn], v[h * 8 + 7][jn])};
            *(u32x4*)(tb + n * 128 + (((kg * 2 + h) ^ (n4 & 7)) << 4)) = w;
        }
    }
    asm volatile("s_waitcnt lgkmcnt(0)" ::: "memory");
#pragma unroll
    for (int it = 0; it < 8; ++it) {
        const int n = it * 8 + (lane >> 3), c = lane & 7;
        const u32x4 w = *(const u32x4*)(tb + n * 128 + ((c ^ ((n >> 2) & 7)) << 4));
        const int nn = n0 + n; int row = nn;
        if (mode == 1 || mode == 2) { const int ct = nn >> 7; row = ct * 256 + (mode == 2 ? 128 : 0) + (nn & 127); }
        *(u32x4*)(dst + (size_t)row * lddst + k0 + c * 8) = w;
    }
}
__device__ __forceinline__ void convert_tile_wave(const MK& p, int j, int lane, char* tb) {
    if (j < CV_E13) {
        const int e = j / 128, r = j % 128, which = r / 64, tt = r % 64;
        const float* src = e < 64 ? (which ? p.ew3 : p.ew1) + (size_t)e * D * DE : (which ? p.sw3 : p.sw1);
        tr_wave<DE>(src, (tt / 4) * 64, (tt % 4) * 64, p.W13t() + (size_t)e * 512 * 1024, 1024, 1 + which, lane, tb); return; }
    j -= CV_E13;
    { const int e = j / 64, tt = j % 64;
      const float* src = e < 64 ? p.ew2 + (size_t)e * DE * D : p.sw2;
      tr_wave<D>(src, (tt / 16) * 64, (tt % 16) * 64, p.W2t() + (size_t)e * 1024 * 256, 256, 0, lane, tb); }
}
__device__ __forceinline__ void ph_convert_dyn(const MK& p, int tid_l) {
    const int lane = tid_l & 63;
    char* tb = smem + (tid_l >> 6) * 8192;
    __syncthreads();
    for (;;) {
        int j = 0;
        if (lane == 0) j = atomicAdd(&p.cnt()[200], 8);
        j = __builtin_amdgcn_readfirstlane(j);
        if (j >= CV_E13) break;
#pragma unroll 1
        for (int k = 0; k < 8; ++k) if (j + k < CV_E13) convert_tile_wave(p, j + k, lane, tb);
    }
}

__device__ __forceinline__ void ph_ln1(const MK& p, int bid, int nb, int tid_l) {
    const int wid = tid_l >> 6, lane = tid_l & 63;
    for (int R = bid * 8 + wid; R < NR; R += nb * 8) {
        int b = R / RB, i = R % RB;
        const float* src = i < CTX ? p.ctx + ((size_t)b * CTX + i) * D : p.x + ((size_t)b * SEQ + (i - CTX)) * D;
        const float* m = p.mod() + (size_t)(i < CTX ? 4 : b) * 6 * D;
        float4 v[4]; float ss = 0;
#pragma unroll
        for (int q = 0; q < 4; ++q) { v[q] = *(const float4*)(src + q * 256 + lane * 4); ss += v[q].x * v[q].x + v[q].y * v[q].y + v[q].z * v[q].z + v[q].w * v[q].w; }
        ss = wave_sum(ss);
        float rstd = rsqrtf(ss * (1.0f / D) + EPS);
#pragma unroll
        for (int q = 0; q < 4; ++q) {
            int c0 = q * 256 + lane * 4;
            float4 gg = *(const float4*)(p.norm1_g + c0), sh = *(const float4*)(m + c0), sc = *(const float4*)(m + D + c0);
            float o0 = v[q].x * rstd * gg.x * (1 + sc.x) + sh.x, o1 = v[q].y * rstd * gg.y * (1 + sc.y) + sh.y;
            float o2 = v[q].z * rstd * gg.z * (1 + sc.z) + sh.z, o3 = v[q].w * rstd * gg.w * (1 + sc.w) + sh.w;
            u32x2 w; w.x = cvtpk(o0, o1); w.y = cvtpk(o2, o3);
            *(u32x2*)(p.H() + (size_t)R * D + c0) = w;
        }
    }
}

__device__ __forceinline__ int lds_byte(int r, int c) { int st = (r >> 4) * 2 + (c >> 5), ob = (r & 15) * 64 + (c & 31) * 2; return st * 1024 + (ob ^ (((ob >> 9) & 1) << 5)); }
__device__ __forceinline__ void stage_rc(int b, int& R, int& C) { int st = b >> 10, sb = b & 1023, swz = sb ^ (((sb >> 9) & 1) << 5); R = (st / 2) * 16 + swz / 64; C = (st % 2) * 32 + (swz % 64) / 2; }
#define WAIT_V0() asm volatile("s_waitcnt vmcnt(0)" ::: "memory")
__device__ __forceinline__ void gemm_core(const char* Abase, const unsigned (&Ao)[4], const char* Bbase, const unsigned (&Bo)[4], int nt, f32x4 (&acc)[8][4], int tid_l, bool pre) {
    const int tid = tid_l, wid = tid >> 6, lane = tid & 63, wr = wid >> 2, wc = wid & 3, fr = lane & 15, fq = lane >> 4;
#pragma unroll
    for (int m = 0; m < 8; ++m)
#pragma unroll
        for (int n = 0; n < 4; ++n) acc[m][n] = (f32x4){0.f, 0.f, 0.f, 0.f};
#define G_SA(b) (smem + (b) * 32768)
#define G_SB(b) (smem + 65536 + (b) * 32768)
#define G_STAGE(buf, kt) do { _Pragma("unroll") for (int i = 0; i < 4; ++i) {                                                     \
        __builtin_amdgcn_global_load_lds((const unsigned*)(Abase + (Ao[i] + (unsigned)(kt) * 128u)), (unsigned*)(G_SA(buf) + wid * 1024 + i * 8192), 16, 0, 0); \
        __builtin_amdgcn_global_load_lds((const unsigned*)(Bbase + (Bo[i] + (unsigned)(kt) * 128u)), (unsigned*)(G_SB(buf) + wid * 1024 + i * 8192), 16, 0, 0); } } while (0)
    if (!pre) G_STAGE(0, 0);
    WAIT_V0(); __syncthreads();
#define G_KSTEP(cur, t) do {                                                                                                   \
        if ((t) + 1 < nt) G_STAGE((cur) ^ 1, (t) + 1);                                                                          \
        _Pragma("unroll") for (int ks = 0; ks < 2; ++ks) {                                                                      \
            bf16x8 At[8], Bf[4];                                                                                                \
            _Pragma("unroll") for (int m = 0; m < 8; ++m) At[m] = *(const bf16x8*)(G_SA(cur) + lds_byte(wr * 128 + m * 16 + fr, ks * 32 + fq * 8)); \
            _Pragma("unroll") for (int n = 0; n < 4; ++n) Bf[n] = *(const bf16x8*)(G_SB(cur) + lds_byte(wc * 64 + n * 16 + fr, ks * 32 + fq * 8));  \
            _Pragma("unroll") for (int m = 0; m < 8; ++m) _Pragma("unroll") for (int n = 0; n < 4; ++n)                         \
                acc[m][n] = __builtin_amdgcn_mfma_f32_16x16x32_bf16(Bf[n], At[m], acc[m][n], 0, 0, 0);                          \
            __builtin_amdgcn_sched_barrier(0);                                                                                  \
        }                                                                                                                       \
        WAIT_V0(); __syncthreads(); } while (0)
#pragma unroll 1
    for (int t = 0; t < nt; ++t) { const int cur = t & 1; G_KSTEP(cur, t); }
}
#ifndef XPREFETCH
#define XPREFETCH 0
#endif
__device__ __forceinline__ void gemm_prefetch(const char* Abase, const unsigned (&Ao)[4], const char* Bbase, const unsigned (&Bo)[4], int tid_l) {
    const int wid = tid_l >> 6;
    G_STAGE(0, 0);
}
__device__ __forceinline__ void stage_offs(unsigned ld_bytes, unsigned (&P)[4], int tid_l) {
    const int wid = tid_l >> 6, lane = tid_l & 63;
#pragma unroll
    for (int i = 0; i < 4; ++i) { int R, C; stage_rc(wid * 1024 + i * 8192 + lane * 16, R, C); P[i] = (unsigned)R * ld_bytes + (unsigned)C * 2u; }
}

constexpr int WAREA = 18432;
__device__ __forceinline__ char* wave_area(int wid) { return smem + wid * WAREA; }

constexpr int A_KVBLK = 64;
constexpr float A_SCALE = 0.125f, A_THR = 8.f;
constexpr int A_SHM_V = A_KVBLK * 128 * 2, A_SHM_K = A_KVBLK * 128 * 2;
#define KSWZ(row, colB) ((row) * 256 + ((colB) ^ (((row) & 7) << 4)))
#define SBAR() __builtin_amdgcn_sched_barrier(0)
__device__ __forceinline__ int crow(int r, int hi) { return (r & 3) + 8 * (r >> 2) + 4 * hi; }

constexpr float A_THRL = 11.0f;
template <bool FIRST> __device__ __forceinline__ void partialSM2(f32x16& p0, f32x16& p1, float& mhat, f32x16& negm, float& alpha) {
    float pmax = p0[0];
#pragma unroll
    for (int r = 1; r < 16; ++r) pmax = fmaxf(pmax, p0[r]);
#pragma unroll
    for (int r = 0; r < 16; ++r) pmax = fmaxf(pmax, p1[r]);
    { auto rr = __builtin_amdgcn_permlane32_swap(__float_as_uint(pmax), __float_as_uint(pmax), false, false);
      pmax = fmaxf(__uint_as_float(rr[0]), __uint_as_float(rr[1])); }
    alpha = 1.f;
    if (FIRST || __builtin_expect(__any(pmax > A_THRL), 0)) {
        const float dl = FIRST ? pmax : fmaxf(pmax, 0.f);
        mhat += dl;
#pragma unroll
        for (int r = 0; r < 16; ++r) { p0[r] -= dl; p1[r] -= dl; }
#pragma unroll
        for (int r = 0; r < 16; ++r) negm[r] = -mhat;
        if (!FIRST) alpha = __builtin_amdgcn_exp2f(-dl);
    }
#pragma unroll
    for (int r = 0; r < 16; ++r) p0[r] = __builtin_amdgcn_exp2f(p0[r]);
}
__device__ __forceinline__ void qkt2(f32x16& p0, f32x16& p1, const char* Ks, const bf16x8* qr, const f32x16& negm, int r32, int hi, int mapc) {
#pragma unroll
    for (int d0 = 0; d0 < 4; ++d0) { int cb = (mapc + d0 * 16 + hi * 8) * 2;
        bf16x8 b0 = *reinterpret_cast<const bf16x8*>(Ks + KSWZ(r32, cb));
        bf16x8 b1 = *reinterpret_cast<const bf16x8*>(Ks + KSWZ(32 + r32, cb));
        if (d0 == 0) { p0 = __builtin_amdgcn_mfma_f32_32x32x16_bf16(b0, qr[0], negm, 0, 0, 0); p1 = __builtin_amdgcn_mfma_f32_32x32x16_bf16(b1, qr[0], negm, 0, 0, 0); }
        else { p0 = __builtin_amdgcn_mfma_f32_32x32x16_bf16(b0, qr[d0], p0, 0, 0, 0); p1 = __builtin_amdgcn_mfma_f32_32x32x16_bf16(b1, qr[d0], p1, 0, 0, 0); } }
}
template <int PROBE = 0> __device__ __forceinline__ void partialSM(f32x16& p0, f32x16& p1, float& m_reg, float& mn, float& alpha) {
    constexpr float C = A_SCALE * 1.4426950408889634f;
    float pmax = p0[0];
#pragma unroll
    for (int r = 1; r < 16; ++r) pmax = fmaxf(pmax, p0[r]);
#pragma unroll
    for (int r = 0; r < 16; ++r) pmax = fmaxf(pmax, p1[r]);
    { auto rr = __builtin_amdgcn_permlane32_swap(__float_as_uint(pmax), __float_as_uint(pmax), false, false);
      pmax = fmaxf(__uint_as_float(rr[0]), __uint_as_float(rr[1])); }
    if (__builtin_expect(__all(pmax - m_reg <= A_THR / A_SCALE), 1)) { mn = m_reg; alpha = 1.f; }
    else { mn = fmaxf(m_reg, pmax); alpha = __builtin_amdgcn_exp2f((m_reg - mn) * C); m_reg = mn; }
    float mnC = -mn * C;
#pragma unroll
    for (int r = 0; r < 16; ++r) p0[r] = fmaf(p0[r], C, mnC);
#pragma unroll
    for (int r = 0; r < 16; ++r) p1[r] = fmaf(p1[r], C, mnC);
#pragma unroll
    for (int r = 0; r < 16; ++r) p0[r] = PROBE == 3 ? p0[r] * 1e-3f : __builtin_amdgcn_exp2f(p0[r]);
}
#define PK4(P, BASE, OUT) do { unsigned a0 = cvtpk(P[BASE + 0], P[BASE + 1]), a1 = cvtpk(P[BASE + 2], P[BASE + 3]);   \
    unsigned b0 = cvtpk(P[BASE + 4], P[BASE + 5]), b1 = cvtpk(P[BASE + 6], P[BASE + 7]);                              \
    auto r0 = __builtin_amdgcn_permlane32_swap(a0, b0, false, false); auto r1 = __builtin_amdgcn_permlane32_swap(a1, b1, false, false); \
    u32x4 w = {r0[0], r1[0], r0[1], r1[1]}; OUT = *reinterpret_cast<bf16x8*>(&w); } while (0)
template <int PROBE = 0, bool DIRECT = false> __device__ __forceinline__ void finishSM(f32x16& p0, f32x16& p1, float alpha, float& l_reg, bf16x8& pa0, bf16x8& pa1, bf16x8& pa2, bf16x8& pa3) {
#pragma unroll
    for (int r = 0; r < 16; ++r) p1[r] = PROBE == 3 ? p1[r] * 1e-3f : __builtin_amdgcn_exp2f(p1[r]);
    float ps = 0;
#pragma unroll
    for (int r = 0; r < 16; ++r) ps += p0[r];
#pragma unroll
    for (int r = 0; r < 16; ++r) ps += p1[r];
    { auto rr = __builtin_amdgcn_permlane32_swap(__float_as_uint(ps), __float_as_uint(ps), false, false);
      ps = __uint_as_float(rr[0]) + __uint_as_float(rr[1]); }
    l_reg = l_reg * alpha + ps;
    if (DIRECT) {
#define PKD(P, B, OUT) do { u32x4 w = {cvtpk(P[B], P[B + 1]), cvtpk(P[B + 2], P[B + 3]), cvtpk(P[B + 4], P[B + 5]), cvtpk(P[B + 6], P[B + 7])}; OUT = *reinterpret_cast<bf16x8*>(&w); } while (0)
        PKD(p0, 0, pa0); PKD(p0, 8, pa1); PKD(p1, 0, pa2); PKD(p1, 8, pa3);
#undef PKD
    } else { PK4(p0, 0, pa0); PK4(p0, 8, pa1); PK4(p1, 0, pa2); PK4(p1, 8, pa3); }
}
__device__ __forceinline__ void qkt(f32x16& p0, f32x16& p1, const char* Ks, const bf16x8* qr, int r32, int hi, int mapc) {
    p0 = f32x16{}; p1 = f32x16{};
#pragma unroll
    for (int d0 = 0; d0 < 4; ++d0) { int cb = (mapc + d0 * 16 + hi * 8) * 2;
        bf16x8 b0 = *reinterpret_cast<const bf16x8*>(Ks + KSWZ(r32, cb));
        bf16x8 b1 = *reinterpret_cast<const bf16x8*>(Ks + KSWZ(32 + r32, cb));
        p0 = __builtin_amdgcn_mfma_f32_32x32x16_bf16(b0, qr[d0], p0, 0, 0, 0);
        p1 = __builtin_amdgcn_mfma_f32_32x32x16_bf16(b1, qr[d0], p1, 0, 0, 0); }
}
__device__ __forceinline__ int v_st(int k, int c) { const int kk = (k & ~0xC) | ((k & 4) << 1) | ((k & 8) >> 1); return ((kk >> 3) * 4 + (c >> 5)) * 512 + ((kk & 7) * 32 + (c & 31)) * 2; }
__device__ __forceinline__ int v_rd_base(int lane) { return ((lane & 3) << 3) | (((lane >> 2) & 3) << 6) | (((lane >> 4) & 1) << 5) | (((lane >> 5) & 1) << 8); }
constexpr int v_rd_off(int d0, int ks, int half) { return d0 * 512 + ks * 4096 + half * 2048; }
template <int OFF> __device__ __forceinline__ s16x4 tr_read(int vb) {
    s16x4 r; asm volatile("ds_read_b64_tr_b16 %0, %1 offset:%2" : "=&v"(r) : "v"(vb), "i"(OFF) : "memory"); return r;
}
template <int D0> __device__ __forceinline__ void pv_one(f32x16& od, int vb, bf16x8 pa0, bf16x8 pa1, bf16x8 pa2, bf16x8 pa3) {
    const s16x4 l0 = tr_read<v_rd_off(D0, 0, 0)>(vb), h0 = tr_read<v_rd_off(D0, 0, 1)>(vb), l1 = tr_read<v_rd_off(D0, 1, 0)>(vb), h1 = tr_read<v_rd_off(D0, 1, 1)>(vb);
    const s16x4 l2 = tr_read<v_rd_off(D0, 2, 0)>(vb), h2 = tr_read<v_rd_off(D0, 2, 1)>(vb), l3 = tr_read<v_rd_off(D0, 3, 0)>(vb), h3 = tr_read<v_rd_off(D0, 3, 1)>(vb);
    asm volatile("s_waitcnt lgkmcnt(0)" ::: "memory"); SBAR();
#define PKV(L, H) (bf16x8){L[0], L[1], L[2], L[3], H[0], H[1], H[2], H[3]}
    od = __builtin_amdgcn_mfma_f32_32x32x16_bf16(pa0, PKV(l0, h0), od, 0, 0, 0);
    od = __builtin_amdgcn_mfma_f32_32x32x16_bf16(pa1, PKV(l1, h1), od, 0, 0, 0);
    od = __builtin_amdgcn_mfma_f32_32x32x16_bf16(pa2, PKV(l2, h2), od, 0, 0, 0);
    od = __builtin_amdgcn_mfma_f32_32x32x16_bf16(pa3, PKV(l3, h3), od, 0, 0, 0);
}
template <int D0> __device__ __forceinline__ void pv_two(f32x16& oa, f32x16& ob, int vb, bf16x8 pa0, bf16x8 pa1, bf16x8 pa2, bf16x8 pa3) {
    const s16x4 l0 = tr_read<v_rd_off(D0, 0, 0)>(vb), h0 = tr_read<v_rd_off(D0, 0, 1)>(vb), l1 = tr_read<v_rd_off(D0, 1, 0)>(vb), h1 = tr_read<v_rd_off(D0, 1, 1)>(vb);
    const s16x4 l2 = tr_read<v_rd_off(D0, 2, 0)>(vb), h2 = tr_read<v_rd_off(D0, 2, 1)>(vb), l3 = tr_read<v_rd_off(D0, 3, 0)>(vb), h3 = tr_read<v_rd_off(D0, 3, 1)>(vb);
    const s16x4 m0 = tr_read<v_rd_off(D0 + 1, 0, 0)>(vb), g0 = tr_read<v_rd_off(D0 + 1, 0, 1)>(vb), m1 = tr_read<v_rd_off(D0 + 1, 1, 0)>(vb), g1 = tr_read<v_rd_off(D0 + 1, 1, 1)>(vb);
    const s16x4 m2 = tr_read<v_rd_off(D0 + 1, 2, 0)>(vb), g2 = tr_read<v_rd_off(D0 + 1, 2, 1)>(vb), m3 = tr_read<v_rd_off(D0 + 1, 3, 0)>(vb), g3 = tr_read<v_rd_off(D0 + 1, 3, 1)>(vb);
    asm volatile("s_waitcnt lgkmcnt(0)" ::: "memory"); SBAR();
    oa = __builtin_amdgcn_mfma_f32_32x32x16_bf16(pa0, PKV(l0, h0), oa, 0, 0, 0);
    ob = __builtin_amdgcn_mfma_f32_32x32x16_bf16(pa0, PKV(m0, g0), ob, 0, 0, 0);
    oa = __builtin_amdgcn_mfma_f32_32x32x16_bf16(pa1, PKV(l1, h1), oa, 0, 0, 0);
    ob = __builtin_amdgcn_mfma_f32_32x32x16_bf16(pa1, PKV(m1, g1), ob, 0, 0, 0);
    oa = __builtin_amdgcn_mfma_f32_32x32x16_bf16(pa2, PKV(l2, h2), oa, 0, 0, 0);
    ob = __builtin_amdgcn_mfma_f32_32x32x16_bf16(pa2, PKV(m2, g2), ob, 0, 0, 0);
    oa = __builtin_amdgcn_mfma_f32_32x32x16_bf16(pa3, PKV(l3, h3), oa, 0, 0, 0);
    ob = __builtin_amdgcn_mfma_f32_32x32x16_bf16(pa3, PKV(m3, g3), ob, 0, 0, 0);
}
__device__ __forceinline__ void pv_d0(f32x16* o, int vb, bf16x8 pa0, bf16x8 pa1, bf16x8 pa2, bf16x8 pa3) {
    pv_one<0>(o[0], vb, pa0, pa1, pa2, pa3); pv_one<1>(o[1], vb, pa0, pa1, pa2, pa3); pv_one<2>(o[2], vb, pa0, pa1, pa2, pa3); pv_one<3>(o[3], vb, pa0, pa1, pa2, pa3);
}

template <int PROBE> __device__ __forceinline__ void attn_item(const bf16_t* __restrict__ Qb, const bf16_t* __restrict__ Kh, const bf16_t* __restrict__ Vh, bf16_t* __restrict__ mixrow,
                                          const float* __restrict__ gd, float lam, int tid_l) {
    char* lds = smem;
    const int tid = tid_l, wid = tid >> 6, lane = tid & 63, r32 = lane & 31, hi = lane >> 5;
    const int map = wid >> 2, wq = wid & 3, mapc = map * 64;
    char* K_lds = lds; char* V_lds = lds + 4 * A_SHM_K;
    float* wsw = (float*)(lds + 4 * A_SHM_V + 4 * A_SHM_K) + wid * 64; float* li_l = wsw; float* al_l = wsw + 32;
    float m_reg = 0.f, l_reg = 0; f32x16 o[4] = {}; bf16x8 qr[4]; f32x16 negm = f32x16{};
    const bf16_t* Qw = Qb + (long)(wq * 32 + r32) * 128 + mapc + hi * 8;
#pragma unroll
    for (int d0 = 0; d0 < 4; ++d0) qr[d0] = *reinterpret_cast<const bf16x8*>(Qw + d0 * 16);
    const int vb0 = (int)(uintptr_t)V_lds + v_rd_base(lane);
    unsigned kofs[2], vofs[2];
    const int widu = __builtin_amdgcn_readfirstlane(wid);
#pragma unroll
    for (int i = 0; i < 2; ++i) {
        const int x = wid * 1024 + i * 8192 + lane * 16;
        { const int row = x >> 8, cs = x & 255, colB = cs ^ ((row & 7) << 4); kofs[i] = (unsigned)(row * 256 + colB); }
        { const int sub = x >> 9, wn = x & 511, k = (sub >> 2) * 8 + (wn >> 6), c = (sub & 3) * 32 + ((wn & 63) >> 1); vofs[i] = (unsigned)(k * 256 + c * 2); }
    }
#define DMA_TILE(slot, k0) do { const char* kt_ = (const char*)Kh + (size_t)(k0) * 256; const char* vt_ = (const char*)Vh + (size_t)(k0) * 256;                  \
      _Pragma("unroll") for (int i = 0; i < 2; ++i) {                                                                   \
        __builtin_amdgcn_global_load_lds((const unsigned*)(kt_ + kofs[i]), (unsigned*)(K_lds + (slot) * A_SHM_K + widu * 1024 + i * 8192), 16, 0, 0); \
        __builtin_amdgcn_global_load_lds((const unsigned*)(vt_ + vofs[i]), (unsigned*)(V_lds + (slot) * A_SHM_V + widu * 1024 + i * 8192), 16, 0, 0); } } while (0)
#define RESC(a) do { if (__any((a) < 1.f)) { if (hi == 0) al_l[r32] = (a); asm volatile("s_waitcnt lgkmcnt(0)" ::: "memory"); \
    _Pragma("unroll") for (int d = 0; d < 4; ++d) _Pragma("unroll") for (int r = 0; r < 16; ++r) o[d][r] *= al_l[crow(r, hi)]; } } while (0)
    f32x16 pA0, pA1, pB0, pB1; float mnA, mnB, alA, alB; bf16x8 pa0, pa1, pa2, pa3; const int NT = RB / A_KVBLK;
    DMA_TILE(0, 0); DMA_TILE(1, A_KVBLK);
    asm volatile("s_waitcnt vmcnt(0)" ::: "memory"); __syncthreads();
    qkt2(pA0, pA1, K_lds, qr, negm, r32, hi, mapc); partialSM2<true>(pA0, pA1, m_reg, negm, alA);
#define ATILE(X0, X1, ALX, Y0, Y1, ALY, CS, PS, NS, T_, DODMA) do {                                                                  \
        asm volatile("s_waitcnt vmcnt(0)" ::: "memory"); __syncthreads();                                                            \
        if (DODMA && PROBE != 1) DMA_TILE(NS, ((T_) + 1) * A_KVBLK);                                                                 \
        SBAR(); qkt2(X0, X1, K_lds + (CS) * A_SHM_K, qr, negm, r32, hi, mapc);                                                       \
        finishSM<PROBE, true>(Y0, Y1, ALY, l_reg, pa0, pa1, pa2, pa3); SBAR();                                                       \
        pv_d0(o, vb0 + (PS) * A_SHM_V, pa0, pa1, pa2, pa3); partialSM2<false>(X0, X1, m_reg, negm, ALX);                             \
        RESC(ALX); } while (0)
#pragma unroll 1
    for (int j = 1; j + 3 < NT; j += 4) {
        ATILE(pB0, pB1, alB, pA0, pA1, alA, 1, 0, 2, j, true);
        ATILE(pA0, pA1, alA, pB0, pB1, alB, 2, 1, 3, j + 1, true);
        ATILE(pB0, pB1, alB, pA0, pA1, alA, 3, 2, 0, j + 2, true);
        ATILE(pA0, pA1, alA, pB0, pB1, alB, 0, 3, 1, j + 3, true);
    }
    ATILE(pB0, pB1, alB, pA0, pA1, alA, 1, 0, 2, NT - 3, true);
    ATILE(pA0, pA1, alA, pB0, pB1, alB, 2, 1, 3, NT - 2, true);
    ATILE(pB0, pB1, alB, pA0, pA1, alA, 3, 2, 0, NT - 1, false);
    finishSM<PROBE, true>(pB0, pB1, alB, l_reg, pa0, pa1, pa2, pa3); SBAR();
    pv_d0(o, vb0 + 3 * A_SHM_V, pa0, pa1, pa2, pa3);
#undef ATILE
#undef DMA_TILE
    if (hi == 0) li_l[r32] = l_reg;
    asm volatile("s_waitcnt lgkmcnt(0)" ::: "memory");
    float rl[16];
#pragma unroll
    for (int r = 0; r < 16; ++r) rl[r] = __builtin_amdgcn_rcpf(li_l[crow(r, hi)]);
    __syncthreads();
    {
        float* xo = (float*)lds + map * 16384 + (wq * 32) * 128 + r32;
#pragma unroll
        for (int r = 0; r < 16; ++r)
#pragma unroll
            for (int d0 = 0; d0 < 4; ++d0) xo[crow(r, hi) * 128 + d0 * 32] = o[d0][r] * rl[r];
    }
    __syncthreads();
    {
        int l2 = lane; asm volatile("" : "+v"(l2));
        const float g0 = gd[l2 * 2], g1 = gd[l2 * 2 + 1];
#pragma unroll 4
        for (int rr = 0; rr < 16; ++rr) {
            const int row = wid * 16 + rr;
            const float2 a0 = *(const float2*)((const float*)lds + row * 128 + l2 * 2), a1 = *(const float2*)((const float*)lds + 16384 + row * 128 + l2 * 2);
            const float xv = a0.x - lam * a1.x, yv = a0.y - lam * a1.y;
            const float ss = wave_sum(xv * xv + yv * yv);
            const float rs = rsqrtf(ss * (1.0f / 128) + EPS) * 0.8f;
            *(unsigned*)(mixrow + (long)row * 1024 + l2 * 2) = cvtpk(xv * rs * g0, yv * rs * g1);
        }
    }
    __syncthreads();
#undef RESC
}


template <int PROBE> __device__ __forceinline__ void ph_attn(const MK& p, int bid, int nb, int tid_l) {
    const int lane = tid_l & 63;
    float s1 = wave_sum(p.lq1[lane] * p.lk1[lane]), s2 = wave_sum(p.lq2[lane] * p.lk2[lane]);
    const float lam = expf(s1) - expf(s2) + 0.2f;
    const int nrounds = (1024 + nb - 1) / nb;
    for (int rr = 0; rr < nrounds; ++rr) {
        int item;
        if (nb == 256) { int x = bid & 7, j = bid >> 3, hh = rr * 8 + x; item = (hh >> 1) * 64 + (hh & 1) * 32 + j; }
        else { item = rr * nb + bid; if (item >= 1024) break; }
        const int bh = item >> 6, qb = item & 63, b = bh >> 2, h = bh & 3;
        attn_item<PROBE>(p.Q() + ((size_t)bh * SEQ + qb * 128) * 128, p.K() + (size_t)bh * RB * 128, p.V() + (size_t)bh * RB * 128,
                  PROBE ? (bf16_t*)(p.ws + 492 * MiB) + h * 128 : p.MIX() + ((size_t)(b * SEQ + qb * 128)) * 1024 + h * 128, p.dattn_g, lam, tid_l);
    }
}


__device__ __forceinline__ bf16x8 ldfrag(const bf16_t* p) { return *reinterpret_cast<const bf16x8*>(p); }

__device__ __forceinline__ void ph_kv(const MK& p, int bid, int nb, int tid_l) {
    const int wid = tid_l >> 6, lane = tid_l & 63, r32 = lane & 31, hi = lane >> 5;
    const int nitems = 16 * 2 * 66;
    for (int it = bid * 8 + wid; it < nitems; it += nb * 8) {
        const int c = it % 66, chain = it / 66, dir = chain & 1, bh = chain >> 1;
        const bf16_t* vt = p.VT() + (size_t)bh * 128 * RB + c * 128 + hi * 8;
        const bf16_t* kt = (dir ? p.KTb() : p.KTf()) + (size_t)bh * 64 * RB + c * 128 + hi * 8;
        f32x16 acc[4][2];
#pragma unroll
        for (int mt = 0; mt < 4; ++mt) { acc[mt][0] = f32x16{}; acc[mt][1] = f32x16{}; }
#pragma unroll 2
        for (int ks = 0; ks < 8; ++ks) {
            bf16x8 a[4], b[2];
#pragma unroll
            for (int mt = 0; mt < 4; ++mt) a[mt] = ldfrag(vt + (size_t)(mt * 32 + r32) * RB + ks * 16);
#pragma unroll
            for (int nt = 0; nt < 2; ++nt) b[nt] = ldfrag(kt + (size_t)(nt * 32 + r32) * RB + ks * 16);
#pragma unroll
            for (int mt = 0; mt < 4; ++mt)
#pragma unroll
                for (int nt = 0; nt < 2; ++nt) acc[mt][nt] = __builtin_amdgcn_mfma_f32_32x32x16_bf16(a[mt], b[nt], acc[mt][nt], 0, 0, 0);
        }
        bf16_t* dst = p.KV() + (size_t)it * 8192;
#pragma unroll
        for (int mt = 0; mt < 4; ++mt)
#pragma unroll
            for (int nt = 0; nt < 2; ++nt)
#pragma unroll
                for (int r = 0; r < 16; ++r) dst[(mt * 32 + crow(r, hi)) * 64 + nt * 32 + r32] = f2bf(acc[mt][nt][r]);
    }
}

__device__ __forceinline__ void ph_scan(const MK& p, int bid, int nb, int tid_l) {
    if (tid_l >= 256) {
        const int lane = tid_l & 63, wq = __builtin_amdgcn_readfirstlane(tid_l >> 6); char* tb = smem + wq * 8192;
#pragma unroll 1
        for (int j = CV_E13 + bid * 4 + (wq - 4); j < CV_E13 + CV_E2; j += nb * 4) convert_tile_wave(p, j, lane, tb);
        return;
    }
    for (int e0 = bid * 256 + tid_l; e0 < 32 * 8192; e0 += nb * 1024) {
        float S[4], g128[4]; const bf16_t* kv[4]; bf16_t* st[4]; int dir[4];
#pragma unroll
        for (int q = 0; q < 4; ++q) {
            int e = e0 + q * nb * 256; if (e >= 32 * 8192) e = e0;
            const int chain = e >> 13, el = e & 8191, h = (chain >> 1) & 3; dir[q] = chain & 1;
            const float d = dir[q] ? p.dec_b[h] : p.dec_f[h];
            g128[q] = exp2f(128.0f * log2f(1.0f / (1.0f + expf(-d))));
            kv[q] = p.KV() + (size_t)chain * 66 * 8192 + el; st[q] = p.ST() + (size_t)chain * 66 * 8192 + el; S[q] = 0.f;
        }
#pragma unroll 2
        for (int n = 0; n < 66; ++n) {
            const int cb = n == 0 ? 1 : (n == 1 ? 0 : 67 - n);
            float x[4];
#pragma unroll
            for (int q = 0; q < 4; ++q) x[q] = bf2f(kv[q][(size_t)(dir[q] ? cb : n) * 8192]);
#pragma unroll
            for (int q = 0; q < 4; ++q) { st[q][(size_t)(dir[q] ? cb : n) * 8192] = f2bf(S[q]); S[q] = fmaf(g128[q], S[q], x[q]); }
        }
    }
}

__device__ __forceinline__ void ph_ret(const MK& p, int bid, int nb, int tid_l) {
    const int tid = tid_l, wid = tid >> 6, lane = tid & 63, r32 = lane & 31, hi = lane >> 5, wq = wid & 3, half = wid >> 2;
    float* img = (float*)smem;
    for (int it = bid; it < 4 * 64 * 2; it += nb) {
        const int hp = it & 1, lc = (it >> 1) & 63, b = it >> 7, h = hp * 2 + half, bh = b * 4 + h;
        const int ib = CTX + lc * 128, c = 2 + lc;
        const float lf = log2f(1.0f / (1.0f + expf(-p.dec_f[h]))), lb = log2f(1.0f / (1.0f + expf(-p.dec_b[h])));
        const bf16_t* rq = p.RQ() + ((size_t)bh * RB + ib + wq * 32 + r32) * 64 + hi * 8;
        bf16x8 q[4];
#pragma unroll
        for (int ks = 0; ks < 4; ++ks) q[ks] = ldfrag(rq + ks * 16);
        f32x16 o[4];
        {
            const bf16_t* stf = p.ST() + ((size_t)(bh * 2 + 0) * 66 + c) * 8192 + hi * 8;
            const bf16_t* stb = p.ST() + ((size_t)(bh * 2 + 1) * 66 + c) * 8192 + hi * 8;
            {
                float rf[16];
#pragma unroll
                for (int r = 0; r < 16; ++r) rf[r] = __builtin_amdgcn_exp2f((float)(wq * 32 + crow(r, hi) + 1) * lf);
#pragma unroll
                for (int d0 = 0; d0 < 4; ++d0) {
                    f32x16 tf = f32x16{};
#pragma unroll
                    for (int ks = 0; ks < 4; ++ks) tf = __builtin_amdgcn_mfma_f32_32x32x16_bf16(q[ks], ldfrag(stf + (size_t)(d0 * 32 + r32) * 64 + ks * 16), tf, 0, 0, 0);
#pragma unroll
                    for (int r = 0; r < 16; ++r) o[d0][r] = tf[r] * rf[r];
                    asm volatile("" ::: "memory");
                }
            }
            {
                float rf[16];
#pragma unroll
                for (int r = 0; r < 16; ++r) rf[r] = __builtin_amdgcn_exp2f((float)(128 - (wq * 32 + crow(r, hi))) * lb);
#pragma unroll
                for (int d0 = 0; d0 < 4; ++d0) {
                    f32x16 tb = f32x16{};
#pragma unroll
                    for (int ks = 0; ks < 4; ++ks) tb = __builtin_amdgcn_mfma_f32_32x32x16_bf16(q[ks], ldfrag(stb + (size_t)(d0 * 32 + r32) * 64 + ks * 16), tb, 0, 0, 0);
#pragma unroll
                    for (int r = 0; r < 16; ++r) o[d0][r] += tb[r] * rf[r];
                    asm volatile("" ::: "memory");
                }
            }
        }
        {
            const int qi = wq * 32 + r32;
            const bf16_t* vt = p.VT() + (size_t)bh * 128 * RB + ib + hi * 8;
#pragma unroll 1
            for (int jb = 0; jb < 4; ++jb) {
                asm volatile("" ::: "memory");
                const bf16_t* rk = p.RK() + ((size_t)bh * RB + ib + jb * 32 + r32) * 64 + hi * 8;
                f32x16 pp = f32x16{};
#pragma unroll
                for (int ks = 0; ks < 4; ++ks) pp = __builtin_amdgcn_mfma_f32_32x32x16_bf16(ldfrag(rk + ks * 16), q[ks], pp, 0, 0, 0);
#pragma unroll
                for (int r = 0; r < 16; ++r) {
                    const int dd = qi - (jb * 32 + crow(r, hi));
                    const float ex = __builtin_amdgcn_exp2f(dd > 0 ? (float)dd * lf : (float)(-dd) * lb); const float w = dd == 0 ? 2.0f : ex;
                    pp[r] *= w;
                }
                bf16x8 pa0, pa1;
                PK4(pp, 0, pa0); PK4(pp, 8, pa1);
#pragma unroll
                for (int d0 = 0; d0 < 4; ++d0) {
                    o[d0] = __builtin_amdgcn_mfma_f32_32x32x16_bf16(pa0, ldfrag(vt + (size_t)(d0 * 32 + r32) * RB + jb * 32), o[d0], 0, 0, 0);
                    o[d0] = __builtin_amdgcn_mfma_f32_32x32x16_bf16(pa1, ldfrag(vt + (size_t)(d0 * 32 + r32) * RB + jb * 32 + 16), o[d0], 0, 0, 0);
                }
            }
        }
        __syncthreads();
        {
            float* xo = img + half * 16384 + (wq * 32) * 128 + r32;
#pragma unroll
            for (int r = 0; r < 16; ++r)
#pragma unroll
                for (int d0 = 0; d0 < 4; ++d0) xo[crow(r, hi) * 128 + d0 * 32] = o[d0][r];
        }
        __syncthreads();
        {
            const float g0 = p.ret_g[lane * 2], g1 = p.ret_g[lane * 2 + 1];
#pragma unroll 4
            for (int rr = 0; rr < 32; ++rr) {
                const int row = wid * 32 + rr, itl = row >> 7, rw = row & 127, hh = hp * 2 + itl;
                const float2 a = *(const float2*)(img + row * 128 + lane * 2);
                const float ss = wave_sum(a.x * a.x + a.y * a.y);
                const float rs = rsqrtf(ss * (1.0f / 128) + EPS);
                const size_t tt = (size_t)b * SEQ + lc * 128 + rw;
                const unsigned gg = *(const unsigned*)(p.RG() + tt * 512 + hh * 128 + lane * 2);
                const float ga = bf2f((bf16_t)(gg & 0xffff)), gb = bf2f((bf16_t)(gg >> 16));
                *(unsigned*)(p.MIX() + tt * 1024 + 512 + hh * 128 + lane * 2) = cvtpk(silu_fast(ga) * a.x * rs * g0, silu_fast(gb) * a.y * rs * g1);
            }
        }
    }
}


namespace pg8 {
constexpr int BM = 256, BK = 64, HALF = 128, HTB = HALF * BK * 2;
__device__ __forceinline__ int perm32(int rho) { const int n = rho >> 4, i = rho & 15; return 8 * (i >> 2) + 4 * n + (i & 3); }
struct GUnit { const char* A; const char* B; int i0, i1, i2, i3; };
template <class Epi, class Sched, bool GATHER, bool ALIGN_EPI>
__device__ __forceinline__ void gemm(int K, const Sched& S, const Epi& E, int tid_l) {
    const int tid = tid_l, wid = __builtin_amdgcn_readfirstlane(tid >> 6), lane = tid & 63, wr = wid >> 2, wc = wid & 3, fr = lane & 15, fq = lane >> 4;
    const int nt = K / BK;
    unsigned voffB[2], vAc[2][2], vAn[2][2];
    const size_t kstep = (size_t)(BK * 2);
    const size_t hstepB = (size_t)HALF * K * 2;
#pragma unroll
    for (int i = 0; i < 2; ++i) { int R, C; stage_rc(tid * 16 + i * 8192, R, C); const int Rb = Epi::PERM ? ((R & ~31) + perm32(R & 31)) : R;
        voffB[i] = (unsigned)(Rb * K + C) * 2u; }
    const unsigned ldsw = (unsigned)wid * 1024u;
    const int aoff = lds_byte(wr * 64 + fr, fq * 8), boff = lds_byte(wc * 32 + fr, fq * 8);
#define PG8_SA(b, h) (((b) * 2 + (h)) * HTB)
#define PG8_SB(b, h) ((4 + (b) * 2 + (h)) * HTB)
#define PG8_STAGE(bufoff, gbase, voff) do { _Pragma("unroll") for (int _i = 0; _i < 2; ++_i) \
        __builtin_amdgcn_global_load_lds((const unsigned*)((const char*)(gbase) + (voff)[_i]), (unsigned*)(smem + (bufoff) + ldsw + _i * 8192), 16, 0, 0); } while (0)
#define PG8_LDA(dst, b, h) do { _Pragma("unroll") for (int m = 0; m < 4; ++m) _Pragma("unroll") for (int k = 0; k < 2; ++k) dst[m][k] = *(const bf16x8*)(smem + PG8_SA(b, h) + aoff + m * 2048 + k * 1024); } while (0)
#define PG8_LDB(dst, b, h) do { _Pragma("unroll") for (int n = 0; n < 2; ++n) _Pragma("unroll") for (int k = 0; k < 2; ++k) dst[n][k] = *(const bf16x8*)(smem + PG8_SB(b, h) + boff + n * 2048 + k * 1024); } while (0)
#define PG8_MMA(ai, bj, At, Bt) do { __builtin_amdgcn_s_setprio(1); _Pragma("unroll") for (int m = 0; m < 4; ++m) _Pragma("unroll") for (int n = 0; n < 2; ++n) _Pragma("unroll") for (int k = 0; k < 2; ++k) \
        acc[ai][bj][m][n] = __builtin_amdgcn_mfma_f32_16x16x32_bf16(Bt[n][k], At[m][k], acc[ai][bj][m][n], 0, 0, 0); __builtin_amdgcn_s_setprio(0); } while (0)
#define PG8_WAIT_V(n) asm volatile("s_waitcnt vmcnt(" #n ")" ::: "memory")
#define PG8_WAIT_L(n) asm volatile("s_waitcnt lgkmcnt(" #n ")" ::: "memory")
#define PG8_BAR __builtin_amdgcn_s_barrier()
#define PG8_SCHED __builtin_amdgcn_sched_barrier(0)
    GUnit cur, nxt; int ui = 0;
    if (!S.next(0, cur, vAc)) return;
    f32x4 acc[2][2][4][2];
#pragma unroll
    for (int a = 0; a < 2; ++a)
#pragma unroll
        for (int b = 0; b < 2; ++b)
#pragma unroll
            for (int m = 0; m < 4; ++m)
#pragma unroll
                for (int n = 0; n < 2; ++n) acc[a][b][m][n] = (f32x4){0.f, 0.f, 0.f, 0.f};
    bf16x8 At[4][2], B0[2][2], B1[2][2];
    const char* cA = cur.A; const char* cB = cur.B;
    PG8_STAGE(PG8_SB(0, 0), cB, voffB); PG8_STAGE(PG8_SB(0, 1), cB + hstepB, voffB); PG8_STAGE(PG8_SA(0, 0), cA, vAc[0]); PG8_STAGE(PG8_SA(0, 1), cA, vAc[1]);
    if (wr == 1) PG8_BAR;
    PG8_WAIT_V(2); PG8_BAR;
    PG8_STAGE(PG8_SB(1, 0), cB + kstep, voffB); PG8_STAGE(PG8_SA(1, 0), cA + kstep, vAc[0]); PG8_STAGE(PG8_SB(1, 1), cB + hstepB + kstep, voffB);
    PG8_WAIT_V(6); PG8_BAR;
    for (;;) {
        const bool has_next = S.next(ui + 1, nxt, vAn);
        if (!GATHER || !has_next) {
#pragma unroll
            for (int h = 0; h < 2; ++h)
#pragma unroll
                for (int i = 0; i < 2; ++i) vAn[h][i] = vAc[h][i];
        }
        const char* nA = has_next ? nxt.A : cA; const char* nB = has_next ? nxt.B : cB;
#pragma unroll 1
        for (int t = 0; t < nt; t += 2) {
            const bool last = (t == nt - 2);
            const char* a1 = cA + (size_t)(t + 1) * kstep;
            const char* a2 = last ? nA : cA + (size_t)(t + 2) * kstep; const char* b2 = last ? nB : cB + (size_t)(t + 2) * kstep;
            const char* a3 = a2 + kstep; const char* b3 = b2 + kstep;
            unsigned va2[2][2];
#pragma unroll
            for (int h = 0; h < 2; ++h)
#pragma unroll
                for (int i = 0; i < 2; ++i) va2[h][i] = (GATHER && last) ? vAn[h][i] : vAc[h][i];
            PG8_LDB(B0, 0, 0); PG8_LDB(B1, 0, 1); PG8_SCHED; PG8_LDA(At, 0, 0); PG8_STAGE(PG8_SA(1, 1), a1, vAc[1]);
            PG8_WAIT_V(8); PG8_WAIT_L(0); PG8_BAR; PG8_MMA(0, 0, At, B0); PG8_MMA(0, 1, At, B1); PG8_BAR; PG8_SCHED;
            PG8_LDA(At, 0, 1); PG8_STAGE(PG8_SB(0, 0), b2, voffB); PG8_STAGE(PG8_SB(0, 1), b2 + hstepB, voffB); PG8_STAGE(PG8_SA(0, 0), a2, va2[0]);
            PG8_WAIT_V(8); PG8_WAIT_L(0); PG8_BAR; PG8_MMA(1, 0, At, B0); PG8_MMA(1, 1, At, B1); PG8_BAR; PG8_SCHED;
            PG8_LDB(B0, 1, 0); PG8_LDB(B1, 1, 1); PG8_SCHED; PG8_LDA(At, 1, 0); PG8_STAGE(PG8_SA(0, 1), a2, va2[1]);
            PG8_WAIT_V(8); PG8_WAIT_L(0); PG8_BAR; PG8_MMA(0, 0, At, B0); PG8_MMA(0, 1, At, B1); PG8_BAR; PG8_SCHED;
            PG8_LDA(At, 1, 1); PG8_STAGE(PG8_SB(1, 0), b3, voffB); PG8_STAGE(PG8_SB(1, 1), b3 + hstepB, voffB); PG8_STAGE(PG8_SA(1, 0), a3, va2[0]);
            PG8_WAIT_V(8); PG8_WAIT_L(0); PG8_BAR; PG8_MMA(1, 0, At, B0); PG8_MMA(1, 1, At, B1); PG8_BAR; PG8_SCHED;
        }
        if (ALIGN_EPI) { if (wr == 0) PG8_BAR; }
        E(acc, cur, wr, wc, fr, fq);
        if (!has_next) break;
#pragma unroll
        for (int a = 0; a < 2; ++a)
#pragma unroll
            for (int b = 0; b < 2; ++b)
#pragma unroll
                for (int m = 0; m < 4; ++m)
#pragma unroll
                    for (int n = 0; n < 2; ++n) acc[a][b][m][n] = (f32x4){0.f, 0.f, 0.f, 0.f};
        cur = nxt; cA = nA; cB = nB; ++ui;
#pragma unroll
        for (int h = 0; h < 2; ++h)
#pragma unroll
            for (int i = 0; i < 2; ++i) vAc[h][i] = vAn[h][i];
        if (ALIGN_EPI) { if (wr == 1) PG8_BAR; }
    }
    PG8_WAIT_V(0);
    if (!ALIGN_EPI) { if (wr == 0) PG8_BAR; }
    PG8_BAR;
#undef PG8_SA
#undef PG8_SB
#undef PG8_STAGE
#undef PG8_LDA
#undef PG8_LDB
#undef PG8_MMA
#undef PG8_WAIT_V
#undef PG8_WAIT_L
#undef PG8_BAR
#undef PG8_SCHED
}
__device__ __forceinline__ void plain_voffA(int K, unsigned (&vA)[2][2], int tid_l) {
#pragma unroll
    for (int i = 0; i < 2; ++i) { int R, C; stage_rc(tid_l * 16 + i * 8192, R, C); vA[0][i] = (unsigned)(R * K + C) * 2u; vA[1][i] = (unsigned)((R + HALF) * K + C) * 2u; }
}
}


__device__ __forceinline__ int xcd_vbid(int bid, int nb) { return (nb & 7) ? bid : (bid & 7) * (nb >> 3) + (bid >> 3); }
struct SchedIn { const MK* p; int bid, nb, tid_l;
    __device__ __forceinline__ bool next(int i, pg8::GUnit& u, unsigned (&vA)[2][2]) const {
        const int tile = xcd_vbid(bid, nb) + i * nb; if (tile >= (NR / 256) * 12) return false;
        const int pm = tile / 12, pn = tile % 12;
        u.A = (const char*)(p->H() + (size_t)(pm * 256) * D); u.B = (const char*)(p->w_inT() + (size_t)(pn * 256) * D); u.i0 = pm; u.i1 = pn; u.i2 = 0; u.i3 = 0;
        pg8::plain_voffA(D, vA, tid_l); return true; } };
struct EpiIn { static constexpr bool PERM = false; const MK* p;
    __device__ __forceinline__ void operator()(f32x4 (&acc)[2][2][4][2], const pg8::GUnit& u, int wr, int wc, int fr_in, int fq_in) const {
        int fr = fr_in, fq = fq_in; asm volatile("" : "+v"(fr), "+v"(fq));
        const int pm = u.i0, seg = u.i1, brow = pm * 256;
        const int b = brow / RB, i0 = brow % RB;
        const bool lat = i0 >= CTX;
        const int wid = wr * 4 + wc, lane = fq * 16 + fr;
        if (lat && (seg <= 3 || seg == 6 || seg == 7)) {
#pragma unroll
            for (int ai = 0; ai < 2; ++ai)
#pragma unroll
                for (int m = 0; m < 4; ++m) {
                    const int t = i0 + ai * 128 + wr * 64 + m * 16 + fr - CTX, pos = (wc & 1) ? (t & 63) : (t >> 6);
                    const f32x4 cc = *(const f32x4*)(p->ropec() + pos * 16 + fq * 4), ss = *(const f32x4*)(p->ropes() + pos * 16 + fq * 4);
#pragma unroll
                    for (int bj = 0; bj < 2; ++bj) { const f32x4 x1 = acc[ai][bj][m][0], x2 = acc[ai][bj][m][1];
                        acc[ai][bj][m][0] = x1 * cc - x2 * ss; acc[ai][bj][m][1] = x1 * ss + x2 * cc; }
                }
        }
        if (seg == 7 || seg <= 1) {
            const float sc_ = seg == 7 ? 0.125f : 0.125f * 1.4426950408889634f;
#pragma unroll
            for (int ai = 0; ai < 2; ++ai)
#pragma unroll
                for (int bj = 0; bj < 2; ++bj)
#pragma unroll
                    for (int m = 0; m < 4; ++m) { acc[ai][bj][m][0] = acc[ai][bj][m][0] * sc_; acc[ai][bj][m][1] = acc[ai][bj][m][1] * sc_; }
        }
        if (seg <= 7 || seg >= 10) {
#pragma unroll
            for (int bj = 0; bj < 2; ++bj) {
                bf16_t* base; long rstride; bool ok = true;
                if (seg <= 1)      { const int h = (seg & 1) * 2 + bj;       base = p->Q() + (((size_t)(b * 4 + h) * SEQ + (i0 - CTX)) * 128 + wc * 32 + fq * 4); rstride = 128; ok = lat; }
                else if (seg <= 3) { const int h = (seg - 2) * 2 + bj;       base = p->K() + (((size_t)(b * 4 + h) * RB + i0) * 128 + wc * 32 + fq * 4);          rstride = 128; }
                else if (seg <= 5) { const int h = (seg - 4) * 2 + bj;       base = p->V() + (((size_t)(b * 4 + h) * RB + i0) * 128 + wc * 32 + fq * 4);          rstride = 128; }
                else if (seg == 6) { const int h = bj * 2 + (wc >> 1);       base = p->RQ() + (((size_t)(b * 4 + h) * RB + i0) * 64 + (wc & 1) * 32 + fq * 4);    rstride = 64; }
                else if (seg == 7) { const int h = bj * 2 + (wc >> 1);       base = p->RK() + (((size_t)(b * 4 + h) * RB + i0) * 64 + (wc & 1) * 32 + fq * 4);    rstride = 64; }
                else               {                                         base = p->RG() + ((size_t)(b * SEQ + (i0 - CTX)) * 512 + (seg - 10) * 256 + bj * 128 + wc * 32 + fq * 4); rstride = 512; ok = lat; }
                if (ok) {
#pragma unroll
                    for (int ai = 0; ai < 2; ++ai)
#pragma unroll
                        for (int m = 0; m < 4; ++m) { bf16_t* rp = base + (long)(ai * 128 + wr * 64 + m * 16 + fr) * rstride;
#pragma unroll
                            for (int n = 0; n < 2; ++n) { u32x2 w; w.x = cvtpk(acc[ai][bj][m][n][0], acc[ai][bj][m][n][1]); w.y = cvtpk(acc[ai][bj][m][n][2], acc[ai][bj][m][n][3]);
                                *(u32x2*)(rp + n * 16) = w; } }
                }
            }
        }
        if (seg >= 7 && seg <= 9) {
            char* img = smem + 131072 + wid * 3968;
            const int npass = seg == 7 ? 2 : 1;
#pragma unroll 1
            for (int ps = 0; ps < npass; ++ps) {
#pragma unroll
                for (int bj = 0; bj < 2; ++bj) {
                    float lg2 = 0.f; bf16_t* baseT;
                    if (seg == 7) { const int h = bj * 2 + (wc >> 1); const float dv = ps == 0 ? p->dec_f[h] : p->dec_b[h]; lg2 = log2f(1.0f / (1.0f + expf(-dv)));
                        baseT = (ps == 0 ? p->KTf() : p->KTb()) + ((size_t)(b * 4 + h) * 64 + (wc & 1) * 32) * RB + i0; }
                    else { const int h = (seg - 8) * 2 + bj; baseT = p->VT() + ((size_t)(b * 4 + h) * 128 + wc * 32) * RB + i0; }
#pragma unroll
                    for (int ai = 0; ai < 2; ++ai)
#pragma unroll
                        for (int mp = 0; mp < 2; ++mp) {
                            asm volatile("s_waitcnt lgkmcnt(0)" ::: "memory");
#pragma unroll
                            for (int mm = 0; mm < 2; ++mm) { const int m = mp * 2 + mm;
                                float f = 1.0f;
                                if (seg == 7) { const int pos = (i0 + ai * 128 + wr * 64 + m * 16 + fr) & 127; f = __builtin_amdgcn_exp2f((float)(ps == 0 ? 127 - pos : pos) * lg2); }
#pragma unroll
                                for (int n = 0; n < 2; ++n)
#pragma unroll
                                    for (int j = 0; j < 4; ++j) *(bf16_t*)(img + (n * 16 + fq * 4 + j) * 80 + (mm * 16 + fr) * 2) = f2bf(acc[ai][bj][m][n][j] * f); }
                            asm volatile("s_waitcnt lgkmcnt(0)" ::: "memory");
                            const int ib = ai * 128 + wr * 64 + mp * 32;
#pragma unroll
                            for (int k = 0; k < 2; ++k) { const int q = lane + 64 * k, col = q >> 2, ch = q & 3;
                                *(u32x4*)(baseT + (size_t)col * RB + ib + ch * 8) = *(const u32x4*)(img + col * 80 + ch * 16); }
                        }
                }
            }
        }
    } };
__device__ __forceinline__ void ph_gemm_in(const MK& p, int bid, int nb, int tid_l) {
    SchedIn S{&p, bid, nb, tid_l}; EpiIn E{&p};
    pg8::gemm<EpiIn, SchedIn, false, true>(D, S, E, tid_l);
}

struct SchedOut { const MK* p; int bid, nb, tid_l;
    __device__ __forceinline__ bool next(int i, pg8::GUnit& u, unsigned (&vA)[2][2]) const {
        const int tile = xcd_vbid(bid, nb) + i * nb; if (tile >= (T / 256) * 4) return false;
        const int pm = tile >> 2, pn = tile & 3;
        u.A = (const char*)(p->MIX() + (size_t)(pm * 256) * D); u.B = (const char*)(p->w_outT() + (size_t)(pn * 256) * D); u.i0 = pm; u.i1 = pn; u.i2 = 0; u.i3 = 0;
        pg8::plain_voffA(D, vA, tid_l); return true; } };
struct EpiOut { static constexpr bool PERM = true; const MK* p;
    __device__ __forceinline__ void operator()(const f32x4 (&acc)[2][2][4][2], const pg8::GUnit& u, int wr, int wc, int fr, int fq) const {
        const int brow = u.i0 * 256, bcol = u.i1 * 256 + wc * 32 + fq * 8;
        const float* g1 = p->mod() + (size_t)(brow / SEQ) * 6 * D + 2 * D + bcol;
        f32x4 gv[2][2];
#pragma unroll
        for (int bj = 0; bj < 2; ++bj)
#pragma unroll
            for (int n = 0; n < 2; ++n) gv[bj][n] = *(const f32x4*)(g1 + bj * 128 + n * 4);
#pragma unroll
        for (int ai = 0; ai < 2; ++ai)
#pragma unroll
            for (int m = 0; m < 4; ++m) {
                const int row = brow + ai * 128 + wr * 64 + m * 16 + fr;
                const float* xp = p->x + (size_t)row * D + bcol;
                f32x4 xv[2][2];
#pragma unroll
                for (int bj = 0; bj < 2; ++bj)
#pragma unroll
                    for (int n = 0; n < 2; ++n) xv[bj][n] = *(const f32x4*)(xp + bj * 128 + n * 4);
#pragma unroll
                for (int bj = 0; bj < 2; ++bj) {
                    const f32x4 a = xv[bj][0] + gv[bj][0] * acc[ai][bj][m][0], b = xv[bj][1] + gv[bj][1] * acc[ai][bj][m][1];
                    const u32x4 w = {cvtpk(a[0], a[1]), cvtpk(a[2], a[3]), cvtpk(b[0], b[1]), cvtpk(b[2], b[3])};
                    *(u32x4*)(p->X1() + (size_t)row * 2048 + bcol + bj * 128) = w;
                }
                if (m & 1) asm volatile("" ::: "memory");
            }
    } };
__device__ __forceinline__ void ph_gemm_out(const MK& p, int bid, int nb, int tid_l) {
    SchedOut S{&p, bid, nb, tid_l}; EpiOut E{&p};
    pg8::gemm<EpiOut, SchedOut, false, true>(D, S, E, tid_l);
}

template <bool DUMMY, int MODE = 0> __device__ __forceinline__ void ph_route(const MK& p, int bid, int nb, int tid_l) {
    int* cntp = p.cnt() + (DUMMY ? 128 : 0); int* tl = DUMMY ? (int*)(p.ws + 480 * MiB) : p.tok_list(); float* wl_ = DUMMY ? (float*)(p.ws + 488 * MiB) : p.wt_list(); int* tm = DUMMY ? (int*)(p.ws + 496 * MiB) : p.tokmap();
    const int tid = tid_l, wid = tid >> 6, lane = tid & 63, fr = lane & 15, fq = lane >> 4;
    float* lg = (float*)smem;
    int* wcnt = (int*)(smem + 34816);
    int* pref = wcnt + 512;
    bf16_t* H2lo = (bf16_t*)(p.ws + 325 * MiB);
    for (int item = bid; item < T / 128; item += nb) {
        const int t0 = item * 128 + wid * 16, b = (item * 128) / SEQ;
        const float* msh = p.mod() + (size_t)b * 6 * D + 3 * D; const float* msc = p.mod() + (size_t)b * 6 * D + 4 * D;
#pragma unroll 1
        for (int r0 = 0; r0 < 16; r0 += 4) {
            float4 xv[4][4];
#pragma unroll
            for (int rr = 0; rr < 4; ++rr)
#pragma unroll
                for (int q = 0; q < 4; ++q) { const u32x2 w = *(const u32x2*)(p.X1() + (size_t)(t0 + r0 + rr) * 2048 + q * 256 + lane * 4);
                    xv[rr][q] = make_float4(__uint_as_float(w.x << 16), __uint_as_float(w.x & 0xffff0000u), __uint_as_float(w.y << 16), __uint_as_float(w.y & 0xffff0000u)); }
#pragma unroll
            for (int rr = 0; rr < 4; ++rr) {
                float ss = 0.f;
#pragma unroll
                for (int q = 0; q < 4; ++q) ss += xv[rr][q].x * xv[rr][q].x + xv[rr][q].y * xv[rr][q].y + xv[rr][q].z * xv[rr][q].z + xv[rr][q].w * xv[rr][q].w;
                ss = wave_sum(ss);
                const float rstd = rsqrtf(ss * (1.0f / D) + EPS);
#pragma unroll
                for (int q = 0; q < 4; ++q) {
                    const int c0 = q * 256 + lane * 4;
                    const float4 gg = *(const float4*)(p.norm2_g + c0), sh = *(const float4*)(msh + c0), sc = *(const float4*)(msc + c0);
                    const float h0 = xv[rr][q].x * rstd * gg.x * (1 + sc.x) + sh.x, h1 = xv[rr][q].y * rstd * gg.y * (1 + sc.y) + sh.y;
                    const float h2v = xv[rr][q].z * rstd * gg.z * (1 + sc.z) + sh.z, h3 = xv[rr][q].w * rstd * gg.w * (1 + sc.w) + sh.w;
                    u32x2 wh, wl2; wh.x = cvtpk(h0, h1); wh.y = cvtpk(h2v, h3);
                    wl2.x = cvtpk(h0 - __uint_as_float(wh.x << 16), h1 - __uint_as_float(wh.x & 0xffff0000u));
                    wl2.y = cvtpk(h2v - __uint_as_float(wh.y << 16), h3 - __uint_as_float(wh.y & 0xffff0000u));
                    *(u32x2*)(p.H2() + (size_t)(t0 + r0 + rr) * D + c0) = wh;
                    *(u32x2*)(H2lo + (size_t)(t0 + r0 + rr) * D + c0) = wl2;
                }
            }
        }
        asm volatile("s_waitcnt vmcnt(0)" ::: "memory");
        __syncthreads();
        if (MODE == 3) continue;
        f32x4 acc[4];
#pragma unroll
        for (int nt = 0; nt < 4; ++nt) acc[nt] = (f32x4){0.f, 0.f, 0.f, 0.f};
        {
            const bf16_t* ah_p = p.H2() + (size_t)(t0 + fr) * D + fq * 8; const bf16_t* al_p = H2lo + (size_t)(t0 + fr) * D + fq * 8;
            const int widu = __builtin_amdgcn_readfirstlane(wid);
            unsigned rofs[4];
#pragma unroll
            for (int i = 0; i < 4; ++i) { const int x = wid * 1024 + i * 8192 + lane * 16, row = x >> 8, c = ((x & 255) >> 4) ^ (row & 15); rofs[i] = (unsigned)(row * 2048 + c * 16); }
#define RT_DMA(kc, buf) do { const char* src_ = (const char*)p.routerT() + (size_t)(kc) * 256;                                             \
            _Pragma("unroll") for (int i = 0; i < 4; ++i) __builtin_amdgcn_global_load_lds((const unsigned*)(src_ + rofs[i]), (unsigned*)(smem + 40960 + (buf) * 32768 + widu * 1024 + i * 8192), 16, 0, 0); } while (0)
            RT_DMA(0, 0);
#pragma unroll 1
            for (int kc = 0; kc < 8; ++kc) {
                bf16x8 ah[4], al[4];
#pragma unroll
                for (int ks = 0; ks < 4; ++ks) { ah[ks] = ldfrag(ah_p + kc * 128 + ks * 32); al[ks] = ldfrag(al_p + kc * 128 + ks * 32); }
                asm volatile("s_waitcnt vmcnt(0)" ::: "memory"); __syncthreads();
                if (kc + 1 < 8) RT_DMA(kc + 1, (kc + 1) & 1);
                const char* bb = smem + 40960 + (kc & 1) * 32768;
#pragma unroll
                for (int ks = 0; ks < 4; ++ks)
#pragma unroll
                    for (int nt = 0; nt < 4; ++nt) {
                        const int row = nt * 16 + fr, cc = ((ks * 4 + fq) ^ (row & 15)) * 16;
                        const bf16x8 bh = *(const bf16x8*)(bb + row * 256 + cc), bl = *(const bf16x8*)(bb + (64 + row) * 256 + cc);
                        acc[nt] = __builtin_amdgcn_mfma_f32_16x16x32_bf16(ah[ks], bh, acc[nt], 0, 0, 0);
                        acc[nt] = __builtin_amdgcn_mfma_f32_16x16x32_bf16(ah[ks], bl, acc[nt], 0, 0, 0);
                        acc[nt] = __builtin_amdgcn_mfma_f32_16x16x32_bf16(al[ks], bh, acc[nt], 0, 0, 0);
                    }
            }
#undef RT_DMA
        }
#pragma unroll
        for (int nt = 0; nt < 4; ++nt)
#pragma unroll
            for (int j = 0; j < 4; ++j) lg[(wid * 16 + fq * 4 + j) * 65 + nt * 16 + fr] = acc[nt][j];
        __syncthreads();
        if (MODE == 2) continue;
        int l3 = lane; asm volatile("" : "+v"(l3));
#define SHXF(v_, m_) __int_as_float(__builtin_amdgcn_ds_bpermute((l3 ^ (m_)) << 2, __float_as_int(v_)))
#define SHXI(v_, m_) __builtin_amdgcn_ds_bpermute((l3 ^ (m_)) << 2, (v_))
#define SHBF(v_, src_) __int_as_float(__builtin_amdgcn_ds_bpermute((src_) << 2, __float_as_int(v_)))
#define SHBI(v_, src_) __builtin_amdgcn_ds_bpermute((src_) << 2, (v_))
        const int q4 = l3 & 3, tt = wid * 16 + (l3 >> 2), t = item * 128 + tt, qbase = l3 & ~3;
        float sc_[16], v[16];
#pragma unroll
        for (int i = 0; i < 16; ++i) { const float x = lg[tt * 65 + q4 * 16 + i]; sc_[i] = __builtin_amdgcn_rcpf(1.0f + __builtin_amdgcn_exp2f(-1.4426950408889634f * x)); v[i] = sc_[i] + p.router_b[q4 * 16 + i]; }
        float gsA, gsB;
        { float m1 = v[0], m2 = -INFINITY;
#pragma unroll
          for (int i = 1; i < 8; ++i) { const float x = v[i]; m2 = fmaxf(m2, fminf(m1, x)); m1 = fmaxf(m1, x); }
          gsA = m1 + m2; m1 = v[8]; m2 = -INFINITY;
#pragma unroll
          for (int i = 9; i < 16; ++i) { const float x = v[i]; m2 = fmaxf(m2, fminf(m1, x)); m1 = fmaxf(m1, x); }
          gsB = m1 + m2; }
        { int rankA = 0, rankB = 0;
#pragma unroll
          for (int qq = 0; qq < 4; ++qq) {
              const float ga = SHBF(gsA, qbase | qq), gb = SHBF(gsB, qbase | qq);
              const int g0 = 2 * qq, g1 = 2 * qq + 1, mA = 2 * q4, mB = 2 * q4 + 1;
              rankA += (g0 != mA && (ga > gsA || (ga == gsA && g0 < mA))) ? 1 : 0; rankA += (g1 != mA && (gb > gsA || (gb == gsA && g1 < mA))) ? 1 : 0;
              rankB += (g0 != mB && (ga > gsB || (ga == gsB && g0 < mB))) ? 1 : 0; rankB += (g1 != mB && (gb > gsB || (gb == gsB && g1 < mB))) ? 1 : 0;
          }
          if (rankA >= 4) {
#pragma unroll
              for (int i = 0; i < 8; ++i) v[i] = -INFINITY; }
          if (rankB >= 4) {
#pragma unroll
              for (int i = 8; i < 16; ++i) v[i] = -INFINITY; } }
        unsigned chm = 0u;
#pragma unroll 1
        for (int it = 0; it < 8; ++it) {
            float lm = v[0];
#pragma unroll
            for (int i = 1; i < 16; ++i) lm = fmaxf(lm, v[i]);
            float gm = fmaxf(lm, SHXF(lm, 1)); gm = fmaxf(gm, SHXF(gm, 2));
            int cand = (lm == gm) ? q4 : 4;
            cand = min(cand, SHXI(cand, 1)); cand = min(cand, SHXI(cand, 2));
            const bool win = cand == q4;
            bool found = false;
#pragma unroll
            for (int i = 0; i < 16; ++i) { const bool hit = win && !found && v[i] == gm; if (hit) { chm |= (1u << i); v[i] = -INFINITY; } found = found || hit; }
        }
        float wsum = 0.f;
#pragma unroll
        for (int i = 0; i < 16; ++i) wsum += ((chm >> i) & 1u) ? sc_[i] : 0.f;
        wsum += SHXF(wsum, 1); wsum += SHXF(wsum, 2);
        const float wscale = 2.5f / wsum;
        const unsigned long long pat = 0x1111111111111111ull << q4;
#pragma unroll
        for (int i = 0; i < 16; ++i) { const unsigned long long bal = __ballot((chm >> i) & 1u); if (l3 < 4) wcnt[wid * 64 + l3 * 16 + i] = __popcll(bal & (0x1111111111111111ull << l3)); }
        __syncthreads();
        if (wid == 0) {
            int tot = 0;
#pragma unroll
            for (int w = 0; w < 8; ++w) tot += wcnt[w * 64 + lane];
            int run = atomicAdd(&cntp[lane], tot);
#pragma unroll
            for (int w = 0; w < 8; ++w) { const int c = wcnt[w * 64 + lane]; pref[w * 64 + lane] = run; run += c; }
        }
        __syncthreads();
        {
            const int pc = __popc(chm);
            int kbase = 0;
#pragma unroll
            for (int qq = 0; qq < 3; ++qq) { const int o = SHBI(pc, qbase | qq); kbase += (qq < q4) ? o : 0; }
#pragma unroll
            for (int i = 0; i < 16; ++i) {
                const bool c = (chm >> i) & 1u;
                const unsigned long long bal = __ballot(c);
                if (c) {
                    const int e = q4 * 16 + i;
                    const int slot = pref[wid * 64 + e] + __popcll(bal & pat & ((1ull << l3) - 1ull));
                    tl[(size_t)e * ECAP + slot] = t; wl_[(size_t)e * ECAP + slot] = sc_[i] * wscale;
                    tm[(size_t)t * 8 + kbase + __popc(chm & ((1u << i) - 1u))] = e * ECAP + slot;
                }
            }
        }
    }
}
#undef SHXF
#undef SHXI
#undef SHBF
#undef SHBI

constexpr int MOE_AUX = 162816;
__device__ __forceinline__ void moe_tables(const MK& p, int colt, int* tpre, int* rbase, int tid_l) {
    __syncthreads();
    if (tid_l == 0) { int tp = 0, rb = 0;
        for (int e = 0; e < 65; ++e) { const int c = e < 64 ? p.cnt()[e] : T; tpre[e] = tp; rbase[e] = rb; tp += ((c + 255) >> 8) * colt; rb += c; }
        tpre[65] = tp; rbase[65] = rb; }
    __syncthreads();
}
struct SchedUp { const MK* p; int bid, nb, tid_l, ntiles; const int* tpre; const int* rbase; mutable int e_hint;
    __device__ __forceinline__ bool next(int i, pg8::GUnit& u, unsigned (&vA)[2][2]) const {
        const int tile = xcd_vbid(bid, nb) + i * nb; if (tile >= ntiles) return false;
        int e = e_hint; while (tile >= tpre[e + 1]) ++e; e_hint = e;
        const int j = tile - tpre[e], rt = j >> 1, ct = j & 1, cnt_e = rbase[e + 1] - rbase[e];
        u.A = (const char*)p->H2(); u.B = (const char*)(p->W13t() + ((size_t)e * 512 + ct * 256) * D); u.i0 = e; u.i1 = rt; u.i2 = ct; u.i3 = cnt_e;
#pragma unroll
        for (int i2 = 0; i2 < 2; ++i2) { int R, C; stage_rc(tid_l * 16 + i2 * 8192, R, C);
#pragma unroll
            for (int h = 0; h < 2; ++h) { int slot = rt * 256 + h * 128 + R; if (slot >= cnt_e) slot = 0;
                const int tok = e < 64 ? p->tok_list()[(size_t)e * ECAP + slot] : slot;
                vA[h][i2] = (unsigned)tok * (D * 2u) + (unsigned)C * 2u; } }
        return true; } };
template <bool NOSTORE = false> struct EpiUpT { static constexpr bool PERM = true; const MK* p; const int* rbase;
    __device__ __forceinline__ void operator()(const f32x4 (&acc)[2][2][4][2], const pg8::GUnit& u, int wr, int wc, int fr, int fq) const {
        const int e = u.i0, rt = u.i1, ct = u.i2, cnt_e = u.i3;
        bf16_t* ab = p->ACT() + (size_t)rbase[e] * DE + ct * 128 + wc * 32 + fq * 8;
#pragma unroll
        for (int ai = 0; ai < 2; ++ai)
#pragma unroll
            for (int m = 0; m < 4; ++m) {
                const int slot = rt * 256 + ai * 128 + wr * 64 + m * 16 + fr;
                u32x4 w;
                w.x = cvtpk(silu_fast(acc[ai][0][m][0][0]) * acc[ai][1][m][0][0], silu_fast(acc[ai][0][m][0][1]) * acc[ai][1][m][0][1]);
                w.y = cvtpk(silu_fast(acc[ai][0][m][0][2]) * acc[ai][1][m][0][2], silu_fast(acc[ai][0][m][0][3]) * acc[ai][1][m][0][3]);
                w.z = cvtpk(silu_fast(acc[ai][0][m][1][0]) * acc[ai][1][m][1][0], silu_fast(acc[ai][0][m][1][1]) * acc[ai][1][m][1][1]);
                w.w = cvtpk(silu_fast(acc[ai][0][m][1][2]) * acc[ai][1][m][1][2], silu_fast(acc[ai][0][m][1][3]) * acc[ai][1][m][1][3]);
                if (NOSTORE) { if (slot < -cnt_e) *(u32x4*)(ab + (size_t)slot * DE) = w; } else if (slot < cnt_e) *(u32x4*)(ab + (size_t)slot * DE) = w;
            }
    } };
__device__ __forceinline__ void ph_moe_up(const MK& p, int bid, int nb, int tid_l) {
    int* tpre = (int*)(smem + MOE_AUX); int* rbase = tpre + 80;
    moe_tables(p, 2, tpre, rbase, tid_l);
    SchedUp S{&p, bid, nb, tid_l, tpre[65], tpre, rbase, 0}; EpiUpT<false> E{&p, rbase};
    pg8::gemm<EpiUpT<false>, SchedUp, true, true>(D, S, E, tid_l);
}
constexpr float Y_SCALE = 64.0f;
struct SchedDown { const MK* p; int bid, nb, tid_l, ntiles; const int* tpre; const int* rbase; mutable int e_hint;
    __device__ __forceinline__ bool next(int i, pg8::GUnit& u, unsigned (&vA)[2][2]) const {
        const int tile = xcd_vbid(bid, nb) + i * nb; if (tile >= ntiles) return false;
        int e = e_hint; while (tile >= tpre[e + 1]) ++e; e_hint = e;
        const int j = tile - tpre[e], rt = j >> 2, ct = j & 3, cnt_e = rbase[e + 1] - rbase[e];
        u.A = (const char*)(p->ACT() + (size_t)(rbase[e] + rt * 256) * DE); u.B = (const char*)(p->W2t() + ((size_t)e * D + ct * 256) * DE); u.i0 = e; u.i1 = rt; u.i2 = ct; u.i3 = cnt_e;
        pg8::plain_voffA(DE, vA, tid_l); return true; } };
template <int MODE> struct EpiDown { static constexpr bool PERM = true; const MK* p; const int* rbase;
    __device__ __forceinline__ void operator()(const f32x4 (&acc)[2][2][4][2], const pg8::GUnit& u, int wr, int wc, int fr, int fq) const {
        const int e = u.i0, rt = u.i1, ct = u.i2, cnt_e = u.i3;
        {
            const float* wl = p->wt_list() + (size_t)(e < 64 ? e : 0) * ECAP;
            float wv[2][4];
#pragma unroll
            for (int ai = 0; ai < 2; ++ai)
#pragma unroll
                for (int m = 0; m < 4; ++m) { const int sl = rt * 256 + ai * 128 + wr * 64 + m * 16 + fr; wv[ai][m] = e < 64 ? wl[sl < cnt_e ? sl : 0] * Y_SCALE : Y_SCALE; }
            const int wid = wr * 4 + wc, lane = fq * 16 + fr;
            char* wa = smem + 131072 + wid * 3968;
            unsigned char* yb = p->Y() + (size_t)rbase[e] * D + ct * 256 + wc * 64 + (lane & 3) * 16;
#pragma unroll
            for (int ai = 0; ai < 2; ++ai)
#pragma unroll
                for (int m = 0; m < 4; ++m) {
                    const float w = wv[ai][m];
                    char* img = wa + ((m & 1) ? 1280 : 0);
#pragma unroll
                    for (int bj = 0; bj < 2; ++bj) {
                        u32x2 pk;
#pragma unroll
                        for (int n = 0; n < 2; ++n) {
                            float v0 = __builtin_amdgcn_fmed3f(acc[ai][bj][m][n][0] * w, -448.f, 448.f), v1 = __builtin_amdgcn_fmed3f(acc[ai][bj][m][n][1] * w, -448.f, 448.f);
                            float v2 = __builtin_amdgcn_fmed3f(acc[ai][bj][m][n][2] * w, -448.f, 448.f), v3 = __builtin_amdgcn_fmed3f(acc[ai][bj][m][n][3] * w, -448.f, 448.f);
                            int q = 0; q = __builtin_amdgcn_cvt_pk_fp8_f32(v0, v1, q, false); q = __builtin_amdgcn_cvt_pk_fp8_f32(v2, v3, q, true);
                            if (n == 0) pk.x = (unsigned)q; else pk.y = (unsigned)q;
                        }
                        *(u32x2*)(img + fr * 80 + bj * 32 + fq * 8) = pk;
                    }
                    asm volatile("s_waitcnt lgkmcnt(0)" ::: "memory");
                    const int rr = lane >> 2, slot = rt * 256 + ai * 128 + wr * 64 + m * 16 + rr;
                    const u32x4 v = *(const u32x4*)(img + rr * 80 + (lane & 3) * 16);
                    if (MODE == 1) asm volatile("" :: "v"(v)); else if (slot < cnt_e) *(u32x4*)(yb + (size_t)slot * D) = v;
                }
        }
    } };
template <bool DUMMY, int MODE = 0> __device__ __forceinline__ void ph_moe_down(const MK& p, int bid, int nb, int tid_l) {
    int* tpre = (int*)(smem + MOE_AUX); int* rbase = tpre + 80;
    moe_tables(p, 4, tpre, rbase, tid_l);
    SchedDown S{&p, bid, nb, tid_l, DUMMY ? tpre[64] : tpre[65], tpre, rbase, 0}; EpiDown<MODE> E{&p, rbase};
    pg8::gemm<EpiDown<MODE>, SchedDown, false, true>(DE, S, E, tid_l);
}

#if DUP >= 21 && DUP <= 29
template <bool PERM_> struct EpiNull { static constexpr bool PERM = PERM_;
    __device__ __forceinline__ void operator()(const f32x4 (&acc)[2][2][4][2], const pg8::GUnit& u, int wr, int wc, int fr, int fq) const {
#pragma unroll
        for (int a = 0; a < 2; ++a)
#pragma unroll
            for (int b = 0; b < 2; ++b)
#pragma unroll
                for (int m = 0; m < 4; ++m) { asm volatile("" :: "v"(acc[a][b][m][0]), "v"(acc[a][b][m][1])); }
    } };
__device__ __forceinline__ void ph_probe_in(const MK& p, int bid, int nb, int tid_l) { SchedIn S{&p, bid, nb, tid_l}; EpiNull<false> E; pg8::gemm<EpiNull<false>, SchedIn, false, true>(D, S, E, tid_l); }
__device__ __forceinline__ void ph_probe_out(const MK& p, int bid, int nb, int tid_l) { SchedOut S{&p, bid, nb, tid_l}; EpiNull<true> E; pg8::gemm<EpiNull<true>, SchedOut, false, true>(D, S, E, tid_l); }
__device__ __forceinline__ void ph_probe_up(const MK& p, int bid, int nb, int tid_l) {
    int* tpre = (int*)(smem + MOE_AUX); int* rbase = tpre + 80; moe_tables(p, 2, tpre, rbase, tid_l);
    SchedUp S{&p, bid, nb, tid_l, tpre[65], tpre, rbase, 0}; EpiNull<true> E; pg8::gemm<EpiNull<true>, SchedUp, true, true>(D, S, E, tid_l); }
__device__ __forceinline__ void ph_probe_up_nostore(const MK& p, int bid, int nb, int tid_l) {
    int* tpre = (int*)(smem + MOE_AUX); int* rbase = tpre + 80; moe_tables(p, 2, tpre, rbase, tid_l);
    SchedUp S{&p, bid, nb, tid_l, tpre[65], tpre, rbase, 0}; EpiUpT<true> E{&p, rbase}; pg8::gemm<EpiUpT<true>, SchedUp, true, true>(D, S, E, tid_l); }
__device__ __forceinline__ void ph_probe_down(const MK& p, int bid, int nb, int tid_l) {
    int* tpre = (int*)(smem + MOE_AUX); int* rbase = tpre + 80; moe_tables(p, 4, tpre, rbase, tid_l);
    SchedDown S{&p, bid, nb, tid_l, tpre[65], tpre, rbase, 0}; EpiNull<true> E; pg8::gemm<EpiNull<true>, SchedDown, false, true>(DE, S, E, tid_l); }
#endif
template <bool DUMMY> __device__ __forceinline__ void ph_final(const MK& p, int bid, int nb, int tid_l) {
    const int wid = tid_l >> 6, lane = tid_l & 63;
    int* tpre = (int*)(smem + MOE_AUX); int* rbase = tpre + 80;
    moe_tables(p, 1, tpre, rbase, tid_l);
    for (int t = bid * 8 + wid; t < T; t += nb * 8) {
        const int b = t / SEQ;
        float f[16];
#pragma unroll
        for (int i = 0; i < 16; ++i) f[i] = 0.f;
#pragma unroll
        for (int k = 0; k < 9; ++k) {
            int row;
            if (k < 8) { const int id = p.tokmap()[(size_t)t * 8 + k], e = id >> 15, slot = id & (ECAP - 1); row = rbase[e] + slot; } else row = rbase[64] + t;
            const unsigned char* yr = p.Y() + (size_t)row * D + lane * 4;
#pragma unroll
            for (int q = 0; q < 4; ++q) {
                const int w = *(const int*)(yr + q * 256);
                const auto lo = __builtin_amdgcn_cvt_pk_f32_fp8(w, false); const auto hi = __builtin_amdgcn_cvt_pk_f32_fp8(w, true);
                f[q * 4 + 0] += lo[0]; f[q * 4 + 1] += lo[1]; f[q * 4 + 2] += hi[0]; f[q * 4 + 3] += hi[1];
            }
        }
        const int pcol = ((lane >> 3) & 1) * 128 + (lane >> 4) * 32 + (lane & 7) * 4;
        const float* g2 = p.mod() + (size_t)b * 6 * D + 5 * D + pcol;
        const bf16_t* x1 = p.X1() + (size_t)t * 2048 + pcol;
        float* xo = p.out + (size_t)t * D + pcol;
        float v[16]; float ss = 0.f;
#pragma unroll
        for (int q = 0; q < 4; ++q) {
            const u32x2 xw = *(const u32x2*)(x1 + q * 256); const float4 g = *(const float4*)(g2 + q * 256);
            v[q * 4 + 0] = __uint_as_float(xw.x << 16) + g.x * f[q * 4 + 0] * (1.0f / Y_SCALE); v[q * 4 + 1] = __uint_as_float(xw.x & 0xffff0000u) + g.y * f[q * 4 + 1] * (1.0f / Y_SCALE);
            v[q * 4 + 2] = __uint_as_float(xw.y << 16) + g.z * f[q * 4 + 2] * (1.0f / Y_SCALE); v[q * 4 + 3] = __uint_as_float(xw.y & 0xffff0000u) + g.w * f[q * 4 + 3] * (1.0f / Y_SCALE);
            ss += v[q * 4] * v[q * 4] + v[q * 4 + 1] * v[q * 4 + 1] + v[q * 4 + 2] * v[q * 4 + 2] + v[q * 4 + 3] * v[q * 4 + 3];
        }
        ss = wave_sum(ss);
        const float rstd = rsqrtf(ss * (1.0f / D) + EPS);
#pragma unroll
        for (int q = 0; q < 4; ++q) {
            const float4 gf = *(const float4*)(p.final_g + q * 256 + pcol);
            *(float4*)((DUMMY ? (float*)(p.ws + 42 * MiB) + (size_t)t * D + pcol : xo) + q * 256) = make_float4(v[q * 4] * rstd * gf.x, v[q * 4 + 1] * rstd * gf.y, v[q * 4 + 2] * rstd * gf.z, v[q * 4 + 3] * rstd * gf.w);
        }
    }
}


#define XB_TMO      128
#define XB_XCNT(j)  (256  + 64 * (j))
#define XB_XSUB(j)  (1280 + 64 * (j))
#define XB_XGEN(j)  (2304 + 64 * (j))
#define XB_TOP      3328
#define XB_TOPGEN   3392
#define XCD_BAR_WORDS 3456
#define XB_SPIN_CAP (1u << 22)
#define LAS __attribute__((address_space(3)))
__device__ __forceinline__ unsigned xb_ld(unsigned* p)              { return __hip_atomic_load(p, __ATOMIC_RELAXED, __HIP_MEMORY_SCOPE_AGENT); }
__device__ __forceinline__ unsigned xb_add(unsigned* p, unsigned v) { return __hip_atomic_fetch_add(p, v, __ATOMIC_RELAXED, __HIP_MEMORY_SCOPE_AGENT); }
__device__ __forceinline__ unsigned xb_xcc_id() { return (unsigned)__builtin_amdgcn_s_getreg((3 << 11) | 20) & 0xFu; }
#define XB_SPIN(cond, bar) do { unsigned _sp = 0; while (cond) { __builtin_amdgcn_s_sleep(1); \
    if ((++_sp & 255u) == 0u) { if (xb_ld(&(bar)[XB_TMO])) break; if (_sp > XB_SPIN_CAP) { atomicAdd(&(bar)[XB_TMO], 1u); break; } } } } while (0)
struct XcdBarrier { unsigned* bar; unsigned x; volatile LAS unsigned* st; };
__device__ __forceinline__ XcdBarrier xcd_barrier_post(unsigned* bar, volatile LAS unsigned* st, int tid) {
    XcdBarrier b; b.bar = bar; b.x = xb_xcc_id(); b.st = st;
    if (tid == 0) (void)xb_add(&bar[XB_XCNT(b.x)], 1u);
    return b;
}
__device__ __forceinline__ void xcd_barrier_complete(unsigned* bar, unsigned x, unsigned& nloc, unsigned& nx) {
    const unsigned G = gridDim.x * gridDim.y * gridDim.z;
    unsigned sum, cnt, mine, sp = 0u;
    for (;;) {
        sum = 0u; cnt = 0u; mine = 0u;
#pragma unroll
        for (unsigned j = 0; j < 16; ++j) { const unsigned c = xb_ld(&bar[XB_XCNT(j)]); sum += c; cnt += (c > 0u) ? 1u : 0u; mine = (j == x) ? c : mine; }
        if (sum == G) break;
        __builtin_amdgcn_s_sleep(1);
        if ((++sp & 255u) == 0u) { if (xb_ld(&bar[XB_TMO])) break; if (sp > XB_SPIN_CAP) { atomicAdd(&bar[XB_TMO], 1u); break; } }
    }
    nloc = mine > 0u ? mine : 1u; nx = cnt > 0u ? cnt : 1u;
}
__device__ __forceinline__ void xcd_barrier(const XcdBarrier& b, int tid) {
    asm volatile("s_waitcnt vmcnt(0)" ::: "memory");
    __syncthreads();
    if (tid == 0) {
        unsigned* bar = b.bar;
        __builtin_amdgcn_s_waitcnt(0);
        unsigned nloc = b.st[0], nx = b.st[1];
        if (nloc == 0u) { xcd_barrier_complete(bar, b.x, nloc, nx); b.st[0] = nloc; b.st[1] = nx; }
        const unsigned old = xb_add(&bar[XB_XSUB(b.x)], 1u);
        const unsigned gen = old / nloc;
        if (old + 1u == (gen + 1u) * nloc) {
            __builtin_amdgcn_fence(__ATOMIC_RELEASE, "agent");
            asm volatile("s_waitcnt vmcnt(0)" ::: "memory");
            const unsigned og = xb_add(&bar[XB_TOP], 1u);
            const unsigned tg = og / nx;
            if (og + 1u == (tg + 1u) * nx) xb_add(&bar[XB_TOPGEN], 1u);
            else XB_SPIN(xb_ld(&bar[XB_TOPGEN]) == tg, bar);
            __builtin_amdgcn_fence(__ATOMIC_ACQUIRE, "agent");
            xb_add(&bar[XB_XGEN(b.x)], 1u);
            asm volatile("s_waitcnt vmcnt(0)" ::: "memory");
        } else {
            XB_SPIN(xb_ld(&bar[XB_XGEN(b.x)]) == gen, bar);
            __builtin_amdgcn_fence(__ATOMIC_ACQUIRE, "agent");
            asm volatile("s_waitcnt vmcnt(0)" ::: "memory");
        }
    }
    __syncthreads();
}

__device__ __forceinline__ int lane_id_volatile() { int l; asm volatile("v_mbcnt_lo_u32_b32 %0, -1, 0\n\tv_mbcnt_hi_u32_b32 %0, -1, %0" : "=v"(l)); return l; }
__global__ __launch_bounds__(512, 2) void k_mega(MK p) {
    cg::grid_group grid = cg::this_grid();
    const int bid = blockIdx.x, nb = gridDim.x;
    volatile LAS unsigned* xst = (volatile LAS unsigned*)(smem + 162816 + 768);
    if (threadIdx.x < 4) xst[threadIdx.x] = 0u;
    __syncthreads();
    const XcdBarrier xb = xcd_barrier_post((unsigned*)(p.ws + 524288), xst, (int)threadIdx.x);
    const int wv_ = __builtin_amdgcn_readfirstlane((int)threadIdx.x >> 6);
#define LANE_ID() lane_id_volatile()
#define PH_TID() int t_ = wv_ * 64 + LANE_ID(); asm volatile("" : "+v"(t_))
    { PH_TID(); if (bid == 0 && t_ < 256) p.cnt()[t_] = 0; ph_mod(p, bid, nb, t_); ph_convert(p, bid, nb, t_); }
#if DUP == 10
    { PH_TID(); ph_convert(p, bid, nb, t_); }
#endif
#if DUP == 12
    { PH_TID(); ph_mod(p, bid, nb, t_); }
#endif
    grid.sync();
    { PH_TID(); ph_ln1(p, bid, nb, t_); }
#if DUP == 1
    { PH_TID(); ph_ln1(p, bid, nb, t_); }
#endif
    xcd_barrier(xb, wv_ * 64 + LANE_ID());
    { PH_TID(); ph_gemm_in(p, bid, nb, t_); }
    { PH_TID(); ph_convert_dyn(p, t_); }
#if DUP == 2
    { PH_TID(); ph_gemm_in(p, bid, nb, t_); }
#endif
#if DUP == 21
    { PH_TID(); ph_probe_in(p, bid, nb, t_); }
#endif
    xcd_barrier(xb, wv_ * 64 + LANE_ID());
    { PH_TID(); ph_attn<0>(p, bid, nb, t_); }
#if DUP == 3
    { PH_TID(); ph_attn<2>(p, bid, nb, t_); }
#endif
#if DUP == 31
    { PH_TID(); ph_attn<1>(p, bid, nb, t_); }
#endif
#if DUP == 33
    { PH_TID(); ph_attn<3>(p, bid, nb, t_); }
#endif
    { PH_TID(); ph_kv(p, bid, nb, t_); }
#if DUP == 11
    { PH_TID(); ph_kv(p, bid, nb, t_); }
#endif
    xcd_barrier(xb, wv_ * 64 + LANE_ID());
    { PH_TID(); ph_scan(p, bid, nb, t_); }
#if DUP == 4
    { PH_TID(); ph_scan(p, bid, nb, t_); }
#endif
    xcd_barrier(xb, wv_ * 64 + LANE_ID());
    { PH_TID(); ph_ret(p, bid, nb, t_); }
#if DUP == 5
    { PH_TID(); ph_ret(p, bid, nb, t_); }
#endif
    xcd_barrier(xb, wv_ * 64 + LANE_ID());
    { PH_TID(); ph_gemm_out(p, bid, nb, t_); }
#if DUP == 6
    { PH_TID(); ph_gemm_out(p, bid, nb, t_); }
#endif
#if DUP == 22
    { PH_TID(); ph_probe_out(p, bid, nb, t_); }
#endif
    xcd_barrier(xb, wv_ * 64 + LANE_ID());
#if DUP == 7
    { PH_TID(); ph_route<true>(p, bid, nb, t_); }
#endif
#if DUP == 72
    { PH_TID(); ph_route<true, 2>(p, bid, nb, t_); }
#endif
#if DUP == 73
    { PH_TID(); ph_route<true, 3>(p, bid, nb, t_); }
#endif
    { PH_TID(); ph_route<false>(p, bid, nb, t_); }
    xcd_barrier(xb, wv_ * 64 + LANE_ID());
    { PH_TID(); ph_moe_up(p, bid, nb, t_); }
#if DUP == 8
    { PH_TID(); ph_moe_up(p, bid, nb, t_); }
#endif
#if DUP == 23
    { PH_TID(); ph_probe_up(p, bid, nb, t_); }
#endif
#if DUP == 25
    { PH_TID(); ph_probe_up_nostore(p, bid, nb, t_); }
#endif
    xcd_barrier(xb, wv_ * 64 + LANE_ID());
#if DUP == 9
    { PH_TID(); ph_moe_down<true>(p, bid, nb, t_); }
#endif
#if DUP == 91
    { PH_TID(); ph_moe_down<true, 1>(p, bid, nb, t_); }
#endif
    { PH_TID(); ph_moe_down<false>(p, bid, nb, t_); }
#if DUP == 24
    { PH_TID(); ph_probe_down(p, bid, nb, t_); }
#endif
    xcd_barrier(xb, wv_ * 64 + LANE_ID());
#if DUP == 13
    { PH_TID(); ph_final<true>(p, bid, nb, t_); }
#endif
    { PH_TID(); ph_final<false>(p, bid, nb, t_); }
#undef PH_TID
#undef LANE_ID
}
constexpr int LDS_TOTAL = 163840;
extern "C" void kernel_launch(void* const* d_in, const int* in_sizes, int n_in, void* d_out, int out_size, void* d_ws, size_t ws_size, hipStream_t stream) {
    char* ws = (char*)d_ws;
    MK mk{};
    mk.x = (const float*)d_in[0]; mk.c = (const float*)d_in[1]; mk.ctx = (const float*)d_in[2]; mk.cctx = (const float*)d_in[3]; mk.ada_w = (const float*)d_in[4]; mk.ada_b = (const float*)d_in[5];
    mk.norm1_g = (const float*)d_in[6]; mk.w_in = (const float*)d_in[7]; mk.lq1 = (const float*)d_in[8]; mk.lk1 = (const float*)d_in[9]; mk.lq2 = (const float*)d_in[10]; mk.lk2 = (const float*)d_in[11];
    mk.dattn_g = (const float*)d_in[12]; mk.dec_f = (const float*)d_in[13]; mk.dec_b = (const float*)d_in[14]; mk.ret_g = (const float*)d_in[15]; mk.w_out = (const float*)d_in[16];
    mk.norm2_g = (const float*)d_in[17]; mk.router_w = (const float*)d_in[18]; mk.router_b = (const float*)d_in[19]; mk.ew1 = (const float*)d_in[20]; mk.ew3 = (const float*)d_in[21];
    mk.ew2 = (const float*)d_in[22]; mk.sw1 = (const float*)d_in[23]; mk.sw3 = (const float*)d_in[24]; mk.sw2 = (const float*)d_in[25]; mk.final_g = (const float*)d_in[26];
    mk.out = (float*)d_out;
    mk.ws = ws;
    mk.dbgP = nullptr; mk.dbg_lo = 0; mk.dbg_hi = 12; mk.conv_limit = 1 << 30;
    static int grid_blocks = 0;
    if (!grid_blocks) {
        (void)hipFuncSetAttribute((const void*)k_mega, hipFuncAttributeMaxDynamicSharedMemorySize, LDS_TOTAL);
        int dev = 0, cus = 0, per_cu = 0;
        (void)hipGetDevice(&dev);
        (void)hipDeviceGetAttribute(&cus, hipDeviceAttributeMultiprocessorCount, dev);
        (void)hipOccupancyMaxActiveBlocksPerMultiprocessor(&per_cu, k_mega, 512, LDS_TOTAL);
        if (per_cu > 1) per_cu = 1;
        grid_blocks = cus * per_cu;
        if (grid_blocks <= 0) { fprintf(stderr, "occupancy query failed: cus %d per_cu %d\n", cus, per_cu); grid_blocks = 256; }
    }
    (void)hipMemsetAsync(ws + 524288, 0, XCD_BAR_WORDS * 4, stream);
    void* args[] = {&mk};
    hipError_t e = hipLaunchCooperativeKernel((void*)k_mega, dim3(grid_blocks), dim3(512), args, LDS_TOTAL, stream);
    if (e != hipSuccess) fprintf(stderr, "cooperative launch failed: %s (grid %d)\n", hipGetErrorString(e), grid_blocks);
}
```

```cpp
#include <hip/hip_runtime.h>
#include <hip/hip_cooperative_groups.h>
#include <cstdio>
namespace cg = cooperative_groups;
#ifndef DUP
#define DUP 0
#endif
#include <stdint.h>

constexpr int D = 1024, NB = 4, SEQ = 8192, CTX = 256, RB = SEQ + CTX  , NR = NB * RB  , T = NB * SEQ;
constexpr int NE = 64, DE = 256, ECAP = 32768;
constexpr float EPS = 1e-6f;
typedef unsigned short bf16_t;

__device__ __forceinline__ float siluf(float v) { return v / (1.0f + expf(-v)); }
__device__ __forceinline__ float silu_fast(float v) { return v * __builtin_amdgcn_rcpf(1.0f + __builtin_amdgcn_exp2f(-1.4426950408889634f * v)); }
__device__ __forceinline__ float wave_sum(float v) {
#pragma unroll
    for (int o = 32; o > 0; o >>= 1) v += __shfl_xor(v, o);
    return v;
}
__device__ __forceinline__ float wave_max(float v) {
#pragma unroll
    for (int o = 32; o > 0; o >>= 1) v = fmaxf(v, __shfl_xor(v, o));
    return v;
}
__device__ __forceinline__ float block_sum(float v, float* red) {
    v = wave_sum(v);
    __syncthreads();
    if ((threadIdx.x & 63) == 0) red[threadIdx.x >> 6] = v;
    __syncthreads();
    return red[0] + red[1] + red[2] + red[3];
}
__device__ __forceinline__ float block_max(float v, float* red) {
    v = wave_max(v);
    __syncthreads();
    if ((threadIdx.x & 63) == 0) red[threadIdx.x >> 6] = v;
    __syncthreads();
    return fmaxf(fmaxf(red[0], red[1]), fmaxf(red[2], red[3]));
}

typedef short bf16x8 __attribute__((ext_vector_type(8)));
typedef short s16x4 __attribute__((ext_vector_type(4)));
typedef float f32x4 __attribute__((ext_vector_type(4)));
typedef float f32x16 __attribute__((ext_vector_type(16)));
typedef unsigned u32x2 __attribute__((ext_vector_type(2)));
typedef unsigned u32x4 __attribute__((ext_vector_type(4)));
extern __shared__ __attribute__((aligned(1024))) char smem[];
constexpr int NTHR = 512;
constexpr int GEMM_LDS = 131072;

__device__ __forceinline__ unsigned cvtpk(float lo, float hi) { unsigned r; asm volatile("v_cvt_pk_bf16_f32 %0, %1, %2" : "=v"(r) : "v"(lo), "v"(hi)); return r; }
__device__ __forceinline__ bf16_t f2bf(float v) { return (bf16_t)(cvtpk(v, v) & 0xffffu); }
__device__ __forceinline__ float bf2f(bf16_t v) { return __uint_as_float(((unsigned)v) << 16); }

constexpr size_t MiB = 1048576;
struct MK {
    const float *x, *c, *ctx, *cctx, *ada_w, *ada_b, *norm1_g, *w_in, *lq1, *lk1, *lq2, *lk2, *dattn_g, *dec_f, *dec_b, *ret_g, *w_out, *norm2_g, *router_w, *router_b,
        *ew1, *ew3, *ew2, *sw1, *sw3, *sw2, *final_g;
    float* out; char* ws;
    float* dbgP; long dbg_lo, dbg_hi; long conv_limit;
#define WSF(name, type, off) __device__ __forceinline__ type* name() const { return (type*)(ws + (off)); }
    WSF(mod, float, 0) WSF(cnt, int, 131072) WSF(ropec, float, 262144) WSF(ropes, float, 262144 + 8192)
    WSF(w_inT, bf16_t, 1 * MiB) WSF(w_outT, bf16_t, 7 * MiB) WSF(routerT, bf16_t, 9 * MiB) WSF(W2t, bf16_t, 9 * MiB + 524288)
    WSF(H, bf16_t, 42 * MiB) WSF(MIX, bf16_t, 42 * MiB) WSF(KV, bf16_t, 112 * MiB) WSF(ST, bf16_t, 147 * MiB) WSF(ACT, bf16_t, 42 * MiB)
    WSF(W13t, bf16_t, 194 * MiB) WSF(H2, bf16_t, 260 * MiB)
    WSF(Q, bf16_t, 260 * MiB) WSF(K, bf16_t, 292 * MiB) WSF(V, bf16_t, 325 * MiB) WSF(RQ, bf16_t, 358 * MiB) WSF(RK, bf16_t, 375 * MiB)
    WSF(KTf, bf16_t, 392 * MiB) WSF(KTb, bf16_t, 409 * MiB) WSF(VT, bf16_t, 426 * MiB) WSF(RG, bf16_t, 459 * MiB)
    WSF(Y, unsigned char, 194 * MiB) WSF(tok_list, int, 484 * MiB) WSF(wt_list, float, 492 * MiB) WSF(tokmap, int, 500 * MiB)
    __device__ __forceinline__ bf16_t* X1() const { return (bf16_t*)out; }
#undef WSF
};

__device__ __forceinline__ void ph_mod(const MK& p, int bid, int nb, int tid_l) {
    float* sl = (float*)smem;
    float* red = (float*)(smem + 32768);
    if (bid < 6 * D / 32) {
        for (int i = tid_l; i < 5 * D; i += NTHR) { const int r = i >> 10, k = i & 1023; const float cv = r < 4 ? p.c[r * D + k] : p.cctx[k]; sl[k * 8 + r] = siluf(cv); }
    }
    __syncthreads();
    for (int it = bid; it < 6 * D / 32; it += nb) {
        const int col = tid_l & 31, kg = tid_l >> 5, j = it * 32 + col;
        const float* wp = p.ada_w + (size_t)(kg * 64) * 6 * D + j;
        float a[5] = {0, 0, 0, 0, 0};
#pragma unroll 1
        for (int k0 = 0; k0 < 64; k0 += 16) {
            float w[16];
#pragma unroll
            for (int kk = 0; kk < 16; ++kk) w[kk] = wp[(size_t)(k0 + kk) * 6 * D];
#pragma unroll
            for (int kk = 0; kk < 16; ++kk) {
                const float4 s4 = *(const float4*)(sl + (kg * 64 + k0 + kk) * 8); const float s5 = sl[(kg * 64 + k0 + kk) * 8 + 4];
                a[0] += s4.x * w[kk]; a[1] += s4.y * w[kk]; a[2] += s4.z * w[kk]; a[3] += s4.w * w[kk]; a[4] += s5 * w[kk];
            }
        }
        __syncthreads();
#pragma unroll
        for (int r = 0; r < 5; ++r) red[(kg * 5 + r) * 32 + col] = a[r];
        __syncthreads();
        if (tid_l < 160) {
            int r = tid_l >> 5; float s = 0;
            for (int g = 0; g < 16; ++g) s += red[(g * 5 + r) * 32 + col];
            p.mod()[(size_t)r * 6 * D + j] = s + p.ada_b[j];
        }
    }
    if (bid == nb - 1) {
        for (int i = tid_l; i < 128 * 16; i += NTHR) {
            int pos = i >> 4, f = i & 15;
            float inv_freq = exp2f(-(float)f * (13.287712379549449f / 16.0f));
            float s, c; sincosf((float)pos * inv_freq, &s, &c);
            p.ropec()[i] = c; p.ropes()[i] = s;
        }
    }
    __syncthreads();
}

__device__ __forceinline__ void tr_tile(const float* src, int ldsrc, int k0, int n0, bf16_t* dst, int lddst, int mode  , bf16_t* dst2, int tid_l) {
    float* t = (float*)smem;
    __syncthreads();
    for (int i = tid_l; i < 64 * 16; i += NTHR) {
        int r = i >> 4, c4 = (i & 15) * 4;
        float4 v = *(const float4*)(src + (size_t)(k0 + r) * ldsrc + n0 + c4);
        t[r * 65 + c4] = v.x; t[r * 65 + c4 + 1] = v.y; t[r * 65 + c4 + 2] = v.z; t[r * 65 + c4 + 3] = v.w;
    }
    __syncthreads();
    for (int i = tid_l; i < 64 * 16; i += NTHR) {
        int n = i >> 4, k4 = (i & 15) * 4;
        float a = t[(k4 + 0) * 65 + n], b = t[(k4 + 1) * 65 + n], c = t[(k4 + 2) * 65 + n], d = t[(k4 + 3) * 65 + n];
        int nn = n0 + n, row = nn;
        if (mode == 1 || mode == 2) { int ct = nn >> 7; row = ct * 256 + (mode == 2 ? 128 : 0) + (nn & 127); }
        u32x2 w; w.x = cvtpk(a, b); w.y = cvtpk(c, d);
        *(u32x2*)(dst + (size_t)row * lddst + k0 + k4) = w;
        if (mode == 3) {
            float ah = bf2f((bf16_t)(w.x & 0xffff)), bh = bf2f((bf16_t)(w.x >> 16)), ch = bf2f((bf16_t)(w.y & 0xffff)), dh = bf2f((bf16_t)(w.y >> 16));
            u32x2 l; l.x = cvtpk(a - ah, b - bh); l.y = cvtpk(c - ch, d - dh);
            *(u32x2*)(dst2 + (size_t)row * lddst + k0 + k4) = l;
        }
    }
}
constexpr int CV_STATIC = 16 * 48 + 16 * 16 + 16, CV_E13 = 65 * 2 * 16 * 4, CV_E2 = 65 * 4 * 16, CV_TOTAL = CV_STATIC + CV_E13 + CV_E2;
__device__ __forceinline__ void convert_tile(const MK& p, int j, int tid_l) {
    const int n_win = 16 * 48, n_wout = 16 * 16, n_rt = 16;
    if (j < n_win) { tr_tile(p.w_in, 3072, (j / 48) * 64, (j % 48) * 64, p.w_inT(), 1024, 0, nullptr, tid_l); return; } j -= n_win;
    if (j < n_wout) { tr_tile(p.w_out, 1024, (j / 16) * 64, (j % 16) * 64, p.w_outT(), 1024, 0, nullptr, tid_l); return; } j -= n_wout;
    if (j < n_rt) { tr_tile(p.router_w, 64, j * 64, 0, p.routerT(), 1024, 3, p.routerT() + 64 * 1024, tid_l); return; } j -= n_rt;
    if (j < CV_E13) {
        int e = j / 128, r = j % 128, which = r / 64, tt = r % 64;
        const float* src = e < 64 ? (which ? p.ew3 : p.ew1) + (size_t)e * D * DE : (which ? p.sw3 : p.sw1);
        tr_tile(src, DE, (tt / 4) * 64, (tt % 4) * 64, p.W13t() + (size_t)e * 512 * 1024, 1024, 1 + which, nullptr, tid_l); return; } j -= CV_E13;
    { int e = j / 64, tt = j % 64;
      const float* src = e < 64 ? p.ew2 + (size_t)e * DE * D : p.sw2;
      tr_tile(src, D, (tt / 16) * 64, (tt % 16) * 64, p.W2t() + (size_t)e * 1024 * 256, 256, 0, nullptr, tid_l); }
}
__device__ __forceinline__ void ph_convert(const MK& p, int bid, int nb, int tid_l) {
    for (int it = bid; it < CV_STATIC; it += nb) convert_tile(p, it, tid_l);
    __syncthreads();
}
template <int LDSRC> __device__ __forceinline__ void tr_wave(const float* __restrict__ src, int k0, int n0, bf16_t* __restrict__ dst, int lddst, int mode, int lane, char* tb) {
    const int n4 = lane & 15, kg = lane >> 4;
    const float* s0 = src + (size_t)(k0 + kg * 16) * LDSRC + n0 + n4 * 4;
    f32x4 v[16];
#pragma unroll
    for (int it = 0; it < 16; ++it) v[it] = *(const f32x4*)(s0 + (size_t)it * LDSRC);
#pragma unroll
    for (int jn = 0; jn < 4; ++jn) {
        const int n = n4 * 4 + jn;
#pragma unroll
        for (int h = 0; h < 2; ++h) {
            const u32x4 w = {cvtpk(v[h * 8][jn], v[h * 8 + 1][jn]), cvtpk(v[h * 8 + 2][jn], v[h * 8 + 3][jn]), cvtpk(v[h * 8 + 4][jn], v[h * 8 + 5][jn]), cvtpk(v[h * 8 + 6][jn], v[h * 8 + 7][jn])};
            *(u32x4*)(tb + n * 128 + (((kg * 2 + h) ^ (n4 & 7)) << 4)) = w;
        }
    }
    asm volatile("s_waitcnt lgkmcnt(0)" ::: "memory");
#pragma unroll
    for (int it = 0; it < 8; ++it) {
        const int n = it * 8 + (lane >> 3), c = lane & 7;
        const u32x4 w = *(const u32x4*)(tb + n * 128 + ((c ^ ((n >> 2) & 7)) << 4));
        const int nn = n0 + n; int row = nn;
        if (mode == 1 || mode == 2) { const int ct = nn >> 7; row = ct * 256 + (mode == 2 ? 128 : 0) + (nn & 127); }
        *(u32x4*)(dst + (size_t)row * lddst + k0 + c * 8) = w;
    }
}
__device__ __forceinline__ void convert_tile_wave(const MK& p, int j, int lane, char* tb) {
    if (j < CV_E13) {
        const int e = j / 128, r = j % 128, which = r / 64, tt = r % 64;
        const float* src = e < 64 ? (which ? p.ew3 : p.ew1) + (size_t)e * D * DE : (which ? p.sw3 : p.sw1);
        tr_wave<DE>(src, (tt / 4) * 64, (tt % 4) * 64, p.W13t() + (size_t)e * 512 * 1024, 1024, 1 + which, lane, tb); return; }
    j -= CV_E13;
    { const int e = j / 64, tt = j % 64;
      const float* src = e < 64 ? p.ew2 + (size_t)e * DE * D : p.sw2;
      tr_wave<D>(src, (tt / 16) * 64, (tt % 16) * 64, p.W2t() + (size_t)e * 1024 * 256, 256, 0, lane, tb); }
}
__device__ __forceinline__ void ph_convert_dyn(const MK& p, int tid_l) {
    const int lane = tid_l & 63;
    char* tb = smem + (tid_l >> 6) * 8192;
    __syncthreads();
    for (;;) {
        int j = 0;
        if (lane == 0) j = atomicAdd(&p.cnt()[200], 8);
        j = __builtin_amdgcn_readfirstlane(j);
        if (j >= CV_E13) break;
#pragma unroll 1
        for (int k = 0; k < 8; ++k) if (j + k < CV_E13) convert_tile_wave(p, j + k, lane, tb);
    }
}

__device__ __forceinline__ void ph_ln1(const MK& p, int bid, int nb, int tid_l) {
    const int wid = tid_l >> 6, lane = tid_l & 63;
    for (int R = bid * 8 + wid; R < NR; R += nb * 8) {
        int b = R / RB, i = R % RB;
        const float* src = i < CTX ? p.ctx + ((size_t)b * CTX + i) * D : p.x + ((size_t)b * SEQ + (i - CTX)) * D;
        const float* m = p.mod() + (size_t)(i < CTX ? 4 : b) * 6 * D;
        float4 v[4]; float ss = 0;
#pragma unroll
        for (int q = 0; q < 4; ++q) { v[q] = *(const float4*)(src + q * 256 + lane * 4); ss += v[q].x * v[q].x + v[q].y * v[q].y + v[q].z * v[q].z + v[q].w * v[q].w; }
        ss = wave_sum(ss);
        float rstd = rsqrtf(ss * (1.0f / D) + EPS);
#pragma unroll
        for (int q = 0; q < 4; ++q) {
            int c0 = q * 256 + lane * 4;
            float4 gg = *(const float4*)(p.norm1_g + c0), sh = *(const float4*)(m + c0), sc = *(const float4*)(m + D + c0);
            float o0 = v[q].x * rstd * gg.x * (1 + sc.x) + sh.x, o1 = v[q].y * rstd * gg.y * (1 + sc.y) + sh.y;
            float o2 = v[q].z * rstd * gg.z * (1 + sc.z) + sh.z, o3 = v[q].w * rstd * gg.w * (1 + sc.w) + sh.w;
            u32x2 w; w.x = cvtpk(o0, o1); w.y = cvtpk(o2, o3);
            *(u32x2*)(p.H() + (size_t)R * D + c0) = w;
        }
    }
}

__device__ __forceinline__ int lds_byte(int r, int c) { int st = (r >> 4) * 2 + (c >> 5), ob = (r & 15) * 64 + (c & 31) * 2; return st * 1024 + (ob ^ (((ob >> 9) & 1) << 5)); }
__device__ __forceinline__ void stage_rc(int b, int& R, int& C) { int st = b >> 10, sb = b & 1023, swz = sb ^ (((sb >> 9) & 1) << 5); R = (st / 2) * 16 + swz / 64; C = (st % 2) * 32 + (swz % 64) / 2; }
#define WAIT_V0() asm volatile("s_waitcnt vmcnt(0)" ::: "memory")
__device__ __forceinline__ void gemm_core(const char* Abase, const unsigned (&Ao)[4], const char* Bbase, const unsigned (&Bo)[4], int nt, f32x4 (&acc)[8][4], int tid_l, bool pre) {
    const int tid = tid_l, wid = tid >> 6, lane = tid & 63, wr = wid >> 2, wc = wid & 3, fr = lane & 15, fq = lane >> 4;
#pragma unroll
    for (int m = 0; m < 8; ++m)
#pragma unroll
        for (int n = 0; n < 4; ++n) acc[m][n] = (f32x4){0.f, 0.f, 0.f, 0.f};
#define G_SA(b) (smem + (b) * 32768)
#define G_SB(b) (smem + 65536 + (b) * 32768)
#define G_STAGE(buf, kt) do { _Pragma("unroll") for (int i = 0; i < 4; ++i) {                                                     \
        __builtin_amdgcn_global_load_lds((const unsigned*)(Abase + (Ao[i] + (unsigned)(kt) * 128u)), (unsigned*)(G_SA(buf) + wid * 1024 + i * 8192), 16, 0, 0); \
        __builtin_amdgcn_global_load_lds((const unsigned*)(Bbase + (Bo[i] + (unsigned)(kt) * 128u)), (unsigned*)(G_SB(buf) + wid * 1024 + i * 8192), 16, 0, 0); } } while (0)
    if (!pre) G_STAGE(0, 0);
    WAIT_V0(); __syncthreads();
#define G_KSTEP(cur, t) do {                                                                                                   \
        if ((t) + 1 < nt) G_STAGE((cur) ^ 1, (t) + 1);                                                                          \
        _Pragma("unroll") for (int ks = 0; ks < 2; ++ks) {                                                                      \
            bf16x8 At[8], Bf[4];                                                                                                \
            _Pragma("unroll") for (int m = 0; m < 8; ++m) At[m] = *(const bf16x8*)(G_SA(cur) + lds_byte(wr * 128 + m * 16 + fr, ks * 32 + fq * 8)); \
            _Pragma("unroll") for (int n = 0; n < 4; ++n) Bf[n] = *(const bf16x8*)(G_SB(cur) + lds_byte(wc * 64 + n * 16 + fr, ks * 32 + fq * 8));  \
            _Pragma("unroll") for (int m = 0; m < 8; ++m) _Pragma("unroll") for (int n = 0; n < 4; ++n)                         \
                acc[m][n] = __builtin_amdgcn_mfma_f32_16x16x32_bf16(Bf[n], At[m], acc[m][n], 0, 0, 0);                          \
            __builtin_amdgcn_sched_barrier(0);                                                                                  \
        }                                                                                                                       \
        WAIT_V0(); __syncthreads(); } while (0)
#pragma unroll 1
    for (int t = 0; t < nt; ++t) { const int cur = t & 1; G_KSTEP(cur, t); }
}
#ifndef XPREFETCH
#define XPREFETCH 0
#endif
__device__ __forceinline__ void gemm_prefetch(const char* Abase, const unsigned (&Ao)[4], const char* Bbase, const unsigned (&Bo)[4], int tid_l) {
    const int wid = tid_l >> 6;
    G_STAGE(0, 0);
}
__device__ __forceinline__ void stage_offs(unsigned ld_bytes, unsigned (&P)[4], int tid_l) {
    const int wid = tid_l >> 6, lane = tid_l & 63;
#pragma unroll
    for (int i = 0; i < 4; ++i) { int R, C; stage_rc(wid * 1024 + i * 8192 + lane * 16, R, C); P[i] = (unsigned)R * ld_bytes + (unsigned)C * 2u; }
}

constexpr int WAREA = 18432;
__device__ __forceinline__ char* wave_area(int wid) { return smem + wid * WAREA; }

constexpr int A_KVBLK = 64;
constexpr float A_SCALE = 0.125f, A_THR = 8.f;
constexpr int A_SHM_V = A_KVBLK * 128 * 2, A_SHM_K = A_KVBLK * 128 * 2;
#define KSWZ(row, colB) ((row) * 256 + ((colB) ^ (((row) & 7) << 4)))
#define SBAR() __builtin_amdgcn_sched_barrier(0)
__device__ __forceinline__ int crow(int r, int hi) { return (r & 3) + 8 * (r >> 2) + 4 * hi; }

constexpr float A_THRL = 11.0f;
template <bool FIRST> __device__ __forceinline__ void partialSM2(f32x16& p0, f32x16& p1, float& mhat, f32x16& negm, float& alpha) {
    float pmax = p0[0];
#pragma unroll
    for (int r = 1; r < 16; ++r) pmax = fmaxf(pmax, p0[r]);
#pragma unroll
    for (int r = 0; r < 16; ++r) pmax = fmaxf(pmax, p1[r]);
    { auto rr = __builtin_amdgcn_permlane32_swap(__float_as_uint(pmax), __float_as_uint(pmax), false, false);
      pmax = fmaxf(__uint_as_float(rr[0]), __uint_as_float(rr[1])); }
    alpha = 1.f;
    if (FIRST || __builtin_expect(__any(pmax > A_THRL), 0)) {
        const float dl = FIRST ? pmax : fmaxf(pmax, 0.f);
        mhat += dl;
#pragma unroll
        for (int r = 0; r < 16; ++r) { p0[r] -= dl; p1[r] -= dl; }
#pragma unroll
        for (int r = 0; r < 16; ++r) negm[r] = -mhat;
        if (!FIRST) alpha = __builtin_amdgcn_exp2f(-dl);
    }
#pragma unroll
    for (int r = 0; r < 16; ++r) p0[r] = __builtin_amdgcn_exp2f(p0[r]);
}
__device__ __forceinline__ void qkt2(f32x16& p0, f32x16& p1, const char* Ks, const bf16x8* qr, const f32x16& negm, int r32, int hi, int mapc) {
#pragma unroll
    for (int d0 = 0; d0 < 4; ++d0) { int cb = (mapc + d0 * 16 + hi * 8) * 2;
        bf16x8 b0 = *reinterpret_cast<const bf16x8*>(Ks + KSWZ(r32, cb));
        bf16x8 b1 = *reinterpret_cast<const bf16x8*>(Ks + KSWZ(32 + r32, cb));
        if (d0 == 0) { p0 = __builtin_amdgcn_mfma_f32_32x32x16_bf16(b0, qr[0], negm, 0, 0, 0); p1 = __builtin_amdgcn_mfma_f32_32x32x16_bf16(b1, qr[0], negm, 0, 0, 0); }
        else { p0 = __builtin_amdgcn_mfma_f32_32x32x16_bf16(b0, qr[d0], p0, 0, 0, 0); p1 = __builtin_amdgcn_mfma_f32_32x32x16_bf16(b1, qr[d0], p1, 0, 0, 0); } }
}
template <int PROBE = 0> __device__ __forceinline__ void partialSM(f32x16& p0, f32x16& p1, float& m_reg, float& mn, float& alpha) {
    constexpr float C = A_SCALE * 1.4426950408889634f;
    float pmax = p0[0];
#pragma unroll
    for (int r = 1; r < 16; ++r) pmax = fmaxf(pmax, p0[r]);
#pragma unroll
    for (int r = 0; r < 16; ++r) pmax = fmaxf(pmax, p1[r]);
    { auto rr = __builtin_amdgcn_permlane32_swap(__float_as_uint(pmax), __float_as_uint(pmax), false, false);
      pmax = fmaxf(__uint_as_float(rr[0]), __uint_as_float(rr[1])); }
    if (__builtin_expect(__all(pmax - m_reg <= A_THR / A_SCALE), 1)) { mn = m_reg; alpha = 1.f; }
    else { mn = fmaxf(m_reg, pmax); alpha = __builtin_amdgcn_exp2f((m_reg - mn) * C); m_reg = mn; }
    float mnC = -mn * C;
#pragma unroll
    for (int r = 0; r < 16; ++r) p0[r] = fmaf(p0[r], C, mnC);
#pragma unroll
    for (int r = 0; r < 16; ++r) p1[r] = fmaf(p1[r], C, mnC);
#pragma unroll
    for (int r = 0; r < 16; ++r) p0[r] = PROBE == 3 ? p0[r] * 1e-3f : __builtin_amdgcn_exp2f(p0[r]);
}
#define PK4(P, BASE, OUT) do { unsigned a0 = cvtpk(P[BASE + 0], P[BASE + 1]), a1 = cvtpk(P[BASE + 2], P[BASE + 3]);   \
    unsigned b0 = cvtpk(P[BASE + 4], P[BASE + 5]), b1 = cvtpk(P[BASE + 6], P[BASE + 7]);                              \
    auto r0 = __builtin_amdgcn_permlane32_swap(a0, b0, false, false); auto r1 = __builtin_amdgcn_permlane32_swap(a1, b1, false, false); \
    u32x4 w = {r0[0], r1[0], r0[1], r1[1]}; OUT = *reinterpret_cast<bf16x8*>(&w); } while (0)
template <int PROBE = 0, bool DIRECT = false> __device__ __forceinline__ void finishSM(f32x16& p0, f32x16& p1, float alpha, float& l_reg, bf16x8& pa0, bf16x8& pa1, bf16x8& pa2, bf16x8& pa3) {
#pragma unroll
    for (int r = 0; r < 16; ++r) p1[r] = PROBE == 3 ? p1[r] * 1e-3f : __builtin_amdgcn_exp2f(p1[r]);
    float ps = 0;
#pragma unroll
    for (int r = 0; r < 16; ++r) ps += p0[r];
#pragma unroll
    for (int r = 0; r < 16; ++r) ps += p1[r];
    { auto rr = __builtin_amdgcn_permlane32_swap(__float_as_uint(ps), __float_as_uint(ps), false, false);
      ps = __uint_as_float(rr[0]) + __uint_as_float(rr[1]); }
    l_reg = l_reg * alpha + ps;
    if (DIRECT) {
#define PKD(P, B, OUT) do { u32x4 w = {cvtpk(P[B], P[B + 1]), cvtpk(P[B + 2], P[B + 3]), cvtpk(P[B + 4], P[B + 5]), cvtpk(P[B + 6], P[B + 7])}; OUT = *reinterpret_cast<bf16x8*>(&w); } while (0)
        PKD(p0, 0, pa0); PKD(p0, 8, pa1); PKD(p1, 0, pa2); PKD(p1, 8, pa3);
#undef PKD
    } else { PK4(p0, 0, pa0); PK4(p0, 8, pa1); PK4(p1, 0, pa2); PK4(p1, 8, pa3); }
}
__device__ __forceinline__ void qkt(f32x16& p0, f32x16& p1, const char* Ks, const bf16x8* qr, int r32, int hi, int mapc) {
    p0 = f32x16{}; p1 = f32x16{};
#pragma unroll
    for (int d0 = 0; d0 < 4; ++d0) { int cb = (mapc + d0 * 16 + hi * 8) * 2;
        bf16x8 b0 = *reinterpret_cast<const bf16x8*>(Ks + KSWZ(r32, cb));
        bf16x8 b1 = *reinterpret_cast<const bf16x8*>(Ks + KSWZ(32 + r32, cb));
        p0 = __builtin_amdgcn_mfma_f32_32x32x16_bf16(b0, qr[d0], p0, 0, 0, 0);
        p1 = __builtin_amdgcn_mfma_f32_32x32x16_bf16(b1, qr[d0], p1, 0, 0, 0); }
}
__device__ __forceinline__ int v_st(int k, int c) { const int kk = (k & ~0xC) | ((k & 4) << 1) | ((k & 8) >> 1); return ((kk >> 3) * 4 + (c >> 5)) * 512 + ((kk & 7) * 32 + (c & 31)) * 2; }
__device__ __forceinline__ int v_rd_base(int lane) { return ((lane & 3) << 3) | (((lane >> 2) & 3) << 6) | (((lane >> 4) & 1) << 5) | (((lane >> 5) & 1) << 8); }
constexpr int v_rd_off(int d0, int ks, int half) { return d0 * 512 + ks * 4096 + half * 2048; }
template <int OFF> __device__ __forceinline__ s16x4 tr_read(int vb) {
    s16x4 r; asm volatile("ds_read_b64_tr_b16 %0, %1 offset:%2" : "=&v"(r) : "v"(vb), "i"(OFF) : "memory"); return r;
}
template <int D0> __device__ __forceinline__ void pv_one(f32x16& od, int vb, bf16x8 pa0, bf16x8 pa1, bf16x8 pa2, bf16x8 pa3) {
    const s16x4 l0 = tr_read<v_rd_off(D0, 0, 0)>(vb), h0 = tr_read<v_rd_off(D0, 0, 1)>(vb), l1 = tr_read<v_rd_off(D0, 1, 0)>(vb), h1 = tr_read<v_rd_off(D0, 1, 1)>(vb);
    const s16x4 l2 = tr_read<v_rd_off(D0, 2, 0)>(vb), h2 = tr_read<v_rd_off(D0, 2, 1)>(vb), l3 = tr_read<v_rd_off(D0, 3, 0)>(vb), h3 = tr_read<v_rd_off(D0, 3, 1)>(vb);
    asm volatile("s_waitcnt lgkmcnt(0)" ::: "memory"); SBAR();
#define PKV(L, H) (bf16x8){L[0], L[1], L[2], L[3], H[0], H[1], H[2], H[3]}
    od = __builtin_amdgcn_mfma_f32_32x32x16_bf16(pa0, PKV(l0, h0), od, 0, 0, 0);
    od = __builtin_amdgcn_mfma_f32_32x32x16_bf16(pa1, PKV(l1, h1), od, 0, 0, 0);
    od = __builtin_amdgcn_mfma_f32_32x32x16_bf16(pa2, PKV(l2, h2), od, 0, 0, 0);
    od = __builtin_amdgcn_mfma_f32_32x32x16_bf16(pa3, PKV(l3, h3), od, 0, 0, 0);
}
template <int D0> __device__ __forceinline__ void pv_two(f32x16& oa, f32x16& ob, int vb, bf16x8 pa0, bf16x8 pa1, bf16x8 pa2, bf16x8 pa3) {
    const s16x4 l0 = tr_read<v_rd_off(D0, 0, 0)>(vb), h0 = tr_read<v_rd_off(D0, 0, 1)>(vb), l1 = tr_read<v_rd_off(D0, 1, 0)>(vb), h1 = tr_read<v_rd_off(D0, 1, 1)>(vb);
    const s16x4 l2 = tr_read<v_rd_off(D0, 2, 0)>(vb), h2 = tr_read<v_rd_off(D0, 2, 1)>(vb), l3 = tr_read<v_rd_off(D0, 3, 0)>(vb), h3 = tr_read<v_rd_off(D0, 3, 1)>(vb);
    const s16x4 m0 = tr_read<v_rd_off(D0 + 1, 0, 0)>(vb), g0 = tr_read<v_rd_off(D0 + 1, 0, 1)>(vb), m1 = tr_read<v_rd_off(D0 + 1, 1, 0)>(vb), g1 = tr_read<v_rd_off(D0 + 1, 1, 1)>(vb);
    const s16x4 m2 = tr_read<v_rd_off(D0 + 1, 2, 0)>(vb), g2 = tr_read<v_rd_off(D0 + 1, 2, 1)>(vb), m3 = tr_read<v_rd_off(D0 + 1, 3, 0)>(vb), g3 = tr_read<v_rd_off(D0 + 1, 3, 1)>(vb);
    asm volatile("s_waitcnt lgkmcnt(0)" ::: "memory"); SBAR();
    oa = __builtin_amdgcn_mfma_f32_32x32x16_bf16(pa0, PKV(l0, h0), oa, 0, 0, 0);
    ob = __builtin_amdgcn_mfma_f32_32x32x16_bf16(pa0, PKV(m0, g0), ob, 0, 0, 0);
    oa = __builtin_amdgcn_mfma_f32_32x32x16_bf16(pa1, PKV(l1, h1), oa, 0, 0, 0);
    ob = __builtin_amdgcn_mfma_f32_32x32x16_bf16(pa1, PKV(m1, g1), ob, 0, 0, 0);
    oa = __builtin_amdgcn_mfma_f32_32x32x16_bf16(pa2, PKV(l2, h2), oa, 0, 0, 0);
    ob = __builtin_amdgcn_mfma_f32_32x32x16_bf16(pa2, PKV(m2, g2), ob, 0, 0, 0);
    oa = __builtin_amdgcn_mfma_f32_32x32x16_bf16(pa3, PKV(l3, h3), oa, 0, 0, 0);
    ob = __builtin_amdgcn_mfma_f32_32x32x16_bf16(pa3, PKV(m3, g3), ob, 0, 0, 0);
}
__device__ __forceinline__ void pv_d0(f32x16* o, int vb, bf16x8 pa0, bf16x8 pa1, bf16x8 pa2, bf16x8 pa3) {
    pv_one<0>(o[0], vb, pa0, pa1, pa2, pa3); pv_one<1>(o[1], vb, pa0, pa1, pa2, pa3); pv_one<2>(o[2], vb, pa0, pa1, pa2, pa3); pv_one<3>(o[3], vb, pa0, pa1, pa2, pa3);
}

template <int PROBE> __device__ __forceinline__ void attn_item(const bf16_t* __restrict__ Qb, const bf16_t* __restrict__ Kh, const bf16_t* __restrict__ Vh, bf16_t* __restrict__ mixrow,
                                          const float* __restrict__ gd, float lam, int tid_l) {
    char* lds = smem;
    const int tid = tid_l, wid = tid >> 6, lane = tid & 63, r32 = lane & 31, hi = lane >> 5;
    const int map = wid >> 2, wq = wid & 3, mapc = map * 64;
    char* K_lds = lds; char* V_lds = lds + 4 * A_SHM_K;
    float* wsw = (float*)(lds + 4 * A_SHM_V + 4 * A_SHM_K) + wid * 64; float* li_l = wsw; float* al_l = wsw + 32;
    float m_reg = 0.f, l_reg = 0; f32x16 o[4] = {}; bf16x8 qr[4]; f32x16 negm = f32x16{};
    const bf16_t* Qw = Qb + (long)(wq * 32 + r32) * 128 + mapc + hi * 8;
#pragma unroll
    for (int d0 = 0; d0 < 4; ++d0) qr[d0] = *reinterpret_cast<const bf16x8*>(Qw + d0 * 16);
    const int vb0 = (int)(uintptr_t)V_lds + v_rd_base(lane);
    unsigned kofs[2], vofs[2];
    const int widu = __builtin_amdgcn_readfirstlane(wid);
#pragma unroll
    for (int i = 0; i < 2; ++i) {
        const int x = wid * 1024 + i * 8192 + lane * 16;
        { const int row = x >> 8, cs = x & 255, colB = cs ^ ((row & 7) << 4); kofs[i] = (unsigned)(row * 256 + colB); }
        { const int sub = x >> 9, wn = x & 511, k = (sub >> 2) * 8 + (wn >> 6), c = (sub & 3) * 32 + ((wn & 63) >> 1); vofs[i] = (unsigned)(k * 256 + c * 2); }
    }
#define DMA_TILE(slot, k0) do { const char* kt_ = (const char*)Kh + (size_t)(k0) * 256; const char* vt_ = (const char*)Vh + (size_t)(k0) * 256;                  \
      _Pragma("unroll") for (int i = 0; i < 2; ++i) {                                                                   \
        __builtin_amdgcn_global_load_lds((const unsigned*)(kt_ + kofs[i]), (unsigned*)(K_lds + (slot) * A_SHM_K + widu * 1024 + i * 8192), 16, 0, 0); \
        __builtin_amdgcn_global_load_lds((const unsigned*)(vt_ + vofs[i]), (unsigned*)(V_lds + (slot) * A_SHM_V + widu * 1024 + i * 8192), 16, 0, 0); } } while (0)
#define RESC(a) do { if (__any((a) < 1.f)) { if (hi == 0) al_l[r32] = (a); asm volatile("s_waitcnt lgkmcnt(0)" ::: "memory"); \
    _Pragma("unroll") for (int d = 0; d < 4; ++d) _Pragma("unroll") for (int r = 0; r < 16; ++r) o[d][r] *= al_l[crow(r, hi)]; } } while (0)
    f32x16 pA0, pA1, pB0, pB1; float mnA, mnB, alA, alB; bf16x8 pa0, pa1, pa2, pa3; const int NT = RB / A_KVBLK;
    DMA_TILE(0, 0); DMA_TILE(1, A_KVBLK);
    asm volatile("s_waitcnt vmcnt(0)" ::: "memory"); __syncthreads();
    qkt2(pA0, pA1, K_lds, qr, negm, r32, hi, mapc); partialSM2<true>(pA0, pA1, m_reg, negm, alA);
#define ATILE(X0, X1, ALX, Y0, Y1, ALY, CS, PS, NS, T_, DODMA) do {                                                                  \
        asm volatile("s_waitcnt vmcnt(0)" ::: "memory"); __syncthreads();                                                            \
        if (DODMA && PROBE != 1) DMA_TILE(NS, ((T_) + 1) * A_KVBLK);                                                                 \
        SBAR(); qkt2(X0, X1, K_lds + (CS) * A_SHM_K, qr, negm, r32, hi, mapc);                                                       \
        finishSM<PROBE, true>(Y0, Y1, ALY, l_reg, pa0, pa1, pa2, pa3); SBAR();                                                       \
        pv_d0(o, vb0 + (PS) * A_SHM_V, pa0, pa1, pa2, pa3); partialSM2<false>(X0, X1, m_reg, negm, ALX);                             \
        RESC(ALX); } while (0)
#pragma unroll 1
    for (int j = 1; j + 3 < NT; j += 4) {
        ATILE(pB0, pB1, alB, pA0, pA1, alA, 1, 0, 2, j, true);
        ATILE(pA0, pA1, alA, pB0, pB1, alB, 2, 1, 3, j + 1, true);
        ATILE(pB0, pB1, alB, pA0, pA1, alA, 3, 2, 0, j + 2, true);
        ATILE(pA0, pA1, alA, pB0, pB1, alB, 0, 3, 1, j + 3, true);
    }
    ATILE(pB0, pB1, alB, pA0, pA1, alA, 1, 0, 2, NT - 3, true);
    ATILE(pA0, pA1, alA, pB0, pB1, alB, 2, 1, 3, NT - 2, true);
    ATILE(pB0, pB1, alB, pA0, pA1, alA, 3, 2, 0, NT - 1, false);
    finishSM<PROBE, true>(pB0, pB1, alB, l_reg, pa0, pa1, pa2, pa3); SBAR();
    pv_d0(o, vb0 + 3 * A_SHM_V, pa0, pa1, pa2, pa3);
#undef ATILE
#undef DMA_TILE
    if (hi == 0) li_l[r32] = l_reg;
    asm volatile("s_waitcnt lgkmcnt(0)" ::: "memory");
    float rl[16];
#pragma unroll
    for (int r = 0; r < 16; ++r) rl[r] = __builtin_amdgcn_rcpf(li_l[crow(r, hi)]);
    __syncthreads();
    {
        float* xo = (float*)lds + map * 16384 + (wq * 32) * 128 + r32;
#pragma unroll
        for (int r = 0; r < 16; ++r)
#pragma unroll
            for (int d0 = 0; d0 < 4; ++d0) xo[crow(r, hi) * 128 + d0 * 32] = o[d0][r] * rl[r];
    }
    __syncthreads();
    {
        int l2 = lane; asm volatile("" : "+v"(l2));
        const float g0 = gd[l2 * 2], g1 = gd[l2 * 2 + 1];
#pragma unroll 4
        for (int rr = 0; rr < 16; ++rr) {
            const int row = wid * 16 + rr;
            const float2 a0 = *(const float2*)((const float*)lds + row * 128 + l2 * 2), a1 = *(const float2*)((const float*)lds + 16384 + row * 128 + l2 * 2);
            const float xv = a0.x - lam * a1.x, yv = a0.y - lam * a1.y;
            const float ss = wave_sum(xv * xv + yv * yv);
            const float rs = rsqrtf(ss * (1.0f / 128) + EPS) * 0.8f;
            *(unsigned*)(mixrow + (long)row * 1024 + l2 * 2) = cvtpk(xv * rs * g0, yv * rs * g1);
        }
    }
    __syncthreads();
#undef RESC
}


template <int PROBE> __device__ __forceinline__ void ph_attn(const MK& p, int bid, int nb, int tid_l) {
    const int lane = tid_l & 63;
    float s1 = wave_sum(p.lq1[lane] * p.lk1[lane]), s2 = wave_sum(p.lq2[lane] * p.lk2[lane]);
    const float lam = expf(s1) - expf(s2) + 0.2f;
    const int nrounds = (1024 + nb - 1) / nb;
    for (int rr = 0; rr < nrounds; ++rr) {
        int item;
        if (nb == 256) { int x = bid & 7, j = bid >> 3, hh = rr * 8 + x; item = (hh >> 1) * 64 + (hh & 1) * 32 + j; }
        else { item = rr * nb + bid; if (item >= 1024) break; }
        const int bh = item >> 6, qb = item & 63, b = bh >> 2, h = bh & 3;
        attn_item<PROBE>(p.Q() + ((size_t)bh * SEQ + qb * 128) * 128, p.K() + (size_t)bh * RB * 128, p.V() + (size_t)bh * RB * 128,
                  PROBE ? (bf16_t*)(p.ws + 492 * MiB) + h * 128 : p.MIX() + ((size_t)(b * SEQ + qb * 128)) * 1024 + h * 128, p.dattn_g, lam, tid_l);
    }
}


__device__ __forceinline__ bf16x8 ldfrag(const bf16_t* p) { return *reinterpret_cast<const bf16x8*>(p); }

__device__ __forceinline__ void ph_kv(const MK& p, int bid, int nb, int tid_l) {
    const int wid = tid_l >> 6, lane = tid_l & 63, r32 = lane & 31, hi = lane >> 5;
    const int nitems = 16 * 2 * 66;
    for (int it = bid * 8 + wid; it < nitems; it += nb * 8) {
        const int c = it % 66, chain = it / 66, dir = chain & 1, bh = chain >> 1;
        const bf16_t* vt = p.VT() + (size_t)bh * 128 * RB + c * 128 + hi * 8;
        const bf16_t* kt = (dir ? p.KTb() : p.KTf()) + (size_t)bh * 64 * RB + c * 128 + hi * 8;
        f32x16 acc[4][2];
#pragma unroll
        for (int mt = 0; mt < 4; ++mt) { acc[mt][0] = f32x16{}; acc[mt][1] = f32x16{}; }
#pragma unroll 1
        for (int kh = 0; kh < 2; ++kh) {
            bf16x8 a[4][4], b2[2][4];
#pragma unroll
            for (int ks = 0; ks < 4; ++ks) {
#pragma unroll
                for (int mt = 0; mt < 4; ++mt) a[mt][ks] = ldfrag(vt + (size_t)(mt * 32 + r32) * RB + (kh * 4 + ks) * 16);
#pragma unroll
                for (int nt = 0; nt < 2; ++nt) b2[nt][ks] = ldfrag(kt + (size_t)(nt * 32 + r32) * RB + (kh * 4 + ks) * 16);
            }
            asm volatile("" ::: "memory");
#pragma unroll
            for (int ks = 0; ks < 4; ++ks)
#pragma unroll
                for (int mt = 0; mt < 4; ++mt)
#pragma unroll
                    for (int nt = 0; nt < 2; ++nt) acc[mt][nt] = __builtin_amdgcn_mfma_f32_32x32x16_bf16(a[mt][ks], b2[nt][ks], acc[mt][nt], 0, 0, 0);
        }
        bf16_t* dst = p.KV() + (size_t)it * 8192;
#pragma unroll
        for (int mt = 0; mt < 4; ++mt)
#pragma unroll
            for (int nt = 0; nt < 2; ++nt)
#pragma unroll
                for (int r = 0; r < 16; ++r) dst[(mt * 32 + crow(r, hi)) * 64 + nt * 32 + r32] = f2bf(acc[mt][nt][r]);
    }
}

__device__ __forceinline__ void ph_scan(const MK& p, int bid, int nb, int tid_l) {
    if (tid_l >= 256) {
        const int lane = tid_l & 63, wq = __builtin_amdgcn_readfirstlane(tid_l >> 6); char* tb = smem + wq * 8192;
#pragma unroll 1
        for (int j = CV_E13 + bid * 4 + (wq - 4); j < CV_E13 + CV_E2; j += nb * 4) convert_tile_wave(p, j, lane, tb);
        return;
    }
    for (int e0 = bid * 256 + tid_l; e0 < 32 * 8192; e0 += nb * 1024) {
        float S[4], g128[4]; const bf16_t* kv[4]; bf16_t* st[4]; int dir[4];
#pragma unroll
        for (int q = 0; q < 4; ++q) {
            int e = e0 + q * nb * 256; if (e >= 32 * 8192) e = e0;
            const int chain = e >> 13, el = e & 8191, h = (chain >> 1) & 3; dir[q] = chain & 1;
            const float d = dir[q] ? p.dec_b[h] : p.dec_f[h];
            g128[q] = exp2f(128.0f * log2f(1.0f / (1.0f + expf(-d))));
            kv[q] = p.KV() + (size_t)chain * 66 * 8192 + el; st[q] = p.ST() + (size_t)chain * 66 * 8192 + el; S[q] = 0.f;
        }
#pragma unroll 2
        for (int n = 0; n < 66; ++n) {
            const int cb = n == 0 ? 1 : (n == 1 ? 0 : 67 - n);
            float x[4];
#pragma unroll
            for (int q = 0; q < 4; ++q) x[q] = bf2f(kv[q][(size_t)(dir[q] ? cb : n) * 8192]);
#pragma unroll
            for (int q = 0; q < 4; ++q) { st[q][(size_t)(dir[q] ? cb : n) * 8192] = f2bf(S[q]); S[q] = fmaf(g128[q], S[q], x[q]); }
        }
    }
}

__device__ __forceinline__ void ph_ret(const MK& p, int bid, int nb, int tid_l) {
    const int tid = tid_l, wid = tid >> 6, lane = tid & 63, r32 = lane & 31, hi = lane >> 5, wq = wid & 3, half = wid >> 2;
    float* img = (float*)smem;
    for (int it = bid; it < 4 * 64 * 2; it += nb) {
        const int hp = it & 1, lc = (it >> 1) & 63, b = it >> 7, h = hp * 2 + half, bh = b * 4 + h;
        const int ib = CTX + lc * 128, c = 2 + lc;
        const float lf = log2f(1.0f / (1.0f + expf(-p.dec_f[h]))), lb = log2f(1.0f / (1.0f + expf(-p.dec_b[h])));
        const bf16_t* rq = p.RQ() + ((size_t)bh * RB + ib + wq * 32 + r32) * 64 + hi * 8;
        bf16x8 q[4];
#pragma unroll
        for (int ks = 0; ks < 4; ++ks) q[ks] = ldfrag(rq + ks * 16);
        f32x16 o[4];
        {
            const bf16_t* stf = p.ST() + ((size_t)(bh * 2 + 0) * 66 + c) * 8192 + hi * 8;
            const bf16_t* stb = p.ST() + ((size_t)(bh * 2 + 1) * 66 + c) * 8192 + hi * 8;
#define QSCALE(dst, f_) do { _Pragma("unroll") for (int ks = 0; ks < 4; ++ks) { const u32x4 w_ = *reinterpret_cast<const u32x4*>(&q[ks]); u32x4 r_;                         \
            _Pragma("unroll") for (int j = 0; j < 4; ++j) r_[j] = cvtpk(__uint_as_float(w_[j] << 16) * (f_), __uint_as_float(w_[j] & 0xffff0000u) * (f_));                 \
            dst[ks] = *reinterpret_cast<const bf16x8*>(&r_); } } while (0)
            {
                bf16x8 sf[4][4];
#pragma unroll
                for (int d0 = 0; d0 < 4; ++d0)
#pragma unroll
                    for (int ks = 0; ks < 4; ++ks) sf[d0][ks] = ldfrag(stf + (size_t)(d0 * 32 + r32) * 64 + ks * 16);
                asm volatile("" ::: "memory");
                bf16x8 qs[4]; QSCALE(qs, __builtin_amdgcn_exp2f((float)(wq * 32 + r32 + 1) * lf));
#pragma unroll
                for (int d0 = 0; d0 < 4; ++d0) {
                    o[d0] = f32x16{};
#pragma unroll
                    for (int ks = 0; ks < 4; ++ks) o[d0] = __builtin_amdgcn_mfma_f32_32x32x16_bf16(qs[ks], sf[d0][ks], o[d0], 0, 0, 0);
                }
            }
            asm volatile("" ::: "memory");
            {
                bf16x8 sb[4][4];
#pragma unroll
                for (int d0 = 0; d0 < 4; ++d0)
#pragma unroll
                    for (int ks = 0; ks < 4; ++ks) sb[d0][ks] = ldfrag(stb + (size_t)(d0 * 32 + r32) * 64 + ks * 16);
                asm volatile("" ::: "memory");
                bf16x8 qs[4]; QSCALE(qs, __builtin_amdgcn_exp2f((float)(128 - (wq * 32 + r32)) * lb));
#pragma unroll
                for (int d0 = 0; d0 < 4; ++d0)
#pragma unroll
                    for (int ks = 0; ks < 4; ++ks) o[d0] = __builtin_amdgcn_mfma_f32_32x32x16_bf16(qs[ks], sb[d0][ks], o[d0], 0, 0, 0);
            }
#undef QSCALE
            asm volatile("" ::: "memory");
        }
        {
            const int qi = wq * 32 + r32;
            const bf16_t* vt = p.VT() + (size_t)bh * 128 * RB + ib + hi * 8;
#pragma unroll 1
            for (int jh = 0; jh < 2; ++jh) {
                asm volatile("" ::: "memory");
                bf16x8 pa[2][2];
                {
                    bf16x8 kf[2][4];
#pragma unroll
                    for (int j2 = 0; j2 < 2; ++j2)
#pragma unroll
                        for (int ks = 0; ks < 4; ++ks) kf[j2][ks] = ldfrag(p.RK() + ((size_t)bh * RB + ib + (jh * 2 + j2) * 32 + r32) * 64 + hi * 8 + ks * 16);
                    asm volatile("" ::: "memory");
#pragma unroll
                    for (int j2 = 0; j2 < 2; ++j2) {
                        f32x16 pp = f32x16{};
#pragma unroll
                        for (int ks = 0; ks < 4; ++ks) pp = __builtin_amdgcn_mfma_f32_32x32x16_bf16(kf[j2][ks], q[ks], pp, 0, 0, 0);
#pragma unroll
                        for (int r = 0; r < 16; ++r) {
                            const int dd = qi - ((jh * 2 + j2) * 32 + crow(r, hi));
                            const float ex = __builtin_amdgcn_exp2f(dd > 0 ? (float)dd * lf : (float)(-dd) * lb); const float w = dd == 0 ? 2.0f : ex;
                            pp[r] *= w;
                        }
                        PK4(pp, 0, pa[j2][0]); PK4(pp, 8, pa[j2][1]);
                    }
                }
                asm volatile("" ::: "memory");
                bf16x8 vf[2][4][2];
#pragma unroll
                for (int j2 = 0; j2 < 2; ++j2)
#pragma unroll
                    for (int d0 = 0; d0 < 4; ++d0) { vf[j2][d0][0] = ldfrag(vt + (size_t)(d0 * 32 + r32) * RB + (jh * 2 + j2) * 32); vf[j2][d0][1] = ldfrag(vt + (size_t)(d0 * 32 + r32) * RB + (jh * 2 + j2) * 32 + 16); }
                asm volatile("" ::: "memory");
#pragma unroll
                for (int j2 = 0; j2 < 2; ++j2)
#pragma unroll
                    for (int d0 = 0; d0 < 4; ++d0) {
                        o[d0] = __builtin_amdgcn_mfma_f32_32x32x16_bf16(pa[j2][0], vf[j2][d0][0], o[d0], 0, 0, 0);
                        o[d0] = __builtin_amdgcn_mfma_f32_32x32x16_bf16(pa[j2][1], vf[j2][d0][1], o[d0], 0, 0, 0);
                    }
            }
        }
        __syncthreads();
        {
            float* xo = img + half * 16384 + (wq * 32) * 128 + r32;
#pragma unroll
            for (int r = 0; r < 16; ++r)
#pragma unroll
                for (int d0 = 0; d0 < 4; ++d0) xo[crow(r, hi) * 128 + d0 * 32] = o[d0][r];
        }
        __syncthreads();
        {
            const float g0 = p.ret_g[lane * 2], g1 = p.ret_g[lane * 2 + 1];
#pragma unroll 8
            for (int rr = 0; rr < 32; ++rr) {
                const int row = wid * 32 + rr, itl = row >> 7, rw = row & 127, hh = hp * 2 + itl;
                const float2 a = *(const float2*)(img + row * 128 + lane * 2);
                const float ss = wave_sum(a.x * a.x + a.y * a.y);
                const float rs = rsqrtf(ss * (1.0f / 128) + EPS);
                const size_t tt = (size_t)b * SEQ + lc * 128 + rw;
                const unsigned ggv = *(const unsigned*)(p.RG() + tt * 512 + hh * 128 + lane * 2);
                const float ga = bf2f((bf16_t)(ggv & 0xffff)), gb = bf2f((bf16_t)(ggv >> 16));
                *(unsigned*)(p.MIX() + tt * 1024 + 512 + hh * 128 + lane * 2) = cvtpk(silu_fast(ga) * a.x * rs * g0, silu_fast(gb) * a.y * rs * g1);
            }
        }
    }
}


namespace pg8 {
constexpr int BM = 256, BK = 64, HALF = 128, HTB = HALF * BK * 2;
__device__ __forceinline__ int perm32(int rho) { const int n = rho >> 4, i = rho & 15; return 8 * (i >> 2) + 4 * n + (i & 3); }
struct GUnit { const char* A; const char* B; int i0, i1, i2, i3; };
template <class Epi, class Sched, bool GATHER, bool ALIGN_EPI>
__device__ __forceinline__ void gemm(int K, const Sched& S, const Epi& E, int tid_l) {
    const int tid = tid_l, wid = __builtin_amdgcn_readfirstlane(tid >> 6), lane = tid & 63, wr = wid >> 2, wc = wid & 3, fr = lane & 15, fq = lane >> 4;
    const int nt = K / BK;
    unsigned voffB[2], vAc[2][2], vAn[2][2];
    const size_t kstep = (size_t)(BK * 2);
    const size_t hstepB = (size_t)HALF * K * 2;
#pragma unroll
    for (int i = 0; i < 2; ++i) { int R, C; stage_rc(tid * 16 + i * 8192, R, C); const int Rb = Epi::PERM ? ((R & ~31) + perm32(R & 31)) : R;
        voffB[i] = (unsigned)(Rb * K + C) * 2u; }
    const unsigned ldsw = (unsigned)wid * 1024u;
    const int aoff = lds_byte(wr * 64 + fr, fq * 8), boff = lds_byte(wc * 32 + fr, fq * 8);
#define PG8_SA(b, h) (((b) * 2 + (h)) * HTB)
#define PG8_SB(b, h) ((4 + (b) * 2 + (h)) * HTB)
#define PG8_STAGE(bufoff, gbase, voff) do { _Pragma("unroll") for (int _i = 0; _i < 2; ++_i) \
        __builtin_amdgcn_global_load_lds((const unsigned*)((const char*)(gbase) + (voff)[_i]), (unsigned*)(smem + (bufoff) + ldsw + _i * 8192), 16, 0, 0); } while (0)
#define PG8_LDA(dst, b, h) do { _Pragma("unroll") for (int m = 0; m < 4; ++m) _Pragma("unroll") for (int k = 0; k < 2; ++k) dst[m][k] = *(const bf16x8*)(smem + PG8_SA(b, h) + aoff + m * 2048 + k * 1024); } while (0)
#define PG8_LDB(dst, b, h) do { _Pragma("unroll") for (int n = 0; n < 2; ++n) _Pragma("unroll") for (int k = 0; k < 2; ++k) dst[n][k] = *(const bf16x8*)(smem + PG8_SB(b, h) + boff + n * 2048 + k * 1024); } while (0)
#define PG8_MMA(ai, bj, At, Bt) do { __builtin_amdgcn_s_setprio(1); _Pragma("unroll") for (int m = 0; m < 4; ++m) _Pragma("unroll") for (int n = 0; n < 2; ++n) _Pragma("unroll") for (int k = 0; k < 2; ++k) \
        acc[ai][bj][m][n] = __builtin_amdgcn_mfma_f32_16x16x32_bf16(Bt[n][k], At[m][k], acc[ai][bj][m][n], 0, 0, 0); __builtin_amdgcn_s_setprio(0); } while (0)
#define PG8_WAIT_V(n) asm volatile("s_waitcnt vmcnt(" #n ")" ::: "memory")
#define PG8_WAIT_L(n) asm volatile("s_waitcnt lgkmcnt(" #n ")" ::: "memory")
#define PG8_BAR __builtin_amdgcn_s_barrier()
#define PG8_SCHED __builtin_amdgcn_sched_barrier(0)
    GUnit cur, nxt; int ui = 0;
    if (!S.next(0, cur, vAc)) return;
    f32x4 acc[2][2][4][2];
#pragma unroll
    for (int a = 0; a < 2; ++a)
#pragma unroll
        for (int b = 0; b < 2; ++b)
#pragma unroll
            for (int m = 0; m < 4; ++m)
#pragma unroll
                for (int n = 0; n < 2; ++n) acc[a][b][m][n] = (f32x4){0.f, 0.f, 0.f, 0.f};
    bf16x8 At[4][2], B0[2][2], B1[2][2];
    const char* cA = cur.A; const char* cB = cur.B;
    PG8_STAGE(PG8_SB(0, 0), cB, voffB); PG8_STAGE(PG8_SB(0, 1), cB + hstepB, voffB); PG8_STAGE(PG8_SA(0, 0), cA, vAc[0]); PG8_STAGE(PG8_SA(0, 1), cA, vAc[1]);
    if (wr == 1) PG8_BAR;
    PG8_WAIT_V(2); PG8_BAR;
    PG8_STAGE(PG8_SB(1, 0), cB + kstep, voffB); PG8_STAGE(PG8_SA(1, 0), cA + kstep, vAc[0]); PG8_STAGE(PG8_SB(1, 1), cB + hstepB + kstep, voffB);
    PG8_WAIT_V(6); PG8_BAR;
    for (;;) {
        const bool has_next = S.next(ui + 1, nxt, vAn);
        if (!GATHER || !has_next) {
#pragma unroll
            for (int h = 0; h < 2; ++h)
#pragma unroll
                for (int i = 0; i < 2; ++i) vAn[h][i] = vAc[h][i];
        }
        const char* nA = has_next ? nxt.A : cA; const char* nB = has_next ? nxt.B : cB;
#pragma unroll 1
        for (int t = 0; t < nt; t += 2) {
            const bool last = (t == nt - 2);
            const char* a1 = cA + (size_t)(t + 1) * kstep;
            const char* a2 = last ? nA : cA + (size_t)(t + 2) * kstep; const char* b2 = last ? nB : cB + (size_t)(t + 2) * kstep;
            const char* a3 = a2 + kstep; const char* b3 = b2 + kstep;
            unsigned va2[2][2];
#pragma unroll
            for (int h = 0; h < 2; ++h)
#pragma unroll
                for (int i = 0; i < 2; ++i) va2[h][i] = (GATHER && last) ? vAn[h][i] : vAc[h][i];
            PG8_LDB(B0, 0, 0); PG8_LDB(B1, 0, 1); PG8_SCHED; PG8_LDA(At, 0, 0); PG8_STAGE(PG8_SA(1, 1), a1, vAc[1]);
            PG8_WAIT_V(8); PG8_WAIT_L(0); PG8_BAR; PG8_MMA(0, 0, At, B0); PG8_MMA(0, 1, At, B1); PG8_BAR; PG8_SCHED;
            PG8_LDA(At, 0, 1); PG8_STAGE(PG8_SB(0, 0), b2, voffB); PG8_STAGE(PG8_SB(0, 1), b2 + hstepB, voffB); PG8_STAGE(PG8_SA(0, 0), a2, va2[0]);
            PG8_WAIT_V(8); PG8_WAIT_L(0); PG8_BAR; PG8_MMA(1, 0, At, B0); PG8_MMA(1, 1, At, B1); PG8_BAR; PG8_SCHED;
            PG8_LDB(B0, 1, 0); PG8_LDB(B1, 1, 1); PG8_SCHED; PG8_LDA(At, 1, 0); PG8_STAGE(PG8_SA(0, 1), a2, va2[1]);
            PG8_WAIT_V(8); PG8_WAIT_L(0); PG8_BAR; PG8_MMA(0, 0, At, B0); PG8_MMA(0, 1, At, B1); PG8_BAR; PG8_SCHED;
            PG8_LDA(At, 1, 1); PG8_STAGE(PG8_SB(1, 0), b3, voffB); PG8_STAGE(PG8_SB(1, 1), b3 + hstepB, voffB); PG8_STAGE(PG8_SA(1, 0), a3, va2[0]);
            PG8_WAIT_V(8); PG8_WAIT_L(0); PG8_BAR; PG8_MMA(1, 0, At, B0); PG8_MMA(1, 1, At, B1); PG8_BAR; PG8_SCHED;
        }
        if (ALIGN_EPI) { if (wr == 0) PG8_BAR; }
        E(acc, cur, wr, wc, fr, fq);
        if (!has_next) break;
#pragma unroll
        for (int a = 0; a < 2; ++a)
#pragma unroll
            for (int b = 0; b < 2; ++b)
#pragma unroll
                for (int m = 0; m < 4; ++m)
#pragma unroll
                    for (int n = 0; n < 2; ++n) acc[a][b][m][n] = (f32x4){0.f, 0.f, 0.f, 0.f};
        cur = nxt; cA = nA; cB = nB; ++ui;
#pragma unroll
        for (int h = 0; h < 2; ++h)
#pragma unroll
            for (int i = 0; i < 2; ++i) vAc[h][i] = vAn[h][i];
        if (ALIGN_EPI) { if (wr == 1) PG8_BAR; }
    }
    PG8_WAIT_V(0);
    if (!ALIGN_EPI) { if (wr == 0) PG8_BAR; }
    PG8_BAR;
#undef PG8_SA
#undef PG8_SB
#undef PG8_STAGE
#undef PG8_LDA
#undef PG8_LDB
#undef PG8_MMA
#undef PG8_WAIT_V
#undef PG8_WAIT_L
#undef PG8_BAR
#undef PG8_SCHED
}
__device__ __forceinline__ void plain_voffA(int K, unsigned (&vA)[2][2], int tid_l) {
#pragma unroll
    for (int i = 0; i < 2; ++i) { int R, C; stage_rc(tid_l * 16 + i * 8192, R, C); vA[0][i] = (unsigned)(R * K + C) * 2u; vA[1][i] = (unsigned)((R + HALF) * K + C) * 2u; }
}
}


__device__ __forceinline__ int xcd_vbid(int bid, int nb) { return (nb & 7) ? bid : (bid & 7) * (nb >> 3) + (bid >> 3); }
struct SchedIn { const MK* p; int bid, nb, tid_l;
    __device__ __forceinline__ bool next(int i, pg8::GUnit& u, unsigned (&vA)[2][2]) const {
        const int tile = xcd_vbid(bid, nb) + i * nb; if (tile >= (NR / 256) * 12) return false;
        const int pm = tile / 12, pn = tile % 12;
        u.A = (const char*)(p->H() + (size_t)(pm * 256) * D); u.B = (const char*)(p->w_inT() + (size_t)(pn * 256) * D); u.i0 = pm; u.i1 = pn; u.i2 = 0; u.i3 = 0;
        pg8::plain_voffA(D, vA, tid_l); return true; } };
struct EpiIn { static constexpr bool PERM = false; const MK* p;
    __device__ __forceinline__ void operator()(f32x4 (&acc)[2][2][4][2], const pg8::GUnit& u, int wr, int wc, int fr_in, int fq_in) const {
        int fr = fr_in, fq = fq_in; asm volatile("" : "+v"(fr), "+v"(fq));
        const int pm = u.i0, seg = u.i1, brow = pm * 256;
        const int b = brow / RB, i0 = brow % RB;
        const bool lat = i0 >= CTX;
        const int wid = wr * 4 + wc, lane = fq * 16 + fr;
        if (lat && (seg <= 3 || seg == 6 || seg == 7)) {
#pragma unroll
            for (int ai = 0; ai < 2; ++ai)
#pragma unroll
                for (int m = 0; m < 4; ++m) {
                    const int t = i0 + ai * 128 + wr * 64 + m * 16 + fr - CTX, pos = (wc & 1) ? (t & 63) : (t >> 6);
                    const f32x4 cc = *(const f32x4*)(p->ropec() + pos * 16 + fq * 4), ss = *(const f32x4*)(p->ropes() + pos * 16 + fq * 4);
#pragma unroll
                    for (int bj = 0; bj < 2; ++bj) { const f32x4 x1 = acc[ai][bj][m][0], x2 = acc[ai][bj][m][1];
                        acc[ai][bj][m][0] = x1 * cc - x2 * ss; acc[ai][bj][m][1] = x1 * ss + x2 * cc; }
                }
        }
        if (seg == 7 || seg <= 1) {
            const float sc_ = seg == 7 ? 0.125f : 0.125f * 1.4426950408889634f;
#pragma unroll
            for (int ai = 0; ai < 2; ++ai)
#pragma unroll
                for (int bj = 0; bj < 2; ++bj)
#pragma unroll
                    for (int m = 0; m < 4; ++m) { acc[ai][bj][m][0] = acc[ai][bj][m][0] * sc_; acc[ai][bj][m][1] = acc[ai][bj][m][1] * sc_; }
        }
        if (seg <= 7 || seg >= 10) {
#pragma unroll
            for (int bj = 0; bj < 2; ++bj) {
                bf16_t* base; long rstride; bool ok = true;
                if (seg <= 1)      { const int h = (seg & 1) * 2 + bj;       base = p->Q() + (((size_t)(b * 4 + h) * SEQ + (i0 - CTX)) * 128 + wc * 32 + fq * 4); rstride = 128; ok = lat; }
                else if (seg <= 3) { const int h = (seg - 2) * 2 + bj;       base = p->K() + (((size_t)(b * 4 + h) * RB + i0) * 128 + wc * 32 + fq * 4);          rstride = 128; }
                else if (seg <= 5) { const int h = (seg - 4) * 2 + bj;       base = p->V() + (((size_t)(b * 4 + h) * RB + i0) * 128 + wc * 32 + fq * 4);          rstride = 128; }
                else if (seg == 6) { const int h = bj * 2 + (wc >> 1);       base = p->RQ() + (((size_t)(b * 4 + h) * RB + i0) * 64 + (wc & 1) * 32 + fq * 4);    rstride = 64; }
                else if (seg == 7) { const int h = bj * 2 + (wc >> 1);       base = p->RK() + (((size_t)(b * 4 + h) * RB + i0) * 64 + (wc & 1) * 32 + fq * 4);    rstride = 64; }
                else               {                                         base = p->RG() + ((size_t)(b * SEQ + (i0 - CTX)) * 512 + (seg - 10) * 256 + bj * 128 + wc * 32 + fq * 4); rstride = 512; ok = lat; }
                if (ok) {
#pragma unroll
                    for (int ai = 0; ai < 2; ++ai)
#pragma unroll
                        for (int m = 0; m < 4; ++m) { bf16_t* rp = base + (long)(ai * 128 + wr * 64 + m * 16 + fr) * rstride;
#pragma unroll
                            for (int n = 0; n < 2; ++n) { u32x2 w; w.x = cvtpk(acc[ai][bj][m][n][0], acc[ai][bj][m][n][1]); w.y = cvtpk(acc[ai][bj][m][n][2], acc[ai][bj][m][n][3]);
                                *(u32x2*)(rp + n * 16) = w; } }
                }
            }
        }
        if (seg >= 7 && seg <= 9) {
            char* img = smem + 131072 + wid * 3968;
            const int npass = seg == 7 ? 2 : 1;
#pragma unroll 1
            for (int ps = 0; ps < npass; ++ps) {
#pragma unroll
                for (int bj = 0; bj < 2; ++bj) {
                    float lg2 = 0.f; bf16_t* baseT;
                    if (seg == 7) { const int h = bj * 2 + (wc >> 1); const float dv = ps == 0 ? p->dec_f[h] : p->dec_b[h]; lg2 = log2f(1.0f / (1.0f + expf(-dv)));
                        baseT = (ps == 0 ? p->KTf() : p->KTb()) + ((size_t)(b * 4 + h) * 64 + (wc & 1) * 32) * RB + i0; }
                    else { const int h = (seg - 8) * 2 + bj; baseT = p->VT() + ((size_t)(b * 4 + h) * 128 + wc * 32) * RB + i0; }
#pragma unroll
                    for (int ai = 0; ai < 2; ++ai)
#pragma unroll
                        for (int mp = 0; mp < 2; ++mp) {
                            asm volatile("s_waitcnt lgkmcnt(0)" ::: "memory");
#pragma unroll
                            for (int mm = 0; mm < 2; ++mm) { const int m = mp * 2 + mm;
                                float f = 1.0f;
                                if (seg == 7) { const int pos = (i0 + ai * 128 + wr * 64 + m * 16 + fr) & 127; f = __builtin_amdgcn_exp2f((float)(ps == 0 ? 127 - pos : pos) * lg2); }
#pragma unroll
                                for (int n = 0; n < 2; ++n)
#pragma unroll
                                    for (int j = 0; j < 4; ++j) *(bf16_t*)(img + (n * 16 + fq * 4 + j) * 80 + (mm * 16 + fr) * 2) = f2bf(acc[ai][bj][m][n][j] * f); }
                            asm volatile("s_waitcnt lgkmcnt(0)" ::: "memory");
                            const int ib = ai * 128 + wr * 64 + mp * 32;
#pragma unroll
                            for (int k = 0; k < 2; ++k) { const int q = lane + 64 * k, col = q >> 2, ch = q & 3;
                                *(u32x4*)(baseT + (size_t)col * RB + ib + ch * 8) = *(const u32x4*)(img + col * 80 + ch * 16); }
                        }
                }
            }
        }
    } };
__device__ __forceinline__ void ph_gemm_in(const MK& p, int bid, int nb, int tid_l) {
    SchedIn S{&p, bid, nb, tid_l}; EpiIn E{&p};
    pg8::gemm<EpiIn, SchedIn, false, true>(D, S, E, tid_l);
}

struct SchedOut { const MK* p; int bid, nb, tid_l;
    __device__ __forceinline__ bool next(int i, pg8::GUnit& u, unsigned (&vA)[2][2]) const {
        const int tile = xcd_vbid(bid, nb) + i * nb; if (tile >= (T / 256) * 4) return false;
        const int pm = tile >> 2, pn = tile & 3;
        u.A = (const char*)(p->MIX() + (size_t)(pm * 256) * D); u.B = (const char*)(p->w_outT() + (size_t)(pn * 256) * D); u.i0 = pm; u.i1 = pn; u.i2 = 0; u.i3 = 0;
        pg8::plain_voffA(D, vA, tid_l); return true; } };
struct EpiOut { static constexpr bool PERM = true; const MK* p;
    __device__ __forceinline__ void operator()(const f32x4 (&acc)[2][2][4][2], const pg8::GUnit& u, int wr, int wc, int fr, int fq) const {
        const int brow = u.i0 * 256, bcol = u.i1 * 256 + wc * 32 + fq * 8;
        const float* g1 = p->mod() + (size_t)(brow / SEQ) * 6 * D + 2 * D + bcol;
        f32x4 gv[2][2];
#pragma unroll
        for (int bj = 0; bj < 2; ++bj)
#pragma unroll
            for (int n = 0; n < 2; ++n) gv[bj][n] = *(const f32x4*)(g1 + bj * 128 + n * 4);
#pragma unroll
        for (int ai = 0; ai < 2; ++ai)
#pragma unroll
            for (int m = 0; m < 4; ++m) {
                const int row = brow + ai * 128 + wr * 64 + m * 16 + fr;
                const float* xp = p->x + (size_t)row * D + bcol;
                f32x4 xv[2][2];
#pragma unroll
                for (int bj = 0; bj < 2; ++bj)
#pragma unroll
                    for (int n = 0; n < 2; ++n) xv[bj][n] = *(const f32x4*)(xp + bj * 128 + n * 4);
#pragma unroll
                for (int bj = 0; bj < 2; ++bj) {
                    const f32x4 a = xv[bj][0] + gv[bj][0] * acc[ai][bj][m][0], b = xv[bj][1] + gv[bj][1] * acc[ai][bj][m][1];
                    const u32x4 w = {cvtpk(a[0], a[1]), cvtpk(a[2], a[3]), cvtpk(b[0], b[1]), cvtpk(b[2], b[3])};
                    *(u32x4*)(p->X1() + (size_t)row * 2048 + bcol + bj * 128) = w;
                }
                if (m & 1) asm volatile("" ::: "memory");
            }
    } };
__device__ __forceinline__ void ph_gemm_out(const MK& p, int bid, int nb, int tid_l) {
    SchedOut S{&p, bid, nb, tid_l}; EpiOut E{&p};
    pg8::gemm<EpiOut, SchedOut, false, true>(D, S, E, tid_l);
}

template <bool DUMMY, int MODE = 0> __device__ __forceinline__ void ph_route(const MK& p, int bid, int nb, int tid_l) {
    int* cntp = p.cnt() + (DUMMY ? 128 : 0); int* tl = DUMMY ? (int*)(p.ws + 480 * MiB) : p.tok_list(); float* wl_ = DUMMY ? (float*)(p.ws + 488 * MiB) : p.wt_list(); int* tm = DUMMY ? (int*)(p.ws + 496 * MiB) : p.tokmap();
    const int tid = tid_l, wid = tid >> 6, lane = tid & 63, fr = lane & 15, fq = lane >> 4;
    float* lg = (float*)smem;
    int* wcnt = (int*)(smem + 34816);
    int* pref = wcnt + 512;
    bf16_t* H2lo = (bf16_t*)(p.ws + 325 * MiB);
    for (int item = bid; item < T / 128; item += nb) {
        const int t0 = item * 128 + wid * 16, b = (item * 128) / SEQ;
        const float* msh = p.mod() + (size_t)b * 6 * D + 3 * D; const float* msc = p.mod() + (size_t)b * 6 * D + 4 * D;
#pragma unroll 1
        for (int r0 = 0; r0 < 16; r0 += 4) {
            float4 xv[4][4];
#pragma unroll
            for (int rr = 0; rr < 4; ++rr)
#pragma unroll
                for (int q = 0; q < 4; ++q) { const u32x2 w = *(const u32x2*)(p.X1() + (size_t)(t0 + r0 + rr) * 2048 + q * 256 + lane * 4);
                    xv[rr][q] = make_float4(__uint_as_float(w.x << 16), __uint_as_float(w.x & 0xffff0000u), __uint_as_float(w.y << 16), __uint_as_float(w.y & 0xffff0000u)); }
#pragma unroll
            for (int rr = 0; rr < 4; ++rr) {
                float ss = 0.f;
#pragma unroll
                for (int q = 0; q < 4; ++q) ss += xv[rr][q].x * xv[rr][q].x + xv[rr][q].y * xv[rr][q].y + xv[rr][q].z * xv[rr][q].z + xv[rr][q].w * xv[rr][q].w;
                ss = wave_sum(ss);
                const float rstd = rsqrtf(ss * (1.0f / D) + EPS);
#pragma unroll
                for (int q = 0; q < 4; ++q) {
                    const int c0 = q * 256 + lane * 4;
                    const float4 gg = *(const float4*)(p.norm2_g + c0), sh = *(const float4*)(msh + c0), sc = *(const float4*)(msc + c0);
                    const float h0 = xv[rr][q].x * rstd * gg.x * (1 + sc.x) + sh.x, h1 = xv[rr][q].y * rstd * gg.y * (1 + sc.y) + sh.y;
                    const float h2v = xv[rr][q].z * rstd * gg.z * (1 + sc.z) + sh.z, h3 = xv[rr][q].w * rstd * gg.w * (1 + sc.w) + sh.w;
                    u32x2 wh, wl2; wh.x = cvtpk(h0, h1); wh.y = cvtpk(h2v, h3);
                    wl2.x = cvtpk(h0 - __uint_as_float(wh.x << 16), h1 - __uint_as_float(wh.x & 0xffff0000u));
                    wl2.y = cvtpk(h2v - __uint_as_float(wh.y << 16), h3 - __uint_as_float(wh.y & 0xffff0000u));
                    *(u32x2*)(p.H2() + (size_t)(t0 + r0 + rr) * D + c0) = wh;
                    *(u32x2*)(H2lo + (size_t)(t0 + r0 + rr) * D + c0) = wl2;
                }
            }
        }
        asm volatile("s_waitcnt vmcnt(0)" ::: "memory");
        __syncthreads();
        if (MODE == 3) continue;
        f32x4 acc[4];
#pragma unroll
        for (int nt = 0; nt < 4; ++nt) acc[nt] = (f32x4){0.f, 0.f, 0.f, 0.f};
        {
            const bf16_t* ah_p = p.H2() + (size_t)(t0 + fr) * D + fq * 8; const bf16_t* al_p = H2lo + (size_t)(t0 + fr) * D + fq * 8;
            const int widu = __builtin_amdgcn_readfirstlane(wid);
            unsigned rofs[4];
#pragma unroll
            for (int i = 0; i < 4; ++i) { const int x = wid * 1024 + i * 8192 + lane * 16, row = x >> 8, c = ((x & 255) >> 4) ^ (row & 15); rofs[i] = (unsigned)(row * 2048 + c * 16); }
#define RT_DMA(kc, buf) do { const char* src_ = (const char*)p.routerT() + (size_t)(kc) * 256;                                             \
            _Pragma("unroll") for (int i = 0; i < 4; ++i) __builtin_amdgcn_global_load_lds((const unsigned*)(src_ + rofs[i]), (unsigned*)(smem + 40960 + (buf) * 32768 + widu * 1024 + i * 8192), 16, 0, 0); } while (0)
            RT_DMA(0, 0);
#pragma unroll 1
            for (int kc = 0; kc < 8; ++kc) {
                bf16x8 ah[4], al[4];
#pragma unroll
                for (int ks = 0; ks < 4; ++ks) { ah[ks] = ldfrag(ah_p + kc * 128 + ks * 32); al[ks] = ldfrag(al_p + kc * 128 + ks * 32); }
                asm volatile("s_waitcnt vmcnt(0)" ::: "memory"); __syncthreads();
                if (kc + 1 < 8) RT_DMA(kc + 1, (kc + 1) & 1);
                const char* bb = smem + 40960 + (kc & 1) * 32768;
#pragma unroll
                for (int ks = 0; ks < 4; ++ks)
#pragma unroll
                    for (int nt = 0; nt < 4; ++nt) {
                        const int row = nt * 16 + fr, cc = ((ks * 4 + fq) ^ (row & 15)) * 16;
                        const bf16x8 bh = *(const bf16x8*)(bb + row * 256 + cc), bl = *(const bf16x8*)(bb + (64 + row) * 256 + cc);
                        acc[nt] = __builtin_amdgcn_mfma_f32_16x16x32_bf16(ah[ks], bh, acc[nt], 0, 0, 0);
                        acc[nt] = __builtin_amdgcn_mfma_f32_16x16x32_bf16(ah[ks], bl, acc[nt], 0, 0, 0);
                        acc[nt] = __builtin_amdgcn_mfma_f32_16x16x32_bf16(al[ks], bh, acc[nt], 0, 0, 0);
                    }
            }
#undef RT_DMA
        }
#pragma unroll
        for (int nt = 0; nt < 4; ++nt)
#pragma unroll
            for (int j = 0; j < 4; ++j) lg[(wid * 16 + fq * 4 + j) * 65 + nt * 16 + fr] = acc[nt][j];
        __syncthreads();
        if (MODE == 2) continue;
        int l3 = lane; asm volatile("" : "+v"(l3));
#define SHXF(v_, m_) __int_as_float(__builtin_amdgcn_ds_bpermute((l3 ^ (m_)) << 2, __float_as_int(v_)))
#define SHXI(v_, m_) __builtin_amdgcn_ds_bpermute((l3 ^ (m_)) << 2, (v_))
#define SHBF(v_, src_) __int_as_float(__builtin_amdgcn_ds_bpermute((src_) << 2, __float_as_int(v_)))
#define SHBI(v_, src_) __builtin_amdgcn_ds_bpermute((src_) << 2, (v_))
        const int q4 = l3 & 3, tt = wid * 16 + (l3 >> 2), t = item * 128 + tt, qbase = l3 & ~3;
        float sc_[16], v[16];
#pragma unroll
        for (int i = 0; i < 16; ++i) { const float x = lg[tt * 65 + q4 * 16 + i]; sc_[i] = __builtin_amdgcn_rcpf(1.0f + __builtin_amdgcn_exp2f(-1.4426950408889634f * x)); v[i] = sc_[i] + p.router_b[q4 * 16 + i]; }
        float gsA, gsB;
        { float m1 = v[0], m2 = -INFINITY;
#pragma unroll
          for (int i = 1; i < 8; ++i) { const float x = v[i]; m2 = fmaxf(m2, fminf(m1, x)); m1 = fmaxf(m1, x); }
          gsA = m1 + m2; m1 = v[8]; m2 = -INFINITY;
#pragma unroll
          for (int i = 9; i < 16; ++i) { const float x = v[i]; m2 = fmaxf(m2, fminf(m1, x)); m1 = fmaxf(m1, x); }
          gsB = m1 + m2; }
        { int rankA = 0, rankB = 0;
#pragma unroll
          for (int qq = 0; qq < 4; ++qq) {
              const float ga = SHBF(gsA, qbase | qq), gb = SHBF(gsB, qbase | qq);
              const int g0 = 2 * qq, g1 = 2 * qq + 1, mA = 2 * q4, mB = 2 * q4 + 1;
              rankA += (g0 != mA && (ga > gsA || (ga == gsA && g0 < mA))) ? 1 : 0; rankA += (g1 != mA && (gb > gsA || (gb == gsA && g1 < mA))) ? 1 : 0;
              rankB += (g0 != mB && (ga > gsB || (ga == gsB && g0 < mB))) ? 1 : 0; rankB += (g1 != mB && (gb > gsB || (gb == gsB && g1 < mB))) ? 1 : 0;
          }
          if (rankA >= 4) {
#pragma unroll
              for (int i = 0; i < 8; ++i) v[i] = -INFINITY; }
          if (rankB >= 4) {
#pragma unroll
              for (int i = 8; i < 16; ++i) v[i] = -INFINITY; } }
        unsigned chm = 0u;
#pragma unroll 1
        for (int it = 0; it < 8; ++it) {
            float lm = v[0];
#pragma unroll
            for (int i = 1; i < 16; ++i) lm = fmaxf(lm, v[i]);
            float gm = fmaxf(lm, SHXF(lm, 1)); gm = fmaxf(gm, SHXF(gm, 2));
            int cand = (lm == gm) ? q4 : 4;
            cand = min(cand, SHXI(cand, 1)); cand = min(cand, SHXI(cand, 2));
            const bool win = cand == q4;
            bool found = false;
#pragma unroll
            for (int i = 0; i < 16; ++i) { const bool hit = win && !found && v[i] == gm; if (hit) { chm |= (1u << i); v[i] = -INFINITY; } found = found || hit; }
        }
        float wsum = 0.f;
#pragma unroll
        for (int i = 0; i < 16; ++i) wsum += ((chm >> i) & 1u) ? sc_[i] : 0.f;
        wsum += SHXF(wsum, 1); wsum += SHXF(wsum, 2);
        const float wscale = 2.5f / wsum;
        const unsigned long long pat = 0x1111111111111111ull << q4;
#pragma unroll
        for (int i = 0; i < 16; ++i) { const unsigned long long bal = __ballot((chm >> i) & 1u); if (l3 < 4) wcnt[wid * 64 + l3 * 16 + i] = __popcll(bal & (0x1111111111111111ull << l3)); }
        __syncthreads();
        if (wid == 0) {
            int tot = 0;
#pragma unroll
            for (int w = 0; w < 8; ++w) tot += wcnt[w * 64 + lane];
            int run = atomicAdd(&cntp[lane], tot);
#pragma unroll
            for (int w = 0; w < 8; ++w) { const int c = wcnt[w * 64 + lane]; pref[w * 64 + lane] = run; run += c; }
        }
        __syncthreads();
        {
            const int pc = __popc(chm);
            int kbase = 0;
#pragma unroll
            for (int qq = 0; qq < 3; ++qq) { const int o = SHBI(pc, qbase | qq); kbase += (qq < q4) ? o : 0; }
#pragma unroll
            for (int i = 0; i < 16; ++i) {
                const bool c = (chm >> i) & 1u;
                const unsigned long long bal = __ballot(c);
                if (c) {
                    const int e = q4 * 16 + i;
                    const int slot = pref[wid * 64 + e] + __popcll(bal & pat & ((1ull << l3) - 1ull));
                    tl[(size_t)e * ECAP + slot] = t; wl_[(size_t)e * ECAP + slot] = sc_[i] * wscale;
                    tm[(size_t)t * 8 + kbase + __popc(chm & ((1u << i) - 1u))] = e * ECAP + slot;
                }
            }
        }
    }
}
#undef SHXF
#undef SHXI
#undef SHBF
#undef SHBI

constexpr int MOE_AUX = 162816;
__device__ __forceinline__ void moe_tables(const MK& p, int colt, int* tpre, int* rbase, int tid_l) {
    __syncthreads();
    if (tid_l == 0) { int tp = 0, rb = 0;
        for (int e = 0; e < 65; ++e) { const int c = e < 64 ? p.cnt()[e] : T; tpre[e] = tp; rbase[e] = rb; tp += ((c + 255) >> 8) * colt; rb += c; }
        tpre[65] = tp; rbase[65] = rb; }
    __syncthreads();
}
struct SchedUp { const MK* p; int bid, nb, tid_l, ntiles; const int* tpre; const int* rbase; mutable int e_hint;
    __device__ __forceinline__ bool next(int i, pg8::GUnit& u, unsigned (&vA)[2][2]) const {
        const int tile = xcd_vbid(bid, nb) + i * nb; if (tile >= ntiles) return false;
        int e = e_hint; while (tile >= tpre[e + 1]) ++e; e_hint = e;
        const int j = tile - tpre[e], rt = j >> 1, ct = j & 1, cnt_e = rbase[e + 1] - rbase[e];
        u.A = (const char*)p->H2(); u.B = (const char*)(p->W13t() + ((size_t)e * 512 + ct * 256) * D); u.i0 = e; u.i1 = rt; u.i2 = ct; u.i3 = cnt_e;
#pragma unroll
        for (int i2 = 0; i2 < 2; ++i2) { int R, C; stage_rc(tid_l * 16 + i2 * 8192, R, C);
#pragma unroll
            for (int h = 0; h < 2; ++h) { int slot = rt * 256 + h * 128 + R; if (slot >= cnt_e) slot = 0;
                const int tok = e < 64 ? p->tok_list()[(size_t)e * ECAP + slot] : slot;
                vA[h][i2] = (unsigned)tok * (D * 2u) + (unsigned)C * 2u; } }
        return true; } };
template <bool NOSTORE = false> struct EpiUpT { static constexpr bool PERM = true; const MK* p; const int* rbase;
    __device__ __forceinline__ void operator()(const f32x4 (&acc)[2][2][4][2], const pg8::GUnit& u, int wr, int wc, int fr, int fq) const {
        const int e = u.i0, rt = u.i1, ct = u.i2, cnt_e = u.i3;
        bf16_t* ab = p->ACT() + (size_t)rbase[e] * DE + ct * 128 + wc * 32 + fq * 8;
#pragma unroll
        for (int ai = 0; ai < 2; ++ai)
#pragma unroll
            for (int m = 0; m < 4; ++m) {
                const int slot = rt * 256 + ai * 128 + wr * 64 + m * 16 + fr;
                u32x4 w;
                w.x = cvtpk(silu_fast(acc[ai][0][m][0][0]) * acc[ai][1][m][0][0], silu_fast(acc[ai][0][m][0][1]) * acc[ai][1][m][0][1]);
                w.y = cvtpk(silu_fast(acc[ai][0][m][0][2]) * acc[ai][1][m][0][2], silu_fast(acc[ai][0][m][0][3]) * acc[ai][1][m][0][3]);
                w.z = cvtpk(silu_fast(acc[ai][0][m][1][0]) * acc[ai][1][m][1][0], silu_fast(acc[ai][0][m][1][1]) * acc[ai][1][m][1][1]);
                w.w = cvtpk(silu_fast(acc[ai][0][m][1][2]) * acc[ai][1][m][1][2], silu_fast(acc[ai][0][m][1][3]) * acc[ai][1][m][1][3]);
                if (NOSTORE) { if (slot < -cnt_e) *(u32x4*)(ab + (size_t)slot * DE) = w; } else if (slot < cnt_e) *(u32x4*)(ab + (size_t)slot * DE) = w;
            }
    } };
__device__ __forceinline__ void ph_moe_up(const MK& p, int bid, int nb, int tid_l) {
    int* tpre = (int*)(smem + MOE_AUX); int* rbase = tpre + 80;
    moe_tables(p, 2, tpre, rbase, tid_l);
    SchedUp S{&p, bid, nb, tid_l, tpre[65], tpre, rbase, 0}; EpiUpT<false> E{&p, rbase};
    pg8::gemm<EpiUpT<false>, SchedUp, true, true>(D, S, E, tid_l);
}
constexpr float Y_SCALE = 64.0f;
struct SchedDown { const MK* p; int bid, nb, tid_l, ntiles; const int* tpre; const int* rbase; mutable int e_hint;
    __device__ __forceinline__ bool next(int i, pg8::GUnit& u, unsigned (&vA)[2][2]) const {
        const int tile = xcd_vbid(bid, nb) + i * nb; if (tile >= ntiles) return false;
        int e = e_hint; while (tile >= tpre[e + 1]) ++e; e_hint = e;
        const int j = tile - tpre[e], rt = j >> 2, ct = j & 3, cnt_e = rbase[e + 1] - rbase[e];
        u.A = (const char*)(p->ACT() + (size_t)(rbase[e] + rt * 256) * DE); u.B = (const char*)(p->W2t() + ((size_t)e * D + ct * 256) * DE); u.i0 = e; u.i1 = rt; u.i2 = ct; u.i3 = cnt_e;
        pg8::plain_voffA(DE, vA, tid_l); return true; } };
template <int MODE> struct EpiDown { static constexpr bool PERM = true; const MK* p; const int* rbase;
    __device__ __forceinline__ void operator()(const f32x4 (&acc)[2][2][4][2], const pg8::GUnit& u, int wr, int wc, int fr, int fq) const {
        const int e = u.i0, rt = u.i1, ct = u.i2, cnt_e = u.i3;
        {
            const float* wl = p->wt_list() + (size_t)(e < 64 ? e : 0) * ECAP;
            float wv[2][4];
#pragma unroll
            for (int ai = 0; ai < 2; ++ai)
#pragma unroll
                for (int m = 0; m < 4; ++m) { const int sl = rt * 256 + ai * 128 + wr * 64 + m * 16 + fr; wv[ai][m] = e < 64 ? wl[sl < cnt_e ? sl : 0] * Y_SCALE : Y_SCALE; }
            const int wid = wr * 4 + wc, lane = fq * 16 + fr;
            char* wa = smem + 131072 + wid * 3968;
            unsigned char* yb = p->Y() + (size_t)rbase[e] * D + ct * 256 + wc * 64 + (lane & 3) * 16;
#pragma unroll
            for (int ai = 0; ai < 2; ++ai)
#pragma unroll
                for (int m = 0; m < 4; ++m) {
                    const float w = wv[ai][m];
                    char* img = wa + ((m & 1) ? 1280 : 0);
#pragma unroll
                    for (int bj = 0; bj < 2; ++bj) {
                        u32x2 pk;
#pragma unroll
                        for (int n = 0; n < 2; ++n) {
                            float v0 = __builtin_amdgcn_fmed3f(acc[ai][bj][m][n][0] * w, -448.f, 448.f), v1 = __builtin_amdgcn_fmed3f(acc[ai][bj][m][n][1] * w, -448.f, 448.f);
                            float v2 = __builtin_amdgcn_fmed3f(acc[ai][bj][m][n][2] * w, -448.f, 448.f), v3 = __builtin_amdgcn_fmed3f(acc[ai][bj][m][n][3] * w, -448.f, 448.f);
                            int q = 0; q = __builtin_amdgcn_cvt_pk_fp8_f32(v0, v1, q, false); q = __builtin_amdgcn_cvt_pk_fp8_f32(v2, v3, q, true);
                            if (n == 0) pk.x = (unsigned)q; else pk.y = (unsigned)q;
                        }
                        *(u32x2*)(img + fr * 80 + bj * 32 + fq * 8) = pk;
                    }
                    asm volatile("s_waitcnt lgkmcnt(0)" ::: "memory");
                    const int rr = lane >> 2, slot = rt * 256 + ai * 128 + wr * 64 + m * 16 + rr;
                    const u32x4 v = *(const u32x4*)(img + rr * 80 + (lane & 3) * 16);
                    if (MODE == 1) asm volatile("" :: "v"(v)); else if (slot < cnt_e) *(u32x4*)(yb + (size_t)slot * D) = v;
                }
        }
    } };
template <bool DUMMY, int MODE = 0> __device__ __forceinline__ void ph_moe_down(const MK& p, int bid, int nb, int tid_l) {
    int* tpre = (int*)(smem + MOE_AUX); int* rbase = tpre + 80;
    moe_tables(p, 4, tpre, rbase, tid_l);
    SchedDown S{&p, bid, nb, tid_l, DUMMY ? tpre[64] : tpre[65], tpre, rbase, 0}; EpiDown<MODE> E{&p, rbase};
    pg8::gemm<EpiDown<MODE>, SchedDown, false, true>(DE, S, E, tid_l);
}

#if DUP >= 21 && DUP <= 29
template <bool PERM_> struct EpiNull { static constexpr bool PERM = PERM_;
    __device__ __forceinline__ void operator()(const f32x4 (&acc)[2][2][4][2], const pg8::GUnit& u, int wr, int wc, int fr, int fq) const {
#pragma unroll
        for (int a = 0; a < 2; ++a)
#pragma unroll
            for (int b = 0; b < 2; ++b)
#pragma unroll
                for (int m = 0; m < 4; ++m) { asm volatile("" :: "v"(acc[a][b][m][0]), "v"(acc[a][b][m][1])); }
    } };
__device__ __forceinline__ void ph_probe_in(const MK& p, int bid, int nb, int tid_l) { SchedIn S{&p, bid, nb, tid_l}; EpiNull<false> E; pg8::gemm<EpiNull<false>, SchedIn, false, true>(D, S, E, tid_l); }
__device__ __forceinline__ void ph_probe_out(const MK& p, int bid, int nb, int tid_l) { SchedOut S{&p, bid, nb, tid_l}; EpiNull<true> E; pg8::gemm<EpiNull<true>, SchedOut, false, true>(D, S, E, tid_l); }
__device__ __forceinline__ void ph_probe_up(const MK& p, int bid, int nb, int tid_l) {
    int* tpre = (int*)(smem + MOE_AUX); int* rbase = tpre + 80; moe_tables(p, 2, tpre, rbase, tid_l);
    SchedUp S{&p, bid, nb, tid_l, tpre[65], tpre, rbase, 0}; EpiNull<true> E; pg8::gemm<EpiNull<true>, SchedUp, true, true>(D, S, E, tid_l); }
__device__ __forceinline__ void ph_probe_up_nostore(const MK& p, int bid, int nb, int tid_l) {
    int* tpre = (int*)(smem + MOE_AUX); int* rbase = tpre + 80; moe_tables(p, 2, tpre, rbase, tid_l);
    SchedUp S{&p, bid, nb, tid_l, tpre[65], tpre, rbase, 0}; EpiUpT<true> E{&p, rbase}; pg8::gemm<EpiUpT<true>, SchedUp, true, true>(D, S, E, tid_l); }
__device__ __forceinline__ void ph_probe_down(const MK& p, int bid, int nb, int tid_l) {
    int* tpre = (int*)(smem + MOE_AUX); int* rbase = tpre + 80; moe_tables(p, 4, tpre, rbase, tid_l);
    SchedDown S{&p, bid, nb, tid_l, tpre[65], tpre, rbase, 0}; EpiNull<true> E; pg8::gemm<EpiNull<true>, SchedDown, false, true>(DE, S, E, tid_l); }
#endif
template <bool DUMMY> __device__ __forceinline__ void ph_final(const MK& p, int bid, int nb, int tid_l) {
    const int wid = tid_l >> 6, lane = tid_l & 63;
    int* tpre = (int*)(smem + MOE_AUX); int* rbase = tpre + 80;
    moe_tables(p, 1, tpre, rbase, tid_l);
    for (int t = bid * 8 + wid; t < T; t += nb * 8) {
        const int b = t / SEQ;
        float f[16];
#pragma unroll
        for (int i = 0; i < 16; ++i) f[i] = 0.f;
#pragma unroll
        for (int k = 0; k < 9; ++k) {
            int row;
            if (k < 8) { const int id = p.tokmap()[(size_t)t * 8 + k], e = id >> 15, slot = id & (ECAP - 1); row = rbase[e] + slot; } else row = rbase[64] + t;
            const unsigned char* yr = p.Y() + (size_t)row * D + lane * 4;
#pragma unroll
            for (int q = 0; q < 4; ++q) {
                const int w = *(const int*)(yr + q * 256);
                const auto lo = __builtin_amdgcn_cvt_pk_f32_fp8(w, false); const auto hi = __builtin_amdgcn_cvt_pk_f32_fp8(w, true);
                f[q * 4 + 0] += lo[0]; f[q * 4 + 1] += lo[1]; f[q * 4 + 2] += hi[0]; f[q * 4 + 3] += hi[1];
            }
        }
        const int pcol = ((lane >> 3) & 1) * 128 + (lane >> 4) * 32 + (lane & 7) * 4;
        const float* g2 = p.mod() + (size_t)b * 6 * D + 5 * D + pcol;
        const bf16_t* x1 = p.X1() + (size_t)t * 2048 + pcol;
        float* xo = p.out + (size_t)t * D + pcol;
        float v[16]; float ss = 0.f;
#pragma unroll
        for (int q = 0; q < 4; ++q) {
            const u32x2 xw = *(const u32x2*)(x1 + q * 256); const float4 g = *(const float4*)(g2 + q * 256);
            v[q * 4 + 0] = __uint_as_float(xw.x << 16) + g.x * f[q * 4 + 0] * (1.0f / Y_SCALE); v[q * 4 + 1] = __uint_as_float(xw.x & 0xffff0000u) + g.y * f[q * 4 + 1] * (1.0f / Y_SCALE);
            v[q * 4 + 2] = __uint_as_float(xw.y << 16) + g.z * f[q * 4 + 2] * (1.0f / Y_SCALE); v[q * 4 + 3] = __uint_as_float(xw.y & 0xffff0000u) + g.w * f[q * 4 + 3] * (1.0f / Y_SCALE);
            ss += v[q * 4] * v[q * 4] + v[q * 4 + 1] * v[q * 4 + 1] + v[q * 4 + 2] * v[q * 4 + 2] + v[q * 4 + 3] * v[q * 4 + 3];
        }
        ss = wave_sum(ss);
        const float rstd = rsqrtf(ss * (1.0f / D) + EPS);
#pragma unroll
        for (int q = 0; q < 4; ++q) {
            const float4 gf = *(const float4*)(p.final_g + q * 256 + pcol);
            *(float4*)((DUMMY ? (float*)(p.ws + 42 * MiB) + (size_t)t * D + pcol : xo) + q * 256) = make_float4(v[q * 4] * rstd * gf.x, v[q * 4 + 1] * rstd * gf.y, v[q * 4 + 2] * rstd * gf.z, v[q * 4 + 3] * rstd * gf.w);
        }
    }
}


#define XB_TMO      128
#define XB_XCNT(j)  (256  + 64 * (j))
#define XB_XSUB(j)  (1280 + 64 * (j))
#define XB_XGEN(j)  (2304 + 64 * (j))
#define XB_TOP      3328
#define XB_TOPGEN   3392
#define XCD_BAR_WORDS 3456
#define XB_SPIN_CAP (1u << 22)
#define LAS __attribute__((address_space(3)))
__device__ __forceinline__ unsigned xb_ld(unsigned* p)              { return __hip_atomic_load(p, __ATOMIC_RELAXED, __HIP_MEMORY_SCOPE_AGENT); }
__device__ __forceinline__ unsigned xb_add(unsigned* p, unsigned v) { return __hip_atomic_fetch_add(p, v, __ATOMIC_RELAXED, __HIP_MEMORY_SCOPE_AGENT); }
__device__ __forceinline__ unsigned xb_xcc_id() { return (unsigned)__builtin_amdgcn_s_getreg((3 << 11) | 20) & 0xFu; }
#define XB_SPIN(cond, bar) do { unsigned _sp = 0; while (cond) { __builtin_amdgcn_s_sleep(1); \
    if ((++_sp & 255u) == 0u) { if (xb_ld(&(bar)[XB_TMO])) break; if (_sp > XB_SPIN_CAP) { atomicAdd(&(bar)[XB_TMO], 1u); break; } } } } while (0)
struct XcdBarrier { unsigned* bar; unsigned x; volatile LAS unsigned* st; };
__device__ __forceinline__ XcdBarrier xcd_barrier_post(unsigned* bar, volatile LAS unsigned* st, int tid) {
    XcdBarrier b; b.bar = bar; b.x = xb_xcc_id(); b.st = st;
    if (tid == 0) (void)xb_add(&bar[XB_XCNT(b.x)], 1u);
    return b;
}
__device__ __forceinline__ void xcd_barrier_complete(unsigned* bar, unsigned x, unsigned& nloc, unsigned& nx) {
    const unsigned G = gridDim.x * gridDim.y * gridDim.z;
    unsigned sum, cnt, mine, sp = 0u;
    for (;;) {
        sum = 0u; cnt = 0u; mine = 0u;
#pragma unroll
        for (unsigned j = 0; j < 16; ++j) { const unsigned c = xb_ld(&bar[XB_XCNT(j)]); sum += c; cnt += (c > 0u) ? 1u : 0u; mine = (j == x) ? c : mine; }
        if (sum == G) break;
        __builtin_amdgcn_s_sleep(1);
        if ((++sp & 255u) == 0u) { if (xb_ld(&bar[XB_TMO])) break; if (sp > XB_SPIN_CAP) { atomicAdd(&bar[XB_TMO], 1u); break; } }
    }
    nloc = mine > 0u ? mine : 1u; nx = cnt > 0u ? cnt : 1u;
}
__device__ __forceinline__ void xcd_barrier(const XcdBarrier& b, int tid) {
    asm volatile("s_waitcnt vmcnt(0)" ::: "memory");
    __syncthreads();
    if (tid == 0) {
        unsigned* bar = b.bar;
        __builtin_amdgcn_s_waitcnt(0);
        unsigned nloc = b.st[0], nx = b.st[1];
        if (nloc == 0u) { xcd_barrier_complete(bar, b.x, nloc, nx); b.st[0] = nloc; b.st[1] = nx; }
        const unsigned old = xb_add(&bar[XB_XSUB(b.x)], 1u);
        const unsigned gen = old / nloc;
        if (old + 1u == (gen + 1u) * nloc) {
            __builtin_amdgcn_fence(__ATOMIC_RELEASE, "agent");
            asm volatile("s_waitcnt vmcnt(0)" ::: "memory");
            const unsigned og = xb_add(&bar[XB_TOP], 1u);
            const unsigned tg = og / nx;
            if (og + 1u == (tg + 1u) * nx) xb_add(&bar[XB_TOPGEN], 1u);
            else XB_SPIN(xb_ld(&bar[XB_TOPGEN]) == tg, bar);
            __builtin_amdgcn_fence(__ATOMIC_ACQUIRE, "agent");
            xb_add(&bar[XB_XGEN(b.x)], 1u);
            asm volatile("s_waitcnt vmcnt(0)" ::: "memory");
        } else {
            XB_SPIN(xb_ld(&bar[XB_XGEN(b.x)]) == gen, bar);
            __builtin_amdgcn_fence(__ATOMIC_ACQUIRE, "agent");
            asm volatile("s_waitcnt vmcnt(0)" ::: "memory");
        }
    }
    __syncthreads();
}

__device__ __forceinline__ int lane_id_volatile() { int l; asm volatile("v_mbcnt_lo_u32_b32 %0, -1, 0\n\tv_mbcnt_hi_u32_b32 %0, -1, %0" : "=v"(l)); return l; }
__global__ __launch_bounds__(512, 2) void k_mega(MK p) {
    cg::grid_group grid = cg::this_grid();
    const int bid = blockIdx.x, nb = gridDim.x;
    volatile LAS unsigned* xst = (volatile LAS unsigned*)(smem + 162816 + 768);
    if (threadIdx.x < 4) xst[threadIdx.x] = 0u;
    __syncthreads();
    const XcdBarrier xb = xcd_barrier_post((unsigned*)(p.ws + 524288), xst, (int)threadIdx.x);
    const int wv_ = __builtin_amdgcn_readfirstlane((int)threadIdx.x >> 6);
#define LANE_ID() lane_id_volatile()
#define PH_TID() int t_ = wv_ * 64 + LANE_ID(); asm volatile("" : "+v"(t_))
    { PH_TID(); if (bid == 0 && t_ < 256) p.cnt()[t_] = 0; ph_mod(p, bid, nb, t_); ph_convert(p, bid, nb, t_); }
#if DUP == 10
    { PH_TID(); ph_convert(p, bid, nb, t_); }
#endif
#if DUP == 12
    { PH_TID(); ph_mod(p, bid, nb, t_); }
#endif
    grid.sync();
    { PH_TID(); ph_ln1(p, bid, nb, t_); }
#if DUP == 1
    { PH_TID(); ph_ln1(p, bid, nb, t_); }
#endif
    xcd_barrier(xb, wv_ * 64 + LANE_ID());
    { PH_TID(); ph_gemm_in(p, bid, nb, t_); }
    { PH_TID(); ph_convert_dyn(p, t_); }
#if DUP == 2
    { PH_TID(); ph_gemm_in(p, bid, nb, t_); }
#endif
#if DUP == 21
    { PH_TID(); ph_probe_in(p, bid, nb, t_); }
#endif
    xcd_barrier(xb, wv_ * 64 + LANE_ID());
    { PH_TID(); ph_attn<0>(p, bid, nb, t_); }
#if DUP == 3
    { PH_TID(); ph_attn<2>(p, bid, nb, t_); }
#endif
#if DUP == 31
    { PH_TID(); ph_attn<1>(p, bid, nb, t_); }
#endif
#if DUP == 33
    { PH_TID(); ph_attn<3>(p, bid, nb, t_); }
#endif
    { PH_TID(); ph_kv(p, bid, nb, t_); }
#if DUP == 11
    { PH_TID(); ph_kv(p, bid, nb, t_); }
#endif
    xcd_barrier(xb, wv_ * 64 + LANE_ID());
    { PH_TID(); ph_scan(p, bid, nb, t_); }
#if DUP == 4
    { PH_TID(); ph_scan(p, bid, nb, t_); }
#endif
    xcd_barrier(xb, wv_ * 64 + LANE_ID());
    { PH_TID(); ph_ret(p, bid, nb, t_); }
#if DUP == 5
    { PH_TID(); ph_ret(p, bid, nb, t_); }
#endif
    xcd_barrier(xb, wv_ * 64 + LANE_ID());
    { PH_TID(); ph_gemm_out(p, bid, nb, t_); }
#if DUP == 6
    { PH_TID(); ph_gemm_out(p, bid, nb, t_); }
#endif
#if DUP == 22
    { PH_TID(); ph_probe_out(p, bid, nb, t_); }
#endif
    xcd_barrier(xb, wv_ * 64 + LANE_ID());
#if DUP == 7
    { PH_TID(); ph_route<true>(p, bid, nb, t_); }
#endif
#if DUP == 72
    { PH_TID(); ph_route<true, 2>(p, bid, nb, t_); }
#endif
#if DUP == 73
    { PH_TID(); ph_route<true, 3>(p, bid, nb, t_); }
#endif
    { PH_TID(); ph_route<false>(p, bid, nb, t_); }
    xcd_barrier(xb, wv_ * 64 + LANE_ID());
    { PH_TID(); ph_moe_up(p, bid, nb, t_); }
#if DUP == 8
    { PH_TID(); ph_moe_up(p, bid, nb, t_); }
#endif
#if DUP == 23
    { PH_TID(); ph_probe_up(p, bid, nb, t_); }
#endif
#if DUP == 25
    { PH_TID(); ph_probe_up_nostore(p, bid, nb, t_); }
#endif
    xcd_barrier(xb, wv_ * 64 + LANE_ID());
#if DUP == 9
    { PH_TID(); ph_moe_down<true>(p, bid, nb, t_); }
#endif
#if DUP == 91
    { PH_TID(); ph_moe_down<true, 1>(p, bid, nb, t_); }
#endif
    { PH_TID(); ph_moe_down<false>(p, bid, nb, t_); }
#if DUP == 24
    { PH_TID(); ph_probe_down(p, bid, nb, t_); }
#endif
    xcd_barrier(xb, wv_ * 64 + LANE_ID());
#if DUP == 13
    { PH_TID(); ph_final<true>(p, bid, nb, t_); }
#endif
    { PH_TID(); ph_final<false>(p, bid, nb, t_); }
#undef PH_TID
#undef LANE_ID
}
constexpr int LDS_TOTAL = 163840;
extern "C" void kernel_launch(void* const* d_in, const int* in_sizes, int n_in, void* d_out, int out_size, void* d_ws, size_t ws_size, hipStream_t stream) {
    char* ws = (char*)d_ws;
    MK mk{};
    mk.x = (const float*)d_in[0]; mk.c = (const float*)d_in[1]; mk.ctx = (const float*)d_in[2]; mk.cctx = (const float*)d_in[3]; mk.ada_w = (const float*)d_in[4]; mk.ada_b = (const float*)d_in[5];
    mk.norm1_g = (const float*)d_in[6]; mk.w_in = (const float*)d_in[7]; mk.lq1 = (const float*)d_in[8]; mk.lk1 = (const float*)d_in[9]; mk.lq2 = (const float*)d_in[10]; mk.lk2 = (const float*)d_in[11];
    mk.dattn_g = (const float*)d_in[12]; mk.dec_f = (const float*)d_in[13]; mk.dec_b = (const float*)d_in[14]; mk.ret_g = (const float*)d_in[15]; mk.w_out = (const float*)d_in[16];
    mk.norm2_g = (const float*)d_in[17]; mk.router_w = (const float*)d_in[18]; mk.router_b = (const float*)d_in[19]; mk.ew1 = (const float*)d_in[20]; mk.ew3 = (const float*)d_in[21];
    mk.ew2 = (const float*)d_in[22]; mk.sw1 = (const float*)d_in[23]; mk.sw3 = (const float*)d_in[24]; mk.sw2 = (const float*)d_in[25]; mk.final_g = (const float*)d_in[26];
    mk.out = (float*)d_out;
    mk.ws = ws;
    mk.dbgP = nullptr; mk.dbg_lo = 0; mk.dbg_hi = 12; mk.conv_limit = 1 << 30;
    static int grid_blocks = 0;
    if (!grid_blocks) {
        (void)hipFuncSetAttribute((const void*)k_mega, hipFuncAttributeMaxDynamicSharedMemorySize, LDS_TOTAL);
        int dev = 0, cus = 0, per_cu = 0;
        (void)hipGetDevice(&dev);
        (void)hipDeviceGetAttribute(&cus, hipDeviceAttributeMultiprocessorCount, dev);
        (void)hipOccupancyMaxActiveBlocksPerMultiprocessor(&per_cu, k_mega, 512, LDS_TOTAL);
        if (per_cu > 1) per_cu = 1;
        grid_blocks = cus * per_cu;
        if (grid_blocks <= 0) { fprintf(stderr, "occupancy query failed: cus %d per_cu %d\n", cus, per_cu); grid_blocks = 256; }
    }
    (void)hipMemsetAsync(ws + 524288, 0, XCD_BAR_WORDS * 4, stream);
    void* args[] = {&mk};
    hipError_t e = hipLaunchCooperativeKernel((void*)k_mega, dim3(grid_blocks), dim3(512), args, LDS_TOTAL, stream);
    if (e != hipSuccess) fprintf(stderr, "cooperative launch failed: %s (grid %d)\n", hipGetErrorString(e), grid_blocks);
}
```

```cpp
#include <hip/hip_runtime.h>
#include <hip/hip_cooperative_groups.h>
#include <cstdio>
namespace cg = cooperative_groups;
#ifndef DUP
#define DUP 0
#endif
#include <stdint.h>

constexpr int D = 1024, NB = 4, SEQ = 8192, CTX = 256, RB = SEQ + CTX  , NR = NB * RB  , T = NB * SEQ;
constexpr int NE = 64, DE = 256, ECAP = 32768;
constexpr float EPS = 1e-6f;
typedef unsigned short bf16_t;

__device__ __forceinline__ float siluf(float v) { return v / (1.0f + expf(-v)); }
__device__ __forceinline__ float silu_fast(float v) { return v * __builtin_amdgcn_rcpf(1.0f + __builtin_amdgcn_exp2f(-1.4426950408889634f * v)); }
__device__ __forceinline__ float wave_sum(float v) {
#pragma unroll
    for (int o = 32; o > 0; o >>= 1) v += __shfl_xor(v, o);
    return v;
}
__device__ __forceinline__ float wave_max(float v) {
#pragma unroll
    for (int o = 32; o > 0; o >>= 1) v = fmaxf(v, __shfl_xor(v, o));
    return v;
}
__device__ __forceinline__ float block_sum(float v, float* red) {
    v = wave_sum(v);
    __syncthreads();
    if ((threadIdx.x & 63) == 0) red[threadIdx.x >> 6] = v;
    __syncthreads();
    return red[0] + red[1] + red[2] + red[3];
}
__device__ __forceinline__ float block_max(float v, float* red) {
    v = wave_max(v);
    __syncthreads();
    if ((threadIdx.x & 63) == 0) red[threadIdx.x >> 6] = v;
    __syncthreads();
    return fmaxf(fmaxf(red[0], red[1]), fmaxf(red[2], red[3]));
}

typedef short bf16x8 __attribute__((ext_vector_type(8)));
typedef short s16x4 __attribute__((ext_vector_type(4)));
typedef float f32x4 __attribute__((ext_vector_type(4)));
typedef float f32x16 __attribute__((ext_vector_type(16)));
typedef unsigned u32x2 __attribute__((ext_vector_type(2)));
typedef unsigned u32x4 __attribute__((ext_vector_type(4)));
extern __shared__ __attribute__((aligned(1024))) char smem[];
constexpr int NTHR = 512;
constexpr int GEMM_LDS = 131072;

__device__ __forceinline__ unsigned cvtpk(float lo, float hi) { unsigned r; asm volatile("v_cvt_pk_bf16_f32 %0, %1, %2" : "=v"(r) : "v"(lo), "v"(hi)); return r; }
__device__ __forceinline__ bf16_t f2bf(float v) { return (bf16_t)(cvtpk(v, v) & 0xffffu); }
__device__ __forceinline__ float bf2f(bf16_t v) { return __uint_as_float(((unsigned)v) << 16); }

constexpr size_t MiB = 1048576;
struct MK {
    const float *x, *c, *ctx, *cctx, *ada_w, *ada_b, *norm1_g, *w_in, *lq1, *lk1, *lq2, *lk2, *dattn_g, *dec_f, *dec_b, *ret_g, *w_out, *norm2_g, *router_w, *router_b,
        *ew1, *ew3, *ew2, *sw1, *sw3, *sw2, *final_g;
    float* out; char* ws;
    float* dbgP; long dbg_lo, dbg_hi; long conv_limit;
#define WSF(name, type, off) __device__ __forceinline__ type* name() const { return (type*)(ws + (off)); }
    WSF(mod, float, 0) WSF(cnt, int, 131072) WSF(ropec, float, 262144) WSF(ropes, float, 262144 + 8192)
    WSF(w_inT, bf16_t, 1 * MiB) WSF(w_outT, bf16_t, 7 * MiB) WSF(routerT, bf16_t, 9 * MiB) WSF(W2t, bf16_t, 9 * MiB + 524288)
    WSF(H, bf16_t, 42 * MiB) WSF(MIX, bf16_t, 42 * MiB) WSF(KV, bf16_t, 112 * MiB) WSF(ST, bf16_t, 147 * MiB) WSF(ACT, bf16_t, 42 * MiB)
    WSF(W13t, bf16_t, 194 * MiB) WSF(H2, bf16_t, 260 * MiB)
    WSF(Q, bf16_t, 260 * MiB) WSF(K, bf16_t, 292 * MiB) WSF(V, bf16_t, 325 * MiB) WSF(RQ, bf16_t, 358 * MiB) WSF(RK, bf16_t, 375 * MiB)
    WSF(KTf, bf16_t, 392 * MiB) WSF(KTb, bf16_t, 409 * MiB) WSF(VT, bf16_t, 426 * MiB) WSF(RG, bf16_t, 459 * MiB)
    WSF(Y, unsigned char, 194 * MiB) WSF(tok_list, int, 484 * MiB) WSF(wt_list, float, 492 * MiB) WSF(tokmap, int, 500 * MiB)
    __device__ __forceinline__ bf16_t* X1() const { return (bf16_t*)out; }
#undef WSF
};

__device__ __forceinline__ void ph_mod(const MK& p, int bid, int nb, int tid_l) {
    float* sl = (float*)smem;
    float* red = (float*)(smem + 32768);
    if (bid < 6 * D / 32) {
        for (int i = tid_l; i < 5 * D; i += NTHR) { const int r = i >> 10, k = i & 1023; const float cv = r < 4 ? p.c[r * D + k] : p.cctx[k]; sl[k * 8 + r] = siluf(cv); }
    }
    __syncthreads();
    for (int it = bid; it < 6 * D / 32; it += nb) {
        const int col = tid_l & 31, kg = tid_l >> 5, j = it * 32 + col;
        const float* wp = p.ada_w + (size_t)(kg * 64) * 6 * D + j;
        float a[5] = {0, 0, 0, 0, 0};
#pragma unroll 1
        for (int k0 = 0; k0 < 64; k0 += 16) {
            float w[16];
#pragma unroll
            for (int kk = 0; kk < 16; ++kk) w[kk] = wp[(size_t)(k0 + kk) * 6 * D];
#pragma unroll
            for (int kk = 0; kk < 16; ++kk) {
                const float4 s4 = *(const float4*)(sl + (kg * 64 + k0 + kk) * 8); const float s5 = sl[(kg * 64 + k0 + kk) * 8 + 4];
                a[0] += s4.x * w[kk]; a[1] += s4.y * w[kk]; a[2] += s4.z * w[kk]; a[3] += s4.w * w[kk]; a[4] += s5 * w[kk];
            }
        }
        __syncthreads();
#pragma unroll
        for (int r = 0; r < 5; ++r) red[(kg * 5 + r) * 32 + col] = a[r];
        __syncthreads();
        if (tid_l < 160) {
            int r = tid_l >> 5; float s = 0;
            for (int g = 0; g < 16; ++g) s += red[(g * 5 + r) * 32 + col];
            p.mod()[(size_t)r * 6 * D + j] = s + p.ada_b[j];
        }
    }
    if (bid == nb - 1) {
        for (int i = tid_l; i < 128 * 16; i += NTHR) {
            int pos = i >> 4, f = i & 15;
            float inv_freq = exp2f(-(float)f * (13.287712379549449f / 16.0f));
            float s, c; sincosf((float)pos * inv_freq, &s, &c);
            p.ropec()[i] = c; p.ropes()[i] = s;
        }
    }
    __syncthreads();
}

__device__ __forceinline__ void tr_tile(const float* src, int ldsrc, int k0, int n0, bf16_t* dst, int lddst, int mode  , bf16_t* dst2, int tid_l) {
    float* t = (float*)smem;
    __syncthreads();
    for (int i = tid_l; i < 64 * 16; i += NTHR) {
        int r = i >> 4, c4 = (i & 15) * 4;
        float4 v = *(const float4*)(src + (size_t)(k0 + r) * ldsrc + n0 + c4);
        t[r * 65 + c4] = v.x; t[r * 65 + c4 + 1] = v.y; t[r * 65 + c4 + 2] = v.z; t[r * 65 + c4 + 3] = v.w;
    }
    __syncthreads();
    for (int i = tid_l; i < 64 * 16; i += NTHR) {
        int n = i >> 4, k4 = (i & 15) * 4;
        float a = t[(k4 + 0) * 65 + n], b = t[(k4 + 1) * 65 + n], c = t[(k4 + 2) * 65 + n], d = t[(k4 + 3) * 65 + n];
        int nn = n0 + n, row = nn;
        if (mode == 1 || mode == 2) { int ct = nn >> 7; row = ct * 256 + (mode == 2 ? 128 : 0) + (nn & 127); }
        u32x2 w; w.x = cvtpk(a, b); w.y = cvtpk(c, d);
        *(u32x2*)(dst + (size_t)row * lddst + k0 + k4) = w;
        if (mode == 3) {
            float ah = bf2f((bf16_t)(w.x & 0xffff)), bh = bf2f((bf16_t)(w.x >> 16)), ch = bf2f((bf16_t)(w.y & 0xffff)), dh = bf2f((bf16_t)(w.y >> 16));
            u32x2 l; l.x = cvtpk(a - ah, b - bh); l.y = cvtpk(c - ch, d - dh);
            *(u32x2*)(dst2 + (size_t)row * lddst + k0 + k4) = l;
        }
    }
}
constexpr int CV_STATIC = 16 * 48 + 16 * 16 + 16, CV_E13 = 65 * 2 * 16 * 4, CV_E2 = 65 * 4 * 16, CV_TOTAL = CV_STATIC + CV_E13 + CV_E2;
__device__ __forceinline__ void convert_tile(const MK& p, int j, int tid_l) {
    const int n_win = 16 * 48, n_wout = 16 * 16, n_rt = 16;
    if (j < n_win) { tr_tile(p.w_in, 3072, (j / 48) * 64, (j % 48) * 64, p.w_inT(), 1024, 0, nullptr, tid_l); return; } j -= n_win;
    if (j < n_wout) { tr_tile(p.w_out, 1024, (j / 16) * 64, (j % 16) * 64, p.w_outT(), 1024, 0, nullptr, tid_l); return; } j -= n_wout;
    if (j < n_rt) { tr_tile(p.router_w, 64, j * 64, 0, p.routerT(), 1024, 3, p.routerT() + 64 * 1024, tid_l); return; } j -= n_rt;
    if (j < CV_E13) {
        int e = j / 128, r = j % 128, which = r / 64, tt = r % 64;
        const float* src = e < 64 ? (which ? p.ew3 : p.ew1) + (size_t)e * D * DE : (which ? p.sw3 : p.sw1);
        tr_tile(src, DE, (tt / 4) * 64, (tt % 4) * 64, p.W13t() + (size_t)e * 512 * 1024, 1024, 1 + which, nullptr, tid_l); return; } j -= CV_E13;
    { int e = j / 64, tt = j % 64;
      const float* src = e < 64 ? p.ew2 + (size_t)e * DE * D : p.sw2;
      tr_tile(src, D, (tt / 16) * 64, (tt % 16) * 64, p.W2t() + (size_t)e * 1024 * 256, 256, 0, nullptr, tid_l); }
}
__device__ __forceinline__ void ph_convert(const MK& p, int bid, int nb, int tid_l) {
    for (int it = bid; it < CV_STATIC; it += nb) convert_tile(p, it, tid_l);
    __syncthreads();
}
template <int LDSRC> __device__ __forceinline__ void tr_wave(const float* __restrict__ src, int k0, int n0, bf16_t* __restrict__ dst, int lddst, int mode, int lane, char* tb) {
    const int n4 = lane & 15, kg = lane >> 4;
    const float* s0 = src + (size_t)(k0 + kg * 16) * LDSRC + n0 + n4 * 4;
    f32x4 v[16];
#pragma unroll
    for (int it = 0; it < 16; ++it) v[it] = *(const f32x4*)(s0 + (size_t)it * LDSRC);
#pragma unroll
    for (int jn = 0; jn < 4; ++jn) {
        const int n = n4 * 4 + jn;
#pragma unroll
        for (int h = 0; h < 2; ++h) {
            const u32x4 w = {cvtpk(v[h * 8][jn], v[h * 8 + 1][jn]), cvtpk(v[h * 8 + 2][jn], v[h * 8 + 3][jn]), cvtpk(v[h * 8 + 4][jn], v[h * 8 + 5][jn]), cvtpk(v[h * 8 + 6][jn], v[h * 8 + 7][jn])};
            *(u32x4*)(tb + n * 128 + (((kg * 2 + h) ^ (n4 & 7)) << 4)) = w;
        }
    }
    asm volatile("s_waitcnt lgkmcnt(0)" ::: "memory");
#pragma unroll
    for (int it = 0; it < 8; ++it) {
        const int n = it * 8 + (lane >> 3), c = lane & 7;
        const u32x4 w = *(const u32x4*)(tb + n * 128 + ((c ^ ((n >> 2) & 7)) << 4));
        const int nn = n0 + n; int row = nn;
        if (mode == 1 || mode == 2) { const int ct = nn >> 7; row = ct * 256 + (mode == 2 ? 128 : 0) + (nn & 127); }
        *(u32x4*)(dst + (size_t)row * lddst + k0 + c * 8) = w;
    }
}
__device__ __forceinline__ void convert_tile_wave(const MK& p, int j, int lane, char* tb) {
    if (j < CV_E13) {
        const int e = j / 128, r = j % 128, which = r / 64, tt = r % 64;
        const float* src = e < 64 ? (which ? p.ew3 : p.ew1) + (size_t)e * D * DE : (which ? p.sw3 : p.sw1);
        tr_wave<DE>(src, (tt / 4) * 64, (tt % 4) * 64, p.W13t() + (size_t)e * 512 * 1024, 1024, 1 + which, lane, tb); return; }
    j -= CV_E13;
    { const int e = j / 64, tt = j % 64;
      const float* src = e < 64 ? p.ew2 + (size_t)e * DE * D : p.sw2;
      tr_wave<D>(src, (tt / 16) * 64, (tt % 16) * 64, p.W2t() + (size_t)e * 1024 * 256, 256, 0, lane, tb); }
}
__device__ __forceinline__ void ph_convert_dyn(const MK& p, int tid_l) {
    const int lane = tid_l & 63;
    char* tb = smem + (tid_l >> 6) * 8192;
    __syncthreads();
    for (;;) {
        int j = 0;
        if (lane == 0) j = atomicAdd(&p.cnt()[200], 8);
        j = __builtin_amdgcn_readfirstlane(j);
        if (j >= CV_E13) break;
#pragma unroll 1
        for (int k = 0; k < 8; ++k) if (j + k < CV_E13) convert_tile_wave(p, j + k, lane, tb);
    }
}

__device__ __forceinline__ void ph_ln1(const MK& p, int bid, int nb, int tid_l) {
    const int wid = tid_l >> 6, lane = tid_l & 63;
    for (int R = bid * 8 + wid; R < NR; R += nb * 8) {
        int b = R / RB, i = R % RB;
        const float* src = i < CTX ? p.ctx + ((size_t)b * CTX + i) * D : p.x + ((size_t)b * SEQ + (i - CTX)) * D;
        const float* m = p.mod() + (size_t)(i < CTX ? 4 : b) * 6 * D;
        float4 v[4]; float ss = 0;
#pragma unroll
        for (int q = 0; q < 4; ++q) { v[q] = *(const float4*)(src + q * 256 + lane * 4); ss += v[q].x * v[q].x + v[q].y * v[q].y + v[q].z * v[q].z + v[q].w * v[q].w; }
        ss = wave_sum(ss);
        float rstd = rsqrtf(ss * (1.0f / D) + EPS);
#pragma unroll
        for (int q = 0; q < 4; ++q) {
            int c0 = q * 256 + lane * 4;
            float4 gg = *(const float4*)(p.norm1_g + c0), sh = *(const float4*)(m + c0), sc = *(const float4*)(m + D + c0);
            float o0 = v[q].x * rstd * gg.x * (1 + sc.x) + sh.x, o1 = v[q].y * rstd * gg.y * (1 + sc.y) + sh.y;
            float o2 = v[q].z * rstd * gg.z * (1 + sc.z) + sh.z, o3 = v[q].w * rstd * gg.w * (1 + sc.w) + sh.w;
            u32x2 w; w.x = cvtpk(o0, o1); w.y = cvtpk(o2, o3);
            *(u32x2*)(p.H() + (size_t)R * D + c0) = w;
        }
    }
}

__device__ __forceinline__ int lds_byte(int r, int c) { int st = (r >> 4) * 2 + (c >> 5), ob = (r & 15) * 64 + (c & 31) * 2; return st * 1024 + (ob ^ (((ob >> 9) & 1) << 5)); }
__device__ __forceinline__ void stage_rc(int b, int& R, int& C) { int st = b >> 10, sb = b & 1023, swz = sb ^ (((sb >> 9) & 1) << 5); R = (st / 2) * 16 + swz / 64; C = (st % 2) * 32 + (swz % 64) / 2; }
#define WAIT_V0() asm volatile("s_waitcnt vmcnt(0)" ::: "memory")
__device__ __forceinline__ void gemm_core(const char* Abase, const unsigned (&Ao)[4], const char* Bbase, const unsigned (&Bo)[4], int nt, f32x4 (&acc)[8][4], int tid_l, bool pre) {
    const int tid = tid_l, wid = tid >> 6, lane = tid & 63, wr = wid >> 2, wc = wid & 3, fr = lane & 15, fq = lane >> 4;
#pragma unroll
    for (int m = 0; m < 8; ++m)
#pragma unroll
        for (int n = 0; n < 4; ++n) acc[m][n] = (f32x4){0.f, 0.f, 0.f, 0.f};
#define G_SA(b) (smem + (b) * 32768)
#define G_SB(b) (smem + 65536 + (b) * 32768)
#define G_STAGE(buf, kt) do { _Pragma("unroll") for (int i = 0; i < 4; ++i) {                                                     \
        __builtin_amdgcn_global_load_lds((const unsigned*)(Abase + (Ao[i] + (unsigned)(kt) * 128u)), (unsigned*)(G_SA(buf) + wid * 1024 + i * 8192), 16, 0, 0); \
        __builtin_amdgcn_global_load_lds((const unsigned*)(Bbase + (Bo[i] + (unsigned)(kt) * 128u)), (unsigned*)(G_SB(buf) + wid * 1024 + i * 8192), 16, 0, 0); } } while (0)
    if (!pre) G_STAGE(0, 0);
    WAIT_V0(); __syncthreads();
#define G_KSTEP(cur, t) do {                                                                                                   \
        if ((t) + 1 < nt) G_STAGE((cur) ^ 1, (t) + 1);                                                                          \
        _Pragma("unroll") for (int ks = 0; ks < 2; ++ks) {                                                                      \
            bf16x8 At[8], Bf[4];                                                                                                \
            _Pragma("unroll") for (int m = 0; m < 8; ++m) At[m] = *(const bf16x8*)(G_SA(cur) + lds_byte(wr * 128 + m * 16 + fr, ks * 32 + fq * 8)); \
            _Pragma("unroll") for (int n = 0; n < 4; ++n) Bf[n] = *(const bf16x8*)(G_SB(cur) + lds_byte(wc * 64 + n * 16 + fr, ks * 32 + fq * 8));  \
            _Pragma("unroll") for (int m = 0; m < 8; ++m) _Pragma("unroll") for (int n = 0; n < 4; ++n)                         \
                acc[m][n] = __builtin_amdgcn_mfma_f32_16x16x32_bf16(Bf[n], At[m], acc[m][n], 0, 0, 0);                          \
            __builtin_amdgcn_sched_barrier(0);                                                                                  \
        }                                                                                                                       \
        WAIT_V0(); __syncthreads(); } while (0)
#pragma unroll 1
    for (int t = 0; t < nt; ++t) { const int cur = t & 1; G_KSTEP(cur, t); }
}
#ifndef XPREFETCH
#define XPREFETCH 0
#endif
__device__ __forceinline__ void gemm_prefetch(const char* Abase, const unsigned (&Ao)[4], const char* Bbase, const unsigned (&Bo)[4], int tid_l) {
    const int wid = tid_l >> 6;
    G_STAGE(0, 0);
}
__device__ __forceinline__ void stage_offs(unsigned ld_bytes, unsigned (&P)[4], int tid_l) {
    const int wid = tid_l >> 6, lane = tid_l & 63;
#pragma unroll
    for (int i = 0; i < 4; ++i) { int R, C; stage_rc(wid * 1024 + i * 8192 + lane * 16, R, C); P[i] = (unsigned)R * ld_bytes + (unsigned)C * 2u; }
}

constexpr int WAREA = 18432;
__device__ __forceinline__ char* wave_area(int wid) { return smem + wid * WAREA; }

constexpr int A_KVBLK = 64;
constexpr float A_SCALE = 0.125f, A_THR = 8.f;
constexpr int A_SHM_V = A_KVBLK * 128 * 2, A_SHM_K = A_KVBLK * 128 * 2;
#define KSWZ(row, colB) ((row) * 256 + ((colB) ^ (((row) & 7) << 4)))
#define SBAR() __builtin_amdgcn_sched_barrier(0)
__device__ __forceinline__ int crow(int r, int hi) { return (r & 3) + 8 * (r >> 2) + 4 * hi; }

constexpr float A_THRL = 11.0f;
template <bool FIRST, bool FAST = false> __device__ __forceinline__ void partialSM2(f32x16& p0, f32x16& p1, float& mhat, f32x16& negm, float& alpha) {
    if (FAST && !FIRST) {
        alpha = 1.f;
#pragma unroll
        for (int r = 0; r < 16; ++r) p0[r] = __builtin_amdgcn_exp2f(p0[r]);
        return;
    }
    float pmax = p0[0];
#pragma unroll
    for (int r = 1; r < 16; ++r) pmax = fmaxf(pmax, p0[r]);
#pragma unroll
    for (int r = 0; r < 16; ++r) pmax = fmaxf(pmax, p1[r]);
    { auto rr = __builtin_amdgcn_permlane32_swap(__float_as_uint(pmax), __float_as_uint(pmax), false, false);
      pmax = fmaxf(__uint_as_float(rr[0]), __uint_as_float(rr[1])); }
    alpha = 1.f;
    if (FIRST || __builtin_expect(__any(pmax > A_THRL), 0)) {
        const float dl = FIRST ? pmax : fmaxf(pmax, 0.f);
        mhat += dl;
#pragma unroll
        for (int r = 0; r < 16; ++r) { p0[r] -= dl; p1[r] -= dl; }
#pragma unroll
        for (int r = 0; r < 16; ++r) negm[r] = -mhat;
        if (!FIRST) alpha = __builtin_amdgcn_exp2f(-dl);
    }
#pragma unroll
    for (int r = 0; r < 16; ++r) p0[r] = __builtin_amdgcn_exp2f(p0[r]);
}
__device__ __forceinline__ void qkt2(f32x16& p0, f32x16& p1, const char* Ks, const bf16x8* qr, const f32x16& negm, int r32, int hi, int mapc) {
#pragma unroll
    for (int d0 = 0; d0 < 4; ++d0) { int cb = (mapc + d0 * 16 + hi * 8) * 2;
        bf16x8 b0 = *reinterpret_cast<const bf16x8*>(Ks + KSWZ(r32, cb));
        bf16x8 b1 = *reinterpret_cast<const bf16x8*>(Ks + KSWZ(32 + r32, cb));
        if (d0 == 0) { p0 = __builtin_amdgcn_mfma_f32_32x32x16_bf16(b0, qr[0], negm, 0, 0, 0); p1 = __builtin_amdgcn_mfma_f32_32x32x16_bf16(b1, qr[0], negm, 0, 0, 0); }
        else { p0 = __builtin_amdgcn_mfma_f32_32x32x16_bf16(b0, qr[d0], p0, 0, 0, 0); p1 = __builtin_amdgcn_mfma_f32_32x32x16_bf16(b1, qr[d0], p1, 0, 0, 0); } }
}
template <int PROBE = 0> __device__ __forceinline__ void partialSM(f32x16& p0, f32x16& p1, float& m_reg, float& mn, float& alpha) {
    constexpr float C = A_SCALE * 1.4426950408889634f;
    float pmax = p0[0];
#pragma unroll
    for (int r = 1; r < 16; ++r) pmax = fmaxf(pmax, p0[r]);
#pragma unroll
    for (int r = 0; r < 16; ++r) pmax = fmaxf(pmax, p1[r]);
    { auto rr = __builtin_amdgcn_permlane32_swap(__float_as_uint(pmax), __float_as_uint(pmax), false, false);
      pmax = fmaxf(__uint_as_float(rr[0]), __uint_as_float(rr[1])); }
    if (__builtin_expect(__all(pmax - m_reg <= A_THR / A_SCALE), 1)) { mn = m_reg; alpha = 1.f; }
    else { mn = fmaxf(m_reg, pmax); alpha = __builtin_amdgcn_exp2f((m_reg - mn) * C); m_reg = mn; }
    float mnC = -mn * C;
#pragma unroll
    for (int r = 0; r < 16; ++r) p0[r] = fmaf(p0[r], C, mnC);
#pragma unroll
    for (int r = 0; r < 16; ++r) p1[r] = fmaf(p1[r], C, mnC);
#pragma unroll
    for (int r = 0; r < 16; ++r) p0[r] = PROBE == 3 ? p0[r] * 1e-3f : __builtin_amdgcn_exp2f(p0[r]);
}
#define PK4(P, BASE, OUT) do { unsigned a0 = cvtpk(P[BASE + 0], P[BASE + 1]), a1 = cvtpk(P[BASE + 2], P[BASE + 3]);   \
    unsigned b0 = cvtpk(P[BASE + 4], P[BASE + 5]), b1 = cvtpk(P[BASE + 6], P[BASE + 7]);                              \
    auto r0 = __builtin_amdgcn_permlane32_swap(a0, b0, false, false); auto r1 = __builtin_amdgcn_permlane32_swap(a1, b1, false, false); \
    u32x4 w = {r0[0], r1[0], r0[1], r1[1]}; OUT = *reinterpret_cast<bf16x8*>(&w); } while (0)
template <int PROBE = 0, bool DIRECT = false, bool FAST = false> __device__ __forceinline__ void finishSM(f32x16& p0, f32x16& p1, float alpha, float& l_reg, bf16x8& pa0, bf16x8& pa1, bf16x8& pa2, bf16x8& pa3, float& bad) {
#pragma unroll
    for (int r = 0; r < 16; ++r) p1[r] = PROBE == 3 ? p1[r] * 1e-3f : __builtin_amdgcn_exp2f(p1[r]);
    float ps = 0;
#pragma unroll
    for (int r = 0; r < 16; ++r) ps += p0[r];
#pragma unroll
    for (int r = 0; r < 16; ++r) ps += p1[r];
    { auto rr = __builtin_amdgcn_permlane32_swap(__float_as_uint(ps), __float_as_uint(ps), false, false);
      ps = __uint_as_float(rr[0]) + __uint_as_float(rr[1]); }
    if (FAST) { l_reg += ps; bad = fmaxf(bad, ps); }
    else l_reg = l_reg * alpha + ps;
    if (DIRECT) {
#define PKD(P, B, OUT) do { u32x4 w = {cvtpk(P[B], P[B + 1]), cvtpk(P[B + 2], P[B + 3]), cvtpk(P[B + 4], P[B + 5]), cvtpk(P[B + 6], P[B + 7])}; OUT = *reinterpret_cast<bf16x8*>(&w); } while (0)
        PKD(p0, 0, pa0); PKD(p0, 8, pa1); PKD(p1, 0, pa2); PKD(p1, 8, pa3);
#undef PKD
    } else { PK4(p0, 0, pa0); PK4(p0, 8, pa1); PK4(p1, 0, pa2); PK4(p1, 8, pa3); }
}
__device__ __forceinline__ void qkt(f32x16& p0, f32x16& p1, const char* Ks, const bf16x8* qr, int r32, int hi, int mapc) {
    p0 = f32x16{}; p1 = f32x16{};
#pragma unroll
    for (int d0 = 0; d0 < 4; ++d0) { int cb = (mapc + d0 * 16 + hi * 8) * 2;
        bf16x8 b0 = *reinterpret_cast<const bf16x8*>(Ks + KSWZ(r32, cb));
        bf16x8 b1 = *reinterpret_cast<const bf16x8*>(Ks + KSWZ(32 + r32, cb));
        p0 = __builtin_amdgcn_mfma_f32_32x32x16_bf16(b0, qr[d0], p0, 0, 0, 0);
        p1 = __builtin_amdgcn_mfma_f32_32x32x16_bf16(b1, qr[d0], p1, 0, 0, 0); }
}
__device__ __forceinline__ int v_st(int k, int c) { const int kk = (k & ~0xC) | ((k & 4) << 1) | ((k & 8) >> 1); return ((kk >> 3) * 4 + (c >> 5)) * 512 + ((kk & 7) * 32 + (c & 31)) * 2; }
__device__ __forceinline__ int v_rd_base(int lane) { return ((lane & 3) << 3) | (((lane >> 2) & 3) << 6) | (((lane >> 4) & 1) << 5) | (((lane >> 5) & 1) << 8); }
constexpr int v_rd_off(int d0, int ks, int half) { return d0 * 512 + ks * 4096 + half * 2048; }
template <int OFF> __device__ __forceinline__ s16x4 tr_read(int vb) {
    s16x4 r; asm volatile("ds_read_b64_tr_b16 %0, %1 offset:%2" : "=&v"(r) : "v"(vb), "i"(OFF) : "memory"); return r;
}
template <int D0> __device__ __forceinline__ void pv_one(f32x16& od, int vb, bf16x8 pa0, bf16x8 pa1, bf16x8 pa2, bf16x8 pa3) {
    const s16x4 l0 = tr_read<v_rd_off(D0, 0, 0)>(vb), h0 = tr_read<v_rd_off(D0, 0, 1)>(vb), l1 = tr_read<v_rd_off(D0, 1, 0)>(vb), h1 = tr_read<v_rd_off(D0, 1, 1)>(vb);
    const s16x4 l2 = tr_read<v_rd_off(D0, 2, 0)>(vb), h2 = tr_read<v_rd_off(D0, 2, 1)>(vb), l3 = tr_read<v_rd_off(D0, 3, 0)>(vb), h3 = tr_read<v_rd_off(D0, 3, 1)>(vb);
    asm volatile("s_waitcnt lgkmcnt(0)" ::: "memory"); SBAR();
#define PKV(L, H) (bf16x8){L[0], L[1], L[2], L[3], H[0], H[1], H[2], H[3]}
    od = __builtin_amdgcn_mfma_f32_32x32x16_bf16(pa0, PKV(l0, h0), od, 0, 0, 0);
    od = __builtin_amdgcn_mfma_f32_32x32x16_bf16(pa1, PKV(l1, h1), od, 0, 0, 0);
    od = __builtin_amdgcn_mfma_f32_32x32x16_bf16(pa2, PKV(l2, h2), od, 0, 0, 0);
    od = __builtin_amdgcn_mfma_f32_32x32x16_bf16(pa3, PKV(l3, h3), od, 0, 0, 0);
}
template <int D0> __device__ __forceinline__ void pv_two(f32x16& oa, f32x16& ob, int vb, bf16x8 pa0, bf16x8 pa1, bf16x8 pa2, bf16x8 pa3) {
    const s16x4 l0 = tr_read<v_rd_off(D0, 0, 0)>(vb), h0 = tr_read<v_rd_off(D0, 0, 1)>(vb), l1 = tr_read<v_rd_off(D0, 1, 0)>(vb), h1 = tr_read<v_rd_off(D0, 1, 1)>(vb);
    const s16x4 l2 = tr_read<v_rd_off(D0, 2, 0)>(vb), h2 = tr_read<v_rd_off(D0, 2, 1)>(vb), l3 = tr_read<v_rd_off(D0, 3, 0)>(vb), h3 = tr_read<v_rd_off(D0, 3, 1)>(vb);
    const s16x4 m0 = tr_read<v_rd_off(D0 + 1, 0, 0)>(vb), g0 = tr_read<v_rd_off(D0 + 1, 0, 1)>(vb), m1 = tr_read<v_rd_off(D0 + 1, 1, 0)>(vb), g1 = tr_read<v_rd_off(D0 + 1, 1, 1)>(vb);
    const s16x4 m2 = tr_read<v_rd_off(D0 + 1, 2, 0)>(vb), g2 = tr_read<v_rd_off(D0 + 1, 2, 1)>(vb), m3 = tr_read<v_rd_off(D0 + 1, 3, 0)>(vb), g3 = tr_read<v_rd_off(D0 + 1, 3, 1)>(vb);
    asm volatile("s_waitcnt lgkmcnt(0)" ::: "memory"); SBAR();
    oa = __builtin_amdgcn_mfma_f32_32x32x16_bf16(pa0, PKV(l0, h0), oa, 0, 0, 0);
    ob = __builtin_amdgcn_mfma_f32_32x32x16_bf16(pa0, PKV(m0, g0), ob, 0, 0, 0);
    oa = __builtin_amdgcn_mfma_f32_32x32x16_bf16(pa1, PKV(l1, h1), oa, 0, 0, 0);
    ob = __builtin_amdgcn_mfma_f32_32x32x16_bf16(pa1, PKV(m1, g1), ob, 0, 0, 0);
    oa = __builtin_amdgcn_mfma_f32_32x32x16_bf16(pa2, PKV(l2, h2), oa, 0, 0, 0);
    ob = __builtin_amdgcn_mfma_f32_32x32x16_bf16(pa2, PKV(m2, g2), ob, 0, 0, 0);
    oa = __builtin_amdgcn_mfma_f32_32x32x16_bf16(pa3, PKV(l3, h3), oa, 0, 0, 0);
    ob = __builtin_amdgcn_mfma_f32_32x32x16_bf16(pa3, PKV(m3, g3), ob, 0, 0, 0);
}
__device__ __forceinline__ void pv_d0(f32x16* o, int vb, bf16x8 pa0, bf16x8 pa1, bf16x8 pa2, bf16x8 pa3) {
    pv_one<0>(o[0], vb, pa0, pa1, pa2, pa3); pv_one<1>(o[1], vb, pa0, pa1, pa2, pa3); pv_one<2>(o[2], vb, pa0, pa1, pa2, pa3); pv_one<3>(o[3], vb, pa0, pa1, pa2, pa3);
}

template <int PROBE, bool FAST> __device__ __forceinline__ int attn_item(const bf16_t* __restrict__ Qb, const bf16_t* __restrict__ Kh, const bf16_t* __restrict__ Vh, bf16_t* __restrict__ mixrow,
                                          const float* __restrict__ gd, float lam, int tid_l) {
    char* lds = smem;
    const int tid = tid_l, wid = tid >> 6, lane = tid & 63, r32 = lane & 31, hi = lane >> 5;
    const int map = wid >> 2, wq = wid & 3, mapc = map * 64;
    char* K_lds = lds; char* V_lds = lds + 4 * A_SHM_K;
    float* wsw = (float*)(lds + 4 * A_SHM_V + 4 * A_SHM_K) + wid * 64; float* li_l = wsw; float* al_l = wsw + 32;
    float m_reg = 0.f, l_reg = 0, bad = 0.f; f32x16 o[4] = {}; bf16x8 qr[4]; f32x16 negm = f32x16{};
    int* flagw = (int*)(lds + 4 * A_SHM_V + 4 * A_SHM_K + 2048);
    if (FAST && tid == 0) *flagw = 0;
    const bf16_t* Qw = Qb + (long)(wq * 32 + r32) * 128 + mapc + hi * 8;
#pragma unroll
    for (int d0 = 0; d0 < 4; ++d0) qr[d0] = *reinterpret_cast<const bf16x8*>(Qw + d0 * 16);
    const int vb0 = (int)(uintptr_t)V_lds + v_rd_base(lane);
    unsigned kofs[2], vofs[2];
    const int widu = __builtin_amdgcn_readfirstlane(wid);
#pragma unroll
    for (int i = 0; i < 2; ++i) {
        const int x = wid * 1024 + i * 8192 + lane * 16;
        { const int row = x >> 8, cs = x & 255, colB = cs ^ ((row & 7) << 4); kofs[i] = (unsigned)(row * 256 + colB); }
        { const int sub = x >> 9, wn = x & 511, k = (sub >> 2) * 8 + (wn >> 6), c = (sub & 3) * 32 + ((wn & 63) >> 1); vofs[i] = (unsigned)(k * 256 + c * 2); }
    }
#define DMA_TILE(slot, k0) do { const char* kt_ = (const char*)Kh + (size_t)(k0) * 256; const char* vt_ = (const char*)Vh + (size_t)(k0) * 256;                  \
      _Pragma("unroll") for (int i = 0; i < 2; ++i) {                                                                   \
        __builtin_amdgcn_global_load_lds((const unsigned*)(kt_ + kofs[i]), (unsigned*)(K_lds + (slot) * A_SHM_K + widu * 1024 + i * 8192), 16, 0, 0); \
        __builtin_amdgcn_global_load_lds((const unsigned*)(vt_ + vofs[i]), (unsigned*)(V_lds + (slot) * A_SHM_V + widu * 1024 + i * 8192), 16, 0, 0); } } while (0)
#define RESC(a) do { if (__any((a) < 1.f)) { if (hi == 0) al_l[r32] = (a); asm volatile("s_waitcnt lgkmcnt(0)" ::: "memory"); \
    _Pragma("unroll") for (int d = 0; d < 4; ++d) _Pragma("unroll") for (int r = 0; r < 16; ++r) o[d][r] *= al_l[crow(r, hi)]; } } while (0)
    f32x16 pA0, pA1, pB0, pB1; float mnA, mnB, alA, alB; bf16x8 pa0, pa1, pa2, pa3; const int NT = RB / A_KVBLK;
    DMA_TILE(0, 0); DMA_TILE(1, A_KVBLK);
    asm volatile("s_waitcnt vmcnt(0)" ::: "memory"); __syncthreads();
    qkt2(pA0, pA1, K_lds, qr, negm, r32, hi, mapc); partialSM2<true>(pA0, pA1, m_reg, negm, alA);
#define ATILE(X0, X1, ALX, Y0, Y1, ALY, CS, PS, NS, T_, DODMA) do {                                                                  \
        asm volatile("s_waitcnt vmcnt(0)" ::: "memory"); __syncthreads();                                                            \
        if (DODMA && PROBE != 1) DMA_TILE(NS, ((T_) + 1) * A_KVBLK);                                                                 \
        SBAR(); qkt2(X0, X1, K_lds + (CS) * A_SHM_K, qr, negm, r32, hi, mapc);                                                       \
        finishSM<PROBE, true, FAST>(Y0, Y1, ALY, l_reg, pa0, pa1, pa2, pa3, bad); SBAR();                                            \
        pv_d0(o, vb0 + (PS) * A_SHM_V, pa0, pa1, pa2, pa3); partialSM2<false, FAST>(X0, X1, m_reg, negm, ALX);                       \
        if (!FAST) RESC(ALX); } while (0)
#pragma unroll 1
    for (int j = 1; j + 3 < NT; j += 4) {
        ATILE(pB0, pB1, alB, pA0, pA1, alA, 1, 0, 2, j, true);
        ATILE(pA0, pA1, alA, pB0, pB1, alB, 2, 1, 3, j + 1, true);
        ATILE(pB0, pB1, alB, pA0, pA1, alA, 3, 2, 0, j + 2, true);
        ATILE(pA0, pA1, alA, pB0, pB1, alB, 0, 3, 1, j + 3, true);
    }
    ATILE(pB0, pB1, alB, pA0, pA1, alA, 1, 0, 2, NT - 3, true);
    ATILE(pA0, pA1, alA, pB0, pB1, alB, 2, 1, 3, NT - 2, true);
    ATILE(pB0, pB1, alB, pA0, pA1, alA, 3, 2, 0, NT - 1, false);
    finishSM<PROBE, true, FAST>(pB0, pB1, alB, l_reg, pa0, pa1, pa2, pa3, bad); SBAR();
    pv_d0(o, vb0 + 3 * A_SHM_V, pa0, pa1, pa2, pa3);
    if (FAST) { if (__any(!(bad <= 1073741824.f) || !(l_reg < 3.0e38f))) *flagw = 1; }
#undef ATILE
#undef DMA_TILE
    if (hi == 0) li_l[r32] = l_reg;
    asm volatile("s_waitcnt lgkmcnt(0)" ::: "memory");
    float rl[16];
#pragma unroll
    for (int r = 0; r < 16; ++r) rl[r] = __builtin_amdgcn_rcpf(li_l[crow(r, hi)]);
    __syncthreads();
    const int flag = FAST ? __builtin_amdgcn_readfirstlane(*flagw) : 0;
    {
        float* xo = (float*)lds + map * 16384 + (wq * 32) * 128 + r32;
#pragma unroll
        for (int r = 0; r < 16; ++r)
#pragma unroll
            for (int d0 = 0; d0 < 4; ++d0) xo[crow(r, hi) * 128 + d0 * 32] = o[d0][r] * rl[r];
    }
    __syncthreads();
    {
        int l2 = lane; asm volatile("" : "+v"(l2));
        const float g0 = gd[l2 * 2], g1 = gd[l2 * 2 + 1];
#pragma unroll 4
        for (int rr = 0; rr < 16; ++rr) {
            const int row = wid * 16 + rr;
            const float2 a0 = *(const float2*)((const float*)lds + row * 128 + l2 * 2), a1 = *(const float2*)((const float*)lds + 16384 + row * 128 + l2 * 2);
            const float xv = a0.x - lam * a1.x, yv = a0.y - lam * a1.y;
            const float ss = wave_sum(xv * xv + yv * yv);
            const float rs = rsqrtf(ss * (1.0f / 128) + EPS) * 0.8f;
            *(unsigned*)(mixrow + (long)row * 1024 + l2 * 2) = cvtpk(xv * rs * g0, yv * rs * g1);
        }
    }
    __syncthreads();
#undef RESC
    return flag;
}


template <int PROBE> __device__ __forceinline__ void ph_attn(const MK& p, int bid, int nb, int tid_l) {
    const int lane = tid_l & 63;
    float s1 = wave_sum(p.lq1[lane] * p.lk1[lane]), s2 = wave_sum(p.lq2[lane] * p.lk2[lane]);
    const float lam = expf(s1) - expf(s2) + 0.2f;
    const int nrounds = (1024 + nb - 1) / nb;
#define ATTN_ITEM_ARGS p.Q() + ((size_t)bh * SEQ + qb * 128) * 128, p.K() + (size_t)bh * RB * 128, p.V() + (size_t)bh * RB * 128, \
                  PROBE ? (bf16_t*)(p.ws + 492 * MiB) + h * 128 : p.MIX() + ((size_t)(b * SEQ + qb * 128)) * 1024 + h * 128, p.dattn_g, lam
    unsigned redo = 0u;
    for (int rr = 0; rr < nrounds; ++rr) {
        int item;
        if (nb == 256) { int x = bid & 7, j = bid >> 3, hh = rr * 8 + x; item = (hh >> 1) * 64 + (hh & 1) * 32 + j; }
        else { item = rr * nb + bid; if (item >= 1024) break; }
        const int bh = item >> 6, qb = item & 63, b = bh >> 2, h = bh & 3;
        if (nrounds <= 32) { if (attn_item<PROBE, true>(ATTN_ITEM_ARGS, tid_l)) redo |= 1u << rr; }
        else redo = 0xffffffffu;
    }
    if (redo) {
#pragma unroll 1
        for (int rr = 0; rr < nrounds; ++rr) {
            if (nrounds <= 32 && !((redo >> rr) & 1u)) continue;
            int item;
            if (nb == 256) { int x = bid & 7, j = bid >> 3, hh = rr * 8 + x; item = (hh >> 1) * 64 + (hh & 1) * 32 + j; }
            else { item = rr * nb + bid; if (item >= 1024) break; }
            const int bh = item >> 6, qb = item & 63, b = bh >> 2, h = bh & 3;
            int t2_ = tid_l; asm volatile("" : "+v"(t2_));
            (void)attn_item<PROBE, false>(ATTN_ITEM_ARGS, t2_);
        }
    }
#undef ATTN_ITEM_ARGS
}


__device__ __forceinline__ bf16x8 ldfrag(const bf16_t* p) { return *reinterpret_cast<const bf16x8*>(p); }

__device__ __forceinline__ void ph_kv(const MK& p, int bid, int nb, int tid_l) {
    const int wid = tid_l >> 6, lane = tid_l & 63, r32 = lane & 31, hi = lane >> 5;
    const int nitems = 16 * 2 * 66;
    for (int it = bid * 8 + wid; it < nitems; it += nb * 8) {
        const int c = it % 66, chain = it / 66, dir = chain & 1, bh = chain >> 1;
        const bf16_t* vt = p.VT() + (size_t)bh * 128 * RB + (size_t)c * 16384 + hi * 8;
        const bf16_t* kt = (dir ? p.KTb() : p.KTf()) + (size_t)bh * 64 * RB + (size_t)c * 8192 + hi * 8;
        f32x16 acc[4][2];
#pragma unroll
        for (int mt = 0; mt < 4; ++mt) { acc[mt][0] = f32x16{}; acc[mt][1] = f32x16{}; }
#pragma unroll 1
        for (int kh = 0; kh < 2; ++kh) {
            bf16x8 a[4][4], b2[2][4];
#pragma unroll
            for (int ks = 0; ks < 4; ++ks) {
#pragma unroll
                for (int mt = 0; mt < 4; ++mt) a[mt][ks] = ldfrag(vt + (mt * 32 + r32) * 128 + (kh * 4 + ks) * 16);
#pragma unroll
                for (int nt = 0; nt < 2; ++nt) b2[nt][ks] = ldfrag(kt + (nt * 32 + r32) * 128 + (kh * 4 + ks) * 16);
            }
#pragma unroll
            for (int ks = 0; ks < 4; ++ks) asm volatile("" : "+v"(a[0][ks]), "+v"(a[1][ks]), "+v"(a[2][ks]), "+v"(a[3][ks]), "+v"(b2[0][ks]), "+v"(b2[1][ks]) :: "memory");
#pragma unroll
            for (int ks = 0; ks < 4; ++ks)
#pragma unroll
                for (int mt = 0; mt < 4; ++mt)
#pragma unroll
                    for (int nt = 0; nt < 2; ++nt) acc[mt][nt] = __builtin_amdgcn_mfma_f32_32x32x16_bf16(a[mt][ks], b2[nt][ks], acc[mt][nt], 0, 0, 0);
        }
        bf16_t* dst = p.KV() + (size_t)it * 8192;
#pragma unroll
        for (int mt = 0; mt < 4; ++mt)
#pragma unroll
            for (int nt = 0; nt < 2; ++nt)
#pragma unroll
                for (int r = 0; r < 16; ++r) dst[(mt * 32 + crow(r, hi)) * 64 + nt * 32 + r32] = f2bf(acc[mt][nt][r]);
    }
}

__device__ __forceinline__ void ph_scan(const MK& p, int bid, int nb, int tid_l) {
    if (tid_l >= 256) {
        const int lane = tid_l & 63, wq = __builtin_amdgcn_readfirstlane(tid_l >> 6); char* tb = smem + wq * 8192;
#pragma unroll 1
        for (int j = CV_E13 + bid * 4 + (wq - 4); j < CV_E13 + CV_E2; j += nb * 4) convert_tile_wave(p, j, lane, tb);
        return;
    }
    for (int e0 = bid * 256 + tid_l; e0 < 32 * 8192; e0 += nb * 1024) {
        float S[4], g128[4]; const bf16_t* kv[4]; bf16_t* st[4]; int dir[4];
#pragma unroll
        for (int q = 0; q < 4; ++q) {
            int e = e0 + q * nb * 256; if (e >= 32 * 8192) e = e0;
            const int chain = e >> 13, el = e & 8191, h = (chain >> 1) & 3; dir[q] = chain & 1;
            const float d = dir[q] ? p.dec_b[h] : p.dec_f[h];
            g128[q] = exp2f(128.0f * log2f(1.0f / (1.0f + expf(-d))));
            kv[q] = p.KV() + (size_t)chain * 66 * 8192 + el; st[q] = p.ST() + (size_t)chain * 66 * 8192 + el; S[q] = 0.f;
        }
#pragma unroll 2
        for (int n = 0; n < 66; ++n) {
            const int cb = n == 0 ? 1 : (n == 1 ? 0 : 67 - n);
            float x[4];
#pragma unroll
            for (int q = 0; q < 4; ++q) x[q] = bf2f(kv[q][(size_t)(dir[q] ? cb : n) * 8192]);
#pragma unroll
            for (int q = 0; q < 4; ++q) { st[q][(size_t)(dir[q] ? cb : n) * 8192] = f2bf(S[q]); S[q] = fmaf(g128[q], S[q], x[q]); }
        }
    }
}

__device__ __forceinline__ void ph_ret(const MK& p, int bid, int nb, int tid_l) {
    const int tid = tid_l, wid = tid >> 6, lane = tid & 63, r32 = lane & 31, hi = lane >> 5, wq = wid & 3, half = wid >> 2;
    float* img = (float*)smem;
    for (int it = bid; it < 4 * 64 * 2; it += nb) {
        const int hp = it & 1, lc = (it >> 1) & 63, b = it >> 7, h = hp * 2 + half, bh = b * 4 + h;
        const int ib = CTX + lc * 128, c = 2 + lc;
        const float lf = log2f(1.0f / (1.0f + expf(-p.dec_f[h]))), lb = log2f(1.0f / (1.0f + expf(-p.dec_b[h])));
        const bf16_t* rq = p.RQ() + ((size_t)bh * RB + ib + wq * 32 + r32) * 64 + hi * 8;
        bf16x8 q[4];
#pragma unroll
        for (int ks = 0; ks < 4; ++ks) q[ks] = ldfrag(rq + ks * 16);
        f32x16 o[4];
        {
            const bf16_t* stf = p.ST() + ((size_t)(bh * 2 + 0) * 66 + c) * 8192 + hi * 8;
            const bf16_t* stb = p.ST() + ((size_t)(bh * 2 + 1) * 66 + c) * 8192 + hi * 8;
#define QSCALE(dst, f_) do { _Pragma("unroll") for (int ks = 0; ks < 4; ++ks) { const u32x4 w_ = *reinterpret_cast<const u32x4*>(&q[ks]); u32x4 r_;                         \
            _Pragma("unroll") for (int j = 0; j < 4; ++j) r_[j] = cvtpk(__uint_as_float(w_[j] << 16) * (f_), __uint_as_float(w_[j] & 0xffff0000u) * (f_));                 \
            dst[ks] = *reinterpret_cast<const bf16x8*>(&r_); } } while (0)
            {
                bf16x8 sf[4][4];
#pragma unroll
                for (int d0 = 0; d0 < 4; ++d0)
#pragma unroll
                    for (int ks = 0; ks < 4; ++ks) sf[d0][ks] = ldfrag(stf + (size_t)(d0 * 32 + r32) * 64 + ks * 16);
                asm volatile("" ::: "memory");
                bf16x8 qs[4]; QSCALE(qs, __builtin_amdgcn_exp2f((float)(wq * 32 + r32 + 1) * lf));
#pragma unroll
                for (int d0 = 0; d0 < 4; ++d0) {
                    o[d0] = f32x16{};
#pragma unroll
                    for (int ks = 0; ks < 4; ++ks) o[d0] = __builtin_amdgcn_mfma_f32_32x32x16_bf16(qs[ks], sf[d0][ks], o[d0], 0, 0, 0);
                }
            }
            asm volatile("" ::: "memory");
            {
                bf16x8 sb[4][4];
#pragma unroll
                for (int d0 = 0; d0 < 4; ++d0)
#pragma unroll
                    for (int ks = 0; ks < 4; ++ks) sb[d0][ks] = ldfrag(stb + (size_t)(d0 * 32 + r32) * 64 + ks * 16);
                asm volatile("" ::: "memory");
                bf16x8 qs[4]; QSCALE(qs, __builtin_amdgcn_exp2f((float)(128 - (wq * 32 + r32)) * lb));
#pragma unroll
                for (int d0 = 0; d0 < 4; ++d0)
#pragma unroll
                    for (int ks = 0; ks < 4; ++ks) o[d0] = __builtin_amdgcn_mfma_f32_32x32x16_bf16(qs[ks], sb[d0][ks], o[d0], 0, 0, 0);
            }
#undef QSCALE
            asm volatile("" ::: "memory");
        }
        {
            const int qi = wq * 32 + r32;
            const bf16_t* vt = p.VT() + (size_t)bh * 128 * RB + (size_t)c * 16384 + hi * 8;
#pragma unroll 1
            for (int jh = 0; jh < 2; ++jh) {
                asm volatile("" ::: "memory");
                bf16x8 pa[2][2];
                {
                    bf16x8 kf[2][4];
#pragma unroll
                    for (int j2 = 0; j2 < 2; ++j2)
#pragma unroll
                        for (int ks = 0; ks < 4; ++ks) kf[j2][ks] = ldfrag(p.RK() + ((size_t)bh * RB + ib + (jh * 2 + j2) * 32 + r32) * 64 + hi * 8 + ks * 16);
                    asm volatile("" ::: "memory");
#pragma unroll
                    for (int j2 = 0; j2 < 2; ++j2) {
                        f32x16 pp = f32x16{};
#pragma unroll
                        for (int ks = 0; ks < 4; ++ks) pp = __builtin_amdgcn_mfma_f32_32x32x16_bf16(kf[j2][ks], q[ks], pp, 0, 0, 0);
#pragma unroll
                        for (int r = 0; r < 16; ++r) {
                            const int dd = qi - ((jh * 2 + j2) * 32 + crow(r, hi));
                            const float ex = __builtin_amdgcn_exp2f(dd > 0 ? (float)dd * lf : (float)(-dd) * lb); const float w = dd == 0 ? 2.0f : ex;
                            pp[r] *= w;
                        }
                        PK4(pp, 0, pa[j2][0]); PK4(pp, 8, pa[j2][1]);
                    }
                }
                asm volatile("" ::: "memory");
                bf16x8 vf[2][4][2];
#pragma unroll
                for (int j2 = 0; j2 < 2; ++j2)
#pragma unroll
                    for (int d0 = 0; d0 < 4; ++d0) { vf[j2][d0][0] = ldfrag(vt + (d0 * 32 + r32) * 128 + (jh * 2 + j2) * 32); vf[j2][d0][1] = ldfrag(vt + (d0 * 32 + r32) * 128 + (jh * 2 + j2) * 32 + 16); }
                asm volatile("" ::: "memory");
#pragma unroll
                for (int j2 = 0; j2 < 2; ++j2)
#pragma unroll
                    for (int d0 = 0; d0 < 4; ++d0) {
                        o[d0] = __builtin_amdgcn_mfma_f32_32x32x16_bf16(pa[j2][0], vf[j2][d0][0], o[d0], 0, 0, 0);
                        o[d0] = __builtin_amdgcn_mfma_f32_32x32x16_bf16(pa[j2][1], vf[j2][d0][1], o[d0], 0, 0, 0);
                    }
            }
        }
        __syncthreads();
        {
            float* xo = img + half * 16384 + (wq * 32) * 128 + r32;
#pragma unroll
            for (int r = 0; r < 16; ++r)
#pragma unroll
                for (int d0 = 0; d0 < 4; ++d0) xo[crow(r, hi) * 128 + d0 * 32] = o[d0][r];
        }
        __syncthreads();
        {
            const float g0 = p.ret_g[lane * 2], g1 = p.ret_g[lane * 2 + 1];
#pragma unroll 8
            for (int rr = 0; rr < 32; ++rr) {
                const int row = wid * 32 + rr, itl = row >> 7, rw = row & 127, hh = hp * 2 + itl;
                const float2 a = *(const float2*)(img + row * 128 + lane * 2);
                const float ss = wave_sum(a.x * a.x + a.y * a.y);
                const float rs = rsqrtf(ss * (1.0f / 128) + EPS);
                const size_t tt = (size_t)b * SEQ + lc * 128 + rw;
                const unsigned ggv = *(const unsigned*)(p.RG() + tt * 512 + hh * 128 + lane * 2);
                const float ga = bf2f((bf16_t)(ggv & 0xffff)), gb = bf2f((bf16_t)(ggv >> 16));
                *(unsigned*)(p.MIX() + tt * 1024 + 512 + hh * 128 + lane * 2) = cvtpk(silu_fast(ga) * a.x * rs * g0, silu_fast(gb) * a.y * rs * g1);
            }
        }
    }
}


namespace pg8 {
constexpr int BM = 256, BK = 64, HALF = 128, HTB = HALF * BK * 2;
__device__ __forceinline__ int perm32(int rho) { const int n = rho >> 4, i = rho & 15; return 8 * (i >> 2) + 4 * n + (i & 3); }
struct GUnit { const char* A; const char* B; int i0, i1, i2, i3; };
template <class Epi, class Sched, bool GATHER, bool ALIGN_EPI>
__device__ __forceinline__ void gemm(int K, const Sched& S, const Epi& E, int tid_l) {
    const int tid = tid_l, wid = __builtin_amdgcn_readfirstlane(tid >> 6), lane = tid & 63, wr = wid >> 2, wc = wid & 3, fr = lane & 15, fq = lane >> 4;
    const int nt = K / BK;
    unsigned voffB[2], vAc[2][2], vAn[2][2];
    const size_t kstep = (size_t)(BK * 2);
    const size_t hstepB = (size_t)HALF * K * 2;
#pragma unroll
    for (int i = 0; i < 2; ++i) { int R, C; stage_rc(tid * 16 + i * 8192, R, C); const int Rb = Epi::PERM ? ((R & ~31) + perm32(R & 31)) : R;
        voffB[i] = (unsigned)(Rb * K + C) * 2u; }
    const unsigned ldsw = (unsigned)wid * 1024u;
    const int aoff = lds_byte(wr * 64 + fr, fq * 8), boff = lds_byte(wc * 32 + fr, fq * 8);
#define PG8_SA(b, h) (((b) * 2 + (h)) * HTB)
#define PG8_SB(b, h) ((4 + (b) * 2 + (h)) * HTB)
#define PG8_STAGE(bufoff, gbase, voff) do { _Pragma("unroll") for (int _i = 0; _i < 2; ++_i) \
        __builtin_amdgcn_global_load_lds((const unsigned*)((const char*)(gbase) + (voff)[_i]), (unsigned*)(smem + (bufoff) + ldsw + _i * 8192), 16, 0, 0); } while (0)
#define PG8_LDA(dst, b, h) do { _Pragma("unroll") for (int m = 0; m < 4; ++m) _Pragma("unroll") for (int k = 0; k < 2; ++k) dst[m][k] = *(const bf16x8*)(smem + PG8_SA(b, h) + aoff + m * 2048 + k * 1024); } while (0)
#define PG8_LDB(dst, b, h) do { _Pragma("unroll") for (int n = 0; n < 2; ++n) _Pragma("unroll") for (int k = 0; k < 2; ++k) dst[n][k] = *(const bf16x8*)(smem + PG8_SB(b, h) + boff + n * 2048 + k * 1024); } while (0)
#define PG8_MMA(ai, bj, At, Bt) do { __builtin_amdgcn_s_setprio(1); _Pragma("unroll") for (int m = 0; m < 4; ++m) _Pragma("unroll") for (int n = 0; n < 2; ++n) _Pragma("unroll") for (int k = 0; k < 2; ++k) \
        acc[ai][bj][m][n] = __builtin_amdgcn_mfma_f32_16x16x32_bf16(Bt[n][k], At[m][k], acc[ai][bj][m][n], 0, 0, 0); __builtin_amdgcn_s_setprio(0); } while (0)
#define PG8_WAIT_V(n) asm volatile("s_waitcnt vmcnt(" #n ")" ::: "memory")
#define PG8_WAIT_L(n) asm volatile("s_waitcnt lgkmcnt(" #n ")" ::: "memory")
#define PG8_BAR __builtin_amdgcn_s_barrier()
#define PG8_SCHED __builtin_amdgcn_sched_barrier(0)
    GUnit cur, nxt; int ui = 0;
    if (!S.next(0, cur, vAc)) return;
    f32x4 acc[2][2][4][2];
#pragma unroll
    for (int a = 0; a < 2; ++a)
#pragma unroll
        for (int b = 0; b < 2; ++b)
#pragma unroll
            for (int m = 0; m < 4; ++m)
#pragma unroll
                for (int n = 0; n < 2; ++n) acc[a][b][m][n] = (f32x4){0.f, 0.f, 0.f, 0.f};
    bf16x8 At[4][2], B0[2][2], B1[2][2];
    const char* cA = cur.A; const char* cB = cur.B;
    PG8_STAGE(PG8_SB(0, 0), cB, voffB); PG8_STAGE(PG8_SB(0, 1), cB + hstepB, voffB); PG8_STAGE(PG8_SA(0, 0), cA, vAc[0]); PG8_STAGE(PG8_SA(0, 1), cA, vAc[1]);
    if (wr == 1) PG8_BAR;
    PG8_WAIT_V(2); PG8_BAR;
    PG8_STAGE(PG8_SB(1, 0), cB + kstep, voffB); PG8_STAGE(PG8_SA(1, 0), cA + kstep, vAc[0]); PG8_STAGE(PG8_SB(1, 1), cB + hstepB + kstep, voffB);
    PG8_WAIT_V(6); PG8_BAR;
    for (;;) {
        const bool has_next = S.next(ui + 1, nxt, vAn);
        if (!GATHER || !has_next) {
#pragma unroll
            for (int h = 0; h < 2; ++h)
#pragma unroll
                for (int i = 0; i < 2; ++i) vAn[h][i] = vAc[h][i];
        }
        const char* nA = has_next ? nxt.A : cA; const char* nB = has_next ? nxt.B : cB;
#pragma unroll 1
        for (int t = 0; t < nt; t += 2) {
            const bool last = (t == nt - 2);
            const char* a1 = cA + (size_t)(t + 1) * kstep;
            const char* a2 = last ? nA : cA + (size_t)(t + 2) * kstep; const char* b2 = last ? nB : cB + (size_t)(t + 2) * kstep;
            const char* a3 = a2 + kstep; const char* b3 = b2 + kstep;
            unsigned va2[2][2];
#pragma unroll
            for (int h = 0; h < 2; ++h)
#pragma unroll
                for (int i = 0; i < 2; ++i) va2[h][i] = (GATHER && last) ? vAn[h][i] : vAc[h][i];
            PG8_LDB(B0, 0, 0); PG8_LDB(B1, 0, 1); PG8_SCHED; PG8_LDA(At, 0, 0); PG8_STAGE(PG8_SA(1, 1), a1, vAc[1]);
            PG8_WAIT_V(8); PG8_WAIT_L(0); PG8_BAR; PG8_MMA(0, 0, At, B0); PG8_MMA(0, 1, At, B1); PG8_BAR; PG8_SCHED;
            PG8_LDA(At, 0, 1); PG8_STAGE(PG8_SB(0, 0), b2, voffB); PG8_STAGE(PG8_SB(0, 1), b2 + hstepB, voffB); PG8_STAGE(PG8_SA(0, 0), a2, va2[0]);
            PG8_WAIT_V(8); PG8_WAIT_L(0); PG8_BAR; PG8_MMA(1, 0, At, B0); PG8_MMA(1, 1, At, B1); PG8_BAR; PG8_SCHED;
            PG8_LDB(B0, 1, 0); PG8_LDB(B1, 1, 1); PG8_SCHED; PG8_LDA(At, 1, 0); PG8_STAGE(PG8_SA(0, 1), a2, va2[1]);
            PG8_WAIT_V(8); PG8_WAIT_L(0); PG8_BAR; PG8_MMA(0, 0, At, B0); PG8_MMA(0, 1, At, B1); PG8_BAR; PG8_SCHED;
            PG8_LDA(At, 1, 1); PG8_STAGE(PG8_SB(1, 0), b3, voffB); PG8_STAGE(PG8_SB(1, 1), b3 + hstepB, voffB); PG8_STAGE(PG8_SA(1, 0), a3, va2[0]);
            PG8_WAIT_V(8); PG8_WAIT_L(0); PG8_BAR; PG8_MMA(1, 0, At, B0); PG8_MMA(1, 1, At, B1); PG8_BAR; PG8_SCHED;
        }
        if (ALIGN_EPI) { if (wr == 0) PG8_BAR; }
        E(acc, cur, wr, wc, fr, fq);
        if (!has_next) break;
#pragma unroll
        for (int a = 0; a < 2; ++a)
#pragma unroll
            for (int b = 0; b < 2; ++b)
#pragma unroll
                for (int m = 0; m < 4; ++m)
#pragma unroll
                    for (int n = 0; n < 2; ++n) acc[a][b][m][n] = (f32x4){0.f, 0.f, 0.f, 0.f};
        cur = nxt; cA = nA; cB = nB; ++ui;
#pragma unroll
        for (int h = 0; h < 2; ++h)
#pragma unroll
            for (int i = 0; i < 2; ++i) vAc[h][i] = vAn[h][i];
        if (ALIGN_EPI) { if (wr == 1) PG8_BAR; }
    }
    PG8_WAIT_V(0);
    if (!ALIGN_EPI) { if (wr == 0) PG8_BAR; }
    PG8_BAR;
#undef PG8_SA
#undef PG8_SB
#undef PG8_STAGE
#undef PG8_LDA
#undef PG8_LDB
#undef PG8_MMA
#undef PG8_WAIT_V
#undef PG8_WAIT_L
#undef PG8_BAR
#undef PG8_SCHED
}
__device__ __forceinline__ void plain_voffA(int K, unsigned (&vA)[2][2], int tid_l) {
#pragma unroll
    for (int i = 0; i < 2; ++i) { int R, C; stage_rc(tid_l * 16 + i * 8192, R, C); vA[0][i] = (unsigned)(R * K + C) * 2u; vA[1][i] = (unsigned)((R + HALF) * K + C) * 2u; }
}
}


__device__ __forceinline__ int xcd_vbid(int bid, int nb) { return (nb & 7) ? bid : (bid & 7) * (nb >> 3) + (bid >> 3); }
struct SchedIn { const MK* p; int bid, nb, tid_l;
    __device__ __forceinline__ bool next(int i, pg8::GUnit& u, unsigned (&vA)[2][2]) const {
        const int tile = xcd_vbid(bid, nb) + i * nb; if (tile >= (NR / 256) * 12) return false;
        const int pm = tile / 12, pn = tile % 12;
        u.A = (const char*)(p->H() + (size_t)(pm * 256) * D); u.B = (const char*)(p->w_inT() + (size_t)(pn * 256) * D); u.i0 = pm; u.i1 = pn; u.i2 = 0; u.i3 = 0;
        pg8::plain_voffA(D, vA, tid_l); return true; } };
struct EpiIn { static constexpr bool PERM = false; const MK* p;
    __device__ __forceinline__ void operator()(f32x4 (&acc)[2][2][4][2], const pg8::GUnit& u, int wr, int wc, int fr_in, int fq_in) const {
        int fr = fr_in, fq = fq_in; asm volatile("" : "+v"(fr), "+v"(fq));
        const int pm = u.i0, seg = u.i1, brow = pm * 256;
        const int b = brow / RB, i0 = brow % RB;
        const bool lat = i0 >= CTX;
        const int wid = wr * 4 + wc, lane = fq * 16 + fr;
        if (lat && (seg <= 3 || seg == 6 || seg == 7)) {
#pragma unroll
            for (int ai = 0; ai < 2; ++ai)
#pragma unroll
                for (int m = 0; m < 4; ++m) {
                    const int t = i0 + ai * 128 + wr * 64 + m * 16 + fr - CTX, pos = (wc & 1) ? (t & 63) : (t >> 6);
                    const f32x4 cc = *(const f32x4*)(p->ropec() + pos * 16 + fq * 4), ss = *(const f32x4*)(p->ropes() + pos * 16 + fq * 4);
#pragma unroll
                    for (int bj = 0; bj < 2; ++bj) { const f32x4 x1 = acc[ai][bj][m][0], x2 = acc[ai][bj][m][1];
                        acc[ai][bj][m][0] = x1 * cc - x2 * ss; acc[ai][bj][m][1] = x1 * ss + x2 * cc; }
                }
        }
        if (seg == 7 || seg <= 1) {
            const float sc_ = seg == 7 ? 0.125f : 0.125f * 1.4426950408889634f;
#pragma unroll
            for (int ai = 0; ai < 2; ++ai)
#pragma unroll
                for (int bj = 0; bj < 2; ++bj)
#pragma unroll
                    for (int m = 0; m < 4; ++m) { acc[ai][bj][m][0] = acc[ai][bj][m][0] * sc_; acc[ai][bj][m][1] = acc[ai][bj][m][1] * sc_; }
        }
        if (seg <= 7 || seg >= 10) {
#pragma unroll
            for (int bj = 0; bj < 2; ++bj) {
                bf16_t* base; long rstride; bool ok = true;
                if (seg <= 1)      { const int h = (seg & 1) * 2 + bj;       base = p->Q() + (((size_t)(b * 4 + h) * SEQ + (i0 - CTX)) * 128 + wc * 32 + fq * 4); rstride = 128; ok = lat; }
                else if (seg <= 3) { const int h = (seg - 2) * 2 + bj;       base = p->K() + (((size_t)(b * 4 + h) * RB + i0) * 128 + wc * 32 + fq * 4);          rstride = 128; }
                else if (seg <= 5) { const int h = (seg - 4) * 2 + bj;       base = p->V() + (((size_t)(b * 4 + h) * RB + i0) * 128 + wc * 32 + fq * 4);          rstride = 128; }
                else if (seg == 6) { const int h = bj * 2 + (wc >> 1);       base = p->RQ() + (((size_t)(b * 4 + h) * RB + i0) * 64 + (wc & 1) * 32 + fq * 4);    rstride = 64; }
                else if (seg == 7) { const int h = bj * 2 + (wc >> 1);       base = p->RK() + (((size_t)(b * 4 + h) * RB + i0) * 64 + (wc & 1) * 32 + fq * 4);    rstride = 64; }
                else               {                                         base = p->RG() + ((size_t)(b * SEQ + (i0 - CTX)) * 512 + (seg - 10) * 256 + bj * 128 + wc * 32 + fq * 4); rstride = 512; ok = lat; }
                if (ok) {
#pragma unroll
                    for (int ai = 0; ai < 2; ++ai)
#pragma unroll
                        for (int m = 0; m < 4; ++m) { bf16_t* rp = base + (long)(ai * 128 + wr * 64 + m * 16 + fr) * rstride;
#pragma unroll
                            for (int n = 0; n < 2; ++n) { u32x2 w; w.x = cvtpk(acc[ai][bj][m][n][0], acc[ai][bj][m][n][1]); w.y = cvtpk(acc[ai][bj][m][n][2], acc[ai][bj][m][n][3]);
                                *(u32x2*)(rp + n * 16) = w; } }
                }
            }
        }
        if (seg >= 7 && seg <= 9) {
            char* img = smem + 131072 + wid * 3968;
            const int npass = seg == 7 ? 2 : 1;
#pragma unroll 1
            for (int ps = 0; ps < npass; ++ps) {
#pragma unroll
                for (int bj = 0; bj < 2; ++bj) {
                    float lg2 = 0.f; bf16_t* baseT;
                    if (seg == 7) { const int h = bj * 2 + (wc >> 1); const float dv = ps == 0 ? p->dec_f[h] : p->dec_b[h]; lg2 = log2f(1.0f / (1.0f + expf(-dv)));
                        baseT = (ps == 0 ? p->KTf() : p->KTb()) + (size_t)(b * 4 + h) * 64 * RB + (size_t)(i0 >> 7) * 8192 + (wc & 1) * 32 * 128; }
                    else { const int h = (seg - 8) * 2 + bj; baseT = p->VT() + (size_t)(b * 4 + h) * 128 * RB + (size_t)(i0 >> 7) * 16384 + wc * 32 * 128; }
#pragma unroll
                    for (int ai = 0; ai < 2; ++ai)
#pragma unroll
                        for (int mp = 0; mp < 2; ++mp) {
                            asm volatile("s_waitcnt lgkmcnt(0)" ::: "memory");
#pragma unroll
                            for (int mm = 0; mm < 2; ++mm) { const int m = mp * 2 + mm;
                                float f = 1.0f;
                                if (seg == 7) { const int pos = (i0 + ai * 128 + wr * 64 + m * 16 + fr) & 127; f = __builtin_amdgcn_exp2f((float)(ps == 0 ? 127 - pos : pos) * lg2); }
#pragma unroll
                                for (int n = 0; n < 2; ++n)
#pragma unroll
                                    for (int j = 0; j < 4; ++j) *(bf16_t*)(img + (n * 16 + fq * 4 + j) * 80 + (mm * 16 + fr) * 2) = f2bf(acc[ai][bj][m][n][j] * f); }
                            asm volatile("s_waitcnt lgkmcnt(0)" ::: "memory");
                            const int ib = ai * (seg == 7 ? 8192 : 16384) + wr * 64 + mp * 32;
#pragma unroll
                            for (int k = 0; k < 2; ++k) { const int q = lane + 64 * k, col = q >> 2, ch = q & 3;
                                *(u32x4*)(baseT + (size_t)col * 128 + ib + ch * 8) = *(const u32x4*)(img + col * 80 + ch * 16); }
                        }
                }
            }
        }
    } };
__device__ __forceinline__ void ph_gemm_in(const MK& p, int bid, int nb, int tid_l) {
    SchedIn S{&p, bid, nb, tid_l}; EpiIn E{&p};
    pg8::gemm<EpiIn, SchedIn, false, true>(D, S, E, tid_l);
}

struct SchedOut { const MK* p; int bid, nb, tid_l;
    __device__ __forceinline__ bool next(int i, pg8::GUnit& u, unsigned (&vA)[2][2]) const {
        const int tile = xcd_vbid(bid, nb) + i * nb; if (tile >= (T / 256) * 4) return false;
        const int pm = tile >> 2, pn = tile & 3;
        u.A = (const char*)(p->MIX() + (size_t)(pm * 256) * D); u.B = (const char*)(p->w_outT() + (size_t)(pn * 256) * D); u.i0 = pm; u.i1 = pn; u.i2 = 0; u.i3 = 0;
        pg8::plain_voffA(D, vA, tid_l); return true; } };
struct EpiOut { static constexpr bool PERM = true; const MK* p;
    __device__ __forceinline__ void operator()(const f32x4 (&acc)[2][2][4][2], const pg8::GUnit& u, int wr, int wc, int fr, int fq) const {
        const int brow = u.i0 * 256, bcol = u.i1 * 256 + wc * 32 + fq * 8;
        const float* g1 = p->mod() + (size_t)(brow / SEQ) * 6 * D + 2 * D + bcol;
        f32x4 gv[2][2];
#pragma unroll
        for (int bj = 0; bj < 2; ++bj)
#pragma unroll
            for (int n = 0; n < 2; ++n) gv[bj][n] = *(const f32x4*)(g1 + bj * 128 + n * 4);
#pragma unroll
        for (int ai = 0; ai < 2; ++ai)
#pragma unroll
            for (int m = 0; m < 4; ++m) {
                const int row = brow + ai * 128 + wr * 64 + m * 16 + fr;
                const float* xp = p->x + (size_t)row * D + bcol;
                f32x4 xv[2][2];
#pragma unroll
                for (int bj = 0; bj < 2; ++bj)
#pragma unroll
                    for (int n = 0; n < 2; ++n) xv[bj][n] = *(const f32x4*)(xp + bj * 128 + n * 4);
#pragma unroll
                for (int bj = 0; bj < 2; ++bj) {
                    const f32x4 a = xv[bj][0] + gv[bj][0] * acc[ai][bj][m][0], b = xv[bj][1] + gv[bj][1] * acc[ai][bj][m][1];
                    const u32x4 w = {cvtpk(a[0], a[1]), cvtpk(a[2], a[3]), cvtpk(b[0], b[1]), cvtpk(b[2], b[3])};
                    *(u32x4*)(p->X1() + (size_t)row * 2048 + bcol + bj * 128) = w;
                }
                if (m & 1) asm volatile("" ::: "memory");
            }
    } };
__device__ __forceinline__ void ph_gemm_out(const MK& p, int bid, int nb, int tid_l) {
    SchedOut S{&p, bid, nb, tid_l}; EpiOut E{&p};
    pg8::gemm<EpiOut, SchedOut, false, true>(D, S, E, tid_l);
}

template <bool DUMMY, int MODE = 0> __device__ __forceinline__ void ph_route(const MK& p, int bid, int nb, int tid_l) {
    int* cntp = p.cnt() + (DUMMY ? 128 : 0); int* tl = DUMMY ? (int*)(p.ws + 480 * MiB) : p.tok_list(); float* wl_ = DUMMY ? (float*)(p.ws + 488 * MiB) : p.wt_list(); int* tm = DUMMY ? (int*)(p.ws + 496 * MiB) : p.tokmap();
    const int tid = tid_l, wid = tid >> 6, lane = tid & 63, fr = lane & 15, fq = lane >> 4;
    float* lg = (float*)smem;
    int* wcnt = (int*)(smem + 34816);
    int* pref = wcnt + 512;
    bf16_t* H2lo = (bf16_t*)(p.ws + 325 * MiB);
    for (int item = bid; item < T / 128; item += nb) {
        const int t0 = item * 128 + wid * 16, b = (item * 128) / SEQ;
        const float* msh = p.mod() + (size_t)b * 6 * D + 3 * D; const float* msc = p.mod() + (size_t)b * 6 * D + 4 * D;
#pragma unroll 1
        for (int r0 = 0; r0 < 16; r0 += 4) {
            float4 xv[4][4];
#pragma unroll
            for (int rr = 0; rr < 4; ++rr)
#pragma unroll
                for (int q = 0; q < 4; ++q) { const u32x2 w = *(const u32x2*)(p.X1() + (size_t)(t0 + r0 + rr) * 2048 + q * 256 + lane * 4);
                    xv[rr][q] = make_float4(__uint_as_float(w.x << 16), __uint_as_float(w.x & 0xffff0000u), __uint_as_float(w.y << 16), __uint_as_float(w.y & 0xffff0000u)); }
#pragma unroll
            for (int rr = 0; rr < 4; ++rr) {
                float ss = 0.f;
#pragma unroll
                for (int q = 0; q < 4; ++q) ss += xv[rr][q].x * xv[rr][q].x + xv[rr][q].y * xv[rr][q].y + xv[rr][q].z * xv[rr][q].z + xv[rr][q].w * xv[rr][q].w;
                ss = wave_sum(ss);
                const float rstd = rsqrtf(ss * (1.0f / D) + EPS);
#pragma unroll
                for (int q = 0; q < 4; ++q) {
                    const int c0 = q * 256 + lane * 4;
                    const float4 gg = *(const float4*)(p.norm2_g + c0), sh = *(const float4*)(msh + c0), sc = *(const float4*)(msc + c0);
                    const float h0 = xv[rr][q].x * rstd * gg.x * (1 + sc.x) + sh.x, h1 = xv[rr][q].y * rstd * gg.y * (1 + sc.y) + sh.y;
                    const float h2v = xv[rr][q].z * rstd * gg.z * (1 + sc.z) + sh.z, h3 = xv[rr][q].w * rstd * gg.w * (1 + sc.w) + sh.w;
                    u32x2 wh, wl2; wh.x = cvtpk(h0, h1); wh.y = cvtpk(h2v, h3);
                    wl2.x = cvtpk(h0 - __uint_as_float(wh.x << 16), h1 - __uint_as_float(wh.x & 0xffff0000u));
                    wl2.y = cvtpk(h2v - __uint_as_float(wh.y << 16), h3 - __uint_as_float(wh.y & 0xffff0000u));
                    *(u32x2*)(p.H2() + (size_t)(t0 + r0 + rr) * D + c0) = wh;
                    *(u32x2*)(H2lo + (size_t)(t0 + r0 + rr) * D + c0) = wl2;
                }
            }
        }
        asm volatile("s_waitcnt vmcnt(0)" ::: "memory");
        __syncthreads();
        if (MODE == 3) continue;
        f32x4 acc[4];
#pragma unroll
        for (int nt = 0; nt < 4; ++nt) acc[nt] = (f32x4){0.f, 0.f, 0.f, 0.f};
        {
            const bf16_t* ah_p = p.H2() + (size_t)(t0 + fr) * D + fq * 8; const bf16_t* al_p = H2lo + (size_t)(t0 + fr) * D + fq * 8;
            const int widu = __builtin_amdgcn_readfirstlane(wid);
            unsigned rofs[4];
#pragma unroll
            for (int i = 0; i < 4; ++i) { const int x = wid * 1024 + i * 8192 + lane * 16, row = x >> 8, c = ((x & 255) >> 4) ^ (row & 15); rofs[i] = (unsigned)(row * 2048 + c * 16); }
#define RT_DMA(kc, buf) do { const char* src_ = (const char*)p.routerT() + (size_t)(kc) * 256;                                             \
            _Pragma("unroll") for (int i = 0; i < 4; ++i) __builtin_amdgcn_global_load_lds((const unsigned*)(src_ + rofs[i]), (unsigned*)(smem + 40960 + (buf) * 32768 + widu * 1024 + i * 8192), 16, 0, 0); } while (0)
            RT_DMA(0, 0);
#pragma unroll 1
            for (int kc = 0; kc < 8; ++kc) {
                bf16x8 ah[4], al[4];
#pragma unroll
                for (int ks = 0; ks < 4; ++ks) { ah[ks] = ldfrag(ah_p + kc * 128 + ks * 32); al[ks] = ldfrag(al_p + kc * 128 + ks * 32); }
                asm volatile("s_waitcnt vmcnt(0)" ::: "memory"); __syncthreads();
                if (kc + 1 < 8) RT_DMA(kc + 1, (kc + 1) & 1);
                const char* bb = smem + 40960 + (kc & 1) * 32768;
#pragma unroll
                for (int ks = 0; ks < 4; ++ks)
#pragma unroll
                    for (int nt = 0; nt < 4; ++nt) {
                        const int row = nt * 16 + fr, cc = ((ks * 4 + fq) ^ (row & 15)) * 16;
                        const bf16x8 bh = *(const bf16x8*)(bb + row * 256 + cc), bl = *(const bf16x8*)(bb + (64 + row) * 256 + cc);
                        acc[nt] = __builtin_amdgcn_mfma_f32_16x16x32_bf16(ah[ks], bh, acc[nt], 0, 0, 0);
                        acc[nt] = __builtin_amdgcn_mfma_f32_16x16x32_bf16(ah[ks], bl, acc[nt], 0, 0, 0);
                        acc[nt] = __builtin_amdgcn_mfma_f32_16x16x32_bf16(al[ks], bh, acc[nt], 0, 0, 0);
                    }
            }
#undef RT_DMA
        }
#pragma unroll
        for (int nt = 0; nt < 4; ++nt)
#pragma unroll
            for (int j = 0; j < 4; ++j) lg[(wid * 16 + fq * 4 + j) * 65 + nt * 16 + fr] = acc[nt][j];
        __syncthreads();
        if (MODE == 2) continue;
        int l3 = lane; asm volatile("" : "+v"(l3));
#define SHXF(v_, m_) __int_as_float(__builtin_amdgcn_ds_bpermute((l3 ^ (m_)) << 2, __float_as_int(v_)))
#define SHXI(v_, m_) __builtin_amdgcn_ds_bpermute((l3 ^ (m_)) << 2, (v_))
#define SHBF(v_, src_) __int_as_float(__builtin_amdgcn_ds_bpermute((src_) << 2, __float_as_int(v_)))
#define SHBI(v_, src_) __builtin_amdgcn_ds_bpermute((src_) << 2, (v_))
        const int q4 = l3 & 3, tt = wid * 16 + (l3 >> 2), t = item * 128 + tt, qbase = l3 & ~3;
        float sc_[16], v[16];
#pragma unroll
        for (int i = 0; i < 16; ++i) { const float x = lg[tt * 65 + q4 * 16 + i]; sc_[i] = __builtin_amdgcn_rcpf(1.0f + __builtin_amdgcn_exp2f(-1.4426950408889634f * x)); v[i] = sc_[i] + p.router_b[q4 * 16 + i]; }
        float gsA, gsB;
        { float m1 = v[0], m2 = -INFINITY;
#pragma unroll
          for (int i = 1; i < 8; ++i) { const float x = v[i]; m2 = fmaxf(m2, fminf(m1, x)); m1 = fmaxf(m1, x); }
          gsA = m1 + m2; m1 = v[8]; m2 = -INFINITY;
#pragma unroll
          for (int i = 9; i < 16; ++i) { const float x = v[i]; m2 = fmaxf(m2, fminf(m1, x)); m1 = fmaxf(m1, x); }
          gsB = m1 + m2; }
        { int rankA = 0, rankB = 0;
#pragma unroll
          for (int qq = 0; qq < 4; ++qq) {
              const float ga = SHBF(gsA, qbase | qq), gb = SHBF(gsB, qbase | qq);
              const int g0 = 2 * qq, g1 = 2 * qq + 1, mA = 2 * q4, mB = 2 * q4 + 1;
              rankA += (g0 != mA && (ga > gsA || (ga == gsA && g0 < mA))) ? 1 : 0; rankA += (g1 != mA && (gb > gsA || (gb == gsA && g1 < mA))) ? 1 : 0;
              rankB += (g0 != mB && (ga > gsB || (ga == gsB && g0 < mB))) ? 1 : 0; rankB += (g1 != mB && (gb > gsB || (gb == gsB && g1 < mB))) ? 1 : 0;
          }
          if (rankA >= 4) {
#pragma unroll
              for (int i = 0; i < 8; ++i) v[i] = -INFINITY; }
          if (rankB >= 4) {
#pragma unroll
              for (int i = 8; i < 16; ++i) v[i] = -INFINITY; } }
        unsigned chm = 0u;
#pragma unroll 1
        for (int it = 0; it < 8; ++it) {
            float lm = v[0];
#pragma unroll
            for (int i = 1; i < 16; ++i) lm = fmaxf(lm, v[i]);
            float gm = fmaxf(lm, SHXF(lm, 1)); gm = fmaxf(gm, SHXF(gm, 2));
            int cand = (lm == gm) ? q4 : 4;
            cand = min(cand, SHXI(cand, 1)); cand = min(cand, SHXI(cand, 2));
            const bool win = cand == q4;
            bool found = false;
#pragma unroll
            for (int i = 0; i < 16; ++i) { const bool hit = win && !found && v[i] == gm; if (hit) { chm |= (1u << i); v[i] = -INFINITY; } found = found || hit; }
        }
        float wsum = 0.f;
#pragma unroll
        for (int i = 0; i < 16; ++i) wsum += ((chm >> i) & 1u) ? sc_[i] : 0.f;
        wsum += SHXF(wsum, 1); wsum += SHXF(wsum, 2);
        const float wscale = 2.5f / wsum;
        const unsigned long long pat = 0x1111111111111111ull << q4;
#pragma unroll
        for (int i = 0; i < 16; ++i) { const unsigned long long bal = __ballot((chm >> i) & 1u); if (l3 < 4) wcnt[wid * 64 + l3 * 16 + i] = __popcll(bal & (0x1111111111111111ull << l3)); }
        __syncthreads();
        if (wid == 0) {
            int tot = 0;
#pragma unroll
            for (int w = 0; w < 8; ++w) tot += wcnt[w * 64 + lane];
            int run = atomicAdd(&cntp[lane], tot);
#pragma unroll
            for (int w = 0; w < 8; ++w) { const int c = wcnt[w * 64 + lane]; pref[w * 64 + lane] = run; run += c; }
        }
        __syncthreads();
        {
            const int pc = __popc(chm);
            int kbase = 0;
#pragma unroll
            for (int qq = 0; qq < 3; ++qq) { const int o = SHBI(pc, qbase | qq); kbase += (qq < q4) ? o : 0; }
#pragma unroll
            for (int i = 0; i < 16; ++i) {
                const bool c = (chm >> i) & 1u;
                const unsigned long long bal = __ballot(c);
                if (c) {
                    const int e = q4 * 16 + i;
                    const int slot = pref[wid * 64 + e] + __popcll(bal & pat & ((1ull << l3) - 1ull));
                    tl[(size_t)e * ECAP + slot] = t; wl_[(size_t)e * ECAP + slot] = sc_[i] * wscale;
                    tm[(size_t)t * 8 + kbase + __popc(chm & ((1u << i) - 1u))] = e * ECAP + slot;
                }
            }
        }
    }
}
#undef SHXF
#undef SHXI
#undef SHBF
#undef SHBI

constexpr int MOE_AUX = 162816;
__device__ __forceinline__ void moe_tables(const MK& p, int colt, int* tpre, int* rbase, int tid_l) {
    __syncthreads();
    if (tid_l == 0) { int tp = 0, rb = 0;
        for (int e = 0; e < 65; ++e) { const int c = e < 64 ? p.cnt()[e] : T; tpre[e] = tp; rbase[e] = rb; tp += ((c + 255) >> 8) * colt; rb += c; }
        tpre[65] = tp; rbase[65] = rb; }
    __syncthreads();
}
struct SchedUp { const MK* p; int bid, nb, tid_l, ntiles; const int* tpre; const int* rbase; mutable int e_hint;
    __device__ __forceinline__ bool next(int i, pg8::GUnit& u, unsigned (&vA)[2][2]) const {
        const int tile = xcd_vbid(bid, nb) + i * nb; if (tile >= ntiles) return false;
        int e = e_hint; while (tile >= tpre[e + 1]) ++e; e_hint = e;
        const int j = tile - tpre[e], rt = j >> 1, ct = j & 1, cnt_e = rbase[e + 1] - rbase[e];
        u.A = (const char*)p->H2(); u.B = (const char*)(p->W13t() + ((size_t)e * 512 + ct * 256) * D); u.i0 = e; u.i1 = rt; u.i2 = ct; u.i3 = cnt_e;
#pragma unroll
        for (int i2 = 0; i2 < 2; ++i2) { int R, C; stage_rc(tid_l * 16 + i2 * 8192, R, C);
#pragma unroll
            for (int h = 0; h < 2; ++h) { int slot = rt * 256 + h * 128 + R; if (slot >= cnt_e) slot = 0;
                const int tok = e < 64 ? p->tok_list()[(size_t)e * ECAP + slot] : slot;
                vA[h][i2] = (unsigned)tok * (D * 2u) + (unsigned)C * 2u; } }
        return true; } };
template <bool NOSTORE = false> struct EpiUpT { static constexpr bool PERM = true; const MK* p; const int* rbase;
    __device__ __forceinline__ void operator()(const f32x4 (&acc)[2][2][4][2], const pg8::GUnit& u, int wr, int wc, int fr, int fq) const {
        const int e = u.i0, rt = u.i1, ct = u.i2, cnt_e = u.i3;
        bf16_t* ab = p->ACT() + (size_t)rbase[e] * DE + ct * 128 + wc * 32 + fq * 8;
#pragma unroll
        for (int ai = 0; ai < 2; ++ai)
#pragma unroll
            for (int m = 0; m < 4; ++m) {
                const int slot = rt * 256 + ai * 128 + wr * 64 + m * 16 + fr;
                u32x4 w;
                w.x = cvtpk(silu_fast(acc[ai][0][m][0][0]) * acc[ai][1][m][0][0], silu_fast(acc[ai][0][m][0][1]) * acc[ai][1][m][0][1]);
                w.y = cvtpk(silu_fast(acc[ai][0][m][0][2]) * acc[ai][1][m][0][2], silu_fast(acc[ai][0][m][0][3]) * acc[ai][1][m][0][3]);
                w.z = cvtpk(silu_fast(acc[ai][0][m][1][0]) * acc[ai][1][m][1][0], silu_fast(acc[ai][0][m][1][1]) * acc[ai][1][m][1][1]);
                w.w = cvtpk(silu_fast(acc[ai][0][m][1][2]) * acc[ai][1][m][1][2], silu_fast(acc[ai][0][m][1][3]) * acc[ai][1][m][1][3]);
                if (NOSTORE) { if (slot < -cnt_e) *(u32x4*)(ab + (size_t)slot * DE) = w; } else if (slot < cnt_e) *(u32x4*)(ab + (size_t)slot * DE) = w;
            }
    } };
__device__ __forceinline__ void ph_moe_up(const MK& p, int bid, int nb, int tid_l) {
    int* tpre = (int*)(smem + MOE_AUX); int* rbase = tpre + 80;
    moe_tables(p, 2, tpre, rbase, tid_l);
    SchedUp S{&p, bid, nb, tid_l, tpre[65], tpre, rbase, 0}; EpiUpT<false> E{&p, rbase};
    pg8::gemm<EpiUpT<false>, SchedUp, true, true>(D, S, E, tid_l);
}
constexpr float Y_SCALE = 64.0f;
struct SchedDown { const MK* p; int bid, nb, tid_l, ntiles; const int* tpre; const int* rbase; mutable int e_hint;
    __device__ __forceinline__ bool next(int i, pg8::GUnit& u, unsigned (&vA)[2][2]) const {
        const int tile = xcd_vbid(bid, nb) + i * nb; if (tile >= ntiles) return false;
        int e = e_hint; while (tile >= tpre[e + 1]) ++e; e_hint = e;
        const int j = tile - tpre[e], rt = j >> 2, ct = j & 3, cnt_e = rbase[e + 1] - rbase[e];
        u.A = (const char*)(p->ACT() + (size_t)(rbase[e] + rt * 256) * DE); u.B = (const char*)(p->W2t() + ((size_t)e * D + ct * 256) * DE); u.i0 = e; u.i1 = rt; u.i2 = ct; u.i3 = cnt_e;
        pg8::plain_voffA(DE, vA, tid_l); return true; } };
template <int MODE> struct EpiDown { static constexpr bool PERM = true; const MK* p; const int* rbase;
    __device__ __forceinline__ void operator()(const f32x4 (&acc)[2][2][4][2], const pg8::GUnit& u, int wr, int wc, int fr, int fq) const {
        const int e = u.i0, rt = u.i1, ct = u.i2, cnt_e = u.i3;
        {
            const float* wl = p->wt_list() + (size_t)(e < 64 ? e : 0) * ECAP;
            float wv[2][4];
#pragma unroll
            for (int ai = 0; ai < 2; ++ai)
#pragma unroll
                for (int m = 0; m < 4; ++m) { const int sl = rt * 256 + ai * 128 + wr * 64 + m * 16 + fr; wv[ai][m] = e < 64 ? wl[sl < cnt_e ? sl : 0] * Y_SCALE : Y_SCALE; }
            const int wid = wr * 4 + wc, lane = fq * 16 + fr;
            char* wa = smem + 131072 + wid * 3968;
            unsigned char* yb = p->Y() + (size_t)rbase[e] * D + ct * 256 + wc * 64 + (lane & 3) * 16;
#pragma unroll
            for (int ai = 0; ai < 2; ++ai)
#pragma unroll
                for (int m = 0; m < 4; ++m) {
                    const float w = wv[ai][m];
                    char* img = wa + ((m & 1) ? 1280 : 0);
#pragma unroll
                    for (int bj = 0; bj < 2; ++bj) {
                        u32x2 pk;
#pragma unroll
                        for (int n = 0; n < 2; ++n) {
                            float v0 = __builtin_amdgcn_fmed3f(acc[ai][bj][m][n][0] * w, -448.f, 448.f), v1 = __builtin_amdgcn_fmed3f(acc[ai][bj][m][n][1] * w, -448.f, 448.f);
                            float v2 = __builtin_amdgcn_fmed3f(acc[ai][bj][m][n][2] * w, -448.f, 448.f), v3 = __builtin_amdgcn_fmed3f(acc[ai][bj][m][n][3] * w, -448.f, 448.f);
                            int q = 0; q = __builtin_amdgcn_cvt_pk_fp8_f32(v0, v1, q, false); q = __builtin_amdgcn_cvt_pk_fp8_f32(v2, v3, q, true);
                            if (n == 0) pk.x = (unsigned)q; else pk.y = (unsigned)q;
                        }
                        *(u32x2*)(img + fr * 80 + bj * 32 + fq * 8) = pk;
                    }
                    asm volatile("s_waitcnt lgkmcnt(0)" ::: "memory");
                    const int rr = lane >> 2, slot = rt * 256 + ai * 128 + wr * 64 + m * 16 + rr;
                    const u32x4 v = *(const u32x4*)(img + rr * 80 + (lane & 3) * 16);
                    if (MODE == 1) asm volatile("" :: "v"(v)); else if (slot < cnt_e) *(u32x4*)(yb + (size_t)slot * D) = v;
                }
        }
    } };
template <bool DUMMY, int MODE = 0> __device__ __forceinline__ void ph_moe_down(const MK& p, int bid, int nb, int tid_l) {
    int* tpre = (int*)(smem + MOE_AUX); int* rbase = tpre + 80;
    moe_tables(p, 4, tpre, rbase, tid_l);
    SchedDown S{&p, bid, nb, tid_l, DUMMY ? tpre[64] : tpre[65], tpre, rbase, 0}; EpiDown<MODE> E{&p, rbase};
    pg8::gemm<EpiDown<MODE>, SchedDown, false, true>(DE, S, E, tid_l);
}

#if DUP >= 21 && DUP <= 29
template <bool PERM_> struct EpiNull { static constexpr bool PERM = PERM_;
    __device__ __forceinline__ void operator()(const f32x4 (&acc)[2][2][4][2], const pg8::GUnit& u, int wr, int wc, int fr, int fq) const {
#pragma unroll
        for (int a = 0; a < 2; ++a)
#pragma unroll
            for (int b = 0; b < 2; ++b)
#pragma unroll
                for (int m = 0; m < 4; ++m) { asm volatile("" :: "v"(acc[a][b][m][0]), "v"(acc[a][b][m][1])); }
    } };
__device__ __forceinline__ void ph_probe_in(const MK& p, int bid, int nb, int tid_l) { SchedIn S{&p, bid, nb, tid_l}; EpiNull<false> E; pg8::gemm<EpiNull<false>, SchedIn, false, true>(D, S, E, tid_l); }
__device__ __forceinline__ void ph_probe_out(const MK& p, int bid, int nb, int tid_l) { SchedOut S{&p, bid, nb, tid_l}; EpiNull<true> E; pg8::gemm<EpiNull<true>, SchedOut, false, true>(D, S, E, tid_l); }
__device__ __forceinline__ void ph_probe_up(const MK& p, int bid, int nb, int tid_l) {
    int* tpre = (int*)(smem + MOE_AUX); int* rbase = tpre + 80; moe_tables(p, 2, tpre, rbase, tid_l);
    SchedUp S{&p, bid, nb, tid_l, tpre[65], tpre, rbase, 0}; EpiNull<true> E; pg8::gemm<EpiNull<true>, SchedUp, true, true>(D, S, E, tid_l); }
__device__ __forceinline__ void ph_probe_up_nostore(const MK& p, int bid, int nb, int tid_l) {
    int* tpre = (int*)(smem + MOE_AUX); int* rbase = tpre + 80; moe_tables(p, 2, tpre, rbase, tid_l);
    SchedUp S{&p, bid, nb, tid_l, tpre[65], tpre, rbase, 0}; EpiUpT<true> E{&p, rbase}; pg8::gemm<EpiUpT<true>, SchedUp, true, true>(D, S, E, tid_l); }
__device__ __forceinline__ void ph_probe_down(const MK& p, int bid, int nb, int tid_l) {
    int* tpre = (int*)(smem + MOE_AUX); int* rbase = tpre + 80; moe_tables(p, 4, tpre, rbase, tid_l);
    SchedDown S{&p, bid, nb, tid_l, tpre[65], tpre, rbase, 0}; EpiNull<true> E; pg8::gemm<EpiNull<true>, SchedDown, false, true>(DE, S, E, tid_l); }
#endif
template <bool DUMMY> __device__ __forceinline__ void ph_final(const MK& p, int bid, int nb, int tid_l) {
    const int wid = tid_l >> 6, lane = tid_l & 63;
    int* tpre = (int*)(smem + MOE_AUX); int* rbase = tpre + 80;
    moe_tables(p, 1, tpre, rbase, tid_l);
    for (int t = bid * 8 + wid; t < T; t += nb * 8) {
        const int b = t / SEQ;
        float f[16];
#pragma unroll
        for (int i = 0; i < 16; ++i) f[i] = 0.f;
#pragma unroll
        for (int k = 0; k < 9; ++k) {
            int row;
            if (k < 8) { const int id = p.tokmap()[(size_t)t * 8 + k], e = id >> 15, slot = id & (ECAP - 1); row = rbase[e] + slot; } else row = rbase[64] + t;
            const unsigned char* yr = p.Y() + (size_t)row * D + lane * 4;
#pragma unroll
            for (int q = 0; q < 4; ++q) {
                const int w = *(const int*)(yr + q * 256);
                const auto lo = __builtin_amdgcn_cvt_pk_f32_fp8(w, false); const auto hi = __builtin_amdgcn_cvt_pk_f32_fp8(w, true);
                f[q * 4 + 0] += lo[0]; f[q * 4 + 1] += lo[1]; f[q * 4 + 2] += hi[0]; f[q * 4 + 3] += hi[1];
            }
        }
        const int pcol = ((lane >> 3) & 1) * 128 + (lane >> 4) * 32 + (lane & 7) * 4;
        const float* g2 = p.mod() + (size_t)b * 6 * D + 5 * D + pcol;
        const bf16_t* x1 = p.X1() + (size_t)t * 2048 + pcol;
        float* xo = p.out + (size_t)t * D + pcol;
        float v[16]; float ss = 0.f;
#pragma unroll
        for (int q = 0; q < 4; ++q) {
            const u32x2 xw = *(const u32x2*)(x1 + q * 256); const float4 g = *(const float4*)(g2 + q * 256);
            v[q * 4 + 0] = __uint_as_float(xw.x << 16) + g.x * f[q * 4 + 0] * (1.0f / Y_SCALE); v[q * 4 + 1] = __uint_as_float(xw.x & 0xffff0000u) + g.y * f[q * 4 + 1] * (1.0f / Y_SCALE);
            v[q * 4 + 2] = __uint_as_float(xw.y << 16) + g.z * f[q * 4 + 2] * (1.0f / Y_SCALE); v[q * 4 + 3] = __uint_as_float(xw.y & 0xffff0000u) + g.w * f[q * 4 + 3] * (1.0f / Y_SCALE);
            ss += v[q * 4] * v[q * 4] + v[q * 4 + 1] * v[q * 4 + 1] + v[q * 4 + 2] * v[q * 4 + 2] + v[q * 4 + 3] * v[q * 4 + 3];
        }
        ss = wave_sum(ss);
        const float rstd = rsqrtf(ss * (1.0f / D) + EPS);
#pragma unroll
        for (int q = 0; q < 4; ++q) {
            const float4 gf = *(const float4*)(p.final_g + q * 256 + pcol);
            *(float4*)((DUMMY ? (float*)(p.ws + 42 * MiB) + (size_t)t * D + pcol : xo) + q * 256) = make_float4(v[q * 4] * rstd * gf.x, v[q * 4 + 1] * rstd * gf.y, v[q * 4 + 2] * rstd * gf.z, v[q * 4 + 3] * rstd * gf.w);
        }
    }
}


#define XB_TMO      128
#define XB_XCNT(j)  (256  + 64 * (j))
#define XB_XSUB(j)  (1280 + 64 * (j))
#define XB_XGEN(j)  (2304 + 64 * (j))
#define XB_TOP      3328
#define XB_TOPGEN   3392
#define XCD_BAR_WORDS 3456
#define XB_SPIN_CAP (1u << 22)
#define LAS __attribute__((address_space(3)))
__device__ __forceinline__ unsigned xb_ld(unsigned* p)              { return __hip_atomic_load(p, __ATOMIC_RELAXED, __HIP_MEMORY_SCOPE_AGENT); }
__device__ __forceinline__ unsigned xb_add(unsigned* p, unsigned v) { return __hip_atomic_fetch_add(p, v, __ATOMIC_RELAXED, __HIP_MEMORY_SCOPE_AGENT); }
__device__ __forceinline__ unsigned xb_xcc_id() { return (unsigned)__builtin_amdgcn_s_getreg((3 << 11) | 20) & 0xFu; }
#define XB_SPIN(cond, bar) do { unsigned _sp = 0; while (cond) { __builtin_amdgcn_s_sleep(1); \
    if ((++_sp & 255u) == 0u) { if (xb_ld(&(bar)[XB_TMO])) break; if (_sp > XB_SPIN_CAP) { atomicAdd(&(bar)[XB_TMO], 1u); break; } } } } while (0)
struct XcdBarrier { unsigned* bar; unsigned x; volatile LAS unsigned* st; };
__device__ __forceinline__ XcdBarrier xcd_barrier_post(unsigned* bar, volatile LAS unsigned* st, int tid) {
    XcdBarrier b; b.bar = bar; b.x = xb_xcc_id(); b.st = st;
    if (tid == 0) (void)xb_add(&bar[XB_XCNT(b.x)], 1u);
    return b;
}
__device__ __forceinline__ void xcd_barrier_complete(unsigned* bar, unsigned x, unsigned& nloc, unsigned& nx) {
    const unsigned G = gridDim.x * gridDim.y * gridDim.z;
    unsigned sum, cnt, mine, sp = 0u;
    for (;;) {
        sum = 0u; cnt = 0u; mine = 0u;
#pragma unroll
        for (unsigned j = 0; j < 16; ++j) { const unsigned c = xb_ld(&bar[XB_XCNT(j)]); sum += c; cnt += (c > 0u) ? 1u : 0u; mine = (j == x) ? c : mine; }
        if (sum == G) break;
        __builtin_amdgcn_s_sleep(1);
        if ((++sp & 255u) == 0u) { if (xb_ld(&bar[XB_TMO])) break; if (sp > XB_SPIN_CAP) { atomicAdd(&bar[XB_TMO], 1u); break; } }
    }
    nloc = mine > 0u ? mine : 1u; nx = cnt > 0u ? cnt : 1u;
}
__device__ __forceinline__ void xcd_barrier(const XcdBarrier& b, int tid) {
    asm volatile("s_waitcnt vmcnt(0)" ::: "memory");
    __syncthreads();
    if (tid == 0) {
        unsigned* bar = b.bar;
        __builtin_amdgcn_s_waitcnt(0);
        unsigned nloc = b.st[0], nx = b.st[1];
        if (nloc == 0u) { xcd_barrier_complete(bar, b.x, nloc, nx); b.st[0] = nloc; b.st[1] = nx; }
        const unsigned old = xb_add(&bar[XB_XSUB(b.x)], 1u);
        const unsigned gen = old / nloc;
        if (old + 1u == (gen + 1u) * nloc) {
            __builtin_amdgcn_fence(__ATOMIC_RELEASE, "agent");
            asm volatile("s_waitcnt vmcnt(0)" ::: "memory");
            const unsigned og = xb_add(&bar[XB_TOP], 1u);
            const unsigned tg = og / nx;
            if (og + 1u == (tg + 1u) * nx) xb_add(&bar[XB_TOPGEN], 1u);
            else XB_SPIN(xb_ld(&bar[XB_TOPGEN]) == tg, bar);
            __builtin_amdgcn_fence(__ATOMIC_ACQUIRE, "agent");
            xb_add(&bar[XB_XGEN(b.x)], 1u);
            asm volatile("s_waitcnt vmcnt(0)" ::: "memory");
        } else {
            XB_SPIN(xb_ld(&bar[XB_XGEN(b.x)]) == gen, bar);
            __builtin_amdgcn_fence(__ATOMIC_ACQUIRE, "agent");
            asm volatile("s_waitcnt vmcnt(0)" ::: "memory");
        }
    }
    __syncthreads();
}

__device__ __forceinline__ int lane_id_volatile() { int l; asm volatile("v_mbcnt_lo_u32_b32 %0, -1, 0\n\tv_mbcnt_hi_u32_b32 %0, -1, %0" : "=v"(l)); return l; }
__global__ __launch_bounds__(512, 2) void k_mega(MK p) {
    cg::grid_group grid = cg::this_grid();
    const int bid = blockIdx.x, nb = gridDim.x;
    volatile LAS unsigned* xst = (volatile LAS unsigned*)(smem + 162816 + 768);
    if (threadIdx.x < 4) xst[threadIdx.x] = 0u;
    __syncthreads();
    const XcdBarrier xb = xcd_barrier_post((unsigned*)(p.ws + 524288), xst, (int)threadIdx.x);
    const int wv_ = __builtin_amdgcn_readfirstlane((int)threadIdx.x >> 6);
#define LANE_ID() lane_id_volatile()
#define PH_TID() int t_ = wv_ * 64 + LANE_ID(); asm volatile("" : "+v"(t_))
    { PH_TID(); if (bid == 0 && t_ < 256) p.cnt()[t_] = 0; ph_mod(p, bid, nb, t_); ph_convert(p, bid, nb, t_); }
#if DUP == 10
    { PH_TID(); ph_convert(p, bid, nb, t_); }
#endif
#if DUP == 12
    { PH_TID(); ph_mod(p, bid, nb, t_); }
#endif
    grid.sync();
    { PH_TID(); ph_ln1(p, bid, nb, t_); }
#if DUP == 1
    { PH_TID(); ph_ln1(p, bid, nb, t_); }
#endif
    xcd_barrier(xb, wv_ * 64 + LANE_ID());
    { PH_TID(); ph_gemm_in(p, bid, nb, t_); }
    { PH_TID(); ph_convert_dyn(p, t_); }
#if DUP == 2
    { PH_TID(); ph_gemm_in(p, bid, nb, t_); }
#endif
#if DUP == 21
    { PH_TID(); ph_probe_in(p, bid, nb, t_); }
#endif
    xcd_barrier(xb, wv_ * 64 + LANE_ID());
    { PH_TID(); ph_attn<0>(p, bid, nb, t_); }
#if DUP == 3
    { PH_TID(); ph_attn<2>(p, bid, nb, t_); }
#endif
#if DUP == 31
    { PH_TID(); ph_attn<1>(p, bid, nb, t_); }
#endif
#if DUP == 33
    { PH_TID(); ph_attn<3>(p, bid, nb, t_); }
#endif
    { PH_TID(); ph_kv(p, bid, nb, t_); }
#if DUP == 11
    { PH_TID(); ph_kv(p, bid, nb, t_); }
#endif
    xcd_barrier(xb, wv_ * 64 + LANE_ID());
    { PH_TID(); ph_scan(p, bid, nb, t_); }
#if DUP == 4
    { PH_TID(); ph_scan(p, bid, nb, t_); }
#endif
    xcd_barrier(xb, wv_ * 64 + LANE_ID());
    { PH_TID(); ph_ret(p, bid, nb, t_); }
#if DUP == 5
    { PH_TID(); ph_ret(p, bid, nb, t_); }
#endif
    xcd_barrier(xb, wv_ * 64 + LANE_ID());
    { PH_TID(); ph_gemm_out(p, bid, nb, t_); }
#if DUP == 6
    { PH_TID(); ph_gemm_out(p, bid, nb, t_); }
#endif
#if DUP == 22
    { PH_TID(); ph_probe_out(p, bid, nb, t_); }
#endif
    xcd_barrier(xb, wv_ * 64 + LANE_ID());
#if DUP == 7
    { PH_TID(); ph_route<true>(p, bid, nb, t_); }
#endif
#if DUP == 72
    { PH_TID(); ph_route<true, 2>(p, bid, nb, t_); }
#endif
#if DUP == 73
    { PH_TID(); ph_route<true, 3>(p, bid, nb, t_); }
#endif
    { PH_TID(); ph_route<false>(p, bid, nb, t_); }
    xcd_barrier(xb, wv_ * 64 + LANE_ID());
    { PH_TID(); ph_moe_up(p, bid, nb, t_); }
#if DUP == 8
    { PH_TID(); ph_moe_up(p, bid, nb, t_); }
#endif
#if DUP == 23
    { PH_TID(); ph_probe_up(p, bid, nb, t_); }
#endif
#if DUP == 25
    { PH_TID(); ph_probe_up_nostore(p, bid, nb, t_); }
#endif
    xcd_barrier(xb, wv_ * 64 + LANE_ID());
#if DUP == 9
    { PH_TID(); ph_moe_down<true>(p, bid, nb, t_); }
#endif
#if DUP == 91
    { PH_TID(); ph_moe_down<true, 1>(p, bid, nb, t_); }
#endif
    { PH_TID(); ph_moe_down<false>(p, bid, nb, t_); }
#if DUP == 24
    { PH_TID(); ph_probe_down(p, bid, nb, t_); }
#endif
    xcd_barrier(xb, wv_ * 64 + LANE_ID());
#if DUP == 13
    { PH_TID(); ph_final<true>(p, bid, nb, t_); }
#endif
    { PH_TID(); ph_final<false>(p, bid, nb, t_); }
#undef PH_TID
#undef LANE_ID
}
constexpr int LDS_TOTAL = 163840;
extern "C" void kernel_launch(void* const* d_in, const int* in_sizes, int n_in, void* d_out, int out_size, void* d_ws, size_t ws_size, hipStream_t stream) {
    char* ws = (char*)d_ws;
    MK mk{};
    mk.x = (const float*)d_in[0]; mk.c = (const float*)d_in[1]; mk.ctx = (const float*)d_in[2]; mk.cctx = (const float*)d_in[3]; mk.ada_w = (const float*)d_in[4]; mk.ada_b = (const float*)d_in[5];
    mk.norm1_g = (const float*)d_in[6]; mk.w_in = (const float*)d_in[7]; mk.lq1 = (const float*)d_in[8]; mk.lk1 = (const float*)d_in[9]; mk.lq2 = (const float*)d_in[10]; mk.lk2 = (const float*)d_in[11];
    mk.dattn_g = (const float*)d_in[12]; mk.dec_f = (const float*)d_in[13]; mk.dec_b = (const float*)d_in[14]; mk.ret_g = (const float*)d_in[15]; mk.w_out = (const float*)d_in[16];
    mk.norm2_g = (const float*)d_in[17]; mk.router_w = (const float*)d_in[18]; mk.router_b = (const float*)d_in[19]; mk.ew1 = (const float*)d_in[20]; mk.ew3 = (const float*)d_in[21];
    mk.ew2 = (const float*)d_in[22]; mk.sw1 = (const float*)d_in[23]; mk.sw3 = (const float*)d_in[24]; mk.sw2 = (const float*)d_in[25]; mk.final_g = (const float*)d_in[26];
    mk.out = (float*)d_out;
    mk.ws = ws;
    mk.dbgP = nullptr; mk.dbg_lo = 0; mk.dbg_hi = 12; mk.conv_limit = 1 << 30;
    static int grid_blocks = 0;
    if (!grid_blocks) {
        (void)hipFuncSetAttribute((const void*)k_mega, hipFuncAttributeMaxDynamicSharedMemorySize, LDS_TOTAL);
        int dev = 0, cus = 0, per_cu = 0;
        (void)hipGetDevice(&dev);
        (void)hipDeviceGetAttribute(&cus, hipDeviceAttributeMultiprocessorCount, dev);
        (void)hipOccupancyMaxActiveBlocksPerMultiprocessor(&per_cu, k_mega, 512, LDS_TOTAL);
        if (per_cu > 1) per_cu = 1;
        grid_blocks = cus * per_cu;
        if (grid_blocks <= 0) { fprintf(stderr, "occupancy query failed: cus %d per_cu %d\n", cus, per_cu); grid_blocks = 256; }
    }
    (void)hipMemsetAsync(ws + 524288, 0, XCD_BAR_WORDS * 4, stream);
    void* args[] = {&mk};
    hipError_t e = hipLaunchCooperativeKernel((void*)k_mega, dim3(grid_blocks), dim3(512), args, LDS_TOTAL, stream);
    if (e != hipSuccess) fprintf(stderr, "cooperative launch failed: %s (grid %d)\n", hipGetErrorString(e), grid_blocks);
}
```

```cpp
#include <hip/hip_runtime.h>
#include <hip/hip_cooperative_groups.h>
#include <cstdio>
namespace cg = cooperative_groups;
#ifndef DUP
#define DUP 0
#endif
#include <stdint.h>

constexpr int D = 1024, NB = 4, SEQ = 8192, CTX = 256, RB = SEQ + CTX  , NR = NB * RB  , T = NB * SEQ;
constexpr int NE = 64, DE = 256, ECAP = 32768;
constexpr float EPS = 1e-6f;
typedef unsigned short bf16_t;

__device__ __forceinline__ float siluf(float v) { return v / (1.0f + expf(-v)); }
__device__ __forceinline__ float silu_fast(float v) { return v * __builtin_amdgcn_rcpf(1.0f + __builtin_amdgcn_exp2f(-1.4426950408889634f * v)); }
__device__ __forceinline__ float wave_sum(float v) {
#pragma unroll
    for (int o = 32; o > 0; o >>= 1) v += __shfl_xor(v, o);
    return v;
}
__device__ __forceinline__ float wave_max(float v) {
#pragma unroll
    for (int o = 32; o > 0; o >>= 1) v = fmaxf(v, __shfl_xor(v, o));
    return v;
}
__device__ __forceinline__ float block_sum(float v, float* red) {
    v = wave_sum(v);
    __syncthreads();
    if ((threadIdx.x & 63) == 0) red[threadIdx.x >> 6] = v;
    __syncthreads();
    return red[0] + red[1] + red[2] + red[3];
}
__device__ __forceinline__ float block_max(float v, float* red) {
    v = wave_max(v);
    __syncthreads();
    if ((threadIdx.x & 63) == 0) red[threadIdx.x >> 6] = v;
    __syncthreads();
    return fmaxf(fmaxf(red[0], red[1]), fmaxf(red[2], red[3]));
}

typedef short bf16x8 __attribute__((ext_vector_type(8)));
typedef short s16x4 __attribute__((ext_vector_type(4)));
typedef float f32x4 __attribute__((ext_vector_type(4)));
typedef float f32x16 __attribute__((ext_vector_type(16)));
typedef unsigned u32x2 __attribute__((ext_vector_type(2)));
typedef unsigned u32x4 __attribute__((ext_vector_type(4)));
extern __shared__ __attribute__((aligned(1024))) char smem[];
constexpr int NTHR = 512;
constexpr int GEMM_LDS = 131072;

__device__ __forceinline__ unsigned cvtpk(float lo, float hi) { unsigned r; asm volatile("v_cvt_pk_bf16_f32 %0, %1, %2" : "=v"(r) : "v"(lo), "v"(hi)); return r; }
__device__ __forceinline__ bf16_t f2bf(float v) { return (bf16_t)(cvtpk(v, v) & 0xffffu); }
__device__ __forceinline__ float bf2f(bf16_t v) { return __uint_as_float(((unsigned)v) << 16); }

constexpr size_t MiB = 1048576;
struct MK {
    const float *x, *c, *ctx, *cctx, *ada_w, *ada_b, *norm1_g, *w_in, *lq1, *lk1, *lq2, *lk2, *dattn_g, *dec_f, *dec_b, *ret_g, *w_out, *norm2_g, *router_w, *router_b,
        *ew1, *ew3, *ew2, *sw1, *sw3, *sw2, *final_g;
    float* out; char* ws;
    float* dbgP; long dbg_lo, dbg_hi; long conv_limit;
#define WSF(name, type, off) __device__ __forceinline__ type* name() const { return (type*)(ws + (off)); }
    WSF(mod, float, 0) WSF(cnt, int, 131072) WSF(ropec, float, 262144) WSF(ropes, float, 262144 + 8192)
    WSF(w_inT, bf16_t, 1 * MiB) WSF(w_outT, bf16_t, 7 * MiB) WSF(routerT, bf16_t, 9 * MiB) WSF(W2t, bf16_t, 9 * MiB + 524288)
    WSF(H, bf16_t, 42 * MiB) WSF(MIX, bf16_t, 42 * MiB) WSF(KV, bf16_t, 112 * MiB) WSF(ST, bf16_t, 147 * MiB) WSF(ACT, bf16_t, 42 * MiB)
    WSF(W13t, bf16_t, 194 * MiB) WSF(H2, bf16_t, 260 * MiB)
    WSF(Q, bf16_t, 260 * MiB) WSF(K, bf16_t, 292 * MiB) WSF(V, bf16_t, 325 * MiB) WSF(RQ, bf16_t, 358 * MiB) WSF(RK, bf16_t, 375 * MiB)
    WSF(KTf, bf16_t, 392 * MiB) WSF(KTb, bf16_t, 409 * MiB) WSF(VT, bf16_t, 426 * MiB) WSF(RG, bf16_t, 459 * MiB)
    WSF(Y, unsigned char, 194 * MiB) WSF(tok_list, int, 484 * MiB) WSF(wt_list, float, 492 * MiB) WSF(tokmap, int, 500 * MiB)
    __device__ __forceinline__ bf16_t* X1() const { return (bf16_t*)out; }
#undef WSF
};

__device__ __forceinline__ void ph_mod(const MK& p, int bid, int nb, int tid_l) {
    float* sl = (float*)smem;
    float* red = (float*)(smem + 32768);
    if (bid < 6 * D / 32) {
        for (int i = tid_l; i < 5 * D; i += NTHR) { const int r = i >> 10, k = i & 1023; const float cv = r < 4 ? p.c[r * D + k] : p.cctx[k]; sl[k * 8 + r] = siluf(cv); }
    }
    __syncthreads();
    for (int it = bid; it < 6 * D / 32; it += nb) {
        const int col = tid_l & 31, kg = tid_l >> 5, j = it * 32 + col;
        const float* wp = p.ada_w + (size_t)(kg * 64) * 6 * D + j;
        float a[5] = {0, 0, 0, 0, 0};
#pragma unroll 1
        for (int k0 = 0; k0 < 64; k0 += 16) {
            float w[16];
#pragma unroll
            for (int kk = 0; kk < 16; ++kk) w[kk] = wp[(size_t)(k0 + kk) * 6 * D];
#pragma unroll
            for (int kk = 0; kk < 16; ++kk) {
                const float4 s4 = *(const float4*)(sl + (kg * 64 + k0 + kk) * 8); const float s5 = sl[(kg * 64 + k0 + kk) * 8 + 4];
                a[0] += s4.x * w[kk]; a[1] += s4.y * w[kk]; a[2] += s4.z * w[kk]; a[3] += s4.w * w[kk]; a[4] += s5 * w[kk];
            }
        }
        __syncthreads();
#pragma unroll
        for (int r = 0; r < 5; ++r) red[(kg * 5 + r) * 32 + col] = a[r];
        __syncthreads();
        if (tid_l < 160) {
            int r = tid_l >> 5; float s = 0;
            for (int g = 0; g < 16; ++g) s += red[(g * 5 + r) * 32 + col];
            p.mod()[(size_t)r * 6 * D + j] = s + p.ada_b[j];
        }
    }
    if (bid == nb - 1) {
        for (int i = tid_l; i < 128 * 16; i += NTHR) {
            int pos = i >> 4, f = i & 15;
            float inv_freq = exp2f(-(float)f * (13.287712379549449f / 16.0f));
            float s, c; sincosf((float)pos * inv_freq, &s, &c);
            p.ropec()[i] = c; p.ropes()[i] = s;
        }
    }
    __syncthreads();
}

__device__ __forceinline__ void tr_tile(const float* src, int ldsrc, int k0, int n0, bf16_t* dst, int lddst, int mode  , bf16_t* dst2, int tid_l) {
    float* t = (float*)smem;
    __syncthreads();
    for (int i = tid_l; i < 64 * 16; i += NTHR) {
        int r = i >> 4, c4 = (i & 15) * 4;
        float4 v = *(const float4*)(src + (size_t)(k0 + r) * ldsrc + n0 + c4);
        t[r * 65 + c4] = v.x; t[r * 65 + c4 + 1] = v.y; t[r * 65 + c4 + 2] = v.z; t[r * 65 + c4 + 3] = v.w;
    }
    __syncthreads();
    for (int i = tid_l; i < 64 * 16; i += NTHR) {
        int n = i >> 4, k4 = (i & 15) * 4;
        float a = t[(k4 + 0) * 65 + n], b = t[(k4 + 1) * 65 + n], c = t[(k4 + 2) * 65 + n], d = t[(k4 + 3) * 65 + n];
        int nn = n0 + n, row = nn;
        if (mode == 1 || mode == 2) { int ct = nn >> 7; row = ct * 256 + (mode == 2 ? 128 : 0) + (nn & 127); }
        u32x2 w; w.x = cvtpk(a, b); w.y = cvtpk(c, d);
        *(u32x2*)(dst + (size_t)row * lddst + k0 + k4) = w;
        if (mode == 3) {
            float ah = bf2f((bf16_t)(w.x & 0xffff)), bh = bf2f((bf16_t)(w.x >> 16)), ch = bf2f((bf16_t)(w.y & 0xffff)), dh = bf2f((bf16_t)(w.y >> 16));
            u32x2 l; l.x = cvtpk(a - ah, b - bh); l.y = cvtpk(c - ch, d - dh);
            *(u32x2*)(dst2 + (size_t)row * lddst + k0 + k4) = l;
        }
    }
}
constexpr int CV_STATIC = 16 * 48 + 16 * 16 + 16, CV_E13 = 65 * 2 * 16 * 4, CV_E2 = 65 * 4 * 16, CV_TOTAL = CV_STATIC + CV_E13 + CV_E2;
__device__ __forceinline__ void convert_tile(const MK& p, int j, int tid_l) {
    const int n_win = 16 * 48, n_wout = 16 * 16, n_rt = 16;
    if (j < n_win) { tr_tile(p.w_in, 3072, (j / 48) * 64, (j % 48) * 64, p.w_inT(), 1024, 0, nullptr, tid_l); return; } j -= n_win;
    if (j < n_wout) { tr_tile(p.w_out, 1024, (j / 16) * 64, (j % 16) * 64, p.w_outT(), 1024, 0, nullptr, tid_l); return; } j -= n_wout;
    if (j < n_rt) { tr_tile(p.router_w, 64, j * 64, 0, p.routerT(), 1024, 3, p.routerT() + 64 * 1024, tid_l); return; } j -= n_rt;
    if (j < CV_E13) {
        int e = j / 128, r = j % 128, which = r / 64, tt = r % 64;
        const float* src = e < 64 ? (which ? p.ew3 : p.ew1) + (size_t)e * D * DE : (which ? p.sw3 : p.sw1);
        tr_tile(src, DE, (tt / 4) * 64, (tt % 4) * 64, p.W13t() + (size_t)e * 512 * 1024, 1024, 1 + which, nullptr, tid_l); return; } j -= CV_E13;
    { int e = j / 64, tt = j % 64;
      const float* src = e < 64 ? p.ew2 + (size_t)e * DE * D : p.sw2;
      tr_tile(src, D, (tt / 16) * 64, (tt % 16) * 64, p.W2t() + (size_t)e * 1024 * 256, 256, 0, nullptr, tid_l); }
}
__device__ __forceinline__ void ph_convert(const MK& p, int bid, int nb, int tid_l) {
    for (int it = bid; it < CV_STATIC; it += nb) convert_tile(p, it, tid_l);
    __syncthreads();
}
template <int LDSRC> __device__ __forceinline__ void tr_wave(const float* __restrict__ src, int k0, int n0, bf16_t* __restrict__ dst, int lddst, int mode, int lane, char* tb) {
    const int n4 = lane & 15, kg = lane >> 4;
    const float* s0 = src + (size_t)(k0 + kg * 16) * LDSRC + n0 + n4 * 4;
    f32x4 v[16];
#pragma unroll
    for (int it = 0; it < 16; ++it) v[it] = *(const f32x4*)(s0 + (size_t)it * LDSRC);
#pragma unroll
    for (int jn = 0; jn < 4; ++jn) {
        const int n = n4 * 4 + jn;
#pragma unroll
        for (int h = 0; h < 2; ++h) {
            const u32x4 w = {cvtpk(v[h * 8][jn], v[h * 8 + 1][jn]), cvtpk(v[h * 8 + 2][jn], v[h * 8 + 3][jn]), cvtpk(v[h * 8 + 4][jn], v[h * 8 + 5][jn]), cvtpk(v[h * 8 + 6][jn], v[h * 8 + 7][jn])};
            *(u32x4*)(tb + n * 128 + (((kg * 2 + h) ^ (n4 & 7)) << 4)) = w;
        }
    }
    asm volatile("s_waitcnt lgkmcnt(0)" ::: "memory");
#pragma unroll
    for (int it = 0; it < 8; ++it) {
        const int n = it * 8 + (lane >> 3), c = lane & 7;
        const u32x4 w = *(const u32x4*)(tb + n * 128 + ((c ^ ((n >> 2) & 7)) << 4));
        const int nn = n0 + n; int row = nn;
        if (mode == 1 || mode == 2) { const int ct = nn >> 7; row = ct * 256 + (mode == 2 ? 128 : 0) + (nn & 127); }
        *(u32x4*)(dst + (size_t)row * lddst + k0 + c * 8) = w;
    }
}
__device__ __forceinline__ void convert_tile_wave(const MK& p, int j, int lane, char* tb) {
    if (j < CV_E13) {
        const int e = j / 128, r = j % 128, which = r / 64, tt = r % 64;
        const float* src = e < 64 ? (which ? p.ew3 : p.ew1) + (size_t)e * D * DE : (which ? p.sw3 : p.sw1);
        tr_wave<DE>(src, (tt / 4) * 64, (tt % 4) * 64, p.W13t() + (size_t)e * 512 * 1024, 1024, 1 + which, lane, tb); return; }
    j -= CV_E13;
    { const int e = j / 64, tt = j % 64;
      const float* src = e < 64 ? p.ew2 + (size_t)e * DE * D : p.sw2;
      tr_wave<D>(src, (tt / 16) * 64, (tt % 16) * 64, p.W2t() + (size_t)e * 1024 * 256, 256, 0, lane, tb); }
}
__device__ __forceinline__ void ph_convert_dyn(const MK& p, int tid_l) {
    const int lane = tid_l & 63;
    char* tb = smem + (tid_l >> 6) * 8192;
    __syncthreads();
    for (;;) {
        int j = 0;
        if (lane == 0) j = atomicAdd(&p.cnt()[200], 8);
        j = __builtin_amdgcn_readfirstlane(j);
        if (j >= CV_E13) break;
#pragma unroll 1
        for (int k = 0; k < 8; ++k) if (j + k < CV_E13) convert_tile_wave(p, j + k, lane, tb);
    }
}

__device__ __forceinline__ void ph_ln1(const MK& p, int bid, int nb, int tid_l) {
    const int wid = tid_l >> 6, lane = tid_l & 63;
    for (int R = bid * 8 + wid; R < NR; R += nb * 8) {
        int b = R / RB, i = R % RB;
        const float* src = i < CTX ? p.ctx + ((size_t)b * CTX + i) * D : p.x + ((size_t)b * SEQ + (i - CTX)) * D;
        const float* m = p.mod() + (size_t)(i < CTX ? 4 : b) * 6 * D;
        float4 v[4]; float ss = 0;
#pragma unroll
        for (int q = 0; q < 4; ++q) { v[q] = *(const float4*)(src + q * 256 + lane * 4); ss += v[q].x * v[q].x + v[q].y * v[q].y + v[q].z * v[q].z + v[q].w * v[q].w; }
        ss = wave_sum(ss);
        float rstd = rsqrtf(ss * (1.0f / D) + EPS);
#pragma unroll
        for (int q = 0; q < 4; ++q) {
            int c0 = q * 256 + lane * 4;
            float4 gg = *(const float4*)(p.norm1_g + c0), sh = *(const float4*)(m + c0), sc = *(const float4*)(m + D + c0);
            float o0 = v[q].x * rstd * gg.x * (1 + sc.x) + sh.x, o1 = v[q].y * rstd * gg.y * (1 + sc.y) + sh.y;
            float o2 = v[q].z * rstd * gg.z * (1 + sc.z) + sh.z, o3 = v[q].w * rstd * gg.w * (1 + sc.w) + sh.w;
            u32x2 w; w.x = cvtpk(o0, o1); w.y = cvtpk(o2, o3);
            *(u32x2*)(p.H() + (size_t)R * D + c0) = w;
        }
    }
}

__device__ __forceinline__ int lds_byte(int r, int c) { int st = (r >> 4) * 2 + (c >> 5), ob = (r & 15) * 64 + (c & 31) * 2; return st * 1024 + (ob ^ (((ob >> 9) & 1) << 5)); }
__device__ __forceinline__ void stage_rc(int b, int& R, int& C) { int st = b >> 10, sb = b & 1023, swz = sb ^ (((sb >> 9) & 1) << 5); R = (st / 2) * 16 + swz / 64; C = (st % 2) * 32 + (swz % 64) / 2; }
#define WAIT_V0() asm volatile("s_waitcnt vmcnt(0)" ::: "memory")
__device__ __forceinline__ void gemm_core(const char* Abase, const unsigned (&Ao)[4], const char* Bbase, const unsigned (&Bo)[4], int nt, f32x4 (&acc)[8][4], int tid_l, bool pre) {
    const int tid = tid_l, wid = tid >> 6, lane = tid & 63, wr = wid >> 2, wc = wid & 3, fr = lane & 15, fq = lane >> 4;
#pragma unroll
    for (int m = 0; m < 8; ++m)
#pragma unroll
        for (int n = 0; n < 4; ++n) acc[m][n] = (f32x4){0.f, 0.f, 0.f, 0.f};
#define G_SA(b) (smem + (b) * 32768)
#define G_SB(b) (smem + 65536 + (b) * 32768)
#define G_STAGE(buf, kt) do { _Pragma("unroll") for (int i = 0; i < 4; ++i) {                                                     \
        __builtin_amdgcn_global_load_lds((const unsigned*)(Abase + (Ao[i] + (unsigned)(kt) * 128u)), (unsigned*)(G_SA(buf) + wid * 1024 + i * 8192), 16, 0, 0); \
        __builtin_amdgcn_global_load_lds((const unsigned*)(Bbase + (Bo[i] + (unsigned)(kt) * 128u)), (unsigned*)(G_SB(buf) + wid * 1024 + i * 8192), 16, 0, 0); } } while (0)
    if (!pre) G_STAGE(0, 0);
    WAIT_V0(); __syncthreads();
#define G_KSTEP(cur, t) do {                                                                                                   \
        if ((t) + 1 < nt) G_STAGE((cur) ^ 1, (t) + 1);                                                                          \
        _Pragma("unroll") for (int ks = 0; ks < 2; ++ks) {                                                                      \
            bf16x8 At[8], Bf[4];                                                                                                \
            _Pragma("unroll") for (int m = 0; m < 8; ++m) At[m] = *(const bf16x8*)(G_SA(cur) + lds_byte(wr * 128 + m * 16 + fr, ks * 32 + fq * 8)); \
            _Pragma("unroll") for (int n = 0; n < 4; ++n) Bf[n] = *(const bf16x8*)(G_SB(cur) + lds_byte(wc * 64 + n * 16 + fr, ks * 32 + fq * 8));  \
            _Pragma("unroll") for (int m = 0; m < 8; ++m) _Pragma("unroll") for (int n = 0; n < 4; ++n)                         \
                acc[m][n] = __builtin_amdgcn_mfma_f32_16x16x32_bf16(Bf[n], At[m], acc[m][n], 0, 0, 0);                          \
            __builtin_amdgcn_sched_barrier(0);                                                                                  \
        }                                                                                                                       \
        WAIT_V0(); __syncthreads(); } while (0)
#pragma unroll 1
    for (int t = 0; t < nt; ++t) { const int cur = t & 1; G_KSTEP(cur, t); }
}
#ifndef XPREFETCH
#define XPREFETCH 0
#endif
__device__ __forceinline__ void gemm_prefetch(const char* Abase, const unsigned (&Ao)[4], const char* Bbase, const unsigned (&Bo)[4], int tid_l) {
    const int wid = tid_l >> 6;
    G_STAGE(0, 0);
}
__device__ __forceinline__ void stage_offs(unsigned ld_bytes, unsigned (&P)[4], int tid_l) {
    const int wid = tid_l >> 6, lane = tid_l & 63;
#pragma unroll
    for (int i = 0; i < 4; ++i) { int R, C; stage_rc(wid * 1024 + i * 8192 + lane * 16, R, C); P[i] = (unsigned)R * ld_bytes + (unsigned)C * 2u; }
}

constexpr int WAREA = 18432;
__device__ __forceinline__ char* wave_area(int wid) { return smem + wid * WAREA; }

constexpr int A_KVBLK = 64;
constexpr float A_SCALE = 0.125f, A_THR = 8.f;
constexpr int A_SHM_V = A_KVBLK * 128 * 2, A_SHM_K = A_KVBLK * 128 * 2;
#define KSWZ(row, colB) ((row) * 256 + ((colB) ^ (((row) & 7) << 4)))
#define SBAR() __builtin_amdgcn_sched_barrier(0)
__device__ __forceinline__ int crow(int r, int hi) { return (r & 3) + 8 * (r >> 2) + 4 * hi; }

constexpr float A_THRL = 11.0f;
template <bool FIRST, bool FAST = false> __device__ __forceinline__ void partialSM2(f32x16& p0, f32x16& p1, float& mhat, f32x16& negm, float& alpha) {
    if (FAST && !FIRST) {
        alpha = 1.f;
#pragma unroll
        for (int r = 0; r < 16; ++r) p0[r] = __builtin_amdgcn_exp2f(p0[r]);
        return;
    }
    float pmax = p0[0];
#pragma unroll
    for (int r = 1; r < 16; ++r) pmax = fmaxf(pmax, p0[r]);
#pragma unroll
    for (int r = 0; r < 16; ++r) pmax = fmaxf(pmax, p1[r]);
    { auto rr = __builtin_amdgcn_permlane32_swap(__float_as_uint(pmax), __float_as_uint(pmax), false, false);
      pmax = fmaxf(__uint_as_float(rr[0]), __uint_as_float(rr[1])); }
    alpha = 1.f;
    if (FIRST || __builtin_expect(__any(pmax > A_THRL), 0)) {
        const float dl = FIRST ? pmax : fmaxf(pmax, 0.f);
        mhat += dl;
#pragma unroll
        for (int r = 0; r < 16; ++r) { p0[r] -= dl; p1[r] -= dl; }
#pragma unroll
        for (int r = 0; r < 16; ++r) negm[r] = -mhat;
        if (!FIRST) alpha = __builtin_amdgcn_exp2f(-dl);
    }
#pragma unroll
    for (int r = 0; r < 16; ++r) p0[r] = __builtin_amdgcn_exp2f(p0[r]);
}
__device__ __forceinline__ void qkt2(f32x16& p0, f32x16& p1, const char* Ks, const bf16x8* qr, const f32x16& negm, int r32, int hi, int mapc) {
#pragma unroll
    for (int d0 = 0; d0 < 4; ++d0) { int cb = (mapc + d0 * 16 + hi * 8) * 2;
        bf16x8 b0 = *reinterpret_cast<const bf16x8*>(Ks + KSWZ(r32, cb));
        bf16x8 b1 = *reinterpret_cast<const bf16x8*>(Ks + KSWZ(32 + r32, cb));
        if (d0 == 0) { p0 = __builtin_amdgcn_mfma_f32_32x32x16_bf16(b0, qr[0], negm, 0, 0, 0); p1 = __builtin_amdgcn_mfma_f32_32x32x16_bf16(b1, qr[0], negm, 0, 0, 0); }
        else { p0 = __builtin_amdgcn_mfma_f32_32x32x16_bf16(b0, qr[d0], p0, 0, 0, 0); p1 = __builtin_amdgcn_mfma_f32_32x32x16_bf16(b1, qr[d0], p1, 0, 0, 0); } }
}
template <int PROBE = 0> __device__ __forceinline__ void partialSM(f32x16& p0, f32x16& p1, float& m_reg, float& mn, float& alpha) {
    constexpr float C = A_SCALE * 1.4426950408889634f;
    float pmax = p0[0];
#pragma unroll
    for (int r = 1; r < 16; ++r) pmax = fmaxf(pmax, p0[r]);
#pragma unroll
    for (int r = 0; r < 16; ++r) pmax = fmaxf(pmax, p1[r]);
    { auto rr = __builtin_amdgcn_permlane32_swap(__float_as_uint(pmax), __float_as_uint(pmax), false, false);
      pmax = fmaxf(__uint_as_float(rr[0]), __uint_as_float(rr[1])); }
    if (__builtin_expect(__all(pmax - m_reg <= A_THR / A_SCALE), 1)) { mn = m_reg; alpha = 1.f; }
    else { mn = fmaxf(m_reg, pmax); alpha = __builtin_amdgcn_exp2f((m_reg - mn) * C); m_reg = mn; }
    float mnC = -mn * C;
#pragma unroll
    for (int r = 0; r < 16; ++r) p0[r] = fmaf(p0[r], C, mnC);
#pragma unroll
    for (int r = 0; r < 16; ++r) p1[r] = fmaf(p1[r], C, mnC);
#pragma unroll
    for (int r = 0; r < 16; ++r) p0[r] = PROBE == 3 ? p0[r] * 1e-3f : __builtin_amdgcn_exp2f(p0[r]);
}
#define PK4(P, BASE, OUT) do { unsigned a0 = cvtpk(P[BASE + 0], P[BASE + 1]), a1 = cvtpk(P[BASE + 2], P[BASE + 3]);   \
    unsigned b0 = cvtpk(P[BASE + 4], P[BASE + 5]), b1 = cvtpk(P[BASE + 6], P[BASE + 7]);                              \
    auto r0 = __builtin_amdgcn_permlane32_swap(a0, b0, false, false); auto r1 = __builtin_amdgcn_permlane32_swap(a1, b1, false, false); \
    u32x4 w = {r0[0], r1[0], r0[1], r1[1]}; OUT = *reinterpret_cast<bf16x8*>(&w); } while (0)
template <int PROBE = 0, bool DIRECT = false, bool FAST = false> __device__ __forceinline__ void finishSM(f32x16& p0, f32x16& p1, float alpha, float& l_reg, bf16x8& pa0, bf16x8& pa1, bf16x8& pa2, bf16x8& pa3, float& bad) {
#pragma unroll
    for (int r = 0; r < 16; ++r) p1[r] = PROBE == 3 ? p1[r] * 1e-3f : __builtin_amdgcn_exp2f(p1[r]);
    float ps = 0;
#pragma unroll
    for (int r = 0; r < 16; ++r) ps += p0[r];
#pragma unroll
    for (int r = 0; r < 16; ++r) ps += p1[r];
    { auto rr = __builtin_amdgcn_permlane32_swap(__float_as_uint(ps), __float_as_uint(ps), false, false);
      ps = __uint_as_float(rr[0]) + __uint_as_float(rr[1]); }
    if (FAST) { l_reg += ps; bad = fmaxf(bad, ps); }
    else l_reg = l_reg * alpha + ps;
    if (DIRECT) {
#define PKD(P, B, OUT) do { u32x4 w = {cvtpk(P[B], P[B + 1]), cvtpk(P[B + 2], P[B + 3]), cvtpk(P[B + 4], P[B + 5]), cvtpk(P[B + 6], P[B + 7])}; OUT = *reinterpret_cast<bf16x8*>(&w); } while (0)
        PKD(p0, 0, pa0); PKD(p0, 8, pa1); PKD(p1, 0, pa2); PKD(p1, 8, pa3);
#undef PKD
    } else { PK4(p0, 0, pa0); PK4(p0, 8, pa1); PK4(p1, 0, pa2); PK4(p1, 8, pa3); }
}
__device__ __forceinline__ void qkt(f32x16& p0, f32x16& p1, const char* Ks, const bf16x8* qr, int r32, int hi, int mapc) {
    p0 = f32x16{}; p1 = f32x16{};
#pragma unroll
    for (int d0 = 0; d0 < 4; ++d0) { int cb = (mapc + d0 * 16 + hi * 8) * 2;
        bf16x8 b0 = *reinterpret_cast<const bf16x8*>(Ks + KSWZ(r32, cb));
        bf16x8 b1 = *reinterpret_cast<const bf16x8*>(Ks + KSWZ(32 + r32, cb));
        p0 = __builtin_amdgcn_mfma_f32_32x32x16_bf16(b0, qr[d0], p0, 0, 0, 0);
        p1 = __builtin_amdgcn_mfma_f32_32x32x16_bf16(b1, qr[d0], p1, 0, 0, 0); }
}
__device__ __forceinline__ int v_st(int k, int c) { const int kk = (k & ~0xC) | ((k & 4) << 1) | ((k & 8) >> 1); return ((kk >> 3) * 4 + (c >> 5)) * 512 + ((kk & 7) * 32 + (c & 31)) * 2; }
__device__ __forceinline__ int v_rd_base(int lane) { return ((lane & 3) << 3) | (((lane >> 2) & 3) << 6) | (((lane >> 4) & 1) << 5) | (((lane >> 5) & 1) << 8); }
constexpr int v_rd_off(int d0, int ks, int half) { return d0 * 512 + ks * 4096 + half * 2048; }
template <int OFF> __device__ __forceinline__ s16x4 tr_read(int vb) {
    s16x4 r; asm volatile("ds_read_b64_tr_b16 %0, %1 offset:%2" : "=&v"(r) : "v"(vb), "i"(OFF) : "memory"); return r;
}
template <int D0> __device__ __forceinline__ void pv_one(f32x16& od, int vb, bf16x8 pa0, bf16x8 pa1, bf16x8 pa2, bf16x8 pa3) {
    const s16x4 l0 = tr_read<v_rd_off(D0, 0, 0)>(vb), h0 = tr_read<v_rd_off(D0, 0, 1)>(vb), l1 = tr_read<v_rd_off(D0, 1, 0)>(vb), h1 = tr_read<v_rd_off(D0, 1, 1)>(vb);
    const s16x4 l2 = tr_read<v_rd_off(D0, 2, 0)>(vb), h2 = tr_read<v_rd_off(D0, 2, 1)>(vb), l3 = tr_read<v_rd_off(D0, 3, 0)>(vb), h3 = tr_read<v_rd_off(D0, 3, 1)>(vb);
    asm volatile("s_waitcnt lgkmcnt(0)" ::: "memory"); SBAR();
#define PKV(L, H) (bf16x8){L[0], L[1], L[2], L[3], H[0], H[1], H[2], H[3]}
    od = __builtin_amdgcn_mfma_f32_32x32x16_bf16(pa0, PKV(l0, h0), od, 0, 0, 0);
    od = __builtin_amdgcn_mfma_f32_32x32x16_bf16(pa1, PKV(l1, h1), od, 0, 0, 0);
    od = __builtin_amdgcn_mfma_f32_32x32x16_bf16(pa2, PKV(l2, h2), od, 0, 0, 0);
    od = __builtin_amdgcn_mfma_f32_32x32x16_bf16(pa3, PKV(l3, h3), od, 0, 0, 0);
}
template <int D0> __device__ __forceinline__ void pv_two(f32x16& oa, f32x16& ob, int vb, bf16x8 pa0, bf16x8 pa1, bf16x8 pa2, bf16x8 pa3) {
    const s16x4 l0 = tr_read<v_rd_off(D0, 0, 0)>(vb), h0 = tr_read<v_rd_off(D0, 0, 1)>(vb), l1 = tr_read<v_rd_off(D0, 1, 0)>(vb), h1 = tr_read<v_rd_off(D0, 1, 1)>(vb);
    const s16x4 l2 = tr_read<v_rd_off(D0, 2, 0)>(vb), h2 = tr_read<v_rd_off(D0, 2, 1)>(vb), l3 = tr_read<v_rd_off(D0, 3, 0)>(vb), h3 = tr_read<v_rd_off(D0, 3, 1)>(vb);
    const s16x4 m0 = tr_read<v_rd_off(D0 + 1, 0, 0)>(vb), g0 = tr_read<v_rd_off(D0 + 1, 0, 1)>(vb), m1 = tr_read<v_rd_off(D0 + 1, 1, 0)>(vb), g1 = tr_read<v_rd_off(D0 + 1, 1, 1)>(vb);
    const s16x4 m2 = tr_read<v_rd_off(D0 + 1, 2, 0)>(vb), g2 = tr_read<v_rd_off(D0 + 1, 2, 1)>(vb), m3 = tr_read<v_rd_off(D0 + 1, 3, 0)>(vb), g3 = tr_read<v_rd_off(D0 + 1, 3, 1)>(vb);
    asm volatile("s_waitcnt lgkmcnt(0)" ::: "memory"); SBAR();
    oa = __builtin_amdgcn_mfma_f32_32x32x16_bf16(pa0, PKV(l0, h0), oa, 0, 0, 0);
    ob = __builtin_amdgcn_mfma_f32_32x32x16_bf16(pa0, PKV(m0, g0), ob, 0, 0, 0);
    oa = __builtin_amdgcn_mfma_f32_32x32x16_bf16(pa1, PKV(l1, h1), oa, 0, 0, 0);
    ob = __builtin_amdgcn_mfma_f32_32x32x16_bf16(pa1, PKV(m1, g1), ob, 0, 0, 0);
    oa = __builtin_amdgcn_mfma_f32_32x32x16_bf16(pa2, PKV(l2, h2), oa, 0, 0, 0);
    ob = __builtin_amdgcn_mfma_f32_32x32x16_bf16(pa2, PKV(m2, g2), ob, 0, 0, 0);
    oa = __builtin_amdgcn_mfma_f32_32x32x16_bf16(pa3, PKV(l3, h3), oa, 0, 0, 0);
    ob = __builtin_amdgcn_mfma_f32_32x32x16_bf16(pa3, PKV(m3, g3), ob, 0, 0, 0);
}
__device__ __forceinline__ void pv_d0(f32x16* o, int vb, bf16x8 pa0, bf16x8 pa1, bf16x8 pa2, bf16x8 pa3) {
    pv_one<0>(o[0], vb, pa0, pa1, pa2, pa3); pv_one<1>(o[1], vb, pa0, pa1, pa2, pa3); pv_one<2>(o[2], vb, pa0, pa1, pa2, pa3); pv_one<3>(o[3], vb, pa0, pa1, pa2, pa3);
}
#define PVR8(D0, L0, H0, L1, H1, L2, H2, L3, H3) do { L0 = tr_read<v_rd_off(D0, 0, 0)>(vb); H0 = tr_read<v_rd_off(D0, 0, 1)>(vb); L1 = tr_read<v_rd_off(D0, 1, 0)>(vb); H1 = tr_read<v_rd_off(D0, 1, 1)>(vb); \
    L2 = tr_read<v_rd_off(D0, 2, 0)>(vb); H2 = tr_read<v_rd_off(D0, 2, 1)>(vb); L3 = tr_read<v_rd_off(D0, 3, 0)>(vb); H3 = tr_read<v_rd_off(D0, 3, 1)>(vb); } while (0)
#define PVM4(OD, L0, H0, L1, H1, L2, H2, L3, H3) do { OD = __builtin_amdgcn_mfma_f32_32x32x16_bf16(pa0, PKV(L0, H0), OD, 0, 0, 0); OD = __builtin_amdgcn_mfma_f32_32x32x16_bf16(pa1, PKV(L1, H1), OD, 0, 0, 0); \
    OD = __builtin_amdgcn_mfma_f32_32x32x16_bf16(pa2, PKV(L2, H2), OD, 0, 0, 0); OD = __builtin_amdgcn_mfma_f32_32x32x16_bf16(pa3, PKV(L3, H3), OD, 0, 0, 0); } while (0)
#define PVX4(B) do { x0[B] = __builtin_amdgcn_exp2f(x0[B]); x0[B + 1] = __builtin_amdgcn_exp2f(x0[B + 1]); x0[B + 2] = __builtin_amdgcn_exp2f(x0[B + 2]); x0[B + 3] = __builtin_amdgcn_exp2f(x0[B + 3]); } while (0)
template <bool EXPS> __device__ __forceinline__ void pv_fast(f32x16* o, int vb, bf16x8 pa0, bf16x8 pa1, bf16x8 pa2, bf16x8 pa3, f32x16& x0) {
    s16x4 a0, a1, a2, a3, a4, a5, a6, a7, b0, b1, b2, b3, b4, b5, b6, b7;
    PVR8(0, a0, a1, a2, a3, a4, a5, a6, a7);
    PVR8(1, b0, b1, b2, b3, b4, b5, b6, b7);
    asm volatile("s_waitcnt lgkmcnt(8)" ::: "memory"); SBAR();
    PVM4(o[0], a0, a1, a2, a3, a4, a5, a6, a7); if (EXPS) PVX4(0); SBAR();
    PVR8(2, a0, a1, a2, a3, a4, a5, a6, a7);
    asm volatile("s_waitcnt lgkmcnt(8)" ::: "memory"); SBAR();
    PVM4(o[1], b0, b1, b2, b3, b4, b5, b6, b7); if (EXPS) PVX4(4); SBAR();
    PVR8(3, b0, b1, b2, b3, b4, b5, b6, b7);
    asm volatile("s_waitcnt lgkmcnt(8)" ::: "memory"); SBAR();
    PVM4(o[2], a0, a1, a2, a3, a4, a5, a6, a7); if (EXPS) PVX4(8); SBAR();
    asm volatile("s_waitcnt lgkmcnt(0)" ::: "memory"); SBAR();
    PVM4(o[3], b0, b1, b2, b3, b4, b5, b6, b7); if (EXPS) PVX4(12);
}

template <int PROBE, bool FAST> __device__ __forceinline__ int attn_item(const bf16_t* __restrict__ Qb, const bf16_t* __restrict__ Kh, const bf16_t* __restrict__ Vh, bf16_t* __restrict__ mixrow,
                                          const float* __restrict__ gd, float lam, int tid_l) {
    char* lds = smem;
    const int tid = tid_l, wid = tid >> 6, lane = tid & 63, r32 = lane & 31, hi = lane >> 5;
    const int map = wid >> 2, wq = wid & 3, mapc = map * 64;
    char* K_lds = lds; char* V_lds = lds + 4 * A_SHM_K;
    float* wsw = (float*)(lds + 4 * A_SHM_V + 4 * A_SHM_K) + wid * 64; float* li_l = wsw; float* al_l = wsw + 32;
    float m_reg = 0.f, l_reg = 0, bad = 0.f; f32x16 o[4] = {}; bf16x8 qr[4]; f32x16 negm = f32x16{};
    int* flagw = (int*)(lds + 4 * A_SHM_V + 4 * A_SHM_K + 2048);
    if (FAST && tid == 0) *flagw = 0;
    const bf16_t* Qw = Qb + (long)(wq * 32 + r32) * 128 + mapc + hi * 8;
#pragma unroll
    for (int d0 = 0; d0 < 4; ++d0) qr[d0] = *reinterpret_cast<const bf16x8*>(Qw + d0 * 16);
    const int vb0 = (int)(uintptr_t)V_lds + v_rd_base(lane);
    unsigned kofs[2], vofs[2];
    const int widu = __builtin_amdgcn_readfirstlane(wid);
#pragma unroll
    for (int i = 0; i < 2; ++i) {
        const int x = wid * 1024 + i * 8192 + lane * 16;
        { const int row = x >> 8, cs = x & 255, colB = cs ^ ((row & 7) << 4); kofs[i] = (unsigned)(row * 256 + colB); }
        { const int sub = x >> 9, wn = x & 511, k = (sub >> 2) * 8 + (wn >> 6), c = (sub & 3) * 32 + ((wn & 63) >> 1); vofs[i] = (unsigned)(k * 256 + c * 2); }
    }
#define DMA_TILE(slot, k0) do { const char* kt_ = (const char*)Kh + (size_t)(k0) * 256; const char* vt_ = (const char*)Vh + (size_t)(k0) * 256;                  \
      _Pragma("unroll") for (int i = 0; i < 2; ++i) {                                                                   \
        __builtin_amdgcn_global_load_lds((const unsigned*)(kt_ + kofs[i]), (unsigned*)(K_lds + (slot) * A_SHM_K + widu * 1024 + i * 8192), 16, 0, 0); \
        __builtin_amdgcn_global_load_lds((const unsigned*)(vt_ + vofs[i]), (unsigned*)(V_lds + (slot) * A_SHM_V + widu * 1024 + i * 8192), 16, 0, 0); } } while (0)
#define RESC(a) do { if (__any((a) < 1.f)) { if (hi == 0) al_l[r32] = (a); asm volatile("s_waitcnt lgkmcnt(0)" ::: "memory"); \
    _Pragma("unroll") for (int d = 0; d < 4; ++d) _Pragma("unroll") for (int r = 0; r < 16; ++r) o[d][r] *= al_l[crow(r, hi)]; } } while (0)
    f32x16 pA0, pA1, pB0, pB1; float mnA, mnB, alA, alB; bf16x8 pa0, pa1, pa2, pa3; const int NT = RB / A_KVBLK;
    DMA_TILE(0, 0); DMA_TILE(1, A_KVBLK);
    asm volatile("s_waitcnt vmcnt(0)" ::: "memory"); __syncthreads();
    qkt2(pA0, pA1, K_lds, qr, negm, r32, hi, mapc); partialSM2<true>(pA0, pA1, m_reg, negm, alA);
#define ATILE(X0, X1, ALX, Y0, Y1, ALY, CS, PS, NS, T_, DODMA) do {                                                                  \
        asm volatile("s_waitcnt vmcnt(0)" ::: "memory"); __syncthreads();                                                            \
        if (DODMA && PROBE != 1) DMA_TILE(NS, ((T_) + 1) * A_KVBLK);                                                                 \
        SBAR(); qkt2(X0, X1, K_lds + (CS) * A_SHM_K, qr, negm, r32, hi, mapc);                                                       \
        finishSM<PROBE, true, FAST>(Y0, Y1, ALY, l_reg, pa0, pa1, pa2, pa3, bad); SBAR();                                            \
        if (FAST) pv_fast<true>(o, vb0 + (PS) * A_SHM_V, pa0, pa1, pa2, pa3, X0);                                                    \
        else { pv_d0(o, vb0 + (PS) * A_SHM_V, pa0, pa1, pa2, pa3); partialSM2<false, false>(X0, X1, m_reg, negm, ALX); RESC(ALX); } } while (0)
#pragma unroll 1
    for (int j = 1; j + 3 < NT; j += 4) {
        ATILE(pB0, pB1, alB, pA0, pA1, alA, 1, 0, 2, j, true);
        ATILE(pA0, pA1, alA, pB0, pB1, alB, 2, 1, 3, j + 1, true);
        ATILE(pB0, pB1, alB, pA0, pA1, alA, 3, 2, 0, j + 2, true);
        ATILE(pA0, pA1, alA, pB0, pB1, alB, 0, 3, 1, j + 3, true);
    }
    ATILE(pB0, pB1, alB, pA0, pA1, alA, 1, 0, 2, NT - 3, true);
    ATILE(pA0, pA1, alA, pB0, pB1, alB, 2, 1, 3, NT - 2, true);
    ATILE(pB0, pB1, alB, pA0, pA1, alA, 3, 2, 0, NT - 1, false);
    finishSM<PROBE, true, FAST>(pB0, pB1, alB, l_reg, pa0, pa1, pa2, pa3, bad); SBAR();
    if (FAST) pv_fast<false>(o, vb0 + 3 * A_SHM_V, pa0, pa1, pa2, pa3, pA0); else pv_d0(o, vb0 + 3 * A_SHM_V, pa0, pa1, pa2, pa3);
    if (FAST) { if (__any(!(bad <= 1073741824.f) || !(l_reg < 3.0e38f))) *flagw = 1; }
#undef ATILE
#undef DMA_TILE
    if (hi == 0) li_l[r32] = l_reg;
    asm volatile("s_waitcnt lgkmcnt(0)" ::: "memory");
    float rl[16];
#pragma unroll
    for (int r = 0; r < 16; ++r) rl[r] = __builtin_amdgcn_rcpf(li_l[crow(r, hi)]);
    __syncthreads();
    const int flag = FAST ? __builtin_amdgcn_readfirstlane(*flagw) : 0;
    {
        float* xo = (float*)lds + map * 16384 + (wq * 32) * 128 + r32;
#pragma unroll
        for (int r = 0; r < 16; ++r)
#pragma unroll
            for (int d0 = 0; d0 < 4; ++d0) xo[crow(r, hi) * 128 + d0 * 32] = o[d0][r] * rl[r];
    }
    __syncthreads();
    {
        int l2 = lane; asm volatile("" : "+v"(l2));
        const float g0 = gd[l2 * 2], g1 = gd[l2 * 2 + 1];
#pragma unroll 4
        for (int rr = 0; rr < 16; ++rr) {
            const int row = wid * 16 + rr;
            const float2 a0 = *(const float2*)((const float*)lds + row * 128 + l2 * 2), a1 = *(const float2*)((const float*)lds + 16384 + row * 128 + l2 * 2);
            const float xv = a0.x - lam * a1.x, yv = a0.y - lam * a1.y;
            const float ss = wave_sum(xv * xv + yv * yv);
            const float rs = rsqrtf(ss * (1.0f / 128) + EPS) * 0.8f;
            *(unsigned*)(mixrow + (long)row * 1024 + l2 * 2) = cvtpk(xv * rs * g0, yv * rs * g1);
        }
    }
    __syncthreads();
#undef RESC
    return flag;
}


template <int PROBE> __device__ __forceinline__ void ph_attn(const MK& p, int bid, int nb, int tid_l) {
    const int lane = tid_l & 63;
    float s1 = wave_sum(p.lq1[lane] * p.lk1[lane]), s2 = wave_sum(p.lq2[lane] * p.lk2[lane]);
    const float lam = expf(s1) - expf(s2) + 0.2f;
    const int nrounds = (1024 + nb - 1) / nb;
#define ATTN_ITEM_ARGS p.Q() + ((size_t)bh * SEQ + qb * 128) * 128, p.K() + (size_t)bh * RB * 128, p.V() + (size_t)bh * RB * 128, \
                  PROBE ? (bf16_t*)(p.ws + 492 * MiB) + h * 128 : p.MIX() + ((size_t)(b * SEQ + qb * 128)) * 1024 + h * 128, p.dattn_g, lam
    unsigned redo = 0u;
    for (int rr = 0; rr < nrounds; ++rr) {
        int item;
        if (nb == 256) { int x = bid & 7, j = bid >> 3, hh = rr * 8 + x; item = (hh >> 1) * 64 + (hh & 1) * 32 + j; }
        else { item = rr * nb + bid; if (item >= 1024) break; }
        const int bh = item >> 6, qb = item & 63, b = bh >> 2, h = bh & 3;
        if (nrounds <= 32) { if (attn_item<PROBE, true>(ATTN_ITEM_ARGS, tid_l)) redo |= 1u << rr; }
        else redo = 0xffffffffu;
    }
    if (redo) {
#pragma unroll 1
        for (int rr = 0; rr < nrounds; ++rr) {
            if (nrounds <= 32 && !((redo >> rr) & 1u)) continue;
            int item;
            if (nb == 256) { int x = bid & 7, j = bid >> 3, hh = rr * 8 + x; item = (hh >> 1) * 64 + (hh & 1) * 32 + j; }
            else { item = rr * nb + bid; if (item >= 1024) break; }
            const int bh = item >> 6, qb = item & 63, b = bh >> 2, h = bh & 3;
            int t2_ = tid_l; asm volatile("" : "+v"(t2_));
            (void)attn_item<PROBE, false>(ATTN_ITEM_ARGS, t2_);
        }
    }
#undef ATTN_ITEM_ARGS
}


__device__ __forceinline__ bf16x8 ldfrag(const bf16_t* p) { return *reinterpret_cast<const bf16x8*>(p); }

__device__ __forceinline__ void ph_kv(const MK& p, int bid, int nb, int tid_l) {
    const int wid = tid_l >> 6, lane = tid_l & 63, r32 = lane & 31, hi = lane >> 5;
    const int nitems = 16 * 2 * 66;
    for (int it = bid * 8 + wid; it < nitems; it += nb * 8) {
        const int c = it % 66, chain = it / 66, dir = chain & 1, bh = chain >> 1;
        const bf16_t* vt = p.VT() + (size_t)bh * 128 * RB + (size_t)c * 16384 + hi * 8;
        const bf16_t* kt = (dir ? p.KTb() : p.KTf()) + (size_t)bh * 64 * RB + (size_t)c * 8192 + hi * 8;
        f32x16 acc[4][2];
#pragma unroll
        for (int mt = 0; mt < 4; ++mt) { acc[mt][0] = f32x16{}; acc[mt][1] = f32x16{}; }
#pragma unroll 1
        for (int kh = 0; kh < 2; ++kh) {
            bf16x8 a[4][4], b2[2][4];
#pragma unroll
            for (int ks = 0; ks < 4; ++ks) {
#pragma unroll
                for (int mt = 0; mt < 4; ++mt) a[mt][ks] = ldfrag(vt + (mt * 32 + r32) * 128 + (kh * 4 + ks) * 16);
#pragma unroll
                for (int nt = 0; nt < 2; ++nt) b2[nt][ks] = ldfrag(kt + (nt * 32 + r32) * 128 + (kh * 4 + ks) * 16);
            }
#pragma unroll
            for (int ks = 0; ks < 4; ++ks) asm volatile("" : "+v"(a[0][ks]), "+v"(a[1][ks]), "+v"(a[2][ks]), "+v"(a[3][ks]), "+v"(b2[0][ks]), "+v"(b2[1][ks]) :: "memory");
#pragma unroll
            for (int ks = 0; ks < 4; ++ks)
#pragma unroll
                for (int mt = 0; mt < 4; ++mt)
#pragma unroll
                    for (int nt = 0; nt < 2; ++nt) acc[mt][nt] = __builtin_amdgcn_mfma_f32_32x32x16_bf16(a[mt][ks], b2[nt][ks], acc[mt][nt], 0, 0, 0);
        }
        bf16_t* dst = p.KV() + (size_t)it * 8192;
#pragma unroll
        for (int mt = 0; mt < 4; ++mt)
#pragma unroll
            for (int nt = 0; nt < 2; ++nt)
#pragma unroll
                for (int r = 0; r < 16; ++r) dst[(mt * 32 + crow(r, hi)) * 64 + nt * 32 + r32] = f2bf(acc[mt][nt][r]);
    }
}

__device__ __forceinline__ void ph_scan(const MK& p, int bid, int nb, int tid_l) {
    if (tid_l >= 256) {
        const int lane = tid_l & 63, wq = __builtin_amdgcn_readfirstlane(tid_l >> 6); char* tb = smem + wq * 8192;
#pragma unroll 1
        for (int j = CV_E13 + bid * 4 + (wq - 4); j < CV_E13 + CV_E2; j += nb * 4) convert_tile_wave(p, j, lane, tb);
        return;
    }
    for (int e0 = bid * 256 + tid_l; e0 < 32 * 8192; e0 += nb * 1024) {
        float S[4], g128[4]; const bf16_t* kv[4]; bf16_t* st[4]; int dir[4];
#pragma unroll
        for (int q = 0; q < 4; ++q) {
            int e = e0 + q * nb * 256; if (e >= 32 * 8192) e = e0;
            const int chain = e >> 13, el = e & 8191, h = (chain >> 1) & 3; dir[q] = chain & 1;
            const float d = dir[q] ? p.dec_b[h] : p.dec_f[h];
            g128[q] = exp2f(128.0f * log2f(1.0f / (1.0f + expf(-d))));
            kv[q] = p.KV() + (size_t)chain * 66 * 8192 + el; st[q] = p.ST() + (size_t)chain * 66 * 8192 + el; S[q] = 0.f;
        }
#pragma unroll 2
        for (int n = 0; n < 66; ++n) {
            const int cb = n == 0 ? 1 : (n == 1 ? 0 : 67 - n);
            float x[4];
#pragma unroll
            for (int q = 0; q < 4; ++q) x[q] = bf2f(kv[q][(size_t)(dir[q] ? cb : n) * 8192]);
#pragma unroll
            for (int q = 0; q < 4; ++q) { st[q][(size_t)(dir[q] ? cb : n) * 8192] = f2bf(S[q]); S[q] = fmaf(g128[q], S[q], x[q]); }
        }
    }
}

__device__ __forceinline__ void ph_ret(const MK& p, int bid, int nb, int tid_l) {
    const int tid = tid_l, wid = tid >> 6, lane = tid & 63, r32 = lane & 31, hi = lane >> 5, wq = wid & 3, half = wid >> 2;
    float* img = (float*)smem;
    for (int it = bid; it < 4 * 64 * 2; it += nb) {
        const int hp = it & 1, lc = (it >> 1) & 63, b = it >> 7, h = hp * 2 + half, bh = b * 4 + h;
        const int ib = CTX + lc * 128, c = 2 + lc;
        const float lf = log2f(1.0f / (1.0f + expf(-p.dec_f[h]))), lb = log2f(1.0f / (1.0f + expf(-p.dec_b[h])));
        const bf16_t* rq = p.RQ() + ((size_t)bh * RB + ib + wq * 32 + r32) * 64 + hi * 8;
        bf16x8 q[4];
#pragma unroll
        for (int ks = 0; ks < 4; ++ks) q[ks] = ldfrag(rq + ks * 16);
        f32x16 o[4];
        {
            const bf16_t* stf = p.ST() + ((size_t)(bh * 2 + 0) * 66 + c) * 8192 + hi * 8;
            const bf16_t* stb = p.ST() + ((size_t)(bh * 2 + 1) * 66 + c) * 8192 + hi * 8;
#define QSCALE(dst, f_) do { _Pragma("unroll") for (int ks = 0; ks < 4; ++ks) { const u32x4 w_ = *reinterpret_cast<const u32x4*>(&q[ks]); u32x4 r_;                         \
            _Pragma("unroll") for (int j = 0; j < 4; ++j) r_[j] = cvtpk(__uint_as_float(w_[j] << 16) * (f_), __uint_as_float(w_[j] & 0xffff0000u) * (f_));                 \
            dst[ks] = *reinterpret_cast<const bf16x8*>(&r_); } } while (0)
            {
                bf16x8 sf[4][4];
#pragma unroll
                for (int d0 = 0; d0 < 4; ++d0)
#pragma unroll
                    for (int ks = 0; ks < 4; ++ks) sf[d0][ks] = ldfrag(stf + (size_t)(d0 * 32 + r32) * 64 + ks * 16);
                asm volatile("" ::: "memory");
                bf16x8 qs[4]; QSCALE(qs, __builtin_amdgcn_exp2f((float)(wq * 32 + r32 + 1) * lf));
#pragma unroll
                for (int d0 = 0; d0 < 4; ++d0) {
                    o[d0] = f32x16{};
#pragma unroll
                    for (int ks = 0; ks < 4; ++ks) o[d0] = __builtin_amdgcn_mfma_f32_32x32x16_bf16(qs[ks], sf[d0][ks], o[d0], 0, 0, 0);
                }
            }
            asm volatile("" ::: "memory");
            {
                bf16x8 sb[4][4];
#pragma unroll
                for (int d0 = 0; d0 < 4; ++d0)
#pragma unroll
                    for (int ks = 0; ks < 4; ++ks) sb[d0][ks] = ldfrag(stb + (size_t)(d0 * 32 + r32) * 64 + ks * 16);
                asm volatile("" ::: "memory");
                bf16x8 qs[4]; QSCALE(qs, __builtin_amdgcn_exp2f((float)(128 - (wq * 32 + r32)) * lb));
#pragma unroll
                for (int d0 = 0; d0 < 4; ++d0)
#pragma unroll
                    for (int ks = 0; ks < 4; ++ks) o[d0] = __builtin_amdgcn_mfma_f32_32x32x16_bf16(qs[ks], sb[d0][ks], o[d0], 0, 0, 0);
            }
#undef QSCALE
            asm volatile("" ::: "memory");
        }
        {
            const int qi = wq * 32 + r32;
            const bf16_t* vt = p.VT() + (size_t)bh * 128 * RB + (size_t)c * 16384 + hi * 8;
#pragma unroll 1
            for (int jh = 0; jh < 2; ++jh) {
                asm volatile("" ::: "memory");
                bf16x8 pa[2][2];
                {
                    bf16x8 kf[2][4];
#pragma unroll
                    for (int j2 = 0; j2 < 2; ++j2)
#pragma unroll
                        for (int ks = 0; ks < 4; ++ks) kf[j2][ks] = ldfrag(p.RK() + ((size_t)bh * RB + ib + (jh * 2 + j2) * 32 + r32) * 64 + hi * 8 + ks * 16);
                    asm volatile("" ::: "memory");
#pragma unroll
                    for (int j2 = 0; j2 < 2; ++j2) {
                        f32x16 pp = f32x16{};
#pragma unroll
                        for (int ks = 0; ks < 4; ++ks) pp = __builtin_amdgcn_mfma_f32_32x32x16_bf16(kf[j2][ks], q[ks], pp, 0, 0, 0);
#pragma unroll
                        for (int r = 0; r < 16; ++r) {
                            const int dd = qi - ((jh * 2 + j2) * 32 + crow(r, hi));
                            const float ex = __builtin_amdgcn_exp2f(dd > 0 ? (float)dd * lf : (float)(-dd) * lb); const float w = dd == 0 ? 2.0f : ex;
                            pp[r] *= w;
                        }
                        PK4(pp, 0, pa[j2][0]); PK4(pp, 8, pa[j2][1]);
                    }
                }
                asm volatile("" ::: "memory");
                bf16x8 vf[2][4][2];
#pragma unroll
                for (int j2 = 0; j2 < 2; ++j2)
#pragma unroll
                    for (int d0 = 0; d0 < 4; ++d0) { vf[j2][d0][0] = ldfrag(vt + (d0 * 32 + r32) * 128 + (jh * 2 + j2) * 32); vf[j2][d0][1] = ldfrag(vt + (d0 * 32 + r32) * 128 + (jh * 2 + j2) * 32 + 16); }
                asm volatile("" ::: "memory");
#pragma unroll
                for (int j2 = 0; j2 < 2; ++j2)
#pragma unroll
                    for (int d0 = 0; d0 < 4; ++d0) {
                        o[d0] = __builtin_amdgcn_mfma_f32_32x32x16_bf16(pa[j2][0], vf[j2][d0][0], o[d0], 0, 0, 0);
                        o[d0] = __builtin_amdgcn_mfma_f32_32x32x16_bf16(pa[j2][1], vf[j2][d0][1], o[d0], 0, 0, 0);
                    }
            }
        }
        __syncthreads();
        {
            float* xo = img + half * 16384 + (wq * 32) * 128 + r32;
#pragma unroll
            for (int r = 0; r < 16; ++r)
#pragma unroll
                for (int d0 = 0; d0 < 4; ++d0) xo[crow(r, hi) * 128 + d0 * 32] = o[d0][r];
        }
        __syncthreads();
        {
            const float g0 = p.ret_g[lane * 2], g1 = p.ret_g[lane * 2 + 1];
#pragma unroll 8
            for (int rr = 0; rr < 32; ++rr) {
                const int row = wid * 32 + rr, itl = row >> 7, rw = row & 127, hh = hp * 2 + itl;
                const float2 a = *(const float2*)(img + row * 128 + lane * 2);
                const float ss = wave_sum(a.x * a.x + a.y * a.y);
                const float rs = rsqrtf(ss * (1.0f / 128) + EPS);
                const size_t tt = (size_t)b * SEQ + lc * 128 + rw;
                const unsigned ggv = *(const unsigned*)(p.RG() + tt * 512 + hh * 128 + lane * 2);
                const float ga = bf2f((bf16_t)(ggv & 0xffff)), gb = bf2f((bf16_t)(ggv >> 16));
                *(unsigned*)(p.MIX() + tt * 1024 + 512 + hh * 128 + lane * 2) = cvtpk(silu_fast(ga) * a.x * rs * g0, silu_fast(gb) * a.y * rs * g1);
            }
        }
    }
}


namespace pg8 {
constexpr int BM = 256, BK = 64, HALF = 128, HTB = HALF * BK * 2;
__device__ __forceinline__ int perm32(int rho) { const int n = rho >> 4, i = rho & 15; return 8 * (i >> 2) + 4 * n + (i & 3); }
struct GUnit { const char* A; const char* B; int i0, i1, i2, i3; };
template <class Epi, class Sched, bool GATHER, bool ALIGN_EPI>
__device__ __forceinline__ void gemm(int K, const Sched& S, const Epi& E, int tid_l) {
    const int tid = tid_l, wid = __builtin_amdgcn_readfirstlane(tid >> 6), lane = tid & 63, wr = wid >> 2, wc = wid & 3, fr = lane & 15, fq = lane >> 4;
    const int nt = K / BK;
    unsigned voffB[2], vAc[2][2], vAn[2][2];
    const size_t kstep = (size_t)(BK * 2);
    const size_t hstepB = (size_t)HALF * K * 2;
#pragma unroll
    for (int i = 0; i < 2; ++i) { int R, C; stage_rc(tid * 16 + i * 8192, R, C); const int Rb = Epi::PERM ? ((R & ~31) + perm32(R & 31)) : R;
        voffB[i] = (unsigned)(Rb * K + C) * 2u; }
    const unsigned ldsw = (unsigned)wid * 1024u;
    const int aoff = lds_byte(wr * 64 + fr, fq * 8), boff = lds_byte(wc * 32 + fr, fq * 8);
#define PG8_SA(b, h) (((b) * 2 + (h)) * HTB)
#define PG8_SB(b, h) ((4 + (b) * 2 + (h)) * HTB)
#define PG8_STAGE(bufoff, gbase, voff) do { _Pragma("unroll") for (int _i = 0; _i < 2; ++_i) \
        __builtin_amdgcn_global_load_lds((const unsigned*)((const char*)(gbase) + (voff)[_i]), (unsigned*)(smem + (bufoff) + ldsw + _i * 8192), 16, 0, 0); } while (0)
#define PG8_LDA(dst, b, h) do { _Pragma("unroll") for (int m = 0; m < 4; ++m) _Pragma("unroll") for (int k = 0; k < 2; ++k) dst[m][k] = *(const bf16x8*)(smem + PG8_SA(b, h) + aoff + m * 2048 + k * 1024); } while (0)
#define PG8_LDB(dst, b, h) do { _Pragma("unroll") for (int n = 0; n < 2; ++n) _Pragma("unroll") for (int k = 0; k < 2; ++k) dst[n][k] = *(const bf16x8*)(smem + PG8_SB(b, h) + boff + n * 2048 + k * 1024); } while (0)
#define PG8_MMA(ai, bj, At, Bt) do { __builtin_amdgcn_s_setprio(1); _Pragma("unroll") for (int m = 0; m < 4; ++m) _Pragma("unroll") for (int n = 0; n < 2; ++n) _Pragma("unroll") for (int k = 0; k < 2; ++k) \
        acc[ai][bj][m][n] = __builtin_amdgcn_mfma_f32_16x16x32_bf16(Bt[n][k], At[m][k], acc[ai][bj][m][n], 0, 0, 0); __builtin_amdgcn_s_setprio(0); } while (0)
#define PG8_WAIT_V(n) asm volatile("s_waitcnt vmcnt(" #n ")" ::: "memory")
#define PG8_WAIT_L(n) asm volatile("s_waitcnt lgkmcnt(" #n ")" ::: "memory")
#define PG8_BAR __builtin_amdgcn_s_barrier()
#define PG8_SCHED __builtin_amdgcn_sched_barrier(0)
    GUnit cur, nxt; int ui = 0;
    if (!S.next(0, cur, vAc)) return;
    f32x4 acc[2][2][4][2];
#pragma unroll
    for (int a = 0; a < 2; ++a)
#pragma unroll
        for (int b = 0; b < 2; ++b)
#pragma unroll
            for (int m = 0; m < 4; ++m)
#pragma unroll
                for (int n = 0; n < 2; ++n) acc[a][b][m][n] = (f32x4){0.f, 0.f, 0.f, 0.f};
    bf16x8 At[4][2], B0[2][2], B1[2][2];
    const char* cA = cur.A; const char* cB = cur.B;
    PG8_STAGE(PG8_SB(0, 0), cB, voffB); PG8_STAGE(PG8_SB(0, 1), cB + hstepB, voffB); PG8_STAGE(PG8_SA(0, 0), cA, vAc[0]); PG8_STAGE(PG8_SA(0, 1), cA, vAc[1]);
    if (wr == 1) PG8_BAR;
    PG8_WAIT_V(2); PG8_BAR;
    PG8_STAGE(PG8_SB(1, 0), cB + kstep, voffB); PG8_STAGE(PG8_SA(1, 0), cA + kstep, vAc[0]); PG8_STAGE(PG8_SB(1, 1), cB + hstepB + kstep, voffB);
    PG8_WAIT_V(6); PG8_BAR;
    for (;;) {
        const bool has_next = S.next(ui + 1, nxt, vAn);
        if (!GATHER || !has_next) {
#pragma unroll
            for (int h = 0; h < 2; ++h)
#pragma unroll
                for (int i = 0; i < 2; ++i) vAn[h][i] = vAc[h][i];
        }
        const char* nA = has_next ? nxt.A : cA; const char* nB = has_next ? nxt.B : cB;
#pragma unroll 1
        for (int t = 0; t < nt; t += 2) {
            const bool last = (t == nt - 2);
            const char* a1 = cA + (size_t)(t + 1) * kstep;
            const char* a2 = last ? nA : cA + (size_t)(t + 2) * kstep; const char* b2 = last ? nB : cB + (size_t)(t + 2) * kstep;
            const char* a3 = a2 + kstep; const char* b3 = b2 + kstep;
            unsigned va2[2][2];
#pragma unroll
            for (int h = 0; h < 2; ++h)
#pragma unroll
                for (int i = 0; i < 2; ++i) va2[h][i] = (GATHER && last) ? vAn[h][i] : vAc[h][i];
            PG8_LDB(B0, 0, 0); PG8_LDB(B1, 0, 1); PG8_SCHED; PG8_LDA(At, 0, 0); PG8_STAGE(PG8_SA(1, 1), a1, vAc[1]);
            PG8_WAIT_V(8); PG8_WAIT_L(0); PG8_BAR; PG8_MMA(0, 0, At, B0); PG8_MMA(0, 1, At, B1); PG8_BAR; PG8_SCHED;
            PG8_LDA(At, 0, 1); PG8_STAGE(PG8_SB(0, 0), b2, voffB); PG8_STAGE(PG8_SB(0, 1), b2 + hstepB, voffB); PG8_STAGE(PG8_SA(0, 0), a2, va2[0]);
            PG8_WAIT_V(8); PG8_WAIT_L(0); PG8_BAR; PG8_MMA(1, 0, At, B0); PG8_MMA(1, 1, At, B1); PG8_BAR; PG8_SCHED;
            PG8_LDB(B0, 1, 0); PG8_LDB(B1, 1, 1); PG8_SCHED; PG8_LDA(At, 1, 0); PG8_STAGE(PG8_SA(0, 1), a2, va2[1]);
            PG8_WAIT_V(8); PG8_WAIT_L(0); PG8_BAR; PG8_MMA(0, 0, At, B0); PG8_MMA(0, 1, At, B1); PG8_BAR; PG8_SCHED;
            PG8_LDA(At, 1, 1); PG8_STAGE(PG8_SB(1, 0), b3, voffB); PG8_STAGE(PG8_SB(1, 1), b3 + hstepB, voffB); PG8_STAGE(PG8_SA(1, 0), a3, va2[0]);
            PG8_WAIT_V(8); PG8_WAIT_L(0); PG8_BAR; PG8_MMA(1, 0, At, B0); PG8_MMA(1, 1, At, B1); PG8_BAR; PG8_SCHED;
        }
        if (ALIGN_EPI) { if (wr == 0) PG8_BAR; }
        E(acc, cur, wr, wc, fr, fq);
        if (!has_next) break;
#pragma unroll
        for (int a = 0; a < 2; ++a)
#pragma unroll
            for (int b = 0; b < 2; ++b)
#pragma unroll
                for (int m = 0; m < 4; ++m)
#pragma unroll
                    for (int n = 0; n < 2; ++n) acc[a][b][m][n] = (f32x4){0.f, 0.f, 0.f, 0.f};
        cur = nxt; cA = nA; cB = nB; ++ui;
#pragma unroll
        for (int h = 0; h < 2; ++h)
#pragma unroll
            for (int i = 0; i < 2; ++i) vAc[h][i] = vAn[h][i];
        if (ALIGN_EPI) { if (wr == 1) PG8_BAR; }
    }
    PG8_WAIT_V(0);
    if (!ALIGN_EPI) { if (wr == 0) PG8_BAR; }
    PG8_BAR;
#undef PG8_SA
#undef PG8_SB
#undef PG8_STAGE
#undef PG8_LDA
#undef PG8_LDB
#undef PG8_MMA
#undef PG8_WAIT_V
#undef PG8_WAIT_L
#undef PG8_BAR
#undef PG8_SCHED
}
__device__ __forceinline__ void plain_voffA(int K, unsigned (&vA)[2][2], int tid_l) {
#pragma unroll
    for (int i = 0; i < 2; ++i) { int R, C; stage_rc(tid_l * 16 + i * 8192, R, C); vA[0][i] = (unsigned)(R * K + C) * 2u; vA[1][i] = (unsigned)((R + HALF) * K + C) * 2u; }
}
}


__device__ __forceinline__ int xcd_vbid(int bid, int nb) { return (nb & 7) ? bid : (bid & 7) * (nb >> 3) + (bid >> 3); }
struct SchedIn { const MK* p; int bid, nb, tid_l;
    __device__ __forceinline__ bool next(int i, pg8::GUnit& u, unsigned (&vA)[2][2]) const {
        const int tile = xcd_vbid(bid, nb) + i * nb; if (tile >= (NR / 256) * 12) return false;
        const int pm = tile / 12, pn = tile % 12;
        u.A = (const char*)(p->H() + (size_t)(pm * 256) * D); u.B = (const char*)(p->w_inT() + (size_t)(pn * 256) * D); u.i0 = pm; u.i1 = pn; u.i2 = 0; u.i3 = 0;
        pg8::plain_voffA(D, vA, tid_l); return true; } };
struct EpiIn { static constexpr bool PERM = false; const MK* p;
    __device__ __forceinline__ void operator()(f32x4 (&acc)[2][2][4][2], const pg8::GUnit& u, int wr, int wc, int fr_in, int fq_in) const {
        int fr = fr_in, fq = fq_in; asm volatile("" : "+v"(fr), "+v"(fq));
        const int pm = u.i0, seg = u.i1, brow = pm * 256;
        const int b = brow / RB, i0 = brow % RB;
        const bool lat = i0 >= CTX;
        const int wid = wr * 4 + wc, lane = fq * 16 + fr;
        if (lat && (seg <= 3 || seg == 6 || seg == 7)) {
#pragma unroll
            for (int ai = 0; ai < 2; ++ai)
#pragma unroll
                for (int m = 0; m < 4; ++m) {
                    const int t = i0 + ai * 128 + wr * 64 + m * 16 + fr - CTX, pos = (wc & 1) ? (t & 63) : (t >> 6);
                    const f32x4 cc = *(const f32x4*)(p->ropec() + pos * 16 + fq * 4), ss = *(const f32x4*)(p->ropes() + pos * 16 + fq * 4);
#pragma unroll
                    for (int bj = 0; bj < 2; ++bj) { const f32x4 x1 = acc[ai][bj][m][0], x2 = acc[ai][bj][m][1];
                        acc[ai][bj][m][0] = x1 * cc - x2 * ss; acc[ai][bj][m][1] = x1 * ss + x2 * cc; }
                }
        }
        if (seg == 7 || seg <= 1) {
            const float sc_ = seg == 7 ? 0.125f : 0.125f * 1.4426950408889634f;
#pragma unroll
            for (int ai = 0; ai < 2; ++ai)
#pragma unroll
                for (int bj = 0; bj < 2; ++bj)
#pragma unroll
                    for (int m = 0; m < 4; ++m) { acc[ai][bj][m][0] = acc[ai][bj][m][0] * sc_; acc[ai][bj][m][1] = acc[ai][bj][m][1] * sc_; }
        }
        if (seg <= 7 || seg >= 10) {
#pragma unroll
            for (int bj = 0; bj < 2; ++bj) {
                bf16_t* base; long rstride; bool ok = true;
                if (seg <= 1)      { const int h = (seg & 1) * 2 + bj;       base = p->Q() + (((size_t)(b * 4 + h) * SEQ + (i0 - CTX)) * 128 + wc * 32 + fq * 4); rstride = 128; ok = lat; }
                else if (seg <= 3) { const int h = (seg - 2) * 2 + bj;       base = p->K() + (((size_t)(b * 4 + h) * RB + i0) * 128 + wc * 32 + fq * 4);          rstride = 128; }
                else if (seg <= 5) { const int h = (seg - 4) * 2 + bj;       base = p->V() + (((size_t)(b * 4 + h) * RB + i0) * 128 + wc * 32 + fq * 4);          rstride = 128; }
                else if (seg == 6) { const int h = bj * 2 + (wc >> 1);       base = p->RQ() + (((size_t)(b * 4 + h) * RB + i0) * 64 + (wc & 1) * 32 + fq * 4);    rstride = 64; }
                else if (seg == 7) { const int h = bj * 2 + (wc >> 1);       base = p->RK() + (((size_t)(b * 4 + h) * RB + i0) * 64 + (wc & 1) * 32 + fq * 4);    rstride = 64; }
                else               {                                         base = p->RG() + ((size_t)(b * SEQ + (i0 - CTX)) * 512 + (seg - 10) * 256 + bj * 128 + wc * 32 + fq * 4); rstride = 512; ok = lat; }
                if (ok) {
#pragma unroll
                    for (int ai = 0; ai < 2; ++ai)
#pragma unroll
                        for (int m = 0; m < 4; ++m) { bf16_t* rp = base + (long)(ai * 128 + wr * 64 + m * 16 + fr) * rstride;
#pragma unroll
                            for (int n = 0; n < 2; ++n) { u32x2 w; w.x = cvtpk(acc[ai][bj][m][n][0], acc[ai][bj][m][n][1]); w.y = cvtpk(acc[ai][bj][m][n][2], acc[ai][bj][m][n][3]);
                                *(u32x2*)(rp + n * 16) = w; } }
                }
            }
        }
        if (seg >= 7 && seg <= 9) {
            char* img = smem + 131072 + wid * 3968;
            const int npass = seg == 7 ? 2 : 1;
#pragma unroll 1
            for (int ps = 0; ps < npass; ++ps) {
#pragma unroll
                for (int bj = 0; bj < 2; ++bj) {
                    float lg2 = 0.f; bf16_t* baseT;
                    if (seg == 7) { const int h = bj * 2 + (wc >> 1); const float dv = ps == 0 ? p->dec_f[h] : p->dec_b[h]; lg2 = log2f(1.0f / (1.0f + expf(-dv)));
                        baseT = (ps == 0 ? p->KTf() : p->KTb()) + (size_t)(b * 4 + h) * 64 * RB + (size_t)(i0 >> 7) * 8192 + (wc & 1) * 32 * 128; }
                    else { const int h = (seg - 8) * 2 + bj; baseT = p->VT() + (size_t)(b * 4 + h) * 128 * RB + (size_t)(i0 >> 7) * 16384 + wc * 32 * 128; }
#pragma unroll
                    for (int ai = 0; ai < 2; ++ai)
#pragma unroll
                        for (int mp = 0; mp < 2; ++mp) {
                            asm volatile("s_waitcnt lgkmcnt(0)" ::: "memory");
#pragma unroll
                            for (int mm = 0; mm < 2; ++mm) { const int m = mp * 2 + mm;
                                float f = 1.0f;
                                if (seg == 7) { const int pos = (i0 + ai * 128 + wr * 64 + m * 16 + fr) & 127; f = __builtin_amdgcn_exp2f((float)(ps == 0 ? 127 - pos : pos) * lg2); }
#pragma unroll
                                for (int n = 0; n < 2; ++n)
#pragma unroll
                                    for (int j = 0; j < 4; ++j) *(bf16_t*)(img + (n * 16 + fq * 4 + j) * 80 + (mm * 16 + fr) * 2) = f2bf(acc[ai][bj][m][n][j] * f); }
                            asm volatile("s_waitcnt lgkmcnt(0)" ::: "memory");
                            const int ib = ai * (seg == 7 ? 8192 : 16384) + wr * 64 + mp * 32;
#pragma unroll
                            for (int k = 0; k < 2; ++k) { const int q = lane + 64 * k, col = q >> 2, ch = q & 3;
                                *(u32x4*)(baseT + (size_t)col * 128 + ib + ch * 8) = *(const u32x4*)(img + col * 80 + ch * 16); }
                        }
                }
            }
        }
    } };
__device__ __forceinline__ void ph_gemm_in(const MK& p, int bid, int nb, int tid_l) {
    SchedIn S{&p, bid, nb, tid_l}; EpiIn E{&p};
    pg8::gemm<EpiIn, SchedIn, false, true>(D, S, E, tid_l);
}

struct SchedOut { const MK* p; int bid, nb, tid_l;
    __device__ __forceinline__ bool next(int i, pg8::GUnit& u, unsigned (&vA)[2][2]) const {
        const int tile = xcd_vbid(bid, nb) + i * nb; if (tile >= (T / 256) * 4) return false;
        const int pm = tile >> 2, pn = tile & 3;
        u.A = (const char*)(p->MIX() + (size_t)(pm * 256) * D); u.B = (const char*)(p->w_outT() + (size_t)(pn * 256) * D); u.i0 = pm; u.i1 = pn; u.i2 = 0; u.i3 = 0;
        pg8::plain_voffA(D, vA, tid_l); return true; } };
struct EpiOut { static constexpr bool PERM = true; const MK* p;
    __device__ __forceinline__ void operator()(const f32x4 (&acc)[2][2][4][2], const pg8::GUnit& u, int wr, int wc, int fr, int fq) const {
        const int brow = u.i0 * 256, bcol = u.i1 * 256 + wc * 32 + fq * 8;
        const float* g1 = p->mod() + (size_t)(brow / SEQ) * 6 * D + 2 * D + bcol;
        f32x4 gv[2][2];
#pragma unroll
        for (int bj = 0; bj < 2; ++bj)
#pragma unroll
            for (int n = 0; n < 2; ++n) gv[bj][n] = *(const f32x4*)(g1 + bj * 128 + n * 4);
#pragma unroll
        for (int ai = 0; ai < 2; ++ai)
#pragma unroll
            for (int m = 0; m < 4; ++m) {
                const int row = brow + ai * 128 + wr * 64 + m * 16 + fr;
                const float* xp = p->x + (size_t)row * D + bcol;
                f32x4 xv[2][2];
#pragma unroll
                for (int bj = 0; bj < 2; ++bj)
#pragma unroll
                    for (int n = 0; n < 2; ++n) xv[bj][n] = *(const f32x4*)(xp + bj * 128 + n * 4);
#pragma unroll
                for (int bj = 0; bj < 2; ++bj) {
                    const f32x4 a = xv[bj][0] + gv[bj][0] * acc[ai][bj][m][0], b = xv[bj][1] + gv[bj][1] * acc[ai][bj][m][1];
                    const u32x4 w = {cvtpk(a[0], a[1]), cvtpk(a[2], a[3]), cvtpk(b[0], b[1]), cvtpk(b[2], b[3])};
                    *(u32x4*)(p->X1() + (size_t)row * 2048 + bcol + bj * 128) = w;
                }
                if (m & 1) asm volatile("" ::: "memory");
            }
    } };
__device__ __forceinline__ void ph_gemm_out(const MK& p, int bid, int nb, int tid_l) {
    SchedOut S{&p, bid, nb, tid_l}; EpiOut E{&p};
    pg8::gemm<EpiOut, SchedOut, false, true>(D, S, E, tid_l);
}

template <bool DUMMY, int MODE = 0> __device__ __forceinline__ void ph_route(const MK& p, int bid, int nb, int tid_l) {
    int* cntp = p.cnt() + (DUMMY ? 128 : 0); int* tl = DUMMY ? (int*)(p.ws + 480 * MiB) : p.tok_list(); float* wl_ = DUMMY ? (float*)(p.ws + 488 * MiB) : p.wt_list(); int* tm = DUMMY ? (int*)(p.ws + 496 * MiB) : p.tokmap();
    const int tid = tid_l, wid = tid >> 6, lane = tid & 63, fr = lane & 15, fq = lane >> 4;
    float* lg = (float*)smem;
    int* wcnt = (int*)(smem + 34816);
    int* pref = wcnt + 512;
    bf16_t* H2lo = (bf16_t*)(p.ws + 325 * MiB);
    for (int item = bid; item < T / 128; item += nb) {
        const int t0 = item * 128 + wid * 16, b = (item * 128) / SEQ;
        const float* msh = p.mod() + (size_t)b * 6 * D + 3 * D; const float* msc = p.mod() + (size_t)b * 6 * D + 4 * D;
#pragma unroll 1
        for (int r0 = 0; r0 < 16; r0 += 4) {
            float4 xv[4][4];
#pragma unroll
            for (int rr = 0; rr < 4; ++rr)
#pragma unroll
                for (int q = 0; q < 4; ++q) { const u32x2 w = *(const u32x2*)(p.X1() + (size_t)(t0 + r0 + rr) * 2048 + q * 256 + lane * 4);
                    xv[rr][q] = make_float4(__uint_as_float(w.x << 16), __uint_as_float(w.x & 0xffff0000u), __uint_as_float(w.y << 16), __uint_as_float(w.y & 0xffff0000u)); }
#pragma unroll
            for (int rr = 0; rr < 4; ++rr) {
                float ss = 0.f;
#pragma unroll
                for (int q = 0; q < 4; ++q) ss += xv[rr][q].x * xv[rr][q].x + xv[rr][q].y * xv[rr][q].y + xv[rr][q].z * xv[rr][q].z + xv[rr][q].w * xv[rr][q].w;
                ss = wave_sum(ss);
                const float rstd = rsqrtf(ss * (1.0f / D) + EPS);
#pragma unroll
                for (int q = 0; q < 4; ++q) {
                    const int c0 = q * 256 + lane * 4;
                    const float4 gg = *(const float4*)(p.norm2_g + c0), sh = *(const float4*)(msh + c0), sc = *(const float4*)(msc + c0);
                    const float h0 = xv[rr][q].x * rstd * gg.x * (1 + sc.x) + sh.x, h1 = xv[rr][q].y * rstd * gg.y * (1 + sc.y) + sh.y;
                    const float h2v = xv[rr][q].z * rstd * gg.z * (1 + sc.z) + sh.z, h3 = xv[rr][q].w * rstd * gg.w * (1 + sc.w) + sh.w;
                    u32x2 wh, wl2; wh.x = cvtpk(h0, h1); wh.y = cvtpk(h2v, h3);
                    wl2.x = cvtpk(h0 - __uint_as_float(wh.x << 16), h1 - __uint_as_float(wh.x & 0xffff0000u));
                    wl2.y = cvtpk(h2v - __uint_as_float(wh.y << 16), h3 - __uint_as_float(wh.y & 0xffff0000u));
                    *(u32x2*)(p.H2() + (size_t)(t0 + r0 + rr) * D + c0) = wh;
                    *(u32x2*)(H2lo + (size_t)(t0 + r0 + rr) * D + c0) = wl2;
                }
            }
        }
        asm volatile("s_waitcnt vmcnt(0)" ::: "memory");
        __syncthreads();
        if (MODE == 3) continue;
        f32x4 acc[4];
#pragma unroll
        for (int nt = 0; nt < 4; ++nt) acc[nt] = (f32x4){0.f, 0.f, 0.f, 0.f};
        {
            const bf16_t* ah_p = p.H2() + (size_t)(t0 + fr) * D + fq * 8; const bf16_t* al_p = H2lo + (size_t)(t0 + fr) * D + fq * 8;
            const int widu = __builtin_amdgcn_readfirstlane(wid);
            unsigned rofs[4];
#pragma unroll
            for (int i = 0; i < 4; ++i) { const int x = wid * 1024 + i * 8192 + lane * 16, row = x >> 8, c = ((x & 255) >> 4) ^ (row & 15); rofs[i] = (unsigned)(row * 2048 + c * 16); }
#define RT_DMA(kc, buf) do { const char* src_ = (const char*)p.routerT() + (size_t)(kc) * 256;                                             \
            _Pragma("unroll") for (int i = 0; i < 4; ++i) __builtin_amdgcn_global_load_lds((const unsigned*)(src_ + rofs[i]), (unsigned*)(smem + 40960 + (buf) * 32768 + widu * 1024 + i * 8192), 16, 0, 0); } while (0)
            RT_DMA(0, 0);
#pragma unroll 1
            for (int kc = 0; kc < 8; ++kc) {
                bf16x8 ah[4], al[4];
#pragma unroll
                for (int ks = 0; ks < 4; ++ks) { ah[ks] = ldfrag(ah_p + kc * 128 + ks * 32); al[ks] = ldfrag(al_p + kc * 128 + ks * 32); }
                asm volatile("s_waitcnt vmcnt(0)" ::: "memory"); __syncthreads();
                if (kc + 1 < 8) RT_DMA(kc + 1, (kc + 1) & 1);
                const char* bb = smem + 40960 + (kc & 1) * 32768;
#pragma unroll
                for (int ks = 0; ks < 4; ++ks)
#pragma unroll
                    for (int nt = 0; nt < 4; ++nt) {
                        const int row = nt * 16 + fr, cc = ((ks * 4 + fq) ^ (row & 15)) * 16;
                        const bf16x8 bh = *(const bf16x8*)(bb + row * 256 + cc), bl = *(const bf16x8*)(bb + (64 + row) * 256 + cc);
                        acc[nt] = __builtin_amdgcn_mfma_f32_16x16x32_bf16(ah[ks], bh, acc[nt], 0, 0, 0);
                        acc[nt] = __builtin_amdgcn_mfma_f32_16x16x32_bf16(ah[ks], bl, acc[nt], 0, 0, 0);
                        acc[nt] = __builtin_amdgcn_mfma_f32_16x16x32_bf16(al[ks], bh, acc[nt], 0, 0, 0);
                    }
            }
#undef RT_DMA
        }
#pragma unroll
        for (int nt = 0; nt < 4; ++nt)
#pragma unroll
            for (int j = 0; j < 4; ++j) lg[(wid * 16 + fq * 4 + j) * 65 + nt * 16 + fr] = acc[nt][j];
        __syncthreads();
        if (MODE == 2) continue;
        int l3 = lane; asm volatile("" : "+v"(l3));
#define SHXF(v_, m_) __int_as_float(__builtin_amdgcn_ds_bpermute((l3 ^ (m_)) << 2, __float_as_int(v_)))
#define SHXI(v_, m_) __builtin_amdgcn_ds_bpermute((l3 ^ (m_)) << 2, (v_))
#define SHBF(v_, src_) __int_as_float(__builtin_amdgcn_ds_bpermute((src_) << 2, __float_as_int(v_)))
#define SHBI(v_, src_) __builtin_amdgcn_ds_bpermute((src_) << 2, (v_))
        const int q4 = l3 & 3, tt = wid * 16 + (l3 >> 2), t = item * 128 + tt, qbase = l3 & ~3;
        float sc_[16], v[16];
#pragma unroll
        for (int i = 0; i < 16; ++i) { const float x = lg[tt * 65 + q4 * 16 + i]; sc_[i] = __builtin_amdgcn_rcpf(1.0f + __builtin_amdgcn_exp2f(-1.4426950408889634f * x)); v[i] = sc_[i] + p.router_b[q4 * 16 + i]; }
        float gsA, gsB;
        { float m1 = v[0], m2 = -INFINITY;
#pragma unroll
          for (int i = 1; i < 8; ++i) { const float x = v[i]; m2 = fmaxf(m2, fminf(m1, x)); m1 = fmaxf(m1, x); }
          gsA = m1 + m2; m1 = v[8]; m2 = -INFINITY;
#pragma unroll
          for (int i = 9; i < 16; ++i) { const float x = v[i]; m2 = fmaxf(m2, fminf(m1, x)); m1 = fmaxf(m1, x); }
          gsB = m1 + m2; }
        { int rankA = 0, rankB = 0;
#pragma unroll
          for (int qq = 0; qq < 4; ++qq) {
              const float ga = SHBF(gsA, qbase | qq), gb = SHBF(gsB, qbase | qq);
              const int g0 = 2 * qq, g1 = 2 * qq + 1, mA = 2 * q4, mB = 2 * q4 + 1;
              rankA += (g0 != mA && (ga > gsA || (ga == gsA && g0 < mA))) ? 1 : 0; rankA += (g1 != mA && (gb > gsA || (gb == gsA && g1 < mA))) ? 1 : 0;
              rankB += (g0 != mB && (ga > gsB || (ga == gsB && g0 < mB))) ? 1 : 0; rankB += (g1 != mB && (gb > gsB || (gb == gsB && g1 < mB))) ? 1 : 0;
          }
          if (rankA >= 4) {
#pragma unroll
              for (int i = 0; i < 8; ++i) v[i] = -INFINITY; }
          if (rankB >= 4) {
#pragma unroll
              for (int i = 8; i < 16; ++i) v[i] = -INFINITY; } }
        unsigned chm = 0u;
#pragma unroll 1
        for (int it = 0; it < 8; ++it) {
            float lm = v[0];
#pragma unroll
            for (int i = 1; i < 16; ++i) lm = fmaxf(lm, v[i]);
            float gm = fmaxf(lm, SHXF(lm, 1)); gm = fmaxf(gm, SHXF(gm, 2));
            int cand = (lm == gm) ? q4 : 4;
            cand = min(cand, SHXI(cand, 1)); cand = min(cand, SHXI(cand, 2));
            const bool win = cand == q4;
            bool found = false;
#pragma unroll
            for (int i = 0; i < 16; ++i) { const bool hit = win && !found && v[i] == gm; if (hit) { chm |= (1u << i); v[i] = -INFINITY; } found = found || hit; }
        }
        float wsum = 0.f;
#pragma unroll
        for (int i = 0; i < 16; ++i) wsum += ((chm >> i) & 1u) ? sc_[i] : 0.f;
        wsum += SHXF(wsum, 1); wsum += SHXF(wsum, 2);
        const float wscale = 2.5f / wsum;
        const unsigned long long pat = 0x1111111111111111ull << q4;
#pragma unroll
        for (int i = 0; i < 16; ++i) { const unsigned long long bal = __ballot((chm >> i) & 1u); if (l3 < 4) wcnt[wid * 64 + l3 * 16 + i] = __popcll(bal & (0x1111111111111111ull << l3)); }
        __syncthreads();
        if (wid == 0) {
            int tot = 0;
#pragma unroll
            for (int w = 0; w < 8; ++w) tot += wcnt[w * 64 + lane];
            int run = atomicAdd(&cntp[lane], tot);
#pragma unroll
            for (int w = 0; w < 8; ++w) { const int c = wcnt[w * 64 + lane]; pref[w * 64 + lane] = run; run += c; }
        }
        __syncthreads();
        {
            const int pc = __popc(chm);
            int kbase = 0;
#pragma unroll
            for (int qq = 0; qq < 3; ++qq) { const int o = SHBI(pc, qbase | qq); kbase += (qq < q4) ? o : 0; }
#pragma unroll
            for (int i = 0; i < 16; ++i) {
                const bool c = (chm >> i) & 1u;
                const unsigned long long bal = __ballot(c);
                if (c) {
                    const int e = q4 * 16 + i;
                    const int slot = pref[wid * 64 + e] + __popcll(bal & pat & ((1ull << l3) - 1ull));
                    tl[(size_t)e * ECAP + slot] = t; wl_[(size_t)e * ECAP + slot] = sc_[i] * wscale;
                    tm[(size_t)t * 8 + kbase + __popc(chm & ((1u << i) - 1u))] = e * ECAP + slot;
                }
            }
        }
    }
}
#undef SHXF
#undef SHXI
#undef SHBF
#undef SHBI

constexpr int MOE_AUX = 162816;
__device__ __forceinline__ void moe_tables(const MK& p, int colt, int* tpre, int* rbase, int tid_l) {
    __syncthreads();
    if (tid_l == 0) { int tp = 0, rb = 0;
        for (int e = 0; e < 65; ++e) { const int c = e < 64 ? p.cnt()[e] : T; tpre[e] = tp; rbase[e] = rb; tp += ((c + 255) >> 8) * colt; rb += c; }
        tpre[65] = tp; rbase[65] = rb; }
    __syncthreads();
}
struct SchedUp { const MK* p; int bid, nb, tid_l, ntiles; const int* tpre; const int* rbase; mutable int e_hint;
    __device__ __forceinline__ bool next(int i, pg8::GUnit& u, unsigned (&vA)[2][2]) const {
        const int tile = xcd_vbid(bid, nb) + i * nb; if (tile >= ntiles) return false;
        int e = e_hint; while (tile >= tpre[e + 1]) ++e; e_hint = e;
        const int j = tile - tpre[e], rt = j >> 1, ct = j & 1, cnt_e = rbase[e + 1] - rbase[e];
        u.A = (const char*)p->H2(); u.B = (const char*)(p->W13t() + ((size_t)e * 512 + ct * 256) * D); u.i0 = e; u.i1 = rt; u.i2 = ct; u.i3 = cnt_e;
#pragma unroll
        for (int i2 = 0; i2 < 2; ++i2) { int R, C; stage_rc(tid_l * 16 + i2 * 8192, R, C);
#pragma unroll
            for (int h = 0; h < 2; ++h) { int slot = rt * 256 + h * 128 + R; if (slot >= cnt_e) slot = 0;
                const int tok = e < 64 ? p->tok_list()[(size_t)e * ECAP + slot] : slot;
                vA[h][i2] = (unsigned)tok * (D * 2u) + (unsigned)C * 2u; } }
        return true; } };
template <bool NOSTORE = false> struct EpiUpT { static constexpr bool PERM = true; const MK* p; const int* rbase;
    __device__ __forceinline__ void operator()(const f32x4 (&acc)[2][2][4][2], const pg8::GUnit& u, int wr, int wc, int fr, int fq) const {
        const int e = u.i0, rt = u.i1, ct = u.i2, cnt_e = u.i3;
        bf16_t* ab = p->ACT() + (size_t)rbase[e] * DE + ct * 128 + wc * 32 + fq * 8;
#pragma unroll
        for (int ai = 0; ai < 2; ++ai)
#pragma unroll
            for (int m = 0; m < 4; ++m) {
                const int slot = rt * 256 + ai * 128 + wr * 64 + m * 16 + fr;
                u32x4 w;
                w.x = cvtpk(silu_fast(acc[ai][0][m][0][0]) * acc[ai][1][m][0][0], silu_fast(acc[ai][0][m][0][1]) * acc[ai][1][m][0][1]);
                w.y = cvtpk(silu_fast(acc[ai][0][m][0][2]) * acc[ai][1][m][0][2], silu_fast(acc[ai][0][m][0][3]) * acc[ai][1][m][0][3]);
                w.z = cvtpk(silu_fast(acc[ai][0][m][1][0]) * acc[ai][1][m][1][0], silu_fast(acc[ai][0][m][1][1]) * acc[ai][1][m][1][1]);
                w.w = cvtpk(silu_fast(acc[ai][0][m][1][2]) * acc[ai][1][m][1][2], silu_fast(acc[ai][0][m][1][3]) * acc[ai][1][m][1][3]);
                if (NOSTORE) { if (slot < -cnt_e) *(u32x4*)(ab + (size_t)slot * DE) = w; } else if (slot < cnt_e) *(u32x4*)(ab + (size_t)slot * DE) = w;
            }
    } };
__device__ __forceinline__ void ph_moe_up(const MK& p, int bid, int nb, int tid_l) {
    int* tpre = (int*)(smem + MOE_AUX); int* rbase = tpre + 80;
    moe_tables(p, 2, tpre, rbase, tid_l);
    SchedUp S{&p, bid, nb, tid_l, tpre[65], tpre, rbase, 0}; EpiUpT<false> E{&p, rbase};
    pg8::gemm<EpiUpT<false>, SchedUp, true, true>(D, S, E, tid_l);
}
constexpr float Y_SCALE = 64.0f;
struct SchedDown { const MK* p; int bid, nb, tid_l, ntiles; const int* tpre; const int* rbase; mutable int e_hint;
    __device__ __forceinline__ bool next(int i, pg8::GUnit& u, unsigned (&vA)[2][2]) const {
        const int tile = xcd_vbid(bid, nb) + i * nb; if (tile >= ntiles) return false;
        int e = e_hint; while (tile >= tpre[e + 1]) ++e; e_hint = e;
        const int j = tile - tpre[e], rt = j >> 2, ct = j & 3, cnt_e = rbase[e + 1] - rbase[e];
        u.A = (const char*)(p->ACT() + (size_t)(rbase[e] + rt * 256) * DE); u.B = (const char*)(p->W2t() + ((size_t)e * D + ct * 256) * DE); u.i0 = e; u.i1 = rt; u.i2 = ct; u.i3 = cnt_e;
        pg8::plain_voffA(DE, vA, tid_l); return true; } };
template <int MODE> struct EpiDown { static constexpr bool PERM = true; const MK* p; const int* rbase;
    __device__ __forceinline__ void operator()(const f32x4 (&acc)[2][2][4][2], const pg8::GUnit& u, int wr, int wc, int fr, int fq) const {
        const int e = u.i0, rt = u.i1, ct = u.i2, cnt_e = u.i3;
        {
            const float* wl = p->wt_list() + (size_t)(e < 64 ? e : 0) * ECAP;
            float wv[2][4];
#pragma unroll
            for (int ai = 0; ai < 2; ++ai)
#pragma unroll
                for (int m = 0; m < 4; ++m) { const int sl = rt * 256 + ai * 128 + wr * 64 + m * 16 + fr; wv[ai][m] = e < 64 ? wl[sl < cnt_e ? sl : 0] * Y_SCALE : Y_SCALE; }
            const int wid = wr * 4 + wc, lane = fq * 16 + fr;
            char* wa = smem + 131072 + wid * 3968;
            unsigned char* yb = p->Y() + (size_t)rbase[e] * D + ct * 256 + wc * 64 + (lane & 3) * 16;
#pragma unroll
            for (int ai = 0; ai < 2; ++ai)
#pragma unroll
                for (int m = 0; m < 4; ++m) {
                    const float w = wv[ai][m];
                    char* img = wa + ((m & 1) ? 1280 : 0);
#pragma unroll
                    for (int bj = 0; bj < 2; ++bj) {
                        u32x2 pk;
#pragma unroll
                        for (int n = 0; n < 2; ++n) {
                            float v0 = __builtin_amdgcn_fmed3f(acc[ai][bj][m][n][0] * w, -448.f, 448.f), v1 = __builtin_amdgcn_fmed3f(acc[ai][bj][m][n][1] * w, -448.f, 448.f);
                            float v2 = __builtin_amdgcn_fmed3f(acc[ai][bj][m][n][2] * w, -448.f, 448.f), v3 = __builtin_amdgcn_fmed3f(acc[ai][bj][m][n][3] * w, -448.f, 448.f);
                            int q = 0; q = __builtin_amdgcn_cvt_pk_fp8_f32(v0, v1, q, false); q = __builtin_amdgcn_cvt_pk_fp8_f32(v2, v3, q, true);
                            if (n == 0) pk.x = (unsigned)q; else pk.y = (unsigned)q;
                        }
                        *(u32x2*)(img + fr * 80 + bj * 32 + fq * 8) = pk;
                    }
                    asm volatile("s_waitcnt lgkmcnt(0)" ::: "memory");
                    const int rr = lane >> 2, slot = rt * 256 + ai * 128 + wr * 64 + m * 16 + rr;
                    const u32x4 v = *(const u32x4*)(img + rr * 80 + (lane & 3) * 16);
                    if (MODE == 1) asm volatile("" :: "v"(v)); else if (slot < cnt_e) *(u32x4*)(yb + (size_t)slot * D) = v;
                }
        }
    } };
template <bool DUMMY, int MODE = 0> __device__ __forceinline__ void ph_moe_down(const MK& p, int bid, int nb, int tid_l) {
    int* tpre = (int*)(smem + MOE_AUX); int* rbase = tpre + 80;
    moe_tables(p, 4, tpre, rbase, tid_l);
    SchedDown S{&p, bid, nb, tid_l, DUMMY ? tpre[64] : tpre[65], tpre, rbase, 0}; EpiDown<MODE> E{&p, rbase};
    pg8::gemm<EpiDown<MODE>, SchedDown, false, true>(DE, S, E, tid_l);
}

#if DUP >= 21 && DUP <= 29
template <bool PERM_> struct EpiNull { static constexpr bool PERM = PERM_;
    __device__ __forceinline__ void operator()(const f32x4 (&acc)[2][2][4][2], const pg8::GUnit& u, int wr, int wc, int fr, int fq) const {
#pragma unroll
        for (int a = 0; a < 2; ++a)
#pragma unroll
            for (int b = 0; b < 2; ++b)
#pragma unroll
                for (int m = 0; m < 4; ++m) { asm volatile("" :: "v"(acc[a][b][m][0]), "v"(acc[a][b][m][1])); }
    } };
__device__ __forceinline__ void ph_probe_in(const MK& p, int bid, int nb, int tid_l) { SchedIn S{&p, bid, nb, tid_l}; EpiNull<false> E; pg8::gemm<EpiNull<false>, SchedIn, false, true>(D, S, E, tid_l); }
__device__ __forceinline__ void ph_probe_out(const MK& p, int bid, int nb, int tid_l) { SchedOut S{&p, bid, nb, tid_l}; EpiNull<true> E; pg8::gemm<EpiNull<true>, SchedOut, false, true>(D, S, E, tid_l); }
__device__ __forceinline__ void ph_probe_up(const MK& p, int bid, int nb, int tid_l) {
    int* tpre = (int*)(smem + MOE_AUX); int* rbase = tpre + 80; moe_tables(p, 2, tpre, rbase, tid_l);
    SchedUp S{&p, bid, nb, tid_l, tpre[65], tpre, rbase, 0}; EpiNull<true> E; pg8::gemm<EpiNull<true>, SchedUp, true, true>(D, S, E, tid_l); }
__device__ __forceinline__ void ph_probe_up_nostore(const MK& p, int bid, int nb, int tid_l) {
    int* tpre = (int*)(smem + MOE_AUX); int* rbase = tpre + 80; moe_tables(p, 2, tpre, rbase, tid_l);
    SchedUp S{&p, bid, nb, tid_l, tpre[65], tpre, rbase, 0}; EpiUpT<true> E{&p, rbase}; pg8::gemm<EpiUpT<true>, SchedUp, true, true>(D, S, E, tid_l); }
__device__ __forceinline__ void ph_probe_down(const MK& p, int bid, int nb, int tid_l) {
    int* tpre = (int*)(smem + MOE_AUX); int* rbase = tpre + 80; moe_tables(p, 4, tpre, rbase, tid_l);
    SchedDown S{&p, bid, nb, tid_l, tpre[65], tpre, rbase, 0}; EpiNull<true> E; pg8::gemm<EpiNull<true>, SchedDown, false, true>(DE, S, E, tid_l); }
#endif
template <bool DUMMY> __device__ __forceinline__ void ph_final(const MK& p, int bid, int nb, int tid_l) {
    const int wid = tid_l >> 6, lane = tid_l & 63;
    int* tpre = (int*)(smem + MOE_AUX); int* rbase = tpre + 80;
    moe_tables(p, 1, tpre, rbase, tid_l);
    for (int t = bid * 8 + wid; t < T; t += nb * 8) {
        const int b = t / SEQ;
        float f[16];
#pragma unroll
        for (int i = 0; i < 16; ++i) f[i] = 0.f;
#pragma unroll
        for (int k = 0; k < 9; ++k) {
            int row;
            if (k < 8) { const int id = p.tokmap()[(size_t)t * 8 + k], e = id >> 15, slot = id & (ECAP - 1); row = rbase[e] + slot; } else row = rbase[64] + t;
            const unsigned char* yr = p.Y() + (size_t)row * D + lane * 4;
#pragma unroll
            for (int q = 0; q < 4; ++q) {
                const int w = *(const int*)(yr + q * 256);
                const auto lo = __builtin_amdgcn_cvt_pk_f32_fp8(w, false); const auto hi = __builtin_amdgcn_cvt_pk_f32_fp8(w, true);
                f[q * 4 + 0] += lo[0]; f[q * 4 + 1] += lo[1]; f[q * 4 + 2] += hi[0]; f[q * 4 + 3] += hi[1];
            }
        }
        const int pcol = ((lane >> 3) & 1) * 128 + (lane >> 4) * 32 + (lane & 7) * 4;
        const float* g2 = p.mod() + (size_t)b * 6 * D + 5 * D + pcol;
        const bf16_t* x1 = p.X1() + (size_t)t * 2048 + pcol;
        float* xo = p.out + (size_t)t * D + pcol;
        float v[16]; float ss = 0.f;
#pragma unroll
        for (int q = 0; q < 4; ++q) {
            const u32x2 xw = *(const u32x2*)(x1 + q * 256); const float4 g = *(const float4*)(g2 + q * 256);
            v[q * 4 + 0] = __uint_as_float(xw.x << 16) + g.x * f[q * 4 + 0] * (1.0f / Y_SCALE); v[q * 4 + 1] = __uint_as_float(xw.x & 0xffff0000u) + g.y * f[q * 4 + 1] * (1.0f / Y_SCALE);
            v[q * 4 + 2] = __uint_as_float(xw.y << 16) + g.z * f[q * 4 + 2] * (1.0f / Y_SCALE); v[q * 4 + 3] = __uint_as_float(xw.y & 0xffff0000u) + g.w * f[q * 4 + 3] * (1.0f / Y_SCALE);
            ss += v[q * 4] * v[q * 4] + v[q * 4 + 1] * v[q * 4 + 1] + v[q * 4 + 2] * v[q * 4 + 2] + v[q * 4 + 3] * v[q * 4 + 3];
        }
        ss = wave_sum(ss);
        const float rstd = rsqrtf(ss * (1.0f / D) + EPS);
#pragma unroll
        for (int q = 0; q < 4; ++q) {
            const float4 gf = *(const float4*)(p.final_g + q * 256 + pcol);
            *(float4*)((DUMMY ? (float*)(p.ws + 42 * MiB) + (size_t)t * D + pcol : xo) + q * 256) = make_float4(v[q * 4] * rstd * gf.x, v[q * 4 + 1] * rstd * gf.y, v[q * 4 + 2] * rstd * gf.z, v[q * 4 + 3] * rstd * gf.w);
        }
    }
}


#define XB_TMO      128
#define XB_XCNT(j)  (256  + 64 * (j))
#define XB_XSUB(j)  (1280 + 64 * (j))
#define XB_XGEN(j)  (2304 + 64 * (j))
#define XB_TOP      3328
#define XB_TOPGEN   3392
#define XCD_BAR_WORDS 3456
#define XB_SPIN_CAP (1u << 22)
#define LAS __attribute__((address_space(3)))
__device__ __forceinline__ unsigned xb_ld(unsigned* p)              { return __hip_atomic_load(p, __ATOMIC_RELAXED, __HIP_MEMORY_SCOPE_AGENT); }
__device__ __forceinline__ unsigned xb_add(unsigned* p, unsigned v) { return __hip_atomic_fetch_add(p, v, __ATOMIC_RELAXED, __HIP_MEMORY_SCOPE_AGENT); }
__device__ __forceinline__ unsigned xb_xcc_id() { return (unsigned)__builtin_amdgcn_s_getreg((3 << 11) | 20) & 0xFu; }
#define XB_SPIN(cond, bar) do { unsigned _sp = 0; while (cond) { __builtin_amdgcn_s_sleep(1); \
    if ((++_sp & 255u) == 0u) { if (xb_ld(&(bar)[XB_TMO])) break; if (_sp > XB_SPIN_CAP) { atomicAdd(&(bar)[XB_TMO], 1u); break; } } } } while (0)
struct XcdBarrier { unsigned* bar; unsigned x; volatile LAS unsigned* st; };
__device__ __forceinline__ XcdBarrier xcd_barrier_post(unsigned* bar, volatile LAS unsigned* st, int tid) {
    XcdBarrier b; b.bar = bar; b.x = xb_xcc_id(); b.st = st;
    if (tid == 0) (void)xb_add(&bar[XB_XCNT(b.x)], 1u);
    return b;
}
__device__ __forceinline__ void xcd_barrier_complete(unsigned* bar, unsigned x, unsigned& nloc, unsigned& nx) {
    const unsigned G = gridDim.x * gridDim.y * gridDim.z;
    unsigned sum, cnt, mine, sp = 0u;
    for (;;) {
        sum = 0u; cnt = 0u; mine = 0u;
#pragma unroll
        for (unsigned j = 0; j < 16; ++j) { const unsigned c = xb_ld(&bar[XB_XCNT(j)]); sum += c; cnt += (c > 0u) ? 1u : 0u; mine = (j == x) ? c : mine; }
        if (sum == G) break;
        __builtin_amdgcn_s_sleep(1);
        if ((++sp & 255u) == 0u) { if (xb_ld(&bar[XB_TMO])) break; if (sp > XB_SPIN_CAP) { atomicAdd(&bar[XB_TMO], 1u); break; } }
    }
    nloc = mine > 0u ? mine : 1u; nx = cnt > 0u ? cnt : 1u;
}
__device__ __forceinline__ void xcd_barrier(const XcdBarrier& b, int tid) {
    asm volatile("s_waitcnt vmcnt(0)" ::: "memory");
    __syncthreads();
    if (tid == 0) {
        unsigned* bar = b.bar;
        __builtin_amdgcn_s_waitcnt(0);
        unsigned nloc = b.st[0], nx = b.st[1];
        if (nloc == 0u) { xcd_barrier_complete(bar, b.x, nloc, nx); b.st[0] = nloc; b.st[1] = nx; }
        const unsigned old = xb_add(&bar[XB_XSUB(b.x)], 1u);
        const unsigned gen = old / nloc;
        if (old + 1u == (gen + 1u) * nloc) {
            __builtin_amdgcn_fence(__ATOMIC_RELEASE, "agent");
            asm volatile("s_waitcnt vmcnt(0)" ::: "memory");
            const unsigned og = xb_add(&bar[XB_TOP], 1u);
            const unsigned tg = og / nx;
            if (og + 1u == (tg + 1u) * nx) xb_add(&bar[XB_TOPGEN], 1u);
            else XB_SPIN(xb_ld(&bar[XB_TOPGEN]) == tg, bar);
            __builtin_amdgcn_fence(__ATOMIC_ACQUIRE, "agent");
            xb_add(&bar[XB_XGEN(b.x)], 1u);
            asm volatile("s_waitcnt vmcnt(0)" ::: "memory");
        } else {
            XB_SPIN(xb_ld(&bar[XB_XGEN(b.x)]) == gen, bar);
            __builtin_amdgcn_fence(__ATOMIC_ACQUIRE, "agent");
            asm volatile("s_waitcnt vmcnt(0)" ::: "memory");
        }
    }
    __syncthreads();
}

__device__ __forceinline__ int lane_id_volatile() { int l; asm volatile("v_mbcnt_lo_u32_b32 %0, -1, 0\n\tv_mbcnt_hi_u32_b32 %0, -1, %0" : "=v"(l)); return l; }
__global__ __launch_bounds__(512, 2) void k_mega(MK p) {
    cg::grid_group grid = cg::this_grid();
    const int bid = blockIdx.x, nb = gridDim.x;
    volatile LAS unsigned* xst = (volatile LAS unsigned*)(smem + 162816 + 768);
    if (threadIdx.x < 4) xst[threadIdx.x] = 0u;
    __syncthreads();
    const XcdBarrier xb = xcd_barrier_post((unsigned*)(p.ws + 524288), xst, (int)threadIdx.x);
    const int wv_ = __builtin_amdgcn_readfirstlane((int)threadIdx.x >> 6);
#define LANE_ID() lane_id_volatile()
#define PH_TID() int t_ = wv_ * 64 + LANE_ID(); asm volatile("" : "+v"(t_))
    { PH_TID(); if (bid == 0 && t_ < 256) p.cnt()[t_] = 0; ph_mod(p, bid, nb, t_); ph_convert(p, bid, nb, t_); }
#if DUP == 10
    { PH_TID(); ph_convert(p, bid, nb, t_); }
#endif
#if DUP == 12
    { PH_TID(); ph_mod(p, bid, nb, t_); }
#endif
    grid.sync();
    { PH_TID(); ph_ln1(p, bid, nb, t_); }
#if DUP == 1
    { PH_TID(); ph_ln1(p, bid, nb, t_); }
#endif
    xcd_barrier(xb, wv_ * 64 + LANE_ID());
    { PH_TID(); ph_gemm_in(p, bid, nb, t_); }
    { PH_TID(); ph_convert_dyn(p, t_); }
#if DUP == 2
    { PH_TID(); ph_gemm_in(p, bid, nb, t_); }
#endif
#if DUP == 21
    { PH_TID(); ph_probe_in(p, bid, nb, t_); }
#endif
    xcd_barrier(xb, wv_ * 64 + LANE_ID());
    { PH_TID(); ph_attn<0>(p, bid, nb, t_); }
#if DUP == 3
    { PH_TID(); ph_attn<2>(p, bid, nb, t_); }
#endif
#if DUP == 31
    { PH_TID(); ph_attn<1>(p, bid, nb, t_); }
#endif
#if DUP == 33
    { PH_TID(); ph_attn<3>(p, bid, nb, t_); }
#endif
    { PH_TID(); ph_kv(p, bid, nb, t_); }
#if DUP == 11
    { PH_TID(); ph_kv(p, bid, nb, t_); }
#endif
    xcd_barrier(xb, wv_ * 64 + LANE_ID());
    { PH_TID(); ph_scan(p, bid, nb, t_); }
#if DUP == 4
    { PH_TID(); ph_scan(p, bid, nb, t_); }
#endif
    xcd_barrier(xb, wv_ * 64 + LANE_ID());
    { PH_TID(); ph_ret(p, bid, nb, t_); }
#if DUP == 5
    { PH_TID(); ph_ret(p, bid, nb, t_); }
#endif
    xcd_barrier(xb, wv_ * 64 + LANE_ID());
    { PH_TID(); ph_gemm_out(p, bid, nb, t_); }
#if DUP == 6
    { PH_TID(); ph_gemm_out(p, bid, nb, t_); }
#endif
#if DUP == 22
    { PH_TID(); ph_probe_out(p, bid, nb, t_); }
#endif
    xcd_barrier(xb, wv_ * 64 + LANE_ID());
#if DUP == 7
    { PH_TID(); ph_route<true>(p, bid, nb, t_); }
#endif
#if DUP == 72
    { PH_TID(); ph_route<true, 2>(p, bid, nb, t_); }
#endif
#if DUP == 73
    { PH_TID(); ph_route<true, 3>(p, bid, nb, t_); }
#endif
    { PH_TID(); ph_route<false>(p, bid, nb, t_); }
    xcd_barrier(xb, wv_ * 64 + LANE_ID());
    { PH_TID(); ph_moe_up(p, bid, nb, t_); }
#if DUP == 8
    { PH_TID(); ph_moe_up(p, bid, nb, t_); }
#endif
#if DUP == 23
    { PH_TID(); ph_probe_up(p, bid, nb, t_); }
#endif
#if DUP == 25
    { PH_TID(); ph_probe_up_nostore(p, bid, nb, t_); }
#endif
    xcd_barrier(xb, wv_ * 64 + LANE_ID());
#if DUP == 9
    { PH_TID(); ph_moe_down<true>(p, bid, nb, t_); }
#endif
#if DUP == 91
    { PH_TID(); ph_moe_down<true, 1>(p, bid, nb, t_); }
#endif
    { PH_TID(); ph_moe_down<false>(p, bid, nb, t_); }
#if DUP == 24
    { PH_TID(); ph_probe_down(p, bid, nb, t_); }
#endif
    xcd_barrier(xb, wv_ * 64 + LANE_ID());
#if DUP == 13
    { PH_TID(); ph_final<true>(p, bid, nb, t_); }
#endif
    { PH_TID(); ph_final<false>(p, bid, nb, t_); }
#undef PH_TID
#undef LANE_ID
}
constexpr int LDS_TOTAL = 163840;
extern "C" void kernel_launch(void* const* d_in, const int* in_sizes, int n_in, void* d_out, int out_size, void* d_ws, size_t ws_size, hipStream_t stream) {
    char* ws = (char*)d_ws;
    MK mk{};
    mk.x = (const float*)d_in[0]; mk.c = (const float*)d_in[1]; mk.ctx = (const float*)d_in[2]; mk.cctx = (const float*)d_in[3]; mk.ada_w = (const float*)d_in[4]; mk.ada_b = (const float*)d_in[5];
    mk.norm1_g = (const float*)d_in[6]; mk.w_in = (const float*)d_in[7]; mk.lq1 = (const float*)d_in[8]; mk.lk1 = (const float*)d_in[9]; mk.lq2 = (const float*)d_in[10]; mk.lk2 = (const float*)d_in[11];
    mk.dattn_g = (const float*)d_in[12]; mk.dec_f = (const float*)d_in[13]; mk.dec_b = (const float*)d_in[14]; mk.ret_g = (const float*)d_in[15]; mk.w_out = (const float*)d_in[16];
    mk.norm2_g = (const float*)d_in[17]; mk.router_w = (const float*)d_in[18]; mk.router_b = (const float*)d_in[19]; mk.ew1 = (const float*)d_in[20]; mk.ew3 = (const float*)d_in[21];
    mk.ew2 = (const float*)d_in[22]; mk.sw1 = (const float*)d_in[23]; mk.sw3 = (const float*)d_in[24]; mk.sw2 = (const float*)d_in[25]; mk.final_g = (const float*)d_in[26];
    mk.out = (float*)d_out;
    mk.ws = ws;
    mk.dbgP = nullptr; mk.dbg_lo = 0; mk.dbg_hi = 12; mk.conv_limit = 1 << 30;
    static int grid_blocks = 0;
    if (!grid_blocks) {
        (void)hipFuncSetAttribute((const void*)k_mega, hipFuncAttributeMaxDynamicSharedMemorySize, LDS_TOTAL);
        int dev = 0, cus = 0, per_cu = 0;
        (void)hipGetDevice(&dev);
        (void)hipDeviceGetAttribute(&cus, hipDeviceAttributeMultiprocessorCount, dev);
        (void)hipOccupancyMaxActiveBlocksPerMultiprocessor(&per_cu, k_mega, 512, LDS_TOTAL);
        if (per_cu > 1) per_cu = 1;
        grid_blocks = cus * per_cu;
        if (grid_blocks <= 0) { fprintf(stderr, "occupancy query failed: cus %d per_cu %d\n", cus, per_cu); grid_blocks = 256; }
    }
    (void)hipMemsetAsync(ws + 524288, 0, XCD_BAR_WORDS * 4, stream);
    void* args[] = {&mk};
    hipError_t e = hipLaunchCooperativeKernel((void*)k_mega, dim3(grid_blocks), dim3(512), args, LDS_TOTAL, stream);
    if (e != hipSuccess) fprintf(stderr, "cooperative launch failed: %s (grid %d)\n", hipGetErrorString(e), grid_blocks);
}
```

```cpp
#include <hip/hip_runtime.h>
#include <hip/hip_cooperative_groups.h>
#include <cstdio>
namespace cg = cooperative_groups;
#ifndef DUP
#define DUP 0
#endif
#include <stdint.h>

constexpr int D = 1024, NB = 4, SEQ = 8192, CTX = 256, RB = SEQ + CTX  , NR = NB * RB  , T = NB * SEQ;
constexpr int NE = 64, DE = 256, ECAP = 32768;
constexpr float EPS = 1e-6f;
typedef unsigned short bf16_t;

__device__ __forceinline__ float siluf(float v) { return v / (1.0f + expf(-v)); }
__device__ __forceinline__ float silu_fast(float v) { return v * __builtin_amdgcn_rcpf(1.0f + __builtin_amdgcn_exp2f(-1.4426950408889634f * v)); }
template <int CTRL> __device__ __forceinline__ float dppf(float v) { return __int_as_float(__builtin_amdgcn_update_dpp(0, __float_as_int(v), CTRL, 0xf, 0xf, true)); }
template <int CTRL> __device__ __forceinline__ int dppi(int v) { return __builtin_amdgcn_update_dpp(0, v, CTRL, 0xf, 0xf, true); }
__device__ __forceinline__ float wave_sum(float v) {
    v += dppf<0xB1>(v);
    v += dppf<0x4E>(v);
    v += dppf<0x141>(v);
    v += dppf<0x140>(v);
    { auto r = __builtin_amdgcn_permlane16_swap(__float_as_uint(v), __float_as_uint(v), false, false); v = __uint_as_float(r[0]) + __uint_as_float(r[1]); }
    { auto r = __builtin_amdgcn_permlane32_swap(__float_as_uint(v), __float_as_uint(v), false, false); v = __uint_as_float(r[0]) + __uint_as_float(r[1]); }
    return v;
}
__device__ __forceinline__ float wave_max(float v) {
#pragma unroll
    for (int o = 32; o > 0; o >>= 1) v = fmaxf(v, __shfl_xor(v, o));
    return v;
}
__device__ __forceinline__ float block_sum(float v, float* red) {
    v = wave_sum(v);
    __syncthreads();
    if ((threadIdx.x & 63) == 0) red[threadIdx.x >> 6] = v;
    __syncthreads();
    return red[0] + red[1] + red[2] + red[3];
}
__device__ __forceinline__ float block_max(float v, float* red) {
    v = wave_max(v);
    __syncthreads();
    if ((threadIdx.x & 63) == 0) red[threadIdx.x >> 6] = v;
    __syncthreads();
    return fmaxf(fmaxf(red[0], red[1]), fmaxf(red[2], red[3]));
}

typedef short bf16x8 __attribute__((ext_vector_type(8)));
typedef short s16x4 __attribute__((ext_vector_type(4)));
typedef float f32x4 __attribute__((ext_vector_type(4)));
typedef float f32x16 __attribute__((ext_vector_type(16)));
typedef unsigned u32x2 __attribute__((ext_vector_type(2)));
typedef unsigned u32x4 __attribute__((ext_vector_type(4)));
extern __shared__ __attribute__((aligned(1024))) char smem[];
constexpr int NTHR = 512;
constexpr int GEMM_LDS = 131072;

__device__ __forceinline__ unsigned cvtpk(float lo, float hi) { unsigned r; asm volatile("v_cvt_pk_bf16_f32 %0, %1, %2" : "=v"(r) : "v"(lo), "v"(hi)); return r; }
__device__ __forceinline__ bf16_t f2bf(float v) { return (bf16_t)(cvtpk(v, v) & 0xffffu); }
__device__ __forceinline__ float bf2f(bf16_t v) { return __uint_as_float(((unsigned)v) << 16); }

constexpr size_t MiB = 1048576;
struct MK {
    const float *x, *c, *ctx, *cctx, *ada_w, *ada_b, *norm1_g, *w_in, *lq1, *lk1, *lq2, *lk2, *dattn_g, *dec_f, *dec_b, *ret_g, *w_out, *norm2_g, *router_w, *router_b,
        *ew1, *ew3, *ew2, *sw1, *sw3, *sw2, *final_g;
    float* out; char* ws;
    float* dbgP; long dbg_lo, dbg_hi; long conv_limit;
#define WSF(name, type, off) __device__ __forceinline__ type* name() const { return (type*)(ws + (off)); }
    WSF(mod, float, 0) WSF(cnt, int, 131072) WSF(ropec, float, 262144) WSF(ropes, float, 262144 + 8192)
    WSF(w_inT, bf16_t, 1 * MiB) WSF(w_outT, bf16_t, 7 * MiB) WSF(routerT, bf16_t, 9 * MiB) WSF(W2t, bf16_t, 9 * MiB + 524288)
    WSF(H, bf16_t, 42 * MiB) WSF(MIX, bf16_t, 42 * MiB) WSF(KV, bf16_t, 112 * MiB) WSF(ST, bf16_t, 147 * MiB) WSF(ACT, bf16_t, 42 * MiB)
    WSF(W13t, bf16_t, 194 * MiB) WSF(H2, bf16_t, 260 * MiB)
    WSF(Q, bf16_t, 260 * MiB) WSF(K, bf16_t, 292 * MiB) WSF(V, bf16_t, 325 * MiB) WSF(RQ, bf16_t, 358 * MiB) WSF(RK, bf16_t, 375 * MiB)
    WSF(KTf, bf16_t, 392 * MiB) WSF(KTb, bf16_t, 409 * MiB) WSF(VT, bf16_t, 426 * MiB) WSF(RG, bf16_t, 459 * MiB)
    WSF(Y, unsigned char, 194 * MiB) WSF(tok_list, int, 484 * MiB) WSF(wt_list, float, 492 * MiB) WSF(tokmap, int, 500 * MiB)
    __device__ __forceinline__ float* SSQ() const { return (float*)(ws + 186 * MiB); }
    __device__ __forceinline__ bf16_t* X1() const { return (bf16_t*)out; }
#undef WSF
};

__device__ __forceinline__ void ph_mod(const MK& p, int bid, int nb, int tid_l) {
    float* sl = (float*)smem;
    float* red = (float*)(smem + 32768);
    const int col = tid_l & 31, kg = tid_l >> 5;
    float w[64];
    if (bid < 6 * D / 32) {
        const float* wp = p.ada_w + (size_t)(kg * 64) * 6 * D + bid * 32 + col;
#pragma unroll
        for (int kk = 0; kk < 64; ++kk) w[kk] = __builtin_nontemporal_load(wp + (size_t)kk * 6 * D);
        for (int i = tid_l; i < 5 * D; i += NTHR) { const int r = i >> 10, k = i & 1023; const float cv = r < 4 ? p.c[r * D + k] : p.cctx[k]; sl[k * 8 + r] = siluf(cv); }
    }
    __syncthreads();
    for (int it = bid; it < 6 * D / 32; it += nb) {
        const int j = it * 32 + col;
        if (it != bid) {
            const float* wp = p.ada_w + (size_t)(kg * 64) * 6 * D + j;
#pragma unroll
            for (int kk = 0; kk < 64; ++kk) w[kk] = __builtin_nontemporal_load(wp + (size_t)kk * 6 * D);
        }
        float a[5] = {0, 0, 0, 0, 0};
#pragma unroll
        for (int kk = 0; kk < 64; ++kk) {
            const float4 s4 = *(const float4*)(sl + (kg * 64 + kk) * 8); const float s5 = sl[(kg * 64 + kk) * 8 + 4];
            a[0] += s4.x * w[kk]; a[1] += s4.y * w[kk]; a[2] += s4.z * w[kk]; a[3] += s4.w * w[kk]; a[4] += s5 * w[kk];
        }
        __syncthreads();
#pragma unroll
        for (int r = 0; r < 5; ++r) red[(kg * 5 + r) * 32 + col] = a[r];
        __syncthreads();
        if (tid_l < 160) {
            int r = tid_l >> 5; float s = 0;
            for (int g = 0; g < 16; ++g) s += red[(g * 5 + r) * 32 + col];
            p.mod()[(size_t)r * 6 * D + j] = s + p.ada_b[j];
        }
    }
    if (bid == nb - 1) {
        for (int i = tid_l; i < 128 * 16; i += NTHR) {
            int pos = i >> 4, f = i & 15;
            float inv_freq = exp2f(-(float)f * (13.287712379549449f / 16.0f));
            float s, c; sincosf((float)pos * inv_freq, &s, &c);
            p.ropec()[i] = c; p.ropes()[i] = s;
        }
    }
    __syncthreads();
}

__device__ __forceinline__ void tr_tile(const float* src, int ldsrc, int k0, int n0, bf16_t* dst, int lddst, int mode  , bf16_t* dst2, int tid_l) {
    float* t = (float*)smem;
    __syncthreads();
    for (int i = tid_l; i < 64 * 16; i += NTHR) {
        int r = i >> 4, c4 = (i & 15) * 4;
        float4 v = *(const float4*)(src + (size_t)(k0 + r) * ldsrc + n0 + c4);
        t[r * 65 + c4] = v.x; t[r * 65 + c4 + 1] = v.y; t[r * 65 + c4 + 2] = v.z; t[r * 65 + c4 + 3] = v.w;
    }
    __syncthreads();
    for (int i = tid_l; i < 64 * 16; i += NTHR) {
        int n = i >> 4, k4 = (i & 15) * 4;
        float a = t[(k4 + 0) * 65 + n], b = t[(k4 + 1) * 65 + n], c = t[(k4 + 2) * 65 + n], d = t[(k4 + 3) * 65 + n];
        int nn = n0 + n, row = nn;
        if (mode == 1 || mode == 2) { int ct = nn >> 7; row = ct * 256 + (mode == 2 ? 128 : 0) + (nn & 127); }
        u32x2 w; w.x = cvtpk(a, b); w.y = cvtpk(c, d);
        *(u32x2*)(dst + (size_t)row * lddst + k0 + k4) = w;
        if (mode == 3) {
            float ah = bf2f((bf16_t)(w.x & 0xffff)), bh = bf2f((bf16_t)(w.x >> 16)), ch = bf2f((bf16_t)(w.y & 0xffff)), dh = bf2f((bf16_t)(w.y >> 16));
            u32x2 l; l.x = cvtpk(a - ah, b - bh); l.y = cvtpk(c - ch, d - dh);
            *(u32x2*)(dst2 + (size_t)row * lddst + k0 + k4) = l;
        }
    }
}
constexpr int CV_STATIC = 16 * 48 + 16 * 16 + 16, CV_E13 = 65 * 2 * 16 * 4, CV_E2 = 65 * 4 * 16, CV_TOTAL = CV_STATIC + CV_E13 + CV_E2;
__device__ __forceinline__ void convert_tile(const MK& p, int j, int tid_l) {
    const int n_win = 16 * 48, n_wout = 16 * 16, n_rt = 16;
    if (j < n_win) { tr_tile(p.w_in, 3072, (j / 48) * 64, (j % 48) * 64, p.w_inT(), 1024, 0, nullptr, tid_l); return; } j -= n_win;
    if (j < n_wout) { tr_tile(p.w_out, 1024, (j / 16) * 64, (j % 16) * 64, p.w_outT(), 1024, 0, nullptr, tid_l); return; } j -= n_wout;
    if (j < n_rt) { tr_tile(p.router_w, 64, j * 64, 0, p.routerT(), 1024, 3, p.routerT() + 64 * 1024, tid_l); return; } j -= n_rt;
    if (j < CV_E13) {
        int e = j / 128, r = j % 128, which = r / 64, tt = r % 64;
        const float* src = e < 64 ? (which ? p.ew3 : p.ew1) + (size_t)e * D * DE : (which ? p.sw3 : p.sw1);
        tr_tile(src, DE, (tt / 4) * 64, (tt % 4) * 64, p.W13t() + (size_t)e * 512 * 1024, 1024, 1 + which, nullptr, tid_l); return; } j -= CV_E13;
    { int e = j / 64, tt = j % 64;
      const float* src = e < 64 ? p.ew2 + (size_t)e * DE * D : p.sw2;
      tr_tile(src, D, (tt / 16) * 64, (tt % 16) * 64, p.W2t() + (size_t)e * 1024 * 256, 256, 0, nullptr, tid_l); }
}
template <int LDSRC> __device__ __forceinline__ void tr_wave(const float* __restrict__ src, int k0, int n0, bf16_t* __restrict__ dst, int lddst, int mode, int lane, char* tb) {
    const int n4 = lane & 15, kg = lane >> 4;
    const float* s0 = src + (size_t)(k0 + kg * 16) * LDSRC + n0 + n4 * 4;
    f32x4 v[16];
#pragma unroll
    for (int it = 0; it < 16; ++it) v[it] = __builtin_nontemporal_load((const f32x4*)(s0 + (size_t)it * LDSRC));
#pragma unroll
    for (int jn = 0; jn < 4; ++jn) {
        const int n = n4 * 4 + jn;
#pragma unroll
        for (int h = 0; h < 2; ++h) {
            const u32x4 w = {cvtpk(v[h * 8][jn], v[h * 8 + 1][jn]), cvtpk(v[h * 8 + 2][jn], v[h * 8 + 3][jn]), cvtpk(v[h * 8 + 4][jn], v[h * 8 + 5][jn]), cvtpk(v[h * 8 + 6][jn], v[h * 8 + 7][jn])};
            *(u32x4*)(tb + n * 128 + (((kg * 2 + h) ^ (n4 & 7)) << 4)) = w;
        }
    }
    asm volatile("s_waitcnt lgkmcnt(0)" ::: "memory");
#pragma unroll
    for (int it = 0; it < 8; ++it) {
        const int n = it * 8 + (lane >> 3), c = lane & 7;
        const u32x4 w = *(const u32x4*)(tb + n * 128 + ((c ^ ((n >> 2) & 7)) << 4));
        const int nn = n0 + n; int row = nn;
        if (mode == 1 || mode == 2) { const int ct = nn >> 7; row = ct * 256 + (mode == 2 ? 128 : 0) + (nn & 127); }
        *(u32x4*)(dst + (size_t)row * lddst + k0 + c * 8) = w;
    }
}
__device__ __forceinline__ void convert_tile_wave(const MK& p, int j, int lane, char* tb) {
    if (j < CV_E13) {
        const int e = j / 128, r = j % 128, which = r / 64, tt = r % 64;
        const float* src = e < 64 ? (which ? p.ew3 : p.ew1) + (size_t)e * D * DE : (which ? p.sw3 : p.sw1);
        tr_wave<DE>(src, (tt / 4) * 64, (tt % 4) * 64, p.W13t() + (size_t)e * 512 * 1024, 1024, 1 + which, lane, tb); return; }
    j -= CV_E13;
    { const int e = j / 64, tt = j % 64;
      const float* src = e < 64 ? p.ew2 + (size_t)e * DE * D : p.sw2;
      tr_wave<D>(src, (tt / 16) * 64, (tt % 16) * 64, p.W2t() + (size_t)e * 1024 * 256, 256, 0, lane, tb); }
}
__device__ __forceinline__ void ph_convert(const MK& p, int bid, int nb, int tid_l) {
    const int vbw = (bid + (nb >> 1)) % nb, vbr = (bid + 16 + nb - (nb >> 1)) % nb;
    for (int it = 16 * 48 + 16 * 16 + vbr; it < CV_STATIC; it += nb) convert_tile(p, it, tid_l);
    __syncthreads();
    const int lane = tid_l & 63, wq = __builtin_amdgcn_readfirstlane(tid_l >> 6); char* tb = smem + wq * 8192;
#pragma unroll 1
    for (int j = vbw * 8 + wq; j < 16 * 48 + 16 * 16; j += nb * 8) {
        if (j < 16 * 48) tr_wave<3072>(p.w_in, (j / 48) * 64, (j % 48) * 64, p.w_inT(), 1024, 0, lane, tb);
        else { const int j2 = j - 16 * 48; tr_wave<1024>(p.w_out, (j2 / 16) * 64, (j2 % 16) * 64, p.w_outT(), 1024, 0, lane, tb); }
    }
    __syncthreads();
}
__device__ __forceinline__ void ph_convert_dyn(const MK& p, int tid_l) {
    const int lane = tid_l & 63;
    char* tb = smem + (tid_l >> 6) * 8192;
    __syncthreads();
    for (;;) {
        int j = 0;
        if (lane == 0) j = atomicAdd(&p.cnt()[200], 8);
        j = __builtin_amdgcn_readfirstlane(j);
        if (j >= CV_E13) break;
#pragma unroll 1
        for (int k = 0; k < 8; ++k) if (j + k < CV_E13) convert_tile_wave(p, j + k, lane, tb);
    }
}

__device__ __forceinline__ void ph_ln1(const MK& p, int bid, int nb, int tid_l) {
    const int wid = tid_l >> 6, lane = tid_l & 63;
    for (int R = (bid * 8 + wid) * 2; R < NR; R += nb * 16) {
        int b = R / RB, i = R % RB;
        const float* src = i < CTX ? p.ctx + ((size_t)b * CTX + i) * D : p.x + ((size_t)b * SEQ + (i - CTX)) * D;
        const float* m = p.mod() + (size_t)(i < CTX ? 4 : b) * 6 * D;
        f32x4 v[2][4]; float ss0 = 0, ss1 = 0;
#pragma unroll
        for (int r = 0; r < 2; ++r)
#pragma unroll
            for (int q = 0; q < 4; ++q) v[r][q] = __builtin_nontemporal_load((const f32x4*)(src + r * D + q * 256 + lane * 4));
#pragma unroll
        for (int q = 0; q < 4; ++q) {
            ss0 += v[0][q][0] * v[0][q][0] + v[0][q][1] * v[0][q][1] + v[0][q][2] * v[0][q][2] + v[0][q][3] * v[0][q][3];
            ss1 += v[1][q][0] * v[1][q][0] + v[1][q][1] * v[1][q][1] + v[1][q][2] * v[1][q][2] + v[1][q][3] * v[1][q][3];
        }
        ss0 = wave_sum(ss0); ss1 = wave_sum(ss1);
        const float rstd0 = rsqrtf(ss0 * (1.0f / D) + EPS), rstd1 = rsqrtf(ss1 * (1.0f / D) + EPS);
#pragma unroll
        for (int q = 0; q < 4; ++q) {
            int c0 = q * 256 + lane * 4;
            float4 gg = *(const float4*)(p.norm1_g + c0), sh = *(const float4*)(m + c0), sc = *(const float4*)(m + D + c0);
#pragma unroll
            for (int r = 0; r < 2; ++r) {
                const float rstd = r ? rstd1 : rstd0;
                float o0 = v[r][q][0] * rstd * gg.x * (1 + sc.x) + sh.x, o1 = v[r][q][1] * rstd * gg.y * (1 + sc.y) + sh.y;
                float o2 = v[r][q][2] * rstd * gg.z * (1 + sc.z) + sh.z, o3 = v[r][q][3] * rstd * gg.w * (1 + sc.w) + sh.w;
                u32x2 w; w.x = cvtpk(o0, o1); w.y = cvtpk(o2, o3);
                *(u32x2*)(p.H() + (size_t)(R + r) * D + c0) = w;
            }
        }
    }
}

__device__ __forceinline__ int lds_byte(int r, int c) { int st = (r >> 4) * 2 + (c >> 5), ob = (r & 15) * 64 + (c & 31) * 2; return st * 1024 + (ob ^ (((ob >> 9) & 1) << 5)); }
__device__ __forceinline__ void stage_rc(int b, int& R, int& C) { int st = b >> 10, sb = b & 1023, swz = sb ^ (((sb >> 9) & 1) << 5); R = (st / 2) * 16 + swz / 64; C = (st % 2) * 32 + (swz % 64) / 2; }
#define WAIT_V0() asm volatile("s_waitcnt vmcnt(0)" ::: "memory")
__device__ __forceinline__ void gemm_core(const char* Abase, const unsigned (&Ao)[4], const char* Bbase, const unsigned (&Bo)[4], int nt, f32x4 (&acc)[8][4], int tid_l, bool pre) {
    const int tid = tid_l, wid = tid >> 6, lane = tid & 63, wr = wid >> 2, wc = wid & 3, fr = lane & 15, fq = lane >> 4;
#pragma unroll
    for (int m = 0; m < 8; ++m)
#pragma unroll
        for (int n = 0; n < 4; ++n) acc[m][n] = (f32x4){0.f, 0.f, 0.f, 0.f};
#define G_SA(b) (smem + (b) * 32768)
#define G_SB(b) (smem + 65536 + (b) * 32768)
#define G_STAGE(buf, kt) do { _Pragma("unroll") for (int i = 0; i < 4; ++i) {                                                     \
        __builtin_amdgcn_global_load_lds((const unsigned*)(Abase + (Ao[i] + (unsigned)(kt) * 128u)), (unsigned*)(G_SA(buf) + wid * 1024 + i * 8192), 16, 0, 0); \
        __builtin_amdgcn_global_load_lds((const unsigned*)(Bbase + (Bo[i] + (unsigned)(kt) * 128u)), (unsigned*)(G_SB(buf) + wid * 1024 + i * 8192), 16, 0, 0); } } while (0)
    if (!pre) G_STAGE(0, 0);
    WAIT_V0(); __syncthreads();
#define G_KSTEP(cur, t) do {                                                                                                   \
        if ((t) + 1 < nt) G_STAGE((cur) ^ 1, (t) + 1);                                                                          \
        _Pragma("unroll") for (int ks = 0; ks < 2; ++ks) {                                                                      \
            bf16x8 At[8], Bf[4];                                                                                                \
            _Pragma("unroll") for (int m = 0; m < 8; ++m) At[m] = *(const bf16x8*)(G_SA(cur) + lds_byte(wr * 128 + m * 16 + fr, ks * 32 + fq * 8)); \
            _Pragma("unroll") for (int n = 0; n < 4; ++n) Bf[n] = *(const bf16x8*)(G_SB(cur) + lds_byte(wc * 64 + n * 16 + fr, ks * 32 + fq * 8));  \
            _Pragma("unroll") for (int m = 0; m < 8; ++m) _Pragma("unroll") for (int n = 0; n < 4; ++n)                         \
                acc[m][n] = __builtin_amdgcn_mfma_f32_16x16x32_bf16(Bf[n], At[m], acc[m][n], 0, 0, 0);                          \
            __builtin_amdgcn_sched_barrier(0);                                                                                  \
        }                                                                                                                       \
        WAIT_V0(); __syncthreads(); } while (0)
#pragma unroll 1
    for (int t = 0; t < nt; ++t) { const int cur = t & 1; G_KSTEP(cur, t); }
}
#ifndef XPREFETCH
#define XPREFETCH 0
#endif
__device__ __forceinline__ void gemm_prefetch(const char* Abase, const unsigned (&Ao)[4], const char* Bbase, const unsigned (&Bo)[4], int tid_l) {
    const int wid = tid_l >> 6;
    G_STAGE(0, 0);
}
__device__ __forceinline__ void stage_offs(unsigned ld_bytes, unsigned (&P)[4], int tid_l) {
    const int wid = tid_l >> 6, lane = tid_l & 63;
#pragma unroll
    for (int i = 0; i < 4; ++i) { int R, C; stage_rc(wid * 1024 + i * 8192 + lane * 16, R, C); P[i] = (unsigned)R * ld_bytes + (unsigned)C * 2u; }
}

constexpr int WAREA = 18432;
__device__ __forceinline__ char* wave_area(int wid) { return smem + wid * WAREA; }

constexpr int A_KVBLK = 64;
constexpr float A_SCALE = 0.125f, A_THR = 8.f;
constexpr int A_SHM_V = A_KVBLK * 128 * 2, A_SHM_K = A_KVBLK * 128 * 2;
#define KSWZ(row, colB) ((row) * 256 + ((colB) ^ (((row) & 7) << 4)))
#define SBAR() __builtin_amdgcn_sched_barrier(0)
__device__ __forceinline__ int crow(int r, int hi) { return (r & 3) + 8 * (r >> 2) + 4 * hi; }

constexpr float A_THRL = 11.0f;
template <bool FIRST, bool FAST = false> __device__ __forceinline__ void partialSM2(f32x16& p0, f32x16& p1, float& mhat, f32x16& negm, float& alpha) {
    if (FAST && !FIRST) {
        alpha = 1.f;
#pragma unroll
        for (int r = 0; r < 16; ++r) p0[r] = __builtin_amdgcn_exp2f(p0[r]);
        return;
    }
    float pmax = p0[0];
#pragma unroll
    for (int r = 1; r < 16; ++r) pmax = fmaxf(pmax, p0[r]);
#pragma unroll
    for (int r = 0; r < 16; ++r) pmax = fmaxf(pmax, p1[r]);
    { auto rr = __builtin_amdgcn_permlane32_swap(__float_as_uint(pmax), __float_as_uint(pmax), false, false);
      pmax = fmaxf(__uint_as_float(rr[0]), __uint_as_float(rr[1])); }
    alpha = 1.f;
    if (FIRST || __builtin_expect(__any(pmax > A_THRL), 0)) {
        const float dl = FIRST ? pmax : fmaxf(pmax, 0.f);
        mhat += dl;
#pragma unroll
        for (int r = 0; r < 16; ++r) { p0[r] -= dl; p1[r] -= dl; }
#pragma unroll
        for (int r = 0; r < 16; ++r) negm[r] = -mhat;
        if (!FIRST) alpha = __builtin_amdgcn_exp2f(-dl);
    }
#pragma unroll
    for (int r = 0; r < 16; ++r) p0[r] = __builtin_amdgcn_exp2f(p0[r]);
}
__device__ __forceinline__ void qkt2(f32x16& p0, f32x16& p1, const char* Ks, const bf16x8* qr, const f32x16& negm, int r32, int hi, int mapc) {
#pragma unroll
    for (int d0 = 0; d0 < 4; ++d0) { int cb = (mapc + d0 * 16 + hi * 8) * 2;
        bf16x8 b0 = *reinterpret_cast<const bf16x8*>(Ks + KSWZ(r32, cb));
        bf16x8 b1 = *reinterpret_cast<const bf16x8*>(Ks + KSWZ(32 + r32, cb));
        if (d0 == 0) { p0 = __builtin_amdgcn_mfma_f32_32x32x16_bf16(b0, qr[0], negm, 0, 0, 0); p1 = __builtin_amdgcn_mfma_f32_32x32x16_bf16(b1, qr[0], negm, 0, 0, 0); }
        else { p0 = __builtin_amdgcn_mfma_f32_32x32x16_bf16(b0, qr[d0], p0, 0, 0, 0); p1 = __builtin_amdgcn_mfma_f32_32x32x16_bf16(b1, qr[d0], p1, 0, 0, 0); } }
}
template <int PROBE = 0> __device__ __forceinline__ void partialSM(f32x16& p0, f32x16& p1, float& m_reg, float& mn, float& alpha) {
    constexpr float C = A_SCALE * 1.4426950408889634f;
    float pmax = p0[0];
#pragma unroll
    for (int r = 1; r < 16; ++r) pmax = fmaxf(pmax, p0[r]);
#pragma unroll
    for (int r = 0; r < 16; ++r) pmax = fmaxf(pmax, p1[r]);
    { auto rr = __builtin_amdgcn_permlane32_swap(__float_as_uint(pmax), __float_as_uint(pmax), false, false);
      pmax = fmaxf(__uint_as_float(rr[0]), __uint_as_float(rr[1])); }
    if (__builtin_expect(__all(pmax - m_reg <= A_THR / A_SCALE), 1)) { mn = m_reg; alpha = 1.f; }
    else { mn = fmaxf(m_reg, pmax); alpha = __builtin_amdgcn_exp2f((m_reg - mn) * C); m_reg = mn; }
    float mnC = -mn * C;
#pragma unroll
    for (int r = 0; r < 16; ++r) p0[r] = fmaf(p0[r], C, mnC);
#pragma unroll
    for (int r = 0; r < 16; ++r) p1[r] = fmaf(p1[r], C, mnC);
#pragma unroll
    for (int r = 0; r < 16; ++r) p0[r] = PROBE == 3 ? p0[r] * 1e-3f : __builtin_amdgcn_exp2f(p0[r]);
}
#define PK4(P, BASE, OUT) do { unsigned a0 = cvtpk(P[BASE + 0], P[BASE + 1]), a1 = cvtpk(P[BASE + 2], P[BASE + 3]);   \
    unsigned b0 = cvtpk(P[BASE + 4], P[BASE + 5]), b1 = cvtpk(P[BASE + 6], P[BASE + 7]);                              \
    auto r0 = __builtin_amdgcn_permlane32_swap(a0, b0, false, false); auto r1 = __builtin_amdgcn_permlane32_swap(a1, b1, false, false); \
    u32x4 w = {r0[0], r1[0], r0[1], r1[1]}; OUT = *reinterpret_cast<bf16x8*>(&w); } while (0)
template <int PROBE = 0, bool DIRECT = false, bool FAST = false> __device__ __forceinline__ void finishSM(f32x16& p0, f32x16& p1, float alpha, float& l_reg, bf16x8& pa0, bf16x8& pa1, bf16x8& pa2, bf16x8& pa3, float& bad) {
#pragma unroll
    for (int r = 0; r < 16; ++r) p1[r] = PROBE == 3 ? p1[r] * 1e-3f : __builtin_amdgcn_exp2f(p1[r]);
    if (!FAST) {
        float ps = 0;
#pragma unroll
        for (int r = 0; r < 16; ++r) ps += p0[r];
#pragma unroll
        for (int r = 0; r < 16; ++r) ps += p1[r];
        { auto rr = __builtin_amdgcn_permlane32_swap(__float_as_uint(ps), __float_as_uint(ps), false, false);
          ps = __uint_as_float(rr[0]) + __uint_as_float(rr[1]); }
        l_reg = l_reg * alpha + ps;
    }
    if (DIRECT) {
#define PKD(P, B, OUT) do { u32x4 w = {cvtpk(P[B], P[B + 1]), cvtpk(P[B + 2], P[B + 3]), cvtpk(P[B + 4], P[B + 5]), cvtpk(P[B + 6], P[B + 7])}; OUT = *reinterpret_cast<bf16x8*>(&w); } while (0)
        PKD(p0, 0, pa0); PKD(p0, 8, pa1); PKD(p1, 0, pa2); PKD(p1, 8, pa3);
#undef PKD
    } else { PK4(p0, 0, pa0); PK4(p0, 8, pa1); PK4(p1, 0, pa2); PK4(p1, 8, pa3); }
}
__device__ __forceinline__ void qkt(f32x16& p0, f32x16& p1, const char* Ks, const bf16x8* qr, int r32, int hi, int mapc) {
    p0 = f32x16{}; p1 = f32x16{};
#pragma unroll
    for (int d0 = 0; d0 < 4; ++d0) { int cb = (mapc + d0 * 16 + hi * 8) * 2;
        bf16x8 b0 = *reinterpret_cast<const bf16x8*>(Ks + KSWZ(r32, cb));
        bf16x8 b1 = *reinterpret_cast<const bf16x8*>(Ks + KSWZ(32 + r32, cb));
        p0 = __builtin_amdgcn_mfma_f32_32x32x16_bf16(b0, qr[d0], p0, 0, 0, 0);
        p1 = __builtin_amdgcn_mfma_f32_32x32x16_bf16(b1, qr[d0], p1, 0, 0, 0); }
}
__device__ __forceinline__ int v_st(int k, int c) { const int kk = (k & ~0xC) | ((k & 4) << 1) | ((k & 8) >> 1); return ((kk >> 3) * 4 + (c >> 5)) * 512 + ((kk & 7) * 32 + (c & 31)) * 2; }
__device__ __forceinline__ int v_rd_base(int lane) { return ((lane & 3) << 3) | (((lane >> 2) & 3) << 6) | (((lane >> 4) & 1) << 5) | (((lane >> 5) & 1) << 8); }
constexpr int v_rd_off(int d0, int ks, int half) { return d0 * 512 + ks * 4096 + half * 2048; }
template <int OFF> __device__ __forceinline__ s16x4 tr_read(int vb) {
    s16x4 r; asm volatile("ds_read_b64_tr_b16 %0, %1 offset:%2" : "=&v"(r) : "v"(vb), "i"(OFF) : "memory"); return r;
}
template <int D0> __device__ __forceinline__ void pv_one(f32x16& od, int vb, bf16x8 pa0, bf16x8 pa1, bf16x8 pa2, bf16x8 pa3) {
    const s16x4 l0 = tr_read<v_rd_off(D0, 0, 0)>(vb), h0 = tr_read<v_rd_off(D0, 0, 1)>(vb), l1 = tr_read<v_rd_off(D0, 1, 0)>(vb), h1 = tr_read<v_rd_off(D0, 1, 1)>(vb);
    const s16x4 l2 = tr_read<v_rd_off(D0, 2, 0)>(vb), h2 = tr_read<v_rd_off(D0, 2, 1)>(vb), l3 = tr_read<v_rd_off(D0, 3, 0)>(vb), h3 = tr_read<v_rd_off(D0, 3, 1)>(vb);
    asm volatile("s_waitcnt lgkmcnt(0)" ::: "memory"); SBAR();
#define PKV(L, H) (bf16x8){L[0], L[1], L[2], L[3], H[0], H[1], H[2], H[3]}
    od = __builtin_amdgcn_mfma_f32_32x32x16_bf16(pa0, PKV(l0, h0), od, 0, 0, 0);
    od = __builtin_amdgcn_mfma_f32_32x32x16_bf16(pa1, PKV(l1, h1), od, 0, 0, 0);
    od = __builtin_amdgcn_mfma_f32_32x32x16_bf16(pa2, PKV(l2, h2), od, 0, 0, 0);
    od = __builtin_amdgcn_mfma_f32_32x32x16_bf16(pa3, PKV(l3, h3), od, 0, 0, 0);
}
template <int D0> __device__ __forceinline__ void pv_two(f32x16& oa, f32x16& ob, int vb, bf16x8 pa0, bf16x8 pa1, bf16x8 pa2, bf16x8 pa3) {
    const s16x4 l0 = tr_read<v_rd_off(D0, 0, 0)>(vb), h0 = tr_read<v_rd_off(D0, 0, 1)>(vb), l1 = tr_read<v_rd_off(D0, 1, 0)>(vb), h1 = tr_read<v_rd_off(D0, 1, 1)>(vb);
    const s16x4 l2 = tr_read<v_rd_off(D0, 2, 0)>(vb), h2 = tr_read<v_rd_off(D0, 2, 1)>(vb), l3 = tr_read<v_rd_off(D0, 3, 0)>(vb), h3 = tr_read<v_rd_off(D0, 3, 1)>(vb);
    const s16x4 m0 = tr_read<v_rd_off(D0 + 1, 0, 0)>(vb), g0 = tr_read<v_rd_off(D0 + 1, 0, 1)>(vb), m1 = tr_read<v_rd_off(D0 + 1, 1, 0)>(vb), g1 = tr_read<v_rd_off(D0 + 1, 1, 1)>(vb);
    const s16x4 m2 = tr_read<v_rd_off(D0 + 1, 2, 0)>(vb), g2 = tr_read<v_rd_off(D0 + 1, 2, 1)>(vb), m3 = tr_read<v_rd_off(D0 + 1, 3, 0)>(vb), g3 = tr_read<v_rd_off(D0 + 1, 3, 1)>(vb);
    asm volatile("s_waitcnt lgkmcnt(0)" ::: "memory"); SBAR();
    oa = __builtin_amdgcn_mfma_f32_32x32x16_bf16(pa0, PKV(l0, h0), oa, 0, 0, 0);
    ob = __builtin_amdgcn_mfma_f32_32x32x16_bf16(pa0, PKV(m0, g0), ob, 0, 0, 0);
    oa = __builtin_amdgcn_mfma_f32_32x32x16_bf16(pa1, PKV(l1, h1), oa, 0, 0, 0);
    ob = __builtin_amdgcn_mfma_f32_32x32x16_bf16(pa1, PKV(m1, g1), ob, 0, 0, 0);
    oa = __builtin_amdgcn_mfma_f32_32x32x16_bf16(pa2, PKV(l2, h2), oa, 0, 0, 0);
    ob = __builtin_amdgcn_mfma_f32_32x32x16_bf16(pa2, PKV(m2, g2), ob, 0, 0, 0);
    oa = __builtin_amdgcn_mfma_f32_32x32x16_bf16(pa3, PKV(l3, h3), oa, 0, 0, 0);
    ob = __builtin_amdgcn_mfma_f32_32x32x16_bf16(pa3, PKV(m3, g3), ob, 0, 0, 0);
}
__device__ __forceinline__ void pv_d0(f32x16* o, int vb, bf16x8 pa0, bf16x8 pa1, bf16x8 pa2, bf16x8 pa3) {
    pv_one<0>(o[0], vb, pa0, pa1, pa2, pa3); pv_one<1>(o[1], vb, pa0, pa1, pa2, pa3); pv_one<2>(o[2], vb, pa0, pa1, pa2, pa3); pv_one<3>(o[3], vb, pa0, pa1, pa2, pa3);
}
#define PVR8(D0, L0, H0, L1, H1, L2, H2, L3, H3) do { L0 = tr_read<v_rd_off(D0, 0, 0)>(vb); H0 = tr_read<v_rd_off(D0, 0, 1)>(vb); L1 = tr_read<v_rd_off(D0, 1, 0)>(vb); H1 = tr_read<v_rd_off(D0, 1, 1)>(vb); \
    L2 = tr_read<v_rd_off(D0, 2, 0)>(vb); H2 = tr_read<v_rd_off(D0, 2, 1)>(vb); L3 = tr_read<v_rd_off(D0, 3, 0)>(vb); H3 = tr_read<v_rd_off(D0, 3, 1)>(vb); } while (0)
#define PVM4(OD, L0, H0, L1, H1, L2, H2, L3, H3) do { OD = __builtin_amdgcn_mfma_f32_32x32x16_bf16(pa0, PKV(L0, H0), OD, 0, 0, 0); OD = __builtin_amdgcn_mfma_f32_32x32x16_bf16(pa1, PKV(L1, H1), OD, 0, 0, 0); \
    OD = __builtin_amdgcn_mfma_f32_32x32x16_bf16(pa2, PKV(L2, H2), OD, 0, 0, 0); OD = __builtin_amdgcn_mfma_f32_32x32x16_bf16(pa3, PKV(L3, H3), OD, 0, 0, 0); } while (0)
#define PVX4(B) do { x0[B] = __builtin_amdgcn_exp2f(x0[B]); x0[B + 1] = __builtin_amdgcn_exp2f(x0[B + 1]); x0[B + 2] = __builtin_amdgcn_exp2f(x0[B + 2]); x0[B + 3] = __builtin_amdgcn_exp2f(x0[B + 3]); } while (0)
#define PVS8(P, B) do { ps += P[B]; ps += P[B + 1]; ps += P[B + 2]; ps += P[B + 3]; ps += P[B + 4]; ps += P[B + 5]; ps += P[B + 6]; ps += P[B + 7]; } while (0)
template <bool EXPS> __device__ __forceinline__ void pv_fast(f32x16* o, int vb, bf16x8 pa0, bf16x8 pa1, bf16x8 pa2, bf16x8 pa3, f32x16& x0, const f32x16& y0, const f32x16& y1, float& l_reg, float& bad) {
    float ps = 0.f;
    s16x4 a0, a1, a2, a3, a4, a5, a6, a7, b0, b1, b2, b3, b4, b5, b6, b7;
    PVR8(0, a0, a1, a2, a3, a4, a5, a6, a7);
    PVR8(1, b0, b1, b2, b3, b4, b5, b6, b7);
    asm volatile("s_waitcnt lgkmcnt(8)" ::: "memory"); SBAR();
    PVM4(o[0], a0, a1, a2, a3, a4, a5, a6, a7); if (EXPS) PVX4(0); PVS8(y0, 0); SBAR();
    PVR8(2, a0, a1, a2, a3, a4, a5, a6, a7);
    asm volatile("s_waitcnt lgkmcnt(8)" ::: "memory"); SBAR();
    PVM4(o[1], b0, b1, b2, b3, b4, b5, b6, b7); if (EXPS) PVX4(4); PVS8(y0, 8); SBAR();
    PVR8(3, b0, b1, b2, b3, b4, b5, b6, b7);
    asm volatile("s_waitcnt lgkmcnt(8)" ::: "memory"); SBAR();
    PVM4(o[2], a0, a1, a2, a3, a4, a5, a6, a7); if (EXPS) PVX4(8); PVS8(y1, 0); SBAR();
    asm volatile("s_waitcnt lgkmcnt(0)" ::: "memory"); SBAR();
    PVM4(o[3], b0, b1, b2, b3, b4, b5, b6, b7); if (EXPS) PVX4(12); PVS8(y1, 8);
    { auto rr = __builtin_amdgcn_permlane32_swap(__float_as_uint(ps), __float_as_uint(ps), false, false); ps = __uint_as_float(rr[0]) + __uint_as_float(rr[1]); }
    l_reg += ps; bad = fmaxf(bad, ps);
}

template <int PROBE, bool FAST> __device__ __forceinline__ int attn_item(const bf16_t* __restrict__ Qb, const bf16_t* __restrict__ Kh, const bf16_t* __restrict__ Vh, bf16_t* __restrict__ mixrow,
                                          const float* __restrict__ gd, float lam, int tid_l) {
    char* lds = smem;
    const int tid = tid_l, wid = tid >> 6, lane = tid & 63, r32 = lane & 31, hi = lane >> 5;
    const int map = wid >> 2, wq = wid & 3, mapc = map * 64;
    char* K_lds = lds; char* V_lds = lds + 4 * A_SHM_K;
    float* wsw = (float*)(lds + 4 * A_SHM_V + 4 * A_SHM_K) + wid * 64; float* li_l = wsw; float* al_l = wsw + 32;
    float m_reg = 0.f, l_reg = 0, bad = 0.f; f32x16 o[4] = {}; bf16x8 qr[4]; f32x16 negm = f32x16{};
    int* flagw = (int*)(lds + 4 * A_SHM_V + 4 * A_SHM_K + 2048);
    if (FAST && tid == 0) *flagw = 0;
    const bf16_t* Qw = Qb + (long)(wq * 32 + r32) * 128 + mapc + hi * 8;
#pragma unroll
    for (int d0 = 0; d0 < 4; ++d0) qr[d0] = *reinterpret_cast<const bf16x8*>(Qw + d0 * 16);
    const int vb0 = (int)(uintptr_t)V_lds + v_rd_base(lane);
    unsigned kofs[2], vofs[2];
    const int widu = __builtin_amdgcn_readfirstlane(wid);
#pragma unroll
    for (int i = 0; i < 2; ++i) {
        const int x = wid * 1024 + i * 8192 + lane * 16;
        { const int row = x >> 8, cs = x & 255, colB = cs ^ ((row & 7) << 4); kofs[i] = (unsigned)(row * 256 + colB); }
        { const int sub = x >> 9, wn = x & 511, k = (sub >> 2) * 8 + (wn >> 6), c = (sub & 3) * 32 + ((wn & 63) >> 1); vofs[i] = (unsigned)(k * 256 + c * 2); }
    }
#define DMA_TILE(slot, k0) do { const char* kt_ = (const char*)Kh + (size_t)(k0) * 256; const char* vt_ = (const char*)Vh + (size_t)(k0) * 256;                  \
      _Pragma("unroll") for (int i = 0; i < 2; ++i) {                                                                   \
        __builtin_amdgcn_global_load_lds((const unsigned*)(kt_ + kofs[i]), (unsigned*)(K_lds + (slot) * A_SHM_K + widu * 1024 + i * 8192), 16, 0, 0); \
        __builtin_amdgcn_global_load_lds((const unsigned*)(vt_ + vofs[i]), (unsigned*)(V_lds + (slot) * A_SHM_V + widu * 1024 + i * 8192), 16, 0, 0); } } while (0)
#define RESC(a) do { if (__any((a) < 1.f)) { if (hi == 0) al_l[r32] = (a); asm volatile("s_waitcnt lgkmcnt(0)" ::: "memory"); \
    _Pragma("unroll") for (int d = 0; d < 4; ++d) _Pragma("unroll") for (int r = 0; r < 16; ++r) o[d][r] *= al_l[crow(r, hi)]; } } while (0)
    f32x16 pA0, pA1, pB0, pB1; float mnA, mnB, alA, alB; bf16x8 pa0, pa1, pa2, pa3; const int NT = RB / A_KVBLK;
    DMA_TILE(0, 0); DMA_TILE(1, A_KVBLK);
    asm volatile("s_waitcnt vmcnt(0)" ::: "memory"); __syncthreads();
    if (FAST) {
        qkt(pA0, pA1, K_lds, qr, r32, hi, mapc); alA = 1.f;
#pragma unroll
        for (int r = 0; r < 16; ++r) pA0[r] = __builtin_amdgcn_exp2f(pA0[r]);
    } else { qkt2(pA0, pA1, K_lds, qr, negm, r32, hi, mapc); partialSM2<true>(pA0, pA1, m_reg, negm, alA); }
#define ATILE(X0, X1, ALX, Y0, Y1, ALY, CS, PS, NS, T_, DODMA) do {                                                                  \
        asm volatile("s_waitcnt vmcnt(0)" ::: "memory"); __syncthreads();                                                            \
        if (DODMA && PROBE != 1) DMA_TILE(NS, ((T_) + 1) * A_KVBLK);                                                                 \
        SBAR(); if (FAST) qkt(X0, X1, K_lds + (CS) * A_SHM_K, qr, r32, hi, mapc); else qkt2(X0, X1, K_lds + (CS) * A_SHM_K, qr, negm, r32, hi, mapc); \
        finishSM<PROBE, true, FAST>(Y0, Y1, ALY, l_reg, pa0, pa1, pa2, pa3, bad); SBAR();                                            \
        if (FAST) pv_fast<true>(o, vb0 + (PS) * A_SHM_V, pa0, pa1, pa2, pa3, X0, Y0, Y1, l_reg, bad);                                                  \
        else { pv_d0(o, vb0 + (PS) * A_SHM_V, pa0, pa1, pa2, pa3); partialSM2<false, false>(X0, X1, m_reg, negm, ALX); RESC(ALX); } } while (0)
#pragma unroll 1
    for (int j = 1; j + 3 < NT; j += 4) {
        ATILE(pB0, pB1, alB, pA0, pA1, alA, 1, 0, 2, j, true);
        ATILE(pA0, pA1, alA, pB0, pB1, alB, 2, 1, 3, j + 1, true);
        ATILE(pB0, pB1, alB, pA0, pA1, alA, 3, 2, 0, j + 2, true);
        ATILE(pA0, pA1, alA, pB0, pB1, alB, 0, 3, 1, j + 3, true);
    }
    ATILE(pB0, pB1, alB, pA0, pA1, alA, 1, 0, 2, NT - 3, true);
    ATILE(pA0, pA1, alA, pB0, pB1, alB, 2, 1, 3, NT - 2, true);
    ATILE(pB0, pB1, alB, pA0, pA1, alA, 3, 2, 0, NT - 1, false);
    finishSM<PROBE, true, FAST>(pB0, pB1, alB, l_reg, pa0, pa1, pa2, pa3, bad); SBAR();
    if (FAST) pv_fast<false>(o, vb0 + 3 * A_SHM_V, pa0, pa1, pa2, pa3, pA0, pB0, pB1, l_reg, bad); else pv_d0(o, vb0 + 3 * A_SHM_V, pa0, pa1, pa2, pa3);
    if (FAST) { if (__any(!(bad <= 1.15e18f) || !(l_reg < 1.8e19f) || !(l_reg > 5.4e-20f))) *flagw = 1; }
#undef ATILE
#undef DMA_TILE
    if (hi == 0) li_l[r32] = l_reg;
    asm volatile("s_waitcnt lgkmcnt(0)" ::: "memory");
    float rl[16];
#pragma unroll
    for (int r = 0; r < 16; ++r) rl[r] = __builtin_amdgcn_rcpf(li_l[crow(r, hi)]);
    __syncthreads();
    const int flag = FAST ? __builtin_amdgcn_readfirstlane(*flagw) : 0;
    {
        float* xo = (float*)lds + map * 16384 + (wq * 32) * 128 + r32;
#pragma unroll
        for (int r = 0; r < 16; ++r)
#pragma unroll
            for (int d0 = 0; d0 < 4; ++d0) xo[crow(r, hi) * 128 + d0 * 32] = o[d0][r] * rl[r];
    }
    __syncthreads();
    {
        int l2 = lane; asm volatile("" : "+v"(l2));
        const float g0 = gd[l2 * 2], g1 = gd[l2 * 2 + 1];
#pragma unroll 4
        for (int rr = 0; rr < 16; ++rr) {
            const int row = wid * 16 + rr;
            const float2 a0 = *(const float2*)((const float*)lds + row * 128 + l2 * 2), a1 = *(const float2*)((const float*)lds + 16384 + row * 128 + l2 * 2);
            const float xv = a0.x - lam * a1.x, yv = a0.y - lam * a1.y;
            const float ss = wave_sum(xv * xv + yv * yv);
            const float rs = rsqrtf(ss * (1.0f / 128) + EPS) * 0.8f;
            *(unsigned*)(mixrow + (long)row * 1024 + l2 * 2) = cvtpk(xv * rs * g0, yv * rs * g1);
        }
    }
    __syncthreads();
#undef RESC
    return flag;
}


template <int PROBE> __device__ __forceinline__ void ph_attn(const MK& p, int bid, int nb, int tid_l) {
    const int lane = tid_l & 63;
    float s1 = wave_sum(p.lq1[lane] * p.lk1[lane]), s2 = wave_sum(p.lq2[lane] * p.lk2[lane]);
    const float lam = expf(s1) - expf(s2) + 0.2f;
    const int nrounds = (1024 + nb - 1) / nb;
#define ATTN_ITEM_ARGS p.Q() + ((size_t)bh * SEQ + qb * 128) * 128, p.K() + (size_t)bh * RB * 128, p.V() + (size_t)bh * RB * 128, \
                  PROBE ? (bf16_t*)(p.ws + 492 * MiB) + h * 128 : p.MIX() + ((size_t)(b * SEQ + qb * 128)) * 1024 + h * 128, p.dattn_g, lam
    unsigned redo = 0u;
    for (int rr = 0; rr < nrounds; ++rr) {
        int item;
        if (nb == 256) { int x = bid & 7, j = bid >> 3, hh = rr * 8 + x; item = (hh >> 1) * 64 + (hh & 1) * 32 + j; }
        else { item = rr * nb + bid; if (item >= 1024) break; }
        const int bh = item >> 6, qb = item & 63, b = bh >> 2, h = bh & 3;
        if (nrounds <= 32) { if (attn_item<PROBE, true>(ATTN_ITEM_ARGS, tid_l)) redo |= 1u << rr; }
        else redo = 0xffffffffu;
    }
    if (redo) {
#pragma unroll 1
        for (int rr = 0; rr < nrounds; ++rr) {
            if (nrounds <= 32 && !((redo >> rr) & 1u)) continue;
            int item;
            if (nb == 256) { int x = bid & 7, j = bid >> 3, hh = rr * 8 + x; item = (hh >> 1) * 64 + (hh & 1) * 32 + j; }
            else { item = rr * nb + bid; if (item >= 1024) break; }
            const int bh = item >> 6, qb = item & 63, b = bh >> 2, h = bh & 3;
            int t2_ = tid_l; asm volatile("" : "+v"(t2_));
            (void)attn_item<PROBE, false>(ATTN_ITEM_ARGS, t2_);
        }
    }
#undef ATTN_ITEM_ARGS
}


__device__ __forceinline__ bf16x8 ldfrag(const bf16_t* p) { return *reinterpret_cast<const bf16x8*>(p); }

__device__ __forceinline__ void ph_kv(const MK& p, int bid, int nb, int tid_l) {
    const int wid = tid_l >> 6, lane = tid_l & 63, r32 = lane & 31, hi = lane >> 5, dir = wid >> 2, mt = wid & 3;
    const int widu = __builtin_amdgcn_readfirstlane(wid);
    const int nitems = 16 * 66;
    const unsigned sofs = (unsigned)(wid * 1024 + ((lane * 16) ^ ((((wid & 1) * 4 + (lane >> 4)) & 7) << 4)));
#define KV_DMA(buf, it_) do { const int bh_ = (it_) / 66, c_ = (it_) % 66;                                                                                   \
        const char* v_ = (const char*)(p.VT() + (size_t)bh_ * 128 * RB + (size_t)c_ * 16384); const char* kf_ = (const char*)(p.KTf() + (size_t)bh_ * 64 * RB + (size_t)c_ * 8192); \
        const char* kb_ = (const char*)(p.KTb() + (size_t)bh_ * 64 * RB + (size_t)c_ * 8192); char* l_ = smem + (buf) * 65536 + widu * 1024;                                      \
        _Pragma("unroll") for (int i = 0; i < 4; ++i) __builtin_amdgcn_global_load_lds((const unsigned*)(v_ + sofs + i * 8192), (unsigned*)(l_ + i * 8192), 16, 0, 0);           \
        _Pragma("unroll") for (int i = 0; i < 2; ++i) { __builtin_amdgcn_global_load_lds((const unsigned*)(kf_ + sofs + i * 8192), (unsigned*)(l_ + 32768 + i * 8192), 16, 0, 2);  \
            __builtin_amdgcn_global_load_lds((const unsigned*)(kb_ + sofs + i * 8192), (unsigned*)(l_ + 49152 + i * 8192), 16, 0, 2);        } } while (0)
    __syncthreads();
    int it = bid;
    for (int n = 0; it < nitems; it += nb, ++n) {
        const int cur = 1;
        __syncthreads();
        KV_DMA(1, it);
        asm volatile("s_waitcnt vmcnt(0)" ::: "memory"); __syncthreads();
        const char* vl = smem + cur * 65536; const char* kl = vl + 32768 + dir * 16384;
        f32x16 acc[2] = {f32x16{}, f32x16{}};
#pragma unroll
        for (int ks = 0; ks < 8; ++ks) {
            const int cb = ks * 32 + hi * 16;
            const bf16x8 vfr = *(const bf16x8*)(vl + KSWZ(mt * 32 + r32, cb));
            const bf16x8 k0 = *(const bf16x8*)(kl + KSWZ(r32, cb)), k1 = *(const bf16x8*)(kl + KSWZ(32 + r32, cb));
            acc[0] = __builtin_amdgcn_mfma_f32_32x32x16_bf16(k0, vfr, acc[0], 0, 0, 0);
            acc[1] = __builtin_amdgcn_mfma_f32_32x32x16_bf16(k1, vfr, acc[1], 0, 0, 0);
        }
        const int bh = it / 66, c = it % 66;
        bf16_t* dst = p.KV() + ((size_t)(bh * 2 + dir) * 66 + c) * 8192 + (mt * 32 + r32) * 64 + hi * 4;
#pragma unroll
        for (int nt = 0; nt < 2; ++nt)
#pragma unroll
            for (int g = 0; g < 4; ++g) {
                u32x2 w; w.x = cvtpk(acc[nt][g * 4], acc[nt][g * 4 + 1]); w.y = cvtpk(acc[nt][g * 4 + 2], acc[nt][g * 4 + 3]);
                *(u32x2*)(dst + nt * 32 + g * 8) = w;
            }
    }
    __syncthreads();
#undef KV_DMA
}

__device__ __forceinline__ void ph_scan(const MK& p, int bid, int nb, int tid_l) {
    if (tid_l >= 256) {
        const int lane = tid_l & 63, wq = __builtin_amdgcn_readfirstlane(tid_l >> 6); char* tb = smem + wq * 8192;
#pragma unroll 1
        for (int j = CV_E13 + bid * 4 + (wq - 4); j < CV_E13 + CV_E2; j += nb * 4) convert_tile_wave(p, j, lane, tb);
        return;
    }
    for (int e0 = bid * 256 + tid_l; e0 < 32 * 8192; e0 += nb * 1024) {
        float S[4], g128[4]; const bf16_t* kv[4]; bf16_t* st[4]; int dir[4];
#pragma unroll
        for (int q = 0; q < 4; ++q) {
            int e = e0 + q * nb * 256; if (e >= 32 * 8192) e = e0;
            const int chain = e >> 13, el = e & 8191, h = (chain >> 1) & 3; dir[q] = chain & 1;
            const float d = dir[q] ? p.dec_b[h] : p.dec_f[h];
            g128[q] = exp2f(128.0f * log2f(1.0f / (1.0f + expf(-d))));
            kv[q] = p.KV() + (size_t)chain * 66 * 8192 + el; st[q] = p.ST() + (size_t)chain * 66 * 8192 + el; S[q] = 0.f;
        }
#pragma unroll 2
        for (int n = 0; n < 66; ++n) {
            const int cb = n == 0 ? 1 : (n == 1 ? 0 : 67 - n);
            float x[4];
#pragma unroll
            for (int q = 0; q < 4; ++q) x[q] = bf2f(kv[q][(size_t)(dir[q] ? cb : n) * 8192]);
#pragma unroll
            for (int q = 0; q < 4; ++q) { st[q][(size_t)(dir[q] ? cb : n) * 8192] = f2bf(S[q]); S[q] = fmaf(g128[q], S[q], x[q]); }
        }
    }
}

__device__ __forceinline__ void ph_ret(const MK& p, int bid, int nb, int tid_l) {
    const int tid = tid_l, wid = tid >> 6, lane = tid & 63, r32 = lane & 31, hi = lane >> 5, wq = wid & 3, half = wid >> 2;
    float* img = (float*)smem;
    for (int it = bid; it < 4 * 64 * 2; it += nb) {
        const int hp = it & 1, lc = (it >> 1) & 63, b = it >> 7, h = hp * 2 + half, bh = b * 4 + h;
        const int ib = CTX + lc * 128, c = 2 + lc;
        const float lf = log2f(1.0f / (1.0f + expf(-p.dec_f[h]))), lb = log2f(1.0f / (1.0f + expf(-p.dec_b[h])));
        const bf16_t* rq = p.RQ() + ((size_t)bh * RB + ib + wq * 32 + r32) * 64 + hi * 8;
        bf16x8 q[4];
#pragma unroll
        for (int ks = 0; ks < 4; ++ks) q[ks] = ldfrag(rq + ks * 16);
        f32x16 o[4];
        {
            const bf16_t* stf = p.ST() + ((size_t)(bh * 2 + 0) * 66 + c) * 8192 + hi * 8;
            const bf16_t* stb = p.ST() + ((size_t)(bh * 2 + 1) * 66 + c) * 8192 + hi * 8;
#define QSCALE(dst, f_) do { _Pragma("unroll") for (int ks = 0; ks < 4; ++ks) { const u32x4 w_ = *reinterpret_cast<const u32x4*>(&q[ks]); u32x4 r_;                         \
            _Pragma("unroll") for (int j = 0; j < 4; ++j) r_[j] = cvtpk(__uint_as_float(w_[j] << 16) * (f_), __uint_as_float(w_[j] & 0xffff0000u) * (f_));                 \
            dst[ks] = *reinterpret_cast<const bf16x8*>(&r_); } } while (0)
            {
                bf16x8 sf[4][4];
#pragma unroll
                for (int d0 = 0; d0 < 4; ++d0)
#pragma unroll
                    for (int ks = 0; ks < 4; ++ks) sf[d0][ks] = ldfrag(stf + (size_t)(d0 * 32 + r32) * 64 + ks * 16);
                asm volatile("" ::: "memory");
                bf16x8 qs[4]; QSCALE(qs, __builtin_amdgcn_exp2f((float)(wq * 32 + r32 + 1) * lf));
#pragma unroll
                for (int d0 = 0; d0 < 4; ++d0) {
                    o[d0] = f32x16{};
#pragma unroll
                    for (int ks = 0; ks < 4; ++ks) o[d0] = __builtin_amdgcn_mfma_f32_32x32x16_bf16(qs[ks], sf[d0][ks], o[d0], 0, 0, 0);
                }
            }
            asm volatile("" ::: "memory");
            {
                bf16x8 sb[4][4];
#pragma unroll
                for (int d0 = 0; d0 < 4; ++d0)
#pragma unroll
                    for (int ks = 0; ks < 4; ++ks) sb[d0][ks] = ldfrag(stb + (size_t)(d0 * 32 + r32) * 64 + ks * 16);
                asm volatile("" ::: "memory");
                bf16x8 qs[4]; QSCALE(qs, __builtin_amdgcn_exp2f((float)(128 - (wq * 32 + r32)) * lb));
#pragma unroll
                for (int d0 = 0; d0 < 4; ++d0)
#pragma unroll
                    for (int ks = 0; ks < 4; ++ks) o[d0] = __builtin_amdgcn_mfma_f32_32x32x16_bf16(qs[ks], sb[d0][ks], o[d0], 0, 0, 0);
            }
#undef QSCALE
            asm volatile("" ::: "memory");
        }
        {
            const int qi = wq * 32 + r32;
            const bf16_t* vt = p.VT() + (size_t)bh * 128 * RB + (size_t)c * 16384 + hi * 8;
#pragma unroll 1
            for (int jh = 0; jh < 2; ++jh) {
                asm volatile("" ::: "memory");
                bf16x8 pa[2][2];
                {
                    bf16x8 kf[2][4];
#pragma unroll
                    for (int j2 = 0; j2 < 2; ++j2)
#pragma unroll
                        for (int ks = 0; ks < 4; ++ks) kf[j2][ks] = ldfrag(p.RK() + ((size_t)bh * RB + ib + (jh * 2 + j2) * 32 + r32) * 64 + hi * 8 + ks * 16);
                    asm volatile("" ::: "memory");
#pragma unroll
                    for (int j2 = 0; j2 < 2; ++j2) {
                        f32x16 pp = f32x16{};
#pragma unroll
                        for (int ks = 0; ks < 4; ++ks) pp = __builtin_amdgcn_mfma_f32_32x32x16_bf16(kf[j2][ks], q[ks], pp, 0, 0, 0);
#pragma unroll
                        for (int r = 0; r < 16; ++r) {
                            const int dd = qi - ((jh * 2 + j2) * 32 + crow(r, hi));
                            const float ex = __builtin_amdgcn_exp2f(dd > 0 ? (float)dd * lf : (float)(-dd) * lb); const float w = dd == 0 ? 2.0f : ex;
                            pp[r] *= w;
                        }
                        PK4(pp, 0, pa[j2][0]); PK4(pp, 8, pa[j2][1]);
                    }
                }
                asm volatile("" ::: "memory");
                bf16x8 vf[2][4][2];
#pragma unroll
                for (int j2 = 0; j2 < 2; ++j2)
#pragma unroll
                    for (int d0 = 0; d0 < 4; ++d0) { vf[j2][d0][0] = ldfrag(vt + (d0 * 32 + r32) * 128 + (jh * 2 + j2) * 32); vf[j2][d0][1] = ldfrag(vt + (d0 * 32 + r32) * 128 + (jh * 2 + j2) * 32 + 16); }
                asm volatile("" ::: "memory");
#pragma unroll
                for (int j2 = 0; j2 < 2; ++j2)
#pragma unroll
                    for (int d0 = 0; d0 < 4; ++d0) {
                        o[d0] = __builtin_amdgcn_mfma_f32_32x32x16_bf16(pa[j2][0], vf[j2][d0][0], o[d0], 0, 0, 0);
                        o[d0] = __builtin_amdgcn_mfma_f32_32x32x16_bf16(pa[j2][1], vf[j2][d0][1], o[d0], 0, 0, 0);
                    }
            }
        }
        __syncthreads();
        {
            float* xo = img + half * 16384 + (wq * 32) * 128 + r32;
#pragma unroll
            for (int r = 0; r < 16; ++r)
#pragma unroll
                for (int d0 = 0; d0 < 4; ++d0) xo[crow(r, hi) * 128 + d0 * 32] = o[d0][r];
        }
        asm volatile("" ::: "memory");
        unsigned gg[16];
#define RET_GG(H_) do { _Pragma("unroll") for (int rr = 0; rr < 16; ++rr) { const int row = wid * 32 + (H_) * 16 + rr, itl = row >> 7, rw = row & 127, hh = hp * 2 + itl;      \
            gg[rr] = __builtin_nontemporal_load((const unsigned*)(p.RG() + ((size_t)b * SEQ + lc * 128 + rw) * 512 + hh * 128 + lane * 2)); } } while (0)
        RET_GG(0);
        __syncthreads();
        {
            const float g0 = p.ret_g[lane * 2], g1 = p.ret_g[lane * 2 + 1];
#pragma unroll 1
            for (int hh2 = 0; hh2 < 2; ++hh2) {
                if (hh2 == 1) RET_GG(1);
#pragma unroll
                for (int rr = 0; rr < 16; ++rr) {
                    const int row = wid * 32 + hh2 * 16 + rr, itl = row >> 7, rw = row & 127, hh = hp * 2 + itl;
                    const float2 a = *(const float2*)(img + row * 128 + lane * 2);
                    const float ss = wave_sum(a.x * a.x + a.y * a.y);
                    const float rs = rsqrtf(ss * (1.0f / 128) + EPS);
                    const size_t tt = (size_t)b * SEQ + lc * 128 + rw;
                    const float ga = bf2f((bf16_t)(gg[rr] & 0xffff)), gb = bf2f((bf16_t)(gg[rr] >> 16));
                    *(unsigned*)(p.MIX() + tt * 1024 + 512 + hh * 128 + lane * 2) = cvtpk(silu_fast(ga) * a.x * rs * g0, silu_fast(gb) * a.y * rs * g1);
                }
            }
        }
#undef RET_GG
    }
}


namespace pg8 {
constexpr int BM = 256, BK = 64, HALF = 128, HTB = HALF * BK * 2;
__device__ __forceinline__ int perm32(int rho) { const int n = rho >> 4, i = rho & 15; return 8 * (i >> 2) + 4 * n + (i & 3); }
struct GUnit { const char* A; const char* B; int i0, i1, i2, i3; };
template <class Epi, class Sched, bool GATHER, bool ALIGN_EPI>
__device__ __forceinline__ void gemm(int K, const Sched& S, const Epi& E, int tid_l) {
    const int tid = tid_l, wid = __builtin_amdgcn_readfirstlane(tid >> 6), lane = tid & 63, wr = wid >> 2, wc = wid & 3, fr = lane & 15, fq = lane >> 4;
    const int nt = K / BK;
    unsigned voffB[2], vAc[2][2], vAn[2][2];
    const size_t kstep = (size_t)(BK * 2);
    const size_t hstepB = (size_t)HALF * K * 2;
#pragma unroll
    for (int i = 0; i < 2; ++i) { int R, C; stage_rc(tid * 16 + i * 8192, R, C); const int Rb = Epi::PERM ? ((R & ~31) + perm32(R & 31)) : R;
        voffB[i] = (unsigned)(Rb * K + C) * 2u; }
    const unsigned ldsw = (unsigned)wid * 1024u;
    const int aoff = lds_byte(wr * 64 + fr, fq * 8), boff = lds_byte(wc * 32 + fr, fq * 8);
#define PG8_SA(b, h) (((b) * 2 + (h)) * HTB)
#define PG8_SB(b, h) ((4 + (b) * 2 + (h)) * HTB)
#define PG8_STAGE(bufoff, gbase, voff) do { _Pragma("unroll") for (int _i = 0; _i < 2; ++_i) \
        __builtin_amdgcn_global_load_lds((const unsigned*)((const char*)(gbase) + (voff)[_i]), (unsigned*)(smem + (bufoff) + ldsw + _i * 8192), 16, 0, 0); } while (0)
#define PG8_LDA(dst, b, h) do { _Pragma("unroll") for (int m = 0; m < 4; ++m) _Pragma("unroll") for (int k = 0; k < 2; ++k) dst[m][k] = *(const bf16x8*)(smem + PG8_SA(b, h) + aoff + m * 2048 + k * 1024); } while (0)
#define PG8_LDB(dst, b, h) do { _Pragma("unroll") for (int n = 0; n < 2; ++n) _Pragma("unroll") for (int k = 0; k < 2; ++k) dst[n][k] = *(const bf16x8*)(smem + PG8_SB(b, h) + boff + n * 2048 + k * 1024); } while (0)
#define PG8_MMA(ai, bj, At, Bt) do { __builtin_amdgcn_s_setprio(1); _Pragma("unroll") for (int m = 0; m < 4; ++m) _Pragma("unroll") for (int n = 0; n < 2; ++n) _Pragma("unroll") for (int k = 0; k < 2; ++k) \
        acc[ai][bj][m][n] = __builtin_amdgcn_mfma_f32_16x16x32_bf16(Bt[n][k], At[m][k], acc[ai][bj][m][n], 0, 0, 0); __builtin_amdgcn_s_setprio(0); } while (0)
#define PG8_WAIT_V(n) asm volatile("s_waitcnt vmcnt(" #n ")" ::: "memory")
#define PG8_WAIT_L(n) asm volatile("s_waitcnt lgkmcnt(" #n ")" ::: "memory")
#define PG8_BAR __builtin_amdgcn_s_barrier()
#define PG8_SCHED __builtin_amdgcn_sched_barrier(0)
    GUnit cur, nxt; int ui = 0;
    if (!S.next(0, cur, vAc)) return;
    f32x4 acc[2][2][4][2];
#pragma unroll
    for (int a = 0; a < 2; ++a)
#pragma unroll
        for (int b = 0; b < 2; ++b)
#pragma unroll
            for (int m = 0; m < 4; ++m)
#pragma unroll
                for (int n = 0; n < 2; ++n) acc[a][b][m][n] = (f32x4){0.f, 0.f, 0.f, 0.f};
    bf16x8 At[4][2], B0[2][2], B1[2][2];
    const char* cA = cur.A; const char* cB = cur.B;
    PG8_STAGE(PG8_SB(0, 0), cB, voffB); PG8_STAGE(PG8_SB(0, 1), cB + hstepB, voffB); PG8_STAGE(PG8_SA(0, 0), cA, vAc[0]); PG8_STAGE(PG8_SA(0, 1), cA, vAc[1]);
    if (wr == 1) PG8_BAR;
    PG8_WAIT_V(2); PG8_BAR;
    PG8_STAGE(PG8_SB(1, 0), cB + kstep, voffB); PG8_STAGE(PG8_SA(1, 0), cA + kstep, vAc[0]); PG8_STAGE(PG8_SB(1, 1), cB + hstepB + kstep, voffB);
    PG8_WAIT_V(6); PG8_BAR;
    for (;;) {
        const bool has_next = S.next(ui + 1, nxt, vAn);
        if (!GATHER || !has_next) {
#pragma unroll
            for (int h = 0; h < 2; ++h)
#pragma unroll
                for (int i = 0; i < 2; ++i) vAn[h][i] = vAc[h][i];
        }
        const char* nA = has_next ? nxt.A : cA; const char* nB = has_next ? nxt.B : cB;
#pragma unroll 1
        for (int t = 0; t < nt; t += 2) {
            const bool last = (t == nt - 2);
            const char* a1 = cA + (size_t)(t + 1) * kstep;
            const char* a2 = last ? nA : cA + (size_t)(t + 2) * kstep; const char* b2 = last ? nB : cB + (size_t)(t + 2) * kstep;
            const char* a3 = a2 + kstep; const char* b3 = b2 + kstep;
            unsigned va2[2][2];
#pragma unroll
            for (int h = 0; h < 2; ++h)
#pragma unroll
                for (int i = 0; i < 2; ++i) va2[h][i] = (GATHER && last) ? vAn[h][i] : vAc[h][i];
            PG8_LDB(B0, 0, 0); PG8_LDB(B1, 0, 1); PG8_SCHED; PG8_LDA(At, 0, 0); PG8_STAGE(PG8_SA(1, 1), a1, vAc[1]);
            PG8_WAIT_V(8); PG8_WAIT_L(0); PG8_BAR; PG8_MMA(0, 0, At, B0); PG8_MMA(0, 1, At, B1); PG8_BAR; PG8_SCHED;
            PG8_LDA(At, 0, 1); PG8_STAGE(PG8_SB(0, 0), b2, voffB); PG8_STAGE(PG8_SB(0, 1), b2 + hstepB, voffB); PG8_STAGE(PG8_SA(0, 0), a2, va2[0]);
            PG8_WAIT_V(8); PG8_WAIT_L(0); PG8_BAR; PG8_MMA(1, 0, At, B0); PG8_MMA(1, 1, At, B1); PG8_BAR; PG8_SCHED;
            PG8_LDB(B0, 1, 0); PG8_LDB(B1, 1, 1); PG8_SCHED; PG8_LDA(At, 1, 0); PG8_STAGE(PG8_SA(0, 1), a2, va2[1]);
            PG8_WAIT_V(8); PG8_WAIT_L(0); PG8_BAR; PG8_MMA(0, 0, At, B0); PG8_MMA(0, 1, At, B1); PG8_BAR; PG8_SCHED;
            PG8_LDA(At, 1, 1); PG8_STAGE(PG8_SB(1, 0), b3, voffB); PG8_STAGE(PG8_SB(1, 1), b3 + hstepB, voffB); PG8_STAGE(PG8_SA(1, 0), a3, va2[0]);
            PG8_WAIT_V(8); PG8_WAIT_L(0); PG8_BAR; PG8_MMA(1, 0, At, B0); PG8_MMA(1, 1, At, B1); PG8_BAR; PG8_SCHED;
        }
        if (ALIGN_EPI) { if (wr == 0) PG8_BAR; }
        E(acc, cur, wr, wc, fr, fq);
        if (!has_next) break;
#pragma unroll
        for (int a = 0; a < 2; ++a)
#pragma unroll
            for (int b = 0; b < 2; ++b)
#pragma unroll
                for (int m = 0; m < 4; ++m)
#pragma unroll
                    for (int n = 0; n < 2; ++n) acc[a][b][m][n] = (f32x4){0.f, 0.f, 0.f, 0.f};
        cur = nxt; cA = nA; cB = nB; ++ui;
#pragma unroll
        for (int h = 0; h < 2; ++h)
#pragma unroll
            for (int i = 0; i < 2; ++i) vAc[h][i] = vAn[h][i];
        if (ALIGN_EPI) { if (wr == 1) PG8_BAR; }
    }
    PG8_WAIT_V(0);
    if (!ALIGN_EPI) { if (wr == 0) PG8_BAR; }
    PG8_BAR;
#undef PG8_SA
#undef PG8_SB
#undef PG8_STAGE
#undef PG8_LDA
#undef PG8_LDB
#undef PG8_MMA
#undef PG8_WAIT_V
#undef PG8_WAIT_L
#undef PG8_BAR
#undef PG8_SCHED
}
__device__ __forceinline__ void plain_voffA(int K, unsigned (&vA)[2][2], int tid_l) {
#pragma unroll
    for (int i = 0; i < 2; ++i) { int R, C; stage_rc(tid_l * 16 + i * 8192, R, C); vA[0][i] = (unsigned)(R * K + C) * 2u; vA[1][i] = (unsigned)((R + HALF) * K + C) * 2u; }
}
}


__device__ __forceinline__ int xcd_vbid(int bid, int nb) { return (nb & 7) ? bid : (bid & 7) * (nb >> 3) + (bid >> 3); }
struct SchedIn { const MK* p; int bid, nb, tid_l;
    __device__ __forceinline__ bool next(int i, pg8::GUnit& u, unsigned (&vA)[2][2]) const {
        const int tile = xcd_vbid(bid, nb) + i * nb; if (tile >= (NR / 256) * 12) return false;
        const int pm = tile / 12, pn = tile % 12;
        u.A = (const char*)(p->H() + (size_t)(pm * 256) * D); u.B = (const char*)(p->w_inT() + (size_t)(pn * 256) * D); u.i0 = pm; u.i1 = pn; u.i2 = 0; u.i3 = 0;
        pg8::plain_voffA(D, vA, tid_l); return true; } };
struct EpiIn { static constexpr bool PERM = false; const MK* p;
    __device__ __forceinline__ void operator()(f32x4 (&acc)[2][2][4][2], const pg8::GUnit& u, int wr, int wc, int fr_in, int fq_in) const {
        int fr = fr_in, fq = fq_in; asm volatile("" : "+v"(fr), "+v"(fq));
        const int pm = u.i0, seg = u.i1, brow = pm * 256;
        const int b = brow / RB, i0 = brow % RB;
        const bool lat = i0 >= CTX;
        const int wid = wr * 4 + wc, lane = fq * 16 + fr;
        if (lat && (seg <= 3 || seg == 6 || seg == 7)) {
#pragma unroll
            for (int ai = 0; ai < 2; ++ai)
#pragma unroll
                for (int m = 0; m < 4; ++m) {
                    const int t = i0 + ai * 128 + wr * 64 + m * 16 + fr - CTX, pos = (wc & 1) ? (t & 63) : (t >> 6);
                    const f32x4 cc = *(const f32x4*)(p->ropec() + pos * 16 + fq * 4), ss = *(const f32x4*)(p->ropes() + pos * 16 + fq * 4);
#pragma unroll
                    for (int bj = 0; bj < 2; ++bj) { const f32x4 x1 = acc[ai][bj][m][0], x2 = acc[ai][bj][m][1];
                        acc[ai][bj][m][0] = x1 * cc - x2 * ss; acc[ai][bj][m][1] = x1 * ss + x2 * cc; }
                }
        }
        if (seg == 7 || seg <= 1) {
            const float sc_ = seg == 7 ? 0.125f : 0.125f * 1.4426950408889634f;
#pragma unroll
            for (int ai = 0; ai < 2; ++ai)
#pragma unroll
                for (int bj = 0; bj < 2; ++bj)
#pragma unroll
                    for (int m = 0; m < 4; ++m) { acc[ai][bj][m][0] = acc[ai][bj][m][0] * sc_; acc[ai][bj][m][1] = acc[ai][bj][m][1] * sc_; }
        }
        if (seg <= 7 || seg >= 10) {
            const int fcol = (fq & 1) * 16 + (fq >> 1) * 8;
#pragma unroll
            for (int bj = 0; bj < 2; ++bj) {
                bf16_t* base; long rstride; bool ok = true;
                if (seg <= 1)      { const int h = (seg & 1) * 2 + bj;       base = p->Q() + (((size_t)(b * 4 + h) * SEQ + (i0 - CTX)) * 128 + wc * 32 + fcol); rstride = 128; ok = lat; }
                else if (seg <= 3) { const int h = (seg - 2) * 2 + bj;       base = p->K() + (((size_t)(b * 4 + h) * RB + i0) * 128 + wc * 32 + fcol);          rstride = 128; }
                else if (seg <= 5) { const int h = (seg - 4) * 2 + bj;       base = p->V() + (((size_t)(b * 4 + h) * RB + i0) * 128 + wc * 32 + fcol);          rstride = 128; }
                else if (seg == 6) { const int h = bj * 2 + (wc >> 1);       base = p->RQ() + (((size_t)(b * 4 + h) * RB + i0) * 64 + (wc & 1) * 32 + fcol);    rstride = 64; }
                else if (seg == 7) { const int h = bj * 2 + (wc >> 1);       base = p->RK() + (((size_t)(b * 4 + h) * RB + i0) * 64 + (wc & 1) * 32 + fcol);    rstride = 64; }
                else               {                                         base = p->RG() + ((size_t)(b * SEQ + (i0 - CTX)) * 512 + (seg - 10) * 256 + bj * 128 + wc * 32 + fcol); rstride = 512; ok = lat; }
                if (ok) {
#pragma unroll
                    for (int ai = 0; ai < 2; ++ai)
#pragma unroll
                        for (int m = 0; m < 4; ++m) { bf16_t* rp = base + (long)(ai * 128 + wr * 64 + m * 16 + fr) * rstride;
                            u32x2 w0, w1; w0.x = cvtpk(acc[ai][bj][m][0][0], acc[ai][bj][m][0][1]); w0.y = cvtpk(acc[ai][bj][m][0][2], acc[ai][bj][m][0][3]);
                            w1.x = cvtpk(acc[ai][bj][m][1][0], acc[ai][bj][m][1][1]); w1.y = cvtpk(acc[ai][bj][m][1][2], acc[ai][bj][m][1][3]);
                            auto rx = __builtin_amdgcn_permlane16_swap(w0.x, w1.x, false, false); auto ry = __builtin_amdgcn_permlane16_swap(w0.y, w1.y, false, false);
                            const u32x4 wv = {rx[0], ry[0], rx[1], ry[1]};
                            *(u32x4*)rp = wv; }
                }
            }
        }
        if (seg >= 7 && seg <= 9) {
            char* img = smem + 131072 + wid * 3968;
            const int npass = seg == 7 ? 2 : 1;
#pragma unroll 1
            for (int ps = 0; ps < npass; ++ps) {
#pragma unroll
                for (int bj = 0; bj < 2; ++bj) {
                    float lg2 = 0.f; bf16_t* baseT;
                    if (seg == 7) { const int h = bj * 2 + (wc >> 1); const float dv = ps == 0 ? p->dec_f[h] : p->dec_b[h]; lg2 = log2f(1.0f / (1.0f + expf(-dv)));
                        baseT = (ps == 0 ? p->KTf() : p->KTb()) + (size_t)(b * 4 + h) * 64 * RB + (size_t)(i0 >> 7) * 8192 + (wc & 1) * 32 * 128; }
                    else { const int h = (seg - 8) * 2 + bj; baseT = p->VT() + (size_t)(b * 4 + h) * 128 * RB + (size_t)(i0 >> 7) * 16384 + wc * 32 * 128; }
#pragma unroll
                    for (int ai = 0; ai < 2; ++ai)
#pragma unroll
                        for (int mp = 0; mp < 2; ++mp) {
                            asm volatile("s_waitcnt lgkmcnt(0)" ::: "memory");
#pragma unroll
                            for (int mm = 0; mm < 2; ++mm) { const int m = mp * 2 + mm;
                                float f = 1.0f;
                                if (seg == 7) { const int pos = (i0 + ai * 128 + wr * 64 + m * 16 + fr) & 127; f = __builtin_amdgcn_exp2f((float)(ps == 0 ? 127 - pos : pos) * lg2); }
#pragma unroll
                                for (int n = 0; n < 2; ++n)
#pragma unroll
                                    for (int j = 0; j < 4; ++j) *(bf16_t*)(img + (n * 16 + fq * 4 + j) * 80 + (mm * 16 + fr) * 2) = f2bf(acc[ai][bj][m][n][j] * f); }
                            asm volatile("s_waitcnt lgkmcnt(0)" ::: "memory");
                            const int ib = ai * (seg == 7 ? 8192 : 16384) + wr * 64 + mp * 32;
#pragma unroll
                            for (int k = 0; k < 2; ++k) { const int q = lane + 64 * k, col = q >> 2, ch = q & 3;
                                *(u32x4*)(baseT + (size_t)col * 128 + ib + ch * 8) = *(const u32x4*)(img + col * 80 + ch * 16); }
                        }
                }
            }
        }
    } };
__device__ __forceinline__ void ph_gemm_in(const MK& p, int bid, int nb, int tid_l) {
    SchedIn S{&p, bid, nb, tid_l}; EpiIn E{&p};
    pg8::gemm<EpiIn, SchedIn, false, true>(D, S, E, tid_l);
}

struct SchedOut { const MK* p; int bid, nb, tid_l;
    __device__ __forceinline__ bool next(int i, pg8::GUnit& u, unsigned (&vA)[2][2]) const {
        const int tile = xcd_vbid(bid, nb) + i * nb; if (tile >= (T / 256) * 4) return false;
        const int pm = tile >> 2, pn = tile & 3;
        u.A = (const char*)(p->MIX() + (size_t)(pm * 256) * D); u.B = (const char*)(p->w_outT() + (size_t)(pn * 256) * D); u.i0 = pm; u.i1 = pn; u.i2 = 0; u.i3 = 0;
        pg8::plain_voffA(D, vA, tid_l); return true; } };
struct EpiOut { static constexpr bool PERM = true; const MK* p;
    __device__ __forceinline__ void operator()(const f32x4 (&acc)[2][2][4][2], const pg8::GUnit& u, int wr, int wc, int fr, int fq) const {
        const int brow = u.i0 * 256, bcol = u.i1 * 256 + wc * 32 + fq * 8;
        const float* g1 = p->mod() + (size_t)(brow / SEQ) * 6 * D + 2 * D + bcol;
        f32x4 gv[2][2];
#pragma unroll
        for (int bj = 0; bj < 2; ++bj)
#pragma unroll
            for (int n = 0; n < 2; ++n) gv[bj][n] = *(const f32x4*)(g1 + bj * 128 + n * 4);
#pragma unroll
        for (int ai = 0; ai < 2; ++ai)
#pragma unroll
            for (int m = 0; m < 4; ++m) {
                const int row = brow + ai * 128 + wr * 64 + m * 16 + fr;
                const float* xp = p->x + (size_t)row * D + bcol;
                f32x4 xv[2][2];
#pragma unroll
                for (int bj = 0; bj < 2; ++bj)
#pragma unroll
                    for (int n = 0; n < 2; ++n) xv[bj][n] = __builtin_nontemporal_load((const f32x4*)(xp + bj * 128 + n * 4));
                float ssl = 0.f;
#pragma unroll
                for (int bj = 0; bj < 2; ++bj) {
                    const f32x4 a = xv[bj][0] + gv[bj][0] * acc[ai][bj][m][0], b = xv[bj][1] + gv[bj][1] * acc[ai][bj][m][1];
                    const u32x4 w = {cvtpk(a[0], a[1]), cvtpk(a[2], a[3]), cvtpk(b[0], b[1]), cvtpk(b[2], b[3])};
                    *(u32x4*)(p->X1() + (size_t)row * 2048 + bcol + bj * 128) = w;
#pragma unroll
                    for (int k = 0; k < 4; ++k) { const float lo_ = __uint_as_float(w[k] << 16), hi_ = __uint_as_float(w[k] & 0xffff0000u); ssl += lo_ * lo_ + hi_ * hi_; }
                }
                { auto r0 = __builtin_amdgcn_permlane16_swap(__float_as_uint(ssl), __float_as_uint(ssl), false, false); ssl = __uint_as_float(r0[0]) + __uint_as_float(r0[1]);
                  auto r1 = __builtin_amdgcn_permlane32_swap(__float_as_uint(ssl), __float_as_uint(ssl), false, false); ssl = __uint_as_float(r1[0]) + __uint_as_float(r1[1]); }
                if (fq == 0) p->SSQ()[(size_t)row * 16 + u.i1 * 4 + wc] = ssl;
                if (m & 1) asm volatile("" ::: "memory");
            }
    } };
__device__ __forceinline__ void ph_gemm_out(const MK& p, int bid, int nb, int tid_l) {
    SchedOut S{&p, bid, nb, tid_l}; EpiOut E{&p};
    pg8::gemm<EpiOut, SchedOut, false, true>(D, S, E, tid_l);
}

template <bool DUMMY, int MODE = 0> __device__ __forceinline__ void ph_route(const MK& p, int bid, int nb, int tid_l) {
    int* cntp = p.cnt() + (DUMMY ? 128 : 0); int* tl = DUMMY ? (int*)(p.ws + 480 * MiB) : p.tok_list(); float* wl_ = DUMMY ? (float*)(p.ws + 488 * MiB) : p.wt_list(); int* tm = DUMMY ? (int*)(p.ws + 496 * MiB) : p.tokmap();
    const int tid = tid_l, wid = tid >> 6, lane = tid & 63, fr = lane & 15, fq = lane >> 4;
    float* lg = (float*)smem;
    int* wcnt = (int*)(smem + 34816);
    int* pref = wcnt + 512;
    for (int item = bid; item < T / 128; item += nb) {
        const int t0 = item * 128 + wid * 16, b = (item * 128) / SEQ;
        const float* msh = p.mod() + (size_t)b * 6 * D + 3 * D; const float* msc = p.mod() + (size_t)b * 6 * D + 4 * D;
        float* gaT = (float*)(smem + 106496); float* shT = gaT + 1024;
        for (int c = tid; c < D; c += NTHR) { gaT[c] = p.norm2_g[c] * (1 + msc[c]); shT[c] = msh[c]; }
        const bf16_t* xp = p.X1() + (size_t)(t0 + fr) * 2048 + fq * 8;
        float rstd;
        {
            const f32x4* sp = (const f32x4*)(p.SSQ() + (size_t)(t0 + fr) * 16);
            const f32x4 s0 = sp[0], s1 = sp[1], s2 = sp[2], s3 = sp[3];
            const float ss = ((s0[0] + s0[1]) + (s0[2] + s0[3])) + ((s1[0] + s1[1]) + (s1[2] + s1[3])) + ((s2[0] + s2[1]) + (s2[2] + s2[3])) + ((s3[0] + s3[1]) + (s3[2] + s3[3]));
            rstd = rsqrtf(ss * (1.0f / D) + EPS);
        }
        f32x4 acc[4];
#pragma unroll
        for (int nt = 0; nt < 4; ++nt) acc[nt] = (f32x4){0.f, 0.f, 0.f, 0.f};
        {
            bf16_t* h2p = p.H2() + (size_t)(t0 + fr) * D + fq * 8;
            const int widu = __builtin_amdgcn_readfirstlane(wid);
            unsigned rofs[4];
#pragma unroll
            for (int i = 0; i < 4; ++i) { const int x = wid * 1024 + i * 8192 + lane * 16, row = x >> 8, c = ((x & 255) >> 4) ^ (row & 15); rofs[i] = (unsigned)(row * 2048 + c * 16); }
#define RT_DMA(kc, buf) do { const char* src_ = (const char*)p.routerT() + (size_t)(kc) * 256;                                             \
            _Pragma("unroll") for (int i = 0; i < 4; ++i) __builtin_amdgcn_global_load_lds((const unsigned*)(src_ + rofs[i]), (unsigned*)(smem + 40960 + (buf) * 32768 + widu * 1024 + i * 8192), 16, 0, 0); } while (0)
            RT_DMA(0, 0);
#pragma unroll 1
            for (int hh = 0; hh < 2; ++hh) {
            u32x4 xq[4][4];
#pragma unroll
            for (int k4 = 0; k4 < 4; ++k4)
#pragma unroll
                for (int ks = 0; ks < 4; ++ks) xq[k4][ks] = __builtin_nontemporal_load((const u32x4*)(xp + (hh * 4 + k4) * 128 + ks * 32));
#pragma unroll
            for (int k4 = 0; k4 < 4; ++k4) {
                const int kc = hh * 4 + k4;
                asm volatile("s_waitcnt vmcnt(0)" ::: "memory"); __syncthreads();
                if (kc + 1 < 8) RT_DMA(kc + 1, (kc + 1) & 1);
                const char* bb = smem + 40960 + (k4 & 1) * 32768;
                bf16x8 ah[4], al[4];
#pragma unroll
                for (int ks = 0; ks < 4; ++ks) {
                    const int c0 = kc * 128 + ks * 32 + fq * 8;
                    const f32x4 ga0 = *(const f32x4*)(gaT + c0), ga1 = *(const f32x4*)(gaT + c0 + 4), sh0 = *(const f32x4*)(shT + c0), sh1 = *(const f32x4*)(shT + c0 + 4);
                    const u32x4 xw = xq[k4][ks];
                    float h[8];
#pragma unroll
                    for (int k = 0; k < 4; ++k) {
                        const float xl = __uint_as_float(xw[k] << 16), xh = __uint_as_float(xw[k] & 0xffff0000u);
                        const float gl = k < 2 ? ga0[2 * k] : ga1[2 * k - 4], gh = k < 2 ? ga0[2 * k + 1] : ga1[2 * k - 3];
                        const float sl_ = k < 2 ? sh0[2 * k] : sh1[2 * k - 4], sh_ = k < 2 ? sh0[2 * k + 1] : sh1[2 * k - 3];
                        h[2 * k] = xl * rstd * gl + sl_; h[2 * k + 1] = xh * rstd * gh + sh_;
                    }
                    u32x4 wh, wl;
#pragma unroll
                    for (int k = 0; k < 4; ++k) { wh[k] = cvtpk(h[2 * k], h[2 * k + 1]); wl[k] = cvtpk(h[2 * k] - __uint_as_float(wh[k] << 16), h[2 * k + 1] - __uint_as_float(wh[k] & 0xffff0000u)); }
                    *(u32x4*)(h2p + kc * 128 + ks * 32) = wh;
                    ah[ks] = *reinterpret_cast<const bf16x8*>(&wh); al[ks] = *reinterpret_cast<const bf16x8*>(&wl);
                }
#pragma unroll
                for (int ks = 0; ks < 4; ++ks)
#pragma unroll
                    for (int nt = 0; nt < 4; ++nt) {
                        const int row = nt * 16 + fr, cc = ((ks * 4 + fq) ^ (row & 15)) * 16;
                        const bf16x8 bh = *(const bf16x8*)(bb + row * 256 + cc), bl = *(const bf16x8*)(bb + (64 + row) * 256 + cc);
                        acc[nt] = __builtin_amdgcn_mfma_f32_16x16x32_bf16(ah[ks], bh, acc[nt], 0, 0, 0);
                        acc[nt] = __builtin_amdgcn_mfma_f32_16x16x32_bf16(ah[ks], bl, acc[nt], 0, 0, 0);
                        acc[nt] = __builtin_amdgcn_mfma_f32_16x16x32_bf16(al[ks], bh, acc[nt], 0, 0, 0);
                    }
            }
            }
#undef RT_DMA
        }
#pragma unroll
        for (int nt = 0; nt < 4; ++nt)
#pragma unroll
            for (int j = 0; j < 4; ++j) lg[(wid * 16 + fq * 4 + j) * 65 + nt * 16 + fr] = acc[nt][j];
        __syncthreads();
        if (MODE == 2) continue;
        int l3 = lane; asm volatile("" : "+v"(l3));
#define SHXF(v_, m_) ((m_) == 1 ? dppf<0xB1>(v_) : dppf<0x4E>(v_))
#define SHXI(v_, m_) ((m_) == 1 ? dppi<0xB1>(v_) : dppi<0x4E>(v_))
#define SHBF(v_, qq_) ((qq_) == 0 ? dppf<0x00>(v_) : (qq_) == 1 ? dppf<0x55>(v_) : (qq_) == 2 ? dppf<0xAA>(v_) : dppf<0xFF>(v_))
#define SHBI(v_, qq_) ((qq_) == 0 ? dppi<0x00>(v_) : (qq_) == 1 ? dppi<0x55>(v_) : (qq_) == 2 ? dppi<0xAA>(v_) : dppi<0xFF>(v_))
        const int q4 = l3 & 3, tt = wid * 16 + (l3 >> 2), t = item * 128 + tt;
        float sc_[16], v[16];
#pragma unroll
        for (int i = 0; i < 16; ++i) { const float x = lg[tt * 65 + q4 * 16 + i]; sc_[i] = __builtin_amdgcn_rcpf(1.0f + __builtin_amdgcn_exp2f(-1.4426950408889634f * x)); v[i] = sc_[i] + p.router_b[q4 * 16 + i]; }
        float gsA, gsB;
        { float m1 = v[0], m2 = -INFINITY;
#pragma unroll
          for (int i = 1; i < 8; ++i) { const float x = v[i]; m2 = fmaxf(m2, fminf(m1, x)); m1 = fmaxf(m1, x); }
          gsA = m1 + m2; m1 = v[8]; m2 = -INFINITY;
#pragma unroll
          for (int i = 9; i < 16; ++i) { const float x = v[i]; m2 = fmaxf(m2, fminf(m1, x)); m1 = fmaxf(m1, x); }
          gsB = m1 + m2; }
        { int rankA = 0, rankB = 0;
#pragma unroll
          for (int qq = 0; qq < 4; ++qq) {
              const float ga = SHBF(gsA, qq), gb = SHBF(gsB, qq);
              const int g0 = 2 * qq, g1 = 2 * qq + 1, mA = 2 * q4, mB = 2 * q4 + 1;
              rankA += (g0 != mA && (ga > gsA || (ga == gsA && g0 < mA))) ? 1 : 0; rankA += (g1 != mA && (gb > gsA || (gb == gsA && g1 < mA))) ? 1 : 0;
              rankB += (g0 != mB && (ga > gsB || (ga == gsB && g0 < mB))) ? 1 : 0; rankB += (g1 != mB && (gb > gsB || (gb == gsB && g1 < mB))) ? 1 : 0;
          }
          if (rankA >= 4) {
#pragma unroll
              for (int i = 0; i < 8; ++i) v[i] = -INFINITY; }
          if (rankB >= 4) {
#pragma unroll
              for (int i = 8; i < 16; ++i) v[i] = -INFINITY; } }
        unsigned chm = 0u;
#pragma unroll 1
        for (int it = 0; it < 8; ++it) {
            float lm = v[0];
#pragma unroll
            for (int i = 1; i < 16; ++i) lm = fmaxf(lm, v[i]);
            float gm = fmaxf(lm, SHXF(lm, 1)); gm = fmaxf(gm, SHXF(gm, 2));
            int cand = (lm == gm) ? q4 : 4;
            cand = min(cand, SHXI(cand, 1)); cand = min(cand, SHXI(cand, 2));
            const bool win = cand == q4;
            bool found = false;
#pragma unroll
            for (int i = 0; i < 16; ++i) { const bool hit = win && !found && v[i] == gm; if (hit) { chm |= (1u << i); v[i] = -INFINITY; } found = found || hit; }
        }
        float wsum = 0.f;
#pragma unroll
        for (int i = 0; i < 16; ++i) wsum += ((chm >> i) & 1u) ? sc_[i] : 0.f;
        wsum += SHXF(wsum, 1); wsum += SHXF(wsum, 2);
        const float wscale = 2.5f / wsum;
        const unsigned long long pat = 0x1111111111111111ull << q4;
#pragma unroll
        for (int i = 0; i < 16; ++i) { const unsigned long long bal = __ballot((chm >> i) & 1u); if (l3 < 4) wcnt[wid * 64 + l3 * 16 + i] = __popcll(bal & (0x1111111111111111ull << l3)); }
        __syncthreads();
        if (wid == 0) {
            int tot = 0;
#pragma unroll
            for (int w = 0; w < 8; ++w) tot += wcnt[w * 64 + lane];
            int run = atomicAdd(&cntp[lane], tot);
#pragma unroll
            for (int w = 0; w < 8; ++w) { const int c = wcnt[w * 64 + lane]; pref[w * 64 + lane] = run; run += c; }
        }
        __syncthreads();
        {
            const int pc = __popc(chm);
            int kbase = 0;
#pragma unroll
            for (int qq = 0; qq < 3; ++qq) { const int o = SHBI(pc, qq); kbase += (qq < q4) ? o : 0; }
#pragma unroll
            for (int i = 0; i < 16; ++i) {
                const bool c = (chm >> i) & 1u;
                const unsigned long long bal = __ballot(c);
                if (c) {
                    const int e = q4 * 16 + i;
                    const int slot = pref[wid * 64 + e] + __popcll(bal & pat & ((1ull << l3) - 1ull));
                    tl[(size_t)e * ECAP + slot] = t; wl_[(size_t)e * ECAP + slot] = sc_[i] * wscale;
                    tm[(size_t)t * 8 + kbase + __popc(chm & ((1u << i) - 1u))] = e * ECAP + slot;
                }
            }
        }
    }
}
#undef SHXF
#undef SHXI
#undef SHBF
#undef SHBI

constexpr int MOE_AUX = 162816;
__device__ __forceinline__ void moe_tables(const MK& p, int colt, int* tpre, int* rbase, int tid_l) {
    __syncthreads();
    if (tid_l == 0) { int tp = 0, rb = 0;
        for (int e = 0; e < 65; ++e) { const int c = e < 64 ? p.cnt()[e] : T; tpre[e] = tp; rbase[e] = rb; tp += ((c + 255) >> 8) * colt; rb += c; }
        tpre[65] = tp; rbase[65] = rb; }
    __syncthreads();
}
struct SchedUp { const MK* p; int bid, nb, tid_l, ntiles; const int* tpre; const int* rbase; mutable int e_hint;
    __device__ __forceinline__ bool next(int i, pg8::GUnit& u, unsigned (&vA)[2][2]) const {
        const int tile = xcd_vbid(bid, nb) + i * nb; if (tile >= ntiles) return false;
        int e = e_hint; while (tile >= tpre[e + 1]) ++e; e_hint = e;
        const int j = tile - tpre[e], rt = j >> 1, ct = j & 1, cnt_e = rbase[e + 1] - rbase[e];
        u.A = (const char*)p->H2(); u.B = (const char*)(p->W13t() + ((size_t)e * 512 + ct * 256) * D); u.i0 = e; u.i1 = rt; u.i2 = ct; u.i3 = cnt_e;
#pragma unroll
        for (int i2 = 0; i2 < 2; ++i2) { int R, C; stage_rc(tid_l * 16 + i2 * 8192, R, C);
#pragma unroll
            for (int h = 0; h < 2; ++h) { int slot = rt * 256 + h * 128 + R; if (slot >= cnt_e) slot = 0;
                const int tok = e < 64 ? p->tok_list()[(size_t)e * ECAP + slot] : slot;
                vA[h][i2] = (unsigned)tok * (D * 2u) + (unsigned)C * 2u; } }
        return true; } };
template <bool NOSTORE = false> struct EpiUpT { static constexpr bool PERM = true; const MK* p; const int* rbase;
    __device__ __forceinline__ void operator()(const f32x4 (&acc)[2][2][4][2], const pg8::GUnit& u, int wr, int wc, int fr, int fq) const {
        const int e = u.i0, rt = u.i1, ct = u.i2, cnt_e = u.i3;
        bf16_t* ab = p->ACT() + (size_t)rbase[e] * DE + ct * 128 + wc * 32 + fq * 8;
        const float* wl = p->wt_list() + (size_t)(e < 64 ? e : 0) * ECAP;
        float wv[2][4];
#pragma unroll
        for (int ai = 0; ai < 2; ++ai)
#pragma unroll
            for (int m = 0; m < 4; ++m) { const int sl = rt * 256 + ai * 128 + wr * 64 + m * 16 + fr; wv[ai][m] = e < 64 ? wl[sl < cnt_e ? sl : 0] : 1.0f; }
#pragma unroll
        for (int ai = 0; ai < 2; ++ai)
#pragma unroll
            for (int m = 0; m < 4; ++m) {
                const int slot = rt * 256 + ai * 128 + wr * 64 + m * 16 + fr;
                const float rw = wv[ai][m];
                u32x4 w;
                w.x = cvtpk(silu_fast(acc[ai][0][m][0][0]) * acc[ai][1][m][0][0] * rw, silu_fast(acc[ai][0][m][0][1]) * acc[ai][1][m][0][1] * rw);
                w.y = cvtpk(silu_fast(acc[ai][0][m][0][2]) * acc[ai][1][m][0][2] * rw, silu_fast(acc[ai][0][m][0][3]) * acc[ai][1][m][0][3] * rw);
                w.z = cvtpk(silu_fast(acc[ai][0][m][1][0]) * acc[ai][1][m][1][0] * rw, silu_fast(acc[ai][0][m][1][1]) * acc[ai][1][m][1][1] * rw);
                w.w = cvtpk(silu_fast(acc[ai][0][m][1][2]) * acc[ai][1][m][1][2] * rw, silu_fast(acc[ai][0][m][1][3]) * acc[ai][1][m][1][3] * rw);
                if (NOSTORE) { if (slot < -cnt_e) *(u32x4*)(ab + (size_t)slot * DE) = w; } else if (slot < cnt_e) *(u32x4*)(ab + (size_t)slot * DE) = w;
            }
    } };
__device__ __forceinline__ void ph_moe_up(const MK& p, int bid, int nb, int tid_l) {
    int* tpre = (int*)(smem + MOE_AUX); int* rbase = tpre + 80;
    moe_tables(p, 2, tpre, rbase, tid_l);
    SchedUp S{&p, bid, nb, tid_l, tpre[65], tpre, rbase, 0}; EpiUpT<false> E{&p, rbase};
    pg8::gemm<EpiUpT<false>, SchedUp, true, true>(D, S, E, tid_l);
}
constexpr float Y_SCALE = 64.0f;
struct SchedDown { const MK* p; int bid, nb, tid_l, ntiles; const int* tpre; const int* rbase; mutable int e_hint;
    __device__ __forceinline__ bool next(int i, pg8::GUnit& u, unsigned (&vA)[2][2]) const {
        const int tile = xcd_vbid(bid, nb) + i * nb; if (tile >= ntiles) return false;
        int e = e_hint; while (tile >= tpre[e + 1]) ++e; e_hint = e;
        const int j = tile - tpre[e], rt = j >> 2, ct = j & 3, cnt_e = rbase[e + 1] - rbase[e];
        u.A = (const char*)(p->ACT() + (size_t)(rbase[e] + rt * 256) * DE); u.B = (const char*)(p->W2t() + ((size_t)e * D + ct * 256) * DE); u.i0 = e; u.i1 = rt; u.i2 = ct; u.i3 = cnt_e;
        pg8::plain_voffA(DE, vA, tid_l); return true; } };
template <int MODE> struct EpiDown { static constexpr bool PERM = true; const MK* p; const int* rbase;
    __device__ __forceinline__ void operator()(const f32x4 (&acc)[2][2][4][2], const pg8::GUnit& u, int wr, int wc, int fr, int fq) const {
        const int e = u.i0, rt = u.i1, ct = u.i2, cnt_e = u.i3;
        const int pos = (fq & 1) ? 32 + 8 * (fq - 1) : 8 * fq;
        unsigned char* yb = p->Y() + (size_t)rbase[e] * D + ct * 256 + wc * 64 + pos;
#pragma unroll
        for (int ai = 0; ai < 2; ++ai)
#pragma unroll
            for (int m = 0; m < 4; ++m) {
                u32x2 pk[2];
#pragma unroll
                for (int bj = 0; bj < 2; ++bj)
#pragma unroll
                    for (int n = 0; n < 2; ++n) {
                        float v0 = __builtin_amdgcn_fmed3f(acc[ai][bj][m][n][0] * Y_SCALE, -448.f, 448.f), v1 = __builtin_amdgcn_fmed3f(acc[ai][bj][m][n][1] * Y_SCALE, -448.f, 448.f);
                        float v2 = __builtin_amdgcn_fmed3f(acc[ai][bj][m][n][2] * Y_SCALE, -448.f, 448.f), v3 = __builtin_amdgcn_fmed3f(acc[ai][bj][m][n][3] * Y_SCALE, -448.f, 448.f);
                        int q = 0; q = __builtin_amdgcn_cvt_pk_fp8_f32(v0, v1, q, false); q = __builtin_amdgcn_cvt_pk_fp8_f32(v2, v3, q, true);
                        if (n == 0) pk[bj].x = (unsigned)q; else pk[bj].y = (unsigned)q;
                    }
                auto rx = __builtin_amdgcn_permlane16_swap(pk[0].x, pk[1].x, false, false); auto ry = __builtin_amdgcn_permlane16_swap(pk[0].y, pk[1].y, false, false);
                const u32x4 v = {rx[0], ry[0], rx[1], ry[1]};
                const int slot = rt * 256 + ai * 128 + wr * 64 + m * 16 + fr;
                if (MODE == 1) asm volatile("" :: "v"(v)); else if (slot < cnt_e) __builtin_nontemporal_store(v, (u32x4*)(yb + (size_t)slot * D));
            }
    } };
template <bool DUMMY, int MODE = 0> __device__ __forceinline__ void ph_moe_down(const MK& p, int bid, int nb, int tid_l) {
    int* tpre = (int*)(smem + MOE_AUX); int* rbase = tpre + 80;
    moe_tables(p, 4, tpre, rbase, tid_l);
    SchedDown S{&p, bid, nb, tid_l, DUMMY ? tpre[64] : tpre[65], tpre, rbase, 0}; EpiDown<MODE> E{&p, rbase};
    pg8::gemm<EpiDown<MODE>, SchedDown, false, true>(DE, S, E, tid_l);
}

#if DUP >= 21 && DUP <= 29
template <bool PERM_> struct EpiNull { static constexpr bool PERM = PERM_;
    __device__ __forceinline__ void operator()(const f32x4 (&acc)[2][2][4][2], const pg8::GUnit& u, int wr, int wc, int fr, int fq) const {
#pragma unroll
        for (int a = 0; a < 2; ++a)
#pragma unroll
            for (int b = 0; b < 2; ++b)
#pragma unroll
                for (int m = 0; m < 4; ++m) { asm volatile("" :: "v"(acc[a][b][m][0]), "v"(acc[a][b][m][1])); }
    } };
__device__ __forceinline__ void ph_probe_in(const MK& p, int bid, int nb, int tid_l) { SchedIn S{&p, bid, nb, tid_l}; EpiNull<false> E; pg8::gemm<EpiNull<false>, SchedIn, false, true>(D, S, E, tid_l); }
__device__ __forceinline__ void ph_probe_out(const MK& p, int bid, int nb, int tid_l) { SchedOut S{&p, bid, nb, tid_l}; EpiNull<true> E; pg8::gemm<EpiNull<true>, SchedOut, false, true>(D, S, E, tid_l); }
__device__ __forceinline__ void ph_probe_up(const MK& p, int bid, int nb, int tid_l) {
    int* tpre = (int*)(smem + MOE_AUX); int* rbase = tpre + 80; moe_tables(p, 2, tpre, rbase, tid_l);
    SchedUp S{&p, bid, nb, tid_l, tpre[65], tpre, rbase, 0}; EpiNull<true> E; pg8::gemm<EpiNull<true>, SchedUp, true, true>(D, S, E, tid_l); }
__device__ __forceinline__ void ph_probe_up_nostore(const MK& p, int bid, int nb, int tid_l) {
    int* tpre = (int*)(smem + MOE_AUX); int* rbase = tpre + 80; moe_tables(p, 2, tpre, rbase, tid_l);
    SchedUp S{&p, bid, nb, tid_l, tpre[65], tpre, rbase, 0}; EpiUpT<true> E{&p, rbase}; pg8::gemm<EpiUpT<true>, SchedUp, true, true>(D, S, E, tid_l); }
__device__ __forceinline__ void ph_probe_down(const MK& p, int bid, int nb, int tid_l) {
    int* tpre = (int*)(smem + MOE_AUX); int* rbase = tpre + 80; moe_tables(p, 4, tpre, rbase, tid_l);
    SchedDown S{&p, bid, nb, tid_l, tpre[65], tpre, rbase, 0}; EpiNull<true> E; pg8::gemm<EpiNull<true>, SchedDown, false, true>(DE, S, E, tid_l); }
#endif
template <bool DUMMY> __device__ __forceinline__ void ph_final(const MK& p, int bid, int nb, int tid_l) {
    const int wid = tid_l >> 6, lane = tid_l & 63;
    int* tpre = (int*)(smem + MOE_AUX); int* rbase = tpre + 80;
    moe_tables(p, 1, tpre, rbase, tid_l);
    for (int t = bid * 8 + wid; t < T; t += nb * 8) {
        const int b = t / SEQ;
        float f[16];
#pragma unroll
        for (int i = 0; i < 16; ++i) f[i] = 0.f;
#pragma unroll
        for (int k = 0; k < 9; ++k) {
            int row;
            if (k < 8) { const int id = p.tokmap()[(size_t)t * 8 + k], e = id >> 15, slot = id & (ECAP - 1); row = rbase[e] + slot; } else row = rbase[64] + t;
            const unsigned char* yr = p.Y() + (size_t)row * D + lane * 4;
#pragma unroll
            for (int q = 0; q < 4; ++q) {
                const int w = __builtin_nontemporal_load((const int*)(yr + q * 256));
                const auto lo = __builtin_amdgcn_cvt_pk_f32_fp8(w, false); const auto hi = __builtin_amdgcn_cvt_pk_f32_fp8(w, true);
                f[q * 4 + 0] += lo[0]; f[q * 4 + 1] += lo[1]; f[q * 4 + 2] += hi[0]; f[q * 4 + 3] += hi[1];
            }
        }
        const int pcol = ((lane >> 3) & 1) * 128 + (lane >> 4) * 32 + (lane & 7) * 4;
        const float* g2 = p.mod() + (size_t)b * 6 * D + 5 * D + pcol;
        const bf16_t* x1 = p.X1() + (size_t)t * 2048 + pcol;
        float* xo = p.out + (size_t)t * D + pcol;
        float v[16]; float ss = 0.f;
#pragma unroll
        for (int q = 0; q < 4; ++q) {
            const u32x2 xw = __builtin_nontemporal_load((const u32x2*)(x1 + q * 256)); const float4 g = *(const float4*)(g2 + q * 256);
            v[q * 4 + 0] = __uint_as_float(xw.x << 16) + g.x * f[q * 4 + 0] * (1.0f / Y_SCALE); v[q * 4 + 1] = __uint_as_float(xw.x & 0xffff0000u) + g.y * f[q * 4 + 1] * (1.0f / Y_SCALE);
            v[q * 4 + 2] = __uint_as_float(xw.y << 16) + g.z * f[q * 4 + 2] * (1.0f / Y_SCALE); v[q * 4 + 3] = __uint_as_float(xw.y & 0xffff0000u) + g.w * f[q * 4 + 3] * (1.0f / Y_SCALE);
            ss += v[q * 4] * v[q * 4] + v[q * 4 + 1] * v[q * 4 + 1] + v[q * 4 + 2] * v[q * 4 + 2] + v[q * 4 + 3] * v[q * 4 + 3];
        }
        ss = wave_sum(ss);
        const float rstd = rsqrtf(ss * (1.0f / D) + EPS);
#pragma unroll
        for (int q = 0; q < 4; ++q) {
            const float4 gf = *(const float4*)(p.final_g + q * 256 + pcol);
            { const f32x4 ov = {v[q * 4] * rstd * gf.x, v[q * 4 + 1] * rstd * gf.y, v[q * 4 + 2] * rstd * gf.z, v[q * 4 + 3] * rstd * gf.w};
              __builtin_nontemporal_store(ov, (f32x4*)((DUMMY ? (float*)(p.ws + 42 * MiB) + (size_t)t * D + pcol : xo) + q * 256)); }
        }
    }
}


#define XB_TMO      128
#define XB_XCNT(j)  (256  + 64 * (j))
#define XB_XSUB(j)  (1280 + 64 * (j))
#define XB_XGEN(j)  (2304 + 64 * (j))
#define XB_TOP      3328
#define XB_TOPGEN   3392
#define XCD_BAR_WORDS 3456
#define XB_SPIN_CAP (1u << 22)
#define LAS __attribute__((address_space(3)))
__device__ __forceinline__ unsigned xb_ld(unsigned* p)              { return __hip_atomic_load(p, __ATOMIC_RELAXED, __HIP_MEMORY_SCOPE_AGENT); }
__device__ __forceinline__ unsigned xb_add(unsigned* p, unsigned v) { return __hip_atomic_fetch_add(p, v, __ATOMIC_RELAXED, __HIP_MEMORY_SCOPE_AGENT); }
__device__ __forceinline__ unsigned xb_xcc_id() { return (unsigned)__builtin_amdgcn_s_getreg((3 << 11) | 20) & 0xFu; }
#define XB_SPIN(cond, bar) do { unsigned _sp = 0; while (cond) { __builtin_amdgcn_s_sleep(1); \
    if ((++_sp & 255u) == 0u) { if (xb_ld(&(bar)[XB_TMO])) break; if (_sp > XB_SPIN_CAP) { atomicAdd(&(bar)[XB_TMO], 1u); break; } } } } while (0)
struct XcdBarrier { unsigned* bar; unsigned x; volatile LAS unsigned* st; };
__device__ __forceinline__ XcdBarrier xcd_barrier_post(unsigned* bar, volatile LAS unsigned* st, int tid) {
    XcdBarrier b; b.bar = bar; b.x = xb_xcc_id(); b.st = st;
    if (tid == 0) (void)xb_add(&bar[XB_XCNT(b.x)], 1u);
    return b;
}
__device__ __forceinline__ void xcd_barrier_complete(unsigned* bar, unsigned x, unsigned& nloc, unsigned& nx) {
    const unsigned G = gridDim.x * gridDim.y * gridDim.z;
    unsigned sum, cnt, mine, sp = 0u;
    for (;;) {
        sum = 0u; cnt = 0u; mine = 0u;
#pragma unroll
        for (unsigned j = 0; j < 16; ++j) { const unsigned c = xb_ld(&bar[XB_XCNT(j)]); sum += c; cnt += (c > 0u) ? 1u : 0u; mine = (j == x) ? c : mine; }
        if (sum == G) break;
        __builtin_amdgcn_s_sleep(1);
        if ((++sp & 255u) == 0u) { if (xb_ld(&bar[XB_TMO])) break; if (sp > XB_SPIN_CAP) { atomicAdd(&bar[XB_TMO], 1u); break; } }
    }
    nloc = mine > 0u ? mine : 1u; nx = cnt > 0u ? cnt : 1u;
}
__device__ __forceinline__ void xcd_barrier(const XcdBarrier& b, int tid) {
    asm volatile("s_waitcnt vmcnt(0)" ::: "memory");
    __syncthreads();
    if (tid == 0) {
        unsigned* bar = b.bar;
        __builtin_amdgcn_s_waitcnt(0);
        unsigned nloc = b.st[0], nx = b.st[1];
        if (nloc == 0u) { xcd_barrier_complete(bar, b.x, nloc, nx); b.st[0] = nloc; b.st[1] = nx; }
        const unsigned old = xb_add(&bar[XB_XSUB(b.x)], 1u);
        const unsigned gen = old / nloc;
        if (old + 1u == (gen + 1u) * nloc) {
            __builtin_amdgcn_fence(__ATOMIC_RELEASE, "agent");
            asm volatile("s_waitcnt vmcnt(0)" ::: "memory");
            const unsigned og = xb_add(&bar[XB_TOP], 1u);
            const unsigned tg = og / nx;
            if (og + 1u == (tg + 1u) * nx) xb_add(&bar[XB_TOPGEN], 1u);
            else XB_SPIN(xb_ld(&bar[XB_TOPGEN]) == tg, bar);
            __builtin_amdgcn_fence(__ATOMIC_ACQUIRE, "agent");
            xb_add(&bar[XB_XGEN(b.x)], 1u);
            asm volatile("s_waitcnt vmcnt(0)" ::: "memory");
        } else {
            XB_SPIN(xb_ld(&bar[XB_XGEN(b.x)]) == gen, bar);
            __builtin_amdgcn_fence(__ATOMIC_ACQUIRE, "agent");
            asm volatile("s_waitcnt vmcnt(0)" ::: "memory");
        }
    }
    __syncthreads();
}

__device__ __forceinline__ int lane_id_volatile() { int l; asm volatile("v_mbcnt_lo_u32_b32 %0, -1, 0\n\tv_mbcnt_hi_u32_b32 %0, -1, %0" : "=v"(l)); return l; }
__global__ __launch_bounds__(512, 2) void k_mega(MK p) {
    cg::grid_group grid = cg::this_grid();
    const int bid = blockIdx.x, nb = gridDim.x;
    volatile LAS unsigned* xst = (volatile LAS unsigned*)(smem + 162816 + 768);
    if (threadIdx.x < 4) xst[threadIdx.x] = 0u;
    __syncthreads();
    const int wv_ = __builtin_amdgcn_readfirstlane((int)threadIdx.x >> 6);
#define LANE_ID() lane_id_volatile()
#define PH_TID() int t_ = wv_ * 64 + LANE_ID(); asm volatile("" : "+v"(t_))
    { PH_TID(); if (bid == 0 && t_ < 256) p.cnt()[t_] = 0;
      if (bid == 1 || nb == 1) { for (int i = t_; i < XCD_BAR_WORDS; i += 512) ((unsigned*)(p.ws + 524288))[i] = 0u; }
      ph_mod(p, bid, nb, t_); ph_convert(p, bid, nb, t_); }
#if DUP == 10
    { PH_TID(); ph_convert(p, bid, nb, t_); }
#endif
#if DUP == 12
    { PH_TID(); ph_mod(p, bid, nb, t_); }
#endif
    grid.sync();
    const XcdBarrier xb = xcd_barrier_post((unsigned*)(p.ws + 524288), xst, wv_ * 64 + LANE_ID());
    { PH_TID(); ph_ln1(p, bid, nb, t_); }
#if DUP == 1
    { PH_TID(); ph_ln1(p, bid, nb, t_); }
#endif
    xcd_barrier(xb, wv_ * 64 + LANE_ID());
    { PH_TID(); ph_gemm_in(p, bid, nb, t_); }
    { PH_TID(); ph_convert_dyn(p, t_); }
#if DUP == 2
    { PH_TID(); ph_gemm_in(p, bid, nb, t_); }
#endif
#if DUP == 21
    { PH_TID(); ph_probe_in(p, bid, nb, t_); }
#endif
    xcd_barrier(xb, wv_ * 64 + LANE_ID());
    { PH_TID(); ph_attn<0>(p, bid, nb, t_); }
#if DUP == 3
    { PH_TID(); ph_attn<2>(p, bid, nb, t_); }
#endif
#if DUP == 31
    { PH_TID(); ph_attn<1>(p, bid, nb, t_); }
#endif
#if DUP == 33
    { PH_TID(); ph_attn<3>(p, bid, nb, t_); }
#endif
    { PH_TID(); ph_kv(p, bid, nb, t_); }
#if DUP == 11
    { PH_TID(); ph_kv(p, bid, nb, t_); }
#endif
    xcd_barrier(xb, wv_ * 64 + LANE_ID());
    { PH_TID(); ph_scan(p, bid, nb, t_); }
#if DUP == 4
    { PH_TID(); ph_scan(p, bid, nb, t_); }
#endif
    xcd_barrier(xb, wv_ * 64 + LANE_ID());
    { PH_TID(); ph_ret(p, bid, nb, t_); }
#if DUP == 5
    { PH_TID(); ph_ret(p, bid, nb, t_); }
#endif
    xcd_barrier(xb, wv_ * 64 + LANE_ID());
    { PH_TID(); ph_gemm_out(p, bid, nb, t_); }
#if DUP == 6
    { PH_TID(); ph_gemm_out(p, bid, nb, t_); }
#endif
#if DUP == 22
    { PH_TID(); ph_probe_out(p, bid, nb, t_); }
#endif
    xcd_barrier(xb, wv_ * 64 + LANE_ID());
#if DUP == 7
    { PH_TID(); ph_route<true>(p, bid, nb, t_); }
#endif
#if DUP == 72
    { PH_TID(); ph_route<true, 2>(p, bid, nb, t_); }
#endif
#if DUP == 73
    { PH_TID(); ph_route<true, 3>(p, bid, nb, t_); }
#endif
    { PH_TID(); ph_route<false>(p, bid, nb, t_); }
    xcd_barrier(xb, wv_ * 64 + LANE_ID());
    { PH_TID(); ph_moe_up(p, bid, nb, t_); }
#if DUP == 8
    { PH_TID(); ph_moe_up(p, bid, nb, t_); }
#endif
#if DUP == 23
    { PH_TID(); ph_probe_up(p, bid, nb, t_); }
#endif
#if DUP == 25
    { PH_TID(); ph_probe_up_nostore(p, bid, nb, t_); }
#endif
    xcd_barrier(xb, wv_ * 64 + LANE_ID());
#if DUP == 9
    { PH_TID(); ph_moe_down<true>(p, bid, nb, t_); }
#endif
#if DUP == 91
    { PH_TID(); ph_moe_down<true, 1>(p, bid, nb, t_); }
#endif
    { PH_TID(); ph_moe_down<false>(p, bid, nb, t_); }
#if DUP == 24
    { PH_TID(); ph_probe_down(p, bid, nb, t_); }
#endif
    xcd_barrier(xb, wv_ * 64 + LANE_ID());
#if DUP == 13
    { PH_TID(); ph_final<true>(p, bid, nb, t_); }
#endif
    { PH_TID(); ph_final<false>(p, bid, nb, t_); }
#undef PH_TID
#undef LANE_ID
}
constexpr int LDS_TOTAL = 163840;
extern "C" void kernel_launch(void* const* d_in, const int* in_sizes, int n_in, void* d_out, int out_size, void* d_ws, size_t ws_size, hipStream_t stream) {
    char* ws = (char*)d_ws;
    MK mk{};
    mk.x = (const float*)d_in[0]; mk.c = (const float*)d_in[1]; mk.ctx = (const float*)d_in[2]; mk.cctx = (const float*)d_in[3]; mk.ada_w = (const float*)d_in[4]; mk.ada_b = (const float*)d_in[5];
    mk.norm1_g = (const float*)d_in[6]; mk.w_in = (const float*)d_in[7]; mk.lq1 = (const float*)d_in[8]; mk.lk1 = (const float*)d_in[9]; mk.lq2 = (const float*)d_in[10]; mk.lk2 = (const float*)d_in[11];
    mk.dattn_g = (const float*)d_in[12]; mk.dec_f = (const float*)d_in[13]; mk.dec_b = (const float*)d_in[14]; mk.ret_g = (const float*)d_in[15]; mk.w_out = (const float*)d_in[16];
    mk.norm2_g = (const float*)d_in[17]; mk.router_w = (const float*)d_in[18]; mk.router_b = (const float*)d_in[19]; mk.ew1 = (const float*)d_in[20]; mk.ew3 = (const float*)d_in[21];
    mk.ew2 = (const float*)d_in[22]; mk.sw1 = (const float*)d_in[23]; mk.sw3 = (const float*)d_in[24]; mk.sw2 = (const float*)d_in[25]; mk.final_g = (const float*)d_in[26];
    mk.out = (float*)d_out;
    mk.ws = ws;
    mk.dbgP = nullptr; mk.dbg_lo = 0; mk.dbg_hi = 12; mk.conv_limit = 1 << 30;
    static int grid_blocks = 0;
    if (!grid_blocks) {
        (void)hipFuncSetAttribute((const void*)k_mega, hipFuncAttributeMaxDynamicSharedMemorySize, LDS_TOTAL);
        int dev = 0, cus = 0, per_cu = 0;
        (void)hipGetDevice(&dev);
        (void)hipDeviceGetAttribute(&cus, hipDeviceAttributeMultiprocessorCount, dev);
        (void)hipOccupancyMaxActiveBlocksPerMultiprocessor(&per_cu, k_mega, 512, LDS_TOTAL);
        if (per_cu > 1) per_cu = 1;
        grid_blocks = cus * per_cu;
        if (grid_blocks <= 0) { fprintf(stderr, "occupancy query failed: cus %d per_cu %d\n", cus, per_cu); grid_blocks = 256; }
    }
    void* args[] = {&mk};
    hipError_t e = hipLaunchCooperativeKernel((void*)k_mega, dim3(grid_blocks), dim3(512), args, LDS_TOTAL, stream);
    if (e != hipSuccess) fprintf(stderr, "cooperative launch failed: %s (grid %d)\n", hipGetErrorString(e), grid_blocks);
}
```
